# Optimizing an MI355X kernel written in HIP

```python
import math
import jax
import jax.numpy as jnp
from jax import lax
import numpy as np

D_MODEL = 1024
BATCH = 32
SEQ = 2048
DEPTH = 2

HEAD_DIM = 64
ROT_DIM = HEAD_DIM // 4
ROPE_THETA = 500000.0
QBLOCK = 128
EPS = 1e-6

MLA_HEADS = 8
MLA_Q_RANK = 256
MLA_KV_RANK = 128
MLA_NOPE = 64
MLA_ROPE = 32
MLA_V = 64

DIL_GROUPS = ((128, 1), (512, 4), (2048, 16))
DIL_HEADS = 4

DSA_HEADS = 8
IDX_HEADS = 8
IDX_DIM = 64
TOPK_MAX = 256

IN_SIZES = (MLA_Q_RANK, MLA_KV_RANK, MLA_ROPE,
            3 * DIL_HEADS * HEAD_DIM, 3 * DIL_HEADS * HEAD_DIM, 3 * DIL_HEADS * HEAD_DIM,
            DSA_HEADS * HEAD_DIM, HEAD_DIM, HEAD_DIM, IDX_HEADS * IDX_DIM, IDX_DIM, IDX_HEADS)
C_IN = sum(IN_SIZES)
N_BRANCH = 3

N_GROUPS = 4
EXPERTS_PER_GROUP = 8
N_EXPERTS = N_GROUPS * EXPERTS_PER_GROUP
TOP_K_SUB = 2
D_EXPERT = 256

kernel_name = "hybrid_mla_dilated_dsa_hmoe_deepnorm"

F32 = jnp.float32


def layer_norm(x, g, b):
    xf = x.astype(F32)
    mu = jnp.mean(xf, axis=-1, keepdims=True)
    xc = xf - mu
    var = jnp.mean(xc * xc, axis=-1, keepdims=True)
    return (xc * lax.rsqrt(var + EPS) * g + b).astype(x.dtype)


def rms_norm(x, g):
    xf = x.astype(F32)
    return (xf * lax.rsqrt(jnp.mean(xf * xf, axis=-1, keepdims=True) + EPS) * g).astype(x.dtype)


def rope_tables(seq, rot_dim):
    inv = ROPE_THETA ** (-jnp.arange(0, rot_dim, 2, dtype=F32) / rot_dim)
    ang = jnp.arange(seq, dtype=F32)[:, None] * inv[None, :]
    return jnp.cos(ang), jnp.sin(ang)


def apply_rope(x, cos, sin):
    half = cos.shape[-1]
    rot = 2 * half
    shape = (1, x.shape[1]) + (1,) * (x.ndim - 3) + (half,)
    c = cos.reshape(shape)
    s = sin.reshape(shape)
    x1 = x[..., :half].astype(F32)
    x2 = x[..., half:rot].astype(F32)
    return jnp.concatenate([(x1 * c - x2 * s).astype(x.dtype),
                            (x2 * c + x1 * s).astype(x.dtype),
                            x[..., rot:]], axis=-1)


def causal_mask(lo, hi):
    return (lo + jnp.arange(hi - lo))[:, None] >= jnp.arange(hi)[None, :]


def mla_branch(c_q, c_kv, k_rope, q_norm_g, w_uq, kv_norm_g, w_ukv, cos_m, sin_m):
    B, S, _ = c_q.shape
    q = (rms_norm(c_q, q_norm_g) @ w_uq).reshape(B, S, MLA_HEADS, MLA_NOPE + MLA_ROPE)
    q_nope = q[..., :MLA_NOPE]
    q_rope = apply_rope(q[..., MLA_NOPE:], cos_m, sin_m)
    kv = (rms_norm(c_kv, kv_norm_g) @ w_ukv).reshape(B, S, MLA_HEADS, MLA_NOPE + MLA_V)
    k_nope = kv[..., :MLA_NOPE]
    v = kv[..., MLA_NOPE:]
    k_rope = apply_rope(k_rope, cos_m, sin_m)
    scale = (MLA_NOPE + MLA_ROPE) ** -0.5
    outs = []
    for i in range(S // QBLOCK):
        lo, hi = i * QBLOCK, (i + 1) * QBLOCK
        s = (jnp.einsum('bqhd,bkhd->bhqk', q_nope[:, lo:hi], k_nope[:, :hi])
             + jnp.einsum('bqhr,bkr->bhqk', q_rope[:, lo:hi], k_rope[:, :hi])).astype(F32) * scale
        s = jnp.where(causal_mask(lo, hi), s, -jnp.inf)
        p = jax.nn.softmax(s, axis=-1).astype(v.dtype)
        outs.append(jnp.einsum('bhqk,bkhd->bqhd', p, v[:, :hi]))
    return jnp.concatenate(outs, axis=1).reshape(B, S, MLA_HEADS * MLA_V)


def dilated_group(q, k, v, window, dilation):
    B, S, H, hd = q.shape
    band = window // dilation
    M = S // dilation
    nblk = -(-M // band)
    Mp = nblk * band

    def lattice(t):
        t = t.reshape(B, M, dilation, H, hd).transpose(0, 2, 1, 3, 4)
        t = jnp.pad(t, ((0, 0), (0, 0), (0, Mp - M), (0, 0), (0, 0)))
        return t.reshape(B, dilation, nblk, band, H, hd)

    def with_prev(t):
        prev = jnp.pad(t[:, :, :-1], ((0, 0), (0, 0), (1, 0), (0, 0), (0, 0), (0, 0)))
        return jnp.concatenate([prev, t], axis=3)

    ql = lattice(q)
    kb = with_prev(lattice(k))
    vb = with_prev(lattice(v))
    s = jnp.einsum('brnqhd,brnkhd->brnhqk', ql, kb).astype(F32) * (hd ** -0.5)
    dist = (band + jnp.arange(band))[:, None] - jnp.arange(2 * band)[None, :]
    in_band = (dist >= 0) & (dist <= band)
    has_prev = (jnp.arange(nblk) > 0)[:, None, None] | (jnp.arange(2 * band) >= band)[None, None, :]
    mask = in_band[None] & has_prev
    s = jnp.where(mask[None, None, :, None], s, -jnp.inf)
    lse = jax.nn.logsumexp(s, axis=-1)
    p = jnp.exp(s - lse[..., None]).astype(v.dtype)
    o = jnp.einsum('brnhqk,brnkhd->brnqhd', p, vb)
    o = o.reshape(B, dilation, Mp, H, hd)[:, :, :M].transpose(0, 2, 1, 3, 4).reshape(B, S, H, hd)
    lse = lse.transpose(0, 1, 2, 4, 3).reshape(B, dilation, Mp, H)[:, :, :M]
    lse = lse.transpose(0, 2, 1, 3).reshape(B, S, H)
    return o, lse


def dilated_branch(group_cols, cos_p, sin_p):
    outs, lses = [], []
    for (window, dilation), cols in zip(DIL_GROUPS, group_cols):
        B, S, _ = cols.shape
        qkv = cols.reshape(B, S, 3, DIL_HEADS, HEAD_DIM)
        q = apply_rope(qkv[:, :, 0], cos_p, sin_p)
        k = apply_rope(qkv[:, :, 1], cos_p, sin_p)
        o, lse = dilated_group(q, k, qkv[:, :, 2], window, dilation)
        outs.append(o)
        lses.append(lse)
    w = jax.nn.softmax(jnp.stack(lses, axis=0), axis=0).astype(outs[0].dtype)
    o = jnp.einsum('gbsh,gbshd->bshd', w, jnp.stack(outs, axis=0))
    return o.reshape(B, S, DIL_HEADS * HEAD_DIM)


def dsa_branch(q, k, v, iq, ik, iw, cos_p, sin_p):
    B, S, _ = q.shape
    q = apply_rope(q.reshape(B, S, DSA_HEADS, HEAD_DIM), cos_p, sin_p)
    k = apply_rope(k, cos_p, sin_p)
    iq = apply_rope(iq.reshape(B, S, IDX_HEADS, IDX_DIM), cos_p, sin_p)
    ik = apply_rope(ik, cos_p, sin_p)
    iw = iw.astype(F32) * (IDX_HEADS ** -0.5 * IDX_DIM ** -0.5)
    top = min(TOPK_MAX, S // 4)
    gather = jax.vmap(lambda t, i: t[i])
    outs = []
    for i in range(S // QBLOCK):
        lo, hi = i * QBLOCK, (i + 1) * QBLOCK
        kk = min(top, hi)
        rel = jax.nn.relu(jnp.einsum('bqhd,bsd->bqhs', iq[:, lo:hi], ik[:, :hi]).astype(F32))
        score = jnp.einsum('bqh,bqhs->bqs', iw[:, lo:hi], rel)
        score = jnp.where(causal_mask(lo, hi)[None], score, -jnp.inf)
        _, idx = lax.top_k(score, kk)
        kg = gather(k[:, :hi], idx)
        vg = gather(v[:, :hi], idx)
        s = jnp.einsum('bqhd,bqkd->bqhk', q[:, lo:hi], kg).astype(F32) * (HEAD_DIM ** -0.5)
        ok = idx <= (lo + jnp.arange(QBLOCK))[None, :, None]
        s = jnp.where(ok[:, :, None, :], s, -jnp.inf)
        p = jax.nn.softmax(s, axis=-1).astype(v.dtype)
        outs.append(jnp.einsum('bqhk,bqkd->bqhd', p, vg))
    return jnp.concatenate(outs, axis=1).reshape(B, S, DSA_HEADS * HEAD_DIM)


def token_mixer(x, w_in, q_norm_g, w_uq, kv_norm_g, w_ukv, w_gate, b_gate, w_a, w_b, w_c, w_o,
                cos_m, sin_m, cos_p, sin_p):
    B, S, D = x.shape
    split_points = tuple(int(v) for v in np.cumsum(IN_SIZES)[:-1])
    parts = jnp.split(x @ w_in, split_points, axis=-1)
    c_q, c_kv, k_r = parts[0], parts[1], parts[2]
    dil_cols = parts[3:6]
    cq, ck, cv, iq, ik, iw = parts[6:12]
    o_a = mla_branch(c_q, c_kv, k_r, q_norm_g, w_uq, kv_norm_g, w_ukv, cos_m, sin_m)
    o_b = dilated_branch(dil_cols, cos_p, sin_p)
    o_c = dsa_branch(cq, ck, cv, iq, ik, iw, cos_p, sin_p)
    g = jax.nn.sigmoid((x @ w_gate + b_gate).astype(F32)).astype(x.dtype).reshape(B, S, N_BRANCH, D)
    merged = g[:, :, 0] * (o_a @ w_a) + g[:, :, 1] * (o_b @ w_b) + g[:, :, 2] * (o_c @ w_c)
    return merged @ w_o


def hier_moe(x, w_group, b_group, w_sub, b_sub, w1, w3, w2):
    B, S, D = x.shape
    T = B * S
    t = x.reshape(T, D)
    g_prob = jax.nn.softmax((t @ w_group + b_group).astype(F32), axis=-1)
    g_p, g_idx = lax.top_k(g_prob, 1)
    sub = (t @ w_sub + b_sub).astype(F32).reshape(T, N_GROUPS, EXPERTS_PER_GROUP)
    sub = jnp.take_along_axis(sub, g_idx[:, :, None], axis=1)[:, 0]
    e_val, e_idx = lax.top_k(sub, TOP_K_SUB)
    e_w = jax.nn.softmax(e_val, axis=-1) * g_p
    expert = g_idx * EXPERTS_PER_GROUP + e_idx
    combine = jnp.einsum('tk,tke->te', e_w, jax.nn.one_hot(expert, N_EXPERTS, dtype=F32))
    combine = combine.astype(x.dtype)
    y = jnp.zeros_like(t)
    for e in range(N_EXPERTS):
        h = jax.nn.silu(t @ w1[e]) * (t @ w3[e])
        y = y + combine[:, e:e + 1] * (h @ w2[e])
    return y.reshape(B, S, D)


def setup_inputs(seed: int = 0) -> dict:
    key = jax.random.key(seed)
    ks = jax.random.split(key, 24)
    L, D = DEPTH, D_MODEL
    beta = (8 * DEPTH) ** -0.25

    def nrm(k, shape, scale):
        return jax.random.normal(k, shape, F32) * scale

    return {
        "x": nrm(ks[0], (BATCH, SEQ, D), 1.0),
        "w_in": nrm(ks[1], (L, D, C_IN), D ** -0.5),
        "q_norm_g": 1.0 + nrm(ks[2], (L, MLA_Q_RANK), 0.01),
        "w_uq": nrm(ks[3], (L, MLA_Q_RANK, MLA_HEADS * (MLA_NOPE + MLA_ROPE)), MLA_Q_RANK ** -0.5),
        "kv_norm_g": 1.0 + nrm(ks[4], (L, MLA_KV_RANK), 0.01),
        "w_ukv": nrm(ks[5], (L, MLA_KV_RANK, MLA_HEADS * (MLA_NOPE + MLA_V)), MLA_KV_RANK ** -0.5),
        "w_gate": nrm(ks[6], (L, D, N_BRANCH * D), D ** -0.5),
        "b_gate": nrm(ks[7], (L, N_BRANCH * D), 0.01),
        "w_a": nrm(ks[8], (L, MLA_HEADS * MLA_V, D), beta * (MLA_HEADS * MLA_V) ** -0.5),
        "w_b": nrm(ks[9], (L, DIL_HEADS * HEAD_DIM, D), beta * (DIL_HEADS * HEAD_DIM) ** -0.5),
        "w_c": nrm(ks[10], (L, DSA_HEADS * HEAD_DIM, D), beta * (DSA_HEADS * HEAD_DIM) ** -0.5),
        "w_o": nrm(ks[11], (L, D, D), beta * D ** -0.5),
        "ln1_g": 1.0 + nrm(ks[12], (L, D), 0.01),
        "ln1_b": nrm(ks[13], (L, D), 0.01),
        "w_group": nrm(ks[14], (L, D, N_GROUPS), D ** -0.5),
        "b_group": nrm(ks[15], (L, N_GROUPS), 0.01),
        "w_sub": nrm(ks[16], (L, D, N_EXPERTS), D ** -0.5),
        "b_sub": nrm(ks[17], (L, N_EXPERTS), 0.01),
        "w1": nrm(ks[18], (L, N_EXPERTS, D, D_EXPERT), D ** -0.5),
        "w3": nrm(ks[19], (L, N_EXPERTS, D, D_EXPERT), D ** -0.5),
        "w2": nrm(ks[20], (L, N_EXPERTS, D_EXPERT, D), beta * D_EXPERT ** -0.5),
        "ln2_g": 1.0 + nrm(ks[21], (L, D), 0.01),
        "ln2_b": nrm(ks[22], (L, D), 0.01),
    }


def reference(x, w_in, q_norm_g, w_uq, kv_norm_g, w_ukv, w_gate, b_gate, w_a, w_b, w_c, w_o,
              ln1_g, ln1_b, w_group, b_group, w_sub, b_sub, w1, w3, w2, ln2_g, ln2_b):
    S = x.shape[1]
    alpha = (2 * DEPTH) ** 0.25
    cos_m, sin_m = rope_tables(S, MLA_ROPE)
    cos_p, sin_p = rope_tables(S, ROT_DIM)
    for l in range(DEPTH):
        mix = token_mixer(x, w_in[l], q_norm_g[l], w_uq[l], kv_norm_g[l], w_ukv[l], w_gate[l],
                          b_gate[l], w_a[l], w_b[l], w_c[l], w_o[l], cos_m, sin_m, cos_p, sin_p)
        x = layer_norm(alpha * x + mix, ln1_g[l], ln1_b[l])
        ffn = hier_moe(x, w_group[l], b_group[l], w_sub[l], b_sub[l], w1[l], w3[l], w2[l])
        x = layer_norm(alpha * x + ffn, ln2_g[l], ln2_b[l])
    return x
```

```cpp
#include <hip/hip_runtime.h>
#include <cstdio>
#include <cstdint>

#define LAS __attribute__((address_space(3)))
#define GAS __attribute__((address_space(1)))
typedef unsigned short bf16_t;
typedef short bf16x8 __attribute__((ext_vector_type(8)));
typedef float f32x4 __attribute__((ext_vector_type(4)));
typedef float f32x2 __attribute__((ext_vector_type(2)));
typedef float f32x16 __attribute__((ext_vector_type(16)));
typedef unsigned u32x4 __attribute__((ext_vector_type(4)));
typedef unsigned u32x2 __attribute__((ext_vector_type(2)));

constexpr int DM = 1024, NB = 32, SEQ = 2048, TT = NB * SEQ;
constexpr int NEXP = 32, DEXP = 256;
constexpr float LN_EPS = 1e-6f;
constexpr float ALPHA = 1.41421356237309515f;
constexpr int NWAVES = 8, NTHREADS = 512;

__device__ __forceinline__ unsigned f2bf(float f) { unsigned u = __builtin_bit_cast(unsigned, f); return (u + 0x7fffu + ((u >> 16) & 1u)) >> 16; }
__device__ __forceinline__ unsigned pk2(float lo, float hi) { return f2bf(lo) | (f2bf(hi) << 16); }
__device__ __forceinline__ float bf2f(unsigned short b) { return __builtin_bit_cast(float, (unsigned)b << 16); }
__device__ __forceinline__ float bflo(unsigned w) { return __builtin_bit_cast(float, w << 16); }
__device__ __forceinline__ float bfhi(unsigned w) { return __builtin_bit_cast(float, w & 0xffff0000u); }
typedef __bf16 bf16x2_t __attribute__((ext_vector_type(2)));
__device__ __forceinline__ unsigned cvt_pk_bf16(float lo, float hi) { const f32x2 v = {lo, hi}; const bf16x2_t b = __builtin_convertvector(v, bf16x2_t); return __builtin_bit_cast(unsigned, b); }
__device__ __forceinline__ float wave_sum(float v) {
#pragma unroll
    for (int o = 1; o < 64; o <<= 1) v += __shfl_xor(v, o);
    return v;
}
__device__ __forceinline__ float fast_exp(float x) { return __builtin_amdgcn_exp2f(x * 1.4426950408889634f); }
__device__ __forceinline__ float sigmoidf_(float x) { return __builtin_amdgcn_rcpf(1.0f + fast_exp(-x)); }
__device__ __forceinline__ unsigned pk4_fp8(float a, float b, float c, float d) {
    int p = __builtin_amdgcn_cvt_pk_fp8_f32(a, b, 0, false); p = __builtin_amdgcn_cvt_pk_fp8_f32(c, d, p, true); return (unsigned)p; }
__device__ __forceinline__ void store8_fp8(unsigned char* p, const f32x4& v0, const f32x4& v1, float sc) {
    u32x2 w; w.x = pk4_fp8(v0[0] * sc, v0[1] * sc, v0[2] * sc, v0[3] * sc); w.y = pk4_fp8(v1[0] * sc, v1[1] * sc, v1[2] * sc, v1[3] * sc); *(u32x2*)p = w;
}
#define LDS_WAIT() asm volatile("s_waitcnt lgkmcnt(0)" ::: "memory")
#define VM_WAIT() asm volatile("s_waitcnt vmcnt(0)" ::: "memory")

namespace pg8 {
constexpr int BM = 256, BK = 64, HALF = 128, HTB = HALF * BK * 2, STAGE_BYTES = 8 * HTB;
__device__ __forceinline__ int lds_byte(int r, int c) { return r * 128 + ((((c >> 3) ^ (r >> 1)) & 7) * 16) + (c & 7) * 2; }
__device__ __forceinline__ void stage_rc(int b, int& R, int& C) { R = b >> 7; C = ((((b >> 4) ^ (R >> 1)) & 7)) * 8; }
__device__ __forceinline__ int perm32(int rho) { const int n = rho >> 4, i = rho & 15; return 8 * (i >> 2) + 4 * n + (i & 3); }
struct Unit { int pm, pn, ord; };

template <class S, class = void> struct SchedVarK { static constexpr bool value = false; };
template <class S> struct SchedVarK<S, decltype((void)S::VARK)> { static constexpr bool value = S::VARK; };
typedef int v4i_t __attribute__((ext_vector_type(4)));
typedef int v8i_t __attribute__((ext_vector_type(8)));
__device__ __forceinline__ v8i_t cat8(const bf16x8& lo, const bf16x8& hi) { return __builtin_shufflevector(__builtin_bit_cast(v4i_t, lo), __builtin_bit_cast(v4i_t, hi), 0, 1, 2, 3, 4, 5, 6, 7); }
template <class Epi, class Sched, bool ALIGN_EPI, bool F8 = false>
__device__ __forceinline__ void gemm_phase(LAS unsigned char* lds, const int K, const Sched& S, const Epi& E) {
    int tid_ = threadIdx.x; asm volatile("" : "+v"(tid_));
    const int tid = tid_, wid = __builtin_amdgcn_readfirstlane(tid >> 6), lane = tid & 63, wr = wid >> 2, wc = wid & 3, fr = lane & 15, fq = lane >> 4;
    int nt = K / BK;
    int Rr[2], Cc[2]; unsigned vB[2][2];
#pragma unroll
    for (int i = 0; i < 2; ++i) { stage_rc(tid * 16 + i * 8192, Rr[i], Cc[i]); const int Rb = (Rr[i] & ~31) + perm32(Rr[i] & 31);
        vB[0][i] = (unsigned)(Rb * S.ldb + Cc[i]) * 2u; vB[1][i] = (unsigned)((HALF + Rb) * S.ldb + Cc[i]) * 2u; }
    const size_t kstep = (size_t)(BK * 2);
    const unsigned ldsw = (unsigned)wid * 1024u;
    const int aoff = lds_byte(wr * 64 + fr, fq * 8), boff = lds_byte(wc * 32 + fr, fq * 8);
    const int aoff1 = lds_byte(wr * 64 + fr, fq * 8 + 32), boff1 = lds_byte(wc * 32 + fr, fq * 8 + 32);
#define PG8_SA(b, h) (((b) * 2 + (h)) * HTB)
#define PG8_SB(b, h) ((4 + (b) * 2 + (h)) * HTB)
#define PG8_STAGE(bufoff, gbase, voff) do { _Pragma("unroll") for (int _i = 0; _i < 2; ++_i) \
        __builtin_amdgcn_global_load_lds((const unsigned*)((const char*)(gbase) + (voff)[_i]), (LAS unsigned*)(lds + (bufoff) + ldsw + _i * 8192), 16, 0, 0); } while (0)
#define PG8_LDA(dst, b, h) do { _Pragma("unroll") for (int m = 0; m < 4; ++m) { \
        const bf16x8 f0_ = *(const LAS bf16x8*)(lds + PG8_SA(b, h) + aoff + m * 2048), f1_ = *(const LAS bf16x8*)(lds + PG8_SA(b, h) + aoff1 + m * 2048); \
        if constexpr (F8) dst##8[m] = cat8(f0_, f1_); else { dst[m][0] = f0_; dst[m][1] = f1_; } } } while (0)
#define PG8_LDB(dst, b, h) do { _Pragma("unroll") for (int n = 0; n < 2; ++n) { \
        const bf16x8 f0_ = *(const LAS bf16x8*)(lds + PG8_SB(b, h) + boff + n * 2048), f1_ = *(const LAS bf16x8*)(lds + PG8_SB(b, h) + boff1 + n * 2048); \
        if constexpr (F8) dst##8[n] = cat8(f0_, f1_); else { dst[n][0] = f0_; dst[n][1] = f1_; } } } while (0)
#define PG8_MMA(ai, bj, At, Bt) do { __builtin_amdgcn_s_setprio(1); \
        if constexpr (F8) { _Pragma("unroll") for (int m = 0; m < 4; ++m) _Pragma("unroll") for (int n = 0; n < 2; ++n) \
            asm volatile("v_mfma_scale_f32_16x16x128_f8f6f4 %0, %1, %2, %0, %3, %4 op_sel_hi:[0,0,0]" : "+v"(acc[ai][bj][m][n]) : "v"(Bt##8[n]), "v"(At##8[m]), "v"(scw8), "v"(sca8)); } \
              \
        else { _Pragma("unroll") for (int m = 0; m < 4; ++m) _Pragma("unroll") for (int n = 0; n < 2; ++n) _Pragma("unroll") for (int k = 0; k < 2; ++k) \
            acc[ai][bj][m][n] = __builtin_amdgcn_mfma_f32_16x16x32_bf16(Bt[n][k], At[m][k], acc[ai][bj][m][n], 0, 0, 0); } \
        __builtin_amdgcn_s_setprio(0); } while (0)
#define PG8_WAIT_V(n) asm volatile("s_waitcnt vmcnt(" #n ")" ::: "memory")
#define PG8_WAIT_L(n) asm volatile("s_waitcnt lgkmcnt(" #n ")" ::: "memory")
#define PG8_BAR __builtin_amdgcn_s_barrier()
#define PG8_SCHED __builtin_amdgcn_sched_barrier(0)
    int scw8 = 0, sca8 = 0;
    if constexpr (F8) { scw8 = S.sw8 * 0x01010101; sca8 = S.sa8 * 0x01010101; }
    Unit cur, nxt; int ui = 0;
    if (!S.next(0, cur)) return;
    f32x4 acc[2][2][4][2];
#pragma unroll
    for (int a = 0; a < 2; ++a)
#pragma unroll
        for (int b = 0; b < 2; ++b)
#pragma unroll
            for (int m = 0; m < 4; ++m)
#pragma unroll
                for (int n = 0; n < 2; ++n) acc[a][b][m][n] = (f32x4){0.f, 0.f, 0.f, 0.f};
    bf16x8 At[4][2], B0[2][2], B1[2][2]; v8i_t At8[4], B08[2], B18[2];
    unsigned vAc[2][2], vAn[2][2];
    const char* cA = S.a_base(cur); const char* cB = S.b_base(cur);
    S.a_off(cur, Rr, Cc, vAc);
    if constexpr (SchedVarK<Sched>::value) nt = S.ktiles(cur);
    PG8_STAGE(PG8_SB(0, 0), cB, vB[0]); PG8_STAGE(PG8_SB(0, 1), cB, vB[1]); PG8_STAGE(PG8_SA(0, 0), cA, vAc[0]); PG8_STAGE(PG8_SA(0, 1), cA, vAc[1]);
    if (wr == 1) PG8_BAR;
    PG8_WAIT_V(2); PG8_BAR;
    PG8_STAGE(PG8_SB(1, 0), cB + kstep, vB[0]); PG8_STAGE(PG8_SA(1, 0), cA + kstep, vAc[0]); PG8_STAGE(PG8_SB(1, 1), cB + kstep, vB[1]);
    PG8_WAIT_V(6); PG8_BAR;
    bool epi_pend = false;
    for (;;) {
        const bool has_next = S.next(ui + 1, nxt);
        const char* nA = cA; const char* nB = cB;
        if constexpr (Sched::GATHER) {
#pragma unroll
            for (int h = 0; h < 2; ++h)
#pragma unroll
                for (int i = 0; i < 2; ++i) vAn[h][i] = vAc[h][i];
        }
        if (has_next) { nA = S.a_base(nxt); nB = S.b_base(nxt); if constexpr (Sched::GATHER) S.a_off(nxt, Rr, Cc, vAn); }
#pragma nounroll
        for (int t = 0; t < nt; t += 2) {
            const bool last = (t == nt - 2);
            const bool ep_ = epi_pend && t == 0;
            const char* a1 = cA + (size_t)(t + 1) * kstep;
            const char* a2 = last ? nA : cA + (size_t)(t + 2) * kstep; const char* b2 = last ? nB : cB + (size_t)(t + 2) * kstep;
            const char* a3 = a2 + kstep; const char* b3 = b2 + kstep;
            unsigned vA2[2][2];
#pragma unroll
            for (int h = 0; h < 2; ++h)
#pragma unroll
                for (int i = 0; i < 2; ++i) { if constexpr (Sched::GATHER) vA2[h][i] = last ? vAn[h][i] : vAc[h][i]; else vA2[h][i] = vAc[h][i]; }
            PG8_LDB(B0, 0, 0); PG8_LDB(B1, 0, 1); PG8_SCHED; PG8_LDA(At, 0, 0); PG8_STAGE(PG8_SA(1, 1), a1, vAc[1]);
            if (ep_) { PG8_WAIT_V(24); } else { PG8_WAIT_V(8); } PG8_WAIT_L(0); PG8_BAR; PG8_MMA(0, 0, At, B0); PG8_MMA(0, 1, At, B1); PG8_BAR; PG8_SCHED;
            PG8_LDA(At, 0, 1); PG8_STAGE(PG8_SB(0, 0), b2, vB[0]); PG8_STAGE(PG8_SB(0, 1), b2, vB[1]); PG8_STAGE(PG8_SA(0, 0), a2, vA2[0]);
            if (ep_) { PG8_WAIT_V(24); } else { PG8_WAIT_V(8); } PG8_WAIT_L(0); PG8_BAR; PG8_MMA(1, 0, At, B0); PG8_MMA(1, 1, At, B1); PG8_BAR; PG8_SCHED;
            PG8_LDB(B0, 1, 0); PG8_LDB(B1, 1, 1); PG8_SCHED; PG8_LDA(At, 1, 0); PG8_STAGE(PG8_SA(0, 1), a2, vA2[1]);
            PG8_WAIT_V(8); PG8_WAIT_L(0); PG8_BAR; PG8_MMA(0, 0, At, B0); PG8_MMA(0, 1, At, B1); PG8_BAR; PG8_SCHED;
            PG8_LDA(At, 1, 1); PG8_STAGE(PG8_SB(1, 0), b3, vB[0]); PG8_STAGE(PG8_SB(1, 1), b3, vB[1]); PG8_STAGE(PG8_SA(1, 0), a3, vA2[0]);
            PG8_WAIT_V(8); PG8_WAIT_L(0); PG8_BAR; PG8_MMA(1, 0, At, B0); PG8_MMA(1, 1, At, B1); PG8_BAR; PG8_SCHED;
        }
        if constexpr (ALIGN_EPI) { if (wr == 0) PG8_BAR; }
        if constexpr (F8) asm volatile("s_nop 15\n\ts_nop 15" ::: "memory");
        { int l2_ = lane; asm volatile("" : "+v"(l2_)); E(acc, cur, wr, wc, l2_ & 15, l2_ >> 4); }
        if (!has_next) break;
        epi_pend = true;
#pragma unroll
        for (int a = 0; a < 2; ++a)
#pragma unroll
            for (int b = 0; b < 2; ++b)
#pragma unroll
                for (int m = 0; m < 4; ++m)
#pragma unroll
                    for (int n = 0; n < 2; ++n) acc[a][b][m][n] = (f32x4){0.f, 0.f, 0.f, 0.f};
        cur = nxt; cA = nA; cB = nB; ++ui;
        if constexpr (SchedVarK<Sched>::value) nt = S.ktiles(cur);
        if constexpr (Sched::GATHER) {
#pragma unroll
            for (int h = 0; h < 2; ++h)
#pragma unroll
                for (int i = 0; i < 2; ++i) vAc[h][i] = vAn[h][i];
        }
        if constexpr (ALIGN_EPI) { if (wr == 1) PG8_BAR; }
    }
    PG8_WAIT_V(0);
    if constexpr (!ALIGN_EPI) { if (wr == 0) PG8_BAR; }
    asm volatile("s_waitcnt vmcnt(0) lgkmcnt(0)\n\ts_barrier" ::: "memory");
    __builtin_amdgcn_sched_barrier(0);
#undef PG8_SA
#undef PG8_SB
#undef PG8_STAGE
#undef PG8_LDA
#undef PG8_LDB
#undef PG8_MMA
#undef PG8_WAIT_V
#undef PG8_WAIT_L
#undef PG8_BAR
#undef PG8_SCHED
}

struct DenseSched {
    static constexpr bool GATHER = false;
    const bf16_t* A; const bf16_t* Bt; int lda, ldb, nM, nN, G, c;
    __device__ __forceinline__ bool next(int i, Unit& u) const { const int v = i * G + c; if (v >= nM * nN) return false; u.pm = v / nN; u.pn = v % nN; u.ord = i; return true; }
    __device__ __forceinline__ const char* a_base(const Unit& u) const { return (const char*)(A + (size_t)u.pm * BM * lda); }
    __device__ __forceinline__ const char* b_base(const Unit& u) const { return (const char*)(Bt + (size_t)u.pn * BM * ldb); }
    __device__ __forceinline__ void a_off(const Unit&, const int (&R)[2], const int (&C)[2], unsigned (&v)[2][2]) const {
#pragma unroll
        for (int i = 0; i < 2; ++i) { v[0][i] = (unsigned)(R[i] * lda + C[i]) * 2u; v[1][i] = (unsigned)((HALF + R[i]) * lda + C[i]) * 2u; }
    }
};
struct DenseSched8 : DenseSched { int sw8, sa8; };
}

#define XB_TMO      128
#define XB_XCNT(j)  (256  + 64 * (j))
#define XB_XSUB(j)  (1280 + 64 * (j))
#define XB_XGEN(j)  (2304 + 64 * (j))
#define XB_TOP      3328
#define XB_TOPGEN   3392
#define XCD_BAR_WORDS 3456
#define XB_SPIN_CAP (1u << 18)
__device__ __forceinline__ unsigned xb_ld(unsigned* p)              { return __hip_atomic_load(p, __ATOMIC_RELAXED, __HIP_MEMORY_SCOPE_AGENT); }
__device__ __forceinline__ unsigned xb_add(unsigned* p, unsigned v) { return __hip_atomic_fetch_add(p, v, __ATOMIC_RELAXED, __HIP_MEMORY_SCOPE_AGENT); }
__device__ __forceinline__ unsigned xb_xcc_id() { return (unsigned)__builtin_amdgcn_s_getreg((3 << 11) | 20) & 0xFu; }
#define XB_SPIN(cond, bar) do { unsigned _sp = 0; while (cond) { __builtin_amdgcn_s_sleep(1); \
    if ((++_sp & 255u) == 0u) { if (xb_ld(&(bar)[XB_TMO])) break; if (_sp > XB_SPIN_CAP) { atomicAdd(&(bar)[XB_TMO], 1u); break; } } } } while (0)
struct XcdBarrier { unsigned* bar; unsigned x; volatile LAS unsigned* st; };
__device__ __forceinline__ XcdBarrier xcd_barrier_post(unsigned* bar, volatile LAS unsigned* st) {
    XcdBarrier b; b.bar = bar; b.x = xb_xcc_id(); b.st = st;
    if (threadIdx.x == 0) (void)xb_add(&bar[XB_XCNT(b.x)], 1u);
    return b;
}
__device__ __forceinline__ void xcd_barrier_complete(unsigned* bar, unsigned x, unsigned& nloc, unsigned& nx) {
    const unsigned G = gridDim.x * gridDim.y * gridDim.z;
    unsigned sum, cnt, mine, sp = 0u;
    for (;;) {
        sum = 0u; cnt = 0u; mine = 0u;
#pragma unroll
        for (unsigned j = 0; j < 16; ++j) { const unsigned c = xb_ld(&bar[XB_XCNT(j)]); sum += c; cnt += (c > 0u) ? 1u : 0u; mine = (j == x) ? c : mine; }
        if (sum == G) break;
        __builtin_amdgcn_s_sleep(1);
        if ((++sp & 255u) == 0u) { if (xb_ld(&bar[XB_TMO])) break; if (sp > XB_SPIN_CAP) { atomicAdd(&bar[XB_TMO], 1u); break; } }
    }
    nloc = mine > 0u ? mine : 1u; nx = cnt > 0u ? cnt : 1u;
}
__device__ __forceinline__ void xcd_barrier(const XcdBarrier& b) {
    asm volatile("s_waitcnt vmcnt(0)" ::: "memory");
    __syncthreads();
    if (threadIdx.x == 0) {
        unsigned* bar = b.bar;
        __builtin_amdgcn_s_waitcnt(0);
        unsigned nloc = b.st[0], nx = b.st[1];
        if (nloc == 0u) { xcd_barrier_complete(bar, b.x, nloc, nx); b.st[0] = nloc; b.st[1] = nx; }
        const unsigned old = xb_add(&bar[XB_XSUB(b.x)], 1u);
        const unsigned gen = old / nloc;
        if (old + 1u == (gen + 1u) * nloc) {
            __builtin_amdgcn_fence(__ATOMIC_RELEASE, "agent");
            asm volatile("s_waitcnt vmcnt(0)" ::: "memory");
            const unsigned og = xb_add(&bar[XB_TOP], 1u);
            const unsigned tg = og / nx;
            if (og + 1u == (tg + 1u) * nx) xb_add(&bar[XB_TOPGEN], 1u);
            else XB_SPIN(xb_ld(&bar[XB_TOPGEN]) == tg, bar);
            __builtin_amdgcn_fence(__ATOMIC_ACQUIRE, "agent");
            xb_add(&bar[XB_XGEN(b.x)], 1u);
            asm volatile("s_waitcnt vmcnt(0)" ::: "memory");
        } else {
            XB_SPIN(xb_ld(&bar[XB_XGEN(b.x)]) == gen, bar);
            __builtin_amdgcn_fence(__ATOMIC_ACQUIRE, "agent");
            asm volatile("s_waitcnt vmcnt(0)" ::: "memory");
        }
    }
    __syncthreads();
}

constexpr size_t MiB = 1u << 20;
constexpr size_t WS_CTL = 0, CTL_ZERO_BYTES = 1 * MiB;
constexpr int CW_BAR = 4096;
constexpr int CW_QUEUE = 16384;
constexpr size_t WS_W13 = 2 * MiB;
constexpr size_t WS_W2  = 34 * MiB;
constexpr size_t WS_WR  = 50 * MiB;
constexpr size_t WS_MISC = 51 * MiB;
constexpr size_t WS_ROUTE = 52 * MiB;
constexpr size_t WS_RPOS = 53 * MiB;
constexpr size_t WS_ROWTOK = 54 * MiB;
constexpr size_t WS_ROPE = 55 * MiB;
constexpr size_t WS_XB = 56 * MiB;
constexpr size_t WS_H = 184 * MiB;
constexpr size_t WS_Y = 256 * MiB;
constexpr size_t WS_WIN = 528 * MiB;
constexpr size_t WS_WG = 536 * MiB;
constexpr size_t WS_WUQ = 542 * MiB;
constexpr size_t WS_WUKV = 543 * MiB;
constexpr size_t WS_WA = 544 * MiB;
constexpr size_t WS_WB = 545 * MiB;
constexpr size_t WS_WC = 546 * MiB;
constexpr size_t WS_WO = 547 * MiB;
constexpr size_t WS_SSQ = 549 * MiB;
constexpr size_t WS_LSE = 550 * MiB;
constexpr size_t WS_MASK = 552 * MiB;
constexpr size_t WS_PROJ = 556 * MiB;
constexpr size_t WS_OB = 684 * MiB;
constexpr size_t WS_QM = 716 * MiB;
constexpr size_t WS_KVM = 740 * MiB;
constexpr size_t WS_SC = WS_Y;
constexpr size_t WS_G3 = WS_Y + 72 * MiB;
constexpr size_t WS_M0 = 772 * MiB;
constexpr size_t WS_M1 = 804 * MiB;
constexpr size_t WS_OA = 844 * MiB;
constexpr size_t WS_OC = 860 * MiB;
constexpr size_t WS_OG = 884 * MiB;
constexpr size_t WS_MERGED = 908 * MiB;
constexpr size_t WS_XB8 = 940 * MiB;
constexpr size_t WS_WIN8 = 1004 * MiB;
constexpr size_t WS_END = 1011 * MiB;
constexpr int F8_SA_X = 127 - 4, F8_SW = 127 - 10;
constexpr int MAXROWS = 139264;
constexpr int NBC = 8, TC = NBC * SEQ, NCHUNK = NB / NBC;
constexpr int CIN = 3944, PW = 4096;

constexpr int MI_BLOCKCNT = 0;
constexpr int MI_PANEL_E = 8192;
constexpr int MI_NPAN = 8192 + 1024;

constexpr int RING_BYTES = 131072;
constexpr int L_CTL = RING_BYTES;
constexpr int L_BARW = L_CTL + 32;
constexpr int L_HIST = L_CTL + 256;
constexpr int L_TOT  = L_CTL + 384;
constexpr int L_PRE  = L_CTL + 512;
constexpr int L_BASE = L_CTL + 640;
constexpr int L_RANK = L_CTL + 896;
constexpr int L_PE   = L_CTL + 1024;
constexpr int L_ROWS = L_CTL + 2048;
constexpr int LDS_BYTES = 147456;
constexpr int L_GB = L_ROWS;
static_assert(L_ROWS + 12288 <= LDS_BYTES, "LDS map");

#ifndef DUPMASK
#define DUPMASK 0
#endif
struct Args { const float* in[23]; float* out; unsigned char* ws; };
#define PHASE_IDS(F) do { int t_ = threadIdx.x; asm volatile("" : "+v"(t_)); (F).tid = t_; (F).lane = t_ & 63; { intab_t p_ = (intab_t)__builtin_amdgcn_kernarg_segment_ptr(); asm volatile("" : "+s"(p_)); (F).in.p = p_; } \
    { unsigned char GAS* w_ = (unsigned char GAS*)(F).ws0; asm volatile("" : "+s"(w_)); (F).ws = (unsigned char*)w_; float GAS* o_ = (float GAS*)(F).out0; asm volatile("" : "+s"(o_)); (F).out = (float*)o_; } } while (0)

typedef const float GAS* gfptr_t;
typedef const gfptr_t __attribute__((address_space(4)))* intab_t;
struct InTab { intab_t p; __device__ __forceinline__ const float* operator[](int i) const { return (const float*)p[i]; } };
struct Frame {
    LAS unsigned char* lds;
    int tid, lane, wave, vcu, G;
    InTab in; float* out; unsigned char* ws; float* out0; unsigned char* ws0;
};

template <class F>
__device__ __forceinline__ void conv_item(bf16_t* WT, int ldk, int k0, int n0, LAS float* scr, int lane, F val) {
#pragma unroll 8
    for (int i = 0; i < 32; ++i) { const int kk = 2 * i + (lane >> 5); scr[kk * 33 + (lane & 31)] = val(k0 + kk, n0 + (lane & 31)); }
    LDS_WAIT(); asm volatile("" ::: "memory");
    const int c = lane & 7;
#pragma unroll
    for (int j = 0; j < 4; ++j) { const int n = (lane >> 3) + 8 * j; const LAS float* s = scr + (8 * c) * 33 + n;
        u32x4 o; o.x = pk2(s[0 * 33], s[1 * 33]); o.y = pk2(s[2 * 33], s[3 * 33]); o.z = pk2(s[4 * 33], s[5 * 33]); o.w = pk2(s[6 * 33], s[7 * 33]);
        *(u32x4*)(WT + (size_t)(n0 + n) * ldk + k0 + 8 * c) = o; }
    LDS_WAIT(); asm volatile("" ::: "memory");
}

template <class F>
__device__ __forceinline__ void conv_item8(unsigned char* WT, int ldk, int k0, int n0, LAS float* scr, int lane, F val) {
#pragma unroll 8
    for (int i = 0; i < 32; ++i) { const int kk = 2 * i + (lane >> 5); scr[kk * 33 + (lane & 31)] = val(k0 + kk, n0 + (lane & 31)); }
    LDS_WAIT(); asm volatile("" ::: "memory");
    const int c = lane & 7;
#pragma unroll
    for (int j = 0; j < 4; ++j) { const int n = (lane >> 3) + 8 * j; const LAS float* s = scr + (8 * c) * 33 + n;
        u32x2 o; o.x = pk4_fp8(s[0 * 33], s[1 * 33], s[2 * 33], s[3 * 33]); o.y = pk4_fp8(s[4 * 33], s[5 * 33], s[6 * 33], s[7 * 33]);
        *(u32x2*)(WT + (size_t)(n0 + n) * ldk + k0 + 8 * c) = o; }
    LDS_WAIT(); asm volatile("" ::: "memory");
}

__device__ __forceinline__ void conv_plain8(unsigned char* WT, int ldk, int k0, int n0, LAS float* scr, int lane, const float* src, int pitch, float sc) {
    f32x4 v[8];
#pragma unroll
    for (int i = 0; i < 8; ++i) v[i] = *(const f32x4*)(src + (size_t)(k0 + (lane >> 3) + 8 * i) * pitch + n0 + (lane & 7) * 4);
#pragma unroll
    for (int i = 0; i < 8; ++i) { LAS float* d = scr + ((lane >> 3) + 8 * i) * 33 + (lane & 7) * 4; d[0] = v[i][0] * sc; d[1] = v[i][1] * sc; d[2] = v[i][2] * sc; d[3] = v[i][3] * sc; }
    LDS_WAIT(); asm volatile("" ::: "memory");
    const int c = lane & 7;
#pragma unroll
    for (int j = 0; j < 4; ++j) { const int n = (lane >> 3) + 8 * j; const LAS float* s = scr + (8 * c) * 33 + n;
        u32x2 o; o.x = pk4_fp8(s[0 * 33], s[1 * 33], s[2 * 33], s[3 * 33]); o.y = pk4_fp8(s[4 * 33], s[5 * 33], s[6 * 33], s[7 * 33]);
        *(u32x2*)(WT + (size_t)(n0 + n) * ldk + k0 + 8 * c) = o; }
    LDS_WAIT(); asm volatile("" ::: "memory");
}
__device__ __forceinline__ void conv_pair8(unsigned char* WT, int ldk, int k0, int n0, LAS float* scr, int lane, const float* a, const float* b, int pitch, float sc) {
    f32x2 va[8], vb[8];
#pragma unroll
    for (int i = 0; i < 8; ++i) { const size_t o = (size_t)(k0 + (lane >> 3) + 8 * i) * pitch + (n0 >> 1) + (lane & 7) * 2; va[i] = *(const f32x2*)(a + o); vb[i] = *(const f32x2*)(b + o); }
#pragma unroll
    for (int i = 0; i < 8; ++i) { LAS float* d = scr + ((lane >> 3) + 8 * i) * 33 + (lane & 7) * 4; d[0] = va[i][0] * sc; d[1] = vb[i][0] * sc; d[2] = va[i][1] * sc; d[3] = vb[i][1] * sc; }
    LDS_WAIT(); asm volatile("" ::: "memory");
    const int c = lane & 7;
#pragma unroll
    for (int j = 0; j < 4; ++j) { const int n = (lane >> 3) + 8 * j; const LAS float* s = scr + (8 * c) * 33 + n;
        u32x2 o; o.x = pk4_fp8(s[0 * 33], s[1 * 33], s[2 * 33], s[3 * 33]); o.y = pk4_fp8(s[4 * 33], s[5 * 33], s[6 * 33], s[7 * 33]);
        *(u32x2*)(WT + (size_t)(n0 + n) * ldk + k0 + 8 * c) = o; }
    LDS_WAIT(); asm volatile("" ::: "memory");
}

__device__ __forceinline__ void phase_conv_moe(Frame& F, int l) {
    PHASE_IDS(F);
    LAS float* scr = (LAS float*)(F.lds + F.wave * 16384);
    const int gw = F.vcu * NWAVES + F.wave, NGW = F.G * NWAVES;
    const float* w1 = F.in[18] + (size_t)l * NEXP * DM * DEXP;
    const float* w3 = F.in[19] + (size_t)l * NEXP * DM * DEXP;
    const float* w2 = F.in[20] + (size_t)l * NEXP * DEXP * DM;
    bf16_t* W13 = (bf16_t*)(F.ws + WS_W13); bf16_t* W2 = (bf16_t*)(F.ws + WS_W2);
    constexpr int I13 = (DM / 64) * (512 / 32);
    constexpr int I2 = (DEXP / 64) * (DM / 32);
    for (int it = gw; it < NEXP * (I13 + I2); it += NGW) {
        if (it < NEXP * I13) {
            const int e = it / I13, r = it % I13, kb = r / 16, nb = r % 16;
            const float* a = w1 + (size_t)e * DM * DEXP; const float* b = w3 + (size_t)e * DM * DEXP;
            conv_pair8((unsigned char*)W13 + (size_t)e * 512 * DM, DM, kb * 64, nb * 32, scr, F.lane, a, b, DEXP, 1024.f);
        } else {
            const int it2 = it - NEXP * I13; const int e = it2 / I2, r = it2 % I2, kb = r / 32, nb = r % 32;
            const float* a = w2 + (size_t)e * DEXP * DM;
            conv_plain8((unsigned char*)W2 + (size_t)e * DM * DEXP, DEXP, kb * 64, nb * 32, scr, F.lane, a, DM, 1024.f);
        }
    }
    const float* wg = F.in[14] + (size_t)l * DM * 4; const float* wsb = F.in[16] + (size_t)l * DM * NEXP;
    const float* g1 = F.in[12] + (size_t)l * DM; const float* b1 = F.in[13] + (size_t)l * DM;
    bf16_t* WRH = (bf16_t*)(F.ws + WS_WR); bf16_t* WRL = (bf16_t*)(F.ws + WS_WR + 128 * 1024); float* WRC = (float*)(F.ws + WS_WR + 256 * 1024);
    for (int idx = (F.vcu * NTHREADS + F.tid); idx < 64 * DM; idx += F.G * NTHREADS) {
        const int c = idx / DM, k = idx % DM;
        const float v = (c < 32 ? wsb[(size_t)k * NEXP + c] : (c < 36 ? wg[(size_t)k * 4 + (c - 32)] : 0.f)) * g1[k];
        const unsigned h = f2bf(v); const int it = k >> 5, hi_ = (k >> 4) & 1, st = (k >> 3) & 1, e = k & 7, ln = (c & 31) + 32 * hi_, p0 = 2 * (c >> 5);
        WRH[((((size_t)it * 4 + p0) * 2 + st) * 64 + ln) * 8 + e] = (bf16_t)h;
        WRH[((((size_t)it * 4 + p0 + 1) * 2 + st) * 64 + ln) * 8 + e] = (bf16_t)f2bf(v - __builtin_bit_cast(float, h << 16)); (void)WRL;
    }
    if (gw < 64) {
        const int c = gw; float s1 = 0.f, s2 = 0.f;
        for (int k = F.lane; k < DM; k += 64) { const float w = c < 32 ? wsb[(size_t)k * NEXP + c] : (c < 36 ? wg[(size_t)k * 4 + (c - 32)] : 0.f); s1 += g1[k] * w; s2 += b1[k] * w; }
        s1 = wave_sum(s1); s2 = wave_sum(s2);
        const float bias = c < 32 ? F.in[17][(size_t)l * NEXP + c] : (c < 36 ? F.in[15][(size_t)l * 4 + (c - 32)] : 0.f);
        if (F.lane == 0) { WRC[c] = s1; WRC[64 + c] = s2 + bias; }
    }
}

__device__ __forceinline__ void ln_row(f32x4 (&v)[4], const f32x4 (&g)[4], const f32x4 (&b)[4], float* omean = nullptr, float* orstd = nullptr) {
    float s = 0.f;
#pragma unroll
    for (int j = 0; j < 4; ++j) s += (v[j].x + v[j].y) + (v[j].z + v[j].w);
    const float mean = wave_sum(s) * (1.f / DM); float s2 = 0.f;
#pragma unroll
    for (int j = 0; j < 4; ++j) { v[j] = v[j] - mean; s2 += (v[j].x * v[j].x + v[j].y * v[j].y) + (v[j].z * v[j].z + v[j].w * v[j].w); }
    const float rstd = 1.0f / sqrtf(wave_sum(s2) * (1.f / DM) + LN_EPS);
#pragma unroll
    for (int j = 0; j < 4; ++j) v[j] = v[j] * rstd * g[j] + b[j];
    if (omean) { *omean = mean; *orstd = rstd; }
}
__device__ __forceinline__ void store_row(const f32x4 (&v)[4], float* orow, unsigned char* brow, int lane) {
#pragma unroll
    for (int j = 0; j < 4; ++j) {
        ((f32x4*)orow)[lane + 64 * j] = v[j];
        ((unsigned*)brow)[lane + 64 * j] = pk4_fp8(v[j].x * 16.f, v[j].y * 16.f, v[j].z * 16.f, v[j].w * 16.f);
    }
}

__device__ __forceinline__ void phase_ln1_router(Frame& F, int l, const float* src, bool scale_alpha) {
    PHASE_IDS(F);
    const int lane = F.lane, hi = lane >> 5, r32 = lane & 31;
    const float* lg = F.in[12] + (size_t)l * DM; const float* lb = F.in[13] + (size_t)l * DM;
    f32x4 g[4], b[4];
#pragma unroll
    for (int j = 0; j < 4; ++j) { g[j] = ((const f32x4*)lg)[lane + 64 * j]; b[j] = ((const f32x4*)lb)[lane + 64 * j]; }
    unsigned char* XB = F.ws + WS_XB8;
    const bf16_t* WRH = (const bf16_t*)(F.ws + WS_WR); const bf16_t* WRL = (const bf16_t*)(F.ws + WS_WR + 128 * 1024);
    const float* WRC = (const float*)(F.ws + WS_WR + 256 * 1024); float* stats = (float*)(F.ws + WS_WR + 512 * 1024);
    unsigned* misc = (unsigned*)(F.ws + WS_MISC);
    int* route = (int*)(F.ws + WS_ROUTE);
    LAS unsigned* hist = (LAS unsigned*)(F.lds + L_HIST);
    const float sc = scale_alpha ? ALPHA : 1.0f;
    for (int blk = F.vcu; blk < TT / 256; blk += F.G) {
        if (F.tid < 32) hist[F.tid] = 0u;
        __syncthreads();
        const int row0 = blk * 256 + F.wave * 32;
        float mu_l = 0.f, rs_l = 1.f;
        for (int i = 0; i < 32; i += 2) {
            f32x4 v0[4], v1[4];
            const f32x4* p0 = (const f32x4*)(src + (size_t)(row0 + i) * DM); const f32x4* p1 = (const f32x4*)(src + (size_t)(row0 + i + 1) * DM);
#pragma unroll
            for (int j = 0; j < 4; ++j) { v0[j] = p0[lane + 64 * j] * sc; v1[j] = p1[lane + 64 * j] * sc; }
            float m0, r0, m1, r1;
            ln_row(v0, g, b, &m0, &r0); ln_row(v1, g, b, &m1, &r1);
            mu_l = (r32 == i) ? m0 : ((r32 == i + 1) ? m1 : mu_l); rs_l = (r32 == i) ? r0 : ((r32 == i + 1) ? r1 : rs_l);
#pragma unroll
            for (int j = 0; j < 4; ++j) {
                ((unsigned*)(XB + (size_t)(row0 + i) * DM))[lane + 64 * j] = pk4_fp8(v0[j].x * 16.f, v0[j].y * 16.f, v0[j].z * 16.f, v0[j].w * 16.f);
                ((unsigned*)(XB + (size_t)(row0 + i + 1) * DM))[lane + 64 * j] = pk4_fp8(v1[j].x * 16.f, v1[j].y * 16.f, v1[j].z * 16.f, v1[j].w * 16.f); }
        }
        if (hi == 0) *(f32x2*)(stats + (size_t)(row0 + r32) * 2) = (f32x2){mu_l, rs_l};
        f32x16 acc0 = {}, acc1 = {};
        {
            const bf16_t* WT = WRH; (void)WRL;
            LAS float* xs = (LAS float*)(F.lds + F.wave * 9216);
            const float* xg = src + (size_t)(row0 + (lane >> 3)) * DM + (lane & 7) * 4;
            f32x4 xv[4]; bf16x8 wv[8];
#pragma unroll
            for (int i = 0; i < 4; ++i) xv[i] = *(const f32x4*)(xg + (size_t)(8 * i) * DM);
#pragma unroll
            for (int q = 0; q < 8; ++q) wv[q] = *(const bf16x8*)(WT + ((size_t)q * 64 + lane) * 8);
#pragma unroll 2
            for (int it = 0; it < 32; ++it) {
                LAS float* xb = xs + (it & 1) * 1152;
#pragma unroll
                for (int i = 0; i < 4; ++i) *(LAS f32x4*)(xb + ((lane >> 3) + 8 * i) * 36 + (lane & 7) * 4) = xv[i];
                bf16x8 wc[8];
#pragma unroll
                for (int q = 0; q < 8; ++q) wc[q] = wv[q];
                { const int nx = it + 1 < 32 ? it + 1 : 31;
#pragma unroll
                  for (int i = 0; i < 4; ++i) xv[i] = *(const f32x4*)(xg + (size_t)(8 * i) * DM + nx * 32);
#pragma unroll
                  for (int q = 0; q < 8; ++q) wv[q] = *(const bf16x8*)(WT + (((size_t)nx * 8 + q) * 64 + lane) * 8); }
                f32x4 xa[4];
#pragma unroll
                for (int j = 0; j < 4; ++j) xa[j] = *(const LAS f32x4*)(xb + r32 * 36 + hi * 16 + 4 * j);
#pragma unroll
                for (int st = 0; st < 2; ++st) {
                    const f32x4 x0 = xa[2 * st], x1 = xa[2 * st + 1];
                    u32x4 xh, xl;
                    xh.x = cvt_pk_bf16(x0[0], x0[1]); xh.y = cvt_pk_bf16(x0[2], x0[3]); xh.z = cvt_pk_bf16(x1[0], x1[1]); xh.w = cvt_pk_bf16(x1[2], x1[3]);
                    xl.x = cvt_pk_bf16(x0[0] - bflo(xh.x), x0[1] - bfhi(xh.x)); xl.y = cvt_pk_bf16(x0[2] - bflo(xh.y), x0[3] - bfhi(xh.y));
                    xl.z = cvt_pk_bf16(x1[0] - bflo(xh.z), x1[1] - bfhi(xh.z)); xl.w = cvt_pk_bf16(x1[2] - bflo(xh.w), x1[3] - bfhi(xh.w));
                    const bf16x8 xhv = __builtin_bit_cast(bf16x8, xh), xlv = __builtin_bit_cast(bf16x8, xl);
                    acc0 = __builtin_amdgcn_mfma_f32_32x32x16_bf16(wc[0 + st], xhv, acc0, 0, 0, 0); acc1 = __builtin_amdgcn_mfma_f32_32x32x16_bf16(wc[4 + st], xhv, acc1, 0, 0, 0);
                    acc0 = __builtin_amdgcn_mfma_f32_32x32x16_bf16(wc[2 + st], xhv, acc0, 0, 0, 0); acc1 = __builtin_amdgcn_mfma_f32_32x32x16_bf16(wc[6 + st], xhv, acc1, 0, 0, 0);
                    acc0 = __builtin_amdgcn_mfma_f32_32x32x16_bf16(wc[0 + st], xlv, acc0, 0, 0, 0); acc1 = __builtin_amdgcn_mfma_f32_32x32x16_bf16(wc[4 + st], xlv, acc1, 0, 0, 0);
                }
            }
        }
        float gl[4];
#pragma unroll
        for (int i = 0; i < 4; ++i) gl[i] = rs_l * (acc1[i] - mu_l * WRC[32 + i]) + WRC[64 + 32 + i];
        int gidx = 0; float gmax = gl[0];
#pragma unroll
        for (int i = 1; i < 4; ++i) if (gl[i] > gmax) { gmax = gl[i]; gidx = i; }
        float gsum = 0.f;
#pragma unroll
        for (int i = 0; i < 4; ++i) gsum += fast_exp(gl[i] - gmax);
        float gp = 1.0f / gsum;
        gidx = __shfl(gidx, r32); gp = __shfl(gp, r32);
        float cv[4];
#pragma unroll
        for (int i = 0; i < 4; ++i) {
            const float a = gidx == 0 ? acc0[i] : gidx == 1 ? acc0[4 + i] : gidx == 2 ? acc0[8 + i] : acc0[12 + i];
            cv[i] = rs_l * (a - mu_l * WRC[8 * gidx + 4 * hi + i]) + WRC[64 + 8 * gidx + 4 * hi + i];
        }
        float v1 = cv[0]; int i1 = 0;
#pragma unroll
        for (int i = 1; i < 4; ++i) if (cv[i] > v1) { v1 = cv[i]; i1 = i; }
        float v2 = -INFINITY; int i2 = 0;
#pragma unroll
        for (int i = 0; i < 4; ++i) if (i != i1 && cv[i] > v2) { v2 = cv[i]; i2 = i; }
        i1 += 4 * hi; i2 += 4 * hi;
        const float pv1 = __shfl_xor(v1, 32), pv2 = __shfl_xor(v2, 32); const int pi1 = __shfl_xor(i1, 32), pi2 = __shfl_xor(i2, 32);
        auto better = [](float av, int ai, float bv, int bi) { return av > bv || (av == bv && ai < bi); };
        float fv, sv; int fi, si;
        if (better(v1, i1, pv1, pi1)) { fv = v1; fi = i1; if (better(v2, i2, pv1, pi1)) { sv = v2; si = i2; } else { sv = pv1; si = pi1; } }
        else { fv = pv1; fi = pi1; if (better(v1, i1, pv2, pi2)) { sv = v1; si = i1; } else { sv = pv2; si = pi2; } }
        const float d = fast_exp(sv - fv), inv = 1.0f / (1.0f + d);
        const float w1 = gp * inv, w2 = gp * d * inv;
        const int e1 = 8 * gidx + fi, e2 = 8 * gidx + si;
        if (hi == 0) {
            *(int4*)(route + (size_t)(row0 + r32) * 4) = make_int4(e1, e2, __float_as_int(w1), __float_as_int(w2));
            atomicAdd((unsigned*)&hist[e1], 1u); atomicAdd((unsigned*)&hist[e2], 1u);
        }
        __syncthreads();
        if (F.tid < 32) misc[MI_BLOCKCNT + blk * 32 + F.tid] = hist[F.tid];
        __syncthreads();
    }
}

__device__ __forceinline__ void phase_moe_scatter(Frame& F) {
    PHASE_IDS(F);
    unsigned* misc = (unsigned*)(F.ws + WS_MISC);
    const int* route = (const int*)(F.ws + WS_ROUTE);
    int* rpos = (int*)(F.ws + WS_RPOS); int* rowtok = (int*)(F.ws + WS_ROWTOK);
    LAS unsigned* tot = (LAS unsigned*)(F.lds + L_TOT); LAS unsigned* pre = (LAS unsigned*)(F.lds + L_PRE);
    LAS unsigned* base = (LAS unsigned*)(F.lds + L_BASE); LAS unsigned* rank = (LAS unsigned*)(F.lds + L_RANK);
    for (int blk = F.vcu; blk < TT / 256; blk += F.G) {
        {
            if (F.tid < 32) { tot[F.tid] = 0u; pre[F.tid] = 0u; rank[F.tid] = 0u; }
            __syncthreads();
            const int e = F.tid & 31, part = F.tid >> 5; unsigned cv[16];
#pragma unroll
            for (int i = 0; i < 16; ++i) cv[i] = misc[MI_BLOCKCNT + (part * 16 + i) * 32 + e];
            unsigned t = 0, p = 0;
#pragma unroll
            for (int i = 0; i < 16; ++i) { t += cv[i]; p += (part * 16 + i < blk) ? cv[i] : 0u; }
            atomicAdd((unsigned*)&tot[e], t); atomicAdd((unsigned*)&pre[e], p);
        }
        __syncthreads();
        if (F.tid == 0) { unsigned a = 0; for (int e = 0; e < NEXP; ++e) { base[e] = a; a += (tot[e] + 255u) & ~255u; } base[NEXP] = a; }
        __syncthreads();
        {
            const int tok = blk * 256 + (F.tid >> 1), slot = F.tid & 1;
            const int e = route[(size_t)tok * 4 + slot];
            const unsigned r = atomicAdd((unsigned*)&rank[e], 1u);
            const unsigned pos = base[e] + pre[e] + r;
            rowtok[pos] = tok; rpos[(size_t)tok * 2 + slot] = (int)pos;
        }
        if (blk < NEXP) {
            const int e = blk; const unsigned end = base[e] + tot[e], nxt = base[e + 1];
            for (unsigned p = end + F.tid; p < nxt; p += NTHREADS) rowtok[p] = 0;
            for (unsigned p = base[e] / 256 + F.tid; p < nxt / 256; p += NTHREADS) misc[MI_PANEL_E + p] = (unsigned)e;
        }
        if (blk == 0 && F.tid == 0) misc[MI_NPAN] = base[NEXP] / 256;
        __syncthreads();
    }
}

struct MoeSched1 {
    static constexpr bool GATHER = true;
    const bf16_t* A; const bf16_t* W; int lda, ldb, ntot, G, c; const LAS int* rows; const LAS int* pe; int sw8, sa8;
    __device__ __forceinline__ bool next(int i, pg8::Unit& u) const { const int v = i * G + c; if (v >= ntot) return false; u.pm = v >> 1; u.pn = v & 1; u.ord = i; return true; }
    __device__ __forceinline__ const char* a_base(const pg8::Unit&) const { return (const char*)A; }
    __device__ __forceinline__ const char* b_base(const pg8::Unit& u) const { return (const char*)(W + (size_t)pe[u.ord] * 512 * ldb + (size_t)u.pn * 256 * ldb); }
    __device__ __forceinline__ void a_off(const pg8::Unit& u, const int (&R)[2], const int (&C)[2], unsigned (&v)[2][2]) const {
#pragma unroll
        for (int h = 0; h < 2; ++h)
#pragma unroll
            for (int i = 0; i < 2; ++i) v[h][i] = (unsigned)(rows[u.ord * 256 + h * 128 + R[i]] * lda + C[i]) * 2u;
    }
};
struct MoeSched2 {
    static constexpr bool GATHER = false;
    const bf16_t* A; const bf16_t* W; int lda, ldb, ntot, G, c; const LAS int* pe; int sw8, sa8;
    __device__ __forceinline__ bool next(int i, pg8::Unit& u) const { const int v = i * G + c; if (v >= ntot) return false; u.pm = v >> 2; u.pn = v & 3; u.ord = i; return true; }
    __device__ __forceinline__ const char* a_base(const pg8::Unit& u) const { return (const char*)(A + (size_t)u.pm * 256 * lda); }
    __device__ __forceinline__ const char* b_base(const pg8::Unit& u) const { return (const char*)(W + (size_t)pe[u.ord] * DM * ldb + (size_t)u.pn * 256 * ldb); }
    __device__ __forceinline__ void a_off(const pg8::Unit&, const int (&R)[2], const int (&C)[2], unsigned (&v)[2][2]) const {
#pragma unroll
        for (int i = 0; i < 2; ++i) { v[0][i] = (unsigned)(R[i] * lda + C[i]) * 2u; v[1][i] = (unsigned)((128 + R[i]) * lda + C[i]) * 2u; }
    }
};
struct EpiSwiGLU {
    bf16_t* H;
    __device__ __forceinline__ void operator()(const f32x4 (&acc)[2][2][4][2], const pg8::Unit& u, int wr, int wc, int fr, int fq) const {
        const int row0 = u.pm * 256 + wr * 64 + fr, col0 = u.pn * 128 + wc * 16 + 4 * fq;
#pragma unroll
        for (int ai = 0; ai < 2; ++ai)
#pragma unroll
            for (int m = 0; m < 4; ++m) { bf16_t* rowp = H + (size_t)(row0 + ai * 128 + m * 16) * DEXP + col0;
#pragma unroll
                for (int bj = 0; bj < 2; ++bj) { const f32x4 v0 = acc[ai][bj][m][0], v1 = acc[ai][bj][m][1];
                    const float h0 = v0[0] * sigmoidf_(v0[0]) * v0[1], h1 = v0[2] * sigmoidf_(v0[2]) * v0[3], h2 = v1[0] * sigmoidf_(v1[0]) * v1[1], h3 = v1[2] * sigmoidf_(v1[2]) * v1[3];
                    *(unsigned*)((unsigned char*)H + (size_t)(row0 + ai * 128 + m * 16) * DEXP + col0 + bj * 64) = pk4_fp8(h0 * 16.f, h1 * 16.f, h2 * 16.f, h3 * 16.f); (void)rowp; } }
    }
};
struct EpiStoreBf16 {
    bf16_t* O; int ldc;
    __device__ __forceinline__ void operator()(const f32x4 (&acc)[2][2][4][2], const pg8::Unit& u, int wr, int wc, int fr, int fq) const {
        const int row0 = u.pm * 256 + wr * 64 + fr, col0 = u.pn * 256 + wc * 32 + 8 * fq;
#pragma unroll
        for (int ai = 0; ai < 2; ++ai)
#pragma unroll
            for (int m = 0; m < 4; ++m) { bf16_t* rowp = O + (size_t)(row0 + ai * 128 + m * 16) * ldc + col0;
#pragma unroll
                for (int bj = 0; bj < 2; ++bj) store8_fp8((unsigned char*)O + (size_t)(row0 + ai * 128 + m * 16) * ldc + col0 + bj * 128, acc[ai][bj][m][0], acc[ai][bj][m][1], 64.f); (void)rowp; }
    }
};

__device__ __forceinline__ void phase_moe_gemm1(Frame& F) {
    PHASE_IDS(F);
    const unsigned* misc = (const unsigned*)(F.ws + WS_MISC);
    const int* rowtok = (const int*)(F.ws + WS_ROWTOK);
    const int npan = (int)misc[MI_NPAN];
    LAS int* rows = (LAS int*)(F.lds + L_ROWS); LAS int* pe = (LAS int*)(F.lds + L_PE);
    const int c = (int)blockIdx.x, ntot = npan * 2;
    for (int i = 0; i * F.G + c < ntot && i < 8; ++i) { const int p = (i * F.G + c) >> 1;
        if (F.tid < 256) rows[i * 256 + F.tid] = rowtok[p * 256 + F.tid];
        if (F.tid == 256) pe[i] = (int)misc[MI_PANEL_E + p]; }
    VM_WAIT(); LDS_WAIT(); __syncthreads();
    MoeSched1 S{(const bf16_t*)(F.ws + WS_XB8), (const bf16_t*)(F.ws + WS_W13), DM / 2, DM / 2, ntot, F.G, c, rows, pe, F8_SW, F8_SA_X};
    EpiSwiGLU E{(bf16_t*)(F.ws + WS_H)};
    pg8::gemm_phase<EpiSwiGLU, MoeSched1, true, true>(F.lds, DM / 2, S, E);
}
__device__ __forceinline__ void phase_moe_gemm2(Frame& F) {
    PHASE_IDS(F);
    const unsigned* misc = (const unsigned*)(F.ws + WS_MISC);
    const int npan = (int)misc[MI_NPAN];
    LAS int* pe = (LAS int*)(F.lds + L_PE);
    const int c = (int)blockIdx.x, ntot = npan * 4;
    __syncthreads();
    if (F.tid < 16) { const int v = F.tid * F.G + c; if (v < ntot) pe[F.tid] = (int)misc[MI_PANEL_E + (v >> 2)]; }
    VM_WAIT(); LDS_WAIT(); __syncthreads();
    MoeSched2 S{(const bf16_t*)(F.ws + WS_H), (const bf16_t*)(F.ws + WS_W2), DEXP / 2, DEXP / 2, ntot, F.G, c, pe, F8_SW, 127 - 4};
    EpiStoreBf16 E{(bf16_t*)(F.ws + WS_Y), DM};
    int k2 = DEXP / 2; asm volatile("" : "+s"(k2));
    pg8::gemm_phase<EpiStoreBf16, MoeSched2, true, true>(F.lds, k2, S, E);
}

__device__ __forceinline__ void phase_combine_ln2(Frame& F, int l) {
    PHASE_IDS(F);
    const int lane = F.lane;
    const float* lg = F.in[21] + (size_t)l * DM; const float* lb = F.in[22] + (size_t)l * DM;
    f32x4 g[4], b[4];
#pragma unroll
    for (int j = 0; j < 4; ++j) { g[j] = ((const f32x4*)lg)[lane + 64 * j]; b[j] = ((const f32x4*)lb)[lane + 64 * j]; }
    const bf16_t* Y = (const bf16_t*)(F.ws + WS_Y);
    const float* l1g = F.in[12] + (size_t)l * DM; const float* l1b = F.in[13] + (size_t)l * DM; const float* stats = (const float*)(F.ws + WS_WR + 512 * 1024);
    f32x4 g1[4], b1[4];
#pragma unroll
    for (int j = 0; j < 4; ++j) { g1[j] = ((const f32x4*)l1g)[lane + 64 * j]; b1[j] = ((const f32x4*)l1b)[lane + 64 * j]; }
    const int* route = (const int*)(F.ws + WS_ROUTE); const int* rpos = (const int*)(F.ws + WS_RPOS);
    const int gw = F.vcu * NWAVES + F.wave, NGW = F.G * NWAVES;
    int4 rt_n = *(const int4*)(route + (size_t)gw * 4); int2 rp_n = *(const int2*)(rpos + (size_t)gw * 2); f32x2 st_n = *(const f32x2*)(stats + (size_t)gw * 2);
    for (int row = gw; row < TT; row += NGW) {
        const int4 rt = rt_n; const int2 rp = rp_n; const f32x2 st = st_n;
        { const int nr = (row + NGW < TT) ? row + NGW : row; rt_n = *(const int4*)(route + (size_t)nr * 4); rp_n = *(const int2*)(rpos + (size_t)nr * 2); st_n = *(const f32x2*)(stats + (size_t)nr * 2); }
        const float w0 = __int_as_float(rt.z) * (1.f / 64.f), w1 = __int_as_float(rt.w) * (1.f / 64.f);
        const f32x4* px = (const f32x4*)(F.out + (size_t)row * DM);
        const unsigned* y0 = (const unsigned*)((const unsigned char*)Y + (size_t)rp.x * DM); const unsigned* y1 = (const unsigned*)((const unsigned char*)Y + (size_t)rp.y * DM);
        f32x4 v[4];
#pragma unroll
        for (int j = 0; j < 4; ++j) {
            const f32x4 x = (px[lane + 64 * j] - st[0]) * st[1] * g1[j] + b1[j]; const unsigned a = y0[lane + 64 * j], c = y1[lane + 64 * j];
            const f32x2 a01 = __builtin_amdgcn_cvt_pk_f32_fp8((int)a, false), a23 = __builtin_amdgcn_cvt_pk_f32_fp8((int)a, true), c01 = __builtin_amdgcn_cvt_pk_f32_fp8((int)c, false), c23 = __builtin_amdgcn_cvt_pk_f32_fp8((int)c, true);
            v[j].x = ALPHA * x.x + w0 * a01[0] + w1 * c01[0]; v[j].y = ALPHA * x.y + w0 * a01[1] + w1 * c01[1];
            v[j].z = ALPHA * x.z + w0 * a23[0] + w1 * c23[0]; v[j].w = ALPHA * x.w + w0 * a23[1] + w1 * c23[1];
        }
        ln_row(v, g, b);
#pragma unroll
        for (int j = 0; j < 4; ++j) ((f32x4*)(F.out + (size_t)row * DM))[lane + 64 * j] = v[j];
        if (l == 0) {
#pragma unroll
            for (int j = 0; j < 4; ++j) ((unsigned*)(F.ws + WS_XB8 + (size_t)row * DM))[lane + 64 * j] = pk4_fp8(v[j].x * 16.f, v[j].y * 16.f, v[j].z * 16.f, v[j].w * 16.f);
        }
    }
}

constexpr float C2D = 0.18033688011112042f;
constexpr float C2M = 0.14724444602590306f;
constexpr float IWS = 0.044194173824159216f;
constexpr float RMS_EPS = 1e-6f;
constexpr int L_QSLOT = L_CTL + 1152;

__device__ __forceinline__ int rope16(int c) { return c < 16 ? (c >> 1) + 8 * (c & 1) : c; }
__device__ __forceinline__ int win_src(int n, float& sc) {
    sc = 1.f;
    if (n < 384) return n;
    if (n < 416) { const int c = n - 384; return 384 + (c >> 1) + 16 * (c & 1); }
    if (n < 512) return -1;
    if (n < 2816) { const int m = n - 512, g = m / 768, r = m % 768, p = r >> 8, hh = (r & 255) >> 6, c = r & 63; if (p == 0) sc = C2D; return 416 + 768 * g + 256 * p + 64 * hh + (p < 2 ? rope16(c) : c); }
    if (n < 3328) { const int m = n - 2816; sc = C2D; return 2720 + (m & ~63) + rope16(m & 63); }
    if (n < 3840) { const int m = n - 3328; return 3360 + (m & ~63) + rope16(m & 63); }
    const int m = n - 3840;
    if (m < 64) return 3232 + rope16(m);
    if (m < 128) return 3296 + (m - 64);
    if (m < 192) return 3872 + rope16(m - 128);
    if (m < 200) { sc = IWS; return 3936 + (m - 192); }
    return -1;
}

__device__ __forceinline__ void sincos_d(double x, double& s, double& c) {
    const double n = __builtin_rint(x * 0.15915494309189535);
    double r = __builtin_fma(-n, 6.2831854820251465, x); r = __builtin_fma(n, 1.7484556025237907e-07, r);
    const double r2 = r * r; double ss = 1.0, cc = 1.0;
#pragma unroll
    for (int k = 15; k >= 1; --k) { ss = 1.0 - r2 * (1.0 / (double)((2 * k) * (2 * k + 1))) * ss; cc = 1.0 - r2 * (1.0 / (double)((2 * k - 1) * (2 * k))) * cc; }
    s = ss * r; c = cc;
}
__device__ __forceinline__ double inv_freq16(int i) {
    const double t[16] = {1.0, 0.44036660267178046, 0.19392274474868576, 0.08539710028576561, 0.03760603093086393, 0.016560440080994446, 0.007292664737217109, 0.003211445994752591,
                          0.001414213562373095, 0.000622772421914596, 0.0002742481756762073, 0.00012076973741146504, 5.318295896944988e-05, 2.341999896140934e-05, 1.031338537721246e-05, 4.5416704806078695e-06};
    double r = t[0];
#pragma unroll
    for (int k = 1; k < 16; ++k) r = (i == k) ? t[k] : r;
    return r;
}

__device__ __forceinline__ void phase_conv_mixer(Frame& F, int l) {
    PHASE_IDS(F);
    LAS float* scr = (LAS float*)(F.lds + F.wave * 16384);
    const int gw = F.vcu * NWAVES + F.wave, NGW = F.G * NWAVES;
    const float* win = F.in[1] + (size_t)l * DM * CIN;
    const float* qg = F.in[2] + (size_t)l * 256; const float* wuq = F.in[3] + (size_t)l * 256 * 768;
    const float* kg = F.in[4] + (size_t)l * 128; const float* wukv = F.in[5] + (size_t)l * 128 * 1024;
    const float* wgate = F.in[6] + (size_t)l * DM * 3072;
    const float* wa = F.in[8] + (size_t)l * 512 * DM; const float* wb = F.in[9] + (size_t)l * 256 * DM; const float* wc = F.in[10] + (size_t)l * 512 * DM; const float* wo = F.in[11] + (size_t)l * DM * DM;
    unsigned char* WIN8 = F.ws + WS_WIN8; bf16_t* WUQ = (bf16_t*)(F.ws + WS_WUQ); bf16_t* WUKV = (bf16_t*)(F.ws + WS_WUKV);
    bf16_t* WA = (bf16_t*)(F.ws + WS_WA); bf16_t* WB = (bf16_t*)(F.ws + WS_WB); bf16_t* WC = (bf16_t*)(F.ws + WS_WC); bf16_t* WO = (bf16_t*)(F.ws + WS_WO);
    constexpr int I_IN = 16 * 128, I_G = 16 * 96, I_UQ = 4 * 24, I_UKV = 4 * 32, I_A = 8 * 32, I_B = 8 * 32, I_C = 8 * 32, I_O = 16 * 32;
    constexpr int NIT = I_IN + I_G + I_UQ + I_UKV + I_A + I_B + I_C + I_O;
    for (int it = gw; it < NIT; it += NGW) {
        int r = it;
        if (r < I_IN) { conv_item8(WIN8, DM, (r / 128) * 64, (r % 128) * 32, scr, F.lane, [&](int k, int n) { float sc; const int sidx = win_src(n, sc); return sidx < 0 ? 0.f : win[(size_t)k * CIN + sidx] * (sc * 1024.f); }); continue; } r -= I_IN;
        if (r < I_G) { conv_plain8(WIN8 + (size_t)PW * DM, DM, (r / 96) * 64, (r % 96) * 32, scr, F.lane, wgate, 3072, 1024.f); continue; } r -= I_G;
        if (r < I_UQ) { conv_item(WUQ, 256, (r / 24) * 64, (r % 24) * 32, scr, F.lane, [&](int k, int n) { const int hh = n / 96, c = n % 96; const int o = c < 64 ? c : 64 + ((c - 64) >> 1) + 16 * ((c - 64) & 1);
                return qg[k] * wuq[(size_t)k * 768 + hh * 96 + o] * C2M; }); continue; } r -= I_UQ;
        if (r < I_UKV) { conv_item(WUKV, 256, (r / 32) * 64, (r % 32) * 32, scr, F.lane, [&](int k, int n) { return k < 128 ? kg[k] * wukv[(size_t)k * 1024 + n] : 0.f; }); continue; } r -= I_UKV;
        if (r < I_A) { conv_plain8((unsigned char*)WA, 512, (r / 32) * 64, (r % 32) * 32, scr, F.lane, wa, DM, 1024.f); continue; } r -= I_A;
        if (r < I_B) { conv_item8((unsigned char*)WB, 512, (r / 32) * 64, (r % 32) * 32, scr, F.lane, [&](int k, int n) { return k < 256 ? wb[(size_t)k * DM + n] * 1024.f : 0.f; }); continue; } r -= I_B;
        if (r < I_C) { conv_plain8((unsigned char*)WC, 512, (r / 32) * 64, (r % 32) * 32, scr, F.lane, wc, DM, 1024.f); continue; } r -= I_C;
        conv_plain8((unsigned char*)WO, DM, (r / 32) * 64, (r % 32) * 32, scr, F.lane, wo, DM, 1024.f);
    }
    if (l == 0) {
        float* rp = (float*)(F.ws + WS_ROPE); float* rm = rp + 2048 * 8 * 2;
        for (int idx = F.vcu * NTHREADS + F.tid; idx < 2048 * 24; idx += F.G * NTHREADS) {
            const int t = idx / 24, j = idx % 24; double sn, cs;
            if (j < 8) { sincos_d((double)t * inv_freq16(2 * j), sn, cs); rp[(t * 8 + j) * 2] = (float)cs; rp[(t * 8 + j) * 2 + 1] = (float)sn; }
            else { sincos_d((double)t * inv_freq16(j - 8), sn, cs); rm[(t * 16 + (j - 8)) * 2] = (float)cs; rm[(t * 16 + (j - 8)) * 2 + 1] = (float)sn; }
        }
        const f32x4* x4 = (const f32x4*)F.in[0]; unsigned* xb8 = (unsigned*)(F.ws + WS_XB8);
        for (size_t i = (size_t)F.vcu * NTHREADS + F.tid; i < (size_t)TT * DM / 4; i += (size_t)F.G * NTHREADS) { const f32x4 v = x4[i] * 16.f; xb8[i] = pk4_fp8(v.x, v.y, v.z, v.w); }
    }
}

__device__ __forceinline__ void rope4(f32x4& v0, f32x4& v1, const float* cs) {
    const f32x4 a = *(const f32x4*)cs, b = *(const f32x4*)(cs + 4);
    const f32x4 w0 = {v0[0] * a[0] - v0[1] * a[1], v0[1] * a[0] + v0[0] * a[1], v0[2] * a[2] - v0[3] * a[3], v0[3] * a[2] + v0[2] * a[3]};
    const f32x4 w1 = {v1[0] * b[0] - v1[1] * b[1], v1[1] * b[0] + v1[0] * b[1], v1[2] * b[2] - v1[3] * b[3], v1[3] * b[2] + v1[2] * b[3]};
    v0 = w0; v1 = w1;
}
__device__ __forceinline__ void store8(bf16_t* p, const f32x4& v0, const f32x4& v1) {
    u32x4 w; w.x = cvt_pk_bf16(v0[0], v0[1]); w.y = cvt_pk_bf16(v0[2], v0[3]); w.z = cvt_pk_bf16(v1[0], v1[1]); w.w = cvt_pk_bf16(v1[2], v1[3]); *(u32x4*)p = w;
}
struct EpiProj {
    bf16_t* P; const float* csp; const float* csm; float* ssq; bf16_t* G3; const LAS float* gbias;
    __device__ __forceinline__ void operator()(const f32x4 (&acc)[2][2][4][2], const pg8::Unit& u, int wr, int wc, int fr, int fq) const {
        const int pn = u.pn, row0 = u.pm * 256 + wr * 64 + fr;
        if (pn >= 16) {
#pragma unroll
            for (int bj = 0; bj < 2; ++bj) { const int col = (pn - 16) * 256 + bj * 128 + wc * 32 + fq * 8;
                const f32x4 b0 = *(const LAS f32x4*)(gbias + col), b1 = *(const LAS f32x4*)(gbias + col + 4);
#pragma unroll
                for (int ai = 0; ai < 2; ++ai)
#pragma unroll
                    for (int m = 0; m < 4; ++m) { f32x4 v0 = acc[ai][bj][m][0] + b0, v1 = acc[ai][bj][m][1] + b1;
#pragma unroll
                        for (int e = 0; e < 4; ++e) { v0[e] = sigmoidf_(v0[e]); v1[e] = sigmoidf_(v1[e]); }
                        store8_fp8((unsigned char*)G3 + (size_t)(row0 + ai * 128 + m * 16) * 3072 + col, v0, v1, 64.f); } }
            return;
        }
#pragma unroll
        for (int bj = 0; bj < 2; ++bj) {
            const int wcu = __builtin_amdgcn_readfirstlane(wc);
            bool ropeP = false, ropeM = false;
            if (pn == 1) ropeM = (bj == 1 && wcu == 0);
            else if (pn >= 2 && pn < 11) ropeP = ((pn - 2) % 3) < 2 && !(wcu & 1);
            else if (pn >= 11 && pn < 15) ropeP = !(wcu & 1);
            else if (pn == 15) ropeP = (wcu == 0);
            const int col = pn * 256 + bj * 128 + wc * 32 + fq * 8;
            if (ropeP || ropeM) {
                const bool lr = ropeM || fq < 2;
                const float* cb = ropeM ? csm + 8 * fq : csp + 8 * (fq & 1);
                const int ts = ropeM ? 32 : 16;
#pragma unroll
                for (int ai = 0; ai < 2; ++ai)
#pragma unroll
                    for (int mh = 0; mh < 2; ++mh) {
                        f32x4 ca[2], cc[2];
#pragma unroll
                        for (int mm = 0; mm < 2; ++mm) { const int t = (row0 + ai * 128 + (2 * mh + mm) * 16) & (SEQ - 1);
                            ca[mm] = *(const f32x4*)(cb + t * ts); cc[mm] = *(const f32x4*)(cb + t * ts + 4); }
#pragma unroll
                        for (int mm = 0; mm < 2; ++mm) { const int m = 2 * mh + mm, row = row0 + ai * 128 + m * 16;
                            const f32x4 v0 = acc[ai][bj][m][0], v1 = acc[ai][bj][m][1];
                            f32x4 a = ca[mm], b = cc[mm];
                            if (!lr) { a = (f32x4){1.f, 0.f, 1.f, 0.f}; b = a; }
                            const f32x4 w0 = {v0[0] * a[0] - v0[1] * a[1], v0[1] * a[0] + v0[0] * a[1], v0[2] * a[2] - v0[3] * a[3], v0[3] * a[2] + v0[2] * a[3]};
                            const f32x4 w1 = {v1[0] * b[0] - v1[1] * b[1], v1[1] * b[0] + v1[0] * b[1], v1[2] * b[2] - v1[3] * b[3], v1[3] * b[2] + v1[2] * b[3]};
                            store8(P + (size_t)row * PW + col, w0, w1); }
                    }
            } else {
#pragma unroll
                for (int ai = 0; ai < 2; ++ai)
#pragma unroll
                    for (int m = 0; m < 4; ++m)
                        store8(P + (size_t)(row0 + ai * 128 + m * 16) * PW + col, acc[ai][bj][m][0], acc[ai][bj][m][1]);
            }
        }
        if (pn < 2) {
#pragma unroll
            for (int ai = 0; ai < 2; ++ai)
#pragma unroll
                for (int m = 0; m < 4; ++m) {
                    float sq = 0.f;
#pragma unroll
                    for (int bj = 0; bj < 2; ++bj) if (pn == 0 || bj == 0) {
#pragma unroll
                        for (int n = 0; n < 2; ++n) { const f32x4 x = acc[ai][bj][m][n]; sq += (x[0] * x[0] + x[1] * x[1]) + (x[2] * x[2] + x[3] * x[3]); } }
                    sq += __shfl_xor(sq, 16); sq += __shfl_xor(sq, 32);
                    if (fq == 0) ssq[(size_t)(row0 + ai * 128 + m * 16) * 8 + pn * 4 + wc] = sq;
                }
        }
    }
};
struct EpiUpQ {
    bf16_t* Q; const float* csm; const float* ssq;
    __device__ __forceinline__ void operator()(const f32x4 (&acc)[2][2][4][2], const pg8::Unit& u, int wr, int wc, int fr, int fq) const {
        const int row0 = u.pm * 256 + wr * 64 + fr;
        f32x4 spv[2][4];
#pragma unroll
        for (int ai = 0; ai < 2; ++ai)
#pragma unroll
            for (int m = 0; m < 4; ++m) spv[ai][m] = *(const f32x4*)(ssq + (size_t)(row0 + ai * 128 + m * 16) * 8);
#pragma unroll
        for (int ai = 0; ai < 2; ++ai)
#pragma unroll
            for (int m = 0; m < 4; ++m) { const f32x4 sp = spv[ai][m];
                spv[ai][m][0] = 1.0f / sqrtf(((sp[0] + sp[1]) + (sp[2] + sp[3])) * (1.f / 256.f) + RMS_EPS); }
        const int wcu = __builtin_amdgcn_readfirstlane(wc);
#pragma unroll
        for (int bj = 0; bj < 2; ++bj) {
            const int c0 = u.pn * 256 + bj * 128 + wcu * 32, col = c0 + fq * 8;
            if (((c0 >> 5) % 3) == 2) {
#pragma unroll
                for (int ai = 0; ai < 2; ++ai)
#pragma unroll
                    for (int mh = 0; mh < 2; ++mh) {
                        f32x4 ca[2], cc[2];
#pragma unroll
                        for (int mm = 0; mm < 2; ++mm) { const int t = (row0 + ai * 128 + (2 * mh + mm) * 16) & (SEQ - 1);
                            ca[mm] = *(const f32x4*)(csm + t * 32 + 8 * fq); cc[mm] = *(const f32x4*)(csm + t * 32 + 8 * fq + 4); }
#pragma unroll
                        for (int mm = 0; mm < 2; ++mm) { const int m = 2 * mh + mm, row = row0 + ai * 128 + m * 16;
                            const float rs = spv[ai][m][0];
                            const f32x4 v0 = acc[ai][bj][m][0] * rs, v1 = acc[ai][bj][m][1] * rs, a = ca[mm], b = cc[mm];
                            const f32x4 w0 = {v0[0] * a[0] - v0[1] * a[1], v0[1] * a[0] + v0[0] * a[1], v0[2] * a[2] - v0[3] * a[3], v0[3] * a[2] + v0[2] * a[3]};
                            const f32x4 w1 = {v1[0] * b[0] - v1[1] * b[1], v1[1] * b[0] + v1[0] * b[1], v1[2] * b[2] - v1[3] * b[3], v1[3] * b[2] + v1[2] * b[3]};
                            store8(Q + (size_t)row * 768 + col, w0, w1); }
                    }
            } else {
#pragma unroll
                for (int ai = 0; ai < 2; ++ai)
#pragma unroll
                    for (int m = 0; m < 4; ++m) { const float rs = spv[ai][m][0];
                        store8(Q + (size_t)(row0 + ai * 128 + m * 16) * 768 + col, acc[ai][bj][m][0] * rs, acc[ai][bj][m][1] * rs); }
            }
        }
    }
};
struct EpiUpKV {
    bf16_t* KV; const float* ssq;
    __device__ __forceinline__ void operator()(const f32x4 (&acc)[2][2][4][2], const pg8::Unit& u, int wr, int wc, int fr, int fq) const {
        const int row0 = u.pm * 256 + wr * 64 + fr;
        f32x4 spv[2][4];
#pragma unroll
        for (int ai = 0; ai < 2; ++ai)
#pragma unroll
            for (int m = 0; m < 4; ++m) spv[ai][m] = *(const f32x4*)(ssq + (size_t)(row0 + ai * 128 + m * 16) * 8 + 4);
#pragma unroll
        for (int ai = 0; ai < 2; ++ai)
#pragma unroll
            for (int m = 0; m < 4; ++m) {
                const int row = row0 + ai * 128 + m * 16;
                const f32x4 sp = spv[ai][m];
                const float rs = 1.0f / sqrtf(((sp[0] + sp[1]) + (sp[2] + sp[3])) * (1.f / 128.f) + RMS_EPS);
#pragma unroll
                for (int bj = 0; bj < 2; ++bj) { const int col = u.pn * 256 + bj * 128 + wc * 32 + fq * 8;
                    store8(KV + (size_t)row * 1024 + col, acc[ai][bj][m][0] * rs, acc[ai][bj][m][1] * rs); }
            }
    }
};
struct EpiBranchAll {
    bf16_t* Mg; bf16_t* M0; bf16_t* M1; const bf16_t* G3;
    __device__ __forceinline__ void operator()(const f32x4 (&acc)[2][2][4][2], const pg8::Unit& u, int wr, int wc, int fr, int fq) const {
        const int row0 = u.pm * 256 + wr * 64 + fr, br = u.ord, col0 = u.pn * 256 + wc * 32 + fq * 8;
        bf16_t* dst = br == 0 ? M0 : (br == 1 ? M1 : Mg);
#pragma unroll
        for (int ai = 0; ai < 2; ++ai)
#pragma unroll
            for (int mh = 0; mh < 2; ++mh) {
                u32x2 gw[2][2]; u32x4 ma[2][2], mb[2][2];
#pragma unroll
                for (int mm = 0; mm < 2; ++mm)
#pragma unroll
                    for (int bj = 0; bj < 2; ++bj) { const int row = row0 + ai * 128 + (2 * mh + mm) * 16, col = col0 + bj * 128;
                        gw[mm][bj] = *(const u32x2*)((const unsigned char*)G3 + (size_t)row * 3072 + br * 1024 + col);
                        ma[mm][bj] = (u32x4){0u, 0u, 0u, 0u}; mb[mm][bj] = (u32x4){0u, 0u, 0u, 0u}; }
                if (br == 2) {
#pragma unroll
                    for (int mm = 0; mm < 2; ++mm)
#pragma unroll
                        for (int bj = 0; bj < 2; ++bj) { const size_t off = (size_t)(row0 + ai * 128 + (2 * mh + mm) * 16) * DM + col0 + bj * 128;
                            const u32x2 p = *(const u32x2*)((const unsigned char*)M0 + off), q = *(const u32x2*)((const unsigned char*)M1 + off);
                            ma[mm][bj] = (u32x4){p.x, p.y, 0u, 0u}; mb[mm][bj] = (u32x4){q.x, q.y, 0u, 0u}; }
                }
#pragma unroll
                for (int mm = 0; mm < 2; ++mm)
#pragma unroll
                    for (int bj = 0; bj < 2; ++bj) { const int m = 2 * mh + mm; const size_t off = (size_t)(row0 + ai * 128 + m * 16) * DM + col0 + bj * 128; const u32x2 g = gw[mm][bj]; const u32x4 a = ma[mm][bj], b2 = mb[mm][bj];
                        const f32x2 g01 = __builtin_amdgcn_cvt_pk_f32_fp8((int)g.x, false) * (1.f / 64.f), g23 = __builtin_amdgcn_cvt_pk_f32_fp8((int)g.x, true) * (1.f / 64.f);
                        const f32x2 g45 = __builtin_amdgcn_cvt_pk_f32_fp8((int)g.y, false) * (1.f / 64.f), g67 = __builtin_amdgcn_cvt_pk_f32_fp8((int)g.y, true) * (1.f / 64.f);
                        f32x4 v0 = acc[ai][bj][m][0], v1 = acc[ai][bj][m][1];
                        const f32x2 s01 = (__builtin_amdgcn_cvt_pk_f32_fp8((int)a.x, false) + __builtin_amdgcn_cvt_pk_f32_fp8((int)b2.x, false)) * (1.f / 64.f), s23 = (__builtin_amdgcn_cvt_pk_f32_fp8((int)a.x, true) + __builtin_amdgcn_cvt_pk_f32_fp8((int)b2.x, true)) * (1.f / 64.f);
                        const f32x2 s45 = (__builtin_amdgcn_cvt_pk_f32_fp8((int)a.y, false) + __builtin_amdgcn_cvt_pk_f32_fp8((int)b2.y, false)) * (1.f / 64.f), s67 = (__builtin_amdgcn_cvt_pk_f32_fp8((int)a.y, true) + __builtin_amdgcn_cvt_pk_f32_fp8((int)b2.y, true)) * (1.f / 64.f);
                        v0[0] = v0[0] * g01[0] + s01[0]; v0[1] = v0[1] * g01[1] + s01[1]; v0[2] = v0[2] * g23[0] + s23[0]; v0[3] = v0[3] * g23[1] + s23[1];
                        v1[0] = v1[0] * g45[0] + s45[0]; v1[1] = v1[1] * g45[1] + s45[1]; v1[2] = v1[2] * g67[0] + s67[0]; v1[3] = v1[3] * g67[1] + s67[1];
                        store8_fp8((unsigned char*)dst + off, v0, v1, 64.f); }
            }
    }
};
struct BranchSched {
    static constexpr bool GATHER = false; static constexpr bool VARK = true;
    const bf16_t* A[3]; const bf16_t* B[3]; int lda, ldb, c, sw8, sa8;
    __device__ __forceinline__ int ktiles(const pg8::Unit& u) const { return u.ord == 1 ? 2 : 4; }
    __device__ __forceinline__ bool next(int i, pg8::Unit& u) const { if (i >= 3) return false; u.pm = c >> 2; u.pn = c & 3; u.ord = i; return true; }
    __device__ __forceinline__ const char* a_base(const pg8::Unit& u) const { const bf16_t* p = u.ord == 0 ? A[0] : (u.ord == 1 ? A[1] : A[2]); return (const char*)(p + (size_t)u.pm * 256 * lda); }
    __device__ __forceinline__ const char* b_base(const pg8::Unit& u) const { const bf16_t* p = u.ord == 0 ? B[0] : (u.ord == 1 ? B[1] : B[2]); return (const char*)(p + (size_t)u.pn * 256 * ldb); }
    __device__ __forceinline__ void a_off(const pg8::Unit&, const int (&R)[2], const int (&C)[2], unsigned (&v)[2][2]) const {
#pragma unroll
        for (int i = 0; i < 2; ++i) { v[0][i] = (unsigned)(R[i] * lda + C[i]) * 2u; v[1][i] = (unsigned)((128 + R[i]) * lda + C[i]) * 2u; }
    }
};
struct EpiWo {
    float* out; const float* xsrc; int rowbase;
    __device__ __forceinline__ void operator()(const f32x4 (&acc)[2][2][4][2], const pg8::Unit& u, int wr, int wc, int fr, int fq) const {
        const int row0 = rowbase + u.pm * 256 + wr * 64 + fr, col0 = u.pn * 256 + wc * 32 + fq * 8;
#pragma unroll
        for (int ai = 0; ai < 2; ++ai)
#pragma unroll
            for (int mh = 0; mh < 2; ++mh) {
                f32x4 x[2][2][2];
#pragma unroll
                for (int mm = 0; mm < 2; ++mm)
#pragma unroll
                    for (int bj = 0; bj < 2; ++bj) { const size_t off = (size_t)(row0 + ai * 128 + (2 * mh + mm) * 16) * DM + col0 + bj * 128;
                        x[mm][bj][0] = *(const f32x4*)(xsrc + off); x[mm][bj][1] = *(const f32x4*)(xsrc + off + 4); }
#pragma unroll
                for (int mm = 0; mm < 2; ++mm)
#pragma unroll
                    for (int bj = 0; bj < 2; ++bj) { const size_t off = (size_t)(row0 + ai * 128 + (2 * mh + mm) * 16) * DM + col0 + bj * 128;
                        *(f32x4*)(out + off) = x[mm][bj][0] * ALPHA + acc[ai][bj][2 * mh + mm][0]; *(f32x4*)(out + off + 4) = x[mm][bj][1] * ALPHA + acc[ai][bj][2 * mh + mm][1]; }
            }
    }
};

__device__ __forceinline__ int dequeue(Frame& F, unsigned* ctr, int& pre) {
    LAS int* slot = (LAS int*)(F.lds + L_QSLOT);
    __syncthreads();
    if (F.tid == 0) {
        *slot = (int)__hip_atomic_fetch_add(ctr, 1u, __ATOMIC_RELAXED, __HIP_MEMORY_SCOPE_AGENT); (void)pre;
    }
    __syncthreads();
    return *slot;
}

namespace att {
constexpr int KSLOT = 12288, VSLOT = 8192, NSLOT = 4;
constexpr int A_K = 0, A_V = NSLOT * KSLOT, A_WS = A_V + NSLOT * VSLOT, A_OST = A_WS + 8 * 256, A_MW = A_OST + 8 * 4096, A_END = A_MW + 8 * NSLOT * 256;
static_assert(A_END <= RING_BYTES, "attention LDS");
typedef short s16x4 __attribute__((ext_vector_type(4)));
__device__ __forceinline__ int crow(int r, int hi) { return (r & 3) + 8 * (r >> 2) + 4 * hi; }
__device__ __forceinline__ void glds16(const void* gsrc, unsigned lds_dst) { unsigned keep;
    asm volatile("s_mov_b32 %0, m0\n\ts_mov_b32 m0, %2\n\ts_nop 0\n\tglobal_load_lds_dwordx4 %1, off\n\ts_mov_b32 m0, %0" : "=&s"(keep) : "v"(gsrc), "s"(lds_dst) : "memory"); }
__device__ __forceinline__ void glds4(const void* gsrc, unsigned lds_dst) { unsigned keep;
    asm volatile("s_mov_b32 %0, m0\n\ts_mov_b32 m0, %2\n\ts_nop 0\n\tglobal_load_lds_dword %1, off\n\ts_mov_b32 m0, %0" : "=&s"(keep) : "v"(gsrc), "s"(lds_dst) : "memory"); }
#define ATT_WAIT_BAR(N) asm volatile("s_waitcnt vmcnt(" #N ") lgkmcnt(0)\n\ts_barrier" ::: "memory")
__device__ __forceinline__ float emax(float a, float b) { return __builtin_elementwise_maximum(a, b); }
__device__ __forceinline__ float halfmax(float m) { auto rr = __builtin_amdgcn_permlane32_swap(__float_as_uint(m), __float_as_uint(m), false, false); return emax(__uint_as_float(rr[0]), __uint_as_float(rr[1])); }
__device__ __forceinline__ float halfsum(float m) { auto rr = __builtin_amdgcn_permlane32_swap(__float_as_uint(m), __float_as_uint(m), false, false); return __uint_as_float(rr[0]) + __uint_as_float(rr[1]); }
typedef short v4i16_t __attribute__((ext_vector_type(4)));
__device__ __forceinline__ s16x4 vtr(const LAS unsigned char* p) { return __builtin_bit_cast(s16x4, __builtin_amdgcn_ds_read_tr16_b64_v4i16((LAS v4i16_t*)p)); }
__device__ __forceinline__ void pv(f32x16* o, f32x16& lacc, const LAS unsigned char* vp, bf16x8 pa0, bf16x8 pa1, bf16x8 pa2, bf16x8 pa3) {
    { const u32x4 one4 = {0x3F803F80u, 0x3F803F80u, 0x3F803F80u, 0x3F803F80u}; const bf16x8 ones = __builtin_bit_cast(bf16x8, one4);
      lacc = __builtin_amdgcn_mfma_f32_32x32x16_bf16(pa0, ones, lacc, 0, 0, 0); lacc = __builtin_amdgcn_mfma_f32_32x32x16_bf16(pa1, ones, lacc, 0, 0, 0);
      lacc = __builtin_amdgcn_mfma_f32_32x32x16_bf16(pa2, ones, lacc, 0, 0, 0); lacc = __builtin_amdgcn_mfma_f32_32x32x16_bf16(pa3, ones, lacc, 0, 0, 0); }
#pragma unroll
    for (int d0 = 0; d0 < 2; ++d0) { s16x4 lo[4], hi[4];
#pragma unroll
        for (int ks = 0; ks < 4; ++ks) { lo[ks] = vtr(vp + d0 * 4096 + ks * 1024); hi[ks] = vtr(vp + d0 * 4096 + ks * 1024 + 512); }
#define ATT_PK(k) (bf16x8){lo[k][0], lo[k][1], lo[k][2], lo[k][3], hi[k][0], hi[k][1], hi[k][2], hi[k][3]}
        o[d0] = __builtin_amdgcn_mfma_f32_32x32x16_bf16(pa0, ATT_PK(0), o[d0], 0, 0, 0);
        o[d0] = __builtin_amdgcn_mfma_f32_32x32x16_bf16(pa1, ATT_PK(1), o[d0], 0, 0, 0);
        o[d0] = __builtin_amdgcn_mfma_f32_32x32x16_bf16(pa2, ATT_PK(2), o[d0], 0, 0, 0);
        o[d0] = __builtin_amdgcn_mfma_f32_32x32x16_bf16(pa3, ATT_PK(3), o[d0], 0, 0, 0);
#undef ATT_PK
    }
}
struct Desc {
    const bf16_t* Q; const bf16_t* K1; const bf16_t* K2; const bf16_t* V; bf16_t* O; float* lse; const unsigned* mask;
    int qpitch, k1pitch, k2pitch, vpitch, opitch, lsepitch;
    int rstride, q0, nq, jlo, jhi;
    int o8;
};
template <int DQK, int MODE>
__device__ __forceinline__ void attn_unit(LAS unsigned char* lds, const Desc& d) {
    int tid_ = threadIdx.x; asm volatile("" : "+v"(tid_));
    const int tid = tid_, lane = tid & 63, r32 = lane & 31, hi = lane >> 5, wid = __builtin_amdgcn_readfirstlane(tid >> 6);
    constexpr int ND = DQK / 16;
    const unsigned lds0 = (unsigned)(size_t)lds;
    LAS float* wsf = (LAS float*)(lds + A_WS) + wid * 64;
    const int qw = d.q0 + wid * 32;
    const bool wvalid = wid * 32 < d.nq;
    const int kkey = 8 * wid + (lane >> 3), kch = (lane & 7) ^ ((kkey >> 1) & 7);
    const bf16_t* ksrc = d.K1 + (size_t)kkey * d.rstride * d.k1pitch + kch * 8;
    const int k2key = 16 * (wid & 3) + (lane >> 2), k2ch = (lane & 3) ^ ((k2key >> 2) & 3);
    const bf16_t* k2src = (DQK == 96) ? d.K2 + (size_t)k2key * d.rstride * d.k2pitch + k2ch * 8 : nullptr;
    int kofs[ND];
#pragma unroll
    for (int d0 = 0; d0 < ND; ++d0) kofs[d0] = d0 < 4 ? r32 * 128 + (((2 * d0 + hi) ^ ((r32 >> 1) & 7)) * 16) : 8192 + r32 * 64 + (((2 * (d0 - 4) + hi) ^ ((r32 >> 2) & 3)) * 16);
    const bf16_t* vsrc = d.V + (size_t)(16 * (wid & 3) + (lane >> 2)) * d.rstride * d.vpitch + (wid >> 2) * 32 + (lane & 3) * 8;
    const size_t kstep = (size_t)64 * d.rstride * d.k1pitch, k2step = (size_t)64 * d.rstride * d.k2pitch, vstep = (size_t)64 * d.rstride * d.vpitch;
    const bool two = (DQK == 96) && wid < 4;
    const unsigned* msrc = (MODE == 2) ? d.mask + (size_t)(wvalid ? (qw + (lane >> 1)) : d.q0) * 64 + (lane & 1) : nullptr;
#define ATT_ISSUE(j) do { const int sl_ = (j) % NSLOT; \
        glds16(ksrc + (size_t)(j) * kstep, (unsigned)__builtin_amdgcn_readfirstlane(lds0 + A_K + sl_ * KSLOT + wid * 1024)); \
        if (two) glds16(k2src + (size_t)(j) * k2step, (unsigned)__builtin_amdgcn_readfirstlane(lds0 + A_K + sl_ * KSLOT + (8 + wid) * 1024)); \
        glds16(vsrc + (size_t)(j) * vstep, (unsigned)__builtin_amdgcn_readfirstlane(lds0 + A_V + sl_ * VSLOT + wid * 1024)); \
        if (MODE == 2) glds4(msrc + 2 * (j), (unsigned)__builtin_amdgcn_readfirstlane(lds0 + A_MW + (wid * NSLOT + sl_) * 256)); } while (0)
    ATT_ISSUE(d.jlo);
    if (d.jlo + 1 < d.jhi) ATT_ISSUE(d.jlo + 1);
    bf16x8 qr[ND];
    if (DQK == 64) {
        LAS unsigned char* qs = lds + A_OST + wid * 4096;
        u32x4 qv[4];
#pragma unroll
        for (int i = 0; i < 4; ++i) { const int row = (lane >> 3) + 8 * i; const int qi = wvalid ? (qw + row) : d.q0;
            qv[i] = *(const u32x4*)(d.Q + (size_t)qi * d.rstride * d.qpitch + (((lane & 7) ^ ((row >> 1) & 7)) * 8)); }
#pragma unroll
        for (int i = 0; i < 4; ++i) *(LAS u32x4*)(qs + ((lane >> 3) + 8 * i) * 128 + (lane & 7) * 16) = qv[i];
#pragma unroll
        for (int d0 = 0; d0 < ND; ++d0) qr[d0] = *(const LAS bf16x8*)(qs + r32 * 128 + (((2 * d0 + hi) ^ ((r32 >> 1) & 7)) * 16));
    } else {
      const int qi = wvalid ? (qw + r32) : d.q0; const bf16_t* qp = d.Q + (size_t)qi * d.rstride * d.qpitch + hi * 8;
#pragma unroll
      for (int d0 = 0; d0 < ND; ++d0) qr[d0] = *(const bf16x8*)(qp + d0 * 16); }
#pragma unroll
    for (int d0 = 0; d0 < ND; ++d0) asm volatile("" : "+v"(qr[d0]));
    float mhat = 0.f; f32x16 o[2]; o[0] = f32x16{}; o[1] = f32x16{}; f32x16 lacc = f32x16{};
    bool started = false;
    const LAS unsigned char* vp0 = lds + A_V + ((lane >> 4) & 1) * 32 + (lane & 3) * 8 + (4 * hi + ((lane & 15) >> 2)) * 64;
    const int qi = qw + r32;
    f32x16 p0 = f32x16{}, p1 = f32x16{};
    f32x16 negm = f32x16{};
#define ATT_REL(j) (wvalid && (64 * (j) <= qw + 31) && (MODE != 1 || (64 * (j) + 63 >= qw - 128)))
#define ATT_QK(j) do { const int sl_ = (j) % NSLOT; \
        const LAS unsigned char* kb = lds + A_K + sl_ * KSLOT; bf16x8 kf[2 * ND]; \
        _Pragma("unroll") for (int d0 = 0; d0 < ND; ++d0) { kf[2 * d0] = *(const LAS bf16x8*)(kb + kofs[d0]); kf[2 * d0 + 1] = *(const LAS bf16x8*)(kb + kofs[d0] + (d0 < 4 ? 4096 : 2048)); } \
        __builtin_amdgcn_sched_barrier(0); \
        _Pragma("unroll") for (int d0 = 0; d0 < ND; ++d0) { \
            if (d0 == 0) { p0 = __builtin_amdgcn_mfma_f32_32x32x16_bf16(kf[0], qr[0], negm, 0, 0, 0); p1 = __builtin_amdgcn_mfma_f32_32x32x16_bf16(kf[1], qr[0], negm, 0, 0, 0); } \
            else { p0 = __builtin_amdgcn_mfma_f32_32x32x16_bf16(kf[2 * d0], qr[d0], p0, 0, 0, 0); p1 = __builtin_amdgcn_mfma_f32_32x32x16_bf16(kf[2 * d0 + 1], qr[d0], p1, 0, 0, 0); } } } while (0)
#define ATT_SMPV(j) do { const int sl_ = (j) % NSLOT; \
        { bool domask = true; unsigned mx_ = 0u, my_ = 0u;        \
          if (MODE == 2) { const u32x2 mw = *(const LAS u32x2*)(lds + A_MW + (wid * NSLOT + sl_) * 256 + r32 * 8); mx_ = mw.x; my_ = mw.y; } \
          else { \
            bool full = (64 * (j) + 63 <= qw); \
            if (MODE == 1) full = full && (64 * (j) >= qw + 31 - 128); \
            domask = !full; \
            if (domask) { const int a_ = qi - 64 * (j), lo_ = (MODE == 1) ? a_ - 128 : -4096;        \
                { const int h_ = a_ < 31 ? a_ : 31, l_ = lo_ > 0 ? lo_ : 0; mx_ = (h_ < l_) ? 0u : ((0xFFFFFFFFu >> (31 - h_)) & (0xFFFFFFFFu << l_)); } \
                { const int h_ = a_ - 32 < 31 ? a_ - 32 : 31, l_ = lo_ - 32 > 0 ? lo_ - 32 : 0; my_ = (h_ < l_) ? 0u : ((0xFFFFFFFFu >> (31 - h_)) & (0xFFFFFFFFu << l_)); } } \
          } \
          if (domask) { const unsigned w0 = mx_ >> (4 * hi), w1 = my_ >> (4 * hi); \
            _Pragma("unroll") for (int r = 0; r < 16; ++r) { const int bit = (r & 3) + 8 * (r >> 2); \
                const unsigned m0 = (unsigned)__builtin_amdgcn_sbfe((int)w0, bit, 1), m1 = (unsigned)__builtin_amdgcn_sbfe((int)w1, bit, 1);        \
                p0[r] = __uint_as_float((m0 & __float_as_uint(p0[r])) | (~m0 & 0xFF800000u)); p1[r] = __uint_as_float((m1 & __float_as_uint(p1[r])) | (~m1 & 0xFF800000u)); } } } \
        float rm = emax(p0[0], p1[0]), rm2 = emax(p0[1], p1[1]); \
        _Pragma("unroll") for (int r = 2; r < 16; r += 2) { rm = emax(emax(rm, p0[r]), p1[r]); rm2 = emax(emax(rm2, p0[r + 1]), p1[r + 1]); } \
        rm = halfmax(emax(rm, rm2)); \
        bool need; float dl; \
        if (!started) { need = true; dl = emax(rm, -200.f); } else { need = __any(rm > 8.f) != 0; dl = emax(rm, 0.f); } \
        if (need) { mhat += dl; \
            _Pragma("unroll") for (int r = 0; r < 16; ++r) negm[r] = -mhat; \
            _Pragma("unroll") for (int r = 0; r < 16; ++r) { p0[r] -= dl; p1[r] -= dl; } \
            if (started) { const float f = __builtin_amdgcn_exp2f(-dl); \
                if (hi == 0) wsf[r32] = f; \
                LDS_WAIT(); \
                _Pragma("unroll") for (int r = 0; r < 16; ++r) { const float fr_ = wsf[crow(r, hi)]; o[0][r] *= fr_; o[1][r] *= fr_; lacc[r] *= fr_; } } } \
        started = true; \
        __builtin_amdgcn_s_setprio(1);        \
        _Pragma("unroll") for (int r = 0; r < 16; ++r) { p0[r] = __builtin_amdgcn_exp2f(p0[r]); p1[r] = __builtin_amdgcn_exp2f(p1[r]); } \
        const u32x4 pw0 = (u32x4){cvt_pk_bf16(p0[0], p0[1]), cvt_pk_bf16(p0[2], p0[3]), cvt_pk_bf16(p0[4], p0[5]), cvt_pk_bf16(p0[6], p0[7])}; \
        const u32x4 pw1 = (u32x4){cvt_pk_bf16(p0[8], p0[9]), cvt_pk_bf16(p0[10], p0[11]), cvt_pk_bf16(p0[12], p0[13]), cvt_pk_bf16(p0[14], p0[15])}; \
        const u32x4 pw2 = (u32x4){cvt_pk_bf16(p1[0], p1[1]), cvt_pk_bf16(p1[2], p1[3]), cvt_pk_bf16(p1[4], p1[5]), cvt_pk_bf16(p1[6], p1[7])}; \
        const u32x4 pw3 = (u32x4){cvt_pk_bf16(p1[8], p1[9]), cvt_pk_bf16(p1[10], p1[11]), cvt_pk_bf16(p1[12], p1[13]), cvt_pk_bf16(p1[14], p1[15])}; \
        pv(o, lacc, vp0 + sl_ * VSLOT, __builtin_bit_cast(bf16x8, pw0), __builtin_bit_cast(bf16x8, pw1), __builtin_bit_cast(bf16x8, pw2), __builtin_bit_cast(bf16x8, pw3)); \
        __builtin_amdgcn_s_setprio(0); } while (0)
#define ATT_TOPWAIT(j) do { if ((j) + 1 < d.jhi) { if (MODE == 2 || two) { ATT_WAIT_BAR(3); } else { ATT_WAIT_BAR(2); } } else { ATT_WAIT_BAR(0); } } while (0)
    if (wid < 4) {
        for (int j = d.jlo; j < d.jhi; ++j) {
            ATT_TOPWAIT(j);
            if (j + 2 < d.jhi) ATT_ISSUE(j + 2);
            if (ATT_REL(j)) { ATT_QK(j); ATT_SMPV(j); }
        }
        asm volatile("s_waitcnt lgkmcnt(0)\n\ts_barrier" ::: "memory");
    } else {
        ATT_TOPWAIT(d.jlo);
        if (d.jlo + 2 < d.jhi) ATT_ISSUE(d.jlo + 2);
        if (ATT_REL(d.jlo)) ATT_QK(d.jlo);
        for (int j = d.jlo + 1; j < d.jhi; ++j) {
            ATT_TOPWAIT(j);
            if (j + 2 < d.jhi) ATT_ISSUE(j + 2);
            if (ATT_REL(j - 1)) ATT_SMPV(j - 1);
            if (ATT_REL(j)) ATT_QK(j);
        }
        asm volatile("s_waitcnt lgkmcnt(0)\n\ts_barrier" ::: "memory");
        if (ATT_REL(d.jhi - 1)) ATT_SMPV(d.jhi - 1);
    }
#undef ATT_REL
#undef ATT_QK
#undef ATT_SMPV
#undef ATT_TOPWAIT
#undef ATT_ISSUE
    if (wvalid) {
        LAS bf16_t* stg = (LAS bf16_t*)(lds + A_OST) + wid * 2048;
        if (d.lse != nullptr && r32 == 0) {
#pragma unroll
            for (int r = 0; r < 16; ++r) wsf[32 + crow(r, hi)] = lacc[r]; }
        if (d.o8) {
            LAS unsigned char* stg8 = (LAS unsigned char*)stg;
#pragma unroll
            for (int r = 0; r < 16; ++r) { const int orow = crow(r, hi); const float rl = __builtin_amdgcn_rcpf(lacc[r]) * 32.f;
                const unsigned p = (unsigned)__builtin_amdgcn_cvt_pk_fp8_f32(o[0][r] * rl, o[1][r] * rl, 0, false);
                stg8[orow * 64 + r32] = (unsigned char)(p & 0xffu); stg8[orow * 64 + 32 + r32] = (unsigned char)((p >> 8) & 0xffu); }
            LDS_WAIT();
#pragma unroll
            for (int i = 0; i < 2; ++i) { const int row = i * 16 + (lane >> 2), ch = lane & 3; const u32x4 v = *(const LAS u32x4*)(stg8 + row * 64 + ch * 16);
                *(u32x4*)((unsigned char*)d.O + (size_t)(qw + row) * d.rstride * d.opitch + ch * 16) = v; }
        } else {
#pragma unroll
        for (int r = 0; r < 16; ++r) { const int orow = crow(r, hi); const float rl = __builtin_amdgcn_rcpf(lacc[r]);
            stg[orow * 64 + r32] = (bf16_t)f2bf(o[0][r] * rl); stg[orow * 64 + 32 + r32] = (bf16_t)f2bf(o[1][r] * rl); }
        LDS_WAIT();
#pragma unroll
        for (int i = 0; i < 4; ++i) { const int row = i * 8 + (lane >> 3), ch = lane & 7; const u32x4 v = *(const LAS u32x4*)(stg + row * 64 + ch * 8);
            *(u32x4*)(d.O + (size_t)(qw + row) * d.rstride * d.opitch + ch * 8) = v; }
        }
        if (d.lse != nullptr && hi == 0) d.lse[(size_t)(qw + r32) * d.rstride * d.lsepitch] = mhat + __builtin_amdgcn_logf(wsf[32 + r32]);
    }
    asm volatile("s_waitcnt lgkmcnt(0)\n\ts_barrier" ::: "memory");
}
}

namespace idx {
constexpr int KS = 8192, I_K = 0, I_ST = 3 * KS, I_END = I_ST + 8 * 8192;
static_assert(I_END <= RING_BYTES, "indexer LDS");
__device__ __forceinline__ void score_unit(LAS unsigned char* lds, const bf16_t* PROJ, float* SC, int b, int qh  , int jg) {
    int tid_ = threadIdx.x; asm volatile("" : "+v"(tid_));
    const int tid = tid_, lane = tid & 63, r32 = lane & 31, hi = lane >> 5, wid = __builtin_amdgcn_readfirstlane(tid >> 6);
    const int qg = wid >> 1, hh = wid & 1;
    const unsigned lds0 = (unsigned)(size_t)lds;
    const int qrow = b * SEQ + qh * 128 + qg * 32 + r32;
    const bf16_t* kbase = PROJ + (size_t)(b * SEQ) * PW + 3968;
    const int kkey = 8 * wid + (lane >> 3);
    const bf16_t* ksrc = kbase + (size_t)kkey * PW + ((lane & 7) ^ ((kkey >> 1) & 7)) * 8;
    const int j0 = 4 * jg;
#define IDX_ISSUE(j) att::glds16(ksrc + (size_t)(j) * 64 * PW, (unsigned)__builtin_amdgcn_readfirstlane(lds0 + I_K + ((j) % 3) * KS + wid * 1024))
    IDX_ISSUE(j0); IDX_ISSUE(j0 + 1);
    bf16x8 qf[4][4]; float wv[4];
    { const bf16_t* qp = PROJ + (size_t)qrow * PW + 3328 + hh * 256 + hi * 8;
#pragma unroll
      for (int h = 0; h < 4; ++h)
#pragma unroll
          for (int d0 = 0; d0 < 4; ++d0) qf[h][d0] = *(const bf16x8*)(qp + h * 64 + d0 * 16);
      const u32x2 ww = *(const u32x2*)(PROJ + (size_t)qrow * PW + 4032 + hh * 4);
      wv[0] = bflo(ww.x); wv[1] = bfhi(ww.x); wv[2] = bflo(ww.y); wv[3] = bfhi(ww.y); }
#pragma unroll
    for (int h = 0; h < 4; ++h) { asm volatile("" : "+v"(wv[h]));
#pragma unroll
        for (int d0 = 0; d0 < 4; ++d0) asm volatile("" : "+v"(qf[h][d0])); }
    const int qb = qh >> 1;
    unsigned* blk = (unsigned*)SC + ((size_t)b * 36 + (size_t)(qb * (qb + 1) / 2)) * 32768; const int pitch = 128 * (qb + 1);
    f32x4 ve[4] = {};
    LAS unsigned char* stg = lds + I_ST + wid * 8192;
    const LAS unsigned char* stg2 = lds + I_ST + (wid ^ 1) * 8192;
#pragma nounroll
    for (int jj = 0; jj < 4; ++jj) { const int j = j0 + jj;
        if (jj < 2) { ATT_WAIT_BAR(1); } else if (jj == 2) { ATT_WAIT_BAR(5); } else { ATT_WAIT_BAR(4); }
        if (jj + 2 < 4) IDX_ISSUE(j + 2);
        const LAS unsigned char* kb = lds + I_K + (j % 3) * KS + r32 * 128;
#pragma nounroll
        for (int half = 0; half < 2; ++half) {
            bf16x8 kf[4];
#pragma unroll
            for (int d0 = 0; d0 < 4; ++d0) kf[d0] = *(const LAS bf16x8*)(kb + half * 4096 + (((2 * d0 + hi) ^ ((r32 >> 1) & 7)) * 16));
            f32x16 t0 = f32x16{};
#pragma unroll
            for (int h = 0; h < 4; ++h) {
                f32x16 p0 = f32x16{};
#pragma unroll
                for (int d0 = 0; d0 < 4; ++d0) p0 = __builtin_amdgcn_mfma_f32_32x32x16_bf16(kf[d0], qf[h][d0], p0, 0, 0, 0);
#pragma unroll
                for (int r = 0; r < 16; ++r) t0[r] += wv[h] * att::emax(p0[r], 0.f);
            }
#pragma unroll
            for (int g = 0; g < 4; ++g) { const int c0 = 8 * half + 2 * g + hi;
                *(LAS f32x4*)(stg + r32 * 256 + ((c0 ^ (r32 & 15)) * 16)) = (f32x4){t0[4 * g], t0[4 * g + 1], t0[4 * g + 2], t0[4 * g + 3]}; }
        }
        asm volatile("s_waitcnt lgkmcnt(0)\n\ts_barrier" ::: "memory");
#pragma unroll
        for (int i = 0; i < 4; ++i) { const int q = hh * 16 + i * 4 + (lane >> 4), c = lane & 15; const int so = q * 256 + ((c ^ (q & 15)) * 16);
            const f32x4 v = *(const LAS f32x4*)(stg + so) + *(const LAS f32x4*)(stg2 + so);
            if (jj & 1) { const f32x4 e = ve[i]; const u32x4 w = {pk2(e[0], v[0]), pk2(e[1], v[1]), pk2(e[2], v[2]), pk2(e[3], v[3])};
                *(u32x4*)(blk + (size_t)((qh & 1) * 128 + qg * 32 + q) * pitch + 64 * (j >> 1) + 4 * c) = w; }
            else ve[i] = v; }
        LDS_WAIT();
    }
#undef IDX_ISSUE
    asm volatile("s_waitcnt lgkmcnt(0)\n\ts_barrier" ::: "memory");
}

__device__ __forceinline__ int wave_sum_i(int v) {
    v += __builtin_amdgcn_update_dpp(0, v, 0xB1, 0xF, 0xF, true);
    v += __builtin_amdgcn_update_dpp(0, v, 0x4E, 0xF, 0xF, true);
    v += __builtin_amdgcn_update_dpp(0, v, 0x141, 0xF, 0xF, true);
    v += __builtin_amdgcn_update_dpp(0, v, 0x140, 0xF, 0xF, true);
    return __builtin_amdgcn_readlane(v, 0) + __builtin_amdgcn_readlane(v, 16) + __builtin_amdgcn_readlane(v, 32) + __builtin_amdgcn_readlane(v, 48);
}
__device__ __forceinline__ unsigned long long keep_low(unsigned long long m, int k) { while (__builtin_popcountll(m) > k) m &= ~(1ull << (63 - __builtin_clzll(m))); return m; }
__device__ __forceinline__ void select_rows4(const float* SC, unsigned* MASK, int row0  , int lane, LAS unsigned* slot  ) {
    const int b = row0 / SEQ, t0 = row0 % SEQ, qb = t0 >> 8;
    if (t0 < 256) {
#pragma unroll 1
        for (int i = 0; i < 4; ++i) { const int t = t0 + i, lo = 64 * lane;
            const unsigned long long w = (lo + 63 <= t) ? ~0ull : (lo > t ? 0ull : ((2ull << (t - lo)) - 1ull));
            if (lane < 32) ((unsigned long long*)(MASK + (size_t)(row0 + i) * 64))[lane] = w; }
        return;
    }
    const int pitch = 128 * (qb + 1), pmax = pitch - 1;
    const unsigned* srow0 = (const unsigned*)SC + ((size_t)b * 36 + (size_t)(qb * (qb + 1) / 2)) * 32768 + (size_t)(t0 - 256 * qb) * pitch;
    unsigned raw[16];
#pragma unroll
    for (int i = 0; i < 16; ++i) { const int s_ = 64 * i + lane; raw[i] = srow0[s_ < pmax ? s_ : pmax]; }
#pragma unroll 1
    for (int r = 0; r < 4; ++r) {
        const int t = t0 + r;
        unsigned P[16];
#pragma unroll
        for (int i = 0; i < 16; ++i) P[i] = raw[i];
        { const unsigned* nx = srow0 + (size_t)(r < 3 ? r + 1 : 3) * pitch;
#pragma unroll
          for (int i = 0; i < 16; ++i) { const int s_ = 64 * i + lane; raw[i] = nx[s_ < pmax ? s_ : pmax]; } }
#define SEL_TSTAGE(sh, m) _Pragma("unroll") for (int q = 0; q < 16; ++q) if (!(q & (sh))) { const unsigned a_ = P[q], b_ = P[q + (sh)]; \
            P[q] = (a_ & (m)) | ((b_ << (sh)) & ~(m)); P[q + (sh)] = ((a_ >> (sh)) & (m)) | (b_ & ~(m)); }
        SEL_TSTAGE(8, 0x00FF00FFu) SEL_TSTAGE(4, 0x0F0F0F0Fu) SEL_TSTAGE(2, 0x33333333u) SEL_TSTAGE(1, 0x55555555u)
#undef SEL_TSTAGE
        { const unsigned sg = P[15];
#pragma unroll
          for (int q = 0; q < 15; ++q) P[q] ^= sg;
          P[15] = ~sg; }
        const int nj = ((t - lane) >> 6) + 1;
        unsigned A = ((1u << ((nj + 1) >> 1)) - 1u) | (((1u << (nj >> 1)) - 1u) << 16), G = 0u;
        int cab = 0, cntA = t + 1;
#pragma unroll
        for (int bit = 15; bit >= 0; --bit) {
            if (cab + cntA != 256) {
                const unsigned ones = A & P[bit];
                const int c = wave_sum_i(__builtin_popcount(ones));
                if (cab + c >= 256) { A = ones; cntA = c; } else { G |= ones; cab += c; A &= ~ones; cntA -= c; }
            }
        }
        int need = 256 - cab;
        unsigned sel = G | A;
        if (cntA != need) {
            unsigned selA = 0u;
#pragma nounroll
            for (int j = 0; j < 32; ++j) { const int pb = (j >> 1) + 16 * (j & 1);
                unsigned long long m = __ballot((A >> pb) & 1u);
                if (__builtin_popcountll(m) > need) m = keep_low(m, need);
                need -= __builtin_popcountll(m);
                selA |= (unsigned)((m >> lane) & 1ull) << pb;
            }
            sel = G | selA;
        }
        int lo = 0, hi = 0;
#pragma unroll
        for (int j = 0; j < 32; ++j) { const unsigned long long m = __ballot((sel >> ((j >> 1) + 16 * (j & 1))) & 1u);
            lo = (lane == j) ? (int)(unsigned)m : lo; hi = (lane == j) ? (int)(unsigned)(m >> 32) : hi; }
        if (lane < 32) ((unsigned long long*)(MASK + (size_t)(row0 + r) * 64))[lane] = (unsigned long long)(unsigned)lo | ((unsigned long long)(unsigned)hi << 32);
    }
}
}

__device__ __forceinline__ unsigned* queue_word(Frame& F, int l, int chunk, int q) { return (unsigned*)(F.ws + WS_CTL) + CW_QUEUE + 64 * ((l * NCHUNK + chunk) * 4 + q); }

__device__ __forceinline__ void phase_proj(Frame& F, int l, int chunk) {
    PHASE_IDS(F);
    { LAS float* gb = (LAS float*)(F.lds + L_GB); const float* bg = F.in[7] + (size_t)l * 3072;
      __syncthreads();
      for (int i = F.tid; i < 3072; i += NTHREADS) gb[i] = bg[i];
      VM_WAIT(); LDS_WAIT(); __syncthreads(); }
    pg8::DenseSched8 S{{(const bf16_t*)(F.ws + WS_XB8 + (size_t)chunk * TC * DM), (const bf16_t*)(F.ws + WS_WIN8), DM / 2, DM / 2, TC / 256, (PW + 3072) / 256, F.G, (int)blockIdx.x}, F8_SW, F8_SA_X};
    const float* rp = (const float*)(F.ws + WS_ROPE);
    EpiProj E{(bf16_t*)(F.ws + WS_PROJ), rp, rp + 2048 * 8 * 2, (float*)(F.ws + WS_SSQ), (bf16_t*)(F.ws + WS_G3), (const LAS float*)(F.lds + L_GB)};
    pg8::gemm_phase<EpiProj, pg8::DenseSched8, true, true>(F.lds, DM / 2, S, E);
}
__device__ __forceinline__ void dilated_unit(Frame& F, int u) {
    const bf16_t* PROJ = (const bf16_t*)(F.ws + WS_PROJ); bf16_t* OG = (bf16_t*)(F.ws + WS_OG); float* LSE = (float*)(F.ws + WS_LSE);
    constexpr int N_G0 = NBC * 4 * 8, N_G1 = NBC * 4 * 4 * 2;
    int g, b, h, res, qb, dil, nq;
    if (u < N_G0) { g = 0; dil = 1; qb = 7 - u / (NBC * 4); const int bh = u % (NBC * 4); b = bh >> 2; h = bh & 3; res = 0; nq = 256; }
    else if (u < N_G0 + N_G1) { const int v = u - N_G0; g = 1; dil = 4; qb = 1 - v / (NBC * 16); const int x = v % (NBC * 16); b = x >> 4; h = (x >> 2) & 3; res = x & 3; nq = 256; }
    else { const int v = u - N_G0 - N_G1; g = 2; dil = 16; qb = 0; b = v >> 6; h = (v >> 4) & 3; res = v & 15; nq = 128; }
    att::Desc d; const size_t r0 = (size_t)b * SEQ + res;
    const bf16_t* base = PROJ + r0 * PW + 512 + 768 * g + 64 * h;
    d.Q = base; d.K1 = base + 256; d.V = base + 512; d.K2 = nullptr; d.qpitch = d.k1pitch = d.vpitch = PW; d.k2pitch = 0;
    d.O = OG + ((size_t)g * TC + r0) * 256 + 64 * h; d.opitch = 256; d.lse = LSE + ((size_t)g * TC + r0) * 4 + h; d.lsepitch = 4; d.mask = nullptr;
    d.rstride = dil; d.q0 = qb * 256; d.nq = nq; d.o8 = 0;
    if (g == 2) { d.jlo = 0; d.jhi = 2; att::attn_unit<64, 0>(F.lds, d); }
    else { d.jlo = (qb * 4 - 2) > 0 ? (qb * 4 - 2) : 0; d.jhi = 4 * (qb + 1); att::attn_unit<64, 1>(F.lds, d); }
}

__device__ __forceinline__ void phase_up_scores(Frame& F, int l, int chunk) {
    PHASE_IDS(F);
    const bf16_t* PROJ = (const bf16_t*)(F.ws + WS_PROJ);
    const float* rp = (const float*)(F.ws + WS_ROPE);
    {   pg8::DenseSched S{PROJ, (const bf16_t*)(F.ws + WS_WUQ), PW, 256, TC / 256, 3, F.G, (int)blockIdx.x};
        EpiUpQ E{(bf16_t*)(F.ws + WS_QM), rp + 2048 * 8 * 2, (const float*)(F.ws + WS_SSQ)};
        pg8::gemm_phase<EpiUpQ, pg8::DenseSched, true>(F.lds, 256, S, E); }
    {   pg8::DenseSched S{PROJ + 256, (const bf16_t*)(F.ws + WS_WUKV), PW, 256, TC / 256, 4, F.G, (int)blockIdx.x};
        EpiUpKV E{(bf16_t*)(F.ws + WS_KVM), (const float*)(F.ws + WS_SSQ)};
        pg8::gemm_phase<EpiUpKV, pg8::DenseSched, true>(F.lds, 256, S, E); }
    unsigned* qw = queue_word(F, l, chunk, 0); int pre = -1;
    for (;;) {
        const int u = dequeue(F, qw, pre);
        if (u < 512) { dilated_unit(F, u); continue; }
        if (u >= 512 + NBC * 72 + 512) break;
        if (u >= 512 + NBC * 72) { dilated_unit(F, u - NBC * 72); continue; }
        const int v = u - 512; const int b = v / 72; int r = v % 72, qh = 0; while (r > (qh >> 1)) { r -= (qh >> 1) + 1; ++qh; }
        idx::score_unit(F.lds, PROJ, (float*)(F.ws + WS_SC), b, qh, r);
    }
}
__device__ __forceinline__ void phase_attn1(Frame& F, int l, int chunk, int tmask = 7) {
    PHASE_IDS(F);
    const bf16_t* PROJ = (const bf16_t*)(F.ws + WS_PROJ); const bf16_t* QM = (const bf16_t*)(F.ws + WS_QM); const bf16_t* KVM = (const bf16_t*)(F.ws + WS_KVM);
    bf16_t* OA = (bf16_t*)(F.ws + WS_OA); bf16_t* OG = (bf16_t*)(F.ws + WS_OG); float* LSE = (float*)(F.ws + WS_LSE);
    constexpr int N_MLA = NBC * 8 * 8, N_SEL = TC / 32;
    unsigned* qw = queue_word(F, l, chunk, 1); int pre = -1;
    for (;;) {
        int u = dequeue(F, qw, pre);
        if (u < N_MLA) {
            if (!(tmask & 1)) continue;
            const int qb = 7 - u / (NBC * 8), bh = u % (NBC * 8), b = bh >> 3, h = bh & 7;
            att::Desc d; const size_t r0 = (size_t)b * SEQ;
            d.Q = QM + r0 * 768 + h * 96; d.qpitch = 768; d.K1 = KVM + r0 * 1024 + h * 128; d.k1pitch = 1024; d.K2 = PROJ + r0 * PW + 384; d.k2pitch = PW;
            d.V = KVM + r0 * 1024 + h * 128 + 64; d.vpitch = 1024; d.O = (bf16_t*)((unsigned char*)OA + r0 * 512 + h * 64); d.opitch = 512; d.o8 = 1; d.lse = nullptr; d.lsepitch = 0; d.mask = nullptr;
            d.rstride = 1; d.q0 = qb * 256; d.nq = 256; d.jlo = 0; d.jhi = 4 * (qb + 1);
            att::attn_unit<96, 0>(F.lds, d); continue; }
        u -= N_MLA;
        if (u >= N_SEL) break;
        if (!(tmask & 4)) continue;
        idx::select_rows4((const float*)(F.ws + WS_SC), (unsigned*)(F.ws + WS_MASK), u * 32 + F.wave * 4, F.lane, (LAS unsigned*)(F.lds + L_GB) + F.wave * 64);
    }
}
__device__ __forceinline__ void phase_attn2(Frame& F, int l, int chunk) {
    PHASE_IDS(F);
    const bf16_t* PROJ = (const bf16_t*)(F.ws + WS_PROJ);
    bf16_t* OC = (bf16_t*)(F.ws + WS_OC);
    unsigned* qw = queue_word(F, l, chunk, 2); int pre = -1;
    for (;;) {
        const int u = dequeue(F, qw, pre);
        if (u >= NBC * 64) break;
        const int qb = 7 - u / (NBC * 8), bh = u % (NBC * 8), b = bh >> 3, h = bh & 7;
        att::Desc d; const size_t r0 = (size_t)b * SEQ;
        d.Q = PROJ + r0 * PW + 2816 + 64 * h; d.K1 = PROJ + r0 * PW + 3840; d.V = PROJ + r0 * PW + 3904; d.K2 = nullptr; d.qpitch = d.k1pitch = d.vpitch = PW; d.k2pitch = 0;
        d.O = (bf16_t*)((unsigned char*)OC + r0 * 512 + 64 * h); d.opitch = 512; d.o8 = 1; d.lse = nullptr; d.lsepitch = 0; d.mask = (const unsigned*)(F.ws + WS_MASK) + r0 * 64;
        d.rstride = 1; d.q0 = qb * 256; d.nq = 256; d.jlo = 0; d.jhi = 4 * (qb + 1);
        att::attn_unit<64, 2>(F.lds, d);
    }
    const bf16_t* OG = (const bf16_t*)(F.ws + WS_OG); const float* LSE = (const float*)(F.ws + WS_LSE); bf16_t* OB = (bf16_t*)(F.ws + WS_OB);
    const int gw = F.vcu * NWAVES + F.wave, NGW = F.G * NWAVES, h = F.lane >> 4;
    for (int row = gw; row < TC; row += NGW) {
        const float l0 = LSE[(size_t)row * 4 + h], l1 = LSE[((size_t)TC + row) * 4 + h], l2 = LSE[((size_t)2 * TC + row) * 4 + h];
        const float mx = fmaxf(l0, fmaxf(l1, l2));
        float w0 = __builtin_amdgcn_exp2f(l0 - mx), w1 = __builtin_amdgcn_exp2f(l1 - mx), w2 = __builtin_amdgcn_exp2f(l2 - mx);
        const float inv = 1.0f / (w0 + w1 + w2); w0 *= inv; w1 *= inv; w2 *= inv;
        const u32x2 a = *(const u32x2*)(OG + (size_t)row * 256 + F.lane * 4), bq = *(const u32x2*)(OG + ((size_t)TC + row) * 256 + F.lane * 4), c = *(const u32x2*)(OG + ((size_t)2 * TC + row) * 256 + F.lane * 4);
        w0 *= 32.f; w1 *= 32.f; w2 *= 32.f;
        *(unsigned*)((unsigned char*)OB + (size_t)row * 512 + F.lane * 4) = pk4_fp8(w0 * bflo(a.x) + w1 * bflo(bq.x) + w2 * bflo(c.x), w0 * bfhi(a.x) + w1 * bfhi(bq.x) + w2 * bfhi(c.x),
                                                                                    w0 * bflo(a.y) + w1 * bflo(bq.y) + w2 * bflo(c.y), w0 * bfhi(a.y) + w1 * bfhi(bq.y) + w2 * bfhi(c.y));
    }
}
__device__ __forceinline__ void phase_branches(Frame& F, int l, int chunk) {
    PHASE_IDS(F);
    BranchSched S{{(const bf16_t*)(F.ws + WS_OA), (const bf16_t*)(F.ws + WS_OB), (const bf16_t*)(F.ws + WS_OC)},
                  {(const bf16_t*)(F.ws + WS_WA), (const bf16_t*)(F.ws + WS_WB), (const bf16_t*)(F.ws + WS_WC)}, 256, 256, (int)blockIdx.x, F8_SW, 127 - 5};
    EpiBranchAll E{(bf16_t*)(F.ws + WS_MERGED), (bf16_t*)(F.ws + WS_M0), (bf16_t*)(F.ws + WS_M1), (const bf16_t*)(F.ws + WS_G3)};
    pg8::gemm_phase<EpiBranchAll, BranchSched, true, true>(F.lds, 256, S, E);
}
__device__ __forceinline__ void phase_wo(Frame& F, int l, int chunk) {
    PHASE_IDS(F);
    pg8::DenseSched8 S{{(const bf16_t*)(F.ws + WS_MERGED), (const bf16_t*)(F.ws + WS_WO), DM / 2, DM / 2, TC / 256, 4, F.G, (int)blockIdx.x}, F8_SW, 127 - 6};
    EpiWo E{F.out, l == 0 ? F.in[0] : F.out, chunk * TC};
    pg8::gemm_phase<EpiWo, pg8::DenseSched8, true, true>(F.lds, DM / 2, S, E);
}

__global__ void __launch_bounds__(NTHREADS, 2) fwd_kernel(Args args) {
    extern __shared__ __attribute__((aligned(16))) unsigned char lds_raw[];
    Frame F;
    F.lds = (LAS unsigned char*)lds_raw;
    F.tid = threadIdx.x; F.lane = F.tid & 63; F.wave = __builtin_amdgcn_readfirstlane(F.tid >> 6);
    F.G = gridDim.x; { const int bx = blockIdx.x; F.vcu = (F.G % 8 == 0) ? (bx % 8) * (F.G / 8) + bx / 8 : bx; }
    F.in.p = (intab_t)__builtin_amdgcn_kernarg_segment_ptr(); F.out = args.out; F.ws = args.ws; F.out0 = args.out; F.ws0 = args.ws;
    for (int u = F.tid; u < (LDS_BYTES - L_CTL) / 4; u += NTHREADS) ((LAS unsigned*)(F.lds + L_CTL))[u] = 0u;
    __syncthreads();
    XcdBarrier bar = xcd_barrier_post((unsigned*)(F.ws + WS_CTL) + CW_BAR, (volatile LAS unsigned*)(F.lds + L_BARW));
#define GRID_BAR() xcd_barrier(bar)

    for (int l = 0; l < 2; ++l) {
        phase_conv_moe(F, l);
        phase_conv_mixer(F, l);
        GRID_BAR();
        for (int chunk = 0; chunk < NCHUNK; ++chunk) {
            phase_proj(F, l, chunk);
            GRID_BAR();
            if (DUPMASK & 2) { phase_proj(F, l, chunk); GRID_BAR(); }
            phase_up_scores(F, l, chunk);
            GRID_BAR();
            if (DUPMASK & 4) { phase_up_scores(F, l + 2, chunk); GRID_BAR(); }
            phase_attn1(F, l, chunk);
            GRID_BAR();
            if (DUPMASK & 8) { phase_attn1(F, l + 2, chunk); GRID_BAR(); }
            if (DUPMASK & 0x700) { phase_attn1(F, l + 2, chunk, (DUPMASK >> 8) & 7); GRID_BAR(); }
            phase_attn2(F, l, chunk);
            GRID_BAR();
            if (DUPMASK & 16) { phase_attn2(F, l + 2, chunk); GRID_BAR(); }
            phase_branches(F, l, chunk);
            GRID_BAR();
            if (DUPMASK & 32) { phase_branches(F, l, chunk); GRID_BAR(); }
            phase_wo(F, l, chunk);
            if ((DUPMASK & 0x800) && l == 0) { GRID_BAR(); phase_wo(F, l, chunk); }
        }
        GRID_BAR();
        phase_ln1_router(F, l, F.out, false);
        GRID_BAR();
        phase_moe_scatter(F);
        GRID_BAR();
        phase_moe_gemm1(F);
        GRID_BAR();
        if (DUPMASK & 64) { phase_moe_gemm1(F); GRID_BAR(); }
        phase_moe_gemm2(F);
        GRID_BAR();
        if (DUPMASK & 128) { phase_moe_gemm2(F); GRID_BAR(); }
        phase_combine_ln2(F, l);
        GRID_BAR();
    }
}

extern "C" void kernel_launch(void* const* d_in, const int* in_sizes, int n_in, void* d_out, int out_size, void* d_ws, size_t ws_size, hipStream_t stream) {
    static int grid = 0;
    if (grid == 0) {
        if (n_in != 23 || out_size != TT * DM || ws_size < WS_END) { fprintf(stderr, "kernel_launch: unexpected shapes n_in %d out %d ws %zu\n", n_in, out_size, ws_size); grid = -1; return; }
        int dev = 0, cus = 0;
        if (hipGetDevice(&dev) != hipSuccess || hipDeviceGetAttribute(&cus, hipDeviceAttributeMultiprocessorCount, dev) != hipSuccess) { grid = -1; return; }
        if (hipFuncSetAttribute((const void*)fwd_kernel, hipFuncAttributeMaxDynamicSharedMemorySize, LDS_BYTES) != hipSuccess) { fprintf(stderr, "kernel_launch: hipFuncSetAttribute failed\n"); grid = -1; return; }
        int per_cu = 0;
        if (hipOccupancyMaxActiveBlocksPerMultiprocessor(&per_cu, (const void*)fwd_kernel, NTHREADS, LDS_BYTES) != hipSuccess || per_cu < 1) fprintf(stderr, "kernel_launch: occupancy query says %d\n", per_cu);
        (void)hipGetLastError();
        grid = cus;
    }
    if (grid < 0) return;
    if (hipMemsetAsync((char*)d_ws + WS_CTL, 0, CTL_ZERO_BYTES, stream) != hipSuccess) return;
    Args a{};
    for (int i = 0; i < 23; ++i) a.in[i] = (const float*)d_in[i];
    a.out = (float*)d_out; a.ws = (unsigned char*)d_ws;
    hipLaunchKernelGGL(fwd_kernel, dim3(grid), dim3(NTHREADS), LDS_BYTES, stream, a);
}
```

```cpp
#include <hip/hip_runtime.h>
#include <cstdio>
#include <cstdint>

#define LAS __attribute__((address_space(3)))
#define GAS __attribute__((address_space(1)))
typedef unsigned short bf16_t;
typedef short bf16x8 __attribute__((ext_vector_type(8)));
typedef float f32x4 __attribute__((ext_vector_type(4)));
typedef float f32x2 __attribute__((ext_vector_type(2)));
typedef float f32x16 __attribute__((ext_vector_type(16)));
typedef unsigned u32x4 __attribute__((ext_vector_type(4)));
typedef unsigned u32x2 __attribute__((ext_vector_type(2)));

constexpr int DM = 1024, NB = 32, SEQ = 2048, TT = NB * SEQ;
constexpr int NEXP = 32, DEXP = 256;
constexpr float LN_EPS = 1e-6f;
constexpr float ALPHA = 1.41421356237309515f;
constexpr int NWAVES = 8, NTHREADS = 512;

__device__ __forceinline__ unsigned f2bf(float f) { unsigned u = __builtin_bit_cast(unsigned, f); return (u + 0x7fffu + ((u >> 16) & 1u)) >> 16; }
__device__ __forceinline__ unsigned pk2(float lo, float hi) { return f2bf(lo) | (f2bf(hi) << 16); }
__device__ __forceinline__ float bf2f(unsigned short b) { return __builtin_bit_cast(float, (unsigned)b << 16); }
__device__ __forceinline__ float bflo(unsigned w) { return __builtin_bit_cast(float, w << 16); }
__device__ __forceinline__ float bfhi(unsigned w) { return __builtin_bit_cast(float, w & 0xffff0000u); }
typedef __bf16 bf16x2_t __attribute__((ext_vector_type(2)));
__device__ __forceinline__ unsigned cvt_pk_bf16(float lo, float hi) { const f32x2 v = {lo, hi}; const bf16x2_t b = __builtin_convertvector(v, bf16x2_t); return __builtin_bit_cast(unsigned, b); }
__device__ __forceinline__ float wave_sum(float v) {
#pragma unroll
    for (int o = 1; o < 64; o <<= 1) v += __shfl_xor(v, o);
    return v;
}
__device__ __forceinline__ float fast_exp(float x) { return __builtin_amdgcn_exp2f(x * 1.4426950408889634f); }
__device__ __forceinline__ float sigmoidf_(float x) { return __builtin_amdgcn_rcpf(1.0f + fast_exp(-x)); }
__device__ __forceinline__ unsigned pk4_fp8(float a, float b, float c, float d) {
    int p = __builtin_amdgcn_cvt_pk_fp8_f32(a, b, 0, false); p = __builtin_amdgcn_cvt_pk_fp8_f32(c, d, p, true); return (unsigned)p; }
__device__ __forceinline__ void store8_fp8(unsigned char* p, const f32x4& v0, const f32x4& v1, float sc) {
    u32x2 w; w.x = pk4_fp8(v0[0] * sc, v0[1] * sc, v0[2] * sc, v0[3] * sc); w.y = pk4_fp8(v1[0] * sc, v1[1] * sc, v1[2] * sc, v1[3] * sc); *(u32x2*)p = w;
}
#define LDS_WAIT() asm volatile("s_waitcnt lgkmcnt(0)" ::: "memory")
#define VM_WAIT() asm volatile("s_waitcnt vmcnt(0)" ::: "memory")

namespace pg8 {
constexpr int BM = 256, BK = 64, HALF = 128, HTB = HALF * BK * 2, STAGE_BYTES = 8 * HTB;
__device__ __forceinline__ int lds_byte(int r, int c) { return r * 128 + ((((c >> 3) ^ (r >> 1)) & 7) * 16) + (c & 7) * 2; }
__device__ __forceinline__ void stage_rc(int b, int& R, int& C) { R = b >> 7; C = ((((b >> 4) ^ (R >> 1)) & 7)) * 8; }
__device__ __forceinline__ int perm32(int rho) { const int n = rho >> 4, i = rho & 15; return 8 * (i >> 2) + 4 * n + (i & 3); }
struct Unit { int pm, pn, ord; };

template <class S, class = void> struct SchedVarK { static constexpr bool value = false; };
template <class S> struct SchedVarK<S, decltype((void)S::VARK)> { static constexpr bool value = S::VARK; };
typedef int v4i_t __attribute__((ext_vector_type(4)));
typedef int v8i_t __attribute__((ext_vector_type(8)));
__device__ __forceinline__ v8i_t cat8(const bf16x8& lo, const bf16x8& hi) { return __builtin_shufflevector(__builtin_bit_cast(v4i_t, lo), __builtin_bit_cast(v4i_t, hi), 0, 1, 2, 3, 4, 5, 6, 7); }
template <class Epi, class Sched, bool ALIGN_EPI, bool F8 = false>
__device__ __forceinline__ void gemm_phase(LAS unsigned char* lds, const int K, const Sched& S, const Epi& E) {
    int tid_ = threadIdx.x; asm volatile("" : "+v"(tid_));
    const int tid = tid_, wid = __builtin_amdgcn_readfirstlane(tid >> 6), lane = tid & 63, wr = wid >> 2, wc = wid & 3, fr = lane & 15, fq = lane >> 4;
    int nt = K / BK;
    int Rr[2], Cc[2]; unsigned vB[2][2];
#pragma unroll
    for (int i = 0; i < 2; ++i) { stage_rc(tid * 16 + i * 8192, Rr[i], Cc[i]); const int Rb = (Rr[i] & ~31) + perm32(Rr[i] & 31);
        vB[0][i] = (unsigned)(Rb * S.ldb + Cc[i]) * 2u; vB[1][i] = (unsigned)((HALF + Rb) * S.ldb + Cc[i]) * 2u; }
    const size_t kstep = (size_t)(BK * 2);
    const unsigned ldsw = (unsigned)wid * 1024u;
    const int aoff = lds_byte(wr * 64 + fr, fq * 8), boff = lds_byte(wc * 32 + fr, fq * 8);
    const int aoff1 = lds_byte(wr * 64 + fr, fq * 8 + 32), boff1 = lds_byte(wc * 32 + fr, fq * 8 + 32);
#define PG8_SA(b, h) (((b) * 2 + (h)) * HTB)
#define PG8_SB(b, h) ((4 + (b) * 2 + (h)) * HTB)
#define PG8_STAGE(bufoff, gbase, voff) do { _Pragma("unroll") for (int _i = 0; _i < 2; ++_i) \
        __builtin_amdgcn_global_load_lds((const unsigned*)((const char*)(gbase) + (voff)[_i]), (LAS unsigned*)(lds + (bufoff) + ldsw + _i * 8192), 16, 0, 0); } while (0)
#define PG8_LDA(dst, b, h) do { _Pragma("unroll") for (int m = 0; m < 4; ++m) { \
        const bf16x8 f0_ = *(const LAS bf16x8*)(lds + PG8_SA(b, h) + aoff + m * 2048), f1_ = *(const LAS bf16x8*)(lds + PG8_SA(b, h) + aoff1 + m * 2048); \
        if constexpr (F8) dst##8[m] = cat8(f0_, f1_); else { dst[m][0] = f0_; dst[m][1] = f1_; } } } while (0)
#define PG8_LDB(dst, b, h) do { _Pragma("unroll") for (int n = 0; n < 2; ++n) { \
        const bf16x8 f0_ = *(const LAS bf16x8*)(lds + PG8_SB(b, h) + boff + n * 2048), f1_ = *(const LAS bf16x8*)(lds + PG8_SB(b, h) + boff1 + n * 2048); \
        if constexpr (F8) dst##8[n] = cat8(f0_, f1_); else { dst[n][0] = f0_; dst[n][1] = f1_; } } } while (0)
#define PG8_MMA(ai, bj, At, Bt) do { __builtin_amdgcn_s_setprio(1); \
        if constexpr (F8) { _Pragma("unroll") for (int m = 0; m < 4; ++m) _Pragma("unroll") for (int n = 0; n < 2; ++n) \
            asm volatile("v_mfma_scale_f32_16x16x128_f8f6f4 %0, %1, %2, %0, %3, %4 op_sel_hi:[0,0,0]" : "+v"(acc[ai][bj][m][n]) : "v"(Bt##8[n]), "v"(At##8[m]), "v"(scw8), "v"(sca8)); } \
              \
        else { _Pragma("unroll") for (int m = 0; m < 4; ++m) _Pragma("unroll") for (int n = 0; n < 2; ++n) _Pragma("unroll") for (int k = 0; k < 2; ++k) \
            acc[ai][bj][m][n] = __builtin_amdgcn_mfma_f32_16x16x32_bf16(Bt[n][k], At[m][k], acc[ai][bj][m][n], 0, 0, 0); } \
        __builtin_amdgcn_s_setprio(0); } while (0)
#define PG8_WAIT_V(n) asm volatile("s_waitcnt vmcnt(" #n ")" ::: "memory")
#define PG8_WAIT_L(n) asm volatile("s_waitcnt lgkmcnt(" #n ")" ::: "memory")
#define PG8_BAR __builtin_amdgcn_s_barrier()
#define PG8_SCHED __builtin_amdgcn_sched_barrier(0)
    int scw8 = 0, sca8 = 0;
    if constexpr (F8) { scw8 = S.sw8 * 0x01010101; sca8 = S.sa8 * 0x01010101; }
    Unit cur, nxt; int ui = 0;
    if (!S.next(0, cur)) return;
    f32x4 acc[2][2][4][2];
#pragma unroll
    for (int a = 0; a < 2; ++a)
#pragma unroll
        for (int b = 0; b < 2; ++b)
#pragma unroll
            for (int m = 0; m < 4; ++m)
#pragma unroll
                for (int n = 0; n < 2; ++n) acc[a][b][m][n] = (f32x4){0.f, 0.f, 0.f, 0.f};
    bf16x8 At[4][2], B0[2][2], B1[2][2]; v8i_t At8[4], B08[2], B18[2];
    unsigned vAc[2][2], vAn[2][2];
    const char* cA = S.a_base(cur); const char* cB = S.b_base(cur);
    S.a_off(cur, Rr, Cc, vAc);
    if constexpr (SchedVarK<Sched>::value) nt = S.ktiles(cur);
    PG8_STAGE(PG8_SB(0, 0), cB, vB[0]); PG8_STAGE(PG8_SB(0, 1), cB, vB[1]); PG8_STAGE(PG8_SA(0, 0), cA, vAc[0]); PG8_STAGE(PG8_SA(0, 1), cA, vAc[1]);
    if (wr == 1) PG8_BAR;
    PG8_WAIT_V(2); PG8_BAR;
    PG8_STAGE(PG8_SB(1, 0), cB + kstep, vB[0]); PG8_STAGE(PG8_SA(1, 0), cA + kstep, vAc[0]); PG8_STAGE(PG8_SB(1, 1), cB + kstep, vB[1]);
    PG8_WAIT_V(6); PG8_BAR;
    bool epi_pend = false;
    for (;;) {
        const bool has_next = S.next(ui + 1, nxt);
        const char* nA = cA; const char* nB = cB;
        if constexpr (Sched::GATHER) {
#pragma unroll
            for (int h = 0; h < 2; ++h)
#pragma unroll
                for (int i = 0; i < 2; ++i) vAn[h][i] = vAc[h][i];
        }
        if (has_next) { nA = S.a_base(nxt); nB = S.b_base(nxt); if constexpr (Sched::GATHER) S.a_off(nxt, Rr, Cc, vAn); }
#pragma nounroll
        for (int t = 0; t < nt; t += 2) {
            const bool last = (t == nt - 2);
            const bool ep_ = epi_pend && t == 0;
            const char* a1 = cA + (size_t)(t + 1) * kstep;
            const char* a2 = last ? nA : cA + (size_t)(t + 2) * kstep; const char* b2 = last ? nB : cB + (size_t)(t + 2) * kstep;
            const char* a3 = a2 + kstep; const char* b3 = b2 + kstep;
            unsigned vA2[2][2];
#pragma unroll
            for (int h = 0; h < 2; ++h)
#pragma unroll
                for (int i = 0; i < 2; ++i) { if constexpr (Sched::GATHER) vA2[h][i] = last ? vAn[h][i] : vAc[h][i]; else vA2[h][i] = vAc[h][i]; }
            PG8_LDB(B0, 0, 0); PG8_LDB(B1, 0, 1); PG8_SCHED; PG8_LDA(At, 0, 0); PG8_STAGE(PG8_SA(1, 1), a1, vAc[1]);
            if (ep_) { PG8_WAIT_V(24); } else { PG8_WAIT_V(8); } PG8_WAIT_L(0); PG8_BAR; PG8_MMA(0, 0, At, B0); PG8_MMA(0, 1, At, B1); PG8_BAR; PG8_SCHED;
            PG8_LDA(At, 0, 1); PG8_STAGE(PG8_SB(0, 0), b2, vB[0]); PG8_STAGE(PG8_SB(0, 1), b2, vB[1]); PG8_STAGE(PG8_SA(0, 0), a2, vA2[0]);
            if (ep_) { PG8_WAIT_V(24); } else { PG8_WAIT_V(8); } PG8_WAIT_L(0); PG8_BAR; PG8_MMA(1, 0, At, B0); PG8_MMA(1, 1, At, B1); PG8_BAR; PG8_SCHED;
            PG8_LDB(B0, 1, 0); PG8_LDB(B1, 1, 1); PG8_SCHED; PG8_LDA(At, 1, 0); PG8_STAGE(PG8_SA(0, 1), a2, vA2[1]);
            PG8_WAIT_V(8); PG8_WAIT_L(0); PG8_BAR; PG8_MMA(0, 0, At, B0); PG8_MMA(0, 1, At, B1); PG8_BAR; PG8_SCHED;
            PG8_LDA(At, 1, 1); PG8_STAGE(PG8_SB(1, 0), b3, vB[0]); PG8_STAGE(PG8_SB(1, 1), b3, vB[1]); PG8_STAGE(PG8_SA(1, 0), a3, vA2[0]);
            PG8_WAIT_V(8); PG8_WAIT_L(0); PG8_BAR; PG8_MMA(1, 0, At, B0); PG8_MMA(1, 1, At, B1); PG8_BAR; PG8_SCHED;
        }
        if constexpr (ALIGN_EPI) { if (wr == 0) PG8_BAR; }
        if constexpr (F8) asm volatile("s_nop 15\n\ts_nop 15" ::: "memory");
        { int l2_ = lane; asm volatile("" : "+v"(l2_)); E(acc, cur, wr, wc, l2_ & 15, l2_ >> 4); }
        if (!has_next) break;
        epi_pend = true;
#pragma unroll
        for (int a = 0; a < 2; ++a)
#pragma unroll
            for (int b = 0; b < 2; ++b)
#pragma unroll
                for (int m = 0; m < 4; ++m)
#pragma unroll
                    for (int n = 0; n < 2; ++n) acc[a][b][m][n] = (f32x4){0.f, 0.f, 0.f, 0.f};
        cur = nxt; cA = nA; cB = nB; ++ui;
        if constexpr (SchedVarK<Sched>::value) nt = S.ktiles(cur);
        if constexpr (Sched::GATHER) {
#pragma unroll
            for (int h = 0; h < 2; ++h)
#pragma unroll
                for (int i = 0; i < 2; ++i) vAc[h][i] = vAn[h][i];
        }
        if constexpr (ALIGN_EPI) { if (wr == 1) PG8_BAR; }
    }
    PG8_WAIT_V(0);
    if constexpr (!ALIGN_EPI) { if (wr == 0) PG8_BAR; }
    asm volatile("s_waitcnt vmcnt(0) lgkmcnt(0)\n\ts_barrier" ::: "memory");
    __builtin_amdgcn_sched_barrier(0);
#undef PG8_SA
#undef PG8_SB
#undef PG8_STAGE
#undef PG8_LDA
#undef PG8_LDB
#undef PG8_MMA
#undef PG8_WAIT_V
#undef PG8_WAIT_L
#undef PG8_BAR
#undef PG8_SCHED
}

struct DenseSched {
    static constexpr bool GATHER = false;
    const bf16_t* A; const bf16_t* Bt; int lda, ldb, nM, nN, G, c;
    __device__ __forceinline__ bool next(int i, Unit& u) const { const int v = i * G + c; if (v >= nM * nN) return false; u.pm = v / nN; u.pn = v % nN; u.ord = i; return true; }
    __device__ __forceinline__ const char* a_base(const Unit& u) const { return (const char*)(A + (size_t)u.pm * BM * lda); }
    __device__ __forceinline__ const char* b_base(const Unit& u) const { return (const char*)(Bt + (size_t)u.pn * BM * ldb); }
    __device__ __forceinline__ void a_off(const Unit&, const int (&R)[2], const int (&C)[2], unsigned (&v)[2][2]) const {
#pragma unroll
        for (int i = 0; i < 2; ++i) { v[0][i] = (unsigned)(R[i] * lda + C[i]) * 2u; v[1][i] = (unsigned)((HALF + R[i]) * lda + C[i]) * 2u; }
    }
};
struct DenseSched8 : DenseSched { int sw8, sa8; };
}

#define XB_TMO      128
#define XB_XCNT(j)  (256  + 64 * (j))
#define XB_XSUB(j)  (1280 + 64 * (j))
#define XB_XGEN(j)  (2304 + 64 * (j))
#define XB_TOP      3328
#define XB_TOPGEN   3392
#define XCD_BAR_WORDS 3456
#define XB_SPIN_CAP (1u << 18)
__device__ __forceinline__ unsigned xb_ld(unsigned* p)              { return __hip_atomic_load(p, __ATOMIC_RELAXED, __HIP_MEMORY_SCOPE_AGENT); }
__device__ __forceinline__ unsigned xb_add(unsigned* p, unsigned v) { return __hip_atomic_fetch_add(p, v, __ATOMIC_RELAXED, __HIP_MEMORY_SCOPE_AGENT); }
__device__ __forceinline__ unsigned xb_xcc_id() { return (unsigned)__builtin_amdgcn_s_getreg((3 << 11) | 20) & 0xFu; }
#define XB_SPIN(cond, bar) do { unsigned _sp = 0; while (cond) { __builtin_amdgcn_s_sleep(1); \
    if ((++_sp & 255u) == 0u) { if (xb_ld(&(bar)[XB_TMO])) break; if (_sp > XB_SPIN_CAP) { atomicAdd(&(bar)[XB_TMO], 1u); break; } } } } while (0)
struct XcdBarrier { unsigned* bar; unsigned x; volatile LAS unsigned* st; };
__device__ __forceinline__ XcdBarrier xcd_barrier_post(unsigned* bar, volatile LAS unsigned* st) {
    XcdBarrier b; b.bar = bar; b.x = xb_xcc_id(); b.st = st;
    if (threadIdx.x == 0) (void)xb_add(&bar[XB_XCNT(b.x)], 1u);
    return b;
}
__device__ __forceinline__ void xcd_barrier_complete(unsigned* bar, unsigned x, unsigned& nloc, unsigned& nx) {
    const unsigned G = gridDim.x * gridDim.y * gridDim.z;
    unsigned sum, cnt, mine, sp = 0u;
    for (;;) {
        sum = 0u; cnt = 0u; mine = 0u;
#pragma unroll
        for (unsigned j = 0; j < 16; ++j) { const unsigned c = xb_ld(&bar[XB_XCNT(j)]); sum += c; cnt += (c > 0u) ? 1u : 0u; mine = (j == x) ? c : mine; }
        if (sum == G) break;
        __builtin_amdgcn_s_sleep(1);
        if ((++sp & 255u) == 0u) { if (xb_ld(&bar[XB_TMO])) break; if (sp > XB_SPIN_CAP) { atomicAdd(&bar[XB_TMO], 1u); break; } }
    }
    nloc = mine > 0u ? mine : 1u; nx = cnt > 0u ? cnt : 1u;
}
__device__ __forceinline__ void xcd_barrier(const XcdBarrier& b) {
    asm volatile("s_waitcnt vmcnt(0)" ::: "memory");
    __syncthreads();
    if (threadIdx.x == 0) {
        unsigned* bar = b.bar;
        __builtin_amdgcn_s_waitcnt(0);
        unsigned nloc = b.st[0], nx = b.st[1];
        if (nloc == 0u) { xcd_barrier_complete(bar, b.x, nloc, nx); b.st[0] = nloc; b.st[1] = nx; }
        const unsigned old = xb_add(&bar[XB_XSUB(b.x)], 1u);
        const unsigned gen = old / nloc;
        if (old + 1u == (gen + 1u) * nloc) {
            __builtin_amdgcn_fence(__ATOMIC_RELEASE, "agent");
            asm volatile("s_waitcnt vmcnt(0)" ::: "memory");
            const unsigned og = xb_add(&bar[XB_TOP], 1u);
            const unsigned tg = og / nx;
            if (og + 1u == (tg + 1u) * nx) xb_add(&bar[XB_TOPGEN], 1u);
            else XB_SPIN(xb_ld(&bar[XB_TOPGEN]) == tg, bar);
            __builtin_amdgcn_fence(__ATOMIC_ACQUIRE, "agent");
            xb_add(&bar[XB_XGEN(b.x)], 1u);
            asm volatile("s_waitcnt vmcnt(0)" ::: "memory");
        } else {
            XB_SPIN(xb_ld(&bar[XB_XGEN(b.x)]) == gen, bar);
            __builtin_amdgcn_fence(__ATOMIC_ACQUIRE, "agent");
            asm volatile("s_waitcnt vmcnt(0)" ::: "memory");
        }
    }
    __syncthreads();
}

constexpr size_t MiB = 1u << 20;
constexpr size_t WS_CTL = 0, CTL_ZERO_BYTES = 1 * MiB;
constexpr int CW_BAR = 4096;
constexpr int CW_QUEUE = 16384;
constexpr size_t WS_W13 = 2 * MiB;
constexpr size_t WS_W2  = 34 * MiB;
constexpr size_t WS_WR  = 50 * MiB;
constexpr size_t WS_MISC = 51 * MiB;
constexpr size_t WS_ROUTE = 52 * MiB;
constexpr size_t WS_RPOS = 53 * MiB;
constexpr size_t WS_ROWTOK = 54 * MiB;
constexpr size_t WS_ROPE = 55 * MiB;
constexpr size_t WS_WUQ = 56 * MiB;
constexpr size_t WS_WUKV = 57 * MiB;
constexpr size_t WS_WA = 58 * MiB;
constexpr size_t WS_WB = 59 * MiB;
constexpr size_t WS_WC = 60 * MiB;
constexpr size_t WS_WO = 61 * MiB;
constexpr size_t WS_SSQ = 63 * MiB;
constexpr size_t WS_LSE = 64 * MiB;
constexpr size_t WS_MASK = 66 * MiB;
constexpr size_t WS_XB8 = 74 * MiB;
constexpr size_t WS_WIN8 = 138 * MiB;
constexpr size_t WS_H = 146 * MiB;
constexpr size_t WS_Y = 182 * MiB;
constexpr size_t WS_SC = WS_Y;
constexpr size_t WS_G3 = 254 * MiB;
constexpr size_t WS_PROJ = 350 * MiB;
constexpr size_t WS_QM = 606 * MiB;
constexpr size_t WS_KVM = 654 * MiB;
constexpr size_t WS_OA = 718 * MiB;
constexpr size_t WS_OB = 734 * MiB;
constexpr size_t WS_OC = 750 * MiB;
constexpr size_t WS_OG = 766 * MiB;
constexpr size_t WS_M0 = 814 * MiB;
constexpr size_t WS_M1 = 846 * MiB;
constexpr size_t WS_MERGED = 878 * MiB;
constexpr size_t WS_END = 910 * MiB;
constexpr int F8_SA_X = 127 - 4, F8_SW = 127 - 10;
constexpr int MAXROWS = 139264;
constexpr int NBC = 16, TC = NBC * SEQ, NCHUNK = NB / NBC;
constexpr int CIN = 3944, PW = 4096;

constexpr int MI_BLOCKCNT = 0;
constexpr int MI_PANEL_E = 8192;
constexpr int MI_NPAN = 8192 + 1024;

constexpr int RING_BYTES = 131072;
constexpr int L_CTL = RING_BYTES;
constexpr int L_BARW = L_CTL + 32;
constexpr int L_HIST = L_CTL + 256;
constexpr int L_TOT  = L_CTL + 384;
constexpr int L_PRE  = L_CTL + 512;
constexpr int L_BASE = L_CTL + 640;
constexpr int L_RANK = L_CTL + 896;
constexpr int L_PE   = L_CTL + 1024;
constexpr int L_ROWS = L_CTL + 2048;
constexpr int LDS_BYTES = 147456;
constexpr int L_GB = L_ROWS;
static_assert(L_ROWS + 12288 <= LDS_BYTES, "LDS map");

#ifndef DUPMASK
#define DUPMASK 0
#endif
struct Args { const float* in[23]; float* out; unsigned char* ws; };
#define PHASE_IDS(F) do { int t_ = threadIdx.x; asm volatile("" : "+v"(t_)); (F).tid = t_; (F).lane = t_ & 63; { intab_t p_ = (intab_t)__builtin_amdgcn_kernarg_segment_ptr(); asm volatile("" : "+s"(p_)); (F).in.p = p_; } \
    { unsigned char GAS* w_ = (unsigned char GAS*)(F).ws0; asm volatile("" : "+s"(w_)); (F).ws = (unsigned char*)w_; float GAS* o_ = (float GAS*)(F).out0; asm volatile("" : "+s"(o_)); (F).out = (float*)o_; } } while (0)

typedef const float GAS* gfptr_t;
typedef const gfptr_t __attribute__((address_space(4)))* intab_t;
struct InTab { intab_t p; __device__ __forceinline__ const float* operator[](int i) const { return (const float*)p[i]; } };
struct Frame {
    LAS unsigned char* lds;
    int tid, lane, wave, vcu, G;
    InTab in; float* out; unsigned char* ws; float* out0; unsigned char* ws0;
};

template <class F>
__device__ __forceinline__ void conv_item(bf16_t* WT, int ldk, int k0, int n0, LAS float* scr, int lane, F val) {
#pragma unroll 8
    for (int i = 0; i < 32; ++i) { const int kk = 2 * i + (lane >> 5); scr[kk * 33 + (lane & 31)] = val(k0 + kk, n0 + (lane & 31)); }
    LDS_WAIT(); asm volatile("" ::: "memory");
    const int c = lane & 7;
#pragma unroll
    for (int j = 0; j < 4; ++j) { const int n = (lane >> 3) + 8 * j; const LAS float* s = scr + (8 * c) * 33 + n;
        u32x4 o; o.x = pk2(s[0 * 33], s[1 * 33]); o.y = pk2(s[2 * 33], s[3 * 33]); o.z = pk2(s[4 * 33], s[5 * 33]); o.w = pk2(s[6 * 33], s[7 * 33]);
        *(u32x4*)(WT + (size_t)(n0 + n) * ldk + k0 + 8 * c) = o; }
    LDS_WAIT(); asm volatile("" ::: "memory");
}

template <class F>
__device__ __forceinline__ void conv_item8(unsigned char* WT, int ldk, int k0, int n0, LAS float* scr, int lane, F val) {
#pragma unroll 8
    for (int i = 0; i < 32; ++i) { const int kk = 2 * i + (lane >> 5); scr[kk * 33 + (lane & 31)] = val(k0 + kk, n0 + (lane & 31)); }
    LDS_WAIT(); asm volatile("" ::: "memory");
    const int c = lane & 7;
#pragma unroll
    for (int j = 0; j < 4; ++j) { const int n = (lane >> 3) + 8 * j; const LAS float* s = scr + (8 * c) * 33 + n;
        u32x2 o; o.x = pk4_fp8(s[0 * 33], s[1 * 33], s[2 * 33], s[3 * 33]); o.y = pk4_fp8(s[4 * 33], s[5 * 33], s[6 * 33], s[7 * 33]);
        *(u32x2*)(WT + (size_t)(n0 + n) * ldk + k0 + 8 * c) = o; }
    LDS_WAIT(); asm volatile("" ::: "memory");
}

__device__ __forceinline__ void conv_plain8(unsigned char* WT, int ldk, int k0, int n0, LAS float* scr, int lane, const float* src, int pitch, float sc) {
    f32x4 v[8];
#pragma unroll
    for (int i = 0; i < 8; ++i) v[i] = *(const f32x4*)(src + (size_t)(k0 + (lane >> 3) + 8 * i) * pitch + n0 + (lane & 7) * 4);
#pragma unroll
    for (int i = 0; i < 8; ++i) { LAS float* d = scr + ((lane >> 3) + 8 * i) * 33 + (lane & 7) * 4; d[0] = v[i][0] * sc; d[1] = v[i][1] * sc; d[2] = v[i][2] * sc; d[3] = v[i][3] * sc; }
    LDS_WAIT(); asm volatile("" ::: "memory");
    const int c = lane & 7;
#pragma unroll
    for (int j = 0; j < 4; ++j) { const int n = (lane >> 3) + 8 * j; const LAS float* s = scr + (8 * c) * 33 + n;
        u32x2 o; o.x = pk4_fp8(s[0 * 33], s[1 * 33], s[2 * 33], s[3 * 33]); o.y = pk4_fp8(s[4 * 33], s[5 * 33], s[6 * 33], s[7 * 33]);
        *(u32x2*)(WT + (size_t)(n0 + n) * ldk + k0 + 8 * c) = o; }
    LDS_WAIT(); asm volatile("" ::: "memory");
}
__device__ __forceinline__ void conv_pair8(unsigned char* WT, int ldk, int k0, int n0, LAS float* scr, int lane, const float* a, const float* b, int pitch, float sc) {
    f32x2 va[8], vb[8];
#pragma unroll
    for (int i = 0; i < 8; ++i) { const size_t o = (size_t)(k0 + (lane >> 3) + 8 * i) * pitch + (n0 >> 1) + (lane & 7) * 2; va[i] = *(const f32x2*)(a + o); vb[i] = *(const f32x2*)(b + o); }
#pragma unroll
    for (int i = 0; i < 8; ++i) { LAS float* d = scr + ((lane >> 3) + 8 * i) * 33 + (lane & 7) * 4; d[0] = va[i][0] * sc; d[1] = vb[i][0] * sc; d[2] = va[i][1] * sc; d[3] = vb[i][1] * sc; }
    LDS_WAIT(); asm volatile("" ::: "memory");
    const int c = lane & 7;
#pragma unroll
    for (int j = 0; j < 4; ++j) { const int n = (lane >> 3) + 8 * j; const LAS float* s = scr + (8 * c) * 33 + n;
        u32x2 o; o.x = pk4_fp8(s[0 * 33], s[1 * 33], s[2 * 33], s[3 * 33]); o.y = pk4_fp8(s[4 * 33], s[5 * 33], s[6 * 33], s[7 * 33]);
        *(u32x2*)(WT + (size_t)(n0 + n) * ldk + k0 + 8 * c) = o; }
    LDS_WAIT(); asm volatile("" ::: "memory");
}

__device__ __forceinline__ void phase_conv_moe(Frame& F, int l) {
    PHASE_IDS(F);
    LAS float* scr = (LAS float*)(F.lds + F.wave * 16384);
    const int gw = F.vcu * NWAVES + F.wave, NGW = F.G * NWAVES;
    const float* w1 = F.in[18] + (size_t)l * NEXP * DM * DEXP;
    const float* w3 = F.in[19] + (size_t)l * NEXP * DM * DEXP;
    const float* w2 = F.in[20] + (size_t)l * NEXP * DEXP * DM;
    bf16_t* W13 = (bf16_t*)(F.ws + WS_W13); bf16_t* W2 = (bf16_t*)(F.ws + WS_W2);
    constexpr int I13 = (DM / 64) * (512 / 32);
    constexpr int I2 = (DEXP / 64) * (DM / 32);
    for (int it = gw; it < NEXP * (I13 + I2); it += NGW) {
        if (it < NEXP * I13) {
            const int e = it / I13, r = it % I13, kb = r / 16, nb = r % 16;
            const float* a = w1 + (size_t)e * DM * DEXP; const float* b = w3 + (size_t)e * DM * DEXP;
            conv_pair8((unsigned char*)W13 + (size_t)e * 512 * DM, DM, kb * 64, nb * 32, scr, F.lane, a, b, DEXP, 1024.f);
        } else {
            const int it2 = it - NEXP * I13; const int e = it2 / I2, r = it2 % I2, kb = r / 32, nb = r % 32;
            const float* a = w2 + (size_t)e * DEXP * DM;
            conv_plain8((unsigned char*)W2 + (size_t)e * DM * DEXP, DEXP, kb * 64, nb * 32, scr, F.lane, a, DM, 1024.f);
        }
    }
    const float* wg = F.in[14] + (size_t)l * DM * 4; const float* wsb = F.in[16] + (size_t)l * DM * NEXP;
    const float* g1 = F.in[12] + (size_t)l * DM; const float* b1 = F.in[13] + (size_t)l * DM;
    bf16_t* WRH = (bf16_t*)(F.ws + WS_WR); bf16_t* WRL = (bf16_t*)(F.ws + WS_WR + 128 * 1024); float* WRC = (float*)(F.ws + WS_WR + 256 * 1024);
    for (int idx = (F.vcu * NTHREADS + F.tid); idx < 64 * DM; idx += F.G * NTHREADS) {
        const int c = idx / DM, k = idx % DM;
        const float v = (c < 32 ? wsb[(size_t)k * NEXP + c] : (c < 36 ? wg[(size_t)k * 4 + (c - 32)] : 0.f)) * g1[k];
        const unsigned h = f2bf(v); const int it = k >> 5, hi_ = (k >> 4) & 1, st = (k >> 3) & 1, e = k & 7, ln = (c & 31) + 32 * hi_, p0 = 2 * (c >> 5);
        WRH[((((size_t)it * 4 + p0) * 2 + st) * 64 + ln) * 8 + e] = (bf16_t)h;
        WRH[((((size_t)it * 4 + p0 + 1) * 2 + st) * 64 + ln) * 8 + e] = (bf16_t)f2bf(v - __builtin_bit_cast(float, h << 16)); (void)WRL;
    }
    if (gw < 64) {
        const int c = gw; float s1 = 0.f, s2 = 0.f;
        for (int k = F.lane; k < DM; k += 64) { const float w = c < 32 ? wsb[(size_t)k * NEXP + c] : (c < 36 ? wg[(size_t)k * 4 + (c - 32)] : 0.f); s1 += g1[k] * w; s2 += b1[k] * w; }
        s1 = wave_sum(s1); s2 = wave_sum(s2);
        const float bias = c < 32 ? F.in[17][(size_t)l * NEXP + c] : (c < 36 ? F.in[15][(size_t)l * 4 + (c - 32)] : 0.f);
        if (F.lane == 0) { WRC[c] = s1; WRC[64 + c] = s2 + bias; }
    }
}

__device__ __forceinline__ void ln_row(f32x4 (&v)[4], const f32x4 (&g)[4], const f32x4 (&b)[4], float* omean = nullptr, float* orstd = nullptr) {
    float s = 0.f;
#pragma unroll
    for (int j = 0; j < 4; ++j) s += (v[j].x + v[j].y) + (v[j].z + v[j].w);
    const float mean = wave_sum(s) * (1.f / DM); float s2 = 0.f;
#pragma unroll
    for (int j = 0; j < 4; ++j) { v[j] = v[j] - mean; s2 += (v[j].x * v[j].x + v[j].y * v[j].y) + (v[j].z * v[j].z + v[j].w * v[j].w); }
    const float rstd = 1.0f / sqrtf(wave_sum(s2) * (1.f / DM) + LN_EPS);
#pragma unroll
    for (int j = 0; j < 4; ++j) v[j] = v[j] * rstd * g[j] + b[j];
    if (omean) { *omean = mean; *orstd = rstd; }
}
__device__ __forceinline__ void store_row(const f32x4 (&v)[4], float* orow, unsigned char* brow, int lane) {
#pragma unroll
    for (int j = 0; j < 4; ++j) {
        ((f32x4*)orow)[lane + 64 * j] = v[j];
        ((unsigned*)brow)[lane + 64 * j] = pk4_fp8(v[j].x * 16.f, v[j].y * 16.f, v[j].z * 16.f, v[j].w * 16.f);
    }
}

__device__ __forceinline__ void phase_ln1_router(Frame& F, int l, const float* src, bool scale_alpha) {
    PHASE_IDS(F);
    const int lane = F.lane, hi = lane >> 5, r32 = lane & 31;
    const float* lg = F.in[12] + (size_t)l * DM; const float* lb = F.in[13] + (size_t)l * DM;
    f32x4 g[4], b[4];
#pragma unroll
    for (int j = 0; j < 4; ++j) { g[j] = ((const f32x4*)lg)[lane + 64 * j]; b[j] = ((const f32x4*)lb)[lane + 64 * j]; }
    unsigned char* XB = F.ws + WS_XB8;
    const bf16_t* WRH = (const bf16_t*)(F.ws + WS_WR); const bf16_t* WRL = (const bf16_t*)(F.ws + WS_WR + 128 * 1024);
    const float* WRC = (const float*)(F.ws + WS_WR + 256 * 1024); float* stats = (float*)(F.ws + WS_WR + 512 * 1024);
    unsigned* misc = (unsigned*)(F.ws + WS_MISC);
    int* route = (int*)(F.ws + WS_ROUTE);
    LAS unsigned* hist = (LAS unsigned*)(F.lds + L_HIST);
    const float sc = scale_alpha ? ALPHA : 1.0f;
    for (int blk = F.vcu; blk < TT / 256; blk += F.G) {
        if (F.tid < 32) hist[F.tid] = 0u;
        __syncthreads();
        const int row0 = blk * 256 + F.wave * 32;
        float mu_l = 0.f, rs_l = 1.f;
        for (int i = 0; i < 32; i += 2) {
            f32x4 v0[4], v1[4];
            const f32x4* p0 = (const f32x4*)(src + (size_t)(row0 + i) * DM); const f32x4* p1 = (const f32x4*)(src + (size_t)(row0 + i + 1) * DM);
#pragma unroll
            for (int j = 0; j < 4; ++j) { v0[j] = p0[lane + 64 * j] * sc; v1[j] = p1[lane + 64 * j] * sc; }
            float m0, r0, m1, r1;
            ln_row(v0, g, b, &m0, &r0); ln_row(v1, g, b, &m1, &r1);
            mu_l = (r32 == i) ? m0 : ((r32 == i + 1) ? m1 : mu_l); rs_l = (r32 == i) ? r0 : ((r32 == i + 1) ? r1 : rs_l);
#pragma unroll
            for (int j = 0; j < 4; ++j) {
                ((unsigned*)(XB + (size_t)(row0 + i) * DM))[lane + 64 * j] = pk4_fp8(v0[j].x * 16.f, v0[j].y * 16.f, v0[j].z * 16.f, v0[j].w * 16.f);
                ((unsigned*)(XB + (size_t)(row0 + i + 1) * DM))[lane + 64 * j] = pk4_fp8(v1[j].x * 16.f, v1[j].y * 16.f, v1[j].z * 16.f, v1[j].w * 16.f); }
        }
        if (hi == 0) *(f32x2*)(stats + (size_t)(row0 + r32) * 2) = (f32x2){mu_l, rs_l};
        f32x16 acc0 = {}, acc1 = {};
        {
            const bf16_t* WT = WRH; (void)WRL;
            LAS float* xs = (LAS float*)(F.lds + F.wave * 9216);
            const float* xg = src + (size_t)(row0 + (lane >> 3)) * DM + (lane & 7) * 4;
            f32x4 xv[4]; bf16x8 wv[8];
#pragma unroll
            for (int i = 0; i < 4; ++i) xv[i] = *(const f32x4*)(xg + (size_t)(8 * i) * DM);
#pragma unroll
            for (int q = 0; q < 8; ++q) wv[q] = *(const bf16x8*)(WT + ((size_t)q * 64 + lane) * 8);
#pragma unroll 2
            for (int it = 0; it < 32; ++it) {
                LAS float* xb = xs + (it & 1) * 1152;
#pragma unroll
                for (int i = 0; i < 4; ++i) *(LAS f32x4*)(xb + ((lane >> 3) + 8 * i) * 36 + (lane & 7) * 4) = xv[i];
                bf16x8 wc[8];
#pragma unroll
                for (int q = 0; q < 8; ++q) wc[q] = wv[q];
                { const int nx = it + 1 < 32 ? it + 1 : 31;
#pragma unroll
                  for (int i = 0; i < 4; ++i) xv[i] = *(const f32x4*)(xg + (size_t)(8 * i) * DM + nx * 32);
#pragma unroll
                  for (int q = 0; q < 8; ++q) wv[q] = *(const bf16x8*)(WT + (((size_t)nx * 8 + q) * 64 + lane) * 8); }
                f32x4 xa[4];
#pragma unroll
                for (int j = 0; j < 4; ++j) xa[j] = *(const LAS f32x4*)(xb + r32 * 36 + hi * 16 + 4 * j);
#pragma unroll
                for (int st = 0; st < 2; ++st) {
                    const f32x4 x0 = xa[2 * st], x1 = xa[2 * st + 1];
                    u32x4 xh, xl;
                    xh.x = cvt_pk_bf16(x0[0], x0[1]); xh.y = cvt_pk_bf16(x0[2], x0[3]); xh.z = cvt_pk_bf16(x1[0], x1[1]); xh.w = cvt_pk_bf16(x1[2], x1[3]);
                    xl.x = cvt_pk_bf16(x0[0] - bflo(xh.x), x0[1] - bfhi(xh.x)); xl.y = cvt_pk_bf16(x0[2] - bflo(xh.y), x0[3] - bfhi(xh.y));
                    xl.z = cvt_pk_bf16(x1[0] - bflo(xh.z), x1[1] - bfhi(xh.z)); xl.w = cvt_pk_bf16(x1[2] - bflo(xh.w), x1[3] - bfhi(xh.w));
                    const bf16x8 xhv = __builtin_bit_cast(bf16x8, xh), xlv = __builtin_bit_cast(bf16x8, xl);
                    acc0 = __builtin_amdgcn_mfma_f32_32x32x16_bf16(wc[0 + st], xhv, acc0, 0, 0, 0); acc1 = __builtin_amdgcn_mfma_f32_32x32x16_bf16(wc[4 + st], xhv, acc1, 0, 0, 0);
                    acc0 = __builtin_amdgcn_mfma_f32_32x32x16_bf16(wc[2 + st], xhv, acc0, 0, 0, 0); acc1 = __builtin_amdgcn_mfma_f32_32x32x16_bf16(wc[6 + st], xhv, acc1, 0, 0, 0);
                    acc0 = __builtin_amdgcn_mfma_f32_32x32x16_bf16(wc[0 + st], xlv, acc0, 0, 0, 0); acc1 = __builtin_amdgcn_mfma_f32_32x32x16_bf16(wc[4 + st], xlv, acc1, 0, 0, 0);
                }
            }
        }
        float gl[4];
#pragma unroll
        for (int i = 0; i < 4; ++i) gl[i] = rs_l * (acc1[i] - mu_l * WRC[32 + i]) + WRC[64 + 32 + i];
        int gidx = 0; float gmax = gl[0];
#pragma unroll
        for (int i = 1; i < 4; ++i) if (gl[i] > gmax) { gmax = gl[i]; gidx = i; }
        float gsum = 0.f;
#pragma unroll
        for (int i = 0; i < 4; ++i) gsum += fast_exp(gl[i] - gmax);
        float gp = 1.0f / gsum;
        gidx = __shfl(gidx, r32); gp = __shfl(gp, r32);
        float cv[4];
#pragma unroll
        for (int i = 0; i < 4; ++i) {
            const float a = gidx == 0 ? acc0[i] : gidx == 1 ? acc0[4 + i] : gidx == 2 ? acc0[8 + i] : acc0[12 + i];
            cv[i] = rs_l * (a - mu_l * WRC[8 * gidx + 4 * hi + i]) + WRC[64 + 8 * gidx + 4 * hi + i];
        }
        float v1 = cv[0]; int i1 = 0;
#pragma unroll
        for (int i = 1; i < 4; ++i) if (cv[i] > v1) { v1 = cv[i]; i1 = i; }
        float v2 = -INFINITY; int i2 = 0;
#pragma unroll
        for (int i = 0; i < 4; ++i) if (i != i1 && cv[i] > v2) { v2 = cv[i]; i2 = i; }
        i1 += 4 * hi; i2 += 4 * hi;
        const float pv1 = __shfl_xor(v1, 32), pv2 = __shfl_xor(v2, 32); const int pi1 = __shfl_xor(i1, 32), pi2 = __shfl_xor(i2, 32);
        auto better = [](float av, int ai, float bv, int bi) { return av > bv || (av == bv && ai < bi); };
        float fv, sv; int fi, si;
        if (better(v1, i1, pv1, pi1)) { fv = v1; fi = i1; if (better(v2, i2, pv1, pi1)) { sv = v2; si = i2; } else { sv = pv1; si = pi1; } }
        else { fv = pv1; fi = pi1; if (better(v1, i1, pv2, pi2)) { sv = v1; si = i1; } else { sv = pv2; si = pi2; } }
        const float d = fast_exp(sv - fv), inv = 1.0f / (1.0f + d);
        const float w1 = gp * inv, w2 = gp * d * inv;
        const int e1 = 8 * gidx + fi, e2 = 8 * gidx + si;
        if (hi == 0) {
            *(int4*)(route + (size_t)(row0 + r32) * 4) = make_int4(e1, e2, __float_as_int(w1), __float_as_int(w2));
            atomicAdd((unsigned*)&hist[e1], 1u); atomicAdd((unsigned*)&hist[e2], 1u);
        }
        __syncthreads();
        if (F.tid < 32) misc[MI_BLOCKCNT + blk * 32 + F.tid] = hist[F.tid];
        __syncthreads();
    }
}

__device__ __forceinline__ void phase_moe_scatter(Frame& F) {
    PHASE_IDS(F);
    unsigned* misc = (unsigned*)(F.ws + WS_MISC);
    const int* route = (const int*)(F.ws + WS_ROUTE);
    int* rpos = (int*)(F.ws + WS_RPOS); int* rowtok = (int*)(F.ws + WS_ROWTOK);
    LAS unsigned* tot = (LAS unsigned*)(F.lds + L_TOT); LAS unsigned* pre = (LAS unsigned*)(F.lds + L_PRE);
    LAS unsigned* base = (LAS unsigned*)(F.lds + L_BASE); LAS unsigned* rank = (LAS unsigned*)(F.lds + L_RANK);
    for (int blk = F.vcu; blk < TT / 256; blk += F.G) {
        {
            if (F.tid < 32) { tot[F.tid] = 0u; pre[F.tid] = 0u; rank[F.tid] = 0u; }
            __syncthreads();
            const int e = F.tid & 31, part = F.tid >> 5; unsigned cv[16];
#pragma unroll
            for (int i = 0; i < 16; ++i) cv[i] = misc[MI_BLOCKCNT + (part * 16 + i) * 32 + e];
            unsigned t = 0, p = 0;
#pragma unroll
            for (int i = 0; i < 16; ++i) { t += cv[i]; p += (part * 16 + i < blk) ? cv[i] : 0u; }
            atomicAdd((unsigned*)&tot[e], t); atomicAdd((unsigned*)&pre[e], p);
        }
        __syncthreads();
        if (F.tid == 0) { unsigned a = 0; for (int e = 0; e < NEXP; ++e) { base[e] = a; a += (tot[e] + 255u) & ~255u; } base[NEXP] = a; }
        __syncthreads();
        {
            const int tok = blk * 256 + (F.tid >> 1), slot = F.tid & 1;
            const int e = route[(size_t)tok * 4 + slot];
            const unsigned r = atomicAdd((unsigned*)&rank[e], 1u);
            const unsigned pos = base[e] + pre[e] + r;
            rowtok[pos] = tok; rpos[(size_t)tok * 2 + slot] = (int)pos;
        }
        if (blk < NEXP) {
            const int e = blk; const unsigned end = base[e] + tot[e], nxt = base[e + 1];
            for (unsigned p = end + F.tid; p < nxt; p += NTHREADS) rowtok[p] = 0;
            for (unsigned p = base[e] / 256 + F.tid; p < nxt / 256; p += NTHREADS) misc[MI_PANEL_E + p] = (unsigned)e;
        }
        if (blk == 0 && F.tid == 0) misc[MI_NPAN] = base[NEXP] / 256;
        __syncthreads();
    }
}

struct MoeSched1 {
    static constexpr bool GATHER = true;
    const bf16_t* A; const bf16_t* W; int lda, ldb, ntot, G, c; const LAS int* rows; const LAS int* pe; int sw8, sa8;
    __device__ __forceinline__ bool next(int i, pg8::Unit& u) const { const int v = i * G + c; if (v >= ntot) return false; u.pm = v >> 1; u.pn = v & 1; u.ord = i; return true; }
    __device__ __forceinline__ const char* a_base(const pg8::Unit&) const { return (const char*)A; }
    __device__ __forceinline__ const char* b_base(const pg8::Unit& u) const { return (const char*)(W + (size_t)pe[u.ord] * 512 * ldb + (size_t)u.pn * 256 * ldb); }
    __device__ __forceinline__ void a_off(const pg8::Unit& u, const int (&R)[2], const int (&C)[2], unsigned (&v)[2][2]) const {
#pragma unroll
        for (int h = 0; h < 2; ++h)
#pragma unroll
            for (int i = 0; i < 2; ++i) v[h][i] = (unsigned)(rows[u.ord * 256 + h * 128 + R[i]] * lda + C[i]) * 2u;
    }
};
struct MoeSched2 {
    static constexpr bool GATHER = false;
    const bf16_t* A; const bf16_t* W; int lda, ldb, ntot, G, c; const LAS int* pe; int sw8, sa8;
    __device__ __forceinline__ bool next(int i, pg8::Unit& u) const { const int v = i * G + c; if (v >= ntot) return false; u.pm = v >> 2; u.pn = v & 3; u.ord = i; return true; }
    __device__ __forceinline__ const char* a_base(const pg8::Unit& u) const { return (const char*)(A + (size_t)u.pm * 256 * lda); }
    __device__ __forceinline__ const char* b_base(const pg8::Unit& u) const { return (const char*)(W + (size_t)pe[u.ord] * DM * ldb + (size_t)u.pn * 256 * ldb); }
    __device__ __forceinline__ void a_off(const pg8::Unit&, const int (&R)[2], const int (&C)[2], unsigned (&v)[2][2]) const {
#pragma unroll
        for (int i = 0; i < 2; ++i) { v[0][i] = (unsigned)(R[i] * lda + C[i]) * 2u; v[1][i] = (unsigned)((128 + R[i]) * lda + C[i]) * 2u; }
    }
};
struct EpiSwiGLU {
    bf16_t* H;
    __device__ __forceinline__ void operator()(const f32x4 (&acc)[2][2][4][2], const pg8::Unit& u, int wr, int wc, int fr, int fq) const {
        const int row0 = u.pm * 256 + wr * 64 + fr, col0 = u.pn * 128 + wc * 16 + 4 * fq;
#pragma unroll
        for (int ai = 0; ai < 2; ++ai)
#pragma unroll
            for (int m = 0; m < 4; ++m) { bf16_t* rowp = H + (size_t)(row0 + ai * 128 + m * 16) * DEXP + col0;
#pragma unroll
                for (int bj = 0; bj < 2; ++bj) { const f32x4 v0 = acc[ai][bj][m][0], v1 = acc[ai][bj][m][1];
                    const float h0 = v0[0] * sigmoidf_(v0[0]) * v0[1], h1 = v0[2] * sigmoidf_(v0[2]) * v0[3], h2 = v1[0] * sigmoidf_(v1[0]) * v1[1], h3 = v1[2] * sigmoidf_(v1[2]) * v1[3];
                    *(unsigned*)((unsigned char*)H + (size_t)(row0 + ai * 128 + m * 16) * DEXP + col0 + bj * 64) = pk4_fp8(h0 * 16.f, h1 * 16.f, h2 * 16.f, h3 * 16.f); (void)rowp; } }
    }
};
struct EpiStoreBf16 {
    bf16_t* O; int ldc;
    __device__ __forceinline__ void operator()(const f32x4 (&acc)[2][2][4][2], const pg8::Unit& u, int wr, int wc, int fr, int fq) const {
        const int row0 = u.pm * 256 + wr * 64 + fr, col0 = u.pn * 256 + wc * 32 + 8 * fq;
#pragma unroll
        for (int ai = 0; ai < 2; ++ai)
#pragma unroll
            for (int m = 0; m < 4; ++m) { bf16_t* rowp = O + (size_t)(row0 + ai * 128 + m * 16) * ldc + col0;
#pragma unroll
                for (int bj = 0; bj < 2; ++bj) store8_fp8((unsigned char*)O + (size_t)(row0 + ai * 128 + m * 16) * ldc + col0 + bj * 128, acc[ai][bj][m][0], acc[ai][bj][m][1], 64.f); (void)rowp; }
    }
};

__device__ __forceinline__ void phase_moe_gemm1(Frame& F) {
    PHASE_IDS(F);
    const unsigned* misc = (const unsigned*)(F.ws + WS_MISC);
    const int* rowtok = (const int*)(F.ws + WS_ROWTOK);
    const int npan = (int)misc[MI_NPAN];
    LAS int* rows = (LAS int*)(F.lds + L_ROWS); LAS int* pe = (LAS int*)(F.lds + L_PE);
    const int c = (int)blockIdx.x, ntot = npan * 2;
    for (int i = 0; i * F.G + c < ntot && i < 8; ++i) { const int p = (i * F.G + c) >> 1;
        if (F.tid < 256) rows[i * 256 + F.tid] = rowtok[p * 256 + F.tid];
        if (F.tid == 256) pe[i] = (int)misc[MI_PANEL_E + p]; }
    VM_WAIT(); LDS_WAIT(); __syncthreads();
    MoeSched1 S{(const bf16_t*)(F.ws + WS_XB8), (const bf16_t*)(F.ws + WS_W13), DM / 2, DM / 2, ntot, F.G, c, rows, pe, F8_SW, F8_SA_X};
    EpiSwiGLU E{(bf16_t*)(F.ws + WS_H)};
    pg8::gemm_phase<EpiSwiGLU, MoeSched1, true, true>(F.lds, DM / 2, S, E);
}
__device__ __forceinline__ void phase_moe_gemm2(Frame& F) {
    PHASE_IDS(F);
    const unsigned* misc = (const unsigned*)(F.ws + WS_MISC);
    const int npan = (int)misc[MI_NPAN];
    LAS int* pe = (LAS int*)(F.lds + L_PE);
    const int c = (int)blockIdx.x, ntot = npan * 4;
    __syncthreads();
    if (F.tid < 16) { const int v = F.tid * F.G + c; if (v < ntot) pe[F.tid] = (int)misc[MI_PANEL_E + (v >> 2)]; }
    VM_WAIT(); LDS_WAIT(); __syncthreads();
    MoeSched2 S{(const bf16_t*)(F.ws + WS_H), (const bf16_t*)(F.ws + WS_W2), DEXP / 2, DEXP / 2, ntot, F.G, c, pe, F8_SW, 127 - 4};
    EpiStoreBf16 E{(bf16_t*)(F.ws + WS_Y), DM};
    int k2 = DEXP / 2; asm volatile("" : "+s"(k2));
    pg8::gemm_phase<EpiStoreBf16, MoeSched2, true, true>(F.lds, k2, S, E);
}

__device__ __forceinline__ void phase_combine_ln2(Frame& F, int l) {
    PHASE_IDS(F);
    const int lane = F.lane;
    const float* lg = F.in[21] + (size_t)l * DM; const float* lb = F.in[22] + (size_t)l * DM;
    f32x4 g[4], b[4];
#pragma unroll
    for (int j = 0; j < 4; ++j) { g[j] = ((const f32x4*)lg)[lane + 64 * j]; b[j] = ((const f32x4*)lb)[lane + 64 * j]; }
    const bf16_t* Y = (const bf16_t*)(F.ws + WS_Y);
    const float* l1g = F.in[12] + (size_t)l * DM; const float* l1b = F.in[13] + (size_t)l * DM; const float* stats = (const float*)(F.ws + WS_WR + 512 * 1024);
    f32x4 g1[4], b1[4];
#pragma unroll
    for (int j = 0; j < 4; ++j) { g1[j] = ((const f32x4*)l1g)[lane + 64 * j]; b1[j] = ((const f32x4*)l1b)[lane + 64 * j]; }
    const int* route = (const int*)(F.ws + WS_ROUTE); const int* rpos = (const int*)(F.ws + WS_RPOS);
    const int gw = F.vcu * NWAVES + F.wave, NGW = F.G * NWAVES;
    int4 rt_n = *(const int4*)(route + (size_t)gw * 4); int2 rp_n = *(const int2*)(rpos + (size_t)gw * 2); f32x2 st_n = *(const f32x2*)(stats + (size_t)gw * 2);
    for (int row = gw; row < TT; row += NGW) {
        const int4 rt = rt_n; const int2 rp = rp_n; const f32x2 st = st_n;
        { const int nr = (row + NGW < TT) ? row + NGW : row; rt_n = *(const int4*)(route + (size_t)nr * 4); rp_n = *(const int2*)(rpos + (size_t)nr * 2); st_n = *(const f32x2*)(stats + (size_t)nr * 2); }
        const float w0 = __int_as_float(rt.z) * (1.f / 64.f), w1 = __int_as_float(rt.w) * (1.f / 64.f);
        const f32x4* px = (const f32x4*)(F.out + (size_t)row * DM);
        const unsigned* y0 = (const unsigned*)((const unsigned char*)Y + (size_t)rp.x * DM); const unsigned* y1 = (const unsigned*)((const unsigned char*)Y + (size_t)rp.y * DM);
        f32x4 v[4];
#pragma unroll
        for (int j = 0; j < 4; ++j) {
            const f32x4 x = (px[lane + 64 * j] - st[0]) * st[1] * g1[j] + b1[j]; const unsigned a = y0[lane + 64 * j], c = y1[lane + 64 * j];
            const f32x2 a01 = __builtin_amdgcn_cvt_pk_f32_fp8((int)a, false), a23 = __builtin_amdgcn_cvt_pk_f32_fp8((int)a, true), c01 = __builtin_amdgcn_cvt_pk_f32_fp8((int)c, false), c23 = __builtin_amdgcn_cvt_pk_f32_fp8((int)c, true);
            v[j].x = ALPHA * x.x + w0 * a01[0] + w1 * c01[0]; v[j].y = ALPHA * x.y + w0 * a01[1] + w1 * c01[1];
            v[j].z = ALPHA * x.z + w0 * a23[0] + w1 * c23[0]; v[j].w = ALPHA * x.w + w0 * a23[1] + w1 * c23[1];
        }
        ln_row(v, g, b);
#pragma unroll
        for (int j = 0; j < 4; ++j) ((f32x4*)(F.out + (size_t)row * DM))[lane + 64 * j] = v[j];
        if (l == 0) {
#pragma unroll
            for (int j = 0; j < 4; ++j) ((unsigned*)(F.ws + WS_XB8 + (size_t)row * DM))[lane + 64 * j] = pk4_fp8(v[j].x * 16.f, v[j].y * 16.f, v[j].z * 16.f, v[j].w * 16.f);
        }
    }
}

constexpr float C2D = 0.18033688011112042f;
constexpr float C2M = 0.14724444602590306f;
constexpr float IWS = 0.044194173824159216f;
constexpr float RMS_EPS = 1e-6f;
constexpr int L_QSLOT = L_CTL + 1152;

__device__ __forceinline__ int rope16(int c) { return c < 16 ? (c >> 1) + 8 * (c & 1) : c; }
__device__ __forceinline__ int win_src(int n, float& sc) {
    sc = 1.f;
    if (n < 384) return n;
    if (n < 416) { const int c = n - 384; return 384 + (c >> 1) + 16 * (c & 1); }
    if (n < 512) return -1;
    if (n < 2816) { const int m = n - 512, g = m / 768, r = m % 768, p = r >> 8, hh = (r & 255) >> 6, c = r & 63; if (p == 0) sc = C2D; return 416 + 768 * g + 256 * p + 64 * hh + (p < 2 ? rope16(c) : c); }
    if (n < 3328) { const int m = n - 2816; sc = C2D; return 2720 + (m & ~63) + rope16(m & 63); }
    if (n < 3840) { const int m = n - 3328; return 3360 + (m & ~63) + rope16(m & 63); }
    const int m = n - 3840;
    if (m < 64) return 3232 + rope16(m);
    if (m < 128) return 3296 + (m - 64);
    if (m < 192) return 3872 + rope16(m - 128);
    if (m < 200) { sc = IWS; return 3936 + (m - 192); }
    return -1;
}

__device__ __forceinline__ void sincos_d(double x, double& s, double& c) {
    const double n = __builtin_rint(x * 0.15915494309189535);
    double r = __builtin_fma(-n, 6.2831854820251465, x); r = __builtin_fma(n, 1.7484556025237907e-07, r);
    const double r2 = r * r; double ss = 1.0, cc = 1.0;
#pragma unroll
    for (int k = 15; k >= 1; --k) { ss = 1.0 - r2 * (1.0 / (double)((2 * k) * (2 * k + 1))) * ss; cc = 1.0 - r2 * (1.0 / (double)((2 * k - 1) * (2 * k))) * cc; }
    s = ss * r; c = cc;
}
__device__ __forceinline__ double inv_freq16(int i) {
    const double t[16] = {1.0, 0.44036660267178046, 0.19392274474868576, 0.08539710028576561, 0.03760603093086393, 0.016560440080994446, 0.007292664737217109, 0.003211445994752591,
                          0.001414213562373095, 0.000622772421914596, 0.0002742481756762073, 0.00012076973741146504, 5.318295896944988e-05, 2.341999896140934e-05, 1.031338537721246e-05, 4.5416704806078695e-06};
    double r = t[0];
#pragma unroll
    for (int k = 1; k < 16; ++k) r = (i == k) ? t[k] : r;
    return r;
}

__device__ __forceinline__ void phase_conv_mixer(Frame& F, int l) {
    PHASE_IDS(F);
    LAS float* scr = (LAS float*)(F.lds + F.wave * 16384);
    const int gw = F.vcu * NWAVES + F.wave, NGW = F.G * NWAVES;
    const float* win = F.in[1] + (size_t)l * DM * CIN;
    const float* qg = F.in[2] + (size_t)l * 256; const float* wuq = F.in[3] + (size_t)l * 256 * 768;
    const float* kg = F.in[4] + (size_t)l * 128; const float* wukv = F.in[5] + (size_t)l * 128 * 1024;
    const float* wgate = F.in[6] + (size_t)l * DM * 3072;
    const float* wa = F.in[8] + (size_t)l * 512 * DM; const float* wb = F.in[9] + (size_t)l * 256 * DM; const float* wc = F.in[10] + (size_t)l * 512 * DM; const float* wo = F.in[11] + (size_t)l * DM * DM;
    unsigned char* WIN8 = F.ws + WS_WIN8; bf16_t* WUQ = (bf16_t*)(F.ws + WS_WUQ); bf16_t* WUKV = (bf16_t*)(F.ws + WS_WUKV);
    bf16_t* WA = (bf16_t*)(F.ws + WS_WA); bf16_t* WB = (bf16_t*)(F.ws + WS_WB); bf16_t* WC = (bf16_t*)(F.ws + WS_WC); bf16_t* WO = (bf16_t*)(F.ws + WS_WO);
    constexpr int I_IN = 16 * 128, I_G = 16 * 96, I_UQ = 4 * 24, I_UKV = 4 * 32, I_A = 8 * 32, I_B = 8 * 32, I_C = 8 * 32, I_O = 16 * 32;
    constexpr int NIT = I_IN + I_G + I_UQ + I_UKV + I_A + I_B + I_C + I_O;
    for (int it = gw; it < NIT; it += NGW) {
        int r = it;
        if (r < I_IN) { conv_item8(WIN8, DM, (r / 128) * 64, (r % 128) * 32, scr, F.lane, [&](int k, int n) { float sc; const int sidx = win_src(n, sc); return sidx < 0 ? 0.f : win[(size_t)k * CIN + sidx] * (sc * 1024.f); }); continue; } r -= I_IN;
        if (r < I_G) { conv_plain8(WIN8 + (size_t)PW * DM, DM, (r / 96) * 64, (r % 96) * 32, scr, F.lane, wgate, 3072, 1024.f); continue; } r -= I_G;
        if (r < I_UQ) { conv_item(WUQ, 256, (r / 24) * 64, (r % 24) * 32, scr, F.lane, [&](int k, int n) { const int hh = n / 96, c = n % 96; const int o = c < 64 ? c : 64 + ((c - 64) >> 1) + 16 * ((c - 64) & 1);
                return qg[k] * wuq[(size_t)k * 768 + hh * 96 + o] * C2M; }); continue; } r -= I_UQ;
        if (r < I_UKV) { conv_item(WUKV, 256, (r / 32) * 64, (r % 32) * 32, scr, F.lane, [&](int k, int n) { return k < 128 ? kg[k] * wukv[(size_t)k * 1024 + n] : 0.f; }); continue; } r -= I_UKV;
        if (r < I_A) { conv_plain8((unsigned char*)WA, 512, (r / 32) * 64, (r % 32) * 32, scr, F.lane, wa, DM, 1024.f); continue; } r -= I_A;
        if (r < I_B) { conv_item8((unsigned char*)WB, 512, (r / 32) * 64, (r % 32) * 32, scr, F.lane, [&](int k, int n) { return k < 256 ? wb[(size_t)k * DM + n] * 1024.f : 0.f; }); continue; } r -= I_B;
        if (r < I_C) { conv_plain8((unsigned char*)WC, 512, (r / 32) * 64, (r % 32) * 32, scr, F.lane, wc, DM, 1024.f); continue; } r -= I_C;
        conv_plain8((unsigned char*)WO, DM, (r / 32) * 64, (r % 32) * 32, scr, F.lane, wo, DM, 1024.f);
    }
    if (l == 0) {
        float* rp = (float*)(F.ws + WS_ROPE); float* rm = rp + 2048 * 8 * 2;
        for (int idx = F.vcu * NTHREADS + F.tid; idx < 2048 * 24; idx += F.G * NTHREADS) {
            const int t = idx / 24, j = idx % 24; double sn, cs;
            if (j < 8) { sincos_d((double)t * inv_freq16(2 * j), sn, cs); rp[(t * 8 + j) * 2] = (float)cs; rp[(t * 8 + j) * 2 + 1] = (float)sn; }
            else { sincos_d((double)t * inv_freq16(j - 8), sn, cs); rm[(t * 16 + (j - 8)) * 2] = (float)cs; rm[(t * 16 + (j - 8)) * 2 + 1] = (float)sn; }
        }
        const f32x4* x4 = (const f32x4*)F.in[0]; unsigned* xb8 = (unsigned*)(F.ws + WS_XB8);
        for (size_t i = (size_t)F.vcu * NTHREADS + F.tid; i < (size_t)TT * DM / 4; i += (size_t)F.G * NTHREADS) { const f32x4 v = x4[i] * 16.f; xb8[i] = pk4_fp8(v.x, v.y, v.z, v.w); }
    }
}

__device__ __forceinline__ void rope4(f32x4& v0, f32x4& v1, const float* cs) {
    const f32x4 a = *(const f32x4*)cs, b = *(const f32x4*)(cs + 4);
    const f32x4 w0 = {v0[0] * a[0] - v0[1] * a[1], v0[1] * a[0] + v0[0] * a[1], v0[2] * a[2] - v0[3] * a[3], v0[3] * a[2] + v0[2] * a[3]};
    const f32x4 w1 = {v1[0] * b[0] - v1[1] * b[1], v1[1] * b[0] + v1[0] * b[1], v1[2] * b[2] - v1[3] * b[3], v1[3] * b[2] + v1[2] * b[3]};
    v0 = w0; v1 = w1;
}
__device__ __forceinline__ void store8(bf16_t* p, const f32x4& v0, const f32x4& v1) {
    u32x4 w; w.x = cvt_pk_bf16(v0[0], v0[1]); w.y = cvt_pk_bf16(v0[2], v0[3]); w.z = cvt_pk_bf16(v1[0], v1[1]); w.w = cvt_pk_bf16(v1[2], v1[3]); *(u32x4*)p = w;
}
struct EpiProj {
    bf16_t* P; const float* csp; const float* csm; float* ssq; bf16_t* G3; const LAS float* gbias;
    __device__ __forceinline__ void operator()(const f32x4 (&acc)[2][2][4][2], const pg8::Unit& u, int wr, int wc, int fr, int fq) const {
        const int pn = u.pn, row0 = u.pm * 256 + wr * 64 + fr;
        if (pn >= 16) {
#pragma unroll
            for (int bj = 0; bj < 2; ++bj) { const int col = (pn - 16) * 256 + bj * 128 + wc * 32 + fq * 8;
                const f32x4 b0 = *(const LAS f32x4*)(gbias + col), b1 = *(const LAS f32x4*)(gbias + col + 4);
#pragma unroll
                for (int ai = 0; ai < 2; ++ai)
#pragma unroll
                    for (int m = 0; m < 4; ++m) { f32x4 v0 = acc[ai][bj][m][0] + b0, v1 = acc[ai][bj][m][1] + b1;
#pragma unroll
                        for (int e = 0; e < 4; ++e) { v0[e] = sigmoidf_(v0[e]); v1[e] = sigmoidf_(v1[e]); }
                        store8_fp8((unsigned char*)G3 + (size_t)(row0 + ai * 128 + m * 16) * 3072 + col, v0, v1, 64.f); } }
            return;
        }
#pragma unroll
        for (int bj = 0; bj < 2; ++bj) {
            const int wcu = __builtin_amdgcn_readfirstlane(wc);
            bool ropeP = false, ropeM = false;
            if (pn == 1) ropeM = (bj == 1 && wcu == 0);
            else if (pn >= 2 && pn < 11) ropeP = ((pn - 2) % 3) < 2 && !(wcu & 1);
            else if (pn >= 11 && pn < 15) ropeP = !(wcu & 1);
            else if (pn == 15) ropeP = (wcu == 0);
            const int col = pn * 256 + bj * 128 + wc * 32 + fq * 8;
            if (ropeP || ropeM) {
                const bool lr = ropeM || fq < 2;
                const float* cb = ropeM ? csm + 8 * fq : csp + 8 * (fq & 1);
                const int ts = ropeM ? 32 : 16;
#pragma unroll
                for (int ai = 0; ai < 2; ++ai)
#pragma unroll
                    for (int mh = 0; mh < 2; ++mh) {
                        f32x4 ca[2], cc[2];
#pragma unroll
                        for (int mm = 0; mm < 2; ++mm) { const int t = (row0 + ai * 128 + (2 * mh + mm) * 16) & (SEQ - 1);
                            ca[mm] = *(const f32x4*)(cb + t * ts); cc[mm] = *(const f32x4*)(cb + t * ts + 4); }
#pragma unroll
                        for (int mm = 0; mm < 2; ++mm) { const int m = 2 * mh + mm, row = row0 + ai * 128 + m * 16;
                            const f32x4 v0 = acc[ai][bj][m][0], v1 = acc[ai][bj][m][1];
                            f32x4 a = ca[mm], b = cc[mm];
                            if (!lr) { a = (f32x4){1.f, 0.f, 1.f, 0.f}; b = a; }
                            const f32x4 w0 = {v0[0] * a[0] - v0[1] * a[1], v0[1] * a[0] + v0[0] * a[1], v0[2] * a[2] - v0[3] * a[3], v0[3] * a[2] + v0[2] * a[3]};
                            const f32x4 w1 = {v1[0] * b[0] - v1[1] * b[1], v1[1] * b[0] + v1[0] * b[1], v1[2] * b[2] - v1[3] * b[3], v1[3] * b[2] + v1[2] * b[3]};
                            store8(P + (size_t)row * PW + col, w0, w1); }
                    }
            } else {
#pragma unroll
                for (int ai = 0; ai < 2; ++ai)
#pragma unroll
                    for (int m = 0; m < 4; ++m)
                        store8(P + (size_t)(row0 + ai * 128 + m * 16) * PW + col, acc[ai][bj][m][0], acc[ai][bj][m][1]);
            }
        }
        if (pn < 2) {
#pragma unroll
            for (int ai = 0; ai < 2; ++ai)
#pragma unroll
                for (int m = 0; m < 4; ++m) {
                    float sq = 0.f;
#pragma unroll
                    for (int bj = 0; bj < 2; ++bj) if (pn == 0 || bj == 0) {
#pragma unroll
                        for (int n = 0; n < 2; ++n) { const f32x4 x = acc[ai][bj][m][n]; sq += (x[0] * x[0] + x[1] * x[1]) + (x[2] * x[2] + x[3] * x[3]); } }
                    sq += __shfl_xor(sq, 16); sq += __shfl_xor(sq, 32);
                    if (fq == 0) ssq[(size_t)(row0 + ai * 128 + m * 16) * 8 + pn * 4 + wc] = sq;
                }
        }
    }
};
struct EpiUpQ {
    bf16_t* Q; const float* csm; const float* ssq;
    __device__ __forceinline__ void operator()(const f32x4 (&acc)[2][2][4][2], const pg8::Unit& u, int wr, int wc, int fr, int fq) const {
        const int row0 = u.pm * 256 + wr * 64 + fr;
        f32x4 spv[2][4];
#pragma unroll
        for (int ai = 0; ai < 2; ++ai)
#pragma unroll
            for (int m = 0; m < 4; ++m) spv[ai][m] = *(const f32x4*)(ssq + (size_t)(row0 + ai * 128 + m * 16) * 8);
#pragma unroll
        for (int ai = 0; ai < 2; ++ai)
#pragma unroll
            for (int m = 0; m < 4; ++m) { const f32x4 sp = spv[ai][m];
                spv[ai][m][0] = 1.0f / sqrtf(((sp[0] + sp[1]) + (sp[2] + sp[3])) * (1.f / 256.f) + RMS_EPS); }
        const int wcu = __builtin_amdgcn_readfirstlane(wc);
#pragma unroll
        for (int bj = 0; bj < 2; ++bj) {
            const int c0 = u.pn * 256 + bj * 128 + wcu * 32, col = c0 + fq * 8;
            if (((c0 >> 5) % 3) == 2) {
#pragma unroll
                for (int ai = 0; ai < 2; ++ai)
#pragma unroll
                    for (int mh = 0; mh < 2; ++mh) {
                        f32x4 ca[2], cc[2];
#pragma unroll
                        for (int mm = 0; mm < 2; ++mm) { const int t = (row0 + ai * 128 + (2 * mh + mm) * 16) & (SEQ - 1);
                            ca[mm] = *(const f32x4*)(csm + t * 32 + 8 * fq); cc[mm] = *(const f32x4*)(csm + t * 32 + 8 * fq + 4); }
#pragma unroll
                        for (int mm = 0; mm < 2; ++mm) { const int m = 2 * mh + mm, row = row0 + ai * 128 + m * 16;
                            const float rs = spv[ai][m][0];
                            const f32x4 v0 = acc[ai][bj][m][0] * rs, v1 = acc[ai][bj][m][1] * rs, a = ca[mm], b = cc[mm];
                            const f32x4 w0 = {v0[0] * a[0] - v0[1] * a[1], v0[1] * a[0] + v0[0] * a[1], v0[2] * a[2] - v0[3] * a[3], v0[3] * a[2] + v0[2] * a[3]};
                            const f32x4 w1 = {v1[0] * b[0] - v1[1] * b[1], v1[1] * b[0] + v1[0] * b[1], v1[2] * b[2] - v1[3] * b[3], v1[3] * b[2] + v1[2] * b[3]};
                            store8(Q + (size_t)row * 768 + col, w0, w1); }
                    }
            } else {
#pragma unroll
                for (int ai = 0; ai < 2; ++ai)
#pragma unroll
                    for (int m = 0; m < 4; ++m) { const float rs = spv[ai][m][0];
                        store8(Q + (size_t)(row0 + ai * 128 + m * 16) * 768 + col, acc[ai][bj][m][0] * rs, acc[ai][bj][m][1] * rs); }
            }
        }
    }
};
struct EpiUpKV {
    bf16_t* KV; const float* ssq;
    __device__ __forceinline__ void operator()(const f32x4 (&acc)[2][2][4][2], const pg8::Unit& u, int wr, int wc, int fr, int fq) const {
        const int row0 = u.pm * 256 + wr * 64 + fr;
        f32x4 spv[2][4];
#pragma unroll
        for (int ai = 0; ai < 2; ++ai)
#pragma unroll
            for (int m = 0; m < 4; ++m) spv[ai][m] = *(const f32x4*)(ssq + (size_t)(row0 + ai * 128 + m * 16) * 8 + 4);
#pragma unroll
        for (int ai = 0; ai < 2; ++ai)
#pragma unroll
            for (int m = 0; m < 4; ++m) {
                const int row = row0 + ai * 128 + m * 16;
                const f32x4 sp = spv[ai][m];
                const float rs = 1.0f / sqrtf(((sp[0] + sp[1]) + (sp[2] + sp[3])) * (1.f / 128.f) + RMS_EPS);
#pragma unroll
                for (int bj = 0; bj < 2; ++bj) { const int col = u.pn * 256 + bj * 128 + wc * 32 + fq * 8;
                    store8(KV + (size_t)row * 1024 + col, acc[ai][bj][m][0] * rs, acc[ai][bj][m][1] * rs); }
            }
    }
};
struct EpiBranchAll {
    bf16_t* Mg; bf16_t* M0; bf16_t* M1; const bf16_t* G3;
    __device__ __forceinline__ void operator()(const f32x4 (&acc)[2][2][4][2], const pg8::Unit& u, int wr, int wc, int fr, int fq) const {
        const int row0 = u.pm * 256 + wr * 64 + fr, br = u.ord, col0 = u.pn * 256 + wc * 32 + fq * 8;
        bf16_t* dst = br == 0 ? M0 : (br == 1 ? M1 : Mg);
#pragma unroll
        for (int ai = 0; ai < 2; ++ai)
#pragma unroll
            for (int mh = 0; mh < 2; ++mh) {
                u32x2 gw[2][2]; u32x4 ma[2][2], mb[2][2];
#pragma unroll
                for (int mm = 0; mm < 2; ++mm)
#pragma unroll
                    for (int bj = 0; bj < 2; ++bj) { const int row = row0 + ai * 128 + (2 * mh + mm) * 16, col = col0 + bj * 128;
                        gw[mm][bj] = *(const u32x2*)((const unsigned char*)G3 + (size_t)row * 3072 + br * 1024 + col);
                        ma[mm][bj] = (u32x4){0u, 0u, 0u, 0u}; mb[mm][bj] = (u32x4){0u, 0u, 0u, 0u}; }
                if (br == 2) {
#pragma unroll
                    for (int mm = 0; mm < 2; ++mm)
#pragma unroll
                        for (int bj = 0; bj < 2; ++bj) { const size_t off = (size_t)(row0 + ai * 128 + (2 * mh + mm) * 16) * DM + col0 + bj * 128;
                            const u32x2 p = *(const u32x2*)((const unsigned char*)M0 + off), q = *(const u32x2*)((const unsigned char*)M1 + off);
                            ma[mm][bj] = (u32x4){p.x, p.y, 0u, 0u}; mb[mm][bj] = (u32x4){q.x, q.y, 0u, 0u}; }
                }
#pragma unroll
                for (int mm = 0; mm < 2; ++mm)
#pragma unroll
                    for (int bj = 0; bj < 2; ++bj) { const int m = 2 * mh + mm; const size_t off = (size_t)(row0 + ai * 128 + m * 16) * DM + col0 + bj * 128; const u32x2 g = gw[mm][bj]; const u32x4 a = ma[mm][bj], b2 = mb[mm][bj];
                        const f32x2 g01 = __builtin_amdgcn_cvt_pk_f32_fp8((int)g.x, false) * (1.f / 64.f), g23 = __builtin_amdgcn_cvt_pk_f32_fp8((int)g.x, true) * (1.f / 64.f);
                        const f32x2 g45 = __builtin_amdgcn_cvt_pk_f32_fp8((int)g.y, false) * (1.f / 64.f), g67 = __builtin_amdgcn_cvt_pk_f32_fp8((int)g.y, true) * (1.f / 64.f);
                        f32x4 v0 = acc[ai][bj][m][0], v1 = acc[ai][bj][m][1];
                        const f32x2 s01 = (__builtin_amdgcn_cvt_pk_f32_fp8((int)a.x, false) + __builtin_amdgcn_cvt_pk_f32_fp8((int)b2.x, false)) * (1.f / 64.f), s23 = (__builtin_amdgcn_cvt_pk_f32_fp8((int)a.x, true) + __builtin_amdgcn_cvt_pk_f32_fp8((int)b2.x, true)) * (1.f / 64.f);
                        const f32x2 s45 = (__builtin_amdgcn_cvt_pk_f32_fp8((int)a.y, false) + __builtin_amdgcn_cvt_pk_f32_fp8((int)b2.y, false)) * (1.f / 64.f), s67 = (__builtin_amdgcn_cvt_pk_f32_fp8((int)a.y, true) + __builtin_amdgcn_cvt_pk_f32_fp8((int)b2.y, true)) * (1.f / 64.f);
                        v0[0] = v0[0] * g01[0] + s01[0]; v0[1] = v0[1] * g01[1] + s01[1]; v0[2] = v0[2] * g23[0] + s23[0]; v0[3] = v0[3] * g23[1] + s23[1];
                        v1[0] = v1[0] * g45[0] + s45[0]; v1[1] = v1[1] * g45[1] + s45[1]; v1[2] = v1[2] * g67[0] + s67[0]; v1[3] = v1[3] * g67[1] + s67[1];
                        store8_fp8((unsigned char*)dst + off, v0, v1, 64.f); }
            }
    }
};
struct BranchSched {
    static constexpr bool GATHER = false; static constexpr bool VARK = true;
    const char* A0; const char* B0; size_t sA, sB; int lda, ldb, c, sw8, sa8, G, ntile;
    __device__ __forceinline__ int ktiles(const pg8::Unit& u) const { return u.ord == 1 ? 2 : 4; }
    __device__ __forceinline__ bool next(int i, pg8::Unit& u) const { const int t = c + (i / 3) * G; if (t >= ntile) return false; u.pm = t >> 2; u.pn = t & 3; u.ord = i % 3; return true; }
    __device__ __forceinline__ const char* a_base(const pg8::Unit& u) const { return A0 + (size_t)u.ord * sA + (size_t)u.pm * 256 * lda * 2; }
    __device__ __forceinline__ const char* b_base(const pg8::Unit& u) const { return B0 + (size_t)u.ord * sB + (size_t)u.pn * 256 * ldb * 2; }
    __device__ __forceinline__ void a_off(const pg8::Unit&, const int (&R)[2], const int (&C)[2], unsigned (&v)[2][2]) const {
#pragma unroll
        for (int i = 0; i < 2; ++i) { v[0][i] = (unsigned)(R[i] * lda + C[i]) * 2u; v[1][i] = (unsigned)((128 + R[i]) * lda + C[i]) * 2u; }
    }
};
struct EpiWo {
    float* out; const float* xsrc; int rowbase;
    __device__ __forceinline__ void operator()(const f32x4 (&acc)[2][2][4][2], const pg8::Unit& u, int wr, int wc, int fr, int fq) const {
        const int row0 = rowbase + u.pm * 256 + wr * 64 + fr, col0 = u.pn * 256 + wc * 32 + fq * 8;
#pragma unroll
        for (int ai = 0; ai < 2; ++ai)
#pragma unroll
            for (int mh = 0; mh < 2; ++mh) {
                f32x4 x[2][2][2];
#pragma unroll
                for (int mm = 0; mm < 2; ++mm)
#pragma unroll
                    for (int bj = 0; bj < 2; ++bj) { const size_t off = (size_t)(row0 + ai * 128 + (2 * mh + mm) * 16) * DM + col0 + bj * 128;
                        x[mm][bj][0] = *(const f32x4*)(xsrc + off); x[mm][bj][1] = *(const f32x4*)(xsrc + off + 4); }
#pragma unroll
                for (int mm = 0; mm < 2; ++mm)
#pragma unroll
                    for (int bj = 0; bj < 2; ++bj) { const size_t off = (size_t)(row0 + ai * 128 + (2 * mh + mm) * 16) * DM + col0 + bj * 128;
                        *(f32x4*)(out + off) = x[mm][bj][0] * ALPHA + acc[ai][bj][2 * mh + mm][0]; *(f32x4*)(out + off + 4) = x[mm][bj][1] * ALPHA + acc[ai][bj][2 * mh + mm][1]; }
            }
    }
};

__device__ __forceinline__ int dequeue(Frame& F, unsigned* ctr, int& pre) {
    LAS int* slot = (LAS int*)(F.lds + L_QSLOT);
    __syncthreads();
    if (F.tid == 0) {
        *slot = (int)__hip_atomic_fetch_add(ctr, 1u, __ATOMIC_RELAXED, __HIP_MEMORY_SCOPE_AGENT); (void)pre;
    }
    __syncthreads();
    return *slot;
}

namespace att {
constexpr int KSLOT = 12288, VSLOT = 8192, NSLOT = 4;
constexpr int A_K = 0, A_V = NSLOT * KSLOT, A_WS = A_V + NSLOT * VSLOT, A_OST = A_WS + 8 * 256, A_MW = A_OST + 8 * 4096, A_END = A_MW + 8 * NSLOT * 256;
static_assert(A_END <= RING_BYTES, "attention LDS");
typedef short s16x4 __attribute__((ext_vector_type(4)));
__device__ __forceinline__ int crow(int r, int hi) { return (r & 3) + 8 * (r >> 2) + 4 * hi; }
__device__ __forceinline__ void glds16(const void* gsrc, unsigned lds_dst) { unsigned keep;
    asm volatile("s_mov_b32 %0, m0\n\ts_mov_b32 m0, %2\n\ts_nop 0\n\tglobal_load_lds_dwordx4 %1, off\n\ts_mov_b32 m0, %0" : "=&s"(keep) : "v"(gsrc), "s"(lds_dst) : "memory"); }
__device__ __forceinline__ void glds4(const void* gsrc, unsigned lds_dst) { unsigned keep;
    asm volatile("s_mov_b32 %0, m0\n\ts_mov_b32 m0, %2\n\ts_nop 0\n\tglobal_load_lds_dword %1, off\n\ts_mov_b32 m0, %0" : "=&s"(keep) : "v"(gsrc), "s"(lds_dst) : "memory"); }
#define ATT_WAIT_BAR(N) asm volatile("s_waitcnt vmcnt(" #N ") lgkmcnt(0)\n\ts_barrier" ::: "memory")
__device__ __forceinline__ float emax(float a, float b) { return __builtin_elementwise_maximum(a, b); }
__device__ __forceinline__ float halfmax(float m) { auto rr = __builtin_amdgcn_permlane32_swap(__float_as_uint(m), __float_as_uint(m), false, false); return emax(__uint_as_float(rr[0]), __uint_as_float(rr[1])); }
__device__ __forceinline__ float halfsum(float m) { auto rr = __builtin_amdgcn_permlane32_swap(__float_as_uint(m), __float_as_uint(m), false, false); return __uint_as_float(rr[0]) + __uint_as_float(rr[1]); }
typedef short v4i16_t __attribute__((ext_vector_type(4)));
__device__ __forceinline__ s16x4 vtr(const LAS unsigned char* p) { return __builtin_bit_cast(s16x4, __builtin_amdgcn_ds_read_tr16_b64_v4i16((LAS v4i16_t*)p)); }
__device__ __forceinline__ void pv(f32x16* o, f32x16& lacc, const LAS unsigned char* vp, bf16x8 pa0, bf16x8 pa1, bf16x8 pa2, bf16x8 pa3) {
    { const u32x4 one4 = {0x3F803F80u, 0x3F803F80u, 0x3F803F80u, 0x3F803F80u}; const bf16x8 ones = __builtin_bit_cast(bf16x8, one4);
      lacc = __builtin_amdgcn_mfma_f32_32x32x16_bf16(pa0, ones, lacc, 0, 0, 0); lacc = __builtin_amdgcn_mfma_f32_32x32x16_bf16(pa1, ones, lacc, 0, 0, 0);
      lacc = __builtin_amdgcn_mfma_f32_32x32x16_bf16(pa2, ones, lacc, 0, 0, 0); lacc = __builtin_amdgcn_mfma_f32_32x32x16_bf16(pa3, ones, lacc, 0, 0, 0); }
#pragma unroll
    for (int d0 = 0; d0 < 2; ++d0) { s16x4 lo[4], hi[4];
#pragma unroll
        for (int ks = 0; ks < 4; ++ks) { lo[ks] = vtr(vp + d0 * 4096 + ks * 1024); hi[ks] = vtr(vp + d0 * 4096 + ks * 1024 + 512); }
#define ATT_PK(k) (bf16x8){lo[k][0], lo[k][1], lo[k][2], lo[k][3], hi[k][0], hi[k][1], hi[k][2], hi[k][3]}
        o[d0] = __builtin_amdgcn_mfma_f32_32x32x16_bf16(pa0, ATT_PK(0), o[d0], 0, 0, 0);
        o[d0] = __builtin_amdgcn_mfma_f32_32x32x16_bf16(pa1, ATT_PK(1), o[d0], 0, 0, 0);
        o[d0] = __builtin_amdgcn_mfma_f32_32x32x16_bf16(pa2, ATT_PK(2), o[d0], 0, 0, 0);
        o[d0] = __builtin_amdgcn_mfma_f32_32x32x16_bf16(pa3, ATT_PK(3), o[d0], 0, 0, 0);
#undef ATT_PK
    }
}
struct Desc {
    const bf16_t* Q; const bf16_t* K1; const bf16_t* K2; const bf16_t* V; bf16_t* O; float* lse; const unsigned* mask;
    int qpitch, k1pitch, k2pitch, vpitch, opitch, lsepitch;
    int rstride, q0, nq, jlo, jhi;
    int o8;
};
template <int DQK, int MODE>
__device__ __forceinline__ void attn_unit(LAS unsigned char* lds, const Desc& d) {
    int tid_ = threadIdx.x; asm volatile("" : "+v"(tid_));
    const int tid = tid_, lane = tid & 63, r32 = lane & 31, hi = lane >> 5, wid = __builtin_amdgcn_readfirstlane(tid >> 6);
    constexpr int ND = DQK / 16;
    const unsigned lds0 = (unsigned)(size_t)lds;
    LAS float* wsf = (LAS float*)(lds + A_WS) + wid * 64;
    const int qw = d.q0 + wid * 32;
    const bool wvalid = wid * 32 < d.nq;
    const int kkey = 8 * wid + (lane >> 3), kch = (lane & 7) ^ ((kkey >> 1) & 7);
    const bf16_t* ksrc = d.K1 + (size_t)kkey * d.rstride * d.k1pitch + kch * 8;
    const int k2key = 16 * (wid & 3) + (lane >> 2), k2ch = (lane & 3) ^ ((k2key >> 2) & 3);
    const bf16_t* k2src = (DQK == 96) ? d.K2 + (size_t)k2key * d.rstride * d.k2pitch + k2ch * 8 : nullptr;
    int kofs[ND];
#pragma unroll
    for (int d0 = 0; d0 < ND; ++d0) kofs[d0] = d0 < 4 ? r32 * 128 + (((2 * d0 + hi) ^ ((r32 >> 1) & 7)) * 16) : 8192 + r32 * 64 + (((2 * (d0 - 4) + hi) ^ ((r32 >> 2) & 3)) * 16);
    const bf16_t* vsrc = d.V + (size_t)(16 * (wid & 3) + (lane >> 2)) * d.rstride * d.vpitch + (wid >> 2) * 32 + (lane & 3) * 8;
    const size_t kstep = (size_t)64 * d.rstride * d.k1pitch, k2step = (size_t)64 * d.rstride * d.k2pitch, vstep = (size_t)64 * d.rstride * d.vpitch;
    const bool two = (DQK == 96) && wid < 4;
    const unsigned* msrc = (MODE == 2) ? d.mask + (size_t)(wvalid ? (qw + (lane >> 1)) : d.q0) * 64 + (lane & 1) : nullptr;
#define ATT_ISSUE(j) do { const int sl_ = (j) % NSLOT; \
        glds16(ksrc + (size_t)(j) * kstep, (unsigned)__builtin_amdgcn_readfirstlane(lds0 + A_K + sl_ * KSLOT + wid * 1024)); \
        if (two) glds16(k2src + (size_t)(j) * k2step, (unsigned)__builtin_amdgcn_readfirstlane(lds0 + A_K + sl_ * KSLOT + (8 + wid) * 1024)); \
        glds16(vsrc + (size_t)(j) * vstep, (unsigned)__builtin_amdgcn_readfirstlane(lds0 + A_V + sl_ * VSLOT + wid * 1024)); \
        if (MODE == 2) glds4(msrc + 2 * (j), (unsigned)__builtin_amdgcn_readfirstlane(lds0 + A_MW + (wid * NSLOT + sl_) * 256)); } while (0)
    ATT_ISSUE(d.jlo);
    if (d.jlo + 1 < d.jhi) ATT_ISSUE(d.jlo + 1);
    bf16x8 qr[ND];
    { const int qi = wvalid ? (qw + r32) : d.q0; const bf16_t* qp = d.Q + (size_t)qi * d.rstride * d.qpitch + hi * 8;
#pragma unroll
      for (int d0 = 0; d0 < ND; ++d0) qr[d0] = *(const bf16x8*)(qp + d0 * 16); }
#pragma unroll
    for (int d0 = 0; d0 < ND; ++d0) asm volatile("" : "+v"(qr[d0]));
    float mhat = 0.f; f32x16 o[2]; o[0] = f32x16{}; o[1] = f32x16{}; f32x16 lacc = f32x16{};
    bool started = false;
    const LAS unsigned char* vp0 = lds + A_V + ((lane >> 4) & 1) * 32 + (lane & 3) * 8 + (4 * hi + ((lane & 15) >> 2)) * 64;
    const int qi = qw + r32;
    f32x16 p0 = f32x16{}, p1 = f32x16{};
    f32x16 negm = f32x16{};
#define ATT_REL(j) (wvalid && (64 * (j) <= qw + 31) && (MODE != 1 || (64 * (j) + 63 >= qw - 128)))
#define ATT_QK(j) do { const int sl_ = (j) % NSLOT; \
        const LAS unsigned char* kb = lds + A_K + sl_ * KSLOT; bf16x8 kf[2 * ND]; \
        _Pragma("unroll") for (int d0 = 0; d0 < ND; ++d0) { kf[2 * d0] = *(const LAS bf16x8*)(kb + kofs[d0]); kf[2 * d0 + 1] = *(const LAS bf16x8*)(kb + kofs[d0] + (d0 < 4 ? 4096 : 2048)); } \
        __builtin_amdgcn_sched_barrier(0); \
        _Pragma("unroll") for (int d0 = 0; d0 < ND; ++d0) { \
            if (d0 == 0) { p0 = __builtin_amdgcn_mfma_f32_32x32x16_bf16(kf[0], qr[0], negm, 0, 0, 0); p1 = __builtin_amdgcn_mfma_f32_32x32x16_bf16(kf[1], qr[0], negm, 0, 0, 0); } \
            else { p0 = __builtin_amdgcn_mfma_f32_32x32x16_bf16(kf[2 * d0], qr[d0], p0, 0, 0, 0); p1 = __builtin_amdgcn_mfma_f32_32x32x16_bf16(kf[2 * d0 + 1], qr[d0], p1, 0, 0, 0); } } } while (0)
#define ATT_SMPV(j) do { const int sl_ = (j) % NSLOT; \
        { bool domask = true; unsigned mx_ = 0u, my_ = 0u;        \
          if (MODE == 2) { const u32x2 mw = *(const LAS u32x2*)(lds + A_MW + (wid * NSLOT + sl_) * 256 + r32 * 8); mx_ = mw.x; my_ = mw.y; } \
          else { \
            bool full = (64 * (j) + 63 <= qw); \
            if (MODE == 1) full = full && (64 * (j) >= qw + 31 - 128); \
            domask = !full; \
            if (domask) { const int a_ = qi - 64 * (j), lo_ = (MODE == 1) ? a_ - 128 : -4096;        \
                { const int h_ = a_ < 31 ? a_ : 31, l_ = lo_ > 0 ? lo_ : 0; mx_ = (h_ < l_) ? 0u : ((0xFFFFFFFFu >> (31 - h_)) & (0xFFFFFFFFu << l_)); } \
                { const int h_ = a_ - 32 < 31 ? a_ - 32 : 31, l_ = lo_ - 32 > 0 ? lo_ - 32 : 0; my_ = (h_ < l_) ? 0u : ((0xFFFFFFFFu >> (31 - h_)) & (0xFFFFFFFFu << l_)); } } \
          } \
          if (domask) { const unsigned w0 = mx_ >> (4 * hi), w1 = my_ >> (4 * hi); \
            _Pragma("unroll") for (int r = 0; r < 16; ++r) { const int bit = (r & 3) + 8 * (r >> 2); \
                const unsigned m0 = (unsigned)__builtin_amdgcn_sbfe((int)w0, bit, 1), m1 = (unsigned)__builtin_amdgcn_sbfe((int)w1, bit, 1);        \
                p0[r] = __uint_as_float((m0 & __float_as_uint(p0[r])) | (~m0 & 0xFF800000u)); p1[r] = __uint_as_float((m1 & __float_as_uint(p1[r])) | (~m1 & 0xFF800000u)); } } } \
        float rm = emax(p0[0], p1[0]), rm2 = emax(p0[1], p1[1]); \
        _Pragma("unroll") for (int r = 2; r < 16; r += 2) { rm = emax(emax(rm, p0[r]), p1[r]); rm2 = emax(emax(rm2, p0[r + 1]), p1[r + 1]); } \
        rm = halfmax(emax(rm, rm2)); \
        bool need; float dl; \
        if (!started) { need = true; dl = emax(rm, -200.f); } else { need = __any(rm > 8.f) != 0; dl = emax(rm, 0.f); } \
        if (need) { mhat += dl; \
            _Pragma("unroll") for (int r = 0; r < 16; ++r) negm[r] = -mhat; \
            _Pragma("unroll") for (int r = 0; r < 16; ++r) { p0[r] -= dl; p1[r] -= dl; } \
            if (started) { const float f = __builtin_amdgcn_exp2f(-dl); \
                if (hi == 0) wsf[r32] = f; \
                LDS_WAIT(); \
                _Pragma("unroll") for (int r = 0; r < 16; ++r) { const float fr_ = wsf[crow(r, hi)]; o[0][r] *= fr_; o[1][r] *= fr_; lacc[r] *= fr_; } } } \
        started = true; \
        __builtin_amdgcn_s_setprio(1);        \
        _Pragma("unroll") for (int r = 0; r < 16; ++r) { p0[r] = __builtin_amdgcn_exp2f(p0[r]); p1[r] = __builtin_amdgcn_exp2f(p1[r]); } \
        const u32x4 pw0 = (u32x4){cvt_pk_bf16(p0[0], p0[1]), cvt_pk_bf16(p0[2], p0[3]), cvt_pk_bf16(p0[4], p0[5]), cvt_pk_bf16(p0[6], p0[7])}; \
        const u32x4 pw1 = (u32x4){cvt_pk_bf16(p0[8], p0[9]), cvt_pk_bf16(p0[10], p0[11]), cvt_pk_bf16(p0[12], p0[13]), cvt_pk_bf16(p0[14], p0[15])}; \
        const u32x4 pw2 = (u32x4){cvt_pk_bf16(p1[0], p1[1]), cvt_pk_bf16(p1[2], p1[3]), cvt_pk_bf16(p1[4], p1[5]), cvt_pk_bf16(p1[6], p1[7])}; \
        const u32x4 pw3 = (u32x4){cvt_pk_bf16(p1[8], p1[9]), cvt_pk_bf16(p1[10], p1[11]), cvt_pk_bf16(p1[12], p1[13]), cvt_pk_bf16(p1[14], p1[15])}; \
        pv(o, lacc, vp0 + sl_ * VSLOT, __builtin_bit_cast(bf16x8, pw0), __builtin_bit_cast(bf16x8, pw1), __builtin_bit_cast(bf16x8, pw2), __builtin_bit_cast(bf16x8, pw3)); \
        __builtin_amdgcn_s_setprio(0); } while (0)
#define ATT_TOPWAIT(j) do { if ((j) + 1 < d.jhi) { if (MODE == 2 || two) { ATT_WAIT_BAR(3); } else { ATT_WAIT_BAR(2); } } else { ATT_WAIT_BAR(0); } } while (0)
    if (wid < 4) {
        for (int j = d.jlo; j < d.jhi; ++j) {
            ATT_TOPWAIT(j);
            if (j + 2 < d.jhi) ATT_ISSUE(j + 2);
            if (ATT_REL(j)) { ATT_QK(j); ATT_SMPV(j); }
        }
        asm volatile("s_waitcnt lgkmcnt(0)\n\ts_barrier" ::: "memory");
    } else {
        ATT_TOPWAIT(d.jlo);
        if (d.jlo + 2 < d.jhi) ATT_ISSUE(d.jlo + 2);
        if (ATT_REL(d.jlo)) ATT_QK(d.jlo);
        for (int j = d.jlo + 1; j < d.jhi; ++j) {
            ATT_TOPWAIT(j);
            if (j + 2 < d.jhi) ATT_ISSUE(j + 2);
            if (ATT_REL(j - 1)) ATT_SMPV(j - 1);
            if (ATT_REL(j)) ATT_QK(j);
        }
        asm volatile("s_waitcnt lgkmcnt(0)\n\ts_barrier" ::: "memory");
        if (ATT_REL(d.jhi - 1)) ATT_SMPV(d.jhi - 1);
    }
#undef ATT_REL
#undef ATT_QK
#undef ATT_SMPV
#undef ATT_TOPWAIT
#undef ATT_ISSUE
    if (wvalid) {
        LAS bf16_t* stg = (LAS bf16_t*)(lds + A_OST) + wid * 2048;
        if (d.lse != nullptr && r32 == 0) {
#pragma unroll
            for (int r = 0; r < 16; ++r) wsf[32 + crow(r, hi)] = lacc[r]; }
        if (d.o8) {
            LAS unsigned char* stg8 = (LAS unsigned char*)stg;
#pragma unroll
            for (int r = 0; r < 16; ++r) { const int orow = crow(r, hi); const float rl = __builtin_amdgcn_rcpf(lacc[r]) * 32.f;
                const unsigned p = (unsigned)__builtin_amdgcn_cvt_pk_fp8_f32(o[0][r] * rl, o[1][r] * rl, 0, false);
                stg8[orow * 64 + r32] = (unsigned char)(p & 0xffu); stg8[orow * 64 + 32 + r32] = (unsigned char)((p >> 8) & 0xffu); }
            LDS_WAIT();
#pragma unroll
            for (int i = 0; i < 2; ++i) { const int row = i * 16 + (lane >> 2), ch = lane & 3; const u32x4 v = *(const LAS u32x4*)(stg8 + row * 64 + ch * 16);
                *(u32x4*)((unsigned char*)d.O + (size_t)(qw + row) * d.rstride * d.opitch + ch * 16) = v; }
        } else {
#pragma unroll
        for (int r = 0; r < 16; ++r) { const int orow = crow(r, hi); const float rl = __builtin_amdgcn_rcpf(lacc[r]);
            stg[orow * 64 + r32] = (bf16_t)f2bf(o[0][r] * rl); stg[orow * 64 + 32 + r32] = (bf16_t)f2bf(o[1][r] * rl); }
        LDS_WAIT();
#pragma unroll
        for (int i = 0; i < 4; ++i) { const int row = i * 8 + (lane >> 3), ch = lane & 7; const u32x4 v = *(const LAS u32x4*)(stg + row * 64 + ch * 8);
            *(u32x4*)(d.O + (size_t)(qw + row) * d.rstride * d.opitch + ch * 8) = v; }
        }
        if (d.lse != nullptr && hi == 0) d.lse[(size_t)(qw + r32) * d.rstride * d.lsepitch] = mhat + __builtin_amdgcn_logf(wsf[32 + r32]);
    }
    asm volatile("s_waitcnt lgkmcnt(0)\n\ts_barrier" ::: "memory");
}
}

namespace idx {
constexpr int KS = 8192, I_K = 0, I_ST = 3 * KS, I_END = I_ST + 8 * 8192;
static_assert(I_END <= RING_BYTES, "indexer LDS");
__device__ __forceinline__ void score_unit(LAS unsigned char* lds, const bf16_t* PROJ, float* SC, int b, int qh  , int jg) {
    int tid_ = threadIdx.x; asm volatile("" : "+v"(tid_));
    const int tid = tid_, lane = tid & 63, r32 = lane & 31, hi = lane >> 5, wid = __builtin_amdgcn_readfirstlane(tid >> 6);
    const int qg = wid >> 1, hh = wid & 1;
    const unsigned lds0 = (unsigned)(size_t)lds;
    const int qrow = b * SEQ + qh * 128 + qg * 32 + r32;
    const bf16_t* kbase = PROJ + (size_t)(b * SEQ) * PW + 3968;
    const int kkey = 8 * wid + (lane >> 3);
    const bf16_t* ksrc = kbase + (size_t)kkey * PW + ((lane & 7) ^ ((kkey >> 1) & 7)) * 8;
    const int j0 = 4 * jg;
#define IDX_ISSUE(j) att::glds16(ksrc + (size_t)(j) * 64 * PW, (unsigned)__builtin_amdgcn_readfirstlane(lds0 + I_K + ((j) % 3) * KS + wid * 1024))
    IDX_ISSUE(j0); IDX_ISSUE(j0 + 1);
    bf16x8 qf[4][4]; float wv[4];
    { const bf16_t* qp = PROJ + (size_t)qrow * PW + 3328 + hh * 256 + hi * 8;
#pragma unroll
      for (int h = 0; h < 4; ++h)
#pragma unroll
          for (int d0 = 0; d0 < 4; ++d0) qf[h][d0] = *(const bf16x8*)(qp + h * 64 + d0 * 16);
      const u32x2 ww = *(const u32x2*)(PROJ + (size_t)qrow * PW + 4032 + hh * 4);
      wv[0] = bflo(ww.x); wv[1] = bfhi(ww.x); wv[2] = bflo(ww.y); wv[3] = bfhi(ww.y); }
#pragma unroll
    for (int h = 0; h < 4; ++h) { asm volatile("" : "+v"(wv[h]));
#pragma unroll
        for (int d0 = 0; d0 < 4; ++d0) asm volatile("" : "+v"(qf[h][d0])); }
    const int qb = qh >> 1;
    unsigned* blk = (unsigned*)SC + ((size_t)b * 36 + (size_t)(qb * (qb + 1) / 2)) * 32768; const int pitch = 128 * (qb + 1);
    f32x4 ve[4] = {};
    LAS unsigned char* stg = lds + I_ST + wid * 8192;
    const LAS unsigned char* stg2 = lds + I_ST + (wid ^ 1) * 8192;
#pragma nounroll
    for (int jj = 0; jj < 4; ++jj) { const int j = j0 + jj;
        if (jj < 2) { ATT_WAIT_BAR(1); } else if (jj == 2) { ATT_WAIT_BAR(5); } else { ATT_WAIT_BAR(4); }
        if (jj + 2 < 4) IDX_ISSUE(j + 2);
        const LAS unsigned char* kb = lds + I_K + (j % 3) * KS + r32 * 128;
#pragma nounroll
        for (int half = 0; half < 2; ++half) {
            bf16x8 kf[4];
#pragma unroll
            for (int d0 = 0; d0 < 4; ++d0) kf[d0] = *(const LAS bf16x8*)(kb + half * 4096 + (((2 * d0 + hi) ^ ((r32 >> 1) & 7)) * 16));
            f32x16 t0 = f32x16{};
#pragma unroll
            for (int h = 0; h < 4; ++h) {
                f32x16 p0 = f32x16{};
#pragma unroll
                for (int d0 = 0; d0 < 4; ++d0) p0 = __builtin_amdgcn_mfma_f32_32x32x16_bf16(kf[d0], qf[h][d0], p0, 0, 0, 0);
#pragma unroll
                for (int r = 0; r < 16; ++r) t0[r] += wv[h] * att::emax(p0[r], 0.f);
            }
#pragma unroll
            for (int g = 0; g < 4; ++g) { const int c0 = 8 * half + 2 * g + hi;
                *(LAS f32x4*)(stg + r32 * 256 + ((c0 ^ (r32 & 15)) * 16)) = (f32x4){t0[4 * g], t0[4 * g + 1], t0[4 * g + 2], t0[4 * g + 3]}; }
        }
        asm volatile("s_waitcnt lgkmcnt(0)\n\ts_barrier" ::: "memory");
#pragma unroll
        for (int i = 0; i < 4; ++i) { const int q = hh * 16 + i * 4 + (lane >> 4), c = lane & 15; const int so = q * 256 + ((c ^ (q & 15)) * 16);
            const f32x4 v = *(const LAS f32x4*)(stg + so) + *(const LAS f32x4*)(stg2 + so);
            if (jj & 1) { const f32x4 e = ve[i]; const u32x4 w = {pk2(e[0], v[0]), pk2(e[1], v[1]), pk2(e[2], v[2]), pk2(e[3], v[3])};
                *(u32x4*)(blk + (size_t)((qh & 1) * 128 + qg * 32 + q) * pitch + 64 * (j >> 1) + 4 * c) = w; }
            else ve[i] = v; }
        LDS_WAIT();
    }
#undef IDX_ISSUE
    asm volatile("s_waitcnt lgkmcnt(0)\n\ts_barrier" ::: "memory");
}

__device__ __forceinline__ int wave_sum_i(int v) {
    v += __builtin_amdgcn_update_dpp(0, v, 0xB1, 0xF, 0xF, true);
    v += __builtin_amdgcn_update_dpp(0, v, 0x4E, 0xF, 0xF, true);
    v += __builtin_amdgcn_update_dpp(0, v, 0x141, 0xF, 0xF, true);
    v += __builtin_amdgcn_update_dpp(0, v, 0x140, 0xF, 0xF, true);
    return __builtin_amdgcn_readlane(v, 0) + __builtin_amdgcn_readlane(v, 16) + __builtin_amdgcn_readlane(v, 32) + __builtin_amdgcn_readlane(v, 48);
}
__device__ __forceinline__ unsigned long long keep_low(unsigned long long m, int k) { while (__builtin_popcountll(m) > k) m &= ~(1ull << (63 - __builtin_clzll(m))); return m; }
__device__ __forceinline__ void select_rows4(const float* SC, unsigned* MASK, int row0  , int lane, LAS unsigned* slot  ) {
    const int b = row0 / SEQ, t0 = row0 % SEQ, qb = t0 >> 8;
    if (t0 < 256) {
#pragma unroll 1
        for (int i = 0; i < 4; ++i) { const int t = t0 + i, lo = 64 * lane;
            const unsigned long long w = (lo + 63 <= t) ? ~0ull : (lo > t ? 0ull : ((2ull << (t - lo)) - 1ull));
            if (lane < 32) ((unsigned long long*)(MASK + (size_t)(row0 + i) * 64))[lane] = w; }
        return;
    }
    const int pitch = 128 * (qb + 1), pmax = pitch - 1;
    const unsigned* srow0 = (const unsigned*)SC + ((size_t)b * 36 + (size_t)(qb * (qb + 1) / 2)) * 32768 + (size_t)(t0 - 256 * qb) * pitch;
    unsigned raw[16];
#pragma unroll
    for (int i = 0; i < 16; ++i) { const int s_ = 64 * i + lane; raw[i] = srow0[s_ < pmax ? s_ : pmax]; }
#pragma unroll 1
    for (int r = 0; r < 4; ++r) {
        const int t = t0 + r;
        unsigned P[16];
#pragma unroll
        for (int i = 0; i < 16; ++i) P[i] = raw[i];
        { const unsigned* nx = srow0 + (size_t)(r < 3 ? r + 1 : 3) * pitch;
#pragma unroll
          for (int i = 0; i < 16; ++i) { const int s_ = 64 * i + lane; raw[i] = nx[s_ < pmax ? s_ : pmax]; } }
#define SEL_TSTAGE(sh, m) _Pragma("unroll") for (int q = 0; q < 16; ++q) if (!(q & (sh))) { const unsigned a_ = P[q], b_ = P[q + (sh)]; \
            P[q] = (a_ & (m)) | ((b_ << (sh)) & ~(m)); P[q + (sh)] = ((a_ >> (sh)) & (m)) | (b_ & ~(m)); }
        SEL_TSTAGE(8, 0x00FF00FFu) SEL_TSTAGE(4, 0x0F0F0F0Fu) SEL_TSTAGE(2, 0x33333333u) SEL_TSTAGE(1, 0x55555555u)
#undef SEL_TSTAGE
        { const unsigned sg = P[15];
#pragma unroll
          for (int q = 0; q < 15; ++q) P[q] ^= sg;
          P[15] = ~sg; }
        const int nj = ((t - lane) >> 6) + 1;
        unsigned A = ((1u << ((nj + 1) >> 1)) - 1u) | (((1u << (nj >> 1)) - 1u) << 16), G = 0u;
        int cab = 0, cntA = t + 1;
#pragma unroll
        for (int bit = 15; bit >= 0; --bit) {
            if (cab + cntA != 256) {
                const unsigned ones = A & P[bit];
                const int c = wave_sum_i(__builtin_popcount(ones));
                if (cab + c >= 256) { A = ones; cntA = c; } else { G |= ones; cab += c; A &= ~ones; cntA -= c; }
            }
        }
        int need = 256 - cab;
        unsigned sel = G | A;
        if (cntA != need) {
            unsigned selA = 0u;
#pragma nounroll
            for (int j = 0; j < 32; ++j) { const int pb = (j >> 1) + 16 * (j & 1);
                unsigned long long m = __ballot((A >> pb) & 1u);
                if (__builtin_popcountll(m) > need) m = keep_low(m, need);
                need -= __builtin_popcountll(m);
                selA |= (unsigned)((m >> lane) & 1ull) << pb;
            }
            sel = G | selA;
        }
        int lo = 0, hi = 0;
#pragma unroll
        for (int j = 0; j < 32; ++j) { const unsigned long long m = __ballot((sel >> ((j >> 1) + 16 * (j & 1))) & 1u);
            lo = (lane == j) ? (int)(unsigned)m : lo; hi = (lane == j) ? (int)(unsigned)(m >> 32) : hi; }
        if (lane < 32) ((unsigned long long*)(MASK + (size_t)(row0 + r) * 64))[lane] = (unsigned long long)(unsigned)lo | ((unsigned long long)(unsigned)hi << 32);
    }
}
}

__device__ __forceinline__ unsigned* queue_word(Frame& F, int l, int chunk, int q) { return (unsigned*)(F.ws + WS_CTL) + CW_QUEUE + 64 * ((l * NCHUNK + chunk) * 4 + q); }

__device__ __forceinline__ void phase_proj(Frame& F, int l, int chunk) {
    PHASE_IDS(F);
    { LAS float* gb = (LAS float*)(F.lds + L_GB); const float* bg = F.in[7] + (size_t)l * 3072;
      __syncthreads();
      for (int i = F.tid; i < 3072; i += NTHREADS) gb[i] = bg[i];
      VM_WAIT(); LDS_WAIT(); __syncthreads(); }
    pg8::DenseSched8 S{{(const bf16_t*)(F.ws + WS_XB8 + (size_t)chunk * TC * DM), (const bf16_t*)(F.ws + WS_WIN8), DM / 2, DM / 2, TC / 256, (PW + 3072) / 256, F.G, (int)blockIdx.x}, F8_SW, F8_SA_X};
    const float* rp = (const float*)(F.ws + WS_ROPE);
    EpiProj E{(bf16_t*)(F.ws + WS_PROJ), rp, rp + 2048 * 8 * 2, (float*)(F.ws + WS_SSQ), (bf16_t*)(F.ws + WS_G3), (const LAS float*)(F.lds + L_GB)};
    pg8::gemm_phase<EpiProj, pg8::DenseSched8, true, true>(F.lds, DM / 2, S, E);
}
__device__ __forceinline__ void dilated_unit(Frame& F, int u) {
    const bf16_t* PROJ = (const bf16_t*)(F.ws + WS_PROJ); bf16_t* OG = (bf16_t*)(F.ws + WS_OG); float* LSE = (float*)(F.ws + WS_LSE);
    constexpr int N_G0 = NBC * 4 * 8, N_G1 = NBC * 4 * 4 * 2;
    int g, b, h, res, qb, dil, nq;
    if (u < N_G0) { g = 0; dil = 1; qb = 7 - u / (NBC * 4); const int bh = u % (NBC * 4); b = bh >> 2; h = bh & 3; res = 0; nq = 256; }
    else if (u < N_G0 + N_G1) { const int v = u - N_G0; g = 1; dil = 4; qb = 1 - v / (NBC * 16); const int x = v % (NBC * 16); b = x >> 4; h = (x >> 2) & 3; res = x & 3; nq = 256; }
    else { const int v = u - N_G0 - N_G1; g = 2; dil = 16; qb = 0; b = v >> 6; h = (v >> 4) & 3; res = v & 15; nq = 128; }
    att::Desc d; const size_t r0 = (size_t)b * SEQ + res;
    const bf16_t* base = PROJ + r0 * PW + 512 + 768 * g + 64 * h;
    d.Q = base; d.K1 = base + 256; d.V = base + 512; d.K2 = nullptr; d.qpitch = d.k1pitch = d.vpitch = PW; d.k2pitch = 0;
    d.O = OG + ((size_t)g * TC + r0) * 256 + 64 * h; d.opitch = 256; d.lse = LSE + ((size_t)g * TC + r0) * 4 + h; d.lsepitch = 4; d.mask = nullptr;
    d.rstride = dil; d.q0 = qb * 256; d.nq = nq; d.o8 = 0;
    if (g == 2) { d.jlo = 0; d.jhi = 2; att::attn_unit<64, 0>(F.lds, d); }
    else { d.jlo = (qb * 4 - 2) > 0 ? (qb * 4 - 2) : 0; d.jhi = 4 * (qb + 1); att::attn_unit<64, 1>(F.lds, d); }
}

__device__ __forceinline__ void phase_up_scores(Frame& F, int l, int chunk) {
    PHASE_IDS(F);
    const bf16_t* PROJ = (const bf16_t*)(F.ws + WS_PROJ);
    const float* rp = (const float*)(F.ws + WS_ROPE);
    {   pg8::DenseSched S{PROJ, (const bf16_t*)(F.ws + WS_WUQ), PW, 256, TC / 256, 3, F.G, (int)blockIdx.x};
        EpiUpQ E{(bf16_t*)(F.ws + WS_QM), rp + 2048 * 8 * 2, (const float*)(F.ws + WS_SSQ)};
        pg8::gemm_phase<EpiUpQ, pg8::DenseSched, true>(F.lds, 256, S, E); }
    {   pg8::DenseSched S{PROJ + 256, (const bf16_t*)(F.ws + WS_WUKV), PW, 256, TC / 256, 4, F.G, (int)blockIdx.x};
        EpiUpKV E{(bf16_t*)(F.ws + WS_KVM), (const float*)(F.ws + WS_SSQ)};
        pg8::gemm_phase<EpiUpKV, pg8::DenseSched, true>(F.lds, 256, S, E); }
    unsigned* qw = queue_word(F, l, chunk, 0); int pre = -1;
    for (;;) {
        const int u = dequeue(F, qw, pre);
        if (u < NBC * 64) { dilated_unit(F, u); continue; }
        if (u >= NBC * 64 + NBC * 72 + NBC * 64) break;
        if (u >= NBC * 64 + NBC * 72) { dilated_unit(F, u - NBC * 72); continue; }
        const int v = u - NBC * 64; const int b = v / 72; int r = v % 72, qh = 0; while (r > (qh >> 1)) { r -= (qh >> 1) + 1; ++qh; }
        idx::score_unit(F.lds, PROJ, (float*)(F.ws + WS_SC), b, qh, r);
    }
}
__device__ __forceinline__ void phase_attn1(Frame& F, int l, int chunk, int tmask = 7) {
    PHASE_IDS(F);
    const bf16_t* PROJ = (const bf16_t*)(F.ws + WS_PROJ); const bf16_t* QM = (const bf16_t*)(F.ws + WS_QM); const bf16_t* KVM = (const bf16_t*)(F.ws + WS_KVM);
    bf16_t* OA = (bf16_t*)(F.ws + WS_OA); bf16_t* OG = (bf16_t*)(F.ws + WS_OG); float* LSE = (float*)(F.ws + WS_LSE);
    constexpr int N_MLA = NBC * 8 * 8, N_SEL = TC / 32;
    unsigned* qw = queue_word(F, l, chunk, 1); int pre = -1;
    for (;;) {
        int u = dequeue(F, qw, pre);
        if (u < N_MLA) {
            if (!(tmask & 1)) continue;
            const int qb = 7 - u / (NBC * 8), bh = u % (NBC * 8), b = bh >> 3, h = bh & 7;
            att::Desc d; const size_t r0 = (size_t)b * SEQ;
            d.Q = QM + r0 * 768 + h * 96; d.qpitch = 768; d.K1 = KVM + r0 * 1024 + h * 128; d.k1pitch = 1024; d.K2 = PROJ + r0 * PW + 384; d.k2pitch = PW;
            d.V = KVM + r0 * 1024 + h * 128 + 64; d.vpitch = 1024; d.O = (bf16_t*)((unsigned char*)OA + r0 * 512 + h * 64); d.opitch = 512; d.o8 = 1; d.lse = nullptr; d.lsepitch = 0; d.mask = nullptr;
            d.rstride = 1; d.q0 = qb * 256; d.nq = 256; d.jlo = 0; d.jhi = 4 * (qb + 1);
            att::attn_unit<96, 0>(F.lds, d); continue; }
        u -= N_MLA;
        if (u >= N_SEL) break;
        if (!(tmask & 4)) continue;
        idx::select_rows4((const float*)(F.ws + WS_SC), (unsigned*)(F.ws + WS_MASK), u * 32 + F.wave * 4, F.lane, (LAS unsigned*)(F.lds + L_GB) + F.wave * 64);
    }
}
__device__ __forceinline__ void phase_attn2(Frame& F, int l, int chunk) {
    PHASE_IDS(F);
    const bf16_t* PROJ = (const bf16_t*)(F.ws + WS_PROJ);
    bf16_t* OC = (bf16_t*)(F.ws + WS_OC);
    unsigned* qw = queue_word(F, l, chunk, 2); int pre = -1;
    for (;;) {
        const int u = dequeue(F, qw, pre);
        if (u >= NBC * 64) break;
        const int qb = 7 - u / (NBC * 8), bh = u % (NBC * 8), b = bh >> 3, h = bh & 7;
        att::Desc d; const size_t r0 = (size_t)b * SEQ;
        d.Q = PROJ + r0 * PW + 2816 + 64 * h; d.K1 = PROJ + r0 * PW + 3840; d.V = PROJ + r0 * PW + 3904; d.K2 = nullptr; d.qpitch = d.k1pitch = d.vpitch = PW; d.k2pitch = 0;
        d.O = (bf16_t*)((unsigned char*)OC + r0 * 512 + 64 * h); d.opitch = 512; d.o8 = 1; d.lse = nullptr; d.lsepitch = 0; d.mask = (const unsigned*)(F.ws + WS_MASK) + r0 * 64;
        d.rstride = 1; d.q0 = qb * 256; d.nq = 256; d.jlo = 0; d.jhi = 4 * (qb + 1);
        att::attn_unit<64, 2>(F.lds, d);
    }
    const bf16_t* OG = (const bf16_t*)(F.ws + WS_OG); const float* LSE = (const float*)(F.ws + WS_LSE); bf16_t* OB = (bf16_t*)(F.ws + WS_OB);
    const int gw = F.vcu * NWAVES + F.wave, NGW = F.G * NWAVES, h = F.lane >> 4;
    for (int row = gw; row < TC; row += NGW) {
        const float l0 = LSE[(size_t)row * 4 + h], l1 = LSE[((size_t)TC + row) * 4 + h], l2 = LSE[((size_t)2 * TC + row) * 4 + h];
        const float mx = fmaxf(l0, fmaxf(l1, l2));
        float w0 = __builtin_amdgcn_exp2f(l0 - mx), w1 = __builtin_amdgcn_exp2f(l1 - mx), w2 = __builtin_amdgcn_exp2f(l2 - mx);
        const float inv = 1.0f / (w0 + w1 + w2); w0 *= inv; w1 *= inv; w2 *= inv;
        const u32x2 a = *(const u32x2*)(OG + (size_t)row * 256 + F.lane * 4), bq = *(const u32x2*)(OG + ((size_t)TC + row) * 256 + F.lane * 4), c = *(const u32x2*)(OG + ((size_t)2 * TC + row) * 256 + F.lane * 4);
        w0 *= 32.f; w1 *= 32.f; w2 *= 32.f;
        *(unsigned*)((unsigned char*)OB + (size_t)row * 512 + F.lane * 4) = pk4_fp8(w0 * bflo(a.x) + w1 * bflo(bq.x) + w2 * bflo(c.x), w0 * bfhi(a.x) + w1 * bfhi(bq.x) + w2 * bfhi(c.x),
                                                                                    w0 * bflo(a.y) + w1 * bflo(bq.y) + w2 * bflo(c.y), w0 * bfhi(a.y) + w1 * bfhi(bq.y) + w2 * bfhi(c.y));
    }
}
__device__ __forceinline__ void phase_branches(Frame& F, int l, int chunk) {
    PHASE_IDS(F);
    static_assert(WS_OB - WS_OA == WS_OC - WS_OB && WS_WB - WS_WA == WS_WC - WS_WB, "equally spaced branch operands");
    BranchSched S{(const char*)(F.ws + WS_OA), (const char*)(F.ws + WS_WA), WS_OB - WS_OA, WS_WB - WS_WA, 256, 256, (int)blockIdx.x, F8_SW, 127 - 5, F.G, (TC / 256) * 4};
    EpiBranchAll E{(bf16_t*)(F.ws + WS_MERGED), (bf16_t*)(F.ws + WS_M0), (bf16_t*)(F.ws + WS_M1), (const bf16_t*)(F.ws + WS_G3)};
    pg8::gemm_phase<EpiBranchAll, BranchSched, true, true>(F.lds, 256, S, E);
}
__device__ __forceinline__ void phase_wo(Frame& F, int l, int chunk) {
    PHASE_IDS(F);
    pg8::DenseSched8 S{{(const bf16_t*)(F.ws + WS_MERGED), (const bf16_t*)(F.ws + WS_WO), DM / 2, DM / 2, TC / 256, 4, F.G, (int)blockIdx.x}, F8_SW, 127 - 6};
    EpiWo E{F.out, l == 0 ? F.in[0] : F.out, chunk * TC};
    pg8::gemm_phase<EpiWo, pg8::DenseSched8, true, true>(F.lds, DM / 2, S, E);
}

__global__ void __launch_bounds__(NTHREADS, 2) fwd_kernel(Args args) {
    extern __shared__ __attribute__((aligned(16))) unsigned char lds_raw[];
    Frame F;
    F.lds = (LAS unsigned char*)lds_raw;
    F.tid = threadIdx.x; F.lane = F.tid & 63; F.wave = __builtin_amdgcn_readfirstlane(F.tid >> 6);
    F.G = gridDim.x; { const int bx = blockIdx.x; F.vcu = (F.G % 8 == 0) ? (bx % 8) * (F.G / 8) + bx / 8 : bx; }
    F.in.p = (intab_t)__builtin_amdgcn_kernarg_segment_ptr(); F.out = args.out; F.ws = args.ws; F.out0 = args.out; F.ws0 = args.ws;
    for (int u = F.tid; u < (LDS_BYTES - L_CTL) / 4; u += NTHREADS) ((LAS unsigned*)(F.lds + L_CTL))[u] = 0u;
    __syncthreads();
    XcdBarrier bar = xcd_barrier_post((unsigned*)(F.ws + WS_CTL) + CW_BAR, (volatile LAS unsigned*)(F.lds + L_BARW));
#define GRID_BAR() xcd_barrier(bar)

    for (int l = 0; l < 2; ++l) {
        phase_conv_moe(F, l);
        phase_conv_mixer(F, l);
        GRID_BAR();
        for (int chunk = 0; chunk < NCHUNK; ++chunk) {
            phase_proj(F, l, chunk);
            GRID_BAR();
            if (DUPMASK & 2) { phase_proj(F, l, chunk); GRID_BAR(); }
            phase_up_scores(F, l, chunk);
            GRID_BAR();
            if (DUPMASK & 4) { phase_up_scores(F, l + 2, chunk); GRID_BAR(); }
            phase_attn1(F, l, chunk);
            GRID_BAR();
            if (DUPMASK & 8) { phase_attn1(F, l + 2, chunk); GRID_BAR(); }
            if (DUPMASK & 0x700) { phase_attn1(F, l + 2, chunk, (DUPMASK >> 8) & 7); GRID_BAR(); }
            phase_attn2(F, l, chunk);
            GRID_BAR();
            if (DUPMASK & 16) { phase_attn2(F, l + 2, chunk); GRID_BAR(); }
            phase_branches(F, l, chunk);
            GRID_BAR();
            if (DUPMASK & 32) { phase_branches(F, l, chunk); GRID_BAR(); }
            phase_wo(F, l, chunk);
            if ((DUPMASK & 0x800) && l == 0) { GRID_BAR(); phase_wo(F, l, chunk); }
        }
        GRID_BAR();
        phase_ln1_router(F, l, F.out, false);
        GRID_BAR();
        phase_moe_scatter(F);
        GRID_BAR();
        phase_moe_gemm1(F);
        GRID_BAR();
        if (DUPMASK & 64) { phase_moe_gemm1(F); GRID_BAR(); }
        phase_moe_gemm2(F);
        GRID_BAR();
        if (DUPMASK & 128) { phase_moe_gemm2(F); GRID_BAR(); }
        phase_combine_ln2(F, l);
        GRID_BAR();
    }
}

extern "C" void kernel_launch(void* const* d_in, const int* in_sizes, int n_in, void* d_out, int out_size, void* d_ws, size_t ws_size, hipStream_t stream) {
    static int grid = 0;
    if (grid == 0) {
        if (n_in != 23 || out_size != TT * DM || ws_size < WS_END) { fprintf(stderr, "kernel_launch: unexpected shapes n_in %d out %d ws %zu\n", n_in, out_size, ws_size); grid = -1; return; }
        int dev = 0, cus = 0;
        if (hipGetDevice(&dev) != hipSuccess || hipDeviceGetAttribute(&cus, hipDeviceAttributeMultiprocessorCount, dev) != hipSuccess) { grid = -1; return; }
        if (hipFuncSetAttribute((const void*)fwd_kernel, hipFuncAttributeMaxDynamicSharedMemorySize, LDS_BYTES) != hipSuccess) { fprintf(stderr, "kernel_launch: hipFuncSetAttribute failed\n"); grid = -1; return; }
        int per_cu = 0;
        if (hipOccupancyMaxActiveBlocksPerMultiprocessor(&per_cu, (const void*)fwd_kernel, NTHREADS, LDS_BYTES) != hipSuccess || per_cu < 1) fprintf(stderr, "kernel_launch: occupancy query says %d\n", per_cu);
        (void)hipGetLastError();
        grid = cus;
    }
    if (grid < 0) return;
    if (hipMemsetAsync((char*)d_ws + WS_CTL, 0, CTL_ZERO_BYTES, stream) != hipSuccess) return;
    Args a{};
    for (int i = 0; i < 23; ++i) a.in[i] = (const float*)d_in[i];
    a.out = (float*)d_out; a.ws = (unsigned char*)d_ws;
    hipLaunchKernelGGL(fwd_kernel, dim3(grid), dim3(NTHREADS), LDS_BYTES, stream, a);
}
```

```cpp
#include <hip/hip_runtime.h>
#include <cstdio>
#include <cstdint>

#define LAS __attribute__((address_space(3)))
#define GAS __attribute__((address_space(1)))
typedef unsigned short bf16_t;
typedef short bf16x8 __attribute__((ext_vector_type(8)));
typedef float f32x4 __attribute__((ext_vector_type(4)));
typedef float f32x2 __attribute__((ext_vector_type(2)));
typedef float f32x16 __attribute__((ext_vector_type(16)));
typedef unsigned u32x4 __attribute__((ext_vector_type(4)));
typedef unsigned u32x2 __attribute__((ext_vector_type(2)));

constexpr int DM = 1024, NB = 32, SEQ = 2048, TT = NB * SEQ;
constexpr int NEXP = 32, DEXP = 256;
constexpr float LN_EPS = 1e-6f;
constexpr float ALPHA = 1.41421356237309515f;
constexpr int NWAVES = 8, NTHREADS = 512;

__device__ __forceinline__ unsigned f2bf(float f) { unsigned u = __builtin_bit_cast(unsigned, f); return (u + 0x7fffu + ((u >> 16) & 1u)) >> 16; }
__device__ __forceinline__ unsigned pk2(float lo, float hi) { return f2bf(lo) | (f2bf(hi) << 16); }
__device__ __forceinline__ float bf2f(unsigned short b) { return __builtin_bit_cast(float, (unsigned)b << 16); }
__device__ __forceinline__ float bflo(unsigned w) { return __builtin_bit_cast(float, w << 16); }
__device__ __forceinline__ float bfhi(unsigned w) { return __builtin_bit_cast(float, w & 0xffff0000u); }
typedef __bf16 bf16x2_t __attribute__((ext_vector_type(2)));
__device__ __forceinline__ unsigned cvt_pk_bf16(float lo, float hi) { const f32x2 v = {lo, hi}; const bf16x2_t b = __builtin_convertvector(v, bf16x2_t); return __builtin_bit_cast(unsigned, b); }
__device__ __forceinline__ float wave_sum(float v) {
#pragma unroll
    for (int o = 1; o < 64; o <<= 1) v += __shfl_xor(v, o);
    return v;
}
__device__ __forceinline__ float fast_exp(float x) { return __builtin_amdgcn_exp2f(x * 1.4426950408889634f); }
__device__ __forceinline__ float sigmoidf_(float x) { return __builtin_amdgcn_rcpf(1.0f + fast_exp(-x)); }
__device__ __forceinline__ unsigned pk4_fp8(float a, float b, float c, float d) {
    int p = __builtin_amdgcn_cvt_pk_fp8_f32(a, b, 0, false); p = __builtin_amdgcn_cvt_pk_fp8_f32(c, d, p, true); return (unsigned)p; }
__device__ __forceinline__ void store8_fp8(unsigned char* p, const f32x4& v0, const f32x4& v1, float sc) {
    u32x2 w; w.x = pk4_fp8(v0[0] * sc, v0[1] * sc, v0[2] * sc, v0[3] * sc); w.y = pk4_fp8(v1[0] * sc, v1[1] * sc, v1[2] * sc, v1[3] * sc); *(u32x2*)p = w;
}
#define LDS_WAIT() asm volatile("s_waitcnt lgkmcnt(0)" ::: "memory")
#define VM_WAIT() asm volatile("s_waitcnt vmcnt(0)" ::: "memory")

namespace pg8 {
constexpr int BM = 256, BK = 64, HALF = 128, HTB = HALF * BK * 2, STAGE_BYTES = 8 * HTB;
__device__ __forceinline__ int lds_byte(int r, int c) { return r * 128 + ((((c >> 3) ^ (r >> 1)) & 7) * 16) + (c & 7) * 2; }
__device__ __forceinline__ void stage_rc(int b, int& R, int& C) { R = b >> 7; C = ((((b >> 4) ^ (R >> 1)) & 7)) * 8; }
__device__ __forceinline__ int perm32(int rho) { const int n = rho >> 4, i = rho & 15; return 8 * (i >> 2) + 4 * n + (i & 3); }
struct Unit { int pm, pn, ord; };

template <class S, class = void> struct SchedVarK { static constexpr bool value = false; };
template <class S> struct SchedVarK<S, decltype((void)S::VARK)> { static constexpr bool value = S::VARK; };
typedef int v4i_t __attribute__((ext_vector_type(4)));
typedef int v8i_t __attribute__((ext_vector_type(8)));
__device__ __forceinline__ v8i_t cat8(const bf16x8& lo, const bf16x8& hi) { return __builtin_shufflevector(__builtin_bit_cast(v4i_t, lo), __builtin_bit_cast(v4i_t, hi), 0, 1, 2, 3, 4, 5, 6, 7); }
template <class Epi, class Sched, bool ALIGN_EPI, bool F8 = false>
__device__ __forceinline__ void gemm_phase(LAS unsigned char* lds, const int K, const Sched& S, const Epi& E) {
    int tid_ = threadIdx.x; asm volatile("" : "+v"(tid_));
    const int tid = tid_, wid = __builtin_amdgcn_readfirstlane(tid >> 6), lane = tid & 63, wr = wid >> 2, wc = wid & 3, fr = lane & 15, fq = lane >> 4;
    int nt = K / BK;
    int Rr[2], Cc[2]; unsigned vB[2][2];
#pragma unroll
    for (int i = 0; i < 2; ++i) { stage_rc(tid * 16 + i * 8192, Rr[i], Cc[i]); const int Rb = (Rr[i] & ~31) + perm32(Rr[i] & 31);
        vB[0][i] = (unsigned)(Rb * S.ldb + Cc[i]) * 2u; vB[1][i] = (unsigned)((HALF + Rb) * S.ldb + Cc[i]) * 2u; }
    const size_t kstep = (size_t)(BK * 2);
    const unsigned ldsw = (unsigned)wid * 1024u;
    const int aoff = lds_byte(wr * 64 + fr, fq * 8), boff = lds_byte(wc * 32 + fr, fq * 8);
    const int aoff1 = lds_byte(wr * 64 + fr, fq * 8 + 32), boff1 = lds_byte(wc * 32 + fr, fq * 8 + 32);
#define PG8_SA(b, h) (((b) * 2 + (h)) * HTB)
#define PG8_SB(b, h) ((4 + (b) * 2 + (h)) * HTB)
#define PG8_STAGE(bufoff, gbase, voff) do { _Pragma("unroll") for (int _i = 0; _i < 2; ++_i) \
        __builtin_amdgcn_global_load_lds((const unsigned*)((const char*)(gbase) + (voff)[_i]), (LAS unsigned*)(lds + (bufoff) + ldsw + _i * 8192), 16, 0, 0); } while (0)
#define PG8_LDA(dst, b, h) do { _Pragma("unroll") for (int m = 0; m < 4; ++m) { \
        const bf16x8 f0_ = *(const LAS bf16x8*)(lds + PG8_SA(b, h) + aoff + m * 2048), f1_ = *(const LAS bf16x8*)(lds + PG8_SA(b, h) + aoff1 + m * 2048); \
        if constexpr (F8) dst##8[m] = cat8(f0_, f1_); else { dst[m][0] = f0_; dst[m][1] = f1_; } } } while (0)
#define PG8_LDB(dst, b, h) do { _Pragma("unroll") for (int n = 0; n < 2; ++n) { \
        const bf16x8 f0_ = *(const LAS bf16x8*)(lds + PG8_SB(b, h) + boff + n * 2048), f1_ = *(const LAS bf16x8*)(lds + PG8_SB(b, h) + boff1 + n * 2048); \
        if constexpr (F8) dst##8[n] = cat8(f0_, f1_); else { dst[n][0] = f0_; dst[n][1] = f1_; } } } while (0)
#define PG8_MMA(ai, bj, At, Bt) do { __builtin_amdgcn_s_setprio(1); \
        if constexpr (F8) { _Pragma("unroll") for (int m = 0; m < 4; ++m) _Pragma("unroll") for (int n = 0; n < 2; ++n) \
            asm volatile("v_mfma_scale_f32_16x16x128_f8f6f4 %0, %1, %2, %0, %3, %4 op_sel_hi:[0,0,0]" : "+v"(acc[ai][bj][m][n]) : "v"(Bt##8[n]), "v"(At##8[m]), "v"(scw8), "v"(sca8)); } \
              \
        else { _Pragma("unroll") for (int m = 0; m < 4; ++m) _Pragma("unroll") for (int n = 0; n < 2; ++n) _Pragma("unroll") for (int k = 0; k < 2; ++k) \
            acc[ai][bj][m][n] = __builtin_amdgcn_mfma_f32_16x16x32_bf16(Bt[n][k], At[m][k], acc[ai][bj][m][n], 0, 0, 0); } \
        __builtin_amdgcn_s_setprio(0); } while (0)
#define PG8_WAIT_V(n) asm volatile("s_waitcnt vmcnt(" #n ")" ::: "memory")
#define PG8_WAIT_L(n) asm volatile("s_waitcnt lgkmcnt(" #n ")" ::: "memory")
#define PG8_BAR __builtin_amdgcn_s_barrier()
#define PG8_SCHED __builtin_amdgcn_sched_barrier(0)
    int scw8 = 0, sca8 = 0;
    if constexpr (F8) { scw8 = S.sw8 * 0x01010101; sca8 = S.sa8 * 0x01010101; }
    Unit cur, nxt; int ui = 0;
    if (!S.next(0, cur)) return;
    f32x4 acc[2][2][4][2];
#pragma unroll
    for (int a = 0; a < 2; ++a)
#pragma unroll
        for (int b = 0; b < 2; ++b)
#pragma unroll
            for (int m = 0; m < 4; ++m)
#pragma unroll
                for (int n = 0; n < 2; ++n) acc[a][b][m][n] = (f32x4){0.f, 0.f, 0.f, 0.f};
    bf16x8 At[4][2], B0[2][2], B1[2][2]; v8i_t At8[4], B08[2], B18[2];
    unsigned vAc[2][2], vAn[2][2];
    const char* cA = S.a_base(cur); const char* cB = S.b_base(cur);
    S.a_off(cur, Rr, Cc, vAc);
    if constexpr (SchedVarK<Sched>::value) nt = S.ktiles(cur);
    PG8_STAGE(PG8_SB(0, 0), cB, vB[0]); PG8_STAGE(PG8_SB(0, 1), cB, vB[1]); PG8_STAGE(PG8_SA(0, 0), cA, vAc[0]); PG8_STAGE(PG8_SA(0, 1), cA, vAc[1]);
    if (wr == 1) PG8_BAR;
    PG8_WAIT_V(2); PG8_BAR;
    PG8_STAGE(PG8_SB(1, 0), cB + kstep, vB[0]); PG8_STAGE(PG8_SA(1, 0), cA + kstep, vAc[0]); PG8_STAGE(PG8_SB(1, 1), cB + kstep, vB[1]);
    PG8_WAIT_V(6); PG8_BAR;
    bool epi_pend = false;
    for (;;) {
        const bool has_next = S.next(ui + 1, nxt);
        const char* nA = cA; const char* nB = cB;
        if constexpr (Sched::GATHER) {
#pragma unroll
            for (int h = 0; h < 2; ++h)
#pragma unroll
                for (int i = 0; i < 2; ++i) vAn[h][i] = vAc[h][i];
        }
        if (has_next) { nA = S.a_base(nxt); nB = S.b_base(nxt); if constexpr (Sched::GATHER) S.a_off(nxt, Rr, Cc, vAn); }
#pragma nounroll
        for (int t = 0; t < nt; t += 2) {
            const bool last = (t == nt - 2);
            const bool ep_ = epi_pend && t == 0;
            const char* a1 = cA + (size_t)(t + 1) * kstep;
            const char* a2 = last ? nA : cA + (size_t)(t + 2) * kstep; const char* b2 = last ? nB : cB + (size_t)(t + 2) * kstep;
            const char* a3 = a2 + kstep; const char* b3 = b2 + kstep;
            unsigned vA2[2][2];
#pragma unroll
            for (int h = 0; h < 2; ++h)
#pragma unroll
                for (int i = 0; i < 2; ++i) { if constexpr (Sched::GATHER) vA2[h][i] = last ? vAn[h][i] : vAc[h][i]; else vA2[h][i] = vAc[h][i]; }
            PG8_LDB(B0, 0, 0); PG8_LDB(B1, 0, 1); PG8_SCHED; PG8_LDA(At, 0, 0); PG8_STAGE(PG8_SA(1, 1), a1, vAc[1]);
            if (ep_) { PG8_WAIT_V(24); } else { PG8_WAIT_V(8); } PG8_WAIT_L(0); PG8_BAR; PG8_MMA(0, 0, At, B0); PG8_MMA(0, 1, At, B1); PG8_BAR; PG8_SCHED;
            PG8_LDA(At, 0, 1); PG8_STAGE(PG8_SB(0, 0), b2, vB[0]); PG8_STAGE(PG8_SB(0, 1), b2, vB[1]); PG8_STAGE(PG8_SA(0, 0), a2, vA2[0]);
            if (ep_) { PG8_WAIT_V(24); } else { PG8_WAIT_V(8); } PG8_WAIT_L(0); PG8_BAR; PG8_MMA(1, 0, At, B0); PG8_MMA(1, 1, At, B1); PG8_BAR; PG8_SCHED;
            PG8_LDB(B0, 1, 0); PG8_LDB(B1, 1, 1); PG8_SCHED; PG8_LDA(At, 1, 0); PG8_STAGE(PG8_SA(0, 1), a2, vA2[1]);
            PG8_WAIT_V(8); PG8_WAIT_L(0); PG8_BAR; PG8_MMA(0, 0, At, B0); PG8_MMA(0, 1, At, B1); PG8_BAR; PG8_SCHED;
            PG8_LDA(At, 1, 1); PG8_STAGE(PG8_SB(1, 0), b3, vB[0]); PG8_STAGE(PG8_SB(1, 1), b3, vB[1]); PG8_STAGE(PG8_SA(1, 0), a3, vA2[0]);
            PG8_WAIT_V(8); PG8_WAIT_L(0); PG8_BAR; PG8_MMA(1, 0, At, B0); PG8_MMA(1, 1, At, B1); PG8_BAR; PG8_SCHED;
        }
        if constexpr (ALIGN_EPI) { if (wr == 0) PG8_BAR; }
        if constexpr (F8) asm volatile("s_nop 15\n\ts_nop 15" ::: "memory");
        { int l2_ = lane; asm volatile("" : "+v"(l2_)); E(acc, cur, wr, wc, l2_ & 15, l2_ >> 4); }
        if (!has_next) break;
        epi_pend = true;
#pragma unroll
        for (int a = 0; a < 2; ++a)
#pragma unroll
            for (int b = 0; b < 2; ++b)
#pragma unroll
                for (int m = 0; m < 4; ++m)
#pragma unroll
                    for (int n = 0; n < 2; ++n) acc[a][b][m][n] = (f32x4){0.f, 0.f, 0.f, 0.f};
        cur = nxt; cA = nA; cB = nB; ++ui;
        if constexpr (SchedVarK<Sched>::value) nt = S.ktiles(cur);
        if constexpr (Sched::GATHER) {
#pragma unroll
            for (int h = 0; h < 2; ++h)
#pragma unroll
                for (int i = 0; i < 2; ++i) vAc[h][i] = vAn[h][i];
        }
        if constexpr (ALIGN_EPI) { if (wr == 1) PG8_BAR; }
    }
    PG8_WAIT_V(0);
    if constexpr (!ALIGN_EPI) { if (wr == 0) PG8_BAR; }
    asm volatile("s_waitcnt vmcnt(0) lgkmcnt(0)\n\ts_barrier" ::: "memory");
    __builtin_amdgcn_sched_barrier(0);
#undef PG8_SA
#undef PG8_SB
#undef PG8_STAGE
#undef PG8_LDA
#undef PG8_LDB
#undef PG8_MMA
#undef PG8_WAIT_V
#undef PG8_WAIT_L
#undef PG8_BAR
#undef PG8_SCHED
}

struct DenseSched {
    static constexpr bool GATHER = false;
    const bf16_t* A; const bf16_t* Bt; int lda, ldb, nM, nN, G, c;
    __device__ __forceinline__ bool next(int i, Unit& u) const { const int v = i * G + c; if (v >= nM * nN) return false; u.pm = v / nN; u.pn = v % nN; u.ord = i; return true; }
    __device__ __forceinline__ const char* a_base(const Unit& u) const { return (const char*)(A + (size_t)u.pm * BM * lda); }
    __device__ __forceinline__ const char* b_base(const Unit& u) const { return (const char*)(Bt + (size_t)u.pn * BM * ldb); }
    __device__ __forceinline__ void a_off(const Unit&, const int (&R)[2], const int (&C)[2], unsigned (&v)[2][2]) const {
#pragma unroll
        for (int i = 0; i < 2; ++i) { v[0][i] = (unsigned)(R[i] * lda + C[i]) * 2u; v[1][i] = (unsigned)((HALF + R[i]) * lda + C[i]) * 2u; }
    }
};
struct DenseSched8 : DenseSched { int sw8, sa8; };
struct ProjSched8 : DenseSched8 {
    __device__ __forceinline__ bool next(int i, Unit& u) const {
        if (nN != 28 || (nM & 1) || (G & 7)) return DenseSched::next(i, u);
        const int x = c & 7, wl = i * (G >> 3) + (c >> 3), half = nM >> 1;
        if (wl >= half * 7) return false;
        u.pm = (x >> 2) * half + wl / 7; u.pn = 7 * (x & 3) + wl % 7; u.ord = i; return true;
    }
};
}

#define XB_TMO      128
#define XB_XCNT(j)  (256  + 64 * (j))
#define XB_XSUB(j)  (1280 + 64 * (j))
#define XB_XGEN(j)  (2304 + 64 * (j))
#define XB_TOP      3328
#define XB_TOPGEN   3392
#define XCD_BAR_WORDS 3456
#define XB_SPIN_CAP (1u << 18)
__device__ __forceinline__ unsigned xb_ld(unsigned* p)              { return __hip_atomic_load(p, __ATOMIC_RELAXED, __HIP_MEMORY_SCOPE_AGENT); }
__device__ __forceinline__ unsigned xb_add(unsigned* p, unsigned v) { return __hip_atomic_fetch_add(p, v, __ATOMIC_RELAXED, __HIP_MEMORY_SCOPE_AGENT); }
__device__ __forceinline__ unsigned xb_xcc_id() { return (unsigned)__builtin_amdgcn_s_getreg((3 << 11) | 20) & 0xFu; }
#define XB_SPIN(cond, bar) do { unsigned _sp = 0; while (cond) { __builtin_amdgcn_s_sleep(1); \
    if ((++_sp & 255u) == 0u) { if (xb_ld(&(bar)[XB_TMO])) break; if (_sp > XB_SPIN_CAP) { atomicAdd(&(bar)[XB_TMO], 1u); break; } } } } while (0)
struct XcdBarrier { unsigned* bar; unsigned x; volatile LAS unsigned* st; };
__device__ __forceinline__ XcdBarrier xcd_barrier_post(unsigned* bar, volatile LAS unsigned* st) {
    XcdBarrier b; b.bar = bar; b.x = xb_xcc_id(); b.st = st;
    if (threadIdx.x == 0) (void)xb_add(&bar[XB_XCNT(b.x)], 1u);
    return b;
}
__device__ __forceinline__ void xcd_barrier_complete(unsigned* bar, unsigned x, unsigned& nloc, unsigned& nx) {
    const unsigned G = gridDim.x * gridDim.y * gridDim.z;
    unsigned sum, cnt, mine, sp = 0u;
    for (;;) {
        sum = 0u; cnt = 0u; mine = 0u;
#pragma unroll
        for (unsigned j = 0; j < 16; ++j) { const unsigned c = xb_ld(&bar[XB_XCNT(j)]); sum += c; cnt += (c > 0u) ? 1u : 0u; mine = (j == x) ? c : mine; }
        if (sum == G) break;
        __builtin_amdgcn_s_sleep(1);
        if ((++sp & 255u) == 0u) { if (xb_ld(&bar[XB_TMO])) break; if (sp > XB_SPIN_CAP) { atomicAdd(&bar[XB_TMO], 1u); break; } }
    }
    nloc = mine > 0u ? mine : 1u; nx = cnt > 0u ? cnt : 1u;
}
__device__ __forceinline__ void xcd_barrier(const XcdBarrier& b) {
    asm volatile("s_waitcnt vmcnt(0)" ::: "memory");
    __syncthreads();
    if (threadIdx.x == 0) {
        unsigned* bar = b.bar;
        __builtin_amdgcn_s_waitcnt(0);
        unsigned nloc = b.st[0], nx = b.st[1];
        if (nloc == 0u) { xcd_barrier_complete(bar, b.x, nloc, nx); b.st[0] = nloc; b.st[1] = nx; }
        const unsigned old = xb_add(&bar[XB_XSUB(b.x)], 1u);
        const unsigned gen = old / nloc;
        if (old + 1u == (gen + 1u) * nloc) {
            __builtin_amdgcn_fence(__ATOMIC_RELEASE, "agent");
            asm volatile("s_waitcnt vmcnt(0)" ::: "memory");
            const unsigned og = xb_add(&bar[XB_TOP], 1u);
            const unsigned tg = og / nx;
            if (og + 1u == (tg + 1u) * nx) xb_add(&bar[XB_TOPGEN], 1u);
            else XB_SPIN(xb_ld(&bar[XB_TOPGEN]) == tg, bar);
            __builtin_amdgcn_fence(__ATOMIC_ACQUIRE, "agent");
            xb_add(&bar[XB_XGEN(b.x)], 1u);
            asm volatile("s_waitcnt vmcnt(0)" ::: "memory");
        } else {
            XB_SPIN(xb_ld(&bar[XB_XGEN(b.x)]) == gen, bar);
            __builtin_amdgcn_fence(__ATOMIC_ACQUIRE, "agent");
            asm volatile("s_waitcnt vmcnt(0)" ::: "memory");
        }
    }
    __syncthreads();
}

constexpr size_t MiB = 1u << 20;
constexpr size_t WS_CTL = 0, CTL_ZERO_BYTES = 1 * MiB;
constexpr int CW_BAR = 4096;
constexpr int CW_QUEUE = 16384;
constexpr size_t WS_W13 = 2 * MiB;
constexpr size_t WS_W2  = 34 * MiB;
constexpr size_t WS_WR  = 50 * MiB;
constexpr size_t WS_MISC = 51 * MiB;
constexpr size_t WS_ROUTE = 52 * MiB;
constexpr size_t WS_RPOS = 53 * MiB;
constexpr size_t WS_ROWTOK = 54 * MiB;
constexpr size_t WS_ROPE = 55 * MiB;
constexpr size_t WS_WUQ = 56 * MiB;
constexpr size_t WS_WUKV = 57 * MiB;
constexpr size_t WS_WA = 58 * MiB;
constexpr size_t WS_WB = 59 * MiB;
constexpr size_t WS_WC = 60 * MiB;
constexpr size_t WS_WO = 61 * MiB;
constexpr size_t WS_SSQ = 63 * MiB;
constexpr size_t WS_LSE = 64 * MiB;
constexpr size_t WS_MASK = 66 * MiB;
constexpr size_t WS_XB8 = 74 * MiB;
constexpr size_t WS_WIN8 = 138 * MiB;
constexpr size_t WS_H = 146 * MiB;
constexpr size_t WS_Y = 182 * MiB;
constexpr size_t WS_SC = WS_Y;
constexpr size_t WS_G3 = 254 * MiB;
constexpr size_t WS_PROJ = 350 * MiB;
constexpr size_t WS_QM = 606 * MiB;
constexpr size_t WS_KVM = 654 * MiB;
constexpr size_t WS_OA = 718 * MiB;
constexpr size_t WS_OB = 734 * MiB;
constexpr size_t WS_OC = 750 * MiB;
constexpr size_t WS_OG = 766 * MiB;
constexpr size_t WS_M0 = 814 * MiB;
constexpr size_t WS_M1 = 846 * MiB;
constexpr size_t WS_MERGED = 878 * MiB;
constexpr size_t WS_END = 910 * MiB;
constexpr int F8_SA_X = 127 - 4, F8_SW = 127 - 10;
constexpr int MAXROWS = 139264;
constexpr int NBC = 16, TC = NBC * SEQ, NCHUNK = NB / NBC;
constexpr int CIN = 3944, PW = 4096;

constexpr int MI_BLOCKCNT = 0;
constexpr int MI_PANEL_E = 8192;
constexpr int MI_NPAN = 8192 + 1024;

constexpr int RING_BYTES = 131072;
constexpr int L_CTL = RING_BYTES;
constexpr int L_BARW = L_CTL + 32;
constexpr int L_HIST = L_CTL + 256;
constexpr int L_TOT  = L_CTL + 384;
constexpr int L_PRE  = L_CTL + 512;
constexpr int L_BASE = L_CTL + 640;
constexpr int L_RANK = L_CTL + 896;
constexpr int L_PE   = L_CTL + 1024;
constexpr int L_ROWS = L_CTL + 2048;
constexpr int LDS_BYTES = 147456;
constexpr int L_GB = L_ROWS;
static_assert(L_ROWS + 12288 <= LDS_BYTES, "LDS map");

#ifndef DUPMASK
#define DUPMASK 0
#endif
struct Args { const float* in[23]; float* out; unsigned char* ws; };
#define PHASE_IDS(F) do { int t_ = threadIdx.x; asm volatile("" : "+v"(t_)); (F).tid = t_; (F).lane = t_ & 63; { intab_t p_ = (intab_t)__builtin_amdgcn_kernarg_segment_ptr(); asm volatile("" : "+s"(p_)); (F).in.p = p_; } \
    { unsigned char GAS* w_ = (unsigned char GAS*)(F).ws0; asm volatile("" : "+s"(w_)); (F).ws = (unsigned char*)w_; float GAS* o_ = (float GAS*)(F).out0; asm volatile("" : "+s"(o_)); (F).out = (float*)o_; } } while (0)

typedef const float GAS* gfptr_t;
typedef const gfptr_t __attribute__((address_space(4)))* intab_t;
struct InTab { intab_t p; __device__ __forceinline__ const float* operator[](int i) const { return (const float*)p[i]; } };
struct Frame {
    LAS unsigned char* lds;
    int tid, lane, wave, vcu, G;
    InTab in; float* out; unsigned char* ws; float* out0; unsigned char* ws0;
};

template <class F>
__device__ __forceinline__ void conv_item(bf16_t* WT, int ldk, int k0, int n0, LAS float* scr, int lane, F val) {
#pragma unroll 8
    for (int i = 0; i < 32; ++i) { const int kk = 2 * i + (lane >> 5); scr[kk * 33 + (lane & 31)] = val(k0 + kk, n0 + (lane & 31)); }
    LDS_WAIT(); asm volatile("" ::: "memory");
    const int c = lane & 7;
#pragma unroll
    for (int j = 0; j < 4; ++j) { const int n = (lane >> 3) + 8 * j; const LAS float* s = scr + (8 * c) * 33 + n;
        u32x4 o; o.x = pk2(s[0 * 33], s[1 * 33]); o.y = pk2(s[2 * 33], s[3 * 33]); o.z = pk2(s[4 * 33], s[5 * 33]); o.w = pk2(s[6 * 33], s[7 * 33]);
        *(u32x4*)(WT + (size_t)(n0 + n) * ldk + k0 + 8 * c) = o; }
    LDS_WAIT(); asm volatile("" ::: "memory");
}

template <class F>
__device__ __forceinline__ void conv_item8(unsigned char* WT, int ldk, int k0, int n0, LAS float* scr, int lane, F val) {
#pragma unroll 8
    for (int i = 0; i < 32; ++i) { const int kk = 2 * i + (lane >> 5); scr[kk * 33 + (lane & 31)] = val(k0 + kk, n0 + (lane & 31)); }
    LDS_WAIT(); asm volatile("" ::: "memory");
    const int c = lane & 7;
#pragma unroll
    for (int j = 0; j < 4; ++j) { const int n = (lane >> 3) + 8 * j; const LAS float* s = scr + (8 * c) * 33 + n;
        u32x2 o; o.x = pk4_fp8(s[0 * 33], s[1 * 33], s[2 * 33], s[3 * 33]); o.y = pk4_fp8(s[4 * 33], s[5 * 33], s[6 * 33], s[7 * 33]);
        *(u32x2*)(WT + (size_t)(n0 + n) * ldk + k0 + 8 * c) = o; }
    LDS_WAIT(); asm volatile("" ::: "memory");
}

__device__ __forceinline__ void conv_plain8(unsigned char* WT, int ldk, int k0, int n0, LAS float* scr, int lane, const float* src, int pitch, float sc) {
    f32x4 v[8];
#pragma unroll
    for (int i = 0; i < 8; ++i) v[i] = *(const f32x4*)(src + (size_t)(k0 + (lane >> 3) + 8 * i) * pitch + n0 + (lane & 7) * 4);
#pragma unroll
    for (int i = 0; i < 8; ++i) { LAS float* d = scr + ((lane >> 3) + 8 * i) * 33 + (lane & 7) * 4; d[0] = v[i][0] * sc; d[1] = v[i][1] * sc; d[2] = v[i][2] * sc; d[3] = v[i][3] * sc; }
    LDS_WAIT(); asm volatile("" ::: "memory");
    const int c = lane & 7;
#pragma unroll
    for (int j = 0; j < 4; ++j) { const int n = (lane >> 3) + 8 * j; const LAS float* s = scr + (8 * c) * 33 + n;
        u32x2 o; o.x = pk4_fp8(s[0 * 33], s[1 * 33], s[2 * 33], s[3 * 33]); o.y = pk4_fp8(s[4 * 33], s[5 * 33], s[6 * 33], s[7 * 33]);
        *(u32x2*)(WT + (size_t)(n0 + n) * ldk + k0 + 8 * c) = o; }
    LDS_WAIT(); asm volatile("" ::: "memory");
}
__device__ __forceinline__ void conv_pair8(unsigned char* WT, int ldk, int k0, int n0, LAS float* scr, int lane, const float* a, const float* b, int pitch, float sc) {
    f32x2 va[8], vb[8];
#pragma unroll
    for (int i = 0; i < 8; ++i) { const size_t o = (size_t)(k0 + (lane >> 3) + 8 * i) * pitch + (n0 >> 1) + (lane & 7) * 2; va[i] = *(const f32x2*)(a + o); vb[i] = *(const f32x2*)(b + o); }
#pragma unroll
    for (int i = 0; i < 8; ++i) { LAS float* d = scr + ((lane >> 3) + 8 * i) * 33 + (lane & 7) * 4; d[0] = va[i][0] * sc; d[1] = vb[i][0] * sc; d[2] = va[i][1] * sc; d[3] = vb[i][1] * sc; }
    LDS_WAIT(); asm volatile("" ::: "memory");
    const int c = lane & 7;
#pragma unroll
    for (int j = 0; j < 4; ++j) { const int n = (lane >> 3) + 8 * j; const LAS float* s = scr + (8 * c) * 33 + n;
        u32x2 o; o.x = pk4_fp8(s[0 * 33], s[1 * 33], s[2 * 33], s[3 * 33]); o.y = pk4_fp8(s[4 * 33], s[5 * 33], s[6 * 33], s[7 * 33]);
        *(u32x2*)(WT + (size_t)(n0 + n) * ldk + k0 + 8 * c) = o; }
    LDS_WAIT(); asm volatile("" ::: "memory");
}

__device__ __forceinline__ void phase_conv_moe(Frame& F, int l) {
    PHASE_IDS(F);
    LAS float* scr = (LAS float*)(F.lds + F.wave * 16384);
    const int gw = F.vcu * NWAVES + F.wave, NGW = F.G * NWAVES;
    const float* w1 = F.in[18] + (size_t)l * NEXP * DM * DEXP;
    const float* w3 = F.in[19] + (size_t)l * NEXP * DM * DEXP;
    const float* w2 = F.in[20] + (size_t)l * NEXP * DEXP * DM;
    bf16_t* W13 = (bf16_t*)(F.ws + WS_W13); bf16_t* W2 = (bf16_t*)(F.ws + WS_W2);
    constexpr int I13 = (DM / 64) * (512 / 32);
    constexpr int I2 = (DEXP / 64) * (DM / 32);
    for (int it = gw; it < NEXP * (I13 + I2); it += NGW) {
        if (it < NEXP * I13) {
            const int e = it / I13, r = it % I13, kb = r / 16, nb = r % 16;
            const float* a = w1 + (size_t)e * DM * DEXP; const float* b = w3 + (size_t)e * DM * DEXP;
            conv_pair8((unsigned char*)W13 + (size_t)e * 512 * DM, DM, kb * 64, nb * 32, scr, F.lane, a, b, DEXP, 1024.f);
        } else {
            const int it2 = it - NEXP * I13; const int e = it2 / I2, r = it2 % I2, kb = r / 32, nb = r % 32;
            const float* a = w2 + (size_t)e * DEXP * DM;
            conv_plain8((unsigned char*)W2 + (size_t)e * DM * DEXP, DEXP, kb * 64, nb * 32, scr, F.lane, a, DM, 1024.f);
        }
    }
    const float* wg = F.in[14] + (size_t)l * DM * 4; const float* wsb = F.in[16] + (size_t)l * DM * NEXP;
    const float* g1 = F.in[12] + (size_t)l * DM; const float* b1 = F.in[13] + (size_t)l * DM;
    bf16_t* WRH = (bf16_t*)(F.ws + WS_WR); bf16_t* WRL = (bf16_t*)(F.ws + WS_WR + 128 * 1024); float* WRC = (float*)(F.ws + WS_WR + 256 * 1024);
    for (int idx = (F.vcu * NTHREADS + F.tid); idx < 64 * DM; idx += F.G * NTHREADS) {
        const int c = idx / DM, k = idx % DM;
        const float v = (c < 32 ? wsb[(size_t)k * NEXP + c] : (c < 36 ? wg[(size_t)k * 4 + (c - 32)] : 0.f)) * g1[k];
        const unsigned h = f2bf(v); const int it = k >> 5, hi_ = (k >> 4) & 1, st = (k >> 3) & 1, e = k & 7, ln = (c & 31) + 32 * hi_, p0 = 2 * (c >> 5);
        WRH[((((size_t)it * 4 + p0) * 2 + st) * 64 + ln) * 8 + e] = (bf16_t)h;
        WRH[((((size_t)it * 4 + p0 + 1) * 2 + st) * 64 + ln) * 8 + e] = (bf16_t)f2bf(v - __builtin_bit_cast(float, h << 16)); (void)WRL;
    }
    if (gw < 64) {
        const int c = gw; float s1 = 0.f, s2 = 0.f;
        for (int k = F.lane; k < DM; k += 64) { const float w = c < 32 ? wsb[(size_t)k * NEXP + c] : (c < 36 ? wg[(size_t)k * 4 + (c - 32)] : 0.f); s1 += g1[k] * w; s2 += b1[k] * w; }
        s1 = wave_sum(s1); s2 = wave_sum(s2);
        const float bias = c < 32 ? F.in[17][(size_t)l * NEXP + c] : (c < 36 ? F.in[15][(size_t)l * 4 + (c - 32)] : 0.f);
        if (F.lane == 0) { WRC[c] = s1; WRC[64 + c] = s2 + bias; }
    }
}

__device__ __forceinline__ void ln_row(f32x4 (&v)[4], const f32x4 (&g)[4], const f32x4 (&b)[4], float* omean = nullptr, float* orstd = nullptr) {
    float s = 0.f;
#pragma unroll
    for (int j = 0; j < 4; ++j) s += (v[j].x + v[j].y) + (v[j].z + v[j].w);
    const float mean = wave_sum(s) * (1.f / DM); float s2 = 0.f;
#pragma unroll
    for (int j = 0; j < 4; ++j) { v[j] = v[j] - mean; s2 += (v[j].x * v[j].x + v[j].y * v[j].y) + (v[j].z * v[j].z + v[j].w * v[j].w); }
    const float rstd = 1.0f / sqrtf(wave_sum(s2) * (1.f / DM) + LN_EPS);
#pragma unroll
    for (int j = 0; j < 4; ++j) v[j] = v[j] * rstd * g[j] + b[j];
    if (omean) { *omean = mean; *orstd = rstd; }
}
__device__ __forceinline__ void store_row(const f32x4 (&v)[4], float* orow, unsigned char* brow, int lane) {
#pragma unroll
    for (int j = 0; j < 4; ++j) {
        ((f32x4*)orow)[lane + 64 * j] = v[j];
        ((unsigned*)brow)[lane + 64 * j] = pk4_fp8(v[j].x * 16.f, v[j].y * 16.f, v[j].z * 16.f, v[j].w * 16.f);
    }
}

__device__ __forceinline__ void phase_ln1_router(Frame& F, int l, const float* src, bool scale_alpha) {
    PHASE_IDS(F);
    const int lane = F.lane, hi = lane >> 5, r32 = lane & 31;
    const float* lg = F.in[12] + (size_t)l * DM; const float* lb = F.in[13] + (size_t)l * DM;
    f32x4 g[4], b[4];
#pragma unroll
    for (int j = 0; j < 4; ++j) { g[j] = ((const f32x4*)lg)[lane + 64 * j]; b[j] = ((const f32x4*)lb)[lane + 64 * j]; }
    unsigned char* XB = F.ws + WS_XB8;
    const bf16_t* WRH = (const bf16_t*)(F.ws + WS_WR); const bf16_t* WRL = (const bf16_t*)(F.ws + WS_WR + 128 * 1024);
    const float* WRC = (const float*)(F.ws + WS_WR + 256 * 1024); float* stats = (float*)(F.ws + WS_WR + 512 * 1024);
    unsigned* misc = (unsigned*)(F.ws + WS_MISC);
    int* route = (int*)(F.ws + WS_ROUTE);
    LAS unsigned* hist = (LAS unsigned*)(F.lds + L_HIST);
    const float sc = scale_alpha ? ALPHA : 1.0f;
    for (int blk = F.vcu; blk < TT / 256; blk += F.G) {
        if (F.tid < 32) hist[F.tid] = 0u;
        __syncthreads();
        const int row0 = blk * 256 + F.wave * 32;
        float mu_l = 0.f, rs_l = 1.f;
        for (int i = 0; i < 32; i += 2) {
            f32x4 v0[4], v1[4];
            const f32x4* p0 = (const f32x4*)(src + (size_t)(row0 + i) * DM); const f32x4* p1 = (const f32x4*)(src + (size_t)(row0 + i + 1) * DM);
#pragma unroll
            for (int j = 0; j < 4; ++j) { v0[j] = p0[lane + 64 * j] * sc; v1[j] = p1[lane + 64 * j] * sc; }
            float m0, r0, m1, r1;
            ln_row(v0, g, b, &m0, &r0); ln_row(v1, g, b, &m1, &r1);
            mu_l = (r32 == i) ? m0 : ((r32 == i + 1) ? m1 : mu_l); rs_l = (r32 == i) ? r0 : ((r32 == i + 1) ? r1 : rs_l);
#pragma unroll
            for (int j = 0; j < 4; ++j) {
                ((unsigned*)(XB + (size_t)(row0 + i) * DM))[lane + 64 * j] = pk4_fp8(v0[j].x * 16.f, v0[j].y * 16.f, v0[j].z * 16.f, v0[j].w * 16.f);
                ((unsigned*)(XB + (size_t)(row0 + i + 1) * DM))[lane + 64 * j] = pk4_fp8(v1[j].x * 16.f, v1[j].y * 16.f, v1[j].z * 16.f, v1[j].w * 16.f); }
        }
        if (hi == 0) *(f32x2*)(stats + (size_t)(row0 + r32) * 2) = (f32x2){mu_l, rs_l};
        f32x16 acc0 = {}, acc1 = {};
        {
            const bf16_t* WT = WRH; (void)WRL;
            LAS float* xs = (LAS float*)(F.lds + F.wave * 9216);
            const float* xg = src + (size_t)(row0 + (lane >> 3)) * DM + (lane & 7) * 4;
            f32x4 xv[4]; bf16x8 wv[8];
#pragma unroll
            for (int i = 0; i < 4; ++i) xv[i] = *(const f32x4*)(xg + (size_t)(8 * i) * DM);
#pragma unroll
            for (int q = 0; q < 8; ++q) wv[q] = *(const bf16x8*)(WT + ((size_t)q * 64 + lane) * 8);
#pragma unroll 2
            for (int it = 0; it < 32; ++it) {
                LAS float* xb = xs + (it & 1) * 1152;
#pragma unroll
                for (int i = 0; i < 4; ++i) *(LAS f32x4*)(xb + ((lane >> 3) + 8 * i) * 36 + (lane & 7) * 4) = xv[i];
                bf16x8 wc[8];
#pragma unroll
                for (int q = 0; q < 8; ++q) wc[q] = wv[q];
                { const int nx = it + 1 < 32 ? it + 1 : 31;
#pragma unroll
                  for (int i = 0; i < 4; ++i) xv[i] = *(const f32x4*)(xg + (size_t)(8 * i) * DM + nx * 32);
#pragma unroll
                  for (int q = 0; q < 8; ++q) wv[q] = *(const bf16x8*)(WT + (((size_t)nx * 8 + q) * 64 + lane) * 8); }
                f32x4 xa[4];
#pragma unroll
                for (int j = 0; j < 4; ++j) xa[j] = *(const LAS f32x4*)(xb + r32 * 36 + hi * 16 + 4 * j);
#pragma unroll
                for (int st = 0; st < 2; ++st) {
                    const f32x4 x0 = xa[2 * st], x1 = xa[2 * st + 1];
                    u32x4 xh, xl;
                    xh.x = cvt_pk_bf16(x0[0], x0[1]); xh.y = cvt_pk_bf16(x0[2], x0[3]); xh.z = cvt_pk_bf16(x1[0], x1[1]); xh.w = cvt_pk_bf16(x1[2], x1[3]);
                    xl.x = cvt_pk_bf16(x0[0] - bflo(xh.x), x0[1] - bfhi(xh.x)); xl.y = cvt_pk_bf16(x0[2] - bflo(xh.y), x0[3] - bfhi(xh.y));
                    xl.z = cvt_pk_bf16(x1[0] - bflo(xh.z), x1[1] - bfhi(xh.z)); xl.w = cvt_pk_bf16(x1[2] - bflo(xh.w), x1[3] - bfhi(xh.w));
                    const bf16x8 xhv = __builtin_bit_cast(bf16x8, xh), xlv = __builtin_bit_cast(bf16x8, xl);
                    acc0 = __builtin_amdgcn_mfma_f32_32x32x16_bf16(wc[0 + st], xhv, acc0, 0, 0, 0); acc1 = __builtin_amdgcn_mfma_f32_32x32x16_bf16(wc[4 + st], xhv, acc1, 0, 0, 0);
                    acc0 = __builtin_amdgcn_mfma_f32_32x32x16_bf16(wc[2 + st], xhv, acc0, 0, 0, 0); acc1 = __builtin_amdgcn_mfma_f32_32x32x16_bf16(wc[6 + st], xhv, acc1, 0, 0, 0);
                    acc0 = __builtin_amdgcn_mfma_f32_32x32x16_bf16(wc[0 + st], xlv, acc0, 0, 0, 0); acc1 = __builtin_amdgcn_mfma_f32_32x32x16_bf16(wc[4 + st], xlv, acc1, 0, 0, 0);
                }
            }
        }
        float gl[4];
#pragma unroll
        for (int i = 0; i < 4; ++i) gl[i] = rs_l * (acc1[i] - mu_l * WRC[32 + i]) + WRC[64 + 32 + i];
        int gidx = 0; float gmax = gl[0];
#pragma unroll
        for (int i = 1; i < 4; ++i) if (gl[i] > gmax) { gmax = gl[i]; gidx = i; }
        float gsum = 0.f;
#pragma unroll
        for (int i = 0; i < 4; ++i) gsum += fast_exp(gl[i] - gmax);
        float gp = 1.0f / gsum;
        gidx = __shfl(gidx, r32); gp = __shfl(gp, r32);
        float cv[4];
#pragma unroll
        for (int i = 0; i < 4; ++i) {
            const float a = gidx == 0 ? acc0[i] : gidx == 1 ? acc0[4 + i] : gidx == 2 ? acc0[8 + i] : acc0[12 + i];
            cv[i] = rs_l * (a - mu_l * WRC[8 * gidx + 4 * hi + i]) + WRC[64 + 8 * gidx + 4 * hi + i];
        }
        float v1 = cv[0]; int i1 = 0;
#pragma unroll
        for (int i = 1; i < 4; ++i) if (cv[i] > v1) { v1 = cv[i]; i1 = i; }
        float v2 = -INFINITY; int i2 = 0;
#pragma unroll
        for (int i = 0; i < 4; ++i) if (i != i1 && cv[i] > v2) { v2 = cv[i]; i2 = i; }
        i1 += 4 * hi; i2 += 4 * hi;
        const float pv1 = __shfl_xor(v1, 32), pv2 = __shfl_xor(v2, 32); const int pi1 = __shfl_xor(i1, 32), pi2 = __shfl_xor(i2, 32);
        auto better = [](float av, int ai, float bv, int bi) { return av > bv || (av == bv && ai < bi); };
        float fv, sv; int fi, si;
        if (better(v1, i1, pv1, pi1)) { fv = v1; fi = i1; if (better(v2, i2, pv1, pi1)) { sv = v2; si = i2; } else { sv = pv1; si = pi1; } }
        else { fv = pv1; fi = pi1; if (better(v1, i1, pv2, pi2)) { sv = v1; si = i1; } else { sv = pv2; si = pi2; } }
        const float d = fast_exp(sv - fv), inv = 1.0f / (1.0f + d);
        const float w1 = gp * inv, w2 = gp * d * inv;
        const int e1 = 8 * gidx + fi, e2 = 8 * gidx + si;
        if (hi == 0) {
            *(int4*)(route + (size_t)(row0 + r32) * 4) = make_int4(e1, e2, __float_as_int(w1), __float_as_int(w2));
            atomicAdd((unsigned*)&hist[e1], 1u); atomicAdd((unsigned*)&hist[e2], 1u);
        }
        __syncthreads();
        if (F.tid < 32) misc[MI_BLOCKCNT + blk * 32 + F.tid] = hist[F.tid];
        __syncthreads();
    }
}

__device__ __forceinline__ void phase_moe_scatter(Frame& F) {
    PHASE_IDS(F);
    unsigned* misc = (unsigned*)(F.ws + WS_MISC);
    const int* route = (const int*)(F.ws + WS_ROUTE);
    int* rpos = (int*)(F.ws + WS_RPOS); int* rowtok = (int*)(F.ws + WS_ROWTOK);
    LAS unsigned* tot = (LAS unsigned*)(F.lds + L_TOT); LAS unsigned* pre = (LAS unsigned*)(F.lds + L_PRE);
    LAS unsigned* base = (LAS unsigned*)(F.lds + L_BASE); LAS unsigned* rank = (LAS unsigned*)(F.lds + L_RANK);
    for (int blk = F.vcu; blk < TT / 256; blk += F.G) {
        {
            if (F.tid < 32) { tot[F.tid] = 0u; pre[F.tid] = 0u; rank[F.tid] = 0u; }
            __syncthreads();
            const int e = F.tid & 31, part = F.tid >> 5; unsigned cv[16];
#pragma unroll
            for (int i = 0; i < 16; ++i) cv[i] = misc[MI_BLOCKCNT + (part * 16 + i) * 32 + e];
            unsigned t = 0, p = 0;
#pragma unroll
            for (int i = 0; i < 16; ++i) { t += cv[i]; p += (part * 16 + i < blk) ? cv[i] : 0u; }
            atomicAdd((unsigned*)&tot[e], t); atomicAdd((unsigned*)&pre[e], p);
        }
        __syncthreads();
        if (F.tid == 0) { unsigned a = 0; for (int e = 0; e < NEXP; ++e) { base[e] = a; a += (tot[e] + 255u) & ~255u; } base[NEXP] = a; }
        __syncthreads();
        {
            const int tok = blk * 256 + (F.tid >> 1), slot = F.tid & 1;
            const int e = route[(size_t)tok * 4 + slot];
            const unsigned r = atomicAdd((unsigned*)&rank[e], 1u);
            const unsigned pos = base[e] + pre[e] + r;
            rowtok[pos] = tok; rpos[(size_t)tok * 2 + slot] = (int)pos;
        }
        if (blk < NEXP) {
            const int e = blk; const unsigned end = base[e] + tot[e], nxt = base[e + 1];
            for (unsigned p = end + F.tid; p < nxt; p += NTHREADS) rowtok[p] = 0;
            for (unsigned p = base[e] / 256 + F.tid; p < nxt / 256; p += NTHREADS) misc[MI_PANEL_E + p] = (unsigned)e;
        }
        if (blk == 0 && F.tid == 0) misc[MI_NPAN] = base[NEXP] / 256;
        __syncthreads();
    }
}

struct MoeSched1 {
    static constexpr bool GATHER = true;
    const bf16_t* A; const bf16_t* W; int lda, ldb, ntot, G, c; const LAS int* rows; const LAS int* pe; int sw8, sa8;
    __device__ __forceinline__ bool next(int i, pg8::Unit& u) const { const int v = i * G + c; if (v >= ntot) return false; u.pm = v >> 1; u.pn = v & 1; u.ord = i; return true; }
    __device__ __forceinline__ const char* a_base(const pg8::Unit&) const { return (const char*)A; }
    __device__ __forceinline__ const char* b_base(const pg8::Unit& u) const { return (const char*)(W + (size_t)pe[u.ord] * 512 * ldb + (size_t)u.pn * 256 * ldb); }
    __device__ __forceinline__ void a_off(const pg8::Unit& u, const int (&R)[2], const int (&C)[2], unsigned (&v)[2][2]) const {
#pragma unroll
        for (int h = 0; h < 2; ++h)
#pragma unroll
            for (int i = 0; i < 2; ++i) v[h][i] = (unsigned)(rows[u.ord * 256 + h * 128 + R[i]] * lda + C[i]) * 2u;
    }
};
struct MoeSched2 {
    static constexpr bool GATHER = false;
    const bf16_t* A; const bf16_t* W; int lda, ldb, ntot, G, c; const LAS int* pe; int sw8, sa8;
    __device__ __forceinline__ bool next(int i, pg8::Unit& u) const { const int v = i * G + c; if (v >= ntot) return false; u.pm = v >> 2; u.pn = v & 3; u.ord = i; return true; }
    __device__ __forceinline__ const char* a_base(const pg8::Unit& u) const { return (const char*)(A + (size_t)u.pm * 256 * lda); }
    __device__ __forceinline__ const char* b_base(const pg8::Unit& u) const { return (const char*)(W + (size_t)pe[u.ord] * DM * ldb + (size_t)u.pn * 256 * ldb); }
    __device__ __forceinline__ void a_off(const pg8::Unit&, const int (&R)[2], const int (&C)[2], unsigned (&v)[2][2]) const {
#pragma unroll
        for (int i = 0; i < 2; ++i) { v[0][i] = (unsigned)(R[i] * lda + C[i]) * 2u; v[1][i] = (unsigned)((128 + R[i]) * lda + C[i]) * 2u; }
    }
};
struct EpiSwiGLU {
    bf16_t* H;
    __device__ __forceinline__ void operator()(const f32x4 (&acc)[2][2][4][2], const pg8::Unit& u, int wr, int wc, int fr, int fq) const {
        const int row0 = u.pm * 256 + wr * 64 + fr, col0 = u.pn * 128 + wc * 16 + 4 * fq;
#pragma unroll
        for (int ai = 0; ai < 2; ++ai)
#pragma unroll
            for (int m = 0; m < 4; ++m) { bf16_t* rowp = H + (size_t)(row0 + ai * 128 + m * 16) * DEXP + col0;
#pragma unroll
                for (int bj = 0; bj < 2; ++bj) { const f32x4 v0 = acc[ai][bj][m][0], v1 = acc[ai][bj][m][1];
                    const float h0 = v0[0] * sigmoidf_(v0[0]) * v0[1], h1 = v0[2] * sigmoidf_(v0[2]) * v0[3], h2 = v1[0] * sigmoidf_(v1[0]) * v1[1], h3 = v1[2] * sigmoidf_(v1[2]) * v1[3];
                    *(unsigned*)((unsigned char*)H + (size_t)(row0 + ai * 128 + m * 16) * DEXP + col0 + bj * 64) = pk4_fp8(h0 * 16.f, h1 * 16.f, h2 * 16.f, h3 * 16.f); (void)rowp; } }
    }
};
struct EpiStoreBf16 {
    bf16_t* O; int ldc;
    __device__ __forceinline__ void operator()(const f32x4 (&acc)[2][2][4][2], const pg8::Unit& u, int wr, int wc, int fr, int fq) const {
        const int row0 = u.pm * 256 + wr * 64 + fr, col0 = u.pn * 256 + wc * 32 + 8 * fq;
#pragma unroll
        for (int ai = 0; ai < 2; ++ai)
#pragma unroll
            for (int m = 0; m < 4; ++m) { bf16_t* rowp = O + (size_t)(row0 + ai * 128 + m * 16) * ldc + col0;
#pragma unroll
                for (int bj = 0; bj < 2; ++bj) store8_fp8((unsigned char*)O + (size_t)(row0 + ai * 128 + m * 16) * ldc + col0 + bj * 128, acc[ai][bj][m][0], acc[ai][bj][m][1], 64.f); (void)rowp; }
    }
};

__device__ __forceinline__ void phase_moe_gemm1(Frame& F) {
    PHASE_IDS(F);
    const unsigned* misc = (const unsigned*)(F.ws + WS_MISC);
    const int* rowtok = (const int*)(F.ws + WS_ROWTOK);
    const int npan = (int)misc[MI_NPAN];
    LAS int* rows = (LAS int*)(F.lds + L_ROWS); LAS int* pe = (LAS int*)(F.lds + L_PE);
    const int c = (int)blockIdx.x, ntot = npan * 2;
    for (int i = 0; i * F.G + c < ntot && i < 8; ++i) { const int p = (i * F.G + c) >> 1;
        if (F.tid < 256) rows[i * 256 + F.tid] = rowtok[p * 256 + F.tid];
        if (F.tid == 256) pe[i] = (int)misc[MI_PANEL_E + p]; }
    VM_WAIT(); LDS_WAIT(); __syncthreads();
    MoeSched1 S{(const bf16_t*)(F.ws + WS_XB8), (const bf16_t*)(F.ws + WS_W13), DM / 2, DM / 2, ntot, F.G, c, rows, pe, F8_SW, F8_SA_X};
    EpiSwiGLU E{(bf16_t*)(F.ws + WS_H)};
    pg8::gemm_phase<EpiSwiGLU, MoeSched1, true, true>(F.lds, DM / 2, S, E);
}
__device__ __forceinline__ void phase_moe_gemm2(Frame& F) {
    PHASE_IDS(F);
    const unsigned* misc = (const unsigned*)(F.ws + WS_MISC);
    const int npan = (int)misc[MI_NPAN];
    LAS int* pe = (LAS int*)(F.lds + L_PE);
    const int c = (int)blockIdx.x, ntot = npan * 4;
    __syncthreads();
    if (F.tid < 16) { const int v = F.tid * F.G + c; if (v < ntot) pe[F.tid] = (int)misc[MI_PANEL_E + (v >> 2)]; }
    VM_WAIT(); LDS_WAIT(); __syncthreads();
    MoeSched2 S{(const bf16_t*)(F.ws + WS_H), (const bf16_t*)(F.ws + WS_W2), DEXP / 2, DEXP / 2, ntot, F.G, c, pe, F8_SW, 127 - 4};
    EpiStoreBf16 E{(bf16_t*)(F.ws + WS_Y), DM};
    int k2 = DEXP / 2; asm volatile("" : "+s"(k2));
    pg8::gemm_phase<EpiStoreBf16, MoeSched2, true, true>(F.lds, k2, S, E);
}

__device__ __forceinline__ void phase_combine_ln2(Frame& F, int l) {
    PHASE_IDS(F);
    const int lane = F.lane;
    const float* lg = F.in[21] + (size_t)l * DM; const float* lb = F.in[22] + (size_t)l * DM;
    f32x4 g[4], b[4];
#pragma unroll
    for (int j = 0; j < 4; ++j) { g[j] = ((const f32x4*)lg)[lane + 64 * j]; b[j] = ((const f32x4*)lb)[lane + 64 * j]; }
    const bf16_t* Y = (const bf16_t*)(F.ws + WS_Y);
    const float* l1g = F.in[12] + (size_t)l * DM; const float* l1b = F.in[13] + (size_t)l * DM; const float* stats = (const float*)(F.ws + WS_WR + 512 * 1024);
    f32x4 g1[4], b1[4];
#pragma unroll
    for (int j = 0; j < 4; ++j) { g1[j] = ((const f32x4*)l1g)[lane + 64 * j]; b1[j] = ((const f32x4*)l1b)[lane + 64 * j]; }
    const int* route = (const int*)(F.ws + WS_ROUTE); const int* rpos = (const int*)(F.ws + WS_RPOS);
    const int gw = F.vcu * NWAVES + F.wave, NGW = F.G * NWAVES;
    int4 rt_n = *(const int4*)(route + (size_t)gw * 4); int2 rp_n = *(const int2*)(rpos + (size_t)gw * 2); f32x2 st_n = *(const f32x2*)(stats + (size_t)gw * 2);
    for (int row = gw; row < TT; row += NGW) {
        const int4 rt = rt_n; const int2 rp = rp_n; const f32x2 st = st_n;
        { const int nr = (row + NGW < TT) ? row + NGW : row; rt_n = *(const int4*)(route + (size_t)nr * 4); rp_n = *(const int2*)(rpos + (size_t)nr * 2); st_n = *(const f32x2*)(stats + (size_t)nr * 2); }
        const float w0 = __int_as_float(rt.z) * (1.f / 64.f), w1 = __int_as_float(rt.w) * (1.f / 64.f);
        const f32x4* px = (const f32x4*)(F.out + (size_t)row * DM);
        const unsigned* y0 = (const unsigned*)((const unsigned char*)Y + (size_t)rp.x * DM); const unsigned* y1 = (const unsigned*)((const unsigned char*)Y + (size_t)rp.y * DM);
        f32x4 v[4];
#pragma unroll
        for (int j = 0; j < 4; ++j) {
            const f32x4 x = (px[lane + 64 * j] - st[0]) * st[1] * g1[j] + b1[j]; const unsigned a = y0[lane + 64 * j], c = y1[lane + 64 * j];
            const f32x2 a01 = __builtin_amdgcn_cvt_pk_f32_fp8((int)a, false), a23 = __builtin_amdgcn_cvt_pk_f32_fp8((int)a, true), c01 = __builtin_amdgcn_cvt_pk_f32_fp8((int)c, false), c23 = __builtin_amdgcn_cvt_pk_f32_fp8((int)c, true);
            v[j].x = ALPHA * x.x + w0 * a01[0] + w1 * c01[0]; v[j].y = ALPHA * x.y + w0 * a01[1] + w1 * c01[1];
            v[j].z = ALPHA * x.z + w0 * a23[0] + w1 * c23[0]; v[j].w = ALPHA * x.w + w0 * a23[1] + w1 * c23[1];
        }
        ln_row(v, g, b);
#pragma unroll
        for (int j = 0; j < 4; ++j) ((f32x4*)(F.out + (size_t)row * DM))[lane + 64 * j] = v[j];
        if (l == 0) {
#pragma unroll
            for (int j = 0; j < 4; ++j) ((unsigned*)(F.ws + WS_XB8 + (size_t)row * DM))[lane + 64 * j] = pk4_fp8(v[j].x * 16.f, v[j].y * 16.f, v[j].z * 16.f, v[j].w * 16.f);
        }
    }
}

constexpr float C2D = 0.18033688011112042f;
constexpr float C2M = 0.14724444602590306f;
constexpr float IWS = 0.044194173824159216f;
constexpr float RMS_EPS = 1e-6f;
constexpr int L_QSLOT = L_CTL + 1152;

__device__ __forceinline__ int rope16(int c) { return c < 16 ? (c >> 1) + 8 * (c & 1) : c; }
__device__ __forceinline__ int win_src(int n, float& sc) {
    sc = 1.f;
    if (n < 384) return n;
    if (n < 416) { const int c = n - 384; return 384 + (c >> 1) + 16 * (c & 1); }
    if (n < 512) return -1;
    if (n < 2816) { const int m = n - 512, g = m / 768, r = m % 768, p = r >> 8, hh = (r & 255) >> 6, c = r & 63; if (p == 0) sc = C2D; return 416 + 768 * g + 256 * p + 64 * hh + (p < 2 ? rope16(c) : c); }
    if (n < 3328) { const int m = n - 2816; sc = C2D; return 2720 + (m & ~63) + rope16(m & 63); }
    if (n < 3840) { const int m = n - 3328; return 3360 + (m & ~63) + rope16(m & 63); }
    const int m = n - 3840;
    if (m < 64) return 3232 + rope16(m);
    if (m < 128) return 3296 + (m - 64);
    if (m < 192) return 3872 + rope16(m - 128);
    if (m < 200) { sc = IWS; return 3936 + (m - 192); }
    return -1;
}

__device__ __forceinline__ void sincos_d(double x, double& s, double& c) {
    const double n = __builtin_rint(x * 0.15915494309189535);
    double r = __builtin_fma(-n, 6.2831854820251465, x); r = __builtin_fma(n, 1.7484556025237907e-07, r);
    const double r2 = r * r; double ss = 1.0, cc = 1.0;
#pragma unroll
    for (int k = 15; k >= 1; --k) { ss = 1.0 - r2 * (1.0 / (double)((2 * k) * (2 * k + 1))) * ss; cc = 1.0 - r2 * (1.0 / (double)((2 * k - 1) * (2 * k))) * cc; }
    s = ss * r; c = cc;
}
__device__ __forceinline__ double inv_freq16(int i) {
    const double t[16] = {1.0, 0.44036660267178046, 0.19392274474868576, 0.08539710028576561, 0.03760603093086393, 0.016560440080994446, 0.007292664737217109, 0.003211445994752591,
                          0.001414213562373095, 0.000622772421914596, 0.0002742481756762073, 0.00012076973741146504, 5.318295896944988e-05, 2.341999896140934e-05, 1.031338537721246e-05, 4.5416704806078695e-06};
    double r = t[0];
#pragma unroll
    for (int k = 1; k < 16; ++k) r = (i == k) ? t[k] : r;
    return r;
}

__device__ __forceinline__ void phase_conv_mixer(Frame& F, int l) {
    PHASE_IDS(F);
    LAS float* scr = (LAS float*)(F.lds + F.wave * 16384);
    const int gw = F.vcu * NWAVES + F.wave, NGW = F.G * NWAVES;
    const float* win = F.in[1] + (size_t)l * DM * CIN;
    const float* qg = F.in[2] + (size_t)l * 256; const float* wuq = F.in[3] + (size_t)l * 256 * 768;
    const float* kg = F.in[4] + (size_t)l * 128; const float* wukv = F.in[5] + (size_t)l * 128 * 1024;
    const float* wgate = F.in[6] + (size_t)l * DM * 3072;
    const float* wa = F.in[8] + (size_t)l * 512 * DM; const float* wb = F.in[9] + (size_t)l * 256 * DM; const float* wc = F.in[10] + (size_t)l * 512 * DM; const float* wo = F.in[11] + (size_t)l * DM * DM;
    unsigned char* WIN8 = F.ws + WS_WIN8; bf16_t* WUQ = (bf16_t*)(F.ws + WS_WUQ); bf16_t* WUKV = (bf16_t*)(F.ws + WS_WUKV);
    bf16_t* WA = (bf16_t*)(F.ws + WS_WA); bf16_t* WB = (bf16_t*)(F.ws + WS_WB); bf16_t* WC = (bf16_t*)(F.ws + WS_WC); bf16_t* WO = (bf16_t*)(F.ws + WS_WO);
    constexpr int I_IN = 16 * 128, I_G = 16 * 96, I_UQ = 4 * 24, I_UKV = 4 * 32, I_A = 8 * 32, I_B = 8 * 32, I_C = 8 * 32, I_O = 16 * 32;
    constexpr int NIT = I_IN + I_G + I_UQ + I_UKV + I_A + I_B + I_C + I_O;
    for (int it = gw; it < NIT; it += NGW) {
        int r = it;
        if (r < I_IN) { conv_item8(WIN8, DM, (r / 128) * 64, (r % 128) * 32, scr, F.lane, [&](int k, int n) { float sc; const int sidx = win_src(n, sc); return sidx < 0 ? 0.f : win[(size_t)k * CIN + sidx] * (sc * 1024.f); }); continue; } r -= I_IN;
        if (r < I_G) { conv_plain8(WIN8 + (size_t)PW * DM, DM, (r / 96) * 64, (r % 96) * 32, scr, F.lane, wgate, 3072, 1024.f); continue; } r -= I_G;
        if (r < I_UQ) { conv_item(WUQ, 256, (r / 24) * 64, (r % 24) * 32, scr, F.lane, [&](int k, int n) { const int hh = n / 96, c = n % 96; const int o = c < 64 ? c : 64 + ((c - 64) >> 1) + 16 * ((c - 64) & 1);
                return qg[k] * wuq[(size_t)k * 768 + hh * 96 + o] * C2M; }); continue; } r -= I_UQ;
        if (r < I_UKV) { conv_item(WUKV, 256, (r / 32) * 64, (r % 32) * 32, scr, F.lane, [&](int k, int n) { return k < 128 ? kg[k] * wukv[(size_t)k * 1024 + n] : 0.f; }); continue; } r -= I_UKV;
        if (r < I_A) { conv_plain8((unsigned char*)WA, 512, (r / 32) * 64, (r % 32) * 32, scr, F.lane, wa, DM, 1024.f); continue; } r -= I_A;
        if (r < I_B) { conv_item8((unsigned char*)WB, 512, (r / 32) * 64, (r % 32) * 32, scr, F.lane, [&](int k, int n) { return k < 256 ? wb[(size_t)k * DM + n] * 1024.f : 0.f; }); continue; } r -= I_B;
        if (r < I_C) { conv_plain8((unsigned char*)WC, 512, (r / 32) * 64, (r % 32) * 32, scr, F.lane, wc, DM, 1024.f); continue; } r -= I_C;
        conv_plain8((unsigned char*)WO, DM, (r / 32) * 64, (r % 32) * 32, scr, F.lane, wo, DM, 1024.f);
    }
    if (l == 0) {
        float* rp = (float*)(F.ws + WS_ROPE); float* rm = rp + 2048 * 8 * 2;
        for (int idx = F.vcu * NTHREADS + F.tid; idx < 2048 * 24; idx += F.G * NTHREADS) {
            const int t = idx / 24, j = idx % 24; double sn, cs;
            if (j < 8) { sincos_d((double)t * inv_freq16(2 * j), sn, cs); rp[(t * 8 + j) * 2] = (float)cs; rp[(t * 8 + j) * 2 + 1] = (float)sn; }
            else { sincos_d((double)t * inv_freq16(j - 8), sn, cs); rm[(t * 16 + (j - 8)) * 2] = (float)cs; rm[(t * 16 + (j - 8)) * 2 + 1] = (float)sn; }
        }
        const f32x4* x4 = (const f32x4*)F.in[0]; unsigned* xb8 = (unsigned*)(F.ws + WS_XB8);
        for (size_t i = (size_t)F.vcu * NTHREADS + F.tid; i < (size_t)TT * DM / 4; i += (size_t)F.G * NTHREADS) { const f32x4 v = x4[i] * 16.f; xb8[i] = pk4_fp8(v.x, v.y, v.z, v.w); }
    }
}

__device__ __forceinline__ void rope4(f32x4& v0, f32x4& v1, const float* cs) {
    const f32x4 a = *(const f32x4*)cs, b = *(const f32x4*)(cs + 4);
    const f32x4 w0 = {v0[0] * a[0] - v0[1] * a[1], v0[1] * a[0] + v0[0] * a[1], v0[2] * a[2] - v0[3] * a[3], v0[3] * a[2] + v0[2] * a[3]};
    const f32x4 w1 = {v1[0] * b[0] - v1[1] * b[1], v1[1] * b[0] + v1[0] * b[1], v1[2] * b[2] - v1[3] * b[3], v1[3] * b[2] + v1[2] * b[3]};
    v0 = w0; v1 = w1;
}
__device__ __forceinline__ void store8(bf16_t* p, const f32x4& v0, const f32x4& v1) {
    u32x4 w; w.x = cvt_pk_bf16(v0[0], v0[1]); w.y = cvt_pk_bf16(v0[2], v0[3]); w.z = cvt_pk_bf16(v1[0], v1[1]); w.w = cvt_pk_bf16(v1[2], v1[3]); *(u32x4*)p = w;
}
struct EpiProj {
    bf16_t* P; const float* csp; const float* csm; float* ssq; bf16_t* G3; const LAS float* gbias;
    __device__ __forceinline__ void operator()(const f32x4 (&acc)[2][2][4][2], const pg8::Unit& u, int wr, int wc, int fr, int fq) const {
        const int pn = u.pn, row0 = u.pm * 256 + wr * 64 + fr;
        if (pn >= 16) {
#pragma unroll
            for (int bj = 0; bj < 2; ++bj) { const int col = (pn - 16) * 256 + bj * 128 + wc * 32 + fq * 8;
                const f32x4 b0 = *(const LAS f32x4*)(gbias + col), b1 = *(const LAS f32x4*)(gbias + col + 4);
#pragma unroll
                for (int ai = 0; ai < 2; ++ai)
#pragma unroll
                    for (int m = 0; m < 4; ++m) { f32x4 v0 = acc[ai][bj][m][0] + b0, v1 = acc[ai][bj][m][1] + b1;
#pragma unroll
                        for (int e = 0; e < 4; ++e) { v0[e] = sigmoidf_(v0[e]); v1[e] = sigmoidf_(v1[e]); }
                        store8_fp8((unsigned char*)G3 + (size_t)(row0 + ai * 128 + m * 16) * 3072 + col, v0, v1, 64.f); } }
            return;
        }
#pragma unroll
        for (int bj = 0; bj < 2; ++bj) {
            const int wcu = __builtin_amdgcn_readfirstlane(wc);
            bool ropeP = false, ropeM = false;
            if (pn == 1) ropeM = (bj == 1 && wcu == 0);
            else if (pn >= 2 && pn < 11) ropeP = ((pn - 2) % 3) < 2 && !(wcu & 1);
            else if (pn >= 11 && pn < 15) ropeP = !(wcu & 1);
            else if (pn == 15) ropeP = (wcu == 0);
            const int col = pn * 256 + bj * 128 + wc * 32 + fq * 8;
            if (ropeP || ropeM) {
                const bool lr = ropeM || fq < 2;
                const float* cb = ropeM ? csm + 8 * fq : csp + 8 * (fq & 1);
                const int ts = ropeM ? 32 : 16;
#pragma unroll
                for (int ai = 0; ai < 2; ++ai)
#pragma unroll
                    for (int mh = 0; mh < 2; ++mh) {
                        f32x4 ca[2], cc[2];
#pragma unroll
                        for (int mm = 0; mm < 2; ++mm) { const int t = (row0 + ai * 128 + (2 * mh + mm) * 16) & (SEQ - 1);
                            ca[mm] = *(const f32x4*)(cb + t * ts); cc[mm] = *(const f32x4*)(cb + t * ts + 4); }
#pragma unroll
                        for (int mm = 0; mm < 2; ++mm) { const int m = 2 * mh + mm, row = row0 + ai * 128 + m * 16;
                            const f32x4 v0 = acc[ai][bj][m][0], v1 = acc[ai][bj][m][1];
                            f32x4 a = ca[mm], b = cc[mm];
                            if (!lr) { a = (f32x4){1.f, 0.f, 1.f, 0.f}; b = a; }
                            const f32x4 w0 = {v0[0] * a[0] - v0[1] * a[1], v0[1] * a[0] + v0[0] * a[1], v0[2] * a[2] - v0[3] * a[3], v0[3] * a[2] + v0[2] * a[3]};
                            const f32x4 w1 = {v1[0] * b[0] - v1[1] * b[1], v1[1] * b[0] + v1[0] * b[1], v1[2] * b[2] - v1[3] * b[3], v1[3] * b[2] + v1[2] * b[3]};
                            store8(P + (size_t)row * PW + col, w0, w1); }
                    }
            } else {
#pragma unroll
                for (int ai = 0; ai < 2; ++ai)
#pragma unroll
                    for (int m = 0; m < 4; ++m)
                        store8(P + (size_t)(row0 + ai * 128 + m * 16) * PW + col, acc[ai][bj][m][0], acc[ai][bj][m][1]);
            }
        }
        if (pn < 2) {
#pragma unroll
            for (int ai = 0; ai < 2; ++ai)
#pragma unroll
                for (int m = 0; m < 4; ++m) {
                    float sq = 0.f;
#pragma unroll
                    for (int bj = 0; bj < 2; ++bj) if (pn == 0 || bj == 0) {
#pragma unroll
                        for (int n = 0; n < 2; ++n) { const f32x4 x = acc[ai][bj][m][n]; sq += (x[0] * x[0] + x[1] * x[1]) + (x[2] * x[2] + x[3] * x[3]); } }
                    sq += __shfl_xor(sq, 16); sq += __shfl_xor(sq, 32);
                    if (fq == 0) ssq[(size_t)(row0 + ai * 128 + m * 16) * 8 + pn * 4 + wc] = sq;
                }
        }
    }
};
struct EpiUpQ {
    bf16_t* Q; const float* csm; const float* ssq;
    __device__ __forceinline__ void operator()(const f32x4 (&acc)[2][2][4][2], const pg8::Unit& u, int wr, int wc, int fr, int fq) const {
        const int row0 = u.pm * 256 + wr * 64 + fr;
        f32x4 spv[2][4];
#pragma unroll
        for (int ai = 0; ai < 2; ++ai)
#pragma unroll
            for (int m = 0; m < 4; ++m) spv[ai][m] = *(const f32x4*)(ssq + (size_t)(row0 + ai * 128 + m * 16) * 8);
#pragma unroll
        for (int ai = 0; ai < 2; ++ai)
#pragma unroll
            for (int m = 0; m < 4; ++m) { const f32x4 sp = spv[ai][m];
                spv[ai][m][0] = 1.0f / sqrtf(((sp[0] + sp[1]) + (sp[2] + sp[3])) * (1.f / 256.f) + RMS_EPS); }
        const int wcu = __builtin_amdgcn_readfirstlane(wc);
#pragma unroll
        for (int bj = 0; bj < 2; ++bj) {
            const int c0 = u.pn * 256 + bj * 128 + wcu * 32, col = c0 + fq * 8;
            if (((c0 >> 5) % 3) == 2) {
#pragma unroll
                for (int ai = 0; ai < 2; ++ai)
#pragma unroll
                    for (int mh = 0; mh < 2; ++mh) {
                        f32x4 ca[2], cc[2];
#pragma unroll
                        for (int mm = 0; mm < 2; ++mm) { const int t = (row0 + ai * 128 + (2 * mh + mm) * 16) & (SEQ - 1);
                            ca[mm] = *(const f32x4*)(csm + t * 32 + 8 * fq); cc[mm] = *(const f32x4*)(csm + t * 32 + 8 * fq + 4); }
#pragma unroll
                        for (int mm = 0; mm < 2; ++mm) { const int m = 2 * mh + mm, row = row0 + ai * 128 + m * 16;
                            const float rs = spv[ai][m][0];
                            const f32x4 v0 = acc[ai][bj][m][0] * rs, v1 = acc[ai][bj][m][1] * rs, a = ca[mm], b = cc[mm];
                            const f32x4 w0 = {v0[0] * a[0] - v0[1] * a[1], v0[1] * a[0] + v0[0] * a[1], v0[2] * a[2] - v0[3] * a[3], v0[3] * a[2] + v0[2] * a[3]};
                            const f32x4 w1 = {v1[0] * b[0] - v1[1] * b[1], v1[1] * b[0] + v1[0] * b[1], v1[2] * b[2] - v1[3] * b[3], v1[3] * b[2] + v1[2] * b[3]};
                            store8(Q + (size_t)row * 768 + col, w0, w1); }
                    }
            } else {
#pragma unroll
                for (int ai = 0; ai < 2; ++ai)
#pragma unroll
                    for (int m = 0; m < 4; ++m) { const float rs = spv[ai][m][0];
                        store8(Q + (size_t)(row0 + ai * 128 + m * 16) * 768 + col, acc[ai][bj][m][0] * rs, acc[ai][bj][m][1] * rs); }
            }
        }
    }
};
struct EpiUpKV {
    bf16_t* KV; const float* ssq;
    __device__ __forceinline__ void operator()(const f32x4 (&acc)[2][2][4][2], const pg8::Unit& u, int wr, int wc, int fr, int fq) const {
        const int row0 = u.pm * 256 + wr * 64 + fr;
        f32x4 spv[2][4];
#pragma unroll
        for (int ai = 0; ai < 2; ++ai)
#pragma unroll
            for (int m = 0; m < 4; ++m) spv[ai][m] = *(const f32x4*)(ssq + (size_t)(row0 + ai * 128 + m * 16) * 8 + 4);
#pragma unroll
        for (int ai = 0; ai < 2; ++ai)
#pragma unroll
            for (int m = 0; m < 4; ++m) {
                const int row = row0 + ai * 128 + m * 16;
                const f32x4 sp = spv[ai][m];
                const float rs = 1.0f / sqrtf(((sp[0] + sp[1]) + (sp[2] + sp[3])) * (1.f / 128.f) + RMS_EPS);
#pragma unroll
                for (int bj = 0; bj < 2; ++bj) { const int col = u.pn * 256 + bj * 128 + wc * 32 + fq * 8;
                    store8(KV + (size_t)row * 1024 + col, acc[ai][bj][m][0] * rs, acc[ai][bj][m][1] * rs); }
            }
    }
};
struct EpiBranchAll {
    bf16_t* Mg; bf16_t* M0; bf16_t* M1; const bf16_t* G3;
    __device__ __forceinline__ void operator()(const f32x4 (&acc)[2][2][4][2], const pg8::Unit& u, int wr, int wc, int fr, int fq) const {
        const int row0 = u.pm * 256 + wr * 64 + fr, br = u.ord, col0 = u.pn * 256 + wc * 32 + fq * 8;
        bf16_t* dst = br == 0 ? M0 : (br == 1 ? M1 : Mg);
#pragma unroll
        for (int ai = 0; ai < 2; ++ai)
#pragma unroll
            for (int mh = 0; mh < 2; ++mh) {
                u32x2 gw[2][2]; u32x4 ma[2][2], mb[2][2];
#pragma unroll
                for (int mm = 0; mm < 2; ++mm)
#pragma unroll
                    for (int bj = 0; bj < 2; ++bj) { const int row = row0 + ai * 128 + (2 * mh + mm) * 16, col = col0 + bj * 128;
                        gw[mm][bj] = *(const u32x2*)((const unsigned char*)G3 + (size_t)row * 3072 + br * 1024 + col);
                        ma[mm][bj] = (u32x4){0u, 0u, 0u, 0u}; mb[mm][bj] = (u32x4){0u, 0u, 0u, 0u}; }
                if (br == 2) {
#pragma unroll
                    for (int mm = 0; mm < 2; ++mm)
#pragma unroll
                        for (int bj = 0; bj < 2; ++bj) { const size_t off = (size_t)(row0 + ai * 128 + (2 * mh + mm) * 16) * DM + col0 + bj * 128;
                            const u32x2 p = *(const u32x2*)((const unsigned char*)M0 + off), q = *(const u32x2*)((const unsigned char*)M1 + off);
                            ma[mm][bj] = (u32x4){p.x, p.y, 0u, 0u}; mb[mm][bj] = (u32x4){q.x, q.y, 0u, 0u}; }
                }
#pragma unroll
                for (int mm = 0; mm < 2; ++mm)
#pragma unroll
                    for (int bj = 0; bj < 2; ++bj) { const int m = 2 * mh + mm; const size_t off = (size_t)(row0 + ai * 128 + m * 16) * DM + col0 + bj * 128; const u32x2 g = gw[mm][bj]; const u32x4 a = ma[mm][bj], b2 = mb[mm][bj];
                        const f32x2 g01 = __builtin_amdgcn_cvt_pk_f32_fp8((int)g.x, false) * (1.f / 64.f), g23 = __builtin_amdgcn_cvt_pk_f32_fp8((int)g.x, true) * (1.f / 64.f);
                        const f32x2 g45 = __builtin_amdgcn_cvt_pk_f32_fp8((int)g.y, false) * (1.f / 64.f), g67 = __builtin_amdgcn_cvt_pk_f32_fp8((int)g.y, true) * (1.f / 64.f);
                        f32x4 v0 = acc[ai][bj][m][0], v1 = acc[ai][bj][m][1];
                        const f32x2 s01 = (__builtin_amdgcn_cvt_pk_f32_fp8((int)a.x, false) + __builtin_amdgcn_cvt_pk_f32_fp8((int)b2.x, false)) * (1.f / 64.f), s23 = (__builtin_amdgcn_cvt_pk_f32_fp8((int)a.x, true) + __builtin_amdgcn_cvt_pk_f32_fp8((int)b2.x, true)) * (1.f / 64.f);
                        const f32x2 s45 = (__builtin_amdgcn_cvt_pk_f32_fp8((int)a.y, false) + __builtin_amdgcn_cvt_pk_f32_fp8((int)b2.y, false)) * (1.f / 64.f), s67 = (__builtin_amdgcn_cvt_pk_f32_fp8((int)a.y, true) + __builtin_amdgcn_cvt_pk_f32_fp8((int)b2.y, true)) * (1.f / 64.f);
                        v0[0] = v0[0] * g01[0] + s01[0]; v0[1] = v0[1] * g01[1] + s01[1]; v0[2] = v0[2] * g23[0] + s23[0]; v0[3] = v0[3] * g23[1] + s23[1];
                        v1[0] = v1[0] * g45[0] + s45[0]; v1[1] = v1[1] * g45[1] + s45[1]; v1[2] = v1[2] * g67[0] + s67[0]; v1[3] = v1[3] * g67[1] + s67[1];
                        store8_fp8((unsigned char*)dst + off, v0, v1, 64.f); }
            }
    }
};
struct BranchSched {
    static constexpr bool GATHER = false; static constexpr bool VARK = true;
    const char* A0; const char* B0; size_t sA, sB; int lda, ldb, c, sw8, sa8, G, ntile;
    __device__ __forceinline__ int ktiles(const pg8::Unit& u) const { return u.ord == 1 ? 2 : 4; }
    __device__ __forceinline__ bool next(int i, pg8::Unit& u) const { const int t = c + (i / 3) * G; if (t >= ntile) return false; u.pm = t >> 2; u.pn = t & 3; u.ord = i % 3; return true; }
    __device__ __forceinline__ const char* a_base(const pg8::Unit& u) const { return A0 + (size_t)u.ord * sA + (size_t)u.pm * 256 * lda * 2; }
    __device__ __forceinline__ const char* b_base(const pg8::Unit& u) const { return B0 + (size_t)u.ord * sB + (size_t)u.pn * 256 * ldb * 2; }
    __device__ __forceinline__ void a_off(const pg8::Unit&, const int (&R)[2], const int (&C)[2], unsigned (&v)[2][2]) const {
#pragma unroll
        for (int i = 0; i < 2; ++i) { v[0][i] = (unsigned)(R[i] * lda + C[i]) * 2u; v[1][i] = (unsigned)((128 + R[i]) * lda + C[i]) * 2u; }
    }
};
struct EpiWo {
    float* out; const float* xsrc; int rowbase;
    __device__ __forceinline__ void operator()(const f32x4 (&acc)[2][2][4][2], const pg8::Unit& u, int wr, int wc, int fr, int fq) const {
        const int row0 = rowbase + u.pm * 256 + wr * 64 + fr, col0 = u.pn * 256 + wc * 32 + fq * 8;
#pragma unroll
        for (int ai = 0; ai < 2; ++ai)
#pragma unroll
            for (int mh = 0; mh < 2; ++mh) {
                f32x4 x[2][2][2];
#pragma unroll
                for (int mm = 0; mm < 2; ++mm)
#pragma unroll
                    for (int bj = 0; bj < 2; ++bj) { const size_t off = (size_t)(row0 + ai * 128 + (2 * mh + mm) * 16) * DM + col0 + bj * 128;
                        x[mm][bj][0] = *(const f32x4*)(xsrc + off); x[mm][bj][1] = *(const f32x4*)(xsrc + off + 4); }
#pragma unroll
                for (int mm = 0; mm < 2; ++mm)
#pragma unroll
                    for (int bj = 0; bj < 2; ++bj) { const size_t off = (size_t)(row0 + ai * 128 + (2 * mh + mm) * 16) * DM + col0 + bj * 128;
                        *(f32x4*)(out + off) = x[mm][bj][0] * ALPHA + acc[ai][bj][2 * mh + mm][0]; *(f32x4*)(out + off + 4) = x[mm][bj][1] * ALPHA + acc[ai][bj][2 * mh + mm][1]; }
            }
    }
};

__device__ __forceinline__ int dequeue(Frame& F, unsigned* ctr, int& pre) {
    LAS int* slot = (LAS int*)(F.lds + L_QSLOT);
    __syncthreads();
    if (F.tid == 0) {
        *slot = (int)__hip_atomic_fetch_add(ctr, 1u, __ATOMIC_RELAXED, __HIP_MEMORY_SCOPE_AGENT); (void)pre;
    }
    __syncthreads();
    return *slot;
}

namespace att {
constexpr int KSLOT = 12288, VSLOT = 8192, NSLOT = 4;
constexpr int A_K = 0, A_V = NSLOT * KSLOT, A_WS = A_V + NSLOT * VSLOT, A_OST = A_WS + 8 * 256, A_MW = A_OST + 8 * 4096, A_END = A_MW + 8 * NSLOT * 256;
static_assert(A_END <= RING_BYTES, "attention LDS");
typedef short s16x4 __attribute__((ext_vector_type(4)));
__device__ __forceinline__ int crow(int r, int hi) { return (r & 3) + 8 * (r >> 2) + 4 * hi; }
__device__ __forceinline__ void glds16(const void* gsrc, unsigned lds_dst) { unsigned keep;
    asm volatile("s_mov_b32 %0, m0\n\ts_mov_b32 m0, %2\n\ts_nop 0\n\tglobal_load_lds_dwordx4 %1, off\n\ts_mov_b32 m0, %0" : "=&s"(keep) : "v"(gsrc), "s"(lds_dst) : "memory"); }
__device__ __forceinline__ void glds4(const void* gsrc, unsigned lds_dst) { unsigned keep;
    asm volatile("s_mov_b32 %0, m0\n\ts_mov_b32 m0, %2\n\ts_nop 0\n\tglobal_load_lds_dword %1, off\n\ts_mov_b32 m0, %0" : "=&s"(keep) : "v"(gsrc), "s"(lds_dst) : "memory"); }
#define ATT_WAIT_BAR(N) asm volatile("s_waitcnt vmcnt(" #N ") lgkmcnt(0)\n\ts_barrier" ::: "memory")
__device__ __forceinline__ float emax(float a, float b) { return __builtin_elementwise_maximum(a, b); }
__device__ __forceinline__ float halfmax(float m) { auto rr = __builtin_amdgcn_permlane32_swap(__float_as_uint(m), __float_as_uint(m), false, false); return emax(__uint_as_float(rr[0]), __uint_as_float(rr[1])); }
__device__ __forceinline__ float halfsum(float m) { auto rr = __builtin_amdgcn_permlane32_swap(__float_as_uint(m), __float_as_uint(m), false, false); return __uint_as_float(rr[0]) + __uint_as_float(rr[1]); }
typedef short v4i16_t __attribute__((ext_vector_type(4)));
__device__ __forceinline__ s16x4 vtr(const LAS unsigned char* p) { return __builtin_bit_cast(s16x4, __builtin_amdgcn_ds_read_tr16_b64_v4i16((LAS v4i16_t*)p)); }
__device__ __forceinline__ void pv(f32x16* o, f32x16& lacc, const LAS unsigned char* vp, bf16x8 pa0, bf16x8 pa1, bf16x8 pa2, bf16x8 pa3) {
    { const u32x4 one4 = {0x3F803F80u, 0x3F803F80u, 0x3F803F80u, 0x3F803F80u}; const bf16x8 ones = __builtin_bit_cast(bf16x8, one4);
      lacc = __builtin_amdgcn_mfma_f32_32x32x16_bf16(pa0, ones, lacc, 0, 0, 0); lacc = __builtin_amdgcn_mfma_f32_32x32x16_bf16(pa1, ones, lacc, 0, 0, 0);
      lacc = __builtin_amdgcn_mfma_f32_32x32x16_bf16(pa2, ones, lacc, 0, 0, 0); lacc = __builtin_amdgcn_mfma_f32_32x32x16_bf16(pa3, ones, lacc, 0, 0, 0); }
#pragma unroll
    for (int d0 = 0; d0 < 2; ++d0) { s16x4 lo[4], hi[4];
#pragma unroll
        for (int ks = 0; ks < 4; ++ks) { lo[ks] = vtr(vp + d0 * 4096 + ks * 1024); hi[ks] = vtr(vp + d0 * 4096 + ks * 1024 + 512); }
#define ATT_PK(k) (bf16x8){lo[k][0], lo[k][1], lo[k][2], lo[k][3], hi[k][0], hi[k][1], hi[k][2], hi[k][3]}
        o[d0] = __builtin_amdgcn_mfma_f32_32x32x16_bf16(pa0, ATT_PK(0), o[d0], 0, 0, 0);
        o[d0] = __builtin_amdgcn_mfma_f32_32x32x16_bf16(pa1, ATT_PK(1), o[d0], 0, 0, 0);
        o[d0] = __builtin_amdgcn_mfma_f32_32x32x16_bf16(pa2, ATT_PK(2), o[d0], 0, 0, 0);
        o[d0] = __builtin_amdgcn_mfma_f32_32x32x16_bf16(pa3, ATT_PK(3), o[d0], 0, 0, 0);
#undef ATT_PK
    }
}
struct Desc {
    const bf16_t* Q; const bf16_t* K1; const bf16_t* K2; const bf16_t* V; bf16_t* O; float* lse; const unsigned* mask;
    int qpitch, k1pitch, k2pitch, vpitch, opitch, lsepitch;
    int rstride, q0, nq, jlo, jhi;
    int o8;
};
template <int DQK, int MODE>
__device__ __forceinline__ void attn_unit(LAS unsigned char* lds, const Desc& d) {
    int tid_ = threadIdx.x; asm volatile("" : "+v"(tid_));
    const int tid = tid_, lane = tid & 63, r32 = lane & 31, hi = lane >> 5, wid = __builtin_amdgcn_readfirstlane(tid >> 6);
    constexpr int ND = DQK / 16;
    const unsigned lds0 = (unsigned)(size_t)lds;
    LAS float* wsf = (LAS float*)(lds + A_WS) + wid * 64;
    const int qw = d.q0 + wid * 32;
    const bool wvalid = wid * 32 < d.nq;
    const int kkey = 8 * wid + (lane >> 3), kch = (lane & 7) ^ ((kkey >> 1) & 7);
    const bf16_t* ksrc = d.K1 + (size_t)kkey * d.rstride * d.k1pitch + kch * 8;
    const int k2key = 16 * (wid & 3) + (lane >> 2), k2ch = (lane & 3) ^ ((k2key >> 2) & 3);
    const bf16_t* k2src = (DQK == 96) ? d.K2 + (size_t)k2key * d.rstride * d.k2pitch + k2ch * 8 : nullptr;
    int kofs[ND];
#pragma unroll
    for (int d0 = 0; d0 < ND; ++d0) kofs[d0] = d0 < 4 ? r32 * 128 + (((2 * d0 + hi) ^ ((r32 >> 1) & 7)) * 16) : 8192 + r32 * 64 + (((2 * (d0 - 4) + hi) ^ ((r32 >> 2) & 3)) * 16);
    const bf16_t* vsrc = d.V + (size_t)(16 * (wid & 3) + (lane >> 2)) * d.rstride * d.vpitch + (wid >> 2) * 32 + (lane & 3) * 8;
    const size_t kstep = (size_t)64 * d.rstride * d.k1pitch, k2step = (size_t)64 * d.rstride * d.k2pitch, vstep = (size_t)64 * d.rstride * d.vpitch;
    const bool two = (DQK == 96) && wid < 4;
    const unsigned* msrc = (MODE == 2) ? d.mask + (size_t)(wvalid ? (qw + (lane >> 1)) : d.q0) * 64 + (lane & 1) : nullptr;
#define ATT_ISSUE(j) do { const int sl_ = (j) % NSLOT; \
        glds16(ksrc + (size_t)(j) * kstep, (unsigned)__builtin_amdgcn_readfirstlane(lds0 + A_K + sl_ * KSLOT + wid * 1024)); \
        if (two) glds16(k2src + (size_t)(j) * k2step, (unsigned)__builtin_amdgcn_readfirstlane(lds0 + A_K + sl_ * KSLOT + (8 + wid) * 1024)); \
        glds16(vsrc + (size_t)(j) * vstep, (unsigned)__builtin_amdgcn_readfirstlane(lds0 + A_V + sl_ * VSLOT + wid * 1024)); \
        if (MODE == 2) glds4(msrc + 2 * (j), (unsigned)__builtin_amdgcn_readfirstlane(lds0 + A_MW + (wid * NSLOT + sl_) * 256)); } while (0)
    ATT_ISSUE(d.jlo);
    if (d.jlo + 1 < d.jhi) ATT_ISSUE(d.jlo + 1);
    bf16x8 qr[ND];
    { const int qi = wvalid ? (qw + r32) : d.q0; const bf16_t* qp = d.Q + (size_t)qi * d.rstride * d.qpitch + hi * 8;
#pragma unroll
      for (int d0 = 0; d0 < ND; ++d0) qr[d0] = *(const bf16x8*)(qp + d0 * 16); }
#pragma unroll
    for (int d0 = 0; d0 < ND; ++d0) asm volatile("" : "+v"(qr[d0]));
    float mhat = 0.f; f32x16 o[2]; o[0] = f32x16{}; o[1] = f32x16{}; f32x16 lacc = f32x16{};
    bool started = false;
    const LAS unsigned char* vp0 = lds + A_V + ((lane >> 4) & 1) * 32 + (lane & 3) * 8 + (4 * hi + ((lane & 15) >> 2)) * 64;
    const int qi = qw + r32;
    f32x16 p0 = f32x16{}, p1 = f32x16{};
    f32x16 negm = f32x16{};
#define ATT_REL(j) (wvalid && (64 * (j) <= qw + 31) && (MODE != 1 || (64 * (j) + 63 >= qw - 128)))
#define ATT_QK(j) do { const int sl_ = (j) % NSLOT; \
        const LAS unsigned char* kb = lds + A_K + sl_ * KSLOT; bf16x8 kf[2 * ND]; \
        _Pragma("unroll") for (int d0 = 0; d0 < ND; ++d0) { kf[2 * d0] = *(const LAS bf16x8*)(kb + kofs[d0]); kf[2 * d0 + 1] = *(const LAS bf16x8*)(kb + kofs[d0] + (d0 < 4 ? 4096 : 2048)); } \
        __builtin_amdgcn_sched_barrier(0); \
        _Pragma("unroll") for (int d0 = 0; d0 < ND; ++d0) { \
            if (d0 == 0) { p0 = __builtin_amdgcn_mfma_f32_32x32x16_bf16(kf[0], qr[0], negm, 0, 0, 0); p1 = __builtin_amdgcn_mfma_f32_32x32x16_bf16(kf[1], qr[0], negm, 0, 0, 0); } \
            else { p0 = __builtin_amdgcn_mfma_f32_32x32x16_bf16(kf[2 * d0], qr[d0], p0, 0, 0, 0); p1 = __builtin_amdgcn_mfma_f32_32x32x16_bf16(kf[2 * d0 + 1], qr[d0], p1, 0, 0, 0); } } } while (0)
#define ATT_SMPV(j) do { const int sl_ = (j) % NSLOT; \
        { bool domask = true; unsigned mx_ = 0u, my_ = 0u;        \
          if (MODE == 2) { const u32x2 mw = *(const LAS u32x2*)(lds + A_MW + (wid * NSLOT + sl_) * 256 + r32 * 8); mx_ = mw.x; my_ = mw.y; } \
          else { \
            bool full = (64 * (j) + 63 <= qw); \
            if (MODE == 1) full = full && (64 * (j) >= qw + 31 - 128); \
            domask = !full; \
            if (domask) { const int a_ = qi - 64 * (j), lo_ = (MODE == 1) ? a_ - 128 : -4096;        \
                { const int h_ = a_ < 31 ? a_ : 31, l_ = lo_ > 0 ? lo_ : 0; mx_ = (h_ < l_) ? 0u : ((0xFFFFFFFFu >> (31 - h_)) & (0xFFFFFFFFu << l_)); } \
                { const int h_ = a_ - 32 < 31 ? a_ - 32 : 31, l_ = lo_ - 32 > 0 ? lo_ - 32 : 0; my_ = (h_ < l_) ? 0u : ((0xFFFFFFFFu >> (31 - h_)) & (0xFFFFFFFFu << l_)); } } \
          } \
          if (domask) { const unsigned w0 = mx_ >> (4 * hi), w1 = my_ >> (4 * hi); \
            _Pragma("unroll") for (int r = 0; r < 16; ++r) { const int bit = (r & 3) + 8 * (r >> 2); \
                const unsigned m0 = (unsigned)__builtin_amdgcn_sbfe((int)w0, bit, 1), m1 = (unsigned)__builtin_amdgcn_sbfe((int)w1, bit, 1);        \
                p0[r] = __uint_as_float((m0 & __float_as_uint(p0[r])) | (~m0 & 0xFF800000u)); p1[r] = __uint_as_float((m1 & __float_as_uint(p1[r])) | (~m1 & 0xFF800000u)); } } } \
        float rm = emax(p0[0], p1[0]), rm2 = emax(p0[1], p1[1]); \
        _Pragma("unroll") for (int r = 2; r < 16; r += 2) { rm = emax(emax(rm, p0[r]), p1[r]); rm2 = emax(emax(rm2, p0[r + 1]), p1[r + 1]); } \
        rm = halfmax(emax(rm, rm2)); \
        bool need; float dl; \
        if (!started) { need = true; dl = emax(rm, -200.f); } else { need = __any(rm > 8.f) != 0; dl = emax(rm, 0.f); } \
        if (need) { mhat += dl; \
            _Pragma("unroll") for (int r = 0; r < 16; ++r) negm[r] = -mhat; \
            _Pragma("unroll") for (int r = 0; r < 16; ++r) { p0[r] -= dl; p1[r] -= dl; } \
            if (started) { const float f = __builtin_amdgcn_exp2f(-dl); \
                if (hi == 0) wsf[r32] = f; \
                LDS_WAIT(); \
                _Pragma("unroll") for (int r = 0; r < 16; ++r) { const float fr_ = wsf[crow(r, hi)]; o[0][r] *= fr_; o[1][r] *= fr_; lacc[r] *= fr_; } } } \
        started = true; \
        __builtin_amdgcn_s_setprio(1);        \
        _Pragma("unroll") for (int r = 0; r < 16; ++r) { p0[r] = __builtin_amdgcn_exp2f(p0[r]); p1[r] = __builtin_amdgcn_exp2f(p1[r]); } \
        const u32x4 pw0 = (u32x4){cvt_pk_bf16(p0[0], p0[1]), cvt_pk_bf16(p0[2], p0[3]), cvt_pk_bf16(p0[4], p0[5]), cvt_pk_bf16(p0[6], p0[7])}; \
        const u32x4 pw1 = (u32x4){cvt_pk_bf16(p0[8], p0[9]), cvt_pk_bf16(p0[10], p0[11]), cvt_pk_bf16(p0[12], p0[13]), cvt_pk_bf16(p0[14], p0[15])}; \
        const u32x4 pw2 = (u32x4){cvt_pk_bf16(p1[0], p1[1]), cvt_pk_bf16(p1[2], p1[3]), cvt_pk_bf16(p1[4], p1[5]), cvt_pk_bf16(p1[6], p1[7])}; \
        const u32x4 pw3 = (u32x4){cvt_pk_bf16(p1[8], p1[9]), cvt_pk_bf16(p1[10], p1[11]), cvt_pk_bf16(p1[12], p1[13]), cvt_pk_bf16(p1[14], p1[15])}; \
        pv(o, lacc, vp0 + sl_ * VSLOT, __builtin_bit_cast(bf16x8, pw0), __builtin_bit_cast(bf16x8, pw1), __builtin_bit_cast(bf16x8, pw2), __builtin_bit_cast(bf16x8, pw3)); \
        __builtin_amdgcn_s_setprio(0); } while (0)
#define ATT_TOPWAIT(j) do { if ((j) + 1 < d.jhi) { if (MODE == 2 || two) { ATT_WAIT_BAR(3); } else { ATT_WAIT_BAR(2); } } else { ATT_WAIT_BAR(0); } } while (0)
    if (wid < 4) {
        for (int j = d.jlo; j < d.jhi; ++j) {
            ATT_TOPWAIT(j);
            if (j + 2 < d.jhi) ATT_ISSUE(j + 2);
            if (ATT_REL(j)) { ATT_QK(j); ATT_SMPV(j); }
        }
        asm volatile("s_waitcnt lgkmcnt(0)\n\ts_barrier" ::: "memory");
    } else {
        ATT_TOPWAIT(d.jlo);
        if (d.jlo + 2 < d.jhi) ATT_ISSUE(d.jlo + 2);
        if (ATT_REL(d.jlo)) ATT_QK(d.jlo);
        for (int j = d.jlo + 1; j < d.jhi; ++j) {
            ATT_TOPWAIT(j);
            if (j + 2 < d.jhi) ATT_ISSUE(j + 2);
            if (ATT_REL(j - 1)) ATT_SMPV(j - 1);
            if (ATT_REL(j)) ATT_QK(j);
        }
        asm volatile("s_waitcnt lgkmcnt(0)\n\ts_barrier" ::: "memory");
        if (ATT_REL(d.jhi - 1)) ATT_SMPV(d.jhi - 1);
    }
#undef ATT_REL
#undef ATT_QK
#undef ATT_SMPV
#undef ATT_TOPWAIT
#undef ATT_ISSUE
    if (wvalid) {
        LAS bf16_t* stg = (LAS bf16_t*)(lds + A_OST) + wid * 2048;
        if (d.lse != nullptr && r32 == 0) {
#pragma unroll
            for (int r = 0; r < 16; ++r) wsf[32 + crow(r, hi)] = lacc[r]; }
        if (d.o8) {
            LAS unsigned char* stg8 = (LAS unsigned char*)stg;
#pragma unroll
            for (int r = 0; r < 16; ++r) { const int orow = crow(r, hi); const float rl = __builtin_amdgcn_rcpf(lacc[r]) * 32.f;
                const unsigned p = (unsigned)__builtin_amdgcn_cvt_pk_fp8_f32(o[0][r] * rl, o[1][r] * rl, 0, false);
                stg8[orow * 64 + r32] = (unsigned char)(p & 0xffu); stg8[orow * 64 + 32 + r32] = (unsigned char)((p >> 8) & 0xffu); }
            LDS_WAIT();
#pragma unroll
            for (int i = 0; i < 2; ++i) { const int row = i * 16 + (lane >> 2), ch = lane & 3; const u32x4 v = *(const LAS u32x4*)(stg8 + row * 64 + ch * 16);
                *(u32x4*)((unsigned char*)d.O + (size_t)(qw + row) * d.rstride * d.opitch + ch * 16) = v; }
        } else {
#pragma unroll
        for (int r = 0; r < 16; ++r) { const int orow = crow(r, hi); const float rl = __builtin_amdgcn_rcpf(lacc[r]);
            stg[orow * 64 + r32] = (bf16_t)f2bf(o[0][r] * rl); stg[orow * 64 + 32 + r32] = (bf16_t)f2bf(o[1][r] * rl); }
        LDS_WAIT();
#pragma unroll
        for (int i = 0; i < 4; ++i) { const int row = i * 8 + (lane >> 3), ch = lane & 7; const u32x4 v = *(const LAS u32x4*)(stg + row * 64 + ch * 8);
            *(u32x4*)(d.O + (size_t)(qw + row) * d.rstride * d.opitch + ch * 8) = v; }
        }
        if (d.lse != nullptr && hi == 0) d.lse[(size_t)(qw + r32) * d.rstride * d.lsepitch] = mhat + __builtin_amdgcn_logf(wsf[32 + r32]);
    }
    asm volatile("s_waitcnt lgkmcnt(0)\n\ts_barrier" ::: "memory");
}
}

namespace idx {
constexpr int KS = 8192, I_K = 0, I_ST = 3 * KS, I_END = I_ST + 8 * 8192;
static_assert(I_END <= RING_BYTES, "indexer LDS");
__device__ __forceinline__ void score_unit(LAS unsigned char* lds, const bf16_t* PROJ, float* SC, int b, int qh  , int jg) {
    int tid_ = threadIdx.x; asm volatile("" : "+v"(tid_));
    const int tid = tid_, lane = tid & 63, r32 = lane & 31, hi = lane >> 5, wid = __builtin_amdgcn_readfirstlane(tid >> 6);
    const int qg = wid >> 1, hh = wid & 1;
    const unsigned lds0 = (unsigned)(size_t)lds;
    const int qrow = b * SEQ + qh * 128 + qg * 32 + r32;
    const bf16_t* kbase = PROJ + (size_t)(b * SEQ) * PW + 3968;
    const int kkey = 8 * wid + (lane >> 3);
    const bf16_t* ksrc = kbase + (size_t)kkey * PW + ((lane & 7) ^ ((kkey >> 1) & 7)) * 8;
    const int j0 = 4 * jg;
#define IDX_ISSUE(j) att::glds16(ksrc + (size_t)(j) * 64 * PW, (unsigned)__builtin_amdgcn_readfirstlane(lds0 + I_K + ((j) % 3) * KS + wid * 1024))
    IDX_ISSUE(j0); IDX_ISSUE(j0 + 1);
    bf16x8 qf[4][4]; float wv[4];
    { const bf16_t* qp = PROJ + (size_t)qrow * PW + 3328 + hh * 256 + hi * 8;
#pragma unroll
      for (int h = 0; h < 4; ++h)
#pragma unroll
          for (int d0 = 0; d0 < 4; ++d0) qf[h][d0] = *(const bf16x8*)(qp + h * 64 + d0 * 16);
      const u32x2 ww = *(const u32x2*)(PROJ + (size_t)qrow * PW + 4032 + hh * 4);
      wv[0] = bflo(ww.x); wv[1] = bfhi(ww.x); wv[2] = bflo(ww.y); wv[3] = bfhi(ww.y); }
#pragma unroll
    for (int h = 0; h < 4; ++h) { asm volatile("" : "+v"(wv[h]));
#pragma unroll
        for (int d0 = 0; d0 < 4; ++d0) asm volatile("" : "+v"(qf[h][d0])); }
    const int qb = qh >> 1;
    unsigned* blk = (unsigned*)SC + ((size_t)b * 36 + (size_t)(qb * (qb + 1) / 2)) * 32768; const int pitch = 128 * (qb + 1);
    f32x4 ve[4] = {};
    LAS unsigned char* stg = lds + I_ST + wid * 8192;
    const LAS unsigned char* stg2 = lds + I_ST + (wid ^ 1) * 8192;
#pragma nounroll
    for (int jj = 0; jj < 4; ++jj) { const int j = j0 + jj;
        if (jj < 2) { ATT_WAIT_BAR(1); } else if (jj == 2) { ATT_WAIT_BAR(5); } else { ATT_WAIT_BAR(4); }
        if (jj + 2 < 4) IDX_ISSUE(j + 2);
        const LAS unsigned char* kb = lds + I_K + (j % 3) * KS + r32 * 128;
#pragma nounroll
        for (int half = 0; half < 2; ++half) {
            bf16x8 kf[4];
#pragma unroll
            for (int d0 = 0; d0 < 4; ++d0) kf[d0] = *(const LAS bf16x8*)(kb + half * 4096 + (((2 * d0 + hi) ^ ((r32 >> 1) & 7)) * 16));
            f32x16 t0 = f32x16{};
#pragma unroll
            for (int h = 0; h < 4; ++h) {
                f32x16 p0 = f32x16{};
#pragma unroll
                for (int d0 = 0; d0 < 4; ++d0) p0 = __builtin_amdgcn_mfma_f32_32x32x16_bf16(kf[d0], qf[h][d0], p0, 0, 0, 0);
#pragma unroll
                for (int r = 0; r < 16; ++r) t0[r] += wv[h] * att::emax(p0[r], 0.f);
            }
#pragma unroll
            for (int g = 0; g < 4; ++g) { const int c0 = 8 * half + 2 * g + hi;
                *(LAS f32x4*)(stg + r32 * 256 + ((c0 ^ (r32 & 15)) * 16)) = (f32x4){t0[4 * g], t0[4 * g + 1], t0[4 * g + 2], t0[4 * g + 3]}; }
        }
        asm volatile("s_waitcnt lgkmcnt(0)\n\ts_barrier" ::: "memory");
#pragma unroll
        for (int i = 0; i < 4; ++i) { const int q = hh * 16 + i * 4 + (lane >> 4), c = lane & 15; const int so = q * 256 + ((c ^ (q & 15)) * 16);
            const f32x4 v = *(const LAS f32x4*)(stg + so) + *(const LAS f32x4*)(stg2 + so);
            if (jj & 1) { const f32x4 e = ve[i]; const u32x4 w = {pk2(e[0], v[0]), pk2(e[1], v[1]), pk2(e[2], v[2]), pk2(e[3], v[3])};
                *(u32x4*)(blk + (size_t)((qh & 1) * 128 + qg * 32 + q) * pitch + 64 * (j >> 1) + 4 * c) = w; }
            else ve[i] = v; }
        LDS_WAIT();
    }
#undef IDX_ISSUE
    asm volatile("s_waitcnt lgkmcnt(0)\n\ts_barrier" ::: "memory");
}

__device__ __forceinline__ int wave_sum_i(int v) {
    v += __builtin_amdgcn_update_dpp(0, v, 0xB1, 0xF, 0xF, true);
    v += __builtin_amdgcn_update_dpp(0, v, 0x4E, 0xF, 0xF, true);
    v += __builtin_amdgcn_update_dpp(0, v, 0x141, 0xF, 0xF, true);
    v += __builtin_amdgcn_update_dpp(0, v, 0x140, 0xF, 0xF, true);
    return __builtin_amdgcn_readlane(v, 0) + __builtin_amdgcn_readlane(v, 16) + __builtin_amdgcn_readlane(v, 32) + __builtin_amdgcn_readlane(v, 48);
}
__device__ __forceinline__ unsigned long long keep_low(unsigned long long m, int k) { while (__builtin_popcountll(m) > k) m &= ~(1ull << (63 - __builtin_clzll(m))); return m; }
__device__ __forceinline__ void select_rows4(const float* SC, unsigned* MASK, int row0  , int lane, LAS unsigned* slot  ) {
    const int b = row0 / SEQ, t0 = row0 % SEQ, qb = t0 >> 8;
    if (t0 < 256) {
#pragma unroll 1
        for (int i = 0; i < 4; ++i) { const int t = t0 + i, lo = 64 * lane;
            const unsigned long long w = (lo + 63 <= t) ? ~0ull : (lo > t ? 0ull : ((2ull << (t - lo)) - 1ull));
            if (lane < 32) ((unsigned long long*)(MASK + (size_t)(row0 + i) * 64))[lane] = w; }
        return;
    }
    const int pitch = 128 * (qb + 1), pmax = pitch - 1;
    const unsigned* srow0 = (const unsigned*)SC + ((size_t)b * 36 + (size_t)(qb * (qb + 1) / 2)) * 32768 + (size_t)(t0 - 256 * qb) * pitch;
    unsigned raw[16];
#pragma unroll
    for (int i = 0; i < 16; ++i) { const int s_ = 64 * i + lane; raw[i] = srow0[s_ < pmax ? s_ : pmax]; }
#pragma unroll 1
    for (int r = 0; r < 4; ++r) {
        const int t = t0 + r;
        unsigned P[16];
#pragma unroll
        for (int i = 0; i < 16; ++i) P[i] = raw[i];
        { const unsigned* nx = srow0 + (size_t)(r < 3 ? r + 1 : 3) * pitch;
#pragma unroll
          for (int i = 0; i < 16; ++i) { const int s_ = 64 * i + lane; raw[i] = nx[s_ < pmax ? s_ : pmax]; } }
#define SEL_TSTAGE(sh, m) _Pragma("unroll") for (int q = 0; q < 16; ++q) if (!(q & (sh))) { const unsigned a_ = P[q], b_ = P[q + (sh)]; \
            P[q] = (a_ & (m)) | ((b_ << (sh)) & ~(m)); P[q + (sh)] = ((a_ >> (sh)) & (m)) | (b_ & ~(m)); }
        SEL_TSTAGE(8, 0x00FF00FFu) SEL_TSTAGE(4, 0x0F0F0F0Fu) SEL_TSTAGE(2, 0x33333333u) SEL_TSTAGE(1, 0x55555555u)
#undef SEL_TSTAGE
        { const unsigned sg = P[15];
#pragma unroll
          for (int q = 0; q < 15; ++q) P[q] ^= sg;
          P[15] = ~sg; }
        const int nj = ((t - lane) >> 6) + 1;
        unsigned A = ((1u << ((nj + 1) >> 1)) - 1u) | (((1u << (nj >> 1)) - 1u) << 16), G = 0u;
        int cab = 0, cntA = t + 1;
#pragma unroll
        for (int bit = 15; bit >= 0; --bit) {
            if (cab + cntA != 256) {
                const unsigned ones = A & P[bit];
                const int c = wave_sum_i(__builtin_popcount(ones));
                if (cab + c >= 256) { A = ones; cntA = c; } else { G |= ones; cab += c; A &= ~ones; cntA -= c; }
            }
        }
        int need = 256 - cab;
        unsigned sel = G | A;
        if (cntA != need) {
            unsigned selA = 0u;
#pragma nounroll
            for (int j = 0; j < 32; ++j) { const int pb = (j >> 1) + 16 * (j & 1);
                unsigned long long m = __ballot((A >> pb) & 1u);
                if (__builtin_popcountll(m) > need) m = keep_low(m, need);
                need -= __builtin_popcountll(m);
                selA |= (unsigned)((m >> lane) & 1ull) << pb;
            }
            sel = G | selA;
        }
        int lo = 0, hi = 0;
#pragma unroll
        for (int j = 0; j < 32; ++j) { const unsigned long long m = __ballot((sel >> ((j >> 1) + 16 * (j & 1))) & 1u);
            lo = (lane == j) ? (int)(unsigned)m : lo; hi = (lane == j) ? (int)(unsigned)(m >> 32) : hi; }
        if (lane < 32) ((unsigned long long*)(MASK + (size_t)(row0 + r) * 64))[lane] = (unsigned long long)(unsigned)lo | ((unsigned long long)(unsigned)hi << 32);
    }
}
}

__device__ __forceinline__ unsigned* queue_word(Frame& F, int l, int chunk, int q) { return (unsigned*)(F.ws + WS_CTL) + CW_QUEUE + 64 * ((l * NCHUNK + chunk) * 4 + q); }

__device__ __forceinline__ void phase_proj(Frame& F, int l, int chunk) {
    PHASE_IDS(F);
    { LAS float* gb = (LAS float*)(F.lds + L_GB); const float* bg = F.in[7] + (size_t)l * 3072;
      __syncthreads();
      for (int i = F.tid; i < 3072; i += NTHREADS) gb[i] = bg[i];
      VM_WAIT(); LDS_WAIT(); __syncthreads(); }
    pg8::ProjSched8 S{{{(const bf16_t*)(F.ws + WS_XB8 + (size_t)chunk * TC * DM), (const bf16_t*)(F.ws + WS_WIN8), DM / 2, DM / 2, TC / 256, (PW + 3072) / 256, F.G, (int)blockIdx.x}, F8_SW, F8_SA_X}};
    const float* rp = (const float*)(F.ws + WS_ROPE);
    EpiProj E{(bf16_t*)(F.ws + WS_PROJ), rp, rp + 2048 * 8 * 2, (float*)(F.ws + WS_SSQ), (bf16_t*)(F.ws + WS_G3), (const LAS float*)(F.lds + L_GB)};
    pg8::gemm_phase<EpiProj, pg8::ProjSched8, true, true>(F.lds, DM / 2, S, E);
}
__device__ __forceinline__ void dilated_unit(Frame& F, int u) {
    const bf16_t* PROJ = (const bf16_t*)(F.ws + WS_PROJ); bf16_t* OG = (bf16_t*)(F.ws + WS_OG); float* LSE = (float*)(F.ws + WS_LSE);
    constexpr int N_G0 = NBC * 4 * 8, N_G1 = NBC * 4 * 4 * 2;
    int g, b, h, res, qb, dil, nq;
    if (u < N_G0) { g = 0; dil = 1; qb = 7 - u / (NBC * 4); const int bh = u % (NBC * 4); b = bh >> 2; h = bh & 3; res = 0; nq = 256; }
    else if (u < N_G0 + N_G1) { const int v = u - N_G0; g = 1; dil = 4; qb = 1 - v / (NBC * 16); const int x = v % (NBC * 16); b = x >> 4; h = (x >> 2) & 3; res = x & 3; nq = 256; }
    else { const int v = u - N_G0 - N_G1; g = 2; dil = 16; qb = 0; b = v >> 6; h = (v >> 4) & 3; res = v & 15; nq = 128; }
    att::Desc d; const size_t r0 = (size_t)b * SEQ + res;
    const bf16_t* base = PROJ + r0 * PW + 512 + 768 * g + 64 * h;
    d.Q = base; d.K1 = base + 256; d.V = base + 512; d.K2 = nullptr; d.qpitch = d.k1pitch = d.vpitch = PW; d.k2pitch = 0;
    d.O = OG + ((size_t)g * TC + r0) * 256 + 64 * h; d.opitch = 256; d.lse = LSE + ((size_t)g * TC + r0) * 4 + h; d.lsepitch = 4; d.mask = nullptr;
    d.rstride = dil; d.q0 = qb * 256; d.nq = nq; d.o8 = 0;
    if (g == 2) { d.jlo = 0; d.jhi = 2; att::attn_unit<64, 0>(F.lds, d); }
    else { d.jlo = (qb * 4 - 2) > 0 ? (qb * 4 - 2) : 0; d.jhi = 4 * (qb + 1); att::attn_unit<64, 1>(F.lds, d); }
}

__device__ __forceinline__ void phase_up_scores(Frame& F, int l, int chunk) {
    PHASE_IDS(F);
    const bf16_t* PROJ = (const bf16_t*)(F.ws + WS_PROJ);
    const float* rp = (const float*)(F.ws + WS_ROPE);
    {   pg8::DenseSched S{PROJ, (const bf16_t*)(F.ws + WS_WUQ), PW, 256, TC / 256, 3, F.G, (int)blockIdx.x};
        EpiUpQ E{(bf16_t*)(F.ws + WS_QM), rp + 2048 * 8 * 2, (const float*)(F.ws + WS_SSQ)};
        pg8::gemm_phase<EpiUpQ, pg8::DenseSched, true>(F.lds, 256, S, E); }
    {   pg8::DenseSched S{PROJ + 256, (const bf16_t*)(F.ws + WS_WUKV), PW, 256, TC / 256, 4, F.G, (int)blockIdx.x};
        EpiUpKV E{(bf16_t*)(F.ws + WS_KVM), (const float*)(F.ws + WS_SSQ)};
        pg8::gemm_phase<EpiUpKV, pg8::DenseSched, true>(F.lds, 256, S, E); }
    unsigned* qw = queue_word(F, l, chunk, 0); int pre = -1;
    for (;;) {
        const int u = dequeue(F, qw, pre);
        if (u < NBC * 64) { dilated_unit(F, u); continue; }
        if (u >= NBC * 64 + NBC * 72 + NBC * 64) break;
        if (u >= NBC * 64 + NBC * 72) { dilated_unit(F, u - NBC * 72); continue; }
        const int v = u - NBC * 64; const int b = v / 72; int r = v % 72, qh = 0; while (r > (qh >> 1)) { r -= (qh >> 1) + 1; ++qh; }
        idx::score_unit(F.lds, PROJ, (float*)(F.ws + WS_SC), b, qh, r);
    }
}
__device__ __forceinline__ void phase_attn1(Frame& F, int l, int chunk, int tmask = 7) {
    PHASE_IDS(F);
    const bf16_t* PROJ = (const bf16_t*)(F.ws + WS_PROJ); const bf16_t* QM = (const bf16_t*)(F.ws + WS_QM); const bf16_t* KVM = (const bf16_t*)(F.ws + WS_KVM);
    bf16_t* OA = (bf16_t*)(F.ws + WS_OA); bf16_t* OG = (bf16_t*)(F.ws + WS_OG); float* LSE = (float*)(F.ws + WS_LSE);
    constexpr int N_MLA = NBC * 8 * 8, N_SEL = TC / 32;
    unsigned* qw = queue_word(F, l, chunk, 1); int pre = -1;
    for (;;) {
        int u = dequeue(F, qw, pre);
        if (u < N_MLA) {
            if (!(tmask & 1)) continue;
            const int qb = 7 - u / (NBC * 8), bh = u % (NBC * 8), b = bh >> 3, h = bh & 7;
            att::Desc d; const size_t r0 = (size_t)b * SEQ;
            d.Q = QM + r0 * 768 + h * 96; d.qpitch = 768; d.K1 = KVM + r0 * 1024 + h * 128; d.k1pitch = 1024; d.K2 = PROJ + r0 * PW + 384; d.k2pitch = PW;
            d.V = KVM + r0 * 1024 + h * 128 + 64; d.vpitch = 1024; d.O = (bf16_t*)((unsigned char*)OA + r0 * 512 + h * 64); d.opitch = 512; d.o8 = 1; d.lse = nullptr; d.lsepitch = 0; d.mask = nullptr;
            d.rstride = 1; d.q0 = qb * 256; d.nq = 256; d.jlo = 0; d.jhi = 4 * (qb + 1);
            att::attn_unit<96, 0>(F.lds, d); continue; }
        u -= N_MLA;
        if (u >= N_SEL) break;
        if (!(tmask & 4)) continue;
        idx::select_rows4((const float*)(F.ws + WS_SC), (unsigned*)(F.ws + WS_MASK), u * 32 + F.wave * 4, F.lane, (LAS unsigned*)(F.lds + L_GB) + F.wave * 64);
    }
}
__device__ __forceinline__ void phase_attn2(Frame& F, int l, int chunk) {
    PHASE_IDS(F);
    const bf16_t* PROJ = (const bf16_t*)(F.ws + WS_PROJ);
    bf16_t* OC = (bf16_t*)(F.ws + WS_OC);
    unsigned* qw = queue_word(F, l, chunk, 2); int pre = -1;
    for (;;) {
        const int u = dequeue(F, qw, pre);
        if (u >= NBC * 64) break;
        const int qb = 7 - u / (NBC * 8), bh = u % (NBC * 8), b = bh >> 3, h = bh & 7;
        att::Desc d; const size_t r0 = (size_t)b * SEQ;
        d.Q = PROJ + r0 * PW + 2816 + 64 * h; d.K1 = PROJ + r0 * PW + 3840; d.V = PROJ + r0 * PW + 3904; d.K2 = nullptr; d.qpitch = d.k1pitch = d.vpitch = PW; d.k2pitch = 0;
        d.O = (bf16_t*)((unsigned char*)OC + r0 * 512 + 64 * h); d.opitch = 512; d.o8 = 1; d.lse = nullptr; d.lsepitch = 0; d.mask = (const unsigned*)(F.ws + WS_MASK) + r0 * 64;
        d.rstride = 1; d.q0 = qb * 256; d.nq = 256; d.jlo = 0; d.jhi = 4 * (qb + 1);
        att::attn_unit<64, 2>(F.lds, d);
    }
    const bf16_t* OG = (const bf16_t*)(F.ws + WS_OG); const float* LSE = (const float*)(F.ws + WS_LSE); bf16_t* OB = (bf16_t*)(F.ws + WS_OB);
    const int gw = F.vcu * NWAVES + F.wave, NGW = F.G * NWAVES, h = F.lane >> 4;
    for (int row = gw; row < TC; row += NGW) {
        const float l0 = LSE[(size_t)row * 4 + h], l1 = LSE[((size_t)TC + row) * 4 + h], l2 = LSE[((size_t)2 * TC + row) * 4 + h];
        const float mx = fmaxf(l0, fmaxf(l1, l2));
        float w0 = __builtin_amdgcn_exp2f(l0 - mx), w1 = __builtin_amdgcn_exp2f(l1 - mx), w2 = __builtin_amdgcn_exp2f(l2 - mx);
        const float inv = 1.0f / (w0 + w1 + w2); w0 *= inv; w1 *= inv; w2 *= inv;
        const u32x2 a = *(const u32x2*)(OG + (size_t)row * 256 + F.lane * 4), bq = *(const u32x2*)(OG + ((size_t)TC + row) * 256 + F.lane * 4), c = *(const u32x2*)(OG + ((size_t)2 * TC + row) * 256 + F.lane * 4);
        w0 *= 32.f; w1 *= 32.f; w2 *= 32.f;
        *(unsigned*)((unsigned char*)OB + (size_t)row * 512 + F.lane * 4) = pk4_fp8(w0 * bflo(a.x) + w1 * bflo(bq.x) + w2 * bflo(c.x), w0 * bfhi(a.x) + w1 * bfhi(bq.x) + w2 * bfhi(c.x),
                                                                                    w0 * bflo(a.y) + w1 * bflo(bq.y) + w2 * bflo(c.y), w0 * bfhi(a.y) + w1 * bfhi(bq.y) + w2 * bfhi(c.y));
    }
}
__device__ __forceinline__ void phase_branches(Frame& F, int l, int chunk) {
    PHASE_IDS(F);
    static_assert(WS_OB - WS_OA == WS_OC - WS_OB && WS_WB - WS_WA == WS_WC - WS_WB, "equally spaced branch operands");
    BranchSched S{(const char*)(F.ws + WS_OA), (const char*)(F.ws + WS_WA), WS_OB - WS_OA, WS_WB - WS_WA, 256, 256, (int)blockIdx.x, F8_SW, 127 - 5, F.G, (TC / 256) * 4};
    EpiBranchAll E{(bf16_t*)(F.ws + WS_MERGED), (bf16_t*)(F.ws + WS_M0), (bf16_t*)(F.ws + WS_M1), (const bf16_t*)(F.ws + WS_G3)};
    pg8::gemm_phase<EpiBranchAll, BranchSched, true, true>(F.lds, 256, S, E);
}
__device__ __forceinline__ void phase_wo(Frame& F, int l, int chunk) {
    PHASE_IDS(F);
    pg8::DenseSched8 S{{(const bf16_t*)(F.ws + WS_MERGED), (const bf16_t*)(F.ws + WS_WO), DM / 2, DM / 2, TC / 256, 4, F.G, (int)blockIdx.x}, F8_SW, 127 - 6};
    EpiWo E{F.out, l == 0 ? F.in[0] : F.out, chunk * TC};
    pg8::gemm_phase<EpiWo, pg8::DenseSched8, true, true>(F.lds, DM / 2, S, E);
}

__global__ void __launch_bounds__(NTHREADS, 2) fwd_kernel(Args args) {
    extern __shared__ __attribute__((aligned(16))) unsigned char lds_raw[];
    Frame F;
    F.lds = (LAS unsigned char*)lds_raw;
    F.tid = threadIdx.x; F.lane = F.tid & 63; F.wave = __builtin_amdgcn_readfirstlane(F.tid >> 6);
    F.G = gridDim.x; { const int bx = blockIdx.x; F.vcu = (F.G % 8 == 0) ? (bx % 8) * (F.G / 8) + bx / 8 : bx; }
    F.in.p = (intab_t)__builtin_amdgcn_kernarg_segment_ptr(); F.out = args.out; F.ws = args.ws; F.out0 = args.out; F.ws0 = args.ws;
    for (int u = F.tid; u < (LDS_BYTES - L_CTL) / 4; u += NTHREADS) ((LAS unsigned*)(F.lds + L_CTL))[u] = 0u;
    __syncthreads();
    XcdBarrier bar = xcd_barrier_post((unsigned*)(F.ws + WS_CTL) + CW_BAR, (volatile LAS unsigned*)(F.lds + L_BARW));
#define GRID_BAR() xcd_barrier(bar)

    for (int l = 0; l < 2; ++l) {
        phase_conv_moe(F, l);
        phase_conv_mixer(F, l);
        GRID_BAR();
        for (int chunk = 0; chunk < NCHUNK; ++chunk) {
            phase_proj(F, l, chunk);
            GRID_BAR();
            if (DUPMASK & 2) { phase_proj(F, l, chunk); GRID_BAR(); }
            phase_up_scores(F, l, chunk);
            GRID_BAR();
            if (DUPMASK & 4) { phase_up_scores(F, l + 2, chunk); GRID_BAR(); }
            phase_attn1(F, l, chunk);
            GRID_BAR();
            if (DUPMASK & 8) { phase_attn1(F, l + 2, chunk); GRID_BAR(); }
            if (DUPMASK & 0x700) { phase_attn1(F, l + 2, chunk, (DUPMASK >> 8) & 7); GRID_BAR(); }
            phase_attn2(F, l, chunk);
            GRID_BAR();
            if (DUPMASK & 16) { phase_attn2(F, l + 2, chunk); GRID_BAR(); }
            phase_branches(F, l, chunk);
            GRID_BAR();
            if (DUPMASK & 32) { phase_branches(F, l, chunk); GRID_BAR(); }
            phase_wo(F, l, chunk);
            if ((DUPMASK & 0x800) && l == 0) { GRID_BAR(); phase_wo(F, l, chunk); }
        }
        GRID_BAR();
        phase_ln1_router(F, l, F.out, false);
        GRID_BAR();
        phase_moe_scatter(F);
        GRID_BAR();
        phase_moe_gemm1(F);
        GRID_BAR();
        if (DUPMASK & 64) { phase_moe_gemm1(F); GRID_BAR(); }
        phase_moe_gemm2(F);
        GRID_BAR();
        if (DUPMASK & 128) { phase_moe_gemm2(F); GRID_BAR(); }
        phase_combine_ln2(F, l);
        GRID_BAR();
    }
}

extern "C" void kernel_launch(void* const* d_in, const int* in_sizes, int n_in, void* d_out, int out_size, void* d_ws, size_t ws_size, hipStream_t stream) {
    static int grid = 0;
    if (grid == 0) {
        if (n_in != 23 || out_size != TT * DM || ws_size < WS_END) { fprintf(stderr, "kernel_launch: unexpected shapes n_in %d out %d ws %zu\n", n_in, out_size, ws_size); grid = -1; return; }
        int dev = 0, cus = 0;
        if (hipGetDevice(&dev) != hipSuccess || hipDeviceGetAttribute(&cus, hipDeviceAttributeMultiprocessorCount, dev) != hipSuccess) { grid = -1; return; }
        if (hipFuncSetAttribute((const void*)fwd_kernel, hipFuncAttributeMaxDynamicSharedMemorySize, LDS_BYTES) != hipSuccess) { fprintf(stderr, "kernel_launch: hipFuncSetAttribute failed\n"); grid = -1; return; }
        int per_cu = 0;
        if (hipOccupancyMaxActiveBlocksPerMultiprocessor(&per_cu, (const void*)fwd_kernel, NTHREADS, LDS_BYTES) != hipSuccess || per_cu < 1) fprintf(stderr, "kernel_launch: occupancy query says %d\n", per_cu);
        (void)hipGetLastError();
        grid = cus;
    }
    if (grid < 0) return;
    if (hipMemsetAsync((char*)d_ws + WS_CTL, 0, CTL_ZERO_BYTES, stream) != hipSuccess) return;
    Args a{};
    for (int i = 0; i < 23; ++i) a.in[i] = (const float*)d_in[i];
    a.out = (float*)d_out; a.ws = (unsigned char*)d_ws;
    hipLaunchKernelGGL(fwd_kernel, dim3(grid), dim3(NTHREADS), LDS_BYTES, stream, a);
}
```

```cpp
#include <hip/hip_runtime.h>
#include <cstdio>
#include <cstdint>

#define LAS __attribute__((address_space(3)))
#define GAS __attribute__((address_space(1)))
typedef unsigned short bf16_t;
typedef short bf16x8 __attribute__((ext_vector_type(8)));
typedef float f32x4 __attribute__((ext_vector_type(4)));
typedef float f32x2 __attribute__((ext_vector_type(2)));
typedef float f32x16 __attribute__((ext_vector_type(16)));
typedef unsigned u32x4 __attribute__((ext_vector_type(4)));
typedef unsigned u32x2 __attribute__((ext_vector_type(2)));

constexpr int DM = 1024, NB = 32, SEQ = 2048, TT = NB * SEQ;
constexpr int NEXP = 32, DEXP = 256;
constexpr float LN_EPS = 1e-6f;
constexpr float ALPHA = 1.41421356237309515f;
constexpr int NWAVES = 8, NTHREADS = 512;

__device__ __forceinline__ unsigned f2bf(float f) { unsigned u = __builtin_bit_cast(unsigned, f); return (u + 0x7fffu + ((u >> 16) & 1u)) >> 16; }
__device__ __forceinline__ unsigned pk2(float lo, float hi) { return f2bf(lo) | (f2bf(hi) << 16); }
__device__ __forceinline__ float bf2f(unsigned short b) { return __builtin_bit_cast(float, (unsigned)b << 16); }
__device__ __forceinline__ float bflo(unsigned w) { return __builtin_bit_cast(float, w << 16); }
__device__ __forceinline__ float bfhi(unsigned w) { return __builtin_bit_cast(float, w & 0xffff0000u); }
typedef __bf16 bf16x2_t __attribute__((ext_vector_type(2)));
__device__ __forceinline__ unsigned cvt_pk_bf16(float lo, float hi) { const f32x2 v = {lo, hi}; const bf16x2_t b = __builtin_convertvector(v, bf16x2_t); return __builtin_bit_cast(unsigned, b); }
__device__ __forceinline__ float wave_sum(float v) {
#pragma unroll
    for (int o = 1; o < 64; o <<= 1) v += __shfl_xor(v, o);
    return v;
}
__device__ __forceinline__ float fast_exp(float x) { return __builtin_amdgcn_exp2f(x * 1.4426950408889634f); }
__device__ __forceinline__ float sigmoidf_(float x) { return __builtin_amdgcn_rcpf(1.0f + fast_exp(-x)); }
__device__ __forceinline__ unsigned pk4_fp8(float a, float b, float c, float d) {
    int p = __builtin_amdgcn_cvt_pk_fp8_f32(a, b, 0, false); p = __builtin_amdgcn_cvt_pk_fp8_f32(c, d, p, true); return (unsigned)p; }
__device__ __forceinline__ void store8_fp8(unsigned char* p, const f32x4& v0, const f32x4& v1, float sc) {
    u32x2 w; w.x = pk4_fp8(v0[0] * sc, v0[1] * sc, v0[2] * sc, v0[3] * sc); w.y = pk4_fp8(v1[0] * sc, v1[1] * sc, v1[2] * sc, v1[3] * sc); *(u32x2*)p = w;
}
#define LDS_WAIT() asm volatile("s_waitcnt lgkmcnt(0)" ::: "memory")
#define VM_WAIT() asm volatile("s_waitcnt vmcnt(0)" ::: "memory")

namespace pg8 {
constexpr int BM = 256, BK = 64, HALF = 128, HTB = HALF * BK * 2, STAGE_BYTES = 8 * HTB;
__device__ __forceinline__ int lds_byte(int r, int c) { return r * 128 + ((((c >> 3) ^ (r >> 1)) & 7) * 16) + (c & 7) * 2; }
__device__ __forceinline__ void stage_rc(int b, int& R, int& C) { R = b >> 7; C = ((((b >> 4) ^ (R >> 1)) & 7)) * 8; }
__device__ __forceinline__ int perm32(int rho) { const int n = rho >> 4, i = rho & 15; return 8 * (i >> 2) + 4 * n + (i & 3); }
struct Unit { int pm, pn, ord; };

template <class S, class = void> struct SchedVarK { static constexpr bool value = false; };
template <class S> struct SchedVarK<S, decltype((void)S::VARK)> { static constexpr bool value = S::VARK; };
typedef int v4i_t __attribute__((ext_vector_type(4)));
typedef int v8i_t __attribute__((ext_vector_type(8)));
__device__ __forceinline__ v8i_t cat8(const bf16x8& lo, const bf16x8& hi) { return __builtin_shufflevector(__builtin_bit_cast(v4i_t, lo), __builtin_bit_cast(v4i_t, hi), 0, 1, 2, 3, 4, 5, 6, 7); }
template <class Epi, class Sched, bool ALIGN_EPI, bool F8 = false>
__device__ __forceinline__ void gemm_phase(LAS unsigned char* lds, const int K, const Sched& S, const Epi& E) {
    int tid_ = threadIdx.x; asm volatile("" : "+v"(tid_));
    const int tid = tid_, wid = __builtin_amdgcn_readfirstlane(tid >> 6), lane = tid & 63, wr = wid >> 2, wc = wid & 3, fr = lane & 15, fq = lane >> 4;
    int nt = K / BK;
    int Rr[2], Cc[2]; unsigned vB[2][2];
#pragma unroll
    for (int i = 0; i < 2; ++i) { stage_rc(tid * 16 + i * 8192, Rr[i], Cc[i]); const int Rb = (Rr[i] & ~31) + perm32(Rr[i] & 31);
        vB[0][i] = (unsigned)(Rb * S.ldb + Cc[i]) * 2u; vB[1][i] = (unsigned)((HALF + Rb) * S.ldb + Cc[i]) * 2u; }
    const size_t kstep = (size_t)(BK * 2);
    const unsigned ldsw = (unsigned)wid * 1024u;
    const int aoff = lds_byte(wr * 64 + fr, fq * 8), boff = lds_byte(wc * 32 + fr, fq * 8);
    const int aoff1 = lds_byte(wr * 64 + fr, fq * 8 + 32), boff1 = lds_byte(wc * 32 + fr, fq * 8 + 32);
#define PG8_SA(b, h) (((b) * 2 + (h)) * HTB)
#define PG8_SB(b, h) ((4 + (b) * 2 + (h)) * HTB)
#define PG8_STAGE(bufoff, gbase, voff) do { _Pragma("unroll") for (int _i = 0; _i < 2; ++_i) \
        __builtin_amdgcn_global_load_lds((const unsigned*)((const char*)(gbase) + (voff)[_i]), (LAS unsigned*)(lds + (bufoff) + ldsw + _i * 8192), 16, 0, 0); } while (0)
#define PG8_LDA(dst, b, h) do { _Pragma("unroll") for (int m = 0; m < 4; ++m) { \
        const bf16x8 f0_ = *(const LAS bf16x8*)(lds + PG8_SA(b, h) + aoff + m * 2048), f1_ = *(const LAS bf16x8*)(lds + PG8_SA(b, h) + aoff1 + m * 2048); \
        if constexpr (F8) dst##8[m] = cat8(f0_, f1_); else { dst[m][0] = f0_; dst[m][1] = f1_; } } } while (0)
#define PG8_LDB(dst, b, h) do { _Pragma("unroll") for (int n = 0; n < 2; ++n) { \
        const bf16x8 f0_ = *(const LAS bf16x8*)(lds + PG8_SB(b, h) + boff + n * 2048), f1_ = *(const LAS bf16x8*)(lds + PG8_SB(b, h) + boff1 + n * 2048); \
        if constexpr (F8) dst##8[n] = cat8(f0_, f1_); else { dst[n][0] = f0_; dst[n][1] = f1_; } } } while (0)
#define PG8_MMA(ai, bj, At, Bt) do { __builtin_amdgcn_s_setprio(1); \
        if constexpr (F8) { _Pragma("unroll") for (int m = 0; m < 4; ++m) _Pragma("unroll") for (int n = 0; n < 2; ++n) \
            asm volatile("v_mfma_scale_f32_16x16x128_f8f6f4 %0, %1, %2, %0, %3, %4 op_sel_hi:[0,0,0]" : "+v"(acc[ai][bj][m][n]) : "v"(Bt##8[n]), "v"(At##8[m]), "v"(scw8), "v"(sca8)); } \
              \
        else { _Pragma("unroll") for (int m = 0; m < 4; ++m) _Pragma("unroll") for (int n = 0; n < 2; ++n) _Pragma("unroll") for (int k = 0; k < 2; ++k) \
            acc[ai][bj][m][n] = __builtin_amdgcn_mfma_f32_16x16x32_bf16(Bt[n][k], At[m][k], acc[ai][bj][m][n], 0, 0, 0); } \
        __builtin_amdgcn_s_setprio(0); } while (0)
#define PG8_WAIT_V(n) asm volatile("s_waitcnt vmcnt(" #n ")" ::: "memory")
#define PG8_WAIT_L(n) asm volatile("s_waitcnt lgkmcnt(" #n ")" ::: "memory")
#define PG8_BAR __builtin_amdgcn_s_barrier()
#define PG8_SCHED __builtin_amdgcn_sched_barrier(0)
    int scw8 = 0, sca8 = 0;
    if constexpr (F8) { scw8 = S.sw8 * 0x01010101; sca8 = S.sa8 * 0x01010101; }
    Unit cur, nxt; int ui = 0;
    if (!S.next(0, cur)) return;
    f32x4 acc[2][2][4][2];
#pragma unroll
    for (int a = 0; a < 2; ++a)
#pragma unroll
        for (int b = 0; b < 2; ++b)
#pragma unroll
            for (int m = 0; m < 4; ++m)
#pragma unroll
                for (int n = 0; n < 2; ++n) acc[a][b][m][n] = (f32x4){0.f, 0.f, 0.f, 0.f};
    bf16x8 At[4][2], B0[2][2], B1[2][2]; v8i_t At8[4], B08[2], B18[2];
    unsigned vAc[2][2], vAn[2][2];
    const char* cA = S.a_base(cur); const char* cB = S.b_base(cur);
    S.a_off(cur, Rr, Cc, vAc);
    if constexpr (SchedVarK<Sched>::value) nt = S.ktiles(cur);
    PG8_STAGE(PG8_SB(0, 0), cB, vB[0]); PG8_STAGE(PG8_SB(0, 1), cB, vB[1]); PG8_STAGE(PG8_SA(0, 0), cA, vAc[0]); PG8_STAGE(PG8_SA(0, 1), cA, vAc[1]);
    if (wr == 1) PG8_BAR;
    PG8_WAIT_V(2); PG8_BAR;
    PG8_STAGE(PG8_SB(1, 0), cB + kstep, vB[0]); PG8_STAGE(PG8_SA(1, 0), cA + kstep, vAc[0]); PG8_STAGE(PG8_SB(1, 1), cB + kstep, vB[1]);
    PG8_WAIT_V(6); PG8_BAR;
    bool epi_pend = false;
    for (;;) {
        const bool has_next = S.next(ui + 1, nxt);
        const char* nA = cA; const char* nB = cB;
        if constexpr (Sched::GATHER) {
#pragma unroll
            for (int h = 0; h < 2; ++h)
#pragma unroll
                for (int i = 0; i < 2; ++i) vAn[h][i] = vAc[h][i];
        }
        if (has_next) { nA = S.a_base(nxt); nB = S.b_base(nxt); if constexpr (Sched::GATHER) S.a_off(nxt, Rr, Cc, vAn); }
#pragma nounroll
        for (int t = 0; t < nt; t += 2) {
            const bool last = (t == nt - 2);
            const bool ep_ = epi_pend && t == 0;
            const char* a1 = cA + (size_t)(t + 1) * kstep;
            const char* a2 = last ? nA : cA + (size_t)(t + 2) * kstep; const char* b2 = last ? nB : cB + (size_t)(t + 2) * kstep;
            const char* a3 = a2 + kstep; const char* b3 = b2 + kstep;
            unsigned vA2[2][2];
#pragma unroll
            for (int h = 0; h < 2; ++h)
#pragma unroll
                for (int i = 0; i < 2; ++i) { if constexpr (Sched::GATHER) vA2[h][i] = last ? vAn[h][i] : vAc[h][i]; else vA2[h][i] = vAc[h][i]; }
            PG8_LDB(B0, 0, 0); PG8_LDB(B1, 0, 1); PG8_SCHED; PG8_LDA(At, 0, 0); PG8_STAGE(PG8_SA(1, 1), a1, vAc[1]);
            if (ep_) { PG8_WAIT_V(24); } else { PG8_WAIT_V(8); } PG8_WAIT_L(0); PG8_BAR; PG8_MMA(0, 0, At, B0); PG8_MMA(0, 1, At, B1); PG8_BAR; PG8_SCHED;
            PG8_LDA(At, 0, 1); PG8_STAGE(PG8_SB(0, 0), b2, vB[0]); PG8_STAGE(PG8_SB(0, 1), b2, vB[1]); PG8_STAGE(PG8_SA(0, 0), a2, vA2[0]);
            if (ep_) { PG8_WAIT_V(24); } else { PG8_WAIT_V(8); } PG8_WAIT_L(0); PG8_BAR; PG8_MMA(1, 0, At, B0); PG8_MMA(1, 1, At, B1); PG8_BAR; PG8_SCHED;
            PG8_LDB(B0, 1, 0); PG8_LDB(B1, 1, 1); PG8_SCHED; PG8_LDA(At, 1, 0); PG8_STAGE(PG8_SA(0, 1), a2, vA2[1]);
            PG8_WAIT_V(8); PG8_WAIT_L(0); PG8_BAR; PG8_MMA(0, 0, At, B0); PG8_MMA(0, 1, At, B1); PG8_BAR; PG8_SCHED;
            PG8_LDA(At, 1, 1); PG8_STAGE(PG8_SB(1, 0), b3, vB[0]); PG8_STAGE(PG8_SB(1, 1), b3, vB[1]); PG8_STAGE(PG8_SA(1, 0), a3, vA2[0]);
            PG8_WAIT_V(8); PG8_WAIT_L(0); PG8_BAR; PG8_MMA(1, 0, At, B0); PG8_MMA(1, 1, At, B1); PG8_BAR; PG8_SCHED;
        }
        if constexpr (ALIGN_EPI) { if (wr == 0) PG8_BAR; }
        if constexpr (F8) asm volatile("s_nop 15\n\ts_nop 15" ::: "memory");
        { int l2_ = lane; asm volatile("" : "+v"(l2_)); E(acc, cur, wr, wc, l2_ & 15, l2_ >> 4); }
        if (!has_next) break;
        epi_pend = true;
#pragma unroll
        for (int a = 0; a < 2; ++a)
#pragma unroll
            for (int b = 0; b < 2; ++b)
#pragma unroll
                for (int m = 0; m < 4; ++m)
#pragma unroll
                    for (int n = 0; n < 2; ++n) acc[a][b][m][n] = (f32x4){0.f, 0.f, 0.f, 0.f};
        cur = nxt; cA = nA; cB = nB; ++ui;
        if constexpr (SchedVarK<Sched>::value) nt = S.ktiles(cur);
        if constexpr (Sched::GATHER) {
#pragma unroll
            for (int h = 0; h < 2; ++h)
#pragma unroll
                for (int i = 0; i < 2; ++i) vAc[h][i] = vAn[h][i];
        }
        if constexpr (ALIGN_EPI) { if (wr == 1) PG8_BAR; }
    }
    PG8_WAIT_V(0);
    if constexpr (!ALIGN_EPI) { if (wr == 0) PG8_BAR; }
    asm volatile("s_waitcnt vmcnt(0) lgkmcnt(0)\n\ts_barrier" ::: "memory");
    __builtin_amdgcn_sched_barrier(0);
#undef PG8_SA
#undef PG8_SB
#undef PG8_STAGE
#undef PG8_LDA
#undef PG8_LDB
#undef PG8_MMA
#undef PG8_WAIT_V
#undef PG8_WAIT_L
#undef PG8_BAR
#undef PG8_SCHED
}

struct DenseSched {
    static constexpr bool GATHER = false;
    const bf16_t* A; const bf16_t* Bt; int lda, ldb, nM, nN, G, c;
    __device__ __forceinline__ bool next(int i, Unit& u) const { const int v = i * G + c; if (v >= nM * nN) return false; u.pm = v / nN; u.pn = v % nN; u.ord = i; return true; }
    __device__ __forceinline__ const char* a_base(const Unit& u) const { return (const char*)(A + (size_t)u.pm * BM * lda); }
    __device__ __forceinline__ const char* b_base(const Unit& u) const { return (const char*)(Bt + (size_t)u.pn * BM * ldb); }
    __device__ __forceinline__ void a_off(const Unit&, const int (&R)[2], const int (&C)[2], unsigned (&v)[2][2]) const {
#pragma unroll
        for (int i = 0; i < 2; ++i) { v[0][i] = (unsigned)(R[i] * lda + C[i]) * 2u; v[1][i] = (unsigned)((HALF + R[i]) * lda + C[i]) * 2u; }
    }
};
struct DenseSched8 : DenseSched { int sw8, sa8; };
struct ProjSched8 : DenseSched8 {
    __device__ __forceinline__ bool next(int i, Unit& u) const {
        if (nN != 28 || (nM & 1) || (G & 7)) return DenseSched::next(i, u);
        const int x = c & 7, wl = i * (G >> 3) + (c >> 3), half = nM >> 1;
        if (wl >= half * 7) return false;
        u.pm = (x >> 2) * half + wl / 7; u.pn = 7 * (x & 3) + wl % 7; u.ord = i; return true;
    }
};
}

#define XB_TMO      128
#define XB_XCNT(j)  (256  + 64 * (j))
#define XB_XSUB(j)  (1280 + 64 * (j))
#define XB_XGEN(j)  (2304 + 64 * (j))
#define XB_TOP      3328
#define XB_TOPGEN   3392
#define XCD_BAR_WORDS 3456
#define XB_SPIN_CAP (1u << 18)
__device__ __forceinline__ unsigned xb_ld(unsigned* p)              { return __hip_atomic_load(p, __ATOMIC_RELAXED, __HIP_MEMORY_SCOPE_AGENT); }
__device__ __forceinline__ unsigned xb_add(unsigned* p, unsigned v) { return __hip_atomic_fetch_add(p, v, __ATOMIC_RELAXED, __HIP_MEMORY_SCOPE_AGENT); }
__device__ __forceinline__ unsigned xb_xcc_id() { return (unsigned)__builtin_amdgcn_s_getreg((3 << 11) | 20) & 0xFu; }
#define XB_SPIN(cond, bar) do { unsigned _sp = 0; while (cond) { __builtin_amdgcn_s_sleep(1); \
    if ((++_sp & 255u) == 0u) { if (xb_ld(&(bar)[XB_TMO])) break; if (_sp > XB_SPIN_CAP) { atomicAdd(&(bar)[XB_TMO], 1u); break; } } } } while (0)
struct XcdBarrier { unsigned* bar; unsigned x; volatile LAS unsigned* st; };
__device__ __forceinline__ XcdBarrier xcd_barrier_post(unsigned* bar, volatile LAS unsigned* st) {
    XcdBarrier b; b.bar = bar; b.x = xb_xcc_id(); b.st = st;
    if (threadIdx.x == 0) (void)xb_add(&bar[XB_XCNT(b.x)], 1u);
    return b;
}
__device__ __forceinline__ void xcd_barrier_complete(unsigned* bar, unsigned x, unsigned& nloc, unsigned& nx) {
    const unsigned G = gridDim.x * gridDim.y * gridDim.z;
    unsigned sum, cnt, mine, sp = 0u;
    for (;;) {
        sum = 0u; cnt = 0u; mine = 0u;
#pragma unroll
        for (unsigned j = 0; j < 16; ++j) { const unsigned c = xb_ld(&bar[XB_XCNT(j)]); sum += c; cnt += (c > 0u) ? 1u : 0u; mine = (j == x) ? c : mine; }
        if (sum == G) break;
        __builtin_amdgcn_s_sleep(1);
        if ((++sp & 255u) == 0u) { if (xb_ld(&bar[XB_TMO])) break; if (sp > XB_SPIN_CAP) { atomicAdd(&bar[XB_TMO], 1u); break; } }
    }
    nloc = mine > 0u ? mine : 1u; nx = cnt > 0u ? cnt : 1u;
}
__device__ __forceinline__ void xcd_barrier(const XcdBarrier& b) {
    asm volatile("s_waitcnt vmcnt(0)" ::: "memory");
    __syncthreads();
    if (threadIdx.x == 0) {
        unsigned* bar = b.bar;
        __builtin_amdgcn_s_waitcnt(0);
        unsigned nloc = b.st[0], nx = b.st[1];
        if (nloc == 0u) { xcd_barrier_complete(bar, b.x, nloc, nx); b.st[0] = nloc; b.st[1] = nx; }
        const unsigned old = xb_add(&bar[XB_XSUB(b.x)], 1u);
        const unsigned gen = old / nloc;
        if (old + 1u == (gen + 1u) * nloc) {
            __builtin_amdgcn_fence(__ATOMIC_RELEASE, "agent");
            asm volatile("s_waitcnt vmcnt(0)" ::: "memory");
            const unsigned og = xb_add(&bar[XB_TOP], 1u);
            const unsigned tg = og / nx;
            if (og + 1u == (tg + 1u) * nx) xb_add(&bar[XB_TOPGEN], 1u);
            else XB_SPIN(xb_ld(&bar[XB_TOPGEN]) == tg, bar);
            __builtin_amdgcn_fence(__ATOMIC_ACQUIRE, "agent");
            xb_add(&bar[XB_XGEN(b.x)], 1u);
            asm volatile("s_waitcnt vmcnt(0)" ::: "memory");
        } else {
            XB_SPIN(xb_ld(&bar[XB_XGEN(b.x)]) == gen, bar);
            __builtin_amdgcn_fence(__ATOMIC_ACQUIRE, "agent");
            asm volatile("s_waitcnt vmcnt(0)" ::: "memory");
        }
    }
    __syncthreads();
}

constexpr size_t MiB = 1u << 20;
constexpr size_t WS_CTL = 0, CTL_ZERO_BYTES = 1 * MiB;
constexpr int CW_BAR = 4096;
constexpr int CW_QUEUE = 16384;
constexpr size_t WS_W13 = 2 * MiB;
constexpr size_t WS_W2  = 34 * MiB;
constexpr size_t WS_WR  = 50 * MiB;
constexpr size_t WS_MISC = 51 * MiB;
constexpr size_t WS_ROUTE = 52 * MiB;
constexpr size_t WS_RPOS = 53 * MiB;
constexpr size_t WS_ROWTOK = 54 * MiB;
constexpr size_t WS_ROPE = 55 * MiB;
constexpr size_t WS_WUQ = 56 * MiB;
constexpr size_t WS_WUKV = 57 * MiB;
constexpr size_t WS_WA = 58 * MiB;
constexpr size_t WS_WB = 59 * MiB;
constexpr size_t WS_WC = 60 * MiB;
constexpr size_t WS_WO = 61 * MiB;
constexpr size_t WS_SSQ = 63 * MiB;
constexpr size_t WS_LSE = 64 * MiB;
constexpr size_t WS_MASK = 66 * MiB;
constexpr size_t WS_XB8 = 74 * MiB;
constexpr size_t WS_WIN8 = 138 * MiB;
constexpr size_t WS_H = 146 * MiB;
constexpr size_t WS_Y = 182 * MiB;
constexpr size_t WS_SC = WS_Y;
constexpr size_t WS_G3 = 254 * MiB;
constexpr size_t WS_PROJ = 350 * MiB;
constexpr size_t WS_QM = 606 * MiB;
constexpr size_t WS_KVM = 654 * MiB;
constexpr size_t WS_OA = 718 * MiB;
constexpr size_t WS_OB = 734 * MiB;
constexpr size_t WS_OC = 750 * MiB;
constexpr size_t WS_OG = 766 * MiB;
constexpr size_t WS_M0 = 814 * MiB;
constexpr size_t WS_M1 = 846 * MiB;
constexpr size_t WS_MERGED = 878 * MiB;
constexpr size_t WS_END = 910 * MiB;
constexpr int F8_SA_X = 127 - 4, F8_SW = 127 - 10;
constexpr int MAXROWS = 139264;
constexpr int NBC = 16, TC = NBC * SEQ, NCHUNK = NB / NBC;
constexpr int CIN = 3944, PW = 4096;

constexpr int MI_BLOCKCNT = 0;
constexpr int MI_PANEL_E = 8192;
constexpr int MI_NPAN = 8192 + 1024;

constexpr int RING_BYTES = 131072;
constexpr int L_CTL = RING_BYTES;
constexpr int L_BARW = L_CTL + 32;
constexpr int L_HIST = L_CTL + 256;
constexpr int L_TOT  = L_CTL + 384;
constexpr int L_PRE  = L_CTL + 512;
constexpr int L_BASE = L_CTL + 640;
constexpr int L_RANK = L_CTL + 896;
constexpr int L_PE   = L_CTL + 1024;
constexpr int L_ROWS = L_CTL + 2048;
constexpr int LDS_BYTES = 147456;
constexpr int L_GB = L_ROWS;
static_assert(L_ROWS + 12288 <= LDS_BYTES, "LDS map");

#ifndef DUPMASK
#define DUPMASK 0
#endif
struct Args { const float* in[23]; float* out; unsigned char* ws; };
#define PHASE_IDS(F) do { int t_ = threadIdx.x; asm volatile("" : "+v"(t_)); (F).tid = t_; (F).lane = t_ & 63; { intab_t p_ = (intab_t)__builtin_amdgcn_kernarg_segment_ptr(); asm volatile("" : "+s"(p_)); (F).in.p = p_; } \
    { unsigned char GAS* w_ = (unsigned char GAS*)(F).ws0; asm volatile("" : "+s"(w_)); (F).ws = (unsigned char*)w_; float GAS* o_ = (float GAS*)(F).out0; asm volatile("" : "+s"(o_)); (F).out = (float*)o_; } } while (0)

typedef const float GAS* gfptr_t;
typedef const gfptr_t __attribute__((address_space(4)))* intab_t;
struct InTab { intab_t p; __device__ __forceinline__ const float* operator[](int i) const { return (const float*)p[i]; } };
struct Frame {
    LAS unsigned char* lds;
    int tid, lane, wave, vcu, G;
    InTab in; float* out; unsigned char* ws; float* out0; unsigned char* ws0;
};

template <class F>
__device__ __forceinline__ void conv_item(bf16_t* WT, int ldk, int k0, int n0, LAS float* scr, int lane, F val) {
#pragma unroll 8
    for (int i = 0; i < 32; ++i) { const int kk = 2 * i + (lane >> 5); scr[kk * 33 + (lane & 31)] = val(k0 + kk, n0 + (lane & 31)); }
    LDS_WAIT(); asm volatile("" ::: "memory");
    const int c = lane & 7;
#pragma unroll
    for (int j = 0; j < 4; ++j) { const int n = (lane >> 3) + 8 * j; const LAS float* s = scr + (8 * c) * 33 + n;
        u32x4 o; o.x = pk2(s[0 * 33], s[1 * 33]); o.y = pk2(s[2 * 33], s[3 * 33]); o.z = pk2(s[4 * 33], s[5 * 33]); o.w = pk2(s[6 * 33], s[7 * 33]);
        *(u32x4*)(WT + (size_t)(n0 + n) * ldk + k0 + 8 * c) = o; }
    LDS_WAIT(); asm volatile("" ::: "memory");
}

template <class F>
__device__ __forceinline__ void conv_item8(unsigned char* WT, int ldk, int k0, int n0, LAS float* scr, int lane, F val) {
#pragma unroll 8
    for (int i = 0; i < 32; ++i) { const int kk = 2 * i + (lane >> 5); scr[kk * 33 + (lane & 31)] = val(k0 + kk, n0 + (lane & 31)); }
    LDS_WAIT(); asm volatile("" ::: "memory");
    const int c = lane & 7;
#pragma unroll
    for (int j = 0; j < 4; ++j) { const int n = (lane >> 3) + 8 * j; const LAS float* s = scr + (8 * c) * 33 + n;
        u32x2 o; o.x = pk4_fp8(s[0 * 33], s[1 * 33], s[2 * 33], s[3 * 33]); o.y = pk4_fp8(s[4 * 33], s[5 * 33], s[6 * 33], s[7 * 33]);
        *(u32x2*)(WT + (size_t)(n0 + n) * ldk + k0 + 8 * c) = o; }
    LDS_WAIT(); asm volatile("" ::: "memory");
}

__device__ __forceinline__ void conv_plain8(unsigned char* WT, int ldk, int k0, int n0, LAS float* scr, int lane, const float* src, int pitch, float sc) {
    f32x4 v[8];
#pragma unroll
    for (int i = 0; i < 8; ++i) v[i] = *(const f32x4*)(src + (size_t)(k0 + (lane >> 3) + 8 * i) * pitch + n0 + (lane & 7) * 4);
#pragma unroll
    for (int i = 0; i < 8; ++i) { LAS float* d = scr + ((lane >> 3) + 8 * i) * 33 + (lane & 7) * 4; d[0] = v[i][0] * sc; d[1] = v[i][1] * sc; d[2] = v[i][2] * sc; d[3] = v[i][3] * sc; }
    LDS_WAIT(); asm volatile("" ::: "memory");
    const int c = lane & 7;
#pragma unroll
    for (int j = 0; j < 4; ++j) { const int n = (lane >> 3) + 8 * j; const LAS float* s = scr + (8 * c) * 33 + n;
        u32x2 o; o.x = pk4_fp8(s[0 * 33], s[1 * 33], s[2 * 33], s[3 * 33]); o.y = pk4_fp8(s[4 * 33], s[5 * 33], s[6 * 33], s[7 * 33]);
        *(u32x2*)(WT + (size_t)(n0 + n) * ldk + k0 + 8 * c) = o; }
    LDS_WAIT(); asm volatile("" ::: "memory");
}
__device__ __forceinline__ void conv_pair8(unsigned char* WT, int ldk, int k0, int n0, LAS float* scr, int lane, const float* a, const float* b, int pitch, float sc) {
    f32x2 va[8], vb[8];
#pragma unroll
    for (int i = 0; i < 8; ++i) { const size_t o = (size_t)(k0 + (lane >> 3) + 8 * i) * pitch + (n0 >> 1) + (lane & 7) * 2; va[i] = *(const f32x2*)(a + o); vb[i] = *(const f32x2*)(b + o); }
#pragma unroll
    for (int i = 0; i < 8; ++i) { LAS float* d = scr + ((lane >> 3) + 8 * i) * 33 + (lane & 7) * 4; d[0] = va[i][0] * sc; d[1] = vb[i][0] * sc; d[2] = va[i][1] * sc; d[3] = vb[i][1] * sc; }
    LDS_WAIT(); asm volatile("" ::: "memory");
    const int c = lane & 7;
#pragma unroll
    for (int j = 0; j < 4; ++j) { const int n = (lane >> 3) + 8 * j; const LAS float* s = scr + (8 * c) * 33 + n;
        u32x2 o; o.x = pk4_fp8(s[0 * 33], s[1 * 33], s[2 * 33], s[3 * 33]); o.y = pk4_fp8(s[4 * 33], s[5 * 33], s[6 * 33], s[7 * 33]);
        *(u32x2*)(WT + (size_t)(n0 + n) * ldk + k0 + 8 * c) = o; }
    LDS_WAIT(); asm volatile("" ::: "memory");
}

__device__ __forceinline__ void phase_conv_moe(Frame& F, int l) {
    PHASE_IDS(F);
    LAS float* scr = (LAS float*)(F.lds + F.wave * 16384);
    const int gw = F.vcu * NWAVES + F.wave, NGW = F.G * NWAVES;
    const float* w1 = F.in[18] + (size_t)l * NEXP * DM * DEXP;
    const float* w3 = F.in[19] + (size_t)l * NEXP * DM * DEXP;
    const float* w2 = F.in[20] + (size_t)l * NEXP * DEXP * DM;
    bf16_t* W13 = (bf16_t*)(F.ws + WS_W13); bf16_t* W2 = (bf16_t*)(F.ws + WS_W2);
    constexpr int I13 = (DM / 64) * (512 / 32);
    constexpr int I2 = (DEXP / 64) * (DM / 32);
    for (int it = gw; it < NEXP * (I13 + I2); it += NGW) {
        if (it < NEXP * I13) {
            const int e = it / I13, r = it % I13, kb = r / 16, nb = r % 16;
            const float* a = w1 + (size_t)e * DM * DEXP; const float* b = w3 + (size_t)e * DM * DEXP;
            conv_pair8((unsigned char*)W13 + (size_t)e * 512 * DM, DM, kb * 64, nb * 32, scr, F.lane, a, b, DEXP, 1024.f);
        } else {
            const int it2 = it - NEXP * I13; const int e = it2 / I2, r = it2 % I2, kb = r / 32, nb = r % 32;
            const float* a = w2 + (size_t)e * DEXP * DM;
            conv_plain8((unsigned char*)W2 + (size_t)e * DM * DEXP, DEXP, kb * 64, nb * 32, scr, F.lane, a, DM, 1024.f);
        }
    }
    const float* wg = F.in[14] + (size_t)l * DM * 4; const float* wsb = F.in[16] + (size_t)l * DM * NEXP;
    const float* g1 = F.in[12] + (size_t)l * DM; const float* b1 = F.in[13] + (size_t)l * DM;
    bf16_t* WRH = (bf16_t*)(F.ws + WS_WR); bf16_t* WRL = (bf16_t*)(F.ws + WS_WR + 128 * 1024); float* WRC = (float*)(F.ws + WS_WR + 256 * 1024);
    for (int idx = (F.vcu * NTHREADS + F.tid); idx < 64 * DM; idx += F.G * NTHREADS) {
        const int c = idx / DM, k = idx % DM;
        const float v = (c < 32 ? wsb[(size_t)k * NEXP + c] : (c < 36 ? wg[(size_t)k * 4 + (c - 32)] : 0.f)) * g1[k];
        const unsigned h = f2bf(v); const int it = k >> 5, hi_ = (k >> 4) & 1, st = (k >> 3) & 1, e = k & 7, ln = (c & 31) + 32 * hi_, p0 = 2 * (c >> 5);
        WRH[((((size_t)it * 4 + p0) * 2 + st) * 64 + ln) * 8 + e] = (bf16_t)h;
        WRH[((((size_t)it * 4 + p0 + 1) * 2 + st) * 64 + ln) * 8 + e] = (bf16_t)f2bf(v - __builtin_bit_cast(float, h << 16)); (void)WRL;
    }
    if (gw < 64) {
        const int c = gw; float s1 = 0.f, s2 = 0.f;
        for (int k = F.lane; k < DM; k += 64) { const float w = c < 32 ? wsb[(size_t)k * NEXP + c] : (c < 36 ? wg[(size_t)k * 4 + (c - 32)] : 0.f); s1 += g1[k] * w; s2 += b1[k] * w; }
        s1 = wave_sum(s1); s2 = wave_sum(s2);
        const float bias = c < 32 ? F.in[17][(size_t)l * NEXP + c] : (c < 36 ? F.in[15][(size_t)l * 4 + (c - 32)] : 0.f);
        if (F.lane == 0) { WRC[c] = s1; WRC[64 + c] = s2 + bias; }
    }
}

__device__ __forceinline__ void ln_row(f32x4 (&v)[4], const f32x4 (&g)[4], const f32x4 (&b)[4], float* omean = nullptr, float* orstd = nullptr) {
    float s = 0.f;
#pragma unroll
    for (int j = 0; j < 4; ++j) s += (v[j].x + v[j].y) + (v[j].z + v[j].w);
    const float mean = wave_sum(s) * (1.f / DM); float s2 = 0.f;
#pragma unroll
    for (int j = 0; j < 4; ++j) { v[j] = v[j] - mean; s2 += (v[j].x * v[j].x + v[j].y * v[j].y) + (v[j].z * v[j].z + v[j].w * v[j].w); }
    const float rstd = 1.0f / sqrtf(wave_sum(s2) * (1.f / DM) + LN_EPS);
#pragma unroll
    for (int j = 0; j < 4; ++j) v[j] = v[j] * rstd * g[j] + b[j];
    if (omean) { *omean = mean; *orstd = rstd; }
}
__device__ __forceinline__ void store_row(const f32x4 (&v)[4], float* orow, unsigned char* brow, int lane) {
#pragma unroll
    for (int j = 0; j < 4; ++j) {
        ((f32x4*)orow)[lane + 64 * j] = v[j];
        ((unsigned*)brow)[lane + 64 * j] = pk4_fp8(v[j].x * 16.f, v[j].y * 16.f, v[j].z * 16.f, v[j].w * 16.f);
    }
}

__device__ __forceinline__ void phase_ln1_router(Frame& F, int l, const float* src, bool scale_alpha) {
    PHASE_IDS(F);
    const int lane = F.lane, hi = lane >> 5, r32 = lane & 31;
    const float* lg = F.in[12] + (size_t)l * DM; const float* lb = F.in[13] + (size_t)l * DM;
    f32x4 g[4], b[4];
#pragma unroll
    for (int j = 0; j < 4; ++j) { g[j] = ((const f32x4*)lg)[lane + 64 * j]; b[j] = ((const f32x4*)lb)[lane + 64 * j]; }
    unsigned char* XB = F.ws + WS_XB8;
    const bf16_t* WRH = (const bf16_t*)(F.ws + WS_WR); const bf16_t* WRL = (const bf16_t*)(F.ws + WS_WR + 128 * 1024);
    const float* WRC = (const float*)(F.ws + WS_WR + 256 * 1024); float* stats = (float*)(F.ws + WS_WR + 512 * 1024);
    unsigned* misc = (unsigned*)(F.ws + WS_MISC);
    int* route = (int*)(F.ws + WS_ROUTE);
    LAS unsigned* hist = (LAS unsigned*)(F.lds + L_HIST);
    const float sc = scale_alpha ? ALPHA : 1.0f;
    for (int blk = F.vcu; blk < TT / 256; blk += F.G) {
        if (F.tid < 32) hist[F.tid] = 0u;
        __syncthreads();
        const int row0 = blk * 256 + F.wave * 32;
        float mu_l = 0.f, rs_l = 1.f;
        for (int i = 0; i < 32; i += 2) {
            f32x4 v0[4], v1[4];
            const f32x4* p0 = (const f32x4*)(src + (size_t)(row0 + i) * DM); const f32x4* p1 = (const f32x4*)(src + (size_t)(row0 + i + 1) * DM);
#pragma unroll
            for (int j = 0; j < 4; ++j) { v0[j] = p0[lane + 64 * j] * sc; v1[j] = p1[lane + 64 * j] * sc; }
            float m0, r0, m1, r1;
            ln_row(v0, g, b, &m0, &r0); ln_row(v1, g, b, &m1, &r1);
            mu_l = (r32 == i) ? m0 : ((r32 == i + 1) ? m1 : mu_l); rs_l = (r32 == i) ? r0 : ((r32 == i + 1) ? r1 : rs_l);
#pragma unroll
            for (int j = 0; j < 4; ++j) {
                ((unsigned*)(XB + (size_t)(row0 + i) * DM))[lane + 64 * j] = pk4_fp8(v0[j].x * 16.f, v0[j].y * 16.f, v0[j].z * 16.f, v0[j].w * 16.f);
                ((unsigned*)(XB + (size_t)(row0 + i + 1) * DM))[lane + 64 * j] = pk4_fp8(v1[j].x * 16.f, v1[j].y * 16.f, v1[j].z * 16.f, v1[j].w * 16.f); }
        }
        if (hi == 0) *(f32x2*)(stats + (size_t)(row0 + r32) * 2) = (f32x2){mu_l, rs_l};
        f32x16 acc0 = {}, acc1 = {};
        {
            const bf16_t* WT = WRH; (void)WRL;
            LAS float* xs = (LAS float*)(F.lds + F.wave * 9216);
            const float* xg = src + (size_t)(row0 + (lane >> 3)) * DM + (lane & 7) * 4;
            f32x4 xv[4]; bf16x8 wv[8];
#pragma unroll
            for (int i = 0; i < 4; ++i) xv[i] = *(const f32x4*)(xg + (size_t)(8 * i) * DM);
#pragma unroll
            for (int q = 0; q < 8; ++q) wv[q] = *(const bf16x8*)(WT + ((size_t)q * 64 + lane) * 8);
#pragma unroll 2
            for (int it = 0; it < 32; ++it) {
                LAS float* xb = xs + (it & 1) * 1152;
#pragma unroll
                for (int i = 0; i < 4; ++i) *(LAS f32x4*)(xb + ((lane >> 3) + 8 * i) * 36 + (lane & 7) * 4) = xv[i];
                bf16x8 wc[8];
#pragma unroll
                for (int q = 0; q < 8; ++q) wc[q] = wv[q];
                { const int nx = it + 1 < 32 ? it + 1 : 31;
#pragma unroll
                  for (int i = 0; i < 4; ++i) xv[i] = *(const f32x4*)(xg + (size_t)(8 * i) * DM + nx * 32);
#pragma unroll
                  for (int q = 0; q < 8; ++q) wv[q] = *(const bf16x8*)(WT + (((size_t)nx * 8 + q) * 64 + lane) * 8); }
                f32x4 xa[4];
#pragma unroll
                for (int j = 0; j < 4; ++j) xa[j] = *(const LAS f32x4*)(xb + r32 * 36 + hi * 16 + 4 * j);
#pragma unroll
                for (int st = 0; st < 2; ++st) {
                    const f32x4 x0 = xa[2 * st], x1 = xa[2 * st + 1];
                    u32x4 xh, xl;
                    xh.x = cvt_pk_bf16(x0[0], x0[1]); xh.y = cvt_pk_bf16(x0[2], x0[3]); xh.z = cvt_pk_bf16(x1[0], x1[1]); xh.w = cvt_pk_bf16(x1[2], x1[3]);
                    xl.x = cvt_pk_bf16(x0[0] - bflo(xh.x), x0[1] - bfhi(xh.x)); xl.y = cvt_pk_bf16(x0[2] - bflo(xh.y), x0[3] - bfhi(xh.y));
                    xl.z = cvt_pk_bf16(x1[0] - bflo(xh.z), x1[1] - bfhi(xh.z)); xl.w = cvt_pk_bf16(x1[2] - bflo(xh.w), x1[3] - bfhi(xh.w));
                    const bf16x8 xhv = __builtin_bit_cast(bf16x8, xh), xlv = __builtin_bit_cast(bf16x8, xl);
                    acc0 = __builtin_amdgcn_mfma_f32_32x32x16_bf16(wc[0 + st], xhv, acc0, 0, 0, 0); acc1 = __builtin_amdgcn_mfma_f32_32x32x16_bf16(wc[4 + st], xhv, acc1, 0, 0, 0);
                    acc0 = __builtin_amdgcn_mfma_f32_32x32x16_bf16(wc[2 + st], xhv, acc0, 0, 0, 0); acc1 = __builtin_amdgcn_mfma_f32_32x32x16_bf16(wc[6 + st], xhv, acc1, 0, 0, 0);
                    acc0 = __builtin_amdgcn_mfma_f32_32x32x16_bf16(wc[0 + st], xlv, acc0, 0, 0, 0); acc1 = __builtin_amdgcn_mfma_f32_32x32x16_bf16(wc[4 + st], xlv, acc1, 0, 0, 0);
                }
            }
        }
        float gl[4];
#pragma unroll
        for (int i = 0; i < 4; ++i) gl[i] = rs_l * (acc1[i] - mu_l * WRC[32 + i]) + WRC[64 + 32 + i];
        int gidx = 0; float gmax = gl[0];
#pragma unroll
        for (int i = 1; i < 4; ++i) if (gl[i] > gmax) { gmax = gl[i]; gidx = i; }
        float gsum = 0.f;
#pragma unroll
        for (int i = 0; i < 4; ++i) gsum += fast_exp(gl[i] - gmax);
        float gp = 1.0f / gsum;
        gidx = __shfl(gidx, r32); gp = __shfl(gp, r32);
        float cv[4];
#pragma unroll
        for (int i = 0; i < 4; ++i) {
            const float a = gidx == 0 ? acc0[i] : gidx == 1 ? acc0[4 + i] : gidx == 2 ? acc0[8 + i] : acc0[12 + i];
            cv[i] = rs_l * (a - mu_l * WRC[8 * gidx + 4 * hi + i]) + WRC[64 + 8 * gidx + 4 * hi + i];
        }
        float v1 = cv[0]; int i1 = 0;
#pragma unroll
        for (int i = 1; i < 4; ++i) if (cv[i] > v1) { v1 = cv[i]; i1 = i; }
        float v2 = -INFINITY; int i2 = 0;
#pragma unroll
        for (int i = 0; i < 4; ++i) if (i != i1 && cv[i] > v2) { v2 = cv[i]; i2 = i; }
        i1 += 4 * hi; i2 += 4 * hi;
        const float pv1 = __shfl_xor(v1, 32), pv2 = __shfl_xor(v2, 32); const int pi1 = __shfl_xor(i1, 32), pi2 = __shfl_xor(i2, 32);
        auto better = [](float av, int ai, float bv, int bi) { return av > bv || (av == bv && ai < bi); };
        float fv, sv; int fi, si;
        if (better(v1, i1, pv1, pi1)) { fv = v1; fi = i1; if (better(v2, i2, pv1, pi1)) { sv = v2; si = i2; } else { sv = pv1; si = pi1; } }
        else { fv = pv1; fi = pi1; if (better(v1, i1, pv2, pi2)) { sv = v1; si = i1; } else { sv = pv2; si = pi2; } }
        const float d = fast_exp(sv - fv), inv = 1.0f / (1.0f + d);
        const float w1 = gp * inv, w2 = gp * d * inv;
        const int e1 = 8 * gidx + fi, e2 = 8 * gidx + si;
        if (hi == 0) {
            *(int4*)(route + (size_t)(row0 + r32) * 4) = make_int4(e1, e2, __float_as_int(w1), __float_as_int(w2));
            atomicAdd((unsigned*)&hist[e1], 1u); atomicAdd((unsigned*)&hist[e2], 1u);
        }
        __syncthreads();
        if (F.tid < 32) misc[MI_BLOCKCNT + blk * 32 + F.tid] = hist[F.tid];
        __syncthreads();
    }
}

__device__ __forceinline__ void phase_moe_scatter(Frame& F) {
    PHASE_IDS(F);
    unsigned* misc = (unsigned*)(F.ws + WS_MISC);
    const int* route = (const int*)(F.ws + WS_ROUTE);
    int* rpos = (int*)(F.ws + WS_RPOS); int* rowtok = (int*)(F.ws + WS_ROWTOK);
    LAS unsigned* tot = (LAS unsigned*)(F.lds + L_TOT); LAS unsigned* pre = (LAS unsigned*)(F.lds + L_PRE);
    LAS unsigned* base = (LAS unsigned*)(F.lds + L_BASE); LAS unsigned* rank = (LAS unsigned*)(F.lds + L_RANK);
    for (int blk = F.vcu; blk < TT / 256; blk += F.G) {
        {
            if (F.tid < 32) { tot[F.tid] = 0u; pre[F.tid] = 0u; rank[F.tid] = 0u; }
            __syncthreads();
            const int e = F.tid & 31, part = F.tid >> 5; unsigned cv[16];
#pragma unroll
            for (int i = 0; i < 16; ++i) cv[i] = misc[MI_BLOCKCNT + (part * 16 + i) * 32 + e];
            unsigned t = 0, p = 0;
#pragma unroll
            for (int i = 0; i < 16; ++i) { t += cv[i]; p += (part * 16 + i < blk) ? cv[i] : 0u; }
            atomicAdd((unsigned*)&tot[e], t); atomicAdd((unsigned*)&pre[e], p);
        }
        __syncthreads();
        if (F.tid == 0) { unsigned a = 0; for (int e = 0; e < NEXP; ++e) { base[e] = a; a += (tot[e] + 255u) & ~255u; } base[NEXP] = a; }
        __syncthreads();
        {
            const int tok = blk * 256 + (F.tid >> 1), slot = F.tid & 1;
            const int e = route[(size_t)tok * 4 + slot];
            const unsigned r = atomicAdd((unsigned*)&rank[e], 1u);
            const unsigned pos = base[e] + pre[e] + r;
            rowtok[pos] = tok; rpos[(size_t)tok * 2 + slot] = (int)pos;
        }
        if (blk < NEXP) {
            const int e = blk; const unsigned end = base[e] + tot[e], nxt = base[e + 1];
            for (unsigned p = end + F.tid; p < nxt; p += NTHREADS) rowtok[p] = 0;
            for (unsigned p = base[e] / 256 + F.tid; p < nxt / 256; p += NTHREADS) misc[MI_PANEL_E + p] = (unsigned)e;
        }
        if (blk == 0 && F.tid == 0) misc[MI_NPAN] = base[NEXP] / 256;
        __syncthreads();
    }
}

struct MoeSched1 {
    static constexpr bool GATHER = true;
    const bf16_t* A; const bf16_t* W; int lda, ldb, ntot, G, c; const LAS int* rows; const LAS int* pe; int sw8, sa8;
    __device__ __forceinline__ bool next(int i, pg8::Unit& u) const { const int v = i * G + c; if (v >= ntot) return false; u.pm = v >> 1; u.pn = v & 1; u.ord = i; return true; }
    __device__ __forceinline__ const char* a_base(const pg8::Unit&) const { return (const char*)A; }
    __device__ __forceinline__ const char* b_base(const pg8::Unit& u) const { return (const char*)(W + (size_t)pe[u.ord] * 512 * ldb + (size_t)u.pn * 256 * ldb); }
    __device__ __forceinline__ void a_off(const pg8::Unit& u, const int (&R)[2], const int (&C)[2], unsigned (&v)[2][2]) const {
#pragma unroll
        for (int h = 0; h < 2; ++h)
#pragma unroll
            for (int i = 0; i < 2; ++i) v[h][i] = (unsigned)(rows[u.ord * 256 + h * 128 + R[i]] * lda + C[i]) * 2u;
    }
};
struct MoeSched2 {
    static constexpr bool GATHER = false;
    const bf16_t* A; const bf16_t* W; int lda, ldb, ntot, G, c; const LAS int* pe; int sw8, sa8;
    __device__ __forceinline__ bool next(int i, pg8::Unit& u) const { const int v = i * G + c; if (v >= ntot) return false; u.pm = v >> 2; u.pn = v & 3; u.ord = i; return true; }
    __device__ __forceinline__ const char* a_base(const pg8::Unit& u) const { return (const char*)(A + (size_t)u.pm * 256 * lda); }
    __device__ __forceinline__ const char* b_base(const pg8::Unit& u) const { return (const char*)(W + (size_t)pe[u.ord] * DM * ldb + (size_t)u.pn * 256 * ldb); }
    __device__ __forceinline__ void a_off(const pg8::Unit&, const int (&R)[2], const int (&C)[2], unsigned (&v)[2][2]) const {
#pragma unroll
        for (int i = 0; i < 2; ++i) { v[0][i] = (unsigned)(R[i] * lda + C[i]) * 2u; v[1][i] = (unsigned)((128 + R[i]) * lda + C[i]) * 2u; }
    }
};
struct EpiSwiGLU {
    bf16_t* H;
    __device__ __forceinline__ void operator()(const f32x4 (&acc)[2][2][4][2], const pg8::Unit& u, int wr, int wc, int fr, int fq) const {
        const int row0 = u.pm * 256 + wr * 64 + fr, col0 = u.pn * 128 + wc * 16 + 4 * fq;
#pragma unroll
        for (int ai = 0; ai < 2; ++ai)
#pragma unroll
            for (int m = 0; m < 4; ++m) { bf16_t* rowp = H + (size_t)(row0 + ai * 128 + m * 16) * DEXP + col0;
#pragma unroll
                for (int bj = 0; bj < 2; ++bj) { const f32x4 v0 = acc[ai][bj][m][0], v1 = acc[ai][bj][m][1];
                    const float h0 = v0[0] * sigmoidf_(v0[0]) * v0[1], h1 = v0[2] * sigmoidf_(v0[2]) * v0[3], h2 = v1[0] * sigmoidf_(v1[0]) * v1[1], h3 = v1[2] * sigmoidf_(v1[2]) * v1[3];
                    *(unsigned*)((unsigned char*)H + (size_t)(row0 + ai * 128 + m * 16) * DEXP + col0 + bj * 64) = pk4_fp8(h0 * 16.f, h1 * 16.f, h2 * 16.f, h3 * 16.f); (void)rowp; } }
    }
};
struct EpiStoreBf16 {
    bf16_t* O; int ldc;
    __device__ __forceinline__ void operator()(const f32x4 (&acc)[2][2][4][2], const pg8::Unit& u, int wr, int wc, int fr, int fq) const {
        const int row0 = u.pm * 256 + wr * 64 + fr, col0 = u.pn * 256 + wc * 32 + 8 * fq;
#pragma unroll
        for (int ai = 0; ai < 2; ++ai)
#pragma unroll
            for (int m = 0; m < 4; ++m) { bf16_t* rowp = O + (size_t)(row0 + ai * 128 + m * 16) * ldc + col0;
#pragma unroll
                for (int bj = 0; bj < 2; ++bj) store8_fp8((unsigned char*)O + (size_t)(row0 + ai * 128 + m * 16) * ldc + col0 + bj * 128, acc[ai][bj][m][0], acc[ai][bj][m][1], 64.f); (void)rowp; }
    }
};

__device__ __forceinline__ void phase_moe_gemm1(Frame& F) {
    PHASE_IDS(F);
    const unsigned* misc = (const unsigned*)(F.ws + WS_MISC);
    const int* rowtok = (const int*)(F.ws + WS_ROWTOK);
    const int npan = (int)misc[MI_NPAN];
    LAS int* rows = (LAS int*)(F.lds + L_ROWS); LAS int* pe = (LAS int*)(F.lds + L_PE);
    const int c = (int)blockIdx.x, ntot = npan * 2;
    for (int i = 0; i * F.G + c < ntot && i < 8; ++i) { const int p = (i * F.G + c) >> 1;
        if (F.tid < 256) rows[i * 256 + F.tid] = rowtok[p * 256 + F.tid];
        if (F.tid == 256) pe[i] = (int)misc[MI_PANEL_E + p]; }
    VM_WAIT(); LDS_WAIT(); __syncthreads();
    MoeSched1 S{(const bf16_t*)(F.ws + WS_XB8), (const bf16_t*)(F.ws + WS_W13), DM / 2, DM / 2, ntot, F.G, c, rows, pe, F8_SW, F8_SA_X};
    EpiSwiGLU E{(bf16_t*)(F.ws + WS_H)};
    pg8::gemm_phase<EpiSwiGLU, MoeSched1, true, true>(F.lds, DM / 2, S, E);
}
__device__ __forceinline__ void phase_moe_gemm2(Frame& F) {
    PHASE_IDS(F);
    const unsigned* misc = (const unsigned*)(F.ws + WS_MISC);
    const int npan = (int)misc[MI_NPAN];
    LAS int* pe = (LAS int*)(F.lds + L_PE);
    const int c = (int)blockIdx.x, ntot = npan * 4;
    __syncthreads();
    if (F.tid < 16) { const int v = F.tid * F.G + c; if (v < ntot) pe[F.tid] = (int)misc[MI_PANEL_E + (v >> 2)]; }
    VM_WAIT(); LDS_WAIT(); __syncthreads();
    MoeSched2 S{(const bf16_t*)(F.ws + WS_H), (const bf16_t*)(F.ws + WS_W2), DEXP / 2, DEXP / 2, ntot, F.G, c, pe, F8_SW, 127 - 4};
    EpiStoreBf16 E{(bf16_t*)(F.ws + WS_Y), DM};
    int k2 = DEXP / 2; asm volatile("" : "+s"(k2));
    pg8::gemm_phase<EpiStoreBf16, MoeSched2, true, true>(F.lds, k2, S, E);
}

__device__ __forceinline__ void phase_combine_ln2(Frame& F, int l) {
    PHASE_IDS(F);
    const int lane = F.lane;
    const float* lg = F.in[21] + (size_t)l * DM; const float* lb = F.in[22] + (size_t)l * DM;
    f32x4 g[4], b[4];
#pragma unroll
    for (int j = 0; j < 4; ++j) { g[j] = ((const f32x4*)lg)[lane + 64 * j]; b[j] = ((const f32x4*)lb)[lane + 64 * j]; }
    const bf16_t* Y = (const bf16_t*)(F.ws + WS_Y);
    const float* l1g = F.in[12] + (size_t)l * DM; const float* l1b = F.in[13] + (size_t)l * DM; const float* stats = (const float*)(F.ws + WS_WR + 512 * 1024);
    f32x4 g1[4], b1[4];
#pragma unroll
    for (int j = 0; j < 4; ++j) { g1[j] = ((const f32x4*)l1g)[lane + 64 * j]; b1[j] = ((const f32x4*)l1b)[lane + 64 * j]; }
    const int* route = (const int*)(F.ws + WS_ROUTE); const int* rpos = (const int*)(F.ws + WS_RPOS);
    const int gw = F.vcu * NWAVES + F.wave, NGW = F.G * NWAVES;
    int4 rt_n = *(const int4*)(route + (size_t)gw * 4); int2 rp_n = *(const int2*)(rpos + (size_t)gw * 2); f32x2 st_n = *(const f32x2*)(stats + (size_t)gw * 2);
    for (int row = gw; row < TT; row += NGW) {
        const int4 rt = rt_n; const int2 rp = rp_n; const f32x2 st = st_n;
        { const int nr = (row + NGW < TT) ? row + NGW : row; rt_n = *(const int4*)(route + (size_t)nr * 4); rp_n = *(const int2*)(rpos + (size_t)nr * 2); st_n = *(const f32x2*)(stats + (size_t)nr * 2); }
        const float w0 = __int_as_float(rt.z) * (1.f / 64.f), w1 = __int_as_float(rt.w) * (1.f / 64.f);
        const f32x4* px = (const f32x4*)(F.out + (size_t)row * DM);
        const unsigned* y0 = (const unsigned*)((const unsigned char*)Y + (size_t)rp.x * DM); const unsigned* y1 = (const unsigned*)((const unsigned char*)Y + (size_t)rp.y * DM);
        f32x4 v[4];
#pragma unroll
        for (int j = 0; j < 4; ++j) {
            const f32x4 x = (px[lane + 64 * j] - st[0]) * st[1] * g1[j] + b1[j]; const unsigned a = y0[lane + 64 * j], c = y1[lane + 64 * j];
            const f32x2 a01 = __builtin_amdgcn_cvt_pk_f32_fp8((int)a, false), a23 = __builtin_amdgcn_cvt_pk_f32_fp8((int)a, true), c01 = __builtin_amdgcn_cvt_pk_f32_fp8((int)c, false), c23 = __builtin_amdgcn_cvt_pk_f32_fp8((int)c, true);
            v[j].x = ALPHA * x.x + w0 * a01[0] + w1 * c01[0]; v[j].y = ALPHA * x.y + w0 * a01[1] + w1 * c01[1];
            v[j].z = ALPHA * x.z + w0 * a23[0] + w1 * c23[0]; v[j].w = ALPHA * x.w + w0 * a23[1] + w1 * c23[1];
        }
        ln_row(v, g, b);
#pragma unroll
        for (int j = 0; j < 4; ++j) ((f32x4*)(F.out + (size_t)row * DM))[lane + 64 * j] = v[j];
        if (l == 0) {
#pragma unroll
            for (int j = 0; j < 4; ++j) ((unsigned*)(F.ws + WS_XB8 + (size_t)row * DM))[lane + 64 * j] = pk4_fp8(v[j].x * 16.f, v[j].y * 16.f, v[j].z * 16.f, v[j].w * 16.f);
        }
    }
}

constexpr float C2D = 0.18033688011112042f;
constexpr float C2M = 0.14724444602590306f;
constexpr float IWS = 0.044194173824159216f;
constexpr float RMS_EPS = 1e-6f;
constexpr int L_QSLOT = L_CTL + 1152;

__device__ __forceinline__ int rope16(int c) { return c < 16 ? (c >> 1) + 8 * (c & 1) : c; }
__device__ __forceinline__ int win_src(int n, float& sc) {
    sc = 1.f;
    if (n < 384) return n;
    if (n < 416) { const int c = n - 384; return 384 + (c >> 1) + 16 * (c & 1); }
    if (n < 512) return -1;
    if (n < 2816) { const int m = n - 512, g = m / 768, r = m % 768, p = r >> 8, hh = (r & 255) >> 6, c = r & 63; if (p == 0) sc = C2D; return 416 + 768 * g + 256 * p + 64 * hh + (p < 2 ? rope16(c) : c); }
    if (n < 3328) { const int m = n - 2816; sc = C2D; return 2720 + (m & ~63) + rope16(m & 63); }
    if (n < 3840) { const int m = n - 3328; return 3360 + (m & ~63) + rope16(m & 63); }
    const int m = n - 3840;
    if (m < 64) return 3232 + rope16(m);
    if (m < 128) return 3296 + (m - 64);
    if (m < 192) return 3872 + rope16(m - 128);
    if (m < 200) { sc = IWS; return 3936 + (m - 192); }
    return -1;
}

__device__ __forceinline__ void sincos_d(double x, double& s, double& c) {
    const double n = __builtin_rint(x * 0.15915494309189535);
    double r = __builtin_fma(-n, 6.2831854820251465, x); r = __builtin_fma(n, 1.7484556025237907e-07, r);
    const double r2 = r * r; double ss = 1.0, cc = 1.0;
#pragma unroll
    for (int k = 15; k >= 1; --k) { ss = 1.0 - r2 * (1.0 / (double)((2 * k) * (2 * k + 1))) * ss; cc = 1.0 - r2 * (1.0 / (double)((2 * k - 1) * (2 * k))) * cc; }
    s = ss * r; c = cc;
}
__device__ __forceinline__ double inv_freq16(int i) {
    const double t[16] = {1.0, 0.44036660267178046, 0.19392274474868576, 0.08539710028576561, 0.03760603093086393, 0.016560440080994446, 0.007292664737217109, 0.003211445994752591,
                          0.001414213562373095, 0.000622772421914596, 0.0002742481756762073, 0.00012076973741146504, 5.318295896944988e-05, 2.341999896140934e-05, 1.031338537721246e-05, 4.5416704806078695e-06};
    double r = t[0];
#pragma unroll
    for (int k = 1; k < 16; ++k) r = (i == k) ? t[k] : r;
    return r;
}

__device__ __forceinline__ void phase_conv_mixer(Frame& F, int l) {
    PHASE_IDS(F);
    LAS float* scr = (LAS float*)(F.lds + F.wave * 16384);
    const int gw = F.vcu * NWAVES + F.wave, NGW = F.G * NWAVES;
    const float* win = F.in[1] + (size_t)l * DM * CIN;
    const float* qg = F.in[2] + (size_t)l * 256; const float* wuq = F.in[3] + (size_t)l * 256 * 768;
    const float* kg = F.in[4] + (size_t)l * 128; const float* wukv = F.in[5] + (size_t)l * 128 * 1024;
    const float* wgate = F.in[6] + (size_t)l * DM * 3072;
    const float* wa = F.in[8] + (size_t)l * 512 * DM; const float* wb = F.in[9] + (size_t)l * 256 * DM; const float* wc = F.in[10] + (size_t)l * 512 * DM; const float* wo = F.in[11] + (size_t)l * DM * DM;
    unsigned char* WIN8 = F.ws + WS_WIN8; bf16_t* WUQ = (bf16_t*)(F.ws + WS_WUQ); bf16_t* WUKV = (bf16_t*)(F.ws + WS_WUKV);
    bf16_t* WA = (bf16_t*)(F.ws + WS_WA); bf16_t* WB = (bf16_t*)(F.ws + WS_WB); bf16_t* WC = (bf16_t*)(F.ws + WS_WC); bf16_t* WO = (bf16_t*)(F.ws + WS_WO);
    constexpr int I_IN = 16 * 128, I_G = 16 * 96, I_UQ = 4 * 24, I_UKV = 4 * 32, I_A = 8 * 32, I_B = 8 * 32, I_C = 8 * 32, I_O = 16 * 32;
    constexpr int NIT = I_IN + I_G + I_UQ + I_UKV + I_A + I_B + I_C + I_O;
    for (int it = gw; it < NIT; it += NGW) {
        int r = it;
        if (r < I_IN) { conv_item8(WIN8, DM, (r / 128) * 64, (r % 128) * 32, scr, F.lane, [&](int k, int n) { float sc; const int sidx = win_src(n, sc); return sidx < 0 ? 0.f : win[(size_t)k * CIN + sidx] * (sc * 1024.f); }); continue; } r -= I_IN;
        if (r < I_G) { conv_plain8(WIN8 + (size_t)PW * DM, DM, (r / 96) * 64, (r % 96) * 32, scr, F.lane, wgate, 3072, 1024.f); continue; } r -= I_G;
        if (r < I_UQ) { conv_item(WUQ, 256, (r / 24) * 64, (r % 24) * 32, scr, F.lane, [&](int k, int n) { const int hh = n / 96, c = n % 96; const int o = c < 64 ? c : 64 + ((c - 64) >> 1) + 16 * ((c - 64) & 1);
                return qg[k] * wuq[(size_t)k * 768 + hh * 96 + o] * C2M; }); continue; } r -= I_UQ;
        if (r < I_UKV) { conv_item(WUKV, 256, (r / 32) * 64, (r % 32) * 32, scr, F.lane, [&](int k, int n) { return k < 128 ? kg[k] * wukv[(size_t)k * 1024 + n] : 0.f; }); continue; } r -= I_UKV;
        if (r < I_A) { conv_plain8((unsigned char*)WA, 512, (r / 32) * 64, (r % 32) * 32, scr, F.lane, wa, DM, 1024.f); continue; } r -= I_A;
        if (r < I_B) { conv_item8((unsigned char*)WB, 512, (r / 32) * 64, (r % 32) * 32, scr, F.lane, [&](int k, int n) { return k < 256 ? wb[(size_t)k * DM + n] * 1024.f : 0.f; }); continue; } r -= I_B;
        if (r < I_C) { conv_plain8((unsigned char*)WC, 512, (r / 32) * 64, (r % 32) * 32, scr, F.lane, wc, DM, 1024.f); continue; } r -= I_C;
        conv_plain8((unsigned char*)WO, DM, (r / 32) * 64, (r % 32) * 32, scr, F.lane, wo, DM, 1024.f);
    }
    if (l == 0) {
        float* rp = (float*)(F.ws + WS_ROPE); float* rm = rp + 2048 * 8 * 2;
        for (int idx = F.vcu * NTHREADS + F.tid; idx < 2048 * 24; idx += F.G * NTHREADS) {
            const int t = idx / 24, j = idx % 24; double sn, cs;
            if (j < 8) { sincos_d((double)t * inv_freq16(2 * j), sn, cs); rp[(t * 8 + j) * 2] = (float)cs; rp[(t * 8 + j) * 2 + 1] = (float)sn; }
            else { sincos_d((double)t * inv_freq16(j - 8), sn, cs); rm[(t * 16 + (j - 8)) * 2] = (float)cs; rm[(t * 16 + (j - 8)) * 2 + 1] = (float)sn; }
        }
        const f32x4* x4 = (const f32x4*)F.in[0]; unsigned* xb8 = (unsigned*)(F.ws + WS_XB8);
        for (size_t i = (size_t)F.vcu * NTHREADS + F.tid; i < (size_t)TT * DM / 4; i += (size_t)F.G * NTHREADS) { const f32x4 v = x4[i] * 16.f; xb8[i] = pk4_fp8(v.x, v.y, v.z, v.w); }
    }
}

__device__ __forceinline__ void rope4(f32x4& v0, f32x4& v1, const float* cs) {
    const f32x4 a = *(const f32x4*)cs, b = *(const f32x4*)(cs + 4);
    const f32x4 w0 = {v0[0] * a[0] - v0[1] * a[1], v0[1] * a[0] + v0[0] * a[1], v0[2] * a[2] - v0[3] * a[3], v0[3] * a[2] + v0[2] * a[3]};
    const f32x4 w1 = {v1[0] * b[0] - v1[1] * b[1], v1[1] * b[0] + v1[0] * b[1], v1[2] * b[2] - v1[3] * b[3], v1[3] * b[2] + v1[2] * b[3]};
    v0 = w0; v1 = w1;
}
__device__ __forceinline__ void store8(bf16_t* p, const f32x4& v0, const f32x4& v1) {
    u32x4 w; w.x = cvt_pk_bf16(v0[0], v0[1]); w.y = cvt_pk_bf16(v0[2], v0[3]); w.z = cvt_pk_bf16(v1[0], v1[1]); w.w = cvt_pk_bf16(v1[2], v1[3]); *(u32x4*)p = w;
}
struct EpiProj {
    bf16_t* P; const float* csp; const float* csm; float* ssq; bf16_t* G3; const LAS float* gbias;
    __device__ __forceinline__ void operator()(const f32x4 (&acc)[2][2][4][2], const pg8::Unit& u, int wr, int wc, int fr, int fq) const {
        const int pn = u.pn, row0 = u.pm * 256 + wr * 64 + fr;
        if (pn >= 16) {
#pragma unroll
            for (int bj = 0; bj < 2; ++bj) { const int col = (pn - 16) * 256 + bj * 128 + wc * 32 + fq * 8;
                const f32x4 b0 = *(const LAS f32x4*)(gbias + col), b1 = *(const LAS f32x4*)(gbias + col + 4);
#pragma unroll
                for (int ai = 0; ai < 2; ++ai)
#pragma unroll
                    for (int m = 0; m < 4; ++m) { f32x4 v0 = acc[ai][bj][m][0] + b0, v1 = acc[ai][bj][m][1] + b1;
#pragma unroll
                        for (int e = 0; e < 4; ++e) { v0[e] = sigmoidf_(v0[e]); v1[e] = sigmoidf_(v1[e]); }
                        store8_fp8((unsigned char*)G3 + (size_t)(row0 + ai * 128 + m * 16) * 3072 + col, v0, v1, 64.f); } }
            return;
        }
#pragma unroll
        for (int bj = 0; bj < 2; ++bj) {
            const int wcu = __builtin_amdgcn_readfirstlane(wc);
            bool ropeP = false, ropeM = false;
            if (pn == 1) ropeM = (bj == 1 && wcu == 0);
            else if (pn >= 2 && pn < 11) ropeP = ((pn - 2) % 3) < 2 && !(wcu & 1);
            else if (pn >= 11 && pn < 15) ropeP = !(wcu & 1);
            else if (pn == 15) ropeP = (wcu == 0);
            const int col = pn * 256 + bj * 128 + wc * 32 + fq * 8;
            if (ropeP || ropeM) {
                const bool lr = ropeM || fq < 2;
                const float* cb = ropeM ? csm + 8 * fq : csp + 8 * (fq & 1);
                const int ts = ropeM ? 32 : 16;
#pragma unroll
                for (int ai = 0; ai < 2; ++ai)
#pragma unroll
                    for (int mh = 0; mh < 2; ++mh) {
                        f32x4 ca[2], cc[2];
#pragma unroll
                        for (int mm = 0; mm < 2; ++mm) { const int t = (row0 + ai * 128 + (2 * mh + mm) * 16) & (SEQ - 1);
                            ca[mm] = *(const f32x4*)(cb + t * ts); cc[mm] = *(const f32x4*)(cb + t * ts + 4); }
#pragma unroll
                        for (int mm = 0; mm < 2; ++mm) { const int m = 2 * mh + mm, row = row0 + ai * 128 + m * 16;
                            const f32x4 v0 = acc[ai][bj][m][0], v1 = acc[ai][bj][m][1];
                            f32x4 a = ca[mm], b = cc[mm];
                            if (!lr) { a = (f32x4){1.f, 0.f, 1.f, 0.f}; b = a; }
                            const f32x4 w0 = {v0[0] * a[0] - v0[1] * a[1], v0[1] * a[0] + v0[0] * a[1], v0[2] * a[2] - v0[3] * a[3], v0[3] * a[2] + v0[2] * a[3]};
                            const f32x4 w1 = {v1[0] * b[0] - v1[1] * b[1], v1[1] * b[0] + v1[0] * b[1], v1[2] * b[2] - v1[3] * b[3], v1[3] * b[2] + v1[2] * b[3]};
                            store8(P + (size_t)row * PW + col, w0, w1); }
                    }
            } else {
#pragma unroll
                for (int ai = 0; ai < 2; ++ai)
#pragma unroll
                    for (int m = 0; m < 4; ++m)
                        store8(P + (size_t)(row0 + ai * 128 + m * 16) * PW + col, acc[ai][bj][m][0], acc[ai][bj][m][1]);
            }
        }
        if (pn < 2) {
#pragma unroll
            for (int ai = 0; ai < 2; ++ai)
#pragma unroll
                for (int m = 0; m < 4; ++m) {
                    float sq = 0.f;
#pragma unroll
                    for (int bj = 0; bj < 2; ++bj) if (pn == 0 || bj == 0) {
#pragma unroll
                        for (int n = 0; n < 2; ++n) { const f32x4 x = acc[ai][bj][m][n]; sq += (x[0] * x[0] + x[1] * x[1]) + (x[2] * x[2] + x[3] * x[3]); } }
                    sq += __shfl_xor(sq, 16); sq += __shfl_xor(sq, 32);
                    if (fq == 0) ssq[(size_t)(row0 + ai * 128 + m * 16) * 8 + pn * 4 + wc] = sq;
                }
        }
    }
};
struct EpiUpQ {
    bf16_t* Q; const float* csm; const float* ssq;
    __device__ __forceinline__ void operator()(const f32x4 (&acc)[2][2][4][2], const pg8::Unit& u, int wr, int wc, int fr, int fq) const {
        const int row0 = u.pm * 256 + wr * 64 + fr;
        f32x4 spv[2][4];
#pragma unroll
        for (int ai = 0; ai < 2; ++ai)
#pragma unroll
            for (int m = 0; m < 4; ++m) spv[ai][m] = *(const f32x4*)(ssq + (size_t)(row0 + ai * 128 + m * 16) * 8);
#pragma unroll
        for (int ai = 0; ai < 2; ++ai)
#pragma unroll
            for (int m = 0; m < 4; ++m) { const f32x4 sp = spv[ai][m];
                spv[ai][m][0] = 1.0f / sqrtf(((sp[0] + sp[1]) + (sp[2] + sp[3])) * (1.f / 256.f) + RMS_EPS); }
        const int wcu = __builtin_amdgcn_readfirstlane(wc);
#pragma unroll
        for (int bj = 0; bj < 2; ++bj) {
            const int c0 = u.pn * 256 + bj * 128 + wcu * 32, col = c0 + fq * 8;
            if (((c0 >> 5) % 3) == 2) {
#pragma unroll
                for (int ai = 0; ai < 2; ++ai)
#pragma unroll
                    for (int mh = 0; mh < 2; ++mh) {
                        f32x4 ca[2], cc[2];
#pragma unroll
                        for (int mm = 0; mm < 2; ++mm) { const int t = (row0 + ai * 128 + (2 * mh + mm) * 16) & (SEQ - 1);
                            ca[mm] = *(const f32x4*)(csm + t * 32 + 8 * fq); cc[mm] = *(const f32x4*)(csm + t * 32 + 8 * fq + 4); }
#pragma unroll
                        for (int mm = 0; mm < 2; ++mm) { const int m = 2 * mh + mm, row = row0 + ai * 128 + m * 16;
                            const float rs = spv[ai][m][0];
                            const f32x4 v0 = acc[ai][bj][m][0] * rs, v1 = acc[ai][bj][m][1] * rs, a = ca[mm], b = cc[mm];
                            const f32x4 w0 = {v0[0] * a[0] - v0[1] * a[1], v0[1] * a[0] + v0[0] * a[1], v0[2] * a[2] - v0[3] * a[3], v0[3] * a[2] + v0[2] * a[3]};
                            const f32x4 w1 = {v1[0] * b[0] - v1[1] * b[1], v1[1] * b[0] + v1[0] * b[1], v1[2] * b[2] - v1[3] * b[3], v1[3] * b[2] + v1[2] * b[3]};
                            store8(Q + (size_t)row * 768 + col, w0, w1); }
                    }
            } else {
#pragma unroll
                for (int ai = 0; ai < 2; ++ai)
#pragma unroll
                    for (int m = 0; m < 4; ++m) { const float rs = spv[ai][m][0];
                        store8(Q + (size_t)(row0 + ai * 128 + m * 16) * 768 + col, acc[ai][bj][m][0] * rs, acc[ai][bj][m][1] * rs); }
            }
        }
    }
};
struct EpiUpKV {
    bf16_t* KV; const float* ssq;
    __device__ __forceinline__ void operator()(const f32x4 (&acc)[2][2][4][2], const pg8::Unit& u, int wr, int wc, int fr, int fq) const {
        const int row0 = u.pm * 256 + wr * 64 + fr;
        f32x4 spv[2][4];
#pragma unroll
        for (int ai = 0; ai < 2; ++ai)
#pragma unroll
            for (int m = 0; m < 4; ++m) spv[ai][m] = *(const f32x4*)(ssq + (size_t)(row0 + ai * 128 + m * 16) * 8 + 4);
#pragma unroll
        for (int ai = 0; ai < 2; ++ai)
#pragma unroll
            for (int m = 0; m < 4; ++m) {
                const int row = row0 + ai * 128 + m * 16;
                const f32x4 sp = spv[ai][m];
                const float rs = 1.0f / sqrtf(((sp[0] + sp[1]) + (sp[2] + sp[3])) * (1.f / 128.f) + RMS_EPS);
#pragma unroll
                for (int bj = 0; bj < 2; ++bj) { const int col = u.pn * 256 + bj * 128 + wc * 32 + fq * 8;
                    store8(KV + (size_t)row * 1024 + col, acc[ai][bj][m][0] * rs, acc[ai][bj][m][1] * rs); }
            }
    }
};
struct EpiBranchAll {
    bf16_t* Mg; bf16_t* M0; bf16_t* M1; const bf16_t* G3;
    __device__ __forceinline__ void operator()(const f32x4 (&acc)[2][2][4][2], const pg8::Unit& u, int wr, int wc, int fr, int fq) const {
        const int row0 = u.pm * 256 + wr * 64 + fr, br = u.ord, col0 = u.pn * 256 + wc * 32 + fq * 8;
        bf16_t* dst = br == 0 ? M0 : (br == 1 ? M1 : Mg);
#pragma unroll
        for (int ai = 0; ai < 2; ++ai)
#pragma unroll
            for (int mh = 0; mh < 2; ++mh) {
                u32x2 gw[2][2]; u32x4 ma[2][2], mb[2][2];
#pragma unroll
                for (int mm = 0; mm < 2; ++mm)
#pragma unroll
                    for (int bj = 0; bj < 2; ++bj) { const int row = row0 + ai * 128 + (2 * mh + mm) * 16, col = col0 + bj * 128;
                        gw[mm][bj] = *(const u32x2*)((const unsigned char*)G3 + (size_t)row * 3072 + br * 1024 + col);
                        ma[mm][bj] = (u32x4){0u, 0u, 0u, 0u}; mb[mm][bj] = (u32x4){0u, 0u, 0u, 0u}; }
                if (br == 2) {
#pragma unroll
                    for (int mm = 0; mm < 2; ++mm)
#pragma unroll
                        for (int bj = 0; bj < 2; ++bj) { const size_t off = (size_t)(row0 + ai * 128 + (2 * mh + mm) * 16) * DM + col0 + bj * 128;
                            const u32x2 p = *(const u32x2*)((const unsigned char*)M0 + off), q = *(const u32x2*)((const unsigned char*)M1 + off);
                            ma[mm][bj] = (u32x4){p.x, p.y, 0u, 0u}; mb[mm][bj] = (u32x4){q.x, q.y, 0u, 0u}; }
                }
#pragma unroll
                for (int mm = 0; mm < 2; ++mm)
#pragma unroll
                    for (int bj = 0; bj < 2; ++bj) { const int m = 2 * mh + mm; const size_t off = (size_t)(row0 + ai * 128 + m * 16) * DM + col0 + bj * 128; const u32x2 g = gw[mm][bj]; const u32x4 a = ma[mm][bj], b2 = mb[mm][bj];
                        const f32x2 g01 = __builtin_amdgcn_cvt_pk_f32_fp8((int)g.x, false) * (1.f / 64.f), g23 = __builtin_amdgcn_cvt_pk_f32_fp8((int)g.x, true) * (1.f / 64.f);
                        const f32x2 g45 = __builtin_amdgcn_cvt_pk_f32_fp8((int)g.y, false) * (1.f / 64.f), g67 = __builtin_amdgcn_cvt_pk_f32_fp8((int)g.y, true) * (1.f / 64.f);
                        f32x4 v0 = acc[ai][bj][m][0], v1 = acc[ai][bj][m][1];
                        const f32x2 s01 = (__builtin_amdgcn_cvt_pk_f32_fp8((int)a.x, false) + __builtin_amdgcn_cvt_pk_f32_fp8((int)b2.x, false)) * (1.f / 64.f), s23 = (__builtin_amdgcn_cvt_pk_f32_fp8((int)a.x, true) + __builtin_amdgcn_cvt_pk_f32_fp8((int)b2.x, true)) * (1.f / 64.f);
                        const f32x2 s45 = (__builtin_amdgcn_cvt_pk_f32_fp8((int)a.y, false) + __builtin_amdgcn_cvt_pk_f32_fp8((int)b2.y, false)) * (1.f / 64.f), s67 = (__builtin_amdgcn_cvt_pk_f32_fp8((int)a.y, true) + __builtin_amdgcn_cvt_pk_f32_fp8((int)b2.y, true)) * (1.f / 64.f);
                        v0[0] = v0[0] * g01[0] + s01[0]; v0[1] = v0[1] * g01[1] + s01[1]; v0[2] = v0[2] * g23[0] + s23[0]; v0[3] = v0[3] * g23[1] + s23[1];
                        v1[0] = v1[0] * g45[0] + s45[0]; v1[1] = v1[1] * g45[1] + s45[1]; v1[2] = v1[2] * g67[0] + s67[0]; v1[3] = v1[3] * g67[1] + s67[1];
                        store8_fp8((unsigned char*)dst + off, v0, v1, 64.f); }
            }
    }
};
struct BranchSched {
    static constexpr bool GATHER = false; static constexpr bool VARK = true;
    const char* A0; const char* B0; size_t sA, sB; int lda, ldb, c, sw8, sa8, G, ntile;
    __device__ __forceinline__ int ktiles(const pg8::Unit& u) const { return u.ord == 1 ? 2 : 4; }
    __device__ __forceinline__ bool next(int i, pg8::Unit& u) const { const int t = c + (i / 3) * G; if (t >= ntile) return false; u.pm = t >> 2; u.pn = t & 3; u.ord = i % 3; return true; }
    __device__ __forceinline__ const char* a_base(const pg8::Unit& u) const { return A0 + (size_t)u.ord * sA + (size_t)u.pm * 256 * lda * 2; }
    __device__ __forceinline__ const char* b_base(const pg8::Unit& u) const { return B0 + (size_t)u.ord * sB + (size_t)u.pn * 256 * ldb * 2; }
    __device__ __forceinline__ void a_off(const pg8::Unit&, const int (&R)[2], const int (&C)[2], unsigned (&v)[2][2]) const {
#pragma unroll
        for (int i = 0; i < 2; ++i) { v[0][i] = (unsigned)(R[i] * lda + C[i]) * 2u; v[1][i] = (unsigned)((128 + R[i]) * lda + C[i]) * 2u; }
    }
};
struct EpiWo {
    float* out; const float* xsrc; int rowbase;
    __device__ __forceinline__ void operator()(const f32x4 (&acc)[2][2][4][2], const pg8::Unit& u, int wr, int wc, int fr, int fq) const {
        const int row0 = rowbase + u.pm * 256 + wr * 64 + fr, col0 = u.pn * 256 + wc * 32 + fq * 8;
#pragma unroll
        for (int ai = 0; ai < 2; ++ai)
#pragma unroll
            for (int mh = 0; mh < 2; ++mh) {
                f32x4 x[2][2][2];
#pragma unroll
                for (int mm = 0; mm < 2; ++mm)
#pragma unroll
                    for (int bj = 0; bj < 2; ++bj) { const size_t off = (size_t)(row0 + ai * 128 + (2 * mh + mm) * 16) * DM + col0 + bj * 128;
                        x[mm][bj][0] = *(const f32x4*)(xsrc + off); x[mm][bj][1] = *(const f32x4*)(xsrc + off + 4); }
#pragma unroll
                for (int mm = 0; mm < 2; ++mm)
#pragma unroll
                    for (int bj = 0; bj < 2; ++bj) { const size_t off = (size_t)(row0 + ai * 128 + (2 * mh + mm) * 16) * DM + col0 + bj * 128;
                        *(f32x4*)(out + off) = x[mm][bj][0] * ALPHA + acc[ai][bj][2 * mh + mm][0]; *(f32x4*)(out + off + 4) = x[mm][bj][1] * ALPHA + acc[ai][bj][2 * mh + mm][1]; }
            }
    }
};

__device__ __forceinline__ int dequeue(Frame& F, unsigned* ctr, int& pre) {
    LAS int* slot = (LAS int*)(F.lds + L_QSLOT);
    __syncthreads();
    if (F.tid == 0) {
        *slot = (int)__hip_atomic_fetch_add(ctr, 1u, __ATOMIC_RELAXED, __HIP_MEMORY_SCOPE_AGENT); (void)pre;
    }
    __syncthreads();
    return *slot;
}

namespace att {
constexpr int KSLOT = 12288, VSLOT = 8192, NSLOT = 4;
constexpr int A_K = 0, A_V = NSLOT * KSLOT, A_WS = A_V + NSLOT * VSLOT, A_OST = A_WS + 8 * 256, A_MW = A_OST + 8 * 4096, A_END = A_MW + 8 * NSLOT * 256;
static_assert(A_END <= RING_BYTES, "attention LDS");
typedef short s16x4 __attribute__((ext_vector_type(4)));
__device__ __forceinline__ int crow(int r, int hi) { return (r & 3) + 8 * (r >> 2) + 4 * hi; }
__device__ __forceinline__ void glds16(const void* gsrc, unsigned lds_dst) { unsigned keep;
    asm volatile("s_mov_b32 %0, m0\n\ts_mov_b32 m0, %2\n\ts_nop 0\n\tglobal_load_lds_dwordx4 %1, off\n\ts_mov_b32 m0, %0" : "=&s"(keep) : "v"(gsrc), "s"(lds_dst) : "memory"); }
__device__ __forceinline__ void glds4(const void* gsrc, unsigned lds_dst) { unsigned keep;
    asm volatile("s_mov_b32 %0, m0\n\ts_mov_b32 m0, %2\n\ts_nop 0\n\tglobal_load_lds_dword %1, off\n\ts_mov_b32 m0, %0" : "=&s"(keep) : "v"(gsrc), "s"(lds_dst) : "memory"); }
#define ATT_WAIT_BAR(N) asm volatile("s_waitcnt vmcnt(" #N ") lgkmcnt(0)\n\ts_barrier" ::: "memory")
__device__ __forceinline__ float emax(float a, float b) { return __builtin_elementwise_maximum(a, b); }
__device__ __forceinline__ float halfmax(float m) { auto rr = __builtin_amdgcn_permlane32_swap(__float_as_uint(m), __float_as_uint(m), false, false); return emax(__uint_as_float(rr[0]), __uint_as_float(rr[1])); }
__device__ __forceinline__ float halfsum(float m) { auto rr = __builtin_amdgcn_permlane32_swap(__float_as_uint(m), __float_as_uint(m), false, false); return __uint_as_float(rr[0]) + __uint_as_float(rr[1]); }
typedef short v4i16_t __attribute__((ext_vector_type(4)));
__device__ __forceinline__ s16x4 vtr(const LAS unsigned char* p) { return __builtin_bit_cast(s16x4, __builtin_amdgcn_ds_read_tr16_b64_v4i16((LAS v4i16_t*)p)); }
__device__ __forceinline__ void pv(f32x16* o, f32x16& lacc, const LAS unsigned char* vp, bf16x8 pa0, bf16x8 pa1, bf16x8 pa2, bf16x8 pa3) {
    { const u32x4 one4 = {0x3F803F80u, 0x3F803F80u, 0x3F803F80u, 0x3F803F80u}; const bf16x8 ones = __builtin_bit_cast(bf16x8, one4);
      lacc = __builtin_amdgcn_mfma_f32_32x32x16_bf16(pa0, ones, lacc, 0, 0, 0); lacc = __builtin_amdgcn_mfma_f32_32x32x16_bf16(pa1, ones, lacc, 0, 0, 0);
      lacc = __builtin_amdgcn_mfma_f32_32x32x16_bf16(pa2, ones, lacc, 0, 0, 0); lacc = __builtin_amdgcn_mfma_f32_32x32x16_bf16(pa3, ones, lacc, 0, 0, 0); }
#pragma unroll
    for (int d0 = 0; d0 < 2; ++d0) { s16x4 lo[4], hi[4];
#pragma unroll
        for (int ks = 0; ks < 4; ++ks) { lo[ks] = vtr(vp + d0 * 4096 + ks * 1024); hi[ks] = vtr(vp + d0 * 4096 + ks * 1024 + 512); }
#define ATT_PK(k) (bf16x8){lo[k][0], lo[k][1], lo[k][2], lo[k][3], hi[k][0], hi[k][1], hi[k][2], hi[k][3]}
        o[d0] = __builtin_amdgcn_mfma_f32_32x32x16_bf16(pa0, ATT_PK(0), o[d0], 0, 0, 0);
        o[d0] = __builtin_amdgcn_mfma_f32_32x32x16_bf16(pa1, ATT_PK(1), o[d0], 0, 0, 0);
        o[d0] = __builtin_amdgcn_mfma_f32_32x32x16_bf16(pa2, ATT_PK(2), o[d0], 0, 0, 0);
        o[d0] = __builtin_amdgcn_mfma_f32_32x32x16_bf16(pa3, ATT_PK(3), o[d0], 0, 0, 0);
#undef ATT_PK
    }
}
struct Desc {
    const bf16_t* Q; const bf16_t* K1; const bf16_t* K2; const bf16_t* V; bf16_t* O; float* lse; const unsigned* mask;
    int qpitch, k1pitch, k2pitch, vpitch, opitch, lsepitch;
    int rstride, q0, nq, jlo, jhi;
    int o8;
};
template <int DQK, int MODE>
__device__ __forceinline__ void attn_unit(LAS unsigned char* lds, const Desc& d) {
    int tid_ = threadIdx.x; asm volatile("" : "+v"(tid_));
    const int tid = tid_, lane = tid & 63, r32 = lane & 31, hi = lane >> 5, wid = __builtin_amdgcn_readfirstlane(tid >> 6);
    constexpr int ND = DQK / 16;
    const unsigned lds0 = (unsigned)(size_t)lds;
    LAS float* wsf = (LAS float*)(lds + A_WS) + wid * 64;
    const int qw = d.q0 + wid * 32;
    const bool wvalid = wid * 32 < d.nq;
    const int kkey = 8 * wid + (lane >> 3), kch = (lane & 7) ^ ((kkey >> 1) & 7);
    const bf16_t* ksrc = d.K1 + (size_t)kkey * d.rstride * d.k1pitch + kch * 8;
    const int k2key = 16 * (wid & 3) + (lane >> 2), k2ch = (lane & 3) ^ ((k2key >> 2) & 3);
    const bf16_t* k2src = (DQK == 96) ? d.K2 + (size_t)k2key * d.rstride * d.k2pitch + k2ch * 8 : nullptr;
    int kofs[ND];
#pragma unroll
    for (int d0 = 0; d0 < ND; ++d0) kofs[d0] = d0 < 4 ? r32 * 128 + (((2 * d0 + hi) ^ ((r32 >> 1) & 7)) * 16) : 8192 + r32 * 64 + (((2 * (d0 - 4) + hi) ^ ((r32 >> 2) & 3)) * 16);
    const bf16_t* vsrc = d.V + (size_t)(16 * (wid & 3) + (lane >> 2)) * d.rstride * d.vpitch + (wid >> 2) * 32 + (lane & 3) * 8;
    const size_t kstep = (size_t)64 * d.rstride * d.k1pitch, k2step = (size_t)64 * d.rstride * d.k2pitch, vstep = (size_t)64 * d.rstride * d.vpitch;
    const bool two = (DQK == 96) && wid < 4;
    const unsigned* msrc = (MODE == 2) ? d.mask + (size_t)(wvalid ? (qw + (lane >> 1)) : d.q0) * 64 + (lane & 1) : nullptr;
#define ATT_ISSUE(j) do { const int sl_ = (j) % NSLOT; \
        glds16(ksrc + (size_t)(j) * kstep, (unsigned)__builtin_amdgcn_readfirstlane(lds0 + A_K + sl_ * KSLOT + wid * 1024)); \
        if (two) glds16(k2src + (size_t)(j) * k2step, (unsigned)__builtin_amdgcn_readfirstlane(lds0 + A_K + sl_ * KSLOT + (8 + wid) * 1024)); \
        glds16(vsrc + (size_t)(j) * vstep, (unsigned)__builtin_amdgcn_readfirstlane(lds0 + A_V + sl_ * VSLOT + wid * 1024)); \
        if (MODE == 2) glds4(msrc + 2 * (j), (unsigned)__builtin_amdgcn_readfirstlane(lds0 + A_MW + (wid * NSLOT + sl_) * 256)); } while (0)
    ATT_ISSUE(d.jlo);
    if (d.jlo + 1 < d.jhi) ATT_ISSUE(d.jlo + 1);
    bf16x8 qr[ND];
    { const int qi = wvalid ? (qw + r32) : d.q0; const bf16_t* qp = d.Q + (size_t)qi * d.rstride * d.qpitch + hi * 8;
#pragma unroll
      for (int d0 = 0; d0 < ND; ++d0) qr[d0] = *(const bf16x8*)(qp + d0 * 16); }
#pragma unroll
    for (int d0 = 0; d0 < ND; ++d0) asm volatile("" : "+v"(qr[d0]));
    float mhat = 0.f; f32x16 o[2]; o[0] = f32x16{}; o[1] = f32x16{}; f32x16 lacc = f32x16{};
    bool started = false;
    const LAS unsigned char* vp0 = lds + A_V + ((lane >> 4) & 1) * 32 + (lane & 3) * 8 + (4 * hi + ((lane & 15) >> 2)) * 64;
    const int qi = qw + r32;
    f32x16 p0 = f32x16{}, p1 = f32x16{};
    f32x16 negm = f32x16{};
#define ATT_REL(j) (wvalid && (64 * (j) <= qw + 31) && (MODE != 1 || (64 * (j) + 63 >= qw - 128)))
#define ATT_QK(j) do { const int sl_ = (j) % NSLOT; \
        const LAS unsigned char* kb = lds + A_K + sl_ * KSLOT; bf16x8 kf[2 * ND]; \
        _Pragma("unroll") for (int d0 = 0; d0 < ND; ++d0) { kf[2 * d0] = *(const LAS bf16x8*)(kb + kofs[d0]); kf[2 * d0 + 1] = *(const LAS bf16x8*)(kb + kofs[d0] + (d0 < 4 ? 4096 : 2048)); } \
        __builtin_amdgcn_sched_barrier(0); \
        _Pragma("unroll") for (int d0 = 0; d0 < ND; ++d0) { \
            if (d0 == 0) { p0 = __builtin_amdgcn_mfma_f32_32x32x16_bf16(kf[0], qr[0], negm, 0, 0, 0); p1 = __builtin_amdgcn_mfma_f32_32x32x16_bf16(kf[1], qr[0], negm, 0, 0, 0); } \
            else { p0 = __builtin_amdgcn_mfma_f32_32x32x16_bf16(kf[2 * d0], qr[d0], p0, 0, 0, 0); p1 = __builtin_amdgcn_mfma_f32_32x32x16_bf16(kf[2 * d0 + 1], qr[d0], p1, 0, 0, 0); } } } while (0)
#define ATT_SMPV(j) do { const int sl_ = (j) % NSLOT; \
        { bool domask = true; unsigned mx_ = 0u, my_ = 0u;        \
          if (MODE == 2) { const u32x2 mw = *(const LAS u32x2*)(lds + A_MW + (wid * NSLOT + sl_) * 256 + r32 * 8); mx_ = mw.x; my_ = mw.y; } \
          else { \
            bool full = (64 * (j) + 63 <= qw); \
            if (MODE == 1) full = full && (64 * (j) >= qw + 31 - 128); \
            domask = !full; \
            if (domask) { const int a_ = qi - 64 * (j), lo_ = (MODE == 1) ? a_ - 128 : -4096;        \
                { const int h_ = a_ < 31 ? a_ : 31, l_ = lo_ > 0 ? lo_ : 0; mx_ = (h_ < l_) ? 0u : ((0xFFFFFFFFu >> (31 - h_)) & (0xFFFFFFFFu << l_)); } \
                { const int h_ = a_ - 32 < 31 ? a_ - 32 : 31, l_ = lo_ - 32 > 0 ? lo_ - 32 : 0; my_ = (h_ < l_) ? 0u : ((0xFFFFFFFFu >> (31 - h_)) & (0xFFFFFFFFu << l_)); } } \
          } \
          if (domask) { const unsigned w0 = mx_ >> (4 * hi), w1 = my_ >> (4 * hi); \
            _Pragma("unroll") for (int r = 0; r < 16; ++r) { const int bit = (r & 3) + 8 * (r >> 2); \
                const unsigned m0 = (unsigned)__builtin_amdgcn_sbfe((int)w0, bit, 1), m1 = (unsigned)__builtin_amdgcn_sbfe((int)w1, bit, 1);        \
                p0[r] = __uint_as_float((m0 & __float_as_uint(p0[r])) | (~m0 & 0xFF800000u)); p1[r] = __uint_as_float((m1 & __float_as_uint(p1[r])) | (~m1 & 0xFF800000u)); } } } \
        float rm = emax(p0[0], p1[0]), rm2 = emax(p0[1], p1[1]); \
        _Pragma("unroll") for (int r = 2; r < 16; r += 2) { rm = emax(emax(rm, p0[r]), p1[r]); rm2 = emax(emax(rm2, p0[r + 1]), p1[r + 1]); } \
        rm = halfmax(emax(rm, rm2)); \
        bool need; float dl; \
        if (!started) { need = true; dl = emax(rm, -200.f); } else { need = __any(rm > 8.f) != 0; dl = emax(rm, 0.f); } \
        if (need) { mhat += dl; \
            _Pragma("unroll") for (int r = 0; r < 16; ++r) negm[r] = -mhat; \
            _Pragma("unroll") for (int r = 0; r < 16; ++r) { p0[r] -= dl; p1[r] -= dl; } \
            if (started) { const float f = __builtin_amdgcn_exp2f(-dl); \
                if (hi == 0) wsf[r32] = f; \
                LDS_WAIT(); \
                _Pragma("unroll") for (int r = 0; r < 16; ++r) { const float fr_ = wsf[crow(r, hi)]; o[0][r] *= fr_; o[1][r] *= fr_; lacc[r] *= fr_; } } } \
        started = true; \
        __builtin_amdgcn_s_setprio(1);        \
        _Pragma("unroll") for (int r = 0; r < 16; ++r) { p0[r] = __builtin_amdgcn_exp2f(p0[r]); p1[r] = __builtin_amdgcn_exp2f(p1[r]); } \
        const u32x4 pw0 = (u32x4){cvt_pk_bf16(p0[0], p0[1]), cvt_pk_bf16(p0[2], p0[3]), cvt_pk_bf16(p0[4], p0[5]), cvt_pk_bf16(p0[6], p0[7])}; \
        const u32x4 pw1 = (u32x4){cvt_pk_bf16(p0[8], p0[9]), cvt_pk_bf16(p0[10], p0[11]), cvt_pk_bf16(p0[12], p0[13]), cvt_pk_bf16(p0[14], p0[15])}; \
        const u32x4 pw2 = (u32x4){cvt_pk_bf16(p1[0], p1[1]), cvt_pk_bf16(p1[2], p1[3]), cvt_pk_bf16(p1[4], p1[5]), cvt_pk_bf16(p1[6], p1[7])}; \
        const u32x4 pw3 = (u32x4){cvt_pk_bf16(p1[8], p1[9]), cvt_pk_bf16(p1[10], p1[11]), cvt_pk_bf16(p1[12], p1[13]), cvt_pk_bf16(p1[14], p1[15])}; \
        pv(o, lacc, vp0 + sl_ * VSLOT, __builtin_bit_cast(bf16x8, pw0), __builtin_bit_cast(bf16x8, pw1), __builtin_bit_cast(bf16x8, pw2), __builtin_bit_cast(bf16x8, pw3)); \
        __builtin_amdgcn_s_setprio(0); } while (0)
#define ATT_TOPWAIT(j) do { if ((j) + 1 < d.jhi) { if (MODE == 2 || two) { ATT_WAIT_BAR(3); } else { ATT_WAIT_BAR(2); } } else { ATT_WAIT_BAR(0); } } while (0)
    if (wid < 4) {
        for (int j = d.jlo; j < d.jhi; ++j) {
            ATT_TOPWAIT(j);
            if (j + 2 < d.jhi) ATT_ISSUE(j + 2);
            if (ATT_REL(j)) { ATT_QK(j); ATT_SMPV(j); }
        }
        asm volatile("s_waitcnt lgkmcnt(0)\n\ts_barrier" ::: "memory");
    } else {
        ATT_TOPWAIT(d.jlo);
        if (d.jlo + 2 < d.jhi) ATT_ISSUE(d.jlo + 2);
        if (ATT_REL(d.jlo)) ATT_QK(d.jlo);
        for (int j = d.jlo + 1; j < d.jhi; ++j) {
            ATT_TOPWAIT(j);
            if (j + 2 < d.jhi) ATT_ISSUE(j + 2);
            if (ATT_REL(j - 1)) ATT_SMPV(j - 1);
            if (ATT_REL(j)) ATT_QK(j);
        }
        asm volatile("s_waitcnt lgkmcnt(0)\n\ts_barrier" ::: "memory");
        if (ATT_REL(d.jhi - 1)) ATT_SMPV(d.jhi - 1);
    }
#undef ATT_REL
#undef ATT_QK
#undef ATT_SMPV
#undef ATT_TOPWAIT
#undef ATT_ISSUE
    if (wvalid) {
        LAS bf16_t* stg = (LAS bf16_t*)(lds + A_OST) + wid * 2048;
        if (d.lse != nullptr && r32 == 0) {
#pragma unroll
            for (int r = 0; r < 16; ++r) wsf[32 + crow(r, hi)] = lacc[r]; }
        if (d.o8) {
            LAS unsigned char* stg8 = (LAS unsigned char*)stg;
#pragma unroll
            for (int r = 0; r < 16; ++r) { const int orow = crow(r, hi); const float rl = __builtin_amdgcn_rcpf(lacc[r]) * 32.f;
                const unsigned p = (unsigned)__builtin_amdgcn_cvt_pk_fp8_f32(o[0][r] * rl, o[1][r] * rl, 0, false);
                stg8[orow * 64 + r32] = (unsigned char)(p & 0xffu); stg8[orow * 64 + 32 + r32] = (unsigned char)((p >> 8) & 0xffu); }
            LDS_WAIT();
#pragma unroll
            for (int i = 0; i < 2; ++i) { const int row = i * 16 + (lane >> 2), ch = lane & 3; const u32x4 v = *(const LAS u32x4*)(stg8 + row * 64 + ch * 16);
                *(u32x4*)((unsigned char*)d.O + (size_t)(qw + row) * d.rstride * d.opitch + ch * 16) = v; }
        } else {
#pragma unroll
        for (int r = 0; r < 16; ++r) { const int orow = crow(r, hi); const float rl = __builtin_amdgcn_rcpf(lacc[r]);
            stg[orow * 64 + r32] = (bf16_t)f2bf(o[0][r] * rl); stg[orow * 64 + 32 + r32] = (bf16_t)f2bf(o[1][r] * rl); }
        LDS_WAIT();
#pragma unroll
        for (int i = 0; i < 4; ++i) { const int row = i * 8 + (lane >> 3), ch = lane & 7; const u32x4 v = *(const LAS u32x4*)(stg + row * 64 + ch * 8);
            *(u32x4*)(d.O + (size_t)(qw + row) * d.rstride * d.opitch + ch * 8) = v; }
        }
        if (d.lse != nullptr && hi == 0) d.lse[(size_t)(qw + r32) * d.rstride * d.lsepitch] = mhat + __builtin_amdgcn_logf(wsf[32 + r32]);
    }
    asm volatile("s_waitcnt lgkmcnt(0)\n\ts_barrier" ::: "memory");
}
}

namespace idx {
constexpr int KS = 8192, I_K = 0, I_ST = 3 * KS, I_END = I_ST + 8 * 8192;
static_assert(I_END <= RING_BYTES, "indexer LDS");
__device__ __forceinline__ void score_unit(LAS unsigned char* lds, const bf16_t* PROJ, float* SC, int b, int qh  , int jg) {
    int tid_ = threadIdx.x; asm volatile("" : "+v"(tid_));
    const int tid = tid_, lane = tid & 63, r32 = lane & 31, hi = lane >> 5, wid = __builtin_amdgcn_readfirstlane(tid >> 6);
    const int qg = wid >> 1, hh = wid & 1;
    const unsigned lds0 = (unsigned)(size_t)lds;
    const int qrow = b * SEQ + qh * 128 + qg * 32 + r32;
    const bf16_t* kbase = PROJ + (size_t)(b * SEQ) * PW + 3968;
    const int kkey = 8 * wid + (lane >> 3);
    const bf16_t* ksrc = kbase + (size_t)kkey * PW + ((lane & 7) ^ ((kkey >> 1) & 7)) * 8;
    const int j0 = 4 * jg;
#define IDX_ISSUE(j) att::glds16(ksrc + (size_t)(j) * 64 * PW, (unsigned)__builtin_amdgcn_readfirstlane(lds0 + I_K + ((j) % 3) * KS + wid * 1024))
    IDX_ISSUE(j0); IDX_ISSUE(j0 + 1);
    bf16x8 qf[4][4]; float wv[4];
    { const bf16_t* qp = PROJ + (size_t)qrow * PW + 3328 + hh * 256 + hi * 8;
#pragma unroll
      for (int h = 0; h < 4; ++h)
#pragma unroll
          for (int d0 = 0; d0 < 4; ++d0) qf[h][d0] = *(const bf16x8*)(qp + h * 64 + d0 * 16);
      const u32x2 ww = *(const u32x2*)(PROJ + (size_t)qrow * PW + 4032 + hh * 4);
      wv[0] = bflo(ww.x); wv[1] = bfhi(ww.x); wv[2] = bflo(ww.y); wv[3] = bfhi(ww.y); }
#pragma unroll
    for (int h = 0; h < 4; ++h) { asm volatile("" : "+v"(wv[h]));
#pragma unroll
        for (int d0 = 0; d0 < 4; ++d0) asm volatile("" : "+v"(qf[h][d0])); }
    const int qb = qh >> 1;
    unsigned* blk = (unsigned*)SC + ((size_t)b * 36 + (size_t)(qb * (qb + 1) / 2)) * 32768; const int pitch = 128 * (qb + 1);
    f32x4 ve[4] = {};
    LAS unsigned char* stg = lds + I_ST + wid * 8192;
    const LAS unsigned char* stg2 = lds + I_ST + (wid ^ 1) * 8192;
#pragma nounroll
    for (int jj = 0; jj < 4; ++jj) { const int j = j0 + jj;
        if (jj < 2) { ATT_WAIT_BAR(1); } else if (jj == 2) { ATT_WAIT_BAR(5); } else { ATT_WAIT_BAR(4); }
        if (jj + 2 < 4) IDX_ISSUE(j + 2);
        const LAS unsigned char* kb = lds + I_K + (j % 3) * KS + r32 * 128;
#pragma nounroll
        for (int half = 0; half < 2; ++half) {
            bf16x8 kf[4];
#pragma unroll
            for (int d0 = 0; d0 < 4; ++d0) kf[d0] = *(const LAS bf16x8*)(kb + half * 4096 + (((2 * d0 + hi) ^ ((r32 >> 1) & 7)) * 16));
            f32x16 t0 = f32x16{};
#pragma unroll
            for (int h = 0; h < 4; ++h) {
                f32x16 p0 = f32x16{};
#pragma unroll
                for (int d0 = 0; d0 < 4; ++d0) p0 = __builtin_amdgcn_mfma_f32_32x32x16_bf16(kf[d0], qf[h][d0], p0, 0, 0, 0);
#pragma unroll
                for (int r = 0; r < 16; ++r) t0[r] += wv[h] * att::emax(p0[r], 0.f);
            }
#pragma unroll
            for (int g = 0; g < 4; ++g) { const int c0 = 8 * half + 2 * g + hi;
                *(LAS f32x4*)(stg + r32 * 256 + ((c0 ^ (r32 & 15)) * 16)) = (f32x4){t0[4 * g], t0[4 * g + 1], t0[4 * g + 2], t0[4 * g + 3]}; }
        }
        asm volatile("s_waitcnt lgkmcnt(0)\n\ts_barrier" ::: "memory");
#pragma unroll
        for (int i = 0; i < 4; ++i) { const int q = hh * 16 + i * 4 + (lane >> 4), c = lane & 15; const int so = q * 256 + ((c ^ (q & 15)) * 16);
            const f32x4 v = *(const LAS f32x4*)(stg + so) + *(const LAS f32x4*)(stg2 + so);
            if (jj & 1) { const f32x4 e = ve[i]; const u32x4 w = {pk2(e[0], v[0]), pk2(e[1], v[1]), pk2(e[2], v[2]), pk2(e[3], v[3])};
                *(u32x4*)(blk + (size_t)((qh & 1) * 128 + qg * 32 + q) * pitch + 64 * (j >> 1) + 4 * c) = w; }
            else ve[i] = v; }
        LDS_WAIT();
    }
#undef IDX_ISSUE
    asm volatile("s_waitcnt lgkmcnt(0)\n\ts_barrier" ::: "memory");
}

__device__ __forceinline__ int wave_sum_i(int v) {
    v += __builtin_amdgcn_update_dpp(0, v, 0xB1, 0xF, 0xF, true);
    v += __builtin_amdgcn_update_dpp(0, v, 0x4E, 0xF, 0xF, true);
    v += __builtin_amdgcn_update_dpp(0, v, 0x141, 0xF, 0xF, true);
    v += __builtin_amdgcn_update_dpp(0, v, 0x140, 0xF, 0xF, true);
    return __builtin_amdgcn_readlane(v, 0) + __builtin_amdgcn_readlane(v, 16) + __builtin_amdgcn_readlane(v, 32) + __builtin_amdgcn_readlane(v, 48);
}
__device__ __forceinline__ unsigned long long keep_low(unsigned long long m, int k) { while (__builtin_popcountll(m) > k) m &= ~(1ull << (63 - __builtin_clzll(m))); return m; }
__device__ __forceinline__ void select_rows4(const float* SC, unsigned* MASK, int row0  , int lane, LAS unsigned* slot  ) {
    const int b = row0 / SEQ, t0 = row0 % SEQ, qb = t0 >> 8;
    if (t0 < 256) {
#pragma unroll 1
        for (int i = 0; i < 4; ++i) { const int t = t0 + i, lo = 64 * lane;
            const unsigned long long w = (lo + 63 <= t) ? ~0ull : (lo > t ? 0ull : ((2ull << (t - lo)) - 1ull));
            if (lane < 32) ((unsigned long long*)(MASK + (size_t)(row0 + i) * 64))[lane] = w; }
        return;
    }
    const int pitch = 128 * (qb + 1), pmax = pitch - 1;
    const unsigned* srow0 = (const unsigned*)SC + ((size_t)b * 36 + (size_t)(qb * (qb + 1) / 2)) * 32768 + (size_t)(t0 - 256 * qb) * pitch;
    unsigned raw[16];
#pragma unroll
    for (int i = 0; i < 16; ++i) { const int s_ = 64 * i + lane; raw[i] = srow0[s_ < pmax ? s_ : pmax]; }
#pragma unroll 1
    for (int r = 0; r < 4; ++r) {
        const int t = t0 + r;
        unsigned P[16];
#pragma unroll
        for (int i = 0; i < 16; ++i) P[i] = raw[i];
        { const unsigned* nx = srow0 + (size_t)(r < 3 ? r + 1 : 3) * pitch;
#pragma unroll
          for (int i = 0; i < 16; ++i) { const int s_ = 64 * i + lane; raw[i] = nx[s_ < pmax ? s_ : pmax]; } }
#define SEL_TSTAGE(sh, m) _Pragma("unroll") for (int q = 0; q < 16; ++q) if (!(q & (sh))) { const unsigned a_ = P[q], b_ = P[q + (sh)]; \
            P[q] = (a_ & (m)) | ((b_ << (sh)) & ~(m)); P[q + (sh)] = ((a_ >> (sh)) & (m)) | (b_ & ~(m)); }
        SEL_TSTAGE(8, 0x00FF00FFu) SEL_TSTAGE(4, 0x0F0F0F0Fu) SEL_TSTAGE(2, 0x33333333u) SEL_TSTAGE(1, 0x55555555u)
#undef SEL_TSTAGE
        { const unsigned sg = P[15];
#pragma unroll
          for (int q = 0; q < 15; ++q) P[q] ^= sg;
          P[15] = ~sg; }
        const int nj = ((t - lane) >> 6) + 1;
        unsigned A = ((1u << ((nj + 1) >> 1)) - 1u) | (((1u << (nj >> 1)) - 1u) << 16), G = 0u;
        int cab = 0, cntA = t + 1;
#pragma unroll
        for (int bit = 15; bit >= 0; --bit) {
            if (cab + cntA != 256) {
                const unsigned ones = A & P[bit];
                const int c = wave_sum_i(__builtin_popcount(ones));
                if (cab + c >= 256) { A = ones; cntA = c; } else { G |= ones; cab += c; A &= ~ones; cntA -= c; }
            }
        }
        int need = 256 - cab;
        unsigned sel = G | A;
        if (cntA != need) {
            unsigned selA = 0u;
#pragma nounroll
            for (int j = 0; j < 32; ++j) { const int pb = (j >> 1) + 16 * (j & 1);
                unsigned long long m = __ballot((A >> pb) & 1u);
                if (__builtin_popcountll(m) > need) m = keep_low(m, need);
                need -= __builtin_popcountll(m);
                selA |= (unsigned)((m >> lane) & 1ull) << pb;
            }
            sel = G | selA;
        }
        int lo = 0, hi = 0;
#pragma unroll
        for (int j = 0; j < 32; ++j) { const unsigned long long m = __ballot((sel >> ((j >> 1) + 16 * (j & 1))) & 1u);
            lo = (lane == j) ? (int)(unsigned)m : lo; hi = (lane == j) ? (int)(unsigned)(m >> 32) : hi; }
        if (lane < 32) ((unsigned long long*)(MASK + (size_t)(row0 + r) * 64))[lane] = (unsigned long long)(unsigned)lo | ((unsigned long long)(unsigned)hi << 32);
    }
}
}

__device__ __forceinline__ unsigned* queue_word(Frame& F, int l, int chunk, int q) { return (unsigned*)(F.ws + WS_CTL) + CW_QUEUE + 64 * ((l * NCHUNK + chunk) * 4 + q); }

__device__ __forceinline__ void phase_proj(Frame& F, int l, int chunk) {
    PHASE_IDS(F);
    { LAS float* gb = (LAS float*)(F.lds + L_GB); const float* bg = F.in[7] + (size_t)l * 3072;
      __syncthreads();
      for (int i = F.tid; i < 3072; i += NTHREADS) gb[i] = bg[i];
      VM_WAIT(); LDS_WAIT(); __syncthreads(); }
    pg8::ProjSched8 S{{{(const bf16_t*)(F.ws + WS_XB8 + (size_t)chunk * TC * DM), (const bf16_t*)(F.ws + WS_WIN8), DM / 2, DM / 2, TC / 256, (PW + 3072) / 256, F.G, (int)blockIdx.x}, F8_SW, F8_SA_X}};
    const float* rp = (const float*)(F.ws + WS_ROPE);
    EpiProj E{(bf16_t*)(F.ws + WS_PROJ), rp, rp + 2048 * 8 * 2, (float*)(F.ws + WS_SSQ), (bf16_t*)(F.ws + WS_G3), (const LAS float*)(F.lds + L_GB)};
    pg8::gemm_phase<EpiProj, pg8::ProjSched8, true, true>(F.lds, DM / 2, S, E);
}
__device__ __forceinline__ void dilated_unit(Frame& F, int u) {
    const bf16_t* PROJ = (const bf16_t*)(F.ws + WS_PROJ); bf16_t* OG = (bf16_t*)(F.ws + WS_OG); float* LSE = (float*)(F.ws + WS_LSE);
    constexpr int N_G0 = NBC * 4 * 8, N_G1 = NBC * 4 * 4 * 2;
    int g, b, h, res, qb, dil, nq;
    if (u < N_G0) { g = 0; dil = 1; qb = 7 - u / (NBC * 4); const int bh = u % (NBC * 4); b = bh >> 2; h = bh & 3; res = 0; nq = 256; }
    else if (u < N_G0 + N_G1) { const int v = u - N_G0; g = 1; dil = 4; qb = 1 - v / (NBC * 16); const int x = v % (NBC * 16); b = x >> 4; h = (x >> 2) & 3; res = x & 3; nq = 256; }
    else { const int v = u - N_G0 - N_G1; g = 2; dil = 16; qb = 0; b = v >> 6; h = (v >> 4) & 3; res = v & 15; nq = 128; }
    att::Desc d; const size_t r0 = (size_t)b * SEQ + res;
    const bf16_t* base = PROJ + r0 * PW + 512 + 768 * g + 64 * h;
    d.Q = base; d.K1 = base + 256; d.V = base + 512; d.K2 = nullptr; d.qpitch = d.k1pitch = d.vpitch = PW; d.k2pitch = 0;
    d.O = OG + ((size_t)g * TC + r0) * 256 + 64 * h; d.opitch = 256; d.lse = LSE + ((size_t)g * TC + r0) * 4 + h; d.lsepitch = 4; d.mask = nullptr;
    d.rstride = dil; d.q0 = qb * 256; d.nq = nq; d.o8 = 0;
    if (g == 2) { d.jlo = 0; d.jhi = 2; att::attn_unit<64, 0>(F.lds, d); }
    else { d.jlo = (qb * 4 - 2) > 0 ? (qb * 4 - 2) : 0; d.jhi = 4 * (qb + 1); att::attn_unit<64, 1>(F.lds, d); }
}

__device__ __forceinline__ void phase_up_scores(Frame& F, int l, int chunk) {
    PHASE_IDS(F);
    const bf16_t* PROJ = (const bf16_t*)(F.ws + WS_PROJ);
    const float* rp = (const float*)(F.ws + WS_ROPE);
    {   pg8::DenseSched S{PROJ, (const bf16_t*)(F.ws + WS_WUQ), PW, 256, TC / 256, 3, F.G, (int)blockIdx.x};
        EpiUpQ E{(bf16_t*)(F.ws + WS_QM), rp + 2048 * 8 * 2, (const float*)(F.ws + WS_SSQ)};
        pg8::gemm_phase<EpiUpQ, pg8::DenseSched, true>(F.lds, 256, S, E); }
    {   pg8::DenseSched S{PROJ + 256, (const bf16_t*)(F.ws + WS_WUKV), PW, 256, TC / 256, 4, F.G, (int)blockIdx.x};
        EpiUpKV E{(bf16_t*)(F.ws + WS_KVM), (const float*)(F.ws + WS_SSQ)};
        pg8::gemm_phase<EpiUpKV, pg8::DenseSched, true>(F.lds, 256, S, E); }
    unsigned* qw = queue_word(F, l, chunk, 0); int pre = -1;
    for (;;) {
        const int u = dequeue(F, qw, pre);
        if (u < NBC * 64) { dilated_unit(F, u); continue; }
        if (u >= NBC * 64 + NBC * 72 + NBC * 64) break;
        if (u >= NBC * 64 + NBC * 72) { dilated_unit(F, u - NBC * 72); continue; }
        const int v = u - NBC * 64; const int b = v / 72; int r = v % 72, qh = 0; while (r > (qh >> 1)) { r -= (qh >> 1) + 1; ++qh; }
        idx::score_unit(F.lds, PROJ, (float*)(F.ws + WS_SC), b, qh, r);
    }
}
__device__ __forceinline__ void phase_attn1(Frame& F, int l, int chunk, int tmask = 7) {
    PHASE_IDS(F);
    const bf16_t* PROJ = (const bf16_t*)(F.ws + WS_PROJ); const bf16_t* QM = (const bf16_t*)(F.ws + WS_QM); const bf16_t* KVM = (const bf16_t*)(F.ws + WS_KVM);
    bf16_t* OA = (bf16_t*)(F.ws + WS_OA); bf16_t* OG = (bf16_t*)(F.ws + WS_OG); float* LSE = (float*)(F.ws + WS_LSE);
    constexpr int N_MLA = NBC * 8 * 8, N_SEL = TC / 32;
    unsigned* qw = queue_word(F, l, chunk, 1); int pre = -1;
    for (;;) {
        int u = dequeue(F, qw, pre);
        if (u < N_MLA) {
            if (!(tmask & 1)) continue;
            const int qb = 7 - u / (NBC * 8), bh = u % (NBC * 8), b = bh >> 3, h = bh & 7;
            att::Desc d; const size_t r0 = (size_t)b * SEQ;
            d.Q = QM + r0 * 768 + h * 96; d.qpitch = 768; d.K1 = KVM + r0 * 1024 + h * 128; d.k1pitch = 1024; d.K2 = PROJ + r0 * PW + 384; d.k2pitch = PW;
            d.V = KVM + r0 * 1024 + h * 128 + 64; d.vpitch = 1024; d.O = (bf16_t*)((unsigned char*)OA + r0 * 512 + h * 64); d.opitch = 512; d.o8 = 1; d.lse = nullptr; d.lsepitch = 0; d.mask = nullptr;
            d.rstride = 1; d.q0 = qb * 256; d.nq = 256; d.jlo = 0; d.jhi = 4 * (qb + 1);
            att::attn_unit<96, 0>(F.lds, d); continue; }
        u -= N_MLA;
        if (u >= N_SEL) break;
        if (!(tmask & 4)) continue;
        idx::select_rows4((const float*)(F.ws + WS_SC), (unsigned*)(F.ws + WS_MASK), u * 32 + F.wave * 4, F.lane, (LAS unsigned*)(F.lds + L_GB) + F.wave * 64);
    }
}
__device__ __forceinline__ void phase_attn2(Frame& F, int l, int chunk) {
    PHASE_IDS(F);
    const bf16_t* PROJ = (const bf16_t*)(F.ws + WS_PROJ);
    bf16_t* OC = (bf16_t*)(F.ws + WS_OC);
    unsigned* qw = queue_word(F, l, chunk, 2); int pre = -1;
    for (;;) {
        const int u = dequeue(F, qw, pre);
        if (u >= NBC * 64) break;
        const int qb = 7 - u / (NBC * 8), bh = u % (NBC * 8), b = bh >> 3, h = bh & 7;
        att::Desc d; const size_t r0 = (size_t)b * SEQ;
        d.Q = PROJ + r0 * PW + 2816 + 64 * h; d.K1 = PROJ + r0 * PW + 3840; d.V = PROJ + r0 * PW + 3904; d.K2 = nullptr; d.qpitch = d.k1pitch = d.vpitch = PW; d.k2pitch = 0;
        d.O = (bf16_t*)((unsigned char*)OC + r0 * 512 + 64 * h); d.opitch = 512; d.o8 = 1; d.lse = nullptr; d.lsepitch = 0; d.mask = (const unsigned*)(F.ws + WS_MASK) + r0 * 64;
        d.rstride = 1; d.q0 = qb * 256; d.nq = 256; d.jlo = 0; d.jhi = 4 * (qb + 1);
        att::attn_unit<64, 2>(F.lds, d);
    }
    const bf16_t* OG = (const bf16_t*)(F.ws + WS_OG); const float* LSE = (const float*)(F.ws + WS_LSE); bf16_t* OB = (bf16_t*)(F.ws + WS_OB);
    const int gw = F.vcu * NWAVES + F.wave, NGW = F.G * NWAVES, h = F.lane >> 4;
    for (int row = gw; row < TC; row += NGW) {
        const float l0 = LSE[(size_t)row * 4 + h], l1 = LSE[((size_t)TC + row) * 4 + h], l2 = LSE[((size_t)2 * TC + row) * 4 + h];
        const float mx = fmaxf(l0, fmaxf(l1, l2));
        float w0 = __builtin_amdgcn_exp2f(l0 - mx), w1 = __builtin_amdgcn_exp2f(l1 - mx), w2 = __builtin_amdgcn_exp2f(l2 - mx);
        const float inv = 1.0f / (w0 + w1 + w2); w0 *= inv; w1 *= inv; w2 *= inv;
        const u32x2 a = *(const u32x2*)(OG + (size_t)row * 256 + F.lane * 4), bq = *(const u32x2*)(OG + ((size_t)TC + row) * 256 + F.lane * 4), c = *(const u32x2*)(OG + ((size_t)2 * TC + row) * 256 + F.lane * 4);
        w0 *= 32.f; w1 *= 32.f; w2 *= 32.f;
        *(unsigned*)((unsigned char*)OB + (size_t)row * 512 + F.lane * 4) = pk4_fp8(w0 * bflo(a.x) + w1 * bflo(bq.x) + w2 * bflo(c.x), w0 * bfhi(a.x) + w1 * bfhi(bq.x) + w2 * bfhi(c.x),
                                                                                    w0 * bflo(a.y) + w1 * bflo(bq.y) + w2 * bflo(c.y), w0 * bfhi(a.y) + w1 * bfhi(bq.y) + w2 * bfhi(c.y));
    }
}
constexpr int CW_DEP = 32768;
__device__ __forceinline__ void phase_attn(Frame& F, int l, int chunk) {
    PHASE_IDS(F);
    const bf16_t* PROJ = (const bf16_t*)(F.ws + WS_PROJ); const bf16_t* QM = (const bf16_t*)(F.ws + WS_QM); const bf16_t* KVM = (const bf16_t*)(F.ws + WS_KVM);
    bf16_t* OA = (bf16_t*)(F.ws + WS_OA); bf16_t* OC = (bf16_t*)(F.ws + WS_OC);
    constexpr int N_SEL = TC / 32, NQ = NBC * 8;
    unsigned* dep = (unsigned*)(F.ws + WS_CTL) + CW_DEP + (l * NCHUNK + chunk) * (NBC * 8);
    unsigned* qw = queue_word(F, l, chunk, 1); int pre = -1;
    for (;;) {
        int u = dequeue(F, qw, pre);
        if (u < N_SEL) {
            idx::select_rows4((const float*)(F.ws + WS_SC), (unsigned*)(F.ws + WS_MASK), u * 32 + F.wave * 4, F.lane, (LAS unsigned*)(F.lds + L_GB) + F.wave * 64);
            VM_WAIT();
            __syncthreads();
            if (F.tid == 0) { const int row = u * 32, b = row / SEQ, qb = (row % SEQ) >> 8;
                __builtin_amdgcn_fence(__ATOMIC_RELEASE, "agent");
                __hip_atomic_fetch_add(dep + b * 8 + qb, 1u, __ATOMIC_RELAXED, __HIP_MEMORY_SCOPE_AGENT); }
            continue; }
        u -= N_SEL;
        if (u >= 16 * NQ) break;
        const int qb = 7 - u / (2 * NQ), w = u % (2 * NQ);
        if (w < NQ) {
            const int b = w >> 3, h = w & 7;
            att::Desc d; const size_t r0 = (size_t)b * SEQ;
            d.Q = QM + r0 * 768 + h * 96; d.qpitch = 768; d.K1 = KVM + r0 * 1024 + h * 128; d.k1pitch = 1024; d.K2 = PROJ + r0 * PW + 384; d.k2pitch = PW;
            d.V = KVM + r0 * 1024 + h * 128 + 64; d.vpitch = 1024; d.O = (bf16_t*)((unsigned char*)OA + r0 * 512 + h * 64); d.opitch = 512; d.o8 = 1; d.lse = nullptr; d.lsepitch = 0; d.mask = nullptr;
            d.rstride = 1; d.q0 = qb * 256; d.nq = 256; d.jlo = 0; d.jhi = 4 * (qb + 1);
            att::attn_unit<96, 0>(F.lds, d);
        } else {
            const int bh = w - NQ, b = bh >> 3, h = bh & 7;
            if (F.tid == 0) { while (__hip_atomic_load(dep + b * 8 + qb, __ATOMIC_RELAXED, __HIP_MEMORY_SCOPE_AGENT) < 8u) __builtin_amdgcn_s_sleep(4);
                __builtin_amdgcn_fence(__ATOMIC_ACQUIRE, "agent"); }
            __syncthreads();
            att::Desc d; const size_t r0 = (size_t)b * SEQ;
            d.Q = PROJ + r0 * PW + 2816 + 64 * h; d.K1 = PROJ + r0 * PW + 3840; d.V = PROJ + r0 * PW + 3904; d.K2 = nullptr; d.qpitch = d.k1pitch = d.vpitch = PW; d.k2pitch = 0;
            d.O = (bf16_t*)((unsigned char*)OC + r0 * 512 + 64 * h); d.opitch = 512; d.o8 = 1; d.lse = nullptr; d.lsepitch = 0; d.mask = (const unsigned*)(F.ws + WS_MASK) + r0 * 64;
            d.rstride = 1; d.q0 = qb * 256; d.nq = 256; d.jlo = 0; d.jhi = 4 * (qb + 1);
            att::attn_unit<64, 2>(F.lds, d);
        }
    }
    const bf16_t* OG = (const bf16_t*)(F.ws + WS_OG); const float* LSE = (const float*)(F.ws + WS_LSE); bf16_t* OB = (bf16_t*)(F.ws + WS_OB);
    const int gw = F.vcu * NWAVES + F.wave, NGW = F.G * NWAVES, h = F.lane >> 4;
    for (int row = gw; row < TC; row += NGW) {
        const float l0 = LSE[(size_t)row * 4 + h], l1 = LSE[((size_t)TC + row) * 4 + h], l2 = LSE[((size_t)2 * TC + row) * 4 + h];
        const float mx = fmaxf(l0, fmaxf(l1, l2));
        float w0 = __builtin_amdgcn_exp2f(l0 - mx), w1 = __builtin_amdgcn_exp2f(l1 - mx), w2 = __builtin_amdgcn_exp2f(l2 - mx);
        const float inv = 1.0f / (w0 + w1 + w2); w0 *= inv; w1 *= inv; w2 *= inv;
        const u32x2 a = *(const u32x2*)(OG + (size_t)row * 256 + F.lane * 4), bq = *(const u32x2*)(OG + ((size_t)TC + row) * 256 + F.lane * 4), c = *(const u32x2*)(OG + ((size_t)2 * TC + row) * 256 + F.lane * 4);
        w0 *= 32.f; w1 *= 32.f; w2 *= 32.f;
        *(unsigned*)((unsigned char*)OB + (size_t)row * 512 + F.lane * 4) = pk4_fp8(w0 * bflo(a.x) + w1 * bflo(bq.x) + w2 * bflo(c.x), w0 * bfhi(a.x) + w1 * bfhi(bq.x) + w2 * bfhi(c.x),
                                                                                    w0 * bflo(a.y) + w1 * bflo(bq.y) + w2 * bflo(c.y), w0 * bfhi(a.y) + w1 * bfhi(bq.y) + w2 * bfhi(c.y));
    }
}
__device__ __forceinline__ void phase_branches(Frame& F, int l, int chunk) {
    PHASE_IDS(F);
    static_assert(WS_OB - WS_OA == WS_OC - WS_OB && WS_WB - WS_WA == WS_WC - WS_WB, "equally spaced branch operands");
    BranchSched S{(const char*)(F.ws + WS_OA), (const char*)(F.ws + WS_WA), WS_OB - WS_OA, WS_WB - WS_WA, 256, 256, (int)blockIdx.x, F8_SW, 127 - 5, F.G, (TC / 256) * 4};
    EpiBranchAll E{(bf16_t*)(F.ws + WS_MERGED), (bf16_t*)(F.ws + WS_M0), (bf16_t*)(F.ws + WS_M1), (const bf16_t*)(F.ws + WS_G3)};
    pg8::gemm_phase<EpiBranchAll, BranchSched, true, true>(F.lds, 256, S, E);
}
__device__ __forceinline__ void phase_wo(Frame& F, int l, int chunk) {
    PHASE_IDS(F);
    pg8::DenseSched8 S{{(const bf16_t*)(F.ws + WS_MERGED), (const bf16_t*)(F.ws + WS_WO), DM / 2, DM / 2, TC / 256, 4, F.G, (int)blockIdx.x}, F8_SW, 127 - 6};
    EpiWo E{F.out, l == 0 ? F.in[0] : F.out, chunk * TC};
    pg8::gemm_phase<EpiWo, pg8::DenseSched8, true, true>(F.lds, DM / 2, S, E);
}

__global__ void __launch_bounds__(NTHREADS, 2) fwd_kernel(Args args) {
    extern __shared__ __attribute__((aligned(16))) unsigned char lds_raw[];
    Frame F;
    F.lds = (LAS unsigned char*)lds_raw;
    F.tid = threadIdx.x; F.lane = F.tid & 63; F.wave = __builtin_amdgcn_readfirstlane(F.tid >> 6);
    F.G = gridDim.x; { const int bx = blockIdx.x; F.vcu = (F.G % 8 == 0) ? (bx % 8) * (F.G / 8) + bx / 8 : bx; }
    F.in.p = (intab_t)__builtin_amdgcn_kernarg_segment_ptr(); F.out = args.out; F.ws = args.ws; F.out0 = args.out; F.ws0 = args.ws;
    for (int u = F.tid; u < (LDS_BYTES - L_CTL) / 4; u += NTHREADS) ((LAS unsigned*)(F.lds + L_CTL))[u] = 0u;
    __syncthreads();
    XcdBarrier bar = xcd_barrier_post((unsigned*)(F.ws + WS_CTL) + CW_BAR, (volatile LAS unsigned*)(F.lds + L_BARW));
#define GRID_BAR() xcd_barrier(bar)

    for (int l = 0; l < 2; ++l) {
        phase_conv_moe(F, l);
        phase_conv_mixer(F, l);
        GRID_BAR();
        for (int chunk = 0; chunk < NCHUNK; ++chunk) {
            phase_proj(F, l, chunk);
            GRID_BAR();
            if (DUPMASK & 2) { phase_proj(F, l, chunk); GRID_BAR(); }
            phase_up_scores(F, l, chunk);
            GRID_BAR();
            if (DUPMASK & 4) { phase_up_scores(F, l + 2, chunk); GRID_BAR(); }
            phase_attn(F, l, chunk);
            GRID_BAR();
            phase_branches(F, l, chunk);
            GRID_BAR();
            if (DUPMASK & 32) { phase_branches(F, l, chunk); GRID_BAR(); }
            phase_wo(F, l, chunk);
            if ((DUPMASK & 0x800) && l == 0) { GRID_BAR(); phase_wo(F, l, chunk); }
        }
        GRID_BAR();
        phase_ln1_router(F, l, F.out, false);
        GRID_BAR();
        phase_moe_scatter(F);
        GRID_BAR();
        phase_moe_gemm1(F);
        GRID_BAR();
        if (DUPMASK & 64) { phase_moe_gemm1(F); GRID_BAR(); }
        phase_moe_gemm2(F);
        GRID_BAR();
        if (DUPMASK & 128) { phase_moe_gemm2(F); GRID_BAR(); }
        phase_combine_ln2(F, l);
        GRID_BAR();
    }
}

extern "C" void kernel_launch(void* const* d_in, const int* in_sizes, int n_in, void* d_out, int out_size, void* d_ws, size_t ws_size, hipStream_t stream) {
    static int grid = 0;
    if (grid == 0) {
        if (n_in != 23 || out_size != TT * DM || ws_size < WS_END) { fprintf(stderr, "kernel_launch: unexpected shapes n_in %d out %d ws %zu\n", n_in, out_size, ws_size); grid = -1; return; }
        int dev = 0, cus = 0;
        if (hipGetDevice(&dev) != hipSuccess || hipDeviceGetAttribute(&cus, hipDeviceAttributeMultiprocessorCount, dev) != hipSuccess) { grid = -1; return; }
        if (hipFuncSetAttribute((const void*)fwd_kernel, hipFuncAttributeMaxDynamicSharedMemorySize, LDS_BYTES) != hipSuccess) { fprintf(stderr, "kernel_launch: hipFuncSetAttribute failed\n"); grid = -1; return; }
        int per_cu = 0;
        if (hipOccupancyMaxActiveBlocksPerMultiprocessor(&per_cu, (const void*)fwd_kernel, NTHREADS, LDS_BYTES) != hipSuccess || per_cu < 1) fprintf(stderr, "kernel_launch: occupancy query says %d\n", per_cu);
        (void)hipGetLastError();
        grid = cus;
    }
    if (grid < 0) return;
    if (hipMemsetAsync((char*)d_ws + WS_CTL, 0, CTL_ZERO_BYTES, stream) != hipSuccess) return;
    Args a{};
    for (int i = 0; i < 23; ++i) a.in[i] = (const float*)d_in[i];
    a.out = (float*)d_out; a.ws = (unsigned char*)d_ws;
    hipLaunchKernelGGL(fwd_kernel, dim3(grid), dim3(NTHREADS), LDS_BYTES, stream, a);
}
```

```cpp
#include <hip/hip_runtime.h>
#include <cstdio>
#include <cstdint>

#define LAS __attribute__((address_space(3)))
#define GAS __attribute__((address_space(1)))
typedef unsigned short bf16_t;
typedef short bf16x8 __attribute__((ext_vector_type(8)));
typedef float f32x4 __attribute__((ext_vector_type(4)));
typedef float f32x2 __attribute__((ext_vector_type(2)));
typedef float f32x16 __attribute__((ext_vector_type(16)));
typedef unsigned u32x4 __attribute__((ext_vector_type(4)));
typedef unsigned u32x2 __attribute__((ext_vector_type(2)));

constexpr int DM = 1024, NB = 32, SEQ = 2048, TT = NB * SEQ;
constexpr int NEXP = 32, DEXP = 256;
constexpr float LN_EPS = 1e-6f;
constexpr float ALPHA = 1.41421356237309515f;
constexpr int NWAVES = 8, NTHREADS = 512;

__device__ __forceinline__ unsigned f2bf(float f) { unsigned u = __builtin_bit_cast(unsigned, f); return (u + 0x7fffu + ((u >> 16) & 1u)) >> 16; }
__device__ __forceinline__ unsigned pk2(float lo, float hi) { return f2bf(lo) | (f2bf(hi) << 16); }
__device__ __forceinline__ float bf2f(unsigned short b) { return __builtin_bit_cast(float, (unsigned)b << 16); }
__device__ __forceinline__ float bflo(unsigned w) { return __builtin_bit_cast(float, w << 16); }
__device__ __forceinline__ float bfhi(unsigned w) { return __builtin_bit_cast(float, w & 0xffff0000u); }
typedef __bf16 bf16x2_t __attribute__((ext_vector_type(2)));
__device__ __forceinline__ unsigned cvt_pk_bf16(float lo, float hi) { const f32x2 v = {lo, hi}; const bf16x2_t b = __builtin_convertvector(v, bf16x2_t); return __builtin_bit_cast(unsigned, b); }
__device__ __forceinline__ float wave_sum(float v) {
#pragma unroll
    for (int o = 1; o < 64; o <<= 1) v += __shfl_xor(v, o);
    return v;
}
__device__ __forceinline__ float fast_exp(float x) { return __builtin_amdgcn_exp2f(x * 1.4426950408889634f); }
__device__ __forceinline__ float sigmoidf_(float x) { return __builtin_amdgcn_rcpf(1.0f + fast_exp(-x)); }
__device__ __forceinline__ unsigned pk4_fp8(float a, float b, float c, float d) {
    int p = __builtin_amdgcn_cvt_pk_fp8_f32(a, b, 0, false); p = __builtin_amdgcn_cvt_pk_fp8_f32(c, d, p, true); return (unsigned)p; }
__device__ __forceinline__ void store8_fp8(unsigned char* p, const f32x4& v0, const f32x4& v1, float sc) {
    u32x2 w; w.x = pk4_fp8(v0[0] * sc, v0[1] * sc, v0[2] * sc, v0[3] * sc); w.y = pk4_fp8(v1[0] * sc, v1[1] * sc, v1[2] * sc, v1[3] * sc); *(u32x2*)p = w;
}
#define LDS_WAIT() asm volatile("s_waitcnt lgkmcnt(0)" ::: "memory")
#define VM_WAIT() asm volatile("s_waitcnt vmcnt(0)" ::: "memory")

namespace pg8 {
constexpr int BM = 256, BK = 64, HALF = 128, HTB = HALF * BK * 2, STAGE_BYTES = 8 * HTB;
__device__ __forceinline__ int lds_byte(int r, int c) { return r * 128 + ((((c >> 3) ^ (r >> 1)) & 7) * 16) + (c & 7) * 2; }
__device__ __forceinline__ void stage_rc(int b, int& R, int& C) { R = b >> 7; C = ((((b >> 4) ^ (R >> 1)) & 7)) * 8; }
__device__ __forceinline__ int perm32(int rho) { const int n = rho >> 4, i = rho & 15; return 8 * (i >> 2) + 4 * n + (i & 3); }
struct Unit { int pm, pn, ord; };

template <class S, class = void> struct SchedVarK { static constexpr bool value = false; };
template <class S> struct SchedVarK<S, decltype((void)S::VARK)> { static constexpr bool value = S::VARK; };
typedef int v4i_t __attribute__((ext_vector_type(4)));
typedef int v8i_t __attribute__((ext_vector_type(8)));
__device__ __forceinline__ v8i_t cat8(const bf16x8& lo, const bf16x8& hi) { return __builtin_shufflevector(__builtin_bit_cast(v4i_t, lo), __builtin_bit_cast(v4i_t, hi), 0, 1, 2, 3, 4, 5, 6, 7); }
template <class Epi, class Sched, bool ALIGN_EPI, bool F8 = false>
__device__ __forceinline__ void gemm_phase(LAS unsigned char* lds, const int K, const Sched& S, const Epi& E) {
    int tid_ = threadIdx.x; asm volatile("" : "+v"(tid_));
    const int tid = tid_, wid = __builtin_amdgcn_readfirstlane(tid >> 6), lane = tid & 63, wr = wid >> 2, wc = wid & 3, fr = lane & 15, fq = lane >> 4;
    int nt = K / BK;
    int Rr[2], Cc[2]; unsigned vB[2][2];
#pragma unroll
    for (int i = 0; i < 2; ++i) { stage_rc(tid * 16 + i * 8192, Rr[i], Cc[i]); const int Rb = (Rr[i] & ~31) + perm32(Rr[i] & 31);
        vB[0][i] = (unsigned)(Rb * S.ldb + Cc[i]) * 2u; vB[1][i] = (unsigned)((HALF + Rb) * S.ldb + Cc[i]) * 2u; }
    const size_t kstep = (size_t)(BK * 2);
    const unsigned ldsw = (unsigned)wid * 1024u;
    const int aoff = lds_byte(wr * 64 + fr, fq * 8), boff = lds_byte(wc * 32 + fr, fq * 8);
    const int aoff1 = lds_byte(wr * 64 + fr, fq * 8 + 32), boff1 = lds_byte(wc * 32 + fr, fq * 8 + 32);
#define PG8_SA(b, h) (((b) * 2 + (h)) * HTB)
#define PG8_SB(b, h) ((4 + (b) * 2 + (h)) * HTB)
#define PG8_STAGE(bufoff, gbase, voff) do { _Pragma("unroll") for (int _i = 0; _i < 2; ++_i) \
        __builtin_amdgcn_global_load_lds((const unsigned*)((const char*)(gbase) + (voff)[_i]), (LAS unsigned*)(lds + (bufoff) + ldsw + _i * 8192), 16, 0, 0); } while (0)
#define PG8_LDA(dst, b, h) do { _Pragma("unroll") for (int m = 0; m < 4; ++m) { \
        const bf16x8 f0_ = *(const LAS bf16x8*)(lds + PG8_SA(b, h) + aoff + m * 2048), f1_ = *(const LAS bf16x8*)(lds + PG8_SA(b, h) + aoff1 + m * 2048); \
        if constexpr (F8) dst##8[m] = cat8(f0_, f1_); else { dst[m][0] = f0_; dst[m][1] = f1_; } } } while (0)
#define PG8_LDB(dst, b, h) do { _Pragma("unroll") for (int n = 0; n < 2; ++n) { \
        const bf16x8 f0_ = *(const LAS bf16x8*)(lds + PG8_SB(b, h) + boff + n * 2048), f1_ = *(const LAS bf16x8*)(lds + PG8_SB(b, h) + boff1 + n * 2048); \
        if constexpr (F8) dst##8[n] = cat8(f0_, f1_); else { dst[n][0] = f0_; dst[n][1] = f1_; } } } while (0)
#define PG8_MMA(ai, bj, At, Bt) do { __builtin_amdgcn_s_setprio(1); \
        if constexpr (F8) { _Pragma("unroll") for (int m = 0; m < 4; ++m) _Pragma("unroll") for (int n = 0; n < 2; ++n) \
            asm volatile("v_mfma_scale_f32_16x16x128_f8f6f4 %0, %1, %2, %0, %3, %4 op_sel_hi:[0,0,0]" : "+v"(acc[ai][bj][m][n]) : "v"(Bt##8[n]), "v"(At##8[m]), "v"(scw8), "v"(sca8)); } \
              \
        else { _Pragma("unroll") for (int m = 0; m < 4; ++m) _Pragma("unroll") for (int n = 0; n < 2; ++n) _Pragma("unroll") for (int k = 0; k < 2; ++k) \
            acc[ai][bj][m][n] = __builtin_amdgcn_mfma_f32_16x16x32_bf16(Bt[n][k], At[m][k], acc[ai][bj][m][n], 0, 0, 0); } \
        __builtin_amdgcn_s_setprio(0); } while (0)
#define PG8_WAIT_V(n) asm volatile("s_waitcnt vmcnt(" #n ")" ::: "memory")
#define PG8_WAIT_L(n) asm volatile("s_waitcnt lgkmcnt(" #n ")" ::: "memory")
#define PG8_BAR __builtin_amdgcn_s_barrier()
#define PG8_SCHED __builtin_amdgcn_sched_barrier(0)
    int scw8 = 0, sca8 = 0;
    if constexpr (F8) { scw8 = S.sw8 * 0x01010101; sca8 = S.sa8 * 0x01010101; }
    Unit cur, nxt; int ui = 0;
    if (!S.next(0, cur)) return;
    f32x4 acc[2][2][4][2];
#pragma unroll
    for (int a = 0; a < 2; ++a)
#pragma unroll
        for (int b = 0; b < 2; ++b)
#pragma unroll
            for (int m = 0; m < 4; ++m)
#pragma unroll
                for (int n = 0; n < 2; ++n) acc[a][b][m][n] = (f32x4){0.f, 0.f, 0.f, 0.f};
    bf16x8 At[4][2], B0[2][2], B1[2][2]; v8i_t At8[4], B08[2], B18[2];
    unsigned vAc[2][2], vAn[2][2];
    const char* cA = S.a_base(cur); const char* cB = S.b_base(cur);
    S.a_off(cur, Rr, Cc, vAc);
    if constexpr (SchedVarK<Sched>::value) nt = S.ktiles(cur);
    PG8_STAGE(PG8_SB(0, 0), cB, vB[0]); PG8_STAGE(PG8_SB(0, 1), cB, vB[1]); PG8_STAGE(PG8_SA(0, 0), cA, vAc[0]); PG8_STAGE(PG8_SA(0, 1), cA, vAc[1]);
    if (wr == 1) PG8_BAR;
    PG8_WAIT_V(2); PG8_BAR;
    PG8_STAGE(PG8_SB(1, 0), cB + kstep, vB[0]); PG8_STAGE(PG8_SA(1, 0), cA + kstep, vAc[0]); PG8_STAGE(PG8_SB(1, 1), cB + kstep, vB[1]);
    PG8_WAIT_V(6); PG8_BAR;
    bool epi_pend = false;
    for (;;) {
        const bool has_next = S.next(ui + 1, nxt);
        const char* nA = cA; const char* nB = cB;
        if constexpr (Sched::GATHER) {
#pragma unroll
            for (int h = 0; h < 2; ++h)
#pragma unroll
                for (int i = 0; i < 2; ++i) vAn[h][i] = vAc[h][i];
        }
        if (has_next) { nA = S.a_base(nxt); nB = S.b_base(nxt); if constexpr (Sched::GATHER) S.a_off(nxt, Rr, Cc, vAn); }
#pragma nounroll
        for (int t = 0; t < nt; t += 2) {
            const bool last = (t == nt - 2);
            const bool ep_ = epi_pend && t == 0;
            const char* a1 = cA + (size_t)(t + 1) * kstep;
            const char* a2 = last ? nA : cA + (size_t)(t + 2) * kstep; const char* b2 = last ? nB : cB + (size_t)(t + 2) * kstep;
            const char* a3 = a2 + kstep; const char* b3 = b2 + kstep;
            unsigned vA2[2][2];
#pragma unroll
            for (int h = 0; h < 2; ++h)
#pragma unroll
                for (int i = 0; i < 2; ++i) { if constexpr (Sched::GATHER) vA2[h][i] = last ? vAn[h][i] : vAc[h][i]; else vA2[h][i] = vAc[h][i]; }
            PG8_LDB(B0, 0, 0); PG8_LDB(B1, 0, 1); PG8_SCHED; PG8_LDA(At, 0, 0); PG8_STAGE(PG8_SA(1, 1), a1, vAc[1]);
            if (ep_) { PG8_WAIT_V(24); } else { PG8_WAIT_V(8); } PG8_WAIT_L(0); PG8_BAR; PG8_MMA(0, 0, At, B0); PG8_MMA(0, 1, At, B1); PG8_BAR; PG8_SCHED;
            PG8_LDA(At, 0, 1); PG8_STAGE(PG8_SB(0, 0), b2, vB[0]); PG8_STAGE(PG8_SB(0, 1), b2, vB[1]); PG8_STAGE(PG8_SA(0, 0), a2, vA2[0]);
            if (ep_) { PG8_WAIT_V(24); } else { PG8_WAIT_V(8); } PG8_WAIT_L(0); PG8_BAR; PG8_MMA(1, 0, At, B0); PG8_MMA(1, 1, At, B1); PG8_BAR; PG8_SCHED;
            PG8_LDB(B0, 1, 0); PG8_LDB(B1, 1, 1); PG8_SCHED; PG8_LDA(At, 1, 0); PG8_STAGE(PG8_SA(0, 1), a2, vA2[1]);
            PG8_WAIT_V(8); PG8_WAIT_L(0); PG8_BAR; PG8_MMA(0, 0, At, B0); PG8_MMA(0, 1, At, B1); PG8_BAR; PG8_SCHED;
            PG8_LDA(At, 1, 1); PG8_STAGE(PG8_SB(1, 0), b3, vB[0]); PG8_STAGE(PG8_SB(1, 1), b3, vB[1]); PG8_STAGE(PG8_SA(1, 0), a3, vA2[0]);
            PG8_WAIT_V(8); PG8_WAIT_L(0); PG8_BAR; PG8_MMA(1, 0, At, B0); PG8_MMA(1, 1, At, B1); PG8_BAR; PG8_SCHED;
        }
        if constexpr (ALIGN_EPI) { if (wr == 0) PG8_BAR; }
        if constexpr (F8) asm volatile("s_nop 15\n\ts_nop 15" ::: "memory");
        { int l2_ = lane; asm volatile("" : "+v"(l2_)); E(acc, cur, wr, wc, l2_ & 15, l2_ >> 4); }
        if (!has_next) break;
        epi_pend = true;
#pragma unroll
        for (int a = 0; a < 2; ++a)
#pragma unroll
            for (int b = 0; b < 2; ++b)
#pragma unroll
                for (int m = 0; m < 4; ++m)
#pragma unroll
                    for (int n = 0; n < 2; ++n) acc[a][b][m][n] = (f32x4){0.f, 0.f, 0.f, 0.f};
        cur = nxt; cA = nA; cB = nB; ++ui;
        if constexpr (SchedVarK<Sched>::value) nt = S.ktiles(cur);
        if constexpr (Sched::GATHER) {
#pragma unroll
            for (int h = 0; h < 2; ++h)
#pragma unroll
                for (int i = 0; i < 2; ++i) vAc[h][i] = vAn[h][i];
        }
        if constexpr (ALIGN_EPI) { if (wr == 1) PG8_BAR; }
    }
    PG8_WAIT_V(0);
    if constexpr (!ALIGN_EPI) { if (wr == 0) PG8_BAR; }
    asm volatile("s_waitcnt vmcnt(0) lgkmcnt(0)\n\ts_barrier" ::: "memory");
    __builtin_amdgcn_sched_barrier(0);
#undef PG8_SA
#undef PG8_SB
#undef PG8_STAGE
#undef PG8_LDA
#undef PG8_LDB
#undef PG8_MMA
#undef PG8_WAIT_V
#undef PG8_WAIT_L
#undef PG8_BAR
#undef PG8_SCHED
}

struct DenseSched {
    static constexpr bool GATHER = false;
    const bf16_t* A; const bf16_t* Bt; int lda, ldb, nM, nN, G, c;
    __device__ __forceinline__ bool next(int i, Unit& u) const { const int v = i * G + c; if (v >= nM * nN) return false; u.pm = v / nN; u.pn = v % nN; u.ord = i; return true; }
    __device__ __forceinline__ const char* a_base(const Unit& u) const { return (const char*)(A + (size_t)u.pm * BM * lda); }
    __device__ __forceinline__ const char* b_base(const Unit& u) const { return (const char*)(Bt + (size_t)u.pn * BM * ldb); }
    __device__ __forceinline__ void a_off(const Unit&, const int (&R)[2], const int (&C)[2], unsigned (&v)[2][2]) const {
#pragma unroll
        for (int i = 0; i < 2; ++i) { v[0][i] = (unsigned)(R[i] * lda + C[i]) * 2u; v[1][i] = (unsigned)((HALF + R[i]) * lda + C[i]) * 2u; }
    }
};
struct DenseSched8 : DenseSched { int sw8, sa8; };
struct ProjSched8 : DenseSched8 {
    __device__ __forceinline__ bool next(int i, Unit& u) const {
        if (nN != 28 || (nM & 1) || (G & 7)) return DenseSched::next(i, u);
        const int x = c & 7, wl = i * (G >> 3) + (c >> 3), half = nM >> 1;
        if (wl >= half * 7) return false;
        u.pm = (x >> 2) * half + wl / 7; u.pn = 7 * (x & 3) + wl % 7; u.ord = i; return true;
    }
};
}

#define XB_TMO      128
#define XB_XCNT(j)  (256  + 64 * (j))
#define XB_XSUB(j)  (1280 + 64 * (j))
#define XB_XGEN(j)  (2304 + 64 * (j))
#define XB_TOP      3328
#define XB_TOPGEN   3392
#define XCD_BAR_WORDS 3456
#define XB_SPIN_CAP (1u << 18)
__device__ __forceinline__ unsigned xb_ld(unsigned* p)              { return __hip_atomic_load(p, __ATOMIC_RELAXED, __HIP_MEMORY_SCOPE_AGENT); }
__device__ __forceinline__ unsigned xb_add(unsigned* p, unsigned v) { return __hip_atomic_fetch_add(p, v, __ATOMIC_RELAXED, __HIP_MEMORY_SCOPE_AGENT); }
__device__ __forceinline__ unsigned xb_xcc_id() { return (unsigned)__builtin_amdgcn_s_getreg((3 << 11) | 20) & 0xFu; }
#define XB_SPIN(cond, bar) do { unsigned _sp = 0; while (cond) { __builtin_amdgcn_s_sleep(1); \
    if ((++_sp & 255u) == 0u) { if (xb_ld(&(bar)[XB_TMO])) break; if (_sp > XB_SPIN_CAP) { atomicAdd(&(bar)[XB_TMO], 1u); break; } } } } while (0)
struct XcdBarrier { unsigned* bar; unsigned x; volatile LAS unsigned* st; };
__device__ __forceinline__ XcdBarrier xcd_barrier_post(unsigned* bar, volatile LAS unsigned* st) {
    XcdBarrier b; b.bar = bar; b.x = xb_xcc_id(); b.st = st;
    if (threadIdx.x == 0) (void)xb_add(&bar[XB_XCNT(b.x)], 1u);
    return b;
}
__device__ __forceinline__ void xcd_barrier_complete(unsigned* bar, unsigned x, unsigned& nloc, unsigned& nx) {
    const unsigned G = gridDim.x * gridDim.y * gridDim.z;
    unsigned sum, cnt, mine, sp = 0u;
    for (;;) {
        sum = 0u; cnt = 0u; mine = 0u;
#pragma unroll
        for (unsigned j = 0; j < 16; ++j) { const unsigned c = xb_ld(&bar[XB_XCNT(j)]); sum += c; cnt += (c > 0u) ? 1u : 0u; mine = (j == x) ? c : mine; }
        if (sum == G) break;
        __builtin_amdgcn_s_sleep(1);
        if ((++sp & 255u) == 0u) { if (xb_ld(&bar[XB_TMO])) break; if (sp > XB_SPIN_CAP) { atomicAdd(&bar[XB_TMO], 1u); break; } }
    }
    nloc = mine > 0u ? mine : 1u; nx = cnt > 0u ? cnt : 1u;
}
__device__ __forceinline__ void xcd_barrier(const XcdBarrier& b) {
    asm volatile("s_waitcnt vmcnt(0)" ::: "memory");
    __syncthreads();
    if (threadIdx.x == 0) {
        unsigned* bar = b.bar;
        __builtin_amdgcn_s_waitcnt(0);
        unsigned nloc = b.st[0], nx = b.st[1];
        if (nloc == 0u) { xcd_barrier_complete(bar, b.x, nloc, nx); b.st[0] = nloc; b.st[1] = nx; }
        const unsigned old = xb_add(&bar[XB_XSUB(b.x)], 1u);
        const unsigned gen = old / nloc;
        if (old + 1u == (gen + 1u) * nloc) {
            __builtin_amdgcn_fence(__ATOMIC_RELEASE, "agent");
            asm volatile("s_waitcnt vmcnt(0)" ::: "memory");
            const unsigned og = xb_add(&bar[XB_TOP], 1u);
            const unsigned tg = og / nx;
            if (og + 1u == (tg + 1u) * nx) xb_add(&bar[XB_TOPGEN], 1u);
            else XB_SPIN(xb_ld(&bar[XB_TOPGEN]) == tg, bar);
            __builtin_amdgcn_fence(__ATOMIC_ACQUIRE, "agent");
            xb_add(&bar[XB_XGEN(b.x)], 1u);
            asm volatile("s_waitcnt vmcnt(0)" ::: "memory");
        } else {
            XB_SPIN(xb_ld(&bar[XB_XGEN(b.x)]) == gen, bar);
            __builtin_amdgcn_fence(__ATOMIC_ACQUIRE, "agent");
            asm volatile("s_waitcnt vmcnt(0)" ::: "memory");
        }
    }
    __syncthreads();
}

constexpr size_t MiB = 1u << 20;
constexpr size_t WS_CTL = 0, CTL_ZERO_BYTES = 1 * MiB;
constexpr int CW_BAR = 4096;
constexpr int CW_QUEUE = 16384;
constexpr size_t WS_W13 = 2 * MiB;
constexpr size_t WS_W2  = 34 * MiB;
constexpr size_t WS_WR  = 50 * MiB;
constexpr size_t WS_MISC = 51 * MiB;
constexpr size_t WS_ROUTE = 52 * MiB;
constexpr size_t WS_RPOS = 53 * MiB;
constexpr size_t WS_ROWTOK = 54 * MiB;
constexpr size_t WS_ROPE = 55 * MiB;
constexpr size_t WS_WUQ = 56 * MiB;
constexpr size_t WS_WUKV = 57 * MiB;
constexpr size_t WS_WA = 58 * MiB;
constexpr size_t WS_WB = 59 * MiB;
constexpr size_t WS_WC = 60 * MiB;
constexpr size_t WS_WO = 61 * MiB;
constexpr size_t WS_SSQ = 63 * MiB;
constexpr size_t WS_LSE = 64 * MiB;
constexpr size_t WS_MASK = 66 * MiB;
constexpr size_t WS_XB8 = 74 * MiB;
constexpr size_t WS_WIN8 = 138 * MiB;
constexpr size_t WS_H = 146 * MiB;
constexpr size_t WS_Y = 182 * MiB;
constexpr size_t WS_SC = WS_Y;
constexpr size_t WS_G3 = 254 * MiB;
constexpr size_t WS_PROJ = 350 * MiB;
constexpr size_t WS_QM = 606 * MiB;
constexpr size_t WS_KVM = 654 * MiB;
constexpr size_t WS_OA = 718 * MiB;
constexpr size_t WS_OB = 734 * MiB;
constexpr size_t WS_OC = 750 * MiB;
constexpr size_t WS_OG = 766 * MiB;
constexpr size_t WS_M0 = 814 * MiB;
constexpr size_t WS_M1 = 846 * MiB;
constexpr size_t WS_MERGED = 878 * MiB;
constexpr size_t WS_END = 910 * MiB;
constexpr int F8_SA_X = 127 - 4, F8_SW = 127 - 10;
constexpr int MAXROWS = 139264;
constexpr int NBC = 16, TC = NBC * SEQ, NCHUNK = NB / NBC;
constexpr int CIN = 3944, PW = 4096;

constexpr int MI_BLOCKCNT = 0;
constexpr int MI_PANEL_E = 8192;
constexpr int MI_NPAN = 8192 + 1024;

constexpr int RING_BYTES = 131072;
constexpr int L_CTL = RING_BYTES;
constexpr int L_BARW = L_CTL + 32;
constexpr int L_HIST = L_CTL + 256;
constexpr int L_TOT  = L_CTL + 384;
constexpr int L_PRE  = L_CTL + 512;
constexpr int L_BASE = L_CTL + 640;
constexpr int L_RANK = L_CTL + 896;
constexpr int L_PE   = L_CTL + 1024;
constexpr int L_ROWS = L_CTL + 2048;
constexpr int LDS_BYTES = 147456;
constexpr int L_GB = L_ROWS;
static_assert(L_ROWS + 12288 <= LDS_BYTES, "LDS map");

#ifndef DUPMASK
#define DUPMASK 0
#endif
struct Args { const float* in[23]; float* out; unsigned char* ws; };
#define PHASE_IDS(F) do { int t_ = threadIdx.x; asm volatile("" : "+v"(t_)); (F).tid = t_; (F).lane = t_ & 63; { intab_t p_ = (intab_t)__builtin_amdgcn_kernarg_segment_ptr(); asm volatile("" : "+s"(p_)); (F).in.p = p_; } \
    { unsigned char GAS* w_ = (unsigned char GAS*)(F).ws0; asm volatile("" : "+s"(w_)); (F).ws = (unsigned char*)w_; float GAS* o_ = (float GAS*)(F).out0; asm volatile("" : "+s"(o_)); (F).out = (float*)o_; } } while (0)

typedef const float GAS* gfptr_t;
typedef const gfptr_t __attribute__((address_space(4)))* intab_t;
struct InTab { intab_t p; __device__ __forceinline__ const float* operator[](int i) const { return (const float*)p[i]; } };
struct Frame {
    LAS unsigned char* lds;
    int tid, lane, wave, vcu, G;
    InTab in; float* out; unsigned char* ws; float* out0; unsigned char* ws0;
};

template <class F>
__device__ __forceinline__ void conv_item(bf16_t* WT, int ldk, int k0, int n0, LAS float* scr, int lane, F val) {
#pragma unroll 8
    for (int i = 0; i < 32; ++i) { const int kk = 2 * i + (lane >> 5); scr[kk * 33 + (lane & 31)] = val(k0 + kk, n0 + (lane & 31)); }
    LDS_WAIT(); asm volatile("" ::: "memory");
    const int c = lane & 7;
#pragma unroll
    for (int j = 0; j < 4; ++j) { const int n = (lane >> 3) + 8 * j; const LAS float* s = scr + (8 * c) * 33 + n;
        u32x4 o; o.x = pk2(s[0 * 33], s[1 * 33]); o.y = pk2(s[2 * 33], s[3 * 33]); o.z = pk2(s[4 * 33], s[5 * 33]); o.w = pk2(s[6 * 33], s[7 * 33]);
        *(u32x4*)(WT + (size_t)(n0 + n) * ldk + k0 + 8 * c) = o; }
    LDS_WAIT(); asm volatile("" ::: "memory");
}

template <class F>
__device__ __forceinline__ void conv_item8(unsigned char* WT, int ldk, int k0, int n0, LAS float* scr, int lane, F val) {
#pragma unroll 8
    for (int i = 0; i < 32; ++i) { const int kk = 2 * i + (lane >> 5); scr[kk * 33 + (lane & 31)] = val(k0 + kk, n0 + (lane & 31)); }
    LDS_WAIT(); asm volatile("" ::: "memory");
    const int c = lane & 7;
#pragma unroll
    for (int j = 0; j < 4; ++j) { const int n = (lane >> 3) + 8 * j; const LAS float* s = scr + (8 * c) * 33 + n;
        u32x2 o; o.x = pk4_fp8(s[0 * 33], s[1 * 33], s[2 * 33], s[3 * 33]); o.y = pk4_fp8(s[4 * 33], s[5 * 33], s[6 * 33], s[7 * 33]);
        *(u32x2*)(WT + (size_t)(n0 + n) * ldk + k0 + 8 * c) = o; }
    LDS_WAIT(); asm volatile("" ::: "memory");
}

__device__ __forceinline__ void conv_plain8(unsigned char* WT, int ldk, int k0, int n0, LAS float* scr, int lane, const float* src, int pitch, float sc) {
    f32x4 v[8];
#pragma unroll
    for (int i = 0; i < 8; ++i) v[i] = *(const f32x4*)(src + (size_t)(k0 + (lane >> 3) + 8 * i) * pitch + n0 + (lane & 7) * 4);
#pragma unroll
    for (int i = 0; i < 8; ++i) { LAS float* d = scr + ((lane >> 3) + 8 * i) * 33 + (lane & 7) * 4; d[0] = v[i][0] * sc; d[1] = v[i][1] * sc; d[2] = v[i][2] * sc; d[3] = v[i][3] * sc; }
    LDS_WAIT(); asm volatile("" ::: "memory");
    const int c = lane & 7;
#pragma unroll
    for (int j = 0; j < 4; ++j) { const int n = (lane >> 3) + 8 * j; const LAS float* s = scr + (8 * c) * 33 + n;
        u32x2 o; o.x = pk4_fp8(s[0 * 33], s[1 * 33], s[2 * 33], s[3 * 33]); o.y = pk4_fp8(s[4 * 33], s[5 * 33], s[6 * 33], s[7 * 33]);
        *(u32x2*)(WT + (size_t)(n0 + n) * ldk + k0 + 8 * c) = o; }
    LDS_WAIT(); asm volatile("" ::: "memory");
}
__device__ __forceinline__ void conv_pair8(unsigned char* WT, int ldk, int k0, int n0, LAS float* scr, int lane, const float* a, const float* b, int pitch, float sc) {
    f32x2 va[8], vb[8];
#pragma unroll
    for (int i = 0; i < 8; ++i) { const size_t o = (size_t)(k0 + (lane >> 3) + 8 * i) * pitch + (n0 >> 1) + (lane & 7) * 2; va[i] = *(const f32x2*)(a + o); vb[i] = *(const f32x2*)(b + o); }
#pragma unroll
    for (int i = 0; i < 8; ++i) { LAS float* d = scr + ((lane >> 3) + 8 * i) * 33 + (lane & 7) * 4; d[0] = va[i][0] * sc; d[1] = vb[i][0] * sc; d[2] = va[i][1] * sc; d[3] = vb[i][1] * sc; }
    LDS_WAIT(); asm volatile("" ::: "memory");
    const int c = lane & 7;
#pragma unroll
    for (int j = 0; j < 4; ++j) { const int n = (lane >> 3) + 8 * j; const LAS float* s = scr + (8 * c) * 33 + n;
        u32x2 o; o.x = pk4_fp8(s[0 * 33], s[1 * 33], s[2 * 33], s[3 * 33]); o.y = pk4_fp8(s[4 * 33], s[5 * 33], s[6 * 33], s[7 * 33]);
        *(u32x2*)(WT + (size_t)(n0 + n) * ldk + k0 + 8 * c) = o; }
    LDS_WAIT(); asm volatile("" ::: "memory");
}

__device__ __forceinline__ void phase_conv_moe(Frame& F, int l) {
    PHASE_IDS(F);
    LAS float* scr = (LAS float*)(F.lds + F.wave * 16384);
    const int gw = F.vcu * NWAVES + F.wave, NGW = F.G * NWAVES;
    const float* w1 = F.in[18] + (size_t)l * NEXP * DM * DEXP;
    const float* w3 = F.in[19] + (size_t)l * NEXP * DM * DEXP;
    const float* w2 = F.in[20] + (size_t)l * NEXP * DEXP * DM;
    bf16_t* W13 = (bf16_t*)(F.ws + WS_W13); bf16_t* W2 = (bf16_t*)(F.ws + WS_W2);
    constexpr int I13 = (DM / 64) * (512 / 32);
    constexpr int I2 = (DEXP / 64) * (DM / 32);
    for (int it = gw; it < NEXP * (I13 + I2); it += NGW) {
        if (it < NEXP * I13) {
            const int e = it / I13, r = it % I13, kb = r / 16, nb = r % 16;
            const float* a = w1 + (size_t)e * DM * DEXP; const float* b = w3 + (size_t)e * DM * DEXP;
            conv_pair8((unsigned char*)W13 + (size_t)e * 512 * DM, DM, kb * 64, nb * 32, scr, F.lane, a, b, DEXP, 1024.f);
        } else {
            const int it2 = it - NEXP * I13; const int e = it2 / I2, r = it2 % I2, kb = r / 32, nb = r % 32;
            const float* a = w2 + (size_t)e * DEXP * DM;
            conv_plain8((unsigned char*)W2 + (size_t)e * DM * DEXP, DEXP, kb * 64, nb * 32, scr, F.lane, a, DM, 1024.f);
        }
    }
    const float* wg = F.in[14] + (size_t)l * DM * 4; const float* wsb = F.in[16] + (size_t)l * DM * NEXP;
    const float* g1 = F.in[12] + (size_t)l * DM; const float* b1 = F.in[13] + (size_t)l * DM;
    bf16_t* WRH = (bf16_t*)(F.ws + WS_WR); bf16_t* WRL = (bf16_t*)(F.ws + WS_WR + 128 * 1024); float* WRC = (float*)(F.ws + WS_WR + 256 * 1024);
    for (int idx = (F.vcu * NTHREADS + F.tid); idx < 64 * DM; idx += F.G * NTHREADS) {
        const int c = idx / DM, k = idx % DM;
        const float v = (c < 32 ? wsb[(size_t)k * NEXP + c] : (c < 36 ? wg[(size_t)k * 4 + (c - 32)] : 0.f)) * g1[k];
        const unsigned h = f2bf(v); const int it = k >> 5, hi_ = (k >> 4) & 1, st = (k >> 3) & 1, e = k & 7, ln = (c & 31) + 32 * hi_, p0 = 2 * (c >> 5);
        WRH[((((size_t)it * 4 + p0) * 2 + st) * 64 + ln) * 8 + e] = (bf16_t)h;
        WRH[((((size_t)it * 4 + p0 + 1) * 2 + st) * 64 + ln) * 8 + e] = (bf16_t)f2bf(v - __builtin_bit_cast(float, h << 16)); (void)WRL;
    }
    if (gw < 64) {
        const int c = gw; float s1 = 0.f, s2 = 0.f;
        for (int k = F.lane; k < DM; k += 64) { const float w = c < 32 ? wsb[(size_t)k * NEXP + c] : (c < 36 ? wg[(size_t)k * 4 + (c - 32)] : 0.f); s1 += g1[k] * w; s2 += b1[k] * w; }
        s1 = wave_sum(s1); s2 = wave_sum(s2);
        const float bias = c < 32 ? F.in[17][(size_t)l * NEXP + c] : (c < 36 ? F.in[15][(size_t)l * 4 + (c - 32)] : 0.f);
        if (F.lane == 0) { WRC[c] = s1; WRC[64 + c] = s2 + bias; }
    }
}

__device__ __forceinline__ void ln_row(f32x4 (&v)[4], const f32x4 (&g)[4], const f32x4 (&b)[4], float* omean = nullptr, float* orstd = nullptr) {
    float s = 0.f;
#pragma unroll
    for (int j = 0; j < 4; ++j) s += (v[j].x + v[j].y) + (v[j].z + v[j].w);
    const float mean = wave_sum(s) * (1.f / DM); float s2 = 0.f;
#pragma unroll
    for (int j = 0; j < 4; ++j) { v[j] = v[j] - mean; s2 += (v[j].x * v[j].x + v[j].y * v[j].y) + (v[j].z * v[j].z + v[j].w * v[j].w); }
    const float rstd = 1.0f / sqrtf(wave_sum(s2) * (1.f / DM) + LN_EPS);
#pragma unroll
    for (int j = 0; j < 4; ++j) v[j] = v[j] * rstd * g[j] + b[j];
    if (omean) { *omean = mean; *orstd = rstd; }
}
__device__ __forceinline__ void store_row(const f32x4 (&v)[4], float* orow, unsigned char* brow, int lane) {
#pragma unroll
    for (int j = 0; j < 4; ++j) {
        ((f32x4*)orow)[lane + 64 * j] = v[j];
        ((unsigned*)brow)[lane + 64 * j] = pk4_fp8(v[j].x * 16.f, v[j].y * 16.f, v[j].z * 16.f, v[j].w * 16.f);
    }
}

__device__ __forceinline__ void phase_ln1_router(Frame& F, int l, const float* src, bool scale_alpha) {
    PHASE_IDS(F);
    const int lane = F.lane, hi = lane >> 5, r32 = lane & 31;
    const float* lg = F.in[12] + (size_t)l * DM; const float* lb = F.in[13] + (size_t)l * DM;
    f32x4 g[4], b[4];
#pragma unroll
    for (int j = 0; j < 4; ++j) { g[j] = ((const f32x4*)lg)[lane + 64 * j]; b[j] = ((const f32x4*)lb)[lane + 64 * j]; }
    unsigned char* XB = F.ws + WS_XB8;
    const bf16_t* WRH = (const bf16_t*)(F.ws + WS_WR); const bf16_t* WRL = (const bf16_t*)(F.ws + WS_WR + 128 * 1024);
    const float* WRC = (const float*)(F.ws + WS_WR + 256 * 1024); float* stats = (float*)(F.ws + WS_WR + 512 * 1024);
    unsigned* misc = (unsigned*)(F.ws + WS_MISC);
    int* route = (int*)(F.ws + WS_ROUTE);
    LAS unsigned* hist = (LAS unsigned*)(F.lds + L_HIST);
    const float sc = scale_alpha ? ALPHA : 1.0f;
    for (int blk = F.vcu; blk < TT / 256; blk += F.G) {
        if (F.tid < 32) hist[F.tid] = 0u;
        __syncthreads();
        const int row0 = blk * 256 + F.wave * 32;
        float mu_l = 0.f, rs_l = 1.f;
        for (int i = 0; i < 32; i += 2) {
            f32x4 v0[4], v1[4];
            const f32x4* p0 = (const f32x4*)(src + (size_t)(row0 + i) * DM); const f32x4* p1 = (const f32x4*)(src + (size_t)(row0 + i + 1) * DM);
#pragma unroll
            for (int j = 0; j < 4; ++j) { v0[j] = p0[lane + 64 * j] * sc; v1[j] = p1[lane + 64 * j] * sc; }
            float m0, r0, m1, r1;
            ln_row(v0, g, b, &m0, &r0); ln_row(v1, g, b, &m1, &r1);
            mu_l = (r32 == i) ? m0 : ((r32 == i + 1) ? m1 : mu_l); rs_l = (r32 == i) ? r0 : ((r32 == i + 1) ? r1 : rs_l);
#pragma unroll
            for (int j = 0; j < 4; ++j) {
                ((unsigned*)(XB + (size_t)(row0 + i) * DM))[lane + 64 * j] = pk4_fp8(v0[j].x * 16.f, v0[j].y * 16.f, v0[j].z * 16.f, v0[j].w * 16.f);
                ((unsigned*)(XB + (size_t)(row0 + i + 1) * DM))[lane + 64 * j] = pk4_fp8(v1[j].x * 16.f, v1[j].y * 16.f, v1[j].z * 16.f, v1[j].w * 16.f); }
        }
        if (hi == 0) *(f32x2*)(stats + (size_t)(row0 + r32) * 2) = (f32x2){mu_l, rs_l};
        f32x16 acc0 = {}, acc1 = {};
        {
            const bf16_t* WT = WRH; (void)WRL;
            LAS float* xs = (LAS float*)(F.lds + F.wave * 9216);
            const float* xg = src + (size_t)(row0 + (lane >> 3)) * DM + (lane & 7) * 4;
            f32x4 xv[4]; bf16x8 wv[8];
#pragma unroll
            for (int i = 0; i < 4; ++i) xv[i] = *(const f32x4*)(xg + (size_t)(8 * i) * DM);
#pragma unroll
            for (int q = 0; q < 8; ++q) wv[q] = *(const bf16x8*)(WT + ((size_t)q * 64 + lane) * 8);
#pragma unroll 2
            for (int it = 0; it < 32; ++it) {
                LAS float* xb = xs + (it & 1) * 1152;
#pragma unroll
                for (int i = 0; i < 4; ++i) *(LAS f32x4*)(xb + ((lane >> 3) + 8 * i) * 36 + (lane & 7) * 4) = xv[i];
                bf16x8 wc[8];
#pragma unroll
                for (int q = 0; q < 8; ++q) wc[q] = wv[q];
                { const int nx = it + 1 < 32 ? it + 1 : 31;
#pragma unroll
                  for (int i = 0; i < 4; ++i) xv[i] = *(const f32x4*)(xg + (size_t)(8 * i) * DM + nx * 32);
#pragma unroll
                  for (int q = 0; q < 8; ++q) wv[q] = *(const bf16x8*)(WT + (((size_t)nx * 8 + q) * 64 + lane) * 8); }
                f32x4 xa[4];
#pragma unroll
                for (int j = 0; j < 4; ++j) xa[j] = *(const LAS f32x4*)(xb + r32 * 36 + hi * 16 + 4 * j);
#pragma unroll
                for (int st = 0; st < 2; ++st) {
                    const f32x4 x0 = xa[2 * st], x1 = xa[2 * st + 1];
                    u32x4 xh, xl;
                    xh.x = cvt_pk_bf16(x0[0], x0[1]); xh.y = cvt_pk_bf16(x0[2], x0[3]); xh.z = cvt_pk_bf16(x1[0], x1[1]); xh.w = cvt_pk_bf16(x1[2], x1[3]);
                    xl.x = cvt_pk_bf16(x0[0] - bflo(xh.x), x0[1] - bfhi(xh.x)); xl.y = cvt_pk_bf16(x0[2] - bflo(xh.y), x0[3] - bfhi(xh.y));
                    xl.z = cvt_pk_bf16(x1[0] - bflo(xh.z), x1[1] - bfhi(xh.z)); xl.w = cvt_pk_bf16(x1[2] - bflo(xh.w), x1[3] - bfhi(xh.w));
                    const bf16x8 xhv = __builtin_bit_cast(bf16x8, xh), xlv = __builtin_bit_cast(bf16x8, xl);
                    acc0 = __builtin_amdgcn_mfma_f32_32x32x16_bf16(wc[0 + st], xhv, acc0, 0, 0, 0); acc1 = __builtin_amdgcn_mfma_f32_32x32x16_bf16(wc[4 + st], xhv, acc1, 0, 0, 0);
                    acc0 = __builtin_amdgcn_mfma_f32_32x32x16_bf16(wc[2 + st], xhv, acc0, 0, 0, 0); acc1 = __builtin_amdgcn_mfma_f32_32x32x16_bf16(wc[6 + st], xhv, acc1, 0, 0, 0);
                    acc0 = __builtin_amdgcn_mfma_f32_32x32x16_bf16(wc[0 + st], xlv, acc0, 0, 0, 0); acc1 = __builtin_amdgcn_mfma_f32_32x32x16_bf16(wc[4 + st], xlv, acc1, 0, 0, 0);
                }
            }
        }
        float gl[4];
#pragma unroll
        for (int i = 0; i < 4; ++i) gl[i] = rs_l * (acc1[i] - mu_l * WRC[32 + i]) + WRC[64 + 32 + i];
        int gidx = 0; float gmax = gl[0];
#pragma unroll
        for (int i = 1; i < 4; ++i) if (gl[i] > gmax) { gmax = gl[i]; gidx = i; }
        float gsum = 0.f;
#pragma unroll
        for (int i = 0; i < 4; ++i) gsum += fast_exp(gl[i] - gmax);
        float gp = 1.0f / gsum;
        gidx = __shfl(gidx, r32); gp = __shfl(gp, r32);
        float cv[4];
#pragma unroll
        for (int i = 0; i < 4; ++i) {
            const float a = gidx == 0 ? acc0[i] : gidx == 1 ? acc0[4 + i] : gidx == 2 ? acc0[8 + i] : acc0[12 + i];
            cv[i] = rs_l * (a - mu_l * WRC[8 * gidx + 4 * hi + i]) + WRC[64 + 8 * gidx + 4 * hi + i];
        }
        float v1 = cv[0]; int i1 = 0;
#pragma unroll
        for (int i = 1; i < 4; ++i) if (cv[i] > v1) { v1 = cv[i]; i1 = i; }
        float v2 = -INFINITY; int i2 = 0;
#pragma unroll
        for (int i = 0; i < 4; ++i) if (i != i1 && cv[i] > v2) { v2 = cv[i]; i2 = i; }
        i1 += 4 * hi; i2 += 4 * hi;
        const float pv1 = __shfl_xor(v1, 32), pv2 = __shfl_xor(v2, 32); const int pi1 = __shfl_xor(i1, 32), pi2 = __shfl_xor(i2, 32);
        auto better = [](float av, int ai, float bv, int bi) { return av > bv || (av == bv && ai < bi); };
        float fv, sv; int fi, si;
        if (better(v1, i1, pv1, pi1)) { fv = v1; fi = i1; if (better(v2, i2, pv1, pi1)) { sv = v2; si = i2; } else { sv = pv1; si = pi1; } }
        else { fv = pv1; fi = pi1; if (better(v1, i1, pv2, pi2)) { sv = v1; si = i1; } else { sv = pv2; si = pi2; } }
        const float d = fast_exp(sv - fv), inv = 1.0f / (1.0f + d);
        const float w1 = gp * inv, w2 = gp * d * inv;
        const int e1 = 8 * gidx + fi, e2 = 8 * gidx + si;
        if (hi == 0) {
            *(int4*)(route + (size_t)(row0 + r32) * 4) = make_int4(e1, e2, __float_as_int(w1), __float_as_int(w2));
            atomicAdd((unsigned*)&hist[e1], 1u); atomicAdd((unsigned*)&hist[e2], 1u);
        }
        __syncthreads();
        if (F.tid < 32) misc[MI_BLOCKCNT + blk * 32 + F.tid] = hist[F.tid];
        __syncthreads();
    }
}

__device__ __forceinline__ void phase_moe_scatter(Frame& F) {
    PHASE_IDS(F);
    unsigned* misc = (unsigned*)(F.ws + WS_MISC);
    const int* route = (const int*)(F.ws + WS_ROUTE);
    int* rpos = (int*)(F.ws + WS_RPOS); int* rowtok = (int*)(F.ws + WS_ROWTOK);
    LAS unsigned* tot = (LAS unsigned*)(F.lds + L_TOT); LAS unsigned* pre = (LAS unsigned*)(F.lds + L_PRE);
    LAS unsigned* base = (LAS unsigned*)(F.lds + L_BASE); LAS unsigned* rank = (LAS unsigned*)(F.lds + L_RANK);
    for (int blk = F.vcu; blk < TT / 256; blk += F.G) {
        {
            if (F.tid < 32) { tot[F.tid] = 0u; pre[F.tid] = 0u; rank[F.tid] = 0u; }
            __syncthreads();
            const int e = F.tid & 31, part = F.tid >> 5; unsigned cv[16];
#pragma unroll
            for (int i = 0; i < 16; ++i) cv[i] = misc[MI_BLOCKCNT + (part * 16 + i) * 32 + e];
            unsigned t = 0, p = 0;
#pragma unroll
            for (int i = 0; i < 16; ++i) { t += cv[i]; p += (part * 16 + i < blk) ? cv[i] : 0u; }
            atomicAdd((unsigned*)&tot[e], t); atomicAdd((unsigned*)&pre[e], p);
        }
        __syncthreads();
        if (F.tid == 0) { unsigned a = 0; for (int e = 0; e < NEXP; ++e) { base[e] = a; a += (tot[e] + 255u) & ~255u; } base[NEXP] = a; }
        __syncthreads();
        {
            const int tok = blk * 256 + (F.tid >> 1), slot = F.tid & 1;
            const int e = route[(size_t)tok * 4 + slot];
            const unsigned r = atomicAdd((unsigned*)&rank[e], 1u);
            const unsigned pos = base[e] + pre[e] + r;
            rowtok[pos] = tok; rpos[(size_t)tok * 2 + slot] = (int)pos;
        }
        if (blk < NEXP) {
            const int e = blk; const unsigned end = base[e] + tot[e], nxt = base[e + 1];
            for (unsigned p = end + F.tid; p < nxt; p += NTHREADS) rowtok[p] = 0;
            for (unsigned p = base[e] / 256 + F.tid; p < nxt / 256; p += NTHREADS) misc[MI_PANEL_E + p] = (unsigned)e;
        }
        if (blk == 0 && F.tid == 0) misc[MI_NPAN] = base[NEXP] / 256;
        __syncthreads();
    }
}

struct MoeSched1 {
    static constexpr bool GATHER = true;
    const bf16_t* A; const bf16_t* W; int lda, ldb, ntot, G, c; const LAS int* rows; const LAS int* pe; int sw8, sa8;
    __device__ __forceinline__ bool next(int i, pg8::Unit& u) const { const int v = i * G + c; if (v >= ntot) return false; u.pm = v >> 1; u.pn = v & 1; u.ord = i; return true; }
    __device__ __forceinline__ const char* a_base(const pg8::Unit&) const { return (const char*)A; }
    __device__ __forceinline__ const char* b_base(const pg8::Unit& u) const { return (const char*)(W + (size_t)pe[u.ord] * 512 * ldb + (size_t)u.pn * 256 * ldb); }
    __device__ __forceinline__ void a_off(const pg8::Unit& u, const int (&R)[2], const int (&C)[2], unsigned (&v)[2][2]) const {
#pragma unroll
        for (int h = 0; h < 2; ++h)
#pragma unroll
            for (int i = 0; i < 2; ++i) v[h][i] = (unsigned)(rows[u.ord * 256 + h * 128 + R[i]] * lda + C[i]) * 2u;
    }
};
struct MoeSched2 {
    static constexpr bool GATHER = false;
    const bf16_t* A; const bf16_t* W; int lda, ldb, ntot, G, c; const LAS int* pe; int sw8, sa8;
    __device__ __forceinline__ bool next(int i, pg8::Unit& u) const { const int v = i * G + c; if (v >= ntot) return false; u.pm = v >> 2; u.pn = v & 3; u.ord = i; return true; }
    __device__ __forceinline__ const char* a_base(const pg8::Unit& u) const { return (const char*)(A + (size_t)u.pm * 256 * lda); }
    __device__ __forceinline__ const char* b_base(const pg8::Unit& u) const { return (const char*)(W + (size_t)pe[u.ord] * DM * ldb + (size_t)u.pn * 256 * ldb); }
    __device__ __forceinline__ void a_off(const pg8::Unit&, const int (&R)[2], const int (&C)[2], unsigned (&v)[2][2]) const {
#pragma unroll
        for (int i = 0; i < 2; ++i) { v[0][i] = (unsigned)(R[i] * lda + C[i]) * 2u; v[1][i] = (unsigned)((128 + R[i]) * lda + C[i]) * 2u; }
    }
};
struct EpiSwiGLU {
    bf16_t* H;
    __device__ __forceinline__ void operator()(const f32x4 (&acc)[2][2][4][2], const pg8::Unit& u, int wr, int wc, int fr, int fq) const {
        const int row0 = u.pm * 256 + wr * 64 + fr, col0 = u.pn * 128 + wc * 16 + 4 * fq;
#pragma unroll
        for (int ai = 0; ai < 2; ++ai)
#pragma unroll
            for (int m = 0; m < 4; ++m) { bf16_t* rowp = H + (size_t)(row0 + ai * 128 + m * 16) * DEXP + col0;
#pragma unroll
                for (int bj = 0; bj < 2; ++bj) { const f32x4 v0 = acc[ai][bj][m][0], v1 = acc[ai][bj][m][1];
                    const float h0 = v0[0] * sigmoidf_(v0[0]) * v0[1], h1 = v0[2] * sigmoidf_(v0[2]) * v0[3], h2 = v1[0] * sigmoidf_(v1[0]) * v1[1], h3 = v1[2] * sigmoidf_(v1[2]) * v1[3];
                    *(unsigned*)((unsigned char*)H + (size_t)(row0 + ai * 128 + m * 16) * DEXP + col0 + bj * 64) = pk4_fp8(h0 * 16.f, h1 * 16.f, h2 * 16.f, h3 * 16.f); (void)rowp; } }
    }
};
struct EpiStoreBf16 {
    bf16_t* O; int ldc;
    __device__ __forceinline__ void operator()(const f32x4 (&acc)[2][2][4][2], const pg8::Unit& u, int wr, int wc, int fr, int fq) const {
        const int row0 = u.pm * 256 + wr * 64 + fr, col0 = u.pn * 256 + wc * 32 + 8 * fq;
#pragma unroll
        for (int ai = 0; ai < 2; ++ai)
#pragma unroll
            for (int m = 0; m < 4; ++m) { bf16_t* rowp = O + (size_t)(row0 + ai * 128 + m * 16) * ldc + col0;
#pragma unroll
                for (int bj = 0; bj < 2; ++bj) store8_fp8((unsigned char*)O + (size_t)(row0 + ai * 128 + m * 16) * ldc + col0 + bj * 128, acc[ai][bj][m][0], acc[ai][bj][m][1], 64.f); (void)rowp; }
    }
};

__device__ __forceinline__ void phase_moe_gemm1(Frame& F) {
    PHASE_IDS(F);
    const unsigned* misc = (const unsigned*)(F.ws + WS_MISC);
    const int* rowtok = (const int*)(F.ws + WS_ROWTOK);
    const int npan = (int)misc[MI_NPAN];
    LAS int* rows = (LAS int*)(F.lds + L_ROWS); LAS int* pe = (LAS int*)(F.lds + L_PE);
    const int c = (int)blockIdx.x, ntot = npan * 2;
    for (int i = 0; i * F.G + c < ntot && i < 8; ++i) { const int p = (i * F.G + c) >> 1;
        if (F.tid < 256) rows[i * 256 + F.tid] = rowtok[p * 256 + F.tid];
        if (F.tid == 256) pe[i] = (int)misc[MI_PANEL_E + p]; }
    VM_WAIT(); LDS_WAIT(); __syncthreads();
    MoeSched1 S{(const bf16_t*)(F.ws + WS_XB8), (const bf16_t*)(F.ws + WS_W13), DM / 2, DM / 2, ntot, F.G, c, rows, pe, F8_SW, F8_SA_X};
    EpiSwiGLU E{(bf16_t*)(F.ws + WS_H)};
    pg8::gemm_phase<EpiSwiGLU, MoeSched1, true, true>(F.lds, DM / 2, S, E);
}
__device__ __forceinline__ void phase_moe_gemm2(Frame& F) {
    PHASE_IDS(F);
    const unsigned* misc = (const unsigned*)(F.ws + WS_MISC);
    const int npan = (int)misc[MI_NPAN];
    LAS int* pe = (LAS int*)(F.lds + L_PE);
    const int c = (int)blockIdx.x, ntot = npan * 4;
    __syncthreads();
    if (F.tid < 16) { const int v = F.tid * F.G + c; if (v < ntot) pe[F.tid] = (int)misc[MI_PANEL_E + (v >> 2)]; }
    VM_WAIT(); LDS_WAIT(); __syncthreads();
    MoeSched2 S{(const bf16_t*)(F.ws + WS_H), (const bf16_t*)(F.ws + WS_W2), DEXP / 2, DEXP / 2, ntot, F.G, c, pe, F8_SW, 127 - 4};
    EpiStoreBf16 E{(bf16_t*)(F.ws + WS_Y), DM};
    int k2 = DEXP / 2; asm volatile("" : "+s"(k2));
    pg8::gemm_phase<EpiStoreBf16, MoeSched2, true, true>(F.lds, k2, S, E);
}

__device__ __forceinline__ void phase_combine_ln2(Frame& F, int l) {
    PHASE_IDS(F);
    const int lane = F.lane;
    const float* lg = F.in[21] + (size_t)l * DM; const float* lb = F.in[22] + (size_t)l * DM;
    f32x4 g[4], b[4];
#pragma unroll
    for (int j = 0; j < 4; ++j) { g[j] = ((const f32x4*)lg)[lane + 64 * j]; b[j] = ((const f32x4*)lb)[lane + 64 * j]; }
    const bf16_t* Y = (const bf16_t*)(F.ws + WS_Y);
    const float* l1g = F.in[12] + (size_t)l * DM; const float* l1b = F.in[13] + (size_t)l * DM; const float* stats = (const float*)(F.ws + WS_WR + 512 * 1024);
    f32x4 g1[4], b1[4];
#pragma unroll
    for (int j = 0; j < 4; ++j) { g1[j] = ((const f32x4*)l1g)[lane + 64 * j]; b1[j] = ((const f32x4*)l1b)[lane + 64 * j]; }
    const int* route = (const int*)(F.ws + WS_ROUTE); const int* rpos = (const int*)(F.ws + WS_RPOS);
    const int gw = F.vcu * NWAVES + F.wave, NGW = F.G * NWAVES;
    int4 rt_n = *(const int4*)(route + (size_t)gw * 4); int2 rp_n = *(const int2*)(rpos + (size_t)gw * 2); f32x2 st_n = *(const f32x2*)(stats + (size_t)gw * 2);
    for (int row = gw; row < TT; row += NGW) {
        const int4 rt = rt_n; const int2 rp = rp_n; const f32x2 st = st_n;
        { const int nr = (row + NGW < TT) ? row + NGW : row; rt_n = *(const int4*)(route + (size_t)nr * 4); rp_n = *(const int2*)(rpos + (size_t)nr * 2); st_n = *(const f32x2*)(stats + (size_t)nr * 2); }
        const float w0 = __int_as_float(rt.z) * (1.f / 64.f), w1 = __int_as_float(rt.w) * (1.f / 64.f);
        const f32x4* px = (const f32x4*)(F.out + (size_t)row * DM);
        const unsigned* y0 = (const unsigned*)((const unsigned char*)Y + (size_t)rp.x * DM); const unsigned* y1 = (const unsigned*)((const unsigned char*)Y + (size_t)rp.y * DM);
        f32x4 v[4];
#pragma unroll
        for (int j = 0; j < 4; ++j) {
            const f32x4 x = (px[lane + 64 * j] - st[0]) * st[1] * g1[j] + b1[j]; const unsigned a = y0[lane + 64 * j], c = y1[lane + 64 * j];
            const f32x2 a01 = __builtin_amdgcn_cvt_pk_f32_fp8((int)a, false), a23 = __builtin_amdgcn_cvt_pk_f32_fp8((int)a, true), c01 = __builtin_amdgcn_cvt_pk_f32_fp8((int)c, false), c23 = __builtin_amdgcn_cvt_pk_f32_fp8((int)c, true);
            v[j].x = ALPHA * x.x + w0 * a01[0] + w1 * c01[0]; v[j].y = ALPHA * x.y + w0 * a01[1] + w1 * c01[1];
            v[j].z = ALPHA * x.z + w0 * a23[0] + w1 * c23[0]; v[j].w = ALPHA * x.w + w0 * a23[1] + w1 * c23[1];
        }
        ln_row(v, g, b);
#pragma unroll
        for (int j = 0; j < 4; ++j) ((f32x4*)(F.out + (size_t)row * DM))[lane + 64 * j] = v[j];
        if (l == 0) {
#pragma unroll
            for (int j = 0; j < 4; ++j) ((unsigned*)(F.ws + WS_XB8 + (size_t)row * DM))[lane + 64 * j] = pk4_fp8(v[j].x * 16.f, v[j].y * 16.f, v[j].z * 16.f, v[j].w * 16.f);
        }
    }
}

constexpr float C2D = 0.18033688011112042f;
constexpr float C2M = 0.14724444602590306f;
constexpr float IWS = 0.044194173824159216f;
constexpr float RMS_EPS = 1e-6f;
constexpr int L_QSLOT = L_CTL + 1152;

__device__ __forceinline__ int rope16(int c) { return c < 16 ? (c >> 1) + 8 * (c & 1) : c; }
__device__ __forceinline__ int win_src(int n, float& sc) {
    sc = 1.f;
    if (n < 384) return n;
    if (n < 416) { const int c = n - 384; return 384 + (c >> 1) + 16 * (c & 1); }
    if (n < 512) return -1;
    if (n < 2816) { const int m = n - 512, g = m / 768, r = m % 768, p = r >> 8, hh = (r & 255) >> 6, c = r & 63; if (p == 0) sc = C2D; return 416 + 768 * g + 256 * p + 64 * hh + (p < 2 ? rope16(c) : c); }
    if (n < 3328) { const int m = n - 2816; sc = C2D; return 2720 + (m & ~63) + rope16(m & 63); }
    if (n < 3840) { const int m = n - 3328; return 3360 + (m & ~63) + rope16(m & 63); }
    const int m = n - 3840;
    if (m < 64) return 3232 + rope16(m);
    if (m < 128) return 3296 + (m - 64);
    if (m < 192) return 3872 + rope16(m - 128);
    if (m < 200) { sc = IWS; return 3936 + (m - 192); }
    return -1;
}

__device__ __forceinline__ void sincos_d(double x, double& s, double& c) {
    const double n = __builtin_rint(x * 0.15915494309189535);
    double r = __builtin_fma(-n, 6.2831854820251465, x); r = __builtin_fma(n, 1.7484556025237907e-07, r);
    const double r2 = r * r; double ss = 1.0, cc = 1.0;
#pragma unroll
    for (int k = 15; k >= 1; --k) { ss = 1.0 - r2 * (1.0 / (double)((2 * k) * (2 * k + 1))) * ss; cc = 1.0 - r2 * (1.0 / (double)((2 * k - 1) * (2 * k))) * cc; }
    s = ss * r; c = cc;
}
__device__ __forceinline__ double inv_freq16(int i) {
    const double t[16] = {1.0, 0.44036660267178046, 0.19392274474868576, 0.08539710028576561, 0.03760603093086393, 0.016560440080994446, 0.007292664737217109, 0.003211445994752591,
                          0.001414213562373095, 0.000622772421914596, 0.0002742481756762073, 0.00012076973741146504, 5.318295896944988e-05, 2.341999896140934e-05, 1.031338537721246e-05, 4.5416704806078695e-06};
    double r = t[0];
#pragma unroll
    for (int k = 1; k < 16; ++k) r = (i == k) ? t[k] : r;
    return r;
}

__device__ __forceinline__ void phase_conv_mixer(Frame& F, int l) {
    PHASE_IDS(F);
    LAS float* scr = (LAS float*)(F.lds + F.wave * 16384);
    const int gw = F.vcu * NWAVES + F.wave, NGW = F.G * NWAVES;
    const float* win = F.in[1] + (size_t)l * DM * CIN;
    const float* qg = F.in[2] + (size_t)l * 256; const float* wuq = F.in[3] + (size_t)l * 256 * 768;
    const float* kg = F.in[4] + (size_t)l * 128; const float* wukv = F.in[5] + (size_t)l * 128 * 1024;
    const float* wgate = F.in[6] + (size_t)l * DM * 3072;
    const float* wa = F.in[8] + (size_t)l * 512 * DM; const float* wb = F.in[9] + (size_t)l * 256 * DM; const float* wc = F.in[10] + (size_t)l * 512 * DM; const float* wo = F.in[11] + (size_t)l * DM * DM;
    unsigned char* WIN8 = F.ws + WS_WIN8; bf16_t* WUQ = (bf16_t*)(F.ws + WS_WUQ); bf16_t* WUKV = (bf16_t*)(F.ws + WS_WUKV);
    bf16_t* WA = (bf16_t*)(F.ws + WS_WA); bf16_t* WB = (bf16_t*)(F.ws + WS_WB); bf16_t* WC = (bf16_t*)(F.ws + WS_WC); bf16_t* WO = (bf16_t*)(F.ws + WS_WO);
    constexpr int I_IN = 16 * 128, I_G = 16 * 96, I_UQ = 4 * 24, I_UKV = 4 * 32, I_A = 8 * 32, I_B = 8 * 32, I_C = 8 * 32, I_O = 16 * 32;
    constexpr int NIT = I_IN + I_G + I_UQ + I_UKV + I_A + I_B + I_C + I_O;
    for (int it = gw; it < NIT; it += NGW) {
        int r = it;
        if (r < I_IN) { conv_item8(WIN8, DM, (r / 128) * 64, (r % 128) * 32, scr, F.lane, [&](int k, int n) { float sc; const int sidx = win_src(n, sc); return sidx < 0 ? 0.f : win[(size_t)k * CIN + sidx] * (sc * 1024.f); }); continue; } r -= I_IN;
        if (r < I_G) { conv_plain8(WIN8 + (size_t)PW * DM, DM, (r / 96) * 64, (r % 96) * 32, scr, F.lane, wgate, 3072, 1024.f); continue; } r -= I_G;
        if (r < I_UQ) { conv_item(WUQ, 256, (r / 24) * 64, (r % 24) * 32, scr, F.lane, [&](int k, int n) { const int hh = n / 96, c = n % 96; const int o = c < 64 ? c : 64 + ((c - 64) >> 1) + 16 * ((c - 64) & 1);
                return qg[k] * wuq[(size_t)k * 768 + hh * 96 + o] * C2M; }); continue; } r -= I_UQ;
        if (r < I_UKV) { conv_item(WUKV, 256, (r / 32) * 64, (r % 32) * 32, scr, F.lane, [&](int k, int n) { return k < 128 ? kg[k] * wukv[(size_t)k * 1024 + n] : 0.f; }); continue; } r -= I_UKV;
        if (r < I_A) { conv_plain8((unsigned char*)WA, 512, (r / 32) * 64, (r % 32) * 32, scr, F.lane, wa, DM, 1024.f); continue; } r -= I_A;
        if (r < I_B) { conv_item8((unsigned char*)WB, 512, (r / 32) * 64, (r % 32) * 32, scr, F.lane, [&](int k, int n) { return k < 256 ? wb[(size_t)k * DM + n] * 1024.f : 0.f; }); continue; } r -= I_B;
        if (r < I_C) { conv_plain8((unsigned char*)WC, 512, (r / 32) * 64, (r % 32) * 32, scr, F.lane, wc, DM, 1024.f); continue; } r -= I_C;
        conv_plain8((unsigned char*)WO, DM, (r / 32) * 64, (r % 32) * 32, scr, F.lane, wo, DM, 1024.f);
    }
    if (l == 0) {
        float* rp = (float*)(F.ws + WS_ROPE); float* rm = rp + 2048 * 8 * 2;
        for (int idx = F.vcu * NTHREADS + F.tid; idx < 2048 * 24; idx += F.G * NTHREADS) {
            const int t = idx / 24, j = idx % 24; double sn, cs;
            if (j < 8) { sincos_d((double)t * inv_freq16(2 * j), sn, cs); rp[(t * 8 + j) * 2] = (float)cs; rp[(t * 8 + j) * 2 + 1] = (float)sn; }
            else { sincos_d((double)t * inv_freq16(j - 8), sn, cs); rm[(t * 16 + (j - 8)) * 2] = (float)cs; rm[(t * 16 + (j - 8)) * 2 + 1] = (float)sn; }
        }
        const f32x4* x4 = (const f32x4*)F.in[0]; unsigned* xb8 = (unsigned*)(F.ws + WS_XB8);
        for (size_t i = (size_t)F.vcu * NTHREADS + F.tid; i < (size_t)TT * DM / 4; i += (size_t)F.G * NTHREADS) { const f32x4 v = x4[i] * 16.f; xb8[i] = pk4_fp8(v.x, v.y, v.z, v.w); }
    }
}

__device__ __forceinline__ void rope4(f32x4& v0, f32x4& v1, const float* cs) {
    const f32x4 a = *(const f32x4*)cs, b = *(const f32x4*)(cs + 4);
    const f32x4 w0 = {v0[0] * a[0] - v0[1] * a[1], v0[1] * a[0] + v0[0] * a[1], v0[2] * a[2] - v0[3] * a[3], v0[3] * a[2] + v0[2] * a[3]};
    const f32x4 w1 = {v1[0] * b[0] - v1[1] * b[1], v1[1] * b[0] + v1[0] * b[1], v1[2] * b[2] - v1[3] * b[3], v1[3] * b[2] + v1[2] * b[3]};
    v0 = w0; v1 = w1;
}
__device__ __forceinline__ void store8(bf16_t* p, const f32x4& v0, const f32x4& v1) {
    u32x4 w; w.x = cvt_pk_bf16(v0[0], v0[1]); w.y = cvt_pk_bf16(v0[2], v0[3]); w.z = cvt_pk_bf16(v1[0], v1[1]); w.w = cvt_pk_bf16(v1[2], v1[3]); *(u32x4*)p = w;
}
struct EpiProj {
    bf16_t* P; const float* csp; const float* csm; float* ssq; bf16_t* G3; const LAS float* gbias;
    __device__ __forceinline__ void operator()(const f32x4 (&acc)[2][2][4][2], const pg8::Unit& u, int wr, int wc, int fr, int fq) const {
        const int pn = u.pn, row0 = u.pm * 256 + wr * 64 + fr;
        if (pn >= 16) {
#pragma unroll
            for (int bj = 0; bj < 2; ++bj) { const int col = (pn - 16) * 256 + bj * 128 + wc * 32 + fq * 8;
                const f32x4 b0 = *(const LAS f32x4*)(gbias + col), b1 = *(const LAS f32x4*)(gbias + col + 4);
#pragma unroll
                for (int ai = 0; ai < 2; ++ai)
#pragma unroll
                    for (int m = 0; m < 4; ++m) { f32x4 v0 = acc[ai][bj][m][0] + b0, v1 = acc[ai][bj][m][1] + b1;
#pragma unroll
                        for (int e = 0; e < 4; ++e) { v0[e] = sigmoidf_(v0[e]); v1[e] = sigmoidf_(v1[e]); }
                        store8_fp8((unsigned char*)G3 + (size_t)(row0 + ai * 128 + m * 16) * 3072 + col, v0, v1, 64.f); } }
            return;
        }
#pragma unroll
        for (int bj = 0; bj < 2; ++bj) {
            const int wcu = __builtin_amdgcn_readfirstlane(wc);
            bool ropeP = false, ropeM = false;
            if (pn == 1) ropeM = (bj == 1 && wcu == 0);
            else if (pn >= 2 && pn < 11) ropeP = ((pn - 2) % 3) < 2 && !(wcu & 1);
            else if (pn >= 11 && pn < 15) ropeP = !(wcu & 1);
            else if (pn == 15) ropeP = (wcu == 0);
            const int col = pn * 256 + bj * 128 + wc * 32 + fq * 8;
            if (ropeP || ropeM) {
                const bool lr = ropeM || fq < 2;
                const float* cb = ropeM ? csm + 8 * fq : csp + 8 * (fq & 1);
                const int ts = ropeM ? 32 : 16;
#pragma unroll
                for (int ai = 0; ai < 2; ++ai)
#pragma unroll
                    for (int mh = 0; mh < 2; ++mh) {
                        f32x4 ca[2], cc[2];
#pragma unroll
                        for (int mm = 0; mm < 2; ++mm) { const int t = (row0 + ai * 128 + (2 * mh + mm) * 16) & (SEQ - 1);
                            ca[mm] = *(const f32x4*)(cb + t * ts); cc[mm] = *(const f32x4*)(cb + t * ts + 4); }
#pragma unroll
                        for (int mm = 0; mm < 2; ++mm) { const int m = 2 * mh + mm, row = row0 + ai * 128 + m * 16;
                            const f32x4 v0 = acc[ai][bj][m][0], v1 = acc[ai][bj][m][1];
                            f32x4 a = ca[mm], b = cc[mm];
                            if (!lr) { a = (f32x4){1.f, 0.f, 1.f, 0.f}; b = a; }
                            const f32x4 w0 = {v0[0] * a[0] - v0[1] * a[1], v0[1] * a[0] + v0[0] * a[1], v0[2] * a[2] - v0[3] * a[3], v0[3] * a[2] + v0[2] * a[3]};
                            const f32x4 w1 = {v1[0] * b[0] - v1[1] * b[1], v1[1] * b[0] + v1[0] * b[1], v1[2] * b[2] - v1[3] * b[3], v1[3] * b[2] + v1[2] * b[3]};
                            store8(P + (size_t)row * PW + col, w0, w1); }
                    }
            } else {
#pragma unroll
                for (int ai = 0; ai < 2; ++ai)
#pragma unroll
                    for (int m = 0; m < 4; ++m)
                        store8(P + (size_t)(row0 + ai * 128 + m * 16) * PW + col, acc[ai][bj][m][0], acc[ai][bj][m][1]);
            }
        }
        if (pn < 2) {
#pragma unroll
            for (int ai = 0; ai < 2; ++ai)
#pragma unroll
                for (int m = 0; m < 4; ++m) {
                    float sq = 0.f;
#pragma unroll
                    for (int bj = 0; bj < 2; ++bj) if (pn == 0 || bj == 0) {
#pragma unroll
                        for (int n = 0; n < 2; ++n) { const f32x4 x = acc[ai][bj][m][n]; sq += (x[0] * x[0] + x[1] * x[1]) + (x[2] * x[2] + x[3] * x[3]); } }
                    sq += __shfl_xor(sq, 16); sq += __shfl_xor(sq, 32);
                    if (fq == 0) ssq[(size_t)(row0 + ai * 128 + m * 16) * 8 + pn * 4 + wc] = sq;
                }
        }
    }
};
struct EpiUpQ {
    bf16_t* Q; const float* csm; const float* ssq;
    __device__ __forceinline__ void operator()(const f32x4 (&acc)[2][2][4][2], const pg8::Unit& u, int wr, int wc, int fr, int fq) const {
        const int row0 = u.pm * 256 + wr * 64 + fr;
        f32x4 spv[2][4];
#pragma unroll
        for (int ai = 0; ai < 2; ++ai)
#pragma unroll
            for (int m = 0; m < 4; ++m) spv[ai][m] = *(const f32x4*)(ssq + (size_t)(row0 + ai * 128 + m * 16) * 8);
#pragma unroll
        for (int ai = 0; ai < 2; ++ai)
#pragma unroll
            for (int m = 0; m < 4; ++m) { const f32x4 sp = spv[ai][m];
                spv[ai][m][0] = 1.0f / sqrtf(((sp[0] + sp[1]) + (sp[2] + sp[3])) * (1.f / 256.f) + RMS_EPS); }
        const int wcu = __builtin_amdgcn_readfirstlane(wc);
#pragma unroll
        for (int bj = 0; bj < 2; ++bj) {
            const int c0 = u.pn * 256 + bj * 128 + wcu * 32, col = c0 + fq * 8;
            if (((c0 >> 5) % 3) == 2) {
#pragma unroll
                for (int ai = 0; ai < 2; ++ai)
#pragma unroll
                    for (int mh = 0; mh < 2; ++mh) {
                        f32x4 ca[2], cc[2];
#pragma unroll
                        for (int mm = 0; mm < 2; ++mm) { const int t = (row0 + ai * 128 + (2 * mh + mm) * 16) & (SEQ - 1);
                            ca[mm] = *(const f32x4*)(csm + t * 32 + 8 * fq); cc[mm] = *(const f32x4*)(csm + t * 32 + 8 * fq + 4); }
#pragma unroll
                        for (int mm = 0; mm < 2; ++mm) { const int m = 2 * mh + mm, row = row0 + ai * 128 + m * 16;
                            const float rs = spv[ai][m][0];
                            const f32x4 v0 = acc[ai][bj][m][0] * rs, v1 = acc[ai][bj][m][1] * rs, a = ca[mm], b = cc[mm];
                            const f32x4 w0 = {v0[0] * a[0] - v0[1] * a[1], v0[1] * a[0] + v0[0] * a[1], v0[2] * a[2] - v0[3] * a[3], v0[3] * a[2] + v0[2] * a[3]};
                            const f32x4 w1 = {v1[0] * b[0] - v1[1] * b[1], v1[1] * b[0] + v1[0] * b[1], v1[2] * b[2] - v1[3] * b[3], v1[3] * b[2] + v1[2] * b[3]};
                            store8(Q + (size_t)row * 768 + col, w0, w1); }
                    }
            } else {
#pragma unroll
                for (int ai = 0; ai < 2; ++ai)
#pragma unroll
                    for (int m = 0; m < 4; ++m) { const float rs = spv[ai][m][0];
                        store8(Q + (size_t)(row0 + ai * 128 + m * 16) * 768 + col, acc[ai][bj][m][0] * rs, acc[ai][bj][m][1] * rs); }
            }
        }
    }
};
struct EpiUpKV {
    bf16_t* KV; const float* ssq;
    __device__ __forceinline__ void operator()(const f32x4 (&acc)[2][2][4][2], const pg8::Unit& u, int wr, int wc, int fr, int fq) const {
        const int row0 = u.pm * 256 + wr * 64 + fr;
        f32x4 spv[2][4];
#pragma unroll
        for (int ai = 0; ai < 2; ++ai)
#pragma unroll
            for (int m = 0; m < 4; ++m) spv[ai][m] = *(const f32x4*)(ssq + (size_t)(row0 + ai * 128 + m * 16) * 8 + 4);
#pragma unroll
        for (int ai = 0; ai < 2; ++ai)
#pragma unroll
            for (int m = 0; m < 4; ++m) {
                const int row = row0 + ai * 128 + m * 16;
                const f32x4 sp = spv[ai][m];
                const float rs = 1.0f / sqrtf(((sp[0] + sp[1]) + (sp[2] + sp[3])) * (1.f / 128.f) + RMS_EPS);
#pragma unroll
                for (int bj = 0; bj < 2; ++bj) { const int col = u.pn * 256 + bj * 128 + wc * 32 + fq * 8;
                    store8(KV + (size_t)row * 1024 + col, acc[ai][bj][m][0] * rs, acc[ai][bj][m][1] * rs); }
            }
    }
};
struct EpiBranchAll {
    bf16_t* Mg; bf16_t* M0; bf16_t* M1; const bf16_t* G3;
    __device__ __forceinline__ void operator()(const f32x4 (&acc)[2][2][4][2], const pg8::Unit& u, int wr, int wc, int fr, int fq) const {
        const int row0 = u.pm * 256 + wr * 64 + fr, br = u.ord, col0 = u.pn * 256 + wc * 32 + fq * 8;
        bf16_t* dst = br == 0 ? M0 : (br == 1 ? M1 : Mg);
#pragma unroll
        for (int ai = 0; ai < 2; ++ai)
#pragma unroll
            for (int mh = 0; mh < 2; ++mh) {
                u32x2 gw[2][2]; u32x4 ma[2][2], mb[2][2];
#pragma unroll
                for (int mm = 0; mm < 2; ++mm)
#pragma unroll
                    for (int bj = 0; bj < 2; ++bj) { const int row = row0 + ai * 128 + (2 * mh + mm) * 16, col = col0 + bj * 128;
                        gw[mm][bj] = *(const u32x2*)((const unsigned char*)G3 + (size_t)row * 3072 + br * 1024 + col);
                        ma[mm][bj] = (u32x4){0u, 0u, 0u, 0u}; mb[mm][bj] = (u32x4){0u, 0u, 0u, 0u}; }
                if (br == 2) {
#pragma unroll
                    for (int mm = 0; mm < 2; ++mm)
#pragma unroll
                        for (int bj = 0; bj < 2; ++bj) { const size_t off = (size_t)(row0 + ai * 128 + (2 * mh + mm) * 16) * DM + col0 + bj * 128;
                            const u32x2 p = *(const u32x2*)((const unsigned char*)M0 + off), q = *(const u32x2*)((const unsigned char*)M1 + off);
                            ma[mm][bj] = (u32x4){p.x, p.y, 0u, 0u}; mb[mm][bj] = (u32x4){q.x, q.y, 0u, 0u}; }
                }
#pragma unroll
                for (int mm = 0; mm < 2; ++mm)
#pragma unroll
                    for (int bj = 0; bj < 2; ++bj) { const int m = 2 * mh + mm; const size_t off = (size_t)(row0 + ai * 128 + m * 16) * DM + col0 + bj * 128; const u32x2 g = gw[mm][bj]; const u32x4 a = ma[mm][bj], b2 = mb[mm][bj];
                        const f32x2 g01 = __builtin_amdgcn_cvt_pk_f32_fp8((int)g.x, false) * (1.f / 64.f), g23 = __builtin_amdgcn_cvt_pk_f32_fp8((int)g.x, true) * (1.f / 64.f);
                        const f32x2 g45 = __builtin_amdgcn_cvt_pk_f32_fp8((int)g.y, false) * (1.f / 64.f), g67 = __builtin_amdgcn_cvt_pk_f32_fp8((int)g.y, true) * (1.f / 64.f);
                        f32x4 v0 = acc[ai][bj][m][0], v1 = acc[ai][bj][m][1];
                        const f32x2 s01 = (__builtin_amdgcn_cvt_pk_f32_fp8((int)a.x, false) + __builtin_amdgcn_cvt_pk_f32_fp8((int)b2.x, false)) * (1.f / 64.f), s23 = (__builtin_amdgcn_cvt_pk_f32_fp8((int)a.x, true) + __builtin_amdgcn_cvt_pk_f32_fp8((int)b2.x, true)) * (1.f / 64.f);
                        const f32x2 s45 = (__builtin_amdgcn_cvt_pk_f32_fp8((int)a.y, false) + __builtin_amdgcn_cvt_pk_f32_fp8((int)b2.y, false)) * (1.f / 64.f), s67 = (__builtin_amdgcn_cvt_pk_f32_fp8((int)a.y, true) + __builtin_amdgcn_cvt_pk_f32_fp8((int)b2.y, true)) * (1.f / 64.f);
                        v0[0] = v0[0] * g01[0] + s01[0]; v0[1] = v0[1] * g01[1] + s01[1]; v0[2] = v0[2] * g23[0] + s23[0]; v0[3] = v0[3] * g23[1] + s23[1];
                        v1[0] = v1[0] * g45[0] + s45[0]; v1[1] = v1[1] * g45[1] + s45[1]; v1[2] = v1[2] * g67[0] + s67[0]; v1[3] = v1[3] * g67[1] + s67[1];
                        store8_fp8((unsigned char*)dst + off, v0, v1, 64.f); }
            }
    }
};
struct BranchSched {
    static constexpr bool GATHER = false; static constexpr bool VARK = true;
    const char* A0; const char* B0; size_t sA, sB; int lda, ldb, c, sw8, sa8, G, ntile;
    __device__ __forceinline__ int ktiles(const pg8::Unit& u) const { return u.ord == 1 ? 2 : 4; }
    __device__ __forceinline__ bool next(int i, pg8::Unit& u) const { const int t = c + (i / 3) * G; if (t >= ntile) return false; u.pm = t >> 2; u.pn = t & 3; u.ord = i % 3; return true; }
    __device__ __forceinline__ const char* a_base(const pg8::Unit& u) const { return A0 + (size_t)u.ord * sA + (size_t)u.pm * 256 * lda * 2; }
    __device__ __forceinline__ const char* b_base(const pg8::Unit& u) const { return B0 + (size_t)u.ord * sB + (size_t)u.pn * 256 * ldb * 2; }
    __device__ __forceinline__ void a_off(const pg8::Unit&, const int (&R)[2], const int (&C)[2], unsigned (&v)[2][2]) const {
#pragma unroll
        for (int i = 0; i < 2; ++i) { v[0][i] = (unsigned)(R[i] * lda + C[i]) * 2u; v[1][i] = (unsigned)((128 + R[i]) * lda + C[i]) * 2u; }
    }
};
struct EpiWo {
    float* out; const float* xsrc; int rowbase;
    __device__ __forceinline__ void operator()(const f32x4 (&acc)[2][2][4][2], const pg8::Unit& u, int wr, int wc, int fr, int fq) const {
        const int row0 = rowbase + u.pm * 256 + wr * 64 + fr, col0 = u.pn * 256 + wc * 32 + fq * 8;
#pragma unroll
        for (int ai = 0; ai < 2; ++ai)
#pragma unroll
            for (int mh = 0; mh < 2; ++mh) {
                f32x4 x[2][2][2];
#pragma unroll
                for (int mm = 0; mm < 2; ++mm)
#pragma unroll
                    for (int bj = 0; bj < 2; ++bj) { const size_t off = (size_t)(row0 + ai * 128 + (2 * mh + mm) * 16) * DM + col0 + bj * 128;
                        x[mm][bj][0] = *(const f32x4*)(xsrc + off); x[mm][bj][1] = *(const f32x4*)(xsrc + off + 4); }
#pragma unroll
                for (int mm = 0; mm < 2; ++mm)
#pragma unroll
                    for (int bj = 0; bj < 2; ++bj) { const size_t off = (size_t)(row0 + ai * 128 + (2 * mh + mm) * 16) * DM + col0 + bj * 128;
                        *(f32x4*)(out + off) = x[mm][bj][0] * ALPHA + acc[ai][bj][2 * mh + mm][0]; *(f32x4*)(out + off + 4) = x[mm][bj][1] * ALPHA + acc[ai][bj][2 * mh + mm][1]; }
            }
    }
};

__device__ __forceinline__ int dequeue(Frame& F, unsigned* ctr, int& pre) {
    LAS int* slot = (LAS int*)(F.lds + L_QSLOT);
    __syncthreads();
    if (F.tid == 0) {
        *slot = (int)__hip_atomic_fetch_add(ctr, 1u, __ATOMIC_RELAXED, __HIP_MEMORY_SCOPE_AGENT); (void)pre;
    }
    __syncthreads();
    return *slot;
}

namespace att {
constexpr int KSLOT = 12288, VSLOT = 8192, NSLOT = 4;
constexpr int A_K = 0, A_V = NSLOT * KSLOT, A_WS = A_V + NSLOT * VSLOT, A_OST = A_WS + 8 * 256, A_MW = A_OST + 8 * 4096, A_END = A_MW + 8 * NSLOT * 256;
static_assert(A_END <= RING_BYTES, "attention LDS");
typedef short s16x4 __attribute__((ext_vector_type(4)));
__device__ __forceinline__ int crow(int r, int hi) { return (r & 3) + 8 * (r >> 2) + 4 * hi; }
__device__ __forceinline__ void glds16(const void* gsrc, unsigned lds_dst) { unsigned keep;
    asm volatile("s_mov_b32 %0, m0\n\ts_mov_b32 m0, %2\n\ts_nop 0\n\tglobal_load_lds_dwordx4 %1, off\n\ts_mov_b32 m0, %0" : "=&s"(keep) : "v"(gsrc), "s"(lds_dst) : "memory"); }
__device__ __forceinline__ void glds4(const void* gsrc, unsigned lds_dst) { unsigned keep;
    asm volatile("s_mov_b32 %0, m0\n\ts_mov_b32 m0, %2\n\ts_nop 0\n\tglobal_load_lds_dword %1, off\n\ts_mov_b32 m0, %0" : "=&s"(keep) : "v"(gsrc), "s"(lds_dst) : "memory"); }
#define ATT_WAIT_BAR(N) asm volatile("s_waitcnt vmcnt(" #N ") lgkmcnt(0)\n\ts_barrier" ::: "memory")
__device__ __forceinline__ float emax(float a, float b) { return __builtin_elementwise_maximum(a, b); }
__device__ __forceinline__ float halfmax(float m) { auto rr = __builtin_amdgcn_permlane32_swap(__float_as_uint(m), __float_as_uint(m), false, false); return emax(__uint_as_float(rr[0]), __uint_as_float(rr[1])); }
__device__ __forceinline__ float halfsum(float m) { auto rr = __builtin_amdgcn_permlane32_swap(__float_as_uint(m), __float_as_uint(m), false, false); return __uint_as_float(rr[0]) + __uint_as_float(rr[1]); }
typedef short v4i16_t __attribute__((ext_vector_type(4)));
__device__ __forceinline__ s16x4 vtr(const LAS unsigned char* p) { return __builtin_bit_cast(s16x4, __builtin_amdgcn_ds_read_tr16_b64_v4i16((LAS v4i16_t*)p)); }
__device__ __forceinline__ void pv(f32x16* o, f32x16& lacc, const LAS unsigned char* vp, bf16x8 pa0, bf16x8 pa1, bf16x8 pa2, bf16x8 pa3) {
    { const u32x4 one4 = {0x3F803F80u, 0x3F803F80u, 0x3F803F80u, 0x3F803F80u}; const bf16x8 ones = __builtin_bit_cast(bf16x8, one4);
      lacc = __builtin_amdgcn_mfma_f32_32x32x16_bf16(pa0, ones, lacc, 0, 0, 0); lacc = __builtin_amdgcn_mfma_f32_32x32x16_bf16(pa1, ones, lacc, 0, 0, 0);
      lacc = __builtin_amdgcn_mfma_f32_32x32x16_bf16(pa2, ones, lacc, 0, 0, 0); lacc = __builtin_amdgcn_mfma_f32_32x32x16_bf16(pa3, ones, lacc, 0, 0, 0); }
#pragma unroll
    for (int d0 = 0; d0 < 2; ++d0) { s16x4 lo[4], hi[4];
#pragma unroll
        for (int ks = 0; ks < 4; ++ks) { lo[ks] = vtr(vp + d0 * 4096 + ks * 1024); hi[ks] = vtr(vp + d0 * 4096 + ks * 1024 + 512); }
#define ATT_PK(k) (bf16x8){lo[k][0], lo[k][1], lo[k][2], lo[k][3], hi[k][0], hi[k][1], hi[k][2], hi[k][3]}
        o[d0] = __builtin_amdgcn_mfma_f32_32x32x16_bf16(pa0, ATT_PK(0), o[d0], 0, 0, 0);
        o[d0] = __builtin_amdgcn_mfma_f32_32x32x16_bf16(pa1, ATT_PK(1), o[d0], 0, 0, 0);
        o[d0] = __builtin_amdgcn_mfma_f32_32x32x16_bf16(pa2, ATT_PK(2), o[d0], 0, 0, 0);
        o[d0] = __builtin_amdgcn_mfma_f32_32x32x16_bf16(pa3, ATT_PK(3), o[d0], 0, 0, 0);
#undef ATT_PK
    }
}
struct Desc {
    const bf16_t* Q; const bf16_t* K1; const bf16_t* K2; const bf16_t* V; bf16_t* O; float* lse; const unsigned* mask;
    int qpitch, k1pitch, k2pitch, vpitch, opitch, lsepitch;
    int rstride, q0, nq, jlo, jhi;
    int o8;
};
template <int DQK, int MODE>
__device__ __forceinline__ void attn_unit(LAS unsigned char* lds, const Desc& d) {
    int tid_ = threadIdx.x; asm volatile("" : "+v"(tid_));
    const int tid = tid_, lane = tid & 63, r32 = lane & 31, hi = lane >> 5, wid = __builtin_amdgcn_readfirstlane(tid >> 6);
    constexpr int ND = DQK / 16;
    const unsigned lds0 = (unsigned)(size_t)lds;
    LAS float* wsf = (LAS float*)(lds + A_WS) + wid * 64;
    const int qw = d.q0 + wid * 32;
    const bool wvalid = wid * 32 < d.nq;
    const int kkey = 8 * wid + (lane >> 3), kch = (lane & 7) ^ ((kkey >> 1) & 7);
    const bf16_t* ksrc = d.K1 + (size_t)kkey * d.rstride * d.k1pitch + kch * 8;
    const int k2key = 16 * (wid & 3) + (lane >> 2), k2ch = (lane & 3) ^ ((k2key >> 2) & 3);
    const bf16_t* k2src = (DQK == 96) ? d.K2 + (size_t)k2key * d.rstride * d.k2pitch + k2ch * 8 : nullptr;
    int kofs[ND];
#pragma unroll
    for (int d0 = 0; d0 < ND; ++d0) kofs[d0] = d0 < 4 ? r32 * 128 + (((2 * d0 + hi) ^ ((r32 >> 1) & 7)) * 16) : 8192 + r32 * 64 + (((2 * (d0 - 4) + hi) ^ ((r32 >> 2) & 3)) * 16);
    const bf16_t* vsrc = d.V + (size_t)(16 * (wid & 3) + (lane >> 2)) * d.rstride * d.vpitch + (wid >> 2) * 32 + (lane & 3) * 8;
    const size_t kstep = (size_t)64 * d.rstride * d.k1pitch, k2step = (size_t)64 * d.rstride * d.k2pitch, vstep = (size_t)64 * d.rstride * d.vpitch;
    const bool two = (DQK == 96) && wid < 4;
    const unsigned* msrc = (MODE == 2) ? d.mask + (size_t)(wvalid ? (qw + (lane >> 1)) : d.q0) * 64 + (lane & 1) : nullptr;
#define ATT_ISSUE(j) do { const int sl_ = (j) % NSLOT; \
        glds16(ksrc + (size_t)(j) * kstep, (unsigned)__builtin_amdgcn_readfirstlane(lds0 + A_K + sl_ * KSLOT + wid * 1024)); \
        if (two) glds16(k2src + (size_t)(j) * k2step, (unsigned)__builtin_amdgcn_readfirstlane(lds0 + A_K + sl_ * KSLOT + (8 + wid) * 1024)); \
        glds16(vsrc + (size_t)(j) * vstep, (unsigned)__builtin_amdgcn_readfirstlane(lds0 + A_V + sl_ * VSLOT + wid * 1024)); \
        if (MODE == 2) glds4(msrc + 2 * (j), (unsigned)__builtin_amdgcn_readfirstlane(lds0 + A_MW + (wid * NSLOT + sl_) * 256)); } while (0)
    ATT_ISSUE(d.jlo);
    if (d.jlo + 1 < d.jhi) ATT_ISSUE(d.jlo + 1);
    bf16x8 qr[ND];
    { const int qi = wvalid ? (qw + r32) : d.q0; const bf16_t* qp = d.Q + (size_t)qi * d.rstride * d.qpitch + hi * 8;
#pragma unroll
      for (int d0 = 0; d0 < ND; ++d0) qr[d0] = *(const bf16x8*)(qp + d0 * 16); }
#pragma unroll
    for (int d0 = 0; d0 < ND; ++d0) asm volatile("" : "+v"(qr[d0]));
    float mhat = 0.f; f32x16 o[2]; o[0] = f32x16{}; o[1] = f32x16{}; f32x16 lacc = f32x16{};
    bool started = false;
    const LAS unsigned char* vp0 = lds + A_V + ((lane >> 4) & 1) * 32 + (lane & 3) * 8 + (4 * hi + ((lane & 15) >> 2)) * 64;
    const int qi = qw + r32;
    f32x16 p0 = f32x16{}, p1 = f32x16{};
    f32x16 negm = f32x16{};
#define ATT_REL(j) (wvalid && (64 * (j) <= qw + 31) && (MODE != 1 || (64 * (j) + 63 >= qw - 128)))
#define ATT_QK(j) do { const int sl_ = (j) % NSLOT; \
        const LAS unsigned char* kb = lds + A_K + sl_ * KSLOT; bf16x8 kf[2 * ND]; \
        _Pragma("unroll") for (int d0 = 0; d0 < ND; ++d0) { kf[2 * d0] = *(const LAS bf16x8*)(kb + kofs[d0]); kf[2 * d0 + 1] = *(const LAS bf16x8*)(kb + kofs[d0] + (d0 < 4 ? 4096 : 2048)); } \
        __builtin_amdgcn_sched_barrier(0); \
        _Pragma("unroll") for (int d0 = 0; d0 < ND; ++d0) { \
            if (d0 == 0) { p0 = __builtin_amdgcn_mfma_f32_32x32x16_bf16(kf[0], qr[0], negm, 0, 0, 0); p1 = __builtin_amdgcn_mfma_f32_32x32x16_bf16(kf[1], qr[0], negm, 0, 0, 0); } \
            else { p0 = __builtin_amdgcn_mfma_f32_32x32x16_bf16(kf[2 * d0], qr[d0], p0, 0, 0, 0); p1 = __builtin_amdgcn_mfma_f32_32x32x16_bf16(kf[2 * d0 + 1], qr[d0], p1, 0, 0, 0); } } } while (0)
#define ATT_SMPV(j) do { const int sl_ = (j) % NSLOT; \
        { bool domask = true; unsigned mx_ = 0u, my_ = 0u;        \
          if (MODE == 2) { const u32x2 mw = *(const LAS u32x2*)(lds + A_MW + (wid * NSLOT + sl_) * 256 + r32 * 8); mx_ = mw.x; my_ = mw.y; } \
          else { \
            bool full = (64 * (j) + 63 <= qw); \
            if (MODE == 1) full = full && (64 * (j) >= qw + 31 - 128); \
            domask = !full; \
            if (domask) { const int a_ = qi - 64 * (j), lo_ = (MODE == 1) ? a_ - 128 : -4096;        \
                { const int h_ = a_ < 31 ? a_ : 31, l_ = lo_ > 0 ? lo_ : 0; mx_ = (h_ < l_) ? 0u : ((0xFFFFFFFFu >> (31 - h_)) & (0xFFFFFFFFu << l_)); } \
                { const int h_ = a_ - 32 < 31 ? a_ - 32 : 31, l_ = lo_ - 32 > 0 ? lo_ - 32 : 0; my_ = (h_ < l_) ? 0u : ((0xFFFFFFFFu >> (31 - h_)) & (0xFFFFFFFFu << l_)); } } \
          } \
          if (domask) { const unsigned w0 = mx_ >> (4 * hi), w1 = my_ >> (4 * hi); \
            _Pragma("unroll") for (int r = 0; r < 16; ++r) { const int bit = (r & 3) + 8 * (r >> 2); \
                const unsigned m0 = (unsigned)__builtin_amdgcn_sbfe((int)w0, bit, 1), m1 = (unsigned)__builtin_amdgcn_sbfe((int)w1, bit, 1);        \
                p0[r] = __uint_as_float((m0 & __float_as_uint(p0[r])) | (~m0 & 0xFF800000u)); p1[r] = __uint_as_float((m1 & __float_as_uint(p1[r])) | (~m1 & 0xFF800000u)); } } } \
        float rm = emax(p0[0], p1[0]), rm2 = emax(p0[1], p1[1]); \
        _Pragma("unroll") for (int r = 2; r < 16; r += 2) { rm = emax(emax(rm, p0[r]), p1[r]); rm2 = emax(emax(rm2, p0[r + 1]), p1[r + 1]); } \
        rm = halfmax(emax(rm, rm2)); \
        bool need; float dl; \
        if (!started) { need = true; dl = emax(rm, -200.f); } else { need = __any(rm > 8.f) != 0; dl = emax(rm, 0.f); } \
        if (need) { mhat += dl; \
            _Pragma("unroll") for (int r = 0; r < 16; ++r) negm[r] = -mhat; \
            _Pragma("unroll") for (int r = 0; r < 16; ++r) { p0[r] -= dl; p1[r] -= dl; } \
            if (started) { const float f = __builtin_amdgcn_exp2f(-dl); \
                if (hi == 0) wsf[r32] = f; \
                LDS_WAIT(); \
                _Pragma("unroll") for (int r = 0; r < 16; ++r) { const float fr_ = wsf[crow(r, hi)]; o[0][r] *= fr_; o[1][r] *= fr_; lacc[r] *= fr_; } } } \
        started = true; \
        __builtin_amdgcn_s_setprio(1);        \
        _Pragma("unroll") for (int r = 0; r < 16; ++r) { p0[r] = __builtin_amdgcn_exp2f(p0[r]); p1[r] = __builtin_amdgcn_exp2f(p1[r]); } \
        const u32x4 pw0 = (u32x4){cvt_pk_bf16(p0[0], p0[1]), cvt_pk_bf16(p0[2], p0[3]), cvt_pk_bf16(p0[4], p0[5]), cvt_pk_bf16(p0[6], p0[7])}; \
        const u32x4 pw1 = (u32x4){cvt_pk_bf16(p0[8], p0[9]), cvt_pk_bf16(p0[10], p0[11]), cvt_pk_bf16(p0[12], p0[13]), cvt_pk_bf16(p0[14], p0[15])}; \
        const u32x4 pw2 = (u32x4){cvt_pk_bf16(p1[0], p1[1]), cvt_pk_bf16(p1[2], p1[3]), cvt_pk_bf16(p1[4], p1[5]), cvt_pk_bf16(p1[6], p1[7])}; \
        const u32x4 pw3 = (u32x4){cvt_pk_bf16(p1[8], p1[9]), cvt_pk_bf16(p1[10], p1[11]), cvt_pk_bf16(p1[12], p1[13]), cvt_pk_bf16(p1[14], p1[15])}; \
        pv(o, lacc, vp0 + sl_ * VSLOT, __builtin_bit_cast(bf16x8, pw0), __builtin_bit_cast(bf16x8, pw1), __builtin_bit_cast(bf16x8, pw2), __builtin_bit_cast(bf16x8, pw3)); \
        __builtin_amdgcn_s_setprio(0); } while (0)
#define ATT_TOPWAIT(j) do { if ((j) + 1 < d.jhi) { if (MODE == 2 || two) { ATT_WAIT_BAR(3); } else { ATT_WAIT_BAR(2); } } else { ATT_WAIT_BAR(0); } } while (0)
    if (wid < 4) {
        for (int j = d.jlo; j < d.jhi; ++j) {
            ATT_TOPWAIT(j);
            if (j + 2 < d.jhi) ATT_ISSUE(j + 2);
            if (ATT_REL(j)) { ATT_QK(j); ATT_SMPV(j); }
        }
        asm volatile("s_waitcnt lgkmcnt(0)\n\ts_barrier" ::: "memory");
    } else {
        ATT_TOPWAIT(d.jlo);
        if (d.jlo + 2 < d.jhi) ATT_ISSUE(d.jlo + 2);
        if (ATT_REL(d.jlo)) ATT_QK(d.jlo);
        for (int j = d.jlo + 1; j < d.jhi; ++j) {
            ATT_TOPWAIT(j);
            if (j + 2 < d.jhi) ATT_ISSUE(j + 2);
            if (ATT_REL(j - 1)) ATT_SMPV(j - 1);
            if (ATT_REL(j)) ATT_QK(j);
        }
        asm volatile("s_waitcnt lgkmcnt(0)\n\ts_barrier" ::: "memory");
        if (ATT_REL(d.jhi - 1)) ATT_SMPV(d.jhi - 1);
    }
#undef ATT_REL
#undef ATT_QK
#undef ATT_SMPV
#undef ATT_TOPWAIT
#undef ATT_ISSUE
    if (wvalid) {
        LAS bf16_t* stg = (LAS bf16_t*)(lds + A_OST) + wid * 2048;
        if (d.lse != nullptr && r32 == 0) {
#pragma unroll
            for (int r = 0; r < 16; ++r) wsf[32 + crow(r, hi)] = lacc[r]; }
        if (d.o8) {
            LAS unsigned char* stg8 = (LAS unsigned char*)stg;
#pragma unroll
            for (int r = 0; r < 16; ++r) { const int orow = crow(r, hi); const float rl = __builtin_amdgcn_rcpf(lacc[r]) * 32.f;
                const unsigned p = (unsigned)__builtin_amdgcn_cvt_pk_fp8_f32(o[0][r] * rl, o[1][r] * rl, 0, false);
                stg8[orow * 64 + r32] = (unsigned char)(p & 0xffu); stg8[orow * 64 + 32 + r32] = (unsigned char)((p >> 8) & 0xffu); }
            LDS_WAIT();
#pragma unroll
            for (int i = 0; i < 2; ++i) { const int row = i * 16 + (lane >> 2), ch = lane & 3; const u32x4 v = *(const LAS u32x4*)(stg8 + row * 64 + ch * 16);
                *(u32x4*)((unsigned char*)d.O + (size_t)(qw + row) * d.rstride * d.opitch + ch * 16) = v; }
        } else {
#pragma unroll
        for (int r = 0; r < 16; ++r) { const int orow = crow(r, hi); const float rl = __builtin_amdgcn_rcpf(lacc[r]);
            stg[orow * 64 + r32] = (bf16_t)f2bf(o[0][r] * rl); stg[orow * 64 + 32 + r32] = (bf16_t)f2bf(o[1][r] * rl); }
        LDS_WAIT();
#pragma unroll
        for (int i = 0; i < 4; ++i) { const int row = i * 8 + (lane >> 3), ch = lane & 7; const u32x4 v = *(const LAS u32x4*)(stg + row * 64 + ch * 8);
            *(u32x4*)(d.O + (size_t)(qw + row) * d.rstride * d.opitch + ch * 8) = v; }
        }
        if (d.lse != nullptr && hi == 0) d.lse[(size_t)(qw + r32) * d.rstride * d.lsepitch] = mhat + __builtin_amdgcn_logf(wsf[32 + r32]);
    }
    asm volatile("s_waitcnt lgkmcnt(0)\n\ts_barrier" ::: "memory");
}
}

namespace idx {
constexpr int KS = 8192, I_K = 0, I_ST = 3 * KS, I_END = I_ST + 8 * 8192;
static_assert(I_END <= RING_BYTES, "indexer LDS");
__device__ __forceinline__ void score_unit(LAS unsigned char* lds, const bf16_t* PROJ, float* SC, int b, int qh  , int jg) {
    int tid_ = threadIdx.x; asm volatile("" : "+v"(tid_));
    const int tid = tid_, lane = tid & 63, r32 = lane & 31, hi = lane >> 5, wid = __builtin_amdgcn_readfirstlane(tid >> 6);
    const int qg = wid >> 1, hh = wid & 1;
    const unsigned lds0 = (unsigned)(size_t)lds;
    const int qrow = b * SEQ + qh * 128 + qg * 32 + r32;
    const bf16_t* kbase = PROJ + (size_t)(b * SEQ) * PW + 3968;
    const int kkey = 8 * wid + (lane >> 3);
    const bf16_t* ksrc = kbase + (size_t)kkey * PW + ((lane & 7) ^ ((kkey >> 1) & 7)) * 8;
    const int j0 = 4 * jg;
#define IDX_ISSUE(j) att::glds16(ksrc + (size_t)(j) * 64 * PW, (unsigned)__builtin_amdgcn_readfirstlane(lds0 + I_K + ((j) % 3) * KS + wid * 1024))
    IDX_ISSUE(j0); IDX_ISSUE(j0 + 1);
    bf16x8 qf[4][4]; float wv[4];
    { const bf16_t* qp = PROJ + (size_t)qrow * PW + 3328 + hh * 256 + hi * 8;
#pragma unroll
      for (int h = 0; h < 4; ++h)
#pragma unroll
          for (int d0 = 0; d0 < 4; ++d0) qf[h][d0] = *(const bf16x8*)(qp + h * 64 + d0 * 16);
      const u32x2 ww = *(const u32x2*)(PROJ + (size_t)qrow * PW + 4032 + hh * 4);
      wv[0] = bflo(ww.x); wv[1] = bfhi(ww.x); wv[2] = bflo(ww.y); wv[3] = bfhi(ww.y); }
#pragma unroll
    for (int h = 0; h < 4; ++h) { asm volatile("" : "+v"(wv[h]));
#pragma unroll
        for (int d0 = 0; d0 < 4; ++d0) asm volatile("" : "+v"(qf[h][d0])); }
    const int qb = qh >> 1;
    unsigned* blk = (unsigned*)SC + ((size_t)b * 36 + (size_t)(qb * (qb + 1) / 2)) * 32768; const int pitch = 128 * (qb + 1);
    f32x4 ve[4] = {};
    LAS unsigned char* stg = lds + I_ST + wid * 8192;
    const LAS unsigned char* stg2 = lds + I_ST + (wid ^ 1) * 8192;
#pragma nounroll
    for (int jj = 0; jj < 4; ++jj) { const int j = j0 + jj;
        if (jj < 2) { ATT_WAIT_BAR(1); } else if (jj == 2) { ATT_WAIT_BAR(5); } else { ATT_WAIT_BAR(4); }
        if (jj + 2 < 4) IDX_ISSUE(j + 2);
        const LAS unsigned char* kb = lds + I_K + (j % 3) * KS + r32 * 128;
#pragma nounroll
        for (int half = 0; half < 2; ++half) {
            bf16x8 kf[4];
#pragma unroll
            for (int d0 = 0; d0 < 4; ++d0) kf[d0] = *(const LAS bf16x8*)(kb + half * 4096 + (((2 * d0 + hi) ^ ((r32 >> 1) & 7)) * 16));
            f32x16 t0 = f32x16{};
#pragma unroll
            for (int h = 0; h < 4; ++h) {
                f32x16 p0 = f32x16{};
#pragma unroll
                for (int d0 = 0; d0 < 4; ++d0) p0 = __builtin_amdgcn_mfma_f32_32x32x16_bf16(kf[d0], qf[h][d0], p0, 0, 0, 0);
#pragma unroll
                for (int r = 0; r < 16; ++r) t0[r] += wv[h] * att::emax(p0[r], 0.f);
            }
#pragma unroll
            for (int g = 0; g < 4; ++g) { const int c0 = 8 * half + 2 * g + hi;
                *(LAS f32x4*)(stg + r32 * 256 + ((c0 ^ (r32 & 15)) * 16)) = (f32x4){t0[4 * g], t0[4 * g + 1], t0[4 * g + 2], t0[4 * g + 3]}; }
        }
        asm volatile("s_waitcnt lgkmcnt(0)\n\ts_barrier" ::: "memory");
#pragma unroll
        for (int i = 0; i < 4; ++i) { const int q = hh * 16 + i * 4 + (lane >> 4), c = lane & 15; const int so = q * 256 + ((c ^ (q & 15)) * 16);
            const f32x4 v = *(const LAS f32x4*)(stg + so) + *(const LAS f32x4*)(stg2 + so);
            if (jj & 1) { const f32x4 e = ve[i]; const u32x4 w = {pk2(e[0], v[0]), pk2(e[1], v[1]), pk2(e[2], v[2]), pk2(e[3], v[3])};
                *(u32x4*)(blk + (size_t)((qh & 1) * 128 + qg * 32 + q) * pitch + 64 * (j >> 1) + 4 * c) = w; }
            else ve[i] = v; }
        LDS_WAIT();
    }
#undef IDX_ISSUE
    asm volatile("s_waitcnt lgkmcnt(0)\n\ts_barrier" ::: "memory");
}

__device__ __forceinline__ int wave_sum_i(int v) {
    v += __builtin_amdgcn_update_dpp(0, v, 0xB1, 0xF, 0xF, true);
    v += __builtin_amdgcn_update_dpp(0, v, 0x4E, 0xF, 0xF, true);
    v += __builtin_amdgcn_update_dpp(0, v, 0x141, 0xF, 0xF, true);
    v += __builtin_amdgcn_update_dpp(0, v, 0x140, 0xF, 0xF, true);
    return __builtin_amdgcn_readlane(v, 0) + __builtin_amdgcn_readlane(v, 16) + __builtin_amdgcn_readlane(v, 32) + __builtin_amdgcn_readlane(v, 48);
}
__device__ __forceinline__ unsigned long long keep_low(unsigned long long m, int k) { while (__builtin_popcountll(m) > k) m &= ~(1ull << (63 - __builtin_clzll(m))); return m; }
__device__ __forceinline__ void select_rows4(const float* SC, unsigned* MASK, int row0  , int lane, LAS unsigned* slot  ) {
    const int b = row0 / SEQ, t0 = row0 % SEQ, qb = t0 >> 8;
    if (t0 < 256) {
#pragma unroll 1
        for (int i = 0; i < 4; ++i) { const int t = t0 + i, lo = 64 * lane;
            const unsigned long long w = (lo + 63 <= t) ? ~0ull : (lo > t ? 0ull : ((2ull << (t - lo)) - 1ull));
            if (lane < 32) ((unsigned long long*)(MASK + (size_t)(row0 + i) * 64))[lane] = w; }
        return;
    }
    const int pitch = 128 * (qb + 1), pmax = pitch - 1;
    const unsigned* srow0 = (const unsigned*)SC + ((size_t)b * 36 + (size_t)(qb * (qb + 1) / 2)) * 32768 + (size_t)(t0 - 256 * qb) * pitch;
    unsigned raw[16];
#pragma unroll
    for (int i = 0; i < 16; ++i) { const int s_ = 64 * i + lane; raw[i] = srow0[s_ < pmax ? s_ : pmax]; }
#pragma unroll 1
    for (int r = 0; r < 4; ++r) {
        const int t = t0 + r;
        unsigned P[16];
#pragma unroll
        for (int i = 0; i < 16; ++i) P[i] = raw[i];
        { const unsigned* nx = srow0 + (size_t)(r < 3 ? r + 1 : 3) * pitch;
#pragma unroll
          for (int i = 0; i < 16; ++i) { const int s_ = 64 * i + lane; raw[i] = nx[s_ < pmax ? s_ : pmax]; } }
#define SEL_TSTAGE(sh, m) _Pragma("unroll") for (int q = 0; q < 16; ++q) if (!(q & (sh))) { const unsigned a_ = P[q], b_ = P[q + (sh)]; \
            P[q] = (a_ & (m)) | ((b_ << (sh)) & ~(m)); P[q + (sh)] = ((a_ >> (sh)) & (m)) | (b_ & ~(m)); }
        SEL_TSTAGE(8, 0x00FF00FFu) SEL_TSTAGE(4, 0x0F0F0F0Fu) SEL_TSTAGE(2, 0x33333333u) SEL_TSTAGE(1, 0x55555555u)
#undef SEL_TSTAGE
        { const unsigned sg = P[15];
#pragma unroll
          for (int q = 0; q < 15; ++q) P[q] ^= sg;
          P[15] = ~sg; }
        const int nj = ((t - lane) >> 6) + 1;
        unsigned A = ((1u << ((nj + 1) >> 1)) - 1u) | (((1u << (nj >> 1)) - 1u) << 16), G = 0u;
        int cab = 0, cntA = t + 1;
#pragma unroll
        for (int bit = 15; bit >= 0; --bit) {
            if (cab + cntA != 256) {
                const unsigned ones = A & P[bit];
                const int c = wave_sum_i(__builtin_popcount(ones));
                if (cab + c >= 256) { A = ones; cntA = c; } else { G |= ones; cab += c; A &= ~ones; cntA -= c; }
            }
        }
        int need = 256 - cab;
        unsigned sel = G | A;
        if (cntA != need) {
            unsigned selA = 0u;
#pragma nounroll
            for (int j = 0; j < 32; ++j) { const int pb = (j >> 1) + 16 * (j & 1);
                unsigned long long m = __ballot((A >> pb) & 1u);
                if (__builtin_popcountll(m) > need) m = keep_low(m, need);
                need -= __builtin_popcountll(m);
                selA |= (unsigned)((m >> lane) & 1ull) << pb;
            }
            sel = G | selA;
        }
        int lo = 0, hi = 0;
#pragma unroll
        for (int j = 0; j < 32; ++j) { const unsigned long long m = __ballot((sel >> ((j >> 1) + 16 * (j & 1))) & 1u);
            lo = (lane == j) ? (int)(unsigned)m : lo; hi = (lane == j) ? (int)(unsigned)(m >> 32) : hi; }
        if (lane < 32) ((unsigned long long*)(MASK + (size_t)(row0 + r) * 64))[lane] = (unsigned long long)(unsigned)lo | ((unsigned long long)(unsigned)hi << 32);
    }
}
}

__device__ __forceinline__ unsigned* queue_word(Frame& F, int l, int chunk, int q) { return (unsigned*)(F.ws + WS_CTL) + CW_QUEUE + 64 * ((l * NCHUNK + chunk) * 4 + q); }

__device__ __forceinline__ void phase_proj(Frame& F, int l, int chunk) {
    PHASE_IDS(F);
    { LAS float* gb = (LAS float*)(F.lds + L_GB); const float* bg = F.in[7] + (size_t)l * 3072;
      __syncthreads();
      for (int i = F.tid; i < 3072; i += NTHREADS) gb[i] = bg[i];
      VM_WAIT(); LDS_WAIT(); __syncthreads(); }
    pg8::ProjSched8 S{{{(const bf16_t*)(F.ws + WS_XB8 + (size_t)chunk * TC * DM), (const bf16_t*)(F.ws + WS_WIN8), DM / 2, DM / 2, TC / 256, (PW + 3072) / 256, F.G, (int)blockIdx.x}, F8_SW, F8_SA_X}};
    const float* rp = (const float*)(F.ws + WS_ROPE);
    EpiProj E{(bf16_t*)(F.ws + WS_PROJ), rp, rp + 2048 * 8 * 2, (float*)(F.ws + WS_SSQ), (bf16_t*)(F.ws + WS_G3), (const LAS float*)(F.lds + L_GB)};
    pg8::gemm_phase<EpiProj, pg8::ProjSched8, true, true>(F.lds, DM / 2, S, E);
}
__device__ __forceinline__ void dilated_unit(Frame& F, int u) {
    const bf16_t* PROJ = (const bf16_t*)(F.ws + WS_PROJ); bf16_t* OG = (bf16_t*)(F.ws + WS_OG); float* LSE = (float*)(F.ws + WS_LSE);
    constexpr int N_G0 = NBC * 4 * 8, N_G1 = NBC * 4 * 4 * 2;
    int g, b, h, res, qb, dil, nq;
    if (u < N_G0) { g = 0; dil = 1; qb = 7 - u / (NBC * 4); const int bh = u % (NBC * 4); b = bh >> 2; h = bh & 3; res = 0; nq = 256; }
    else if (u < N_G0 + N_G1) { const int v = u - N_G0; g = 1; dil = 4; qb = 1 - v / (NBC * 16); const int x = v % (NBC * 16); b = x >> 4; h = (x >> 2) & 3; res = x & 3; nq = 256; }
    else { const int v = u - N_G0 - N_G1; g = 2; dil = 16; qb = 0; b = v >> 6; h = (v >> 4) & 3; res = v & 15; nq = 128; }
    att::Desc d; const size_t r0 = (size_t)b * SEQ + res;
    const bf16_t* base = PROJ + r0 * PW + 512 + 768 * g + 64 * h;
    d.Q = base; d.K1 = base + 256; d.V = base + 512; d.K2 = nullptr; d.qpitch = d.k1pitch = d.vpitch = PW; d.k2pitch = 0;
    d.O = OG + ((size_t)g * TC + r0) * 256 + 64 * h; d.opitch = 256; d.lse = LSE + ((size_t)g * TC + r0) * 4 + h; d.lsepitch = 4; d.mask = nullptr;
    d.rstride = dil; d.q0 = qb * 256; d.nq = nq; d.o8 = 0;
    if (g == 2) { d.jlo = 0; d.jhi = 2; att::attn_unit<64, 0>(F.lds, d); }
    else { d.jlo = (qb * 4 - 2) > 0 ? (qb * 4 - 2) : 0; d.jhi = 4 * (qb + 1); att::attn_unit<64, 1>(F.lds, d); }
}

__device__ __forceinline__ void phase_up_scores(Frame& F, int l, int chunk) {
    PHASE_IDS(F);
    const bf16_t* PROJ = (const bf16_t*)(F.ws + WS_PROJ);
    const float* rp = (const float*)(F.ws + WS_ROPE);
    {   pg8::DenseSched S{PROJ, (const bf16_t*)(F.ws + WS_WUQ), PW, 256, TC / 256, 3, F.G, (int)blockIdx.x};
        EpiUpQ E{(bf16_t*)(F.ws + WS_QM), rp + 2048 * 8 * 2, (const float*)(F.ws + WS_SSQ)};
        pg8::gemm_phase<EpiUpQ, pg8::DenseSched, true>(F.lds, 256, S, E); }
    {   pg8::DenseSched S{PROJ + 256, (const bf16_t*)(F.ws + WS_WUKV), PW, 256, TC / 256, 4, F.G, (int)blockIdx.x};
        EpiUpKV E{(bf16_t*)(F.ws + WS_KVM), (const float*)(F.ws + WS_SSQ)};
        pg8::gemm_phase<EpiUpKV, pg8::DenseSched, true>(F.lds, 256, S, E); }
    unsigned* qw = queue_word(F, l, chunk, 0); int pre = -1;
    for (;;) {
        const int u = dequeue(F, qw, pre);
        if (u < NBC * 64) { dilated_unit(F, u); continue; }
        if (u >= NBC * 64 + NBC * 72 + NBC * 64) break;
        if (u >= NBC * 64 + NBC * 72) { dilated_unit(F, u - NBC * 72); continue; }
        const int v = u - NBC * 64; const int b = v / 72; int r = v % 72, qh = 0; while (r > (qh >> 1)) { r -= (qh >> 1) + 1; ++qh; }
        idx::score_unit(F.lds, PROJ, (float*)(F.ws + WS_SC), b, qh, r);
    }
}
__device__ __forceinline__ void phase_attn1(Frame& F, int l, int chunk, int tmask = 7) {
    PHASE_IDS(F);
    const bf16_t* PROJ = (const bf16_t*)(F.ws + WS_PROJ); const bf16_t* QM = (const bf16_t*)(F.ws + WS_QM); const bf16_t* KVM = (const bf16_t*)(F.ws + WS_KVM);
    bf16_t* OA = (bf16_t*)(F.ws + WS_OA); bf16_t* OG = (bf16_t*)(F.ws + WS_OG); float* LSE = (float*)(F.ws + WS_LSE);
    constexpr int N_MLA = NBC * 8 * 8, N_SEL = TC / 32;
    unsigned* qw = queue_word(F, l, chunk, 1); int pre = -1;
    for (;;) {
        int u = dequeue(F, qw, pre);
        if (u < N_MLA) {
            if (!(tmask & 1)) continue;
            const int qb = 7 - u / (NBC * 8), bh = u % (NBC * 8), b = bh >> 3, h = bh & 7;
            att::Desc d; const size_t r0 = (size_t)b * SEQ;
            d.Q = QM + r0 * 768 + h * 96; d.qpitch = 768; d.K1 = KVM + r0 * 1024 + h * 128; d.k1pitch = 1024; d.K2 = PROJ + r0 * PW + 384; d.k2pitch = PW;
            d.V = KVM + r0 * 1024 + h * 128 + 64; d.vpitch = 1024; d.O = (bf16_t*)((unsigned char*)OA + r0 * 512 + h * 64); d.opitch = 512; d.o8 = 1; d.lse = nullptr; d.lsepitch = 0; d.mask = nullptr;
            d.rstride = 1; d.q0 = qb * 256; d.nq = 256; d.jlo = 0; d.jhi = 4 * (qb + 1);
            att::attn_unit<96, 0>(F.lds, d); continue; }
        u -= N_MLA;
        if (u >= N_SEL) break;
        if (!(tmask & 4)) continue;
        idx::select_rows4((const float*)(F.ws + WS_SC), (unsigned*)(F.ws + WS_MASK), u * 32 + F.wave * 4, F.lane, (LAS unsigned*)(F.lds + L_GB) + F.wave * 64);
    }
}
__device__ __forceinline__ void phase_attn2(Frame& F, int l, int chunk) {
    PHASE_IDS(F);
    const bf16_t* PROJ = (const bf16_t*)(F.ws + WS_PROJ);
    bf16_t* OC = (bf16_t*)(F.ws + WS_OC);
    unsigned* qw = queue_word(F, l, chunk, 2); int pre = -1;
    for (;;) {
        const int u = dequeue(F, qw, pre);
        if (u >= NBC * 64) break;
        const int qb = 7 - u / (NBC * 8), bh = u % (NBC * 8), b = bh >> 3, h = bh & 7;
        att::Desc d; const size_t r0 = (size_t)b * SEQ;
        d.Q = PROJ + r0 * PW + 2816 + 64 * h; d.K1 = PROJ + r0 * PW + 3840; d.V = PROJ + r0 * PW + 3904; d.K2 = nullptr; d.qpitch = d.k1pitch = d.vpitch = PW; d.k2pitch = 0;
        d.O = (bf16_t*)((unsigned char*)OC + r0 * 512 + 64 * h); d.opitch = 512; d.o8 = 1; d.lse = nullptr; d.lsepitch = 0; d.mask = (const unsigned*)(F.ws + WS_MASK) + r0 * 64;
        d.rstride = 1; d.q0 = qb * 256; d.nq = 256; d.jlo = 0; d.jhi = 4 * (qb + 1);
        att::attn_unit<64, 2>(F.lds, d);
    }
    const bf16_t* OG = (const bf16_t*)(F.ws + WS_OG); const float* LSE = (const float*)(F.ws + WS_LSE); bf16_t* OB = (bf16_t*)(F.ws + WS_OB);
    const int gw = F.vcu * NWAVES + F.wave, NGW = F.G * NWAVES, h = F.lane >> 4;
    for (int row = gw; row < TC; row += NGW) {
        const float l0 = LSE[(size_t)row * 4 + h], l1 = LSE[((size_t)TC + row) * 4 + h], l2 = LSE[((size_t)2 * TC + row) * 4 + h];
        const float mx = fmaxf(l0, fmaxf(l1, l2));
        float w0 = __builtin_amdgcn_exp2f(l0 - mx), w1 = __builtin_amdgcn_exp2f(l1 - mx), w2 = __builtin_amdgcn_exp2f(l2 - mx);
        const float inv = 1.0f / (w0 + w1 + w2); w0 *= inv; w1 *= inv; w2 *= inv;
        const u32x2 a = *(const u32x2*)(OG + (size_t)row * 256 + F.lane * 4), bq = *(const u32x2*)(OG + ((size_t)TC + row) * 256 + F.lane * 4), c = *(const u32x2*)(OG + ((size_t)2 * TC + row) * 256 + F.lane * 4);
        w0 *= 32.f; w1 *= 32.f; w2 *= 32.f;
        *(unsigned*)((unsigned char*)OB + (size_t)row * 512 + F.lane * 4) = pk4_fp8(w0 * bflo(a.x) + w1 * bflo(bq.x) + w2 * bflo(c.x), w0 * bfhi(a.x) + w1 * bfhi(bq.x) + w2 * bfhi(c.x),
                                                                                    w0 * bflo(a.y) + w1 * bflo(bq.y) + w2 * bflo(c.y), w0 * bfhi(a.y) + w1 * bfhi(bq.y) + w2 * bfhi(c.y));
    }
}
constexpr int CW_DEP = 32768;
__device__ __forceinline__ void phase_attn(Frame& F, int l, int chunk) {
    PHASE_IDS(F);
    const bf16_t* PROJ = (const bf16_t*)(F.ws + WS_PROJ); const bf16_t* QM = (const bf16_t*)(F.ws + WS_QM); const bf16_t* KVM = (const bf16_t*)(F.ws + WS_KVM);
    bf16_t* OA = (bf16_t*)(F.ws + WS_OA); bf16_t* OC = (bf16_t*)(F.ws + WS_OC);
    constexpr int N_SEL = TC / 32, NQ = NBC * 8;
    unsigned* dep = (unsigned*)(F.ws + WS_CTL) + CW_DEP + (l * NCHUNK + chunk) * (NBC * 8);
    unsigned* qw = queue_word(F, l, chunk, 1); int pre = -1;
    for (;;) {
        int u = dequeue(F, qw, pre);
        if (u < N_SEL) {
            idx::select_rows4((const float*)(F.ws + WS_SC), (unsigned*)(F.ws + WS_MASK), u * 32 + F.wave * 4, F.lane, (LAS unsigned*)(F.lds + L_GB) + F.wave * 64);
            VM_WAIT();
            __syncthreads();
            if (F.tid == 0) { const int row = u * 32, b = row / SEQ, qb = (row % SEQ) >> 8;
                __builtin_amdgcn_fence(__ATOMIC_RELEASE, "agent");
                __hip_atomic_fetch_add(dep + b * 8 + qb, 1u, __ATOMIC_RELAXED, __HIP_MEMORY_SCOPE_AGENT); }
            continue; }
        u -= N_SEL;
        if (u >= 16 * NQ) break;
        const int qb = 7 - u / (2 * NQ), w = u % (2 * NQ);
        if (w < NQ) {
            const int b = w >> 3, h = w & 7;
            att::Desc d; const size_t r0 = (size_t)b * SEQ;
            d.Q = QM + r0 * 768 + h * 96; d.qpitch = 768; d.K1 = KVM + r0 * 1024 + h * 128; d.k1pitch = 1024; d.K2 = PROJ + r0 * PW + 384; d.k2pitch = PW;
            d.V = KVM + r0 * 1024 + h * 128 + 64; d.vpitch = 1024; d.O = (bf16_t*)((unsigned char*)OA + r0 * 512 + h * 64); d.opitch = 512; d.o8 = 1; d.lse = nullptr; d.lsepitch = 0; d.mask = nullptr;
            d.rstride = 1; d.q0 = qb * 256; d.nq = 256; d.jlo = 0; d.jhi = 4 * (qb + 1);
            att::attn_unit<96, 0>(F.lds, d);
        } else {
            const int bh = w - NQ, b = bh >> 3, h = bh & 7;
            if (F.tid == 0) { while (__hip_atomic_load(dep + b * 8 + qb, __ATOMIC_RELAXED, __HIP_MEMORY_SCOPE_AGENT) < 8u) __builtin_amdgcn_s_sleep(4);
                __builtin_amdgcn_fence(__ATOMIC_ACQUIRE, "agent"); }
            __syncthreads();
            att::Desc d; const size_t r0 = (size_t)b * SEQ;
            d.Q = PROJ + r0 * PW + 2816 + 64 * h; d.K1 = PROJ + r0 * PW + 3840; d.V = PROJ + r0 * PW + 3904; d.K2 = nullptr; d.qpitch = d.k1pitch = d.vpitch = PW; d.k2pitch = 0;
            d.O = (bf16_t*)((unsigned char*)OC + r0 * 512 + 64 * h); d.opitch = 512; d.o8 = 1; d.lse = nullptr; d.lsepitch = 0; d.mask = (const unsigned*)(F.ws + WS_MASK) + r0 * 64;
            d.rstride = 1; d.q0 = qb * 256; d.nq = 256; d.jlo = 0; d.jhi = 4 * (qb + 1);
            att::attn_unit<64, 2>(F.lds, d);
        }
    }
    const bf16_t* OG = (const bf16_t*)(F.ws + WS_OG); const float* LSE = (const float*)(F.ws + WS_LSE); bf16_t* OB = (bf16_t*)(F.ws + WS_OB);
    const int gw = F.vcu * NWAVES + F.wave, NGW = F.G * NWAVES, h = F.lane >> 4;
    for (int row = gw; row < TC; row += NGW) {
        const float l0 = LSE[(size_t)row * 4 + h], l1 = LSE[((size_t)TC + row) * 4 + h], l2 = LSE[((size_t)2 * TC + row) * 4 + h];
        const float mx = fmaxf(l0, fmaxf(l1, l2));
        float w0 = __builtin_amdgcn_exp2f(l0 - mx), w1 = __builtin_amdgcn_exp2f(l1 - mx), w2 = __builtin_amdgcn_exp2f(l2 - mx);
        const float inv = 1.0f / (w0 + w1 + w2); w0 *= inv; w1 *= inv; w2 *= inv;
        const u32x2 a = *(const u32x2*)(OG + (size_t)row * 256 + F.lane * 4), bq = *(const u32x2*)(OG + ((size_t)TC + row) * 256 + F.lane * 4), c = *(const u32x2*)(OG + ((size_t)2 * TC + row) * 256 + F.lane * 4);
        w0 *= 32.f; w1 *= 32.f; w2 *= 32.f;
        *(unsigned*)((unsigned char*)OB + (size_t)row * 512 + F.lane * 4) = pk4_fp8(w0 * bflo(a.x) + w1 * bflo(bq.x) + w2 * bflo(c.x), w0 * bfhi(a.x) + w1 * bfhi(bq.x) + w2 * bfhi(c.x),
                                                                                    w0 * bflo(a.y) + w1 * bflo(bq.y) + w2 * bflo(c.y), w0 * bfhi(a.y) + w1 * bfhi(bq.y) + w2 * bfhi(c.y));
    }
}
__device__ __forceinline__ void phase_branches(Frame& F, int l, int chunk) {
    PHASE_IDS(F);
    static_assert(WS_OB - WS_OA == WS_OC - WS_OB && WS_WB - WS_WA == WS_WC - WS_WB, "equally spaced branch operands");
    BranchSched S{(const char*)(F.ws + WS_OA), (const char*)(F.ws + WS_WA), WS_OB - WS_OA, WS_WB - WS_WA, 256, 256, (int)blockIdx.x, F8_SW, 127 - 5, F.G, (TC / 256) * 4};
    EpiBranchAll E{(bf16_t*)(F.ws + WS_MERGED), (bf16_t*)(F.ws + WS_M0), (bf16_t*)(F.ws + WS_M1), (const bf16_t*)(F.ws + WS_G3)};
    pg8::gemm_phase<EpiBranchAll, BranchSched, true, true>(F.lds, 256, S, E);
}
__device__ __forceinline__ void phase_wo(Frame& F, int l, int chunk) {
    PHASE_IDS(F);
    pg8::DenseSched8 S{{(const bf16_t*)(F.ws + WS_MERGED), (const bf16_t*)(F.ws + WS_WO), DM / 2, DM / 2, TC / 256, 4, F.G, (int)blockIdx.x}, F8_SW, 127 - 6};
    EpiWo E{F.out, l == 0 ? F.in[0] : F.out, chunk * TC};
    pg8::gemm_phase<EpiWo, pg8::DenseSched8, true, true>(F.lds, DM / 2, S, E);
}

__global__ void __launch_bounds__(NTHREADS, 2) fwd_kernel(Args args) {
    extern __shared__ __attribute__((aligned(16))) unsigned char lds_raw[];
    Frame F;
    F.lds = (LAS unsigned char*)lds_raw;
    F.tid = threadIdx.x; F.lane = F.tid & 63; F.wave = __builtin_amdgcn_readfirstlane(F.tid >> 6);
    F.G = gridDim.x; { const int bx = blockIdx.x; F.vcu = (F.G % 8 == 0) ? (bx % 8) * (F.G / 8) + bx / 8 : bx; }
    F.in.p = (intab_t)__builtin_amdgcn_kernarg_segment_ptr(); F.out = args.out; F.ws = args.ws; F.out0 = args.out; F.ws0 = args.ws;
    for (int u = F.tid; u < (LDS_BYTES - L_CTL) / 4; u += NTHREADS) ((LAS unsigned*)(F.lds + L_CTL))[u] = 0u;
    __syncthreads();
    XcdBarrier bar = xcd_barrier_post((unsigned*)(F.ws + WS_CTL) + CW_BAR, (volatile LAS unsigned*)(F.lds + L_BARW));
#define GRID_BAR() xcd_barrier(bar)

    for (int l = 0; l < 2; ++l) {
        phase_conv_moe(F, l);
        phase_conv_mixer(F, l);
        GRID_BAR();
        for (int chunk = 0; chunk < NCHUNK; ++chunk) {
            phase_proj(F, l, chunk);
            GRID_BAR();
            if (DUPMASK & 2) { phase_proj(F, l, chunk); GRID_BAR(); }
            phase_up_scores(F, l, chunk);
            GRID_BAR();
            if (DUPMASK & 4) { phase_up_scores(F, l + 2, chunk); GRID_BAR(); }
            phase_attn(F, l, chunk);
            GRID_BAR();
            phase_branches(F, l, chunk);
            GRID_BAR();
            if (DUPMASK & 32) { phase_branches(F, l, chunk); GRID_BAR(); }
            phase_wo(F, l, chunk);
            if ((DUPMASK & 0x800) && l == 0) { GRID_BAR(); phase_wo(F, l, chunk); }
        }
        GRID_BAR();
        phase_ln1_router(F, l, F.out, false);
        GRID_BAR();
        phase_moe_scatter(F);
        GRID_BAR();
        phase_moe_gemm1(F);
        GRID_BAR();
        if (DUPMASK & 64) { phase_moe_gemm1(F); GRID_BAR(); }
        phase_moe_gemm2(F);
        GRID_BAR();
        if (DUPMASK & 128) { phase_moe_gemm2(F); GRID_BAR(); }
        phase_combine_ln2(F, l);
    }
}

extern "C" void kernel_launch(void* const* d_in, const int* in_sizes, int n_in, void* d_out, int out_size, void* d_ws, size_t ws_size, hipStream_t stream) {
    static int grid = 0;
    if (grid == 0) {
        if (n_in != 23 || out_size != TT * DM || ws_size < WS_END) { fprintf(stderr, "kernel_launch: unexpected shapes n_in %d out %d ws %zu\n", n_in, out_size, ws_size); grid = -1; return; }
        int dev = 0, cus = 0;
        if (hipGetDevice(&dev) != hipSuccess || hipDeviceGetAttribute(&cus, hipDeviceAttributeMultiprocessorCount, dev) != hipSuccess) { grid = -1; return; }
        if (hipFuncSetAttribute((const void*)fwd_kernel, hipFuncAttributeMaxDynamicSharedMemorySize, LDS_BYTES) != hipSuccess) { fprintf(stderr, "kernel_launch: hipFuncSetAttribute failed\n"); grid = -1; return; }
        int per_cu = 0;
        if (hipOccupancyMaxActiveBlocksPerMultiprocessor(&per_cu, (const void*)fwd_kernel, NTHREADS, LDS_BYTES) != hipSuccess || per_cu < 1) fprintf(stderr, "kernel_launch: occupancy query says %d\n", per_cu);
        (void)hipGetLastError();
        grid = cus;
    }
    if (grid < 0) return;
    if (hipMemsetAsync((char*)d_ws + WS_CTL, 0, CTL_ZERO_BYTES, stream) != hipSuccess) return;
    Args a{};
    for (int i = 0; i < 23; ++i) a.in[i] = (const float*)d_in[i];
    a.out = (float*)d_out; a.ws = (unsigned char*)d_ws;
    hipLaunchKernelGGL(fwd_kernel, dim3(grid), dim3(NTHREADS), LDS_BYTES, stream, a);
}
```

```cpp
#include <hip/hip_runtime.h>
#include <cstdio>
#include <cstdint>

#define LAS __attribute__((address_space(3)))
#define GAS __attribute__((address_space(1)))
typedef unsigned short bf16_t;
typedef short bf16x8 __attribute__((ext_vector_type(8)));
typedef float f32x4 __attribute__((ext_vector_type(4)));
typedef float f32x2 __attribute__((ext_vector_type(2)));
typedef float f32x16 __attribute__((ext_vector_type(16)));
typedef unsigned u32x4 __attribute__((ext_vector_type(4)));
typedef unsigned u32x2 __attribute__((ext_vector_type(2)));

constexpr int DM = 1024, NB = 32, SEQ = 2048, TT = NB * SEQ;
constexpr int NEXP = 32, DEXP = 256;
constexpr float LN_EPS = 1e-6f;
constexpr float ALPHA = 1.41421356237309515f;
constexpr int NWAVES = 8, NTHREADS = 512;

__device__ __forceinline__ unsigned f2bf(float f) { unsigned u = __builtin_bit_cast(unsigned, f); return (u + 0x7fffu + ((u >> 16) & 1u)) >> 16; }
__device__ __forceinline__ unsigned pk2(float lo, float hi) { return f2bf(lo) | (f2bf(hi) << 16); }
__device__ __forceinline__ float bf2f(unsigned short b) { return __builtin_bit_cast(float, (unsigned)b << 16); }
__device__ __forceinline__ float bflo(unsigned w) { return __builtin_bit_cast(float, w << 16); }
__device__ __forceinline__ float bfhi(unsigned w) { return __builtin_bit_cast(float, w & 0xffff0000u); }
typedef __bf16 bf16x2_t __attribute__((ext_vector_type(2)));
__device__ __forceinline__ unsigned cvt_pk_bf16(float lo, float hi) { const f32x2 v = {lo, hi}; const bf16x2_t b = __builtin_convertvector(v, bf16x2_t); return __builtin_bit_cast(unsigned, b); }
__device__ __forceinline__ float wave_sum(float v) {
#pragma unroll
    for (int o = 1; o < 64; o <<= 1) v += __shfl_xor(v, o);
    return v;
}
__device__ __forceinline__ float fast_exp(float x) { return __builtin_amdgcn_exp2f(x * 1.4426950408889634f); }
__device__ __forceinline__ float sigmoidf_(float x) { return __builtin_amdgcn_rcpf(1.0f + fast_exp(-x)); }
__device__ __forceinline__ unsigned pk4_fp8(float a, float b, float c, float d) {
    int p = __builtin_amdgcn_cvt_pk_fp8_f32(a, b, 0, false); p = __builtin_amdgcn_cvt_pk_fp8_f32(c, d, p, true); return (unsigned)p; }
__device__ __forceinline__ void store8_fp8(unsigned char* p, const f32x4& v0, const f32x4& v1, float sc) {
    u32x2 w; w.x = pk4_fp8(v0[0] * sc, v0[1] * sc, v0[2] * sc, v0[3] * sc); w.y = pk4_fp8(v1[0] * sc, v1[1] * sc, v1[2] * sc, v1[3] * sc); *(u32x2*)p = w;
}
#define LDS_WAIT() asm volatile("s_waitcnt lgkmcnt(0)" ::: "memory")
#define VM_WAIT() asm volatile("s_waitcnt vmcnt(0)" ::: "memory")

namespace pg8 {
constexpr int BM = 256, BK = 64, HALF = 128, HTB = HALF * BK * 2, STAGE_BYTES = 8 * HTB;
__device__ __forceinline__ int lds_byte(int r, int c) { return r * 128 + ((((c >> 3) ^ (r >> 1)) & 7) * 16) + (c & 7) * 2; }
__device__ __forceinline__ void stage_rc(int b, int& R, int& C) { R = b >> 7; C = ((((b >> 4) ^ (R >> 1)) & 7)) * 8; }
__device__ __forceinline__ int perm32(int rho) { const int n = rho >> 4, i = rho & 15; return 8 * (i >> 2) + 4 * n + (i & 3); }
struct Unit { int pm, pn, ord; };

template <class S, class = void> struct SchedVarK { static constexpr bool value = false; };
template <class S> struct SchedVarK<S, decltype((void)S::VARK)> { static constexpr bool value = S::VARK; };
typedef int v4i_t __attribute__((ext_vector_type(4)));
typedef int v8i_t __attribute__((ext_vector_type(8)));
__device__ __forceinline__ v8i_t cat8(const bf16x8& lo, const bf16x8& hi) { return __builtin_shufflevector(__builtin_bit_cast(v4i_t, lo), __builtin_bit_cast(v4i_t, hi), 0, 1, 2, 3, 4, 5, 6, 7); }
template <class Epi, class Sched, bool ALIGN_EPI, bool F8 = false>
__device__ __forceinline__ void gemm_phase(LAS unsigned char* lds, const int K, const Sched& S, const Epi& E) {
    int tid_ = threadIdx.x; asm volatile("" : "+v"(tid_));
    const int tid = tid_, wid = __builtin_amdgcn_readfirstlane(tid >> 6), lane = tid & 63, wr = wid >> 2, wc = wid & 3, fr = lane & 15, fq = lane >> 4;
    int nt = K / BK;
    int Rr[2], Cc[2]; unsigned vB[2][2];
#pragma unroll
    for (int i = 0; i < 2; ++i) { stage_rc(tid * 16 + i * 8192, Rr[i], Cc[i]); const int Rb = (Rr[i] & ~31) + perm32(Rr[i] & 31);
        vB[0][i] = (unsigned)(Rb * S.ldb + Cc[i]) * 2u; vB[1][i] = (unsigned)((HALF + Rb) * S.ldb + Cc[i]) * 2u; }
    const size_t kstep = (size_t)(BK * 2);
    const unsigned ldsw = (unsigned)wid * 1024u;
    const int aoff = lds_byte(wr * 64 + fr, fq * 8), boff = lds_byte(wc * 32 + fr, fq * 8);
    const int aoff1 = lds_byte(wr * 64 + fr, fq * 8 + 32), boff1 = lds_byte(wc * 32 + fr, fq * 8 + 32);
#define PG8_SA(b, h) (((b) * 2 + (h)) * HTB)
#define PG8_SB(b, h) ((4 + (b) * 2 + (h)) * HTB)
#define PG8_STAGE(bufoff, gbase, voff) do { _Pragma("unroll") for (int _i = 0; _i < 2; ++_i) \
        __builtin_amdgcn_global_load_lds((const unsigned*)((const char*)(gbase) + (voff)[_i]), (LAS unsigned*)(lds + (bufoff) + ldsw + _i * 8192), 16, 0, 0); } while (0)
#define PG8_LDA(dst, b, h) do { _Pragma("unroll") for (int m = 0; m < 4; ++m) { \
        const bf16x8 f0_ = *(const LAS bf16x8*)(lds + PG8_SA(b, h) + aoff + m * 2048), f1_ = *(const LAS bf16x8*)(lds + PG8_SA(b, h) + aoff1 + m * 2048); \
        if constexpr (F8) dst##8[m] = cat8(f0_, f1_); else { dst[m][0] = f0_; dst[m][1] = f1_; } } } while (0)
#define PG8_LDB(dst, b, h) do { _Pragma("unroll") for (int n = 0; n < 2; ++n) { \
        const bf16x8 f0_ = *(const LAS bf16x8*)(lds + PG8_SB(b, h) + boff + n * 2048), f1_ = *(const LAS bf16x8*)(lds + PG8_SB(b, h) + boff1 + n * 2048); \
        if constexpr (F8) dst##8[n] = cat8(f0_, f1_); else { dst[n][0] = f0_; dst[n][1] = f1_; } } } while (0)
#define PG8_MMA(ai, bj, At, Bt) do { __builtin_amdgcn_s_setprio(1); \
        if constexpr (F8) { _Pragma("unroll") for (int m = 0; m < 4; ++m) _Pragma("unroll") for (int n = 0; n < 2; ++n) \
            asm volatile("v_mfma_scale_f32_16x16x128_f8f6f4 %0, %1, %2, %0, %3, %4 op_sel_hi:[0,0,0]" : "+v"(acc[ai][bj][m][n]) : "v"(Bt##8[n]), "v"(At##8[m]), "v"(scw8), "v"(sca8)); } \
              \
        else { _Pragma("unroll") for (int m = 0; m < 4; ++m) _Pragma("unroll") for (int n = 0; n < 2; ++n) _Pragma("unroll") for (int k = 0; k < 2; ++k) \
            acc[ai][bj][m][n] = __builtin_amdgcn_mfma_f32_16x16x32_bf16(Bt[n][k], At[m][k], acc[ai][bj][m][n], 0, 0, 0); } \
        __builtin_amdgcn_s_setprio(0); } while (0)
#define PG8_WAIT_V(n) asm volatile("s_waitcnt vmcnt(" #n ")" ::: "memory")
#define PG8_WAIT_L(n) asm volatile("s_waitcnt lgkmcnt(" #n ")" ::: "memory")
#define PG8_BAR __builtin_amdgcn_s_barrier()
#define PG8_SCHED __builtin_amdgcn_sched_barrier(0)
    int scw8 = 0, sca8 = 0;
    if constexpr (F8) { scw8 = S.sw8 * 0x01010101; sca8 = S.sa8 * 0x01010101; }
    Unit cur, nxt; int ui = 0;
    if (!S.next(0, cur)) return;
    f32x4 acc[2][2][4][2];
#pragma unroll
    for (int a = 0; a < 2; ++a)
#pragma unroll
        for (int b = 0; b < 2; ++b)
#pragma unroll
            for (int m = 0; m < 4; ++m)
#pragma unroll
                for (int n = 0; n < 2; ++n) acc[a][b][m][n] = (f32x4){0.f, 0.f, 0.f, 0.f};
    bf16x8 At[4][2], B0[2][2], B1[2][2]; v8i_t At8[4], B08[2], B18[2];
    unsigned vAc[2][2], vAn[2][2];
    const char* cA = S.a_base(cur); const char* cB = S.b_base(cur);
    S.a_off(cur, Rr, Cc, vAc);
    if constexpr (SchedVarK<Sched>::value) nt = S.ktiles(cur);
    PG8_STAGE(PG8_SB(0, 0), cB, vB[0]); PG8_STAGE(PG8_SB(0, 1), cB, vB[1]); PG8_STAGE(PG8_SA(0, 0), cA, vAc[0]); PG8_STAGE(PG8_SA(0, 1), cA, vAc[1]);
    if (wr == 1) PG8_BAR;
    PG8_WAIT_V(2); PG8_BAR;
    PG8_STAGE(PG8_SB(1, 0), cB + kstep, vB[0]); PG8_STAGE(PG8_SA(1, 0), cA + kstep, vAc[0]); PG8_STAGE(PG8_SB(1, 1), cB + kstep, vB[1]);
    PG8_WAIT_V(6); PG8_BAR;
    bool epi_pend = false;
    for (;;) {
        const bool has_next = S.next(ui + 1, nxt);
        const char* nA = cA; const char* nB = cB;
        if constexpr (Sched::GATHER) {
#pragma unroll
            for (int h = 0; h < 2; ++h)
#pragma unroll
                for (int i = 0; i < 2; ++i) vAn[h][i] = vAc[h][i];
        }
        if (has_next) { nA = S.a_base(nxt); nB = S.b_base(nxt); if constexpr (Sched::GATHER) S.a_off(nxt, Rr, Cc, vAn); }
#pragma nounroll
        for (int t = 0; t < nt; t += 2) {
            const bool last = (t == nt - 2);
            const bool ep_ = epi_pend && t == 0;
            const char* a1 = cA + (size_t)(t + 1) * kstep;
            const char* a2 = last ? nA : cA + (size_t)(t + 2) * kstep; const char* b2 = last ? nB : cB + (size_t)(t + 2) * kstep;
            const char* a3 = a2 + kstep; const char* b3 = b2 + kstep;
            unsigned vA2[2][2];
#pragma unroll
            for (int h = 0; h < 2; ++h)
#pragma unroll
                for (int i = 0; i < 2; ++i) { if constexpr (Sched::GATHER) vA2[h][i] = last ? vAn[h][i] : vAc[h][i]; else vA2[h][i] = vAc[h][i]; }
            PG8_LDB(B0, 0, 0); PG8_LDB(B1, 0, 1); PG8_SCHED; PG8_LDA(At, 0, 0); PG8_STAGE(PG8_SA(1, 1), a1, vAc[1]);
            if (ep_) { PG8_WAIT_V(24); } else { PG8_WAIT_V(8); } PG8_WAIT_L(0); PG8_BAR; PG8_MMA(0, 0, At, B0); PG8_MMA(0, 1, At, B1); PG8_BAR; PG8_SCHED;
            PG8_LDA(At, 0, 1); PG8_STAGE(PG8_SB(0, 0), b2, vB[0]); PG8_STAGE(PG8_SB(0, 1), b2, vB[1]); PG8_STAGE(PG8_SA(0, 0), a2, vA2[0]);
            if (ep_) { PG8_WAIT_V(24); } else { PG8_WAIT_V(8); } PG8_WAIT_L(0); PG8_BAR; PG8_MMA(1, 0, At, B0); PG8_MMA(1, 1, At, B1); PG8_BAR; PG8_SCHED;
            PG8_LDB(B0, 1, 0); PG8_LDB(B1, 1, 1); PG8_SCHED; PG8_LDA(At, 1, 0); PG8_STAGE(PG8_SA(0, 1), a2, vA2[1]);
            PG8_WAIT_V(8); PG8_WAIT_L(0); PG8_BAR; PG8_MMA(0, 0, At, B0); PG8_MMA(0, 1, At, B1); PG8_BAR; PG8_SCHED;
            PG8_LDA(At, 1, 1); PG8_STAGE(PG8_SB(1, 0), b3, vB[0]); PG8_STAGE(PG8_SB(1, 1), b3, vB[1]); PG8_STAGE(PG8_SA(1, 0), a3, vA2[0]);
            PG8_WAIT_V(8); PG8_WAIT_L(0); PG8_BAR; PG8_MMA(1, 0, At, B0); PG8_MMA(1, 1, At, B1); PG8_BAR; PG8_SCHED;
        }
        if constexpr (ALIGN_EPI) { if (wr == 0) PG8_BAR; }
        if constexpr (F8) asm volatile("s_nop 15\n\ts_nop 15" ::: "memory");
        { int l2_ = lane; asm volatile("" : "+v"(l2_)); E(acc, cur, wr, wc, l2_ & 15, l2_ >> 4); }
        if (!has_next) break;
        epi_pend = true;
#pragma unroll
        for (int a = 0; a < 2; ++a)
#pragma unroll
            for (int b = 0; b < 2; ++b)
#pragma unroll
                for (int m = 0; m < 4; ++m)
#pragma unroll
                    for (int n = 0; n < 2; ++n) acc[a][b][m][n] = (f32x4){0.f, 0.f, 0.f, 0.f};
        cur = nxt; cA = nA; cB = nB; ++ui;
        if constexpr (SchedVarK<Sched>::value) nt = S.ktiles(cur);
        if constexpr (Sched::GATHER) {
#pragma unroll
            for (int h = 0; h < 2; ++h)
#pragma unroll
                for (int i = 0; i < 2; ++i) vAc[h][i] = vAn[h][i];
        }
        if constexpr (ALIGN_EPI) { if (wr == 1) PG8_BAR; }
    }
    PG8_WAIT_V(0);
    if constexpr (!ALIGN_EPI) { if (wr == 0) PG8_BAR; }
    asm volatile("s_waitcnt vmcnt(0) lgkmcnt(0)\n\ts_barrier" ::: "memory");
    __builtin_amdgcn_sched_barrier(0);
#undef PG8_SA
#undef PG8_SB
#undef PG8_STAGE
#undef PG8_LDA
#undef PG8_LDB
#undef PG8_MMA
#undef PG8_WAIT_V
#undef PG8_WAIT_L
#undef PG8_BAR
#undef PG8_SCHED
}

struct DenseSched {
    static constexpr bool GATHER = false;
    const bf16_t* A; const bf16_t* Bt; int lda, ldb, nM, nN, G, c;
    __device__ __forceinline__ bool next(int i, Unit& u) const { const int v = i * G + c; if (v >= nM * nN) return false; u.pm = v / nN; u.pn = v % nN; u.ord = i; return true; }
    __device__ __forceinline__ const char* a_base(const Unit& u) const { return (const char*)(A + (size_t)u.pm * BM * lda); }
    __device__ __forceinline__ const char* b_base(const Unit& u) const { return (const char*)(Bt + (size_t)u.pn * BM * ldb); }
    __device__ __forceinline__ void a_off(const Unit&, const int (&R)[2], const int (&C)[2], unsigned (&v)[2][2]) const {
#pragma unroll
        for (int i = 0; i < 2; ++i) { v[0][i] = (unsigned)(R[i] * lda + C[i]) * 2u; v[1][i] = (unsigned)((HALF + R[i]) * lda + C[i]) * 2u; }
    }
};
struct DenseSched8 : DenseSched { int sw8, sa8; };
struct ProjSched8 : DenseSched8 {
    __device__ __forceinline__ bool next(int i, Unit& u) const {
        if (nN != 28 || (nM & 1) || (G & 7)) return DenseSched::next(i, u);
        const int x = c & 7, wl = i * (G >> 3) + (c >> 3), half = nM >> 1;
        if (wl >= half * 7) return false;
        u.pm = (x >> 2) * half + wl / 7; u.pn = 7 * (x & 3) + wl % 7; u.ord = i; return true;
    }
};
}

#define XB_TMO      128
#define XB_XCNT(j)  (256  + 64 * (j))
#define XB_XSUB(j)  (1280 + 64 * (j))
#define XB_XGEN(j)  (2304 + 64 * (j))
#define XB_TOP      3328
#define XB_TOPGEN   3392
#define XCD_BAR_WORDS 3456
#define XB_SPIN_CAP (1u << 18)
__device__ __forceinline__ unsigned xb_ld(unsigned* p)              { return __hip_atomic_load(p, __ATOMIC_RELAXED, __HIP_MEMORY_SCOPE_AGENT); }
__device__ __forceinline__ unsigned xb_add(unsigned* p, unsigned v) { return __hip_atomic_fetch_add(p, v, __ATOMIC_RELAXED, __HIP_MEMORY_SCOPE_AGENT); }
__device__ __forceinline__ unsigned xb_xcc_id() { return (unsigned)__builtin_amdgcn_s_getreg((3 << 11) | 20) & 0xFu; }
#define XB_SPIN(cond, bar) do { unsigned _sp = 0; while (cond) { __builtin_amdgcn_s_sleep(1); \
    if ((++_sp & 255u) == 0u) { if (xb_ld(&(bar)[XB_TMO])) break; if (_sp > XB_SPIN_CAP) { atomicAdd(&(bar)[XB_TMO], 1u); break; } } } } while (0)
struct XcdBarrier { unsigned* bar; unsigned x; volatile LAS unsigned* st; };
__device__ __forceinline__ XcdBarrier xcd_barrier_post(unsigned* bar, volatile LAS unsigned* st) {
    XcdBarrier b; b.bar = bar; b.x = xb_xcc_id(); b.st = st;
    if (threadIdx.x == 0) (void)xb_add(&bar[XB_XCNT(b.x)], 1u);
    return b;
}
__device__ __forceinline__ void xcd_barrier_complete(unsigned* bar, unsigned x, unsigned& nloc, unsigned& nx) {
    const unsigned G = gridDim.x * gridDim.y * gridDim.z;
    unsigned sum, cnt, mine, sp = 0u;
    for (;;) {
        sum = 0u; cnt = 0u; mine = 0u;
#pragma unroll
        for (unsigned j = 0; j < 16; ++j) { const unsigned c = xb_ld(&bar[XB_XCNT(j)]); sum += c; cnt += (c > 0u) ? 1u : 0u; mine = (j == x) ? c : mine; }
        if (sum == G) break;
        __builtin_amdgcn_s_sleep(1);
        if ((++sp & 255u) == 0u) { if (xb_ld(&bar[XB_TMO])) break; if (sp > XB_SPIN_CAP) { atomicAdd(&bar[XB_TMO], 1u); break; } }
    }
    nloc = mine > 0u ? mine : 1u; nx = cnt > 0u ? cnt : 1u;
}
__device__ __forceinline__ void xcd_barrier(const XcdBarrier& b) {
    asm volatile("s_waitcnt vmcnt(0)" ::: "memory");
    __syncthreads();
    if (threadIdx.x == 0) {
        unsigned* bar = b.bar;
        __builtin_amdgcn_s_waitcnt(0);
        unsigned nloc = b.st[0], nx = b.st[1];
        if (nloc == 0u) { xcd_barrier_complete(bar, b.x, nloc, nx); b.st[0] = nloc; b.st[1] = nx; }
        const unsigned old = xb_add(&bar[XB_XSUB(b.x)], 1u);
        const unsigned gen = old / nloc;
        if (old + 1u == (gen + 1u) * nloc) {
            __builtin_amdgcn_fence(__ATOMIC_RELEASE, "agent");
            asm volatile("s_waitcnt vmcnt(0)" ::: "memory");
            const unsigned og = xb_add(&bar[XB_TOP], 1u);
            const unsigned tg = og / nx;
            if (og + 1u == (tg + 1u) * nx) xb_add(&bar[XB_TOPGEN], 1u);
            else XB_SPIN(xb_ld(&bar[XB_TOPGEN]) == tg, bar);
            __builtin_amdgcn_fence(__ATOMIC_ACQUIRE, "agent");
            xb_add(&bar[XB_XGEN(b.x)], 1u);
            asm volatile("s_waitcnt vmcnt(0)" ::: "memory");
        } else {
            XB_SPIN(xb_ld(&bar[XB_XGEN(b.x)]) == gen, bar);
            __builtin_amdgcn_fence(__ATOMIC_ACQUIRE, "agent");
            asm volatile("s_waitcnt vmcnt(0)" ::: "memory");
        }
    }
    __syncthreads();
}

constexpr size_t MiB = 1u << 20;
constexpr size_t WS_CTL = 0, CTL_ZERO_BYTES = 1 * MiB;
constexpr int CW_BAR = 4096;
constexpr int CW_QUEUE = 16384;
constexpr size_t WS_W13 = 2 * MiB;
constexpr size_t WS_W2  = 34 * MiB;
constexpr size_t WS_WR  = 50 * MiB;
constexpr size_t WS_MISC = 51 * MiB;
constexpr size_t WS_ROUTE = 52 * MiB;
constexpr size_t WS_RPOS = 53 * MiB;
constexpr size_t WS_ROWTOK = 54 * MiB;
constexpr size_t WS_ROPE = 55 * MiB;
constexpr size_t WS_WUQ = 56 * MiB;
constexpr size_t WS_WUKV = 57 * MiB;
constexpr size_t WS_WA = 58 * MiB;
constexpr size_t WS_WB = 59 * MiB;
constexpr size_t WS_WC = 60 * MiB;
constexpr size_t WS_WO = 61 * MiB;
constexpr size_t WS_SSQ = 63 * MiB;
constexpr size_t WS_LSE = 64 * MiB;
constexpr size_t WS_MASK = 66 * MiB;
constexpr size_t WS_XB8 = 74 * MiB;
constexpr size_t WS_WIN8 = 138 * MiB;
constexpr size_t WS_H = 146 * MiB;
constexpr size_t WS_Y = 182 * MiB;
constexpr size_t WS_SC = WS_Y;
constexpr size_t WS_G3 = 254 * MiB;
constexpr size_t WS_PROJ = 350 * MiB;
constexpr size_t WS_QM = 606 * MiB;
constexpr size_t WS_KVM = 654 * MiB;
constexpr size_t WS_OA = 718 * MiB;
constexpr size_t WS_OB = 734 * MiB;
constexpr size_t WS_OC = 750 * MiB;
constexpr size_t WS_OG = 766 * MiB;
constexpr size_t WS_M0 = 814 * MiB;
constexpr size_t WS_M1 = 846 * MiB;
constexpr size_t WS_MERGED = 878 * MiB;
constexpr size_t WS_END = 910 * MiB;
constexpr int F8_SA_X = 127 - 4, F8_SW = 127 - 10;
constexpr int MAXROWS = 139264;
constexpr int NBC = 16, TC = NBC * SEQ, NCHUNK = NB / NBC;
constexpr int CIN = 3944, PW = 4096;

constexpr int MI_BLOCKCNT = 0;
constexpr int MI_PANEL_E = 8192;
constexpr int MI_NPAN = 8192 + 1024;

constexpr int RING_BYTES = 131072;
constexpr int L_CTL = RING_BYTES;
constexpr int L_BARW = L_CTL + 32;
constexpr int L_HIST = L_CTL + 256;
constexpr int L_TOT  = L_CTL + 384;
constexpr int L_PRE  = L_CTL + 512;
constexpr int L_BASE = L_CTL + 640;
constexpr int L_RANK = L_CTL + 896;
constexpr int L_PE   = L_CTL + 1024;
constexpr int L_ROWS = L_CTL + 2048;
constexpr int LDS_BYTES = 147456;
constexpr int L_GB = L_ROWS;
static_assert(L_ROWS + 12288 <= LDS_BYTES, "LDS map");

#ifndef DUPMASK
#define DUPMASK 0
#endif
struct Args { const float* in[23]; float* out; unsigned char* ws; };
#define PHASE_IDS(F) do { int t_ = threadIdx.x; asm volatile("" : "+v"(t_)); (F).tid = t_; (F).lane = t_ & 63; { intab_t p_ = (intab_t)__builtin_amdgcn_kernarg_segment_ptr(); asm volatile("" : "+s"(p_)); (F).in.p = p_; } \
    { unsigned char GAS* w_ = (unsigned char GAS*)(F).ws0; asm volatile("" : "+s"(w_)); (F).ws = (unsigned char*)w_; float GAS* o_ = (float GAS*)(F).out0; asm volatile("" : "+s"(o_)); (F).out = (float*)o_; } } while (0)

typedef const float GAS* gfptr_t;
typedef const gfptr_t __attribute__((address_space(4)))* intab_t;
struct InTab { intab_t p; __device__ __forceinline__ const float* operator[](int i) const { return (const float*)p[i]; } };
struct Frame {
    LAS unsigned char* lds;
    int tid, lane, wave, vcu, G;
    InTab in; float* out; unsigned char* ws; float* out0; unsigned char* ws0;
};

template <class F>
__device__ __forceinline__ void conv_item(bf16_t* WT, int ldk, int k0, int n0, LAS float* scr, int lane, F val) {
#pragma unroll 8
    for (int i = 0; i < 32; ++i) { const int kk = 2 * i + (lane >> 5); scr[kk * 33 + (lane & 31)] = val(k0 + kk, n0 + (lane & 31)); }
    LDS_WAIT(); asm volatile("" ::: "memory");
    const int c = lane & 7;
#pragma unroll
    for (int j = 0; j < 4; ++j) { const int n = (lane >> 3) + 8 * j; const LAS float* s = scr + (8 * c) * 33 + n;
        u32x4 o; o.x = pk2(s[0 * 33], s[1 * 33]); o.y = pk2(s[2 * 33], s[3 * 33]); o.z = pk2(s[4 * 33], s[5 * 33]); o.w = pk2(s[6 * 33], s[7 * 33]);
        *(u32x4*)(WT + (size_t)(n0 + n) * ldk + k0 + 8 * c) = o; }
    LDS_WAIT(); asm volatile("" ::: "memory");
}

template <class F>
__device__ __forceinline__ void conv_item8(unsigned char* WT, int ldk, int k0, int n0, LAS float* scr, int lane, F val) {
#pragma unroll 8
    for (int i = 0; i < 32; ++i) { const int kk = 2 * i + (lane >> 5); scr[kk * 33 + (lane & 31)] = val(k0 + kk, n0 + (lane & 31)); }
    LDS_WAIT(); asm volatile("" ::: "memory");
    const int c = lane & 7;
#pragma unroll
    for (int j = 0; j < 4; ++j) { const int n = (lane >> 3) + 8 * j; const LAS float* s = scr + (8 * c) * 33 + n;
        u32x2 o; o.x = pk4_fp8(s[0 * 33], s[1 * 33], s[2 * 33], s[3 * 33]); o.y = pk4_fp8(s[4 * 33], s[5 * 33], s[6 * 33], s[7 * 33]);
        *(u32x2*)(WT + (size_t)(n0 + n) * ldk + k0 + 8 * c) = o; }
    LDS_WAIT(); asm volatile("" ::: "memory");
}

__device__ __forceinline__ void conv_plain8(unsigned char* WT, int ldk, int k0, int n0, LAS float* scr, int lane, const float* src, int pitch, float sc) {
    f32x4 v[8];
#pragma unroll
    for (int i = 0; i < 8; ++i) v[i] = *(const f32x4*)(src + (size_t)(k0 + (lane >> 3) + 8 * i) * pitch + n0 + (lane & 7) * 4);
#pragma unroll
    for (int i = 0; i < 8; ++i) { LAS float* d = scr + ((lane >> 3) + 8 * i) * 33 + (lane & 7) * 4; d[0] = v[i][0] * sc; d[1] = v[i][1] * sc; d[2] = v[i][2] * sc; d[3] = v[i][3] * sc; }
    LDS_WAIT(); asm volatile("" ::: "memory");
    const int c = lane & 7;
#pragma unroll
    for (int j = 0; j < 4; ++j) { const int n = (lane >> 3) + 8 * j; const LAS float* s = scr + (8 * c) * 33 + n;
        u32x2 o; o.x = pk4_fp8(s[0 * 33], s[1 * 33], s[2 * 33], s[3 * 33]); o.y = pk4_fp8(s[4 * 33], s[5 * 33], s[6 * 33], s[7 * 33]);
        *(u32x2*)(WT + (size_t)(n0 + n) * ldk + k0 + 8 * c) = o; }
    LDS_WAIT(); asm volatile("" ::: "memory");
}
__device__ __forceinline__ void conv_pair8(unsigned char* WT, int ldk, int k0, int n0, LAS float* scr, int lane, const float* a, const float* b, int pitch, float sc) {
    f32x2 va[8], vb[8];
#pragma unroll
    for (int i = 0; i < 8; ++i) { const size_t o = (size_t)(k0 + (lane >> 3) + 8 * i) * pitch + (n0 >> 1) + (lane & 7) * 2; va[i] = *(const f32x2*)(a + o); vb[i] = *(const f32x2*)(b + o); }
#pragma unroll
    for (int i = 0; i < 8; ++i) { LAS float* d = scr + ((lane >> 3) + 8 * i) * 33 + (lane & 7) * 4; d[0] = va[i][0] * sc; d[1] = vb[i][0] * sc; d[2] = va[i][1] * sc; d[3] = vb[i][1] * sc; }
    LDS_WAIT(); asm volatile("" ::: "memory");
    const int c = lane & 7;
#pragma unroll
    for (int j = 0; j < 4; ++j) { const int n = (lane >> 3) + 8 * j; const LAS float* s = scr + (8 * c) * 33 + n;
        u32x2 o; o.x = pk4_fp8(s[0 * 33], s[1 * 33], s[2 * 33], s[3 * 33]); o.y = pk4_fp8(s[4 * 33], s[5 * 33], s[6 * 33], s[7 * 33]);
        *(u32x2*)(WT + (size_t)(n0 + n) * ldk + k0 + 8 * c) = o; }
    LDS_WAIT(); asm volatile("" ::: "memory");
}

__device__ __forceinline__ void phase_conv_moe(Frame& F, int l) {
    PHASE_IDS(F);
    LAS float* scr = (LAS float*)(F.lds + F.wave * 16384);
    const int gw = F.vcu * NWAVES + F.wave, NGW = F.G * NWAVES;
    const float* w1 = F.in[18] + (size_t)l * NEXP * DM * DEXP;
    const float* w3 = F.in[19] + (size_t)l * NEXP * DM * DEXP;
    const float* w2 = F.in[20] + (size_t)l * NEXP * DEXP * DM;
    bf16_t* W13 = (bf16_t*)(F.ws + WS_W13); bf16_t* W2 = (bf16_t*)(F.ws + WS_W2);
    constexpr int I13 = (DM / 64) * (512 / 32);
    constexpr int I2 = (DEXP / 64) * (DM / 32);
    for (int it = gw; it < NEXP * (I13 + I2); it += NGW) {
        if (it < NEXP * I13) {
            const int e = it / I13, r = it % I13, kb = r / 16, nb = r % 16;
            const float* a = w1 + (size_t)e * DM * DEXP; const float* b = w3 + (size_t)e * DM * DEXP;
            conv_pair8((unsigned char*)W13 + (size_t)e * 512 * DM, DM, kb * 64, nb * 32, scr, F.lane, a, b, DEXP, 1024.f);
        } else {
            const int it2 = it - NEXP * I13; const int e = it2 / I2, r = it2 % I2, kb = r / 32, nb = r % 32;
            const float* a = w2 + (size_t)e * DEXP * DM;
            conv_plain8((unsigned char*)W2 + (size_t)e * DM * DEXP, DEXP, kb * 64, nb * 32, scr, F.lane, a, DM, 1024.f);
        }
    }
    const float* wg = F.in[14] + (size_t)l * DM * 4; const float* wsb = F.in[16] + (size_t)l * DM * NEXP;
    const float* g1 = F.in[12] + (size_t)l * DM; const float* b1 = F.in[13] + (size_t)l * DM;
    bf16_t* WRH = (bf16_t*)(F.ws + WS_WR); bf16_t* WRL = (bf16_t*)(F.ws + WS_WR + 128 * 1024); float* WRC = (float*)(F.ws + WS_WR + 256 * 1024);
    for (int idx = (F.vcu * NTHREADS + F.tid); idx < 64 * DM; idx += F.G * NTHREADS) {
        const int c = idx / DM, k = idx % DM;
        const float v = (c < 32 ? wsb[(size_t)k * NEXP + c] : (c < 36 ? wg[(size_t)k * 4 + (c - 32)] : 0.f)) * g1[k];
        const unsigned h = f2bf(v); const int it = k >> 5, hi_ = (k >> 4) & 1, st = (k >> 3) & 1, e = k & 7, ln = (c & 31) + 32 * hi_, p0 = 2 * (c >> 5);
        WRH[((((size_t)it * 4 + p0) * 2 + st) * 64 + ln) * 8 + e] = (bf16_t)h;
        WRH[((((size_t)it * 4 + p0 + 1) * 2 + st) * 64 + ln) * 8 + e] = (bf16_t)f2bf(v - __builtin_bit_cast(float, h << 16)); (void)WRL;
    }
    if (gw < 64) {
        const int c = gw; float s1 = 0.f, s2 = 0.f;
        for (int k = F.lane; k < DM; k += 64) { const float w = c < 32 ? wsb[(size_t)k * NEXP + c] : (c < 36 ? wg[(size_t)k * 4 + (c - 32)] : 0.f); s1 += g1[k] * w; s2 += b1[k] * w; }
        s1 = wave_sum(s1); s2 = wave_sum(s2);
        const float bias = c < 32 ? F.in[17][(size_t)l * NEXP + c] : (c < 36 ? F.in[15][(size_t)l * 4 + (c - 32)] : 0.f);
        if (F.lane == 0) { WRC[c] = s1; WRC[64 + c] = s2 + bias; }
    }
}

__device__ __forceinline__ void ln_row(f32x4 (&v)[4], const f32x4 (&g)[4], const f32x4 (&b)[4], float* omean = nullptr, float* orstd = nullptr) {
    float s = 0.f;
#pragma unroll
    for (int j = 0; j < 4; ++j) s += (v[j].x + v[j].y) + (v[j].z + v[j].w);
    const float mean = wave_sum(s) * (1.f / DM); float s2 = 0.f;
#pragma unroll
    for (int j = 0; j < 4; ++j) { v[j] = v[j] - mean; s2 += (v[j].x * v[j].x + v[j].y * v[j].y) + (v[j].z * v[j].z + v[j].w * v[j].w); }
    const float rstd = 1.0f / sqrtf(wave_sum(s2) * (1.f / DM) + LN_EPS);
#pragma unroll
    for (int j = 0; j < 4; ++j) v[j] = v[j] * rstd * g[j] + b[j];
    if (omean) { *omean = mean; *orstd = rstd; }
}
__device__ __forceinline__ void store_row(const f32x4 (&v)[4], float* orow, unsigned char* brow, int lane) {
#pragma unroll
    for (int j = 0; j < 4; ++j) {
        ((f32x4*)orow)[lane + 64 * j] = v[j];
        ((unsigned*)brow)[lane + 64 * j] = pk4_fp8(v[j].x * 16.f, v[j].y * 16.f, v[j].z * 16.f, v[j].w * 16.f);
    }
}

__device__ __forceinline__ void phase_ln1_router(Frame& F, int l, const float* src, bool scale_alpha) {
    PHASE_IDS(F);
    const int lane = F.lane, hi = lane >> 5, r32 = lane & 31;
    const float* lg = F.in[12] + (size_t)l * DM; const float* lb = F.in[13] + (size_t)l * DM;
    f32x4 g[4], b[4];
#pragma unroll
    for (int j = 0; j < 4; ++j) { g[j] = ((const f32x4*)lg)[lane + 64 * j]; b[j] = ((const f32x4*)lb)[lane + 64 * j]; }
    unsigned char* XB = F.ws + WS_XB8;
    const bf16_t* WRH = (const bf16_t*)(F.ws + WS_WR); const bf16_t* WRL = (const bf16_t*)(F.ws + WS_WR + 128 * 1024);
    const float* WRC = (const float*)(F.ws + WS_WR + 256 * 1024); float* stats = (float*)(F.ws + WS_WR + 512 * 1024);
    unsigned* misc = (unsigned*)(F.ws + WS_MISC);
    int* route = (int*)(F.ws + WS_ROUTE);
    LAS unsigned* hist = (LAS unsigned*)(F.lds + L_HIST);
    const float sc = scale_alpha ? ALPHA : 1.0f;
    for (int blk = F.vcu; blk < TT / 256; blk += F.G) {
        if (F.tid < 32) hist[F.tid] = 0u;
        __syncthreads();
        const int row0 = blk * 256 + F.wave * 32;
        float mu_l = 0.f, rs_l = 1.f;
        for (int i = 0; i < 32; i += 2) {
            f32x4 v0[4], v1[4];
            const f32x4* p0 = (const f32x4*)(src + (size_t)(row0 + i) * DM); const f32x4* p1 = (const f32x4*)(src + (size_t)(row0 + i + 1) * DM);
#pragma unroll
            for (int j = 0; j < 4; ++j) { v0[j] = p0[lane + 64 * j] * sc; v1[j] = p1[lane + 64 * j] * sc; }
            float m0, r0, m1, r1;
            ln_row(v0, g, b, &m0, &r0); ln_row(v1, g, b, &m1, &r1);
            mu_l = (r32 == i) ? m0 : ((r32 == i + 1) ? m1 : mu_l); rs_l = (r32 == i) ? r0 : ((r32 == i + 1) ? r1 : rs_l);
#pragma unroll
            for (int j = 0; j < 4; ++j) {
                ((unsigned*)(XB + (size_t)(row0 + i) * DM))[lane + 64 * j] = pk4_fp8(v0[j].x * 16.f, v0[j].y * 16.f, v0[j].z * 16.f, v0[j].w * 16.f);
                ((unsigned*)(XB + (size_t)(row0 + i + 1) * DM))[lane + 64 * j] = pk4_fp8(v1[j].x * 16.f, v1[j].y * 16.f, v1[j].z * 16.f, v1[j].w * 16.f); }
        }
        if (hi == 0) *(f32x2*)(stats + (size_t)(row0 + r32) * 2) = (f32x2){mu_l, rs_l};
        f32x16 acc0 = {}, acc1 = {};
        {
            const bf16_t* WT = WRH; (void)WRL;
            LAS float* xs = (LAS float*)(F.lds + F.wave * 9216);
            const float* xg = src + (size_t)(row0 + (lane >> 3)) * DM + (lane & 7) * 4;
            f32x4 xv[4]; bf16x8 wv[8];
#pragma unroll
            for (int i = 0; i < 4; ++i) xv[i] = *(const f32x4*)(xg + (size_t)(8 * i) * DM);
#pragma unroll
            for (int q = 0; q < 8; ++q) wv[q] = *(const bf16x8*)(WT + ((size_t)q * 64 + lane) * 8);
#pragma unroll 2
            for (int it = 0; it < 32; ++it) {
                LAS float* xb = xs + (it & 1) * 1152;
#pragma unroll
                for (int i = 0; i < 4; ++i) *(LAS f32x4*)(xb + ((lane >> 3) + 8 * i) * 36 + (lane & 7) * 4) = xv[i];
                bf16x8 wc[8];
#pragma unroll
                for (int q = 0; q < 8; ++q) wc[q] = wv[q];
                { const int nx = it + 1 < 32 ? it + 1 : 31;
#pragma unroll
                  for (int i = 0; i < 4; ++i) xv[i] = *(const f32x4*)(xg + (size_t)(8 * i) * DM + nx * 32);
#pragma unroll
                  for (int q = 0; q < 8; ++q) wv[q] = *(const bf16x8*)(WT + (((size_t)nx * 8 + q) * 64 + lane) * 8); }
                f32x4 xa[4];
#pragma unroll
                for (int j = 0; j < 4; ++j) xa[j] = *(const LAS f32x4*)(xb + r32 * 36 + hi * 16 + 4 * j);
#pragma unroll
                for (int st = 0; st < 2; ++st) {
                    const f32x4 x0 = xa[2 * st], x1 = xa[2 * st + 1];
                    u32x4 xh, xl;
                    xh.x = cvt_pk_bf16(x0[0], x0[1]); xh.y = cvt_pk_bf16(x0[2], x0[3]); xh.z = cvt_pk_bf16(x1[0], x1[1]); xh.w = cvt_pk_bf16(x1[2], x1[3]);
                    xl.x = cvt_pk_bf16(x0[0] - bflo(xh.x), x0[1] - bfhi(xh.x)); xl.y = cvt_pk_bf16(x0[2] - bflo(xh.y), x0[3] - bfhi(xh.y));
                    xl.z = cvt_pk_bf16(x1[0] - bflo(xh.z), x1[1] - bfhi(xh.z)); xl.w = cvt_pk_bf16(x1[2] - bflo(xh.w), x1[3] - bfhi(xh.w));
                    const bf16x8 xhv = __builtin_bit_cast(bf16x8, xh), xlv = __builtin_bit_cast(bf16x8, xl);
                    acc0 = __builtin_amdgcn_mfma_f32_32x32x16_bf16(wc[0 + st], xhv, acc0, 0, 0, 0); acc1 = __builtin_amdgcn_mfma_f32_32x32x16_bf16(wc[4 + st], xhv, acc1, 0, 0, 0);
                    acc0 = __builtin_amdgcn_mfma_f32_32x32x16_bf16(wc[2 + st], xhv, acc0, 0, 0, 0); acc1 = __builtin_amdgcn_mfma_f32_32x32x16_bf16(wc[6 + st], xhv, acc1, 0, 0, 0);
                    acc0 = __builtin_amdgcn_mfma_f32_32x32x16_bf16(wc[0 + st], xlv, acc0, 0, 0, 0); acc1 = __builtin_amdgcn_mfma_f32_32x32x16_bf16(wc[4 + st], xlv, acc1, 0, 0, 0);
                }
            }
        }
        float gl[4];
#pragma unroll
        for (int i = 0; i < 4; ++i) gl[i] = rs_l * (acc1[i] - mu_l * WRC[32 + i]) + WRC[64 + 32 + i];
        int gidx = 0; float gmax = gl[0];
#pragma unroll
        for (int i = 1; i < 4; ++i) if (gl[i] > gmax) { gmax = gl[i]; gidx = i; }
        float gsum = 0.f;
#pragma unroll
        for (int i = 0; i < 4; ++i) gsum += fast_exp(gl[i] - gmax);
        float gp = 1.0f / gsum;
        gidx = __shfl(gidx, r32); gp = __shfl(gp, r32);
        float cv[4];
#pragma unroll
        for (int i = 0; i < 4; ++i) {
            const float a = gidx == 0 ? acc0[i] : gidx == 1 ? acc0[4 + i] : gidx == 2 ? acc0[8 + i] : acc0[12 + i];
            cv[i] = rs_l * (a - mu_l * WRC[8 * gidx + 4 * hi + i]) + WRC[64 + 8 * gidx + 4 * hi + i];
        }
        float v1 = cv[0]; int i1 = 0;
#pragma unroll
        for (int i = 1; i < 4; ++i) if (cv[i] > v1) { v1 = cv[i]; i1 = i; }
        float v2 = -INFINITY; int i2 = 0;
#pragma unroll
        for (int i = 0; i < 4; ++i) if (i != i1 && cv[i] > v2) { v2 = cv[i]; i2 = i; }
        i1 += 4 * hi; i2 += 4 * hi;
        const float pv1 = __shfl_xor(v1, 32), pv2 = __shfl_xor(v2, 32); const int pi1 = __shfl_xor(i1, 32), pi2 = __shfl_xor(i2, 32);
        auto better = [](float av, int ai, float bv, int bi) { return av > bv || (av == bv && ai < bi); };
        float fv, sv; int fi, si;
        if (better(v1, i1, pv1, pi1)) { fv = v1; fi = i1; if (better(v2, i2, pv1, pi1)) { sv = v2; si = i2; } else { sv = pv1; si = pi1; } }
        else { fv = pv1; fi = pi1; if (better(v1, i1, pv2, pi2)) { sv = v1; si = i1; } else { sv = pv2; si = pi2; } }
        const float d = fast_exp(sv - fv), inv = 1.0f / (1.0f + d);
        const float w1 = gp * inv, w2 = gp * d * inv;
        const int e1 = 8 * gidx + fi, e2 = 8 * gidx + si;
        if (hi == 0) {
            *(int4*)(route + (size_t)(row0 + r32) * 4) = make_int4(e1, e2, __float_as_int(w1), __float_as_int(w2));
            atomicAdd((unsigned*)&hist[e1], 1u); atomicAdd((unsigned*)&hist[e2], 1u);
        }
        __syncthreads();
        if (F.tid < 32) misc[MI_BLOCKCNT + blk * 32 + F.tid] = hist[F.tid];
        __syncthreads();
    }
}

__device__ __forceinline__ void phase_moe_scatter(Frame& F) {
    PHASE_IDS(F);
    unsigned* misc = (unsigned*)(F.ws + WS_MISC);
    const int* route = (const int*)(F.ws + WS_ROUTE);
    int* rpos = (int*)(F.ws + WS_RPOS); int* rowtok = (int*)(F.ws + WS_ROWTOK);
    LAS unsigned* tot = (LAS unsigned*)(F.lds + L_TOT); LAS unsigned* pre = (LAS unsigned*)(F.lds + L_PRE);
    LAS unsigned* base = (LAS unsigned*)(F.lds + L_BASE); LAS unsigned* rank = (LAS unsigned*)(F.lds + L_RANK);
    for (int blk = F.vcu; blk < TT / 256; blk += F.G) {
        {
            if (F.tid < 32) { tot[F.tid] = 0u; pre[F.tid] = 0u; rank[F.tid] = 0u; }
            __syncthreads();
            const int e = F.tid & 31, part = F.tid >> 5; unsigned cv[16];
#pragma unroll
            for (int i = 0; i < 16; ++i) cv[i] = misc[MI_BLOCKCNT + (part * 16 + i) * 32 + e];
            unsigned t = 0, p = 0;
#pragma unroll
            for (int i = 0; i < 16; ++i) { t += cv[i]; p += (part * 16 + i < blk) ? cv[i] : 0u; }
            atomicAdd((unsigned*)&tot[e], t); atomicAdd((unsigned*)&pre[e], p);
        }
        __syncthreads();
        if (F.tid == 0) { unsigned a = 0; for (int e = 0; e < NEXP; ++e) { base[e] = a; a += (tot[e] + 255u) & ~255u; } base[NEXP] = a; }
        __syncthreads();
        {
            const int tok = blk * 256 + (F.tid >> 1), slot = F.tid & 1;
            const int e = route[(size_t)tok * 4 + slot];
            const unsigned r = atomicAdd((unsigned*)&rank[e], 1u);
            const unsigned pos = base[e] + pre[e] + r;
            rowtok[pos] = tok; rpos[(size_t)tok * 2 + slot] = (int)pos;
        }
        if (blk < NEXP) {
            const int e = blk; const unsigned end = base[e] + tot[e], nxt = base[e + 1];
            for (unsigned p = end + F.tid; p < nxt; p += NTHREADS) rowtok[p] = 0;
            for (unsigned p = base[e] / 256 + F.tid; p < nxt / 256; p += NTHREADS) misc[MI_PANEL_E + p] = (unsigned)e;
        }
        if (blk == 0 && F.tid == 0) misc[MI_NPAN] = base[NEXP] / 256;
        __syncthreads();
    }
}

struct MoeSched1 {
    static constexpr bool GATHER = true;
    const bf16_t* A; const bf16_t* W; int lda, ldb, ntot, G, c; const LAS int* rows; const LAS int* pe; int sw8, sa8;
    __device__ __forceinline__ bool next(int i, pg8::Unit& u) const { const int v = i * G + c; if (v >= ntot) return false; u.pm = v >> 1; u.pn = v & 1; u.ord = i; return true; }
    __device__ __forceinline__ const char* a_base(const pg8::Unit&) const { return (const char*)A; }
    __device__ __forceinline__ const char* b_base(const pg8::Unit& u) const { return (const char*)(W + (size_t)pe[u.ord] * 512 * ldb + (size_t)u.pn * 256 * ldb); }
    __device__ __forceinline__ void a_off(const pg8::Unit& u, const int (&R)[2], const int (&C)[2], unsigned (&v)[2][2]) const {
#pragma unroll
        for (int h = 0; h < 2; ++h)
#pragma unroll
            for (int i = 0; i < 2; ++i) v[h][i] = (unsigned)(rows[u.ord * 256 + h * 128 + R[i]] * lda + C[i]) * 2u;
    }
};
struct MoeSched2 {
    static constexpr bool GATHER = false;
    const bf16_t* A; const bf16_t* W; int lda, ldb, ntot, G, c; const LAS int* pe; int sw8, sa8;
    __device__ __forceinline__ bool next(int i, pg8::Unit& u) const { const int v = i * G + c; if (v >= ntot) return false; u.pm = v >> 2; u.pn = v & 3; u.ord = i; return true; }
    __device__ __forceinline__ const char* a_base(const pg8::Unit& u) const { return (const char*)(A + (size_t)u.pm * 256 * lda); }
    __device__ __forceinline__ const char* b_base(const pg8::Unit& u) const { return (const char*)(W + (size_t)pe[u.ord] * DM * ldb + (size_t)u.pn * 256 * ldb); }
    __device__ __forceinline__ void a_off(const pg8::Unit&, const int (&R)[2], const int (&C)[2], unsigned (&v)[2][2]) const {
#pragma unroll
        for (int i = 0; i < 2; ++i) { v[0][i] = (unsigned)(R[i] * lda + C[i]) * 2u; v[1][i] = (unsigned)((128 + R[i]) * lda + C[i]) * 2u; }
    }
};
struct EpiSwiGLU {
    bf16_t* H;
    __device__ __forceinline__ void operator()(const f32x4 (&acc)[2][2][4][2], const pg8::Unit& u, int wr, int wc, int fr, int fq) const {
        const int row0 = u.pm * 256 + wr * 64 + fr, col0 = u.pn * 128 + wc * 16 + 4 * fq;
#pragma unroll
        for (int ai = 0; ai < 2; ++ai)
#pragma unroll
            for (int m = 0; m < 4; ++m) { bf16_t* rowp = H + (size_t)(row0 + ai * 128 + m * 16) * DEXP + col0;
#pragma unroll
                for (int bj = 0; bj < 2; ++bj) { const f32x4 v0 = acc[ai][bj][m][0], v1 = acc[ai][bj][m][1];
                    const float h0 = v0[0] * sigmoidf_(v0[0]) * v0[1], h1 = v0[2] * sigmoidf_(v0[2]) * v0[3], h2 = v1[0] * sigmoidf_(v1[0]) * v1[1], h3 = v1[2] * sigmoidf_(v1[2]) * v1[3];
                    *(unsigned*)((unsigned char*)H + (size_t)(row0 + ai * 128 + m * 16) * DEXP + col0 + bj * 64) = pk4_fp8(h0 * 16.f, h1 * 16.f, h2 * 16.f, h3 * 16.f); (void)rowp; } }
    }
};
struct EpiStoreBf16 {
    bf16_t* O; int ldc;
    __device__ __forceinline__ void operator()(const f32x4 (&acc)[2][2][4][2], const pg8::Unit& u, int wr, int wc, int fr, int fq) const {
        const int row0 = u.pm * 256 + wr * 64 + fr, col0 = u.pn * 256 + wc * 32 + 8 * fq;
#pragma unroll
        for (int ai = 0; ai < 2; ++ai)
#pragma unroll
            for (int m = 0; m < 4; ++m) { bf16_t* rowp = O + (size_t)(row0 + ai * 128 + m * 16) * ldc + col0;
#pragma unroll
                for (int bj = 0; bj < 2; ++bj) store8_fp8((unsigned char*)O + (size_t)(row0 + ai * 128 + m * 16) * ldc + col0 + bj * 128, acc[ai][bj][m][0], acc[ai][bj][m][1], 64.f); (void)rowp; }
    }
};

__device__ __forceinline__ void phase_moe_gemm1(Frame& F) {
    PHASE_IDS(F);
    const unsigned* misc = (const unsigned*)(F.ws + WS_MISC);
    const int* rowtok = (const int*)(F.ws + WS_ROWTOK);
    const int npan = (int)misc[MI_NPAN];
    LAS int* rows = (LAS int*)(F.lds + L_ROWS); LAS int* pe = (LAS int*)(F.lds + L_PE);
    const int c = (int)blockIdx.x, ntot = npan * 2;
    for (int i = 0; i * F.G + c < ntot && i < 8; ++i) { const int p = (i * F.G + c) >> 1;
        if (F.tid < 256) rows[i * 256 + F.tid] = rowtok[p * 256 + F.tid];
        if (F.tid == 256) pe[i] = (int)misc[MI_PANEL_E + p]; }
    VM_WAIT(); LDS_WAIT(); __syncthreads();
    MoeSched1 S{(const bf16_t*)(F.ws + WS_XB8), (const bf16_t*)(F.ws + WS_W13), DM / 2, DM / 2, ntot, F.G, c, rows, pe, F8_SW, F8_SA_X};
    EpiSwiGLU E{(bf16_t*)(F.ws + WS_H)};
    pg8::gemm_phase<EpiSwiGLU, MoeSched1, true, true>(F.lds, DM / 2, S, E);
}
__device__ __forceinline__ void phase_moe_gemm2(Frame& F) {
    PHASE_IDS(F);
    const unsigned* misc = (const unsigned*)(F.ws + WS_MISC);
    const int npan = (int)misc[MI_NPAN];
    LAS int* pe = (LAS int*)(F.lds + L_PE);
    const int c = (int)blockIdx.x, ntot = npan * 4;
    __syncthreads();
    if (F.tid < 16) { const int v = F.tid * F.G + c; if (v < ntot) pe[F.tid] = (int)misc[MI_PANEL_E + (v >> 2)]; }
    VM_WAIT(); LDS_WAIT(); __syncthreads();
    MoeSched2 S{(const bf16_t*)(F.ws + WS_H), (const bf16_t*)(F.ws + WS_W2), DEXP / 2, DEXP / 2, ntot, F.G, c, pe, F8_SW, 127 - 4};
    EpiStoreBf16 E{(bf16_t*)(F.ws + WS_Y), DM};
    int k2 = DEXP / 2; asm volatile("" : "+s"(k2));
    pg8::gemm_phase<EpiStoreBf16, MoeSched2, true, true>(F.lds, k2, S, E);
}

__device__ __forceinline__ void phase_combine_ln2(Frame& F, int l) {
    PHASE_IDS(F);
    const int lane = F.lane;
    const float* lg = F.in[21] + (size_t)l * DM; const float* lb = F.in[22] + (size_t)l * DM;
    f32x4 g[4], b[4];
#pragma unroll
    for (int j = 0; j < 4; ++j) { g[j] = ((const f32x4*)lg)[lane + 64 * j]; b[j] = ((const f32x4*)lb)[lane + 64 * j]; }
    const bf16_t* Y = (const bf16_t*)(F.ws + WS_Y);
    const float* l1g = F.in[12] + (size_t)l * DM; const float* l1b = F.in[13] + (size_t)l * DM; const float* stats = (const float*)(F.ws + WS_WR + 512 * 1024);
    f32x4 g1[4], b1[4];
#pragma unroll
    for (int j = 0; j < 4; ++j) { g1[j] = ((const f32x4*)l1g)[lane + 64 * j]; b1[j] = ((const f32x4*)l1b)[lane + 64 * j]; }
    const int* route = (const int*)(F.ws + WS_ROUTE); const int* rpos = (const int*)(F.ws + WS_RPOS);
    const int gw = F.vcu * NWAVES + F.wave, NGW = F.G * NWAVES;
    int4 rt_n = *(const int4*)(route + (size_t)gw * 4); int2 rp_n = *(const int2*)(rpos + (size_t)gw * 2); f32x2 st_n = *(const f32x2*)(stats + (size_t)gw * 2);
    for (int row = gw; row < TT; row += NGW) {
        const int4 rt = rt_n; const int2 rp = rp_n; const f32x2 st = st_n;
        { const int nr = (row + NGW < TT) ? row + NGW : row; rt_n = *(const int4*)(route + (size_t)nr * 4); rp_n = *(const int2*)(rpos + (size_t)nr * 2); st_n = *(const f32x2*)(stats + (size_t)nr * 2); }
        const float w0 = __int_as_float(rt.z) * (1.f / 64.f), w1 = __int_as_float(rt.w) * (1.f / 64.f);
        const f32x4* px = (const f32x4*)(F.out + (size_t)row * DM);
        const unsigned* y0 = (const unsigned*)((const unsigned char*)Y + (size_t)rp.x * DM); const unsigned* y1 = (const unsigned*)((const unsigned char*)Y + (size_t)rp.y * DM);
        f32x4 v[4];
#pragma unroll
        for (int j = 0; j < 4; ++j) {
            const f32x4 x = (px[lane + 64 * j] - st[0]) * st[1] * g1[j] + b1[j]; const unsigned a = y0[lane + 64 * j], c = y1[lane + 64 * j];
            const f32x2 a01 = __builtin_amdgcn_cvt_pk_f32_fp8((int)a, false), a23 = __builtin_amdgcn_cvt_pk_f32_fp8((int)a, true), c01 = __builtin_amdgcn_cvt_pk_f32_fp8((int)c, false), c23 = __builtin_amdgcn_cvt_pk_f32_fp8((int)c, true);
            v[j].x = ALPHA * x.x + w0 * a01[0] + w1 * c01[0]; v[j].y = ALPHA * x.y + w0 * a01[1] + w1 * c01[1];
            v[j].z = ALPHA * x.z + w0 * a23[0] + w1 * c23[0]; v[j].w = ALPHA * x.w + w0 * a23[1] + w1 * c23[1];
        }
        ln_row(v, g, b);
#pragma unroll
        for (int j = 0; j < 4; ++j) ((f32x4*)(F.out + (size_t)row * DM))[lane + 64 * j] = v[j];
        if (l == 0) {
#pragma unroll
            for (int j = 0; j < 4; ++j) ((unsigned*)(F.ws + WS_XB8 + (size_t)row * DM))[lane + 64 * j] = pk4_fp8(v[j].x * 16.f, v[j].y * 16.f, v[j].z * 16.f, v[j].w * 16.f);
        }
    }
}

constexpr float C2D = 0.18033688011112042f;
constexpr float C2M = 0.14724444602590306f;
constexpr float IWS = 0.044194173824159216f;
constexpr float RMS_EPS = 1e-6f;
constexpr int L_QSLOT = L_CTL + 1152;

__device__ __forceinline__ int rope16(int c) { return c < 16 ? (c >> 1) + 8 * (c & 1) : c; }
__device__ __forceinline__ int win_src(int n, float& sc) {
    sc = 1.f;
    if (n < 384) return n;
    if (n < 416) { const int c = n - 384; return 384 + (c >> 1) + 16 * (c & 1); }
    if (n < 512) return -1;
    if (n < 2816) { const int m = n - 512, g = m / 768, r = m % 768, p = r >> 8, hh = (r & 255) >> 6, c = r & 63; if (p == 0) sc = C2D; return 416 + 768 * g + 256 * p + 64 * hh + (p < 2 ? rope16(c) : c); }
    if (n < 3328) { const int m = n - 2816; sc = C2D; return 2720 + (m & ~63) + rope16(m & 63); }
    if (n < 3840) { const int m = n - 3328; return 3360 + (m & ~63) + rope16(m & 63); }
    const int m = n - 3840;
    if (m < 64) return 3232 + rope16(m);
    if (m < 128) return 3296 + (m - 64);
    if (m < 192) return 3872 + rope16(m - 128);
    if (m < 200) { sc = IWS; return 3936 + (m - 192); }
    return -1;
}

__device__ __forceinline__ void sincos_d(double x, double& s, double& c) {
    const double n = __builtin_rint(x * 0.15915494309189535);
    double r = __builtin_fma(-n, 6.2831854820251465, x); r = __builtin_fma(n, 1.7484556025237907e-07, r);
    const double r2 = r * r; double ss = 1.0, cc = 1.0;
#pragma unroll
    for (int k = 15; k >= 1; --k) { ss = 1.0 - r2 * (1.0 / (double)((2 * k) * (2 * k + 1))) * ss; cc = 1.0 - r2 * (1.0 / (double)((2 * k - 1) * (2 * k))) * cc; }
    s = ss * r; c = cc;
}
__device__ __forceinline__ double inv_freq16(int i) {
    const double t[16] = {1.0, 0.44036660267178046, 0.19392274474868576, 0.08539710028576561, 0.03760603093086393, 0.016560440080994446, 0.007292664737217109, 0.003211445994752591,
                          0.001414213562373095, 0.000622772421914596, 0.0002742481756762073, 0.00012076973741146504, 5.318295896944988e-05, 2.341999896140934e-05, 1.031338537721246e-05, 4.5416704806078695e-06};
    double r = t[0];
#pragma unroll
    for (int k = 1; k < 16; ++k) r = (i == k) ? t[k] : r;
    return r;
}

__device__ __forceinline__ void phase_conv_mixer(Frame& F, int l) {
    PHASE_IDS(F);
    LAS float* scr = (LAS float*)(F.lds + F.wave * 16384);
    const int gw = F.vcu * NWAVES + F.wave, NGW = F.G * NWAVES;
    const float* win = F.in[1] + (size_t)l * DM * CIN;
    const float* qg = F.in[2] + (size_t)l * 256; const float* wuq = F.in[3] + (size_t)l * 256 * 768;
    const float* kg = F.in[4] + (size_t)l * 128; const float* wukv = F.in[5] + (size_t)l * 128 * 1024;
    const float* wgate = F.in[6] + (size_t)l * DM * 3072;
    const float* wa = F.in[8] + (size_t)l * 512 * DM; const float* wb = F.in[9] + (size_t)l * 256 * DM; const float* wc = F.in[10] + (size_t)l * 512 * DM; const float* wo = F.in[11] + (size_t)l * DM * DM;
    unsigned char* WIN8 = F.ws + WS_WIN8; bf16_t* WUQ = (bf16_t*)(F.ws + WS_WUQ); bf16_t* WUKV = (bf16_t*)(F.ws + WS_WUKV);
    bf16_t* WA = (bf16_t*)(F.ws + WS_WA); bf16_t* WB = (bf16_t*)(F.ws + WS_WB); bf16_t* WC = (bf16_t*)(F.ws + WS_WC); bf16_t* WO = (bf16_t*)(F.ws + WS_WO);
    constexpr int I_IN = 16 * 128, I_G = 16 * 96, I_UQ = 4 * 24, I_UKV = 4 * 32, I_A = 8 * 32, I_B = 8 * 32, I_C = 8 * 32, I_O = 16 * 32;
    constexpr int NIT = I_IN + I_G + I_UQ + I_UKV + I_A + I_B + I_C + I_O;
    for (int it = gw; it < NIT; it += NGW) {
        int r = it;
        if (r < I_IN) { conv_item8(WIN8, DM, (r / 128) * 64, (r % 128) * 32, scr, F.lane, [&](int k, int n) { float sc; const int sidx = win_src(n, sc); return sidx < 0 ? 0.f : win[(size_t)k * CIN + sidx] * (sc * 1024.f); }); continue; } r -= I_IN;
        if (r < I_G) { conv_plain8(WIN8 + (size_t)PW * DM, DM, (r / 96) * 64, (r % 96) * 32, scr, F.lane, wgate, 3072, 1024.f); continue; } r -= I_G;
        if (r < I_UQ) { conv_item(WUQ, 256, (r / 24) * 64, (r % 24) * 32, scr, F.lane, [&](int k, int n) { const int hh = n / 96, c = n % 96; const int o = c < 64 ? c : 64 + ((c - 64) >> 1) + 16 * ((c - 64) & 1);
                return qg[k] * wuq[(size_t)k * 768 + hh * 96 + o] * C2M; }); continue; } r -= I_UQ;
        if (r < I_UKV) { conv_item(WUKV, 256, (r / 32) * 64, (r % 32) * 32, scr, F.lane, [&](int k, int n) { return k < 128 ? kg[k] * wukv[(size_t)k * 1024 + n] : 0.f; }); continue; } r -= I_UKV;
        if (r < I_A) { conv_plain8((unsigned char*)WA, 512, (r / 32) * 64, (r % 32) * 32, scr, F.lane, wa, DM, 1024.f); continue; } r -= I_A;
        if (r < I_B) { conv_item8((unsigned char*)WB, 512, (r / 32) * 64, (r % 32) * 32, scr, F.lane, [&](int k, int n) { return k < 256 ? wb[(size_t)k * DM + n] * 1024.f : 0.f; }); continue; } r -= I_B;
        if (r < I_C) { conv_plain8((unsigned char*)WC, 512, (r / 32) * 64, (r % 32) * 32, scr, F.lane, wc, DM, 1024.f); continue; } r -= I_C;
        conv_plain8((unsigned char*)WO, DM, (r / 32) * 64, (r % 32) * 32, scr, F.lane, wo, DM, 1024.f);
    }
    if (l == 0) {
        float* rp = (float*)(F.ws + WS_ROPE); float* rm = rp + 2048 * 8 * 2;
        for (int idx = F.vcu * NTHREADS + F.tid; idx < 2048 * 24; idx += F.G * NTHREADS) {
            const int t = idx / 24, j = idx % 24; double sn, cs;
            if (j < 8) { sincos_d((double)t * inv_freq16(2 * j), sn, cs); rp[(t * 8 + j) * 2] = (float)cs; rp[(t * 8 + j) * 2 + 1] = (float)sn; }
            else { sincos_d((double)t * inv_freq16(j - 8), sn, cs); rm[(t * 16 + (j - 8)) * 2] = (float)cs; rm[(t * 16 + (j - 8)) * 2 + 1] = (float)sn; }
        }
        const f32x4* x4 = (const f32x4*)F.in[0]; unsigned* xb8 = (unsigned*)(F.ws + WS_XB8);
        for (size_t i = (size_t)F.vcu * NTHREADS + F.tid; i < (size_t)TT * DM / 4; i += (size_t)F.G * NTHREADS) { const f32x4 v = x4[i] * 16.f; xb8[i] = pk4_fp8(v.x, v.y, v.z, v.w); }
    }
}

__device__ __forceinline__ void rope4(f32x4& v0, f32x4& v1, const float* cs) {
    const f32x4 a = *(const f32x4*)cs, b = *(const f32x4*)(cs + 4);
    const f32x4 w0 = {v0[0] * a[0] - v0[1] * a[1], v0[1] * a[0] + v0[0] * a[1], v0[2] * a[2] - v0[3] * a[3], v0[3] * a[2] + v0[2] * a[3]};
    const f32x4 w1 = {v1[0] * b[0] - v1[1] * b[1], v1[1] * b[0] + v1[0] * b[1], v1[2] * b[2] - v1[3] * b[3], v1[3] * b[2] + v1[2] * b[3]};
    v0 = w0; v1 = w1;
}
__device__ __forceinline__ void store8(bf16_t* p, const f32x4& v0, const f32x4& v1) {
    u32x4 w; w.x = cvt_pk_bf16(v0[0], v0[1]); w.y = cvt_pk_bf16(v0[2], v0[3]); w.z = cvt_pk_bf16(v1[0], v1[1]); w.w = cvt_pk_bf16(v1[2], v1[3]); *(u32x4*)p = w;
}
struct EpiProj {
    bf16_t* P; const float* csp; const float* csm; float* ssq; bf16_t* G3; const LAS float* gbias;
    __device__ __forceinline__ void operator()(const f32x4 (&acc)[2][2][4][2], const pg8::Unit& u, int wr, int wc, int fr, int fq) const {
        const int pn = u.pn, row0 = u.pm * 256 + wr * 64 + fr;
        if (pn >= 16) {
#pragma unroll
            for (int bj = 0; bj < 2; ++bj) { const int col = (pn - 16) * 256 + bj * 128 + wc * 32 + fq * 8;
                const f32x4 b0 = *(const LAS f32x4*)(gbias + col), b1 = *(const LAS f32x4*)(gbias + col + 4);
#pragma unroll
                for (int ai = 0; ai < 2; ++ai)
#pragma unroll
                    for (int m = 0; m < 4; ++m) { f32x4 v0 = acc[ai][bj][m][0] + b0, v1 = acc[ai][bj][m][1] + b1;
#pragma unroll
                        for (int e = 0; e < 4; ++e) { v0[e] = sigmoidf_(v0[e]); v1[e] = sigmoidf_(v1[e]); }
                        store8_fp8((unsigned char*)G3 + (size_t)(row0 + ai * 128 + m * 16) * 3072 + col, v0, v1, 64.f); } }
            return;
        }
#pragma unroll
        for (int bj = 0; bj < 2; ++bj) {
            const int wcu = __builtin_amdgcn_readfirstlane(wc);
            bool ropeP = false, ropeM = false;
            if (pn == 1) ropeM = (bj == 1 && wcu == 0);
            else if (pn >= 2 && pn < 11) ropeP = ((pn - 2) % 3) < 2 && !(wcu & 1);
            else if (pn >= 11 && pn < 15) ropeP = !(wcu & 1);
            else if (pn == 15) ropeP = (wcu == 0);
            const int col = pn * 256 + bj * 128 + wc * 32 + fq * 8;
            if (ropeP || ropeM) {
                const bool lr = ropeM || fq < 2;
                const float* cb = ropeM ? csm + 8 * fq : csp + 8 * (fq & 1);
                const int ts = ropeM ? 32 : 16;
#pragma unroll
                for (int ai = 0; ai < 2; ++ai)
#pragma unroll
                    for (int mh = 0; mh < 2; ++mh) {
                        f32x4 ca[2], cc[2];
#pragma unroll
                        for (int mm = 0; mm < 2; ++mm) { const int t = (row0 + ai * 128 + (2 * mh + mm) * 16) & (SEQ - 1);
                            ca[mm] = *(const f32x4*)(cb + t * ts); cc[mm] = *(const f32x4*)(cb + t * ts + 4); }
#pragma unroll
                        for (int mm = 0; mm < 2; ++mm) { const int m = 2 * mh + mm, row = row0 + ai * 128 + m * 16;
                            const f32x4 v0 = acc[ai][bj][m][0], v1 = acc[ai][bj][m][1];
                            f32x4 a = ca[mm], b = cc[mm];
                            if (!lr) { a = (f32x4){1.f, 0.f, 1.f, 0.f}; b = a; }
                            const f32x4 w0 = {v0[0] * a[0] - v0[1] * a[1], v0[1] * a[0] + v0[0] * a[1], v0[2] * a[2] - v0[3] * a[3], v0[3] * a[2] + v0[2] * a[3]};
                            const f32x4 w1 = {v1[0] * b[0] - v1[1] * b[1], v1[1] * b[0] + v1[0] * b[1], v1[2] * b[2] - v1[3] * b[3], v1[3] * b[2] + v1[2] * b[3]};
                            store8(P + (size_t)row * PW + col, w0, w1); }
                    }
            } else {
#pragma unroll
                for (int ai = 0; ai < 2; ++ai)
#pragma unroll
                    for (int m = 0; m < 4; ++m)
                        store8(P + (size_t)(row0 + ai * 128 + m * 16) * PW + col, acc[ai][bj][m][0], acc[ai][bj][m][1]);
            }
        }
        if (pn < 2) {
#pragma unroll
            for (int ai = 0; ai < 2; ++ai)
#pragma unroll
                for (int m = 0; m < 4; ++m) {
                    float sq = 0.f;
#pragma unroll
                    for (int bj = 0; bj < 2; ++bj) if (pn == 0 || bj == 0) {
#pragma unroll
                        for (int n = 0; n < 2; ++n) { const f32x4 x = acc[ai][bj][m][n]; sq += (x[0] * x[0] + x[1] * x[1]) + (x[2] * x[2] + x[3] * x[3]); } }
                    sq += __shfl_xor(sq, 16); sq += __shfl_xor(sq, 32);
                    if (fq == 0) ssq[(size_t)(row0 + ai * 128 + m * 16) * 8 + pn * 4 + wc] = sq;
                }
        }
    }
};
struct EpiUpQ {
    bf16_t* Q; const float* csm; const float* ssq;
    __device__ __forceinline__ void operator()(const f32x4 (&acc)[2][2][4][2], const pg8::Unit& u, int wr, int wc, int fr, int fq) const {
        const int row0 = u.pm * 256 + wr * 64 + fr;
        f32x4 spv[2][4];
#pragma unroll
        for (int ai = 0; ai < 2; ++ai)
#pragma unroll
            for (int m = 0; m < 4; ++m) spv[ai][m] = *(const f32x4*)(ssq + (size_t)(row0 + ai * 128 + m * 16) * 8);
#pragma unroll
        for (int ai = 0; ai < 2; ++ai)
#pragma unroll
            for (int m = 0; m < 4; ++m) { const f32x4 sp = spv[ai][m];
                spv[ai][m][0] = 1.0f / sqrtf(((sp[0] + sp[1]) + (sp[2] + sp[3])) * (1.f / 256.f) + RMS_EPS); }
        const int wcu = __builtin_amdgcn_readfirstlane(wc);
#pragma unroll
        for (int bj = 0; bj < 2; ++bj) {
            const int c0 = u.pn * 256 + bj * 128 + wcu * 32, col = c0 + fq * 8;
            if (((c0 >> 5) % 3) == 2) {
#pragma unroll
                for (int ai = 0; ai < 2; ++ai)
#pragma unroll
                    for (int mh = 0; mh < 2; ++mh) {
                        f32x4 ca[2], cc[2];
#pragma unroll
                        for (int mm = 0; mm < 2; ++mm) { const int t = (row0 + ai * 128 + (2 * mh + mm) * 16) & (SEQ - 1);
                            ca[mm] = *(const f32x4*)(csm + t * 32 + 8 * fq); cc[mm] = *(const f32x4*)(csm + t * 32 + 8 * fq + 4); }
#pragma unroll
                        for (int mm = 0; mm < 2; ++mm) { const int m = 2 * mh + mm, row = row0 + ai * 128 + m * 16;
                            const float rs = spv[ai][m][0];
                            const f32x4 v0 = acc[ai][bj][m][0] * rs, v1 = acc[ai][bj][m][1] * rs, a = ca[mm], b = cc[mm];
                            const f32x4 w0 = {v0[0] * a[0] - v0[1] * a[1], v0[1] * a[0] + v0[0] * a[1], v0[2] * a[2] - v0[3] * a[3], v0[3] * a[2] + v0[2] * a[3]};
                            const f32x4 w1 = {v1[0] * b[0] - v1[1] * b[1], v1[1] * b[0] + v1[0] * b[1], v1[2] * b[2] - v1[3] * b[3], v1[3] * b[2] + v1[2] * b[3]};
                            store8(Q + (size_t)row * 768 + col, w0, w1); }
                    }
            } else {
#pragma unroll
                for (int ai = 0; ai < 2; ++ai)
#pragma unroll
                    for (int m = 0; m < 4; ++m) { const float rs = spv[ai][m][0];
                        store8(Q + (size_t)(row0 + ai * 128 + m * 16) * 768 + col, acc[ai][bj][m][0] * rs, acc[ai][bj][m][1] * rs); }
            }
        }
    }
};
struct EpiUpKV {
    bf16_t* KV; const float* ssq;
    __device__ __forceinline__ void operator()(const f32x4 (&acc)[2][2][4][2], const pg8::Unit& u, int wr, int wc, int fr, int fq) const {
        const int row0 = u.pm * 256 + wr * 64 + fr;
        f32x4 spv[2][4];
#pragma unroll
        for (int ai = 0; ai < 2; ++ai)
#pragma unroll
            for (int m = 0; m < 4; ++m) spv[ai][m] = *(const f32x4*)(ssq + (size_t)(row0 + ai * 128 + m * 16) * 8 + 4);
#pragma unroll
        for (int ai = 0; ai < 2; ++ai)
#pragma unroll
            for (int m = 0; m < 4; ++m) {
                const int row = row0 + ai * 128 + m * 16;
                const f32x4 sp = spv[ai][m];
                const float rs = 1.0f / sqrtf(((sp[0] + sp[1]) + (sp[2] + sp[3])) * (1.f / 128.f) + RMS_EPS);
#pragma unroll
                for (int bj = 0; bj < 2; ++bj) { const int col = u.pn * 256 + bj * 128 + wc * 32 + fq * 8;
                    store8(KV + (size_t)row * 1024 + col, acc[ai][bj][m][0] * rs, acc[ai][bj][m][1] * rs); }
            }
    }
};
struct EpiBranchAll {
    bf16_t* Mg; bf16_t* M0; bf16_t* M1; const bf16_t* G3;
    __device__ __forceinline__ void operator()(const f32x4 (&acc)[2][2][4][2], const pg8::Unit& u, int wr, int wc, int fr, int fq) const {
        const int row0 = u.pm * 256 + wr * 64 + fr, br = u.ord, col0 = u.pn * 256 + wc * 32 + fq * 8;
        bf16_t* dst = br == 0 ? M0 : (br == 1 ? M1 : Mg);
#pragma unroll
        for (int ai = 0; ai < 2; ++ai)
#pragma unroll
            for (int mh = 0; mh < 2; ++mh) {
                u32x2 gw[2][2]; u32x4 ma[2][2], mb[2][2];
#pragma unroll
                for (int mm = 0; mm < 2; ++mm)
#pragma unroll
                    for (int bj = 0; bj < 2; ++bj) { const int row = row0 + ai * 128 + (2 * mh + mm) * 16, col = col0 + bj * 128;
                        gw[mm][bj] = *(const u32x2*)((const unsigned char*)G3 + (size_t)row * 3072 + br * 1024 + col);
                        ma[mm][bj] = (u32x4){0u, 0u, 0u, 0u}; mb[mm][bj] = (u32x4){0u, 0u, 0u, 0u}; }
                if (br == 2) {
#pragma unroll
                    for (int mm = 0; mm < 2; ++mm)
#pragma unroll
                        for (int bj = 0; bj < 2; ++bj) { const size_t off = (size_t)(row0 + ai * 128 + (2 * mh + mm) * 16) * DM + col0 + bj * 128;
                            const u32x2 p = *(const u32x2*)((const unsigned char*)M0 + off), q = *(const u32x2*)((const unsigned char*)M1 + off);
                            ma[mm][bj] = (u32x4){p.x, p.y, 0u, 0u}; mb[mm][bj] = (u32x4){q.x, q.y, 0u, 0u}; }
                }
#pragma unroll
                for (int mm = 0; mm < 2; ++mm)
#pragma unroll
                    for (int bj = 0; bj < 2; ++bj) { const int m = 2 * mh + mm; const size_t off = (size_t)(row0 + ai * 128 + m * 16) * DM + col0 + bj * 128; const u32x2 g = gw[mm][bj]; const u32x4 a = ma[mm][bj], b2 = mb[mm][bj];
                        const f32x2 g01 = __builtin_amdgcn_cvt_pk_f32_fp8((int)g.x, false) * (1.f / 64.f), g23 = __builtin_amdgcn_cvt_pk_f32_fp8((int)g.x, true) * (1.f / 64.f);
                        const f32x2 g45 = __builtin_amdgcn_cvt_pk_f32_fp8((int)g.y, false) * (1.f / 64.f), g67 = __builtin_amdgcn_cvt_pk_f32_fp8((int)g.y, true) * (1.f / 64.f);
                        f32x4 v0 = acc[ai][bj][m][0], v1 = acc[ai][bj][m][1];
                        const f32x2 s01 = (__builtin_amdgcn_cvt_pk_f32_fp8((int)a.x, false) + __builtin_amdgcn_cvt_pk_f32_fp8((int)b2.x, false)) * (1.f / 64.f), s23 = (__builtin_amdgcn_cvt_pk_f32_fp8((int)a.x, true) + __builtin_amdgcn_cvt_pk_f32_fp8((int)b2.x, true)) * (1.f / 64.f);
                        const f32x2 s45 = (__builtin_amdgcn_cvt_pk_f32_fp8((int)a.y, false) + __builtin_amdgcn_cvt_pk_f32_fp8((int)b2.y, false)) * (1.f / 64.f), s67 = (__builtin_amdgcn_cvt_pk_f32_fp8((int)a.y, true) + __builtin_amdgcn_cvt_pk_f32_fp8((int)b2.y, true)) * (1.f / 64.f);
                        v0[0] = v0[0] * g01[0] + s01[0]; v0[1] = v0[1] * g01[1] + s01[1]; v0[2] = v0[2] * g23[0] + s23[0]; v0[3] = v0[3] * g23[1] + s23[1];
                        v1[0] = v1[0] * g45[0] + s45[0]; v1[1] = v1[1] * g45[1] + s45[1]; v1[2] = v1[2] * g67[0] + s67[0]; v1[3] = v1[3] * g67[1] + s67[1];
                        store8_fp8((unsigned char*)dst + off, v0, v1, 64.f); }
            }
    }
};
struct BranchSched {
    static constexpr bool GATHER = false; static constexpr bool VARK = true;
    const char* A0; const char* B0; size_t sA, sB; int lda, ldb, c, sw8, sa8, G, ntile;
    __device__ __forceinline__ int ktiles(const pg8::Unit& u) const { return u.ord == 1 ? 2 : 4; }
    __device__ __forceinline__ bool next(int i, pg8::Unit& u) const { const int t = c + (i / 3) * G; if (t >= ntile) return false; u.pm = t >> 2; u.pn = t & 3; u.ord = i % 3; return true; }
    __device__ __forceinline__ const char* a_base(const pg8::Unit& u) const { return A0 + (size_t)u.ord * sA + (size_t)u.pm * 256 * lda * 2; }
    __device__ __forceinline__ const char* b_base(const pg8::Unit& u) const { return B0 + (size_t)u.ord * sB + (size_t)u.pn * 256 * ldb * 2; }
    __device__ __forceinline__ void a_off(const pg8::Unit&, const int (&R)[2], const int (&C)[2], unsigned (&v)[2][2]) const {
#pragma unroll
        for (int i = 0; i < 2; ++i) { v[0][i] = (unsigned)(R[i] * lda + C[i]) * 2u; v[1][i] = (unsigned)((128 + R[i]) * lda + C[i]) * 2u; }
    }
};
struct EpiWo {
    float* out; const float* xsrc; int rowbase;
    __device__ __forceinline__ void operator()(const f32x4 (&acc)[2][2][4][2], const pg8::Unit& u, int wr, int wc, int fr, int fq) const {
        const int row0 = rowbase + u.pm * 256 + wr * 64 + fr, col0 = u.pn * 256 + wc * 32 + fq * 8;
#pragma unroll
        for (int ai = 0; ai < 2; ++ai)
#pragma unroll
            for (int mh = 0; mh < 2; ++mh) {
                f32x4 x[2][2][2];
#pragma unroll
                for (int mm = 0; mm < 2; ++mm)
#pragma unroll
                    for (int bj = 0; bj < 2; ++bj) { const size_t off = (size_t)(row0 + ai * 128 + (2 * mh + mm) * 16) * DM + col0 + bj * 128;
                        x[mm][bj][0] = *(const f32x4*)(xsrc + off); x[mm][bj][1] = *(const f32x4*)(xsrc + off + 4); }
#pragma unroll
                for (int mm = 0; mm < 2; ++mm)
#pragma unroll
                    for (int bj = 0; bj < 2; ++bj) { const size_t off = (size_t)(row0 + ai * 128 + (2 * mh + mm) * 16) * DM + col0 + bj * 128;
                        *(f32x4*)(out + off) = x[mm][bj][0] * ALPHA + acc[ai][bj][2 * mh + mm][0]; *(f32x4*)(out + off + 4) = x[mm][bj][1] * ALPHA + acc[ai][bj][2 * mh + mm][1]; }
            }
    }
};

__device__ __forceinline__ int dequeue(Frame& F, unsigned* ctr, int& pre) {
    LAS int* slot = (LAS int*)(F.lds + L_QSLOT);
    __syncthreads();
    if (F.tid == 0) {
        *slot = (int)__hip_atomic_fetch_add(ctr, 1u, __ATOMIC_RELAXED, __HIP_MEMORY_SCOPE_AGENT); (void)pre;
    }
    __syncthreads();
    return *slot;
}

namespace att {
constexpr int KSLOT = 12288, VSLOT = 8192, NSLOT = 4;
constexpr int A_K = 0, A_V = NSLOT * KSLOT, A_WS = A_V + NSLOT * VSLOT, A_OST = A_WS + 8 * 256, A_MW = A_OST + 8 * 4096, A_END = A_MW + 8 * NSLOT * 256;
static_assert(A_END <= RING_BYTES, "attention LDS");
typedef short s16x4 __attribute__((ext_vector_type(4)));
__device__ __forceinline__ int crow(int r, int hi) { return (r & 3) + 8 * (r >> 2) + 4 * hi; }
__device__ __forceinline__ void glds16(const void* gsrc, unsigned lds_dst) { unsigned keep;
    asm volatile("s_mov_b32 %0, m0\n\ts_mov_b32 m0, %2\n\ts_nop 0\n\tglobal_load_lds_dwordx4 %1, off\n\ts_mov_b32 m0, %0" : "=&s"(keep) : "v"(gsrc), "s"(lds_dst) : "memory"); }
__device__ __forceinline__ void glds4(const void* gsrc, unsigned lds_dst) { unsigned keep;
    asm volatile("s_mov_b32 %0, m0\n\ts_mov_b32 m0, %2\n\ts_nop 0\n\tglobal_load_lds_dword %1, off\n\ts_mov_b32 m0, %0" : "=&s"(keep) : "v"(gsrc), "s"(lds_dst) : "memory"); }
#define ATT_WAIT_BAR(N) asm volatile("s_waitcnt vmcnt(" #N ") lgkmcnt(0)\n\ts_barrier" ::: "memory")
__device__ __forceinline__ float emax(float a, float b) { return __builtin_elementwise_maximum(a, b); }
__device__ __forceinline__ float halfmax(float m) { auto rr = __builtin_amdgcn_permlane32_swap(__float_as_uint(m), __float_as_uint(m), false, false); return emax(__uint_as_float(rr[0]), __uint_as_float(rr[1])); }
__device__ __forceinline__ float halfsum(float m) { auto rr = __builtin_amdgcn_permlane32_swap(__float_as_uint(m), __float_as_uint(m), false, false); return __uint_as_float(rr[0]) + __uint_as_float(rr[1]); }
typedef short v4i16_t __attribute__((ext_vector_type(4)));
__device__ __forceinline__ s16x4 vtr(const LAS unsigned char* p) { return __builtin_bit_cast(s16x4, __builtin_amdgcn_ds_read_tr16_b64_v4i16((LAS v4i16_t*)p)); }
__device__ __forceinline__ void pv(f32x16* o, f32x16& lacc, const LAS unsigned char* vp, bf16x8 pa0, bf16x8 pa1, bf16x8 pa2, bf16x8 pa3) {
    { const u32x4 one4 = {0x3F803F80u, 0x3F803F80u, 0x3F803F80u, 0x3F803F80u}; const bf16x8 ones = __builtin_bit_cast(bf16x8, one4);
      lacc = __builtin_amdgcn_mfma_f32_32x32x16_bf16(pa0, ones, lacc, 0, 0, 0); lacc = __builtin_amdgcn_mfma_f32_32x32x16_bf16(pa1, ones, lacc, 0, 0, 0);
      lacc = __builtin_amdgcn_mfma_f32_32x32x16_bf16(pa2, ones, lacc, 0, 0, 0); lacc = __builtin_amdgcn_mfma_f32_32x32x16_bf16(pa3, ones, lacc, 0, 0, 0); }
#pragma unroll
    for (int d0 = 0; d0 < 2; ++d0) { s16x4 lo[4], hi[4];
#pragma unroll
        for (int ks = 0; ks < 4; ++ks) { lo[ks] = vtr(vp + d0 * 4096 + ks * 1024); hi[ks] = vtr(vp + d0 * 4096 + ks * 1024 + 512); }
#define ATT_PK(k) (bf16x8){lo[k][0], lo[k][1], lo[k][2], lo[k][3], hi[k][0], hi[k][1], hi[k][2], hi[k][3]}
        o[d0] = __builtin_amdgcn_mfma_f32_32x32x16_bf16(pa0, ATT_PK(0), o[d0], 0, 0, 0);
        o[d0] = __builtin_amdgcn_mfma_f32_32x32x16_bf16(pa1, ATT_PK(1), o[d0], 0, 0, 0);
        o[d0] = __builtin_amdgcn_mfma_f32_32x32x16_bf16(pa2, ATT_PK(2), o[d0], 0, 0, 0);
        o[d0] = __builtin_amdgcn_mfma_f32_32x32x16_bf16(pa3, ATT_PK(3), o[d0], 0, 0, 0);
#undef ATT_PK
    }
}
struct Desc {
    const bf16_t* Q; const bf16_t* K1; const bf16_t* K2; const bf16_t* V; bf16_t* O; float* lse; const unsigned* mask;
    int qpitch, k1pitch, k2pitch, vpitch, opitch, lsepitch;
    int rstride, q0, nq, jlo, jhi;
    int o8;
};
template <int DQK, int MODE>
__device__ __forceinline__ void attn_unit(LAS unsigned char* lds, const Desc& d) {
    int tid_ = threadIdx.x; asm volatile("" : "+v"(tid_));
    const int tid = tid_, lane = tid & 63, r32 = lane & 31, hi = lane >> 5, wid = __builtin_amdgcn_readfirstlane(tid >> 6);
    constexpr int ND = DQK / 16;
    const unsigned lds0 = (unsigned)(size_t)lds;
    LAS float* wsf = (LAS float*)(lds + A_WS) + wid * 64;
    const int qw = d.q0 + wid * 32;
    const bool wvalid = wid * 32 < d.nq;
    const int kkey = 8 * wid + (lane >> 3), kch = (lane & 7) ^ ((kkey >> 1) & 7);
    const bf16_t* ksrc = d.K1 + (size_t)kkey * d.rstride * d.k1pitch + kch * 8;
    const int k2key = 16 * (wid & 3) + (lane >> 2), k2ch = (lane & 3) ^ ((k2key >> 2) & 3);
    const bf16_t* k2src = (DQK == 96) ? d.K2 + (size_t)k2key * d.rstride * d.k2pitch + k2ch * 8 : nullptr;
    int kofs[ND];
#pragma unroll
    for (int d0 = 0; d0 < ND; ++d0) kofs[d0] = d0 < 4 ? r32 * 128 + (((2 * d0 + hi) ^ ((r32 >> 1) & 7)) * 16) : 8192 + r32 * 64 + (((2 * (d0 - 4) + hi) ^ ((r32 >> 2) & 3)) * 16);
    const bf16_t* vsrc = d.V + (size_t)(16 * (wid & 3) + (lane >> 2)) * d.rstride * d.vpitch + (wid >> 2) * 32 + (lane & 3) * 8;
    const size_t kstep = (size_t)64 * d.rstride * d.k1pitch, k2step = (size_t)64 * d.rstride * d.k2pitch, vstep = (size_t)64 * d.rstride * d.vpitch;
    const bool two = (DQK == 96) && wid < 4;
    const unsigned* msrc = (MODE == 2) ? d.mask + (size_t)(wvalid ? (qw + (lane >> 1)) : d.q0) * 64 + (lane & 1) : nullptr;
#define ATT_ISSUE(j) do { const int sl_ = (j) % NSLOT; \
        glds16(ksrc + (size_t)(j) * kstep, (unsigned)__builtin_amdgcn_readfirstlane(lds0 + A_K + sl_ * KSLOT + wid * 1024)); \
        if (two) glds16(k2src + (size_t)(j) * k2step, (unsigned)__builtin_amdgcn_readfirstlane(lds0 + A_K + sl_ * KSLOT + (8 + wid) * 1024)); \
        glds16(vsrc + (size_t)(j) * vstep, (unsigned)__builtin_amdgcn_readfirstlane(lds0 + A_V + sl_ * VSLOT + wid * 1024)); \
        if (MODE == 2) glds4(msrc + 2 * (j), (unsigned)__builtin_amdgcn_readfirstlane(lds0 + A_MW + (wid * NSLOT + sl_) * 256)); } while (0)
    ATT_ISSUE(d.jlo);
    if (d.jlo + 1 < d.jhi) ATT_ISSUE(d.jlo + 1);
    bf16x8 qr[ND];
    { const int qi = wvalid ? (qw + r32) : d.q0; const bf16_t* qp = d.Q + (size_t)qi * d.rstride * d.qpitch + hi * 8;
#pragma unroll
      for (int d0 = 0; d0 < ND; ++d0) qr[d0] = *(const bf16x8*)(qp + d0 * 16); }
#pragma unroll
    for (int d0 = 0; d0 < ND; ++d0) asm volatile("" : "+v"(qr[d0]));
    float mhat = 0.f; f32x16 o[2]; o[0] = f32x16{}; o[1] = f32x16{}; f32x16 lacc = f32x16{};
    bool started = false;
    const LAS unsigned char* vp0 = lds + A_V + ((lane >> 4) & 1) * 32 + (lane & 3) * 8 + (4 * hi + ((lane & 15) >> 2)) * 64;
    const int qi = qw + r32;
    f32x16 p0 = f32x16{}, p1 = f32x16{};
    f32x16 negm = f32x16{};
#define ATT_REL(j) (wvalid && (64 * (j) <= qw + 31) && (MODE != 1 || (64 * (j) + 63 >= qw - 128)))
#define ATT_QK(j) do { const int sl_ = (j) % NSLOT; \
        const LAS unsigned char* kb = lds + A_K + sl_ * KSLOT; bf16x8 kf[2 * ND]; \
        _Pragma("unroll") for (int d0 = 0; d0 < ND; ++d0) { kf[2 * d0] = *(const LAS bf16x8*)(kb + kofs[d0]); kf[2 * d0 + 1] = *(const LAS bf16x8*)(kb + kofs[d0] + (d0 < 4 ? 4096 : 2048)); } \
        __builtin_amdgcn_sched_barrier(0); \
        _Pragma("unroll") for (int d0 = 0; d0 < ND; ++d0) { \
            if (d0 == 0) { p0 = __builtin_amdgcn_mfma_f32_32x32x16_bf16(kf[0], qr[0], negm, 0, 0, 0); p1 = __builtin_amdgcn_mfma_f32_32x32x16_bf16(kf[1], qr[0], negm, 0, 0, 0); } \
            else { p0 = __builtin_amdgcn_mfma_f32_32x32x16_bf16(kf[2 * d0], qr[d0], p0, 0, 0, 0); p1 = __builtin_amdgcn_mfma_f32_32x32x16_bf16(kf[2 * d0 + 1], qr[d0], p1, 0, 0, 0); } } } while (0)
#define ATT_SMPV(j) do { const int sl_ = (j) % NSLOT; \
        { bool domask = true; unsigned mx_ = 0u, my_ = 0u;        \
          if (MODE == 2) { const u32x2 mw = *(const LAS u32x2*)(lds + A_MW + (wid * NSLOT + sl_) * 256 + r32 * 8); mx_ = mw.x; my_ = mw.y; } \
          else { \
            bool full = (64 * (j) + 63 <= qw); \
            if (MODE == 1) full = full && (64 * (j) >= qw + 31 - 128); \
            domask = !full; \
            if (domask) { const int a_ = qi - 64 * (j), lo_ = (MODE == 1) ? a_ - 128 : -4096;        \
                { const int h_ = a_ < 31 ? a_ : 31, l_ = lo_ > 0 ? lo_ : 0; mx_ = (h_ < l_) ? 0u : ((0xFFFFFFFFu >> (31 - h_)) & (0xFFFFFFFFu << l_)); } \
                { const int h_ = a_ - 32 < 31 ? a_ - 32 : 31, l_ = lo_ - 32 > 0 ? lo_ - 32 : 0; my_ = (h_ < l_) ? 0u : ((0xFFFFFFFFu >> (31 - h_)) & (0xFFFFFFFFu << l_)); } } \
          } \
          if (domask) { const unsigned w0 = mx_ >> (4 * hi), w1 = my_ >> (4 * hi); \
            _Pragma("unroll") for (int r = 0; r < 16; ++r) { const int bit = (r & 3) + 8 * (r >> 2); \
                const unsigned m0 = (unsigned)__builtin_amdgcn_sbfe((int)w0, bit, 1), m1 = (unsigned)__builtin_amdgcn_sbfe((int)w1, bit, 1);        \
                p0[r] = __uint_as_float((m0 & __float_as_uint(p0[r])) | (~m0 & 0xFF800000u)); p1[r] = __uint_as_float((m1 & __float_as_uint(p1[r])) | (~m1 & 0xFF800000u)); } } } \
        float rm = emax(p0[0], p1[0]), rm2 = emax(p0[1], p1[1]); \
        _Pragma("unroll") for (int r = 2; r < 16; r += 2) { rm = emax(emax(rm, p0[r]), p1[r]); rm2 = emax(emax(rm2, p0[r + 1]), p1[r + 1]); } \
        rm = halfmax(emax(rm, rm2)); \
        bool need; float dl; \
        if (!started) { need = true; dl = emax(rm, -200.f); } else { need = __any(rm > 8.f) != 0; dl = emax(rm, 0.f); } \
        if (need) { mhat += dl; \
            _Pragma("unroll") for (int r = 0; r < 16; ++r) negm[r] = -mhat; \
            _Pragma("unroll") for (int r = 0; r < 16; ++r) { p0[r] -= dl; p1[r] -= dl; } \
            if (started) { const float f = __builtin_amdgcn_exp2f(-dl); \
                if (hi == 0) wsf[r32] = f; \
                LDS_WAIT(); \
                _Pragma("unroll") for (int r = 0; r < 16; ++r) { const float fr_ = wsf[crow(r, hi)]; o[0][r] *= fr_; o[1][r] *= fr_; lacc[r] *= fr_; } } } \
        started = true; \
        __builtin_amdgcn_s_setprio(1);        \
        _Pragma("unroll") for (int r = 0; r < 16; ++r) { p0[r] = __builtin_amdgcn_exp2f(p0[r]); p1[r] = __builtin_amdgcn_exp2f(p1[r]); } \
        const u32x4 pw0 = (u32x4){cvt_pk_bf16(p0[0], p0[1]), cvt_pk_bf16(p0[2], p0[3]), cvt_pk_bf16(p0[4], p0[5]), cvt_pk_bf16(p0[6], p0[7])}; \
        const u32x4 pw1 = (u32x4){cvt_pk_bf16(p0[8], p0[9]), cvt_pk_bf16(p0[10], p0[11]), cvt_pk_bf16(p0[12], p0[13]), cvt_pk_bf16(p0[14], p0[15])}; \
        const u32x4 pw2 = (u32x4){cvt_pk_bf16(p1[0], p1[1]), cvt_pk_bf16(p1[2], p1[3]), cvt_pk_bf16(p1[4], p1[5]), cvt_pk_bf16(p1[6], p1[7])}; \
        const u32x4 pw3 = (u32x4){cvt_pk_bf16(p1[8], p1[9]), cvt_pk_bf16(p1[10], p1[11]), cvt_pk_bf16(p1[12], p1[13]), cvt_pk_bf16(p1[14], p1[15])}; \
        pv(o, lacc, vp0 + sl_ * VSLOT, __builtin_bit_cast(bf16x8, pw0), __builtin_bit_cast(bf16x8, pw1), __builtin_bit_cast(bf16x8, pw2), __builtin_bit_cast(bf16x8, pw3)); \
        __builtin_amdgcn_s_setprio(0); } while (0)
#define ATT_TOPWAIT(j) do { if ((j) + 1 < d.jhi) { if (MODE == 2 || two) { ATT_WAIT_BAR(3); } else { ATT_WAIT_BAR(2); } } else { ATT_WAIT_BAR(0); } } while (0)
    if (wid < 4) {
        for (int j = d.jlo; j < d.jhi; ++j) {
            ATT_TOPWAIT(j);
            if (j + 2 < d.jhi) ATT_ISSUE(j + 2);
            if (ATT_REL(j)) { ATT_QK(j); ATT_SMPV(j); }
        }
        asm volatile("s_waitcnt lgkmcnt(0)\n\ts_barrier" ::: "memory");
    } else {
        ATT_TOPWAIT(d.jlo);
        if (d.jlo + 2 < d.jhi) ATT_ISSUE(d.jlo + 2);
        if (ATT_REL(d.jlo)) ATT_QK(d.jlo);
        for (int j = d.jlo + 1; j < d.jhi; ++j) {
            ATT_TOPWAIT(j);
            if (j + 2 < d.jhi) ATT_ISSUE(j + 2);
            if (ATT_REL(j - 1)) ATT_SMPV(j - 1);
            if (ATT_REL(j)) ATT_QK(j);
        }
        asm volatile("s_waitcnt lgkmcnt(0)\n\ts_barrier" ::: "memory");
        if (ATT_REL(d.jhi - 1)) ATT_SMPV(d.jhi - 1);
    }
#undef ATT_REL
#undef ATT_QK
#undef ATT_SMPV
#undef ATT_TOPWAIT
#undef ATT_ISSUE
    if (wvalid) {
        LAS bf16_t* stg = (LAS bf16_t*)(lds + A_OST) + wid * 2048;
        if (d.lse != nullptr && r32 == 0) {
#pragma unroll
            for (int r = 0; r < 16; ++r) wsf[32 + crow(r, hi)] = lacc[r]; }
        if (d.o8) {
            LAS unsigned char* stg8 = (LAS unsigned char*)stg;
#pragma unroll
            for (int r = 0; r < 16; ++r) { const int orow = crow(r, hi); const float rl = __builtin_amdgcn_rcpf(lacc[r]) * 32.f;
                const unsigned p = (unsigned)__builtin_amdgcn_cvt_pk_fp8_f32(o[0][r] * rl, o[1][r] * rl, 0, false);
                stg8[orow * 64 + r32] = (unsigned char)(p & 0xffu); stg8[orow * 64 + 32 + r32] = (unsigned char)((p >> 8) & 0xffu); }
            LDS_WAIT();
#pragma unroll
            for (int i = 0; i < 2; ++i) { const int row = i * 16 + (lane >> 2), ch = lane & 3; const u32x4 v = *(const LAS u32x4*)(stg8 + row * 64 + ch * 16);
                *(u32x4*)((unsigned char*)d.O + (size_t)(qw + row) * d.rstride * d.opitch + ch * 16) = v; }
        } else {
#pragma unroll
        for (int r = 0; r < 16; ++r) { const int orow = crow(r, hi); const float rl = __builtin_amdgcn_rcpf(lacc[r]);
            stg[orow * 64 + r32] = (bf16_t)f2bf(o[0][r] * rl); stg[orow * 64 + 32 + r32] = (bf16_t)f2bf(o[1][r] * rl); }
        LDS_WAIT();
#pragma unroll
        for (int i = 0; i < 4; ++i) { const int row = i * 8 + (lane >> 3), ch = lane & 7; const u32x4 v = *(const LAS u32x4*)(stg + row * 64 + ch * 8);
            *(u32x4*)(d.O + (size_t)(qw + row) * d.rstride * d.opitch + ch * 8) = v; }
        }
        if (d.lse != nullptr && hi == 0) d.lse[(size_t)(qw + r32) * d.rstride * d.lsepitch] = mhat + __builtin_amdgcn_logf(wsf[32 + r32]);
    }
    asm volatile("s_waitcnt lgkmcnt(0)\n\ts_barrier" ::: "memory");
}
}

namespace idx {
constexpr int KS = 8192, I_K = 0, I_ST = 3 * KS, I_END = I_ST + 8 * 8192;
static_assert(I_END <= RING_BYTES, "indexer LDS");
__device__ __forceinline__ void score_unit(LAS unsigned char* lds, const bf16_t* PROJ, float* SC, int b, int qh  , int jg) {
    int tid_ = threadIdx.x; asm volatile("" : "+v"(tid_));
    const int tid = tid_, lane = tid & 63, r32 = lane & 31, hi = lane >> 5, wid = __builtin_amdgcn_readfirstlane(tid >> 6);
    const int qg = wid >> 1, hh = wid & 1;
    const unsigned lds0 = (unsigned)(size_t)lds;
    const int qrow = b * SEQ + qh * 128 + qg * 32 + r32;
    const bf16_t* kbase = PROJ + (size_t)(b * SEQ) * PW + 3968;
    const int kkey = 8 * wid + (lane >> 3);
    const bf16_t* ksrc = kbase + (size_t)kkey * PW + ((lane & 7) ^ ((kkey >> 1) & 7)) * 8;
    const int j0 = 4 * jg;
#define IDX_ISSUE(j) att::glds16(ksrc + (size_t)(j) * 64 * PW, (unsigned)__builtin_amdgcn_readfirstlane(lds0 + I_K + ((j) % 3) * KS + wid * 1024))
    IDX_ISSUE(j0); IDX_ISSUE(j0 + 1);
    bf16x8 qf[4][4]; float wv[4];
    { const bf16_t* qp = PROJ + (size_t)qrow * PW + 3328 + hh * 256 + hi * 8;
#pragma unroll
      for (int h = 0; h < 4; ++h)
#pragma unroll
          for (int d0 = 0; d0 < 4; ++d0) qf[h][d0] = *(const bf16x8*)(qp + h * 64 + d0 * 16);
      const u32x2 ww = *(const u32x2*)(PROJ + (size_t)qrow * PW + 4032 + hh * 4);
      wv[0] = bflo(ww.x); wv[1] = bfhi(ww.x); wv[2] = bflo(ww.y); wv[3] = bfhi(ww.y); }
#pragma unroll
    for (int h = 0; h < 4; ++h) { asm volatile("" : "+v"(wv[h]));
#pragma unroll
        for (int d0 = 0; d0 < 4; ++d0) asm volatile("" : "+v"(qf[h][d0])); }
    const int qb = qh >> 1;
    unsigned* blk = (unsigned*)SC + ((size_t)b * 36 + (size_t)(qb * (qb + 1) / 2)) * 32768; const int pitch = 128 * (qb + 1);
    f32x4 ve[4] = {};
    LAS unsigned char* stg = lds + I_ST + wid * 8192;
    const LAS unsigned char* stg2 = lds + I_ST + (wid ^ 1) * 8192;
#pragma nounroll
    for (int jj = 0; jj < 4; ++jj) { const int j = j0 + jj;
        if (jj < 2) { ATT_WAIT_BAR(1); } else if (jj == 2) { ATT_WAIT_BAR(5); } else { ATT_WAIT_BAR(4); }
        if (jj + 2 < 4) IDX_ISSUE(j + 2);
        const LAS unsigned char* kb = lds + I_K + (j % 3) * KS + r32 * 128;
#pragma nounroll
        for (int half = 0; half < 2; ++half) {
            bf16x8 kf[4];
#pragma unroll
            for (int d0 = 0; d0 < 4; ++d0) kf[d0] = *(const LAS bf16x8*)(kb + half * 4096 + (((2 * d0 + hi) ^ ((r32 >> 1) & 7)) * 16));
            f32x16 t0 = f32x16{};
#pragma unroll
            for (int h = 0; h < 4; ++h) {
                f32x16 p0 = f32x16{};
#pragma unroll
                for (int d0 = 0; d0 < 4; ++d0) p0 = __builtin_amdgcn_mfma_f32_32x32x16_bf16(kf[d0], qf[h][d0], p0, 0, 0, 0);
#pragma unroll
                for (int r = 0; r < 16; ++r) t0[r] += wv[h] * att::emax(p0[r], 0.f);
            }
#pragma unroll
            for (int g = 0; g < 4; ++g) { const int c0 = 8 * half + 2 * g + hi;
                *(LAS f32x4*)(stg + r32 * 256 + ((c0 ^ (r32 & 15)) * 16)) = (f32x4){t0[4 * g], t0[4 * g + 1], t0[4 * g + 2], t0[4 * g + 3]}; }
        }
        asm volatile("s_waitcnt lgkmcnt(0)\n\ts_barrier" ::: "memory");
#pragma unroll
        for (int i = 0; i < 4; ++i) { const int q = hh * 16 + i * 4 + (lane >> 4), c = lane & 15; const int so = q * 256 + ((c ^ (q & 15)) * 16);
            const f32x4 v = *(const LAS f32x4*)(stg + so) + *(const LAS f32x4*)(stg2 + so);
            if (jj & 1) { const f32x4 e = ve[i]; const u32x4 w = {pk2(e[0], v[0]), pk2(e[1], v[1]), pk2(e[2], v[2]), pk2(e[3], v[3])};
                *(u32x4*)(blk + (size_t)((qh & 1) * 128 + qg * 32 + q) * pitch + 64 * (j >> 1) + 4 * c) = w; }
            else ve[i] = v; }
        LDS_WAIT();
    }
#undef IDX_ISSUE
    asm volatile("s_waitcnt lgkmcnt(0)\n\ts_barrier" ::: "memory");
}

__device__ __forceinline__ int wave_sum_i(int v) {
    v += __builtin_amdgcn_update_dpp(0, v, 0xB1, 0xF, 0xF, true);
    v += __builtin_amdgcn_update_dpp(0, v, 0x4E, 0xF, 0xF, true);
    v += __builtin_amdgcn_update_dpp(0, v, 0x141, 0xF, 0xF, true);
    v += __builtin_amdgcn_update_dpp(0, v, 0x140, 0xF, 0xF, true);
    return __builtin_amdgcn_readlane(v, 0) + __builtin_amdgcn_readlane(v, 16) + __builtin_amdgcn_readlane(v, 32) + __builtin_amdgcn_readlane(v, 48);
}
__device__ __forceinline__ unsigned long long keep_low(unsigned long long m, int k) { while (__builtin_popcountll(m) > k) m &= ~(1ull << (63 - __builtin_clzll(m))); return m; }
__device__ __forceinline__ void select_rows4(const float* SC, unsigned* MASK, int row0  , int lane, LAS unsigned* slot  ) {
    const int b = row0 / SEQ, t0 = row0 % SEQ, qb = t0 >> 8;
    if (t0 < 256) {
#pragma unroll 1
        for (int i = 0; i < 4; ++i) { const int t = t0 + i, lo = 64 * lane;
            const unsigned long long w = (lo + 63 <= t) ? ~0ull : (lo > t ? 0ull : ((2ull << (t - lo)) - 1ull));
            if (lane < 32) ((unsigned long long*)(MASK + (size_t)(row0 + i) * 64))[lane] = w; }
        return;
    }
    const int pitch = 128 * (qb + 1), pmax = pitch - 1;
    const unsigned* srow0 = (const unsigned*)SC + ((size_t)b * 36 + (size_t)(qb * (qb + 1) / 2)) * 32768 + (size_t)(t0 - 256 * qb) * pitch;
    unsigned raw[16];
#pragma unroll
    for (int i = 0; i < 16; ++i) { const int s_ = 64 * i + lane; raw[i] = srow0[s_ < pmax ? s_ : pmax]; }
#pragma unroll 1
    for (int r = 0; r < 4; ++r) {
        const int t = t0 + r;
        unsigned P[16];
#pragma unroll
        for (int i = 0; i < 16; ++i) P[i] = raw[i];
        { const unsigned* nx = srow0 + (size_t)(r < 3 ? r + 1 : 3) * pitch;
#pragma unroll
          for (int i = 0; i < 16; ++i) { const int s_ = 64 * i + lane; raw[i] = nx[s_ < pmax ? s_ : pmax]; } }
#define SEL_TSTAGE(sh, m) _Pragma("unroll") for (int q = 0; q < 16; ++q) if (!(q & (sh))) { const unsigned a_ = P[q], b_ = P[q + (sh)]; \
            P[q] = (a_ & (m)) | ((b_ << (sh)) & ~(m)); P[q + (sh)] = ((a_ >> (sh)) & (m)) | (b_ & ~(m)); }
        SEL_TSTAGE(8, 0x00FF00FFu) SEL_TSTAGE(4, 0x0F0F0F0Fu) SEL_TSTAGE(2, 0x33333333u) SEL_TSTAGE(1, 0x55555555u)
#undef SEL_TSTAGE
        { const unsigned sg = P[15];
#pragma unroll
          for (int q = 0; q < 15; ++q) P[q] ^= sg;
          P[15] = ~sg; }
        const int nj = ((t - lane) >> 6) + 1;
        unsigned A = ((1u << ((nj + 1) >> 1)) - 1u) | (((1u << (nj >> 1)) - 1u) << 16), G = 0u;
        int cab = 0, cntA = t + 1;
#pragma unroll
        for (int bit = 15; bit >= 0; --bit) {
            if (cab + cntA != 256) {
                const unsigned ones = A & P[bit];
                const int c = wave_sum_i(__builtin_popcount(ones));
                if (cab + c >= 256) { A = ones; cntA = c; } else { G |= ones; cab += c; A &= ~ones; cntA -= c; }
            }
        }
        int need = 256 - cab;
        unsigned sel = G | A;
        if (cntA != need) {
            unsigned selA = 0u;
#pragma nounroll
            for (int j = 0; j < 32; ++j) { const int pb = (j >> 1) + 16 * (j & 1);
                unsigned long long m = __ballot((A >> pb) & 1u);
                if (__builtin_popcountll(m) > need) m = keep_low(m, need);
                need -= __builtin_popcountll(m);
                selA |= (unsigned)((m >> lane) & 1ull) << pb;
            }
            sel = G | selA;
        }
        int lo = 0, hi = 0;
#pragma unroll
        for (int j = 0; j < 32; ++j) { const unsigned long long m = __ballot((sel >> ((j >> 1) + 16 * (j & 1))) & 1u);
            lo = (lane == j) ? (int)(unsigned)m : lo; hi = (lane == j) ? (int)(unsigned)(m >> 32) : hi; }
        if (lane < 32) ((unsigned long long*)(MASK + (size_t)(row0 + r) * 64))[lane] = (unsigned long long)(unsigned)lo | ((unsigned long long)(unsigned)hi << 32);
    }
}
}

__device__ __forceinline__ unsigned* queue_word(Frame& F, int l, int chunk, int q) { return (unsigned*)(F.ws + WS_CTL) + CW_QUEUE + 64 * ((l * NCHUNK + chunk) * 4 + q); }

__device__ __forceinline__ void phase_proj(Frame& F, int l, int chunk) {
    PHASE_IDS(F);
    { LAS float* gb = (LAS float*)(F.lds + L_GB); const float* bg = F.in[7] + (size_t)l * 3072;
      __syncthreads();
      for (int i = F.tid; i < 3072; i += NTHREADS) gb[i] = bg[i];
      VM_WAIT(); LDS_WAIT(); __syncthreads(); }
    pg8::ProjSched8 S{{{(const bf16_t*)(F.ws + WS_XB8 + (size_t)chunk * TC * DM), (const bf16_t*)(F.ws + WS_WIN8), DM / 2, DM / 2, TC / 256, (PW + 3072) / 256, F.G, (int)blockIdx.x}, F8_SW, F8_SA_X}};
    const float* rp = (const float*)(F.ws + WS_ROPE);
    EpiProj E{(bf16_t*)(F.ws + WS_PROJ), rp, rp + 2048 * 8 * 2, (float*)(F.ws + WS_SSQ), (bf16_t*)(F.ws + WS_G3), (const LAS float*)(F.lds + L_GB)};
    pg8::gemm_phase<EpiProj, pg8::ProjSched8, true, true>(F.lds, DM / 2, S, E);
}
__device__ __forceinline__ void dilated_unit(Frame& F, int u) {
    const bf16_t* PROJ = (const bf16_t*)(F.ws + WS_PROJ); bf16_t* OG = (bf16_t*)(F.ws + WS_OG); float* LSE = (float*)(F.ws + WS_LSE);
    constexpr int N_G0 = NBC * 4 * 8, N_G1 = NBC * 4 * 4 * 2;
    int g, b, h, res, qb, dil, nq;
    if (u < N_G0) { g = 0; dil = 1; qb = 7 - u / (NBC * 4); const int bh = u % (NBC * 4); b = bh >> 2; h = bh & 3; res = 0; nq = 256; }
    else if (u < N_G0 + N_G1) { const int v = u - N_G0; g = 1; dil = 4; qb = 1 - v / (NBC * 16); const int x = v % (NBC * 16); b = x >> 4; h = (x >> 2) & 3; res = x & 3; nq = 256; }
    else { const int v = u - N_G0 - N_G1; g = 2; dil = 16; qb = 0; b = v >> 6; h = (v >> 4) & 3; res = v & 15; nq = 128; }
    att::Desc d; const size_t r0 = (size_t)b * SEQ + res;
    const bf16_t* base = PROJ + r0 * PW + 512 + 768 * g + 64 * h;
    d.Q = base; d.K1 = base + 256; d.V = base + 512; d.K2 = nullptr; d.qpitch = d.k1pitch = d.vpitch = PW; d.k2pitch = 0;
    d.O = OG + ((size_t)g * TC + r0) * 256 + 64 * h; d.opitch = 256; d.lse = LSE + ((size_t)g * TC + r0) * 4 + h; d.lsepitch = 4; d.mask = nullptr;
    d.rstride = dil; d.q0 = qb * 256; d.nq = nq; d.o8 = 0;
    if (g == 2) { d.jlo = 0; d.jhi = 2; att::attn_unit<64, 0>(F.lds, d); }
    else { d.jlo = (qb * 4 - 2) > 0 ? (qb * 4 - 2) : 0; d.jhi = 4 * (qb + 1); att::attn_unit<64, 1>(F.lds, d); }
}

struct UpSched {
    static constexpr bool GATHER = false;
    const char* A; const char* B; size_t sB; int lda, ldb, nM, G, c;
    __device__ __forceinline__ bool next(int i, pg8::Unit& u) const { const int v = i * G + c; if (v >= nM * 7) return false; u.pm = v / 7; u.pn = v % 7; u.ord = i; return true; }
    __device__ __forceinline__ const char* a_base(const pg8::Unit& u) const { return A + ((size_t)u.pm * 256 * lda + (u.pn >= 3 ? 256 : 0)) * 2; }
    __device__ __forceinline__ const char* b_base(const pg8::Unit& u) const { return B + (u.pn >= 3 ? sB + (size_t)(u.pn - 3) * 256 * ldb * 2 : (size_t)u.pn * 256 * ldb * 2); }
    __device__ __forceinline__ void a_off(const pg8::Unit&, const int (&R)[2], const int (&C)[2], unsigned (&v)[2][2]) const {
#pragma unroll
        for (int i = 0; i < 2; ++i) { v[0][i] = (unsigned)(R[i] * lda + C[i]) * 2u; v[1][i] = (unsigned)((128 + R[i]) * lda + C[i]) * 2u; }
    }
};
struct EpiUp {
    EpiUpQ q; EpiUpKV kv;
    __device__ __forceinline__ void operator()(const f32x4 (&acc)[2][2][4][2], const pg8::Unit& u, int wr, int wc, int fr, int fq) const {
        if (u.pn < 3) q(acc, u, wr, wc, fr, fq);
        else { pg8::Unit u2 = u; u2.pn = u.pn - 3; kv(acc, u2, wr, wc, fr, fq); }
    }
};
__device__ __forceinline__ void phase_up_scores(Frame& F, int l, int chunk) {
    PHASE_IDS(F);
    const bf16_t* PROJ = (const bf16_t*)(F.ws + WS_PROJ);
    const float* rp = (const float*)(F.ws + WS_ROPE);
    {   UpSched S{(const char*)PROJ, (const char*)(F.ws + WS_WUQ), WS_WUKV - WS_WUQ, PW, 256, TC / 256, F.G, (int)blockIdx.x};
        EpiUp E{{(bf16_t*)(F.ws + WS_QM), rp + 2048 * 8 * 2, (const float*)(F.ws + WS_SSQ)}, {(bf16_t*)(F.ws + WS_KVM), (const float*)(F.ws + WS_SSQ)}};
        pg8::gemm_phase<EpiUp, UpSched, true>(F.lds, 256, S, E); }
    unsigned* qw = queue_word(F, l, chunk, 0); int pre = -1;
    for (;;) {
        const int u = dequeue(F, qw, pre);
        if (u < NBC * 64) { dilated_unit(F, u); continue; }
        if (u >= NBC * 64 + NBC * 72 + NBC * 64) break;
        if (u >= NBC * 64 + NBC * 72) { dilated_unit(F, u - NBC * 72); continue; }
        const int v = u - NBC * 64; const int b = v / 72; int r = v % 72, qh = 0; while (r > (qh >> 1)) { r -= (qh >> 1) + 1; ++qh; }
        idx::score_unit(F.lds, PROJ, (float*)(F.ws + WS_SC), b, qh, r);
    }
}
__device__ __forceinline__ void phase_attn1(Frame& F, int l, int chunk, int tmask = 7) {
    PHASE_IDS(F);
    const bf16_t* PROJ = (const bf16_t*)(F.ws + WS_PROJ); const bf16_t* QM = (const bf16_t*)(F.ws + WS_QM); const bf16_t* KVM = (const bf16_t*)(F.ws + WS_KVM);
    bf16_t* OA = (bf16_t*)(F.ws + WS_OA); bf16_t* OG = (bf16_t*)(F.ws + WS_OG); float* LSE = (float*)(F.ws + WS_LSE);
    constexpr int N_MLA = NBC * 8 * 8, N_SEL = TC / 32;
    unsigned* qw = queue_word(F, l, chunk, 1); int pre = -1;
    for (;;) {
        int u = dequeue(F, qw, pre);
        if (u < N_MLA) {
            if (!(tmask & 1)) continue;
            const int qb = 7 - u / (NBC * 8), bh = u % (NBC * 8), b = bh >> 3, h = bh & 7;
            att::Desc d; const size_t r0 = (size_t)b * SEQ;
            d.Q = QM + r0 * 768 + h * 96; d.qpitch = 768; d.K1 = KVM + r0 * 1024 + h * 128; d.k1pitch = 1024; d.K2 = PROJ + r0 * PW + 384; d.k2pitch = PW;
            d.V = KVM + r0 * 1024 + h * 128 + 64; d.vpitch = 1024; d.O = (bf16_t*)((unsigned char*)OA + r0 * 512 + h * 64); d.opitch = 512; d.o8 = 1; d.lse = nullptr; d.lsepitch = 0; d.mask = nullptr;
            d.rstride = 1; d.q0 = qb * 256; d.nq = 256; d.jlo = 0; d.jhi = 4 * (qb + 1);
            att::attn_unit<96, 0>(F.lds, d); continue; }
        u -= N_MLA;
        if (u >= N_SEL) break;
        if (!(tmask & 4)) continue;
        idx::select_rows4((const float*)(F.ws + WS_SC), (unsigned*)(F.ws + WS_MASK), u * 32 + F.wave * 4, F.lane, (LAS unsigned*)(F.lds + L_GB) + F.wave * 64);
    }
}
__device__ __forceinline__ void phase_attn2(Frame& F, int l, int chunk) {
    PHASE_IDS(F);
    const bf16_t* PROJ = (const bf16_t*)(F.ws + WS_PROJ);
    bf16_t* OC = (bf16_t*)(F.ws + WS_OC);
    unsigned* qw = queue_word(F, l, chunk, 2); int pre = -1;
    for (;;) {
        const int u = dequeue(F, qw, pre);
        if (u >= NBC * 64) break;
        const int qb = 7 - u / (NBC * 8), bh = u % (NBC * 8), b = bh >> 3, h = bh & 7;
        att::Desc d; const size_t r0 = (size_t)b * SEQ;
        d.Q = PROJ + r0 * PW + 2816 + 64 * h; d.K1 = PROJ + r0 * PW + 3840; d.V = PROJ + r0 * PW + 3904; d.K2 = nullptr; d.qpitch = d.k1pitch = d.vpitch = PW; d.k2pitch = 0;
        d.O = (bf16_t*)((unsigned char*)OC + r0 * 512 + 64 * h); d.opitch = 512; d.o8 = 1; d.lse = nullptr; d.lsepitch = 0; d.mask = (const unsigned*)(F.ws + WS_MASK) + r0 * 64;
        d.rstride = 1; d.q0 = qb * 256; d.nq = 256; d.jlo = 0; d.jhi = 4 * (qb + 1);
        att::attn_unit<64, 2>(F.lds, d);
    }
    const bf16_t* OG = (const bf16_t*)(F.ws + WS_OG); const float* LSE = (const float*)(F.ws + WS_LSE); bf16_t* OB = (bf16_t*)(F.ws + WS_OB);
    const int gw = F.vcu * NWAVES + F.wave, NGW = F.G * NWAVES, h = F.lane >> 4;
    for (int row = gw; row < TC; row += NGW) {
        const float l0 = LSE[(size_t)row * 4 + h], l1 = LSE[((size_t)TC + row) * 4 + h], l2 = LSE[((size_t)2 * TC + row) * 4 + h];
        const float mx = fmaxf(l0, fmaxf(l1, l2));
        float w0 = __builtin_amdgcn_exp2f(l0 - mx), w1 = __builtin_amdgcn_exp2f(l1 - mx), w2 = __builtin_amdgcn_exp2f(l2 - mx);
        const float inv = 1.0f / (w0 + w1 + w2); w0 *= inv; w1 *= inv; w2 *= inv;
        const u32x2 a = *(const u32x2*)(OG + (size_t)row * 256 + F.lane * 4), bq = *(const u32x2*)(OG + ((size_t)TC + row) * 256 + F.lane * 4), c = *(const u32x2*)(OG + ((size_t)2 * TC + row) * 256 + F.lane * 4);
        w0 *= 32.f; w1 *= 32.f; w2 *= 32.f;
        *(unsigned*)((unsigned char*)OB + (size_t)row * 512 + F.lane * 4) = pk4_fp8(w0 * bflo(a.x) + w1 * bflo(bq.x) + w2 * bflo(c.x), w0 * bfhi(a.x) + w1 * bfhi(bq.x) + w2 * bfhi(c.x),
                                                                                    w0 * bflo(a.y) + w1 * bflo(bq.y) + w2 * bflo(c.y), w0 * bfhi(a.y) + w1 * bfhi(bq.y) + w2 * bfhi(c.y));
    }
}
constexpr int CW_DEP = 32768;
__device__ __forceinline__ void phase_attn(Frame& F, int l, int chunk) {
    PHASE_IDS(F);
    const bf16_t* PROJ = (const bf16_t*)(F.ws + WS_PROJ); const bf16_t* QM = (const bf16_t*)(F.ws + WS_QM); const bf16_t* KVM = (const bf16_t*)(F.ws + WS_KVM);
    bf16_t* OA = (bf16_t*)(F.ws + WS_OA); bf16_t* OC = (bf16_t*)(F.ws + WS_OC);
    constexpr int N_SEL = TC / 32, NQ = NBC * 8;
    unsigned* dep = (unsigned*)(F.ws + WS_CTL) + CW_DEP + (l * NCHUNK + chunk) * (NBC * 8);
    unsigned* qw = queue_word(F, l, chunk, 1); int pre = -1;
    for (;;) {
        int u = dequeue(F, qw, pre);
        if (u < N_SEL) {
            idx::select_rows4((const float*)(F.ws + WS_SC), (unsigned*)(F.ws + WS_MASK), u * 32 + F.wave * 4, F.lane, (LAS unsigned*)(F.lds + L_GB) + F.wave * 64);
            VM_WAIT();
            __syncthreads();
            if (F.tid == 0) { const int row = u * 32, b = row / SEQ, qb = (row % SEQ) >> 8;
                __builtin_amdgcn_fence(__ATOMIC_RELEASE, "agent");
                __hip_atomic_fetch_add(dep + b * 8 + qb, 1u, __ATOMIC_RELAXED, __HIP_MEMORY_SCOPE_AGENT); }
            continue; }
        u -= N_SEL;
        if (u >= 16 * NQ) break;
        const int qb = 7 - u / (2 * NQ), w = u % (2 * NQ);
        if (w < NQ) {
            const int b = w >> 3, h = w & 7;
            att::Desc d; const size_t r0 = (size_t)b * SEQ;
            d.Q = QM + r0 * 768 + h * 96; d.qpitch = 768; d.K1 = KVM + r0 * 1024 + h * 128; d.k1pitch = 1024; d.K2 = PROJ + r0 * PW + 384; d.k2pitch = PW;
            d.V = KVM + r0 * 1024 + h * 128 + 64; d.vpitch = 1024; d.O = (bf16_t*)((unsigned char*)OA + r0 * 512 + h * 64); d.opitch = 512; d.o8 = 1; d.lse = nullptr; d.lsepitch = 0; d.mask = nullptr;
            d.rstride = 1; d.q0 = qb * 256; d.nq = 256; d.jlo = 0; d.jhi = 4 * (qb + 1);
            att::attn_unit<96, 0>(F.lds, d);
        } else {
            const int bh = w - NQ, b = bh >> 3, h = bh & 7;
            if (F.tid == 0) { while (__hip_atomic_load(dep + b * 8 + qb, __ATOMIC_RELAXED, __HIP_MEMORY_SCOPE_AGENT) < 8u) __builtin_amdgcn_s_sleep(4);
                __builtin_amdgcn_fence(__ATOMIC_ACQUIRE, "agent"); }
            __syncthreads();
            att::Desc d; const size_t r0 = (size_t)b * SEQ;
            d.Q = PROJ + r0 * PW + 2816 + 64 * h; d.K1 = PROJ + r0 * PW + 3840; d.V = PROJ + r0 * PW + 3904; d.K2 = nullptr; d.qpitch = d.k1pitch = d.vpitch = PW; d.k2pitch = 0;
            d.O = (bf16_t*)((unsigned char*)OC + r0 * 512 + 64 * h); d.opitch = 512; d.o8 = 1; d.lse = nullptr; d.lsepitch = 0; d.mask = (const unsigned*)(F.ws + WS_MASK) + r0 * 64;
            d.rstride = 1; d.q0 = qb * 256; d.nq = 256; d.jlo = 0; d.jhi = 4 * (qb + 1);
            att::attn_unit<64, 2>(F.lds, d);
        }
    }
    const bf16_t* OG = (const bf16_t*)(F.ws + WS_OG); const float* LSE = (const float*)(F.ws + WS_LSE); bf16_t* OB = (bf16_t*)(F.ws + WS_OB);
    const int gw = F.vcu * NWAVES + F.wave, NGW = F.G * NWAVES, h = F.lane >> 4;
    for (int row = gw; row < TC; row += NGW) {
        const float l0 = LSE[(size_t)row * 4 + h], l1 = LSE[((size_t)TC + row) * 4 + h], l2 = LSE[((size_t)2 * TC + row) * 4 + h];
        const float mx = fmaxf(l0, fmaxf(l1, l2));
        float w0 = __builtin_amdgcn_exp2f(l0 - mx), w1 = __builtin_amdgcn_exp2f(l1 - mx), w2 = __builtin_amdgcn_exp2f(l2 - mx);
        const float inv = 1.0f / (w0 + w1 + w2); w0 *= inv; w1 *= inv; w2 *= inv;
        const u32x2 a = *(const u32x2*)(OG + (size_t)row * 256 + F.lane * 4), bq = *(const u32x2*)(OG + ((size_t)TC + row) * 256 + F.lane * 4), c = *(const u32x2*)(OG + ((size_t)2 * TC + row) * 256 + F.lane * 4);
        w0 *= 32.f; w1 *= 32.f; w2 *= 32.f;
        *(unsigned*)((unsigned char*)OB + (size_t)row * 512 + F.lane * 4) = pk4_fp8(w0 * bflo(a.x) + w1 * bflo(bq.x) + w2 * bflo(c.x), w0 * bfhi(a.x) + w1 * bfhi(bq.x) + w2 * bfhi(c.x),
                                                                                    w0 * bflo(a.y) + w1 * bflo(bq.y) + w2 * bflo(c.y), w0 * bfhi(a.y) + w1 * bfhi(bq.y) + w2 * bfhi(c.y));
    }
}
__device__ __forceinline__ void phase_branches(Frame& F, int l, int chunk) {
    PHASE_IDS(F);
    static_assert(WS_OB - WS_OA == WS_OC - WS_OB && WS_WB - WS_WA == WS_WC - WS_WB, "equally spaced branch operands");
    BranchSched S{(const char*)(F.ws + WS_OA), (const char*)(F.ws + WS_WA), WS_OB - WS_OA, WS_WB - WS_WA, 256, 256, (int)blockIdx.x, F8_SW, 127 - 5, F.G, (TC / 256) * 4};
    EpiBranchAll E{(bf16_t*)(F.ws + WS_MERGED), (bf16_t*)(F.ws + WS_M0), (bf16_t*)(F.ws + WS_M1), (const bf16_t*)(F.ws + WS_G3)};
    pg8::gemm_phase<EpiBranchAll, BranchSched, true, true>(F.lds, 256, S, E);
}
__device__ __forceinline__ void phase_wo(Frame& F, int l, int chunk) {
    PHASE_IDS(F);
    pg8::DenseSched8 S{{(const bf16_t*)(F.ws + WS_MERGED), (const bf16_t*)(F.ws + WS_WO), DM / 2, DM / 2, TC / 256, 4, F.G, (int)blockIdx.x}, F8_SW, 127 - 6};
    EpiWo E{F.out, l == 0 ? F.in[0] : F.out, chunk * TC};
    pg8::gemm_phase<EpiWo, pg8::DenseSched8, true, true>(F.lds, DM / 2, S, E);
}

__global__ void __launch_bounds__(NTHREADS, 2) fwd_kernel(Args args) {
    extern __shared__ __attribute__((aligned(16))) unsigned char lds_raw[];
    Frame F;
    F.lds = (LAS unsigned char*)lds_raw;
    F.tid = threadIdx.x; F.lane = F.tid & 63; F.wave = __builtin_amdgcn_readfirstlane(F.tid >> 6);
    F.G = gridDim.x; { const int bx = blockIdx.x; F.vcu = (F.G % 8 == 0) ? (bx % 8) * (F.G / 8) + bx / 8 : bx; }
    F.in.p = (intab_t)__builtin_amdgcn_kernarg_segment_ptr(); F.out = args.out; F.ws = args.ws; F.out0 = args.out; F.ws0 = args.ws;
    for (int u = F.tid; u < (LDS_BYTES - L_CTL) / 4; u += NTHREADS) ((LAS unsigned*)(F.lds + L_CTL))[u] = 0u;
    __syncthreads();
    XcdBarrier bar = xcd_barrier_post((unsigned*)(F.ws + WS_CTL) + CW_BAR, (volatile LAS unsigned*)(F.lds + L_BARW));
#define GRID_BAR() xcd_barrier(bar)

    for (int l = 0; l < 2; ++l) {
        phase_conv_moe(F, l);
        phase_conv_mixer(F, l);
        GRID_BAR();
        for (int chunk = 0; chunk < NCHUNK; ++chunk) {
            phase_proj(F, l, chunk);
            GRID_BAR();
            if (DUPMASK & 2) { phase_proj(F, l, chunk); GRID_BAR(); }
            phase_up_scores(F, l, chunk);
            GRID_BAR();
            if (DUPMASK & 4) { phase_up_scores(F, l + 2, chunk); GRID_BAR(); }
            phase_attn(F, l, chunk);
            GRID_BAR();
            phase_branches(F, l, chunk);
            GRID_BAR();
            if (DUPMASK & 32) { phase_branches(F, l, chunk); GRID_BAR(); }
            phase_wo(F, l, chunk);
            if ((DUPMASK & 0x800) && l == 0) { GRID_BAR(); phase_wo(F, l, chunk); }
        }
        GRID_BAR();
        phase_ln1_router(F, l, F.out, false);
        GRID_BAR();
        phase_moe_scatter(F);
        GRID_BAR();
        phase_moe_gemm1(F);
        GRID_BAR();
        if (DUPMASK & 64) { phase_moe_gemm1(F); GRID_BAR(); }
        phase_moe_gemm2(F);
        GRID_BAR();
        if (DUPMASK & 128) { phase_moe_gemm2(F); GRID_BAR(); }
        phase_combine_ln2(F, l);
    }
}

extern "C" void kernel_launch(void* const* d_in, const int* in_sizes, int n_in, void* d_out, int out_size, void* d_ws, size_t ws_size, hipStream_t stream) {
    static int grid = 0;
    if (grid == 0) {
        if (n_in != 23 || out_size != TT * DM || ws_size < WS_END) { fprintf(stderr, "kernel_launch: unexpected shapes n_in %d out %d ws %zu\n", n_in, out_size, ws_size); grid = -1; return; }
        int dev = 0, cus = 0;
        if (hipGetDevice(&dev) != hipSuccess || hipDeviceGetAttribute(&cus, hipDeviceAttributeMultiprocessorCount, dev) != hipSuccess) { grid = -1; return; }
        if (hipFuncSetAttribute((const void*)fwd_kernel, hipFuncAttributeMaxDynamicSharedMemorySize, LDS_BYTES) != hipSuccess) { fprintf(stderr, "kernel_launch: hipFuncSetAttribute failed\n"); grid = -1; return; }
        int per_cu = 0;
        if (hipOccupancyMaxActiveBlocksPerMultiprocessor(&per_cu, (const void*)fwd_kernel, NTHREADS, LDS_BYTES) != hipSuccess || per_cu < 1) fprintf(stderr, "kernel_launch: occupancy query says %d\n", per_cu);
        (void)hipGetLastError();
        grid = cus;
    }
    if (grid < 0) return;
    if (hipMemsetAsync((char*)d_ws + WS_CTL, 0, CTL_ZERO_BYTES, stream) != hipSuccess) return;
    Args a{};
    for (int i = 0; i < 23; ++i) a.in[i] = (const float*)d_in[i];
    a.out = (float*)d_out; a.ws = (unsigned char*)d_ws;
    hipLaunchKernelGGL(fwd_kernel, dim3(grid), dim3(NTHREADS), LDS_BYTES, stream, a);
}
```

```cpp
#include <hip/hip_runtime.h>
#include <cstdio>
#include <cstdint>

#define LAS __attribute__((address_space(3)))
#define GAS __attribute__((address_space(1)))
typedef unsigned short bf16_t;
typedef short bf16x8 __attribute__((ext_vector_type(8)));
typedef float f32x4 __attribute__((ext_vector_type(4)));
typedef float f32x2 __attribute__((ext_vector_type(2)));
typedef float f32x16 __attribute__((ext_vector_type(16)));
typedef unsigned u32x4 __attribute__((ext_vector_type(4)));
typedef unsigned u32x2 __attribute__((ext_vector_type(2)));

constexpr int DM = 1024, NB = 32, SEQ = 2048, TT = NB * SEQ;
constexpr int NEXP = 32, DEXP = 256;
constexpr float LN_EPS = 1e-6f;
constexpr float ALPHA = 1.41421356237309515f;
constexpr int NWAVES = 8, NTHREADS = 512;

__device__ __forceinline__ unsigned f2bf(float f) { unsigned u = __builtin_bit_cast(unsigned, f); return (u + 0x7fffu + ((u >> 16) & 1u)) >> 16; }
__device__ __forceinline__ unsigned pk2(float lo, float hi) { return f2bf(lo) | (f2bf(hi) << 16); }
__device__ __forceinline__ float bf2f(unsigned short b) { return __builtin_bit_cast(float, (unsigned)b << 16); }
__device__ __forceinline__ float bflo(unsigned w) { return __builtin_bit_cast(float, w << 16); }
__device__ __forceinline__ float bfhi(unsigned w) { return __builtin_bit_cast(float, w & 0xffff0000u); }
typedef __bf16 bf16x2_t __attribute__((ext_vector_type(2)));
__device__ __forceinline__ unsigned cvt_pk_bf16(float lo, float hi) { const f32x2 v = {lo, hi}; const bf16x2_t b = __builtin_convertvector(v, bf16x2_t); return __builtin_bit_cast(unsigned, b); }
__device__ __forceinline__ float wave_sum(float v) {
#pragma unroll
    for (int o = 1; o < 64; o <<= 1) v += __shfl_xor(v, o);
    return v;
}
__device__ __forceinline__ float fast_exp(float x) { return __builtin_amdgcn_exp2f(x * 1.4426950408889634f); }
__device__ __forceinline__ float sigmoidf_(float x) { return __builtin_amdgcn_rcpf(1.0f + fast_exp(-x)); }
__device__ __forceinline__ unsigned pk4_fp8(float a, float b, float c, float d) {
    int p = __builtin_amdgcn_cvt_pk_fp8_f32(a, b, 0, false); p = __builtin_amdgcn_cvt_pk_fp8_f32(c, d, p, true); return (unsigned)p; }
__device__ __forceinline__ void store8_fp8(unsigned char* p, const f32x4& v0, const f32x4& v1, float sc) {
    u32x2 w; w.x = pk4_fp8(v0[0] * sc, v0[1] * sc, v0[2] * sc, v0[3] * sc); w.y = pk4_fp8(v1[0] * sc, v1[1] * sc, v1[2] * sc, v1[3] * sc); *(u32x2*)p = w;
}
#define LDS_WAIT() asm volatile("s_waitcnt lgkmcnt(0)" ::: "memory")
#define VM_WAIT() asm volatile("s_waitcnt vmcnt(0)" ::: "memory")

namespace pg8 {
constexpr int BM = 256, BK = 64, HALF = 128, HTB = HALF * BK * 2, STAGE_BYTES = 8 * HTB;
__device__ __forceinline__ int lds_byte(int r, int c) { return r * 128 + ((((c >> 3) ^ (r >> 1)) & 7) * 16) + (c & 7) * 2; }
__device__ __forceinline__ void stage_rc(int b, int& R, int& C) { R = b >> 7; C = ((((b >> 4) ^ (R >> 1)) & 7)) * 8; }
__device__ __forceinline__ int perm32(int rho) { const int n = rho >> 4, i = rho & 15; return 8 * (i >> 2) + 4 * n + (i & 3); }
struct Unit { int pm, pn, ord; };

template <class S, class = void> struct SchedVarK { static constexpr bool value = false; };
template <class S> struct SchedVarK<S, decltype((void)S::VARK)> { static constexpr bool value = S::VARK; };
typedef int v4i_t __attribute__((ext_vector_type(4)));
typedef int v8i_t __attribute__((ext_vector_type(8)));
__device__ __forceinline__ v8i_t cat8(const bf16x8& lo, const bf16x8& hi) { return __builtin_shufflevector(__builtin_bit_cast(v4i_t, lo), __builtin_bit_cast(v4i_t, hi), 0, 1, 2, 3, 4, 5, 6, 7); }
template <class Epi, class Sched, bool ALIGN_EPI, bool F8 = false>
__device__ __forceinline__ void gemm_phase(LAS unsigned char* lds, const int K, const Sched& S, const Epi& E) {
    int tid_ = threadIdx.x; asm volatile("" : "+v"(tid_));
    const int tid = tid_, wid = __builtin_amdgcn_readfirstlane(tid >> 6), lane = tid & 63, wr = wid >> 2, wc = wid & 3, fr = lane & 15, fq = lane >> 4;
    int nt = K / BK;
    int Rr[2], Cc[2]; unsigned vB[2][2];
#pragma unroll
    for (int i = 0; i < 2; ++i) { stage_rc(tid * 16 + i * 8192, Rr[i], Cc[i]); const int Rb = (Rr[i] & ~31) + perm32(Rr[i] & 31);
        vB[0][i] = (unsigned)(Rb * S.ldb + Cc[i]) * 2u; vB[1][i] = (unsigned)((HALF + Rb) * S.ldb + Cc[i]) * 2u; }
    const size_t kstep = (size_t)(BK * 2);
    const unsigned ldsw = (unsigned)wid * 1024u;
    const int aoff = lds_byte(wr * 64 + fr, fq * 8), boff = lds_byte(wc * 32 + fr, fq * 8);
    const int aoff1 = lds_byte(wr * 64 + fr, fq * 8 + 32), boff1 = lds_byte(wc * 32 + fr, fq * 8 + 32);
#define PG8_SA(b, h) (((b) * 2 + (h)) * HTB)
#define PG8_SB(b, h) ((4 + (b) * 2 + (h)) * HTB)
#define PG8_STAGE(bufoff, gbase, voff) do { _Pragma("unroll") for (int _i = 0; _i < 2; ++_i) \
        __builtin_amdgcn_global_load_lds((const unsigned*)((const char*)(gbase) + (voff)[_i]), (LAS unsigned*)(lds + (bufoff) + ldsw + _i * 8192), 16, 0, 0); } while (0)
#define PG8_LDA(dst, b, h) do { _Pragma("unroll") for (int m = 0; m < 4; ++m) { \
        const bf16x8 f0_ = *(const LAS bf16x8*)(lds + PG8_SA(b, h) + aoff + m * 2048), f1_ = *(const LAS bf16x8*)(lds + PG8_SA(b, h) + aoff1 + m * 2048); \
        if constexpr (F8) dst##8[m] = cat8(f0_, f1_); else { dst[m][0] = f0_; dst[m][1] = f1_; } } } while (0)
#define PG8_LDB(dst, b, h) do { _Pragma("unroll") for (int n = 0; n < 2; ++n) { \
        const bf16x8 f0_ = *(const LAS bf16x8*)(lds + PG8_SB(b, h) + boff + n * 2048), f1_ = *(const LAS bf16x8*)(lds + PG8_SB(b, h) + boff1 + n * 2048); \
        if constexpr (F8) dst##8[n] = cat8(f0_, f1_); else { dst[n][0] = f0_; dst[n][1] = f1_; } } } while (0)
#define PG8_MMA(ai, bj, At, Bt) do { __builtin_amdgcn_s_setprio(1); \
        if constexpr (F8) { _Pragma("unroll") for (int m = 0; m < 4; ++m) _Pragma("unroll") for (int n = 0; n < 2; ++n) \
            asm volatile("v_mfma_scale_f32_16x16x128_f8f6f4 %0, %1, %2, %0, %3, %4 op_sel_hi:[0,0,0]" : "+v"(acc[ai][bj][m][n]) : "v"(Bt##8[n]), "v"(At##8[m]), "v"(scw8), "v"(sca8)); } \
              \
        else { _Pragma("unroll") for (int m = 0; m < 4; ++m) _Pragma("unroll") for (int n = 0; n < 2; ++n) _Pragma("unroll") for (int k = 0; k < 2; ++k) \
            acc[ai][bj][m][n] = __builtin_amdgcn_mfma_f32_16x16x32_bf16(Bt[n][k], At[m][k], acc[ai][bj][m][n], 0, 0, 0); } \
        __builtin_amdgcn_s_setprio(0); } while (0)
#define PG8_WAIT_V(n) asm volatile("s_waitcnt vmcnt(" #n ")" ::: "memory")
#define PG8_WAIT_L(n) asm volatile("s_waitcnt lgkmcnt(" #n ")" ::: "memory")
#define PG8_BAR __builtin_amdgcn_s_barrier()
#define PG8_SCHED __builtin_amdgcn_sched_barrier(0)
    int scw8 = 0, sca8 = 0;
    if constexpr (F8) { scw8 = S.sw8 * 0x01010101; sca8 = S.sa8 * 0x01010101; }
    Unit cur, nxt; int ui = 0;
    if (!S.next(0, cur)) return;
    f32x4 acc[2][2][4][2];
#pragma unroll
    for (int a = 0; a < 2; ++a)
#pragma unroll
        for (int b = 0; b < 2; ++b)
#pragma unroll
            for (int m = 0; m < 4; ++m)
#pragma unroll
                for (int n = 0; n < 2; ++n) acc[a][b][m][n] = (f32x4){0.f, 0.f, 0.f, 0.f};
    bf16x8 At[4][2], B0[2][2], B1[2][2]; v8i_t At8[4], B08[2], B18[2];
    unsigned vAc[2][2], vAn[2][2];
    const char* cA = S.a_base(cur); const char* cB = S.b_base(cur);
    S.a_off(cur, Rr, Cc, vAc);
    if constexpr (SchedVarK<Sched>::value) nt = S.ktiles(cur);
    PG8_STAGE(PG8_SB(0, 0), cB, vB[0]); PG8_STAGE(PG8_SB(0, 1), cB, vB[1]); PG8_STAGE(PG8_SA(0, 0), cA, vAc[0]); PG8_STAGE(PG8_SA(0, 1), cA, vAc[1]);
    if (wr == 1) PG8_BAR;
    PG8_WAIT_V(2); PG8_BAR;
    PG8_STAGE(PG8_SB(1, 0), cB + kstep, vB[0]); PG8_STAGE(PG8_SA(1, 0), cA + kstep, vAc[0]); PG8_STAGE(PG8_SB(1, 1), cB + kstep, vB[1]);
    PG8_WAIT_V(6); PG8_BAR;
    bool epi_pend = false;
    for (;;) {
        const bool has_next = S.next(ui + 1, nxt);
        const char* nA = cA; const char* nB = cB;
        if constexpr (Sched::GATHER) {
#pragma unroll
            for (int h = 0; h < 2; ++h)
#pragma unroll
                for (int i = 0; i < 2; ++i) vAn[h][i] = vAc[h][i];
        }
        if (has_next) { nA = S.a_base(nxt); nB = S.b_base(nxt); if constexpr (Sched::GATHER) S.a_off(nxt, Rr, Cc, vAn); }
#pragma nounroll
        for (int t = 0; t < nt; t += 2) {
            const bool last = (t == nt - 2);
            const bool ep_ = epi_pend && t == 0;
            const char* a1 = cA + (size_t)(t + 1) * kstep;
            const char* a2 = last ? nA : cA + (size_t)(t + 2) * kstep; const char* b2 = last ? nB : cB + (size_t)(t + 2) * kstep;
            const char* a3 = a2 + kstep; const char* b3 = b2 + kstep;
            unsigned vA2[2][2];
#pragma unroll
            for (int h = 0; h < 2; ++h)
#pragma unroll
                for (int i = 0; i < 2; ++i) { if constexpr (Sched::GATHER) vA2[h][i] = last ? vAn[h][i] : vAc[h][i]; else vA2[h][i] = vAc[h][i]; }
            PG8_LDB(B0, 0, 0); PG8_LDB(B1, 0, 1); PG8_SCHED; PG8_LDA(At, 0, 0); PG8_STAGE(PG8_SA(1, 1), a1, vAc[1]);
            if (ep_) { PG8_WAIT_V(24); } else { PG8_WAIT_V(8); } PG8_WAIT_L(0); PG8_BAR; PG8_MMA(0, 0, At, B0); PG8_MMA(0, 1, At, B1); PG8_BAR; PG8_SCHED;
            PG8_LDA(At, 0, 1); PG8_STAGE(PG8_SB(0, 0), b2, vB[0]); PG8_STAGE(PG8_SB(0, 1), b2, vB[1]); PG8_STAGE(PG8_SA(0, 0), a2, vA2[0]);
            if (ep_) { PG8_WAIT_V(24); } else { PG8_WAIT_V(8); } PG8_WAIT_L(0); PG8_BAR; PG8_MMA(1, 0, At, B0); PG8_MMA(1, 1, At, B1); PG8_BAR; PG8_SCHED;
            PG8_LDB(B0, 1, 0); PG8_LDB(B1, 1, 1); PG8_SCHED; PG8_LDA(At, 1, 0); PG8_STAGE(PG8_SA(0, 1), a2, vA2[1]);
            PG8_WAIT_V(8); PG8_WAIT_L(0); PG8_BAR; PG8_MMA(0, 0, At, B0); PG8_MMA(0, 1, At, B1); PG8_BAR; PG8_SCHED;
            PG8_LDA(At, 1, 1); PG8_STAGE(PG8_SB(1, 0), b3, vB[0]); PG8_STAGE(PG8_SB(1, 1), b3, vB[1]); PG8_STAGE(PG8_SA(1, 0), a3, vA2[0]);
            PG8_WAIT_V(8); PG8_WAIT_L(0); PG8_BAR; PG8_MMA(1, 0, At, B0); PG8_MMA(1, 1, At, B1); PG8_BAR; PG8_SCHED;
        }
        if constexpr (ALIGN_EPI) { if (wr == 0) PG8_BAR; }
        if constexpr (F8) asm volatile("s_nop 15\n\ts_nop 15" ::: "memory");
        { int l2_ = lane; asm volatile("" : "+v"(l2_)); E(acc, cur, wr, wc, l2_ & 15, l2_ >> 4); }
        if (!has_next) break;
        epi_pend = true;
#pragma unroll
        for (int a = 0; a < 2; ++a)
#pragma unroll
            for (int b = 0; b < 2; ++b)
#pragma unroll
                for (int m = 0; m < 4; ++m)
#pragma unroll
                    for (int n = 0; n < 2; ++n) acc[a][b][m][n] = (f32x4){0.f, 0.f, 0.f, 0.f};
        cur = nxt; cA = nA; cB = nB; ++ui;
        if constexpr (SchedVarK<Sched>::value) nt = S.ktiles(cur);
        if constexpr (Sched::GATHER) {
#pragma unroll
            for (int h = 0; h < 2; ++h)
#pragma unroll
                for (int i = 0; i < 2; ++i) vAc[h][i] = vAn[h][i];
        }
        if constexpr (ALIGN_EPI) { if (wr == 1) PG8_BAR; }
    }
    PG8_WAIT_V(0);
    if constexpr (!ALIGN_EPI) { if (wr == 0) PG8_BAR; }
    asm volatile("s_waitcnt vmcnt(0) lgkmcnt(0)\n\ts_barrier" ::: "memory");
    __builtin_amdgcn_sched_barrier(0);
#undef PG8_SA
#undef PG8_SB
#undef PG8_STAGE
#undef PG8_LDA
#undef PG8_LDB
#undef PG8_MMA
#undef PG8_WAIT_V
#undef PG8_WAIT_L
#undef PG8_BAR
#undef PG8_SCHED
}

struct DenseSched {
    static constexpr bool GATHER = false;
    const bf16_t* A; const bf16_t* Bt; int lda, ldb, nM, nN, G, c;
    __device__ __forceinline__ bool next(int i, Unit& u) const { const int v = i * G + c; if (v >= nM * nN) return false; u.pm = v / nN; u.pn = v % nN; u.ord = i; return true; }
    __device__ __forceinline__ const char* a_base(const Unit& u) const { return (const char*)(A + (size_t)u.pm * BM * lda); }
    __device__ __forceinline__ const char* b_base(const Unit& u) const { return (const char*)(Bt + (size_t)u.pn * BM * ldb); }
    __device__ __forceinline__ void a_off(const Unit&, const int (&R)[2], const int (&C)[2], unsigned (&v)[2][2]) const {
#pragma unroll
        for (int i = 0; i < 2; ++i) { v[0][i] = (unsigned)(R[i] * lda + C[i]) * 2u; v[1][i] = (unsigned)((HALF + R[i]) * lda + C[i]) * 2u; }
    }
};
struct DenseSched8 : DenseSched { int sw8, sa8; };
struct ProjSched8 : DenseSched8 {
    __device__ __forceinline__ bool next(int i, Unit& u) const {
        if (nN != 28 || (nM & 1) || (G & 7)) return DenseSched::next(i, u);
        const int x = c & 7, wl = i * (G >> 3) + (c >> 3), half = nM >> 1;
        if (wl >= half * 7) return false;
        u.pm = (x >> 2) * half + wl / 7; u.pn = 7 * (x & 3) + wl % 7; u.ord = i; return true;
    }
};
}

#define XB_TMO      128
#define XB_XCNT(j)  (256  + 64 * (j))
#define XB_XSUB(j)  (1280 + 64 * (j))
#define XB_XGEN(j)  (2304 + 64 * (j))
#define XB_TOP      3328
#define XB_TOPGEN   3392
#define XCD_BAR_WORDS 3456
#define XB_SPIN_CAP (1u << 18)
__device__ __forceinline__ unsigned xb_ld(unsigned* p)              { return __hip_atomic_load(p, __ATOMIC_RELAXED, __HIP_MEMORY_SCOPE_AGENT); }
__device__ __forceinline__ unsigned xb_add(unsigned* p, unsigned v) { return __hip_atomic_fetch_add(p, v, __ATOMIC_RELAXED, __HIP_MEMORY_SCOPE_AGENT); }
__device__ __forceinline__ unsigned xb_xcc_id() { return (unsigned)__builtin_amdgcn_s_getreg((3 << 11) | 20) & 0xFu; }
#define XB_SPIN(cond, bar) do { unsigned _sp = 0; while (cond) { __builtin_amdgcn_s_sleep(1); \
    if ((++_sp & 255u) == 0u) { if (xb_ld(&(bar)[XB_TMO])) break; if (_sp > XB_SPIN_CAP) { atomicAdd(&(bar)[XB_TMO], 1u); break; } } } } while (0)
struct XcdBarrier { unsigned* bar; unsigned x; volatile LAS unsigned* st; };
__device__ __forceinline__ XcdBarrier xcd_barrier_post(unsigned* bar, volatile LAS unsigned* st) {
    XcdBarrier b; b.bar = bar; b.x = xb_xcc_id(); b.st = st;
    if (threadIdx.x == 0) (void)xb_add(&bar[XB_XCNT(b.x)], 1u);
    return b;
}
__device__ __forceinline__ void xcd_barrier_complete(unsigned* bar, unsigned x, unsigned& nloc, unsigned& nx) {
    const unsigned G = gridDim.x * gridDim.y * gridDim.z;
    unsigned sum, cnt, mine, sp = 0u;
    for (;;) {
        sum = 0u; cnt = 0u; mine = 0u;
#pragma unroll
        for (unsigned j = 0; j < 16; ++j) { const unsigned c = xb_ld(&bar[XB_XCNT(j)]); sum += c; cnt += (c > 0u) ? 1u : 0u; mine = (j == x) ? c : mine; }
        if (sum == G) break;
        __builtin_amdgcn_s_sleep(1);
        if ((++sp & 255u) == 0u) { if (xb_ld(&bar[XB_TMO])) break; if (sp > XB_SPIN_CAP) { atomicAdd(&bar[XB_TMO], 1u); break; } }
    }
    nloc = mine > 0u ? mine : 1u; nx = cnt > 0u ? cnt : 1u;
}
__device__ __forceinline__ void xcd_barrier(const XcdBarrier& b) {
    asm volatile("s_waitcnt vmcnt(0)" ::: "memory");
    __syncthreads();
    if (threadIdx.x == 0) {
        unsigned* bar = b.bar;
        __builtin_amdgcn_s_waitcnt(0);
        unsigned nloc = b.st[0], nx = b.st[1];
        if (nloc == 0u) { xcd_barrier_complete(bar, b.x, nloc, nx); b.st[0] = nloc; b.st[1] = nx; }
        const unsigned old = xb_add(&bar[XB_XSUB(b.x)], 1u);
        const unsigned gen = old / nloc;
        if (old + 1u == (gen + 1u) * nloc) {
            __builtin_amdgcn_fence(__ATOMIC_RELEASE, "agent");
            asm volatile("s_waitcnt vmcnt(0)" ::: "memory");
            const unsigned og = xb_add(&bar[XB_TOP], 1u);
            const unsigned tg = og / nx;
            if (og + 1u == (tg + 1u) * nx) xb_add(&bar[XB_TOPGEN], 1u);
            else XB_SPIN(xb_ld(&bar[XB_TOPGEN]) == tg, bar);
            __builtin_amdgcn_fence(__ATOMIC_ACQUIRE, "agent");
            xb_add(&bar[XB_XGEN(b.x)], 1u);
            asm volatile("s_waitcnt vmcnt(0)" ::: "memory");
        } else {
            XB_SPIN(xb_ld(&bar[XB_XGEN(b.x)]) == gen, bar);
            __builtin_amdgcn_fence(__ATOMIC_ACQUIRE, "agent");
            asm volatile("s_waitcnt vmcnt(0)" ::: "memory");
        }
    }
    __syncthreads();
}

constexpr size_t MiB = 1u << 20;
constexpr size_t WS_CTL = 0, CTL_ZERO_BYTES = 1 * MiB;
constexpr int CW_BAR = 4096;
constexpr int CW_QUEUE = 16384;
constexpr size_t WS_W13 = 2 * MiB;
constexpr size_t WS_W2  = 34 * MiB;
constexpr size_t WS_WR  = 50 * MiB;
constexpr size_t WS_MISC = 51 * MiB;
constexpr size_t WS_ROUTE = 52 * MiB;
constexpr size_t WS_RPOS = 53 * MiB;
constexpr size_t WS_ROWTOK = 54 * MiB;
constexpr size_t WS_ROPE = 55 * MiB;
constexpr size_t WS_WUQ = 56 * MiB;
constexpr size_t WS_WUKV = 57 * MiB;
constexpr size_t WS_WA = 58 * MiB;
constexpr size_t WS_WB = 59 * MiB;
constexpr size_t WS_WC = 60 * MiB;
constexpr size_t WS_WO = 61 * MiB;
constexpr size_t WS_SSQ = 63 * MiB;
constexpr size_t WS_LSE = 64 * MiB;
constexpr size_t WS_MASK = 66 * MiB;
constexpr size_t WS_XB8 = 74 * MiB;
constexpr size_t WS_WIN8 = 138 * MiB;
constexpr size_t WS_H = 146 * MiB;
constexpr size_t WS_Y = 182 * MiB;
constexpr size_t WS_SC = WS_Y;
constexpr size_t WS_G3 = 254 * MiB;
constexpr size_t WS_PROJ = 350 * MiB;
constexpr size_t WS_QM = 606 * MiB;
constexpr size_t WS_KVM = 654 * MiB;
constexpr size_t WS_OA = 718 * MiB;
constexpr size_t WS_OB = 734 * MiB;
constexpr size_t WS_OC = 750 * MiB;
constexpr size_t WS_OG = 766 * MiB;
constexpr size_t WS_M0 = 814 * MiB;
constexpr size_t WS_M1 = 846 * MiB;
constexpr size_t WS_MERGED = 878 * MiB;
constexpr size_t WS_END = 910 * MiB;
constexpr int F8_SA_X = 127 - 4, F8_SW = 127 - 10;
constexpr int MAXROWS = 139264;
constexpr int NBC = 16, TC = NBC * SEQ, NCHUNK = NB / NBC;
constexpr int CIN = 3944, PW = 4096;

constexpr int MI_BLOCKCNT = 0;
constexpr int MI_PANEL_E = 8192;
constexpr int MI_NPAN = 8192 + 1024;

constexpr int RING_BYTES = 131072;
constexpr int L_CTL = RING_BYTES;
constexpr int L_BARW = L_CTL + 32;
constexpr int L_HIST = L_CTL + 256;
constexpr int L_TOT  = L_CTL + 384;
constexpr int L_PRE  = L_CTL + 512;
constexpr int L_BASE = L_CTL + 640;
constexpr int L_RANK = L_CTL + 896;
constexpr int L_PE   = L_CTL + 1024;
constexpr int L_ROWS = L_CTL + 2048;
constexpr int LDS_BYTES = 147456;
constexpr int L_GB = L_ROWS;
static_assert(L_ROWS + 12288 <= LDS_BYTES, "LDS map");

#ifndef DUPMASK
#define DUPMASK 0
#endif
struct Args { const float* in[23]; float* out; unsigned char* ws; };
#define PHASE_IDS(F) do { int t_ = threadIdx.x; asm volatile("" : "+v"(t_)); (F).tid = t_; (F).lane = t_ & 63; { intab_t p_ = (intab_t)__builtin_amdgcn_kernarg_segment_ptr(); asm volatile("" : "+s"(p_)); (F).in.p = p_; } \
    { unsigned char GAS* w_ = (unsigned char GAS*)(F).ws0; asm volatile("" : "+s"(w_)); (F).ws = (unsigned char*)w_; float GAS* o_ = (float GAS*)(F).out0; asm volatile("" : "+s"(o_)); (F).out = (float*)o_; } } while (0)

typedef const float GAS* gfptr_t;
typedef const gfptr_t __attribute__((address_space(4)))* intab_t;
struct InTab { intab_t p; __device__ __forceinline__ const float* operator[](int i) const { return (const float*)p[i]; } };
struct Frame {
    LAS unsigned char* lds;
    int tid, lane, wave, vcu, G;
    InTab in; float* out; unsigned char* ws; float* out0; unsigned char* ws0;
};

template <class F>
__device__ __forceinline__ void conv_item(bf16_t* WT, int ldk, int k0, int n0, LAS float* scr, int lane, F val) {
#pragma unroll 8
    for (int i = 0; i < 32; ++i) { const int kk = 2 * i + (lane >> 5); scr[kk * 33 + (lane & 31)] = val(k0 + kk, n0 + (lane & 31)); }
    LDS_WAIT(); asm volatile("" ::: "memory");
    const int c = lane & 7;
#pragma unroll
    for (int j = 0; j < 4; ++j) { const int n = (lane >> 3) + 8 * j; const LAS float* s = scr + (8 * c) * 33 + n;
        u32x4 o; o.x = pk2(s[0 * 33], s[1 * 33]); o.y = pk2(s[2 * 33], s[3 * 33]); o.z = pk2(s[4 * 33], s[5 * 33]); o.w = pk2(s[6 * 33], s[7 * 33]);
        *(u32x4*)(WT + (size_t)(n0 + n) * ldk + k0 + 8 * c) = o; }
    LDS_WAIT(); asm volatile("" ::: "memory");
}

template <class F>
__device__ __forceinline__ void conv_item8(unsigned char* WT, int ldk, int k0, int n0, LAS float* scr, int lane, F val) {
#pragma unroll 8
    for (int i = 0; i < 32; ++i) { const int kk = 2 * i + (lane >> 5); scr[kk * 33 + (lane & 31)] = val(k0 + kk, n0 + (lane & 31)); }
    LDS_WAIT(); asm volatile("" ::: "memory");
    const int c = lane & 7;
#pragma unroll
    for (int j = 0; j < 4; ++j) { const int n = (lane >> 3) + 8 * j; const LAS float* s = scr + (8 * c) * 33 + n;
        u32x2 o; o.x = pk4_fp8(s[0 * 33], s[1 * 33], s[2 * 33], s[3 * 33]); o.y = pk4_fp8(s[4 * 33], s[5 * 33], s[6 * 33], s[7 * 33]);
        *(u32x2*)(WT + (size_t)(n0 + n) * ldk + k0 + 8 * c) = o; }
    LDS_WAIT(); asm volatile("" ::: "memory");
}

__device__ __forceinline__ void conv_plain8(unsigned char* WT, int ldk, int k0, int n0, LAS float* scr, int lane, const float* src, int pitch, float sc) {
    f32x4 v[8];
#pragma unroll
    for (int i = 0; i < 8; ++i) v[i] = *(const f32x4*)(src + (size_t)(k0 + (lane >> 3) + 8 * i) * pitch + n0 + (lane & 7) * 4);
#pragma unroll
    for (int i = 0; i < 8; ++i) { LAS float* d = scr + ((lane >> 3) + 8 * i) * 33 + (lane & 7) * 4; d[0] = v[i][0] * sc; d[1] = v[i][1] * sc; d[2] = v[i][2] * sc; d[3] = v[i][3] * sc; }
    LDS_WAIT(); asm volatile("" ::: "memory");
    const int c = lane & 7;
#pragma unroll
    for (int j = 0; j < 4; ++j) { const int n = (lane >> 3) + 8 * j; const LAS float* s = scr + (8 * c) * 33 + n;
        u32x2 o; o.x = pk4_fp8(s[0 * 33], s[1 * 33], s[2 * 33], s[3 * 33]); o.y = pk4_fp8(s[4 * 33], s[5 * 33], s[6 * 33], s[7 * 33]);
        *(u32x2*)(WT + (size_t)(n0 + n) * ldk + k0 + 8 * c) = o; }
    LDS_WAIT(); asm volatile("" ::: "memory");
}
__device__ __forceinline__ void conv_pair8(unsigned char* WT, int ldk, int k0, int n0, LAS float* scr, int lane, const float* a, const float* b, int pitch, float sc) {
    f32x2 va[8], vb[8];
#pragma unroll
    for (int i = 0; i < 8; ++i) { const size_t o = (size_t)(k0 + (lane >> 3) + 8 * i) * pitch + (n0 >> 1) + (lane & 7) * 2; va[i] = *(const f32x2*)(a + o); vb[i] = *(const f32x2*)(b + o); }
#pragma unroll
    for (int i = 0; i < 8; ++i) { LAS float* d = scr + ((lane >> 3) + 8 * i) * 33 + (lane & 7) * 4; d[0] = va[i][0] * sc; d[1] = vb[i][0] * sc; d[2] = va[i][1] * sc; d[3] = vb[i][1] * sc; }
    LDS_WAIT(); asm volatile("" ::: "memory");
    const int c = lane & 7;
#pragma unroll
    for (int j = 0; j < 4; ++j) { const int n = (lane >> 3) + 8 * j; const LAS float* s = scr + (8 * c) * 33 + n;
        u32x2 o; o.x = pk4_fp8(s[0 * 33], s[1 * 33], s[2 * 33], s[3 * 33]); o.y = pk4_fp8(s[4 * 33], s[5 * 33], s[6 * 33], s[7 * 33]);
        *(u32x2*)(WT + (size_t)(n0 + n) * ldk + k0 + 8 * c) = o; }
    LDS_WAIT(); asm volatile("" ::: "memory");
}

__device__ __forceinline__ void phase_conv_moe(Frame& F, int l) {
    PHASE_IDS(F);
    LAS float* scr = (LAS float*)(F.lds + F.wave * 16384);
    const int gw = F.vcu * NWAVES + F.wave, NGW = F.G * NWAVES;
    const float* w1 = F.in[18] + (size_t)l * NEXP * DM * DEXP;
    const float* w3 = F.in[19] + (size_t)l * NEXP * DM * DEXP;
    const float* w2 = F.in[20] + (size_t)l * NEXP * DEXP * DM;
    bf16_t* W13 = (bf16_t*)(F.ws + WS_W13); bf16_t* W2 = (bf16_t*)(F.ws + WS_W2);
    constexpr int I13 = (DM / 64) * (512 / 32);
    constexpr int I2 = (DEXP / 64) * (DM / 32);
    for (int it = gw; it < NEXP * (I13 + I2); it += NGW) {
        if (it < NEXP * I13) {
            const int e = it / I13, r = it % I13, kb = r / 16, nb = r % 16;
            const float* a = w1 + (size_t)e * DM * DEXP; const float* b = w3 + (size_t)e * DM * DEXP;
            conv_pair8((unsigned char*)W13 + (size_t)e * 512 * DM, DM, kb * 64, nb * 32, scr, F.lane, a, b, DEXP, 1024.f);
        } else {
            const int it2 = it - NEXP * I13; const int e = it2 / I2, r = it2 % I2, kb = r / 32, nb = r % 32;
            const float* a = w2 + (size_t)e * DEXP * DM;
            conv_plain8((unsigned char*)W2 + (size_t)e * DM * DEXP, DEXP, kb * 64, nb * 32, scr, F.lane, a, DM, 1024.f);
        }
    }
    const float* wg = F.in[14] + (size_t)l * DM * 4; const float* wsb = F.in[16] + (size_t)l * DM * NEXP;
    const float* g1 = F.in[12] + (size_t)l * DM; const float* b1 = F.in[13] + (size_t)l * DM;
    bf16_t* WRH = (bf16_t*)(F.ws + WS_WR); bf16_t* WRL = (bf16_t*)(F.ws + WS_WR + 128 * 1024); float* WRC = (float*)(F.ws + WS_WR + 256 * 1024);
    for (int idx = (F.vcu * NTHREADS + F.tid); idx < 64 * DM; idx += F.G * NTHREADS) {
        const int c = idx / DM, k = idx % DM;
        const float v = (c < 32 ? wsb[(size_t)k * NEXP + c] : (c < 36 ? wg[(size_t)k * 4 + (c - 32)] : 0.f)) * g1[k];
        const unsigned h = f2bf(v); const int it = k >> 5, hi_ = (k >> 4) & 1, st = (k >> 3) & 1, e = k & 7, ln = (c & 31) + 32 * hi_, p0 = 2 * (c >> 5);
        WRH[((((size_t)it * 4 + p0) * 2 + st) * 64 + ln) * 8 + e] = (bf16_t)h;
        WRH[((((size_t)it * 4 + p0 + 1) * 2 + st) * 64 + ln) * 8 + e] = (bf16_t)f2bf(v - __builtin_bit_cast(float, h << 16)); (void)WRL;
    }
    if (gw < 64) {
        const int c = gw; float s1 = 0.f, s2 = 0.f;
        for (int k = F.lane; k < DM; k += 64) { const float w = c < 32 ? wsb[(size_t)k * NEXP + c] : (c < 36 ? wg[(size_t)k * 4 + (c - 32)] : 0.f); s1 += g1[k] * w; s2 += b1[k] * w; }
        s1 = wave_sum(s1); s2 = wave_sum(s2);
        const float bias = c < 32 ? F.in[17][(size_t)l * NEXP + c] : (c < 36 ? F.in[15][(size_t)l * 4 + (c - 32)] : 0.f);
        if (F.lane == 0) { WRC[c] = s1; WRC[64 + c] = s2 + bias; }
    }
}

__device__ __forceinline__ void ln_row(f32x4 (&v)[4], const f32x4 (&g)[4], const f32x4 (&b)[4], float* omean = nullptr, float* orstd = nullptr) {
    float s = 0.f;
#pragma unroll
    for (int j = 0; j < 4; ++j) s += (v[j].x + v[j].y) + (v[j].z + v[j].w);
    const float mean = wave_sum(s) * (1.f / DM); float s2 = 0.f;
#pragma unroll
    for (int j = 0; j < 4; ++j) { v[j] = v[j] - mean; s2 += (v[j].x * v[j].x + v[j].y * v[j].y) + (v[j].z * v[j].z + v[j].w * v[j].w); }
    const float rstd = 1.0f / sqrtf(wave_sum(s2) * (1.f / DM) + LN_EPS);
#pragma unroll
    for (int j = 0; j < 4; ++j) v[j] = v[j] * rstd * g[j] + b[j];
    if (omean) { *omean = mean; *orstd = rstd; }
}
__device__ __forceinline__ void store_row(const f32x4 (&v)[4], float* orow, unsigned char* brow, int lane) {
#pragma unroll
    for (int j = 0; j < 4; ++j) {
        ((f32x4*)orow)[lane + 64 * j] = v[j];
        ((unsigned*)brow)[lane + 64 * j] = pk4_fp8(v[j].x * 16.f, v[j].y * 16.f, v[j].z * 16.f, v[j].w * 16.f);
    }
}

__device__ __forceinline__ void phase_ln1_router(Frame& F, int l, const float* src, bool scale_alpha) {
    PHASE_IDS(F);
    const int lane = F.lane, hi = lane >> 5, r32 = lane & 31;
    const float* lg = F.in[12] + (size_t)l * DM; const float* lb = F.in[13] + (size_t)l * DM;
    f32x4 g[4], b[4];
#pragma unroll
    for (int j = 0; j < 4; ++j) { g[j] = ((const f32x4*)lg)[lane + 64 * j]; b[j] = ((const f32x4*)lb)[lane + 64 * j]; }
    unsigned char* XB = F.ws + WS_XB8;
    const bf16_t* WRH = (const bf16_t*)(F.ws + WS_WR); const bf16_t* WRL = (const bf16_t*)(F.ws + WS_WR + 128 * 1024);
    const float* WRC = (const float*)(F.ws + WS_WR + 256 * 1024); float* stats = (float*)(F.ws + WS_WR + 512 * 1024);
    unsigned* misc = (unsigned*)(F.ws + WS_MISC);
    int* route = (int*)(F.ws + WS_ROUTE);
    LAS unsigned* hist = (LAS unsigned*)(F.lds + L_HIST);
    const float sc = scale_alpha ? ALPHA : 1.0f;
    for (int blk = F.vcu; blk < TT / 256; blk += F.G) {
        if (F.tid < 32) hist[F.tid] = 0u;
        __syncthreads();
        const int row0 = blk * 256 + F.wave * 32;
        float mu_l = 0.f, rs_l = 1.f;
        for (int i = 0; i < 32; i += 2) {
            f32x4 v0[4], v1[4];
            const f32x4* p0 = (const f32x4*)(src + (size_t)(row0 + i) * DM); const f32x4* p1 = (const f32x4*)(src + (size_t)(row0 + i + 1) * DM);
#pragma unroll
            for (int j = 0; j < 4; ++j) { v0[j] = p0[lane + 64 * j] * sc; v1[j] = p1[lane + 64 * j] * sc; }
            float m0, r0, m1, r1;
            ln_row(v0, g, b, &m0, &r0); ln_row(v1, g, b, &m1, &r1);
            mu_l = (r32 == i) ? m0 : ((r32 == i + 1) ? m1 : mu_l); rs_l = (r32 == i) ? r0 : ((r32 == i + 1) ? r1 : rs_l);
#pragma unroll
            for (int j = 0; j < 4; ++j) {
                ((unsigned*)(XB + (size_t)(row0 + i) * DM))[lane + 64 * j] = pk4_fp8(v0[j].x * 16.f, v0[j].y * 16.f, v0[j].z * 16.f, v0[j].w * 16.f);
                ((unsigned*)(XB + (size_t)(row0 + i + 1) * DM))[lane + 64 * j] = pk4_fp8(v1[j].x * 16.f, v1[j].y * 16.f, v1[j].z * 16.f, v1[j].w * 16.f); }
        }
        if (hi == 0) *(f32x2*)(stats + (size_t)(row0 + r32) * 2) = (f32x2){mu_l, rs_l};
        f32x16 acc0 = {}, acc1 = {};
        {
            const bf16_t* WT = WRH; (void)WRL;
            LAS float* xs = (LAS float*)(F.lds + F.wave * 9216);
            const float* xg = src + (size_t)(row0 + (lane >> 3)) * DM + (lane & 7) * 4;
            f32x4 xv[4]; bf16x8 wv[8];
#pragma unroll
            for (int i = 0; i < 4; ++i) xv[i] = *(const f32x4*)(xg + (size_t)(8 * i) * DM);
#pragma unroll
            for (int q = 0; q < 8; ++q) wv[q] = *(const bf16x8*)(WT + ((size_t)q * 64 + lane) * 8);
#pragma unroll 2
            for (int it = 0; it < 32; ++it) {
                LAS float* xb = xs + (it & 1) * 1152;
#pragma unroll
                for (int i = 0; i < 4; ++i) *(LAS f32x4*)(xb + ((lane >> 3) + 8 * i) * 36 + (lane & 7) * 4) = xv[i];
                bf16x8 wc[8];
#pragma unroll
                for (int q = 0; q < 8; ++q) wc[q] = wv[q];
                { const int nx = it + 1 < 32 ? it + 1 : 31;
#pragma unroll
                  for (int i = 0; i < 4; ++i) xv[i] = *(const f32x4*)(xg + (size_t)(8 * i) * DM + nx * 32);
#pragma unroll
                  for (int q = 0; q < 8; ++q) wv[q] = *(const bf16x8*)(WT + (((size_t)nx * 8 + q) * 64 + lane) * 8); }
                f32x4 xa[4];
#pragma unroll
                for (int j = 0; j < 4; ++j) xa[j] = *(const LAS f32x4*)(xb + r32 * 36 + hi * 16 + 4 * j);
#pragma unroll
                for (int st = 0; st < 2; ++st) {
                    const f32x4 x0 = xa[2 * st], x1 = xa[2 * st + 1];
                    u32x4 xh, xl;
                    xh.x = cvt_pk_bf16(x0[0], x0[1]); xh.y = cvt_pk_bf16(x0[2], x0[3]); xh.z = cvt_pk_bf16(x1[0], x1[1]); xh.w = cvt_pk_bf16(x1[2], x1[3]);
                    xl.x = cvt_pk_bf16(x0[0] - bflo(xh.x), x0[1] - bfhi(xh.x)); xl.y = cvt_pk_bf16(x0[2] - bflo(xh.y), x0[3] - bfhi(xh.y));
                    xl.z = cvt_pk_bf16(x1[0] - bflo(xh.z), x1[1] - bfhi(xh.z)); xl.w = cvt_pk_bf16(x1[2] - bflo(xh.w), x1[3] - bfhi(xh.w));
                    const bf16x8 xhv = __builtin_bit_cast(bf16x8, xh), xlv = __builtin_bit_cast(bf16x8, xl);
                    acc0 = __builtin_amdgcn_mfma_f32_32x32x16_bf16(wc[0 + st], xhv, acc0, 0, 0, 0); acc1 = __builtin_amdgcn_mfma_f32_32x32x16_bf16(wc[4 + st], xhv, acc1, 0, 0, 0);
                    acc0 = __builtin_amdgcn_mfma_f32_32x32x16_bf16(wc[2 + st], xhv, acc0, 0, 0, 0); acc1 = __builtin_amdgcn_mfma_f32_32x32x16_bf16(wc[6 + st], xhv, acc1, 0, 0, 0);
                    acc0 = __builtin_amdgcn_mfma_f32_32x32x16_bf16(wc[0 + st], xlv, acc0, 0, 0, 0); acc1 = __builtin_amdgcn_mfma_f32_32x32x16_bf16(wc[4 + st], xlv, acc1, 0, 0, 0);
                }
            }
        }
        float gl[4];
#pragma unroll
        for (int i = 0; i < 4; ++i) gl[i] = rs_l * (acc1[i] - mu_l * WRC[32 + i]) + WRC[64 + 32 + i];
        int gidx = 0; float gmax = gl[0];
#pragma unroll
        for (int i = 1; i < 4; ++i) if (gl[i] > gmax) { gmax = gl[i]; gidx = i; }
        float gsum = 0.f;
#pragma unroll
        for (int i = 0; i < 4; ++i) gsum += fast_exp(gl[i] - gmax);
        float gp = 1.0f / gsum;
        gidx = __shfl(gidx, r32); gp = __shfl(gp, r32);
        float cv[4];
#pragma unroll
        for (int i = 0; i < 4; ++i) {
            const float a = gidx == 0 ? acc0[i] : gidx == 1 ? acc0[4 + i] : gidx == 2 ? acc0[8 + i] : acc0[12 + i];
            cv[i] = rs_l * (a - mu_l * WRC[8 * gidx + 4 * hi + i]) + WRC[64 + 8 * gidx + 4 * hi + i];
        }
        float v1 = cv[0]; int i1 = 0;
#pragma unroll
        for (int i = 1; i < 4; ++i) if (cv[i] > v1) { v1 = cv[i]; i1 = i; }
        float v2 = -INFINITY; int i2 = 0;
#pragma unroll
        for (int i = 0; i < 4; ++i) if (i != i1 && cv[i] > v2) { v2 = cv[i]; i2 = i; }
        i1 += 4 * hi; i2 += 4 * hi;
        const float pv1 = __shfl_xor(v1, 32), pv2 = __shfl_xor(v2, 32); const int pi1 = __shfl_xor(i1, 32), pi2 = __shfl_xor(i2, 32);
        auto better = [](float av, int ai, float bv, int bi) { return av > bv || (av == bv && ai < bi); };
        float fv, sv; int fi, si;
        if (better(v1, i1, pv1, pi1)) { fv = v1; fi = i1; if (better(v2, i2, pv1, pi1)) { sv = v2; si = i2; } else { sv = pv1; si = pi1; } }
        else { fv = pv1; fi = pi1; if (better(v1, i1, pv2, pi2)) { sv = v1; si = i1; } else { sv = pv2; si = pi2; } }
        const float d = fast_exp(sv - fv), inv = 1.0f / (1.0f + d);
        const float w1 = gp * inv, w2 = gp * d * inv;
        const int e1 = 8 * gidx + fi, e2 = 8 * gidx + si;
        if (hi == 0) {
            *(int4*)(route + (size_t)(row0 + r32) * 4) = make_int4(e1, e2, __float_as_int(w1), __float_as_int(w2));
            atomicAdd((unsigned*)&hist[e1], 1u); atomicAdd((unsigned*)&hist[e2], 1u);
        }
        __syncthreads();
        if (F.tid < 32) misc[MI_BLOCKCNT + blk * 32 + F.tid] = hist[F.tid];
        __syncthreads();
    }
}

__device__ __forceinline__ void phase_moe_scatter(Frame& F) {
    PHASE_IDS(F);
    unsigned* misc = (unsigned*)(F.ws + WS_MISC);
    const int* route = (const int*)(F.ws + WS_ROUTE);
    int* rpos = (int*)(F.ws + WS_RPOS); int* rowtok = (int*)(F.ws + WS_ROWTOK);
    LAS unsigned* tot = (LAS unsigned*)(F.lds + L_TOT); LAS unsigned* pre = (LAS unsigned*)(F.lds + L_PRE);
    LAS unsigned* base = (LAS unsigned*)(F.lds + L_BASE); LAS unsigned* rank = (LAS unsigned*)(F.lds + L_RANK);
    for (int blk = F.vcu; blk < TT / 256; blk += F.G) {
        {
            if (F.tid < 32) { tot[F.tid] = 0u; pre[F.tid] = 0u; rank[F.tid] = 0u; }
            __syncthreads();
            const int e = F.tid & 31, part = F.tid >> 5; unsigned cv[16];
#pragma unroll
            for (int i = 0; i < 16; ++i) cv[i] = misc[MI_BLOCKCNT + (part * 16 + i) * 32 + e];
            unsigned t = 0, p = 0;
#pragma unroll
            for (int i = 0; i < 16; ++i) { t += cv[i]; p += (part * 16 + i < blk) ? cv[i] : 0u; }
            atomicAdd((unsigned*)&tot[e], t); atomicAdd((unsigned*)&pre[e], p);
        }
        __syncthreads();
        if (F.tid == 0) { unsigned a = 0; for (int e = 0; e < NEXP; ++e) { base[e] = a; a += (tot[e] + 255u) & ~255u; } base[NEXP] = a; }
        __syncthreads();
        {
            const int tok = blk * 256 + (F.tid >> 1), slot = F.tid & 1;
            const int e = route[(size_t)tok * 4 + slot];
            const unsigned r = atomicAdd((unsigned*)&rank[e], 1u);
            const unsigned pos = base[e] + pre[e] + r;
            rowtok[pos] = tok; rpos[(size_t)tok * 2 + slot] = (int)pos;
        }
        if (blk < NEXP) {
            const int e = blk; const unsigned end = base[e] + tot[e], nxt = base[e + 1];
            for (unsigned p = end + F.tid; p < nxt; p += NTHREADS) rowtok[p] = 0;
            for (unsigned p = base[e] / 256 + F.tid; p < nxt / 256; p += NTHREADS) misc[MI_PANEL_E + p] = (unsigned)e;
        }
        if (blk == 0 && F.tid == 0) misc[MI_NPAN] = base[NEXP] / 256;
        __syncthreads();
    }
}

struct MoeSched1 {
    static constexpr bool GATHER = true;
    const bf16_t* A; const bf16_t* W; int lda, ldb, ntot, G, c; const LAS int* rows; const LAS int* pe; int sw8, sa8;
    __device__ __forceinline__ bool next(int i, pg8::Unit& u) const { const int v = i * G + c; if (v >= ntot) return false; u.pm = v >> 1; u.pn = v & 1; u.ord = i; return true; }
    __device__ __forceinline__ const char* a_base(const pg8::Unit&) const { return (const char*)A; }
    __device__ __forceinline__ const char* b_base(const pg8::Unit& u) const { return (const char*)(W + (size_t)pe[u.ord] * 512 * ldb + (size_t)u.pn * 256 * ldb); }
    __device__ __forceinline__ void a_off(const pg8::Unit& u, const int (&R)[2], const int (&C)[2], unsigned (&v)[2][2]) const {
#pragma unroll
        for (int h = 0; h < 2; ++h)
#pragma unroll
            for (int i = 0; i < 2; ++i) v[h][i] = (unsigned)(rows[u.ord * 256 + h * 128 + R[i]] * lda + C[i]) * 2u;
    }
};
struct MoeSched2 {
    static constexpr bool GATHER = false;
    const bf16_t* A; const bf16_t* W; int lda, ldb, ntot, G, c; const LAS int* pe; int sw8, sa8;
    __device__ __forceinline__ bool next(int i, pg8::Unit& u) const { const int v = i * G + c; if (v >= ntot) return false; u.pm = v >> 2; u.pn = v & 3; u.ord = i; return true; }
    __device__ __forceinline__ const char* a_base(const pg8::Unit& u) const { return (const char*)(A + (size_t)u.pm * 256 * lda); }
    __device__ __forceinline__ const char* b_base(const pg8::Unit& u) const { return (const char*)(W + (size_t)pe[u.ord] * DM * ldb + (size_t)u.pn * 256 * ldb); }
    __device__ __forceinline__ void a_off(const pg8::Unit&, const int (&R)[2], const int (&C)[2], unsigned (&v)[2][2]) const {
#pragma unroll
        for (int i = 0; i < 2; ++i) { v[0][i] = (unsigned)(R[i] * lda + C[i]) * 2u; v[1][i] = (unsigned)((128 + R[i]) * lda + C[i]) * 2u; }
    }
};
struct EpiSwiGLU {
    bf16_t* H;
    __device__ __forceinline__ void operator()(const f32x4 (&acc)[2][2][4][2], const pg8::Unit& u, int wr, int wc, int fr, int fq) const {
        const int row0 = u.pm * 256 + wr * 64 + fr, col0 = u.pn * 128 + wc * 16 + 4 * fq;
#pragma unroll
        for (int ai = 0; ai < 2; ++ai)
#pragma unroll
            for (int m = 0; m < 4; ++m) { bf16_t* rowp = H + (size_t)(row0 + ai * 128 + m * 16) * DEXP + col0;
#pragma unroll
                for (int bj = 0; bj < 2; ++bj) { const f32x4 v0 = acc[ai][bj][m][0], v1 = acc[ai][bj][m][1];
                    const float h0 = v0[0] * sigmoidf_(v0[0]) * v0[1], h1 = v0[2] * sigmoidf_(v0[2]) * v0[3], h2 = v1[0] * sigmoidf_(v1[0]) * v1[1], h3 = v1[2] * sigmoidf_(v1[2]) * v1[3];
                    *(unsigned*)((unsigned char*)H + (size_t)(row0 + ai * 128 + m * 16) * DEXP + col0 + bj * 64) = pk4_fp8(h0 * 16.f, h1 * 16.f, h2 * 16.f, h3 * 16.f); (void)rowp; } }
    }
};
struct EpiStoreBf16 {
    bf16_t* O; int ldc;
    __device__ __forceinline__ void operator()(const f32x4 (&acc)[2][2][4][2], const pg8::Unit& u, int wr, int wc, int fr, int fq) const {
        const int row0 = u.pm * 256 + wr * 64 + fr, col0 = u.pn * 256 + wc * 32 + 8 * fq;
#pragma unroll
        for (int ai = 0; ai < 2; ++ai)
#pragma unroll
            for (int m = 0; m < 4; ++m) { bf16_t* rowp = O + (size_t)(row0 + ai * 128 + m * 16) * ldc + col0;
#pragma unroll
                for (int bj = 0; bj < 2; ++bj) store8_fp8((unsigned char*)O + (size_t)(row0 + ai * 128 + m * 16) * ldc + col0 + bj * 128, acc[ai][bj][m][0], acc[ai][bj][m][1], 64.f); (void)rowp; }
    }
};

__device__ __forceinline__ void phase_moe_gemm1(Frame& F) {
    PHASE_IDS(F);
    const unsigned* misc = (const unsigned*)(F.ws + WS_MISC);
    const int* rowtok = (const int*)(F.ws + WS_ROWTOK);
    const int npan = (int)misc[MI_NPAN];
    LAS int* rows = (LAS int*)(F.lds + L_ROWS); LAS int* pe = (LAS int*)(F.lds + L_PE);
    const int c = (int)blockIdx.x, ntot = npan * 2;
    for (int i = 0; i * F.G + c < ntot && i < 8; ++i) { const int p = (i * F.G + c) >> 1;
        if (F.tid < 256) rows[i * 256 + F.tid] = rowtok[p * 256 + F.tid];
        if (F.tid == 256) pe[i] = (int)misc[MI_PANEL_E + p]; }
    VM_WAIT(); LDS_WAIT(); __syncthreads();
    MoeSched1 S{(const bf16_t*)(F.ws + WS_XB8), (const bf16_t*)(F.ws + WS_W13), DM / 2, DM / 2, ntot, F.G, c, rows, pe, F8_SW, F8_SA_X};
    EpiSwiGLU E{(bf16_t*)(F.ws + WS_H)};
    pg8::gemm_phase<EpiSwiGLU, MoeSched1, true, true>(F.lds, DM / 2, S, E);
}
__device__ __forceinline__ void phase_moe_gemm2(Frame& F) {
    PHASE_IDS(F);
    const unsigned* misc = (const unsigned*)(F.ws + WS_MISC);
    const int npan = (int)misc[MI_NPAN];
    LAS int* pe = (LAS int*)(F.lds + L_PE);
    const int c = (int)blockIdx.x, ntot = npan * 4;
    __syncthreads();
    if (F.tid < 16) { const int v = F.tid * F.G + c; if (v < ntot) pe[F.tid] = (int)misc[MI_PANEL_E + (v >> 2)]; }
    VM_WAIT(); LDS_WAIT(); __syncthreads();
    MoeSched2 S{(const bf16_t*)(F.ws + WS_H), (const bf16_t*)(F.ws + WS_W2), DEXP / 2, DEXP / 2, ntot, F.G, c, pe, F8_SW, 127 - 4};
    EpiStoreBf16 E{(bf16_t*)(F.ws + WS_Y), DM};
    int k2 = DEXP / 2; asm volatile("" : "+s"(k2));
    pg8::gemm_phase<EpiStoreBf16, MoeSched2, true, true>(F.lds, k2, S, E);
}

__device__ __forceinline__ void phase_combine_ln2(Frame& F, int l) {
    PHASE_IDS(F);
    const int lane = F.lane;
    const float* lg = F.in[21] + (size_t)l * DM; const float* lb = F.in[22] + (size_t)l * DM;
    f32x4 g[4], b[4];
#pragma unroll
    for (int j = 0; j < 4; ++j) { g[j] = ((const f32x4*)lg)[lane + 64 * j]; b[j] = ((const f32x4*)lb)[lane + 64 * j]; }
    const bf16_t* Y = (const bf16_t*)(F.ws + WS_Y);
    const float* l1g = F.in[12] + (size_t)l * DM; const float* l1b = F.in[13] + (size_t)l * DM; const float* stats = (const float*)(F.ws + WS_WR + 512 * 1024);
    f32x4 g1[4], b1[4];
#pragma unroll
    for (int j = 0; j < 4; ++j) { g1[j] = ((const f32x4*)l1g)[lane + 64 * j]; b1[j] = ((const f32x4*)l1b)[lane + 64 * j]; }
    const int* route = (const int*)(F.ws + WS_ROUTE); const int* rpos = (const int*)(F.ws + WS_RPOS);
    const int gw = F.vcu * NWAVES + F.wave, NGW = F.G * NWAVES;
    int4 rt_n = *(const int4*)(route + (size_t)gw * 4); int2 rp_n = *(const int2*)(rpos + (size_t)gw * 2); f32x2 st_n = *(const f32x2*)(stats + (size_t)gw * 2);
    for (int row = gw; row < TT; row += NGW) {
        const int4 rt = rt_n; const int2 rp = rp_n; const f32x2 st = st_n;
        { const int nr = (row + NGW < TT) ? row + NGW : row; rt_n = *(const int4*)(route + (size_t)nr * 4); rp_n = *(const int2*)(rpos + (size_t)nr * 2); st_n = *(const f32x2*)(stats + (size_t)nr * 2); }
        const float w0 = __int_as_float(rt.z) * (1.f / 64.f), w1 = __int_as_float(rt.w) * (1.f / 64.f);
        const f32x4* px = (const f32x4*)(F.out + (size_t)row * DM);
        const unsigned* y0 = (const unsigned*)((const unsigned char*)Y + (size_t)rp.x * DM); const unsigned* y1 = (const unsigned*)((const unsigned char*)Y + (size_t)rp.y * DM);
        f32x4 v[4];
#pragma unroll
        for (int j = 0; j < 4; ++j) {
            const f32x4 x = (px[lane + 64 * j] - st[0]) * st[1] * g1[j] + b1[j]; const unsigned a = y0[lane + 64 * j], c = y1[lane + 64 * j];
            const f32x2 a01 = __builtin_amdgcn_cvt_pk_f32_fp8((int)a, false), a23 = __builtin_amdgcn_cvt_pk_f32_fp8((int)a, true), c01 = __builtin_amdgcn_cvt_pk_f32_fp8((int)c, false), c23 = __builtin_amdgcn_cvt_pk_f32_fp8((int)c, true);
            v[j].x = ALPHA * x.x + w0 * a01[0] + w1 * c01[0]; v[j].y = ALPHA * x.y + w0 * a01[1] + w1 * c01[1];
            v[j].z = ALPHA * x.z + w0 * a23[0] + w1 * c23[0]; v[j].w = ALPHA * x.w + w0 * a23[1] + w1 * c23[1];
        }
        ln_row(v, g, b);
#pragma unroll
        for (int j = 0; j < 4; ++j) ((f32x4*)(F.out + (size_t)row * DM))[lane + 64 * j] = v[j];
        if (l == 0) {
#pragma unroll
            for (int j = 0; j < 4; ++j) ((unsigned*)(F.ws + WS_XB8 + (size_t)row * DM))[lane + 64 * j] = pk4_fp8(v[j].x * 16.f, v[j].y * 16.f, v[j].z * 16.f, v[j].w * 16.f);
        }
    }
}

constexpr float C2D = 0.18033688011112042f;
constexpr float C2M = 0.14724444602590306f;
constexpr float IWS = 0.044194173824159216f;
constexpr float RMS_EPS = 1e-6f;
constexpr int L_QSLOT = L_CTL + 1152;

__device__ __forceinline__ int rope16(int c) { return c < 16 ? (c >> 1) + 8 * (c & 1) : c; }
__device__ __forceinline__ int win_src(int n, float& sc) {
    sc = 1.f;
    if (n < 384) return n;
    if (n < 416) { const int c = n - 384; return 384 + (c >> 1) + 16 * (c & 1); }
    if (n < 512) return -1;
    if (n < 2816) { const int m = n - 512, g = m / 768, r = m % 768, p = r >> 8, hh = (r & 255) >> 6, c = r & 63; if (p == 0) sc = C2D; return 416 + 768 * g + 256 * p + 64 * hh + (p < 2 ? rope16(c) : c); }
    if (n < 3328) { const int m = n - 2816; sc = C2D; return 2720 + (m & ~63) + rope16(m & 63); }
    if (n < 3840) { const int m = n - 3328; return 3360 + (m & ~63) + rope16(m & 63); }
    const int m = n - 3840;
    if (m < 64) return 3232 + rope16(m);
    if (m < 128) return 3296 + (m - 64);
    if (m < 192) return 3872 + rope16(m - 128);
    if (m < 200) { sc = IWS; return 3936 + (m - 192); }
    return -1;
}

__device__ __forceinline__ void sincos_d(double x, double& s, double& c) {
    const double n = __builtin_rint(x * 0.15915494309189535);
    double r = __builtin_fma(-n, 6.2831854820251465, x); r = __builtin_fma(n, 1.7484556025237907e-07, r);
    const double r2 = r * r; double ss = 1.0, cc = 1.0;
#pragma unroll
    for (int k = 15; k >= 1; --k) { ss = 1.0 - r2 * (1.0 / (double)((2 * k) * (2 * k + 1))) * ss; cc = 1.0 - r2 * (1.0 / (double)((2 * k - 1) * (2 * k))) * cc; }
    s = ss * r; c = cc;
}
__device__ __forceinline__ double inv_freq16(int i) {
    const double t[16] = {1.0, 0.44036660267178046, 0.19392274474868576, 0.08539710028576561, 0.03760603093086393, 0.016560440080994446, 0.007292664737217109, 0.003211445994752591,
                          0.001414213562373095, 0.000622772421914596, 0.0002742481756762073, 0.00012076973741146504, 5.318295896944988e-05, 2.341999896140934e-05, 1.031338537721246e-05, 4.5416704806078695e-06};
    double r = t[0];
#pragma unroll
    for (int k = 1; k < 16; ++k) r = (i == k) ? t[k] : r;
    return r;
}

__device__ __forceinline__ void phase_conv_mixer(Frame& F, int l) {
    PHASE_IDS(F);
    LAS float* scr = (LAS float*)(F.lds + F.wave * 16384);
    const int gw = F.vcu * NWAVES + F.wave, NGW = F.G * NWAVES;
    const float* win = F.in[1] + (size_t)l * DM * CIN;
    const float* qg = F.in[2] + (size_t)l * 256; const float* wuq = F.in[3] + (size_t)l * 256 * 768;
    const float* kg = F.in[4] + (size_t)l * 128; const float* wukv = F.in[5] + (size_t)l * 128 * 1024;
    const float* wgate = F.in[6] + (size_t)l * DM * 3072;
    const float* wa = F.in[8] + (size_t)l * 512 * DM; const float* wb = F.in[9] + (size_t)l * 256 * DM; const float* wc = F.in[10] + (size_t)l * 512 * DM; const float* wo = F.in[11] + (size_t)l * DM * DM;
    unsigned char* WIN8 = F.ws + WS_WIN8; bf16_t* WUQ = (bf16_t*)(F.ws + WS_WUQ); bf16_t* WUKV = (bf16_t*)(F.ws + WS_WUKV);
    bf16_t* WA = (bf16_t*)(F.ws + WS_WA); bf16_t* WB = (bf16_t*)(F.ws + WS_WB); bf16_t* WC = (bf16_t*)(F.ws + WS_WC); bf16_t* WO = (bf16_t*)(F.ws + WS_WO);
    constexpr int I_IN = 16 * 128, I_G = 16 * 96, I_UQ = 4 * 24, I_UKV = 4 * 32, I_A = 8 * 32, I_B = 8 * 32, I_C = 8 * 32, I_O = 16 * 32;
    constexpr int NIT = I_IN + I_G + I_UQ + I_UKV + I_A + I_B + I_C + I_O;
    for (int it = gw; it < NIT; it += NGW) {
        int r = it;
        if (r < I_IN) { conv_item8(WIN8, DM, (r / 128) * 64, (r % 128) * 32, scr, F.lane, [&](int k, int n) { float sc; const int sidx = win_src(n, sc); return sidx < 0 ? 0.f : win[(size_t)k * CIN + sidx] * (sc * 1024.f); }); continue; } r -= I_IN;
        if (r < I_G) { conv_plain8(WIN8 + (size_t)PW * DM, DM, (r / 96) * 64, (r % 96) * 32, scr, F.lane, wgate, 3072, 1024.f); continue; } r -= I_G;
        if (r < I_UQ) { conv_item(WUQ, 256, (r / 24) * 64, (r % 24) * 32, scr, F.lane, [&](int k, int n) { const int hh = n / 96, c = n % 96; const int o = c < 64 ? c : 64 + ((c - 64) >> 1) + 16 * ((c - 64) & 1);
                return qg[k] * wuq[(size_t)k * 768 + hh * 96 + o] * C2M; }); continue; } r -= I_UQ;
        if (r < I_UKV) { conv_item(WUKV, 256, (r / 32) * 64, (r % 32) * 32, scr, F.lane, [&](int k, int n) { return k < 128 ? kg[k] * wukv[(size_t)k * 1024 + n] : 0.f; }); continue; } r -= I_UKV;
        if (r < I_A) { conv_plain8((unsigned char*)WA, 512, (r / 32) * 64, (r % 32) * 32, scr, F.lane, wa, DM, 1024.f); continue; } r -= I_A;
        if (r < I_B) { conv_item8((unsigned char*)WB, 512, (r / 32) * 64, (r % 32) * 32, scr, F.lane, [&](int k, int n) { return k < 256 ? wb[(size_t)k * DM + n] * 1024.f : 0.f; }); continue; } r -= I_B;
        if (r < I_C) { conv_plain8((unsigned char*)WC, 512, (r / 32) * 64, (r % 32) * 32, scr, F.lane, wc, DM, 1024.f); continue; } r -= I_C;
        conv_plain8((unsigned char*)WO, DM, (r / 32) * 64, (r % 32) * 32, scr, F.lane, wo, DM, 1024.f);
    }
    if (l == 0) {
        float* rp = (float*)(F.ws + WS_ROPE); float* rm = rp + 2048 * 8 * 2;
        for (int idx = F.vcu * NTHREADS + F.tid; idx < 2048 * 24; idx += F.G * NTHREADS) {
            const int t = idx / 24, j = idx % 24; double sn, cs;
            if (j < 8) { sincos_d((double)t * inv_freq16(2 * j), sn, cs); rp[(t * 8 + j) * 2] = (float)cs; rp[(t * 8 + j) * 2 + 1] = (float)sn; }
            else { sincos_d((double)t * inv_freq16(j - 8), sn, cs); rm[(t * 16 + (j - 8)) * 2] = (float)cs; rm[(t * 16 + (j - 8)) * 2 + 1] = (float)sn; }
        }
        const f32x4* x4 = (const f32x4*)F.in[0]; unsigned* xb8 = (unsigned*)(F.ws + WS_XB8);
        for (size_t i = (size_t)F.vcu * NTHREADS + F.tid; i < (size_t)TT * DM / 4; i += (size_t)F.G * NTHREADS) { const f32x4 v = x4[i] * 16.f; xb8[i] = pk4_fp8(v.x, v.y, v.z, v.w); }
    }
}

__device__ __forceinline__ void rope4(f32x4& v0, f32x4& v1, const float* cs) {
    const f32x4 a = *(const f32x4*)cs, b = *(const f32x4*)(cs + 4);
    const f32x4 w0 = {v0[0] * a[0] - v0[1] * a[1], v0[1] * a[0] + v0[0] * a[1], v0[2] * a[2] - v0[3] * a[3], v0[3] * a[2] + v0[2] * a[3]};
    const f32x4 w1 = {v1[0] * b[0] - v1[1] * b[1], v1[1] * b[0] + v1[0] * b[1], v1[2] * b[2] - v1[3] * b[3], v1[3] * b[2] + v1[2] * b[3]};
    v0 = w0; v1 = w1;
}
__device__ __forceinline__ void store8(bf16_t* p, const f32x4& v0, const f32x4& v1) {
    u32x4 w; w.x = cvt_pk_bf16(v0[0], v0[1]); w.y = cvt_pk_bf16(v0[2], v0[3]); w.z = cvt_pk_bf16(v1[0], v1[1]); w.w = cvt_pk_bf16(v1[2], v1[3]); *(u32x4*)p = w;
}
struct EpiProj {
    bf16_t* P; const float* csp; const float* csm; float* ssq; bf16_t* G3; const LAS float* gbias;
    __device__ __forceinline__ void operator()(const f32x4 (&acc)[2][2][4][2], const pg8::Unit& u, int wr, int wc, int fr, int fq) const {
        const int pn = u.pn, row0 = u.pm * 256 + wr * 64 + fr;
        if (pn >= 16) {
#pragma unroll
            for (int bj = 0; bj < 2; ++bj) { const int col = (pn - 16) * 256 + bj * 128 + wc * 32 + fq * 8;
                const f32x4 b0 = *(const LAS f32x4*)(gbias + col), b1 = *(const LAS f32x4*)(gbias + col + 4);
#pragma unroll
                for (int ai = 0; ai < 2; ++ai)
#pragma unroll
                    for (int m = 0; m < 4; ++m) { f32x4 v0 = acc[ai][bj][m][0] + b0, v1 = acc[ai][bj][m][1] + b1;
#pragma unroll
                        for (int e = 0; e < 4; ++e) { v0[e] = sigmoidf_(v0[e]); v1[e] = sigmoidf_(v1[e]); }
                        store8_fp8((unsigned char*)G3 + (size_t)(row0 + ai * 128 + m * 16) * 3072 + col, v0, v1, 64.f); } }
            return;
        }
#pragma unroll
        for (int bj = 0; bj < 2; ++bj) {
            const int wcu = __builtin_amdgcn_readfirstlane(wc);
            bool ropeP = false, ropeM = false;
            if (pn == 1) ropeM = (bj == 1 && wcu == 0);
            else if (pn >= 2 && pn < 11) ropeP = ((pn - 2) % 3) < 2 && !(wcu & 1);
            else if (pn >= 11 && pn < 15) ropeP = !(wcu & 1);
            else if (pn == 15) ropeP = (wcu == 0);
            const int col = pn * 256 + bj * 128 + wc * 32 + fq * 8;
            if (ropeP || ropeM) {
                const bool lr = ropeM || fq < 2;
                const float* cb = ropeM ? csm + 8 * fq : csp + 8 * (fq & 1);
                const int ts = ropeM ? 32 : 16;
#pragma unroll
                for (int ai = 0; ai < 2; ++ai)
#pragma unroll
                    for (int mh = 0; mh < 2; ++mh) {
                        f32x4 ca[2], cc[2];
#pragma unroll
                        for (int mm = 0; mm < 2; ++mm) { const int t = (row0 + ai * 128 + (2 * mh + mm) * 16) & (SEQ - 1);
                            ca[mm] = *(const f32x4*)(cb + t * ts); cc[mm] = *(const f32x4*)(cb + t * ts + 4); }
#pragma unroll
                        for (int mm = 0; mm < 2; ++mm) { const int m = 2 * mh + mm, row = row0 + ai * 128 + m * 16;
                            const f32x4 v0 = acc[ai][bj][m][0], v1 = acc[ai][bj][m][1];
                            f32x4 a = ca[mm], b = cc[mm];
                            if (!lr) { a = (f32x4){1.f, 0.f, 1.f, 0.f}; b = a; }
                            const f32x4 w0 = {v0[0] * a[0] - v0[1] * a[1], v0[1] * a[0] + v0[0] * a[1], v0[2] * a[2] - v0[3] * a[3], v0[3] * a[2] + v0[2] * a[3]};
                            const f32x4 w1 = {v1[0] * b[0] - v1[1] * b[1], v1[1] * b[0] + v1[0] * b[1], v1[2] * b[2] - v1[3] * b[3], v1[3] * b[2] + v1[2] * b[3]};
                            store8(P + (size_t)row * PW + col, w0, w1); }
                    }
            } else {
#pragma unroll
                for (int ai = 0; ai < 2; ++ai)
#pragma unroll
                    for (int m = 0; m < 4; ++m)
                        store8(P + (size_t)(row0 + ai * 128 + m * 16) * PW + col, acc[ai][bj][m][0], acc[ai][bj][m][1]);
            }
        }
        if (pn < 2) {
#pragma unroll
            for (int ai = 0; ai < 2; ++ai)
#pragma unroll
                for (int m = 0; m < 4; ++m) {
                    float sq = 0.f;
#pragma unroll
                    for (int bj = 0; bj < 2; ++bj) if (pn == 0 || bj == 0) {
#pragma unroll
                        for (int n = 0; n < 2; ++n) { const f32x4 x = acc[ai][bj][m][n]; sq += (x[0] * x[0] + x[1] * x[1]) + (x[2] * x[2] + x[3] * x[3]); } }
                    sq += __shfl_xor(sq, 16); sq += __shfl_xor(sq, 32);
                    if (fq == 0) ssq[(size_t)(row0 + ai * 128 + m * 16) * 8 + pn * 4 + wc] = sq;
                }
        }
    }
};
struct EpiUpQ {
    bf16_t* Q; const float* csm; const float* ssq;
    __device__ __forceinline__ void operator()(const f32x4 (&acc)[2][2][4][2], const pg8::Unit& u, int wr, int wc, int fr, int fq) const {
        const int row0 = u.pm * 256 + wr * 64 + fr;
        f32x4 spv[2][4];
#pragma unroll
        for (int ai = 0; ai < 2; ++ai)
#pragma unroll
            for (int m = 0; m < 4; ++m) spv[ai][m] = *(const f32x4*)(ssq + (size_t)(row0 + ai * 128 + m * 16) * 8);
#pragma unroll
        for (int ai = 0; ai < 2; ++ai)
#pragma unroll
            for (int m = 0; m < 4; ++m) { const f32x4 sp = spv[ai][m];
                spv[ai][m][0] = 1.0f / sqrtf(((sp[0] + sp[1]) + (sp[2] + sp[3])) * (1.f / 256.f) + RMS_EPS); }
        const int wcu = __builtin_amdgcn_readfirstlane(wc);
#pragma unroll
        for (int bj = 0; bj < 2; ++bj) {
            const int c0 = u.pn * 256 + bj * 128 + wcu * 32, col = c0 + fq * 8;
            if (((c0 >> 5) % 3) == 2) {
#pragma unroll
                for (int ai = 0; ai < 2; ++ai)
#pragma unroll
                    for (int mh = 0; mh < 2; ++mh) {
                        f32x4 ca[2], cc[2];
#pragma unroll
                        for (int mm = 0; mm < 2; ++mm) { const int t = (row0 + ai * 128 + (2 * mh + mm) * 16) & (SEQ - 1);
                            ca[mm] = *(const f32x4*)(csm + t * 32 + 8 * fq); cc[mm] = *(const f32x4*)(csm + t * 32 + 8 * fq + 4); }
#pragma unroll
                        for (int mm = 0; mm < 2; ++mm) { const int m = 2 * mh + mm, row = row0 + ai * 128 + m * 16;
                            const float rs = spv[ai][m][0];
                            const f32x4 v0 = acc[ai][bj][m][0] * rs, v1 = acc[ai][bj][m][1] * rs, a = ca[mm], b = cc[mm];
                            const f32x4 w0 = {v0[0] * a[0] - v0[1] * a[1], v0[1] * a[0] + v0[0] * a[1], v0[2] * a[2] - v0[3] * a[3], v0[3] * a[2] + v0[2] * a[3]};
                            const f32x4 w1 = {v1[0] * b[0] - v1[1] * b[1], v1[1] * b[0] + v1[0] * b[1], v1[2] * b[2] - v1[3] * b[3], v1[3] * b[2] + v1[2] * b[3]};
                            store8(Q + (size_t)row * 768 + col, w0, w1); }
                    }
            } else {
#pragma unroll
                for (int ai = 0; ai < 2; ++ai)
#pragma unroll
                    for (int m = 0; m < 4; ++m) { const float rs = spv[ai][m][0];
                        store8(Q + (size_t)(row0 + ai * 128 + m * 16) * 768 + col, acc[ai][bj][m][0] * rs, acc[ai][bj][m][1] * rs); }
            }
        }
    }
};
struct EpiUpKV {
    bf16_t* KV; const float* ssq;
    __device__ __forceinline__ void operator()(const f32x4 (&acc)[2][2][4][2], const pg8::Unit& u, int wr, int wc, int fr, int fq) const {
        const int row0 = u.pm * 256 + wr * 64 + fr;
        f32x4 spv[2][4];
#pragma unroll
        for (int ai = 0; ai < 2; ++ai)
#pragma unroll
            for (int m = 0; m < 4; ++m) spv[ai][m] = *(const f32x4*)(ssq + (size_t)(row0 + ai * 128 + m * 16) * 8 + 4);
#pragma unroll
        for (int ai = 0; ai < 2; ++ai)
#pragma unroll
            for (int m = 0; m < 4; ++m) {
                const int row = row0 + ai * 128 + m * 16;
                const f32x4 sp = spv[ai][m];
                const float rs = 1.0f / sqrtf(((sp[0] + sp[1]) + (sp[2] + sp[3])) * (1.f / 128.f) + RMS_EPS);
#pragma unroll
                for (int bj = 0; bj < 2; ++bj) { const int col = u.pn * 256 + bj * 128 + wc * 32 + fq * 8;
                    store8(KV + (size_t)row * 1024 + col, acc[ai][bj][m][0] * rs, acc[ai][bj][m][1] * rs); }
            }
    }
};
struct EpiBranchAll {
    bf16_t* Mg; bf16_t* M0; bf16_t* M1; const bf16_t* G3;
    __device__ __forceinline__ void operator()(const f32x4 (&acc)[2][2][4][2], const pg8::Unit& u, int wr, int wc, int fr, int fq) const {
        const int row0 = u.pm * 256 + wr * 64 + fr, br = u.ord, col0 = u.pn * 256 + wc * 32 + fq * 8;
        bf16_t* dst = br == 0 ? M0 : (br == 1 ? M1 : Mg);
#pragma unroll
        for (int ai = 0; ai < 2; ++ai)
#pragma unroll
            for (int mh = 0; mh < 2; ++mh) {
                u32x2 gw[2][2]; u32x4 ma[2][2], mb[2][2];
#pragma unroll
                for (int mm = 0; mm < 2; ++mm)
#pragma unroll
                    for (int bj = 0; bj < 2; ++bj) { const int row = row0 + ai * 128 + (2 * mh + mm) * 16, col = col0 + bj * 128;
                        gw[mm][bj] = *(const u32x2*)((const unsigned char*)G3 + (size_t)row * 3072 + br * 1024 + col);
                        ma[mm][bj] = (u32x4){0u, 0u, 0u, 0u}; mb[mm][bj] = (u32x4){0u, 0u, 0u, 0u}; }
                if (br == 2) {
#pragma unroll
                    for (int mm = 0; mm < 2; ++mm)
#pragma unroll
                        for (int bj = 0; bj < 2; ++bj) { const size_t off = (size_t)(row0 + ai * 128 + (2 * mh + mm) * 16) * DM + col0 + bj * 128;
                            const u32x2 p = *(const u32x2*)((const unsigned char*)M0 + off), q = *(const u32x2*)((const unsigned char*)M1 + off);
                            ma[mm][bj] = (u32x4){p.x, p.y, 0u, 0u}; mb[mm][bj] = (u32x4){q.x, q.y, 0u, 0u}; }
                }
#pragma unroll
                for (int mm = 0; mm < 2; ++mm)
#pragma unroll
                    for (int bj = 0; bj < 2; ++bj) { const int m = 2 * mh + mm; const size_t off = (size_t)(row0 + ai * 128 + m * 16) * DM + col0 + bj * 128; const u32x2 g = gw[mm][bj]; const u32x4 a = ma[mm][bj], b2 = mb[mm][bj];
                        const f32x2 g01 = __builtin_amdgcn_cvt_pk_f32_fp8((int)g.x, false) * (1.f / 64.f), g23 = __builtin_amdgcn_cvt_pk_f32_fp8((int)g.x, true) * (1.f / 64.f);
                        const f32x2 g45 = __builtin_amdgcn_cvt_pk_f32_fp8((int)g.y, false) * (1.f / 64.f), g67 = __builtin_amdgcn_cvt_pk_f32_fp8((int)g.y, true) * (1.f / 64.f);
                        f32x4 v0 = acc[ai][bj][m][0], v1 = acc[ai][bj][m][1];
                        const f32x2 s01 = (__builtin_amdgcn_cvt_pk_f32_fp8((int)a.x, false) + __builtin_amdgcn_cvt_pk_f32_fp8((int)b2.x, false)) * (1.f / 64.f), s23 = (__builtin_amdgcn_cvt_pk_f32_fp8((int)a.x, true) + __builtin_amdgcn_cvt_pk_f32_fp8((int)b2.x, true)) * (1.f / 64.f);
                        const f32x2 s45 = (__builtin_amdgcn_cvt_pk_f32_fp8((int)a.y, false) + __builtin_amdgcn_cvt_pk_f32_fp8((int)b2.y, false)) * (1.f / 64.f), s67 = (__builtin_amdgcn_cvt_pk_f32_fp8((int)a.y, true) + __builtin_amdgcn_cvt_pk_f32_fp8((int)b2.y, true)) * (1.f / 64.f);
                        v0[0] = v0[0] * g01[0] + s01[0]; v0[1] = v0[1] * g01[1] + s01[1]; v0[2] = v0[2] * g23[0] + s23[0]; v0[3] = v0[3] * g23[1] + s23[1];
                        v1[0] = v1[0] * g45[0] + s45[0]; v1[1] = v1[1] * g45[1] + s45[1]; v1[2] = v1[2] * g67[0] + s67[0]; v1[3] = v1[3] * g67[1] + s67[1];
                        store8_fp8((unsigned char*)dst + off, v0, v1, 64.f); }
            }
    }
};
struct BranchSched {
    static constexpr bool GATHER = false; static constexpr bool VARK = true;
    const char* A0; const char* B0; size_t sA, sB; int lda, ldb, c, sw8, sa8, G, ntile;
    __device__ __forceinline__ int ktiles(const pg8::Unit& u) const { return u.ord == 1 ? 2 : 4; }
    __device__ __forceinline__ bool next(int i, pg8::Unit& u) const { const int t = c + (i / 3) * G; if (t >= ntile) return false; u.pm = t >> 2; u.pn = t & 3; u.ord = i % 3; return true; }
    __device__ __forceinline__ const char* a_base(const pg8::Unit& u) const { return A0 + (size_t)u.ord * sA + (size_t)u.pm * 256 * lda * 2; }
    __device__ __forceinline__ const char* b_base(const pg8::Unit& u) const { return B0 + (size_t)u.ord * sB + (size_t)u.pn * 256 * ldb * 2; }
    __device__ __forceinline__ void a_off(const pg8::Unit&, const int (&R)[2], const int (&C)[2], unsigned (&v)[2][2]) const {
#pragma unroll
        for (int i = 0; i < 2; ++i) { v[0][i] = (unsigned)(R[i] * lda + C[i]) * 2u; v[1][i] = (unsigned)((128 + R[i]) * lda + C[i]) * 2u; }
    }
};
struct EpiWo {
    float* out; const float* xsrc; int rowbase;
    __device__ __forceinline__ void operator()(const f32x4 (&acc)[2][2][4][2], const pg8::Unit& u, int wr, int wc, int fr, int fq) const {
        const int row0 = rowbase + u.pm * 256 + wr * 64 + fr, col0 = u.pn * 256 + wc * 32 + fq * 8;
#pragma unroll
        for (int ai = 0; ai < 2; ++ai)
#pragma unroll
            for (int mh = 0; mh < 2; ++mh) {
                f32x4 x[2][2][2];
#pragma unroll
                for (int mm = 0; mm < 2; ++mm)
#pragma unroll
                    for (int bj = 0; bj < 2; ++bj) { const size_t off = (size_t)(row0 + ai * 128 + (2 * mh + mm) * 16) * DM + col0 + bj * 128;
                        x[mm][bj][0] = *(const f32x4*)(xsrc + off); x[mm][bj][1] = *(const f32x4*)(xsrc + off + 4); }
#pragma unroll
                for (int mm = 0; mm < 2; ++mm)
#pragma unroll
                    for (int bj = 0; bj < 2; ++bj) { const size_t off = (size_t)(row0 + ai * 128 + (2 * mh + mm) * 16) * DM + col0 + bj * 128;
                        *(f32x4*)(out + off) = x[mm][bj][0] * ALPHA + acc[ai][bj][2 * mh + mm][0]; *(f32x4*)(out + off + 4) = x[mm][bj][1] * ALPHA + acc[ai][bj][2 * mh + mm][1]; }
            }
    }
};

__device__ __forceinline__ int dequeue(Frame& F, unsigned* ctr, int& pre) {
    LAS int* slot = (LAS int*)(F.lds + L_QSLOT);
    __syncthreads();
    if (F.tid == 0) {
        *slot = (int)__hip_atomic_fetch_add(ctr, 1u, __ATOMIC_RELAXED, __HIP_MEMORY_SCOPE_AGENT); (void)pre;
    }
    __syncthreads();
    return *slot;
}

namespace att {
constexpr int KSLOT = 12288, VSLOT = 8192, NSLOT = 4;
constexpr int A_K = 0, A_V = NSLOT * KSLOT, A_WS = A_V + NSLOT * VSLOT, A_OST = A_WS + 8 * 256, A_MW = A_OST + 8 * 4096, A_END = A_MW + 8 * NSLOT * 256;
static_assert(A_END <= RING_BYTES, "attention LDS");
typedef short s16x4 __attribute__((ext_vector_type(4)));
__device__ __forceinline__ int crow(int r, int hi) { return (r & 3) + 8 * (r >> 2) + 4 * hi; }
__device__ __forceinline__ void glds16(const void* gsrc, unsigned lds_dst) { unsigned keep;
    asm volatile("s_mov_b32 %0, m0\n\ts_mov_b32 m0, %2\n\ts_nop 0\n\tglobal_load_lds_dwordx4 %1, off\n\ts_mov_b32 m0, %0" : "=&s"(keep) : "v"(gsrc), "s"(lds_dst) : "memory"); }
__device__ __forceinline__ void glds4(const void* gsrc, unsigned lds_dst) { unsigned keep;
    asm volatile("s_mov_b32 %0, m0\n\ts_mov_b32 m0, %2\n\ts_nop 0\n\tglobal_load_lds_dword %1, off\n\ts_mov_b32 m0, %0" : "=&s"(keep) : "v"(gsrc), "s"(lds_dst) : "memory"); }
#define ATT_WAIT_BAR(N) asm volatile("s_waitcnt vmcnt(" #N ") lgkmcnt(0)\n\ts_barrier" ::: "memory")
__device__ __forceinline__ float emax(float a, float b) { return __builtin_elementwise_maximum(a, b); }
__device__ __forceinline__ float halfmax(float m) { auto rr = __builtin_amdgcn_permlane32_swap(__float_as_uint(m), __float_as_uint(m), false, false); return emax(__uint_as_float(rr[0]), __uint_as_float(rr[1])); }
__device__ __forceinline__ float halfsum(float m) { auto rr = __builtin_amdgcn_permlane32_swap(__float_as_uint(m), __float_as_uint(m), false, false); return __uint_as_float(rr[0]) + __uint_as_float(rr[1]); }
typedef short v4i16_t __attribute__((ext_vector_type(4)));
__device__ __forceinline__ s16x4 vtr(const LAS unsigned char* p) { return __builtin_bit_cast(s16x4, __builtin_amdgcn_ds_read_tr16_b64_v4i16((LAS v4i16_t*)p)); }
__device__ __forceinline__ void pv(f32x16* o, f32x16& lacc, const LAS unsigned char* vp, bf16x8 pa0, bf16x8 pa1, bf16x8 pa2, bf16x8 pa3) {
    { const u32x4 one4 = {0x3F803F80u, 0x3F803F80u, 0x3F803F80u, 0x3F803F80u}; const bf16x8 ones = __builtin_bit_cast(bf16x8, one4);
      lacc = __builtin_amdgcn_mfma_f32_32x32x16_bf16(pa0, ones, lacc, 0, 0, 0); lacc = __builtin_amdgcn_mfma_f32_32x32x16_bf16(pa1, ones, lacc, 0, 0, 0);
      lacc = __builtin_amdgcn_mfma_f32_32x32x16_bf16(pa2, ones, lacc, 0, 0, 0); lacc = __builtin_amdgcn_mfma_f32_32x32x16_bf16(pa3, ones, lacc, 0, 0, 0); }
#pragma unroll
    for (int d0 = 0; d0 < 2; ++d0) { s16x4 lo[4], hi[4];
#pragma unroll
        for (int ks = 0; ks < 4; ++ks) { lo[ks] = vtr(vp + d0 * 4096 + ks * 1024); hi[ks] = vtr(vp + d0 * 4096 + ks * 1024 + 512); }
#define ATT_PK(k) (bf16x8){lo[k][0], lo[k][1], lo[k][2], lo[k][3], hi[k][0], hi[k][1], hi[k][2], hi[k][3]}
        o[d0] = __builtin_amdgcn_mfma_f32_32x32x16_bf16(pa0, ATT_PK(0), o[d0], 0, 0, 0);
        o[d0] = __builtin_amdgcn_mfma_f32_32x32x16_bf16(pa1, ATT_PK(1), o[d0], 0, 0, 0);
        o[d0] = __builtin_amdgcn_mfma_f32_32x32x16_bf16(pa2, ATT_PK(2), o[d0], 0, 0, 0);
        o[d0] = __builtin_amdgcn_mfma_f32_32x32x16_bf16(pa3, ATT_PK(3), o[d0], 0, 0, 0);
#undef ATT_PK
    }
}
struct Desc {
    const bf16_t* Q; const bf16_t* K1; const bf16_t* K2; const bf16_t* V; bf16_t* O; float* lse; const unsigned* mask;
    int qpitch, k1pitch, k2pitch, vpitch, opitch, lsepitch;
    int rstride, q0, nq, jlo, jhi;
    int o8;
};
template <int DQK, int MODE, bool DUAL = false>
__device__ __forceinline__ void attn_unit(LAS unsigned char* lds, const Desc& d) {
    static_assert(!DUAL || (DQK == 64 && MODE == 0), "dual mode");
    constexpr int NSLOT = DUAL ? 2 : att::NSLOT, KSLOT = DUAL ? 8192 : att::KSLOT;
    constexpr int A_K = 0, A_V = DUAL ? 32768 : att::A_V, A_WS = DUAL ? 65536 : att::A_WS, A_OST = DUAL ? 67584 : att::A_OST, A_MW = att::A_MW;
    int tid_ = threadIdx.x; asm volatile("" : "+v"(tid_));
    const int tid = tid_, lane = tid & 63, r32 = lane & 31, hi = lane >> 5, wid = __builtin_amdgcn_readfirstlane(tid >> 6);
    constexpr int ND = DQK / 16;
    const unsigned lds0 = (unsigned)(size_t)lds;
    LAS float* wsf = (LAS float*)(lds + A_WS) + wid * 64;
    const int grp = DUAL ? (wid >> 2) : 0, w4 = DUAL ? (wid & 3) : wid, gofs = grp * 16384;
    Desc dd = d;
    if (DUAL) { dd.Q = d.Q + (size_t)grp * d.qpitch; dd.K1 = d.K1 + (size_t)grp * d.k1pitch; dd.V = d.V + (size_t)grp * d.vpitch; dd.O = d.O + (size_t)grp * d.opitch; if (d.lse) dd.lse = d.lse + (size_t)grp * d.lsepitch; }
    const Desc& d_ = dd;
    const int qw = d.q0 + w4 * 32;
    const bool wvalid = DUAL || wid * 32 < d.nq;
    const int kkey = 8 * wid + (lane >> 3), kch = (lane & 7) ^ ((kkey >> 1) & 7);
    const bf16_t* ksrc = d_.K1 + (size_t)kkey * d.rstride * d.k1pitch + kch * 8;
    const int k2key = 16 * (wid & 3) + (lane >> 2), k2ch = (lane & 3) ^ ((k2key >> 2) & 3);
    const bf16_t* k2src = (DQK == 96) ? d_.K2 + (size_t)k2key * d.rstride * d.k2pitch + k2ch * 8 : nullptr;
    int kofs[ND];
#pragma unroll
    for (int d0 = 0; d0 < ND; ++d0) kofs[d0] = d0 < 4 ? r32 * 128 + (((2 * d0 + hi) ^ ((r32 >> 1) & 7)) * 16) : 8192 + r32 * 64 + (((2 * (d0 - 4) + hi) ^ ((r32 >> 2) & 3)) * 16);
    const bf16_t* vsrc = d_.V + (size_t)(16 * (wid & 3) + (lane >> 2)) * d.rstride * d.vpitch + (DUAL ? 0 : (wid >> 2) * 32) + (lane & 3) * 8;
    const int kkeyB = 8 * (2 * w4 + 1) + (lane >> 3);
    const bf16_t* ksrcA = DUAL ? d_.K1 + (size_t)(8 * (2 * w4) + (lane >> 3)) * d.rstride * d.k1pitch + (((lane & 7) ^ (((8 * (2 * w4) + (lane >> 3)) >> 1) & 7)) * 8) : nullptr;
    const bf16_t* ksrcB = DUAL ? d_.K1 + (size_t)kkeyB * d.rstride * d.k1pitch + (((lane & 7) ^ ((kkeyB >> 1) & 7)) * 8) : nullptr;
    const size_t kstep = (size_t)64 * d.rstride * d.k1pitch, k2step = (size_t)64 * d.rstride * d.k2pitch, vstep = (size_t)64 * d.rstride * d.vpitch;
    const bool two = (DQK == 96) && wid < 4;
    const unsigned* msrc = (MODE == 2) ? d.mask + (size_t)(wvalid ? (qw + (lane >> 1)) : d.q0) * 64 + (lane & 1) : nullptr;
#define ATT_ISSUE(j) do { const int sl_ = (j) % NSLOT; \
        if (DUAL) { \
            glds16(ksrcA + (size_t)(j) * kstep, (unsigned)__builtin_amdgcn_readfirstlane(lds0 + A_K + gofs + sl_ * KSLOT + (2 * w4) * 1024)); \
            glds16(ksrcB + (size_t)(j) * kstep, (unsigned)__builtin_amdgcn_readfirstlane(lds0 + A_K + gofs + sl_ * KSLOT + (2 * w4 + 1) * 1024)); \
            glds16(vsrc + (size_t)(j) * vstep, (unsigned)__builtin_amdgcn_readfirstlane(lds0 + A_V + gofs + sl_ * VSLOT + w4 * 1024)); \
            glds16(vsrc + 32 + (size_t)(j) * vstep, (unsigned)__builtin_amdgcn_readfirstlane(lds0 + A_V + gofs + sl_ * VSLOT + (4 + w4) * 1024)); \
            break; } \
        glds16(ksrc + (size_t)(j) * kstep, (unsigned)__builtin_amdgcn_readfirstlane(lds0 + A_K + sl_ * KSLOT + wid * 1024)); \
        if (two) glds16(k2src + (size_t)(j) * k2step, (unsigned)__builtin_amdgcn_readfirstlane(lds0 + A_K + sl_ * KSLOT + (8 + wid) * 1024)); \
        glds16(vsrc + (size_t)(j) * vstep, (unsigned)__builtin_amdgcn_readfirstlane(lds0 + A_V + sl_ * VSLOT + wid * 1024)); \
        if (MODE == 2) glds4(msrc + 2 * (j), (unsigned)__builtin_amdgcn_readfirstlane(lds0 + A_MW + (wid * NSLOT + sl_) * 256)); } while (0)
    ATT_ISSUE(d.jlo);
    if (d.jlo + 1 < d.jhi) ATT_ISSUE(d.jlo + 1);
    bf16x8 qr[ND];
    { const int qi = wvalid ? (qw + r32) : d.q0; const bf16_t* qp = d_.Q + (size_t)qi * d.rstride * d.qpitch + hi * 8;
#pragma unroll
      for (int d0 = 0; d0 < ND; ++d0) qr[d0] = *(const bf16x8*)(qp + d0 * 16); }
#pragma unroll
    for (int d0 = 0; d0 < ND; ++d0) asm volatile("" : "+v"(qr[d0]));
    float mhat = 0.f; f32x16 o[2]; o[0] = f32x16{}; o[1] = f32x16{}; f32x16 lacc = f32x16{};
    bool started = false;
    const LAS unsigned char* vp0 = lds + A_V + gofs + ((lane >> 4) & 1) * 32 + (lane & 3) * 8 + (4 * hi + ((lane & 15) >> 2)) * 64;
    const int qi = qw + r32;
    f32x16 p0 = f32x16{}, p1 = f32x16{};
    f32x16 negm = f32x16{};
#define ATT_REL(j) (wvalid && (64 * (j) <= qw + 31) && (MODE != 1 || (64 * (j) + 63 >= qw - 128)))
#define ATT_QK(j) do { const int sl_ = (j) % NSLOT; \
        const LAS unsigned char* kb = lds + A_K + gofs + sl_ * KSLOT; bf16x8 kf[2 * ND]; \
        _Pragma("unroll") for (int d0 = 0; d0 < ND; ++d0) { kf[2 * d0] = *(const LAS bf16x8*)(kb + kofs[d0]); kf[2 * d0 + 1] = *(const LAS bf16x8*)(kb + kofs[d0] + (d0 < 4 ? 4096 : 2048)); } \
        __builtin_amdgcn_sched_barrier(0); \
        _Pragma("unroll") for (int d0 = 0; d0 < ND; ++d0) { \
            if (d0 == 0) { p0 = __builtin_amdgcn_mfma_f32_32x32x16_bf16(kf[0], qr[0], negm, 0, 0, 0); p1 = __builtin_amdgcn_mfma_f32_32x32x16_bf16(kf[1], qr[0], negm, 0, 0, 0); } \
            else { p0 = __builtin_amdgcn_mfma_f32_32x32x16_bf16(kf[2 * d0], qr[d0], p0, 0, 0, 0); p1 = __builtin_amdgcn_mfma_f32_32x32x16_bf16(kf[2 * d0 + 1], qr[d0], p1, 0, 0, 0); } } } while (0)
#define ATT_SMPV(j) do { const int sl_ = (j) % NSLOT; \
        { bool domask = true; unsigned mx_ = 0u, my_ = 0u;        \
          if (MODE == 2) { const u32x2 mw = *(const LAS u32x2*)(lds + A_MW + (wid * NSLOT + sl_) * 256 + r32 * 8); mx_ = mw.x; my_ = mw.y; } \
          else { \
            bool full = (64 * (j) + 63 <= qw); \
            if (MODE == 1) full = full && (64 * (j) >= qw + 31 - 128); \
            domask = !full; \
            if (domask) { const int a_ = qi - 64 * (j), lo_ = (MODE == 1) ? a_ - 128 : -4096;        \
                { const int h_ = a_ < 31 ? a_ : 31, l_ = lo_ > 0 ? lo_ : 0; mx_ = (h_ < l_) ? 0u : ((0xFFFFFFFFu >> (31 - h_)) & (0xFFFFFFFFu << l_)); } \
                { const int h_ = a_ - 32 < 31 ? a_ - 32 : 31, l_ = lo_ - 32 > 0 ? lo_ - 32 : 0; my_ = (h_ < l_) ? 0u : ((0xFFFFFFFFu >> (31 - h_)) & (0xFFFFFFFFu << l_)); } } \
          } \
          if (domask) { const unsigned w0 = mx_ >> (4 * hi), w1 = my_ >> (4 * hi); \
            _Pragma("unroll") for (int r = 0; r < 16; ++r) { const int bit = (r & 3) + 8 * (r >> 2); \
                const unsigned m0 = (unsigned)__builtin_amdgcn_sbfe((int)w0, bit, 1), m1 = (unsigned)__builtin_amdgcn_sbfe((int)w1, bit, 1);        \
                p0[r] = __uint_as_float((m0 & __float_as_uint(p0[r])) | (~m0 & 0xFF800000u)); p1[r] = __uint_as_float((m1 & __float_as_uint(p1[r])) | (~m1 & 0xFF800000u)); } } } \
        float rm = emax(p0[0], p1[0]), rm2 = emax(p0[1], p1[1]); \
        _Pragma("unroll") for (int r = 2; r < 16; r += 2) { rm = emax(emax(rm, p0[r]), p1[r]); rm2 = emax(emax(rm2, p0[r + 1]), p1[r + 1]); } \
        rm = halfmax(emax(rm, rm2)); \
        bool need; float dl; \
        if (!started) { need = true; dl = emax(rm, -200.f); } else { need = __any(rm > 8.f) != 0; dl = emax(rm, 0.f); } \
        if (need) { mhat += dl; \
            _Pragma("unroll") for (int r = 0; r < 16; ++r) negm[r] = -mhat; \
            _Pragma("unroll") for (int r = 0; r < 16; ++r) { p0[r] -= dl; p1[r] -= dl; } \
            if (started) { const float f = __builtin_amdgcn_exp2f(-dl); \
                if (hi == 0) wsf[r32] = f; \
                LDS_WAIT(); \
                _Pragma("unroll") for (int r = 0; r < 16; ++r) { const float fr_ = wsf[crow(r, hi)]; o[0][r] *= fr_; o[1][r] *= fr_; lacc[r] *= fr_; } } } \
        started = true; \
        __builtin_amdgcn_s_setprio(1);        \
        _Pragma("unroll") for (int r = 0; r < 16; ++r) { p0[r] = __builtin_amdgcn_exp2f(p0[r]); p1[r] = __builtin_amdgcn_exp2f(p1[r]); } \
        const u32x4 pw0 = (u32x4){cvt_pk_bf16(p0[0], p0[1]), cvt_pk_bf16(p0[2], p0[3]), cvt_pk_bf16(p0[4], p0[5]), cvt_pk_bf16(p0[6], p0[7])}; \
        const u32x4 pw1 = (u32x4){cvt_pk_bf16(p0[8], p0[9]), cvt_pk_bf16(p0[10], p0[11]), cvt_pk_bf16(p0[12], p0[13]), cvt_pk_bf16(p0[14], p0[15])}; \
        const u32x4 pw2 = (u32x4){cvt_pk_bf16(p1[0], p1[1]), cvt_pk_bf16(p1[2], p1[3]), cvt_pk_bf16(p1[4], p1[5]), cvt_pk_bf16(p1[6], p1[7])}; \
        const u32x4 pw3 = (u32x4){cvt_pk_bf16(p1[8], p1[9]), cvt_pk_bf16(p1[10], p1[11]), cvt_pk_bf16(p1[12], p1[13]), cvt_pk_bf16(p1[14], p1[15])}; \
        pv(o, lacc, vp0 + sl_ * VSLOT, __builtin_bit_cast(bf16x8, pw0), __builtin_bit_cast(bf16x8, pw1), __builtin_bit_cast(bf16x8, pw2), __builtin_bit_cast(bf16x8, pw3)); \
        __builtin_amdgcn_s_setprio(0); } while (0)
#define ATT_TOPWAIT(j) do { if ((j) + 1 < d.jhi) { if (DUAL) { ATT_WAIT_BAR(4); } else if (MODE == 2 || two) { ATT_WAIT_BAR(3); } else { ATT_WAIT_BAR(2); } } else { ATT_WAIT_BAR(0); } } while (0)
    if (wid < 4) {
        for (int j = d.jlo; j < d.jhi; ++j) {
            ATT_TOPWAIT(j);
            if (j + 2 < d.jhi) ATT_ISSUE(j + 2);
            if (ATT_REL(j)) { ATT_QK(j); ATT_SMPV(j); }
        }
        asm volatile("s_waitcnt lgkmcnt(0)\n\ts_barrier" ::: "memory");
    } else {
        ATT_TOPWAIT(d.jlo);
        if (d.jlo + 2 < d.jhi) ATT_ISSUE(d.jlo + 2);
        if (ATT_REL(d.jlo)) ATT_QK(d.jlo);
        for (int j = d.jlo + 1; j < d.jhi; ++j) {
            ATT_TOPWAIT(j);
            if (j + 2 < d.jhi) ATT_ISSUE(j + 2);
            if (ATT_REL(j - 1)) ATT_SMPV(j - 1);
            if (ATT_REL(j)) ATT_QK(j);
        }
        asm volatile("s_waitcnt lgkmcnt(0)\n\ts_barrier" ::: "memory");
        if (ATT_REL(d.jhi - 1)) ATT_SMPV(d.jhi - 1);
    }
#undef ATT_REL
#undef ATT_QK
#undef ATT_SMPV
#undef ATT_TOPWAIT
#undef ATT_ISSUE
    if (wvalid) {
        LAS bf16_t* stg = (LAS bf16_t*)(lds + A_OST) + wid * 2048;
        if (d_.lse != nullptr && r32 == 0) {
#pragma unroll
            for (int r = 0; r < 16; ++r) wsf[32 + crow(r, hi)] = lacc[r]; }
        if (d.o8) {
            LAS unsigned char* stg8 = (LAS unsigned char*)stg;
#pragma unroll
            for (int r = 0; r < 16; ++r) { const int orow = crow(r, hi); const float rl = __builtin_amdgcn_rcpf(lacc[r]) * 32.f;
                const unsigned p = (unsigned)__builtin_amdgcn_cvt_pk_fp8_f32(o[0][r] * rl, o[1][r] * rl, 0, false);
                stg8[orow * 64 + r32] = (unsigned char)(p & 0xffu); stg8[orow * 64 + 32 + r32] = (unsigned char)((p >> 8) & 0xffu); }
            LDS_WAIT();
#pragma unroll
            for (int i = 0; i < 2; ++i) { const int row = i * 16 + (lane >> 2), ch = lane & 3; const u32x4 v = *(const LAS u32x4*)(stg8 + row * 64 + ch * 16);
                *(u32x4*)((unsigned char*)d_.O + (size_t)(qw + row) * d.rstride * d.opitch + ch * 16) = v; }
        } else {
#pragma unroll
        for (int r = 0; r < 16; ++r) { const int orow = crow(r, hi); const float rl = __builtin_amdgcn_rcpf(lacc[r]);
            stg[orow * 64 + r32] = (bf16_t)f2bf(o[0][r] * rl); stg[orow * 64 + 32 + r32] = (bf16_t)f2bf(o[1][r] * rl); }
        LDS_WAIT();
#pragma unroll
        for (int i = 0; i < 4; ++i) { const int row = i * 8 + (lane >> 3), ch = lane & 7; const u32x4 v = *(const LAS u32x4*)(stg + row * 64 + ch * 8);
            *(u32x4*)(d_.O + (size_t)(qw + row) * d.rstride * d.opitch + ch * 8) = v; }
        }
        if (d_.lse != nullptr && hi == 0) d_.lse[(size_t)(qw + r32) * d.rstride * d.lsepitch] = mhat + __builtin_amdgcn_logf(wsf[32 + r32]);
    }
    asm volatile("s_waitcnt lgkmcnt(0)\n\ts_barrier" ::: "memory");
}
}

namespace idx {
constexpr int KS = 8192, I_K = 0, I_ST = 3 * KS, I_END = I_ST + 8 * 8192;
static_assert(I_END <= RING_BYTES, "indexer LDS");
__device__ __forceinline__ void score_unit(LAS unsigned char* lds, const bf16_t* PROJ, float* SC, int b, int qh  , int jg) {
    int tid_ = threadIdx.x; asm volatile("" : "+v"(tid_));
    const int tid = tid_, lane = tid & 63, r32 = lane & 31, hi = lane >> 5, wid = __builtin_amdgcn_readfirstlane(tid >> 6);
    const int qg = wid >> 1, hh = wid & 1;
    const unsigned lds0 = (unsigned)(size_t)lds;
    const int qrow = b * SEQ + qh * 128 + qg * 32 + r32;
    const bf16_t* kbase = PROJ + (size_t)(b * SEQ) * PW + 3968;
    const int kkey = 8 * wid + (lane >> 3);
    const bf16_t* ksrc = kbase + (size_t)kkey * PW + ((lane & 7) ^ ((kkey >> 1) & 7)) * 8;
    const int j0 = 4 * jg;
#define IDX_ISSUE(j) att::glds16(ksrc + (size_t)(j) * 64 * PW, (unsigned)__builtin_amdgcn_readfirstlane(lds0 + I_K + ((j) % 3) * KS + wid * 1024))
    IDX_ISSUE(j0); IDX_ISSUE(j0 + 1);
    bf16x8 qf[4][4]; float wv[4];
    { const bf16_t* qp = PROJ + (size_t)qrow * PW + 3328 + hh * 256 + hi * 8;
#pragma unroll
      for (int h = 0; h < 4; ++h)
#pragma unroll
          for (int d0 = 0; d0 < 4; ++d0) qf[h][d0] = *(const bf16x8*)(qp + h * 64 + d0 * 16);
      const u32x2 ww = *(const u32x2*)(PROJ + (size_t)qrow * PW + 4032 + hh * 4);
      wv[0] = bflo(ww.x); wv[1] = bfhi(ww.x); wv[2] = bflo(ww.y); wv[3] = bfhi(ww.y); }
#pragma unroll
    for (int h = 0; h < 4; ++h) { asm volatile("" : "+v"(wv[h]));
#pragma unroll
        for (int d0 = 0; d0 < 4; ++d0) asm volatile("" : "+v"(qf[h][d0])); }
    const int qb = qh >> 1;
    unsigned* blk = (unsigned*)SC + ((size_t)b * 36 + (size_t)(qb * (qb + 1) / 2)) * 32768; const int pitch = 128 * (qb + 1);
    f32x4 ve[4] = {};
    LAS unsigned char* stg = lds + I_ST + wid * 8192;
    const LAS unsigned char* stg2 = lds + I_ST + (wid ^ 1) * 8192;
#pragma nounroll
    for (int jj = 0; jj < 4; ++jj) { const int j = j0 + jj;
        if (jj < 2) { ATT_WAIT_BAR(1); } else if (jj == 2) { ATT_WAIT_BAR(5); } else { ATT_WAIT_BAR(4); }
        if (jj + 2 < 4) IDX_ISSUE(j + 2);
        const LAS unsigned char* kb = lds + I_K + (j % 3) * KS + r32 * 128;
#pragma nounroll
        for (int half = 0; half < 2; ++half) {
            bf16x8 kf[4];
#pragma unroll
            for (int d0 = 0; d0 < 4; ++d0) kf[d0] = *(const LAS bf16x8*)(kb + half * 4096 + (((2 * d0 + hi) ^ ((r32 >> 1) & 7)) * 16));
            f32x16 t0 = f32x16{};
#pragma unroll
            for (int h = 0; h < 4; ++h) {
                f32x16 p0 = f32x16{};
#pragma unroll
                for (int d0 = 0; d0 < 4; ++d0) p0 = __builtin_amdgcn_mfma_f32_32x32x16_bf16(kf[d0], qf[h][d0], p0, 0, 0, 0);
#pragma unroll
                for (int r = 0; r < 16; ++r) t0[r] += wv[h] * att::emax(p0[r], 0.f);
            }
#pragma unroll
            for (int g = 0; g < 4; ++g) { const int c0 = 8 * half + 2 * g + hi;
                *(LAS f32x4*)(stg + r32 * 256 + ((c0 ^ (r32 & 15)) * 16)) = (f32x4){t0[4 * g], t0[4 * g + 1], t0[4 * g + 2], t0[4 * g + 3]}; }
        }
        asm volatile("s_waitcnt lgkmcnt(0)\n\ts_barrier" ::: "memory");
#pragma unroll
        for (int i = 0; i < 4; ++i) { const int q = hh * 16 + i * 4 + (lane >> 4), c = lane & 15; const int so = q * 256 + ((c ^ (q & 15)) * 16);
            const f32x4 v = *(const LAS f32x4*)(stg + so) + *(const LAS f32x4*)(stg2 + so);
            if (jj & 1) { const f32x4 e = ve[i]; const u32x4 w = {pk2(e[0], v[0]), pk2(e[1], v[1]), pk2(e[2], v[2]), pk2(e[3], v[3])};
                *(u32x4*)(blk + (size_t)((qh & 1) * 128 + qg * 32 + q) * pitch + 64 * (j >> 1) + 4 * c) = w; }
            else ve[i] = v; }
        LDS_WAIT();
    }
#undef IDX_ISSUE
    asm volatile("s_waitcnt lgkmcnt(0)\n\ts_barrier" ::: "memory");
}

__device__ __forceinline__ int wave_sum_i(int v) {
    v += __builtin_amdgcn_update_dpp(0, v, 0xB1, 0xF, 0xF, true);
    v += __builtin_amdgcn_update_dpp(0, v, 0x4E, 0xF, 0xF, true);
    v += __builtin_amdgcn_update_dpp(0, v, 0x141, 0xF, 0xF, true);
    v += __builtin_amdgcn_update_dpp(0, v, 0x140, 0xF, 0xF, true);
    return __builtin_amdgcn_readlane(v, 0) + __builtin_amdgcn_readlane(v, 16) + __builtin_amdgcn_readlane(v, 32) + __builtin_amdgcn_readlane(v, 48);
}
__device__ __forceinline__ unsigned long long keep_low(unsigned long long m, int k) { while (__builtin_popcountll(m) > k) m &= ~(1ull << (63 - __builtin_clzll(m))); return m; }
__device__ __forceinline__ void select_rows4(const float* SC, unsigned* MASK, int row0  , int lane, LAS unsigned* slot  ) {
    const int b = row0 / SEQ, t0 = row0 % SEQ, qb = t0 >> 8;
    if (t0 < 256) {
#pragma unroll 1
        for (int i = 0; i < 4; ++i) { const int t = t0 + i, lo = 64 * lane;
            const unsigned long long w = (lo + 63 <= t) ? ~0ull : (lo > t ? 0ull : ((2ull << (t - lo)) - 1ull));
            if (lane < 32) ((unsigned long long*)(MASK + (size_t)(row0 + i) * 64))[lane] = w; }
        return;
    }
    const int pitch = 128 * (qb + 1), pmax = pitch - 1;
    const unsigned* srow0 = (const unsigned*)SC + ((size_t)b * 36 + (size_t)(qb * (qb + 1) / 2)) * 32768 + (size_t)(t0 - 256 * qb) * pitch;
    unsigned raw[16];
#pragma unroll
    for (int i = 0; i < 16; ++i) { const int s_ = 64 * i + lane; raw[i] = srow0[s_ < pmax ? s_ : pmax]; }
#pragma unroll 1
    for (int r = 0; r < 4; ++r) {
        const int t = t0 + r;
        unsigned P[16];
#pragma unroll
        for (int i = 0; i < 16; ++i) P[i] = raw[i];
        { const unsigned* nx = srow0 + (size_t)(r < 3 ? r + 1 : 3) * pitch;
#pragma unroll
          for (int i = 0; i < 16; ++i) { const int s_ = 64 * i + lane; raw[i] = nx[s_ < pmax ? s_ : pmax]; } }
#define SEL_TSTAGE(sh, m) _Pragma("unroll") for (int q = 0; q < 16; ++q) if (!(q & (sh))) { const unsigned a_ = P[q], b_ = P[q + (sh)]; \
            P[q] = (a_ & (m)) | ((b_ << (sh)) & ~(m)); P[q + (sh)] = ((a_ >> (sh)) & (m)) | (b_ & ~(m)); }
        SEL_TSTAGE(8, 0x00FF00FFu) SEL_TSTAGE(4, 0x0F0F0F0Fu) SEL_TSTAGE(2, 0x33333333u) SEL_TSTAGE(1, 0x55555555u)
#undef SEL_TSTAGE
        { const unsigned sg = P[15];
#pragma unroll
          for (int q = 0; q < 15; ++q) P[q] ^= sg;
          P[15] = ~sg; }
        const int nj = ((t - lane) >> 6) + 1;
        unsigned A = ((1u << ((nj + 1) >> 1)) - 1u) | (((1u << (nj >> 1)) - 1u) << 16), G = 0u;
        int cab = 0, cntA = t + 1;
#pragma unroll
        for (int bit = 15; bit >= 0; --bit) {
            if (cab + cntA != 256) {
                const unsigned ones = A & P[bit];
                const int c = wave_sum_i(__builtin_popcount(ones));
                if (cab + c >= 256) { A = ones; cntA = c; } else { G |= ones; cab += c; A &= ~ones; cntA -= c; }
            }
        }
        int need = 256 - cab;
        unsigned sel = G | A;
        if (cntA != need) {
            unsigned selA = 0u;
#pragma nounroll
            for (int j = 0; j < 32; ++j) { const int pb = (j >> 1) + 16 * (j & 1);
                unsigned long long m = __ballot((A >> pb) & 1u);
                if (__builtin_popcountll(m) > need) m = keep_low(m, need);
                need -= __builtin_popcountll(m);
                selA |= (unsigned)((m >> lane) & 1ull) << pb;
            }
            sel = G | selA;
        }
        int lo = 0, hi = 0;
#pragma unroll
        for (int j = 0; j < 32; ++j) { const unsigned long long m = __ballot((sel >> ((j >> 1) + 16 * (j & 1))) & 1u);
            lo = (lane == j) ? (int)(unsigned)m : lo; hi = (lane == j) ? (int)(unsigned)(m >> 32) : hi; }
        if (lane < 32) ((unsigned long long*)(MASK + (size_t)(row0 + r) * 64))[lane] = (unsigned long long)(unsigned)lo | ((unsigned long long)(unsigned)hi << 32);
    }
}
}

__device__ __forceinline__ unsigned* queue_word(Frame& F, int l, int chunk, int q) { return (unsigned*)(F.ws + WS_CTL) + CW_QUEUE + 64 * ((l * NCHUNK + chunk) * 4 + q); }

__device__ __forceinline__ void phase_proj(Frame& F, int l, int chunk) {
    PHASE_IDS(F);
    { LAS float* gb = (LAS float*)(F.lds + L_GB); const float* bg = F.in[7] + (size_t)l * 3072;
      __syncthreads();
      for (int i = F.tid; i < 3072; i += NTHREADS) gb[i] = bg[i];
      VM_WAIT(); LDS_WAIT(); __syncthreads(); }
    pg8::ProjSched8 S{{{(const bf16_t*)(F.ws + WS_XB8 + (size_t)chunk * TC * DM), (const bf16_t*)(F.ws + WS_WIN8), DM / 2, DM / 2, TC / 256, (PW + 3072) / 256, F.G, (int)blockIdx.x}, F8_SW, F8_SA_X}};
    const float* rp = (const float*)(F.ws + WS_ROPE);
    EpiProj E{(bf16_t*)(F.ws + WS_PROJ), rp, rp + 2048 * 8 * 2, (float*)(F.ws + WS_SSQ), (bf16_t*)(F.ws + WS_G3), (const LAS float*)(F.lds + L_GB)};
    pg8::gemm_phase<EpiProj, pg8::ProjSched8, true, true>(F.lds, DM / 2, S, E);
}
__device__ __forceinline__ void dilated_unit(Frame& F, int u) {
    const bf16_t* PROJ = (const bf16_t*)(F.ws + WS_PROJ); bf16_t* OG = (bf16_t*)(F.ws + WS_OG); float* LSE = (float*)(F.ws + WS_LSE);
    constexpr int N_G0 = NBC * 4 * 8, N_G1 = NBC * 4 * 4 * 2;
    int g, b, h, res, qb, dil, nq;
    if (u < N_G0) { g = 0; dil = 1; qb = 7 - u / (NBC * 4); const int bh = u % (NBC * 4); b = bh >> 2; h = bh & 3; res = 0; nq = 256; }
    else if (u < N_G0 + N_G1) { const int v = u - N_G0; g = 1; dil = 4; qb = 1 - v / (NBC * 16); const int x = v % (NBC * 16); b = x >> 4; h = (x >> 2) & 3; res = x & 3; nq = 256; }
    else { const int v = u - N_G0 - N_G1; g = 2; dil = 16; qb = 0; b = v >> 5; h = (v >> 3) & 3; res = (v & 7) * 2; nq = 128; }
    att::Desc d; const size_t r0 = (size_t)b * SEQ + res;
    const bf16_t* base = PROJ + r0 * PW + 512 + 768 * g + 64 * h;
    d.Q = base; d.K1 = base + 256; d.V = base + 512; d.K2 = nullptr; d.qpitch = d.k1pitch = d.vpitch = PW; d.k2pitch = 0;
    d.O = OG + ((size_t)g * TC + r0) * 256 + 64 * h; d.opitch = 256; d.lse = LSE + ((size_t)g * TC + r0) * 4 + h; d.lsepitch = 4; d.mask = nullptr;
    d.rstride = dil; d.q0 = qb * 256; d.nq = nq; d.o8 = 0;
    if (g == 2) { d.jlo = 0; d.jhi = 2; att::attn_unit<64, 0, true>(F.lds, d); }
    else { d.jlo = (qb * 4 - 2) > 0 ? (qb * 4 - 2) : 0; d.jhi = 4 * (qb + 1); att::attn_unit<64, 1>(F.lds, d); }
}

struct UpSched {
    static constexpr bool GATHER = false;
    const char* A; const char* B; size_t sB; int lda, ldb, nM, G, c;
    __device__ __forceinline__ bool next(int i, pg8::Unit& u) const { const int v = i * G + c; if (v >= nM * 7) return false; u.pm = v / 7; u.pn = v % 7; u.ord = i; return true; }
    __device__ __forceinline__ const char* a_base(const pg8::Unit& u) const { return A + ((size_t)u.pm * 256 * lda + (u.pn >= 3 ? 256 : 0)) * 2; }
    __device__ __forceinline__ const char* b_base(const pg8::Unit& u) const { return B + (u.pn >= 3 ? sB + (size_t)(u.pn - 3) * 256 * ldb * 2 : (size_t)u.pn * 256 * ldb * 2); }
    __device__ __forceinline__ void a_off(const pg8::Unit&, const int (&R)[2], const int (&C)[2], unsigned (&v)[2][2]) const {
#pragma unroll
        for (int i = 0; i < 2; ++i) { v[0][i] = (unsigned)(R[i] * lda + C[i]) * 2u; v[1][i] = (unsigned)((128 + R[i]) * lda + C[i]) * 2u; }
    }
};
struct EpiUp {
    EpiUpQ q; EpiUpKV kv;
    __device__ __forceinline__ void operator()(const f32x4 (&acc)[2][2][4][2], const pg8::Unit& u, int wr, int wc, int fr, int fq) const {
        if (u.pn < 3) q(acc, u, wr, wc, fr, fq);
        else { pg8::Unit u2 = u; u2.pn = u.pn - 3; kv(acc, u2, wr, wc, fr, fq); }
    }
};
__device__ __forceinline__ void phase_up_scores(Frame& F, int l, int chunk) {
    PHASE_IDS(F);
    const bf16_t* PROJ = (const bf16_t*)(F.ws + WS_PROJ);
    const float* rp = (const float*)(F.ws + WS_ROPE);
    {   UpSched S{(const char*)PROJ, (const char*)(F.ws + WS_WUQ), WS_WUKV - WS_WUQ, PW, 256, TC / 256, F.G, (int)blockIdx.x};
        EpiUp E{{(bf16_t*)(F.ws + WS_QM), rp + 2048 * 8 * 2, (const float*)(F.ws + WS_SSQ)}, {(bf16_t*)(F.ws + WS_KVM), (const float*)(F.ws + WS_SSQ)}};
        pg8::gemm_phase<EpiUp, UpSched, true>(F.lds, 256, S, E); }
    unsigned* qw = queue_word(F, l, chunk, 0); int pre = -1;
    for (;;) {
        const int u = dequeue(F, qw, pre);
        if (u < NBC * 64) { dilated_unit(F, u); continue; }
        if (u >= NBC * 64 + NBC * 72 + NBC * 32) break;
        if (u >= NBC * 64 + NBC * 72) { dilated_unit(F, u - NBC * 72); continue; }
        const int v = u - NBC * 64; const int b = v / 72; int r = v % 72, qh = 0; while (r > (qh >> 1)) { r -= (qh >> 1) + 1; ++qh; }
        idx::score_unit(F.lds, PROJ, (float*)(F.ws + WS_SC), b, qh, r);
    }
}
__device__ __forceinline__ void phase_attn1(Frame& F, int l, int chunk, int tmask = 7) {
    PHASE_IDS(F);
    const bf16_t* PROJ = (const bf16_t*)(F.ws + WS_PROJ); const bf16_t* QM = (const bf16_t*)(F.ws + WS_QM); const bf16_t* KVM = (const bf16_t*)(F.ws + WS_KVM);
    bf16_t* OA = (bf16_t*)(F.ws + WS_OA); bf16_t* OG = (bf16_t*)(F.ws + WS_OG); float* LSE = (float*)(F.ws + WS_LSE);
    constexpr int N_MLA = NBC * 8 * 8, N_SEL = TC / 32;
    unsigned* qw = queue_word(F, l, chunk, 1); int pre = -1;
    for (;;) {
        int u = dequeue(F, qw, pre);
        if (u < N_MLA) {
            if (!(tmask & 1)) continue;
            const int qb = 7 - u / (NBC * 8), bh = u % (NBC * 8), b = bh >> 3, h = bh & 7;
            att::Desc d; const size_t r0 = (size_t)b * SEQ;
            d.Q = QM + r0 * 768 + h * 96; d.qpitch = 768; d.K1 = KVM + r0 * 1024 + h * 128; d.k1pitch = 1024; d.K2 = PROJ + r0 * PW + 384; d.k2pitch = PW;
            d.V = KVM + r0 * 1024 + h * 128 + 64; d.vpitch = 1024; d.O = (bf16_t*)((unsigned char*)OA + r0 * 512 + h * 64); d.opitch = 512; d.o8 = 1; d.lse = nullptr; d.lsepitch = 0; d.mask = nullptr;
            d.rstride = 1; d.q0 = qb * 256; d.nq = 256; d.jlo = 0; d.jhi = 4 * (qb + 1);
            att::attn_unit<96, 0>(F.lds, d); continue; }
        u -= N_MLA;
        if (u >= N_SEL) break;
        if (!(tmask & 4)) continue;
        idx::select_rows4((const float*)(F.ws + WS_SC), (unsigned*)(F.ws + WS_MASK), u * 32 + F.wave * 4, F.lane, (LAS unsigned*)(F.lds + L_GB) + F.wave * 64);
    }
}
__device__ __forceinline__ void phase_attn2(Frame& F, int l, int chunk) {
    PHASE_IDS(F);
    const bf16_t* PROJ = (const bf16_t*)(F.ws + WS_PROJ);
    bf16_t* OC = (bf16_t*)(F.ws + WS_OC);
    unsigned* qw = queue_word(F, l, chunk, 2); int pre = -1;
    for (;;) {
        const int u = dequeue(F, qw, pre);
        if (u >= NBC * 64) break;
        const int qb = 7 - u / (NBC * 8), bh = u % (NBC * 8), b = bh >> 3, h = bh & 7;
        att::Desc d; const size_t r0 = (size_t)b * SEQ;
        d.Q = PROJ + r0 * PW + 2816 + 64 * h; d.K1 = PROJ + r0 * PW + 3840; d.V = PROJ + r0 * PW + 3904; d.K2 = nullptr; d.qpitch = d.k1pitch = d.vpitch = PW; d.k2pitch = 0;
        d.O = (bf16_t*)((unsigned char*)OC + r0 * 512 + 64 * h); d.opitch = 512; d.o8 = 1; d.lse = nullptr; d.lsepitch = 0; d.mask = (const unsigned*)(F.ws + WS_MASK) + r0 * 64;
        d.rstride = 1; d.q0 = qb * 256; d.nq = 256; d.jlo = 0; d.jhi = 4 * (qb + 1);
        att::attn_unit<64, 2>(F.lds, d);
    }
    const bf16_t* OG = (const bf16_t*)(F.ws + WS_OG); const float* LSE = (const float*)(F.ws + WS_LSE); bf16_t* OB = (bf16_t*)(F.ws + WS_OB);
    const int gw = F.vcu * NWAVES + F.wave, NGW = F.G * NWAVES, h = F.lane >> 4;
    for (int row = gw; row < TC; row += NGW) {
        const float l0 = LSE[(size_t)row * 4 + h], l1 = LSE[((size_t)TC + row) * 4 + h], l2 = LSE[((size_t)2 * TC + row) * 4 + h];
        const float mx = fmaxf(l0, fmaxf(l1, l2));
        float w0 = __builtin_amdgcn_exp2f(l0 - mx), w1 = __builtin_amdgcn_exp2f(l1 - mx), w2 = __builtin_amdgcn_exp2f(l2 - mx);
        const float inv = 1.0f / (w0 + w1 + w2); w0 *= inv; w1 *= inv; w2 *= inv;
        const u32x2 a = *(const u32x2*)(OG + (size_t)row * 256 + F.lane * 4), bq = *(const u32x2*)(OG + ((size_t)TC + row) * 256 + F.lane * 4), c = *(const u32x2*)(OG + ((size_t)2 * TC + row) * 256 + F.lane * 4);
        w0 *= 32.f; w1 *= 32.f; w2 *= 32.f;
        *(unsigned*)((unsigned char*)OB + (size_t)row * 512 + F.lane * 4) = pk4_fp8(w0 * bflo(a.x) + w1 * bflo(bq.x) + w2 * bflo(c.x), w0 * bfhi(a.x) + w1 * bfhi(bq.x) + w2 * bfhi(c.x),
                                                                                    w0 * bflo(a.y) + w1 * bflo(bq.y) + w2 * bflo(c.y), w0 * bfhi(a.y) + w1 * bfhi(bq.y) + w2 * bfhi(c.y));
    }
}
constexpr int CW_DEP = 32768;
__device__ __forceinline__ void phase_attn(Frame& F, int l, int chunk) {
    PHASE_IDS(F);
    const bf16_t* PROJ = (const bf16_t*)(F.ws + WS_PROJ); const bf16_t* QM = (const bf16_t*)(F.ws + WS_QM); const bf16_t* KVM = (const bf16_t*)(F.ws + WS_KVM);
    bf16_t* OA = (bf16_t*)(F.ws + WS_OA); bf16_t* OC = (bf16_t*)(F.ws + WS_OC);
    constexpr int N_SEL = TC / 32, NQ = NBC * 8;
    unsigned* dep = (unsigned*)(F.ws + WS_CTL) + CW_DEP + (l * NCHUNK + chunk) * (NBC * 8);
    unsigned* qw = queue_word(F, l, chunk, 1); int pre = -1;
    for (;;) {
        int u = dequeue(F, qw, pre);
        if (u < N_SEL) {
            idx::select_rows4((const float*)(F.ws + WS_SC), (unsigned*)(F.ws + WS_MASK), u * 32 + F.wave * 4, F.lane, (LAS unsigned*)(F.lds + L_GB) + F.wave * 64);
            VM_WAIT();
            __syncthreads();
            if (F.tid == 0) { const int row = u * 32, b = row / SEQ, qb = (row % SEQ) >> 8;
                __builtin_amdgcn_fence(__ATOMIC_RELEASE, "agent");
                __hip_atomic_fetch_add(dep + b * 8 + qb, 1u, __ATOMIC_RELAXED, __HIP_MEMORY_SCOPE_AGENT); }
            continue; }
        u -= N_SEL;
        if (u >= 16 * NQ) break;
        const int qb = 7 - u / (2 * NQ), w = u % (2 * NQ);
        if (w < NQ) {
            const int b = w >> 3, h = w & 7;
            att::Desc d; const size_t r0 = (size_t)b * SEQ;
            d.Q = QM + r0 * 768 + h * 96; d.qpitch = 768; d.K1 = KVM + r0 * 1024 + h * 128; d.k1pitch = 1024; d.K2 = PROJ + r0 * PW + 384; d.k2pitch = PW;
            d.V = KVM + r0 * 1024 + h * 128 + 64; d.vpitch = 1024; d.O = (bf16_t*)((unsigned char*)OA + r0 * 512 + h * 64); d.opitch = 512; d.o8 = 1; d.lse = nullptr; d.lsepitch = 0; d.mask = nullptr;
            d.rstride = 1; d.q0 = qb * 256; d.nq = 256; d.jlo = 0; d.jhi = 4 * (qb + 1);
            att::attn_unit<96, 0>(F.lds, d);
        } else {
            const int bh = w - NQ, b = bh >> 3, h = bh & 7;
            if (F.tid == 0) { while (__hip_atomic_load(dep + b * 8 + qb, __ATOMIC_RELAXED, __HIP_MEMORY_SCOPE_AGENT) < 8u) __builtin_amdgcn_s_sleep(4);
                __builtin_amdgcn_fence(__ATOMIC_ACQUIRE, "agent"); }
            __syncthreads();
            att::Desc d; const size_t r0 = (size_t)b * SEQ;
            d.Q = PROJ + r0 * PW + 2816 + 64 * h; d.K1 = PROJ + r0 * PW + 3840; d.V = PROJ + r0 * PW + 3904; d.K2 = nullptr; d.qpitch = d.k1pitch = d.vpitch = PW; d.k2pitch = 0;
            d.O = (bf16_t*)((unsigned char*)OC + r0 * 512 + 64 * h); d.opitch = 512; d.o8 = 1; d.lse = nullptr; d.lsepitch = 0; d.mask = (const unsigned*)(F.ws + WS_MASK) + r0 * 64;
            d.rstride = 1; d.q0 = qb * 256; d.nq = 256; d.jlo = 0; d.jhi = 4 * (qb + 1);
            att::attn_unit<64, 2>(F.lds, d);
        }
    }
    const bf16_t* OG = (const bf16_t*)(F.ws + WS_OG); const float* LSE = (const float*)(F.ws + WS_LSE); bf16_t* OB = (bf16_t*)(F.ws + WS_OB);
    const int gw = F.vcu * NWAVES + F.wave, NGW = F.G * NWAVES, h = F.lane >> 4;
    for (int row = gw; row < TC; row += NGW) {
        const float l0 = LSE[(size_t)row * 4 + h], l1 = LSE[((size_t)TC + row) * 4 + h], l2 = LSE[((size_t)2 * TC + row) * 4 + h];
        const float mx = fmaxf(l0, fmaxf(l1, l2));
        float w0 = __builtin_amdgcn_exp2f(l0 - mx), w1 = __builtin_amdgcn_exp2f(l1 - mx), w2 = __builtin_amdgcn_exp2f(l2 - mx);
        const float inv = 1.0f / (w0 + w1 + w2); w0 *= inv; w1 *= inv; w2 *= inv;
        const u32x2 a = *(const u32x2*)(OG + (size_t)row * 256 + F.lane * 4), bq = *(const u32x2*)(OG + ((size_t)TC + row) * 256 + F.lane * 4), c = *(const u32x2*)(OG + ((size_t)2 * TC + row) * 256 + F.lane * 4);
        w0 *= 32.f; w1 *= 32.f; w2 *= 32.f;
        *(unsigned*)((unsigned char*)OB + (size_t)row * 512 + F.lane * 4) = pk4_fp8(w0 * bflo(a.x) + w1 * bflo(bq.x) + w2 * bflo(c.x), w0 * bfhi(a.x) + w1 * bfhi(bq.x) + w2 * bfhi(c.x),
                                                                                    w0 * bflo(a.y) + w1 * bflo(bq.y) + w2 * bflo(c.y), w0 * bfhi(a.y) + w1 * bfhi(bq.y) + w2 * bfhi(c.y));
    }
}
__device__ __forceinline__ void phase_branches(Frame& F, int l, int chunk) {
    PHASE_IDS(F);
    static_assert(WS_OB - WS_OA == WS_OC - WS_OB && WS_WB - WS_WA == WS_WC - WS_WB, "equally spaced branch operands");
    BranchSched S{(const char*)(F.ws + WS_OA), (const char*)(F.ws + WS_WA), WS_OB - WS_OA, WS_WB - WS_WA, 256, 256, (int)blockIdx.x, F8_SW, 127 - 5, F.G, (TC / 256) * 4};
    EpiBranchAll E{(bf16_t*)(F.ws + WS_MERGED), (bf16_t*)(F.ws + WS_M0), (bf16_t*)(F.ws + WS_M1), (const bf16_t*)(F.ws + WS_G3)};
    pg8::gemm_phase<EpiBranchAll, BranchSched, true, true>(F.lds, 256, S, E);
}
__device__ __forceinline__ void phase_wo(Frame& F, int l, int chunk) {
    PHASE_IDS(F);
    pg8::DenseSched8 S{{(const bf16_t*)(F.ws + WS_MERGED), (const bf16_t*)(F.ws + WS_WO), DM / 2, DM / 2, TC / 256, 4, F.G, (int)blockIdx.x}, F8_SW, 127 - 6};
    EpiWo E{F.out, l == 0 ? F.in[0] : F.out, chunk * TC};
    pg8::gemm_phase<EpiWo, pg8::DenseSched8, true, true>(F.lds, DM / 2, S, E);
}

__global__ void __launch_bounds__(NTHREADS, 2) fwd_kernel(Args args) {
    extern __shared__ __attribute__((aligned(16))) unsigned char lds_raw[];
    Frame F;
    F.lds = (LAS unsigned char*)lds_raw;
    F.tid = threadIdx.x; F.lane = F.tid & 63; F.wave = __builtin_amdgcn_readfirstlane(F.tid >> 6);
    F.G = gridDim.x; { const int bx = blockIdx.x; F.vcu = (F.G % 8 == 0) ? (bx % 8) * (F.G / 8) + bx / 8 : bx; }
    F.in.p = (intab_t)__builtin_amdgcn_kernarg_segment_ptr(); F.out = args.out; F.ws = args.ws; F.out0 = args.out; F.ws0 = args.ws;
    for (int u = F.tid; u < (LDS_BYTES - L_CTL) / 4; u += NTHREADS) ((LAS unsigned*)(F.lds + L_CTL))[u] = 0u;
    __syncthreads();
    XcdBarrier bar = xcd_barrier_post((unsigned*)(F.ws + WS_CTL) + CW_BAR, (volatile LAS unsigned*)(F.lds + L_BARW));
#define GRID_BAR() xcd_barrier(bar)

    for (int l = 0; l < 2; ++l) {
        phase_conv_moe(F, l);
        phase_conv_mixer(F, l);
        GRID_BAR();
        for (int chunk = 0; chunk < NCHUNK; ++chunk) {
            phase_proj(F, l, chunk);
            GRID_BAR();
            if (DUPMASK & 2) { phase_proj(F, l, chunk); GRID_BAR(); }
            phase_up_scores(F, l, chunk);
            GRID_BAR();
            if (DUPMASK & 4) { phase_up_scores(F, l + 2, chunk); GRID_BAR(); }
            phase_attn(F, l, chunk);
            GRID_BAR();
            phase_branches(F, l, chunk);
            GRID_BAR();
            if (DUPMASK & 32) { phase_branches(F, l, chunk); GRID_BAR(); }
            phase_wo(F, l, chunk);
            if ((DUPMASK & 0x800) && l == 0) { GRID_BAR(); phase_wo(F, l, chunk); }
        }
        GRID_BAR();
        phase_ln1_router(F, l, F.out, false);
        GRID_BAR();
        phase_moe_scatter(F);
        GRID_BAR();
        phase_moe_gemm1(F);
        GRID_BAR();
        if (DUPMASK & 64) { phase_moe_gemm1(F); GRID_BAR(); }
        phase_moe_gemm2(F);
        GRID_BAR();
        if (DUPMASK & 128) { phase_moe_gemm2(F); GRID_BAR(); }
        phase_combine_ln2(F, l);
    }
}

extern "C" void kernel_launch(void* const* d_in, const int* in_sizes, int n_in, void* d_out, int out_size, void* d_ws, size_t ws_size, hipStream_t stream) {
    static int grid = 0;
    if (grid == 0) {
        if (n_in != 23 || out_size != TT * DM || ws_size < WS_END) { fprintf(stderr, "kernel_launch: unexpected shapes n_in %d out %d ws %zu\n", n_in, out_size, ws_size); grid = -1; return; }
        int dev = 0, cus = 0;
        if (hipGetDevice(&dev) != hipSuccess || hipDeviceGetAttribute(&cus, hipDeviceAttributeMultiprocessorCount, dev) != hipSuccess) { grid = -1; return; }
        if (hipFuncSetAttribute((const void*)fwd_kernel, hipFuncAttributeMaxDynamicSharedMemorySize, LDS_BYTES) != hipSuccess) { fprintf(stderr, "kernel_launch: hipFuncSetAttribute failed\n"); grid = -1; return; }
        int per_cu = 0;
        if (hipOccupancyMaxActiveBlocksPerMultiprocessor(&per_cu, (const void*)fwd_kernel, NTHREADS, LDS_BYTES) != hipSuccess || per_cu < 1) fprintf(stderr, "kernel_launch: occupancy query says %d\n", per_cu);
        (void)hipGetLastError();
        grid = cus;
    }
    if (grid < 0) return;
    if (hipMemsetAsync((char*)d_ws + WS_CTL, 0, CTL_ZERO_BYTES, stream) != hipSuccess) return;
    Args a{};
    for (int i = 0; i < 23; ++i) a.in[i] = (const float*)d_in[i];
    a.out = (float*)d_out; a.ws = (unsigned char*)d_ws;
    hipLaunchKernelGGL(fwd_kernel, dim3(grid), dim3(NTHREADS), LDS_BYTES, stream, a);
}
```

```cpp
#include <hip/hip_runtime.h>
#include <cstdio>
#include <cstdint>

#define LAS __attribute__((address_space(3)))
#define GAS __attribute__((address_space(1)))
typedef unsigned short bf16_t;
typedef short bf16x8 __attribute__((ext_vector_type(8)));
typedef float f32x4 __attribute__((ext_vector_type(4)));
typedef float f32x2 __attribute__((ext_vector_type(2)));
typedef float f32x16 __attribute__((ext_vector_type(16)));
typedef unsigned u32x4 __attribute__((ext_vector_type(4)));
typedef unsigned u32x2 __attribute__((ext_vector_type(2)));

constexpr int DM = 1024, NB = 32, SEQ = 2048, TT = NB * SEQ;
constexpr int NEXP = 32, DEXP = 256;
constexpr float LN_EPS = 1e-6f;
constexpr float ALPHA = 1.41421356237309515f;
constexpr int NWAVES = 8, NTHREADS = 512;

__device__ __forceinline__ unsigned f2bf(float f) { unsigned u = __builtin_bit_cast(unsigned, f); return (u + 0x7fffu + ((u >> 16) & 1u)) >> 16; }
__device__ __forceinline__ unsigned pk2(float lo, float hi) { return f2bf(lo) | (f2bf(hi) << 16); }
__device__ __forceinline__ float bf2f(unsigned short b) { return __builtin_bit_cast(float, (unsigned)b << 16); }
__device__ __forceinline__ float bflo(unsigned w) { return __builtin_bit_cast(float, w << 16); }
__device__ __forceinline__ float bfhi(unsigned w) { return __builtin_bit_cast(float, w & 0xffff0000u); }
typedef __bf16 bf16x2_t __attribute__((ext_vector_type(2)));
__device__ __forceinline__ unsigned cvt_pk_bf16(float lo, float hi) { const f32x2 v = {lo, hi}; const bf16x2_t b = __builtin_convertvector(v, bf16x2_t); return __builtin_bit_cast(unsigned, b); }
__device__ __forceinline__ float wave_sum(float v) {
#pragma unroll
    for (int o = 1; o < 64; o <<= 1) v += __shfl_xor(v, o);
    return v;
}
__device__ __forceinline__ float fast_exp(float x) { return __builtin_amdgcn_exp2f(x * 1.4426950408889634f); }
__device__ __forceinline__ float sigmoidf_(float x) { return __builtin_amdgcn_rcpf(1.0f + fast_exp(-x)); }
__device__ __forceinline__ unsigned pk4_fp8(float a, float b, float c, float d) {
    int p = __builtin_amdgcn_cvt_pk_fp8_f32(a, b, 0, false); p = __builtin_amdgcn_cvt_pk_fp8_f32(c, d, p, true); return (unsigned)p; }
__device__ __forceinline__ void store8_fp8(unsigned char* p, const f32x4& v0, const f32x4& v1, float sc) {
    u32x2 w; w.x = pk4_fp8(v0[0] * sc, v0[1] * sc, v0[2] * sc, v0[3] * sc); w.y = pk4_fp8(v1[0] * sc, v1[1] * sc, v1[2] * sc, v1[3] * sc); *(u32x2*)p = w;
}
#define LDS_WAIT() asm volatile("s_waitcnt lgkmcnt(0)" ::: "memory")
#define VM_WAIT() asm volatile("s_waitcnt vmcnt(0)" ::: "memory")

namespace pg8 {
constexpr int BM = 256, BK = 64, HALF = 128, HTB = HALF * BK * 2, STAGE_BYTES = 8 * HTB;
__device__ __forceinline__ int lds_byte(int r, int c) { return r * 128 + ((((c >> 3) ^ (r >> 1)) & 7) * 16) + (c & 7) * 2; }
__device__ __forceinline__ void stage_rc(int b, int& R, int& C) { R = b >> 7; C = ((((b >> 4) ^ (R >> 1)) & 7)) * 8; }
__device__ __forceinline__ int perm32(int rho) { const int n = rho >> 4, i = rho & 15; return 8 * (i >> 2) + 4 * n + (i & 3); }
struct Unit { int pm, pn, ord; };

template <class S, class = void> struct SchedVarK { static constexpr bool value = false; };
template <class S> struct SchedVarK<S, decltype((void)S::VARK)> { static constexpr bool value = S::VARK; };
typedef int v4i_t __attribute__((ext_vector_type(4)));
typedef int v8i_t __attribute__((ext_vector_type(8)));
__device__ __forceinline__ v8i_t cat8(const bf16x8& lo, const bf16x8& hi) { return __builtin_shufflevector(__builtin_bit_cast(v4i_t, lo), __builtin_bit_cast(v4i_t, hi), 0, 1, 2, 3, 4, 5, 6, 7); }
template <class Epi, class Sched, bool ALIGN_EPI, bool F8 = false>
__device__ __forceinline__ void gemm_phase(LAS unsigned char* lds, const int K, const Sched& S, const Epi& E) {
    int tid_ = threadIdx.x; asm volatile("" : "+v"(tid_));
    const int tid = tid_, wid = __builtin_amdgcn_readfirstlane(tid >> 6), lane = tid & 63, wr = wid >> 2, wc = wid & 3, fr = lane & 15, fq = lane >> 4;
    int nt = K / BK;
    int Rr[2], Cc[2]; unsigned vB[2][2];
#pragma unroll
    for (int i = 0; i < 2; ++i) { stage_rc(tid * 16 + i * 8192, Rr[i], Cc[i]); const int Rb = (Rr[i] & ~31) + perm32(Rr[i] & 31);
        vB[0][i] = (unsigned)(Rb * S.ldb + Cc[i]) * 2u; vB[1][i] = (unsigned)((HALF + Rb) * S.ldb + Cc[i]) * 2u; }
    const size_t kstep = (size_t)(BK * 2);
    const unsigned ldsw = (unsigned)wid * 1024u;
    const int aoff = lds_byte(wr * 64 + fr, fq * 8), boff = lds_byte(wc * 32 + fr, fq * 8);
    const int aoff1 = lds_byte(wr * 64 + fr, fq * 8 + 32), boff1 = lds_byte(wc * 32 + fr, fq * 8 + 32);
#define PG8_SA(b, h) (((b) * 2 + (h)) * HTB)
#define PG8_SB(b, h) ((4 + (b) * 2 + (h)) * HTB)
#define PG8_STAGE(bufoff, gbase, voff) do { _Pragma("unroll") for (int _i = 0; _i < 2; ++_i) \
        __builtin_amdgcn_global_load_lds((const unsigned*)((const char*)(gbase) + (voff)[_i]), (LAS unsigned*)(lds + (bufoff) + ldsw + _i * 8192), 16, 0, 0); } while (0)
#define PG8_LDA(dst, b, h) do { _Pragma("unroll") for (int m = 0; m < 4; ++m) { \
        const bf16x8 f0_ = *(const LAS bf16x8*)(lds + PG8_SA(b, h) + aoff + m * 2048), f1_ = *(const LAS bf16x8*)(lds + PG8_SA(b, h) + aoff1 + m * 2048); \
        if constexpr (F8) dst##8[m] = cat8(f0_, f1_); else { dst[m][0] = f0_; dst[m][1] = f1_; } } } while (0)
#define PG8_LDB(dst, b, h) do { _Pragma("unroll") for (int n = 0; n < 2; ++n) { \
        const bf16x8 f0_ = *(const LAS bf16x8*)(lds + PG8_SB(b, h) + boff + n * 2048), f1_ = *(const LAS bf16x8*)(lds + PG8_SB(b, h) + boff1 + n * 2048); \
        if constexpr (F8) dst##8[n] = cat8(f0_, f1_); else { dst[n][0] = f0_; dst[n][1] = f1_; } } } while (0)
#define PG8_MMA(ai, bj, At, Bt) do { __builtin_amdgcn_s_setprio(1); \
        if constexpr (F8) { _Pragma("unroll") for (int m = 0; m < 4; ++m) _Pragma("unroll") for (int n = 0; n < 2; ++n) \
            asm volatile("v_mfma_scale_f32_16x16x128_f8f6f4 %0, %1, %2, %0, %3, %4 op_sel_hi:[0,0,0]" : "+v"(acc[ai][bj][m][n]) : "v"(Bt##8[n]), "v"(At##8[m]), "v"(scw8), "v"(sca8)); } \
              \
        else { _Pragma("unroll") for (int m = 0; m < 4; ++m) _Pragma("unroll") for (int n = 0; n < 2; ++n) _Pragma("unroll") for (int k = 0; k < 2; ++k) \
            acc[ai][bj][m][n] = __builtin_amdgcn_mfma_f32_16x16x32_bf16(Bt[n][k], At[m][k], acc[ai][bj][m][n], 0, 0, 0); } \
        __builtin_amdgcn_s_setprio(0); } while (0)
#define PG8_WAIT_V(n) asm volatile("s_waitcnt vmcnt(" #n ")" ::: "memory")
#define PG8_WAIT_L(n) asm volatile("s_waitcnt lgkmcnt(" #n ")" ::: "memory")
#define PG8_BAR __builtin_amdgcn_s_barrier()
#define PG8_SCHED __builtin_amdgcn_sched_barrier(0)
    int scw8 = 0, sca8 = 0;
    if constexpr (F8) { scw8 = S.sw8 * 0x01010101; sca8 = S.sa8 * 0x01010101; }
    Unit cur, nxt; int ui = 0;
    if (!S.next(0, cur)) return;
    f32x4 acc[2][2][4][2];
#pragma unroll
    for (int a = 0; a < 2; ++a)
#pragma unroll
        for (int b = 0; b < 2; ++b)
#pragma unroll
            for (int m = 0; m < 4; ++m)
#pragma unroll
                for (int n = 0; n < 2; ++n) acc[a][b][m][n] = (f32x4){0.f, 0.f, 0.f, 0.f};
    bf16x8 At[4][2], B0[2][2], B1[2][2]; v8i_t At8[4], B08[2], B18[2];
    unsigned vAc[2][2], vAn[2][2];
    const char* cA = S.a_base(cur); const char* cB = S.b_base(cur);
    S.a_off(cur, Rr, Cc, vAc);
    if constexpr (SchedVarK<Sched>::value) nt = S.ktiles(cur);
    PG8_STAGE(PG8_SB(0, 0), cB, vB[0]); PG8_STAGE(PG8_SB(0, 1), cB, vB[1]); PG8_STAGE(PG8_SA(0, 0), cA, vAc[0]); PG8_STAGE(PG8_SA(0, 1), cA, vAc[1]);
    if (wr == 1) PG8_BAR;
    PG8_WAIT_V(2); PG8_BAR;
    PG8_STAGE(PG8_SB(1, 0), cB + kstep, vB[0]); PG8_STAGE(PG8_SA(1, 0), cA + kstep, vAc[0]); PG8_STAGE(PG8_SB(1, 1), cB + kstep, vB[1]);
    PG8_WAIT_V(6); PG8_BAR;
    bool epi_pend = false;
    for (;;) {
        const bool has_next = S.next(ui + 1, nxt);
        const char* nA = cA; const char* nB = cB;
        if constexpr (Sched::GATHER) {
#pragma unroll
            for (int h = 0; h < 2; ++h)
#pragma unroll
                for (int i = 0; i < 2; ++i) vAn[h][i] = vAc[h][i];
        }
        if (has_next) { nA = S.a_base(nxt); nB = S.b_base(nxt); if constexpr (Sched::GATHER) S.a_off(nxt, Rr, Cc, vAn); }
#pragma nounroll
        for (int t = 0; t < nt; t += 2) {
            const bool last = (t == nt - 2);
            const bool ep_ = epi_pend && t == 0;
            const char* a1 = cA + (size_t)(t + 1) * kstep;
            const char* a2 = last ? nA : cA + (size_t)(t + 2) * kstep; const char* b2 = last ? nB : cB + (size_t)(t + 2) * kstep;
            const char* a3 = a2 + kstep; const char* b3 = b2 + kstep;
            unsigned vA2[2][2];
#pragma unroll
            for (int h = 0; h < 2; ++h)
#pragma unroll
                for (int i = 0; i < 2; ++i) { if constexpr (Sched::GATHER) vA2[h][i] = last ? vAn[h][i] : vAc[h][i]; else vA2[h][i] = vAc[h][i]; }
            PG8_LDB(B0, 0, 0); PG8_LDB(B1, 0, 1); PG8_SCHED; PG8_LDA(At, 0, 0); PG8_STAGE(PG8_SA(1, 1), a1, vAc[1]);
            if (ep_) { PG8_WAIT_V(24); } else { PG8_WAIT_V(8); } PG8_WAIT_L(0); PG8_BAR; PG8_MMA(0, 0, At, B0); PG8_MMA(0, 1, At, B1); PG8_BAR; PG8_SCHED;
            PG8_LDA(At, 0, 1); PG8_STAGE(PG8_SB(0, 0), b2, vB[0]); PG8_STAGE(PG8_SB(0, 1), b2, vB[1]); PG8_STAGE(PG8_SA(0, 0), a2, vA2[0]);
            if (ep_) { PG8_WAIT_V(24); } else { PG8_WAIT_V(8); } PG8_WAIT_L(0); PG8_BAR; PG8_MMA(1, 0, At, B0); PG8_MMA(1, 1, At, B1); PG8_BAR; PG8_SCHED;
            PG8_LDB(B0, 1, 0); PG8_LDB(B1, 1, 1); PG8_SCHED; PG8_LDA(At, 1, 0); PG8_STAGE(PG8_SA(0, 1), a2, vA2[1]);
            PG8_WAIT_V(8); PG8_WAIT_L(0); PG8_BAR; PG8_MMA(0, 0, At, B0); PG8_MMA(0, 1, At, B1); PG8_BAR; PG8_SCHED;
            PG8_LDA(At, 1, 1); PG8_STAGE(PG8_SB(1, 0), b3, vB[0]); PG8_STAGE(PG8_SB(1, 1), b3, vB[1]); PG8_STAGE(PG8_SA(1, 0), a3, vA2[0]);
            PG8_WAIT_V(8); PG8_WAIT_L(0); PG8_BAR; PG8_MMA(1, 0, At, B0); PG8_MMA(1, 1, At, B1); PG8_BAR; PG8_SCHED;
        }
        if constexpr (ALIGN_EPI) { if (wr == 0) PG8_BAR; }
        if constexpr (F8) asm volatile("s_nop 15\n\ts_nop 15" ::: "memory");
        { int l2_ = lane; asm volatile("" : "+v"(l2_)); E(acc, cur, wr, wc, l2_ & 15, l2_ >> 4); }
        if (!has_next) break;
        epi_pend = true;
#pragma unroll
        for (int a = 0; a < 2; ++a)
#pragma unroll
            for (int b = 0; b < 2; ++b)
#pragma unroll
                for (int m = 0; m < 4; ++m)
#pragma unroll
                    for (int n = 0; n < 2; ++n) acc[a][b][m][n] = (f32x4){0.f, 0.f, 0.f, 0.f};
        cur = nxt; cA = nA; cB = nB; ++ui;
        if constexpr (SchedVarK<Sched>::value) nt = S.ktiles(cur);
        if constexpr (Sched::GATHER) {
#pragma unroll
            for (int h = 0; h < 2; ++h)
#pragma unroll
                for (int i = 0; i < 2; ++i) vAc[h][i] = vAn[h][i];
        }
        if constexpr (ALIGN_EPI) { if (wr == 1) PG8_BAR; }
    }
    PG8_WAIT_V(0);
    if constexpr (!ALIGN_EPI) { if (wr == 0) PG8_BAR; }
    asm volatile("s_waitcnt vmcnt(0) lgkmcnt(0)\n\ts_barrier" ::: "memory");
    __builtin_amdgcn_sched_barrier(0);
#undef PG8_SA
#undef PG8_SB
#undef PG8_STAGE
#undef PG8_LDA
#undef PG8_LDB
#undef PG8_MMA
#undef PG8_WAIT_V
#undef PG8_WAIT_L
#undef PG8_BAR
#undef PG8_SCHED
}

struct DenseSched {
    static constexpr bool GATHER = false;
    const bf16_t* A; const bf16_t* Bt; int lda, ldb, nM, nN, G, c;
    __device__ __forceinline__ bool next(int i, Unit& u) const { const int v = i * G + c; if (v >= nM * nN) return false; u.pm = v / nN; u.pn = v % nN; u.ord = i; return true; }
    __device__ __forceinline__ const char* a_base(const Unit& u) const { return (const char*)(A + (size_t)u.pm * BM * lda); }
    __device__ __forceinline__ const char* b_base(const Unit& u) const { return (const char*)(Bt + (size_t)u.pn * BM * ldb); }
    __device__ __forceinline__ void a_off(const Unit&, const int (&R)[2], const int (&C)[2], unsigned (&v)[2][2]) const {
#pragma unroll
        for (int i = 0; i < 2; ++i) { v[0][i] = (unsigned)(R[i] * lda + C[i]) * 2u; v[1][i] = (unsigned)((HALF + R[i]) * lda + C[i]) * 2u; }
    }
};
struct DenseSched8 : DenseSched { int sw8, sa8; };
struct ProjSched8 : DenseSched8 {
    __device__ __forceinline__ bool next(int i, Unit& u) const {
        if (nN != 28 || (nM & 1) || (G & 7)) return DenseSched::next(i, u);
        const int x = c & 7, wl = i * (G >> 3) + (c >> 3), half = nM >> 1;
        if (wl >= half * 7) return false;
        u.pm = (x >> 2) * half + wl / 7; u.pn = 7 * (x & 3) + wl % 7; u.ord = i; return true;
    }
};
}

#define XB_TMO      128
#define XB_XCNT(j)  (256  + 64 * (j))
#define XB_XSUB(j)  (1280 + 64 * (j))
#define XB_XGEN(j)  (2304 + 64 * (j))
#define XB_TOP      3328
#define XB_TOPGEN   3392
#define XCD_BAR_WORDS 3456
#define XB_SPIN_CAP (1u << 18)
__device__ __forceinline__ unsigned xb_ld(unsigned* p)              { return __hip_atomic_load(p, __ATOMIC_RELAXED, __HIP_MEMORY_SCOPE_AGENT); }
__device__ __forceinline__ unsigned xb_add(unsigned* p, unsigned v) { return __hip_atomic_fetch_add(p, v, __ATOMIC_RELAXED, __HIP_MEMORY_SCOPE_AGENT); }
__device__ __forceinline__ unsigned xb_xcc_id() { return (unsigned)__builtin_amdgcn_s_getreg((3 << 11) | 20) & 0xFu; }
#define XB_SPIN(cond, bar) do { unsigned _sp = 0; while (cond) { __builtin_amdgcn_s_sleep(1); \
    if ((++_sp & 255u) == 0u) { if (xb_ld(&(bar)[XB_TMO])) break; if (_sp > XB_SPIN_CAP) { atomicAdd(&(bar)[XB_TMO], 1u); break; } } } } while (0)
struct XcdBarrier { unsigned* bar; unsigned x; volatile LAS unsigned* st; };
__device__ __forceinline__ XcdBarrier xcd_barrier_post(unsigned* bar, volatile LAS unsigned* st) {
    XcdBarrier b; b.bar = bar; b.x = xb_xcc_id(); b.st = st;
    if (threadIdx.x == 0) (void)xb_add(&bar[XB_XCNT(b.x)], 1u);
    return b;
}
__device__ __forceinline__ void xcd_barrier_complete(unsigned* bar, unsigned x, unsigned& nloc, unsigned& nx) {
    const unsigned G = gridDim.x * gridDim.y * gridDim.z;
    unsigned sum, cnt, mine, sp = 0u;
    for (;;) {
        sum = 0u; cnt = 0u; mine = 0u;
#pragma unroll
        for (unsigned j = 0; j < 16; ++j) { const unsigned c = xb_ld(&bar[XB_XCNT(j)]); sum += c; cnt += (c > 0u) ? 1u : 0u; mine = (j == x) ? c : mine; }
        if (sum == G) break;
        __builtin_amdgcn_s_sleep(1);
        if ((++sp & 255u) == 0u) { if (xb_ld(&bar[XB_TMO])) break; if (sp > XB_SPIN_CAP) { atomicAdd(&bar[XB_TMO], 1u); break; } }
    }
    nloc = mine > 0u ? mine : 1u; nx = cnt > 0u ? cnt : 1u;
}
__device__ __forceinline__ void xcd_barrier(const XcdBarrier& b) {
    asm volatile("s_waitcnt vmcnt(0)" ::: "memory");
    __syncthreads();
    if (threadIdx.x == 0) {
        unsigned* bar = b.bar;
        __builtin_amdgcn_s_waitcnt(0);
        unsigned nloc = b.st[0], nx = b.st[1];
        if (nloc == 0u) { xcd_barrier_complete(bar, b.x, nloc, nx); b.st[0] = nloc; b.st[1] = nx; }
        const unsigned old = xb_add(&bar[XB_XSUB(b.x)], 1u);
        const unsigned gen = old / nloc;
        if (old + 1u == (gen + 1u) * nloc) {
            __builtin_amdgcn_fence(__ATOMIC_RELEASE, "agent");
            asm volatile("s_waitcnt vmcnt(0)" ::: "memory");
            const unsigned og = xb_add(&bar[XB_TOP], 1u);
            const unsigned tg = og / nx;
            if (og + 1u == (tg + 1u) * nx) xb_add(&bar[XB_TOPGEN], 1u);
            else XB_SPIN(xb_ld(&bar[XB_TOPGEN]) == tg, bar);
            __builtin_amdgcn_fence(__ATOMIC_ACQUIRE, "agent");
            xb_add(&bar[XB_XGEN(b.x)], 1u);
            asm volatile("s_waitcnt vmcnt(0)" ::: "memory");
        } else {
            XB_SPIN(xb_ld(&bar[XB_XGEN(b.x)]) == gen, bar);
            __builtin_amdgcn_fence(__ATOMIC_ACQUIRE, "agent");
            asm volatile("s_waitcnt vmcnt(0)" ::: "memory");
        }
    }
    __syncthreads();
}

constexpr size_t MiB = 1u << 20;
constexpr size_t WS_CTL = 0, CTL_ZERO_BYTES = 1 * MiB;
constexpr int CW_BAR = 4096;
constexpr int CW_QUEUE = 16384;
constexpr size_t WS_W13 = 2 * MiB;
constexpr size_t WS_W2  = 34 * MiB;
constexpr size_t WS_WR  = 50 * MiB;
constexpr size_t WS_MISC = 51 * MiB;
constexpr size_t WS_ROUTE = 52 * MiB;
constexpr size_t WS_RPOS = 53 * MiB;
constexpr size_t WS_ROWTOK = 54 * MiB;
constexpr size_t WS_ROPE = 55 * MiB;
constexpr size_t WS_WUQ = 56 * MiB;
constexpr size_t WS_WUKV = 57 * MiB;
constexpr size_t WS_WA = 58 * MiB;
constexpr size_t WS_WB = 59 * MiB;
constexpr size_t WS_WC = 60 * MiB;
constexpr size_t WS_WO = 61 * MiB;
constexpr size_t WS_SSQ = 63 * MiB;
constexpr size_t WS_LSE = 64 * MiB;
constexpr size_t WS_MASK = 66 * MiB;
constexpr size_t WS_XB8 = 74 * MiB;
constexpr size_t WS_WIN8 = 138 * MiB;
constexpr size_t WS_H = 146 * MiB;
constexpr size_t WS_Y = 182 * MiB;
constexpr size_t WS_SC = WS_Y;
constexpr size_t WS_G3 = 254 * MiB;
constexpr size_t WS_PROJ = 350 * MiB;
constexpr size_t WS_QM = 606 * MiB;
constexpr size_t WS_KVM = 654 * MiB;
constexpr size_t WS_OA = 718 * MiB;
constexpr size_t WS_OB = 734 * MiB;
constexpr size_t WS_OC = 750 * MiB;
constexpr size_t WS_OG = 766 * MiB;
constexpr size_t WS_M0 = 814 * MiB;
constexpr size_t WS_M1 = 846 * MiB;
constexpr size_t WS_MERGED = 878 * MiB;
constexpr size_t WS_END = 910 * MiB;
constexpr int F8_SA_X = 127 - 4, F8_SW = 127 - 10;
constexpr int MAXROWS = 139264;
constexpr int NBC = 16, TC = NBC * SEQ, NCHUNK = NB / NBC;
constexpr int CIN = 3944, PW = 4096;

constexpr int MI_BLOCKCNT = 0;
constexpr int MI_PANEL_E = 8192;
constexpr int MI_NPAN = 8192 + 1024;

constexpr int RING_BYTES = 131072;
constexpr int L_CTL = RING_BYTES;
constexpr int L_BARW = L_CTL + 32;
constexpr int L_HIST = L_CTL + 256;
constexpr int L_TOT  = L_CTL + 384;
constexpr int L_PRE  = L_CTL + 512;
constexpr int L_BASE = L_CTL + 640;
constexpr int L_RANK = L_CTL + 896;
constexpr int L_PE   = L_CTL + 1024;
constexpr int L_ROWS = L_CTL + 2048;
constexpr int LDS_BYTES = 147456;
constexpr int L_GB = L_ROWS;
static_assert(L_ROWS + 12288 <= LDS_BYTES, "LDS map");

#ifndef DUPMASK
#define DUPMASK 0
#endif
struct Args { const float* in[23]; float* out; unsigned char* ws; };
#define PHASE_IDS(F) do { int t_ = threadIdx.x; asm volatile("" : "+v"(t_)); (F).tid = t_; (F).lane = t_ & 63; { intab_t p_ = (intab_t)__builtin_amdgcn_kernarg_segment_ptr(); asm volatile("" : "+s"(p_)); (F).in.p = p_; } \
    { unsigned char GAS* w_ = (unsigned char GAS*)(F).ws0; asm volatile("" : "+s"(w_)); (F).ws = (unsigned char*)w_; float GAS* o_ = (float GAS*)(F).out0; asm volatile("" : "+s"(o_)); (F).out = (float*)o_; } } while (0)

typedef const float GAS* gfptr_t;
typedef const gfptr_t __attribute__((address_space(4)))* intab_t;
struct InTab { intab_t p; __device__ __forceinline__ const float* operator[](int i) const { return (const float*)p[i]; } };
struct Frame {
    LAS unsigned char* lds;
    int tid, lane, wave, vcu, G;
    InTab in; float* out; unsigned char* ws; float* out0; unsigned char* ws0;
};

template <class F>
__device__ __forceinline__ void conv_item(bf16_t* WT, int ldk, int k0, int n0, LAS float* scr, int lane, F val) {
#pragma unroll 8
    for (int i = 0; i < 32; ++i) { const int kk = 2 * i + (lane >> 5); scr[kk * 33 + (lane & 31)] = val(k0 + kk, n0 + (lane & 31)); }
    LDS_WAIT(); asm volatile("" ::: "memory");
    const int c = lane & 7;
#pragma unroll
    for (int j = 0; j < 4; ++j) { const int n = (lane >> 3) + 8 * j; const LAS float* s = scr + (8 * c) * 33 + n;
        u32x4 o; o.x = pk2(s[0 * 33], s[1 * 33]); o.y = pk2(s[2 * 33], s[3 * 33]); o.z = pk2(s[4 * 33], s[5 * 33]); o.w = pk2(s[6 * 33], s[7 * 33]);
        *(u32x4*)(WT + (size_t)(n0 + n) * ldk + k0 + 8 * c) = o; }
    LDS_WAIT(); asm volatile("" ::: "memory");
}

template <class F>
__device__ __forceinline__ void conv_item8(unsigned char* WT, int ldk, int k0, int n0, LAS float* scr, int lane, F val) {
#pragma unroll 8
    for (int i = 0; i < 32; ++i) { const int kk = 2 * i + (lane >> 5); scr[kk * 33 + (lane & 31)] = val(k0 + kk, n0 + (lane & 31)); }
    LDS_WAIT(); asm volatile("" ::: "memory");
    const int c = lane & 7;
#pragma unroll
    for (int j = 0; j < 4; ++j) { const int n = (lane >> 3) + 8 * j; const LAS float* s = scr + (8 * c) * 33 + n;
        u32x2 o; o.x = pk4_fp8(s[0 * 33], s[1 * 33], s[2 * 33], s[3 * 33]); o.y = pk4_fp8(s[4 * 33], s[5 * 33], s[6 * 33], s[7 * 33]);
        *(u32x2*)(WT + (size_t)(n0 + n) * ldk + k0 + 8 * c) = o; }
    LDS_WAIT(); asm volatile("" ::: "memory");
}

__device__ __forceinline__ void conv_plain8(unsigned char* WT, int ldk, int k0, int n0, LAS float* scr, int lane, const float* src, int pitch, float sc) {
    f32x4 v[8];
#pragma unroll
    for (int i = 0; i < 8; ++i) v[i] = *(const f32x4*)(src + (size_t)(k0 + (lane >> 3) + 8 * i) * pitch + n0 + (lane & 7) * 4);
#pragma unroll
    for (int i = 0; i < 8; ++i) { LAS float* d = scr + ((lane >> 3) + 8 * i) * 33 + (lane & 7) * 4; d[0] = v[i][0] * sc; d[1] = v[i][1] * sc; d[2] = v[i][2] * sc; d[3] = v[i][3] * sc; }
    LDS_WAIT(); asm volatile("" ::: "memory");
    const int c = lane & 7;
#pragma unroll
    for (int j = 0; j < 4; ++j) { const int n = (lane >> 3) + 8 * j; const LAS float* s = scr + (8 * c) * 33 + n;
        u32x2 o; o.x = pk4_fp8(s[0 * 33], s[1 * 33], s[2 * 33], s[3 * 33]); o.y = pk4_fp8(s[4 * 33], s[5 * 33], s[6 * 33], s[7 * 33]);
        *(u32x2*)(WT + (size_t)(n0 + n) * ldk + k0 + 8 * c) = o; }
    LDS_WAIT(); asm volatile("" ::: "memory");
}
__device__ __forceinline__ void conv_pair8(unsigned char* WT, int ldk, int k0, int n0, LAS float* scr, int lane, const float* a, const float* b, int pitch, float sc) {
    f32x2 va[8], vb[8];
#pragma unroll
    for (int i = 0; i < 8; ++i) { const size_t o = (size_t)(k0 + (lane >> 3) + 8 * i) * pitch + (n0 >> 1) + (lane & 7) * 2; va[i] = *(const f32x2*)(a + o); vb[i] = *(const f32x2*)(b + o); }
#pragma unroll
    for (int i = 0; i < 8; ++i) { LAS float* d = scr + ((lane >> 3) + 8 * i) * 33 + (lane & 7) * 4; d[0] = va[i][0] * sc; d[1] = vb[i][0] * sc; d[2] = va[i][1] * sc; d[3] = vb[i][1] * sc; }
    LDS_WAIT(); asm volatile("" ::: "memory");
    const int c = lane & 7;
#pragma unroll
    for (int j = 0; j < 4; ++j) { const int n = (lane >> 3) + 8 * j; const LAS float* s = scr + (8 * c) * 33 + n;
        u32x2 o; o.x = pk4_fp8(s[0 * 33], s[1 * 33], s[2 * 33], s[3 * 33]); o.y = pk4_fp8(s[4 * 33], s[5 * 33], s[6 * 33], s[7 * 33]);
        *(u32x2*)(WT + (size_t)(n0 + n) * ldk + k0 + 8 * c) = o; }
    LDS_WAIT(); asm volatile("" ::: "memory");
}

__device__ __forceinline__ void phase_conv_moe(Frame& F, int l) {
    PHASE_IDS(F);
    LAS float* scr = (LAS float*)(F.lds + F.wave * 16384);
    const int gw = F.vcu * NWAVES + F.wave, NGW = F.G * NWAVES;
    const float* w1 = F.in[18] + (size_t)l * NEXP * DM * DEXP;
    const float* w3 = F.in[19] + (size_t)l * NEXP * DM * DEXP;
    const float* w2 = F.in[20] + (size_t)l * NEXP * DEXP * DM;
    bf16_t* W13 = (bf16_t*)(F.ws + WS_W13); bf16_t* W2 = (bf16_t*)(F.ws + WS_W2);
    constexpr int I13 = (DM / 64) * (512 / 32);
    constexpr int I2 = (DEXP / 64) * (DM / 32);
    for (int it = gw; it < NEXP * (I13 + I2); it += NGW) {
        if (it < NEXP * I13) {
            const int e = it / I13, r = it % I13, kb = r / 16, nb = r % 16;
            const float* a = w1 + (size_t)e * DM * DEXP; const float* b = w3 + (size_t)e * DM * DEXP;
            conv_pair8((unsigned char*)W13 + (size_t)e * 512 * DM, DM, kb * 64, nb * 32, scr, F.lane, a, b, DEXP, 1024.f);
        } else {
            const int it2 = it - NEXP * I13; const int e = it2 / I2, r = it2 % I2, kb = r / 32, nb = r % 32;
            const float* a = w2 + (size_t)e * DEXP * DM;
            conv_plain8((unsigned char*)W2 + (size_t)e * DM * DEXP, DEXP, kb * 64, nb * 32, scr, F.lane, a, DM, 1024.f);
        }
    }
    const float* wg = F.in[14] + (size_t)l * DM * 4; const float* wsb = F.in[16] + (size_t)l * DM * NEXP;
    const float* g1 = F.in[12] + (size_t)l * DM; const float* b1 = F.in[13] + (size_t)l * DM;
    bf16_t* WRH = (bf16_t*)(F.ws + WS_WR); bf16_t* WRL = (bf16_t*)(F.ws + WS_WR + 128 * 1024); float* WRC = (float*)(F.ws + WS_WR + 256 * 1024);
    for (int idx = (F.vcu * NTHREADS + F.tid); idx < 64 * DM; idx += F.G * NTHREADS) {
        const int c = idx / DM, k = idx % DM;
        const float v = (c < 32 ? wsb[(size_t)k * NEXP + c] : (c < 36 ? wg[(size_t)k * 4 + (c - 32)] : 0.f)) * g1[k];
        const unsigned h = f2bf(v); const int it = k >> 5, hi_ = (k >> 4) & 1, st = (k >> 3) & 1, e = k & 7, ln = (c & 31) + 32 * hi_, p0 = 2 * (c >> 5);
        WRH[((((size_t)it * 4 + p0) * 2 + st) * 64 + ln) * 8 + e] = (bf16_t)h;
        WRH[((((size_t)it * 4 + p0 + 1) * 2 + st) * 64 + ln) * 8 + e] = (bf16_t)f2bf(v - __builtin_bit_cast(float, h << 16)); (void)WRL;
    }
    if (gw < 64) {
        const int c = gw; float s1 = 0.f, s2 = 0.f;
        for (int k = F.lane; k < DM; k += 64) { const float w = c < 32 ? wsb[(size_t)k * NEXP + c] : (c < 36 ? wg[(size_t)k * 4 + (c - 32)] : 0.f); s1 += g1[k] * w; s2 += b1[k] * w; }
        s1 = wave_sum(s1); s2 = wave_sum(s2);
        const float bias = c < 32 ? F.in[17][(size_t)l * NEXP + c] : (c < 36 ? F.in[15][(size_t)l * 4 + (c - 32)] : 0.f);
        if (F.lane == 0) { WRC[c] = s1; WRC[64 + c] = s2 + bias; }
    }
}

__device__ __forceinline__ void ln_row(f32x4 (&v)[4], const f32x4 (&g)[4], const f32x4 (&b)[4], float* omean = nullptr, float* orstd = nullptr) {
    float s = 0.f;
#pragma unroll
    for (int j = 0; j < 4; ++j) s += (v[j].x + v[j].y) + (v[j].z + v[j].w);
    const float mean = wave_sum(s) * (1.f / DM); float s2 = 0.f;
#pragma unroll
    for (int j = 0; j < 4; ++j) { v[j] = v[j] - mean; s2 += (v[j].x * v[j].x + v[j].y * v[j].y) + (v[j].z * v[j].z + v[j].w * v[j].w); }
    const float rstd = 1.0f / sqrtf(wave_sum(s2) * (1.f / DM) + LN_EPS);
#pragma unroll
    for (int j = 0; j < 4; ++j) v[j] = v[j] * rstd * g[j] + b[j];
    if (omean) { *omean = mean; *orstd = rstd; }
}
__device__ __forceinline__ void store_row(const f32x4 (&v)[4], float* orow, unsigned char* brow, int lane) {
#pragma unroll
    for (int j = 0; j < 4; ++j) {
        ((f32x4*)orow)[lane + 64 * j] = v[j];
        ((unsigned*)brow)[lane + 64 * j] = pk4_fp8(v[j].x * 16.f, v[j].y * 16.f, v[j].z * 16.f, v[j].w * 16.f);
    }
}

__device__ __forceinline__ void phase_ln1_router(Frame& F, int l, const float* src, bool scale_alpha) {
    PHASE_IDS(F);
    const int lane = F.lane, hi = lane >> 5, r32 = lane & 31;
    const float* lg = F.in[12] + (size_t)l * DM; const float* lb = F.in[13] + (size_t)l * DM;
    f32x4 g[4], b[4];
#pragma unroll
    for (int j = 0; j < 4; ++j) { g[j] = ((const f32x4*)lg)[lane + 64 * j]; b[j] = ((const f32x4*)lb)[lane + 64 * j]; }
    unsigned char* XB = F.ws + WS_XB8;
    const bf16_t* WRH = (const bf16_t*)(F.ws + WS_WR); const bf16_t* WRL = (const bf16_t*)(F.ws + WS_WR + 128 * 1024);
    const float* WRC = (const float*)(F.ws + WS_WR + 256 * 1024); float* stats = (float*)(F.ws + WS_WR + 512 * 1024);
    unsigned* misc = (unsigned*)(F.ws + WS_MISC);
    int* route = (int*)(F.ws + WS_ROUTE);
    LAS unsigned* hist = (LAS unsigned*)(F.lds + L_HIST);
    const float sc = scale_alpha ? ALPHA : 1.0f;
    for (int blk = F.vcu; blk < TT / 256; blk += F.G) {
        if (F.tid < 32) hist[F.tid] = 0u;
        __syncthreads();
        const int row0 = blk * 256 + F.wave * 32;
        float mu_l = 0.f, rs_l = 1.f;
        for (int i = 0; i < 32; i += 2) {
            f32x4 v0[4], v1[4];
            const f32x4* p0 = (const f32x4*)(src + (size_t)(row0 + i) * DM); const f32x4* p1 = (const f32x4*)(src + (size_t)(row0 + i + 1) * DM);
#pragma unroll
            for (int j = 0; j < 4; ++j) { v0[j] = p0[lane + 64 * j] * sc; v1[j] = p1[lane + 64 * j] * sc; }
            float m0, r0, m1, r1;
            ln_row(v0, g, b, &m0, &r0); ln_row(v1, g, b, &m1, &r1);
            mu_l = (r32 == i) ? m0 : ((r32 == i + 1) ? m1 : mu_l); rs_l = (r32 == i) ? r0 : ((r32 == i + 1) ? r1 : rs_l);
#pragma unroll
            for (int j = 0; j < 4; ++j) {
                ((unsigned*)(XB + (size_t)(row0 + i) * DM))[lane + 64 * j] = pk4_fp8(v0[j].x * 16.f, v0[j].y * 16.f, v0[j].z * 16.f, v0[j].w * 16.f);
                ((unsigned*)(XB + (size_t)(row0 + i + 1) * DM))[lane + 64 * j] = pk4_fp8(v1[j].x * 16.f, v1[j].y * 16.f, v1[j].z * 16.f, v1[j].w * 16.f); }
        }
        if (hi == 0) *(f32x2*)(stats + (size_t)(row0 + r32) * 2) = (f32x2){mu_l, rs_l};
        f32x16 acc0 = {}, acc1 = {};
        {
            const bf16_t* WT = WRH; (void)WRL;
            LAS float* xs = (LAS float*)(F.lds + F.wave * 9216);
            const float* xg = src + (size_t)(row0 + (lane >> 3)) * DM + (lane & 7) * 4;
            f32x4 xv[4]; bf16x8 wv[8];
#pragma unroll
            for (int i = 0; i < 4; ++i) xv[i] = *(const f32x4*)(xg + (size_t)(8 * i) * DM);
#pragma unroll
            for (int q = 0; q < 8; ++q) wv[q] = *(const bf16x8*)(WT + ((size_t)q * 64 + lane) * 8);
#pragma unroll 2
            for (int it = 0; it < 32; ++it) {
                LAS float* xb = xs + (it & 1) * 1152;
#pragma unroll
                for (int i = 0; i < 4; ++i) *(LAS f32x4*)(xb + ((lane >> 3) + 8 * i) * 36 + (lane & 7) * 4) = xv[i];
                bf16x8 wc[8];
#pragma unroll
                for (int q = 0; q < 8; ++q) wc[q] = wv[q];
                { const int nx = it + 1 < 32 ? it + 1 : 31;
#pragma unroll
                  for (int i = 0; i < 4; ++i) xv[i] = *(const f32x4*)(xg + (size_t)(8 * i) * DM + nx * 32);
#pragma unroll
                  for (int q = 0; q < 8; ++q) wv[q] = *(const bf16x8*)(WT + (((size_t)nx * 8 + q) * 64 + lane) * 8); }
                f32x4 xa[4];
#pragma unroll
                for (int j = 0; j < 4; ++j) xa[j] = *(const LAS f32x4*)(xb + r32 * 36 + hi * 16 + 4 * j);
#pragma unroll
                for (int st = 0; st < 2; ++st) {
                    const f32x4 x0 = xa[2 * st], x1 = xa[2 * st + 1];
                    u32x4 xh, xl;
                    xh.x = cvt_pk_bf16(x0[0], x0[1]); xh.y = cvt_pk_bf16(x0[2], x0[3]); xh.z = cvt_pk_bf16(x1[0], x1[1]); xh.w = cvt_pk_bf16(x1[2], x1[3]);
                    xl.x = cvt_pk_bf16(x0[0] - bflo(xh.x), x0[1] - bfhi(xh.x)); xl.y = cvt_pk_bf16(x0[2] - bflo(xh.y), x0[3] - bfhi(xh.y));
                    xl.z = cvt_pk_bf16(x1[0] - bflo(xh.z), x1[1] - bfhi(xh.z)); xl.w = cvt_pk_bf16(x1[2] - bflo(xh.w), x1[3] - bfhi(xh.w));
                    const bf16x8 xhv = __builtin_bit_cast(bf16x8, xh), xlv = __builtin_bit_cast(bf16x8, xl);
                    acc0 = __builtin_amdgcn_mfma_f32_32x32x16_bf16(wc[0 + st], xhv, acc0, 0, 0, 0); acc1 = __builtin_amdgcn_mfma_f32_32x32x16_bf16(wc[4 + st], xhv, acc1, 0, 0, 0);
                    acc0 = __builtin_amdgcn_mfma_f32_32x32x16_bf16(wc[2 + st], xhv, acc0, 0, 0, 0); acc1 = __builtin_amdgcn_mfma_f32_32x32x16_bf16(wc[6 + st], xhv, acc1, 0, 0, 0);
                    acc0 = __builtin_amdgcn_mfma_f32_32x32x16_bf16(wc[0 + st], xlv, acc0, 0, 0, 0); acc1 = __builtin_amdgcn_mfma_f32_32x32x16_bf16(wc[4 + st], xlv, acc1, 0, 0, 0);
                }
            }
        }
        float gl[4];
#pragma unroll
        for (int i = 0; i < 4; ++i) gl[i] = rs_l * (acc1[i] - mu_l * WRC[32 + i]) + WRC[64 + 32 + i];
        int gidx = 0; float gmax = gl[0];
#pragma unroll
        for (int i = 1; i < 4; ++i) if (gl[i] > gmax) { gmax = gl[i]; gidx = i; }
        float gsum = 0.f;
#pragma unroll
        for (int i = 0; i < 4; ++i) gsum += fast_exp(gl[i] - gmax);
        float gp = 1.0f / gsum;
        gidx = __shfl(gidx, r32); gp = __shfl(gp, r32);
        float cv[4];
#pragma unroll
        for (int i = 0; i < 4; ++i) {
            const float a = gidx == 0 ? acc0[i] : gidx == 1 ? acc0[4 + i] : gidx == 2 ? acc0[8 + i] : acc0[12 + i];
            cv[i] = rs_l * (a - mu_l * WRC[8 * gidx + 4 * hi + i]) + WRC[64 + 8 * gidx + 4 * hi + i];
        }
        float v1 = cv[0]; int i1 = 0;
#pragma unroll
        for (int i = 1; i < 4; ++i) if (cv[i] > v1) { v1 = cv[i]; i1 = i; }
        float v2 = -INFINITY; int i2 = 0;
#pragma unroll
        for (int i = 0; i < 4; ++i) if (i != i1 && cv[i] > v2) { v2 = cv[i]; i2 = i; }
        i1 += 4 * hi; i2 += 4 * hi;
        const float pv1 = __shfl_xor(v1, 32), pv2 = __shfl_xor(v2, 32); const int pi1 = __shfl_xor(i1, 32), pi2 = __shfl_xor(i2, 32);
        auto better = [](float av, int ai, float bv, int bi) { return av > bv || (av == bv && ai < bi); };
        float fv, sv; int fi, si;
        if (better(v1, i1, pv1, pi1)) { fv = v1; fi = i1; if (better(v2, i2, pv1, pi1)) { sv = v2; si = i2; } else { sv = pv1; si = pi1; } }
        else { fv = pv1; fi = pi1; if (better(v1, i1, pv2, pi2)) { sv = v1; si = i1; } else { sv = pv2; si = pi2; } }
        const float d = fast_exp(sv - fv), inv = 1.0f / (1.0f + d);
        const float w1 = gp * inv, w2 = gp * d * inv;
        const int e1 = 8 * gidx + fi, e2 = 8 * gidx + si;
        if (hi == 0) {
            *(int4*)(route + (size_t)(row0 + r32) * 4) = make_int4(e1, e2, __float_as_int(w1), __float_as_int(w2));
            atomicAdd((unsigned*)&hist[e1], 1u); atomicAdd((unsigned*)&hist[e2], 1u);
        }
        __syncthreads();
        if (F.tid < 32) misc[MI_BLOCKCNT + blk * 32 + F.tid] = hist[F.tid];
        __syncthreads();
    }
}

__device__ __forceinline__ void phase_moe_scatter(Frame& F) {
    PHASE_IDS(F);
    unsigned* misc = (unsigned*)(F.ws + WS_MISC);
    const int* route = (const int*)(F.ws + WS_ROUTE);
    int* rpos = (int*)(F.ws + WS_RPOS); int* rowtok = (int*)(F.ws + WS_ROWTOK);
    LAS unsigned* tot = (LAS unsigned*)(F.lds + L_TOT); LAS unsigned* pre = (LAS unsigned*)(F.lds + L_PRE);
    LAS unsigned* base = (LAS unsigned*)(F.lds + L_BASE); LAS unsigned* rank = (LAS unsigned*)(F.lds + L_RANK);
    for (int blk = F.vcu; blk < TT / 256; blk += F.G) {
        {
            if (F.tid < 32) { tot[F.tid] = 0u; pre[F.tid] = 0u; rank[F.tid] = 0u; }
            __syncthreads();
            const int e = F.tid & 31, part = F.tid >> 5; unsigned cv[16];
#pragma unroll
            for (int i = 0; i < 16; ++i) cv[i] = misc[MI_BLOCKCNT + (part * 16 + i) * 32 + e];
            unsigned t = 0, p = 0;
#pragma unroll
            for (int i = 0; i < 16; ++i) { t += cv[i]; p += (part * 16 + i < blk) ? cv[i] : 0u; }
            atomicAdd((unsigned*)&tot[e], t); atomicAdd((unsigned*)&pre[e], p);
        }
        __syncthreads();
        if (F.tid == 0) { unsigned a = 0; for (int e = 0; e < NEXP; ++e) { base[e] = a; a += (tot[e] + 255u) & ~255u; } base[NEXP] = a; }
        __syncthreads();
        {
            const int tok = blk * 256 + (F.tid >> 1), slot = F.tid & 1;
            const int e = route[(size_t)tok * 4 + slot];
            const unsigned r = atomicAdd((unsigned*)&rank[e], 1u);
            const unsigned pos = base[e] + pre[e] + r;
            rowtok[pos] = tok; rpos[(size_t)tok * 2 + slot] = (int)pos;
        }
        if (blk < NEXP) {
            const int e = blk; const unsigned end = base[e] + tot[e], nxt = base[e + 1];
            for (unsigned p = end + F.tid; p < nxt; p += NTHREADS) rowtok[p] = 0;
            for (unsigned p = base[e] / 256 + F.tid; p < nxt / 256; p += NTHREADS) misc[MI_PANEL_E + p] = (unsigned)e;
        }
        if (blk == 0 && F.tid == 0) misc[MI_NPAN] = base[NEXP] / 256;
        __syncthreads();
    }
}

struct MoeSched1 {
    static constexpr bool GATHER = true;
    const bf16_t* A; const bf16_t* W; int lda, ldb, ntot, G, c; const LAS int* rows; const LAS int* pe; int sw8, sa8;
    __device__ __forceinline__ bool next(int i, pg8::Unit& u) const { const int v = i * G + c; if (v >= ntot) return false; u.pm = v >> 1; u.pn = v & 1; u.ord = i; return true; }
    __device__ __forceinline__ const char* a_base(const pg8::Unit&) const { return (const char*)A; }
    __device__ __forceinline__ const char* b_base(const pg8::Unit& u) const { return (const char*)(W + (size_t)pe[u.ord] * 512 * ldb + (size_t)u.pn * 256 * ldb); }
    __device__ __forceinline__ void a_off(const pg8::Unit& u, const int (&R)[2], const int (&C)[2], unsigned (&v)[2][2]) const {
#pragma unroll
        for (int h = 0; h < 2; ++h)
#pragma unroll
            for (int i = 0; i < 2; ++i) v[h][i] = (unsigned)(rows[u.ord * 256 + h * 128 + R[i]] * lda + C[i]) * 2u;
    }
};
struct MoeSched2 {
    static constexpr bool GATHER = false;
    const bf16_t* A; const bf16_t* W; int lda, ldb, ntot, G, c; const LAS int* pe; int sw8, sa8;
    __device__ __forceinline__ bool next(int i, pg8::Unit& u) const { const int v = i * G + c; if (v >= ntot) return false; u.pm = v >> 2; u.pn = v & 3; u.ord = i; return true; }
    __device__ __forceinline__ const char* a_base(const pg8::Unit& u) const { return (const char*)(A + (size_t)u.pm * 256 * lda); }
    __device__ __forceinline__ const char* b_base(const pg8::Unit& u) const { return (const char*)(W + (size_t)pe[u.ord] * DM * ldb + (size_t)u.pn * 256 * ldb); }
    __device__ __forceinline__ void a_off(const pg8::Unit&, const int (&R)[2], const int (&C)[2], unsigned (&v)[2][2]) const {
#pragma unroll
        for (int i = 0; i < 2; ++i) { v[0][i] = (unsigned)(R[i] * lda + C[i]) * 2u; v[1][i] = (unsigned)((128 + R[i]) * lda + C[i]) * 2u; }
    }
};
struct EpiSwiGLU {
    bf16_t* H;
    __device__ __forceinline__ void operator()(const f32x4 (&acc)[2][2][4][2], const pg8::Unit& u, int wr, int wc, int fr, int fq) const {
        const int row0 = u.pm * 256 + wr * 64 + fr, col0 = u.pn * 128 + wc * 16 + 4 * fq;
#pragma unroll
        for (int ai = 0; ai < 2; ++ai)
#pragma unroll
            for (int m = 0; m < 4; ++m) { bf16_t* rowp = H + (size_t)(row0 + ai * 128 + m * 16) * DEXP + col0;
#pragma unroll
                for (int bj = 0; bj < 2; ++bj) { const f32x4 v0 = acc[ai][bj][m][0], v1 = acc[ai][bj][m][1];
                    const float h0 = v0[0] * sigmoidf_(v0[0]) * v0[1], h1 = v0[2] * sigmoidf_(v0[2]) * v0[3], h2 = v1[0] * sigmoidf_(v1[0]) * v1[1], h3 = v1[2] * sigmoidf_(v1[2]) * v1[3];
                    *(unsigned*)((unsigned char*)H + (size_t)(row0 + ai * 128 + m * 16) * DEXP + col0 + bj * 64) = pk4_fp8(h0 * 16.f, h1 * 16.f, h2 * 16.f, h3 * 16.f); (void)rowp; } }
    }
};
struct EpiStoreBf16 {
    bf16_t* O; int ldc;
    __device__ __forceinline__ void operator()(const f32x4 (&acc)[2][2][4][2], const pg8::Unit& u, int wr, int wc, int fr, int fq) const {
        const int row0 = u.pm * 256 + wr * 64 + fr, col0 = u.pn * 256 + wc * 32 + 8 * fq;
#pragma unroll
        for (int ai = 0; ai < 2; ++ai)
#pragma unroll
            for (int m = 0; m < 4; ++m) { bf16_t* rowp = O + (size_t)(row0 + ai * 128 + m * 16) * ldc + col0;
#pragma unroll
                for (int bj = 0; bj < 2; ++bj) store8_fp8((unsigned char*)O + (size_t)(row0 + ai * 128 + m * 16) * ldc + col0 + bj * 128, acc[ai][bj][m][0], acc[ai][bj][m][1], 64.f); (void)rowp; }
    }
};

__device__ __forceinline__ void phase_moe_gemm1(Frame& F) {
    PHASE_IDS(F);
    const unsigned* misc = (const unsigned*)(F.ws + WS_MISC);
    const int* rowtok = (const int*)(F.ws + WS_ROWTOK);
    const int npan = (int)misc[MI_NPAN];
    LAS int* rows = (LAS int*)(F.lds + L_ROWS); LAS int* pe = (LAS int*)(F.lds + L_PE);
    const int c = (int)blockIdx.x, ntot = npan * 2;
    for (int i = 0; i * F.G + c < ntot && i < 8; ++i) { const int p = (i * F.G + c) >> 1;
        if (F.tid < 256) rows[i * 256 + F.tid] = rowtok[p * 256 + F.tid];
        if (F.tid == 256) pe[i] = (int)misc[MI_PANEL_E + p]; }
    VM_WAIT(); LDS_WAIT(); __syncthreads();
    MoeSched1 S{(const bf16_t*)(F.ws + WS_XB8), (const bf16_t*)(F.ws + WS_W13), DM / 2, DM / 2, ntot, F.G, c, rows, pe, F8_SW, F8_SA_X};
    EpiSwiGLU E{(bf16_t*)(F.ws + WS_H)};
    pg8::gemm_phase<EpiSwiGLU, MoeSched1, true, true>(F.lds, DM / 2, S, E);
}
__device__ __forceinline__ void phase_moe_gemm2(Frame& F) {
    PHASE_IDS(F);
    const unsigned* misc = (const unsigned*)(F.ws + WS_MISC);
    const int npan = (int)misc[MI_NPAN];
    LAS int* pe = (LAS int*)(F.lds + L_PE);
    const int c = (int)blockIdx.x, ntot = npan * 4;
    __syncthreads();
    if (F.tid < 16) { const int v = F.tid * F.G + c; if (v < ntot) pe[F.tid] = (int)misc[MI_PANEL_E + (v >> 2)]; }
    VM_WAIT(); LDS_WAIT(); __syncthreads();
    MoeSched2 S{(const bf16_t*)(F.ws + WS_H), (const bf16_t*)(F.ws + WS_W2), DEXP / 2, DEXP / 2, ntot, F.G, c, pe, F8_SW, 127 - 4};
    EpiStoreBf16 E{(bf16_t*)(F.ws + WS_Y), DM};
    int k2 = DEXP / 2; asm volatile("" : "+s"(k2));
    pg8::gemm_phase<EpiStoreBf16, MoeSched2, true, true>(F.lds, k2, S, E);
}

__device__ __forceinline__ void phase_combine_ln2(Frame& F, int l) {
    PHASE_IDS(F);
    const int lane = F.lane;
    const float* lg = F.in[21] + (size_t)l * DM; const float* lb = F.in[22] + (size_t)l * DM;
    f32x4 g[4], b[4];
#pragma unroll
    for (int j = 0; j < 4; ++j) { g[j] = ((const f32x4*)lg)[lane + 64 * j]; b[j] = ((const f32x4*)lb)[lane + 64 * j]; }
    const bf16_t* Y = (const bf16_t*)(F.ws + WS_Y);
    const float* l1g = F.in[12] + (size_t)l * DM; const float* l1b = F.in[13] + (size_t)l * DM; const float* stats = (const float*)(F.ws + WS_WR + 512 * 1024);
    f32x4 g1[4], b1[4];
#pragma unroll
    for (int j = 0; j < 4; ++j) { g1[j] = ((const f32x4*)l1g)[lane + 64 * j]; b1[j] = ((const f32x4*)l1b)[lane + 64 * j]; }
    const int* route = (const int*)(F.ws + WS_ROUTE); const int* rpos = (const int*)(F.ws + WS_RPOS);
    const int gw = F.vcu * NWAVES + F.wave, NGW = F.G * NWAVES;
    auto recs = [&](int r, int4& rt, int2& rp, f32x2& st) { rt = *(const int4*)(route + (size_t)r * 4); rp = *(const int2*)(rpos + (size_t)r * 2); st = *(const f32x2*)(stats + (size_t)r * 2); };
    auto rowload = [&](int r, const int2& rp, f32x4 (&x)[4], unsigned (&ya)[4], unsigned (&yc)[4]) {
        const f32x4* px = (const f32x4*)(F.out + (size_t)r * DM);
        const unsigned* y0 = (const unsigned*)((const unsigned char*)Y + (size_t)rp.x * DM); const unsigned* y1 = (const unsigned*)((const unsigned char*)Y + (size_t)rp.y * DM);
#pragma unroll
        for (int j = 0; j < 4; ++j) { x[j] = __builtin_nontemporal_load(px + lane + 64 * j); ya[j] = __builtin_nontemporal_load(y0 + lane + 64 * j); yc[j] = __builtin_nontemporal_load(y1 + lane + 64 * j); } };
    int4 rt_c, rt_n; int2 rp_c, rp_n; f32x2 st_c, st_n;
    recs(gw, rt_c, rp_c, st_c);
    { const int r1 = gw + NGW < TT ? gw + NGW : gw; recs(r1, rt_n, rp_n, st_n); }
    f32x4 xc[4]; unsigned yac[4], ycc[4];
    rowload(gw, rp_c, xc, yac, ycc);
    for (int row = gw; row < TT; row += NGW) {
        const int r1 = row + NGW < TT ? row + NGW : row, r2 = row + 2 * NGW < TT ? row + 2 * NGW : row;
        f32x4 xn[4]; unsigned yan[4], ycn[4];
        rowload(r1, rp_n, xn, yan, ycn);
        int4 rt_2; int2 rp_2; f32x2 st_2; recs(r2, rt_2, rp_2, st_2);
        const float w0 = __int_as_float(rt_c.z) * (1.f / 64.f), w1 = __int_as_float(rt_c.w) * (1.f / 64.f);
        f32x4 v[4];
#pragma unroll
        for (int j = 0; j < 4; ++j) {
            const f32x4 x = (xc[j] - st_c[0]) * st_c[1] * g1[j] + b1[j]; const unsigned a = yac[j], c = ycc[j];
            const f32x2 a01 = __builtin_amdgcn_cvt_pk_f32_fp8((int)a, false), a23 = __builtin_amdgcn_cvt_pk_f32_fp8((int)a, true), c01 = __builtin_amdgcn_cvt_pk_f32_fp8((int)c, false), c23 = __builtin_amdgcn_cvt_pk_f32_fp8((int)c, true);
            v[j].x = ALPHA * x.x + w0 * a01[0] + w1 * c01[0]; v[j].y = ALPHA * x.y + w0 * a01[1] + w1 * c01[1];
            v[j].z = ALPHA * x.z + w0 * a23[0] + w1 * c23[0]; v[j].w = ALPHA * x.w + w0 * a23[1] + w1 * c23[1];
        }
        ln_row(v, g, b);
#pragma unroll
        for (int j = 0; j < 4; ++j) __builtin_nontemporal_store(v[j], (f32x4*)(F.out + (size_t)row * DM) + lane + 64 * j);
        if (l == 0) {
#pragma unroll
            for (int j = 0; j < 4; ++j) ((unsigned*)(F.ws + WS_XB8 + (size_t)row * DM))[lane + 64 * j] = pk4_fp8(v[j].x * 16.f, v[j].y * 16.f, v[j].z * 16.f, v[j].w * 16.f);
        }
        rt_c = rt_n; rp_c = rp_n; st_c = st_n; rt_n = rt_2; rp_n = rp_2; st_n = st_2;
#pragma unroll
        for (int j = 0; j < 4; ++j) { xc[j] = xn[j]; yac[j] = yan[j]; ycc[j] = ycn[j]; }
    }
}

constexpr float C2D = 0.18033688011112042f;
constexpr float C2M = 0.14724444602590306f;
constexpr float IWS = 0.044194173824159216f;
constexpr float RMS_EPS = 1e-6f;
constexpr int L_QSLOT = L_CTL + 1152;

__device__ __forceinline__ int rope16(int c) { return c < 16 ? (c >> 1) + 8 * (c & 1) : c; }
__device__ __forceinline__ int win_src(int n, float& sc) {
    sc = 1.f;
    if (n < 384) return n;
    if (n < 416) { const int c = n - 384; return 384 + (c >> 1) + 16 * (c & 1); }
    if (n < 512) return -1;
    if (n < 2816) { const int m = n - 512, g = m / 768, r = m % 768, p = r >> 8, hh = (r & 255) >> 6, c = r & 63; if (p == 0) sc = C2D; return 416 + 768 * g + 256 * p + 64 * hh + (p < 2 ? rope16(c) : c); }
    if (n < 3328) { const int m = n - 2816; sc = C2D; return 2720 + (m & ~63) + rope16(m & 63); }
    if (n < 3840) { const int m = n - 3328; return 3360 + (m & ~63) + rope16(m & 63); }
    const int m = n - 3840;
    if (m < 64) return 3232 + rope16(m);
    if (m < 128) return 3296 + (m - 64);
    if (m < 192) return 3872 + rope16(m - 128);
    if (m < 200) { sc = IWS; return 3936 + (m - 192); }
    return -1;
}

__device__ __forceinline__ void sincos_d(double x, double& s, double& c) {
    const double n = __builtin_rint(x * 0.15915494309189535);
    double r = __builtin_fma(-n, 6.2831854820251465, x); r = __builtin_fma(n, 1.7484556025237907e-07, r);
    const double r2 = r * r; double ss = 1.0, cc = 1.0;
#pragma unroll
    for (int k = 15; k >= 1; --k) { ss = 1.0 - r2 * (1.0 / (double)((2 * k) * (2 * k + 1))) * ss; cc = 1.0 - r2 * (1.0 / (double)((2 * k - 1) * (2 * k))) * cc; }
    s = ss * r; c = cc;
}
__device__ __forceinline__ double inv_freq16(int i) {
    const double t[16] = {1.0, 0.44036660267178046, 0.19392274474868576, 0.08539710028576561, 0.03760603093086393, 0.016560440080994446, 0.007292664737217109, 0.003211445994752591,
                          0.001414213562373095, 0.000622772421914596, 0.0002742481756762073, 0.00012076973741146504, 5.318295896944988e-05, 2.341999896140934e-05, 1.031338537721246e-05, 4.5416704806078695e-06};
    double r = t[0];
#pragma unroll
    for (int k = 1; k < 16; ++k) r = (i == k) ? t[k] : r;
    return r;
}

__device__ __forceinline__ void phase_conv_mixer(Frame& F, int l) {
    PHASE_IDS(F);
    LAS float* scr = (LAS float*)(F.lds + F.wave * 16384);
    const int gw = F.vcu * NWAVES + F.wave, NGW = F.G * NWAVES;
    const float* win = F.in[1] + (size_t)l * DM * CIN;
    const float* qg = F.in[2] + (size_t)l * 256; const float* wuq = F.in[3] + (size_t)l * 256 * 768;
    const float* kg = F.in[4] + (size_t)l * 128; const float* wukv = F.in[5] + (size_t)l * 128 * 1024;
    const float* wgate = F.in[6] + (size_t)l * DM * 3072;
    const float* wa = F.in[8] + (size_t)l * 512 * DM; const float* wb = F.in[9] + (size_t)l * 256 * DM; const float* wc = F.in[10] + (size_t)l * 512 * DM; const float* wo = F.in[11] + (size_t)l * DM * DM;
    unsigned char* WIN8 = F.ws + WS_WIN8; bf16_t* WUQ = (bf16_t*)(F.ws + WS_WUQ); bf16_t* WUKV = (bf16_t*)(F.ws + WS_WUKV);
    bf16_t* WA = (bf16_t*)(F.ws + WS_WA); bf16_t* WB = (bf16_t*)(F.ws + WS_WB); bf16_t* WC = (bf16_t*)(F.ws + WS_WC); bf16_t* WO = (bf16_t*)(F.ws + WS_WO);
    constexpr int I_IN = 16 * 128, I_G = 16 * 96, I_UQ = 4 * 24, I_UKV = 4 * 32, I_A = 8 * 32, I_B = 8 * 32, I_C = 8 * 32, I_O = 16 * 32;
    constexpr int NIT = I_IN + I_G + I_UQ + I_UKV + I_A + I_B + I_C + I_O;
    for (int it = gw; it < NIT; it += NGW) {
        int r = it;
        if (r < I_IN) { conv_item8(WIN8, DM, (r / 128) * 64, (r % 128) * 32, scr, F.lane, [&](int k, int n) { float sc; const int sidx = win_src(n, sc); return sidx < 0 ? 0.f : win[(size_t)k * CIN + sidx] * (sc * 1024.f); }); continue; } r -= I_IN;
        if (r < I_G) { conv_plain8(WIN8 + (size_t)PW * DM, DM, (r / 96) * 64, (r % 96) * 32, scr, F.lane, wgate, 3072, 1024.f); continue; } r -= I_G;
        if (r < I_UQ) { conv_item(WUQ, 256, (r / 24) * 64, (r % 24) * 32, scr, F.lane, [&](int k, int n) { const int hh = n / 96, c = n % 96; const int o = c < 64 ? c : 64 + ((c - 64) >> 1) + 16 * ((c - 64) & 1);
                return qg[k] * wuq[(size_t)k * 768 + hh * 96 + o] * C2M; }); continue; } r -= I_UQ;
        if (r < I_UKV) { conv_item(WUKV, 256, (r / 32) * 64, (r % 32) * 32, scr, F.lane, [&](int k, int n) { return k < 128 ? kg[k] * wukv[(size_t)k * 1024 + n] : 0.f; }); continue; } r -= I_UKV;
        if (r < I_A) { conv_plain8((unsigned char*)WA, 512, (r / 32) * 64, (r % 32) * 32, scr, F.lane, wa, DM, 1024.f); continue; } r -= I_A;
        if (r < I_B) { conv_item8((unsigned char*)WB, 512, (r / 32) * 64, (r % 32) * 32, scr, F.lane, [&](int k, int n) { return k < 256 ? wb[(size_t)k * DM + n] * 1024.f : 0.f; }); continue; } r -= I_B;
        if (r < I_C) { conv_plain8((unsigned char*)WC, 512, (r / 32) * 64, (r % 32) * 32, scr, F.lane, wc, DM, 1024.f); continue; } r -= I_C;
        conv_plain8((unsigned char*)WO, DM, (r / 32) * 64, (r % 32) * 32, scr, F.lane, wo, DM, 1024.f);
    }
    if (l == 0) {
        float* rp = (float*)(F.ws + WS_ROPE); float* rm = rp + 2048 * 8 * 2;
        for (int idx = F.vcu * NTHREADS + F.tid; idx < 2048 * 24; idx += F.G * NTHREADS) {
            const int t = idx / 24, j = idx % 24; double sn, cs;
            if (j < 8) { sincos_d((double)t * inv_freq16(2 * j), sn, cs); rp[(t * 8 + j) * 2] = (float)cs; rp[(t * 8 + j) * 2 + 1] = (float)sn; }
            else { sincos_d((double)t * inv_freq16(j - 8), sn, cs); rm[(t * 16 + (j - 8)) * 2] = (float)cs; rm[(t * 16 + (j - 8)) * 2 + 1] = (float)sn; }
        }
        const f32x4* x4 = (const f32x4*)F.in[0]; unsigned* xb8 = (unsigned*)(F.ws + WS_XB8);
        for (size_t i = (size_t)F.vcu * NTHREADS + F.tid; i < (size_t)TT * DM / 4; i += (size_t)F.G * NTHREADS) { const f32x4 v = x4[i] * 16.f; xb8[i] = pk4_fp8(v.x, v.y, v.z, v.w); }
    }
}

__device__ __forceinline__ void rope4(f32x4& v0, f32x4& v1, const float* cs) {
    const f32x4 a = *(const f32x4*)cs, b = *(const f32x4*)(cs + 4);
    const f32x4 w0 = {v0[0] * a[0] - v0[1] * a[1], v0[1] * a[0] + v0[0] * a[1], v0[2] * a[2] - v0[3] * a[3], v0[3] * a[2] + v0[2] * a[3]};
    const f32x4 w1 = {v1[0] * b[0] - v1[1] * b[1], v1[1] * b[0] + v1[0] * b[1], v1[2] * b[2] - v1[3] * b[3], v1[3] * b[2] + v1[2] * b[3]};
    v0 = w0; v1 = w1;
}
__device__ __forceinline__ void store8(bf16_t* p, const f32x4& v0, const f32x4& v1) {
    u32x4 w; w.x = cvt_pk_bf16(v0[0], v0[1]); w.y = cvt_pk_bf16(v0[2], v0[3]); w.z = cvt_pk_bf16(v1[0], v1[1]); w.w = cvt_pk_bf16(v1[2], v1[3]); *(u32x4*)p = w;
}
struct EpiProj {
    bf16_t* P; const float* csp; const float* csm; float* ssq; bf16_t* G3; const LAS float* gbias;
    __device__ __forceinline__ void operator()(const f32x4 (&acc)[2][2][4][2], const pg8::Unit& u, int wr, int wc, int fr, int fq) const {
        const int pn = u.pn, row0 = u.pm * 256 + wr * 64 + fr;
        if (pn >= 16) {
#pragma unroll
            for (int bj = 0; bj < 2; ++bj) { const int col = (pn - 16) * 256 + bj * 128 + wc * 32 + fq * 8;
                const f32x4 b0 = *(const LAS f32x4*)(gbias + col), b1 = *(const LAS f32x4*)(gbias + col + 4);
#pragma unroll
                for (int ai = 0; ai < 2; ++ai)
#pragma unroll
                    for (int m = 0; m < 4; ++m) { f32x4 v0 = acc[ai][bj][m][0] + b0, v1 = acc[ai][bj][m][1] + b1;
#pragma unroll
                        for (int e = 0; e < 4; ++e) { v0[e] = sigmoidf_(v0[e]); v1[e] = sigmoidf_(v1[e]); }
                        store8_fp8((unsigned char*)G3 + (size_t)(row0 + ai * 128 + m * 16) * 3072 + col, v0, v1, 64.f); } }
            return;
        }
#pragma unroll
        for (int bj = 0; bj < 2; ++bj) {
            const int wcu = __builtin_amdgcn_readfirstlane(wc);
            bool ropeP = false, ropeM = false;
            if (pn == 1) ropeM = (bj == 1 && wcu == 0);
            else if (pn >= 2 && pn < 11) ropeP = ((pn - 2) % 3) < 2 && !(wcu & 1);
            else if (pn >= 11 && pn < 15) ropeP = !(wcu & 1);
            else if (pn == 15) ropeP = (wcu == 0);
            const int col = pn * 256 + bj * 128 + wc * 32 + fq * 8;
            if (ropeP || ropeM) {
                const bool lr = ropeM || fq < 2;
                const float* cb = ropeM ? csm + 8 * fq : csp + 8 * (fq & 1);
                const int ts = ropeM ? 32 : 16;
#pragma unroll
                for (int ai = 0; ai < 2; ++ai)
#pragma unroll
                    for (int mh = 0; mh < 2; ++mh) {
                        f32x4 ca[2], cc[2];
#pragma unroll
                        for (int mm = 0; mm < 2; ++mm) { const int t = (row0 + ai * 128 + (2 * mh + mm) * 16) & (SEQ - 1);
                            ca[mm] = *(const f32x4*)(cb + t * ts); cc[mm] = *(const f32x4*)(cb + t * ts + 4); }
#pragma unroll
                        for (int mm = 0; mm < 2; ++mm) { const int m = 2 * mh + mm, row = row0 + ai * 128 + m * 16;
                            const f32x4 v0 = acc[ai][bj][m][0], v1 = acc[ai][bj][m][1];
                            f32x4 a = ca[mm], b = cc[mm];
                            if (!lr) { a = (f32x4){1.f, 0.f, 1.f, 0.f}; b = a; }
                            const f32x4 w0 = {v0[0] * a[0] - v0[1] * a[1], v0[1] * a[0] + v0[0] * a[1], v0[2] * a[2] - v0[3] * a[3], v0[3] * a[2] + v0[2] * a[3]};
                            const f32x4 w1 = {v1[0] * b[0] - v1[1] * b[1], v1[1] * b[0] + v1[0] * b[1], v1[2] * b[2] - v1[3] * b[3], v1[3] * b[2] + v1[2] * b[3]};
                            store8(P + (size_t)row * PW + col, w0, w1); }
                    }
            } else {
#pragma unroll
                for (int ai = 0; ai < 2; ++ai)
#pragma unroll
                    for (int m = 0; m < 4; ++m)
                        store8(P + (size_t)(row0 + ai * 128 + m * 16) * PW + col, acc[ai][bj][m][0], acc[ai][bj][m][1]);
            }
        }
        if (pn < 2) {
#pragma unroll
            for (int ai = 0; ai < 2; ++ai)
#pragma unroll
                for (int m = 0; m < 4; ++m) {
                    float sq = 0.f;
#pragma unroll
                    for (int bj = 0; bj < 2; ++bj) if (pn == 0 || bj == 0) {
#pragma unroll
                        for (int n = 0; n < 2; ++n) { const f32x4 x = acc[ai][bj][m][n]; sq += (x[0] * x[0] + x[1] * x[1]) + (x[2] * x[2] + x[3] * x[3]); } }
                    sq += __shfl_xor(sq, 16); sq += __shfl_xor(sq, 32);
                    if (fq == 0) ssq[(size_t)(row0 + ai * 128 + m * 16) * 8 + pn * 4 + wc] = sq;
                }
        }
    }
};
struct EpiUpQ {
    bf16_t* Q; const float* csm; const float* ssq;
    __device__ __forceinline__ void operator()(const f32x4 (&acc)[2][2][4][2], const pg8::Unit& u, int wr, int wc, int fr, int fq) const {
        const int row0 = u.pm * 256 + wr * 64 + fr;
        f32x4 spv[2][4];
#pragma unroll
        for (int ai = 0; ai < 2; ++ai)
#pragma unroll
            for (int m = 0; m < 4; ++m) spv[ai][m] = *(const f32x4*)(ssq + (size_t)(row0 + ai * 128 + m * 16) * 8);
#pragma unroll
        for (int ai = 0; ai < 2; ++ai)
#pragma unroll
            for (int m = 0; m < 4; ++m) { const f32x4 sp = spv[ai][m];
                spv[ai][m][0] = 1.0f / sqrtf(((sp[0] + sp[1]) + (sp[2] + sp[3])) * (1.f / 256.f) + RMS_EPS); }
        const int wcu = __builtin_amdgcn_readfirstlane(wc);
#pragma unroll
        for (int bj = 0; bj < 2; ++bj) {
            const int c0 = u.pn * 256 + bj * 128 + wcu * 32, col = c0 + fq * 8;
            if (((c0 >> 5) % 3) == 2) {
#pragma unroll
                for (int ai = 0; ai < 2; ++ai)
#pragma unroll
                    for (int mh = 0; mh < 2; ++mh) {
                        f32x4 ca[2], cc[2];
#pragma unroll
                        for (int mm = 0; mm < 2; ++mm) { const int t = (row0 + ai * 128 + (2 * mh + mm) * 16) & (SEQ - 1);
                            ca[mm] = *(const f32x4*)(csm + t * 32 + 8 * fq); cc[mm] = *(const f32x4*)(csm + t * 32 + 8 * fq + 4); }
#pragma unroll
                        for (int mm = 0; mm < 2; ++mm) { const int m = 2 * mh + mm, row = row0 + ai * 128 + m * 16;
                            const float rs = spv[ai][m][0];
                            const f32x4 v0 = acc[ai][bj][m][0] * rs, v1 = acc[ai][bj][m][1] * rs, a = ca[mm], b = cc[mm];
                            const f32x4 w0 = {v0[0] * a[0] - v0[1] * a[1], v0[1] * a[0] + v0[0] * a[1], v0[2] * a[2] - v0[3] * a[3], v0[3] * a[2] + v0[2] * a[3]};
                            const f32x4 w1 = {v1[0] * b[0] - v1[1] * b[1], v1[1] * b[0] + v1[0] * b[1], v1[2] * b[2] - v1[3] * b[3], v1[3] * b[2] + v1[2] * b[3]};
                            store8(Q + (size_t)row * 768 + col, w0, w1); }
                    }
            } else {
#pragma unroll
                for (int ai = 0; ai < 2; ++ai)
#pragma unroll
                    for (int m = 0; m < 4; ++m) { const float rs = spv[ai][m][0];
                        store8(Q + (size_t)(row0 + ai * 128 + m * 16) * 768 + col, acc[ai][bj][m][0] * rs, acc[ai][bj][m][1] * rs); }
            }
        }
    }
};
struct EpiUpKV {
    bf16_t* KV; const float* ssq;
    __device__ __forceinline__ void operator()(const f32x4 (&acc)[2][2][4][2], const pg8::Unit& u, int wr, int wc, int fr, int fq) const {
        const int row0 = u.pm * 256 + wr * 64 + fr;
        f32x4 spv[2][4];
#pragma unroll
        for (int ai = 0; ai < 2; ++ai)
#pragma unroll
            for (int m = 0; m < 4; ++m) spv[ai][m] = *(const f32x4*)(ssq + (size_t)(row0 + ai * 128 + m * 16) * 8 + 4);
#pragma unroll
        for (int ai = 0; ai < 2; ++ai)
#pragma unroll
            for (int m = 0; m < 4; ++m) {
                const int row = row0 + ai * 128 + m * 16;
                const f32x4 sp = spv[ai][m];
                const float rs = 1.0f / sqrtf(((sp[0] + sp[1]) + (sp[2] + sp[3])) * (1.f / 128.f) + RMS_EPS);
#pragma unroll
                for (int bj = 0; bj < 2; ++bj) { const int col = u.pn * 256 + bj * 128 + wc * 32 + fq * 8;
                    store8(KV + (size_t)row * 1024 + col, acc[ai][bj][m][0] * rs, acc[ai][bj][m][1] * rs); }
            }
    }
};
struct EpiBranchAll {
    bf16_t* Mg; bf16_t* M0; bf16_t* M1; const bf16_t* G3;
    __device__ __forceinline__ void operator()(const f32x4 (&acc)[2][2][4][2], const pg8::Unit& u, int wr, int wc, int fr, int fq) const {
        const int row0 = u.pm * 256 + wr * 64 + fr, br = u.ord, col0 = u.pn * 256 + wc * 32 + fq * 8;
        bf16_t* dst = br == 0 ? M0 : (br == 1 ? M1 : Mg);
#pragma unroll
        for (int ai = 0; ai < 2; ++ai)
#pragma unroll
            for (int mh = 0; mh < 2; ++mh) {
                u32x2 gw[2][2]; u32x4 ma[2][2], mb[2][2];
#pragma unroll
                for (int mm = 0; mm < 2; ++mm)
#pragma unroll
                    for (int bj = 0; bj < 2; ++bj) { const int row = row0 + ai * 128 + (2 * mh + mm) * 16, col = col0 + bj * 128;
                        gw[mm][bj] = *(const u32x2*)((const unsigned char*)G3 + (size_t)row * 3072 + br * 1024 + col);
                        ma[mm][bj] = (u32x4){0u, 0u, 0u, 0u}; mb[mm][bj] = (u32x4){0u, 0u, 0u, 0u}; }
                if (br == 2) {
#pragma unroll
                    for (int mm = 0; mm < 2; ++mm)
#pragma unroll
                        for (int bj = 0; bj < 2; ++bj) { const size_t off = (size_t)(row0 + ai * 128 + (2 * mh + mm) * 16) * DM + col0 + bj * 128;
                            const u32x2 p = *(const u32x2*)((const unsigned char*)M0 + off), q = *(const u32x2*)((const unsigned char*)M1 + off);
                            ma[mm][bj] = (u32x4){p.x, p.y, 0u, 0u}; mb[mm][bj] = (u32x4){q.x, q.y, 0u, 0u}; }
                }
#pragma unroll
                for (int mm = 0; mm < 2; ++mm)
#pragma unroll
                    for (int bj = 0; bj < 2; ++bj) { const int m = 2 * mh + mm; const size_t off = (size_t)(row0 + ai * 128 + m * 16) * DM + col0 + bj * 128; const u32x2 g = gw[mm][bj]; const u32x4 a = ma[mm][bj], b2 = mb[mm][bj];
                        const f32x2 g01 = __builtin_amdgcn_cvt_pk_f32_fp8((int)g.x, false) * (1.f / 64.f), g23 = __builtin_amdgcn_cvt_pk_f32_fp8((int)g.x, true) * (1.f / 64.f);
                        const f32x2 g45 = __builtin_amdgcn_cvt_pk_f32_fp8((int)g.y, false) * (1.f / 64.f), g67 = __builtin_amdgcn_cvt_pk_f32_fp8((int)g.y, true) * (1.f / 64.f);
                        f32x4 v0 = acc[ai][bj][m][0], v1 = acc[ai][bj][m][1];
                        const f32x2 s01 = (__builtin_amdgcn_cvt_pk_f32_fp8((int)a.x, false) + __builtin_amdgcn_cvt_pk_f32_fp8((int)b2.x, false)) * (1.f / 64.f), s23 = (__builtin_amdgcn_cvt_pk_f32_fp8((int)a.x, true) + __builtin_amdgcn_cvt_pk_f32_fp8((int)b2.x, true)) * (1.f / 64.f);
                        const f32x2 s45 = (__builtin_amdgcn_cvt_pk_f32_fp8((int)a.y, false) + __builtin_amdgcn_cvt_pk_f32_fp8((int)b2.y, false)) * (1.f / 64.f), s67 = (__builtin_amdgcn_cvt_pk_f32_fp8((int)a.y, true) + __builtin_amdgcn_cvt_pk_f32_fp8((int)b2.y, true)) * (1.f / 64.f);
                        v0[0] = v0[0] * g01[0] + s01[0]; v0[1] = v0[1] * g01[1] + s01[1]; v0[2] = v0[2] * g23[0] + s23[0]; v0[3] = v0[3] * g23[1] + s23[1];
                        v1[0] = v1[0] * g45[0] + s45[0]; v1[1] = v1[1] * g45[1] + s45[1]; v1[2] = v1[2] * g67[0] + s67[0]; v1[3] = v1[3] * g67[1] + s67[1];
                        store8_fp8((unsigned char*)dst + off, v0, v1, 64.f); }
            }
    }
};
struct BranchSched {
    static constexpr bool GATHER = false; static constexpr bool VARK = true;
    const char* A0; const char* B0; size_t sA, sB; int lda, ldb, c, sw8, sa8, G, ntile;
    __device__ __forceinline__ int ktiles(const pg8::Unit& u) const { return u.ord == 1 ? 2 : 4; }
    __device__ __forceinline__ bool next(int i, pg8::Unit& u) const { const int t = c + (i / 3) * G; if (t >= ntile) return false; u.pm = t >> 2; u.pn = t & 3; u.ord = i % 3; return true; }
    __device__ __forceinline__ const char* a_base(const pg8::Unit& u) const { return A0 + (size_t)u.ord * sA + (size_t)u.pm * 256 * lda * 2; }
    __device__ __forceinline__ const char* b_base(const pg8::Unit& u) const { return B0 + (size_t)u.ord * sB + (size_t)u.pn * 256 * ldb * 2; }
    __device__ __forceinline__ void a_off(const pg8::Unit&, const int (&R)[2], const int (&C)[2], unsigned (&v)[2][2]) const {
#pragma unroll
        for (int i = 0; i < 2; ++i) { v[0][i] = (unsigned)(R[i] * lda + C[i]) * 2u; v[1][i] = (unsigned)((128 + R[i]) * lda + C[i]) * 2u; }
    }
};
struct EpiWo {
    float* out; const float* xsrc; int rowbase;
    __device__ __forceinline__ void operator()(const f32x4 (&acc)[2][2][4][2], const pg8::Unit& u, int wr, int wc, int fr, int fq) const {
        const int row0 = rowbase + u.pm * 256 + wr * 64 + fr, col0 = u.pn * 256 + wc * 32 + fq * 8;
#pragma unroll
        for (int ai = 0; ai < 2; ++ai)
#pragma unroll
            for (int mh = 0; mh < 2; ++mh) {
                f32x4 x[2][2][2];
#pragma unroll
                for (int mm = 0; mm < 2; ++mm)
#pragma unroll
                    for (int bj = 0; bj < 2; ++bj) { const size_t off = (size_t)(row0 + ai * 128 + (2 * mh + mm) * 16) * DM + col0 + bj * 128;
                        x[mm][bj][0] = *(const f32x4*)(xsrc + off); x[mm][bj][1] = *(const f32x4*)(xsrc + off + 4); }
#pragma unroll
                for (int mm = 0; mm < 2; ++mm)
#pragma unroll
                    for (int bj = 0; bj < 2; ++bj) { const size_t off = (size_t)(row0 + ai * 128 + (2 * mh + mm) * 16) * DM + col0 + bj * 128;
                        *(f32x4*)(out + off) = x[mm][bj][0] * ALPHA + acc[ai][bj][2 * mh + mm][0]; *(f32x4*)(out + off + 4) = x[mm][bj][1] * ALPHA + acc[ai][bj][2 * mh + mm][1]; }
            }
    }
};

__device__ __forceinline__ int dequeue(Frame& F, unsigned* ctr, int& pre) {
    LAS int* slot = (LAS int*)(F.lds + L_QSLOT);
    __syncthreads();
    if (F.tid == 0) {
        *slot = (int)__hip_atomic_fetch_add(ctr, 1u, __ATOMIC_RELAXED, __HIP_MEMORY_SCOPE_AGENT); (void)pre;
    }
    __syncthreads();
    return *slot;
}

namespace att {
constexpr int KSLOT = 12288, VSLOT = 8192, NSLOT = 4;
constexpr int A_K = 0, A_V = NSLOT * KSLOT, A_WS = A_V + NSLOT * VSLOT, A_OST = A_WS + 8 * 256, A_MW = A_OST + 8 * 4096, A_END = A_MW + 8 * NSLOT * 256;
static_assert(A_END <= RING_BYTES, "attention LDS");
typedef short s16x4 __attribute__((ext_vector_type(4)));
__device__ __forceinline__ int crow(int r, int hi) { return (r & 3) + 8 * (r >> 2) + 4 * hi; }
__device__ __forceinline__ void glds16(const void* gsrc, unsigned lds_dst) { unsigned keep;
    asm volatile("s_mov_b32 %0, m0\n\ts_mov_b32 m0, %2\n\ts_nop 0\n\tglobal_load_lds_dwordx4 %1, off\n\ts_mov_b32 m0, %0" : "=&s"(keep) : "v"(gsrc), "s"(lds_dst) : "memory"); }
__device__ __forceinline__ void glds4(const void* gsrc, unsigned lds_dst) { unsigned keep;
    asm volatile("s_mov_b32 %0, m0\n\ts_mov_b32 m0, %2\n\ts_nop 0\n\tglobal_load_lds_dword %1, off\n\ts_mov_b32 m0, %0" : "=&s"(keep) : "v"(gsrc), "s"(lds_dst) : "memory"); }
#define ATT_WAIT_BAR(N) asm volatile("s_waitcnt vmcnt(" #N ") lgkmcnt(0)\n\ts_barrier" ::: "memory")
__device__ __forceinline__ float emax(float a, float b) { return __builtin_elementwise_maximum(a, b); }
__device__ __forceinline__ float halfmax(float m) { auto rr = __builtin_amdgcn_permlane32_swap(__float_as_uint(m), __float_as_uint(m), false, false); return emax(__uint_as_float(rr[0]), __uint_as_float(rr[1])); }
__device__ __forceinline__ float halfsum(float m) { auto rr = __builtin_amdgcn_permlane32_swap(__float_as_uint(m), __float_as_uint(m), false, false); return __uint_as_float(rr[0]) + __uint_as_float(rr[1]); }
typedef short v4i16_t __attribute__((ext_vector_type(4)));
__device__ __forceinline__ s16x4 vtr(const LAS unsigned char* p) { return __builtin_bit_cast(s16x4, __builtin_amdgcn_ds_read_tr16_b64_v4i16((LAS v4i16_t*)p)); }
__device__ __forceinline__ void pv(f32x16* o, f32x16& lacc, const LAS unsigned char* vp, bf16x8 pa0, bf16x8 pa1, bf16x8 pa2, bf16x8 pa3) {
    { const u32x4 one4 = {0x3F803F80u, 0x3F803F80u, 0x3F803F80u, 0x3F803F80u}; const bf16x8 ones = __builtin_bit_cast(bf16x8, one4);
      lacc = __builtin_amdgcn_mfma_f32_32x32x16_bf16(pa0, ones, lacc, 0, 0, 0); lacc = __builtin_amdgcn_mfma_f32_32x32x16_bf16(pa1, ones, lacc, 0, 0, 0);
      lacc = __builtin_amdgcn_mfma_f32_32x32x16_bf16(pa2, ones, lacc, 0, 0, 0); lacc = __builtin_amdgcn_mfma_f32_32x32x16_bf16(pa3, ones, lacc, 0, 0, 0); }
#pragma unroll
    for (int d0 = 0; d0 < 2; ++d0) { s16x4 lo[4], hi[4];
#pragma unroll
        for (int ks = 0; ks < 4; ++ks) { lo[ks] = vtr(vp + d0 * 4096 + ks * 1024); hi[ks] = vtr(vp + d0 * 4096 + ks * 1024 + 512); }
#define ATT_PK(k) (bf16x8){lo[k][0], lo[k][1], lo[k][2], lo[k][3], hi[k][0], hi[k][1], hi[k][2], hi[k][3]}
        o[d0] = __builtin_amdgcn_mfma_f32_32x32x16_bf16(pa0, ATT_PK(0), o[d0], 0, 0, 0);
        o[d0] = __builtin_amdgcn_mfma_f32_32x32x16_bf16(pa1, ATT_PK(1), o[d0], 0, 0, 0);
        o[d0] = __builtin_amdgcn_mfma_f32_32x32x16_bf16(pa2, ATT_PK(2), o[d0], 0, 0, 0);
        o[d0] = __builtin_amdgcn_mfma_f32_32x32x16_bf16(pa3, ATT_PK(3), o[d0], 0, 0, 0);
#undef ATT_PK
    }
}
struct Desc {
    const bf16_t* Q; const bf16_t* K1; const bf16_t* K2; const bf16_t* V; bf16_t* O; float* lse; const unsigned* mask;
    int qpitch, k1pitch, k2pitch, vpitch, opitch, lsepitch;
    int rstride, q0, nq, jlo, jhi;
    int o8;
};
template <int DQK, int MODE, bool DUAL = false>
__device__ __forceinline__ void attn_unit(LAS unsigned char* lds, const Desc& d) {
    static_assert(!DUAL || (DQK == 64 && MODE == 0), "dual mode");
    constexpr int NSLOT = DUAL ? 2 : att::NSLOT, KSLOT = DUAL ? 8192 : att::KSLOT;
    constexpr int A_K = 0, A_V = DUAL ? 32768 : att::A_V, A_WS = DUAL ? 65536 : att::A_WS, A_OST = DUAL ? 67584 : att::A_OST, A_MW = att::A_MW;
    int tid_ = threadIdx.x; asm volatile("" : "+v"(tid_));
    const int tid = tid_, lane = tid & 63, r32 = lane & 31, hi = lane >> 5, wid = __builtin_amdgcn_readfirstlane(tid >> 6);
    constexpr int ND = DQK / 16;
    const unsigned lds0 = (unsigned)(size_t)lds;
    LAS float* wsf = (LAS float*)(lds + A_WS) + wid * 64;
    const int grp = DUAL ? (wid >> 2) : 0, w4 = DUAL ? (wid & 3) : wid, gofs = grp * 16384;
    Desc dd = d;
    if (DUAL) { dd.Q = d.Q + (size_t)grp * d.qpitch; dd.K1 = d.K1 + (size_t)grp * d.k1pitch; dd.V = d.V + (size_t)grp * d.vpitch; dd.O = d.O + (size_t)grp * d.opitch; if (d.lse) dd.lse = d.lse + (size_t)grp * d.lsepitch; }
    const Desc& d_ = dd;
    const int qw = d.q0 + w4 * 32;
    const bool wvalid = DUAL || wid * 32 < d.nq;
    const int kkey = 8 * wid + (lane >> 3), kch = (lane & 7) ^ ((kkey >> 1) & 7);
    const bf16_t* ksrc = d_.K1 + (size_t)kkey * d.rstride * d.k1pitch + kch * 8;
    const int k2key = 16 * (wid & 3) + (lane >> 2), k2ch = (lane & 3) ^ ((k2key >> 2) & 3);
    const bf16_t* k2src = (DQK == 96) ? d_.K2 + (size_t)k2key * d.rstride * d.k2pitch + k2ch * 8 : nullptr;
    int kofs[ND];
#pragma unroll
    for (int d0 = 0; d0 < ND; ++d0) kofs[d0] = d0 < 4 ? r32 * 128 + (((2 * d0 + hi) ^ ((r32 >> 1) & 7)) * 16) : 8192 + r32 * 64 + (((2 * (d0 - 4) + hi) ^ ((r32 >> 2) & 3)) * 16);
    const bf16_t* vsrc = d_.V + (size_t)(16 * (wid & 3) + (lane >> 2)) * d.rstride * d.vpitch + (DUAL ? 0 : (wid >> 2) * 32) + (lane & 3) * 8;
    const int kkeyB = 8 * (2 * w4 + 1) + (lane >> 3);
    const bf16_t* ksrcA = DUAL ? d_.K1 + (size_t)(8 * (2 * w4) + (lane >> 3)) * d.rstride * d.k1pitch + (((lane & 7) ^ (((8 * (2 * w4) + (lane >> 3)) >> 1) & 7)) * 8) : nullptr;
    const bf16_t* ksrcB = DUAL ? d_.K1 + (size_t)kkeyB * d.rstride * d.k1pitch + (((lane & 7) ^ ((kkeyB >> 1) & 7)) * 8) : nullptr;
    const size_t kstep = (size_t)64 * d.rstride * d.k1pitch, k2step = (size_t)64 * d.rstride * d.k2pitch, vstep = (size_t)64 * d.rstride * d.vpitch;
    const bool two = (DQK == 96) && wid < 4;
    const unsigned* msrc = (MODE == 2) ? d.mask + (size_t)(wvalid ? (qw + (lane >> 1)) : d.q0) * 64 + (lane & 1) : nullptr;
#define ATT_ISSUE(j) do { const int sl_ = (j) % NSLOT; \
        if (DUAL) { \
            glds16(ksrcA + (size_t)(j) * kstep, (unsigned)__builtin_amdgcn_readfirstlane(lds0 + A_K + gofs + sl_ * KSLOT + (2 * w4) * 1024)); \
            glds16(ksrcB + (size_t)(j) * kstep, (unsigned)__builtin_amdgcn_readfirstlane(lds0 + A_K + gofs + sl_ * KSLOT + (2 * w4 + 1) * 1024)); \
            glds16(vsrc + (size_t)(j) * vstep, (unsigned)__builtin_amdgcn_readfirstlane(lds0 + A_V + gofs + sl_ * VSLOT + w4 * 1024)); \
            glds16(vsrc + 32 + (size_t)(j) * vstep, (unsigned)__builtin_amdgcn_readfirstlane(lds0 + A_V + gofs + sl_ * VSLOT + (4 + w4) * 1024)); \
            break; } \
        glds16(ksrc + (size_t)(j) * kstep, (unsigned)__builtin_amdgcn_readfirstlane(lds0 + A_K + sl_ * KSLOT + wid * 1024)); \
        if (two) glds16(k2src + (size_t)(j) * k2step, (unsigned)__builtin_amdgcn_readfirstlane(lds0 + A_K + sl_ * KSLOT + (8 + wid) * 1024)); \
        glds16(vsrc + (size_t)(j) * vstep, (unsigned)__builtin_amdgcn_readfirstlane(lds0 + A_V + sl_ * VSLOT + wid * 1024)); \
        if (MODE == 2) glds4(msrc + 2 * (j), (unsigned)__builtin_amdgcn_readfirstlane(lds0 + A_MW + (wid * NSLOT + sl_) * 256)); } while (0)
    ATT_ISSUE(d.jlo);
    if (d.jlo + 1 < d.jhi) ATT_ISSUE(d.jlo + 1);
    bf16x8 qr[ND];
    { const int qi = wvalid ? (qw + r32) : d.q0; const bf16_t* qp = d_.Q + (size_t)qi * d.rstride * d.qpitch + hi * 8;
#pragma unroll
      for (int d0 = 0; d0 < ND; ++d0) qr[d0] = *(const bf16x8*)(qp + d0 * 16); }
#pragma unroll
    for (int d0 = 0; d0 < ND; ++d0) asm volatile("" : "+v"(qr[d0]));
    float mhat = 0.f; f32x16 o[2]; o[0] = f32x16{}; o[1] = f32x16{}; f32x16 lacc = f32x16{};
    bool started = false;
    const LAS unsigned char* vp0 = lds + A_V + gofs + ((lane >> 4) & 1) * 32 + (lane & 3) * 8 + (4 * hi + ((lane & 15) >> 2)) * 64;
    const int qi = qw + r32;
    f32x16 p0 = f32x16{}, p1 = f32x16{};
    f32x16 negm = f32x16{};
#define ATT_REL(j) (wvalid && (64 * (j) <= qw + 31) && (MODE != 1 || (64 * (j) + 63 >= qw - 128)))
#define ATT_QK(j) do { const int sl_ = (j) % NSLOT; \
        const LAS unsigned char* kb = lds + A_K + gofs + sl_ * KSLOT; bf16x8 kf[2 * ND]; \
        _Pragma("unroll") for (int d0 = 0; d0 < ND; ++d0) { kf[2 * d0] = *(const LAS bf16x8*)(kb + kofs[d0]); kf[2 * d0 + 1] = *(const LAS bf16x8*)(kb + kofs[d0] + (d0 < 4 ? 4096 : 2048)); } \
        __builtin_amdgcn_sched_barrier(0); \
        _Pragma("unroll") for (int d0 = 0; d0 < ND; ++d0) { \
            if (d0 == 0) { p0 = __builtin_amdgcn_mfma_f32_32x32x16_bf16(kf[0], qr[0], negm, 0, 0, 0); p1 = __builtin_amdgcn_mfma_f32_32x32x16_bf16(kf[1], qr[0], negm, 0, 0, 0); } \
            else { p0 = __builtin_amdgcn_mfma_f32_32x32x16_bf16(kf[2 * d0], qr[d0], p0, 0, 0, 0); p1 = __builtin_amdgcn_mfma_f32_32x32x16_bf16(kf[2 * d0 + 1], qr[d0], p1, 0, 0, 0); } } } while (0)
#define ATT_SMPV(j) do { const int sl_ = (j) % NSLOT; \
        { bool domask = true; unsigned mx_ = 0u, my_ = 0u;        \
          if (MODE == 2) { const u32x2 mw = *(const LAS u32x2*)(lds + A_MW + (wid * NSLOT + sl_) * 256 + r32 * 8); mx_ = mw.x; my_ = mw.y; } \
          else { \
            bool full = (64 * (j) + 63 <= qw); \
            if (MODE == 1) full = full && (64 * (j) >= qw + 31 - 128); \
            domask = !full; \
            if (domask) { const int a_ = qi - 64 * (j), lo_ = (MODE == 1) ? a_ - 128 : -4096;        \
                { const int h_ = a_ < 31 ? a_ : 31, l_ = lo_ > 0 ? lo_ : 0; mx_ = (h_ < l_) ? 0u : ((0xFFFFFFFFu >> (31 - h_)) & (0xFFFFFFFFu << l_)); } \
                { const int h_ = a_ - 32 < 31 ? a_ - 32 : 31, l_ = lo_ - 32 > 0 ? lo_ - 32 : 0; my_ = (h_ < l_) ? 0u : ((0xFFFFFFFFu >> (31 - h_)) & (0xFFFFFFFFu << l_)); } } \
          } \
          if (domask) { const unsigned w0 = mx_ >> (4 * hi), w1 = my_ >> (4 * hi); \
            _Pragma("unroll") for (int r = 0; r < 16; ++r) { const int bit = (r & 3) + 8 * (r >> 2); \
                const unsigned m0 = (unsigned)__builtin_amdgcn_sbfe((int)w0, bit, 1), m1 = (unsigned)__builtin_amdgcn_sbfe((int)w1, bit, 1);        \
                p0[r] = __uint_as_float((m0 & __float_as_uint(p0[r])) | (~m0 & 0xFF800000u)); p1[r] = __uint_as_float((m1 & __float_as_uint(p1[r])) | (~m1 & 0xFF800000u)); } } } \
        float rm = emax(p0[0], p1[0]), rm2 = emax(p0[1], p1[1]); \
        _Pragma("unroll") for (int r = 2; r < 16; r += 2) { rm = emax(emax(rm, p0[r]), p1[r]); rm2 = emax(emax(rm2, p0[r + 1]), p1[r + 1]); } \
        rm = halfmax(emax(rm, rm2)); \
        bool need; float dl; \
        if (!started) { need = true; dl = emax(rm, -200.f); } else { need = __any(rm > 8.f) != 0; dl = emax(rm, 0.f); } \
        if (need) { mhat += dl; \
            _Pragma("unroll") for (int r = 0; r < 16; ++r) negm[r] = -mhat; \
            _Pragma("unroll") for (int r = 0; r < 16; ++r) { p0[r] -= dl; p1[r] -= dl; } \
            if (started) { const float f = __builtin_amdgcn_exp2f(-dl); \
                if (hi == 0) wsf[r32] = f; \
                LDS_WAIT(); \
                _Pragma("unroll") for (int r = 0; r < 16; ++r) { const float fr_ = wsf[crow(r, hi)]; o[0][r] *= fr_; o[1][r] *= fr_; lacc[r] *= fr_; } } } \
        started = true; \
        __builtin_amdgcn_s_setprio(1);        \
        _Pragma("unroll") for (int r = 0; r < 16; ++r) { p0[r] = __builtin_amdgcn_exp2f(p0[r]); p1[r] = __builtin_amdgcn_exp2f(p1[r]); } \
        const u32x4 pw0 = (u32x4){cvt_pk_bf16(p0[0], p0[1]), cvt_pk_bf16(p0[2], p0[3]), cvt_pk_bf16(p0[4], p0[5]), cvt_pk_bf16(p0[6], p0[7])}; \
        const u32x4 pw1 = (u32x4){cvt_pk_bf16(p0[8], p0[9]), cvt_pk_bf16(p0[10], p0[11]), cvt_pk_bf16(p0[12], p0[13]), cvt_pk_bf16(p0[14], p0[15])}; \
        const u32x4 pw2 = (u32x4){cvt_pk_bf16(p1[0], p1[1]), cvt_pk_bf16(p1[2], p1[3]), cvt_pk_bf16(p1[4], p1[5]), cvt_pk_bf16(p1[6], p1[7])}; \
        const u32x4 pw3 = (u32x4){cvt_pk_bf16(p1[8], p1[9]), cvt_pk_bf16(p1[10], p1[11]), cvt_pk_bf16(p1[12], p1[13]), cvt_pk_bf16(p1[14], p1[15])}; \
        pv(o, lacc, vp0 + sl_ * VSLOT, __builtin_bit_cast(bf16x8, pw0), __builtin_bit_cast(bf16x8, pw1), __builtin_bit_cast(bf16x8, pw2), __builtin_bit_cast(bf16x8, pw3)); \
        __builtin_amdgcn_s_setprio(0); } while (0)
#define ATT_TOPWAIT(j) do { if ((j) + 1 < d.jhi) { if (DUAL) { ATT_WAIT_BAR(4); } else if (MODE == 2 || two) { ATT_WAIT_BAR(3); } else { ATT_WAIT_BAR(2); } } else { ATT_WAIT_BAR(0); } } while (0)
    if (wid < 4) {
        for (int j = d.jlo; j < d.jhi; ++j) {
            ATT_TOPWAIT(j);
            if (j + 2 < d.jhi) ATT_ISSUE(j + 2);
            if (ATT_REL(j)) { ATT_QK(j); ATT_SMPV(j); }
        }
        asm volatile("s_waitcnt lgkmcnt(0)\n\ts_barrier" ::: "memory");
    } else {
        ATT_TOPWAIT(d.jlo);
        if (d.jlo + 2 < d.jhi) ATT_ISSUE(d.jlo + 2);
        if (ATT_REL(d.jlo)) ATT_QK(d.jlo);
        for (int j = d.jlo + 1; j < d.jhi; ++j) {
            ATT_TOPWAIT(j);
            if (j + 2 < d.jhi) ATT_ISSUE(j + 2);
            if (ATT_REL(j - 1)) ATT_SMPV(j - 1);
            if (ATT_REL(j)) ATT_QK(j);
        }
        asm volatile("s_waitcnt lgkmcnt(0)\n\ts_barrier" ::: "memory");
        if (ATT_REL(d.jhi - 1)) ATT_SMPV(d.jhi - 1);
    }
#undef ATT_REL
#undef ATT_QK
#undef ATT_SMPV
#undef ATT_TOPWAIT
#undef ATT_ISSUE
    if (wvalid) {
        LAS bf16_t* stg = (LAS bf16_t*)(lds + A_OST) + wid * 2048;
        if (d_.lse != nullptr && r32 == 0) {
#pragma unroll
            for (int r = 0; r < 16; ++r) wsf[32 + crow(r, hi)] = lacc[r]; }
        if (d.o8) {
            LAS unsigned char* stg8 = (LAS unsigned char*)stg;
#pragma unroll
            for (int r = 0; r < 16; ++r) { const int orow = crow(r, hi); const float rl = __builtin_amdgcn_rcpf(lacc[r]) * 32.f;
                const unsigned p = (unsigned)__builtin_amdgcn_cvt_pk_fp8_f32(o[0][r] * rl, o[1][r] * rl, 0, false);
                stg8[orow * 64 + r32] = (unsigned char)(p & 0xffu); stg8[orow * 64 + 32 + r32] = (unsigned char)((p >> 8) & 0xffu); }
            LDS_WAIT();
#pragma unroll
            for (int i = 0; i < 2; ++i) { const int row = i * 16 + (lane >> 2), ch = lane & 3; const u32x4 v = *(const LAS u32x4*)(stg8 + row * 64 + ch * 16);
                *(u32x4*)((unsigned char*)d_.O + (size_t)(qw + row) * d.rstride * d.opitch + ch * 16) = v; }
        } else {
#pragma unroll
        for (int r = 0; r < 16; ++r) { const int orow = crow(r, hi); const float rl = __builtin_amdgcn_rcpf(lacc[r]);
            stg[orow * 64 + r32] = (bf16_t)f2bf(o[0][r] * rl); stg[orow * 64 + 32 + r32] = (bf16_t)f2bf(o[1][r] * rl); }
        LDS_WAIT();
#pragma unroll
        for (int i = 0; i < 4; ++i) { const int row = i * 8 + (lane >> 3), ch = lane & 7; const u32x4 v = *(const LAS u32x4*)(stg + row * 64 + ch * 8);
            *(u32x4*)(d_.O + (size_t)(qw + row) * d.rstride * d.opitch + ch * 8) = v; }
        }
        if (d_.lse != nullptr && hi == 0) d_.lse[(size_t)(qw + r32) * d.rstride * d.lsepitch] = mhat + __builtin_amdgcn_logf(wsf[32 + r32]);
    }
    asm volatile("s_waitcnt lgkmcnt(0)\n\ts_barrier" ::: "memory");
}
}

namespace idx {
constexpr int KS = 8192, I_K = 0, I_ST = 3 * KS, I_END = I_ST + 8 * 8192;
static_assert(I_END <= RING_BYTES, "indexer LDS");
__device__ __forceinline__ void score_unit(LAS unsigned char* lds, const bf16_t* PROJ, float* SC, int b, int qh  , int jg) {
    int tid_ = threadIdx.x; asm volatile("" : "+v"(tid_));
    const int tid = tid_, lane = tid & 63, r32 = lane & 31, hi = lane >> 5, wid = __builtin_amdgcn_readfirstlane(tid >> 6);
    const int qg = wid >> 1, hh = wid & 1;
    const unsigned lds0 = (unsigned)(size_t)lds;
    const int qrow = b * SEQ + qh * 128 + qg * 32 + r32;
    const bf16_t* kbase = PROJ + (size_t)(b * SEQ) * PW + 3968;
    const int kkey = 8 * wid + (lane >> 3);
    const bf16_t* ksrc = kbase + (size_t)kkey * PW + ((lane & 7) ^ ((kkey >> 1) & 7)) * 8;
    const int j0 = 4 * jg;
#define IDX_ISSUE(j) att::glds16(ksrc + (size_t)(j) * 64 * PW, (unsigned)__builtin_amdgcn_readfirstlane(lds0 + I_K + ((j) % 3) * KS + wid * 1024))
    IDX_ISSUE(j0); IDX_ISSUE(j0 + 1);
    bf16x8 qf[4][4]; float wv[4];
    { const bf16_t* qp = PROJ + (size_t)qrow * PW + 3328 + hh * 256 + hi * 8;
#pragma unroll
      for (int h = 0; h < 4; ++h)
#pragma unroll
          for (int d0 = 0; d0 < 4; ++d0) qf[h][d0] = *(const bf16x8*)(qp + h * 64 + d0 * 16);
      const u32x2 ww = *(const u32x2*)(PROJ + (size_t)qrow * PW + 4032 + hh * 4);
      wv[0] = bflo(ww.x); wv[1] = bfhi(ww.x); wv[2] = bflo(ww.y); wv[3] = bfhi(ww.y); }
#pragma unroll
    for (int h = 0; h < 4; ++h) { asm volatile("" : "+v"(wv[h]));
#pragma unroll
        for (int d0 = 0; d0 < 4; ++d0) asm volatile("" : "+v"(qf[h][d0])); }
    const int qb = qh >> 1;
    unsigned* blk = (unsigned*)SC + ((size_t)b * 36 + (size_t)(qb * (qb + 1) / 2)) * 32768; const int pitch = 128 * (qb + 1);
    f32x4 ve[4] = {};
    LAS unsigned char* stg = lds + I_ST + wid * 8192;
    const LAS unsigned char* stg2 = lds + I_ST + (wid ^ 1) * 8192;
#pragma nounroll
    for (int jj = 0; jj < 4; ++jj) { const int j = j0 + jj;
        if (jj < 2) { ATT_WAIT_BAR(1); } else if (jj == 2) { ATT_WAIT_BAR(5); } else { ATT_WAIT_BAR(4); }
        if (jj + 2 < 4) IDX_ISSUE(j + 2);
        const LAS unsigned char* kb = lds + I_K + (j % 3) * KS + r32 * 128;
#pragma nounroll
        for (int half = 0; half < 2; ++half) {
            bf16x8 kf[4];
#pragma unroll
            for (int d0 = 0; d0 < 4; ++d0) kf[d0] = *(const LAS bf16x8*)(kb + half * 4096 + (((2 * d0 + hi) ^ ((r32 >> 1) & 7)) * 16));
            f32x16 t0 = f32x16{};
#pragma unroll
            for (int h = 0; h < 4; ++h) {
                f32x16 p0 = f32x16{};
#pragma unroll
                for (int d0 = 0; d0 < 4; ++d0) p0 = __builtin_amdgcn_mfma_f32_32x32x16_bf16(kf[d0], qf[h][d0], p0, 0, 0, 0);
#pragma unroll
                for (int r = 0; r < 16; ++r) t0[r] += wv[h] * att::emax(p0[r], 0.f);
            }
#pragma unroll
            for (int g = 0; g < 4; ++g) { const int c0 = 8 * half + 2 * g + hi;
                *(LAS f32x4*)(stg + r32 * 256 + ((c0 ^ (r32 & 15)) * 16)) = (f32x4){t0[4 * g], t0[4 * g + 1], t0[4 * g + 2], t0[4 * g + 3]}; }
        }
        asm volatile("s_waitcnt lgkmcnt(0)\n\ts_barrier" ::: "memory");
#pragma unroll
        for (int i = 0; i < 4; ++i) { const int q = hh * 16 + i * 4 + (lane >> 4), c = lane & 15; const int so = q * 256 + ((c ^ (q & 15)) * 16);
            const f32x4 v = *(const LAS f32x4*)(stg + so) + *(const LAS f32x4*)(stg2 + so);
            if (jj & 1) { const f32x4 e = ve[i]; const u32x4 w = {pk2(e[0], v[0]), pk2(e[1], v[1]), pk2(e[2], v[2]), pk2(e[3], v[3])};
                *(u32x4*)(blk + (size_t)((qh & 1) * 128 + qg * 32 + q) * pitch + 64 * (j >> 1) + 4 * c) = w; }
            else ve[i] = v; }
        LDS_WAIT();
    }
#undef IDX_ISSUE
    asm volatile("s_waitcnt lgkmcnt(0)\n\ts_barrier" ::: "memory");
}

__device__ __forceinline__ int wave_sum_i(int v) {
    v += __builtin_amdgcn_update_dpp(0, v, 0xB1, 0xF, 0xF, true);
    v += __builtin_amdgcn_update_dpp(0, v, 0x4E, 0xF, 0xF, true);
    v += __builtin_amdgcn_update_dpp(0, v, 0x141, 0xF, 0xF, true);
    v += __builtin_amdgcn_update_dpp(0, v, 0x140, 0xF, 0xF, true);
    return __builtin_amdgcn_readlane(v, 0) + __builtin_amdgcn_readlane(v, 16) + __builtin_amdgcn_readlane(v, 32) + __builtin_amdgcn_readlane(v, 48);
}
__device__ __forceinline__ unsigned long long keep_low(unsigned long long m, int k) { while (__builtin_popcountll(m) > k) m &= ~(1ull << (63 - __builtin_clzll(m))); return m; }
__device__ __forceinline__ void select_rows4(const float* SC, unsigned* MASK, int row0  , int lane, LAS unsigned* slot  ) {
    const int b = row0 / SEQ, t0 = row0 % SEQ, qb = t0 >> 8;
    if (t0 < 256) {
#pragma unroll 1
        for (int i = 0; i < 4; ++i) { const int t = t0 + i, lo = 64 * lane;
            const unsigned long long w = (lo + 63 <= t) ? ~0ull : (lo > t ? 0ull : ((2ull << (t - lo)) - 1ull));
            if (lane < 32) ((unsigned long long*)(MASK + (size_t)(row0 + i) * 64))[lane] = w; }
        return;
    }
    const int pitch = 128 * (qb + 1), pmax = pitch - 1;
    const unsigned* srow0 = (const unsigned*)SC + ((size_t)b * 36 + (size_t)(qb * (qb + 1) / 2)) * 32768 + (size_t)(t0 - 256 * qb) * pitch;
    unsigned raw[16];
#pragma unroll
    for (int i = 0; i < 16; ++i) { const int s_ = 64 * i + lane; raw[i] = srow0[s_ < pmax ? s_ : pmax]; }
#pragma unroll 1
    for (int r = 0; r < 4; ++r) {
        const int t = t0 + r;
        unsigned P[16];
#pragma unroll
        for (int i = 0; i < 16; ++i) P[i] = raw[i];
        { const unsigned* nx = srow0 + (size_t)(r < 3 ? r + 1 : 3) * pitch;
#pragma unroll
          for (int i = 0; i < 16; ++i) { const int s_ = 64 * i + lane; raw[i] = nx[s_ < pmax ? s_ : pmax]; } }
#define SEL_TSTAGE(sh, m) _Pragma("unroll") for (int q = 0; q < 16; ++q) if (!(q & (sh))) { const unsigned a_ = P[q], b_ = P[q + (sh)]; \
            P[q] = (a_ & (m)) | ((b_ << (sh)) & ~(m)); P[q + (sh)] = ((a_ >> (sh)) & (m)) | (b_ & ~(m)); }
        SEL_TSTAGE(8, 0x00FF00FFu) SEL_TSTAGE(4, 0x0F0F0F0Fu) SEL_TSTAGE(2, 0x33333333u) SEL_TSTAGE(1, 0x55555555u)
#undef SEL_TSTAGE
        { const unsigned sg = P[15];
#pragma unroll
          for (int q = 0; q < 15; ++q) P[q] ^= sg;
          P[15] = ~sg; }
        const int nj = ((t - lane) >> 6) + 1;
        unsigned A = ((1u << ((nj + 1) >> 1)) - 1u) | (((1u << (nj >> 1)) - 1u) << 16), G = 0u;
        int cab = 0, cntA = t + 1;
#pragma unroll
        for (int bit = 15; bit >= 0; --bit) {
            if (cab + cntA != 256) {
                const unsigned ones = A & P[bit];
                const int c = wave_sum_i(__builtin_popcount(ones));
                if (cab + c >= 256) { A = ones; cntA = c; } else { G |= ones; cab += c; A &= ~ones; cntA -= c; }
            }
        }
        int need = 256 - cab;
        unsigned sel = G | A;
        if (cntA != need) {
            unsigned selA = 0u;
#pragma nounroll
            for (int j = 0; j < 32; ++j) { const int pb = (j >> 1) + 16 * (j & 1);
                unsigned long long m = __ballot((A >> pb) & 1u);
                if (__builtin_popcountll(m) > need) m = keep_low(m, need);
                need -= __builtin_popcountll(m);
                selA |= (unsigned)((m >> lane) & 1ull) << pb;
            }
            sel = G | selA;
        }
        int lo = 0, hi = 0;
#pragma unroll
        for (int j = 0; j < 32; ++j) { const unsigned long long m = __ballot((sel >> ((j >> 1) + 16 * (j & 1))) & 1u);
            lo = (lane == j) ? (int)(unsigned)m : lo; hi = (lane == j) ? (int)(unsigned)(m >> 32) : hi; }
        if (lane < 32) ((unsigned long long*)(MASK + (size_t)(row0 + r) * 64))[lane] = (unsigned long long)(unsigned)lo | ((unsigned long long)(unsigned)hi << 32);
    }
}
}

__device__ __forceinline__ unsigned* queue_word(Frame& F, int l, int chunk, int q) { return (unsigned*)(F.ws + WS_CTL) + CW_QUEUE + 64 * ((l * NCHUNK + chunk) * 4 + q); }

__device__ __forceinline__ void phase_proj(Frame& F, int l, int chunk) {
    PHASE_IDS(F);
    { LAS float* gb = (LAS float*)(F.lds + L_GB); const float* bg = F.in[7] + (size_t)l * 3072;
      __syncthreads();
      for (int i = F.tid; i < 3072; i += NTHREADS) gb[i] = bg[i];
      VM_WAIT(); LDS_WAIT(); __syncthreads(); }
    pg8::ProjSched8 S{{{(const bf16_t*)(F.ws + WS_XB8 + (size_t)chunk * TC * DM), (const bf16_t*)(F.ws + WS_WIN8), DM / 2, DM / 2, TC / 256, (PW + 3072) / 256, F.G, (int)blockIdx.x}, F8_SW, F8_SA_X}};
    const float* rp = (const float*)(F.ws + WS_ROPE);
    EpiProj E{(bf16_t*)(F.ws + WS_PROJ), rp, rp + 2048 * 8 * 2, (float*)(F.ws + WS_SSQ), (bf16_t*)(F.ws + WS_G3), (const LAS float*)(F.lds + L_GB)};
    pg8::gemm_phase<EpiProj, pg8::ProjSched8, true, true>(F.lds, DM / 2, S, E);
}
__device__ __forceinline__ void dilated_unit(Frame& F, int u) {
    const bf16_t* PROJ = (const bf16_t*)(F.ws + WS_PROJ); bf16_t* OG = (bf16_t*)(F.ws + WS_OG); float* LSE = (float*)(F.ws + WS_LSE);
    constexpr int N_G0 = NBC * 4 * 8, N_G1 = NBC * 4 * 4 * 2;
    int g, b, h, res, qb, dil, nq;
    if (u < N_G0) { g = 0; dil = 1; qb = 7 - u / (NBC * 4); const int bh = u % (NBC * 4); b = bh >> 2; h = bh & 3; res = 0; nq = 256; }
    else if (u < N_G0 + N_G1) { const int v = u - N_G0; g = 1; dil = 4; qb = 1 - v / (NBC * 16); const int x = v % (NBC * 16); b = x >> 4; h = (x >> 2) & 3; res = x & 3; nq = 256; }
    else { const int v = u - N_G0 - N_G1; g = 2; dil = 16; qb = 0; b = v >> 5; h = (v >> 3) & 3; res = (v & 7) * 2; nq = 128; }
    att::Desc d; const size_t r0 = (size_t)b * SEQ + res;
    const bf16_t* base = PROJ + r0 * PW + 512 + 768 * g + 64 * h;
    d.Q = base; d.K1 = base + 256; d.V = base + 512; d.K2 = nullptr; d.qpitch = d.k1pitch = d.vpitch = PW; d.k2pitch = 0;
    d.O = OG + ((size_t)g * TC + r0) * 256 + 64 * h; d.opitch = 256; d.lse = LSE + ((size_t)g * TC + r0) * 4 + h; d.lsepitch = 4; d.mask = nullptr;
    d.rstride = dil; d.q0 = qb * 256; d.nq = nq; d.o8 = 0;
    if (g == 2) { d.jlo = 0; d.jhi = 2; att::attn_unit<64, 0, true>(F.lds, d); }
    else { d.jlo = (qb * 4 - 2) > 0 ? (qb * 4 - 2) : 0; d.jhi = 4 * (qb + 1); att::attn_unit<64, 1>(F.lds, d); }
}

struct UpSched {
    static constexpr bool GATHER = false;
    const char* A; const char* B; size_t sB; int lda, ldb, nM, G, c;
    __device__ __forceinline__ bool next(int i, pg8::Unit& u) const { const int v = i * G + c; if (v >= nM * 7) return false; u.pm = v / 7; u.pn = v % 7; u.ord = i; return true; }
    __device__ __forceinline__ const char* a_base(const pg8::Unit& u) const { return A + ((size_t)u.pm * 256 * lda + (u.pn >= 3 ? 256 : 0)) * 2; }
    __device__ __forceinline__ const char* b_base(const pg8::Unit& u) const { return B + (u.pn >= 3 ? sB + (size_t)(u.pn - 3) * 256 * ldb * 2 : (size_t)u.pn * 256 * ldb * 2); }
    __device__ __forceinline__ void a_off(const pg8::Unit&, const int (&R)[2], const int (&C)[2], unsigned (&v)[2][2]) const {
#pragma unroll
        for (int i = 0; i < 2; ++i) { v[0][i] = (unsigned)(R[i] * lda + C[i]) * 2u; v[1][i] = (unsigned)((128 + R[i]) * lda + C[i]) * 2u; }
    }
};
struct EpiUp {
    EpiUpQ q; EpiUpKV kv;
    __device__ __forceinline__ void operator()(const f32x4 (&acc)[2][2][4][2], const pg8::Unit& u, int wr, int wc, int fr, int fq) const {
        if (u.pn < 3) q(acc, u, wr, wc, fr, fq);
        else { pg8::Unit u2 = u; u2.pn = u.pn - 3; kv(acc, u2, wr, wc, fr, fq); }
    }
};
__device__ __forceinline__ void phase_up_scores(Frame& F, int l, int chunk) {
    PHASE_IDS(F);
    const bf16_t* PROJ = (const bf16_t*)(F.ws + WS_PROJ);
    const float* rp = (const float*)(F.ws + WS_ROPE);
    {   UpSched S{(const char*)PROJ, (const char*)(F.ws + WS_WUQ), WS_WUKV - WS_WUQ, PW, 256, TC / 256, F.G, (int)blockIdx.x};
        EpiUp E{{(bf16_t*)(F.ws + WS_QM), rp + 2048 * 8 * 2, (const float*)(F.ws + WS_SSQ)}, {(bf16_t*)(F.ws + WS_KVM), (const float*)(F.ws + WS_SSQ)}};
        pg8::gemm_phase<EpiUp, UpSched, true>(F.lds, 256, S, E); }
    unsigned* qw = queue_word(F, l, chunk, 0); int pre = -1;
    for (;;) {
        const int u = dequeue(F, qw, pre);
        if (u < NBC * 64) { dilated_unit(F, u); continue; }
        if (u >= NBC * 64 + NBC * 72 + NBC * 32) break;
        if (u >= NBC * 64 + NBC * 72) { dilated_unit(F, u - NBC * 72); continue; }
        const int v = u - NBC * 64; const int b = v / 72; int r = v % 72, qh = 0; while (r > (qh >> 1)) { r -= (qh >> 1) + 1; ++qh; }
        idx::score_unit(F.lds, PROJ, (float*)(F.ws + WS_SC), b, qh, r);
    }
}
__device__ __forceinline__ void phase_attn1(Frame& F, int l, int chunk, int tmask = 7) {
    PHASE_IDS(F);
    const bf16_t* PROJ = (const bf16_t*)(F.ws + WS_PROJ); const bf16_t* QM = (const bf16_t*)(F.ws + WS_QM); const bf16_t* KVM = (const bf16_t*)(F.ws + WS_KVM);
    bf16_t* OA = (bf16_t*)(F.ws + WS_OA); bf16_t* OG = (bf16_t*)(F.ws + WS_OG); float* LSE = (float*)(F.ws + WS_LSE);
    constexpr int N_MLA = NBC * 8 * 8, N_SEL = TC / 32;
    unsigned* qw = queue_word(F, l, chunk, 1); int pre = -1;
    for (;;) {
        int u = dequeue(F, qw, pre);
        if (u < N_MLA) {
            if (!(tmask & 1)) continue;
            const int qb = 7 - u / (NBC * 8), bh = u % (NBC * 8), b = bh >> 3, h = bh & 7;
            att::Desc d; const size_t r0 = (size_t)b * SEQ;
            d.Q = QM + r0 * 768 + h * 96; d.qpitch = 768; d.K1 = KVM + r0 * 1024 + h * 128; d.k1pitch = 1024; d.K2 = PROJ + r0 * PW + 384; d.k2pitch = PW;
            d.V = KVM + r0 * 1024 + h * 128 + 64; d.vpitch = 1024; d.O = (bf16_t*)((unsigned char*)OA + r0 * 512 + h * 64); d.opitch = 512; d.o8 = 1; d.lse = nullptr; d.lsepitch = 0; d.mask = nullptr;
            d.rstride = 1; d.q0 = qb * 256; d.nq = 256; d.jlo = 0; d.jhi = 4 * (qb + 1);
            att::attn_unit<96, 0>(F.lds, d); continue; }
        u -= N_MLA;
        if (u >= N_SEL) break;
        if (!(tmask & 4)) continue;
        idx::select_rows4((const float*)(F.ws + WS_SC), (unsigned*)(F.ws + WS_MASK), u * 32 + F.wave * 4, F.lane, (LAS unsigned*)(F.lds + L_GB) + F.wave * 64);
    }
}
__device__ __forceinline__ void phase_attn2(Frame& F, int l, int chunk) {
    PHASE_IDS(F);
    const bf16_t* PROJ = (const bf16_t*)(F.ws + WS_PROJ);
    bf16_t* OC = (bf16_t*)(F.ws + WS_OC);
    unsigned* qw = queue_word(F, l, chunk, 2); int pre = -1;
    for (;;) {
        const int u = dequeue(F, qw, pre);
        if (u >= NBC * 64) break;
        const int qb = 7 - u / (NBC * 8), bh = u % (NBC * 8), b = bh >> 3, h = bh & 7;
        att::Desc d; const size_t r0 = (size_t)b * SEQ;
        d.Q = PROJ + r0 * PW + 2816 + 64 * h; d.K1 = PROJ + r0 * PW + 3840; d.V = PROJ + r0 * PW + 3904; d.K2 = nullptr; d.qpitch = d.k1pitch = d.vpitch = PW; d.k2pitch = 0;
        d.O = (bf16_t*)((unsigned char*)OC + r0 * 512 + 64 * h); d.opitch = 512; d.o8 = 1; d.lse = nullptr; d.lsepitch = 0; d.mask = (const unsigned*)(F.ws + WS_MASK) + r0 * 64;
        d.rstride = 1; d.q0 = qb * 256; d.nq = 256; d.jlo = 0; d.jhi = 4 * (qb + 1);
        att::attn_unit<64, 2>(F.lds, d);
    }
    const bf16_t* OG = (const bf16_t*)(F.ws + WS_OG); const float* LSE = (const float*)(F.ws + WS_LSE); bf16_t* OB = (bf16_t*)(F.ws + WS_OB);
    const int gw = F.vcu * NWAVES + F.wave, NGW = F.G * NWAVES, h = F.lane >> 4;
    for (int row = gw; row < TC; row += NGW) {
        const float l0 = LSE[(size_t)row * 4 + h], l1 = LSE[((size_t)TC + row) * 4 + h], l2 = LSE[((size_t)2 * TC + row) * 4 + h];
        const float mx = fmaxf(l0, fmaxf(l1, l2));
        float w0 = __builtin_amdgcn_exp2f(l0 - mx), w1 = __builtin_amdgcn_exp2f(l1 - mx), w2 = __builtin_amdgcn_exp2f(l2 - mx);
        const float inv = 1.0f / (w0 + w1 + w2); w0 *= inv; w1 *= inv; w2 *= inv;
        const u32x2 a = *(const u32x2*)(OG + (size_t)row * 256 + F.lane * 4), bq = *(const u32x2*)(OG + ((size_t)TC + row) * 256 + F.lane * 4), c = *(const u32x2*)(OG + ((size_t)2 * TC + row) * 256 + F.lane * 4);
        w0 *= 32.f; w1 *= 32.f; w2 *= 32.f;
        *(unsigned*)((unsigned char*)OB + (size_t)row * 512 + F.lane * 4) = pk4_fp8(w0 * bflo(a.x) + w1 * bflo(bq.x) + w2 * bflo(c.x), w0 * bfhi(a.x) + w1 * bfhi(bq.x) + w2 * bfhi(c.x),
                                                                                    w0 * bflo(a.y) + w1 * bflo(bq.y) + w2 * bflo(c.y), w0 * bfhi(a.y) + w1 * bfhi(bq.y) + w2 * bfhi(c.y));
    }
}
constexpr int CW_DEP = 32768;
__device__ __forceinline__ void phase_attn(Frame& F, int l, int chunk) {
    PHASE_IDS(F);
    const bf16_t* PROJ = (const bf16_t*)(F.ws + WS_PROJ); const bf16_t* QM = (const bf16_t*)(F.ws + WS_QM); const bf16_t* KVM = (const bf16_t*)(F.ws + WS_KVM);
    bf16_t* OA = (bf16_t*)(F.ws + WS_OA); bf16_t* OC = (bf16_t*)(F.ws + WS_OC);
    constexpr int N_SEL = TC / 32, NQ = NBC * 8;
    unsigned* dep = (unsigned*)(F.ws + WS_CTL) + CW_DEP + (l * NCHUNK + chunk) * (NBC * 8);
    unsigned* qw = queue_word(F, l, chunk, 1); int pre = -1;
    for (;;) {
        int u = dequeue(F, qw, pre);
        if (u < N_SEL) {
            idx::select_rows4((const float*)(F.ws + WS_SC), (unsigned*)(F.ws + WS_MASK), u * 32 + F.wave * 4, F.lane, (LAS unsigned*)(F.lds + L_GB) + F.wave * 64);
            VM_WAIT();
            __syncthreads();
            if (F.tid == 0) { const int row = u * 32, b = row / SEQ, qb = (row % SEQ) >> 8;
                __builtin_amdgcn_fence(__ATOMIC_RELEASE, "agent");
                __hip_atomic_fetch_add(dep + b * 8 + qb, 1u, __ATOMIC_RELAXED, __HIP_MEMORY_SCOPE_AGENT); }
            continue; }
        u -= N_SEL;
        if (u >= 16 * NQ) break;
        const int qb = 7 - u / (2 * NQ), w = u % (2 * NQ);
        if (w < NQ) {
            const int b = w >> 3, h = w & 7;
            att::Desc d; const size_t r0 = (size_t)b * SEQ;
            d.Q = QM + r0 * 768 + h * 96; d.qpitch = 768; d.K1 = KVM + r0 * 1024 + h * 128; d.k1pitch = 1024; d.K2 = PROJ + r0 * PW + 384; d.k2pitch = PW;
            d.V = KVM + r0 * 1024 + h * 128 + 64; d.vpitch = 1024; d.O = (bf16_t*)((unsigned char*)OA + r0 * 512 + h * 64); d.opitch = 512; d.o8 = 1; d.lse = nullptr; d.lsepitch = 0; d.mask = nullptr;
            d.rstride = 1; d.q0 = qb * 256; d.nq = 256; d.jlo = 0; d.jhi = 4 * (qb + 1);
            att::attn_unit<96, 0>(F.lds, d);
        } else {
            const int bh = w - NQ, b = bh >> 3, h = bh & 7;
            if (F.tid == 0) { while (__hip_atomic_load(dep + b * 8 + qb, __ATOMIC_RELAXED, __HIP_MEMORY_SCOPE_AGENT) < 8u) __builtin_amdgcn_s_sleep(4);
                __builtin_amdgcn_fence(__ATOMIC_ACQUIRE, "agent"); }
            __syncthreads();
            att::Desc d; const size_t r0 = (size_t)b * SEQ;
            d.Q = PROJ + r0 * PW + 2816 + 64 * h; d.K1 = PROJ + r0 * PW + 3840; d.V = PROJ + r0 * PW + 3904; d.K2 = nullptr; d.qpitch = d.k1pitch = d.vpitch = PW; d.k2pitch = 0;
            d.O = (bf16_t*)((unsigned char*)OC + r0 * 512 + 64 * h); d.opitch = 512; d.o8 = 1; d.lse = nullptr; d.lsepitch = 0; d.mask = (const unsigned*)(F.ws + WS_MASK) + r0 * 64;
            d.rstride = 1; d.q0 = qb * 256; d.nq = 256; d.jlo = 0; d.jhi = 4 * (qb + 1);
            att::attn_unit<64, 2>(F.lds, d);
        }
    }
    const bf16_t* OG = (const bf16_t*)(F.ws + WS_OG); const float* LSE = (const float*)(F.ws + WS_LSE); bf16_t* OB = (bf16_t*)(F.ws + WS_OB);
    const int gw = F.vcu * NWAVES + F.wave, NGW = F.G * NWAVES, h = F.lane >> 4;
    for (int row = gw; row < TC; row += NGW) {
        const float l0 = LSE[(size_t)row * 4 + h], l1 = LSE[((size_t)TC + row) * 4 + h], l2 = LSE[((size_t)2 * TC + row) * 4 + h];
        const float mx = fmaxf(l0, fmaxf(l1, l2));
        float w0 = __builtin_amdgcn_exp2f(l0 - mx), w1 = __builtin_amdgcn_exp2f(l1 - mx), w2 = __builtin_amdgcn_exp2f(l2 - mx);
        const float inv = 1.0f / (w0 + w1 + w2); w0 *= inv; w1 *= inv; w2 *= inv;
        const u32x2 a = *(const u32x2*)(OG + (size_t)row * 256 + F.lane * 4), bq = *(const u32x2*)(OG + ((size_t)TC + row) * 256 + F.lane * 4), c = *(const u32x2*)(OG + ((size_t)2 * TC + row) * 256 + F.lane * 4);
        w0 *= 32.f; w1 *= 32.f; w2 *= 32.f;
        *(unsigned*)((unsigned char*)OB + (size_t)row * 512 + F.lane * 4) = pk4_fp8(w0 * bflo(a.x) + w1 * bflo(bq.x) + w2 * bflo(c.x), w0 * bfhi(a.x) + w1 * bfhi(bq.x) + w2 * bfhi(c.x),
                                                                                    w0 * bflo(a.y) + w1 * bflo(bq.y) + w2 * bflo(c.y), w0 * bfhi(a.y) + w1 * bfhi(bq.y) + w2 * bfhi(c.y));
    }
}
__device__ __forceinline__ void phase_branches(Frame& F, int l, int chunk) {
    PHASE_IDS(F);
    static_assert(WS_OB - WS_OA == WS_OC - WS_OB && WS_WB - WS_WA == WS_WC - WS_WB, "equally spaced branch operands");
    BranchSched S{(const char*)(F.ws + WS_OA), (const char*)(F.ws + WS_WA), WS_OB - WS_OA, WS_WB - WS_WA, 256, 256, (int)blockIdx.x, F8_SW, 127 - 5, F.G, (TC / 256) * 4};
    EpiBranchAll E{(bf16_t*)(F.ws + WS_MERGED), (bf16_t*)(F.ws + WS_M0), (bf16_t*)(F.ws + WS_M1), (const bf16_t*)(F.ws + WS_G3)};
    pg8::gemm_phase<EpiBranchAll, BranchSched, true, true>(F.lds, 256, S, E);
}
__device__ __forceinline__ void phase_wo(Frame& F, int l, int chunk) {
    PHASE_IDS(F);
    pg8::DenseSched8 S{{(const bf16_t*)(F.ws + WS_MERGED), (const bf16_t*)(F.ws + WS_WO), DM / 2, DM / 2, TC / 256, 4, F.G, (int)blockIdx.x}, F8_SW, 127 - 6};
    EpiWo E{F.out, l == 0 ? F.in[0] : F.out, chunk * TC};
    pg8::gemm_phase<EpiWo, pg8::DenseSched8, true, true>(F.lds, DM / 2, S, E);
}

__global__ void __launch_bounds__(NTHREADS, 2) fwd_kernel(Args args) {
    extern __shared__ __attribute__((aligned(16))) unsigned char lds_raw[];
    Frame F;
    F.lds = (LAS unsigned char*)lds_raw;
    F.tid = threadIdx.x; F.lane = F.tid & 63; F.wave = __builtin_amdgcn_readfirstlane(F.tid >> 6);
    F.G = gridDim.x; { const int bx = blockIdx.x; F.vcu = (F.G % 8 == 0) ? (bx % 8) * (F.G / 8) + bx / 8 : bx; }
    F.in.p = (intab_t)__builtin_amdgcn_kernarg_segment_ptr(); F.out = args.out; F.ws = args.ws; F.out0 = args.out; F.ws0 = args.ws;
    for (int u = F.tid; u < (LDS_BYTES - L_CTL) / 4; u += NTHREADS) ((LAS unsigned*)(F.lds + L_CTL))[u] = 0u;
    __syncthreads();
    XcdBarrier bar = xcd_barrier_post((unsigned*)(F.ws + WS_CTL) + CW_BAR, (volatile LAS unsigned*)(F.lds + L_BARW));
#define GRID_BAR() xcd_barrier(bar)

    for (int l = 0; l < 2; ++l) {
        phase_conv_moe(F, l);
        phase_conv_mixer(F, l);
        GRID_BAR();
        for (int chunk = 0; chunk < NCHUNK; ++chunk) {
            phase_proj(F, l, chunk);
            GRID_BAR();
            if (DUPMASK & 2) { phase_proj(F, l, chunk); GRID_BAR(); }
            phase_up_scores(F, l, chunk);
            GRID_BAR();
            if (DUPMASK & 4) { phase_up_scores(F, l + 2, chunk); GRID_BAR(); }
            phase_attn(F, l, chunk);
            GRID_BAR();
            phase_branches(F, l, chunk);
            GRID_BAR();
            if (DUPMASK & 32) { phase_branches(F, l, chunk); GRID_BAR(); }
            phase_wo(F, l, chunk);
            if ((DUPMASK & 0x800) && l == 0) { GRID_BAR(); phase_wo(F, l, chunk); }
        }
        GRID_BAR();
        phase_ln1_router(F, l, F.out, false);
        GRID_BAR();
        phase_moe_scatter(F);
        GRID_BAR();
        phase_moe_gemm1(F);
        GRID_BAR();
        if (DUPMASK & 64) { phase_moe_gemm1(F); GRID_BAR(); }
        phase_moe_gemm2(F);
        GRID_BAR();
        if (DUPMASK & 128) { phase_moe_gemm2(F); GRID_BAR(); }
        phase_combine_ln2(F, l);
    }
}

extern "C" void kernel_launch(void* const* d_in, const int* in_sizes, int n_in, void* d_out, int out_size, void* d_ws, size_t ws_size, hipStream_t stream) {
    static int grid = 0;
    if (grid == 0) {
        if (n_in != 23 || out_size != TT * DM || ws_size < WS_END) { fprintf(stderr, "kernel_launch: unexpected shapes n_in %d out %d ws %zu\n", n_in, out_size, ws_size); grid = -1; return; }
        int dev = 0, cus = 0;
        if (hipGetDevice(&dev) != hipSuccess || hipDeviceGetAttribute(&cus, hipDeviceAttributeMultiprocessorCount, dev) != hipSuccess) { grid = -1; return; }
        if (hipFuncSetAttribute((const void*)fwd_kernel, hipFuncAttributeMaxDynamicSharedMemorySize, LDS_BYTES) != hipSuccess) { fprintf(stderr, "kernel_launch: hipFuncSetAttribute failed\n"); grid = -1; return; }
        int per_cu = 0;
        if (hipOccupancyMaxActiveBlocksPerMultiprocessor(&per_cu, (const void*)fwd_kernel, NTHREADS, LDS_BYTES) != hipSuccess || per_cu < 1) fprintf(stderr, "kernel_launch: occupancy query says %d\n", per_cu);
        (void)hipGetLastError();
        grid = cus;
    }
    if (grid < 0) return;
    if (hipMemsetAsync((char*)d_ws + WS_CTL, 0, CTL_ZERO_BYTES, stream) != hipSuccess) return;
    Args a{};
    for (int i = 0; i < 23; ++i) a.in[i] = (const float*)d_in[i];
    a.out = (float*)d_out; a.ws = (unsigned char*)d_ws;
    hipLaunchKernelGGL(fwd_kernel, dim3(grid), dim3(NTHREADS), LDS_BYTES, stream, a);
}
```

```cpp
#include <hip/hip_runtime.h>
#include <cstdio>
#include <cstdint>

#define LAS __attribute__((address_space(3)))
#define GAS __attribute__((address_space(1)))
typedef unsigned short bf16_t;
typedef short bf16x8 __attribute__((ext_vector_type(8)));
typedef float f32x4 __attribute__((ext_vector_type(4)));
typedef float f32x2 __attribute__((ext_vector_type(2)));
typedef float f32x16 __attribute__((ext_vector_type(16)));
typedef unsigned u32x4 __attribute__((ext_vector_type(4)));
typedef unsigned u32x2 __attribute__((ext_vector_type(2)));

constexpr int DM = 1024, NB = 32, SEQ = 2048, TT = NB * SEQ;
constexpr int NEXP = 32, DEXP = 256;
constexpr float LN_EPS = 1e-6f;
constexpr float ALPHA = 1.41421356237309515f;
constexpr int NWAVES = 8, NTHREADS = 512;

__device__ __forceinline__ unsigned f2bf(float f) { unsigned u = __builtin_bit_cast(unsigned, f); return (u + 0x7fffu + ((u >> 16) & 1u)) >> 16; }
__device__ __forceinline__ unsigned pk2(float lo, float hi) { return f2bf(lo) | (f2bf(hi) << 16); }
__device__ __forceinline__ float bf2f(unsigned short b) { return __builtin_bit_cast(float, (unsigned)b << 16); }
__device__ __forceinline__ float bflo(unsigned w) { return __builtin_bit_cast(float, w << 16); }
__device__ __forceinline__ float bfhi(unsigned w) { return __builtin_bit_cast(float, w & 0xffff0000u); }
typedef __bf16 bf16x2_t __attribute__((ext_vector_type(2)));
__device__ __forceinline__ unsigned cvt_pk_bf16(float lo, float hi) { const f32x2 v = {lo, hi}; const bf16x2_t b = __builtin_convertvector(v, bf16x2_t); return __builtin_bit_cast(unsigned, b); }
__device__ __forceinline__ float wave_sum(float v) {
#pragma unroll
    for (int o = 1; o < 64; o <<= 1) v += __shfl_xor(v, o);
    return v;
}
__device__ __forceinline__ float fast_exp(float x) { return __builtin_amdgcn_exp2f(x * 1.4426950408889634f); }
__device__ __forceinline__ float sigmoidf_(float x) { return __builtin_amdgcn_rcpf(1.0f + fast_exp(-x)); }
__device__ __forceinline__ unsigned pk4_fp8(float a, float b, float c, float d) {
    int p = __builtin_amdgcn_cvt_pk_fp8_f32(a, b, 0, false); p = __builtin_amdgcn_cvt_pk_fp8_f32(c, d, p, true); return (unsigned)p; }
__device__ __forceinline__ void store8_fp8(unsigned char* p, const f32x4& v0, const f32x4& v1, float sc) {
    u32x2 w; w.x = pk4_fp8(v0[0] * sc, v0[1] * sc, v0[2] * sc, v0[3] * sc); w.y = pk4_fp8(v1[0] * sc, v1[1] * sc, v1[2] * sc, v1[3] * sc); *(u32x2*)p = w;
}
#define LDS_WAIT() asm volatile("s_waitcnt lgkmcnt(0)" ::: "memory")
#define VM_WAIT() asm volatile("s_waitcnt vmcnt(0)" ::: "memory")

namespace pg8 {
constexpr int BM = 256, BK = 64, HALF = 128, HTB = HALF * BK * 2, STAGE_BYTES = 8 * HTB;
__device__ __forceinline__ int lds_byte(int r, int c) { return r * 128 + ((((c >> 3) ^ (r >> 1)) & 7) * 16) + (c & 7) * 2; }
__device__ __forceinline__ void stage_rc(int b, int& R, int& C) { R = b >> 7; C = ((((b >> 4) ^ (R >> 1)) & 7)) * 8; }
__device__ __forceinline__ int perm32(int rho) { const int n = rho >> 4, i = rho & 15; return 8 * (i >> 2) + 4 * n + (i & 3); }
struct Unit { int pm, pn, ord; };

template <class S, class = void> struct SchedVarK { static constexpr bool value = false; };
template <class S> struct SchedVarK<S, decltype((void)S::VARK)> { static constexpr bool value = S::VARK; };
typedef int v4i_t __attribute__((ext_vector_type(4)));
typedef int v8i_t __attribute__((ext_vector_type(8)));
__device__ __forceinline__ v8i_t cat8(const bf16x8& lo, const bf16x8& hi) { return __builtin_shufflevector(__builtin_bit_cast(v4i_t, lo), __builtin_bit_cast(v4i_t, hi), 0, 1, 2, 3, 4, 5, 6, 7); }
template <class Epi, class Sched, bool ALIGN_EPI, bool F8 = false>
__device__ __forceinline__ void gemm_phase(LAS unsigned char* lds, const int K, const Sched& S, const Epi& E) {
    int tid_ = threadIdx.x; asm volatile("" : "+v"(tid_));
    const int tid = tid_, wid = __builtin_amdgcn_readfirstlane(tid >> 6), lane = tid & 63, wr = wid >> 2, wc = wid & 3, fr = lane & 15, fq = lane >> 4;
    int nt = K / BK;
    int Rr[2], Cc[2]; unsigned vB[2][2];
#pragma unroll
    for (int i = 0; i < 2; ++i) { stage_rc(tid * 16 + i * 8192, Rr[i], Cc[i]); const int Rb = (Rr[i] & ~31) + perm32(Rr[i] & 31);
        vB[0][i] = (unsigned)(Rb * S.ldb + Cc[i]) * 2u; vB[1][i] = (unsigned)((HALF + Rb) * S.ldb + Cc[i]) * 2u; }
    const size_t kstep = (size_t)(BK * 2);
    const unsigned ldsw = (unsigned)wid * 1024u;
    const int aoff = lds_byte(wr * 64 + fr, fq * 8), boff = lds_byte(wc * 32 + fr, fq * 8);
    const int aoff1 = lds_byte(wr * 64 + fr, fq * 8 + 32), boff1 = lds_byte(wc * 32 + fr, fq * 8 + 32);
#define PG8_SA(b, h) (((b) * 2 + (h)) * HTB)
#define PG8_SB(b, h) ((4 + (b) * 2 + (h)) * HTB)
#define PG8_STAGE(bufoff, gbase, voff) do { _Pragma("unroll") for (int _i = 0; _i < 2; ++_i) \
        __builtin_amdgcn_global_load_lds((const unsigned*)((const char*)(gbase) + (voff)[_i]), (LAS unsigned*)(lds + (bufoff) + ldsw + _i * 8192), 16, 0, 0); } while (0)
#define PG8_LDA(dst, b, h) do { _Pragma("unroll") for (int m = 0; m < 4; ++m) { \
        const bf16x8 f0_ = *(const LAS bf16x8*)(lds + PG8_SA(b, h) + aoff + m * 2048), f1_ = *(const LAS bf16x8*)(lds + PG8_SA(b, h) + aoff1 + m * 2048); \
        if constexpr (F8) dst##8[m] = cat8(f0_, f1_); else { dst[m][0] = f0_; dst[m][1] = f1_; } } } while (0)
#define PG8_LDB(dst, b, h) do { _Pragma("unroll") for (int n = 0; n < 2; ++n) { \
        const bf16x8 f0_ = *(const LAS bf16x8*)(lds + PG8_SB(b, h) + boff + n * 2048), f1_ = *(const LAS bf16x8*)(lds + PG8_SB(b, h) + boff1 + n * 2048); \
        if constexpr (F8) dst##8[n] = cat8(f0_, f1_); else { dst[n][0] = f0_; dst[n][1] = f1_; } } } while (0)
#define PG8_MMA(ai, bj, At, Bt) do { __builtin_amdgcn_s_setprio(1); \
        if constexpr (F8) { _Pragma("unroll") for (int m = 0; m < 4; ++m) _Pragma("unroll") for (int n = 0; n < 2; ++n) \
            asm volatile("v_mfma_scale_f32_16x16x128_f8f6f4 %0, %1, %2, %0, %3, %4 op_sel_hi:[0,0,0]" : "+v"(acc[ai][bj][m][n]) : "v"(Bt##8[n]), "v"(At##8[m]), "v"(scw8), "v"(sca8)); } \
              \
        else { _Pragma("unroll") for (int m = 0; m < 4; ++m) _Pragma("unroll") for (int n = 0; n < 2; ++n) _Pragma("unroll") for (int k = 0; k < 2; ++k) \
            acc[ai][bj][m][n] = __builtin_amdgcn_mfma_f32_16x16x32_bf16(Bt[n][k], At[m][k], acc[ai][bj][m][n], 0, 0, 0); } \
        __builtin_amdgcn_s_setprio(0); } while (0)
#define PG8_WAIT_V(n) asm volatile("s_waitcnt vmcnt(" #n ")" ::: "memory")
#define PG8_WAIT_L(n) asm volatile("s_waitcnt lgkmcnt(" #n ")" ::: "memory")
#define PG8_BAR __builtin_amdgcn_s_barrier()
#define PG8_SCHED __builtin_amdgcn_sched_barrier(0)
    int scw8 = 0, sca8 = 0;
    if constexpr (F8) { scw8 = S.sw8 * 0x01010101; sca8 = S.sa8 * 0x01010101; }
    Unit cur, nxt; int ui = 0;
    if (!S.next(0, cur)) return;
    f32x4 acc[2][2][4][2];
#pragma unroll
    for (int a = 0; a < 2; ++a)
#pragma unroll
        for (int b = 0; b < 2; ++b)
#pragma unroll
            for (int m = 0; m < 4; ++m)
#pragma unroll
                for (int n = 0; n < 2; ++n) acc[a][b][m][n] = (f32x4){0.f, 0.f, 0.f, 0.f};
    bf16x8 At[4][2], B0[2][2], B1[2][2]; v8i_t At8[4], B08[2], B18[2];
    unsigned vAc[2][2], vAn[2][2];
    const char* cA = S.a_base(cur); const char* cB = S.b_base(cur);
    S.a_off(cur, Rr, Cc, vAc);
    if constexpr (SchedVarK<Sched>::value) nt = S.ktiles(cur);
    PG8_STAGE(PG8_SB(0, 0), cB, vB[0]); PG8_STAGE(PG8_SB(0, 1), cB, vB[1]); PG8_STAGE(PG8_SA(0, 0), cA, vAc[0]); PG8_STAGE(PG8_SA(0, 1), cA, vAc[1]);
    if (wr == 1) PG8_BAR;
    PG8_WAIT_V(2); PG8_BAR;
    PG8_STAGE(PG8_SB(1, 0), cB + kstep, vB[0]); PG8_STAGE(PG8_SA(1, 0), cA + kstep, vAc[0]); PG8_STAGE(PG8_SB(1, 1), cB + kstep, vB[1]);
    PG8_WAIT_V(6); PG8_BAR;
    bool epi_pend = false;
    for (;;) {
        const bool has_next = S.next(ui + 1, nxt);
        const char* nA = cA; const char* nB = cB;
        if constexpr (Sched::GATHER) {
#pragma unroll
            for (int h = 0; h < 2; ++h)
#pragma unroll
                for (int i = 0; i < 2; ++i) vAn[h][i] = vAc[h][i];
        }
        if (has_next) { nA = S.a_base(nxt); nB = S.b_base(nxt); if constexpr (Sched::GATHER) S.a_off(nxt, Rr, Cc, vAn); }
#pragma nounroll
        for (int t = 0; t < nt; t += 2) {
            const bool last = (t == nt - 2);
            const bool ep_ = epi_pend && t == 0;
            const char* a1 = cA + (size_t)(t + 1) * kstep;
            const char* a2 = last ? nA : cA + (size_t)(t + 2) * kstep; const char* b2 = last ? nB : cB + (size_t)(t + 2) * kstep;
            const char* a3 = a2 + kstep; const char* b3 = b2 + kstep;
            unsigned vA2[2][2];
#pragma unroll
            for (int h = 0; h < 2; ++h)
#pragma unroll
                for (int i = 0; i < 2; ++i) { if constexpr (Sched::GATHER) vA2[h][i] = last ? vAn[h][i] : vAc[h][i]; else vA2[h][i] = vAc[h][i]; }
            PG8_LDB(B0, 0, 0); PG8_LDB(B1, 0, 1); PG8_SCHED; PG8_LDA(At, 0, 0); PG8_STAGE(PG8_SA(1, 1), a1, vAc[1]);
            if (ep_) { PG8_WAIT_V(24); } else { PG8_WAIT_V(8); } PG8_WAIT_L(0); PG8_BAR; PG8_MMA(0, 0, At, B0); PG8_MMA(0, 1, At, B1); PG8_BAR; PG8_SCHED;
            PG8_LDA(At, 0, 1); PG8_STAGE(PG8_SB(0, 0), b2, vB[0]); PG8_STAGE(PG8_SB(0, 1), b2, vB[1]); PG8_STAGE(PG8_SA(0, 0), a2, vA2[0]);
            if (ep_) { PG8_WAIT_V(24); } else { PG8_WAIT_V(8); } PG8_WAIT_L(0); PG8_BAR; PG8_MMA(1, 0, At, B0); PG8_MMA(1, 1, At, B1); PG8_BAR; PG8_SCHED;
            PG8_LDB(B0, 1, 0); PG8_LDB(B1, 1, 1); PG8_SCHED; PG8_LDA(At, 1, 0); PG8_STAGE(PG8_SA(0, 1), a2, vA2[1]);
            PG8_WAIT_V(8); PG8_WAIT_L(0); PG8_BAR; PG8_MMA(0, 0, At, B0); PG8_MMA(0, 1, At, B1); PG8_BAR; PG8_SCHED;
            PG8_LDA(At, 1, 1); PG8_STAGE(PG8_SB(1, 0), b3, vB[0]); PG8_STAGE(PG8_SB(1, 1), b3, vB[1]); PG8_STAGE(PG8_SA(1, 0), a3, vA2[0]);
            PG8_WAIT_V(8); PG8_WAIT_L(0); PG8_BAR; PG8_MMA(1, 0, At, B0); PG8_MMA(1, 1, At, B1); PG8_BAR; PG8_SCHED;
        }
        if constexpr (ALIGN_EPI) { if (wr == 0) PG8_BAR; }
        if constexpr (F8) asm volatile("s_nop 15\n\ts_nop 15" ::: "memory");
        { int l2_ = lane; asm volatile("" : "+v"(l2_)); E(acc, cur, wr, wc, l2_ & 15, l2_ >> 4); }
        if (!has_next) break;
        epi_pend = true;
#pragma unroll
        for (int a = 0; a < 2; ++a)
#pragma unroll
            for (int b = 0; b < 2; ++b)
#pragma unroll
                for (int m = 0; m < 4; ++m)
#pragma unroll
                    for (int n = 0; n < 2; ++n) acc[a][b][m][n] = (f32x4){0.f, 0.f, 0.f, 0.f};
        cur = nxt; cA = nA; cB = nB; ++ui;
        if constexpr (SchedVarK<Sched>::value) nt = S.ktiles(cur);
        if constexpr (Sched::GATHER) {
#pragma unroll
            for (int h = 0; h < 2; ++h)
#pragma unroll
                for (int i = 0; i < 2; ++i) vAc[h][i] = vAn[h][i];
        }
        if constexpr (ALIGN_EPI) { if (wr == 1) PG8_BAR; }
    }
    PG8_WAIT_V(0);
    if constexpr (!ALIGN_EPI) { if (wr == 0) PG8_BAR; }
    asm volatile("s_waitcnt vmcnt(0) lgkmcnt(0)\n\ts_barrier" ::: "memory");
    __builtin_amdgcn_sched_barrier(0);
#undef PG8_SA
#undef PG8_SB
#undef PG8_STAGE
#undef PG8_LDA
#undef PG8_LDB
#undef PG8_MMA
#undef PG8_WAIT_V
#undef PG8_WAIT_L
#undef PG8_BAR
#undef PG8_SCHED
}

struct DenseSched {
    static constexpr bool GATHER = false;
    const bf16_t* A; const bf16_t* Bt; int lda, ldb, nM, nN, G, c;
    __device__ __forceinline__ bool next(int i, Unit& u) const { const int v = i * G + c; if (v >= nM * nN) return false; u.pm = v / nN; u.pn = v % nN; u.ord = i; return true; }
    __device__ __forceinline__ const char* a_base(const Unit& u) const { return (const char*)(A + (size_t)u.pm * BM * lda); }
    __device__ __forceinline__ const char* b_base(const Unit& u) const { return (const char*)(Bt + (size_t)u.pn * BM * ldb); }
    __device__ __forceinline__ void a_off(const Unit&, const int (&R)[2], const int (&C)[2], unsigned (&v)[2][2]) const {
#pragma unroll
        for (int i = 0; i < 2; ++i) { v[0][i] = (unsigned)(R[i] * lda + C[i]) * 2u; v[1][i] = (unsigned)((HALF + R[i]) * lda + C[i]) * 2u; }
    }
};
struct DenseSched8 : DenseSched { int sw8, sa8; };
struct ProjSched8 : DenseSched8 {
    __device__ __forceinline__ bool next(int i, Unit& u) const {
        if (nN != 28 || (nM & 1) || (G & 7)) return DenseSched::next(i, u);
        const int x = c & 7, wl = i * (G >> 3) + (c >> 3), half = nM >> 1;
        if (wl >= half * 7) return false;
        u.pm = (x >> 2) * half + wl / 7; u.pn = 7 * (x & 3) + wl % 7; u.ord = i; return true;
    }
};
}

#define XB_TMO      128
#define XB_XCNT(j)  (256  + 64 * (j))
#define XB_XSUB(j)  (1280 + 64 * (j))
#define XB_XGEN(j)  (2304 + 64 * (j))
#define XB_TOP      3328
#define XB_TOPGEN   3392
#define XCD_BAR_WORDS 3456
#define XB_SPIN_CAP (1u << 18)
__device__ __forceinline__ unsigned xb_ld(unsigned* p)              { return __hip_atomic_load(p, __ATOMIC_RELAXED, __HIP_MEMORY_SCOPE_AGENT); }
__device__ __forceinline__ unsigned xb_add(unsigned* p, unsigned v) { return __hip_atomic_fetch_add(p, v, __ATOMIC_RELAXED, __HIP_MEMORY_SCOPE_AGENT); }
__device__ __forceinline__ unsigned xb_xcc_id() { return (unsigned)__builtin_amdgcn_s_getreg((3 << 11) | 20) & 0xFu; }
#define XB_SPIN(cond, bar) do { unsigned _sp = 0; while (cond) { __builtin_amdgcn_s_sleep(1); \
    if ((++_sp & 255u) == 0u) { if (xb_ld(&(bar)[XB_TMO])) break; if (_sp > XB_SPIN_CAP) { atomicAdd(&(bar)[XB_TMO], 1u); break; } } } } while (0)
struct XcdBarrier { unsigned* bar; unsigned x; volatile LAS unsigned* st; };
__device__ __forceinline__ XcdBarrier xcd_barrier_post(unsigned* bar, volatile LAS unsigned* st) {
    XcdBarrier b; b.bar = bar; b.x = xb_xcc_id(); b.st = st;
    if (threadIdx.x == 0) (void)xb_add(&bar[XB_XCNT(b.x)], 1u);
    return b;
}
__device__ __forceinline__ void xcd_barrier_complete(unsigned* bar, unsigned x, unsigned& nloc, unsigned& nx) {
    const unsigned G = gridDim.x * gridDim.y * gridDim.z;
    unsigned sum, cnt, mine, sp = 0u;
    for (;;) {
        sum = 0u; cnt = 0u; mine = 0u;
#pragma unroll
        for (unsigned j = 0; j < 16; ++j) { const unsigned c = xb_ld(&bar[XB_XCNT(j)]); sum += c; cnt += (c > 0u) ? 1u : 0u; mine = (j == x) ? c : mine; }
        if (sum == G) break;
        __builtin_amdgcn_s_sleep(1);
        if ((++sp & 255u) == 0u) { if (xb_ld(&bar[XB_TMO])) break; if (sp > XB_SPIN_CAP) { atomicAdd(&bar[XB_TMO], 1u); break; } }
    }
    nloc = mine > 0u ? mine : 1u; nx = cnt > 0u ? cnt : 1u;
}
__device__ __forceinline__ void xcd_barrier(const XcdBarrier& b) {
    asm volatile("s_waitcnt vmcnt(0)" ::: "memory");
    __syncthreads();
    if (threadIdx.x == 0) {
        unsigned* bar = b.bar;
        __builtin_amdgcn_s_waitcnt(0);
        unsigned nloc = b.st[0], nx = b.st[1];
        if (nloc == 0u) { xcd_barrier_complete(bar, b.x, nloc, nx); b.st[0] = nloc; b.st[1] = nx; }
        const unsigned old = xb_add(&bar[XB_XSUB(b.x)], 1u);
        const unsigned gen = old / nloc;
        if (old + 1u == (gen + 1u) * nloc) {
            __builtin_amdgcn_fence(__ATOMIC_RELEASE, "agent");
            asm volatile("s_waitcnt vmcnt(0)" ::: "memory");
            const unsigned og = xb_add(&bar[XB_TOP], 1u);
            const unsigned tg = og / nx;
            if (og + 1u == (tg + 1u) * nx) xb_add(&bar[XB_TOPGEN], 1u);
            else XB_SPIN(xb_ld(&bar[XB_TOPGEN]) == tg, bar);
            __builtin_amdgcn_fence(__ATOMIC_ACQUIRE, "agent");
            xb_add(&bar[XB_XGEN(b.x)], 1u);
            asm volatile("s_waitcnt vmcnt(0)" ::: "memory");
        } else {
            XB_SPIN(xb_ld(&bar[XB_XGEN(b.x)]) == gen, bar);
            __builtin_amdgcn_fence(__ATOMIC_ACQUIRE, "agent");
            asm volatile("s_waitcnt vmcnt(0)" ::: "memory");
        }
    }
    __syncthreads();
}

constexpr size_t MiB = 1u << 20;
constexpr size_t WS_CTL = 0, CTL_ZERO_BYTES = 1 * MiB;
constexpr int CW_BAR = 4096;
constexpr int CW_QUEUE = 16384;
constexpr size_t WS_W13 = 2 * MiB;
constexpr size_t WS_W2  = 34 * MiB;
constexpr size_t WS_WR  = 50 * MiB;
constexpr size_t WS_MISC = 51 * MiB;
constexpr size_t WS_ROUTE = 52 * MiB;
constexpr size_t WS_RPOS = 53 * MiB;
constexpr size_t WS_ROWTOK = 54 * MiB;
constexpr size_t WS_ROPE = 55 * MiB;
constexpr size_t WS_WUQ = 56 * MiB;
constexpr size_t WS_WUKV = 57 * MiB;
constexpr size_t WS_WA = 58 * MiB;
constexpr size_t WS_WB = 59 * MiB;
constexpr size_t WS_WC = 60 * MiB;
constexpr size_t WS_WO = 61 * MiB;
constexpr size_t WS_SSQ = 63 * MiB;
constexpr size_t WS_LSE = 64 * MiB;
constexpr size_t WS_MASK = 66 * MiB;
constexpr size_t WS_XB8 = 74 * MiB;
constexpr size_t WS_WIN8 = 138 * MiB;
constexpr size_t WS_H = 146 * MiB;
constexpr size_t WS_Y = 182 * MiB;
constexpr size_t WS_SC = WS_Y;
constexpr size_t WS_G3 = 254 * MiB;
constexpr size_t WS_PROJ = 350 * MiB;
constexpr size_t WS_QM = 606 * MiB;
constexpr size_t WS_KVM = 654 * MiB;
constexpr size_t WS_OA = 718 * MiB;
constexpr size_t WS_OB = 734 * MiB;
constexpr size_t WS_OC = 750 * MiB;
constexpr size_t WS_OG = 766 * MiB;
constexpr size_t WS_M0 = 814 * MiB;
constexpr size_t WS_M1 = 846 * MiB;
constexpr size_t WS_MERGED = 878 * MiB;
constexpr size_t WS_END = 910 * MiB;
constexpr int F8_SA_X = 127 - 4, F8_SW = 127 - 10;
constexpr int MAXROWS = 139264;
constexpr int NBC = 16, TC = NBC * SEQ, NCHUNK = NB / NBC;
constexpr int CIN = 3944, PW = 4096;

constexpr int MI_BLOCKCNT = 0;
constexpr int MI_PANEL_E = 8192;
constexpr int MI_NPAN = 8192 + 1024;

constexpr int RING_BYTES = 131072;
constexpr int L_CTL = RING_BYTES;
constexpr int L_BARW = L_CTL + 32;
constexpr int L_HIST = L_CTL + 256;
constexpr int L_TOT  = L_CTL + 384;
constexpr int L_PRE  = L_CTL + 512;
constexpr int L_BASE = L_CTL + 640;
constexpr int L_RANK = L_CTL + 896;
constexpr int L_PE   = L_CTL + 1024;
constexpr int L_ROWS = L_CTL + 2048;
constexpr int LDS_BYTES = 147456;
constexpr int L_GB = L_ROWS;
static_assert(L_ROWS + 12288 <= LDS_BYTES, "LDS map");

#ifndef DUPMASK
#define DUPMASK 0
#endif
struct Args { const float* in[23]; float* out; unsigned char* ws; };
#define PHASE_IDS(F) do { int t_ = threadIdx.x; asm volatile("" : "+v"(t_)); (F).tid = t_; (F).lane = t_ & 63; { intab_t p_ = (intab_t)__builtin_amdgcn_kernarg_segment_ptr(); asm volatile("" : "+s"(p_)); (F).in.p = p_; } \
    { unsigned char GAS* w_ = (unsigned char GAS*)(F).ws0; asm volatile("" : "+s"(w_)); (F).ws = (unsigned char*)w_; float GAS* o_ = (float GAS*)(F).out0; asm volatile("" : "+s"(o_)); (F).out = (float*)o_; } } while (0)

typedef const float GAS* gfptr_t;
typedef const gfptr_t __attribute__((address_space(4)))* intab_t;
struct InTab { intab_t p; __device__ __forceinline__ const float* operator[](int i) const { return (const float*)p[i]; } };
struct Frame {
    LAS unsigned char* lds;
    int tid, lane, wave, vcu, G;
    InTab in; float* out; unsigned char* ws; float* out0; unsigned char* ws0;
};

template <class F>
__device__ __forceinline__ void conv_item(bf16_t* WT, int ldk, int k0, int n0, LAS float* scr, int lane, F val) {
#pragma unroll 8
    for (int i = 0; i < 32; ++i) { const int kk = 2 * i + (lane >> 5); scr[kk * 33 + (lane & 31)] = val(k0 + kk, n0 + (lane & 31)); }
    LDS_WAIT(); asm volatile("" ::: "memory");
    const int c = lane & 7;
#pragma unroll
    for (int j = 0; j < 4; ++j) { const int n = (lane >> 3) + 8 * j; const LAS float* s = scr + (8 * c) * 33 + n;
        u32x4 o; o.x = pk2(s[0 * 33], s[1 * 33]); o.y = pk2(s[2 * 33], s[3 * 33]); o.z = pk2(s[4 * 33], s[5 * 33]); o.w = pk2(s[6 * 33], s[7 * 33]);
        *(u32x4*)(WT + (size_t)(n0 + n) * ldk + k0 + 8 * c) = o; }
    LDS_WAIT(); asm volatile("" ::: "memory");
}

template <class F>
__device__ __forceinline__ void conv_item8(unsigned char* WT, int ldk, int k0, int n0, LAS float* scr, int lane, F val) {
#pragma unroll 8
    for (int i = 0; i < 32; ++i) { const int kk = 2 * i + (lane >> 5); scr[kk * 33 + (lane & 31)] = val(k0 + kk, n0 + (lane & 31)); }
    LDS_WAIT(); asm volatile("" ::: "memory");
    const int c = lane & 7;
#pragma unroll
    for (int j = 0; j < 4; ++j) { const int n = (lane >> 3) + 8 * j; const LAS float* s = scr + (8 * c) * 33 + n;
        u32x2 o; o.x = pk4_fp8(s[0 * 33], s[1 * 33], s[2 * 33], s[3 * 33]); o.y = pk4_fp8(s[4 * 33], s[5 * 33], s[6 * 33], s[7 * 33]);
        *(u32x2*)(WT + (size_t)(n0 + n) * ldk + k0 + 8 * c) = o; }
    LDS_WAIT(); asm volatile("" ::: "memory");
}

__device__ __forceinline__ void conv_plain8(unsigned char* WT, int ldk, int k0, int n0, LAS float* scr, int lane, const float* src, int pitch, float sc) {
    f32x4 v[8];
#pragma unroll
    for (int i = 0; i < 8; ++i) v[i] = *(const f32x4*)(src + (size_t)(k0 + (lane >> 3) + 8 * i) * pitch + n0 + (lane & 7) * 4);
#pragma unroll
    for (int i = 0; i < 8; ++i) { LAS float* d = scr + ((lane >> 3) + 8 * i) * 33 + (lane & 7) * 4; d[0] = v[i][0] * sc; d[1] = v[i][1] * sc; d[2] = v[i][2] * sc; d[3] = v[i][3] * sc; }
    LDS_WAIT(); asm volatile("" ::: "memory");
    const int c = lane & 7;
#pragma unroll
    for (int j = 0; j < 4; ++j) { const int n = (lane >> 3) + 8 * j; const LAS float* s = scr + (8 * c) * 33 + n;
        u32x2 o; o.x = pk4_fp8(s[0 * 33], s[1 * 33], s[2 * 33], s[3 * 33]); o.y = pk4_fp8(s[4 * 33], s[5 * 33], s[6 * 33], s[7 * 33]);
        *(u32x2*)(WT + (size_t)(n0 + n) * ldk + k0 + 8 * c) = o; }
    LDS_WAIT(); asm volatile("" ::: "memory");
}
__device__ __forceinline__ void conv_pair8(unsigned char* WT, int ldk, int k0, int n0, LAS float* scr, int lane, const float* a, const float* b, int pitch, float sc) {
    f32x2 va[8], vb[8];
#pragma unroll
    for (int i = 0; i < 8; ++i) { const size_t o = (size_t)(k0 + (lane >> 3) + 8 * i) * pitch + (n0 >> 1) + (lane & 7) * 2; va[i] = *(const f32x2*)(a + o); vb[i] = *(const f32x2*)(b + o); }
#pragma unroll
    for (int i = 0; i < 8; ++i) { LAS float* d = scr + ((lane >> 3) + 8 * i) * 33 + (lane & 7) * 4; d[0] = va[i][0] * sc; d[1] = vb[i][0] * sc; d[2] = va[i][1] * sc; d[3] = vb[i][1] * sc; }
    LDS_WAIT(); asm volatile("" ::: "memory");
    const int c = lane & 7;
#pragma unroll
    for (int j = 0; j < 4; ++j) { const int n = (lane >> 3) + 8 * j; const LAS float* s = scr + (8 * c) * 33 + n;
        u32x2 o; o.x = pk4_fp8(s[0 * 33], s[1 * 33], s[2 * 33], s[3 * 33]); o.y = pk4_fp8(s[4 * 33], s[5 * 33], s[6 * 33], s[7 * 33]);
        *(u32x2*)(WT + (size_t)(n0 + n) * ldk + k0 + 8 * c) = o; }
    LDS_WAIT(); asm volatile("" ::: "memory");
}

__device__ __forceinline__ void phase_conv_moe(Frame& F, int l) {
    PHASE_IDS(F);
    LAS float* scr = (LAS float*)(F.lds + F.wave * 16384);
    const int gw = F.vcu * NWAVES + F.wave, NGW = F.G * NWAVES;
    const float* w1 = F.in[18] + (size_t)l * NEXP * DM * DEXP;
    const float* w3 = F.in[19] + (size_t)l * NEXP * DM * DEXP;
    const float* w2 = F.in[20] + (size_t)l * NEXP * DEXP * DM;
    bf16_t* W13 = (bf16_t*)(F.ws + WS_W13); bf16_t* W2 = (bf16_t*)(F.ws + WS_W2);
    constexpr int I13 = (DM / 64) * (512 / 32);
    constexpr int I2 = (DEXP / 64) * (DM / 32);
    for (int it = gw; it < NEXP * (I13 + I2); it += NGW) {
        if (it < NEXP * I13) {
            const int e = it / I13, r = it % I13, kb = r / 16, nb = r % 16;
            const float* a = w1 + (size_t)e * DM * DEXP; const float* b = w3 + (size_t)e * DM * DEXP;
            conv_pair8((unsigned char*)W13 + (size_t)e * 512 * DM, DM, kb * 64, nb * 32, scr, F.lane, a, b, DEXP, 1024.f);
        } else {
            const int it2 = it - NEXP * I13; const int e = it2 / I2, r = it2 % I2, kb = r / 32, nb = r % 32;
            const float* a = w2 + (size_t)e * DEXP * DM;
            conv_plain8((unsigned char*)W2 + (size_t)e * DM * DEXP, DEXP, kb * 64, nb * 32, scr, F.lane, a, DM, 1024.f);
        }
    }
    const float* wg = F.in[14] + (size_t)l * DM * 4; const float* wsb = F.in[16] + (size_t)l * DM * NEXP;
    const float* g1 = F.in[12] + (size_t)l * DM; const float* b1 = F.in[13] + (size_t)l * DM;
    bf16_t* WRH = (bf16_t*)(F.ws + WS_WR); bf16_t* WRL = (bf16_t*)(F.ws + WS_WR + 128 * 1024); float* WRC = (float*)(F.ws + WS_WR + 256 * 1024);
    for (int idx = (F.vcu * NTHREADS + F.tid); idx < 64 * DM; idx += F.G * NTHREADS) {
        const int c = idx / DM, k = idx % DM;
        const float v = (c < 32 ? wsb[(size_t)k * NEXP + c] : (c < 36 ? wg[(size_t)k * 4 + (c - 32)] : 0.f)) * g1[k];
        const unsigned h = f2bf(v); const int it = k >> 5, hi_ = (k >> 4) & 1, st = (k >> 3) & 1, e = k & 7, ln = (c & 31) + 32 * hi_, p0 = 2 * (c >> 5);
        WRH[((((size_t)it * 4 + p0) * 2 + st) * 64 + ln) * 8 + e] = (bf16_t)h;
        WRH[((((size_t)it * 4 + p0 + 1) * 2 + st) * 64 + ln) * 8 + e] = (bf16_t)f2bf(v - __builtin_bit_cast(float, h << 16)); (void)WRL;
    }
    if (gw < 64) {
        const int c = gw; float s1 = 0.f, s2 = 0.f;
        for (int k = F.lane; k < DM; k += 64) { const float w = c < 32 ? wsb[(size_t)k * NEXP + c] : (c < 36 ? wg[(size_t)k * 4 + (c - 32)] : 0.f); s1 += g1[k] * w; s2 += b1[k] * w; }
        s1 = wave_sum(s1); s2 = wave_sum(s2);
        const float bias = c < 32 ? F.in[17][(size_t)l * NEXP + c] : (c < 36 ? F.in[15][(size_t)l * 4 + (c - 32)] : 0.f);
        if (F.lane == 0) { WRC[c] = s1; WRC[64 + c] = s2 + bias; }
    }
}

__device__ __forceinline__ void ln_row(f32x4 (&v)[4], const f32x4 (&g)[4], const f32x4 (&b)[4], float* omean = nullptr, float* orstd = nullptr) {
    float s = 0.f;
#pragma unroll
    for (int j = 0; j < 4; ++j) s += (v[j].x + v[j].y) + (v[j].z + v[j].w);
    const float mean = wave_sum(s) * (1.f / DM); float s2 = 0.f;
#pragma unroll
    for (int j = 0; j < 4; ++j) { v[j] = v[j] - mean; s2 += (v[j].x * v[j].x + v[j].y * v[j].y) + (v[j].z * v[j].z + v[j].w * v[j].w); }
    const float rstd = 1.0f / sqrtf(wave_sum(s2) * (1.f / DM) + LN_EPS);
#pragma unroll
    for (int j = 0; j < 4; ++j) v[j] = v[j] * rstd * g[j] + b[j];
    if (omean) { *omean = mean; *orstd = rstd; }
}
__device__ __forceinline__ void store_row(const f32x4 (&v)[4], float* orow, unsigned char* brow, int lane) {
#pragma unroll
    for (int j = 0; j < 4; ++j) {
        ((f32x4*)orow)[lane + 64 * j] = v[j];
        ((unsigned*)brow)[lane + 64 * j] = pk4_fp8(v[j].x * 16.f, v[j].y * 16.f, v[j].z * 16.f, v[j].w * 16.f);
    }
}

__device__ __forceinline__ void phase_ln1_router(Frame& F, int l, const float* src, bool scale_alpha) {
    PHASE_IDS(F);
    const int lane = F.lane, hi = lane >> 5, r32 = lane & 31;
    const float* lg = F.in[12] + (size_t)l * DM; const float* lb = F.in[13] + (size_t)l * DM;
    f32x4 g[4], b[4];
#pragma unroll
    for (int j = 0; j < 4; ++j) { g[j] = ((const f32x4*)lg)[lane + 64 * j]; b[j] = ((const f32x4*)lb)[lane + 64 * j]; }
    unsigned char* XB = F.ws + WS_XB8;
    const bf16_t* WRH = (const bf16_t*)(F.ws + WS_WR); const bf16_t* WRL = (const bf16_t*)(F.ws + WS_WR + 128 * 1024);
    const float* WRC = (const float*)(F.ws + WS_WR + 256 * 1024); float* stats = (float*)(F.ws + WS_WR + 512 * 1024);
    unsigned* misc = (unsigned*)(F.ws + WS_MISC);
    int* route = (int*)(F.ws + WS_ROUTE);
    LAS unsigned* hist = (LAS unsigned*)(F.lds + L_HIST);
    const float sc = scale_alpha ? ALPHA : 1.0f;
    for (int blk = F.vcu; blk < TT / 256; blk += F.G) {
        if (F.tid < 32) hist[F.tid] = 0u;
        __syncthreads();
        const int row0 = blk * 256 + F.wave * 32;
        float mu_l = 0.f, rs_l = 1.f;
        for (int i = 0; i < 32; i += 2) {
            f32x4 v0[4], v1[4];
            const f32x4* p0 = (const f32x4*)(src + (size_t)(row0 + i) * DM); const f32x4* p1 = (const f32x4*)(src + (size_t)(row0 + i + 1) * DM);
#pragma unroll
            for (int j = 0; j < 4; ++j) { v0[j] = p0[lane + 64 * j] * sc; v1[j] = p1[lane + 64 * j] * sc; }
            float m0, r0, m1, r1;
            ln_row(v0, g, b, &m0, &r0); ln_row(v1, g, b, &m1, &r1);
            mu_l = (r32 == i) ? m0 : ((r32 == i + 1) ? m1 : mu_l); rs_l = (r32 == i) ? r0 : ((r32 == i + 1) ? r1 : rs_l);
#pragma unroll
            for (int j = 0; j < 4; ++j) {
                ((unsigned*)(XB + (size_t)(row0 + i) * DM))[lane + 64 * j] = pk4_fp8(v0[j].x * 16.f, v0[j].y * 16.f, v0[j].z * 16.f, v0[j].w * 16.f);
                ((unsigned*)(XB + (size_t)(row0 + i + 1) * DM))[lane + 64 * j] = pk4_fp8(v1[j].x * 16.f, v1[j].y * 16.f, v1[j].z * 16.f, v1[j].w * 16.f); }
        }
        if (hi == 0) *(f32x2*)(stats + (size_t)(row0 + r32) * 2) = (f32x2){mu_l, rs_l};
        f32x16 acc0 = {}, acc1 = {};
        {
            const bf16_t* WT = WRH; (void)WRL;
            LAS float* xs = (LAS float*)(F.lds + F.wave * 9216);
            const float* xg = src + (size_t)(row0 + (lane >> 3)) * DM + (lane & 7) * 4;
            f32x4 xv[4]; bf16x8 wv[8];
#pragma unroll
            for (int i = 0; i < 4; ++i) xv[i] = *(const f32x4*)(xg + (size_t)(8 * i) * DM);
#pragma unroll
            for (int q = 0; q < 8; ++q) wv[q] = *(const bf16x8*)(WT + ((size_t)q * 64 + lane) * 8);
#pragma unroll 2
            for (int it = 0; it < 32; ++it) {
                LAS float* xb = xs + (it & 1) * 1152;
#pragma unroll
                for (int i = 0; i < 4; ++i) *(LAS f32x4*)(xb + ((lane >> 3) + 8 * i) * 36 + (lane & 7) * 4) = xv[i];
                bf16x8 wc[8];
#pragma unroll
                for (int q = 0; q < 8; ++q) wc[q] = wv[q];
                { const int nx = it + 1 < 32 ? it + 1 : 31;
#pragma unroll
                  for (int i = 0; i < 4; ++i) xv[i] = *(const f32x4*)(xg + (size_t)(8 * i) * DM + nx * 32);
#pragma unroll
                  for (int q = 0; q < 8; ++q) wv[q] = *(const bf16x8*)(WT + (((size_t)nx * 8 + q) * 64 + lane) * 8); }
                f32x4 xa[4];
#pragma unroll
                for (int j = 0; j < 4; ++j) xa[j] = *(const LAS f32x4*)(xb + r32 * 36 + hi * 16 + 4 * j);
#pragma unroll
                for (int st = 0; st < 2; ++st) {
                    const f32x4 x0 = xa[2 * st], x1 = xa[2 * st + 1];
                    u32x4 xh, xl;
                    xh.x = cvt_pk_bf16(x0[0], x0[1]); xh.y = cvt_pk_bf16(x0[2], x0[3]); xh.z = cvt_pk_bf16(x1[0], x1[1]); xh.w = cvt_pk_bf16(x1[2], x1[3]);
                    xl.x = cvt_pk_bf16(x0[0] - bflo(xh.x), x0[1] - bfhi(xh.x)); xl.y = cvt_pk_bf16(x0[2] - bflo(xh.y), x0[3] - bfhi(xh.y));
                    xl.z = cvt_pk_bf16(x1[0] - bflo(xh.z), x1[1] - bfhi(xh.z)); xl.w = cvt_pk_bf16(x1[2] - bflo(xh.w), x1[3] - bfhi(xh.w));
                    const bf16x8 xhv = __builtin_bit_cast(bf16x8, xh), xlv = __builtin_bit_cast(bf16x8, xl);
                    acc0 = __builtin_amdgcn_mfma_f32_32x32x16_bf16(wc[0 + st], xhv, acc0, 0, 0, 0); acc1 = __builtin_amdgcn_mfma_f32_32x32x16_bf16(wc[4 + st], xhv, acc1, 0, 0, 0);
                    acc0 = __builtin_amdgcn_mfma_f32_32x32x16_bf16(wc[2 + st], xhv, acc0, 0, 0, 0); acc1 = __builtin_amdgcn_mfma_f32_32x32x16_bf16(wc[6 + st], xhv, acc1, 0, 0, 0);
                    acc0 = __builtin_amdgcn_mfma_f32_32x32x16_bf16(wc[0 + st], xlv, acc0, 0, 0, 0); acc1 = __builtin_amdgcn_mfma_f32_32x32x16_bf16(wc[4 + st], xlv, acc1, 0, 0, 0);
                }
            }
        }
        float gl[4];
#pragma unroll
        for (int i = 0; i < 4; ++i) gl[i] = rs_l * (acc1[i] - mu_l * WRC[32 + i]) + WRC[64 + 32 + i];
        int gidx = 0; float gmax = gl[0];
#pragma unroll
        for (int i = 1; i < 4; ++i) if (gl[i] > gmax) { gmax = gl[i]; gidx = i; }
        float gsum = 0.f;
#pragma unroll
        for (int i = 0; i < 4; ++i) gsum += fast_exp(gl[i] - gmax);
        float gp = 1.0f / gsum;
        gidx = __shfl(gidx, r32); gp = __shfl(gp, r32);
        float cv[4];
#pragma unroll
        for (int i = 0; i < 4; ++i) {
            const float a = gidx == 0 ? acc0[i] : gidx == 1 ? acc0[4 + i] : gidx == 2 ? acc0[8 + i] : acc0[12 + i];
            cv[i] = rs_l * (a - mu_l * WRC[8 * gidx + 4 * hi + i]) + WRC[64 + 8 * gidx + 4 * hi + i];
        }
        float v1 = cv[0]; int i1 = 0;
#pragma unroll
        for (int i = 1; i < 4; ++i) if (cv[i] > v1) { v1 = cv[i]; i1 = i; }
        float v2 = -INFINITY; int i2 = 0;
#pragma unroll
        for (int i = 0; i < 4; ++i) if (i != i1 && cv[i] > v2) { v2 = cv[i]; i2 = i; }
        i1 += 4 * hi; i2 += 4 * hi;
        const float pv1 = __shfl_xor(v1, 32), pv2 = __shfl_xor(v2, 32); const int pi1 = __shfl_xor(i1, 32), pi2 = __shfl_xor(i2, 32);
        auto better = [](float av, int ai, float bv, int bi) { return av > bv || (av == bv && ai < bi); };
        float fv, sv; int fi, si;
        if (better(v1, i1, pv1, pi1)) { fv = v1; fi = i1; if (better(v2, i2, pv1, pi1)) { sv = v2; si = i2; } else { sv = pv1; si = pi1; } }
        else { fv = pv1; fi = pi1; if (better(v1, i1, pv2, pi2)) { sv = v1; si = i1; } else { sv = pv2; si = pi2; } }
        const float d = fast_exp(sv - fv), inv = 1.0f / (1.0f + d);
        const float w1 = gp * inv, w2 = gp * d * inv;
        const int e1 = 8 * gidx + fi, e2 = 8 * gidx + si;
        if (hi == 0) {
            *(int4*)(route + (size_t)(row0 + r32) * 4) = make_int4(e1, e2, __float_as_int(w1), __float_as_int(w2));
            atomicAdd((unsigned*)&hist[e1], 1u); atomicAdd((unsigned*)&hist[e2], 1u);
        }
        __syncthreads();
        if (F.tid < 32) misc[MI_BLOCKCNT + blk * 32 + F.tid] = hist[F.tid];
        __syncthreads();
    }
}

__device__ __forceinline__ void phase_moe_scatter(Frame& F) {
    PHASE_IDS(F);
    unsigned* misc = (unsigned*)(F.ws + WS_MISC);
    const int* route = (const int*)(F.ws + WS_ROUTE);
    int* rpos = (int*)(F.ws + WS_RPOS); int* rowtok = (int*)(F.ws + WS_ROWTOK);
    LAS unsigned* tot = (LAS unsigned*)(F.lds + L_TOT); LAS unsigned* pre = (LAS unsigned*)(F.lds + L_PRE);
    LAS unsigned* base = (LAS unsigned*)(F.lds + L_BASE); LAS unsigned* rank = (LAS unsigned*)(F.lds + L_RANK);
    for (int blk = F.vcu; blk < TT / 256; blk += F.G) {
        {
            if (F.tid < 32) { tot[F.tid] = 0u; pre[F.tid] = 0u; rank[F.tid] = 0u; }
            __syncthreads();
            const int e = F.tid & 31, part = F.tid >> 5; unsigned cv[16];
#pragma unroll
            for (int i = 0; i < 16; ++i) cv[i] = misc[MI_BLOCKCNT + (part * 16 + i) * 32 + e];
            unsigned t = 0, p = 0;
#pragma unroll
            for (int i = 0; i < 16; ++i) { t += cv[i]; p += (part * 16 + i < blk) ? cv[i] : 0u; }
            atomicAdd((unsigned*)&tot[e], t); atomicAdd((unsigned*)&pre[e], p);
        }
        __syncthreads();
        if (F.tid == 0) { unsigned a = 0; for (int e = 0; e < NEXP; ++e) { base[e] = a; a += (tot[e] + 255u) & ~255u; } base[NEXP] = a; }
        __syncthreads();
        {
            const int tok = blk * 256 + (F.tid >> 1), slot = F.tid & 1;
            const int e = route[(size_t)tok * 4 + slot];
            const unsigned r = atomicAdd((unsigned*)&rank[e], 1u);
            const unsigned pos = base[e] + pre[e] + r;
            rowtok[pos] = tok; rpos[(size_t)tok * 2 + slot] = (int)pos;
        }
        if (blk < NEXP) {
            const int e = blk; const unsigned end = base[e] + tot[e], nxt = base[e + 1];
            for (unsigned p = end + F.tid; p < nxt; p += NTHREADS) rowtok[p] = 0;
            for (unsigned p = base[e] / 256 + F.tid; p < nxt / 256; p += NTHREADS) misc[MI_PANEL_E + p] = (unsigned)e;
        }
        if (blk == 0 && F.tid == 0) misc[MI_NPAN] = base[NEXP] / 256;
        __syncthreads();
    }
}

struct MoeSched1 {
    static constexpr bool GATHER = true;
    const bf16_t* A; const bf16_t* W; int lda, ldb, ntot, G, c; const LAS int* rows; const LAS int* pe; int sw8, sa8;
    __device__ __forceinline__ bool next(int i, pg8::Unit& u) const { const int v = i * G + c; if (v >= ntot) return false; u.pm = v >> 1; u.pn = v & 1; u.ord = i; return true; }
    __device__ __forceinline__ const char* a_base(const pg8::Unit&) const { return (const char*)A; }
    __device__ __forceinline__ const char* b_base(const pg8::Unit& u) const { return (const char*)(W + (size_t)pe[u.ord] * 512 * ldb + (size_t)u.pn * 256 * ldb); }
    __device__ __forceinline__ void a_off(const pg8::Unit& u, const int (&R)[2], const int (&C)[2], unsigned (&v)[2][2]) const {
#pragma unroll
        for (int h = 0; h < 2; ++h)
#pragma unroll
            for (int i = 0; i < 2; ++i) v[h][i] = (unsigned)(rows[u.ord * 256 + h * 128 + R[i]] * lda + C[i]) * 2u;
    }
};
struct MoeSched2 {
    static constexpr bool GATHER = false;
    const bf16_t* A; const bf16_t* W; int lda, ldb, ntot, G, c; const LAS int* pe; int sw8, sa8;
    __device__ __forceinline__ bool next(int i, pg8::Unit& u) const { const int v = i * G + c; if (v >= ntot) return false; u.pm = v >> 2; u.pn = v & 3; u.ord = i; return true; }
    __device__ __forceinline__ const char* a_base(const pg8::Unit& u) const { return (const char*)(A + (size_t)u.pm * 256 * lda); }
    __device__ __forceinline__ const char* b_base(const pg8::Unit& u) const { return (const char*)(W + (size_t)pe[u.ord] * DM * ldb + (size_t)u.pn * 256 * ldb); }
    __device__ __forceinline__ void a_off(const pg8::Unit&, const int (&R)[2], const int (&C)[2], unsigned (&v)[2][2]) const {
#pragma unroll
        for (int i = 0; i < 2; ++i) { v[0][i] = (unsigned)(R[i] * lda + C[i]) * 2u; v[1][i] = (unsigned)((128 + R[i]) * lda + C[i]) * 2u; }
    }
};
struct EpiSwiGLU {
    bf16_t* H;
    __device__ __forceinline__ void operator()(const f32x4 (&acc)[2][2][4][2], const pg8::Unit& u, int wr, int wc, int fr, int fq) const {
        const int row0 = u.pm * 256 + wr * 64 + fr, col0 = u.pn * 128 + wc * 16 + 4 * fq;
#pragma unroll
        for (int ai = 0; ai < 2; ++ai)
#pragma unroll
            for (int m = 0; m < 4; ++m) { bf16_t* rowp = H + (size_t)(row0 + ai * 128 + m * 16) * DEXP + col0;
#pragma unroll
                for (int bj = 0; bj < 2; ++bj) { const f32x4 v0 = acc[ai][bj][m][0], v1 = acc[ai][bj][m][1];
                    const float h0 = v0[0] * sigmoidf_(v0[0]) * v0[1], h1 = v0[2] * sigmoidf_(v0[2]) * v0[3], h2 = v1[0] * sigmoidf_(v1[0]) * v1[1], h3 = v1[2] * sigmoidf_(v1[2]) * v1[3];
                    *(unsigned*)((unsigned char*)H + (size_t)(row0 + ai * 128 + m * 16) * DEXP + col0 + bj * 64) = pk4_fp8(h0 * 16.f, h1 * 16.f, h2 * 16.f, h3 * 16.f); (void)rowp; } }
    }
};
struct EpiStoreBf16 {
    bf16_t* O; int ldc;
    __device__ __forceinline__ void operator()(const f32x4 (&acc)[2][2][4][2], const pg8::Unit& u, int wr, int wc, int fr, int fq) const {
        const int row0 = u.pm * 256 + wr * 64 + fr, col0 = u.pn * 256 + wc * 32 + 8 * fq;
#pragma unroll
        for (int ai = 0; ai < 2; ++ai)
#pragma unroll
            for (int m = 0; m < 4; ++m) { bf16_t* rowp = O + (size_t)(row0 + ai * 128 + m * 16) * ldc + col0;
#pragma unroll
                for (int bj = 0; bj < 2; ++bj) store8_fp8((unsigned char*)O + (size_t)(row0 + ai * 128 + m * 16) * ldc + col0 + bj * 128, acc[ai][bj][m][0], acc[ai][bj][m][1], 64.f); (void)rowp; }
    }
};

__device__ __forceinline__ void phase_moe_gemm1(Frame& F) {
    PHASE_IDS(F);
    const unsigned* misc = (const unsigned*)(F.ws + WS_MISC);
    const int* rowtok = (const int*)(F.ws + WS_ROWTOK);
    const int npan = (int)misc[MI_NPAN];
    LAS int* rows = (LAS int*)(F.lds + L_ROWS); LAS int* pe = (LAS int*)(F.lds + L_PE);
    const int c = (int)blockIdx.x, ntot = npan * 2;
    for (int i = 0; i * F.G + c < ntot && i < 8; ++i) { const int p = (i * F.G + c) >> 1;
        if (F.tid < 256) rows[i * 256 + F.tid] = rowtok[p * 256 + F.tid];
        if (F.tid == 256) pe[i] = (int)misc[MI_PANEL_E + p]; }
    VM_WAIT(); LDS_WAIT(); __syncthreads();
    MoeSched1 S{(const bf16_t*)(F.ws + WS_XB8), (const bf16_t*)(F.ws + WS_W13), DM / 2, DM / 2, ntot, F.G, c, rows, pe, F8_SW, F8_SA_X};
    EpiSwiGLU E{(bf16_t*)(F.ws + WS_H)};
    pg8::gemm_phase<EpiSwiGLU, MoeSched1, true, true>(F.lds, DM / 2, S, E);
}
__device__ __forceinline__ void phase_moe_gemm2(Frame& F) {
    PHASE_IDS(F);
    const unsigned* misc = (const unsigned*)(F.ws + WS_MISC);
    const int npan = (int)misc[MI_NPAN];
    LAS int* pe = (LAS int*)(F.lds + L_PE);
    const int c = (int)blockIdx.x, ntot = npan * 4;
    __syncthreads();
    if (F.tid < 16) { const int v = F.tid * F.G + c; if (v < ntot) pe[F.tid] = (int)misc[MI_PANEL_E + (v >> 2)]; }
    VM_WAIT(); LDS_WAIT(); __syncthreads();
    MoeSched2 S{(const bf16_t*)(F.ws + WS_H), (const bf16_t*)(F.ws + WS_W2), DEXP / 2, DEXP / 2, ntot, F.G, c, pe, F8_SW, 127 - 4};
    EpiStoreBf16 E{(bf16_t*)(F.ws + WS_Y), DM};
    int k2 = DEXP / 2; asm volatile("" : "+s"(k2));
    pg8::gemm_phase<EpiStoreBf16, MoeSched2, true, true>(F.lds, k2, S, E);
}

__device__ __forceinline__ void phase_combine_ln2(Frame& F, int l) {
    PHASE_IDS(F);
    const int lane = F.lane;
    const float* lg = F.in[21] + (size_t)l * DM; const float* lb = F.in[22] + (size_t)l * DM;
    f32x4 g[4], b[4];
#pragma unroll
    for (int j = 0; j < 4; ++j) { g[j] = ((const f32x4*)lg)[lane + 64 * j]; b[j] = ((const f32x4*)lb)[lane + 64 * j]; }
    const bf16_t* Y = (const bf16_t*)(F.ws + WS_Y);
    const float* l1g = F.in[12] + (size_t)l * DM; const float* l1b = F.in[13] + (size_t)l * DM; const float* stats = (const float*)(F.ws + WS_WR + 512 * 1024);
    f32x4 g1[4], b1[4];
#pragma unroll
    for (int j = 0; j < 4; ++j) { g1[j] = ((const f32x4*)l1g)[lane + 64 * j]; b1[j] = ((const f32x4*)l1b)[lane + 64 * j]; }
    const int* route = (const int*)(F.ws + WS_ROUTE); const int* rpos = (const int*)(F.ws + WS_RPOS);
    const int gw = F.vcu * NWAVES + F.wave, NGW = F.G * NWAVES;
    auto recs = [&](int r, int4& rt, int2& rp, f32x2& st) { rt = *(const int4*)(route + (size_t)r * 4); rp = *(const int2*)(rpos + (size_t)r * 2); st = *(const f32x2*)(stats + (size_t)r * 2); };
    auto rowload = [&](int r, const int2& rp, f32x4 (&x)[4], unsigned (&ya)[4], unsigned (&yc)[4]) {
        const f32x4* px = (const f32x4*)(F.out + (size_t)r * DM);
        const unsigned* y0 = (const unsigned*)((const unsigned char*)Y + (size_t)rp.x * DM); const unsigned* y1 = (const unsigned*)((const unsigned char*)Y + (size_t)rp.y * DM);
#pragma unroll
        for (int j = 0; j < 4; ++j) { x[j] = __builtin_nontemporal_load(px + lane + 64 * j); ya[j] = __builtin_nontemporal_load(y0 + lane + 64 * j); yc[j] = __builtin_nontemporal_load(y1 + lane + 64 * j); } };
    int4 rt_c, rt_n; int2 rp_c, rp_n; f32x2 st_c, st_n;
    recs(gw, rt_c, rp_c, st_c);
    { const int r1 = gw + NGW < TT ? gw + NGW : gw; recs(r1, rt_n, rp_n, st_n); }
    f32x4 xc[4]; unsigned yac[4], ycc[4];
    rowload(gw, rp_c, xc, yac, ycc);
    for (int row = gw; row < TT; row += NGW) {
        const int r1 = row + NGW < TT ? row + NGW : row, r2 = row + 2 * NGW < TT ? row + 2 * NGW : row;
        f32x4 xn[4]; unsigned yan[4], ycn[4];
        rowload(r1, rp_n, xn, yan, ycn);
        int4 rt_2; int2 rp_2; f32x2 st_2; recs(r2, rt_2, rp_2, st_2);
        const float w0 = __int_as_float(rt_c.z) * (1.f / 64.f), w1 = __int_as_float(rt_c.w) * (1.f / 64.f);
        f32x4 v[4];
#pragma unroll
        for (int j = 0; j < 4; ++j) {
            const f32x4 x = (xc[j] - st_c[0]) * st_c[1] * g1[j] + b1[j]; const unsigned a = yac[j], c = ycc[j];
            const f32x2 a01 = __builtin_amdgcn_cvt_pk_f32_fp8((int)a, false), a23 = __builtin_amdgcn_cvt_pk_f32_fp8((int)a, true), c01 = __builtin_amdgcn_cvt_pk_f32_fp8((int)c, false), c23 = __builtin_amdgcn_cvt_pk_f32_fp8((int)c, true);
            v[j].x = ALPHA * x.x + w0 * a01[0] + w1 * c01[0]; v[j].y = ALPHA * x.y + w0 * a01[1] + w1 * c01[1];
            v[j].z = ALPHA * x.z + w0 * a23[0] + w1 * c23[0]; v[j].w = ALPHA * x.w + w0 * a23[1] + w1 * c23[1];
        }
        ln_row(v, g, b);
#pragma unroll
        for (int j = 0; j < 4; ++j) __builtin_nontemporal_store(v[j], (f32x4*)(F.out + (size_t)row * DM) + lane + 64 * j);
        if (l == 0) {
#pragma unroll
            for (int j = 0; j < 4; ++j) ((unsigned*)(F.ws + WS_XB8 + (size_t)row * DM))[lane + 64 * j] = pk4_fp8(v[j].x * 16.f, v[j].y * 16.f, v[j].z * 16.f, v[j].w * 16.f);
        }
        rt_c = rt_n; rp_c = rp_n; st_c = st_n; rt_n = rt_2; rp_n = rp_2; st_n = st_2;
#pragma unroll
        for (int j = 0; j < 4; ++j) { xc[j] = xn[j]; yac[j] = yan[j]; ycc[j] = ycn[j]; }
    }
}

constexpr float C2D = 0.18033688011112042f;
constexpr float C2M = 0.14724444602590306f;
constexpr float IWS = 0.044194173824159216f;
constexpr float RMS_EPS = 1e-6f;
constexpr int L_QSLOT = L_CTL + 1152;

__device__ __forceinline__ int rope16(int c) { return c < 16 ? (c >> 1) + 8 * (c & 1) : c; }
__device__ __forceinline__ int win_src(int n, float& sc) {
    sc = 1.f;
    if (n < 384) return n;
    if (n < 416) { const int c = n - 384; return 384 + (c >> 1) + 16 * (c & 1); }
    if (n < 512) return -1;
    if (n < 2816) { const int m = n - 512, g = m / 768, r = m % 768, p = r >> 8, hh = (r & 255) >> 6, c = r & 63; if (p == 0) sc = C2D; return 416 + 768 * g + 256 * p + 64 * hh + (p < 2 ? rope16(c) : c); }
    if (n < 3328) { const int m = n - 2816; sc = C2D; return 2720 + (m & ~63) + rope16(m & 63); }
    if (n < 3840) { const int m = n - 3328; return 3360 + (m & ~63) + rope16(m & 63); }
    const int m = n - 3840;
    if (m < 64) return 3232 + rope16(m);
    if (m < 128) return 3296 + (m - 64);
    if (m < 192) return 3872 + rope16(m - 128);
    if (m < 200) { sc = IWS; return 3936 + (m - 192); }
    return -1;
}

__device__ __forceinline__ void sincos_d(double x, double& s, double& c) {
    const double n = __builtin_rint(x * 0.15915494309189535);
    double r = __builtin_fma(-n, 6.2831854820251465, x); r = __builtin_fma(n, 1.7484556025237907e-07, r);
    const double r2 = r * r; double ss = 1.0, cc = 1.0;
#pragma unroll
    for (int k = 15; k >= 1; --k) { ss = 1.0 - r2 * (1.0 / (double)((2 * k) * (2 * k + 1))) * ss; cc = 1.0 - r2 * (1.0 / (double)((2 * k - 1) * (2 * k))) * cc; }
    s = ss * r; c = cc;
}
__device__ __forceinline__ double inv_freq16(int i) {
    const double t[16] = {1.0, 0.44036660267178046, 0.19392274474868576, 0.08539710028576561, 0.03760603093086393, 0.016560440080994446, 0.007292664737217109, 0.003211445994752591,
                          0.001414213562373095, 0.000622772421914596, 0.0002742481756762073, 0.00012076973741146504, 5.318295896944988e-05, 2.341999896140934e-05, 1.031338537721246e-05, 4.5416704806078695e-06};
    double r = t[0];
#pragma unroll
    for (int k = 1; k < 16; ++k) r = (i == k) ? t[k] : r;
    return r;
}

__device__ __forceinline__ void phase_conv_mixer(Frame& F, int l) {
    PHASE_IDS(F);
    LAS float* scr = (LAS float*)(F.lds + F.wave * 16384);
    const int gw = F.vcu * NWAVES + F.wave, NGW = F.G * NWAVES;
    const float* win = F.in[1] + (size_t)l * DM * CIN;
    const float* qg = F.in[2] + (size_t)l * 256; const float* wuq = F.in[3] + (size_t)l * 256 * 768;
    const float* kg = F.in[4] + (size_t)l * 128; const float* wukv = F.in[5] + (size_t)l * 128 * 1024;
    const float* wgate = F.in[6] + (size_t)l * DM * 3072;
    const float* wa = F.in[8] + (size_t)l * 512 * DM; const float* wb = F.in[9] + (size_t)l * 256 * DM; const float* wc = F.in[10] + (size_t)l * 512 * DM; const float* wo = F.in[11] + (size_t)l * DM * DM;
    unsigned char* WIN8 = F.ws + WS_WIN8; bf16_t* WUQ = (bf16_t*)(F.ws + WS_WUQ); bf16_t* WUKV = (bf16_t*)(F.ws + WS_WUKV);
    bf16_t* WA = (bf16_t*)(F.ws + WS_WA); bf16_t* WB = (bf16_t*)(F.ws + WS_WB); bf16_t* WC = (bf16_t*)(F.ws + WS_WC); bf16_t* WO = (bf16_t*)(F.ws + WS_WO);
    constexpr int I_IN = 16 * 128, I_G = 16 * 96, I_UQ = 4 * 24, I_UKV = 4 * 32, I_A = 8 * 32, I_B = 8 * 32, I_C = 8 * 32, I_O = 16 * 32;
    constexpr int NIT = I_IN + I_G + I_UQ + I_UKV + I_A + I_B + I_C + I_O;
    for (int it = gw; it < NIT; it += NGW) {
        int r = it;
        if (r < I_IN) { conv_item8(WIN8, DM, (r / 128) * 64, (r % 128) * 32, scr, F.lane, [&](int k, int n) { float sc; const int sidx = win_src(n, sc); return sidx < 0 ? 0.f : win[(size_t)k * CIN + sidx] * (sc * 1024.f); }); continue; } r -= I_IN;
        if (r < I_G) { conv_plain8(WIN8 + (size_t)PW * DM, DM, (r / 96) * 64, (r % 96) * 32, scr, F.lane, wgate, 3072, 1024.f); continue; } r -= I_G;
        if (r < I_UQ) { conv_item(WUQ, 256, (r / 24) * 64, (r % 24) * 32, scr, F.lane, [&](int k, int n) { const int hh = n / 96, c = n % 96; const int o = c < 64 ? c : 64 + ((c - 64) >> 1) + 16 * ((c - 64) & 1);
                return qg[k] * wuq[(size_t)k * 768 + hh * 96 + o] * C2M; }); continue; } r -= I_UQ;
        if (r < I_UKV) { conv_item(WUKV, 256, (r / 32) * 64, (r % 32) * 32, scr, F.lane, [&](int k, int n) { return k < 128 ? kg[k] * wukv[(size_t)k * 1024 + n] : 0.f; }); continue; } r -= I_UKV;
        if (r < I_A) { conv_plain8((unsigned char*)WA, 512, (r / 32) * 64, (r % 32) * 32, scr, F.lane, wa, DM, 1024.f); continue; } r -= I_A;
        if (r < I_B) { conv_item8((unsigned char*)WB, 512, (r / 32) * 64, (r % 32) * 32, scr, F.lane, [&](int k, int n) { return k < 256 ? wb[(size_t)k * DM + n] * 1024.f : 0.f; }); continue; } r -= I_B;
        if (r < I_C) { conv_plain8((unsigned char*)WC, 512, (r / 32) * 64, (r % 32) * 32, scr, F.lane, wc, DM, 1024.f); continue; } r -= I_C;
        conv_plain8((unsigned char*)WO, DM, (r / 32) * 64, (r % 32) * 32, scr, F.lane, wo, DM, 1024.f);
    }
    if (l == 0) {
        float* rp = (float*)(F.ws + WS_ROPE); float* rm = rp + 2048 * 8 * 2;
        for (int idx = F.vcu * NTHREADS + F.tid; idx < 2048 * 24; idx += F.G * NTHREADS) {
            const int t = idx / 24, j = idx % 24; double sn, cs;
            if (j < 8) { sincos_d((double)t * inv_freq16(2 * j), sn, cs); rp[(t * 8 + j) * 2] = (float)cs; rp[(t * 8 + j) * 2 + 1] = (float)sn; }
            else { sincos_d((double)t * inv_freq16(j - 8), sn, cs); rm[(t * 16 + (j - 8)) * 2] = (float)cs; rm[(t * 16 + (j - 8)) * 2 + 1] = (float)sn; }
        }
        const f32x4* x4 = (const f32x4*)F.in[0]; unsigned* xb8 = (unsigned*)(F.ws + WS_XB8);
        for (size_t i = (size_t)F.vcu * NTHREADS + F.tid; i < (size_t)TT * DM / 4; i += (size_t)F.G * NTHREADS) { const f32x4 v = x4[i] * 16.f; xb8[i] = pk4_fp8(v.x, v.y, v.z, v.w); }
    }
}

__device__ __forceinline__ void rope4(f32x4& v0, f32x4& v1, const float* cs) {
    const f32x4 a = *(const f32x4*)cs, b = *(const f32x4*)(cs + 4);
    const f32x4 w0 = {v0[0] * a[0] - v0[1] * a[1], v0[1] * a[0] + v0[0] * a[1], v0[2] * a[2] - v0[3] * a[3], v0[3] * a[2] + v0[2] * a[3]};
    const f32x4 w1 = {v1[0] * b[0] - v1[1] * b[1], v1[1] * b[0] + v1[0] * b[1], v1[2] * b[2] - v1[3] * b[3], v1[3] * b[2] + v1[2] * b[3]};
    v0 = w0; v1 = w1;
}
__device__ __forceinline__ void store8(bf16_t* p, const f32x4& v0, const f32x4& v1) {
    u32x4 w; w.x = cvt_pk_bf16(v0[0], v0[1]); w.y = cvt_pk_bf16(v0[2], v0[3]); w.z = cvt_pk_bf16(v1[0], v1[1]); w.w = cvt_pk_bf16(v1[2], v1[3]); *(u32x4*)p = w;
}
struct EpiProj {
    bf16_t* P; const float* csp; const float* csm; float* ssq; bf16_t* G3; const LAS float* gbias;
    __device__ __forceinline__ void operator()(const f32x4 (&acc)[2][2][4][2], const pg8::Unit& u, int wr, int wc, int fr, int fq) const {
        const int pn = u.pn, row0 = u.pm * 256 + wr * 64 + fr;
        if (pn >= 16) {
#pragma unroll
            for (int bj = 0; bj < 2; ++bj) { const int col = (pn - 16) * 256 + bj * 128 + wc * 32 + fq * 8;
                const f32x4 b0 = *(const LAS f32x4*)(gbias + col), b1 = *(const LAS f32x4*)(gbias + col + 4);
#pragma unroll
                for (int ai = 0; ai < 2; ++ai)
#pragma unroll
                    for (int m = 0; m < 4; ++m) { f32x4 v0 = acc[ai][bj][m][0] + b0, v1 = acc[ai][bj][m][1] + b1;
#pragma unroll
                        for (int e = 0; e < 4; ++e) { v0[e] = sigmoidf_(v0[e]); v1[e] = sigmoidf_(v1[e]); }
                        store8_fp8((unsigned char*)G3 + (size_t)(row0 + ai * 128 + m * 16) * 3072 + col, v0, v1, 64.f); } }
            return;
        }
#pragma unroll
        for (int bj = 0; bj < 2; ++bj) {
            const int wcu = __builtin_amdgcn_readfirstlane(wc);
            bool ropeP = false, ropeM = false;
            if (pn == 1) ropeM = (bj == 1 && wcu == 0);
            else if (pn >= 2 && pn < 11) ropeP = ((pn - 2) % 3) < 2 && !(wcu & 1);
            else if (pn >= 11 && pn < 15) ropeP = !(wcu & 1);
            else if (pn == 15) ropeP = (wcu == 0);
            const int col = pn * 256 + bj * 128 + wc * 32 + fq * 8;
            if (ropeP || ropeM) {
                const bool lr = ropeM || fq < 2;
                const float* cb = ropeM ? csm + 8 * fq : csp + 8 * (fq & 1);
                const int ts = ropeM ? 32 : 16;
#pragma unroll
                for (int ai = 0; ai < 2; ++ai)
#pragma unroll
                    for (int mh = 0; mh < 2; ++mh) {
                        f32x4 ca[2], cc[2];
#pragma unroll
                        for (int mm = 0; mm < 2; ++mm) { const int t = (row0 + ai * 128 + (2 * mh + mm) * 16) & (SEQ - 1);
                            ca[mm] = *(const f32x4*)(cb + t * ts); cc[mm] = *(const f32x4*)(cb + t * ts + 4); }
#pragma unroll
                        for (int mm = 0; mm < 2; ++mm) { const int m = 2 * mh + mm, row = row0 + ai * 128 + m * 16;
                            const f32x4 v0 = acc[ai][bj][m][0], v1 = acc[ai][bj][m][1];
                            f32x4 a = ca[mm], b = cc[mm];
                            if (!lr) { a = (f32x4){1.f, 0.f, 1.f, 0.f}; b = a; }
                            const f32x4 w0 = {v0[0] * a[0] - v0[1] * a[1], v0[1] * a[0] + v0[0] * a[1], v0[2] * a[2] - v0[3] * a[3], v0[3] * a[2] + v0[2] * a[3]};
                            const f32x4 w1 = {v1[0] * b[0] - v1[1] * b[1], v1[1] * b[0] + v1[0] * b[1], v1[2] * b[2] - v1[3] * b[3], v1[3] * b[2] + v1[2] * b[3]};
                            store8(P + (size_t)row * PW + col, w0, w1); }
                    }
            } else {
#pragma unroll
                for (int ai = 0; ai < 2; ++ai)
#pragma unroll
                    for (int m = 0; m < 4; ++m)
                        store8(P + (size_t)(row0 + ai * 128 + m * 16) * PW + col, acc[ai][bj][m][0], acc[ai][bj][m][1]);
            }
        }
        if (pn < 2) {
#pragma unroll
            for (int ai = 0; ai < 2; ++ai)
#pragma unroll
                for (int m = 0; m < 4; ++m) {
                    float sq = 0.f;
#pragma unroll
                    for (int bj = 0; bj < 2; ++bj) if (pn == 0 || bj == 0) {
#pragma unroll
                        for (int n = 0; n < 2; ++n) { const f32x4 x = acc[ai][bj][m][n]; sq += (x[0] * x[0] + x[1] * x[1]) + (x[2] * x[2] + x[3] * x[3]); } }
                    sq += __shfl_xor(sq, 16); sq += __shfl_xor(sq, 32);
                    if (fq == 0) ssq[(size_t)(row0 + ai * 128 + m * 16) * 8 + pn * 4 + wc] = sq;
                }
        }
    }
};
struct EpiUpQ {
    bf16_t* Q; const float* csm; const float* ssq;
    __device__ __forceinline__ void operator()(const f32x4 (&acc)[2][2][4][2], const pg8::Unit& u, int wr, int wc, int fr, int fq) const {
        const int row0 = u.pm * 256 + wr * 64 + fr;
        f32x4 spv[2][4];
#pragma unroll
        for (int ai = 0; ai < 2; ++ai)
#pragma unroll
            for (int m = 0; m < 4; ++m) spv[ai][m] = *(const f32x4*)(ssq + (size_t)(row0 + ai * 128 + m * 16) * 8);
#pragma unroll
        for (int ai = 0; ai < 2; ++ai)
#pragma unroll
            for (int m = 0; m < 4; ++m) { const f32x4 sp = spv[ai][m];
                spv[ai][m][0] = 1.0f / sqrtf(((sp[0] + sp[1]) + (sp[2] + sp[3])) * (1.f / 256.f) + RMS_EPS); }
        const int wcu = __builtin_amdgcn_readfirstlane(wc);
#pragma unroll
        for (int bj = 0; bj < 2; ++bj) {
            const int c0 = u.pn * 256 + bj * 128 + wcu * 32, col = c0 + fq * 8;
            if (((c0 >> 5) % 3) == 2) {
#pragma unroll
                for (int ai = 0; ai < 2; ++ai)
#pragma unroll
                    for (int mh = 0; mh < 2; ++mh) {
                        f32x4 ca[2], cc[2];
#pragma unroll
                        for (int mm = 0; mm < 2; ++mm) { const int t = (row0 + ai * 128 + (2 * mh + mm) * 16) & (SEQ - 1);
                            ca[mm] = *(const f32x4*)(csm + t * 32 + 8 * fq); cc[mm] = *(const f32x4*)(csm + t * 32 + 8 * fq + 4); }
#pragma unroll
                        for (int mm = 0; mm < 2; ++mm) { const int m = 2 * mh + mm, row = row0 + ai * 128 + m * 16;
                            const float rs = spv[ai][m][0];
                            const f32x4 v0 = acc[ai][bj][m][0] * rs, v1 = acc[ai][bj][m][1] * rs, a = ca[mm], b = cc[mm];
                            const f32x4 w0 = {v0[0] * a[0] - v0[1] * a[1], v0[1] * a[0] + v0[0] * a[1], v0[2] * a[2] - v0[3] * a[3], v0[3] * a[2] + v0[2] * a[3]};
                            const f32x4 w1 = {v1[0] * b[0] - v1[1] * b[1], v1[1] * b[0] + v1[0] * b[1], v1[2] * b[2] - v1[3] * b[3], v1[3] * b[2] + v1[2] * b[3]};
                            store8(Q + (size_t)row * 768 + col, w0, w1); }
                    }
            } else {
#pragma unroll
                for (int ai = 0; ai < 2; ++ai)
#pragma unroll
                    for (int m = 0; m < 4; ++m) { const float rs = spv[ai][m][0];
                        store8(Q + (size_t)(row0 + ai * 128 + m * 16) * 768 + col, acc[ai][bj][m][0] * rs, acc[ai][bj][m][1] * rs); }
            }
        }
    }
};
struct EpiUpKV {
    bf16_t* KV; const float* ssq;
    __device__ __forceinline__ void operator()(const f32x4 (&acc)[2][2][4][2], const pg8::Unit& u, int wr, int wc, int fr, int fq) const {
        const int row0 = u.pm * 256 + wr * 64 + fr;
        f32x4 spv[2][4];
#pragma unroll
        for (int ai = 0; ai < 2; ++ai)
#pragma unroll
            for (int m = 0; m < 4; ++m) spv[ai][m] = *(const f32x4*)(ssq + (size_t)(row0 + ai * 128 + m * 16) * 8 + 4);
#pragma unroll
        for (int ai = 0; ai < 2; ++ai)
#pragma unroll
            for (int m = 0; m < 4; ++m) {
                const int row = row0 + ai * 128 + m * 16;
                const f32x4 sp = spv[ai][m];
                const float rs = 1.0f / sqrtf(((sp[0] + sp[1]) + (sp[2] + sp[3])) * (1.f / 128.f) + RMS_EPS);
#pragma unroll
                for (int bj = 0; bj < 2; ++bj) { const int col = u.pn * 256 + bj * 128 + wc * 32 + fq * 8;
                    store8(KV + (size_t)row * 1024 + col, acc[ai][bj][m][0] * rs, acc[ai][bj][m][1] * rs); }
            }
    }
};
struct EpiBranchAll {
    bf16_t* Mg; bf16_t* M0; bf16_t* M1; const bf16_t* G3;
    __device__ __forceinline__ void operator()(const f32x4 (&acc)[2][2][4][2], const pg8::Unit& u, int wr, int wc, int fr, int fq) const {
        const int row0 = u.pm * 256 + wr * 64 + fr, br = u.ord, col0 = u.pn * 256 + wc * 32 + fq * 8;
        bf16_t* dst = br == 0 ? M0 : (br == 1 ? M1 : Mg);
#pragma unroll
        for (int ai = 0; ai < 2; ++ai)
#pragma unroll
            for (int mh = 0; mh < 2; ++mh) {
                u32x2 gw[2][2]; u32x4 ma[2][2], mb[2][2];
#pragma unroll
                for (int mm = 0; mm < 2; ++mm)
#pragma unroll
                    for (int bj = 0; bj < 2; ++bj) { const int row = row0 + ai * 128 + (2 * mh + mm) * 16, col = col0 + bj * 128;
                        gw[mm][bj] = *(const u32x2*)((const unsigned char*)G3 + (size_t)row * 3072 + br * 1024 + col);
                        ma[mm][bj] = (u32x4){0u, 0u, 0u, 0u}; mb[mm][bj] = (u32x4){0u, 0u, 0u, 0u}; }
                if (br == 2) {
#pragma unroll
                    for (int mm = 0; mm < 2; ++mm)
#pragma unroll
                        for (int bj = 0; bj < 2; ++bj) { const size_t off = (size_t)(row0 + ai * 128 + (2 * mh + mm) * 16) * DM + col0 + bj * 128;
                            const u32x2 p = *(const u32x2*)((const unsigned char*)M0 + off), q = *(const u32x2*)((const unsigned char*)M1 + off);
                            ma[mm][bj] = (u32x4){p.x, p.y, 0u, 0u}; mb[mm][bj] = (u32x4){q.x, q.y, 0u, 0u}; }
                }
#pragma unroll
                for (int mm = 0; mm < 2; ++mm)
#pragma unroll
                    for (int bj = 0; bj < 2; ++bj) { const int m = 2 * mh + mm; const size_t off = (size_t)(row0 + ai * 128 + m * 16) * DM + col0 + bj * 128; const u32x2 g = gw[mm][bj]; const u32x4 a = ma[mm][bj], b2 = mb[mm][bj];
                        const f32x2 g01 = __builtin_amdgcn_cvt_pk_f32_fp8((int)g.x, false) * (1.f / 64.f), g23 = __builtin_amdgcn_cvt_pk_f32_fp8((int)g.x, true) * (1.f / 64.f);
                        const f32x2 g45 = __builtin_amdgcn_cvt_pk_f32_fp8((int)g.y, false) * (1.f / 64.f), g67 = __builtin_amdgcn_cvt_pk_f32_fp8((int)g.y, true) * (1.f / 64.f);
                        f32x4 v0 = acc[ai][bj][m][0], v1 = acc[ai][bj][m][1];
                        const f32x2 s01 = (__builtin_amdgcn_cvt_pk_f32_fp8((int)a.x, false) + __builtin_amdgcn_cvt_pk_f32_fp8((int)b2.x, false)) * (1.f / 64.f), s23 = (__builtin_amdgcn_cvt_pk_f32_fp8((int)a.x, true) + __builtin_amdgcn_cvt_pk_f32_fp8((int)b2.x, true)) * (1.f / 64.f);
                        const f32x2 s45 = (__builtin_amdgcn_cvt_pk_f32_fp8((int)a.y, false) + __builtin_amdgcn_cvt_pk_f32_fp8((int)b2.y, false)) * (1.f / 64.f), s67 = (__builtin_amdgcn_cvt_pk_f32_fp8((int)a.y, true) + __builtin_amdgcn_cvt_pk_f32_fp8((int)b2.y, true)) * (1.f / 64.f);
                        v0[0] = v0[0] * g01[0] + s01[0]; v0[1] = v0[1] * g01[1] + s01[1]; v0[2] = v0[2] * g23[0] + s23[0]; v0[3] = v0[3] * g23[1] + s23[1];
                        v1[0] = v1[0] * g45[0] + s45[0]; v1[1] = v1[1] * g45[1] + s45[1]; v1[2] = v1[2] * g67[0] + s67[0]; v1[3] = v1[3] * g67[1] + s67[1];
                        store8_fp8((unsigned char*)dst + off, v0, v1, 64.f); }
            }
    }
};
struct BranchSched {
    static constexpr bool GATHER = false; static constexpr bool VARK = true;
    const char* A0; const char* B0; size_t sA, sB; int lda, ldb, c, sw8, sa8, G, ntile;
    __device__ __forceinline__ int ktiles(const pg8::Unit& u) const { return u.ord == 1 ? 2 : 4; }
    __device__ __forceinline__ bool next(int i, pg8::Unit& u) const { const int t = c + (i / 3) * G; if (t >= ntile) return false; u.pm = t >> 2; u.pn = t & 3; u.ord = i % 3; return true; }
    __device__ __forceinline__ const char* a_base(const pg8::Unit& u) const { return A0 + (size_t)u.ord * sA + (size_t)u.pm * 256 * lda * 2; }
    __device__ __forceinline__ const char* b_base(const pg8::Unit& u) const { return B0 + (size_t)u.ord * sB + (size_t)u.pn * 256 * ldb * 2; }
    __device__ __forceinline__ void a_off(const pg8::Unit&, const int (&R)[2], const int (&C)[2], unsigned (&v)[2][2]) const {
#pragma unroll
        for (int i = 0; i < 2; ++i) { v[0][i] = (unsigned)(R[i] * lda + C[i]) * 2u; v[1][i] = (unsigned)((128 + R[i]) * lda + C[i]) * 2u; }
    }
};
struct EpiWo {
    float* out; const float* xsrc; int rowbase;
    __device__ __forceinline__ void operator()(const f32x4 (&acc)[2][2][4][2], const pg8::Unit& u, int wr, int wc, int fr, int fq) const {
        const int row0 = rowbase + u.pm * 256 + wr * 64 + fr, col0 = u.pn * 256 + wc * 32 + fq * 8;
#pragma unroll
        for (int ai = 0; ai < 2; ++ai)
#pragma unroll
            for (int mh = 0; mh < 2; ++mh) {
                f32x4 x[2][2][2];
#pragma unroll
                for (int mm = 0; mm < 2; ++mm)
#pragma unroll
                    for (int bj = 0; bj < 2; ++bj) { const size_t off = (size_t)(row0 + ai * 128 + (2 * mh + mm) * 16) * DM + col0 + bj * 128;
                        x[mm][bj][0] = *(const f32x4*)(xsrc + off); x[mm][bj][1] = *(const f32x4*)(xsrc + off + 4); }
#pragma unroll
                for (int mm = 0; mm < 2; ++mm)
#pragma unroll
                    for (int bj = 0; bj < 2; ++bj) { const size_t off = (size_t)(row0 + ai * 128 + (2 * mh + mm) * 16) * DM + col0 + bj * 128;
                        *(f32x4*)(out + off) = x[mm][bj][0] * ALPHA + acc[ai][bj][2 * mh + mm][0]; *(f32x4*)(out + off + 4) = x[mm][bj][1] * ALPHA + acc[ai][bj][2 * mh + mm][1]; }
            }
    }
};

__device__ __forceinline__ int dequeue(Frame& F, unsigned* ctr, int& pre) {
    LAS int* slot = (LAS int*)(F.lds + L_QSLOT);
    __syncthreads();
    if (F.tid == 0) {
        *slot = (int)__hip_atomic_fetch_add(ctr, 1u, __ATOMIC_RELAXED, __HIP_MEMORY_SCOPE_AGENT); (void)pre;
    }
    __syncthreads();
    return *slot;
}

namespace att {
constexpr int KSLOT = 12288, VSLOT = 8192, NSLOT = 4;
constexpr int A_K = 0, A_V = NSLOT * KSLOT, A_WS = A_V + NSLOT * VSLOT, A_OST = A_WS + 8 * 256, A_MW = A_OST + 8 * 4096, A_END = A_MW + 8 * NSLOT * 256;
static_assert(A_END <= RING_BYTES, "attention LDS");
typedef short s16x4 __attribute__((ext_vector_type(4)));
__device__ __forceinline__ int crow(int r, int hi) { return (r & 3) + 8 * (r >> 2) + 4 * hi; }
__device__ __forceinline__ void glds16(const void* gsrc, unsigned lds_dst) { unsigned keep;
    asm volatile("s_mov_b32 %0, m0\n\ts_mov_b32 m0, %2\n\ts_nop 0\n\tglobal_load_lds_dwordx4 %1, off\n\ts_mov_b32 m0, %0" : "=&s"(keep) : "v"(gsrc), "s"(lds_dst) : "memory"); }
__device__ __forceinline__ void glds4(const void* gsrc, unsigned lds_dst) { unsigned keep;
    asm volatile("s_mov_b32 %0, m0\n\ts_mov_b32 m0, %2\n\ts_nop 0\n\tglobal_load_lds_dword %1, off\n\ts_mov_b32 m0, %0" : "=&s"(keep) : "v"(gsrc), "s"(lds_dst) : "memory"); }
#define ATT_WAIT_BAR(N) asm volatile("s_waitcnt vmcnt(" #N ") lgkmcnt(0)\n\ts_barrier" ::: "memory")
__device__ __forceinline__ float emax(float a, float b) { return __builtin_elementwise_maximum(a, b); }
__device__ __forceinline__ float halfmax(float m) { auto rr = __builtin_amdgcn_permlane32_swap(__float_as_uint(m), __float_as_uint(m), false, false); return emax(__uint_as_float(rr[0]), __uint_as_float(rr[1])); }
__device__ __forceinline__ float halfsum(float m) { auto rr = __builtin_amdgcn_permlane32_swap(__float_as_uint(m), __float_as_uint(m), false, false); return __uint_as_float(rr[0]) + __uint_as_float(rr[1]); }
typedef short v4i16_t __attribute__((ext_vector_type(4)));
__device__ __forceinline__ s16x4 vtr(const LAS unsigned char* p) { return __builtin_bit_cast(s16x4, __builtin_amdgcn_ds_read_tr16_b64_v4i16((LAS v4i16_t*)p)); }
__device__ __forceinline__ void pv(f32x16* o, f32x16& lacc, const LAS unsigned char* vp, bf16x8 pa0, bf16x8 pa1, bf16x8 pa2, bf16x8 pa3) {
    { const u32x4 one4 = {0x3F803F80u, 0x3F803F80u, 0x3F803F80u, 0x3F803F80u}; const bf16x8 ones = __builtin_bit_cast(bf16x8, one4);
      lacc = __builtin_amdgcn_mfma_f32_32x32x16_bf16(pa0, ones, lacc, 0, 0, 0); lacc = __builtin_amdgcn_mfma_f32_32x32x16_bf16(pa1, ones, lacc, 0, 0, 0);
      lacc = __builtin_amdgcn_mfma_f32_32x32x16_bf16(pa2, ones, lacc, 0, 0, 0); lacc = __builtin_amdgcn_mfma_f32_32x32x16_bf16(pa3, ones, lacc, 0, 0, 0); }
#pragma unroll
    for (int d0 = 0; d0 < 2; ++d0) { s16x4 lo[4], hi[4];
#pragma unroll
        for (int ks = 0; ks < 4; ++ks) { lo[ks] = vtr(vp + d0 * 4096 + ks * 1024); hi[ks] = vtr(vp + d0 * 4096 + ks * 1024 + 512); }
#define ATT_PK(k) (bf16x8){lo[k][0], lo[k][1], lo[k][2], lo[k][3], hi[k][0], hi[k][1], hi[k][2], hi[k][3]}
        o[d0] = __builtin_amdgcn_mfma_f32_32x32x16_bf16(pa0, ATT_PK(0), o[d0], 0, 0, 0);
        o[d0] = __builtin_amdgcn_mfma_f32_32x32x16_bf16(pa1, ATT_PK(1), o[d0], 0, 0, 0);
        o[d0] = __builtin_amdgcn_mfma_f32_32x32x16_bf16(pa2, ATT_PK(2), o[d0], 0, 0, 0);
        o[d0] = __builtin_amdgcn_mfma_f32_32x32x16_bf16(pa3, ATT_PK(3), o[d0], 0, 0, 0);
#undef ATT_PK
    }
}
struct Desc {
    const bf16_t* Q; const bf16_t* K1; const bf16_t* K2; const bf16_t* V; bf16_t* O; float* lse; const unsigned* mask;
    int qpitch, k1pitch, k2pitch, vpitch, opitch, lsepitch;
    int rstride, q0, nq, jlo, jhi;
    int o8;
};
template <int DQK, int MODE, bool DUAL = false>
__device__ __forceinline__ void attn_unit(LAS unsigned char* lds, const Desc& d) {
    static_assert(!DUAL || (DQK == 64 && MODE == 0), "dual mode");
    constexpr int NSLOT = DUAL ? 2 : att::NSLOT, KSLOT = DUAL ? 8192 : att::KSLOT;
    constexpr int A_K = 0, A_V = DUAL ? 32768 : att::A_V, A_WS = DUAL ? 65536 : att::A_WS, A_OST = DUAL ? 67584 : att::A_OST, A_MW = att::A_MW;
    int tid_ = threadIdx.x; asm volatile("" : "+v"(tid_));
    const int tid = tid_, lane = tid & 63, r32 = lane & 31, hi = lane >> 5, wid = __builtin_amdgcn_readfirstlane(tid >> 6);
    constexpr int ND = DQK / 16;
    const unsigned lds0 = (unsigned)(size_t)lds;
    LAS float* wsf = (LAS float*)(lds + A_WS) + wid * 64;
    const int grp = DUAL ? (wid >> 2) : 0, w4 = DUAL ? (wid & 3) : wid, gofs = grp * 16384;
    Desc dd = d;
    if (DUAL) { dd.Q = d.Q + (size_t)grp * d.qpitch; dd.K1 = d.K1 + (size_t)grp * d.k1pitch; dd.V = d.V + (size_t)grp * d.vpitch; dd.O = d.O + (size_t)grp * d.opitch; if (d.lse) dd.lse = d.lse + (size_t)grp * d.lsepitch; }
    const Desc& d_ = dd;
    const int qw = d.q0 + w4 * 32;
    const bool wvalid = DUAL || wid * 32 < d.nq;
    const int kkey = 8 * wid + (lane >> 3), kch = (lane & 7) ^ ((kkey >> 1) & 7);
    const bf16_t* ksrc = d_.K1 + (size_t)kkey * d.rstride * d.k1pitch + kch * 8;
    const int k2key = 16 * (wid & 3) + (lane >> 2), k2ch = (lane & 3) ^ ((k2key >> 2) & 3);
    const bf16_t* k2src = (DQK == 96) ? d_.K2 + (size_t)k2key * d.rstride * d.k2pitch + k2ch * 8 : nullptr;
    int kofs[ND];
#pragma unroll
    for (int d0 = 0; d0 < ND; ++d0) kofs[d0] = d0 < 4 ? r32 * 128 + (((2 * d0 + hi) ^ ((r32 >> 1) & 7)) * 16) : 8192 + r32 * 64 + (((2 * (d0 - 4) + hi) ^ ((r32 >> 2) & 3)) * 16);
    const bf16_t* vsrc = d_.V + (size_t)(16 * (wid & 3) + (lane >> 2)) * d.rstride * d.vpitch + (DUAL ? 0 : (wid >> 2) * 32) + (lane & 3) * 8;
    const int kkeyB = 8 * (2 * w4 + 1) + (lane >> 3);
    const bf16_t* ksrcA = DUAL ? d_.K1 + (size_t)(8 * (2 * w4) + (lane >> 3)) * d.rstride * d.k1pitch + (((lane & 7) ^ (((8 * (2 * w4) + (lane >> 3)) >> 1) & 7)) * 8) : nullptr;
    const bf16_t* ksrcB = DUAL ? d_.K1 + (size_t)kkeyB * d.rstride * d.k1pitch + (((lane & 7) ^ ((kkeyB >> 1) & 7)) * 8) : nullptr;
    const size_t kstep = (size_t)64 * d.rstride * d.k1pitch, k2step = (size_t)64 * d.rstride * d.k2pitch, vstep = (size_t)64 * d.rstride * d.vpitch;
    const bool two = (DQK == 96) && wid < 4;
    const unsigned* msrc = (MODE == 2) ? d.mask + (size_t)(wvalid ? (qw + (lane >> 1)) : d.q0) * 64 + (lane & 1) : nullptr;
#define ATT_ISSUE(j) do { const int sl_ = (j) % NSLOT; \
        if (DUAL) { \
            glds16(ksrcA + (size_t)(j) * kstep, (unsigned)__builtin_amdgcn_readfirstlane(lds0 + A_K + gofs + sl_ * KSLOT + (2 * w4) * 1024)); \
            glds16(ksrcB + (size_t)(j) * kstep, (unsigned)__builtin_amdgcn_readfirstlane(lds0 + A_K + gofs + sl_ * KSLOT + (2 * w4 + 1) * 1024)); \
            glds16(vsrc + (size_t)(j) * vstep, (unsigned)__builtin_amdgcn_readfirstlane(lds0 + A_V + gofs + sl_ * VSLOT + w4 * 1024)); \
            glds16(vsrc + 32 + (size_t)(j) * vstep, (unsigned)__builtin_amdgcn_readfirstlane(lds0 + A_V + gofs + sl_ * VSLOT + (4 + w4) * 1024)); \
            break; } \
        glds16(ksrc + (size_t)(j) * kstep, (unsigned)__builtin_amdgcn_readfirstlane(lds0 + A_K + sl_ * KSLOT + wid * 1024)); \
        if (two) glds16(k2src + (size_t)(j) * k2step, (unsigned)__builtin_amdgcn_readfirstlane(lds0 + A_K + sl_ * KSLOT + (8 + wid) * 1024)); \
        glds16(vsrc + (size_t)(j) * vstep, (unsigned)__builtin_amdgcn_readfirstlane(lds0 + A_V + sl_ * VSLOT + wid * 1024)); \
        if (MODE == 2) glds4(msrc + 2 * (j), (unsigned)__builtin_amdgcn_readfirstlane(lds0 + A_MW + (wid * NSLOT + sl_) * 256)); } while (0)
    ATT_ISSUE(d.jlo);
    if (d.jlo + 1 < d.jhi) ATT_ISSUE(d.jlo + 1);
    bf16x8 qr[ND];
    { const int qi = wvalid ? (qw + r32) : d.q0; const bf16_t* qp = d_.Q + (size_t)qi * d.rstride * d.qpitch + hi * 8;
#pragma unroll
      for (int d0 = 0; d0 < ND; ++d0) qr[d0] = *(const bf16x8*)(qp + d0 * 16); }
#pragma unroll
    for (int d0 = 0; d0 < ND; ++d0) asm volatile("" : "+v"(qr[d0]));
    float mhat = 0.f; f32x16 o[2]; o[0] = f32x16{}; o[1] = f32x16{}; f32x16 lacc = f32x16{};
    bool started = false;
    const LAS unsigned char* vp0 = lds + A_V + gofs + ((lane >> 4) & 1) * 32 + (lane & 3) * 8 + (4 * hi + ((lane & 15) >> 2)) * 64;
    const int qi = qw + r32;
    f32x16 p0 = f32x16{}, p1 = f32x16{};
    f32x16 negm = f32x16{};
#define ATT_REL(j) (wvalid && (64 * (j) <= qw + 31) && (MODE != 1 || (64 * (j) + 63 >= qw - 128)))
#define ATT_QK(j) do { const int sl_ = (j) % NSLOT; \
        const LAS unsigned char* kb = lds + A_K + gofs + sl_ * KSLOT; bf16x8 kf[2 * ND]; \
        _Pragma("unroll") for (int d0 = 0; d0 < ND; ++d0) { kf[2 * d0] = *(const LAS bf16x8*)(kb + kofs[d0]); kf[2 * d0 + 1] = *(const LAS bf16x8*)(kb + kofs[d0] + (d0 < 4 ? 4096 : 2048)); } \
        __builtin_amdgcn_sched_barrier(0); \
        _Pragma("unroll") for (int d0 = 0; d0 < ND; ++d0) { \
            if (d0 == 0) { p0 = __builtin_amdgcn_mfma_f32_32x32x16_bf16(kf[0], qr[0], negm, 0, 0, 0); p1 = __builtin_amdgcn_mfma_f32_32x32x16_bf16(kf[1], qr[0], negm, 0, 0, 0); } \
            else { p0 = __builtin_amdgcn_mfma_f32_32x32x16_bf16(kf[2 * d0], qr[d0], p0, 0, 0, 0); p1 = __builtin_amdgcn_mfma_f32_32x32x16_bf16(kf[2 * d0 + 1], qr[d0], p1, 0, 0, 0); } } } while (0)
#define ATT_SMPV(j) do { const int sl_ = (j) % NSLOT; \
        { bool domask = true; unsigned mx_ = 0u, my_ = 0u;        \
          if (MODE == 2) { const u32x2 mw = *(const LAS u32x2*)(lds + A_MW + (wid * NSLOT + sl_) * 256 + r32 * 8); mx_ = mw.x; my_ = mw.y; } \
          else { \
            bool full = (64 * (j) + 63 <= qw); \
            if (MODE == 1) full = full && (64 * (j) >= qw + 31 - 128); \
            domask = !full; \
            if (domask) { const int a_ = qi - 64 * (j), lo_ = (MODE == 1) ? a_ - 128 : -4096;        \
                { const int h_ = a_ < 31 ? a_ : 31, l_ = lo_ > 0 ? lo_ : 0; mx_ = (h_ < l_) ? 0u : ((0xFFFFFFFFu >> (31 - h_)) & (0xFFFFFFFFu << l_)); } \
                { const int h_ = a_ - 32 < 31 ? a_ - 32 : 31, l_ = lo_ - 32 > 0 ? lo_ - 32 : 0; my_ = (h_ < l_) ? 0u : ((0xFFFFFFFFu >> (31 - h_)) & (0xFFFFFFFFu << l_)); } } \
          } \
          if (domask) { const unsigned w0 = mx_ >> (4 * hi), w1 = my_ >> (4 * hi); \
            _Pragma("unroll") for (int r = 0; r < 16; ++r) { const int bit = (r & 3) + 8 * (r >> 2); \
                const unsigned m0 = (unsigned)__builtin_amdgcn_sbfe((int)w0, bit, 1), m1 = (unsigned)__builtin_amdgcn_sbfe((int)w1, bit, 1);        \
                p0[r] = __uint_as_float((m0 & __float_as_uint(p0[r])) | (~m0 & 0xFF800000u)); p1[r] = __uint_as_float((m1 & __float_as_uint(p1[r])) | (~m1 & 0xFF800000u)); } } } \
        float rm = emax(p0[0], p1[0]), rm2 = emax(p0[1], p1[1]); \
        _Pragma("unroll") for (int r = 2; r < 16; r += 2) { rm = emax(emax(rm, p0[r]), p1[r]); rm2 = emax(emax(rm2, p0[r + 1]), p1[r + 1]); } \
        rm = halfmax(emax(rm, rm2)); \
        bool need; float dl; \
        if (!started) { need = true; dl = emax(rm, -200.f); } else { need = __any(rm > 8.f) != 0; dl = emax(rm, 0.f); } \
        if (need) { mhat += dl; \
            _Pragma("unroll") for (int r = 0; r < 16; ++r) negm[r] = -mhat; \
            _Pragma("unroll") for (int r = 0; r < 16; ++r) { p0[r] -= dl; p1[r] -= dl; } \
            if (started) { const float f = __builtin_amdgcn_exp2f(-dl); \
                if (hi == 0) wsf[r32] = f; \
                LDS_WAIT(); \
                _Pragma("unroll") for (int r = 0; r < 16; ++r) { const float fr_ = wsf[crow(r, hi)]; o[0][r] *= fr_; o[1][r] *= fr_; lacc[r] *= fr_; } } } \
        started = true; \
        __builtin_amdgcn_s_setprio(1);        \
        _Pragma("unroll") for (int r = 0; r < 16; ++r) { p0[r] = __builtin_amdgcn_exp2f(p0[r]); p1[r] = __builtin_amdgcn_exp2f(p1[r]); } \
        const u32x4 pw0 = (u32x4){cvt_pk_bf16(p0[0], p0[1]), cvt_pk_bf16(p0[2], p0[3]), cvt_pk_bf16(p0[4], p0[5]), cvt_pk_bf16(p0[6], p0[7])}; \
        const u32x4 pw1 = (u32x4){cvt_pk_bf16(p0[8], p0[9]), cvt_pk_bf16(p0[10], p0[11]), cvt_pk_bf16(p0[12], p0[13]), cvt_pk_bf16(p0[14], p0[15])}; \
        const u32x4 pw2 = (u32x4){cvt_pk_bf16(p1[0], p1[1]), cvt_pk_bf16(p1[2], p1[3]), cvt_pk_bf16(p1[4], p1[5]), cvt_pk_bf16(p1[6], p1[7])}; \
        const u32x4 pw3 = (u32x4){cvt_pk_bf16(p1[8], p1[9]), cvt_pk_bf16(p1[10], p1[11]), cvt_pk_bf16(p1[12], p1[13]), cvt_pk_bf16(p1[14], p1[15])}; \
        pv(o, lacc, vp0 + sl_ * VSLOT, __builtin_bit_cast(bf16x8, pw0), __builtin_bit_cast(bf16x8, pw1), __builtin_bit_cast(bf16x8, pw2), __builtin_bit_cast(bf16x8, pw3)); \
        __builtin_amdgcn_s_setprio(0); } while (0)
#define ATT_TOPWAIT(j) do { if ((j) + 1 < d.jhi) { if (DUAL) { ATT_WAIT_BAR(4); } else if (MODE == 2 || two) { ATT_WAIT_BAR(3); } else { ATT_WAIT_BAR(2); } } else { ATT_WAIT_BAR(0); } } while (0)
    if (wid < 4) {
        for (int j = d.jlo; j < d.jhi; ++j) {
            ATT_TOPWAIT(j);
            if (j + 2 < d.jhi) ATT_ISSUE(j + 2);
            if (ATT_REL(j)) { ATT_QK(j); ATT_SMPV(j); }
        }
        asm volatile("s_waitcnt lgkmcnt(0)\n\ts_barrier" ::: "memory");
    } else {
        ATT_TOPWAIT(d.jlo);
        if (d.jlo + 2 < d.jhi) ATT_ISSUE(d.jlo + 2);
        if (ATT_REL(d.jlo)) ATT_QK(d.jlo);
        for (int j = d.jlo + 1; j < d.jhi; ++j) {
            ATT_TOPWAIT(j);
            if (j + 2 < d.jhi) ATT_ISSUE(j + 2);
            if (ATT_REL(j - 1)) ATT_SMPV(j - 1);
            if (ATT_REL(j)) ATT_QK(j);
        }
        asm volatile("s_waitcnt lgkmcnt(0)\n\ts_barrier" ::: "memory");
        if (ATT_REL(d.jhi - 1)) ATT_SMPV(d.jhi - 1);
    }
#undef ATT_REL
#undef ATT_QK
#undef ATT_SMPV
#undef ATT_TOPWAIT
#undef ATT_ISSUE
    if (wvalid) {
        LAS bf16_t* stg = (LAS bf16_t*)(lds + A_OST) + wid * 2048;
        if (d_.lse != nullptr && r32 == 0) {
#pragma unroll
            for (int r = 0; r < 16; ++r) wsf[32 + crow(r, hi)] = lacc[r]; }
        if (d.o8) {
            LAS unsigned char* stg8 = (LAS unsigned char*)stg;
#pragma unroll
            for (int r = 0; r < 16; ++r) { const int orow = crow(r, hi); const float rl = __builtin_amdgcn_rcpf(lacc[r]) * 32.f;
                const unsigned p = (unsigned)__builtin_amdgcn_cvt_pk_fp8_f32(o[0][r] * rl, o[1][r] * rl, 0, false);
                stg8[orow * 64 + r32] = (unsigned char)(p & 0xffu); stg8[orow * 64 + 32 + r32] = (unsigned char)((p >> 8) & 0xffu); }
            LDS_WAIT();
#pragma unroll
            for (int i = 0; i < 2; ++i) { const int row = i * 16 + (lane >> 2), ch = lane & 3; const u32x4 v = *(const LAS u32x4*)(stg8 + row * 64 + ch * 16);
                *(u32x4*)((unsigned char*)d_.O + (size_t)(qw + row) * d.rstride * d.opitch + ch * 16) = v; }
        } else {
#pragma unroll
        for (int r = 0; r < 16; ++r) { const int orow = crow(r, hi); const float rl = __builtin_amdgcn_rcpf(lacc[r]);
            stg[orow * 64 + r32] = (bf16_t)f2bf(o[0][r] * rl); stg[orow * 64 + 32 + r32] = (bf16_t)f2bf(o[1][r] * rl); }
        LDS_WAIT();
#pragma unroll
        for (int i = 0; i < 4; ++i) { const int row = i * 8 + (lane >> 3), ch = lane & 7; const u32x4 v = *(const LAS u32x4*)(stg + row * 64 + ch * 8);
            *(u32x4*)(d_.O + (size_t)(qw + row) * d.rstride * d.opitch + ch * 8) = v; }
        }
        if (d_.lse != nullptr && hi == 0) d_.lse[(size_t)(qw + r32) * d.rstride * d.lsepitch] = mhat + __builtin_amdgcn_logf(wsf[32 + r32]);
    }
    asm volatile("s_waitcnt lgkmcnt(0)\n\ts_barrier" ::: "memory");
}
}

namespace idx {
constexpr int KS = 8192, I_K = 0, I_ST = 3 * KS, I_END = I_ST + 8 * 8192;
static_assert(I_END <= RING_BYTES, "indexer LDS");
__device__ __forceinline__ void score_unit(LAS unsigned char* lds, const bf16_t* PROJ, float* SC, int b, int qh  , int jg) {
    int tid_ = threadIdx.x; asm volatile("" : "+v"(tid_));
    const int tid = tid_, lane = tid & 63, r32 = lane & 31, hi = lane >> 5, wid = __builtin_amdgcn_readfirstlane(tid >> 6);
    const int qg = wid >> 1, hh = wid & 1;
    const unsigned lds0 = (unsigned)(size_t)lds;
    const int qrow = b * SEQ + qh * 128 + qg * 32 + r32;
    const bf16_t* kbase = PROJ + (size_t)(b * SEQ) * PW + 3968;
    const int kkey = 8 * wid + (lane >> 3);
    const bf16_t* ksrc = kbase + (size_t)kkey * PW + ((lane & 7) ^ ((kkey >> 1) & 7)) * 8;
    const int j0 = 4 * jg;
#define IDX_ISSUE(j) att::glds16(ksrc + (size_t)(j) * 64 * PW, (unsigned)__builtin_amdgcn_readfirstlane(lds0 + I_K + ((j) % 3) * KS + wid * 1024))
    IDX_ISSUE(j0); IDX_ISSUE(j0 + 1);
    bf16x8 qf[4][4]; float wv[4];
    { const bf16_t* qp = PROJ + (size_t)qrow * PW + 3328 + hh * 256 + hi * 8;
#pragma unroll
      for (int h = 0; h < 4; ++h)
#pragma unroll
          for (int d0 = 0; d0 < 4; ++d0) qf[h][d0] = *(const bf16x8*)(qp + h * 64 + d0 * 16);
      const u32x2 ww = *(const u32x2*)(PROJ + (size_t)qrow * PW + 4032 + hh * 4);
      wv[0] = bflo(ww.x); wv[1] = bfhi(ww.x); wv[2] = bflo(ww.y); wv[3] = bfhi(ww.y); }
#pragma unroll
    for (int h = 0; h < 4; ++h) { asm volatile("" : "+v"(wv[h]));
#pragma unroll
        for (int d0 = 0; d0 < 4; ++d0) asm volatile("" : "+v"(qf[h][d0])); }
    const int qb = qh >> 1;
    unsigned* blk = (unsigned*)SC + ((size_t)b * 36 + (size_t)(qb * (qb + 1) / 2)) * 32768; const int pitch = 128 * (qb + 1);
    f32x4 ve[4] = {};
    LAS unsigned char* stg = lds + I_ST + wid * 8192;
    const LAS unsigned char* stg2 = lds + I_ST + (wid ^ 1) * 8192;
#pragma nounroll
    for (int jj = 0; jj < 4; ++jj) { const int j = j0 + jj;
        if (jj < 2) { ATT_WAIT_BAR(1); } else if (jj == 2) { ATT_WAIT_BAR(5); } else { ATT_WAIT_BAR(4); }
        if (jj + 2 < 4) IDX_ISSUE(j + 2);
        const LAS unsigned char* kb = lds + I_K + (j % 3) * KS + r32 * 128;
#pragma nounroll
        for (int half = 0; half < 2; ++half) {
            bf16x8 kf[4];
#pragma unroll
            for (int d0 = 0; d0 < 4; ++d0) kf[d0] = *(const LAS bf16x8*)(kb + half * 4096 + (((2 * d0 + hi) ^ ((r32 >> 1) & 7)) * 16));
            f32x16 t0 = f32x16{};
#pragma unroll
            for (int h = 0; h < 4; ++h) {
                f32x16 p0 = f32x16{};
#pragma unroll
                for (int d0 = 0; d0 < 4; ++d0) p0 = __builtin_amdgcn_mfma_f32_32x32x16_bf16(kf[d0], qf[h][d0], p0, 0, 0, 0);
#pragma unroll
                for (int r = 0; r < 16; ++r) t0[r] += wv[h] * att::emax(p0[r], 0.f);
            }
#pragma unroll
            for (int g = 0; g < 4; ++g) { const int c0 = 8 * half + 2 * g + hi;
                *(LAS f32x4*)(stg + r32 * 256 + ((c0 ^ (r32 & 15)) * 16)) = (f32x4){t0[4 * g], t0[4 * g + 1], t0[4 * g + 2], t0[4 * g + 3]}; }
        }
        asm volatile("s_waitcnt lgkmcnt(0)\n\ts_barrier" ::: "memory");
#pragma unroll
        for (int i = 0; i < 4; ++i) { const int q = hh * 16 + i * 4 + (lane >> 4), c = lane & 15; const int so = q * 256 + ((c ^ (q & 15)) * 16);
            const f32x4 v = *(const LAS f32x4*)(stg + so) + *(const LAS f32x4*)(stg2 + so);
            if (jj & 1) { const f32x4 e = ve[i]; const u32x4 w = {pk2(e[0], v[0]), pk2(e[1], v[1]), pk2(e[2], v[2]), pk2(e[3], v[3])};
                *(u32x4*)(blk + (size_t)((qh & 1) * 128 + qg * 32 + q) * pitch + 64 * (j >> 1) + 4 * c) = w; }
            else ve[i] = v; }
        LDS_WAIT();
    }
#undef IDX_ISSUE
    asm volatile("s_waitcnt lgkmcnt(0)\n\ts_barrier" ::: "memory");
}

__device__ __forceinline__ int wave_sum_i(int v) {
    v += __builtin_amdgcn_update_dpp(0, v, 0xB1, 0xF, 0xF, true);
    v += __builtin_amdgcn_update_dpp(0, v, 0x4E, 0xF, 0xF, true);
    v += __builtin_amdgcn_update_dpp(0, v, 0x141, 0xF, 0xF, true);
    v += __builtin_amdgcn_update_dpp(0, v, 0x140, 0xF, 0xF, true);
    return __builtin_amdgcn_readlane(v, 0) + __builtin_amdgcn_readlane(v, 16) + __builtin_amdgcn_readlane(v, 32) + __builtin_amdgcn_readlane(v, 48);
}
__device__ __forceinline__ unsigned long long keep_low(unsigned long long m, int k) { while (__builtin_popcountll(m) > k) m &= ~(1ull << (63 - __builtin_clzll(m))); return m; }
__device__ __forceinline__ void select_rows4(const float* SC, unsigned* MASK, int row0  , int lane, LAS unsigned* slot  ) {
    const int b = row0 / SEQ, t0 = row0 % SEQ, qb = t0 >> 8;
    if (t0 < 256) {
#pragma unroll 1
        for (int i = 0; i < 4; ++i) { const int t = t0 + i, lo = 64 * lane;
            const unsigned long long w = (lo + 63 <= t) ? ~0ull : (lo > t ? 0ull : ((2ull << (t - lo)) - 1ull));
            if (lane < 32) ((unsigned long long*)(MASK + (size_t)(row0 + i) * 64))[lane] = w; }
        return;
    }
    const int pitch = 128 * (qb + 1), pmax = pitch - 1;
    const unsigned* srow0 = (const unsigned*)SC + ((size_t)b * 36 + (size_t)(qb * (qb + 1) / 2)) * 32768 + (size_t)(t0 - 256 * qb) * pitch;
    unsigned raw[16];
#pragma unroll
    for (int i = 0; i < 16; ++i) { const int s_ = 64 * i + lane; raw[i] = srow0[s_ < pmax ? s_ : pmax]; }
#pragma unroll 1
    for (int r = 0; r < 4; ++r) {
        const int t = t0 + r;
        unsigned P[16];
#pragma unroll
        for (int i = 0; i < 16; ++i) P[i] = raw[i];
        { const unsigned* nx = srow0 + (size_t)(r < 3 ? r + 1 : 3) * pitch;
#pragma unroll
          for (int i = 0; i < 16; ++i) { const int s_ = 64 * i + lane; raw[i] = nx[s_ < pmax ? s_ : pmax]; } }
#define SEL_TSTAGE(sh, m) _Pragma("unroll") for (int q = 0; q < 16; ++q) if (!(q & (sh))) { const unsigned a_ = P[q], b_ = P[q + (sh)]; \
            P[q] = (a_ & (m)) | ((b_ << (sh)) & ~(m)); P[q + (sh)] = ((a_ >> (sh)) & (m)) | (b_ & ~(m)); }
        SEL_TSTAGE(8, 0x00FF00FFu) SEL_TSTAGE(4, 0x0F0F0F0Fu) SEL_TSTAGE(2, 0x33333333u) SEL_TSTAGE(1, 0x55555555u)
#undef SEL_TSTAGE
        { const unsigned sg = P[15];
#pragma unroll
          for (int q = 0; q < 15; ++q) P[q] ^= sg;
          P[15] = ~sg; }
        const int nj = ((t - lane) >> 6) + 1;
        unsigned A = ((1u << ((nj + 1) >> 1)) - 1u) | (((1u << (nj >> 1)) - 1u) << 16), G = 0u;
        int cab = 0, cntA = t + 1;
#pragma unroll
        for (int bit = 15; bit >= 0; --bit) {
            if (cab + cntA != 256) {
                const unsigned ones = A & P[bit];
                const int c = wave_sum_i(__builtin_popcount(ones));
                if (cab + c >= 256) { A = ones; cntA = c; } else { G |= ones; cab += c; A &= ~ones; cntA -= c; }
            }
        }
        int need = 256 - cab;
        unsigned sel = G | A;
        if (cntA != need) {
            unsigned selA = 0u;
#pragma nounroll
            for (int j = 0; j < 32; ++j) { const int pb = (j >> 1) + 16 * (j & 1);
                unsigned long long m = __ballot((A >> pb) & 1u);
                if (__builtin_popcountll(m) > need) m = keep_low(m, need);
                need -= __builtin_popcountll(m);
                selA |= (unsigned)((m >> lane) & 1ull) << pb;
            }
            sel = G | selA;
        }
        int lo = 0, hi = 0;
#pragma unroll
        for (int j = 0; j < 32; ++j) { const unsigned long long m = __ballot((sel >> ((j >> 1) + 16 * (j & 1))) & 1u);
            lo = (lane == j) ? (int)(unsigned)m : lo; hi = (lane == j) ? (int)(unsigned)(m >> 32) : hi; }
        if (lane < 32) ((unsigned long long*)(MASK + (size_t)(row0 + r) * 64))[lane] = (unsigned long long)(unsigned)lo | ((unsigned long long)(unsigned)hi << 32);
    }
}
}

__device__ __forceinline__ unsigned* queue_word(Frame& F, int l, int chunk, int q) { return (unsigned*)(F.ws + WS_CTL) + CW_QUEUE + 64 * ((l * NCHUNK + chunk) * 4 + q); }

__device__ __forceinline__ void phase_proj(Frame& F, int l, int chunk) {
    PHASE_IDS(F);
    { LAS float* gb = (LAS float*)(F.lds + L_GB); const float* bg = F.in[7] + (size_t)l * 3072;
      __syncthreads();
      for (int i = F.tid; i < 3072; i += NTHREADS) gb[i] = bg[i];
      VM_WAIT(); LDS_WAIT(); __syncthreads(); }
    pg8::ProjSched8 S{{{(const bf16_t*)(F.ws + WS_XB8 + (size_t)chunk * TC * DM), (const bf16_t*)(F.ws + WS_WIN8), DM / 2, DM / 2, TC / 256, (PW + 3072) / 256, F.G, (int)blockIdx.x}, F8_SW, F8_SA_X}};
    const float* rp = (const float*)(F.ws + WS_ROPE);
    EpiProj E{(bf16_t*)(F.ws + WS_PROJ), rp, rp + 2048 * 8 * 2, (float*)(F.ws + WS_SSQ), (bf16_t*)(F.ws + WS_G3), (const LAS float*)(F.lds + L_GB)};
    pg8::gemm_phase<EpiProj, pg8::ProjSched8, true, true>(F.lds, DM / 2, S, E);
}
__device__ __forceinline__ void dilated_unit(Frame& F, int u) {
    const bf16_t* PROJ = (const bf16_t*)(F.ws + WS_PROJ); bf16_t* OG = (bf16_t*)(F.ws + WS_OG); float* LSE = (float*)(F.ws + WS_LSE);
    constexpr int N_G0 = NBC * 4 * 8, N_G1 = NBC * 4 * 4 * 2;
    int g, b, h, res, qb, dil, nq;
    if (u < N_G0) { g = 0; dil = 1; qb = 7 - u / (NBC * 4); const int bh = u % (NBC * 4); b = bh >> 2; h = bh & 3; res = 0; nq = 256; }
    else if (u < N_G0 + N_G1) { const int v = u - N_G0; g = 1; dil = 4; qb = 1 - v / (NBC * 16); const int x = v % (NBC * 16); b = x >> 4; h = (x >> 2) & 3; res = x & 3; nq = 256; }
    else { const int v = u - N_G0 - N_G1; g = 2; dil = 16; qb = 0; b = v >> 5; h = (v >> 3) & 3; res = (v & 7) * 2; nq = 128; }
    att::Desc d; const size_t r0 = (size_t)b * SEQ + res;
    const bf16_t* base = PROJ + r0 * PW + 512 + 768 * g + 64 * h;
    d.Q = base; d.K1 = base + 256; d.V = base + 512; d.K2 = nullptr; d.qpitch = d.k1pitch = d.vpitch = PW; d.k2pitch = 0;
    d.O = OG + ((size_t)g * TC + r0) * 256 + 64 * h; d.opitch = 256; d.lse = LSE + ((size_t)g * TC + r0) * 4 + h; d.lsepitch = 4; d.mask = nullptr;
    d.rstride = dil; d.q0 = qb * 256; d.nq = nq; d.o8 = 0;
    if (g == 2) { d.jlo = 0; d.jhi = 2; att::attn_unit<64, 0, true>(F.lds, d); }
    else { d.jlo = (qb * 4 - 2) > 0 ? (qb * 4 - 2) : 0; d.jhi = 4 * (qb + 1); att::attn_unit<64, 1>(F.lds, d); }
}

struct UpSched {
    static constexpr bool GATHER = false;
    const char* A; const char* B; size_t sB; int lda, ldb, nM, G, c;
    __device__ __forceinline__ bool next(int i, pg8::Unit& u) const { const int v = i * G + c; if (v >= nM * 7) return false; u.pm = v / 7; u.pn = v % 7; u.ord = i; return true; }
    __device__ __forceinline__ const char* a_base(const pg8::Unit& u) const { return A + ((size_t)u.pm * 256 * lda + (u.pn >= 3 ? 256 : 0)) * 2; }
    __device__ __forceinline__ const char* b_base(const pg8::Unit& u) const { return B + (u.pn >= 3 ? sB + (size_t)(u.pn - 3) * 256 * ldb * 2 : (size_t)u.pn * 256 * ldb * 2); }
    __device__ __forceinline__ void a_off(const pg8::Unit&, const int (&R)[2], const int (&C)[2], unsigned (&v)[2][2]) const {
#pragma unroll
        for (int i = 0; i < 2; ++i) { v[0][i] = (unsigned)(R[i] * lda + C[i]) * 2u; v[1][i] = (unsigned)((128 + R[i]) * lda + C[i]) * 2u; }
    }
};
struct EpiUp {
    EpiUpQ q; EpiUpKV kv;
    __device__ __forceinline__ void operator()(const f32x4 (&acc)[2][2][4][2], const pg8::Unit& u, int wr, int wc, int fr, int fq) const {
        if (u.pn < 3) q(acc, u, wr, wc, fr, fq);
        else { pg8::Unit u2 = u; u2.pn = u.pn - 3; kv(acc, u2, wr, wc, fr, fq); }
    }
};
__device__ __forceinline__ void phase_up_scores(Frame& F, int l, int chunk) {
    PHASE_IDS(F);
    const bf16_t* PROJ = (const bf16_t*)(F.ws + WS_PROJ);
    const float* rp = (const float*)(F.ws + WS_ROPE);
    {   UpSched S{(const char*)PROJ, (const char*)(F.ws + WS_WUQ), WS_WUKV - WS_WUQ, PW, 256, TC / 256, F.G, (int)blockIdx.x};
        EpiUp E{{(bf16_t*)(F.ws + WS_QM), rp + 2048 * 8 * 2, (const float*)(F.ws + WS_SSQ)}, {(bf16_t*)(F.ws + WS_KVM), (const float*)(F.ws + WS_SSQ)}};
        pg8::gemm_phase<EpiUp, UpSched, true>(F.lds, 256, S, E); }
    unsigned* qw = queue_word(F, l, chunk, 0); int pre = -1;
    for (;;) {
        const int u = dequeue(F, qw, pre);
        if (u < NBC * 64) { dilated_unit(F, u); continue; }
        if (u >= NBC * 64 + NBC * 72 + NBC * 32) break;
        if (u >= NBC * 64 + NBC * 72) { dilated_unit(F, u - NBC * 72); continue; }
        const int v = u - NBC * 64; const int b = v / 72; int r = v % 72, qh = 0; while (r > (qh >> 1)) { r -= (qh >> 1) + 1; ++qh; }
        idx::score_unit(F.lds, PROJ, (float*)(F.ws + WS_SC), b, qh, r);
    }
}
__device__ __forceinline__ void phase_attn1(Frame& F, int l, int chunk, int tmask = 7) {
    PHASE_IDS(F);
    const bf16_t* PROJ = (const bf16_t*)(F.ws + WS_PROJ); const bf16_t* QM = (const bf16_t*)(F.ws + WS_QM); const bf16_t* KVM = (const bf16_t*)(F.ws + WS_KVM);
    bf16_t* OA = (bf16_t*)(F.ws + WS_OA); bf16_t* OG = (bf16_t*)(F.ws + WS_OG); float* LSE = (float*)(F.ws + WS_LSE);
    constexpr int N_MLA = NBC * 8 * 8, N_SEL = TC / 32;
    unsigned* qw = queue_word(F, l, chunk, 1); int pre = -1;
    for (;;) {
        int u = dequeue(F, qw, pre);
        if (u < N_MLA) {
            if (!(tmask & 1)) continue;
            const int qb = 7 - u / (NBC * 8), bh = u % (NBC * 8), b = bh >> 3, h = bh & 7;
            att::Desc d; const size_t r0 = (size_t)b * SEQ;
            d.Q = QM + r0 * 768 + h * 96; d.qpitch = 768; d.K1 = KVM + r0 * 1024 + h * 128; d.k1pitch = 1024; d.K2 = PROJ + r0 * PW + 384; d.k2pitch = PW;
            d.V = KVM + r0 * 1024 + h * 128 + 64; d.vpitch = 1024; d.O = (bf16_t*)((unsigned char*)OA + r0 * 512 + h * 64); d.opitch = 512; d.o8 = 1; d.lse = nullptr; d.lsepitch = 0; d.mask = nullptr;
            d.rstride = 1; d.q0 = qb * 256; d.nq = 256; d.jlo = 0; d.jhi = 4 * (qb + 1);
            att::attn_unit<96, 0>(F.lds, d); continue; }
        u -= N_MLA;
        if (u >= N_SEL) break;
        if (!(tmask & 4)) continue;
        idx::select_rows4((const float*)(F.ws + WS_SC), (unsigned*)(F.ws + WS_MASK), u * 32 + F.wave * 4, F.lane, (LAS unsigned*)(F.lds + L_GB) + F.wave * 64);
    }
}
__device__ __forceinline__ void phase_attn2(Frame& F, int l, int chunk) {
    PHASE_IDS(F);
    const bf16_t* PROJ = (const bf16_t*)(F.ws + WS_PROJ);
    bf16_t* OC = (bf16_t*)(F.ws + WS_OC);
    unsigned* qw = queue_word(F, l, chunk, 2); int pre = -1;
    for (;;) {
        const int u = dequeue(F, qw, pre);
        if (u >= NBC * 64) break;
        const int qb = 7 - u / (NBC * 8), bh = u % (NBC * 8), b = bh >> 3, h = bh & 7;
        att::Desc d; const size_t r0 = (size_t)b * SEQ;
        d.Q = PROJ + r0 * PW + 2816 + 64 * h; d.K1 = PROJ + r0 * PW + 3840; d.V = PROJ + r0 * PW + 3904; d.K2 = nullptr; d.qpitch = d.k1pitch = d.vpitch = PW; d.k2pitch = 0;
        d.O = (bf16_t*)((unsigned char*)OC + r0 * 512 + 64 * h); d.opitch = 512; d.o8 = 1; d.lse = nullptr; d.lsepitch = 0; d.mask = (const unsigned*)(F.ws + WS_MASK) + r0 * 64;
        d.rstride = 1; d.q0 = qb * 256; d.nq = 256; d.jlo = 0; d.jhi = 4 * (qb + 1);
        att::attn_unit<64, 2>(F.lds, d);
    }
    const bf16_t* OG = (const bf16_t*)(F.ws + WS_OG); const float* LSE = (const float*)(F.ws + WS_LSE); bf16_t* OB = (bf16_t*)(F.ws + WS_OB);
    const int gw = F.vcu * NWAVES + F.wave, NGW = F.G * NWAVES, h = F.lane >> 4;
    for (int row = gw; row < TC; row += NGW) {
        const float l0 = LSE[(size_t)row * 4 + h], l1 = LSE[((size_t)TC + row) * 4 + h], l2 = LSE[((size_t)2 * TC + row) * 4 + h];
        const float mx = fmaxf(l0, fmaxf(l1, l2));
        float w0 = __builtin_amdgcn_exp2f(l0 - mx), w1 = __builtin_amdgcn_exp2f(l1 - mx), w2 = __builtin_amdgcn_exp2f(l2 - mx);
        const float inv = 1.0f / (w0 + w1 + w2); w0 *= inv; w1 *= inv; w2 *= inv;
        const u32x2 a = *(const u32x2*)(OG + (size_t)row * 256 + F.lane * 4), bq = *(const u32x2*)(OG + ((size_t)TC + row) * 256 + F.lane * 4), c = *(const u32x2*)(OG + ((size_t)2 * TC + row) * 256 + F.lane * 4);
        w0 *= 32.f; w1 *= 32.f; w2 *= 32.f;
        *(unsigned*)((unsigned char*)OB + (size_t)row * 512 + F.lane * 4) = pk4_fp8(w0 * bflo(a.x) + w1 * bflo(bq.x) + w2 * bflo(c.x), w0 * bfhi(a.x) + w1 * bfhi(bq.x) + w2 * bfhi(c.x),
                                                                                    w0 * bflo(a.y) + w1 * bflo(bq.y) + w2 * bflo(c.y), w0 * bfhi(a.y) + w1 * bfhi(bq.y) + w2 * bfhi(c.y));
    }
}
constexpr int CW_DEP = 32768;
__device__ __forceinline__ void phase_attn(Frame& F, int l, int chunk) {
    PHASE_IDS(F);
    const bf16_t* PROJ = (const bf16_t*)(F.ws + WS_PROJ); const bf16_t* QM = (const bf16_t*)(F.ws + WS_QM); const bf16_t* KVM = (const bf16_t*)(F.ws + WS_KVM);
    bf16_t* OA = (bf16_t*)(F.ws + WS_OA); bf16_t* OC = (bf16_t*)(F.ws + WS_OC);
    constexpr int N_SEL = TC / 32, NQ = NBC * 8;
    unsigned* dep = (unsigned*)(F.ws + WS_CTL) + CW_DEP + (l * NCHUNK + chunk) * (NBC * 8);
    unsigned* qw = queue_word(F, l, chunk, 1); int pre = -1;
    for (;;) {
        int u = dequeue(F, qw, pre);
        if (u < N_SEL) {
            idx::select_rows4((const float*)(F.ws + WS_SC), (unsigned*)(F.ws + WS_MASK), u * 32 + F.wave * 4, F.lane, (LAS unsigned*)(F.lds + L_GB) + F.wave * 64);
            VM_WAIT();
            __syncthreads();
            if (F.tid == 0) { const int row = u * 32, b = row / SEQ, qb = (row % SEQ) >> 8;
                __builtin_amdgcn_fence(__ATOMIC_RELEASE, "agent");
                __hip_atomic_fetch_add(dep + b * 8 + qb, 1u, __ATOMIC_RELAXED, __HIP_MEMORY_SCOPE_AGENT); }
            continue; }
        u -= N_SEL;
        if (u >= 16 * NQ) break;
        const int qb = 7 - u / (2 * NQ), w = u % (2 * NQ);
        if (w < NQ) {
            const int b = w >> 3, h = w & 7;
            att::Desc d; const size_t r0 = (size_t)b * SEQ;
            d.Q = QM + r0 * 768 + h * 96; d.qpitch = 768; d.K1 = KVM + r0 * 1024 + h * 128; d.k1pitch = 1024; d.K2 = PROJ + r0 * PW + 384; d.k2pitch = PW;
            d.V = KVM + r0 * 1024 + h * 128 + 64; d.vpitch = 1024; d.O = (bf16_t*)((unsigned char*)OA + r0 * 512 + h * 64); d.opitch = 512; d.o8 = 1; d.lse = nullptr; d.lsepitch = 0; d.mask = nullptr;
            d.rstride = 1; d.q0 = qb * 256; d.nq = 256; d.jlo = 0; d.jhi = 4 * (qb + 1);
            att::attn_unit<96, 0>(F.lds, d);
        } else {
            const int bh = w - NQ, b = bh >> 3, h = bh & 7;
            if (F.tid == 0) { while (__hip_atomic_load(dep + b * 8 + qb, __ATOMIC_RELAXED, __HIP_MEMORY_SCOPE_AGENT) < 8u) __builtin_amdgcn_s_sleep(4);
                __builtin_amdgcn_fence(__ATOMIC_ACQUIRE, "agent"); }
            __syncthreads();
            att::Desc d; const size_t r0 = (size_t)b * SEQ;
            d.Q = PROJ + r0 * PW + 2816 + 64 * h; d.K1 = PROJ + r0 * PW + 3840; d.V = PROJ + r0 * PW + 3904; d.K2 = nullptr; d.qpitch = d.k1pitch = d.vpitch = PW; d.k2pitch = 0;
            d.O = (bf16_t*)((unsigned char*)OC + r0 * 512 + 64 * h); d.opitch = 512; d.o8 = 1; d.lse = nullptr; d.lsepitch = 0; d.mask = (const unsigned*)(F.ws + WS_MASK) + r0 * 64;
            d.rstride = 1; d.q0 = qb * 256; d.nq = 256; d.jlo = 0; d.jhi = 4 * (qb + 1);
            att::attn_unit<64, 2>(F.lds, d);
        }
    }
    const bf16_t* OG = (const bf16_t*)(F.ws + WS_OG); const float* LSE = (const float*)(F.ws + WS_LSE); bf16_t* OB = (bf16_t*)(F.ws + WS_OB);
    const int gw = F.vcu * NWAVES + F.wave, NGW = F.G * NWAVES, h = F.lane >> 4;
    for (int row0 = gw; row0 < TC; row0 += 4 * NGW) {
        float l0[4], l1[4], l2[4]; u32x2 a[4], bq[4], c[4]; int rows[4];
#pragma unroll
        for (int i = 0; i < 4; ++i) { const int row = row0 + i * NGW < TC ? row0 + i * NGW : row0; rows[i] = row;
            l0[i] = LSE[(size_t)row * 4 + h]; l1[i] = LSE[((size_t)TC + row) * 4 + h]; l2[i] = LSE[((size_t)2 * TC + row) * 4 + h];
            a[i] = *(const u32x2*)(OG + (size_t)row * 256 + F.lane * 4); bq[i] = *(const u32x2*)(OG + ((size_t)TC + row) * 256 + F.lane * 4); c[i] = *(const u32x2*)(OG + ((size_t)2 * TC + row) * 256 + F.lane * 4); }
#pragma unroll
        for (int i = 0; i < 4; ++i) {
            const float mx = fmaxf(l0[i], fmaxf(l1[i], l2[i]));
            float w0 = __builtin_amdgcn_exp2f(l0[i] - mx), w1 = __builtin_amdgcn_exp2f(l1[i] - mx), w2 = __builtin_amdgcn_exp2f(l2[i] - mx);
            const float inv = 32.0f / (w0 + w1 + w2); w0 *= inv; w1 *= inv; w2 *= inv;
            *(unsigned*)((unsigned char*)OB + (size_t)rows[i] * 512 + F.lane * 4) = pk4_fp8(w0 * bflo(a[i].x) + w1 * bflo(bq[i].x) + w2 * bflo(c[i].x), w0 * bfhi(a[i].x) + w1 * bfhi(bq[i].x) + w2 * bfhi(c[i].x),
                                                                                          w0 * bflo(a[i].y) + w1 * bflo(bq[i].y) + w2 * bflo(c[i].y), w0 * bfhi(a[i].y) + w1 * bfhi(bq[i].y) + w2 * bfhi(c[i].y));
        }
    }
}
__device__ __forceinline__ void phase_branches(Frame& F, int l, int chunk) {
    PHASE_IDS(F);
    static_assert(WS_OB - WS_OA == WS_OC - WS_OB && WS_WB - WS_WA == WS_WC - WS_WB, "equally spaced branch operands");
    BranchSched S{(const char*)(F.ws + WS_OA), (const char*)(F.ws + WS_WA), WS_OB - WS_OA, WS_WB - WS_WA, 256, 256, (int)blockIdx.x, F8_SW, 127 - 5, F.G, (TC / 256) * 4};
    EpiBranchAll E{(bf16_t*)(F.ws + WS_MERGED), (bf16_t*)(F.ws + WS_M0), (bf16_t*)(F.ws + WS_M1), (const bf16_t*)(F.ws + WS_G3)};
    pg8::gemm_phase<EpiBranchAll, BranchSched, true, true>(F.lds, 256, S, E);
}
__device__ __forceinline__ void phase_wo(Frame& F, int l, int chunk) {
    PHASE_IDS(F);
    pg8::DenseSched8 S{{(const bf16_t*)(F.ws + WS_MERGED), (const bf16_t*)(F.ws + WS_WO), DM / 2, DM / 2, TC / 256, 4, F.G, (int)blockIdx.x}, F8_SW, 127 - 6};
    EpiWo E{F.out, l == 0 ? F.in[0] : F.out, chunk * TC};
    pg8::gemm_phase<EpiWo, pg8::DenseSched8, true, true>(F.lds, DM / 2, S, E);
}

__global__ void __launch_bounds__(NTHREADS, 2) fwd_kernel(Args args) {
    extern __shared__ __attribute__((aligned(16))) unsigned char lds_raw[];
    Frame F;
    F.lds = (LAS unsigned char*)lds_raw;
    F.tid = threadIdx.x; F.lane = F.tid & 63; F.wave = __builtin_amdgcn_readfirstlane(F.tid >> 6);
    F.G = gridDim.x; { const int bx = blockIdx.x; F.vcu = (F.G % 8 == 0) ? (bx % 8) * (F.G / 8) + bx / 8 : bx; }
    F.in.p = (intab_t)__builtin_amdgcn_kernarg_segment_ptr(); F.out = args.out; F.ws = args.ws; F.out0 = args.out; F.ws0 = args.ws;
    for (int u = F.tid; u < (LDS_BYTES - L_CTL) / 4; u += NTHREADS) ((LAS unsigned*)(F.lds + L_CTL))[u] = 0u;
    __syncthreads();
    XcdBarrier bar = xcd_barrier_post((unsigned*)(F.ws + WS_CTL) + CW_BAR, (volatile LAS unsigned*)(F.lds + L_BARW));
#define GRID_BAR() xcd_barrier(bar)

    for (int l = 0; l < 2; ++l) {
        phase_conv_moe(F, l);
        phase_conv_mixer(F, l);
        GRID_BAR();
        for (int chunk = 0; chunk < NCHUNK; ++chunk) {
            phase_proj(F, l, chunk);
            GRID_BAR();
            if (DUPMASK & 2) { phase_proj(F, l, chunk); GRID_BAR(); }
            phase_up_scores(F, l, chunk);
            GRID_BAR();
            if (DUPMASK & 4) { phase_up_scores(F, l + 2, chunk); GRID_BAR(); }
            phase_attn(F, l, chunk);
            GRID_BAR();
            phase_branches(F, l, chunk);
            GRID_BAR();
            if (DUPMASK & 32) { phase_branches(F, l, chunk); GRID_BAR(); }
            phase_wo(F, l, chunk);
            if ((DUPMASK & 0x800) && l == 0) { GRID_BAR(); phase_wo(F, l, chunk); }
        }
        GRID_BAR();
        phase_ln1_router(F, l, F.out, false);
        GRID_BAR();
        phase_moe_scatter(F);
        GRID_BAR();
        phase_moe_gemm1(F);
        GRID_BAR();
        if (DUPMASK & 64) { phase_moe_gemm1(F); GRID_BAR(); }
        phase_moe_gemm2(F);
        GRID_BAR();
        if (DUPMASK & 128) { phase_moe_gemm2(F); GRID_BAR(); }
        phase_combine_ln2(F, l);
    }
}

extern "C" void kernel_launch(void* const* d_in, const int* in_sizes, int n_in, void* d_out, int out_size, void* d_ws, size_t ws_size, hipStream_t stream) {
    static int grid = 0;
    if (grid == 0) {
        if (n_in != 23 || out_size != TT * DM || ws_size < WS_END) { fprintf(stderr, "kernel_launch: unexpected shapes n_in %d out %d ws %zu\n", n_in, out_size, ws_size); grid = -1; return; }
        int dev = 0, cus = 0;
        if (hipGetDevice(&dev) != hipSuccess || hipDeviceGetAttribute(&cus, hipDeviceAttributeMultiprocessorCount, dev) != hipSuccess) { grid = -1; return; }
        if (hipFuncSetAttribute((const void*)fwd_kernel, hipFuncAttributeMaxDynamicSharedMemorySize, LDS_BYTES) != hipSuccess) { fprintf(stderr, "kernel_launch: hipFuncSetAttribute failed\n"); grid = -1; return; }
        int per_cu = 0;
        if (hipOccupancyMaxActiveBlocksPerMultiprocessor(&per_cu, (const void*)fwd_kernel, NTHREADS, LDS_BYTES) != hipSuccess || per_cu < 1) fprintf(stderr, "kernel_launch: occupancy query says %d\n", per_cu);
        (void)hipGetLastError();
        grid = cus;
    }
    if (grid < 0) return;
    if (hipMemsetAsync((char*)d_ws + WS_CTL, 0, CTL_ZERO_BYTES, stream) != hipSuccess) return;
    Args a{};
    for (int i = 0; i < 23; ++i) a.in[i] = (const float*)d_in[i];
    a.out = (float*)d_out; a.ws = (unsigned char*)d_ws;
    hipLaunchKernelGGL(fwd_kernel, dim3(grid), dim3(NTHREADS), LDS_BYTES, stream, a);
}
```

```cpp
#include <hip/hip_runtime.h>
#include <cstdio>
#include <cstdint>

#define LAS __attribute__((address_space(3)))
#define GAS __attribute__((address_space(1)))
typedef unsigned short bf16_t;
typedef short bf16x8 __attribute__((ext_vector_type(8)));
typedef float f32x4 __attribute__((ext_vector_type(4)));
typedef float f32x2 __attribute__((ext_vector_type(2)));
typedef float f32x16 __attribute__((ext_vector_type(16)));
typedef unsigned u32x4 __attribute__((ext_vector_type(4)));
typedef unsigned u32x2 __attribute__((ext_vector_type(2)));

constexpr int DM = 1024, NB = 32, SEQ = 2048, TT = NB * SEQ;
constexpr int NEXP = 32, DEXP = 256;
constexpr float LN_EPS = 1e-6f;
constexpr float ALPHA = 1.41421356237309515f;
constexpr int NWAVES = 8, NTHREADS = 512;

__device__ __forceinline__ unsigned f2bf(float f) { unsigned u = __builtin_bit_cast(unsigned, f); return (u + 0x7fffu + ((u >> 16) & 1u)) >> 16; }
__device__ __forceinline__ unsigned pk2(float lo, float hi) { return f2bf(lo) | (f2bf(hi) << 16); }
__device__ __forceinline__ float bf2f(unsigned short b) { return __builtin_bit_cast(float, (unsigned)b << 16); }
__device__ __forceinline__ float bflo(unsigned w) { return __builtin_bit_cast(float, w << 16); }
__device__ __forceinline__ float bfhi(unsigned w) { return __builtin_bit_cast(float, w & 0xffff0000u); }
typedef __bf16 bf16x2_t __attribute__((ext_vector_type(2)));
__device__ __forceinline__ unsigned cvt_pk_bf16(float lo, float hi) { const f32x2 v = {lo, hi}; const bf16x2_t b = __builtin_convertvector(v, bf16x2_t); return __builtin_bit_cast(unsigned, b); }
__device__ __forceinline__ float wave_sum(float v) {
#pragma unroll
    for (int o = 1; o < 64; o <<= 1) v += __shfl_xor(v, o);
    return v;
}
__device__ __forceinline__ float fast_exp(float x) { return __builtin_amdgcn_exp2f(x * 1.4426950408889634f); }
__device__ __forceinline__ float sigmoidf_(float x) { return __builtin_amdgcn_rcpf(1.0f + fast_exp(-x)); }
__device__ __forceinline__ unsigned pk4_fp8(float a, float b, float c, float d) {
    int p = __builtin_amdgcn_cvt_pk_fp8_f32(a, b, 0, false); p = __builtin_amdgcn_cvt_pk_fp8_f32(c, d, p, true); return (unsigned)p; }
__device__ __forceinline__ void store8_fp8(unsigned char* p, const f32x4& v0, const f32x4& v1, float sc) {
    u32x2 w; w.x = pk4_fp8(v0[0] * sc, v0[1] * sc, v0[2] * sc, v0[3] * sc); w.y = pk4_fp8(v1[0] * sc, v1[1] * sc, v1[2] * sc, v1[3] * sc); *(u32x2*)p = w;
}
#define LDS_WAIT() asm volatile("s_waitcnt lgkmcnt(0)" ::: "memory")
#define VM_WAIT() asm volatile("s_waitcnt vmcnt(0)" ::: "memory")

namespace pg8 {
constexpr int BM = 256, BK = 64, HALF = 128, HTB = HALF * BK * 2, STAGE_BYTES = 8 * HTB;
__device__ __forceinline__ int lds_byte(int r, int c) { return r * 128 + ((((c >> 3) ^ (r >> 1)) & 7) * 16) + (c & 7) * 2; }
__device__ __forceinline__ void stage_rc(int b, int& R, int& C) { R = b >> 7; C = ((((b >> 4) ^ (R >> 1)) & 7)) * 8; }
__device__ __forceinline__ int perm32(int rho) { const int n = rho >> 4, i = rho & 15; return 8 * (i >> 2) + 4 * n + (i & 3); }
struct Unit { int pm, pn, ord; };

template <class S, class = void> struct SchedVarK { static constexpr bool value = false; };
template <class S> struct SchedVarK<S, decltype((void)S::VARK)> { static constexpr bool value = S::VARK; };
typedef int v4i_t __attribute__((ext_vector_type(4)));
typedef int v8i_t __attribute__((ext_vector_type(8)));
__device__ __forceinline__ v8i_t cat8(const bf16x8& lo, const bf16x8& hi) { return __builtin_shufflevector(__builtin_bit_cast(v4i_t, lo), __builtin_bit_cast(v4i_t, hi), 0, 1, 2, 3, 4, 5, 6, 7); }
template <class Epi, class Sched, bool ALIGN_EPI, bool F8 = false>
__device__ __forceinline__ void gemm_phase(LAS unsigned char* lds, const int K, const Sched& S, const Epi& E) {
    int tid_ = threadIdx.x; asm volatile("" : "+v"(tid_));
    const int tid = tid_, wid = __builtin_amdgcn_readfirstlane(tid >> 6), lane = tid & 63, wr = wid >> 2, wc = wid & 3, fr = lane & 15, fq = lane >> 4;
    int nt = K / BK;
    int Rr[2], Cc[2]; unsigned vB[2][2];
#pragma unroll
    for (int i = 0; i < 2; ++i) { stage_rc(tid * 16 + i * 8192, Rr[i], Cc[i]); const int Rb = (Rr[i] & ~31) + perm32(Rr[i] & 31);
        vB[0][i] = (unsigned)(Rb * S.ldb + Cc[i]) * 2u; vB[1][i] = (unsigned)((HALF + Rb) * S.ldb + Cc[i]) * 2u; }
    const size_t kstep = (size_t)(BK * 2);
    const unsigned ldsw = (unsigned)wid * 1024u;
    const int aoff = lds_byte(wr * 64 + fr, fq * 8), boff = lds_byte(wc * 32 + fr, fq * 8);
    const int aoff1 = lds_byte(wr * 64 + fr, fq * 8 + 32), boff1 = lds_byte(wc * 32 + fr, fq * 8 + 32);
#define PG8_SA(b, h) (((b) * 2 + (h)) * HTB)
#define PG8_SB(b, h) ((4 + (b) * 2 + (h)) * HTB)
#define PG8_STAGE(bufoff, gbase, voff) do { _Pragma("unroll") for (int _i = 0; _i < 2; ++_i) \
        __builtin_amdgcn_global_load_lds((const unsigned*)((const char*)(gbase) + (voff)[_i]), (LAS unsigned*)(lds + (bufoff) + ldsw + _i * 8192), 16, 0, 0); } while (0)
#define PG8_LDA(dst, b, h) do { _Pragma("unroll") for (int m = 0; m < 4; ++m) { \
        const bf16x8 f0_ = *(const LAS bf16x8*)(lds + PG8_SA(b, h) + aoff + m * 2048), f1_ = *(const LAS bf16x8*)(lds + PG8_SA(b, h) + aoff1 + m * 2048); \
        if constexpr (F8) dst##8[m] = cat8(f0_, f1_); else { dst[m][0] = f0_; dst[m][1] = f1_; } } } while (0)
#define PG8_LDB(dst, b, h) do { _Pragma("unroll") for (int n = 0; n < 2; ++n) { \
        const bf16x8 f0_ = *(const LAS bf16x8*)(lds + PG8_SB(b, h) + boff + n * 2048), f1_ = *(const LAS bf16x8*)(lds + PG8_SB(b, h) + boff1 + n * 2048); \
        if constexpr (F8) dst##8[n] = cat8(f0_, f1_); else { dst[n][0] = f0_; dst[n][1] = f1_; } } } while (0)
#define PG8_MMA(ai, bj, At, Bt) do { __builtin_amdgcn_s_setprio(1); \
        if constexpr (F8) { _Pragma("unroll") for (int m = 0; m < 4; ++m) _Pragma("unroll") for (int n = 0; n < 2; ++n) \
            asm volatile("v_mfma_scale_f32_16x16x128_f8f6f4 %0, %1, %2, %0, %3, %4 op_sel_hi:[0,0,0]" : "+v"(acc[ai][bj][m][n]) : "v"(Bt##8[n]), "v"(At##8[m]), "v"(scw8), "v"(sca8)); } \
              \
        else { _Pragma("unroll") for (int m = 0; m < 4; ++m) _Pragma("unroll") for (int n = 0; n < 2; ++n) _Pragma("unroll") for (int k = 0; k < 2; ++k) \
            acc[ai][bj][m][n] = __builtin_amdgcn_mfma_f32_16x16x32_bf16(Bt[n][k], At[m][k], acc[ai][bj][m][n], 0, 0, 0); } \
        __builtin_amdgcn_s_setprio(0); } while (0)
#define PG8_WAIT_V(n) asm volatile("s_waitcnt vmcnt(" #n ")" ::: "memory")
#define PG8_WAIT_L(n) asm volatile("s_waitcnt lgkmcnt(" #n ")" ::: "memory")
#define PG8_BAR __builtin_amdgcn_s_barrier()
#define PG8_SCHED __builtin_amdgcn_sched_barrier(0)
    int scw8 = 0, sca8 = 0;
    if constexpr (F8) { scw8 = S.sw8 * 0x01010101; sca8 = S.sa8 * 0x01010101; }
    Unit cur, nxt; int ui = 0;
    if (!S.next(0, cur)) return;
    f32x4 acc[2][2][4][2];
#pragma unroll
    for (int a = 0; a < 2; ++a)
#pragma unroll
        for (int b = 0; b < 2; ++b)
#pragma unroll
            for (int m = 0; m < 4; ++m)
#pragma unroll
                for (int n = 0; n < 2; ++n) acc[a][b][m][n] = (f32x4){0.f, 0.f, 0.f, 0.f};
    bf16x8 At[4][2], B0[2][2], B1[2][2]; v8i_t At8[4], B08[2], B18[2];
    unsigned vAc[2][2], vAn[2][2];
    const char* cA = S.a_base(cur); const char* cB = S.b_base(cur);
    S.a_off(cur, Rr, Cc, vAc);
    if constexpr (SchedVarK<Sched>::value) nt = S.ktiles(cur);
    PG8_STAGE(PG8_SB(0, 0), cB, vB[0]); PG8_STAGE(PG8_SB(0, 1), cB, vB[1]); PG8_STAGE(PG8_SA(0, 0), cA, vAc[0]); PG8_STAGE(PG8_SA(0, 1), cA, vAc[1]);
    if (wr == 1) PG8_BAR;
    PG8_WAIT_V(2); PG8_BAR;
    PG8_STAGE(PG8_SB(1, 0), cB + kstep, vB[0]); PG8_STAGE(PG8_SA(1, 0), cA + kstep, vAc[0]); PG8_STAGE(PG8_SB(1, 1), cB + kstep, vB[1]);
    PG8_WAIT_V(6); PG8_BAR;
    bool epi_pend = false;
    for (;;) {
        const bool has_next = S.next(ui + 1, nxt);
        const char* nA = cA; const char* nB = cB;
        if constexpr (Sched::GATHER) {
#pragma unroll
            for (int h = 0; h < 2; ++h)
#pragma unroll
                for (int i = 0; i < 2; ++i) vAn[h][i] = vAc[h][i];
        }
        if (has_next) { nA = S.a_base(nxt); nB = S.b_base(nxt); if constexpr (Sched::GATHER) S.a_off(nxt, Rr, Cc, vAn); }
#pragma nounroll
        for (int t = 0; t < nt; t += 2) {
            const bool last = (t == nt - 2);
            const bool ep_ = epi_pend && t == 0;
            const char* a1 = cA + (size_t)(t + 1) * kstep;
            const char* a2 = last ? nA : cA + (size_t)(t + 2) * kstep; const char* b2 = last ? nB : cB + (size_t)(t + 2) * kstep;
            const char* a3 = a2 + kstep; const char* b3 = b2 + kstep;
            unsigned vA2[2][2];
#pragma unroll
            for (int h = 0; h < 2; ++h)
#pragma unroll
                for (int i = 0; i < 2; ++i) { if constexpr (Sched::GATHER) vA2[h][i] = last ? vAn[h][i] : vAc[h][i]; else vA2[h][i] = vAc[h][i]; }
            PG8_LDB(B0, 0, 0); PG8_LDB(B1, 0, 1); PG8_SCHED; PG8_LDA(At, 0, 0); PG8_STAGE(PG8_SA(1, 1), a1, vAc[1]);
            if (ep_) { PG8_WAIT_V(24); } else { PG8_WAIT_V(8); } PG8_WAIT_L(0); PG8_BAR; PG8_MMA(0, 0, At, B0); PG8_MMA(0, 1, At, B1); PG8_BAR; PG8_SCHED;
            PG8_LDA(At, 0, 1); PG8_STAGE(PG8_SB(0, 0), b2, vB[0]); PG8_STAGE(PG8_SB(0, 1), b2, vB[1]); PG8_STAGE(PG8_SA(0, 0), a2, vA2[0]);
            if (ep_) { PG8_WAIT_V(24); } else { PG8_WAIT_V(8); } PG8_WAIT_L(0); PG8_BAR; PG8_MMA(1, 0, At, B0); PG8_MMA(1, 1, At, B1); PG8_BAR; PG8_SCHED;
            PG8_LDB(B0, 1, 0); PG8_LDB(B1, 1, 1); PG8_SCHED; PG8_LDA(At, 1, 0); PG8_STAGE(PG8_SA(0, 1), a2, vA2[1]);
            PG8_WAIT_V(8); PG8_WAIT_L(0); PG8_BAR; PG8_MMA(0, 0, At, B0); PG8_MMA(0, 1, At, B1); PG8_BAR; PG8_SCHED;
            PG8_LDA(At, 1, 1); PG8_STAGE(PG8_SB(1, 0), b3, vB[0]); PG8_STAGE(PG8_SB(1, 1), b3, vB[1]); PG8_STAGE(PG8_SA(1, 0), a3, vA2[0]);
            PG8_WAIT_V(8); PG8_WAIT_L(0); PG8_BAR; PG8_MMA(1, 0, At, B0); PG8_MMA(1, 1, At, B1); PG8_BAR; PG8_SCHED;
        }
        if constexpr (ALIGN_EPI) { if (wr == 0) PG8_BAR; }
        if constexpr (F8) asm volatile("s_nop 15\n\ts_nop 15" ::: "memory");
        { int l2_ = lane; asm volatile("" : "+v"(l2_)); E(acc, cur, wr, wc, l2_ & 15, l2_ >> 4); }
        if (!has_next) break;
        epi_pend = true;
#pragma unroll
        for (int a = 0; a < 2; ++a)
#pragma unroll
            for (int b = 0; b < 2; ++b)
#pragma unroll
                for (int m = 0; m < 4; ++m)
#pragma unroll
                    for (int n = 0; n < 2; ++n) acc[a][b][m][n] = (f32x4){0.f, 0.f, 0.f, 0.f};
        cur = nxt; cA = nA; cB = nB; ++ui;
        if constexpr (SchedVarK<Sched>::value) nt = S.ktiles(cur);
        if constexpr (Sched::GATHER) {
#pragma unroll
            for (int h = 0; h < 2; ++h)
#pragma unroll
                for (int i = 0; i < 2; ++i) vAc[h][i] = vAn[h][i];
        }
        if constexpr (ALIGN_EPI) { if (wr == 1) PG8_BAR; }
    }
    PG8_WAIT_V(0);
    if constexpr (!ALIGN_EPI) { if (wr == 0) PG8_BAR; }
    asm volatile("s_waitcnt vmcnt(0) lgkmcnt(0)\n\ts_barrier" ::: "memory");
    __builtin_amdgcn_sched_barrier(0);
#undef PG8_SA
#undef PG8_SB
#undef PG8_STAGE
#undef PG8_LDA
#undef PG8_LDB
#undef PG8_MMA
#undef PG8_WAIT_V
#undef PG8_WAIT_L
#undef PG8_BAR
#undef PG8_SCHED
}

struct DenseSched {
    static constexpr bool GATHER = false;
    const bf16_t* A; const bf16_t* Bt; int lda, ldb, nM, nN, G, c;
    __device__ __forceinline__ bool next(int i, Unit& u) const { const int v = i * G + c; if (v >= nM * nN) return false; u.pm = v / nN; u.pn = v % nN; u.ord = i; return true; }
    __device__ __forceinline__ const char* a_base(const Unit& u) const { return (const char*)(A + (size_t)u.pm * BM * lda); }
    __device__ __forceinline__ const char* b_base(const Unit& u) const { return (const char*)(Bt + (size_t)u.pn * BM * ldb); }
    __device__ __forceinline__ void a_off(const Unit&, const int (&R)[2], const int (&C)[2], unsigned (&v)[2][2]) const {
#pragma unroll
        for (int i = 0; i < 2; ++i) { v[0][i] = (unsigned)(R[i] * lda + C[i]) * 2u; v[1][i] = (unsigned)((HALF + R[i]) * lda + C[i]) * 2u; }
    }
};
struct DenseSched8 : DenseSched { int sw8, sa8; };
struct ProjSched8 : DenseSched8 {
    __device__ __forceinline__ bool next(int i, Unit& u) const {
        if (nN != 28 || (nM & 1) || (G & 7)) return DenseSched::next(i, u);
        const int x = c & 7, wl = i * (G >> 3) + (c >> 3), half = nM >> 1;
        if (wl >= half * 7) return false;
        u.pm = (x >> 2) * half + wl / 7; u.pn = 7 * (x & 3) + wl % 7; u.ord = i; return true;
    }
};
}

#define XB_TMO      128
#define XB_XCNT(j)  (256  + 64 * (j))
#define XB_XSUB(j)  (1280 + 64 * (j))
#define XB_XGEN(j)  (2304 + 64 * (j))
#define XB_TOP      3328
#define XB_TOPGEN   3392
#define XCD_BAR_WORDS 3456
#define XB_SPIN_CAP (1u << 18)
__device__ __forceinline__ unsigned xb_ld(unsigned* p)              { return __hip_atomic_load(p, __ATOMIC_RELAXED, __HIP_MEMORY_SCOPE_AGENT); }
__device__ __forceinline__ unsigned xb_add(unsigned* p, unsigned v) { return __hip_atomic_fetch_add(p, v, __ATOMIC_RELAXED, __HIP_MEMORY_SCOPE_AGENT); }
__device__ __forceinline__ unsigned xb_xcc_id() { return (unsigned)__builtin_amdgcn_s_getreg((3 << 11) | 20) & 0xFu; }
#define XB_SPIN(cond, bar) do { unsigned _sp = 0; while (cond) { __builtin_amdgcn_s_sleep(1); \
    if ((++_sp & 255u) == 0u) { if (xb_ld(&(bar)[XB_TMO])) break; if (_sp > XB_SPIN_CAP) { atomicAdd(&(bar)[XB_TMO], 1u); break; } } } } while (0)
struct XcdBarrier { unsigned* bar; unsigned x; volatile LAS unsigned* st; };
__device__ __forceinline__ XcdBarrier xcd_barrier_post(unsigned* bar, volatile LAS unsigned* st) {
    XcdBarrier b; b.bar = bar; b.x = xb_xcc_id(); b.st = st;
    if (threadIdx.x == 0) (void)xb_add(&bar[XB_XCNT(b.x)], 1u);
    return b;
}
__device__ __forceinline__ void xcd_barrier_complete(unsigned* bar, unsigned x, unsigned& nloc, unsigned& nx) {
    const unsigned G = gridDim.x * gridDim.y * gridDim.z;
    unsigned sum, cnt, mine, sp = 0u;
    for (;;) {
        sum = 0u; cnt = 0u; mine = 0u;
#pragma unroll
        for (unsigned j = 0; j < 16; ++j) { const unsigned c = xb_ld(&bar[XB_XCNT(j)]); sum += c; cnt += (c > 0u) ? 1u : 0u; mine = (j == x) ? c : mine; }
        if (sum == G) break;
        __builtin_amdgcn_s_sleep(1);
        if ((++sp & 255u) == 0u) { if (xb_ld(&bar[XB_TMO])) break; if (sp > XB_SPIN_CAP) { atomicAdd(&bar[XB_TMO], 1u); break; } }
    }
    nloc = mine > 0u ? mine : 1u; nx = cnt > 0u ? cnt : 1u;
}
__device__ __forceinline__ void xcd_barrier(const XcdBarrier& b) {
    asm volatile("s_waitcnt vmcnt(0)" ::: "memory");
    __syncthreads();
    if (threadIdx.x == 0) {
        unsigned* bar = b.bar;
        __builtin_amdgcn_s_waitcnt(0);
        unsigned nloc = b.st[0], nx = b.st[1];
        if (nloc == 0u) { xcd_barrier_complete(bar, b.x, nloc, nx); b.st[0] = nloc; b.st[1] = nx; }
        const unsigned old = xb_add(&bar[XB_XSUB(b.x)], 1u);
        const unsigned gen = old / nloc;
        if (old + 1u == (gen + 1u) * nloc) {
            __builtin_amdgcn_fence(__ATOMIC_RELEASE, "agent");
            asm volatile("s_waitcnt vmcnt(0)" ::: "memory");
            const unsigned og = xb_add(&bar[XB_TOP], 1u);
            const unsigned tg = og / nx;
            if (og + 1u == (tg + 1u) * nx) xb_add(&bar[XB_TOPGEN], 1u);
            else XB_SPIN(xb_ld(&bar[XB_TOPGEN]) == tg, bar);
            __builtin_amdgcn_fence(__ATOMIC_ACQUIRE, "agent");
            xb_add(&bar[XB_XGEN(b.x)], 1u);
            asm volatile("s_waitcnt vmcnt(0)" ::: "memory");
        } else {
            XB_SPIN(xb_ld(&bar[XB_XGEN(b.x)]) == gen, bar);
            __builtin_amdgcn_fence(__ATOMIC_ACQUIRE, "agent");
            asm volatile("s_waitcnt vmcnt(0)" ::: "memory");
        }
    }
    __syncthreads();
}

constexpr size_t MiB = 1u << 20;
constexpr size_t WS_CTL = 0, CTL_ZERO_BYTES = 1 * MiB;
constexpr int CW_BAR = 4096;
constexpr int CW_QUEUE = 16384;
constexpr size_t WS_W13 = 2 * MiB;
constexpr size_t WS_W2  = 34 * MiB;
constexpr size_t WS_WR  = 50 * MiB;
constexpr size_t WS_MISC = 51 * MiB;
constexpr size_t WS_ROUTE = 52 * MiB;
constexpr size_t WS_RPOS = 53 * MiB;
constexpr size_t WS_ROWTOK = 54 * MiB;
constexpr size_t WS_ROPE = 55 * MiB;
constexpr size_t WS_WUQ = 56 * MiB;
constexpr size_t WS_WUKV = 57 * MiB;
constexpr size_t WS_WA = 58 * MiB;
constexpr size_t WS_WB = 59 * MiB;
constexpr size_t WS_WC = 60 * MiB;
constexpr size_t WS_WO = 61 * MiB;
constexpr size_t WS_SSQ = 63 * MiB;
constexpr size_t WS_LSE = 64 * MiB;
constexpr size_t WS_MASK = 66 * MiB;
constexpr size_t WS_XB8 = 74 * MiB;
constexpr size_t WS_WIN8 = 138 * MiB;
constexpr size_t WS_H = 146 * MiB;
constexpr size_t WS_Y = 182 * MiB;
constexpr size_t WS_SC = WS_Y;
constexpr size_t WS_G3 = 254 * MiB;
constexpr size_t WS_PROJ = 350 * MiB;
constexpr size_t WS_QM = 606 * MiB;
constexpr size_t WS_KVM = 654 * MiB;
constexpr size_t WS_OA = 718 * MiB;
constexpr size_t WS_OB = 734 * MiB;
constexpr size_t WS_OC = 750 * MiB;
constexpr size_t WS_OG = 766 * MiB;
constexpr size_t WS_M0 = 814 * MiB;
constexpr size_t WS_M1 = 846 * MiB;
constexpr size_t WS_MERGED = 878 * MiB;
constexpr size_t WS_END = 910 * MiB;
constexpr int F8_SA_X = 127 - 4, F8_SW = 127 - 10;
constexpr int MAXROWS = 139264;
constexpr int NBC = 16, TC = NBC * SEQ, NCHUNK = NB / NBC;
constexpr int CIN = 3944, PW = 4096;

constexpr int MI_BLOCKCNT = 0;
constexpr int MI_PANEL_E = 8192;
constexpr int MI_NPAN = 8192 + 1024;

constexpr int RING_BYTES = 131072;
constexpr int L_CTL = RING_BYTES;
constexpr int L_BARW = L_CTL + 32;
constexpr int L_HIST = L_CTL + 256;
constexpr int L_TOT  = L_CTL + 384;
constexpr int L_PRE  = L_CTL + 512;
constexpr int L_BASE = L_CTL + 640;
constexpr int L_RANK = L_CTL + 896;
constexpr int L_PE   = L_CTL + 1024;
constexpr int L_ROWS = L_CTL + 2048;
constexpr int LDS_BYTES = 147456;
constexpr int L_GB = L_ROWS;
static_assert(L_ROWS + 12288 <= LDS_BYTES, "LDS map");

#ifndef DUPMASK
#define DUPMASK 0
#endif
struct Args { const float* in[23]; float* out; unsigned char* ws; };
#define PHASE_IDS(F) do { int t_ = threadIdx.x; asm volatile("" : "+v"(t_)); (F).tid = t_; (F).lane = t_ & 63; { intab_t p_ = (intab_t)__builtin_amdgcn_kernarg_segment_ptr(); asm volatile("" : "+s"(p_)); (F).in.p = p_; } \
    { unsigned char GAS* w_ = (unsigned char GAS*)(F).ws0; asm volatile("" : "+s"(w_)); (F).ws = (unsigned char*)w_; float GAS* o_ = (float GAS*)(F).out0; asm volatile("" : "+s"(o_)); (F).out = (float*)o_; } } while (0)

typedef const float GAS* gfptr_t;
typedef const gfptr_t __attribute__((address_space(4)))* intab_t;
struct InTab { intab_t p; __device__ __forceinline__ const float* operator[](int i) const { return (const float*)p[i]; } };
struct Frame {
    LAS unsigned char* lds;
    int tid, lane, wave, vcu, G;
    InTab in; float* out; unsigned char* ws; float* out0; unsigned char* ws0;
};

template <class F>
__device__ __forceinline__ void conv_item(bf16_t* WT, int ldk, int k0, int n0, LAS float* scr, int lane, F val) {
#pragma unroll 8
    for (int i = 0; i < 32; ++i) { const int kk = 2 * i + (lane >> 5); scr[kk * 33 + (lane & 31)] = val(k0 + kk, n0 + (lane & 31)); }
    LDS_WAIT(); asm volatile("" ::: "memory");
    const int c = lane & 7;
#pragma unroll
    for (int j = 0; j < 4; ++j) { const int n = (lane >> 3) + 8 * j; const LAS float* s = scr + (8 * c) * 33 + n;
        u32x4 o; o.x = pk2(s[0 * 33], s[1 * 33]); o.y = pk2(s[2 * 33], s[3 * 33]); o.z = pk2(s[4 * 33], s[5 * 33]); o.w = pk2(s[6 * 33], s[7 * 33]);
        *(u32x4*)(WT + (size_t)(n0 + n) * ldk + k0 + 8 * c) = o; }
    LDS_WAIT(); asm volatile("" ::: "memory");
}

template <class F>
__device__ __forceinline__ void conv_item8(unsigned char* WT, int ldk, int k0, int n0, LAS float* scr, int lane, F val) {
#pragma unroll 8
    for (int i = 0; i < 32; ++i) { const int kk = 2 * i + (lane >> 5); scr[kk * 33 + (lane & 31)] = val(k0 + kk, n0 + (lane & 31)); }
    LDS_WAIT(); asm volatile("" ::: "memory");
    const int c = lane & 7;
#pragma unroll
    for (int j = 0; j < 4; ++j) { const int n = (lane >> 3) + 8 * j; const LAS float* s = scr + (8 * c) * 33 + n;
        u32x2 o; o.x = pk4_fp8(s[0 * 33], s[1 * 33], s[2 * 33], s[3 * 33]); o.y = pk4_fp8(s[4 * 33], s[5 * 33], s[6 * 33], s[7 * 33]);
        *(u32x2*)(WT + (size_t)(n0 + n) * ldk + k0 + 8 * c) = o; }
    LDS_WAIT(); asm volatile("" ::: "memory");
}

__device__ __forceinline__ void conv_plain8(unsigned char* WT, int ldk, int k0, int n0, LAS float* scr, int lane, const float* src, int pitch, float sc) {
    f32x4 v[8];
#pragma unroll
    for (int i = 0; i < 8; ++i) v[i] = *(const f32x4*)(src + (size_t)(k0 + (lane >> 3) + 8 * i) * pitch + n0 + (lane & 7) * 4);
#pragma unroll
    for (int i = 0; i < 8; ++i) { LAS float* d = scr + ((lane >> 3) + 8 * i) * 33 + (lane & 7) * 4; d[0] = v[i][0] * sc; d[1] = v[i][1] * sc; d[2] = v[i][2] * sc; d[3] = v[i][3] * sc; }
    LDS_WAIT(); asm volatile("" ::: "memory");
    const int c = lane & 7;
#pragma unroll
    for (int j = 0; j < 4; ++j) { const int n = (lane >> 3) + 8 * j; const LAS float* s = scr + (8 * c) * 33 + n;
        u32x2 o; o.x = pk4_fp8(s[0 * 33], s[1 * 33], s[2 * 33], s[3 * 33]); o.y = pk4_fp8(s[4 * 33], s[5 * 33], s[6 * 33], s[7 * 33]);
        *(u32x2*)(WT + (size_t)(n0 + n) * ldk + k0 + 8 * c) = o; }
    LDS_WAIT(); asm volatile("" ::: "memory");
}
__device__ __forceinline__ void conv_pair8(unsigned char* WT, int ldk, int k0, int n0, LAS float* scr, int lane, const float* a, const float* b, int pitch, float sc) {
    f32x2 va[8], vb[8];
#pragma unroll
    for (int i = 0; i < 8; ++i) { const size_t o = (size_t)(k0 + (lane >> 3) + 8 * i) * pitch + (n0 >> 1) + (lane & 7) * 2; va[i] = *(const f32x2*)(a + o); vb[i] = *(const f32x2*)(b + o); }
#pragma unroll
    for (int i = 0; i < 8; ++i) { LAS float* d = scr + ((lane >> 3) + 8 * i) * 33 + (lane & 7) * 4; d[0] = va[i][0] * sc; d[1] = vb[i][0] * sc; d[2] = va[i][1] * sc; d[3] = vb[i][1] * sc; }
    LDS_WAIT(); asm volatile("" ::: "memory");
    const int c = lane & 7;
#pragma unroll
    for (int j = 0; j < 4; ++j) { const int n = (lane >> 3) + 8 * j; const LAS float* s = scr + (8 * c) * 33 + n;
        u32x2 o; o.x = pk4_fp8(s[0 * 33], s[1 * 33], s[2 * 33], s[3 * 33]); o.y = pk4_fp8(s[4 * 33], s[5 * 33], s[6 * 33], s[7 * 33]);
        *(u32x2*)(WT + (size_t)(n0 + n) * ldk + k0 + 8 * c) = o; }
    LDS_WAIT(); asm volatile("" ::: "memory");
}

__device__ __forceinline__ void phase_conv_moe(Frame& F, int l) {
    PHASE_IDS(F);
    LAS float* scr = (LAS float*)(F.lds + F.wave * 16384);
    const int gw = F.vcu * NWAVES + F.wave, NGW = F.G * NWAVES;
    const float* w1 = F.in[18] + (size_t)l * NEXP * DM * DEXP;
    const float* w3 = F.in[19] + (size_t)l * NEXP * DM * DEXP;
    const float* w2 = F.in[20] + (size_t)l * NEXP * DEXP * DM;
    bf16_t* W13 = (bf16_t*)(F.ws + WS_W13); bf16_t* W2 = (bf16_t*)(F.ws + WS_W2);
    constexpr int I13 = (DM / 64) * (512 / 32);
    constexpr int I2 = (DEXP / 64) * (DM / 32);
    for (int it = gw; it < NEXP * (I13 + I2); it += NGW) {
        if (it < NEXP * I13) {
            const int e = it / I13, r = it % I13, kb = r / 16, nb = r % 16;
            const float* a = w1 + (size_t)e * DM * DEXP; const float* b = w3 + (size_t)e * DM * DEXP;
            conv_pair8((unsigned char*)W13 + (size_t)e * 512 * DM, DM, kb * 64, nb * 32, scr, F.lane, a, b, DEXP, 1024.f);
        } else {
            const int it2 = it - NEXP * I13; const int e = it2 / I2, r = it2 % I2, kb = r / 32, nb = r % 32;
            const float* a = w2 + (size_t)e * DEXP * DM;
            conv_plain8((unsigned char*)W2 + (size_t)e * DM * DEXP, DEXP, kb * 64, nb * 32, scr, F.lane, a, DM, 1024.f);
        }
    }
    const float* wg = F.in[14] + (size_t)l * DM * 4; const float* wsb = F.in[16] + (size_t)l * DM * NEXP;
    const float* g1 = F.in[12] + (size_t)l * DM; const float* b1 = F.in[13] + (size_t)l * DM;
    bf16_t* WRH = (bf16_t*)(F.ws + WS_WR); bf16_t* WRL = (bf16_t*)(F.ws + WS_WR + 128 * 1024); float* WRC = (float*)(F.ws + WS_WR + 256 * 1024);
    for (int idx = (F.vcu * NTHREADS + F.tid); idx < 64 * DM; idx += F.G * NTHREADS) {
        const int c = idx / DM, k = idx % DM;
        const float v = (c < 32 ? wsb[(size_t)k * NEXP + c] : (c < 36 ? wg[(size_t)k * 4 + (c - 32)] : 0.f)) * g1[k];
        const unsigned h = f2bf(v); const int it = k >> 5, hi_ = (k >> 4) & 1, st = (k >> 3) & 1, e = k & 7, ln = (c & 31) + 32 * hi_, p0 = 2 * (c >> 5);
        WRH[((((size_t)it * 4 + p0) * 2 + st) * 64 + ln) * 8 + e] = (bf16_t)h;
        WRH[((((size_t)it * 4 + p0 + 1) * 2 + st) * 64 + ln) * 8 + e] = (bf16_t)f2bf(v - __builtin_bit_cast(float, h << 16)); (void)WRL;
    }
    if (gw < 64) {
        const int c = gw; float s1 = 0.f, s2 = 0.f;
        for (int k = F.lane; k < DM; k += 64) { const float w = c < 32 ? wsb[(size_t)k * NEXP + c] : (c < 36 ? wg[(size_t)k * 4 + (c - 32)] : 0.f); s1 += g1[k] * w; s2 += b1[k] * w; }
        s1 = wave_sum(s1); s2 = wave_sum(s2);
        const float bias = c < 32 ? F.in[17][(size_t)l * NEXP + c] : (c < 36 ? F.in[15][(size_t)l * 4 + (c - 32)] : 0.f);
        if (F.lane == 0) { WRC[c] = s1; WRC[64 + c] = s2 + bias; }
    }
}

__device__ __forceinline__ void ln_row(f32x4 (&v)[4], const f32x4 (&g)[4], const f32x4 (&b)[4], float* omean = nullptr, float* orstd = nullptr) {
    float s = 0.f;
#pragma unroll
    for (int j = 0; j < 4; ++j) s += (v[j].x + v[j].y) + (v[j].z + v[j].w);
    const float mean = wave_sum(s) * (1.f / DM); float s2 = 0.f;
#pragma unroll
    for (int j = 0; j < 4; ++j) { v[j] = v[j] - mean; s2 += (v[j].x * v[j].x + v[j].y * v[j].y) + (v[j].z * v[j].z + v[j].w * v[j].w); }
    const float rstd = 1.0f / sqrtf(wave_sum(s2) * (1.f / DM) + LN_EPS);
#pragma unroll
    for (int j = 0; j < 4; ++j) v[j] = v[j] * rstd * g[j] + b[j];
    if (omean) { *omean = mean; *orstd = rstd; }
}
__device__ __forceinline__ void store_row(const f32x4 (&v)[4], float* orow, unsigned char* brow, int lane) {
#pragma unroll
    for (int j = 0; j < 4; ++j) {
        ((f32x4*)orow)[lane + 64 * j] = v[j];
        ((unsigned*)brow)[lane + 64 * j] = pk4_fp8(v[j].x * 16.f, v[j].y * 16.f, v[j].z * 16.f, v[j].w * 16.f);
    }
}

__device__ __forceinline__ void phase_ln1_router(Frame& F, int l, const float* src, bool scale_alpha) {
    PHASE_IDS(F);
    const int lane = F.lane, hi = lane >> 5, r32 = lane & 31;
    const float* lg = F.in[12] + (size_t)l * DM; const float* lb = F.in[13] + (size_t)l * DM;
    f32x4 g[4], b[4];
#pragma unroll
    for (int j = 0; j < 4; ++j) { g[j] = ((const f32x4*)lg)[lane + 64 * j]; b[j] = ((const f32x4*)lb)[lane + 64 * j]; }
    unsigned char* XB = F.ws + WS_XB8;
    const bf16_t* WRH = (const bf16_t*)(F.ws + WS_WR); const bf16_t* WRL = (const bf16_t*)(F.ws + WS_WR + 128 * 1024);
    const float* WRC = (const float*)(F.ws + WS_WR + 256 * 1024); float* stats = (float*)(F.ws + WS_WR + 512 * 1024);
    unsigned* misc = (unsigned*)(F.ws + WS_MISC);
    int* route = (int*)(F.ws + WS_ROUTE);
    LAS unsigned* hist = (LAS unsigned*)(F.lds + L_HIST);
    const float sc = scale_alpha ? ALPHA : 1.0f;
    for (int blk = F.vcu; blk < TT / 256; blk += F.G) {
        if (F.tid < 32) hist[F.tid] = 0u;
        __syncthreads();
        const int row0 = blk * 256 + F.wave * 32;
        float mu_l = 0.f, rs_l = 1.f;
        for (int i = 0; i < 32; i += 2) {
            f32x4 v0[4], v1[4];
            const f32x4* p0 = (const f32x4*)(src + (size_t)(row0 + i) * DM); const f32x4* p1 = (const f32x4*)(src + (size_t)(row0 + i + 1) * DM);
#pragma unroll
            for (int j = 0; j < 4; ++j) { v0[j] = p0[lane + 64 * j] * sc; v1[j] = p1[lane + 64 * j] * sc; }
            float m0, r0, m1, r1;
            ln_row(v0, g, b, &m0, &r0); ln_row(v1, g, b, &m1, &r1);
            mu_l = (r32 == i) ? m0 : ((r32 == i + 1) ? m1 : mu_l); rs_l = (r32 == i) ? r0 : ((r32 == i + 1) ? r1 : rs_l);
#pragma unroll
            for (int j = 0; j < 4; ++j) {
                ((unsigned*)(XB + (size_t)(row0 + i) * DM))[lane + 64 * j] = pk4_fp8(v0[j].x * 16.f, v0[j].y * 16.f, v0[j].z * 16.f, v0[j].w * 16.f);
                ((unsigned*)(XB + (size_t)(row0 + i + 1) * DM))[lane + 64 * j] = pk4_fp8(v1[j].x * 16.f, v1[j].y * 16.f, v1[j].z * 16.f, v1[j].w * 16.f); }
        }
        if (hi == 0) *(f32x2*)(stats + (size_t)(row0 + r32) * 2) = (f32x2){mu_l, rs_l};
        f32x16 acc0 = {}, acc1 = {};
        {
            const bf16_t* WT = WRH; (void)WRL;
            LAS float* xs = (LAS float*)(F.lds + F.wave * 9216);
            const float* xg = src + (size_t)(row0 + (lane >> 3)) * DM + (lane & 7) * 4;
            f32x4 xv[4]; bf16x8 wv[8];
#pragma unroll
            for (int i = 0; i < 4; ++i) xv[i] = *(const f32x4*)(xg + (size_t)(8 * i) * DM);
#pragma unroll
            for (int q = 0; q < 8; ++q) wv[q] = *(const bf16x8*)(WT + ((size_t)q * 64 + lane) * 8);
#pragma unroll 2
            for (int it = 0; it < 32; ++it) {
                LAS float* xb = xs + (it & 1) * 1152;
#pragma unroll
                for (int i = 0; i < 4; ++i) *(LAS f32x4*)(xb + ((lane >> 3) + 8 * i) * 36 + (lane & 7) * 4) = xv[i];
                bf16x8 wc[8];
#pragma unroll
                for (int q = 0; q < 8; ++q) wc[q] = wv[q];
                { const int nx = it + 1 < 32 ? it + 1 : 31;
#pragma unroll
                  for (int i = 0; i < 4; ++i) xv[i] = *(const f32x4*)(xg + (size_t)(8 * i) * DM + nx * 32);
#pragma unroll
                  for (int q = 0; q < 8; ++q) wv[q] = *(const bf16x8*)(WT + (((size_t)nx * 8 + q) * 64 + lane) * 8); }
                f32x4 xa[4];
#pragma unroll
                for (int j = 0; j < 4; ++j) xa[j] = *(const LAS f32x4*)(xb + r32 * 36 + hi * 16 + 4 * j);
#pragma unroll
                for (int st = 0; st < 2; ++st) {
                    const f32x4 x0 = xa[2 * st], x1 = xa[2 * st + 1];
                    u32x4 xh, xl;
                    xh.x = cvt_pk_bf16(x0[0], x0[1]); xh.y = cvt_pk_bf16(x0[2], x0[3]); xh.z = cvt_pk_bf16(x1[0], x1[1]); xh.w = cvt_pk_bf16(x1[2], x1[3]);
                    xl.x = cvt_pk_bf16(x0[0] - bflo(xh.x), x0[1] - bfhi(xh.x)); xl.y = cvt_pk_bf16(x0[2] - bflo(xh.y), x0[3] - bfhi(xh.y));
                    xl.z = cvt_pk_bf16(x1[0] - bflo(xh.z), x1[1] - bfhi(xh.z)); xl.w = cvt_pk_bf16(x1[2] - bflo(xh.w), x1[3] - bfhi(xh.w));
                    const bf16x8 xhv = __builtin_bit_cast(bf16x8, xh), xlv = __builtin_bit_cast(bf16x8, xl);
                    acc0 = __builtin_amdgcn_mfma_f32_32x32x16_bf16(wc[0 + st], xhv, acc0, 0, 0, 0); acc1 = __builtin_amdgcn_mfma_f32_32x32x16_bf16(wc[4 + st], xhv, acc1, 0, 0, 0);
                    acc0 = __builtin_amdgcn_mfma_f32_32x32x16_bf16(wc[2 + st], xhv, acc0, 0, 0, 0); acc1 = __builtin_amdgcn_mfma_f32_32x32x16_bf16(wc[6 + st], xhv, acc1, 0, 0, 0);
                    acc0 = __builtin_amdgcn_mfma_f32_32x32x16_bf16(wc[0 + st], xlv, acc0, 0, 0, 0); acc1 = __builtin_amdgcn_mfma_f32_32x32x16_bf16(wc[4 + st], xlv, acc1, 0, 0, 0);
                }
            }
        }
        float gl[4];
#pragma unroll
        for (int i = 0; i < 4; ++i) gl[i] = rs_l * (acc1[i] - mu_l * WRC[32 + i]) + WRC[64 + 32 + i];
        int gidx = 0; float gmax = gl[0];
#pragma unroll
        for (int i = 1; i < 4; ++i) if (gl[i] > gmax) { gmax = gl[i]; gidx = i; }
        float gsum = 0.f;
#pragma unroll
        for (int i = 0; i < 4; ++i) gsum += fast_exp(gl[i] - gmax);
        float gp = 1.0f / gsum;
        gidx = __shfl(gidx, r32); gp = __shfl(gp, r32);
        float cv[4];
#pragma unroll
        for (int i = 0; i < 4; ++i) {
            const float a = gidx == 0 ? acc0[i] : gidx == 1 ? acc0[4 + i] : gidx == 2 ? acc0[8 + i] : acc0[12 + i];
            cv[i] = rs_l * (a - mu_l * WRC[8 * gidx + 4 * hi + i]) + WRC[64 + 8 * gidx + 4 * hi + i];
        }
        float v1 = cv[0]; int i1 = 0;
#pragma unroll
        for (int i = 1; i < 4; ++i) if (cv[i] > v1) { v1 = cv[i]; i1 = i; }
        float v2 = -INFINITY; int i2 = 0;
#pragma unroll
        for (int i = 0; i < 4; ++i) if (i != i1 && cv[i] > v2) { v2 = cv[i]; i2 = i; }
        i1 += 4 * hi; i2 += 4 * hi;
        const float pv1 = __shfl_xor(v1, 32), pv2 = __shfl_xor(v2, 32); const int pi1 = __shfl_xor(i1, 32), pi2 = __shfl_xor(i2, 32);
        auto better = [](float av, int ai, float bv, int bi) { return av > bv || (av == bv && ai < bi); };
        float fv, sv; int fi, si;
        if (better(v1, i1, pv1, pi1)) { fv = v1; fi = i1; if (better(v2, i2, pv1, pi1)) { sv = v2; si = i2; } else { sv = pv1; si = pi1; } }
        else { fv = pv1; fi = pi1; if (better(v1, i1, pv2, pi2)) { sv = v1; si = i1; } else { sv = pv2; si = pi2; } }
        const float d = fast_exp(sv - fv), inv = 1.0f / (1.0f + d);
        const float w1 = gp * inv, w2 = gp * d * inv;
        const int e1 = 8 * gidx + fi, e2 = 8 * gidx + si;
        if (hi == 0) {
            *(int4*)(route + (size_t)(row0 + r32) * 4) = make_int4(e1, e2, __float_as_int(w1), __float_as_int(w2));
            atomicAdd((unsigned*)&hist[e1], 1u); atomicAdd((unsigned*)&hist[e2], 1u);
        }
        __syncthreads();
        if (F.tid < 32) misc[MI_BLOCKCNT + blk * 32 + F.tid] = hist[F.tid];
        __syncthreads();
    }
}

__device__ __forceinline__ void phase_moe_scatter(Frame& F) {
    PHASE_IDS(F);
    unsigned* misc = (unsigned*)(F.ws + WS_MISC);
    const int* route = (const int*)(F.ws + WS_ROUTE);
    int* rpos = (int*)(F.ws + WS_RPOS); int* rowtok = (int*)(F.ws + WS_ROWTOK);
    LAS unsigned* tot = (LAS unsigned*)(F.lds + L_TOT); LAS unsigned* pre = (LAS unsigned*)(F.lds + L_PRE);
    LAS unsigned* base = (LAS unsigned*)(F.lds + L_BASE); LAS unsigned* rank = (LAS unsigned*)(F.lds + L_RANK);
    for (int blk = F.vcu; blk < TT / 256; blk += F.G) {
        {
            if (F.tid < 32) { tot[F.tid] = 0u; pre[F.tid] = 0u; rank[F.tid] = 0u; }
            __syncthreads();
            const int e = F.tid & 31, part = F.tid >> 5; unsigned cv[16];
#pragma unroll
            for (int i = 0; i < 16; ++i) cv[i] = misc[MI_BLOCKCNT + (part * 16 + i) * 32 + e];
            unsigned t = 0, p = 0;
#pragma unroll
            for (int i = 0; i < 16; ++i) { t += cv[i]; p += (part * 16 + i < blk) ? cv[i] : 0u; }
            atomicAdd((unsigned*)&tot[e], t); atomicAdd((unsigned*)&pre[e], p);
        }
        __syncthreads();
        if (F.tid == 0) { unsigned a = 0; for (int e = 0; e < NEXP; ++e) { base[e] = a; a += (tot[e] + 255u) & ~255u; } base[NEXP] = a; }
        __syncthreads();
        {
            const int tok = blk * 256 + (F.tid >> 1), slot = F.tid & 1;
            const int e = route[(size_t)tok * 4 + slot];
            const unsigned r = atomicAdd((unsigned*)&rank[e], 1u);
            const unsigned pos = base[e] + pre[e] + r;
            rowtok[pos] = tok; rpos[(size_t)tok * 2 + slot] = (int)pos;
        }
        if (blk < NEXP) {
            const int e = blk; const unsigned end = base[e] + tot[e], nxt = base[e + 1];
            for (unsigned p = end + F.tid; p < nxt; p += NTHREADS) rowtok[p] = 0;
            for (unsigned p = base[e] / 256 + F.tid; p < nxt / 256; p += NTHREADS) misc[MI_PANEL_E + p] = (unsigned)e;
        }
        if (blk == 0 && F.tid == 0) misc[MI_NPAN] = base[NEXP] / 256;
        __syncthreads();
    }
}

struct MoeSched1 {
    static constexpr bool GATHER = true;
    const bf16_t* A; const bf16_t* W; int lda, ldb, ntot, G, c; const LAS int* rows; const LAS int* pe; int sw8, sa8;
    __device__ __forceinline__ bool next(int i, pg8::Unit& u) const { const int v = i * G + c; if (v >= ntot) return false; u.pm = v >> 1; u.pn = v & 1; u.ord = i; return true; }
    __device__ __forceinline__ const char* a_base(const pg8::Unit&) const { return (const char*)A; }
    __device__ __forceinline__ const char* b_base(const pg8::Unit& u) const { return (const char*)(W + (size_t)pe[u.ord] * 512 * ldb + (size_t)u.pn * 256 * ldb); }
    __device__ __forceinline__ void a_off(const pg8::Unit& u, const int (&R)[2], const int (&C)[2], unsigned (&v)[2][2]) const {
#pragma unroll
        for (int h = 0; h < 2; ++h)
#pragma unroll
            for (int i = 0; i < 2; ++i) v[h][i] = (unsigned)(rows[u.ord * 256 + h * 128 + R[i]] * lda + C[i]) * 2u;
    }
};
struct MoeSched2 {
    static constexpr bool GATHER = false;
    const bf16_t* A; const bf16_t* W; int lda, ldb, ntot, G, c; const LAS int* pe; int sw8, sa8;
    __device__ __forceinline__ bool next(int i, pg8::Unit& u) const { const int v = i * G + c; if (v >= ntot) return false; u.pm = v >> 2; u.pn = v & 3; u.ord = i; return true; }
    __device__ __forceinline__ const char* a_base(const pg8::Unit& u) const { return (const char*)(A + (size_t)u.pm * 256 * lda); }
    __device__ __forceinline__ const char* b_base(const pg8::Unit& u) const { return (const char*)(W + (size_t)pe[u.ord] * DM * ldb + (size_t)u.pn * 256 * ldb); }
    __device__ __forceinline__ void a_off(const pg8::Unit&, const int (&R)[2], const int (&C)[2], unsigned (&v)[2][2]) const {
#pragma unroll
        for (int i = 0; i < 2; ++i) { v[0][i] = (unsigned)(R[i] * lda + C[i]) * 2u; v[1][i] = (unsigned)((128 + R[i]) * lda + C[i]) * 2u; }
    }
};
struct EpiSwiGLU {
    bf16_t* H;
    __device__ __forceinline__ void operator()(const f32x4 (&acc)[2][2][4][2], const pg8::Unit& u, int wr, int wc, int fr, int fq) const {
        const int row0 = u.pm * 256 + wr * 64 + fr, col0 = u.pn * 128 + wc * 16 + 4 * fq;
#pragma unroll
        for (int ai = 0; ai < 2; ++ai)
#pragma unroll
            for (int m = 0; m < 4; ++m) { bf16_t* rowp = H + (size_t)(row0 + ai * 128 + m * 16) * DEXP + col0;
#pragma unroll
                for (int bj = 0; bj < 2; ++bj) { const f32x4 v0 = acc[ai][bj][m][0], v1 = acc[ai][bj][m][1];
                    const float h0 = v0[0] * sigmoidf_(v0[0]) * v0[1], h1 = v0[2] * sigmoidf_(v0[2]) * v0[3], h2 = v1[0] * sigmoidf_(v1[0]) * v1[1], h3 = v1[2] * sigmoidf_(v1[2]) * v1[3];
                    *(unsigned*)((unsigned char*)H + (size_t)(row0 + ai * 128 + m * 16) * DEXP + col0 + bj * 64) = pk4_fp8(h0 * 16.f, h1 * 16.f, h2 * 16.f, h3 * 16.f); (void)rowp; } }
    }
};
struct EpiStoreBf16 {
    bf16_t* O; int ldc;
    __device__ __forceinline__ void operator()(const f32x4 (&acc)[2][2][4][2], const pg8::Unit& u, int wr, int wc, int fr, int fq) const {
        const int row0 = u.pm * 256 + wr * 64 + fr, col0 = u.pn * 256 + wc * 32 + 8 * fq;
#pragma unroll
        for (int ai = 0; ai < 2; ++ai)
#pragma unroll
            for (int m = 0; m < 4; ++m) { bf16_t* rowp = O + (size_t)(row0 + ai * 128 + m * 16) * ldc + col0;
#pragma unroll
                for (int bj = 0; bj < 2; ++bj) store8_fp8((unsigned char*)O + (size_t)(row0 + ai * 128 + m * 16) * ldc + col0 + bj * 128, acc[ai][bj][m][0], acc[ai][bj][m][1], 64.f); (void)rowp; }
    }
};

__device__ __forceinline__ void phase_moe_gemm1(Frame& F) {
    PHASE_IDS(F);
    const unsigned* misc = (const unsigned*)(F.ws + WS_MISC);
    const int* rowtok = (const int*)(F.ws + WS_ROWTOK);
    const int npan = (int)misc[MI_NPAN];
    LAS int* rows = (LAS int*)(F.lds + L_ROWS); LAS int* pe = (LAS int*)(F.lds + L_PE);
    const int c = (int)blockIdx.x, ntot = npan * 2;
    for (int i = 0; i * F.G + c < ntot && i < 8; ++i) { const int p = (i * F.G + c) >> 1;
        if (F.tid < 256) rows[i * 256 + F.tid] = rowtok[p * 256 + F.tid];
        if (F.tid == 256) pe[i] = (int)misc[MI_PANEL_E + p]; }
    VM_WAIT(); LDS_WAIT(); __syncthreads();
    MoeSched1 S{(const bf16_t*)(F.ws + WS_XB8), (const bf16_t*)(F.ws + WS_W13), DM / 2, DM / 2, ntot, F.G, c, rows, pe, F8_SW, F8_SA_X};
    EpiSwiGLU E{(bf16_t*)(F.ws + WS_H)};
    pg8::gemm_phase<EpiSwiGLU, MoeSched1, true, true>(F.lds, DM / 2, S, E);
}
__device__ __forceinline__ void phase_moe_gemm2(Frame& F) {
    PHASE_IDS(F);
    const unsigned* misc = (const unsigned*)(F.ws + WS_MISC);
    const int npan = (int)misc[MI_NPAN];
    LAS int* pe = (LAS int*)(F.lds + L_PE);
    const int c = (int)blockIdx.x, ntot = npan * 4;
    __syncthreads();
    if (F.tid < 16) { const int v = F.tid * F.G + c; if (v < ntot) pe[F.tid] = (int)misc[MI_PANEL_E + (v >> 2)]; }
    VM_WAIT(); LDS_WAIT(); __syncthreads();
    MoeSched2 S{(const bf16_t*)(F.ws + WS_H), (const bf16_t*)(F.ws + WS_W2), DEXP / 2, DEXP / 2, ntot, F.G, c, pe, F8_SW, 127 - 4};
    EpiStoreBf16 E{(bf16_t*)(F.ws + WS_Y), DM};
    int k2 = DEXP / 2; asm volatile("" : "+s"(k2));
    pg8::gemm_phase<EpiStoreBf16, MoeSched2, true, true>(F.lds, k2, S, E);
}

__device__ __forceinline__ void phase_combine_ln2(Frame& F, int l) {
    PHASE_IDS(F);
    const int lane = F.lane;
    const float* lg = F.in[21] + (size_t)l * DM; const float* lb = F.in[22] + (size_t)l * DM;
    f32x4 g[4], b[4];
#pragma unroll
    for (int j = 0; j < 4; ++j) { g[j] = ((const f32x4*)lg)[lane + 64 * j]; b[j] = ((const f32x4*)lb)[lane + 64 * j]; }
    const bf16_t* Y = (const bf16_t*)(F.ws + WS_Y);
    const float* l1g = F.in[12] + (size_t)l * DM; const float* l1b = F.in[13] + (size_t)l * DM; const float* stats = (const float*)(F.ws + WS_WR + 512 * 1024);
    f32x4 g1[4], b1[4];
#pragma unroll
    for (int j = 0; j < 4; ++j) { g1[j] = ((const f32x4*)l1g)[lane + 64 * j]; b1[j] = ((const f32x4*)l1b)[lane + 64 * j]; }
    const int* route = (const int*)(F.ws + WS_ROUTE); const int* rpos = (const int*)(F.ws + WS_RPOS);
    const int gw = F.vcu * NWAVES + F.wave, NGW = F.G * NWAVES;
    auto recs = [&](int r, int4& rt, int2& rp, f32x2& st) { rt = *(const int4*)(route + (size_t)r * 4); rp = *(const int2*)(rpos + (size_t)r * 2); st = *(const f32x2*)(stats + (size_t)r * 2); };
    auto rowload = [&](int r, const int2& rp, f32x4 (&x)[4], unsigned (&ya)[4], unsigned (&yc)[4]) {
        const f32x4* px = (const f32x4*)(F.out + (size_t)r * DM);
        const unsigned* y0 = (const unsigned*)((const unsigned char*)Y + (size_t)rp.x * DM); const unsigned* y1 = (const unsigned*)((const unsigned char*)Y + (size_t)rp.y * DM);
#pragma unroll
        for (int j = 0; j < 4; ++j) { x[j] = __builtin_nontemporal_load(px + lane + 64 * j); ya[j] = __builtin_nontemporal_load(y0 + lane + 64 * j); yc[j] = __builtin_nontemporal_load(y1 + lane + 64 * j); } };
    int4 rt_c, rt_n; int2 rp_c, rp_n; f32x2 st_c, st_n;
    recs(gw, rt_c, rp_c, st_c);
    { const int r1 = gw + NGW < TT ? gw + NGW : gw; recs(r1, rt_n, rp_n, st_n); }
    f32x4 xc[4]; unsigned yac[4], ycc[4];
    rowload(gw, rp_c, xc, yac, ycc);
    for (int row = gw; row < TT; row += NGW) {
        const int r1 = row + NGW < TT ? row + NGW : row, r2 = row + 2 * NGW < TT ? row + 2 * NGW : row;
        f32x4 xn[4]; unsigned yan[4], ycn[4];
        rowload(r1, rp_n, xn, yan, ycn);
        int4 rt_2; int2 rp_2; f32x2 st_2; recs(r2, rt_2, rp_2, st_2);
        const float w0 = __int_as_float(rt_c.z) * (1.f / 64.f), w1 = __int_as_float(rt_c.w) * (1.f / 64.f);
        f32x4 v[4];
#pragma unroll
        for (int j = 0; j < 4; ++j) {
            const f32x4 x = (xc[j] - st_c[0]) * st_c[1] * g1[j] + b1[j]; const unsigned a = yac[j], c = ycc[j];
            const f32x2 a01 = __builtin_amdgcn_cvt_pk_f32_fp8((int)a, false), a23 = __builtin_amdgcn_cvt_pk_f32_fp8((int)a, true), c01 = __builtin_amdgcn_cvt_pk_f32_fp8((int)c, false), c23 = __builtin_amdgcn_cvt_pk_f32_fp8((int)c, true);
            v[j].x = ALPHA * x.x + w0 * a01[0] + w1 * c01[0]; v[j].y = ALPHA * x.y + w0 * a01[1] + w1 * c01[1];
            v[j].z = ALPHA * x.z + w0 * a23[0] + w1 * c23[0]; v[j].w = ALPHA * x.w + w0 * a23[1] + w1 * c23[1];
        }
        ln_row(v, g, b);
#pragma unroll
        for (int j = 0; j < 4; ++j) __builtin_nontemporal_store(v[j], (f32x4*)(F.out + (size_t)row * DM) + lane + 64 * j);
        if (l == 0) {
#pragma unroll
            for (int j = 0; j < 4; ++j) ((unsigned*)(F.ws + WS_XB8 + (size_t)row * DM))[lane + 64 * j] = pk4_fp8(v[j].x * 16.f, v[j].y * 16.f, v[j].z * 16.f, v[j].w * 16.f);
        }
        rt_c = rt_n; rp_c = rp_n; st_c = st_n; rt_n = rt_2; rp_n = rp_2; st_n = st_2;
#pragma unroll
        for (int j = 0; j < 4; ++j) { xc[j] = xn[j]; yac[j] = yan[j]; ycc[j] = ycn[j]; }
    }
}

constexpr float C2D = 0.18033688011112042f;
constexpr float C2M = 0.14724444602590306f;
constexpr float IWS = 0.044194173824159216f;
constexpr float RMS_EPS = 1e-6f;
constexpr int L_QSLOT = L_CTL + 1152;

__device__ __forceinline__ int rope16(int c) { return c < 16 ? (c >> 1) + 8 * (c & 1) : c; }
__device__ __forceinline__ int win_src(int n, float& sc) {
    sc = 1.f;
    if (n < 384) return n;
    if (n < 416) { const int c = n - 384; return 384 + (c >> 1) + 16 * (c & 1); }
    if (n < 512) return -1;
    if (n < 2816) { const int m = n - 512, g = m / 768, r = m % 768, p = r >> 8, hh = (r & 255) >> 6, c = r & 63; if (p == 0) sc = C2D; return 416 + 768 * g + 256 * p + 64 * hh + (p < 2 ? rope16(c) : c); }
    if (n < 3328) { const int m = n - 2816; sc = C2D; return 2720 + (m & ~63) + rope16(m & 63); }
    if (n < 3840) { const int m = n - 3328; return 3360 + (m & ~63) + rope16(m & 63); }
    const int m = n - 3840;
    if (m < 64) return 3232 + rope16(m);
    if (m < 128) return 3296 + (m - 64);
    if (m < 192) return 3872 + rope16(m - 128);
    if (m < 200) { sc = IWS; return 3936 + (m - 192); }
    return -1;
}

__device__ __forceinline__ void sincos_d(double x, double& s, double& c) {
    const double n = __builtin_rint(x * 0.15915494309189535);
    double r = __builtin_fma(-n, 6.2831854820251465, x); r = __builtin_fma(n, 1.7484556025237907e-07, r);
    const double r2 = r * r; double ss = 1.0, cc = 1.0;
#pragma unroll
    for (int k = 15; k >= 1; --k) { ss = 1.0 - r2 * (1.0 / (double)((2 * k) * (2 * k + 1))) * ss; cc = 1.0 - r2 * (1.0 / (double)((2 * k - 1) * (2 * k))) * cc; }
    s = ss * r; c = cc;
}
__device__ __forceinline__ double inv_freq16(int i) {
    const double t[16] = {1.0, 0.44036660267178046, 0.19392274474868576, 0.08539710028576561, 0.03760603093086393, 0.016560440080994446, 0.007292664737217109, 0.003211445994752591,
                          0.001414213562373095, 0.000622772421914596, 0.0002742481756762073, 0.00012076973741146504, 5.318295896944988e-05, 2.341999896140934e-05, 1.031338537721246e-05, 4.5416704806078695e-06};
    double r = t[0];
#pragma unroll
    for (int k = 1; k < 16; ++k) r = (i == k) ? t[k] : r;
    return r;
}

__device__ __forceinline__ void phase_conv_mixer(Frame& F, int l) {
    PHASE_IDS(F);
    LAS float* scr = (LAS float*)(F.lds + F.wave * 16384);
    const int gw = F.vcu * NWAVES + F.wave, NGW = F.G * NWAVES;
    const float* win = F.in[1] + (size_t)l * DM * CIN;
    const float* qg = F.in[2] + (size_t)l * 256; const float* wuq = F.in[3] + (size_t)l * 256 * 768;
    const float* kg = F.in[4] + (size_t)l * 128; const float* wukv = F.in[5] + (size_t)l * 128 * 1024;
    const float* wgate = F.in[6] + (size_t)l * DM * 3072;
    const float* wa = F.in[8] + (size_t)l * 512 * DM; const float* wb = F.in[9] + (size_t)l * 256 * DM; const float* wc = F.in[10] + (size_t)l * 512 * DM; const float* wo = F.in[11] + (size_t)l * DM * DM;
    unsigned char* WIN8 = F.ws + WS_WIN8; bf16_t* WUQ = (bf16_t*)(F.ws + WS_WUQ); bf16_t* WUKV = (bf16_t*)(F.ws + WS_WUKV);
    bf16_t* WA = (bf16_t*)(F.ws + WS_WA); bf16_t* WB = (bf16_t*)(F.ws + WS_WB); bf16_t* WC = (bf16_t*)(F.ws + WS_WC); bf16_t* WO = (bf16_t*)(F.ws + WS_WO);
    constexpr int I_IN = 16 * 128, I_G = 16 * 96, I_UQ = 4 * 24, I_UKV = 4 * 32, I_A = 8 * 32, I_B = 8 * 32, I_C = 8 * 32, I_O = 16 * 32;
    constexpr int NIT = I_IN + I_G + I_UQ + I_UKV + I_A + I_B + I_C + I_O;
    for (int it = gw; it < NIT; it += NGW) {
        int r = it;
        if (r < I_IN) { conv_item8(WIN8, DM, (r / 128) * 64, (r % 128) * 32, scr, F.lane, [&](int k, int n) { float sc; const int sidx = win_src(n, sc); return sidx < 0 ? 0.f : win[(size_t)k * CIN + sidx] * (sc * 1024.f); }); continue; } r -= I_IN;
        if (r < I_G) { conv_plain8(WIN8 + (size_t)PW * DM, DM, (r / 96) * 64, (r % 96) * 32, scr, F.lane, wgate, 3072, 1024.f); continue; } r -= I_G;
        if (r < I_UQ) { conv_item(WUQ, 256, (r / 24) * 64, (r % 24) * 32, scr, F.lane, [&](int k, int n) { const int hh = n / 96, c = n % 96; const int o = c < 64 ? c : 64 + ((c - 64) >> 1) + 16 * ((c - 64) & 1);
                return qg[k] * wuq[(size_t)k * 768 + hh * 96 + o] * C2M; }); continue; } r -= I_UQ;
        if (r < I_UKV) { conv_item(WUKV, 256, (r / 32) * 64, (r % 32) * 32, scr, F.lane, [&](int k, int n) { return k < 128 ? kg[k] * wukv[(size_t)k * 1024 + n] : 0.f; }); continue; } r -= I_UKV;
        if (r < I_A) { conv_plain8((unsigned char*)WA, 512, (r / 32) * 64, (r % 32) * 32, scr, F.lane, wa, DM, 1024.f); continue; } r -= I_A;
        if (r < I_B) { conv_item8((unsigned char*)WB, 512, (r / 32) * 64, (r % 32) * 32, scr, F.lane, [&](int k, int n) { return k < 256 ? wb[(size_t)k * DM + n] * 1024.f : 0.f; }); continue; } r -= I_B;
        if (r < I_C) { conv_plain8((unsigned char*)WC, 512, (r / 32) * 64, (r % 32) * 32, scr, F.lane, wc, DM, 1024.f); continue; } r -= I_C;
        conv_plain8((unsigned char*)WO, DM, (r / 32) * 64, (r % 32) * 32, scr, F.lane, wo, DM, 1024.f);
    }
    if (l == 0) {
        float* rp = (float*)(F.ws + WS_ROPE); float* rm = rp + 2048 * 8 * 2;
        for (int idx = F.vcu * NTHREADS + F.tid; idx < 2048 * 24; idx += F.G * NTHREADS) {
            const int t = idx / 24, j = idx % 24; double sn, cs;
            if (j < 8) { sincos_d((double)t * inv_freq16(2 * j), sn, cs); rp[(t * 8 + j) * 2] = (float)cs; rp[(t * 8 + j) * 2 + 1] = (float)sn; }
            else { sincos_d((double)t * inv_freq16(j - 8), sn, cs); rm[(t * 16 + (j - 8)) * 2] = (float)cs; rm[(t * 16 + (j - 8)) * 2 + 1] = (float)sn; }
        }
        const f32x4* x4 = (const f32x4*)F.in[0]; unsigned* xb8 = (unsigned*)(F.ws + WS_XB8);
        {
            const size_t NT = (size_t)F.G * NTHREADS, N4 = (size_t)TT * DM / 4;
            for (size_t i0 = (size_t)F.vcu * NTHREADS + F.tid; i0 < N4; i0 += 8 * NT) {
                f32x4 v[8];
#pragma unroll
                for (int q = 0; q < 8; ++q) { const size_t i = i0 + q * NT < N4 ? i0 + q * NT : i0; v[q] = __builtin_nontemporal_load(x4 + i); }
#pragma unroll
                for (int q = 0; q < 8; ++q) { const size_t i = i0 + q * NT < N4 ? i0 + q * NT : i0; const f32x4 w = v[q] * 16.f; xb8[i] = pk4_fp8(w.x, w.y, w.z, w.w); }
            }
        }
    }
}

__device__ __forceinline__ void rope4(f32x4& v0, f32x4& v1, const float* cs) {
    const f32x4 a = *(const f32x4*)cs, b = *(const f32x4*)(cs + 4);
    const f32x4 w0 = {v0[0] * a[0] - v0[1] * a[1], v0[1] * a[0] + v0[0] * a[1], v0[2] * a[2] - v0[3] * a[3], v0[3] * a[2] + v0[2] * a[3]};
    const f32x4 w1 = {v1[0] * b[0] - v1[1] * b[1], v1[1] * b[0] + v1[0] * b[1], v1[2] * b[2] - v1[3] * b[3], v1[3] * b[2] + v1[2] * b[3]};
    v0 = w0; v1 = w1;
}
__device__ __forceinline__ void store8(bf16_t* p, const f32x4& v0, const f32x4& v1) {
    u32x4 w; w.x = cvt_pk_bf16(v0[0], v0[1]); w.y = cvt_pk_bf16(v0[2], v0[3]); w.z = cvt_pk_bf16(v1[0], v1[1]); w.w = cvt_pk_bf16(v1[2], v1[3]); *(u32x4*)p = w;
}
struct EpiProj {
    bf16_t* P; const float* csp; const float* csm; float* ssq; bf16_t* G3; const LAS float* gbias;
    __device__ __forceinline__ void operator()(const f32x4 (&acc)[2][2][4][2], const pg8::Unit& u, int wr, int wc, int fr, int fq) const {
        const int pn = u.pn, row0 = u.pm * 256 + wr * 64 + fr;
        if (pn >= 16) {
#pragma unroll
            for (int bj = 0; bj < 2; ++bj) { const int col = (pn - 16) * 256 + bj * 128 + wc * 32 + fq * 8;
                const f32x4 b0 = *(const LAS f32x4*)(gbias + col), b1 = *(const LAS f32x4*)(gbias + col + 4);
#pragma unroll
                for (int ai = 0; ai < 2; ++ai)
#pragma unroll
                    for (int m = 0; m < 4; ++m) { f32x4 v0 = acc[ai][bj][m][0] + b0, v1 = acc[ai][bj][m][1] + b1;
#pragma unroll
                        for (int e = 0; e < 4; ++e) { v0[e] = sigmoidf_(v0[e]); v1[e] = sigmoidf_(v1[e]); }
                        store8_fp8((unsigned char*)G3 + (size_t)(row0 + ai * 128 + m * 16) * 3072 + col, v0, v1, 64.f); } }
            return;
        }
#pragma unroll
        for (int bj = 0; bj < 2; ++bj) {
            const int wcu = __builtin_amdgcn_readfirstlane(wc);
            bool ropeP = false, ropeM = false;
            if (pn == 1) ropeM = (bj == 1 && wcu == 0);
            else if (pn >= 2 && pn < 11) ropeP = ((pn - 2) % 3) < 2 && !(wcu & 1);
            else if (pn >= 11 && pn < 15) ropeP = !(wcu & 1);
            else if (pn == 15) ropeP = (wcu == 0);
            const int col = pn * 256 + bj * 128 + wc * 32 + fq * 8;
            if (ropeP || ropeM) {
                const bool lr = ropeM || fq < 2;
                const float* cb = ropeM ? csm + 8 * fq : csp + 8 * (fq & 1);
                const int ts = ropeM ? 32 : 16;
#pragma unroll
                for (int ai = 0; ai < 2; ++ai)
#pragma unroll
                    for (int mh = 0; mh < 2; ++mh) {
                        f32x4 ca[2], cc[2];
#pragma unroll
                        for (int mm = 0; mm < 2; ++mm) { const int t = (row0 + ai * 128 + (2 * mh + mm) * 16) & (SEQ - 1);
                            ca[mm] = *(const f32x4*)(cb + t * ts); cc[mm] = *(const f32x4*)(cb + t * ts + 4); }
#pragma unroll
                        for (int mm = 0; mm < 2; ++mm) { const int m = 2 * mh + mm, row = row0 + ai * 128 + m * 16;
                            const f32x4 v0 = acc[ai][bj][m][0], v1 = acc[ai][bj][m][1];
                            f32x4 a = ca[mm], b = cc[mm];
                            if (!lr) { a = (f32x4){1.f, 0.f, 1.f, 0.f}; b = a; }
                            const f32x4 w0 = {v0[0] * a[0] - v0[1] * a[1], v0[1] * a[0] + v0[0] * a[1], v0[2] * a[2] - v0[3] * a[3], v0[3] * a[2] + v0[2] * a[3]};
                            const f32x4 w1 = {v1[0] * b[0] - v1[1] * b[1], v1[1] * b[0] + v1[0] * b[1], v1[2] * b[2] - v1[3] * b[3], v1[3] * b[2] + v1[2] * b[3]};
                            store8(P + (size_t)row * PW + col, w0, w1); }
                    }
            } else {
#pragma unroll
                for (int ai = 0; ai < 2; ++ai)
#pragma unroll
                    for (int m = 0; m < 4; ++m)
                        store8(P + (size_t)(row0 + ai * 128 + m * 16) * PW + col, acc[ai][bj][m][0], acc[ai][bj][m][1]);
            }
        }
        if (pn < 2) {
#pragma unroll
            for (int ai = 0; ai < 2; ++ai)
#pragma unroll
                for (int m = 0; m < 4; ++m) {
                    float sq = 0.f;
#pragma unroll
                    for (int bj = 0; bj < 2; ++bj) if (pn == 0 || bj == 0) {
#pragma unroll
                        for (int n = 0; n < 2; ++n) { const f32x4 x = acc[ai][bj][m][n]; sq += (x[0] * x[0] + x[1] * x[1]) + (x[2] * x[2] + x[3] * x[3]); } }
                    sq += __shfl_xor(sq, 16); sq += __shfl_xor(sq, 32);
                    if (fq == 0) ssq[(size_t)(row0 + ai * 128 + m * 16) * 8 + pn * 4 + wc] = sq;
                }
        }
    }
};
struct EpiUpQ {
    bf16_t* Q; const float* csm; const float* ssq;
    __device__ __forceinline__ void operator()(const f32x4 (&acc)[2][2][4][2], const pg8::Unit& u, int wr, int wc, int fr, int fq) const {
        const int row0 = u.pm * 256 + wr * 64 + fr;
        f32x4 spv[2][4];
#pragma unroll
        for (int ai = 0; ai < 2; ++ai)
#pragma unroll
            for (int m = 0; m < 4; ++m) spv[ai][m] = *(const f32x4*)(ssq + (size_t)(row0 + ai * 128 + m * 16) * 8);
#pragma unroll
        for (int ai = 0; ai < 2; ++ai)
#pragma unroll
            for (int m = 0; m < 4; ++m) { const f32x4 sp = spv[ai][m];
                spv[ai][m][0] = 1.0f / sqrtf(((sp[0] + sp[1]) + (sp[2] + sp[3])) * (1.f / 256.f) + RMS_EPS); }
        const int wcu = __builtin_amdgcn_readfirstlane(wc);
#pragma unroll
        for (int bj = 0; bj < 2; ++bj) {
            const int c0 = u.pn * 256 + bj * 128 + wcu * 32, col = c0 + fq * 8;
            if (((c0 >> 5) % 3) == 2) {
#pragma unroll
                for (int ai = 0; ai < 2; ++ai)
#pragma unroll
                    for (int mh = 0; mh < 2; ++mh) {
                        f32x4 ca[2], cc[2];
#pragma unroll
                        for (int mm = 0; mm < 2; ++mm) { const int t = (row0 + ai * 128 + (2 * mh + mm) * 16) & (SEQ - 1);
                            ca[mm] = *(const f32x4*)(csm + t * 32 + 8 * fq); cc[mm] = *(const f32x4*)(csm + t * 32 + 8 * fq + 4); }
#pragma unroll
                        for (int mm = 0; mm < 2; ++mm) { const int m = 2 * mh + mm, row = row0 + ai * 128 + m * 16;
                            const float rs = spv[ai][m][0];
                            const f32x4 v0 = acc[ai][bj][m][0] * rs, v1 = acc[ai][bj][m][1] * rs, a = ca[mm], b = cc[mm];
                            const f32x4 w0 = {v0[0] * a[0] - v0[1] * a[1], v0[1] * a[0] + v0[0] * a[1], v0[2] * a[2] - v0[3] * a[3], v0[3] * a[2] + v0[2] * a[3]};
                            const f32x4 w1 = {v1[0] * b[0] - v1[1] * b[1], v1[1] * b[0] + v1[0] * b[1], v1[2] * b[2] - v1[3] * b[3], v1[3] * b[2] + v1[2] * b[3]};
                            store8(Q + (size_t)row * 768 + col, w0, w1); }
                    }
            } else {
#pragma unroll
                for (int ai = 0; ai < 2; ++ai)
#pragma unroll
                    for (int m = 0; m < 4; ++m) { const float rs = spv[ai][m][0];
                        store8(Q + (size_t)(row0 + ai * 128 + m * 16) * 768 + col, acc[ai][bj][m][0] * rs, acc[ai][bj][m][1] * rs); }
            }
        }
    }
};
struct EpiUpKV {
    bf16_t* KV; const float* ssq;
    __device__ __forceinline__ void operator()(const f32x4 (&acc)[2][2][4][2], const pg8::Unit& u, int wr, int wc, int fr, int fq) const {
        const int row0 = u.pm * 256 + wr * 64 + fr;
        f32x4 spv[2][4];
#pragma unroll
        for (int ai = 0; ai < 2; ++ai)
#pragma unroll
            for (int m = 0; m < 4; ++m) spv[ai][m] = *(const f32x4*)(ssq + (size_t)(row0 + ai * 128 + m * 16) * 8 + 4);
#pragma unroll
        for (int ai = 0; ai < 2; ++ai)
#pragma unroll
            for (int m = 0; m < 4; ++m) {
                const int row = row0 + ai * 128 + m * 16;
                const f32x4 sp = spv[ai][m];
                const float rs = 1.0f / sqrtf(((sp[0] + sp[1]) + (sp[2] + sp[3])) * (1.f / 128.f) + RMS_EPS);
#pragma unroll
                for (int bj = 0; bj < 2; ++bj) { const int col = u.pn * 256 + bj * 128 + wc * 32 + fq * 8;
                    store8(KV + (size_t)row * 1024 + col, acc[ai][bj][m][0] * rs, acc[ai][bj][m][1] * rs); }
            }
    }
};
struct EpiBranchAll {
    bf16_t* Mg; bf16_t* M0; bf16_t* M1; const bf16_t* G3;
    __device__ __forceinline__ void operator()(const f32x4 (&acc)[2][2][4][2], const pg8::Unit& u, int wr, int wc, int fr, int fq) const {
        const int row0 = u.pm * 256 + wr * 64 + fr, br = u.ord, col0 = u.pn * 256 + wc * 32 + fq * 8;
        bf16_t* dst = br == 0 ? M0 : (br == 1 ? M1 : Mg);
#pragma unroll
        for (int ai = 0; ai < 2; ++ai)
#pragma unroll
            for (int mh = 0; mh < 2; ++mh) {
                u32x2 gw[2][2]; u32x4 ma[2][2], mb[2][2];
#pragma unroll
                for (int mm = 0; mm < 2; ++mm)
#pragma unroll
                    for (int bj = 0; bj < 2; ++bj) { const int row = row0 + ai * 128 + (2 * mh + mm) * 16, col = col0 + bj * 128;
                        gw[mm][bj] = *(const u32x2*)((const unsigned char*)G3 + (size_t)row * 3072 + br * 1024 + col);
                        ma[mm][bj] = (u32x4){0u, 0u, 0u, 0u}; mb[mm][bj] = (u32x4){0u, 0u, 0u, 0u}; }
                if (br == 2) {
#pragma unroll
                    for (int mm = 0; mm < 2; ++mm)
#pragma unroll
                        for (int bj = 0; bj < 2; ++bj) { const size_t off = (size_t)(row0 + ai * 128 + (2 * mh + mm) * 16) * DM + col0 + bj * 128;
                            const u32x2 p = *(const u32x2*)((const unsigned char*)M0 + off), q = *(const u32x2*)((const unsigned char*)M1 + off);
                            ma[mm][bj] = (u32x4){p.x, p.y, 0u, 0u}; mb[mm][bj] = (u32x4){q.x, q.y, 0u, 0u}; }
                }
#pragma unroll
                for (int mm = 0; mm < 2; ++mm)
#pragma unroll
                    for (int bj = 0; bj < 2; ++bj) { const int m = 2 * mh + mm; const size_t off = (size_t)(row0 + ai * 128 + m * 16) * DM + col0 + bj * 128; const u32x2 g = gw[mm][bj]; const u32x4 a = ma[mm][bj], b2 = mb[mm][bj];
                        const f32x2 g01 = __builtin_amdgcn_cvt_pk_f32_fp8((int)g.x, false) * (1.f / 64.f), g23 = __builtin_amdgcn_cvt_pk_f32_fp8((int)g.x, true) * (1.f / 64.f);
                        const f32x2 g45 = __builtin_amdgcn_cvt_pk_f32_fp8((int)g.y, false) * (1.f / 64.f), g67 = __builtin_amdgcn_cvt_pk_f32_fp8((int)g.y, true) * (1.f / 64.f);
                        f32x4 v0 = acc[ai][bj][m][0], v1 = acc[ai][bj][m][1];
                        const f32x2 s01 = (__builtin_amdgcn_cvt_pk_f32_fp8((int)a.x, false) + __builtin_amdgcn_cvt_pk_f32_fp8((int)b2.x, false)) * (1.f / 64.f), s23 = (__builtin_amdgcn_cvt_pk_f32_fp8((int)a.x, true) + __builtin_amdgcn_cvt_pk_f32_fp8((int)b2.x, true)) * (1.f / 64.f);
                        const f32x2 s45 = (__builtin_amdgcn_cvt_pk_f32_fp8((int)a.y, false) + __builtin_amdgcn_cvt_pk_f32_fp8((int)b2.y, false)) * (1.f / 64.f), s67 = (__builtin_amdgcn_cvt_pk_f32_fp8((int)a.y, true) + __builtin_amdgcn_cvt_pk_f32_fp8((int)b2.y, true)) * (1.f / 64.f);
                        v0[0] = v0[0] * g01[0] + s01[0]; v0[1] = v0[1] * g01[1] + s01[1]; v0[2] = v0[2] * g23[0] + s23[0]; v0[3] = v0[3] * g23[1] + s23[1];
                        v1[0] = v1[0] * g45[0] + s45[0]; v1[1] = v1[1] * g45[1] + s45[1]; v1[2] = v1[2] * g67[0] + s67[0]; v1[3] = v1[3] * g67[1] + s67[1];
                        store8_fp8((unsigned char*)dst + off, v0, v1, 64.f); }
            }
    }
};
struct BranchSched {
    static constexpr bool GATHER = false; static constexpr bool VARK = true;
    const char* A0; const char* B0; size_t sA, sB; int lda, ldb, c, sw8, sa8, G, ntile;
    __device__ __forceinline__ int ktiles(const pg8::Unit& u) const { return u.ord == 1 ? 2 : 4; }
    __device__ __forceinline__ bool next(int i, pg8::Unit& u) const { const int t = c + (i / 3) * G; if (t >= ntile) return false; u.pm = t >> 2; u.pn = t & 3; u.ord = i % 3; return true; }
    __device__ __forceinline__ const char* a_base(const pg8::Unit& u) const { return A0 + (size_t)u.ord * sA + (size_t)u.pm * 256 * lda * 2; }
    __device__ __forceinline__ const char* b_base(const pg8::Unit& u) const { return B0 + (size_t)u.ord * sB + (size_t)u.pn * 256 * ldb * 2; }
    __device__ __forceinline__ void a_off(const pg8::Unit&, const int (&R)[2], const int (&C)[2], unsigned (&v)[2][2]) const {
#pragma unroll
        for (int i = 0; i < 2; ++i) { v[0][i] = (unsigned)(R[i] * lda + C[i]) * 2u; v[1][i] = (unsigned)((128 + R[i]) * lda + C[i]) * 2u; }
    }
};
struct EpiWo {
    float* out; const float* xsrc; int rowbase;
    __device__ __forceinline__ void operator()(const f32x4 (&acc)[2][2][4][2], const pg8::Unit& u, int wr, int wc, int fr, int fq) const {
        const int row0 = rowbase + u.pm * 256 + wr * 64 + fr, col0 = u.pn * 256 + wc * 32 + fq * 8;
#pragma unroll
        for (int ai = 0; ai < 2; ++ai)
#pragma unroll
            for (int mh = 0; mh < 2; ++mh) {
                f32x4 x[2][2][2];
#pragma unroll
                for (int mm = 0; mm < 2; ++mm)
#pragma unroll
                    for (int bj = 0; bj < 2; ++bj) { const size_t off = (size_t)(row0 + ai * 128 + (2 * mh + mm) * 16) * DM + col0 + bj * 128;
                        x[mm][bj][0] = *(const f32x4*)(xsrc + off); x[mm][bj][1] = *(const f32x4*)(xsrc + off + 4); }
#pragma unroll
                for (int mm = 0; mm < 2; ++mm)
#pragma unroll
                    for (int bj = 0; bj < 2; ++bj) { const size_t off = (size_t)(row0 + ai * 128 + (2 * mh + mm) * 16) * DM + col0 + bj * 128;
                        *(f32x4*)(out + off) = x[mm][bj][0] * ALPHA + acc[ai][bj][2 * mh + mm][0]; *(f32x4*)(out + off + 4) = x[mm][bj][1] * ALPHA + acc[ai][bj][2 * mh + mm][1]; }
            }
    }
};

__device__ __forceinline__ int dequeue(Frame& F, unsigned* ctr, int& pre) {
    LAS int* slot = (LAS int*)(F.lds + L_QSLOT);
    __syncthreads();
    if (F.tid == 0) {
        *slot = (int)__hip_atomic_fetch_add(ctr, 1u, __ATOMIC_RELAXED, __HIP_MEMORY_SCOPE_AGENT); (void)pre;
    }
    __syncthreads();
    return *slot;
}

namespace att {
constexpr int KSLOT = 12288, VSLOT = 8192, NSLOT = 4;
constexpr int A_K = 0, A_V = NSLOT * KSLOT, A_WS = A_V + NSLOT * VSLOT, A_OST = A_WS + 8 * 256, A_MW = A_OST + 8 * 4096, A_END = A_MW + 8 * NSLOT * 256;
static_assert(A_END <= RING_BYTES, "attention LDS");
typedef short s16x4 __attribute__((ext_vector_type(4)));
__device__ __forceinline__ int crow(int r, int hi) { return (r & 3) + 8 * (r >> 2) + 4 * hi; }
__device__ __forceinline__ void glds16(const void* gsrc, unsigned lds_dst) { unsigned keep;
    asm volatile("s_mov_b32 %0, m0\n\ts_mov_b32 m0, %2\n\ts_nop 0\n\tglobal_load_lds_dwordx4 %1, off\n\ts_mov_b32 m0, %0" : "=&s"(keep) : "v"(gsrc), "s"(lds_dst) : "memory"); }
__device__ __forceinline__ void glds4(const void* gsrc, unsigned lds_dst) { unsigned keep;
    asm volatile("s_mov_b32 %0, m0\n\ts_mov_b32 m0, %2\n\ts_nop 0\n\tglobal_load_lds_dword %1, off\n\ts_mov_b32 m0, %0" : "=&s"(keep) : "v"(gsrc), "s"(lds_dst) : "memory"); }
#define ATT_WAIT_BAR(N) asm volatile("s_waitcnt vmcnt(" #N ") lgkmcnt(0)\n\ts_barrier" ::: "memory")
__device__ __forceinline__ float emax(float a, float b) { return __builtin_elementwise_maximum(a, b); }
__device__ __forceinline__ float halfmax(float m) { auto rr = __builtin_amdgcn_permlane32_swap(__float_as_uint(m), __float_as_uint(m), false, false); return emax(__uint_as_float(rr[0]), __uint_as_float(rr[1])); }
__device__ __forceinline__ float halfsum(float m) { auto rr = __builtin_amdgcn_permlane32_swap(__float_as_uint(m), __float_as_uint(m), false, false); return __uint_as_float(rr[0]) + __uint_as_float(rr[1]); }
typedef short v4i16_t __attribute__((ext_vector_type(4)));
__device__ __forceinline__ s16x4 vtr(const LAS unsigned char* p) { return __builtin_bit_cast(s16x4, __builtin_amdgcn_ds_read_tr16_b64_v4i16((LAS v4i16_t*)p)); }
__device__ __forceinline__ void pv(f32x16* o, f32x16& lacc, const LAS unsigned char* vp, bf16x8 pa0, bf16x8 pa1, bf16x8 pa2, bf16x8 pa3) {
    { const u32x4 one4 = {0x3F803F80u, 0x3F803F80u, 0x3F803F80u, 0x3F803F80u}; const bf16x8 ones = __builtin_bit_cast(bf16x8, one4);
      lacc = __builtin_amdgcn_mfma_f32_32x32x16_bf16(pa0, ones, lacc, 0, 0, 0); lacc = __builtin_amdgcn_mfma_f32_32x32x16_bf16(pa1, ones, lacc, 0, 0, 0);
      lacc = __builtin_amdgcn_mfma_f32_32x32x16_bf16(pa2, ones, lacc, 0, 0, 0); lacc = __builtin_amdgcn_mfma_f32_32x32x16_bf16(pa3, ones, lacc, 0, 0, 0); }
#pragma unroll
    for (int d0 = 0; d0 < 2; ++d0) { s16x4 lo[4], hi[4];
#pragma unroll
        for (int ks = 0; ks < 4; ++ks) { lo[ks] = vtr(vp + d0 * 4096 + ks * 1024); hi[ks] = vtr(vp + d0 * 4096 + ks * 1024 + 512); }
#define ATT_PK(k) (bf16x8){lo[k][0], lo[k][1], lo[k][2], lo[k][3], hi[k][0], hi[k][1], hi[k][2], hi[k][3]}
        o[d0] = __builtin_amdgcn_mfma_f32_32x32x16_bf16(pa0, ATT_PK(0), o[d0], 0, 0, 0);
        o[d0] = __builtin_amdgcn_mfma_f32_32x32x16_bf16(pa1, ATT_PK(1), o[d0], 0, 0, 0);
        o[d0] = __builtin_amdgcn_mfma_f32_32x32x16_bf16(pa2, ATT_PK(2), o[d0], 0, 0, 0);
        o[d0] = __builtin_amdgcn_mfma_f32_32x32x16_bf16(pa3, ATT_PK(3), o[d0], 0, 0, 0);
#undef ATT_PK
    }
}
struct Desc {
    const bf16_t* Q; const bf16_t* K1; const bf16_t* K2; const bf16_t* V; bf16_t* O; float* lse; const unsigned* mask;
    int qpitch, k1pitch, k2pitch, vpitch, opitch, lsepitch;
    int rstride, q0, nq, jlo, jhi;
    int o8;
};
template <int DQK, int MODE, bool DUAL = false>
__device__ __forceinline__ void attn_unit(LAS unsigned char* lds, const Desc& d) {
    static_assert(!DUAL || (DQK == 64 && MODE == 0), "dual mode");
    constexpr int NSLOT = DUAL ? 2 : att::NSLOT, KSLOT = DUAL ? 8192 : att::KSLOT;
    constexpr int A_K = 0, A_V = DUAL ? 32768 : att::A_V, A_WS = DUAL ? 65536 : att::A_WS, A_OST = DUAL ? 67584 : att::A_OST, A_MW = att::A_MW;
    int tid_ = threadIdx.x; asm volatile("" : "+v"(tid_));
    const int tid = tid_, lane = tid & 63, r32 = lane & 31, hi = lane >> 5, wid = __builtin_amdgcn_readfirstlane(tid >> 6);
    constexpr int ND = DQK / 16;
    const unsigned lds0 = (unsigned)(size_t)lds;
    LAS float* wsf = (LAS float*)(lds + A_WS) + wid * 64;
    const int grp = DUAL ? (wid >> 2) : 0, w4 = DUAL ? (wid & 3) : wid, gofs = grp * 16384;
    Desc dd = d;
    if (DUAL) { dd.Q = d.Q + (size_t)grp * d.qpitch; dd.K1 = d.K1 + (size_t)grp * d.k1pitch; dd.V = d.V + (size_t)grp * d.vpitch; dd.O = d.O + (size_t)grp * d.opitch; if (d.lse) dd.lse = d.lse + (size_t)grp * d.lsepitch; }
    const Desc& d_ = dd;
    const int qw = d.q0 + w4 * 32;
    const bool wvalid = DUAL || wid * 32 < d.nq;
    const int kkey = 8 * wid + (lane >> 3), kch = (lane & 7) ^ ((kkey >> 1) & 7);
    const bf16_t* ksrc = d_.K1 + (size_t)kkey * d.rstride * d.k1pitch + kch * 8;
    const int k2key = 16 * (wid & 3) + (lane >> 2), k2ch = (lane & 3) ^ ((k2key >> 2) & 3);
    const bf16_t* k2src = (DQK == 96) ? d_.K2 + (size_t)k2key * d.rstride * d.k2pitch + k2ch * 8 : nullptr;
    int kofs[ND];
#pragma unroll
    for (int d0 = 0; d0 < ND; ++d0) kofs[d0] = d0 < 4 ? r32 * 128 + (((2 * d0 + hi) ^ ((r32 >> 1) & 7)) * 16) : 8192 + r32 * 64 + (((2 * (d0 - 4) + hi) ^ ((r32 >> 2) & 3)) * 16);
    const bf16_t* vsrc = d_.V + (size_t)(16 * (wid & 3) + (lane >> 2)) * d.rstride * d.vpitch + (DUAL ? 0 : (wid >> 2) * 32) + (lane & 3) * 8;
    const int kkeyB = 8 * (2 * w4 + 1) + (lane >> 3);
    const bf16_t* ksrcA = DUAL ? d_.K1 + (size_t)(8 * (2 * w4) + (lane >> 3)) * d.rstride * d.k1pitch + (((lane & 7) ^ (((8 * (2 * w4) + (lane >> 3)) >> 1) & 7)) * 8) : nullptr;
    const bf16_t* ksrcB = DUAL ? d_.K1 + (size_t)kkeyB * d.rstride * d.k1pitch + (((lane & 7) ^ ((kkeyB >> 1) & 7)) * 8) : nullptr;
    const size_t kstep = (size_t)64 * d.rstride * d.k1pitch, k2step = (size_t)64 * d.rstride * d.k2pitch, vstep = (size_t)64 * d.rstride * d.vpitch;
    const bool two = (DQK == 96) && wid < 4;
    const unsigned* msrc = (MODE == 2) ? d.mask + (size_t)(wvalid ? (qw + (lane >> 1)) : d.q0) * 64 + (lane & 1) : nullptr;
#define ATT_ISSUE(j) do { const int sl_ = (j) % NSLOT; \
        if (DUAL) { \
            glds16(ksrcA + (size_t)(j) * kstep, (unsigned)__builtin_amdgcn_readfirstlane(lds0 + A_K + gofs + sl_ * KSLOT + (2 * w4) * 1024)); \
            glds16(ksrcB + (size_t)(j) * kstep, (unsigned)__builtin_amdgcn_readfirstlane(lds0 + A_K + gofs + sl_ * KSLOT + (2 * w4 + 1) * 1024)); \
            glds16(vsrc + (size_t)(j) * vstep, (unsigned)__builtin_amdgcn_readfirstlane(lds0 + A_V + gofs + sl_ * VSLOT + w4 * 1024)); \
            glds16(vsrc + 32 + (size_t)(j) * vstep, (unsigned)__builtin_amdgcn_readfirstlane(lds0 + A_V + gofs + sl_ * VSLOT + (4 + w4) * 1024)); \
            break; } \
        glds16(ksrc + (size_t)(j) * kstep, (unsigned)__builtin_amdgcn_readfirstlane(lds0 + A_K + sl_ * KSLOT + wid * 1024)); \
        if (two) glds16(k2src + (size_t)(j) * k2step, (unsigned)__builtin_amdgcn_readfirstlane(lds0 + A_K + sl_ * KSLOT + (8 + wid) * 1024)); \
        glds16(vsrc + (size_t)(j) * vstep, (unsigned)__builtin_amdgcn_readfirstlane(lds0 + A_V + sl_ * VSLOT + wid * 1024)); \
        if (MODE == 2) glds4(msrc + 2 * (j), (unsigned)__builtin_amdgcn_readfirstlane(lds0 + A_MW + (wid * NSLOT + sl_) * 256)); } while (0)
    ATT_ISSUE(d.jlo);
    if (d.jlo + 1 < d.jhi) ATT_ISSUE(d.jlo + 1);
    bf16x8 qr[ND];
    { const int qi = wvalid ? (qw + r32) : d.q0; const bf16_t* qp = d_.Q + (size_t)qi * d.rstride * d.qpitch + hi * 8;
#pragma unroll
      for (int d0 = 0; d0 < ND; ++d0) qr[d0] = *(const bf16x8*)(qp + d0 * 16); }
#pragma unroll
    for (int d0 = 0; d0 < ND; ++d0) asm volatile("" : "+v"(qr[d0]));
    float mhat = 0.f; f32x16 o[2]; o[0] = f32x16{}; o[1] = f32x16{}; f32x16 lacc = f32x16{};
    bool started = false;
    const LAS unsigned char* vp0 = lds + A_V + gofs + ((lane >> 4) & 1) * 32 + (lane & 3) * 8 + (4 * hi + ((lane & 15) >> 2)) * 64;
    const int qi = qw + r32;
    f32x16 p0 = f32x16{}, p1 = f32x16{};
    f32x16 negm = f32x16{};
#define ATT_REL(j) (wvalid && (64 * (j) <= qw + 31) && (MODE != 1 || (64 * (j) + 63 >= qw - 128)))
#define ATT_QK(j) do { const int sl_ = (j) % NSLOT; \
        const LAS unsigned char* kb = lds + A_K + gofs + sl_ * KSLOT; bf16x8 kf[2 * ND]; \
        _Pragma("unroll") for (int d0 = 0; d0 < ND; ++d0) { kf[2 * d0] = *(const LAS bf16x8*)(kb + kofs[d0]); kf[2 * d0 + 1] = *(const LAS bf16x8*)(kb + kofs[d0] + (d0 < 4 ? 4096 : 2048)); } \
        __builtin_amdgcn_sched_barrier(0); \
        _Pragma("unroll") for (int d0 = 0; d0 < ND; ++d0) { \
            if (d0 == 0) { p0 = __builtin_amdgcn_mfma_f32_32x32x16_bf16(kf[0], qr[0], negm, 0, 0, 0); p1 = __builtin_amdgcn_mfma_f32_32x32x16_bf16(kf[1], qr[0], negm, 0, 0, 0); } \
            else { p0 = __builtin_amdgcn_mfma_f32_32x32x16_bf16(kf[2 * d0], qr[d0], p0, 0, 0, 0); p1 = __builtin_amdgcn_mfma_f32_32x32x16_bf16(kf[2 * d0 + 1], qr[d0], p1, 0, 0, 0); } } } while (0)
#define ATT_SMPV(j) do { const int sl_ = (j) % NSLOT; \
        { bool domask = true; unsigned mx_ = 0u, my_ = 0u;        \
          if (MODE == 2) { const u32x2 mw = *(const LAS u32x2*)(lds + A_MW + (wid * NSLOT + sl_) * 256 + r32 * 8); mx_ = mw.x; my_ = mw.y; } \
          else { \
            bool full = (64 * (j) + 63 <= qw); \
            if (MODE == 1) full = full && (64 * (j) >= qw + 31 - 128); \
            domask = !full; \
            if (domask) { const int a_ = qi - 64 * (j), lo_ = (MODE == 1) ? a_ - 128 : -4096;        \
                { const int h_ = a_ < 31 ? a_ : 31, l_ = lo_ > 0 ? lo_ : 0; mx_ = (h_ < l_) ? 0u : ((0xFFFFFFFFu >> (31 - h_)) & (0xFFFFFFFFu << l_)); } \
                { const int h_ = a_ - 32 < 31 ? a_ - 32 : 31, l_ = lo_ - 32 > 0 ? lo_ - 32 : 0; my_ = (h_ < l_) ? 0u : ((0xFFFFFFFFu >> (31 - h_)) & (0xFFFFFFFFu << l_)); } } \
          } \
          if (domask) { const unsigned w0 = mx_ >> (4 * hi), w1 = my_ >> (4 * hi); \
            _Pragma("unroll") for (int r = 0; r < 16; ++r) { const int bit = (r & 3) + 8 * (r >> 2); \
                const unsigned m0 = (unsigned)__builtin_amdgcn_sbfe((int)w0, bit, 1), m1 = (unsigned)__builtin_amdgcn_sbfe((int)w1, bit, 1);        \
                p0[r] = __uint_as_float((m0 & __float_as_uint(p0[r])) | (~m0 & 0xFF800000u)); p1[r] = __uint_as_float((m1 & __float_as_uint(p1[r])) | (~m1 & 0xFF800000u)); } } } \
        float rm = emax(p0[0], p1[0]), rm2 = emax(p0[1], p1[1]); \
        _Pragma("unroll") for (int r = 2; r < 16; r += 2) { rm = emax(emax(rm, p0[r]), p1[r]); rm2 = emax(emax(rm2, p0[r + 1]), p1[r + 1]); } \
        rm = halfmax(emax(rm, rm2)); \
        bool need; float dl; \
        if (!started) { need = true; dl = emax(rm, -200.f); } else { need = __any(rm > 8.f) != 0; dl = emax(rm, 0.f); } \
        if (need) { mhat += dl; \
            _Pragma("unroll") for (int r = 0; r < 16; ++r) negm[r] = -mhat; \
            _Pragma("unroll") for (int r = 0; r < 16; ++r) { p0[r] -= dl; p1[r] -= dl; } \
            if (started) { const float f = __builtin_amdgcn_exp2f(-dl); \
                if (hi == 0) wsf[r32] = f; \
                LDS_WAIT(); \
                _Pragma("unroll") for (int r = 0; r < 16; ++r) { const float fr_ = wsf[crow(r, hi)]; o[0][r] *= fr_; o[1][r] *= fr_; lacc[r] *= fr_; } } } \
        started = true; \
        __builtin_amdgcn_s_setprio(1);        \
        _Pragma("unroll") for (int r = 0; r < 16; ++r) { p0[r] = __builtin_amdgcn_exp2f(p0[r]); p1[r] = __builtin_amdgcn_exp2f(p1[r]); } \
        const u32x4 pw0 = (u32x4){cvt_pk_bf16(p0[0], p0[1]), cvt_pk_bf16(p0[2], p0[3]), cvt_pk_bf16(p0[4], p0[5]), cvt_pk_bf16(p0[6], p0[7])}; \
        const u32x4 pw1 = (u32x4){cvt_pk_bf16(p0[8], p0[9]), cvt_pk_bf16(p0[10], p0[11]), cvt_pk_bf16(p0[12], p0[13]), cvt_pk_bf16(p0[14], p0[15])}; \
        const u32x4 pw2 = (u32x4){cvt_pk_bf16(p1[0], p1[1]), cvt_pk_bf16(p1[2], p1[3]), cvt_pk_bf16(p1[4], p1[5]), cvt_pk_bf16(p1[6], p1[7])}; \
        const u32x4 pw3 = (u32x4){cvt_pk_bf16(p1[8], p1[9]), cvt_pk_bf16(p1[10], p1[11]), cvt_pk_bf16(p1[12], p1[13]), cvt_pk_bf16(p1[14], p1[15])}; \
        pv(o, lacc, vp0 + sl_ * VSLOT, __builtin_bit_cast(bf16x8, pw0), __builtin_bit_cast(bf16x8, pw1), __builtin_bit_cast(bf16x8, pw2), __builtin_bit_cast(bf16x8, pw3)); \
        __builtin_amdgcn_s_setprio(0); } while (0)
#define ATT_TOPWAIT(j) do { if ((j) + 1 < d.jhi) { if (DUAL) { ATT_WAIT_BAR(4); } else if (MODE == 2 || two) { ATT_WAIT_BAR(3); } else { ATT_WAIT_BAR(2); } } else { ATT_WAIT_BAR(0); } } while (0)
    if (wid < 4) {
        for (int j = d.jlo; j < d.jhi; ++j) {
            ATT_TOPWAIT(j);
            if (j + 2 < d.jhi) ATT_ISSUE(j + 2);
            if (ATT_REL(j)) { ATT_QK(j); ATT_SMPV(j); }
        }
        asm volatile("s_waitcnt lgkmcnt(0)\n\ts_barrier" ::: "memory");
    } else {
        ATT_TOPWAIT(d.jlo);
        if (d.jlo + 2 < d.jhi) ATT_ISSUE(d.jlo + 2);
        if (ATT_REL(d.jlo)) ATT_QK(d.jlo);
        for (int j = d.jlo + 1; j < d.jhi; ++j) {
            ATT_TOPWAIT(j);
            if (j + 2 < d.jhi) ATT_ISSUE(j + 2);
            if (ATT_REL(j - 1)) ATT_SMPV(j - 1);
            if (ATT_REL(j)) ATT_QK(j);
        }
        asm volatile("s_waitcnt lgkmcnt(0)\n\ts_barrier" ::: "memory");
        if (ATT_REL(d.jhi - 1)) ATT_SMPV(d.jhi - 1);
    }
#undef ATT_REL
#undef ATT_QK
#undef ATT_SMPV
#undef ATT_TOPWAIT
#undef ATT_ISSUE
    if (wvalid) {
        LAS bf16_t* stg = (LAS bf16_t*)(lds + A_OST) + wid * 2048;
        if (d_.lse != nullptr && r32 == 0) {
#pragma unroll
            for (int r = 0; r < 16; ++r) wsf[32 + crow(r, hi)] = lacc[r]; }
        if (d.o8) {
            LAS unsigned char* stg8 = (LAS unsigned char*)stg;
#pragma unroll
            for (int r = 0; r < 16; ++r) { const int orow = crow(r, hi); const float rl = __builtin_amdgcn_rcpf(lacc[r]) * 32.f;
                const unsigned p = (unsigned)__builtin_amdgcn_cvt_pk_fp8_f32(o[0][r] * rl, o[1][r] * rl, 0, false);
                stg8[orow * 64 + r32] = (unsigned char)(p & 0xffu); stg8[orow * 64 + 32 + r32] = (unsigned char)((p >> 8) & 0xffu); }
            LDS_WAIT();
#pragma unroll
            for (int i = 0; i < 2; ++i) { const int row = i * 16 + (lane >> 2), ch = lane & 3; const u32x4 v = *(const LAS u32x4*)(stg8 + row * 64 + ch * 16);
                *(u32x4*)((unsigned char*)d_.O + (size_t)(qw + row) * d.rstride * d.opitch + ch * 16) = v; }
        } else {
#pragma unroll
        for (int r = 0; r < 16; ++r) { const int orow = crow(r, hi); const float rl = __builtin_amdgcn_rcpf(lacc[r]);
            stg[orow * 64 + r32] = (bf16_t)f2bf(o[0][r] * rl); stg[orow * 64 + 32 + r32] = (bf16_t)f2bf(o[1][r] * rl); }
        LDS_WAIT();
#pragma unroll
        for (int i = 0; i < 4; ++i) { const int row = i * 8 + (lane >> 3), ch = lane & 7; const u32x4 v = *(const LAS u32x4*)(stg + row * 64 + ch * 8);
            *(u32x4*)(d_.O + (size_t)(qw + row) * d.rstride * d.opitch + ch * 8) = v; }
        }
        if (d_.lse != nullptr && hi == 0) d_.lse[(size_t)(qw + r32) * d.rstride * d.lsepitch] = mhat + __builtin_amdgcn_logf(wsf[32 + r32]);
    }
    asm volatile("s_waitcnt lgkmcnt(0)\n\ts_barrier" ::: "memory");
}
}

namespace idx {
constexpr int KS = 8192, I_K = 0, I_ST = 3 * KS, I_END = I_ST + 8 * 8192;
static_assert(I_END <= RING_BYTES, "indexer LDS");
__device__ __forceinline__ void score_unit(LAS unsigned char* lds, const bf16_t* PROJ, float* SC, int b, int qh  , int jg) {
    int tid_ = threadIdx.x; asm volatile("" : "+v"(tid_));
    const int tid = tid_, lane = tid & 63, r32 = lane & 31, hi = lane >> 5, wid = __builtin_amdgcn_readfirstlane(tid >> 6);
    const int qg = wid >> 1, hh = wid & 1;
    const unsigned lds0 = (unsigned)(size_t)lds;
    const int qrow = b * SEQ + qh * 128 + qg * 32 + r32;
    const bf16_t* kbase = PROJ + (size_t)(b * SEQ) * PW + 3968;
    const int kkey = 8 * wid + (lane >> 3);
    const bf16_t* ksrc = kbase + (size_t)kkey * PW + ((lane & 7) ^ ((kkey >> 1) & 7)) * 8;
    const int j0 = 4 * jg;
#define IDX_ISSUE(j) att::glds16(ksrc + (size_t)(j) * 64 * PW, (unsigned)__builtin_amdgcn_readfirstlane(lds0 + I_K + ((j) % 3) * KS + wid * 1024))
    IDX_ISSUE(j0); IDX_ISSUE(j0 + 1);
    bf16x8 qf[4][4]; float wv[4];
    { const bf16_t* qp = PROJ + (size_t)qrow * PW + 3328 + hh * 256 + hi * 8;
#pragma unroll
      for (int h = 0; h < 4; ++h)
#pragma unroll
          for (int d0 = 0; d0 < 4; ++d0) qf[h][d0] = *(const bf16x8*)(qp + h * 64 + d0 * 16);
      const u32x2 ww = *(const u32x2*)(PROJ + (size_t)qrow * PW + 4032 + hh * 4);
      wv[0] = bflo(ww.x); wv[1] = bfhi(ww.x); wv[2] = bflo(ww.y); wv[3] = bfhi(ww.y); }
#pragma unroll
    for (int h = 0; h < 4; ++h) { asm volatile("" : "+v"(wv[h]));
#pragma unroll
        for (int d0 = 0; d0 < 4; ++d0) asm volatile("" : "+v"(qf[h][d0])); }
    const int qb = qh >> 1;
    unsigned* blk = (unsigned*)SC + ((size_t)b * 36 + (size_t)(qb * (qb + 1) / 2)) * 32768; const int pitch = 128 * (qb + 1);
    f32x4 ve[4] = {};
    LAS unsigned char* stg = lds + I_ST + wid * 8192;
    const LAS unsigned char* stg2 = lds + I_ST + (wid ^ 1) * 8192;
#pragma nounroll
    for (int jj = 0; jj < 4; ++jj) { const int j = j0 + jj;
        if (jj < 2) { ATT_WAIT_BAR(1); } else if (jj == 2) { ATT_WAIT_BAR(5); } else { ATT_WAIT_BAR(4); }
        if (jj + 2 < 4) IDX_ISSUE(j + 2);
        const LAS unsigned char* kb = lds + I_K + (j % 3) * KS + r32 * 128;
#pragma nounroll
        for (int half = 0; half < 2; ++half) {
            bf16x8 kf[4];
#pragma unroll
            for (int d0 = 0; d0 < 4; ++d0) kf[d0] = *(const LAS bf16x8*)(kb + half * 4096 + (((2 * d0 + hi) ^ ((r32 >> 1) & 7)) * 16));
            f32x16 t0 = f32x16{};
#pragma unroll
            for (int h = 0; h < 4; ++h) {
                f32x16 p0 = f32x16{};
#pragma unroll
                for (int d0 = 0; d0 < 4; ++d0) p0 = __builtin_amdgcn_mfma_f32_32x32x16_bf16(kf[d0], qf[h][d0], p0, 0, 0, 0);
#pragma unroll
                for (int r = 0; r < 16; ++r) t0[r] += wv[h] * att::emax(p0[r], 0.f);
            }
#pragma unroll
            for (int g = 0; g < 4; ++g) { const int c0 = 8 * half + 2 * g + hi;
                *(LAS f32x4*)(stg + r32 * 256 + ((c0 ^ (r32 & 15)) * 16)) = (f32x4){t0[4 * g], t0[4 * g + 1], t0[4 * g + 2], t0[4 * g + 3]}; }
        }
        asm volatile("s_waitcnt lgkmcnt(0)\n\ts_barrier" ::: "memory");
#pragma unroll
        for (int i = 0; i < 4; ++i) { const int q = hh * 16 + i * 4 + (lane >> 4), c = lane & 15; const int so = q * 256 + ((c ^ (q & 15)) * 16);
            const f32x4 v = *(const LAS f32x4*)(stg + so) + *(const LAS f32x4*)(stg2 + so);
            if (jj & 1) { const f32x4 e = ve[i]; const u32x4 w = {pk2(e[0], v[0]), pk2(e[1], v[1]), pk2(e[2], v[2]), pk2(e[3], v[3])};
                *(u32x4*)(blk + (size_t)((qh & 1) * 128 + qg * 32 + q) * pitch + 64 * (j >> 1) + 4 * c) = w; }
            else ve[i] = v; }
        LDS_WAIT();
    }
#undef IDX_ISSUE
    asm volatile("s_waitcnt lgkmcnt(0)\n\ts_barrier" ::: "memory");
}

__device__ __forceinline__ int wave_sum_i(int v) {
    v += __builtin_amdgcn_update_dpp(0, v, 0xB1, 0xF, 0xF, true);
    v += __builtin_amdgcn_update_dpp(0, v, 0x4E, 0xF, 0xF, true);
    v += __builtin_amdgcn_update_dpp(0, v, 0x141, 0xF, 0xF, true);
    v += __builtin_amdgcn_update_dpp(0, v, 0x140, 0xF, 0xF, true);
    return __builtin_amdgcn_readlane(v, 0) + __builtin_amdgcn_readlane(v, 16) + __builtin_amdgcn_readlane(v, 32) + __builtin_amdgcn_readlane(v, 48);
}
__device__ __forceinline__ unsigned long long keep_low(unsigned long long m, int k) { while (__builtin_popcountll(m) > k) m &= ~(1ull << (63 - __builtin_clzll(m))); return m; }
__device__ __forceinline__ void select_rows4(const float* SC, unsigned* MASK, int row0  , int lane, LAS unsigned* slot  ) {
    const int b = row0 / SEQ, t0 = row0 % SEQ, qb = t0 >> 8;
    if (t0 < 256) {
#pragma unroll 1
        for (int i = 0; i < 4; ++i) { const int t = t0 + i, lo = 64 * lane;
            const unsigned long long w = (lo + 63 <= t) ? ~0ull : (lo > t ? 0ull : ((2ull << (t - lo)) - 1ull));
            if (lane < 32) ((unsigned long long*)(MASK + (size_t)(row0 + i) * 64))[lane] = w; }
        return;
    }
    const int pitch = 128 * (qb + 1), pmax = pitch - 1;
    const unsigned* srow0 = (const unsigned*)SC + ((size_t)b * 36 + (size_t)(qb * (qb + 1) / 2)) * 32768 + (size_t)(t0 - 256 * qb) * pitch;
    unsigned raw[16];
#pragma unroll
    for (int i = 0; i < 16; ++i) { const int s_ = 64 * i + lane; raw[i] = srow0[s_ < pmax ? s_ : pmax]; }
#pragma unroll 1
    for (int r = 0; r < 4; ++r) {
        const int t = t0 + r;
        unsigned P[16];
#pragma unroll
        for (int i = 0; i < 16; ++i) P[i] = raw[i];
        { const unsigned* nx = srow0 + (size_t)(r < 3 ? r + 1 : 3) * pitch;
#pragma unroll
          for (int i = 0; i < 16; ++i) { const int s_ = 64 * i + lane; raw[i] = nx[s_ < pmax ? s_ : pmax]; } }
#define SEL_TSTAGE(sh, m) _Pragma("unroll") for (int q = 0; q < 16; ++q) if (!(q & (sh))) { const unsigned a_ = P[q], b_ = P[q + (sh)]; \
            P[q] = (a_ & (m)) | ((b_ << (sh)) & ~(m)); P[q + (sh)] = ((a_ >> (sh)) & (m)) | (b_ & ~(m)); }
        SEL_TSTAGE(8, 0x00FF00FFu) SEL_TSTAGE(4, 0x0F0F0F0Fu) SEL_TSTAGE(2, 0x33333333u) SEL_TSTAGE(1, 0x55555555u)
#undef SEL_TSTAGE
        { const unsigned sg = P[15];
#pragma unroll
          for (int q = 0; q < 15; ++q) P[q] ^= sg;
          P[15] = ~sg; }
        const int nj = ((t - lane) >> 6) + 1;
        unsigned A = ((1u << ((nj + 1) >> 1)) - 1u) | (((1u << (nj >> 1)) - 1u) << 16), G = 0u;
        int cab = 0, cntA = t + 1;
#pragma unroll
        for (int bit = 15; bit >= 0; --bit) {
            if (cab + cntA != 256) {
                const unsigned ones = A & P[bit];
                const int c = wave_sum_i(__builtin_popcount(ones));
                if (cab + c >= 256) { A = ones; cntA = c; } else { G |= ones; cab += c; A &= ~ones; cntA -= c; }
            }
        }
        int need = 256 - cab;
        unsigned sel = G | A;
        if (cntA != need) {
            unsigned selA = 0u;
#pragma nounroll
            for (int j = 0; j < 32; ++j) { const int pb = (j >> 1) + 16 * (j & 1);
                unsigned long long m = __ballot((A >> pb) & 1u);
                if (__builtin_popcountll(m) > need) m = keep_low(m, need);
                need -= __builtin_popcountll(m);
                selA |= (unsigned)((m >> lane) & 1ull) << pb;
            }
            sel = G | selA;
        }
        int lo = 0, hi = 0;
#pragma unroll
        for (int j = 0; j < 32; ++j) { const unsigned long long m = __ballot((sel >> ((j >> 1) + 16 * (j & 1))) & 1u);
            lo = (lane == j) ? (int)(unsigned)m : lo; hi = (lane == j) ? (int)(unsigned)(m >> 32) : hi; }
        if (lane < 32) ((unsigned long long*)(MASK + (size_t)(row0 + r) * 64))[lane] = (unsigned long long)(unsigned)lo | ((unsigned long long)(unsigned)hi << 32);
    }
}
}

__device__ __forceinline__ unsigned* queue_word(Frame& F, int l, int chunk, int q) { return (unsigned*)(F.ws + WS_CTL) + CW_QUEUE + 64 * ((l * NCHUNK + chunk) * 4 + q); }

__device__ __forceinline__ void phase_proj(Frame& F, int l, int chunk) {
    PHASE_IDS(F);
    { LAS float* gb = (LAS float*)(F.lds + L_GB); const float* bg = F.in[7] + (size_t)l * 3072;
      __syncthreads();
      for (int i = F.tid; i < 3072; i += NTHREADS) gb[i] = bg[i];
      VM_WAIT(); LDS_WAIT(); __syncthreads(); }
    pg8::ProjSched8 S{{{(const bf16_t*)(F.ws + WS_XB8 + (size_t)chunk * TC * DM), (const bf16_t*)(F.ws + WS_WIN8), DM / 2, DM / 2, TC / 256, (PW + 3072) / 256, F.G, (int)blockIdx.x}, F8_SW, F8_SA_X}};
    const float* rp = (const float*)(F.ws + WS_ROPE);
    EpiProj E{(bf16_t*)(F.ws + WS_PROJ), rp, rp + 2048 * 8 * 2, (float*)(F.ws + WS_SSQ), (bf16_t*)(F.ws + WS_G3), (const LAS float*)(F.lds + L_GB)};
    pg8::gemm_phase<EpiProj, pg8::ProjSched8, true, true>(F.lds, DM / 2, S, E);
}
__device__ __forceinline__ void dilated_unit(Frame& F, int u) {
    const bf16_t* PROJ = (const bf16_t*)(F.ws + WS_PROJ); bf16_t* OG = (bf16_t*)(F.ws + WS_OG); float* LSE = (float*)(F.ws + WS_LSE);
    constexpr int N_G0 = NBC * 4 * 8, N_G1 = NBC * 4 * 4 * 2;
    int g, b, h, res, qb, dil, nq;
    if (u < N_G0) { g = 0; dil = 1; qb = 7 - u / (NBC * 4); const int bh = u % (NBC * 4); b = bh >> 2; h = bh & 3; res = 0; nq = 256; }
    else if (u < N_G0 + N_G1) { const int v = u - N_G0; g = 1; dil = 4; qb = 1 - v / (NBC * 16); const int x = v % (NBC * 16); b = x >> 4; h = (x >> 2) & 3; res = x & 3; nq = 256; }
    else { const int v = u - N_G0 - N_G1; g = 2; dil = 16; qb = 0; b = v >> 5; h = (v >> 3) & 3; res = (v & 7) * 2; nq = 128; }
    att::Desc d; const size_t r0 = (size_t)b * SEQ + res;
    const bf16_t* base = PROJ + r0 * PW + 512 + 768 * g + 64 * h;
    d.Q = base; d.K1 = base + 256; d.V = base + 512; d.K2 = nullptr; d.qpitch = d.k1pitch = d.vpitch = PW; d.k2pitch = 0;
    d.O = OG + ((size_t)g * TC + r0) * 256 + 64 * h; d.opitch = 256; d.lse = LSE + ((size_t)g * TC + r0) * 4 + h; d.lsepitch = 4; d.mask = nullptr;
    d.rstride = dil; d.q0 = qb * 256; d.nq = nq; d.o8 = 0;
    if (g == 2) { d.jlo = 0; d.jhi = 2; att::attn_unit<64, 0, true>(F.lds, d); }
    else { d.jlo = (qb * 4 - 2) > 0 ? (qb * 4 - 2) : 0; d.jhi = 4 * (qb + 1); att::attn_unit<64, 1>(F.lds, d); }
}

struct UpSched {
    static constexpr bool GATHER = false;
    const char* A; const char* B; size_t sB; int lda, ldb, nM, G, c;
    __device__ __forceinline__ bool next(int i, pg8::Unit& u) const { const int v = i * G + c; if (v >= nM * 7) return false; u.pm = v / 7; u.pn = v % 7; u.ord = i; return true; }
    __device__ __forceinline__ const char* a_base(const pg8::Unit& u) const { return A + ((size_t)u.pm * 256 * lda + (u.pn >= 3 ? 256 : 0)) * 2; }
    __device__ __forceinline__ const char* b_base(const pg8::Unit& u) const { return B + (u.pn >= 3 ? sB + (size_t)(u.pn - 3) * 256 * ldb * 2 : (size_t)u.pn * 256 * ldb * 2); }
    __device__ __forceinline__ void a_off(const pg8::Unit&, const int (&R)[2], const int (&C)[2], unsigned (&v)[2][2]) const {
#pragma unroll
        for (int i = 0; i < 2; ++i) { v[0][i] = (unsigned)(R[i] * lda + C[i]) * 2u; v[1][i] = (unsigned)((128 + R[i]) * lda + C[i]) * 2u; }
    }
};
struct EpiUp {
    EpiUpQ q; EpiUpKV kv;
    __device__ __forceinline__ void operator()(const f32x4 (&acc)[2][2][4][2], const pg8::Unit& u, int wr, int wc, int fr, int fq) const {
        if (u.pn < 3) q(acc, u, wr, wc, fr, fq);
        else { pg8::Unit u2 = u; u2.pn = u.pn - 3; kv(acc, u2, wr, wc, fr, fq); }
    }
};
__device__ __forceinline__ void phase_up_scores(Frame& F, int l, int chunk) {
    PHASE_IDS(F);
    const bf16_t* PROJ = (const bf16_t*)(F.ws + WS_PROJ);
    const float* rp = (const float*)(F.ws + WS_ROPE);
    {   UpSched S{(const char*)PROJ, (const char*)(F.ws + WS_WUQ), WS_WUKV - WS_WUQ, PW, 256, TC / 256, F.G, (int)blockIdx.x};
        EpiUp E{{(bf16_t*)(F.ws + WS_QM), rp + 2048 * 8 * 2, (const float*)(F.ws + WS_SSQ)}, {(bf16_t*)(F.ws + WS_KVM), (const float*)(F.ws + WS_SSQ)}};
        pg8::gemm_phase<EpiUp, UpSched, true>(F.lds, 256, S, E); }
    unsigned* qw = queue_word(F, l, chunk, 0); int pre = -1;
    for (;;) {
        const int u = dequeue(F, qw, pre);
        if (u < NBC * 64) { dilated_unit(F, u); continue; }
        if (u >= NBC * 64 + NBC * 72 + NBC * 32) break;
        if (u >= NBC * 64 + NBC * 72) { dilated_unit(F, u - NBC * 72); continue; }
        const int v = u - NBC * 64; const int b = v / 72; int r = v % 72, qh = 0; while (r > (qh >> 1)) { r -= (qh >> 1) + 1; ++qh; }
        idx::score_unit(F.lds, PROJ, (float*)(F.ws + WS_SC), b, qh, r);
    }
}
__device__ __forceinline__ void phase_attn1(Frame& F, int l, int chunk, int tmask = 7) {
    PHASE_IDS(F);
    const bf16_t* PROJ = (const bf16_t*)(F.ws + WS_PROJ); const bf16_t* QM = (const bf16_t*)(F.ws + WS_QM); const bf16_t* KVM = (const bf16_t*)(F.ws + WS_KVM);
    bf16_t* OA = (bf16_t*)(F.ws + WS_OA); bf16_t* OG = (bf16_t*)(F.ws + WS_OG); float* LSE = (float*)(F.ws + WS_LSE);
    constexpr int N_MLA = NBC * 8 * 8, N_SEL = TC / 32;
    unsigned* qw = queue_word(F, l, chunk, 1); int pre = -1;
    for (;;) {
        int u = dequeue(F, qw, pre);
        if (u < N_MLA) {
            if (!(tmask & 1)) continue;
            const int qb = 7 - u / (NBC * 8), bh = u % (NBC * 8), b = bh >> 3, h = bh & 7;
            att::Desc d; const size_t r0 = (size_t)b * SEQ;
            d.Q = QM + r0 * 768 + h * 96; d.qpitch = 768; d.K1 = KVM + r0 * 1024 + h * 128; d.k1pitch = 1024; d.K2 = PROJ + r0 * PW + 384; d.k2pitch = PW;
            d.V = KVM + r0 * 1024 + h * 128 + 64; d.vpitch = 1024; d.O = (bf16_t*)((unsigned char*)OA + r0 * 512 + h * 64); d.opitch = 512; d.o8 = 1; d.lse = nullptr; d.lsepitch = 0; d.mask = nullptr;
            d.rstride = 1; d.q0 = qb * 256; d.nq = 256; d.jlo = 0; d.jhi = 4 * (qb + 1);
            att::attn_unit<96, 0>(F.lds, d); continue; }
        u -= N_MLA;
        if (u >= N_SEL) break;
        if (!(tmask & 4)) continue;
        idx::select_rows4((const float*)(F.ws + WS_SC), (unsigned*)(F.ws + WS_MASK), u * 32 + F.wave * 4, F.lane, (LAS unsigned*)(F.lds + L_GB) + F.wave * 64);
    }
}
__device__ __forceinline__ void phase_attn2(Frame& F, int l, int chunk) {
    PHASE_IDS(F);
    const bf16_t* PROJ = (const bf16_t*)(F.ws + WS_PROJ);
    bf16_t* OC = (bf16_t*)(F.ws + WS_OC);
    unsigned* qw = queue_word(F, l, chunk, 2); int pre = -1;
    for (;;) {
        const int u = dequeue(F, qw, pre);
        if (u >= NBC * 64) break;
        const int qb = 7 - u / (NBC * 8), bh = u % (NBC * 8), b = bh >> 3, h = bh & 7;
        att::Desc d; const size_t r0 = (size_t)b * SEQ;
        d.Q = PROJ + r0 * PW + 2816 + 64 * h; d.K1 = PROJ + r0 * PW + 3840; d.V = PROJ + r0 * PW + 3904; d.K2 = nullptr; d.qpitch = d.k1pitch = d.vpitch = PW; d.k2pitch = 0;
        d.O = (bf16_t*)((unsigned char*)OC + r0 * 512 + 64 * h); d.opitch = 512; d.o8 = 1; d.lse = nullptr; d.lsepitch = 0; d.mask = (const unsigned*)(F.ws + WS_MASK) + r0 * 64;
        d.rstride = 1; d.q0 = qb * 256; d.nq = 256; d.jlo = 0; d.jhi = 4 * (qb + 1);
        att::attn_unit<64, 2>(F.lds, d);
    }
    const bf16_t* OG = (const bf16_t*)(F.ws + WS_OG); const float* LSE = (const float*)(F.ws + WS_LSE); bf16_t* OB = (bf16_t*)(F.ws + WS_OB);
    const int gw = F.vcu * NWAVES + F.wave, NGW = F.G * NWAVES, h = F.lane >> 4;
    for (int row = gw; row < TC; row += NGW) {
        const float l0 = LSE[(size_t)row * 4 + h], l1 = LSE[((size_t)TC + row) * 4 + h], l2 = LSE[((size_t)2 * TC + row) * 4 + h];
        const float mx = fmaxf(l0, fmaxf(l1, l2));
        float w0 = __builtin_amdgcn_exp2f(l0 - mx), w1 = __builtin_amdgcn_exp2f(l1 - mx), w2 = __builtin_amdgcn_exp2f(l2 - mx);
        const float inv = 1.0f / (w0 + w1 + w2); w0 *= inv; w1 *= inv; w2 *= inv;
        const u32x2 a = *(const u32x2*)(OG + (size_t)row * 256 + F.lane * 4), bq = *(const u32x2*)(OG + ((size_t)TC + row) * 256 + F.lane * 4), c = *(const u32x2*)(OG + ((size_t)2 * TC + row) * 256 + F.lane * 4);
        w0 *= 32.f; w1 *= 32.f; w2 *= 32.f;
        *(unsigned*)((unsigned char*)OB + (size_t)row * 512 + F.lane * 4) = pk4_fp8(w0 * bflo(a.x) + w1 * bflo(bq.x) + w2 * bflo(c.x), w0 * bfhi(a.x) + w1 * bfhi(bq.x) + w2 * bfhi(c.x),
                                                                                    w0 * bflo(a.y) + w1 * bflo(bq.y) + w2 * bflo(c.y), w0 * bfhi(a.y) + w1 * bfhi(bq.y) + w2 * bfhi(c.y));
    }
}
constexpr int CW_DEP = 32768;
__device__ __forceinline__ void phase_attn(Frame& F, int l, int chunk) {
    PHASE_IDS(F);
    const bf16_t* PROJ = (const bf16_t*)(F.ws + WS_PROJ); const bf16_t* QM = (const bf16_t*)(F.ws + WS_QM); const bf16_t* KVM = (const bf16_t*)(F.ws + WS_KVM);
    bf16_t* OA = (bf16_t*)(F.ws + WS_OA); bf16_t* OC = (bf16_t*)(F.ws + WS_OC);
    constexpr int N_SEL = TC / 32, NQ = NBC * 8;
    unsigned* dep = (unsigned*)(F.ws + WS_CTL) + CW_DEP + (l * NCHUNK + chunk) * (NBC * 8);
    unsigned* qw = queue_word(F, l, chunk, 1); int pre = -1;
    for (;;) {
        int u = dequeue(F, qw, pre);
        if (u < N_SEL) {
            idx::select_rows4((const float*)(F.ws + WS_SC), (unsigned*)(F.ws + WS_MASK), u * 32 + F.wave * 4, F.lane, (LAS unsigned*)(F.lds + L_GB) + F.wave * 64);
            VM_WAIT();
            __syncthreads();
            if (F.tid == 0) { const int row = u * 32, b = row / SEQ, qb = (row % SEQ) >> 8;
                __builtin_amdgcn_fence(__ATOMIC_RELEASE, "agent");
                __hip_atomic_fetch_add(dep + b * 8 + qb, 1u, __ATOMIC_RELAXED, __HIP_MEMORY_SCOPE_AGENT); }
            continue; }
        u -= N_SEL;
        if (u >= 16 * NQ) break;
        const int qb = 7 - u / (2 * NQ), w = u % (2 * NQ);
        if (w < NQ) {
            const int b = w >> 3, h = w & 7;
            att::Desc d; const size_t r0 = (size_t)b * SEQ;
            d.Q = QM + r0 * 768 + h * 96; d.qpitch = 768; d.K1 = KVM + r0 * 1024 + h * 128; d.k1pitch = 1024; d.K2 = PROJ + r0 * PW + 384; d.k2pitch = PW;
            d.V = KVM + r0 * 1024 + h * 128 + 64; d.vpitch = 1024; d.O = (bf16_t*)((unsigned char*)OA + r0 * 512 + h * 64); d.opitch = 512; d.o8 = 1; d.lse = nullptr; d.lsepitch = 0; d.mask = nullptr;
            d.rstride = 1; d.q0 = qb * 256; d.nq = 256; d.jlo = 0; d.jhi = 4 * (qb + 1);
            att::attn_unit<96, 0>(F.lds, d);
        } else {
            const int bh = w - NQ, b = bh >> 3, h = bh & 7;
            if (F.tid == 0) { while (__hip_atomic_load(dep + b * 8 + qb, __ATOMIC_RELAXED, __HIP_MEMORY_SCOPE_AGENT) < 8u) __builtin_amdgcn_s_sleep(4);
                __builtin_amdgcn_fence(__ATOMIC_ACQUIRE, "agent"); }
            __syncthreads();
            att::Desc d; const size_t r0 = (size_t)b * SEQ;
            d.Q = PROJ + r0 * PW + 2816 + 64 * h; d.K1 = PROJ + r0 * PW + 3840; d.V = PROJ + r0 * PW + 3904; d.K2 = nullptr; d.qpitch = d.k1pitch = d.vpitch = PW; d.k2pitch = 0;
            d.O = (bf16_t*)((unsigned char*)OC + r0 * 512 + 64 * h); d.opitch = 512; d.o8 = 1; d.lse = nullptr; d.lsepitch = 0; d.mask = (const unsigned*)(F.ws + WS_MASK) + r0 * 64;
            d.rstride = 1; d.q0 = qb * 256; d.nq = 256; d.jlo = 0; d.jhi = 4 * (qb + 1);
            att::attn_unit<64, 2>(F.lds, d);
        }
    }
    const bf16_t* OG = (const bf16_t*)(F.ws + WS_OG); const float* LSE = (const float*)(F.ws + WS_LSE); bf16_t* OB = (bf16_t*)(F.ws + WS_OB);
    const int gw = F.vcu * NWAVES + F.wave, NGW = F.G * NWAVES, h = F.lane >> 4;
    for (int row0 = gw; row0 < TC; row0 += 4 * NGW) {
        float l0[4], l1[4], l2[4]; u32x2 a[4], bq[4], c[4]; int rows[4];
#pragma unroll
        for (int i = 0; i < 4; ++i) { const int row = row0 + i * NGW < TC ? row0 + i * NGW : row0; rows[i] = row;
            l0[i] = LSE[(size_t)row * 4 + h]; l1[i] = LSE[((size_t)TC + row) * 4 + h]; l2[i] = LSE[((size_t)2 * TC + row) * 4 + h];
            a[i] = *(const u32x2*)(OG + (size_t)row * 256 + F.lane * 4); bq[i] = *(const u32x2*)(OG + ((size_t)TC + row) * 256 + F.lane * 4); c[i] = *(const u32x2*)(OG + ((size_t)2 * TC + row) * 256 + F.lane * 4); }
#pragma unroll
        for (int i = 0; i < 4; ++i) {
            const float mx = fmaxf(l0[i], fmaxf(l1[i], l2[i]));
            float w0 = __builtin_amdgcn_exp2f(l0[i] - mx), w1 = __builtin_amdgcn_exp2f(l1[i] - mx), w2 = __builtin_amdgcn_exp2f(l2[i] - mx);
            const float inv = 32.0f / (w0 + w1 + w2); w0 *= inv; w1 *= inv; w2 *= inv;
            *(unsigned*)((unsigned char*)OB + (size_t)rows[i] * 512 + F.lane * 4) = pk4_fp8(w0 * bflo(a[i].x) + w1 * bflo(bq[i].x) + w2 * bflo(c[i].x), w0 * bfhi(a[i].x) + w1 * bfhi(bq[i].x) + w2 * bfhi(c[i].x),
                                                                                          w0 * bflo(a[i].y) + w1 * bflo(bq[i].y) + w2 * bflo(c[i].y), w0 * bfhi(a[i].y) + w1 * bfhi(bq[i].y) + w2 * bfhi(c[i].y));
        }
    }
}
__device__ __forceinline__ void phase_branches(Frame& F, int l, int chunk) {
    PHASE_IDS(F);
    static_assert(WS_OB - WS_OA == WS_OC - WS_OB && WS_WB - WS_WA == WS_WC - WS_WB, "equally spaced branch operands");
    BranchSched S{(const char*)(F.ws + WS_OA), (const char*)(F.ws + WS_WA), WS_OB - WS_OA, WS_WB - WS_WA, 256, 256, (int)blockIdx.x, F8_SW, 127 - 5, F.G, (TC / 256) * 4};
    EpiBranchAll E{(bf16_t*)(F.ws + WS_MERGED), (bf16_t*)(F.ws + WS_M0), (bf16_t*)(F.ws + WS_M1), (const bf16_t*)(F.ws + WS_G3)};
    pg8::gemm_phase<EpiBranchAll, BranchSched, true, true>(F.lds, 256, S, E);
}
__device__ __forceinline__ void phase_wo(Frame& F, int l, int chunk) {
    PHASE_IDS(F);
    pg8::DenseSched8 S{{(const bf16_t*)(F.ws + WS_MERGED), (const bf16_t*)(F.ws + WS_WO), DM / 2, DM / 2, TC / 256, 4, F.G, (int)blockIdx.x}, F8_SW, 127 - 6};
    EpiWo E{F.out, l == 0 ? F.in[0] : F.out, chunk * TC};
    pg8::gemm_phase<EpiWo, pg8::DenseSched8, true, true>(F.lds, DM / 2, S, E);
}

__global__ void __launch_bounds__(NTHREADS, 2) fwd_kernel(Args args) {
    extern __shared__ __attribute__((aligned(16))) unsigned char lds_raw[];
    Frame F;
    F.lds = (LAS unsigned char*)lds_raw;
    F.tid = threadIdx.x; F.lane = F.tid & 63; F.wave = __builtin_amdgcn_readfirstlane(F.tid >> 6);
    F.G = gridDim.x; { const int bx = blockIdx.x; F.vcu = (F.G % 8 == 0) ? (bx % 8) * (F.G / 8) + bx / 8 : bx; }
    F.in.p = (intab_t)__builtin_amdgcn_kernarg_segment_ptr(); F.out = args.out; F.ws = args.ws; F.out0 = args.out; F.ws0 = args.ws;
    for (int u = F.tid; u < (LDS_BYTES - L_CTL) / 4; u += NTHREADS) ((LAS unsigned*)(F.lds + L_CTL))[u] = 0u;
    __syncthreads();
    XcdBarrier bar = xcd_barrier_post((unsigned*)(F.ws + WS_CTL) + CW_BAR, (volatile LAS unsigned*)(F.lds + L_BARW));
#define GRID_BAR() xcd_barrier(bar)

    for (int l = 0; l < 2; ++l) {
        phase_conv_moe(F, l);
        phase_conv_mixer(F, l);
        GRID_BAR();
        for (int chunk = 0; chunk < NCHUNK; ++chunk) {
            phase_proj(F, l, chunk);
            GRID_BAR();
            if (DUPMASK & 2) { phase_proj(F, l, chunk); GRID_BAR(); }
            phase_up_scores(F, l, chunk);
            GRID_BAR();
            if (DUPMASK & 4) { phase_up_scores(F, l + 2, chunk); GRID_BAR(); }
            phase_attn(F, l, chunk);
            GRID_BAR();
            phase_branches(F, l, chunk);
            GRID_BAR();
            if (DUPMASK & 32) { phase_branches(F, l, chunk); GRID_BAR(); }
            phase_wo(F, l, chunk);
            if ((DUPMASK & 0x800) && l == 0) { GRID_BAR(); phase_wo(F, l, chunk); }
        }
        GRID_BAR();
        phase_ln1_router(F, l, F.out, false);
        GRID_BAR();
        phase_moe_scatter(F);
        GRID_BAR();
        phase_moe_gemm1(F);
        GRID_BAR();
        if (DUPMASK & 64) { phase_moe_gemm1(F); GRID_BAR(); }
        phase_moe_gemm2(F);
        GRID_BAR();
        if (DUPMASK & 128) { phase_moe_gemm2(F); GRID_BAR(); }
        phase_combine_ln2(F, l);
    }
}

extern "C" void kernel_launch(void* const* d_in, const int* in_sizes, int n_in, void* d_out, int out_size, void* d_ws, size_t ws_size, hipStream_t stream) {
    static int grid = 0;
    if (grid == 0) {
        if (n_in != 23 || out_size != TT * DM || ws_size < WS_END) { fprintf(stderr, "kernel_launch: unexpected shapes n_in %d out %d ws %zu\n", n_in, out_size, ws_size); grid = -1; return; }
        int dev = 0, cus = 0;
        if (hipGetDevice(&dev) != hipSuccess || hipDeviceGetAttribute(&cus, hipDeviceAttributeMultiprocessorCount, dev) != hipSuccess) { grid = -1; return; }
        if (hipFuncSetAttribute((const void*)fwd_kernel, hipFuncAttributeMaxDynamicSharedMemorySize, LDS_BYTES) != hipSuccess) { fprintf(stderr, "kernel_launch: hipFuncSetAttribute failed\n"); grid = -1; return; }
        int per_cu = 0;
        if (hipOccupancyMaxActiveBlocksPerMultiprocessor(&per_cu, (const void*)fwd_kernel, NTHREADS, LDS_BYTES) != hipSuccess || per_cu < 1) fprintf(stderr, "kernel_launch: occupancy query says %d\n", per_cu);
        (void)hipGetLastError();
        grid = cus;
    }
    if (grid < 0) return;
    if (hipMemsetAsync((char*)d_ws + WS_CTL, 0, CTL_ZERO_BYTES, stream) != hipSuccess) return;
    Args a{};
    for (int i = 0; i < 23; ++i) a.in[i] = (const float*)d_in[i];
    a.out = (float*)d_out; a.ws = (unsigned char*)d_ws;
    hipLaunchKernelGGL(fwd_kernel, dim3(grid), dim3(NTHREADS), LDS_BYTES, stream, a);
}
```

```cpp
#include <hip/hip_runtime.h>
#include <cstdio>
#include <cstdint>

#define LAS __attribute__((address_space(3)))
#define GAS __attribute__((address_space(1)))
typedef unsigned short bf16_t;
typedef short bf16x8 __attribute__((ext_vector_type(8)));
typedef float f32x4 __attribute__((ext_vector_type(4)));
typedef float f32x2 __attribute__((ext_vector_type(2)));
typedef float f32x16 __attribute__((ext_vector_type(16)));
typedef unsigned u32x4 __attribute__((ext_vector_type(4)));
typedef unsigned u32x2 __attribute__((ext_vector_type(2)));

constexpr int DM = 1024, NB = 32, SEQ = 2048, TT = NB * SEQ;
constexpr int NEXP = 32, DEXP = 256;
constexpr float LN_EPS = 1e-6f;
constexpr float ALPHA = 1.41421356237309515f;
constexpr int NWAVES = 8, NTHREADS = 512;

__device__ __forceinline__ unsigned f2bf(float f) { unsigned u = __builtin_bit_cast(unsigned, f); return (u + 0x7fffu + ((u >> 16) & 1u)) >> 16; }
__device__ __forceinline__ unsigned pk2(float lo, float hi) { return f2bf(lo) | (f2bf(hi) << 16); }
__device__ __forceinline__ float bf2f(unsigned short b) { return __builtin_bit_cast(float, (unsigned)b << 16); }
__device__ __forceinline__ float bflo(unsigned w) { return __builtin_bit_cast(float, w << 16); }
__device__ __forceinline__ float bfhi(unsigned w) { return __builtin_bit_cast(float, w & 0xffff0000u); }
typedef __bf16 bf16x2_t __attribute__((ext_vector_type(2)));
__device__ __forceinline__ unsigned cvt_pk_bf16(float lo, float hi) { const f32x2 v = {lo, hi}; const bf16x2_t b = __builtin_convertvector(v, bf16x2_t); return __builtin_bit_cast(unsigned, b); }
__device__ __forceinline__ float wave_sum(float v) {
#pragma unroll
    for (int o = 1; o < 64; o <<= 1) v += __shfl_xor(v, o);
    return v;
}
__device__ __forceinline__ float fast_exp(float x) { return __builtin_amdgcn_exp2f(x * 1.4426950408889634f); }
__device__ __forceinline__ float sigmoidf_(float x) { return __builtin_amdgcn_rcpf(1.0f + fast_exp(-x)); }
__device__ __forceinline__ unsigned pk4_fp8(float a, float b, float c, float d) {
    int p = __builtin_amdgcn_cvt_pk_fp8_f32(a, b, 0, false); p = __builtin_amdgcn_cvt_pk_fp8_f32(c, d, p, true); return (unsigned)p; }
__device__ __forceinline__ void store8_fp8(unsigned char* p, const f32x4& v0, const f32x4& v1, float sc) {
    u32x2 w; w.x = pk4_fp8(v0[0] * sc, v0[1] * sc, v0[2] * sc, v0[3] * sc); w.y = pk4_fp8(v1[0] * sc, v1[1] * sc, v1[2] * sc, v1[3] * sc); *(u32x2*)p = w;
}
#define LDS_WAIT() asm volatile("s_waitcnt lgkmcnt(0)" ::: "memory")
#define VM_WAIT() asm volatile("s_waitcnt vmcnt(0)" ::: "memory")

namespace pg8 {
constexpr int BM = 256, BK = 64, HALF = 128, HTB = HALF * BK * 2, STAGE_BYTES = 8 * HTB;
__device__ __forceinline__ int lds_byte(int r, int c) { return r * 128 + ((((c >> 3) ^ (r >> 1)) & 7) * 16) + (c & 7) * 2; }
__device__ __forceinline__ void stage_rc(int b, int& R, int& C) { R = b >> 7; C = ((((b >> 4) ^ (R >> 1)) & 7)) * 8; }
__device__ __forceinline__ int perm32(int rho) { const int n = rho >> 4, i = rho & 15; return 8 * (i >> 2) + 4 * n + (i & 3); }
struct Unit { int pm, pn, ord; };

template <class S, class = void> struct SchedVarK { static constexpr bool value = false; };
template <class S> struct SchedVarK<S, decltype((void)S::VARK)> { static constexpr bool value = S::VARK; };
typedef int v4i_t __attribute__((ext_vector_type(4)));
typedef int v8i_t __attribute__((ext_vector_type(8)));
__device__ __forceinline__ v8i_t cat8(const bf16x8& lo, const bf16x8& hi) { return __builtin_shufflevector(__builtin_bit_cast(v4i_t, lo), __builtin_bit_cast(v4i_t, hi), 0, 1, 2, 3, 4, 5, 6, 7); }
template <class Epi, class Sched, bool ALIGN_EPI, bool F8 = false>
__device__ __forceinline__ void gemm_phase(LAS unsigned char* lds, const int K, const Sched& S, const Epi& E) {
    int tid_ = threadIdx.x; asm volatile("" : "+v"(tid_));
    const int tid = tid_, wid = __builtin_amdgcn_readfirstlane(tid >> 6), lane = tid & 63, wr = wid >> 2, wc = wid & 3, fr = lane & 15, fq = lane >> 4;
    int nt = K / BK;
    int Rr[2], Cc[2]; unsigned vB[2][2];
#pragma unroll
    for (int i = 0; i < 2; ++i) { stage_rc(tid * 16 + i * 8192, Rr[i], Cc[i]); const int Rb = (Rr[i] & ~31) + perm32(Rr[i] & 31);
        vB[0][i] = (unsigned)(Rb * S.ldb + Cc[i]) * 2u; vB[1][i] = (unsigned)((HALF + Rb) * S.ldb + Cc[i]) * 2u; }
    const size_t kstep = (size_t)(BK * 2);
    const unsigned ldsw = (unsigned)wid * 1024u;
    const int aoff = lds_byte(wr * 64 + fr, fq * 8), boff = lds_byte(wc * 32 + fr, fq * 8);
    const int aoff1 = lds_byte(wr * 64 + fr, fq * 8 + 32), boff1 = lds_byte(wc * 32 + fr, fq * 8 + 32);
#define PG8_SA(b, h) (((b) * 2 + (h)) * HTB)
#define PG8_SB(b, h) ((4 + (b) * 2 + (h)) * HTB)
#define PG8_STAGE(bufoff, gbase, voff) do { _Pragma("unroll") for (int _i = 0; _i < 2; ++_i) \
        __builtin_amdgcn_global_load_lds((const unsigned*)((const char*)(gbase) + (voff)[_i]), (LAS unsigned*)(lds + (bufoff) + ldsw + _i * 8192), 16, 0, 0); } while (0)
#define PG8_LDA(dst, b, h) do { _Pragma("unroll") for (int m = 0; m < 4; ++m) { \
        const bf16x8 f0_ = *(const LAS bf16x8*)(lds + PG8_SA(b, h) + aoff + m * 2048), f1_ = *(const LAS bf16x8*)(lds + PG8_SA(b, h) + aoff1 + m * 2048); \
        if constexpr (F8) dst##8[m] = cat8(f0_, f1_); else { dst[m][0] = f0_; dst[m][1] = f1_; } } } while (0)
#define PG8_LDB(dst, b, h) do { _Pragma("unroll") for (int n = 0; n < 2; ++n) { \
        const bf16x8 f0_ = *(const LAS bf16x8*)(lds + PG8_SB(b, h) + boff + n * 2048), f1_ = *(const LAS bf16x8*)(lds + PG8_SB(b, h) + boff1 + n * 2048); \
        if constexpr (F8) dst##8[n] = cat8(f0_, f1_); else { dst[n][0] = f0_; dst[n][1] = f1_; } } } while (0)
#define PG8_MMA(ai, bj, At, Bt) do { __builtin_amdgcn_s_setprio(1); \
        if constexpr (F8) { _Pragma("unroll") for (int m = 0; m < 4; ++m) _Pragma("unroll") for (int n = 0; n < 2; ++n) \
            asm volatile("v_mfma_scale_f32_16x16x128_f8f6f4 %0, %1, %2, %0, %3, %4 op_sel_hi:[0,0,0]" : "+v"(acc[ai][bj][m][n]) : "v"(Bt##8[n]), "v"(At##8[m]), "v"(scw8), "v"(sca8)); } \
              \
        else { _Pragma("unroll") for (int m = 0; m < 4; ++m) _Pragma("unroll") for (int n = 0; n < 2; ++n) _Pragma("unroll") for (int k = 0; k < 2; ++k) \
            acc[ai][bj][m][n] = __builtin_amdgcn_mfma_f32_16x16x32_bf16(Bt[n][k], At[m][k], acc[ai][bj][m][n], 0, 0, 0); } \
        __builtin_amdgcn_s_setprio(0); } while (0)
#define PG8_WAIT_V(n) asm volatile("s_waitcnt vmcnt(" #n ")" ::: "memory")
#define PG8_WAIT_L(n) asm volatile("s_waitcnt lgkmcnt(" #n ")" ::: "memory")
#define PG8_BAR __builtin_amdgcn_s_barrier()
#define PG8_SCHED __builtin_amdgcn_sched_barrier(0)
    int scw8 = 0, sca8 = 0;
    if constexpr (F8) { scw8 = S.sw8 * 0x01010101; sca8 = S.sa8 * 0x01010101; }
    Unit cur, nxt; int ui = 0;
    if (!S.next(0, cur)) return;
    f32x4 acc[2][2][4][2];
#pragma unroll
    for (int a = 0; a < 2; ++a)
#pragma unroll
        for (int b = 0; b < 2; ++b)
#pragma unroll
            for (int m = 0; m < 4; ++m)
#pragma unroll
                for (int n = 0; n < 2; ++n) acc[a][b][m][n] = (f32x4){0.f, 0.f, 0.f, 0.f};
    bf16x8 At[4][2], B0[2][2], B1[2][2]; v8i_t At8[4], B08[2], B18[2];
    unsigned vAc[2][2], vAn[2][2];
    const char* cA = S.a_base(cur); const char* cB = S.b_base(cur);
    S.a_off(cur, Rr, Cc, vAc);
    if constexpr (SchedVarK<Sched>::value) nt = S.ktiles(cur);
    PG8_STAGE(PG8_SB(0, 0), cB, vB[0]); PG8_STAGE(PG8_SB(0, 1), cB, vB[1]); PG8_STAGE(PG8_SA(0, 0), cA, vAc[0]); PG8_STAGE(PG8_SA(0, 1), cA, vAc[1]);
    if (wr == 1) PG8_BAR;
    PG8_WAIT_V(2); PG8_BAR;
    PG8_STAGE(PG8_SB(1, 0), cB + kstep, vB[0]); PG8_STAGE(PG8_SA(1, 0), cA + kstep, vAc[0]); PG8_STAGE(PG8_SB(1, 1), cB + kstep, vB[1]);
    PG8_WAIT_V(6); PG8_BAR;
    bool epi_pend = false;
    for (;;) {
        const bool has_next = S.next(ui + 1, nxt);
        const char* nA = cA; const char* nB = cB;
        if constexpr (Sched::GATHER) {
#pragma unroll
            for (int h = 0; h < 2; ++h)
#pragma unroll
                for (int i = 0; i < 2; ++i) vAn[h][i] = vAc[h][i];
        }
        if (has_next) { nA = S.a_base(nxt); nB = S.b_base(nxt); if constexpr (Sched::GATHER) S.a_off(nxt, Rr, Cc, vAn); }
#pragma nounroll
        for (int t = 0; t < nt; t += 2) {
            const bool last = (t == nt - 2);
            const bool ep_ = epi_pend && t == 0;
            const char* a1 = cA + (size_t)(t + 1) * kstep;
            const char* a2 = last ? nA : cA + (size_t)(t + 2) * kstep; const char* b2 = last ? nB : cB + (size_t)(t + 2) * kstep;
            const char* a3 = a2 + kstep; const char* b3 = b2 + kstep;
            unsigned vA2[2][2];
#pragma unroll
            for (int h = 0; h < 2; ++h)
#pragma unroll
                for (int i = 0; i < 2; ++i) { if constexpr (Sched::GATHER) vA2[h][i] = last ? vAn[h][i] : vAc[h][i]; else vA2[h][i] = vAc[h][i]; }
            PG8_LDB(B0, 0, 0); PG8_LDB(B1, 0, 1); PG8_SCHED; PG8_LDA(At, 0, 0); PG8_STAGE(PG8_SA(1, 1), a1, vAc[1]);
            if (ep_) { PG8_WAIT_V(24); } else { PG8_WAIT_V(8); } PG8_WAIT_L(0); PG8_BAR; PG8_MMA(0, 0, At, B0); PG8_MMA(0, 1, At, B1); PG8_BAR; PG8_SCHED;
            PG8_LDA(At, 0, 1); PG8_STAGE(PG8_SB(0, 0), b2, vB[0]); PG8_STAGE(PG8_SB(0, 1), b2, vB[1]); PG8_STAGE(PG8_SA(0, 0), a2, vA2[0]);
            if (ep_) { PG8_WAIT_V(24); } else { PG8_WAIT_V(8); } PG8_WAIT_L(0); PG8_BAR; PG8_MMA(1, 0, At, B0); PG8_MMA(1, 1, At, B1); PG8_BAR; PG8_SCHED;
            PG8_LDB(B0, 1, 0); PG8_LDB(B1, 1, 1); PG8_SCHED; PG8_LDA(At, 1, 0); PG8_STAGE(PG8_SA(0, 1), a2, vA2[1]);
            PG8_WAIT_V(8); PG8_WAIT_L(0); PG8_BAR; PG8_MMA(0, 0, At, B0); PG8_MMA(0, 1, At, B1); PG8_BAR; PG8_SCHED;
            PG8_LDA(At, 1, 1); PG8_STAGE(PG8_SB(1, 0), b3, vB[0]); PG8_STAGE(PG8_SB(1, 1), b3, vB[1]); PG8_STAGE(PG8_SA(1, 0), a3, vA2[0]);
            PG8_WAIT_V(8); PG8_WAIT_L(0); PG8_BAR; PG8_MMA(1, 0, At, B0); PG8_MMA(1, 1, At, B1); PG8_BAR; PG8_SCHED;
        }
        if constexpr (ALIGN_EPI) { if (wr == 0) PG8_BAR; }
        if constexpr (F8) asm volatile("s_nop 15\n\ts_nop 15" ::: "memory");
        { int l2_ = lane; asm volatile("" : "+v"(l2_)); E(acc, cur, wr, wc, l2_ & 15, l2_ >> 4); }
        if (!has_next) break;
        epi_pend = true;
#pragma unroll
        for (int a = 0; a < 2; ++a)
#pragma unroll
            for (int b = 0; b < 2; ++b)
#pragma unroll
                for (int m = 0; m < 4; ++m)
#pragma unroll
                    for (int n = 0; n < 2; ++n) acc[a][b][m][n] = (f32x4){0.f, 0.f, 0.f, 0.f};
        cur = nxt; cA = nA; cB = nB; ++ui;
        if constexpr (SchedVarK<Sched>::value) nt = S.ktiles(cur);
        if constexpr (Sched::GATHER) {
#pragma unroll
            for (int h = 0; h < 2; ++h)
#pragma unroll
                for (int i = 0; i < 2; ++i) vAc[h][i] = vAn[h][i];
        }
        if constexpr (ALIGN_EPI) { if (wr == 1) PG8_BAR; }
    }
    PG8_WAIT_V(0);
    if constexpr (!ALIGN_EPI) { if (wr == 0) PG8_BAR; }
    asm volatile("s_waitcnt vmcnt(0) lgkmcnt(0)\n\ts_barrier" ::: "memory");
    __builtin_amdgcn_sched_barrier(0);
#undef PG8_SA
#undef PG8_SB
#undef PG8_STAGE
#undef PG8_LDA
#undef PG8_LDB
#undef PG8_MMA
#undef PG8_WAIT_V
#undef PG8_WAIT_L
#undef PG8_BAR
#undef PG8_SCHED
}

struct DenseSched {
    static constexpr bool GATHER = false;
    const bf16_t* A; const bf16_t* Bt; int lda, ldb, nM, nN, G, c;
    __device__ __forceinline__ bool next(int i, Unit& u) const { const int v = i * G + c; if (v >= nM * nN) return false; u.pm = v / nN; u.pn = v % nN; u.ord = i; return true; }
    __device__ __forceinline__ const char* a_base(const Unit& u) const { return (const char*)(A + (size_t)u.pm * BM * lda); }
    __device__ __forceinline__ const char* b_base(const Unit& u) const { return (const char*)(Bt + (size_t)u.pn * BM * ldb); }
    __device__ __forceinline__ void a_off(const Unit&, const int (&R)[2], const int (&C)[2], unsigned (&v)[2][2]) const {
#pragma unroll
        for (int i = 0; i < 2; ++i) { v[0][i] = (unsigned)(R[i] * lda + C[i]) * 2u; v[1][i] = (unsigned)((HALF + R[i]) * lda + C[i]) * 2u; }
    }
};
struct DenseSched8 : DenseSched { int sw8, sa8; };
struct ProjSched8 : DenseSched8 {
    __device__ __forceinline__ bool next(int i, Unit& u) const {
        if (nN != 28 || (nM & 1) || (G & 7)) return DenseSched::next(i, u);
        const int x = c & 7, wl = i * (G >> 3) + (c >> 3), half = nM >> 1;
        if (wl >= half * 7) return false;
        u.pm = (x >> 2) * half + wl / 7; u.pn = 7 * (x & 3) + wl % 7; u.ord = i; return true;
    }
};
}

#define XB_TMO      128
#define XB_XCNT(j)  (256  + 64 * (j))
#define XB_XSUB(j)  (1280 + 64 * (j))
#define XB_XGEN(j)  (2304 + 64 * (j))
#define XB_TOP      3328
#define XB_TOPGEN   3392
#define XCD_BAR_WORDS 3456
#define XB_SPIN_CAP (1u << 18)
__device__ __forceinline__ unsigned xb_ld(unsigned* p)              { return __hip_atomic_load(p, __ATOMIC_RELAXED, __HIP_MEMORY_SCOPE_AGENT); }
__device__ __forceinline__ unsigned xb_add(unsigned* p, unsigned v) { return __hip_atomic_fetch_add(p, v, __ATOMIC_RELAXED, __HIP_MEMORY_SCOPE_AGENT); }
__device__ __forceinline__ unsigned xb_xcc_id() { return (unsigned)__builtin_amdgcn_s_getreg((3 << 11) | 20) & 0xFu; }
#define XB_SPIN(cond, bar) do { unsigned _sp = 0; while (cond) { __builtin_amdgcn_s_sleep(1); \
    if ((++_sp & 255u) == 0u) { if (xb_ld(&(bar)[XB_TMO])) break; if (_sp > XB_SPIN_CAP) { atomicAdd(&(bar)[XB_TMO], 1u); break; } } } } while (0)
struct XcdBarrier { unsigned* bar; unsigned x; volatile LAS unsigned* st; };
__device__ __forceinline__ XcdBarrier xcd_barrier_post(unsigned* bar, volatile LAS unsigned* st) {
    XcdBarrier b; b.bar = bar; b.x = xb_xcc_id(); b.st = st;
    if (threadIdx.x == 0) (void)xb_add(&bar[XB_XCNT(b.x)], 1u);
    return b;
}
__device__ __forceinline__ void xcd_barrier_complete(unsigned* bar, unsigned x, unsigned& nloc, unsigned& nx) {
    const unsigned G = gridDim.x * gridDim.y * gridDim.z;
    unsigned sum, cnt, mine, sp = 0u;
    for (;;) {
        sum = 0u; cnt = 0u; mine = 0u;
#pragma unroll
        for (unsigned j = 0; j < 16; ++j) { const unsigned c = xb_ld(&bar[XB_XCNT(j)]); sum += c; cnt += (c > 0u) ? 1u : 0u; mine = (j == x) ? c : mine; }
        if (sum == G) break;
        __builtin_amdgcn_s_sleep(1);
        if ((++sp & 255u) == 0u) { if (xb_ld(&bar[XB_TMO])) break; if (sp > XB_SPIN_CAP) { atomicAdd(&bar[XB_TMO], 1u); break; } }
    }
    nloc = mine > 0u ? mine : 1u; nx = cnt > 0u ? cnt : 1u;
}
__device__ __forceinline__ void xcd_barrier(const XcdBarrier& b) {
    asm volatile("s_waitcnt vmcnt(0)" ::: "memory");
    __syncthreads();
    if (threadIdx.x == 0) {
        unsigned* bar = b.bar;
        __builtin_amdgcn_s_waitcnt(0);
        unsigned nloc = b.st[0], nx = b.st[1];
        if (nloc == 0u) { xcd_barrier_complete(bar, b.x, nloc, nx); b.st[0] = nloc; b.st[1] = nx; }
        const unsigned old = xb_add(&bar[XB_XSUB(b.x)], 1u);
        const unsigned gen = old / nloc;
        if (old + 1u == (gen + 1u) * nloc) {
            __builtin_amdgcn_fence(__ATOMIC_RELEASE, "agent");
            asm volatile("s_waitcnt vmcnt(0)" ::: "memory");
            const unsigned og = xb_add(&bar[XB_TOP], 1u);
            const unsigned tg = og / nx;
            if (og + 1u == (tg + 1u) * nx) xb_add(&bar[XB_TOPGEN], 1u);
            else XB_SPIN(xb_ld(&bar[XB_TOPGEN]) == tg, bar);
            __builtin_amdgcn_fence(__ATOMIC_ACQUIRE, "agent");
            xb_add(&bar[XB_XGEN(b.x)], 1u);
            asm volatile("s_waitcnt vmcnt(0)" ::: "memory");
        } else {
            XB_SPIN(xb_ld(&bar[XB_XGEN(b.x)]) == gen, bar);
            __builtin_amdgcn_fence(__ATOMIC_ACQUIRE, "agent");
            asm volatile("s_waitcnt vmcnt(0)" ::: "memory");
        }
    }
    __syncthreads();
}

constexpr size_t MiB = 1u << 20;
constexpr size_t WS_CTL = 0, CTL_ZERO_BYTES = 1 * MiB;
constexpr int CW_BAR = 4096;
constexpr int CW_QUEUE = 16384;
constexpr size_t WS_W13 = 2 * MiB;
constexpr size_t WS_W2  = 34 * MiB;
constexpr size_t WS_WR  = 50 * MiB;
constexpr size_t WS_MISC = 51 * MiB;
constexpr size_t WS_ROUTE = 52 * MiB;
constexpr size_t WS_RPOS = 53 * MiB;
constexpr size_t WS_ROWTOK = 54 * MiB;
constexpr size_t WS_ROPE = 55 * MiB;
constexpr size_t WS_WUQ = 56 * MiB;
constexpr size_t WS_WUKV = 57 * MiB;
constexpr size_t WS_WA = 58 * MiB;
constexpr size_t WS_WB = 59 * MiB;
constexpr size_t WS_WC = 60 * MiB;
constexpr size_t WS_WO = 61 * MiB;
constexpr size_t WS_SSQ = 63 * MiB;
constexpr size_t WS_LSE = 64 * MiB;
constexpr size_t WS_MASK = 66 * MiB;
constexpr size_t WS_XB8 = 74 * MiB;
constexpr size_t WS_WIN8 = 138 * MiB;
constexpr size_t WS_H = 146 * MiB;
constexpr size_t WS_Y = 182 * MiB;
constexpr size_t WS_SC = WS_Y;
constexpr size_t WS_G3 = 254 * MiB;
constexpr size_t WS_PROJ = 350 * MiB;
constexpr size_t WS_QM = 606 * MiB;
constexpr size_t WS_KVM = 654 * MiB;
constexpr size_t WS_OA = 718 * MiB;
constexpr size_t WS_OB = 734 * MiB;
constexpr size_t WS_OC = 750 * MiB;
constexpr size_t WS_OG = 766 * MiB;
constexpr size_t WS_M0 = 814 * MiB;
constexpr size_t WS_M1 = 846 * MiB;
constexpr size_t WS_MERGED = 878 * MiB;
constexpr size_t WS_END = 910 * MiB;
constexpr int F8_SA_X = 127 - 4, F8_SW = 127 - 10;
constexpr int MAXROWS = 139264;
constexpr int NBC = 16, TC = NBC * SEQ, NCHUNK = NB / NBC;
constexpr int CIN = 3944, PW = 4096;

constexpr int MI_BLOCKCNT = 0;
constexpr int MI_PANEL_E = 8192;
constexpr int MI_NPAN = 8192 + 1024;

constexpr int RING_BYTES = 131072;
constexpr int L_CTL = RING_BYTES;
constexpr int L_BARW = L_CTL + 32;
constexpr int L_HIST = L_CTL + 256;
constexpr int L_TOT  = L_CTL + 384;
constexpr int L_PRE  = L_CTL + 512;
constexpr int L_BASE = L_CTL + 640;
constexpr int L_RANK = L_CTL + 896;
constexpr int L_PE   = L_CTL + 1024;
constexpr int L_ROWS = L_CTL + 2048;
constexpr int LDS_BYTES = 147456;
constexpr int L_GB = L_ROWS;
static_assert(L_ROWS + 12288 <= LDS_BYTES, "LDS map");

#ifndef DUPMASK
#define DUPMASK 0
#endif
struct Args { const float* in[23]; float* out; unsigned char* ws; };
#define PHASE_IDS(F) do { int t_ = threadIdx.x; asm volatile("" : "+v"(t_)); (F).tid = t_; (F).lane = t_ & 63; { intab_t p_ = (intab_t)__builtin_amdgcn_kernarg_segment_ptr(); asm volatile("" : "+s"(p_)); (F).in.p = p_; } \
    { unsigned char GAS* w_ = (unsigned char GAS*)(F).ws0; asm volatile("" : "+s"(w_)); (F).ws = (unsigned char*)w_; float GAS* o_ = (float GAS*)(F).out0; asm volatile("" : "+s"(o_)); (F).out = (float*)o_; } } while (0)

typedef const float GAS* gfptr_t;
typedef const gfptr_t __attribute__((address_space(4)))* intab_t;
struct InTab { intab_t p; __device__ __forceinline__ const float* operator[](int i) const { return (const float*)p[i]; } };
struct Frame {
    LAS unsigned char* lds;
    int tid, lane, wave, vcu, G;
    InTab in; float* out; unsigned char* ws; float* out0; unsigned char* ws0;
};

template <class F>
__device__ __forceinline__ void conv_item(bf16_t* WT, int ldk, int k0, int n0, LAS float* scr, int lane, F val) {
#pragma unroll 8
    for (int i = 0; i < 32; ++i) { const int kk = 2 * i + (lane >> 5); scr[kk * 33 + (lane & 31)] = val(k0 + kk, n0 + (lane & 31)); }
    LDS_WAIT(); asm volatile("" ::: "memory");
    const int c = lane & 7;
#pragma unroll
    for (int j = 0; j < 4; ++j) { const int n = (lane >> 3) + 8 * j; const LAS float* s = scr + (8 * c) * 33 + n;
        u32x4 o; o.x = pk2(s[0 * 33], s[1 * 33]); o.y = pk2(s[2 * 33], s[3 * 33]); o.z = pk2(s[4 * 33], s[5 * 33]); o.w = pk2(s[6 * 33], s[7 * 33]);
        *(u32x4*)(WT + (size_t)(n0 + n) * ldk + k0 + 8 * c) = o; }
    LDS_WAIT(); asm volatile("" ::: "memory");
}

template <class F>
__device__ __forceinline__ void conv_item8(unsigned char* WT, int ldk, int k0, int n0, LAS float* scr, int lane, F val) {
#pragma unroll 8
    for (int i = 0; i < 32; ++i) { const int kk = 2 * i + (lane >> 5); scr[kk * 33 + (lane & 31)] = val(k0 + kk, n0 + (lane & 31)); }
    LDS_WAIT(); asm volatile("" ::: "memory");
    const int c = lane & 7;
#pragma unroll
    for (int j = 0; j < 4; ++j) { const int n = (lane >> 3) + 8 * j; const LAS float* s = scr + (8 * c) * 33 + n;
        u32x2 o; o.x = pk4_fp8(s[0 * 33], s[1 * 33], s[2 * 33], s[3 * 33]); o.y = pk4_fp8(s[4 * 33], s[5 * 33], s[6 * 33], s[7 * 33]);
        *(u32x2*)(WT + (size_t)(n0 + n) * ldk + k0 + 8 * c) = o; }
    LDS_WAIT(); asm volatile("" ::: "memory");
}

__device__ __forceinline__ void conv_plain8(unsigned char* WT, int ldk, int k0, int n0, LAS float* scr, int lane, const float* src, int pitch, float sc) {
    f32x4 v[8];
#pragma unroll
    for (int i = 0; i < 8; ++i) v[i] = *(const f32x4*)(src + (size_t)(k0 + (lane >> 3) + 8 * i) * pitch + n0 + (lane & 7) * 4);
#pragma unroll
    for (int i = 0; i < 8; ++i) { LAS float* d = scr + ((lane >> 3) + 8 * i) * 33 + (lane & 7) * 4; d[0] = v[i][0] * sc; d[1] = v[i][1] * sc; d[2] = v[i][2] * sc; d[3] = v[i][3] * sc; }
    LDS_WAIT(); asm volatile("" ::: "memory");
    const int c = lane & 7;
#pragma unroll
    for (int j = 0; j < 4; ++j) { const int n = (lane >> 3) + 8 * j; const LAS float* s = scr + (8 * c) * 33 + n;
        u32x2 o; o.x = pk4_fp8(s[0 * 33], s[1 * 33], s[2 * 33], s[3 * 33]); o.y = pk4_fp8(s[4 * 33], s[5 * 33], s[6 * 33], s[7 * 33]);
        *(u32x2*)(WT + (size_t)(n0 + n) * ldk + k0 + 8 * c) = o; }
    LDS_WAIT(); asm volatile("" ::: "memory");
}
__device__ __forceinline__ void conv_pair8(unsigned char* WT, int ldk, int k0, int n0, LAS float* scr, int lane, const float* a, const float* b, int pitch, float sc) {
    f32x2 va[8], vb[8];
#pragma unroll
    for (int i = 0; i < 8; ++i) { const size_t o = (size_t)(k0 + (lane >> 3) + 8 * i) * pitch + (n0 >> 1) + (lane & 7) * 2; va[i] = *(const f32x2*)(a + o); vb[i] = *(const f32x2*)(b + o); }
#pragma unroll
    for (int i = 0; i < 8; ++i) { LAS float* d = scr + ((lane >> 3) + 8 * i) * 33 + (lane & 7) * 4; d[0] = va[i][0] * sc; d[1] = vb[i][0] * sc; d[2] = va[i][1] * sc; d[3] = vb[i][1] * sc; }
    LDS_WAIT(); asm volatile("" ::: "memory");
    const int c = lane & 7;
#pragma unroll
    for (int j = 0; j < 4; ++j) { const int n = (lane >> 3) + 8 * j; const LAS float* s = scr + (8 * c) * 33 + n;
        u32x2 o; o.x = pk4_fp8(s[0 * 33], s[1 * 33], s[2 * 33], s[3 * 33]); o.y = pk4_fp8(s[4 * 33], s[5 * 33], s[6 * 33], s[7 * 33]);
        *(u32x2*)(WT + (size_t)(n0 + n) * ldk + k0 + 8 * c) = o; }
    LDS_WAIT(); asm volatile("" ::: "memory");
}

__device__ __forceinline__ void phase_conv_moe(Frame& F, int l) {
    PHASE_IDS(F);
    LAS float* scr = (LAS float*)(F.lds + F.wave * 16384);
    const int gw = F.vcu * NWAVES + F.wave, NGW = F.G * NWAVES;
    const float* w1 = F.in[18] + (size_t)l * NEXP * DM * DEXP;
    const float* w3 = F.in[19] + (size_t)l * NEXP * DM * DEXP;
    const float* w2 = F.in[20] + (size_t)l * NEXP * DEXP * DM;
    bf16_t* W13 = (bf16_t*)(F.ws + WS_W13); bf16_t* W2 = (bf16_t*)(F.ws + WS_W2);
    constexpr int I13 = (DM / 64) * (512 / 32);
    constexpr int I2 = (DEXP / 64) * (DM / 32);
    for (int it = gw; it < NEXP * (I13 + I2); it += NGW) {
        if (it < NEXP * I13) {
            const int e = it / I13, r = it % I13, kb = r / 16, nb = r % 16;
            const float* a = w1 + (size_t)e * DM * DEXP; const float* b = w3 + (size_t)e * DM * DEXP;
            conv_pair8((unsigned char*)W13 + (size_t)e * 512 * DM, DM, kb * 64, nb * 32, scr, F.lane, a, b, DEXP, 1024.f);
        } else {
            const int it2 = it - NEXP * I13; const int e = it2 / I2, r = it2 % I2, kb = r / 32, nb = r % 32;
            const float* a = w2 + (size_t)e * DEXP * DM;
            conv_plain8((unsigned char*)W2 + (size_t)e * DM * DEXP, DEXP, kb * 64, nb * 32, scr, F.lane, a, DM, 1024.f);
        }
    }
    const float* wg = F.in[14] + (size_t)l * DM * 4; const float* wsb = F.in[16] + (size_t)l * DM * NEXP;
    const float* g1 = F.in[12] + (size_t)l * DM; const float* b1 = F.in[13] + (size_t)l * DM;
    bf16_t* WRH = (bf16_t*)(F.ws + WS_WR); bf16_t* WRL = (bf16_t*)(F.ws + WS_WR + 128 * 1024); float* WRC = (float*)(F.ws + WS_WR + 256 * 1024);
    for (int idx = (F.vcu * NTHREADS + F.tid); idx < 64 * DM; idx += F.G * NTHREADS) {
        const int c = idx / DM, k = idx % DM;
        const float v = (c < 32 ? wsb[(size_t)k * NEXP + c] : (c < 36 ? wg[(size_t)k * 4 + (c - 32)] : 0.f)) * g1[k];
        const unsigned h = f2bf(v); const int it = k >> 5, hi_ = (k >> 4) & 1, st = (k >> 3) & 1, e = k & 7, ln = (c & 31) + 32 * hi_, p0 = 2 * (c >> 5);
        WRH[((((size_t)it * 4 + p0) * 2 + st) * 64 + ln) * 8 + e] = (bf16_t)h;
        WRH[((((size_t)it * 4 + p0 + 1) * 2 + st) * 64 + ln) * 8 + e] = (bf16_t)f2bf(v - __builtin_bit_cast(float, h << 16)); (void)WRL;
    }
    if (gw < 64) {
        const int c = gw; float s1 = 0.f, s2 = 0.f;
        for (int k = F.lane; k < DM; k += 64) { const float w = c < 32 ? wsb[(size_t)k * NEXP + c] : (c < 36 ? wg[(size_t)k * 4 + (c - 32)] : 0.f); s1 += g1[k] * w; s2 += b1[k] * w; }
        s1 = wave_sum(s1); s2 = wave_sum(s2);
        const float bias = c < 32 ? F.in[17][(size_t)l * NEXP + c] : (c < 36 ? F.in[15][(size_t)l * 4 + (c - 32)] : 0.f);
        if (F.lane == 0) { WRC[c] = s1; WRC[64 + c] = s2 + bias; }
    }
}

__device__ __forceinline__ void ln_row(f32x4 (&v)[4], const f32x4 (&g)[4], const f32x4 (&b)[4], float* omean = nullptr, float* orstd = nullptr) {
    float s = 0.f;
#pragma unroll
    for (int j = 0; j < 4; ++j) s += (v[j].x + v[j].y) + (v[j].z + v[j].w);
    const float mean = wave_sum(s) * (1.f / DM); float s2 = 0.f;
#pragma unroll
    for (int j = 0; j < 4; ++j) { v[j] = v[j] - mean; s2 += (v[j].x * v[j].x + v[j].y * v[j].y) + (v[j].z * v[j].z + v[j].w * v[j].w); }
    const float rstd = 1.0f / sqrtf(wave_sum(s2) * (1.f / DM) + LN_EPS);
#pragma unroll
    for (int j = 0; j < 4; ++j) v[j] = v[j] * rstd * g[j] + b[j];
    if (omean) { *omean = mean; *orstd = rstd; }
}
__device__ __forceinline__ void store_row(const f32x4 (&v)[4], float* orow, unsigned char* brow, int lane) {
#pragma unroll
    for (int j = 0; j < 4; ++j) {
        ((f32x4*)orow)[lane + 64 * j] = v[j];
        ((unsigned*)brow)[lane + 64 * j] = pk4_fp8(v[j].x * 16.f, v[j].y * 16.f, v[j].z * 16.f, v[j].w * 16.f);
    }
}

__device__ __forceinline__ void phase_ln1_router(Frame& F, int l, const float* src, bool scale_alpha) {
    PHASE_IDS(F);
    const int lane = F.lane, hi = lane >> 5, r32 = lane & 31;
    const float* lg = F.in[12] + (size_t)l * DM; const float* lb = F.in[13] + (size_t)l * DM;
    f32x4 g[4], b[4];
#pragma unroll
    for (int j = 0; j < 4; ++j) { g[j] = ((const f32x4*)lg)[lane + 64 * j]; b[j] = ((const f32x4*)lb)[lane + 64 * j]; }
    unsigned char* XB = F.ws + WS_XB8;
    const bf16_t* WRH = (const bf16_t*)(F.ws + WS_WR); const bf16_t* WRL = (const bf16_t*)(F.ws + WS_WR + 128 * 1024);
    const float* WRC = (const float*)(F.ws + WS_WR + 256 * 1024); float* stats = (float*)(F.ws + WS_WR + 512 * 1024);
    unsigned* misc = (unsigned*)(F.ws + WS_MISC);
    int* route = (int*)(F.ws + WS_ROUTE);
    LAS unsigned* hist = (LAS unsigned*)(F.lds + L_HIST);
    const float sc = scale_alpha ? ALPHA : 1.0f;
    for (int blk = F.vcu; blk < TT / 256; blk += F.G) {
        if (F.tid < 32) hist[F.tid] = 0u;
        __syncthreads();
        const int row0 = blk * 256 + F.wave * 32;
        float mu_l = 0.f, rs_l = 1.f;
        for (int i = 0; i < 32; i += 2) {
            f32x4 v0[4], v1[4];
            const f32x4* p0 = (const f32x4*)(src + (size_t)(row0 + i) * DM); const f32x4* p1 = (const f32x4*)(src + (size_t)(row0 + i + 1) * DM);
#pragma unroll
            for (int j = 0; j < 4; ++j) { v0[j] = p0[lane + 64 * j] * sc; v1[j] = p1[lane + 64 * j] * sc; }
            float m0, r0, m1, r1;
            ln_row(v0, g, b, &m0, &r0); ln_row(v1, g, b, &m1, &r1);
            mu_l = (r32 == i) ? m0 : ((r32 == i + 1) ? m1 : mu_l); rs_l = (r32 == i) ? r0 : ((r32 == i + 1) ? r1 : rs_l);
#pragma unroll
            for (int j = 0; j < 4; ++j) {
                ((unsigned*)(XB + (size_t)(row0 + i) * DM))[lane + 64 * j] = pk4_fp8(v0[j].x * 16.f, v0[j].y * 16.f, v0[j].z * 16.f, v0[j].w * 16.f);
                ((unsigned*)(XB + (size_t)(row0 + i + 1) * DM))[lane + 64 * j] = pk4_fp8(v1[j].x * 16.f, v1[j].y * 16.f, v1[j].z * 16.f, v1[j].w * 16.f); }
        }
        if (hi == 0) *(f32x2*)(stats + (size_t)(row0 + r32) * 2) = (f32x2){mu_l, rs_l};
        f32x16 acc0 = {}, acc1 = {};
        {
            const bf16_t* WT = WRH; (void)WRL;
            LAS float* xs = (LAS float*)(F.lds + F.wave * 9216);
            const float* xg = src + (size_t)(row0 + (lane >> 3)) * DM + (lane & 7) * 4;
            f32x4 xv[4]; bf16x8 wv[8];
#pragma unroll
            for (int i = 0; i < 4; ++i) xv[i] = *(const f32x4*)(xg + (size_t)(8 * i) * DM);
#pragma unroll
            for (int q = 0; q < 8; ++q) wv[q] = *(const bf16x8*)(WT + ((size_t)q * 64 + lane) * 8);
#pragma unroll 2
            for (int it = 0; it < 32; ++it) {
                LAS float* xb = xs + (it & 1) * 1152;
#pragma unroll
                for (int i = 0; i < 4; ++i) *(LAS f32x4*)(xb + ((lane >> 3) + 8 * i) * 36 + (lane & 7) * 4) = xv[i];
                bf16x8 wc[8];
#pragma unroll
                for (int q = 0; q < 8; ++q) wc[q] = wv[q];
                { const int nx = it + 1 < 32 ? it + 1 : 31;
#pragma unroll
                  for (int i = 0; i < 4; ++i) xv[i] = *(const f32x4*)(xg + (size_t)(8 * i) * DM + nx * 32);
#pragma unroll
                  for (int q = 0; q < 8; ++q) wv[q] = *(const bf16x8*)(WT + (((size_t)nx * 8 + q) * 64 + lane) * 8); }
                f32x4 xa[4];
#pragma unroll
                for (int j = 0; j < 4; ++j) xa[j] = *(const LAS f32x4*)(xb + r32 * 36 + hi * 16 + 4 * j);
#pragma unroll
                for (int st = 0; st < 2; ++st) {
                    const f32x4 x0 = xa[2 * st], x1 = xa[2 * st + 1];
                    u32x4 xh, xl;
                    xh.x = cvt_pk_bf16(x0[0], x0[1]); xh.y = cvt_pk_bf16(x0[2], x0[3]); xh.z = cvt_pk_bf16(x1[0], x1[1]); xh.w = cvt_pk_bf16(x1[2], x1[3]);
                    xl.x = cvt_pk_bf16(x0[0] - bflo(xh.x), x0[1] - bfhi(xh.x)); xl.y = cvt_pk_bf16(x0[2] - bflo(xh.y), x0[3] - bfhi(xh.y));
                    xl.z = cvt_pk_bf16(x1[0] - bflo(xh.z), x1[1] - bfhi(xh.z)); xl.w = cvt_pk_bf16(x1[2] - bflo(xh.w), x1[3] - bfhi(xh.w));
                    const bf16x8 xhv = __builtin_bit_cast(bf16x8, xh), xlv = __builtin_bit_cast(bf16x8, xl);
                    acc0 = __builtin_amdgcn_mfma_f32_32x32x16_bf16(wc[0 + st], xhv, acc0, 0, 0, 0); acc1 = __builtin_amdgcn_mfma_f32_32x32x16_bf16(wc[4 + st], xhv, acc1, 0, 0, 0);
                    acc0 = __builtin_amdgcn_mfma_f32_32x32x16_bf16(wc[2 + st], xhv, acc0, 0, 0, 0); acc1 = __builtin_amdgcn_mfma_f32_32x32x16_bf16(wc[6 + st], xhv, acc1, 0, 0, 0);
                    acc0 = __builtin_amdgcn_mfma_f32_32x32x16_bf16(wc[0 + st], xlv, acc0, 0, 0, 0); acc1 = __builtin_amdgcn_mfma_f32_32x32x16_bf16(wc[4 + st], xlv, acc1, 0, 0, 0);
                }
            }
        }
        float gl[4];
#pragma unroll
        for (int i = 0; i < 4; ++i) gl[i] = rs_l * (acc1[i] - mu_l * WRC[32 + i]) + WRC[64 + 32 + i];
        int gidx = 0; float gmax = gl[0];
#pragma unroll
        for (int i = 1; i < 4; ++i) if (gl[i] > gmax) { gmax = gl[i]; gidx = i; }
        float gsum = 0.f;
#pragma unroll
        for (int i = 0; i < 4; ++i) gsum += fast_exp(gl[i] - gmax);
        float gp = 1.0f / gsum;
        gidx = __shfl(gidx, r32); gp = __shfl(gp, r32);
        float cv[4];
#pragma unroll
        for (int i = 0; i < 4; ++i) {
            const float a = gidx == 0 ? acc0[i] : gidx == 1 ? acc0[4 + i] : gidx == 2 ? acc0[8 + i] : acc0[12 + i];
            cv[i] = rs_l * (a - mu_l * WRC[8 * gidx + 4 * hi + i]) + WRC[64 + 8 * gidx + 4 * hi + i];
        }
        float v1 = cv[0]; int i1 = 0;
#pragma unroll
        for (int i = 1; i < 4; ++i) if (cv[i] > v1) { v1 = cv[i]; i1 = i; }
        float v2 = -INFINITY; int i2 = 0;
#pragma unroll
        for (int i = 0; i < 4; ++i) if (i != i1 && cv[i] > v2) { v2 = cv[i]; i2 = i; }
        i1 += 4 * hi; i2 += 4 * hi;
        const float pv1 = __shfl_xor(v1, 32), pv2 = __shfl_xor(v2, 32); const int pi1 = __shfl_xor(i1, 32), pi2 = __shfl_xor(i2, 32);
        auto better = [](float av, int ai, float bv, int bi) { return av > bv || (av == bv && ai < bi); };
        float fv, sv; int fi, si;
        if (better(v1, i1, pv1, pi1)) { fv = v1; fi = i1; if (better(v2, i2, pv1, pi1)) { sv = v2; si = i2; } else { sv = pv1; si = pi1; } }
        else { fv = pv1; fi = pi1; if (better(v1, i1, pv2, pi2)) { sv = v1; si = i1; } else { sv = pv2; si = pi2; } }
        const float d = fast_exp(sv - fv), inv = 1.0f / (1.0f + d);
        const float w1 = gp * inv, w2 = gp * d * inv;
        const int e1 = 8 * gidx + fi, e2 = 8 * gidx + si;
        if (hi == 0) {
            *(int4*)(route + (size_t)(row0 + r32) * 4) = make_int4(e1, e2, __float_as_int(w1), __float_as_int(w2));
            atomicAdd((unsigned*)&hist[e1], 1u); atomicAdd((unsigned*)&hist[e2], 1u);
        }
        __syncthreads();
        if (F.tid < 32) misc[MI_BLOCKCNT + blk * 32 + F.tid] = hist[F.tid];
        __syncthreads();
    }
}

__device__ __forceinline__ void phase_moe_scatter(Frame& F) {
    PHASE_IDS(F);
    unsigned* misc = (unsigned*)(F.ws + WS_MISC);
    const int* route = (const int*)(F.ws + WS_ROUTE);
    int* rpos = (int*)(F.ws + WS_RPOS); int* rowtok = (int*)(F.ws + WS_ROWTOK);
    LAS unsigned* tot = (LAS unsigned*)(F.lds + L_TOT); LAS unsigned* pre = (LAS unsigned*)(F.lds + L_PRE);
    LAS unsigned* base = (LAS unsigned*)(F.lds + L_BASE); LAS unsigned* rank = (LAS unsigned*)(F.lds + L_RANK);
    for (int blk = F.vcu; blk < TT / 256; blk += F.G) {
        {
            if (F.tid < 32) { tot[F.tid] = 0u; pre[F.tid] = 0u; rank[F.tid] = 0u; }
            __syncthreads();
            const int e = F.tid & 31, part = F.tid >> 5; unsigned cv[16];
#pragma unroll
            for (int i = 0; i < 16; ++i) cv[i] = misc[MI_BLOCKCNT + (part * 16 + i) * 32 + e];
            unsigned t = 0, p = 0;
#pragma unroll
            for (int i = 0; i < 16; ++i) { t += cv[i]; p += (part * 16 + i < blk) ? cv[i] : 0u; }
            atomicAdd((unsigned*)&tot[e], t); atomicAdd((unsigned*)&pre[e], p);
        }
        __syncthreads();
        if (F.tid == 0) { unsigned a = 0; for (int e = 0; e < NEXP; ++e) { base[e] = a; a += (tot[e] + 255u) & ~255u; } base[NEXP] = a; }
        __syncthreads();
        {
            const int tok = blk * 256 + (F.tid >> 1), slot = F.tid & 1;
            const int e = route[(size_t)tok * 4 + slot];
            const unsigned r = atomicAdd((unsigned*)&rank[e], 1u);
            const unsigned pos = base[e] + pre[e] + r;
            rowtok[pos] = tok; rpos[(size_t)tok * 2 + slot] = (int)pos;
        }
        if (blk < NEXP) {
            const int e = blk; const unsigned end = base[e] + tot[e], nxt = base[e + 1];
            for (unsigned p = end + F.tid; p < nxt; p += NTHREADS) rowtok[p] = 0;
            for (unsigned p = base[e] / 256 + F.tid; p < nxt / 256; p += NTHREADS) misc[MI_PANEL_E + p] = (unsigned)e;
        }
        if (blk == 0 && F.tid == 0) misc[MI_NPAN] = base[NEXP] / 256;
        __syncthreads();
    }
}

struct MoeSched1 {
    static constexpr bool GATHER = true;
    const bf16_t* A; const bf16_t* W; int lda, ldb, ntot, G, c; const LAS int* rows; const LAS int* pe; int sw8, sa8;
    __device__ __forceinline__ bool next(int i, pg8::Unit& u) const { const int v = i * G + c; if (v >= ntot) return false; u.pm = v >> 1; u.pn = v & 1; u.ord = i; return true; }
    __device__ __forceinline__ const char* a_base(const pg8::Unit&) const { return (const char*)A; }
    __device__ __forceinline__ const char* b_base(const pg8::Unit& u) const { return (const char*)(W + (size_t)pe[u.ord] * 512 * ldb + (size_t)u.pn * 256 * ldb); }
    __device__ __forceinline__ void a_off(const pg8::Unit& u, const int (&R)[2], const int (&C)[2], unsigned (&v)[2][2]) const {
#pragma unroll
        for (int h = 0; h < 2; ++h)
#pragma unroll
            for (int i = 0; i < 2; ++i) v[h][i] = (unsigned)(rows[u.ord * 256 + h * 128 + R[i]] * lda + C[i]) * 2u;
    }
};
struct MoeSched2 {
    static constexpr bool GATHER = false;
    const bf16_t* A; const bf16_t* W; int lda, ldb, ntot, G, c; const LAS int* pe; int sw8, sa8;
    __device__ __forceinline__ bool next(int i, pg8::Unit& u) const { const int v = i * G + c; if (v >= ntot) return false; u.pm = v >> 2; u.pn = v & 3; u.ord = i; return true; }
    __device__ __forceinline__ const char* a_base(const pg8::Unit& u) const { return (const char*)(A + (size_t)u.pm * 256 * lda); }
    __device__ __forceinline__ const char* b_base(const pg8::Unit& u) const { return (const char*)(W + (size_t)pe[u.ord] * DM * ldb + (size_t)u.pn * 256 * ldb); }
    __device__ __forceinline__ void a_off(const pg8::Unit&, const int (&R)[2], const int (&C)[2], unsigned (&v)[2][2]) const {
#pragma unroll
        for (int i = 0; i < 2; ++i) { v[0][i] = (unsigned)(R[i] * lda + C[i]) * 2u; v[1][i] = (unsigned)((128 + R[i]) * lda + C[i]) * 2u; }
    }
};
struct EpiSwiGLU {
    bf16_t* H;
    __device__ __forceinline__ void operator()(const f32x4 (&acc)[2][2][4][2], const pg8::Unit& u, int wr, int wc, int fr, int fq) const {
        const int row0 = u.pm * 256 + wr * 64 + fr, col0 = u.pn * 128 + wc * 16 + 4 * fq;
#pragma unroll
        for (int ai = 0; ai < 2; ++ai)
#pragma unroll
            for (int m = 0; m < 4; ++m) { bf16_t* rowp = H + (size_t)(row0 + ai * 128 + m * 16) * DEXP + col0;
#pragma unroll
                for (int bj = 0; bj < 2; ++bj) { const f32x4 v0 = acc[ai][bj][m][0], v1 = acc[ai][bj][m][1];
                    const float h0 = v0[0] * sigmoidf_(v0[0]) * v0[1], h1 = v0[2] * sigmoidf_(v0[2]) * v0[3], h2 = v1[0] * sigmoidf_(v1[0]) * v1[1], h3 = v1[2] * sigmoidf_(v1[2]) * v1[3];
                    *(unsigned*)((unsigned char*)H + (size_t)(row0 + ai * 128 + m * 16) * DEXP + col0 + bj * 64) = pk4_fp8(h0 * 16.f, h1 * 16.f, h2 * 16.f, h3 * 16.f); (void)rowp; } }
    }
};
struct EpiStoreBf16 {
    bf16_t* O; int ldc;
    __device__ __forceinline__ void operator()(const f32x4 (&acc)[2][2][4][2], const pg8::Unit& u, int wr, int wc, int fr, int fq) const {
        const int row0 = u.pm * 256 + wr * 64 + fr, col0 = u.pn * 256 + wc * 32 + 8 * fq;
#pragma unroll
        for (int ai = 0; ai < 2; ++ai)
#pragma unroll
            for (int m = 0; m < 4; ++m) { bf16_t* rowp = O + (size_t)(row0 + ai * 128 + m * 16) * ldc + col0;
#pragma unroll
                for (int bj = 0; bj < 2; ++bj) store8_fp8((unsigned char*)O + (size_t)(row0 + ai * 128 + m * 16) * ldc + col0 + bj * 128, acc[ai][bj][m][0], acc[ai][bj][m][1], 64.f); (void)rowp; }
    }
};

__device__ __forceinline__ void phase_moe_gemm1(Frame& F) {
    PHASE_IDS(F);
    const unsigned* misc = (const unsigned*)(F.ws + WS_MISC);
    const int* rowtok = (const int*)(F.ws + WS_ROWTOK);
    const int npan = (int)misc[MI_NPAN];
    LAS int* rows = (LAS int*)(F.lds + L_ROWS); LAS int* pe = (LAS int*)(F.lds + L_PE);
    const int c = (int)blockIdx.x, ntot = npan * 2;
    for (int i = 0; i * F.G + c < ntot && i < 8; ++i) { const int p = (i * F.G + c) >> 1;
        if (F.tid < 256) rows[i * 256 + F.tid] = rowtok[p * 256 + F.tid];
        if (F.tid == 256) pe[i] = (int)misc[MI_PANEL_E + p]; }
    VM_WAIT(); LDS_WAIT(); __syncthreads();
    MoeSched1 S{(const bf16_t*)(F.ws + WS_XB8), (const bf16_t*)(F.ws + WS_W13), DM / 2, DM / 2, ntot, F.G, c, rows, pe, F8_SW, F8_SA_X};
    EpiSwiGLU E{(bf16_t*)(F.ws + WS_H)};
    pg8::gemm_phase<EpiSwiGLU, MoeSched1, true, true>(F.lds, DM / 2, S, E);
}
__device__ __forceinline__ void phase_moe_gemm2(Frame& F) {
    PHASE_IDS(F);
    const unsigned* misc = (const unsigned*)(F.ws + WS_MISC);
    const int npan = (int)misc[MI_NPAN];
    LAS int* pe = (LAS int*)(F.lds + L_PE);
    const int c = (int)blockIdx.x, ntot = npan * 4;
    __syncthreads();
    if (F.tid < 16) { const int v = F.tid * F.G + c; if (v < ntot) pe[F.tid] = (int)misc[MI_PANEL_E + (v >> 2)]; }
    VM_WAIT(); LDS_WAIT(); __syncthreads();
    MoeSched2 S{(const bf16_t*)(F.ws + WS_H), (const bf16_t*)(F.ws + WS_W2), DEXP / 2, DEXP / 2, ntot, F.G, c, pe, F8_SW, 127 - 4};
    EpiStoreBf16 E{(bf16_t*)(F.ws + WS_Y), DM};
    int k2 = DEXP / 2; asm volatile("" : "+s"(k2));
    pg8::gemm_phase<EpiStoreBf16, MoeSched2, true, true>(F.lds, k2, S, E);
}

__device__ __forceinline__ void phase_combine_ln2(Frame& F, int l) {
    PHASE_IDS(F);
    const int lane = F.lane;
    const float* lg = F.in[21] + (size_t)l * DM; const float* lb = F.in[22] + (size_t)l * DM;
    f32x4 g[4], b[4];
#pragma unroll
    for (int j = 0; j < 4; ++j) { g[j] = ((const f32x4*)lg)[lane + 64 * j]; b[j] = ((const f32x4*)lb)[lane + 64 * j]; }
    const bf16_t* Y = (const bf16_t*)(F.ws + WS_Y);
    const float* l1g = F.in[12] + (size_t)l * DM; const float* l1b = F.in[13] + (size_t)l * DM; const float* stats = (const float*)(F.ws + WS_WR + 512 * 1024);
    f32x4 g1[4], b1[4];
#pragma unroll
    for (int j = 0; j < 4; ++j) { g1[j] = ((const f32x4*)l1g)[lane + 64 * j]; b1[j] = ((const f32x4*)l1b)[lane + 64 * j]; }
    const int* route = (const int*)(F.ws + WS_ROUTE); const int* rpos = (const int*)(F.ws + WS_RPOS);
    const int gw = F.vcu * NWAVES + F.wave, NGW = F.G * NWAVES;
    auto recs = [&](int r, int4& rt, int2& rp, f32x2& st) { rt = *(const int4*)(route + (size_t)r * 4); rp = *(const int2*)(rpos + (size_t)r * 2); st = *(const f32x2*)(stats + (size_t)r * 2); };
    auto rowload = [&](int r, const int2& rp, f32x4 (&x)[4], unsigned (&ya)[4], unsigned (&yc)[4]) {
        const f32x4* px = (const f32x4*)(F.out + (size_t)r * DM);
        const unsigned* y0 = (const unsigned*)((const unsigned char*)Y + (size_t)rp.x * DM); const unsigned* y1 = (const unsigned*)((const unsigned char*)Y + (size_t)rp.y * DM);
#pragma unroll
        for (int j = 0; j < 4; ++j) { x[j] = __builtin_nontemporal_load(px + lane + 64 * j); ya[j] = __builtin_nontemporal_load(y0 + lane + 64 * j); yc[j] = __builtin_nontemporal_load(y1 + lane + 64 * j); } };
    int4 rt_c, rt_n; int2 rp_c, rp_n; f32x2 st_c, st_n;
    recs(gw, rt_c, rp_c, st_c);
    { const int r1 = gw + NGW < TT ? gw + NGW : gw; recs(r1, rt_n, rp_n, st_n); }
    f32x4 xc[4]; unsigned yac[4], ycc[4];
    rowload(gw, rp_c, xc, yac, ycc);
    for (int row = gw; row < TT; row += NGW) {
        const int r1 = row + NGW < TT ? row + NGW : row, r2 = row + 2 * NGW < TT ? row + 2 * NGW : row;
        f32x4 xn[4]; unsigned yan[4], ycn[4];
        rowload(r1, rp_n, xn, yan, ycn);
        int4 rt_2; int2 rp_2; f32x2 st_2; recs(r2, rt_2, rp_2, st_2);
        const float w0 = __int_as_float(rt_c.z) * (1.f / 64.f), w1 = __int_as_float(rt_c.w) * (1.f / 64.f);
        f32x4 v[4];
#pragma unroll
        for (int j = 0; j < 4; ++j) {
            const f32x4 x = (xc[j] - st_c[0]) * st_c[1] * g1[j] + b1[j]; const unsigned a = yac[j], c = ycc[j];
            const f32x2 a01 = __builtin_amdgcn_cvt_pk_f32_fp8((int)a, false), a23 = __builtin_amdgcn_cvt_pk_f32_fp8((int)a, true), c01 = __builtin_amdgcn_cvt_pk_f32_fp8((int)c, false), c23 = __builtin_amdgcn_cvt_pk_f32_fp8((int)c, true);
            v[j].x = ALPHA * x.x + w0 * a01[0] + w1 * c01[0]; v[j].y = ALPHA * x.y + w0 * a01[1] + w1 * c01[1];
            v[j].z = ALPHA * x.z + w0 * a23[0] + w1 * c23[0]; v[j].w = ALPHA * x.w + w0 * a23[1] + w1 * c23[1];
        }
        ln_row(v, g, b);
#pragma unroll
        for (int j = 0; j < 4; ++j) __builtin_nontemporal_store(v[j], (f32x4*)(F.out + (size_t)row * DM) + lane + 64 * j);
        if (l == 0) {
#pragma unroll
            for (int j = 0; j < 4; ++j) ((unsigned*)(F.ws + WS_XB8 + (size_t)row * DM))[lane + 64 * j] = pk4_fp8(v[j].x * 16.f, v[j].y * 16.f, v[j].z * 16.f, v[j].w * 16.f);
        }
        rt_c = rt_n; rp_c = rp_n; st_c = st_n; rt_n = rt_2; rp_n = rp_2; st_n = st_2;
#pragma unroll
        for (int j = 0; j < 4; ++j) { xc[j] = xn[j]; yac[j] = yan[j]; ycc[j] = ycn[j]; }
    }
}

constexpr float C2D = 0.18033688011112042f;
constexpr float C2M = 0.14724444602590306f;
constexpr float IWS = 0.044194173824159216f;
constexpr float RMS_EPS = 1e-6f;
constexpr int L_QSLOT = L_CTL + 1152;

__device__ __forceinline__ int rope16(int c) { return c < 16 ? (c >> 1) + 8 * (c & 1) : c; }
__device__ __forceinline__ int win_src(int n, float& sc) {
    sc = 1.f;
    if (n < 384) return n;
    if (n < 416) { const int c = n - 384; return 384 + (c >> 1) + 16 * (c & 1); }
    if (n < 512) return -1;
    if (n < 2816) { const int m = n - 512, g = m / 768, r = m % 768, p = r >> 8, hh = (r & 255) >> 6, c = r & 63; if (p == 0) sc = C2D; return 416 + 768 * g + 256 * p + 64 * hh + (p < 2 ? rope16(c) : c); }
    if (n < 3328) { const int m = n - 2816; sc = C2D; return 2720 + (m & ~63) + rope16(m & 63); }
    if (n < 3840) { const int m = n - 3328; return 3360 + (m & ~63) + rope16(m & 63); }
    const int m = n - 3840;
    if (m < 64) return 3232 + rope16(m);
    if (m < 128) return 3296 + (m - 64);
    if (m < 192) return 3872 + rope16(m - 128);
    if (m < 200) { sc = IWS; return 3936 + (m - 192); }
    return -1;
}

__device__ __forceinline__ void sincos_d(double x, double& s, double& c) {
    const double n = __builtin_rint(x * 0.15915494309189535);
    double r = __builtin_fma(-n, 6.2831854820251465, x); r = __builtin_fma(n, 1.7484556025237907e-07, r);
    const double r2 = r * r; double ss = 1.0, cc = 1.0;
#pragma unroll
    for (int k = 15; k >= 1; --k) { ss = 1.0 - r2 * (1.0 / (double)((2 * k) * (2 * k + 1))) * ss; cc = 1.0 - r2 * (1.0 / (double)((2 * k - 1) * (2 * k))) * cc; }
    s = ss * r; c = cc;
}
__device__ __forceinline__ double inv_freq16(int i) {
    const double t[16] = {1.0, 0.44036660267178046, 0.19392274474868576, 0.08539710028576561, 0.03760603093086393, 0.016560440080994446, 0.007292664737217109, 0.003211445994752591,
                          0.001414213562373095, 0.000622772421914596, 0.0002742481756762073, 0.00012076973741146504, 5.318295896944988e-05, 2.341999896140934e-05, 1.031338537721246e-05, 4.5416704806078695e-06};
    double r = t[0];
#pragma unroll
    for (int k = 1; k < 16; ++k) r = (i == k) ? t[k] : r;
    return r;
}

__device__ __forceinline__ void phase_conv_mixer(Frame& F, int l) {
    PHASE_IDS(F);
    LAS float* scr = (LAS float*)(F.lds + F.wave * 16384);
    const int gw = F.vcu * NWAVES + F.wave, NGW = F.G * NWAVES;
    const float* win = F.in[1] + (size_t)l * DM * CIN;
    const float* qg = F.in[2] + (size_t)l * 256; const float* wuq = F.in[3] + (size_t)l * 256 * 768;
    const float* kg = F.in[4] + (size_t)l * 128; const float* wukv = F.in[5] + (size_t)l * 128 * 1024;
    const float* wgate = F.in[6] + (size_t)l * DM * 3072;
    const float* wa = F.in[8] + (size_t)l * 512 * DM; const float* wb = F.in[9] + (size_t)l * 256 * DM; const float* wc = F.in[10] + (size_t)l * 512 * DM; const float* wo = F.in[11] + (size_t)l * DM * DM;
    unsigned char* WIN8 = F.ws + WS_WIN8; bf16_t* WUQ = (bf16_t*)(F.ws + WS_WUQ); bf16_t* WUKV = (bf16_t*)(F.ws + WS_WUKV);
    bf16_t* WA = (bf16_t*)(F.ws + WS_WA); bf16_t* WB = (bf16_t*)(F.ws + WS_WB); bf16_t* WC = (bf16_t*)(F.ws + WS_WC); bf16_t* WO = (bf16_t*)(F.ws + WS_WO);
    constexpr int I_IN = 16 * 128, I_G = 16 * 96, I_UQ = 4 * 24, I_UKV = 4 * 32, I_A = 8 * 32, I_B = 8 * 32, I_C = 8 * 32, I_O = 16 * 32;
    constexpr int NIT = I_IN + I_G + I_UQ + I_UKV + I_A + I_B + I_C + I_O;
    for (int it = gw; it < NIT; it += NGW) {
        int r = it;
        if (r < I_IN) { conv_item8(WIN8, DM, (r / 128) * 64, (r % 128) * 32, scr, F.lane, [&](int k, int n) { float sc; const int sidx = win_src(n, sc); return sidx < 0 ? 0.f : win[(size_t)k * CIN + sidx] * (sc * 1024.f); }); continue; } r -= I_IN;
        if (r < I_G) { conv_plain8(WIN8 + (size_t)PW * DM, DM, (r / 96) * 64, (r % 96) * 32, scr, F.lane, wgate, 3072, 1024.f); continue; } r -= I_G;
        if (r < I_UQ) { conv_item(WUQ, 256, (r / 24) * 64, (r % 24) * 32, scr, F.lane, [&](int k, int n) { const int hh = n / 96, c = n % 96; const int o = c < 64 ? c : 64 + ((c - 64) >> 1) + 16 * ((c - 64) & 1);
                return qg[k] * wuq[(size_t)k * 768 + hh * 96 + o] * C2M; }); continue; } r -= I_UQ;
        if (r < I_UKV) { conv_item(WUKV, 256, (r / 32) * 64, (r % 32) * 32, scr, F.lane, [&](int k, int n) { return k < 128 ? kg[k] * wukv[(size_t)k * 1024 + n] : 0.f; }); continue; } r -= I_UKV;
        if (r < I_A) { conv_plain8((unsigned char*)WA, 512, (r / 32) * 64, (r % 32) * 32, scr, F.lane, wa, DM, 1024.f); continue; } r -= I_A;
        if (r < I_B) { conv_item8((unsigned char*)WB, 512, (r / 32) * 64, (r % 32) * 32, scr, F.lane, [&](int k, int n) { return k < 256 ? wb[(size_t)k * DM + n] * 1024.f : 0.f; }); continue; } r -= I_B;
        if (r < I_C) { conv_plain8((unsigned char*)WC, 512, (r / 32) * 64, (r % 32) * 32, scr, F.lane, wc, DM, 1024.f); continue; } r -= I_C;
        conv_plain8((unsigned char*)WO, DM, (r / 32) * 64, (r % 32) * 32, scr, F.lane, wo, DM, 1024.f);
    }
    if (l == 0) {
        float* rp = (float*)(F.ws + WS_ROPE); float* rm = rp + 2048 * 8 * 2;
        for (int idx = F.vcu * NTHREADS + F.tid; idx < 2048 * 24; idx += F.G * NTHREADS) {
            const int t = idx / 24, j = idx % 24; double sn, cs;
            if (j < 8) { sincos_d((double)t * inv_freq16(2 * j), sn, cs); rp[(t * 8 + j) * 2] = (float)cs; rp[(t * 8 + j) * 2 + 1] = (float)sn; }
            else { sincos_d((double)t * inv_freq16(j - 8), sn, cs); rm[(t * 16 + (j - 8)) * 2] = (float)cs; rm[(t * 16 + (j - 8)) * 2 + 1] = (float)sn; }
        }
        const f32x4* x4 = (const f32x4*)F.in[0]; unsigned* xb8 = (unsigned*)(F.ws + WS_XB8);
        {
            const size_t NT = (size_t)F.G * NTHREADS, N4 = (size_t)TT * DM / 4;
            for (size_t i0 = (size_t)F.vcu * NTHREADS + F.tid; i0 < N4; i0 += 8 * NT) {
                f32x4 v[8];
#pragma unroll
                for (int q = 0; q < 8; ++q) { const size_t i = i0 + q * NT < N4 ? i0 + q * NT : i0; v[q] = __builtin_nontemporal_load(x4 + i); }
#pragma unroll
                for (int q = 0; q < 8; ++q) { const size_t i = i0 + q * NT < N4 ? i0 + q * NT : i0; const f32x4 w = v[q] * 16.f; xb8[i] = pk4_fp8(w.x, w.y, w.z, w.w); }
            }
        }
    }
}

__device__ __forceinline__ void rope4(f32x4& v0, f32x4& v1, const float* cs) {
    const f32x4 a = *(const f32x4*)cs, b = *(const f32x4*)(cs + 4);
    const f32x4 w0 = {v0[0] * a[0] - v0[1] * a[1], v0[1] * a[0] + v0[0] * a[1], v0[2] * a[2] - v0[3] * a[3], v0[3] * a[2] + v0[2] * a[3]};
    const f32x4 w1 = {v1[0] * b[0] - v1[1] * b[1], v1[1] * b[0] + v1[0] * b[1], v1[2] * b[2] - v1[3] * b[3], v1[3] * b[2] + v1[2] * b[3]};
    v0 = w0; v1 = w1;
}
__device__ __forceinline__ void store8(bf16_t* p, const f32x4& v0, const f32x4& v1) {
    u32x4 w; w.x = cvt_pk_bf16(v0[0], v0[1]); w.y = cvt_pk_bf16(v0[2], v0[3]); w.z = cvt_pk_bf16(v1[0], v1[1]); w.w = cvt_pk_bf16(v1[2], v1[3]); *(u32x4*)p = w;
}
struct EpiProj {
    bf16_t* P; const float* csp; const float* csm; float* ssq; bf16_t* G3; const LAS float* gbias;
    __device__ __forceinline__ void operator()(const f32x4 (&acc)[2][2][4][2], const pg8::Unit& u, int wr, int wc, int fr, int fq) const {
        const int pn = u.pn, row0 = u.pm * 256 + wr * 64 + fr;
        if (pn >= 16) {
#pragma unroll
            for (int bj = 0; bj < 2; ++bj) { const int col = (pn - 16) * 256 + bj * 128 + wc * 32 + fq * 8;
                const f32x4 b0 = *(const LAS f32x4*)(gbias + col), b1 = *(const LAS f32x4*)(gbias + col + 4);
#pragma unroll
                for (int ai = 0; ai < 2; ++ai)
#pragma unroll
                    for (int m = 0; m < 4; ++m) { f32x4 v0 = acc[ai][bj][m][0] + b0, v1 = acc[ai][bj][m][1] + b1;
#pragma unroll
                        for (int e = 0; e < 4; ++e) { v0[e] = sigmoidf_(v0[e]); v1[e] = sigmoidf_(v1[e]); }
                        store8_fp8((unsigned char*)G3 + (size_t)(row0 + ai * 128 + m * 16) * 3072 + col, v0, v1, 64.f); } }
            return;
        }
#pragma unroll
        for (int bj = 0; bj < 2; ++bj) {
            const int wcu = __builtin_amdgcn_readfirstlane(wc);
            bool ropeP = false, ropeM = false;
            if (pn == 1) ropeM = (bj == 1 && wcu == 0);
            else if (pn >= 2 && pn < 11) ropeP = ((pn - 2) % 3) < 2 && !(wcu & 1);
            else if (pn >= 11 && pn < 15) ropeP = !(wcu & 1);
            else if (pn == 15) ropeP = (wcu == 0);
            const int col = pn * 256 + bj * 128 + wc * 32 + fq * 8;
            if (ropeP || ropeM) {
                const bool lr = ropeM || fq < 2;
                const float* cb = ropeM ? csm + 8 * fq : csp + 8 * (fq & 1);
                const int ts = ropeM ? 32 : 16;
#pragma unroll
                for (int ai = 0; ai < 2; ++ai)
#pragma unroll
                    for (int mh = 0; mh < 2; ++mh) {
                        f32x4 ca[2], cc[2];
#pragma unroll
                        for (int mm = 0; mm < 2; ++mm) { const int t = (row0 + ai * 128 + (2 * mh + mm) * 16) & (SEQ - 1);
                            ca[mm] = *(const f32x4*)(cb + t * ts); cc[mm] = *(const f32x4*)(cb + t * ts + 4); }
#pragma unroll
                        for (int mm = 0; mm < 2; ++mm) { const int m = 2 * mh + mm, row = row0 + ai * 128 + m * 16;
                            const f32x4 v0 = acc[ai][bj][m][0], v1 = acc[ai][bj][m][1];
                            f32x4 a = ca[mm], b = cc[mm];
                            if (!lr) { a = (f32x4){1.f, 0.f, 1.f, 0.f}; b = a; }
                            const f32x4 w0 = {v0[0] * a[0] - v0[1] * a[1], v0[1] * a[0] + v0[0] * a[1], v0[2] * a[2] - v0[3] * a[3], v0[3] * a[2] + v0[2] * a[3]};
                            const f32x4 w1 = {v1[0] * b[0] - v1[1] * b[1], v1[1] * b[0] + v1[0] * b[1], v1[2] * b[2] - v1[3] * b[3], v1[3] * b[2] + v1[2] * b[3]};
                            store8(P + (size_t)row * PW + col, w0, w1); }
                    }
            } else {
#pragma unroll
                for (int ai = 0; ai < 2; ++ai)
#pragma unroll
                    for (int m = 0; m < 4; ++m)
                        store8(P + (size_t)(row0 + ai * 128 + m * 16) * PW + col, acc[ai][bj][m][0], acc[ai][bj][m][1]);
            }
        }
        if (pn < 2) {
#pragma unroll
            for (int ai = 0; ai < 2; ++ai)
#pragma unroll
                for (int m = 0; m < 4; ++m) {
                    float sq = 0.f;
#pragma unroll
                    for (int bj = 0; bj < 2; ++bj) if (pn == 0 || bj == 0) {
#pragma unroll
                        for (int n = 0; n < 2; ++n) { const f32x4 x = acc[ai][bj][m][n]; sq += (x[0] * x[0] + x[1] * x[1]) + (x[2] * x[2] + x[3] * x[3]); } }
                    sq += __shfl_xor(sq, 16); sq += __shfl_xor(sq, 32);
                    if (fq == 0) ssq[(size_t)(row0 + ai * 128 + m * 16) * 8 + pn * 4 + wc] = sq;
                }
        }
    }
};
struct EpiUpQ {
    bf16_t* Q; const float* csm; const float* ssq;
    __device__ __forceinline__ void operator()(const f32x4 (&acc)[2][2][4][2], const pg8::Unit& u, int wr, int wc, int fr, int fq) const {
        const int row0 = u.pm * 256 + wr * 64 + fr;
        f32x4 spv[2][4];
#pragma unroll
        for (int ai = 0; ai < 2; ++ai)
#pragma unroll
            for (int m = 0; m < 4; ++m) spv[ai][m] = *(const f32x4*)(ssq + (size_t)(row0 + ai * 128 + m * 16) * 8);
#pragma unroll
        for (int ai = 0; ai < 2; ++ai)
#pragma unroll
            for (int m = 0; m < 4; ++m) { const f32x4 sp = spv[ai][m];
                spv[ai][m][0] = 1.0f / sqrtf(((sp[0] + sp[1]) + (sp[2] + sp[3])) * (1.f / 256.f) + RMS_EPS); }
        const int wcu = __builtin_amdgcn_readfirstlane(wc);
#pragma unroll
        for (int bj = 0; bj < 2; ++bj) {
            const int c0 = u.pn * 256 + bj * 128 + wcu * 32, col = c0 + fq * 8;
            if (((c0 >> 5) % 3) == 2) {
#pragma unroll
                for (int ai = 0; ai < 2; ++ai)
#pragma unroll
                    for (int mh = 0; mh < 2; ++mh) {
                        f32x4 ca[2], cc[2];
#pragma unroll
                        for (int mm = 0; mm < 2; ++mm) { const int t = (row0 + ai * 128 + (2 * mh + mm) * 16) & (SEQ - 1);
                            ca[mm] = *(const f32x4*)(csm + t * 32 + 8 * fq); cc[mm] = *(const f32x4*)(csm + t * 32 + 8 * fq + 4); }
#pragma unroll
                        for (int mm = 0; mm < 2; ++mm) { const int m = 2 * mh + mm, row = row0 + ai * 128 + m * 16;
                            const float rs = spv[ai][m][0];
                            const f32x4 v0 = acc[ai][bj][m][0] * rs, v1 = acc[ai][bj][m][1] * rs, a = ca[mm], b = cc[mm];
                            const f32x4 w0 = {v0[0] * a[0] - v0[1] * a[1], v0[1] * a[0] + v0[0] * a[1], v0[2] * a[2] - v0[3] * a[3], v0[3] * a[2] + v0[2] * a[3]};
                            const f32x4 w1 = {v1[0] * b[0] - v1[1] * b[1], v1[1] * b[0] + v1[0] * b[1], v1[2] * b[2] - v1[3] * b[3], v1[3] * b[2] + v1[2] * b[3]};
                            store8(Q + (size_t)row * 768 + col, w0, w1); }
                    }
            } else {
#pragma unroll
                for (int ai = 0; ai < 2; ++ai)
#pragma unroll
                    for (int m = 0; m < 4; ++m) { const float rs = spv[ai][m][0];
                        store8(Q + (size_t)(row0 + ai * 128 + m * 16) * 768 + col, acc[ai][bj][m][0] * rs, acc[ai][bj][m][1] * rs); }
            }
        }
    }
};
struct EpiUpKV {
    bf16_t* KV; const float* ssq;
    __device__ __forceinline__ void operator()(const f32x4 (&acc)[2][2][4][2], const pg8::Unit& u, int wr, int wc, int fr, int fq) const {
        const int row0 = u.pm * 256 + wr * 64 + fr;
        f32x4 spv[2][4];
#pragma unroll
        for (int ai = 0; ai < 2; ++ai)
#pragma unroll
            for (int m = 0; m < 4; ++m) spv[ai][m] = *(const f32x4*)(ssq + (size_t)(row0 + ai * 128 + m * 16) * 8 + 4);
#pragma unroll
        for (int ai = 0; ai < 2; ++ai)
#pragma unroll
            for (int m = 0; m < 4; ++m) {
                const int row = row0 + ai * 128 + m * 16;
                const f32x4 sp = spv[ai][m];
                const float rs = 1.0f / sqrtf(((sp[0] + sp[1]) + (sp[2] + sp[3])) * (1.f / 128.f) + RMS_EPS);
#pragma unroll
                for (int bj = 0; bj < 2; ++bj) { const int col = u.pn * 256 + bj * 128 + wc * 32 + fq * 8;
                    store8(KV + (size_t)row * 1024 + col, acc[ai][bj][m][0] * rs, acc[ai][bj][m][1] * rs); }
            }
    }
};
template <int T> struct IC { static constexpr int value = T; };
struct EpiBranchAll {
    bf16_t* Mg; bf16_t* M0; bf16_t* M1; const bf16_t* G3;
    __device__ __forceinline__ void operator()(const f32x4 (&acc)[2][2][4][2], const pg8::Unit& u, int wr, int wc, int fr, int fq) const {
        const int row0 = u.pm * 256 + wr * 64 + fr, br = u.ord, col0 = u.pn * 256 + wc * 32 + fq * 8;
        bf16_t* dst = br == 0 ? M0 : (br == 1 ? M1 : Mg);
        auto ldb = [&](auto tc, u32x2 (&gw)[2][2], u32x2 (&ma)[2][2], u32x2 (&mb)[2][2]) { constexpr int t = decltype(tc)::value, ai = t >> 1, mh = t & 1;
#pragma unroll
            for (int mm = 0; mm < 2; ++mm)
#pragma unroll
                for (int bj = 0; bj < 2; ++bj) { const int row = row0 + ai * 128 + (2 * mh + mm) * 16, col = col0 + bj * 128;
                    gw[mm][bj] = *(const u32x2*)((const unsigned char*)G3 + (size_t)row * 3072 + br * 1024 + col);
                    ma[mm][bj] = (u32x2){0u, 0u}; mb[mm][bj] = (u32x2){0u, 0u}; }
            if (br == 2) {
#pragma unroll
                for (int mm = 0; mm < 2; ++mm)
#pragma unroll
                    for (int bj = 0; bj < 2; ++bj) { const size_t off = (size_t)(row0 + ai * 128 + (2 * mh + mm) * 16) * DM + col0 + bj * 128;
                        ma[mm][bj] = *(const u32x2*)((const unsigned char*)M0 + off); mb[mm][bj] = *(const u32x2*)((const unsigned char*)M1 + off); }
            } };
        auto cpb = [&](auto tc, const u32x2 (&gw)[2][2], const u32x2 (&ma)[2][2], const u32x2 (&mb)[2][2]) { constexpr int t = decltype(tc)::value, ai = t >> 1, mh = t & 1;
#pragma unroll
            for (int mm = 0; mm < 2; ++mm)
#pragma unroll
                for (int bj = 0; bj < 2; ++bj) { constexpr int dummy = 0; (void)dummy; const int m = 2 * mh + mm; const size_t off = (size_t)(row0 + ai * 128 + m * 16) * DM + col0 + bj * 128; const u32x2 g = gw[mm][bj], a = ma[mm][bj], b2 = mb[mm][bj];
                    const f32x2 g01 = __builtin_amdgcn_cvt_pk_f32_fp8((int)g.x, false) * (1.f / 64.f), g23 = __builtin_amdgcn_cvt_pk_f32_fp8((int)g.x, true) * (1.f / 64.f);
                    const f32x2 g45 = __builtin_amdgcn_cvt_pk_f32_fp8((int)g.y, false) * (1.f / 64.f), g67 = __builtin_amdgcn_cvt_pk_f32_fp8((int)g.y, true) * (1.f / 64.f);
                    f32x4 v0 = acc[ai][bj][m][0], v1 = acc[ai][bj][m][1];
                    const f32x2 s01 = (__builtin_amdgcn_cvt_pk_f32_fp8((int)a.x, false) + __builtin_amdgcn_cvt_pk_f32_fp8((int)b2.x, false)) * (1.f / 64.f), s23 = (__builtin_amdgcn_cvt_pk_f32_fp8((int)a.x, true) + __builtin_amdgcn_cvt_pk_f32_fp8((int)b2.x, true)) * (1.f / 64.f);
                    const f32x2 s45 = (__builtin_amdgcn_cvt_pk_f32_fp8((int)a.y, false) + __builtin_amdgcn_cvt_pk_f32_fp8((int)b2.y, false)) * (1.f / 64.f), s67 = (__builtin_amdgcn_cvt_pk_f32_fp8((int)a.y, true) + __builtin_amdgcn_cvt_pk_f32_fp8((int)b2.y, true)) * (1.f / 64.f);
                    v0[0] = v0[0] * g01[0] + s01[0]; v0[1] = v0[1] * g01[1] + s01[1]; v0[2] = v0[2] * g23[0] + s23[0]; v0[3] = v0[3] * g23[1] + s23[1];
                    v1[0] = v1[0] * g45[0] + s45[0]; v1[1] = v1[1] * g45[1] + s45[1]; v1[2] = v1[2] * g67[0] + s67[0]; v1[3] = v1[3] * g67[1] + s67[1];
                    store8_fp8((unsigned char*)dst + off, v0, v1, 64.f); } };
        u32x2 gA[2][2], aA[2][2], bA[2][2], gB[2][2], aB[2][2], bB[2][2];
        ldb(IC<0>{}, gA, aA, bA); ldb(IC<1>{}, gB, aB, bB);
        cpb(IC<0>{}, gA, aA, bA); ldb(IC<2>{}, gA, aA, bA);
        cpb(IC<1>{}, gB, aB, bB); ldb(IC<3>{}, gB, aB, bB);
        cpb(IC<2>{}, gA, aA, bA); cpb(IC<3>{}, gB, aB, bB);
    }
};
struct BranchSched {
    static constexpr bool GATHER = false; static constexpr bool VARK = true;
    const char* A0; const char* B0; size_t sA, sB; int lda, ldb, c, sw8, sa8, G, ntile;
    __device__ __forceinline__ int ktiles(const pg8::Unit& u) const { return u.ord == 1 ? 2 : 4; }
    __device__ __forceinline__ bool next(int i, pg8::Unit& u) const { const int t = c + (i / 3) * G; if (t >= ntile) return false; u.pm = t >> 2; u.pn = t & 3; u.ord = i % 3; return true; }
    __device__ __forceinline__ const char* a_base(const pg8::Unit& u) const { return A0 + (size_t)u.ord * sA + (size_t)u.pm * 256 * lda * 2; }
    __device__ __forceinline__ const char* b_base(const pg8::Unit& u) const { return B0 + (size_t)u.ord * sB + (size_t)u.pn * 256 * ldb * 2; }
    __device__ __forceinline__ void a_off(const pg8::Unit&, const int (&R)[2], const int (&C)[2], unsigned (&v)[2][2]) const {
#pragma unroll
        for (int i = 0; i < 2; ++i) { v[0][i] = (unsigned)(R[i] * lda + C[i]) * 2u; v[1][i] = (unsigned)((128 + R[i]) * lda + C[i]) * 2u; }
    }
};
struct EpiWo {
    float* out; const float* xsrc; int rowbase;
    __device__ __forceinline__ void operator()(const f32x4 (&acc)[2][2][4][2], const pg8::Unit& u, int wr, int wc, int fr, int fq) const {
        const int row0 = rowbase + u.pm * 256 + wr * 64 + fr, col0 = u.pn * 256 + wc * 32 + fq * 8;
#pragma unroll
        for (int ai = 0; ai < 2; ++ai)
#pragma unroll
            for (int mh = 0; mh < 2; ++mh) {
                f32x4 x[2][2][2];
#pragma unroll
                for (int mm = 0; mm < 2; ++mm)
#pragma unroll
                    for (int bj = 0; bj < 2; ++bj) { const size_t off = (size_t)(row0 + ai * 128 + (2 * mh + mm) * 16) * DM + col0 + bj * 128;
                        x[mm][bj][0] = *(const f32x4*)(xsrc + off); x[mm][bj][1] = *(const f32x4*)(xsrc + off + 4); }
#pragma unroll
                for (int mm = 0; mm < 2; ++mm)
#pragma unroll
                    for (int bj = 0; bj < 2; ++bj) { const size_t off = (size_t)(row0 + ai * 128 + (2 * mh + mm) * 16) * DM + col0 + bj * 128;
                        *(f32x4*)(out + off) = x[mm][bj][0] * ALPHA + acc[ai][bj][2 * mh + mm][0]; *(f32x4*)(out + off + 4) = x[mm][bj][1] * ALPHA + acc[ai][bj][2 * mh + mm][1]; }
            }
    }
};

__device__ __forceinline__ int dequeue(Frame& F, unsigned* ctr, int& pre) {
    LAS int* slot = (LAS int*)(F.lds + L_QSLOT);
    __syncthreads();
    if (F.tid == 0) {
        *slot = (int)__hip_atomic_fetch_add(ctr, 1u, __ATOMIC_RELAXED, __HIP_MEMORY_SCOPE_AGENT); (void)pre;
    }
    __syncthreads();
    return *slot;
}

namespace att {
constexpr int KSLOT = 12288, VSLOT = 8192, NSLOT = 4;
constexpr int A_K = 0, A_V = NSLOT * KSLOT, A_WS = A_V + NSLOT * VSLOT, A_OST = A_WS + 8 * 256, A_MW = A_OST + 8 * 4096, A_END = A_MW + 8 * NSLOT * 256;
static_assert(A_END <= RING_BYTES, "attention LDS");
typedef short s16x4 __attribute__((ext_vector_type(4)));
__device__ __forceinline__ int crow(int r, int hi) { return (r & 3) + 8 * (r >> 2) + 4 * hi; }
__device__ __forceinline__ void glds16(const void* gsrc, unsigned lds_dst) { unsigned keep;
    asm volatile("s_mov_b32 %0, m0\n\ts_mov_b32 m0, %2\n\ts_nop 0\n\tglobal_load_lds_dwordx4 %1, off\n\ts_mov_b32 m0, %0" : "=&s"(keep) : "v"(gsrc), "s"(lds_dst) : "memory"); }
__device__ __forceinline__ void glds4(const void* gsrc, unsigned lds_dst) { unsigned keep;
    asm volatile("s_mov_b32 %0, m0\n\ts_mov_b32 m0, %2\n\ts_nop 0\n\tglobal_load_lds_dword %1, off\n\ts_mov_b32 m0, %0" : "=&s"(keep) : "v"(gsrc), "s"(lds_dst) : "memory"); }
#define ATT_WAIT_BAR(N) asm volatile("s_waitcnt vmcnt(" #N ") lgkmcnt(0)\n\ts_barrier" ::: "memory")
__device__ __forceinline__ float emax(float a, float b) { return __builtin_elementwise_maximum(a, b); }
__device__ __forceinline__ float halfmax(float m) { auto rr = __builtin_amdgcn_permlane32_swap(__float_as_uint(m), __float_as_uint(m), false, false); return emax(__uint_as_float(rr[0]), __uint_as_float(rr[1])); }
__device__ __forceinline__ float halfsum(float m) { auto rr = __builtin_amdgcn_permlane32_swap(__float_as_uint(m), __float_as_uint(m), false, false); return __uint_as_float(rr[0]) + __uint_as_float(rr[1]); }
typedef short v4i16_t __attribute__((ext_vector_type(4)));
__device__ __forceinline__ s16x4 vtr(const LAS unsigned char* p) { return __builtin_bit_cast(s16x4, __builtin_amdgcn_ds_read_tr16_b64_v4i16((LAS v4i16_t*)p)); }
__device__ __forceinline__ void pv(f32x16* o, f32x16& lacc, const LAS unsigned char* vp, bf16x8 pa0, bf16x8 pa1, bf16x8 pa2, bf16x8 pa3) {
    { const u32x4 one4 = {0x3F803F80u, 0x3F803F80u, 0x3F803F80u, 0x3F803F80u}; const bf16x8 ones = __builtin_bit_cast(bf16x8, one4);
      lacc = __builtin_amdgcn_mfma_f32_32x32x16_bf16(pa0, ones, lacc, 0, 0, 0); lacc = __builtin_amdgcn_mfma_f32_32x32x16_bf16(pa1, ones, lacc, 0, 0, 0);
      lacc = __builtin_amdgcn_mfma_f32_32x32x16_bf16(pa2, ones, lacc, 0, 0, 0); lacc = __builtin_amdgcn_mfma_f32_32x32x16_bf16(pa3, ones, lacc, 0, 0, 0); }
#pragma unroll
    for (int d0 = 0; d0 < 2; ++d0) { s16x4 lo[4], hi[4];
#pragma unroll
        for (int ks = 0; ks < 4; ++ks) { lo[ks] = vtr(vp + d0 * 4096 + ks * 1024); hi[ks] = vtr(vp + d0 * 4096 + ks * 1024 + 512); }
#define ATT_PK(k) (bf16x8){lo[k][0], lo[k][1], lo[k][2], lo[k][3], hi[k][0], hi[k][1], hi[k][2], hi[k][3]}
        o[d0] = __builtin_amdgcn_mfma_f32_32x32x16_bf16(pa0, ATT_PK(0), o[d0], 0, 0, 0);
        o[d0] = __builtin_amdgcn_mfma_f32_32x32x16_bf16(pa1, ATT_PK(1), o[d0], 0, 0, 0);
        o[d0] = __builtin_amdgcn_mfma_f32_32x32x16_bf16(pa2, ATT_PK(2), o[d0], 0, 0, 0);
        o[d0] = __builtin_amdgcn_mfma_f32_32x32x16_bf16(pa3, ATT_PK(3), o[d0], 0, 0, 0);
#undef ATT_PK
    }
}
struct Desc {
    const bf16_t* Q; const bf16_t* K1; const bf16_t* K2; const bf16_t* V; bf16_t* O; float* lse; const unsigned* mask;
    int qpitch, k1pitch, k2pitch, vpitch, opitch, lsepitch;
    int rstride, q0, nq, jlo, jhi;
    int o8;
};
template <int DQK, int MODE, bool DUAL = false>
__device__ __forceinline__ void attn_unit(LAS unsigned char* lds, const Desc& d) {
    static_assert(!DUAL || (DQK == 64 && MODE == 0), "dual mode");
    constexpr int NSLOT = DUAL ? 2 : att::NSLOT, KSLOT = DUAL ? 8192 : att::KSLOT;
    constexpr int A_K = 0, A_V = DUAL ? 32768 : att::A_V, A_WS = DUAL ? 65536 : att::A_WS, A_OST = DUAL ? 67584 : att::A_OST, A_MW = att::A_MW;
    int tid_ = threadIdx.x; asm volatile("" : "+v"(tid_));
    const int tid = tid_, lane = tid & 63, r32 = lane & 31, hi = lane >> 5, wid = __builtin_amdgcn_readfirstlane(tid >> 6);
    constexpr int ND = DQK / 16;
    const unsigned lds0 = (unsigned)(size_t)lds;
    LAS float* wsf = (LAS float*)(lds + A_WS) + wid * 64;
    const int grp = DUAL ? (wid >> 2) : 0, w4 = DUAL ? (wid & 3) : wid, gofs = grp * 16384;
    Desc dd = d;
    if (DUAL) { dd.Q = d.Q + (size_t)grp * d.qpitch; dd.K1 = d.K1 + (size_t)grp * d.k1pitch; dd.V = d.V + (size_t)grp * d.vpitch; dd.O = d.O + (size_t)grp * d.opitch; if (d.lse) dd.lse = d.lse + (size_t)grp * d.lsepitch; }
    const Desc& d_ = dd;
    const int qw = d.q0 + w4 * 32;
    const bool wvalid = DUAL || wid * 32 < d.nq;
    const int kkey = 8 * wid + (lane >> 3), kch = (lane & 7) ^ ((kkey >> 1) & 7);
    const bf16_t* ksrc = d_.K1 + (size_t)kkey * d.rstride * d.k1pitch + kch * 8;
    const int k2key = 16 * (wid & 3) + (lane >> 2), k2ch = (lane & 3) ^ ((k2key >> 2) & 3);
    const bf16_t* k2src = (DQK == 96) ? d_.K2 + (size_t)k2key * d.rstride * d.k2pitch + k2ch * 8 : nullptr;
    int kofs[ND];
#pragma unroll
    for (int d0 = 0; d0 < ND; ++d0) kofs[d0] = d0 < 4 ? r32 * 128 + (((2 * d0 + hi) ^ ((r32 >> 1) & 7)) * 16) : 8192 + r32 * 64 + (((2 * (d0 - 4) + hi) ^ ((r32 >> 2) & 3)) * 16);
    const bf16_t* vsrc = d_.V + (size_t)(16 * (wid & 3) + (lane >> 2)) * d.rstride * d.vpitch + (DUAL ? 0 : (wid >> 2) * 32) + (lane & 3) * 8;
    const int kkeyB = 8 * (2 * w4 + 1) + (lane >> 3);
    const bf16_t* ksrcA = DUAL ? d_.K1 + (size_t)(8 * (2 * w4) + (lane >> 3)) * d.rstride * d.k1pitch + (((lane & 7) ^ (((8 * (2 * w4) + (lane >> 3)) >> 1) & 7)) * 8) : nullptr;
    const bf16_t* ksrcB = DUAL ? d_.K1 + (size_t)kkeyB * d.rstride * d.k1pitch + (((lane & 7) ^ ((kkeyB >> 1) & 7)) * 8) : nullptr;
    const size_t kstep = (size_t)64 * d.rstride * d.k1pitch, k2step = (size_t)64 * d.rstride * d.k2pitch, vstep = (size_t)64 * d.rstride * d.vpitch;
    const bool two = (DQK == 96) && wid < 4;
    const unsigned* msrc = (MODE == 2) ? d.mask + (size_t)(wvalid ? (qw + (lane >> 1)) : d.q0) * 64 + (lane & 1) : nullptr;
#define ATT_ISSUE(j) do { const int sl_ = (j) % NSLOT; \
        if (DUAL) { \
            glds16(ksrcA + (size_t)(j) * kstep, (unsigned)__builtin_amdgcn_readfirstlane(lds0 + A_K + gofs + sl_ * KSLOT + (2 * w4) * 1024)); \
            glds16(ksrcB + (size_t)(j) * kstep, (unsigned)__builtin_amdgcn_readfirstlane(lds0 + A_K + gofs + sl_ * KSLOT + (2 * w4 + 1) * 1024)); \
            glds16(vsrc + (size_t)(j) * vstep, (unsigned)__builtin_amdgcn_readfirstlane(lds0 + A_V + gofs + sl_ * VSLOT + w4 * 1024)); \
            glds16(vsrc + 32 + (size_t)(j) * vstep, (unsigned)__builtin_amdgcn_readfirstlane(lds0 + A_V + gofs + sl_ * VSLOT + (4 + w4) * 1024)); \
            break; } \
        glds16(ksrc + (size_t)(j) * kstep, (unsigned)__builtin_amdgcn_readfirstlane(lds0 + A_K + sl_ * KSLOT + wid * 1024)); \
        if (two) glds16(k2src + (size_t)(j) * k2step, (unsigned)__builtin_amdgcn_readfirstlane(lds0 + A_K + sl_ * KSLOT + (8 + wid) * 1024)); \
        glds16(vsrc + (size_t)(j) * vstep, (unsigned)__builtin_amdgcn_readfirstlane(lds0 + A_V + sl_ * VSLOT + wid * 1024)); \
        if (MODE == 2) glds4(msrc + 2 * (j), (unsigned)__builtin_amdgcn_readfirstlane(lds0 + A_MW + (wid * NSLOT + sl_) * 256)); } while (0)
    ATT_ISSUE(d.jlo);
    if (d.jlo + 1 < d.jhi) ATT_ISSUE(d.jlo + 1);
    bf16x8 qr[ND];
    { const int qi = wvalid ? (qw + r32) : d.q0; const bf16_t* qp = d_.Q + (size_t)qi * d.rstride * d.qpitch + hi * 8;
#pragma unroll
      for (int d0 = 0; d0 < ND; ++d0) qr[d0] = *(const bf16x8*)(qp + d0 * 16); }
#pragma unroll
    for (int d0 = 0; d0 < ND; ++d0) asm volatile("" : "+v"(qr[d0]));
    float mhat = 0.f; f32x16 o[2]; o[0] = f32x16{}; o[1] = f32x16{}; f32x16 lacc = f32x16{};
    bool started = false;
    const LAS unsigned char* vp0 = lds + A_V + gofs + ((lane >> 4) & 1) * 32 + (lane & 3) * 8 + (4 * hi + ((lane & 15) >> 2)) * 64;
    const int qi = qw + r32;
    f32x16 p0 = f32x16{}, p1 = f32x16{};
    f32x16 negm = f32x16{};
#define ATT_REL(j) (wvalid && (64 * (j) <= qw + 31) && (MODE != 1 || (64 * (j) + 63 >= qw - 128)))
#define ATT_QK(j) do { const int sl_ = (j) % NSLOT; \
        const LAS unsigned char* kb = lds + A_K + gofs + sl_ * KSLOT; bf16x8 kf[2 * ND]; \
        _Pragma("unroll") for (int d0 = 0; d0 < ND; ++d0) { kf[2 * d0] = *(const LAS bf16x8*)(kb + kofs[d0]); kf[2 * d0 + 1] = *(const LAS bf16x8*)(kb + kofs[d0] + (d0 < 4 ? 4096 : 2048)); } \
        __builtin_amdgcn_sched_barrier(0); \
        _Pragma("unroll") for (int d0 = 0; d0 < ND; ++d0) { \
            if (d0 == 0) { p0 = __builtin_amdgcn_mfma_f32_32x32x16_bf16(kf[0], qr[0], negm, 0, 0, 0); p1 = __builtin_amdgcn_mfma_f32_32x32x16_bf16(kf[1], qr[0], negm, 0, 0, 0); } \
            else { p0 = __builtin_amdgcn_mfma_f32_32x32x16_bf16(kf[2 * d0], qr[d0], p0, 0, 0, 0); p1 = __builtin_amdgcn_mfma_f32_32x32x16_bf16(kf[2 * d0 + 1], qr[d0], p1, 0, 0, 0); } } } while (0)
#define ATT_SMPV(j) do { const int sl_ = (j) % NSLOT; \
        { bool domask = true; unsigned mx_ = 0u, my_ = 0u;        \
          if (MODE == 2) { const u32x2 mw = *(const LAS u32x2*)(lds + A_MW + (wid * NSLOT + sl_) * 256 + r32 * 8); mx_ = mw.x; my_ = mw.y; } \
          else { \
            bool full = (64 * (j) + 63 <= qw); \
            if (MODE == 1) full = full && (64 * (j) >= qw + 31 - 128); \
            domask = !full; \
            if (domask) { const int a_ = qi - 64 * (j), lo_ = (MODE == 1) ? a_ - 128 : -4096;        \
                { const int h_ = a_ < 31 ? a_ : 31, l_ = lo_ > 0 ? lo_ : 0; mx_ = (h_ < l_) ? 0u : ((0xFFFFFFFFu >> (31 - h_)) & (0xFFFFFFFFu << l_)); } \
                { const int h_ = a_ - 32 < 31 ? a_ - 32 : 31, l_ = lo_ - 32 > 0 ? lo_ - 32 : 0; my_ = (h_ < l_) ? 0u : ((0xFFFFFFFFu >> (31 - h_)) & (0xFFFFFFFFu << l_)); } } \
          } \
          if (domask) { const unsigned w0 = mx_ >> (4 * hi), w1 = my_ >> (4 * hi); \
            _Pragma("unroll") for (int r = 0; r < 16; ++r) { const int bit = (r & 3) + 8 * (r >> 2); \
                const unsigned m0 = (unsigned)__builtin_amdgcn_sbfe((int)w0, bit, 1), m1 = (unsigned)__builtin_amdgcn_sbfe((int)w1, bit, 1);        \
                p0[r] = __uint_as_float((m0 & __float_as_uint(p0[r])) | (~m0 & 0xFF800000u)); p1[r] = __uint_as_float((m1 & __float_as_uint(p1[r])) | (~m1 & 0xFF800000u)); } } } \
        float rm = emax(p0[0], p1[0]), rm2 = emax(p0[1], p1[1]); \
        _Pragma("unroll") for (int r = 2; r < 16; r += 2) { rm = emax(emax(rm, p0[r]), p1[r]); rm2 = emax(emax(rm2, p0[r + 1]), p1[r + 1]); } \
        rm = halfmax(emax(rm, rm2)); \
        bool need; float dl; \
        if (!started) { need = true; dl = emax(rm, -200.f); } else { need = __any(rm > 8.f) != 0; dl = emax(rm, 0.f); } \
        if (need) { mhat += dl; \
            _Pragma("unroll") for (int r = 0; r < 16; ++r) negm[r] = -mhat; \
            _Pragma("unroll") for (int r = 0; r < 16; ++r) { p0[r] -= dl; p1[r] -= dl; } \
            if (started) { const float f = __builtin_amdgcn_exp2f(-dl); \
                if (hi == 0) wsf[r32] = f; \
                LDS_WAIT(); \
                _Pragma("unroll") for (int r = 0; r < 16; ++r) { const float fr_ = wsf[crow(r, hi)]; o[0][r] *= fr_; o[1][r] *= fr_; lacc[r] *= fr_; } } } \
        started = true; \
        __builtin_amdgcn_s_setprio(1);        \
        _Pragma("unroll") for (int r = 0; r < 16; ++r) { p0[r] = __builtin_amdgcn_exp2f(p0[r]); p1[r] = __builtin_amdgcn_exp2f(p1[r]); } \
        const u32x4 pw0 = (u32x4){cvt_pk_bf16(p0[0], p0[1]), cvt_pk_bf16(p0[2], p0[3]), cvt_pk_bf16(p0[4], p0[5]), cvt_pk_bf16(p0[6], p0[7])}; \
        const u32x4 pw1 = (u32x4){cvt_pk_bf16(p0[8], p0[9]), cvt_pk_bf16(p0[10], p0[11]), cvt_pk_bf16(p0[12], p0[13]), cvt_pk_bf16(p0[14], p0[15])}; \
        const u32x4 pw2 = (u32x4){cvt_pk_bf16(p1[0], p1[1]), cvt_pk_bf16(p1[2], p1[3]), cvt_pk_bf16(p1[4], p1[5]), cvt_pk_bf16(p1[6], p1[7])}; \
        const u32x4 pw3 = (u32x4){cvt_pk_bf16(p1[8], p1[9]), cvt_pk_bf16(p1[10], p1[11]), cvt_pk_bf16(p1[12], p1[13]), cvt_pk_bf16(p1[14], p1[15])}; \
        pv(o, lacc, vp0 + sl_ * VSLOT, __builtin_bit_cast(bf16x8, pw0), __builtin_bit_cast(bf16x8, pw1), __builtin_bit_cast(bf16x8, pw2), __builtin_bit_cast(bf16x8, pw3)); \
        __builtin_amdgcn_s_setprio(0); } while (0)
#define ATT_TOPWAIT(j) do { if ((j) + 1 < d.jhi) { if (DUAL) { ATT_WAIT_BAR(4); } else if (MODE == 2 || two) { ATT_WAIT_BAR(3); } else { ATT_WAIT_BAR(2); } } else { ATT_WAIT_BAR(0); } } while (0)
    if (wid < 4) {
        for (int j = d.jlo; j < d.jhi; ++j) {
            ATT_TOPWAIT(j);
            if (j + 2 < d.jhi) ATT_ISSUE(j + 2);
            if (ATT_REL(j)) { ATT_QK(j); ATT_SMPV(j); }
        }
        asm volatile("s_waitcnt lgkmcnt(0)\n\ts_barrier" ::: "memory");
    } else {
        ATT_TOPWAIT(d.jlo);
        if (d.jlo + 2 < d.jhi) ATT_ISSUE(d.jlo + 2);
        if (ATT_REL(d.jlo)) ATT_QK(d.jlo);
        for (int j = d.jlo + 1; j < d.jhi; ++j) {
            ATT_TOPWAIT(j);
            if (j + 2 < d.jhi) ATT_ISSUE(j + 2);
            if (ATT_REL(j - 1)) ATT_SMPV(j - 1);
            if (ATT_REL(j)) ATT_QK(j);
        }
        asm volatile("s_waitcnt lgkmcnt(0)\n\ts_barrier" ::: "memory");
        if (ATT_REL(d.jhi - 1)) ATT_SMPV(d.jhi - 1);
    }
#undef ATT_REL
#undef ATT_QK
#undef ATT_SMPV
#undef ATT_TOPWAIT
#undef ATT_ISSUE
    if (wvalid) {
        LAS bf16_t* stg = (LAS bf16_t*)(lds + A_OST) + wid * 2048;
        if (d_.lse != nullptr && r32 == 0) {
#pragma unroll
            for (int r = 0; r < 16; ++r) wsf[32 + crow(r, hi)] = lacc[r]; }
        if (d.o8) {
            LAS unsigned char* stg8 = (LAS unsigned char*)stg;
#pragma unroll
            for (int r = 0; r < 16; ++r) { const int orow = crow(r, hi); const float rl = __builtin_amdgcn_rcpf(lacc[r]) * 32.f;
                const unsigned p = (unsigned)__builtin_amdgcn_cvt_pk_fp8_f32(o[0][r] * rl, o[1][r] * rl, 0, false);
                stg8[orow * 64 + r32] = (unsigned char)(p & 0xffu); stg8[orow * 64 + 32 + r32] = (unsigned char)((p >> 8) & 0xffu); }
            LDS_WAIT();
#pragma unroll
            for (int i = 0; i < 2; ++i) { const int row = i * 16 + (lane >> 2), ch = lane & 3; const u32x4 v = *(const LAS u32x4*)(stg8 + row * 64 + ch * 16);
                *(u32x4*)((unsigned char*)d_.O + (size_t)(qw + row) * d.rstride * d.opitch + ch * 16) = v; }
        } else {
#pragma unroll
        for (int r = 0; r < 16; ++r) { const int orow = crow(r, hi); const float rl = __builtin_amdgcn_rcpf(lacc[r]);
            stg[orow * 64 + r32] = (bf16_t)f2bf(o[0][r] * rl); stg[orow * 64 + 32 + r32] = (bf16_t)f2bf(o[1][r] * rl); }
        LDS_WAIT();
#pragma unroll
        for (int i = 0; i < 4; ++i) { const int row = i * 8 + (lane >> 3), ch = lane & 7; const u32x4 v = *(const LAS u32x4*)(stg + row * 64 + ch * 8);
            *(u32x4*)(d_.O + (size_t)(qw + row) * d.rstride * d.opitch + ch * 8) = v; }
        }
        if (d_.lse != nullptr && hi == 0) d_.lse[(size_t)(qw + r32) * d.rstride * d.lsepitch] = mhat + __builtin_amdgcn_logf(wsf[32 + r32]);
    }
    asm volatile("s_waitcnt lgkmcnt(0)\n\ts_barrier" ::: "memory");
}
}

namespace idx {
constexpr int KS = 8192, I_K = 0, I_ST = 3 * KS, I_END = I_ST + 8 * 8192;
static_assert(I_END <= RING_BYTES, "indexer LDS");
__device__ __forceinline__ void score_unit(LAS unsigned char* lds, const bf16_t* PROJ, float* SC, int b, int qh  , int jg) {
    int tid_ = threadIdx.x; asm volatile("" : "+v"(tid_));
    const int tid = tid_, lane = tid & 63, r32 = lane & 31, hi = lane >> 5, wid = __builtin_amdgcn_readfirstlane(tid >> 6);
    const int qg = wid >> 1, hh = wid & 1;
    const unsigned lds0 = (unsigned)(size_t)lds;
    const int qrow = b * SEQ + qh * 128 + qg * 32 + r32;
    const bf16_t* kbase = PROJ + (size_t)(b * SEQ) * PW + 3968;
    const int kkey = 8 * wid + (lane >> 3);
    const bf16_t* ksrc = kbase + (size_t)kkey * PW + ((lane & 7) ^ ((kkey >> 1) & 7)) * 8;
    const int j0 = 4 * jg;
#define IDX_ISSUE(j) att::glds16(ksrc + (size_t)(j) * 64 * PW, (unsigned)__builtin_amdgcn_readfirstlane(lds0 + I_K + ((j) % 3) * KS + wid * 1024))
    IDX_ISSUE(j0); IDX_ISSUE(j0 + 1);
    bf16x8 qf[4][4]; float wv[4];
    { const bf16_t* qp = PROJ + (size_t)qrow * PW + 3328 + hh * 256 + hi * 8;
#pragma unroll
      for (int h = 0; h < 4; ++h)
#pragma unroll
          for (int d0 = 0; d0 < 4; ++d0) qf[h][d0] = *(const bf16x8*)(qp + h * 64 + d0 * 16);
      const u32x2 ww = *(const u32x2*)(PROJ + (size_t)qrow * PW + 4032 + hh * 4);
      wv[0] = bflo(ww.x); wv[1] = bfhi(ww.x); wv[2] = bflo(ww.y); wv[3] = bfhi(ww.y); }
#pragma unroll
    for (int h = 0; h < 4; ++h) { asm volatile("" : "+v"(wv[h]));
#pragma unroll
        for (int d0 = 0; d0 < 4; ++d0) asm volatile("" : "+v"(qf[h][d0])); }
    const int qb = qh >> 1;
    unsigned* blk = (unsigned*)SC + ((size_t)b * 36 + (size_t)(qb * (qb + 1) / 2)) * 32768; const int pitch = 128 * (qb + 1);
    f32x4 ve[4] = {};
    LAS unsigned char* stg = lds + I_ST + wid * 8192;
    const LAS unsigned char* stg2 = lds + I_ST + (wid ^ 1) * 8192;
#pragma nounroll
    for (int jj = 0; jj < 4; ++jj) { const int j = j0 + jj;
        if (jj < 2) { ATT_WAIT_BAR(1); } else if (jj == 2) { ATT_WAIT_BAR(5); } else { ATT_WAIT_BAR(4); }
        if (jj + 2 < 4) IDX_ISSUE(j + 2);
        const LAS unsigned char* kb = lds + I_K + (j % 3) * KS + r32 * 128;
#pragma nounroll
        for (int half = 0; half < 2; ++half) {
            bf16x8 kf[4];
#pragma unroll
            for (int d0 = 0; d0 < 4; ++d0) kf[d0] = *(const LAS bf16x8*)(kb + half * 4096 + (((2 * d0 + hi) ^ ((r32 >> 1) & 7)) * 16));
            f32x16 t0 = f32x16{};
#pragma unroll
            for (int h = 0; h < 4; ++h) {
                f32x16 p0 = f32x16{};
#pragma unroll
                for (int d0 = 0; d0 < 4; ++d0) p0 = __builtin_amdgcn_mfma_f32_32x32x16_bf16(kf[d0], qf[h][d0], p0, 0, 0, 0);
#pragma unroll
                for (int r = 0; r < 16; ++r) t0[r] += wv[h] * att::emax(p0[r], 0.f);
            }
#pragma unroll
            for (int g = 0; g < 4; ++g) { const int c0 = 8 * half + 2 * g + hi;
                *(LAS f32x4*)(stg + r32 * 256 + ((c0 ^ (r32 & 15)) * 16)) = (f32x4){t0[4 * g], t0[4 * g + 1], t0[4 * g + 2], t0[4 * g + 3]}; }
        }
        asm volatile("s_waitcnt lgkmcnt(0)\n\ts_barrier" ::: "memory");
#pragma unroll
        for (int i = 0; i < 4; ++i) { const int q = hh * 16 + i * 4 + (lane >> 4), c = lane & 15; const int so = q * 256 + ((c ^ (q & 15)) * 16);
            const f32x4 v = *(const LAS f32x4*)(stg + so) + *(const LAS f32x4*)(stg2 + so);
            if (jj & 1) { const f32x4 e = ve[i]; const u32x4 w = {pk2(e[0], v[0]), pk2(e[1], v[1]), pk2(e[2], v[2]), pk2(e[3], v[3])};
                *(u32x4*)(blk + (size_t)((qh & 1) * 128 + qg * 32 + q) * pitch + 64 * (j >> 1) + 4 * c) = w; }
            else ve[i] = v; }
        LDS_WAIT();
    }
#undef IDX_ISSUE
    asm volatile("s_waitcnt lgkmcnt(0)\n\ts_barrier" ::: "memory");
}

__device__ __forceinline__ int wave_sum_i(int v) {
    v += __builtin_amdgcn_update_dpp(0, v, 0xB1, 0xF, 0xF, true);
    v += __builtin_amdgcn_update_dpp(0, v, 0x4E, 0xF, 0xF, true);
    v += __builtin_amdgcn_update_dpp(0, v, 0x141, 0xF, 0xF, true);
    v += __builtin_amdgcn_update_dpp(0, v, 0x140, 0xF, 0xF, true);
    return __builtin_amdgcn_readlane(v, 0) + __builtin_amdgcn_readlane(v, 16) + __builtin_amdgcn_readlane(v, 32) + __builtin_amdgcn_readlane(v, 48);
}
__device__ __forceinline__ unsigned long long keep_low(unsigned long long m, int k) { while (__builtin_popcountll(m) > k) m &= ~(1ull << (63 - __builtin_clzll(m))); return m; }
__device__ __forceinline__ void select_rows4(const float* SC, unsigned* MASK, int row0  , int lane, LAS unsigned* slot  ) {
    const int b = row0 / SEQ, t0 = row0 % SEQ, qb = t0 >> 8;
    if (t0 < 256) {
#pragma unroll 1
        for (int i = 0; i < 4; ++i) { const int t = t0 + i, lo = 64 * lane;
            const unsigned long long w = (lo + 63 <= t) ? ~0ull : (lo > t ? 0ull : ((2ull << (t - lo)) - 1ull));
            if (lane < 32) ((unsigned long long*)(MASK + (size_t)(row0 + i) * 64))[lane] = w; }
        return;
    }
    const int pitch = 128 * (qb + 1), pmax = pitch - 1;
    const unsigned* srow0 = (const unsigned*)SC + ((size_t)b * 36 + (size_t)(qb * (qb + 1) / 2)) * 32768 + (size_t)(t0 - 256 * qb) * pitch;
    unsigned raw[16];
#pragma unroll
    for (int i = 0; i < 16; ++i) { const int s_ = 64 * i + lane; raw[i] = srow0[s_ < pmax ? s_ : pmax]; }
#pragma unroll 1
    for (int r = 0; r < 4; ++r) {
        const int t = t0 + r;
        unsigned P[16];
#pragma unroll
        for (int i = 0; i < 16; ++i) P[i] = raw[i];
        { const unsigned* nx = srow0 + (size_t)(r < 3 ? r + 1 : 3) * pitch;
#pragma unroll
          for (int i = 0; i < 16; ++i) { const int s_ = 64 * i + lane; raw[i] = nx[s_ < pmax ? s_ : pmax]; } }
#define SEL_TSTAGE(sh, m) _Pragma("unroll") for (int q = 0; q < 16; ++q) if (!(q & (sh))) { const unsigned a_ = P[q], b_ = P[q + (sh)]; \
            P[q] = (a_ & (m)) | ((b_ << (sh)) & ~(m)); P[q + (sh)] = ((a_ >> (sh)) & (m)) | (b_ & ~(m)); }
        SEL_TSTAGE(8, 0x00FF00FFu) SEL_TSTAGE(4, 0x0F0F0F0Fu) SEL_TSTAGE(2, 0x33333333u) SEL_TSTAGE(1, 0x55555555u)
#undef SEL_TSTAGE
        { const unsigned sg = P[15];
#pragma unroll
          for (int q = 0; q < 15; ++q) P[q] ^= sg;
          P[15] = ~sg; }
        const int nj = ((t - lane) >> 6) + 1;
        unsigned A = ((1u << ((nj + 1) >> 1)) - 1u) | (((1u << (nj >> 1)) - 1u) << 16), G = 0u;
        int cab = 0, cntA = t + 1;
#pragma unroll
        for (int bit = 15; bit >= 0; --bit) {
            if (cab + cntA != 256) {
                const unsigned ones = A & P[bit];
                const int c = wave_sum_i(__builtin_popcount(ones));
                if (cab + c >= 256) { A = ones; cntA = c; } else { G |= ones; cab += c; A &= ~ones; cntA -= c; }
            }
        }
        int need = 256 - cab;
        unsigned sel = G | A;
        if (cntA != need) {
            unsigned selA = 0u;
#pragma nounroll
            for (int j = 0; j < 32; ++j) { const int pb = (j >> 1) + 16 * (j & 1);
                unsigned long long m = __ballot((A >> pb) & 1u);
                if (__builtin_popcountll(m) > need) m = keep_low(m, need);
                need -= __builtin_popcountll(m);
                selA |= (unsigned)((m >> lane) & 1ull) << pb;
            }
            sel = G | selA;
        }
        int lo = 0, hi = 0;
#pragma unroll
        for (int j = 0; j < 32; ++j) { const unsigned long long m = __ballot((sel >> ((j >> 1) + 16 * (j & 1))) & 1u);
            lo = (lane == j) ? (int)(unsigned)m : lo; hi = (lane == j) ? (int)(unsigned)(m >> 32) : hi; }
        if (lane < 32) ((unsigned long long*)(MASK + (size_t)(row0 + r) * 64))[lane] = (unsigned long long)(unsigned)lo | ((unsigned long long)(unsigned)hi << 32);
    }
}
}

__device__ __forceinline__ unsigned* queue_word(Frame& F, int l, int chunk, int q) { return (unsigned*)(F.ws + WS_CTL) + CW_QUEUE + 64 * ((l * NCHUNK + chunk) * 4 + q); }

__device__ __forceinline__ void phase_proj(Frame& F, int l, int chunk) {
    PHASE_IDS(F);
    { LAS float* gb = (LAS float*)(F.lds + L_GB); const float* bg = F.in[7] + (size_t)l * 3072;
      __syncthreads();
      for (int i = F.tid; i < 3072; i += NTHREADS) gb[i] = bg[i];
      VM_WAIT(); LDS_WAIT(); __syncthreads(); }
    pg8::ProjSched8 S{{{(const bf16_t*)(F.ws + WS_XB8 + (size_t)chunk * TC * DM), (const bf16_t*)(F.ws + WS_WIN8), DM / 2, DM / 2, TC / 256, (PW + 3072) / 256, F.G, (int)blockIdx.x}, F8_SW, F8_SA_X}};
    const float* rp = (const float*)(F.ws + WS_ROPE);
    EpiProj E{(bf16_t*)(F.ws + WS_PROJ), rp, rp + 2048 * 8 * 2, (float*)(F.ws + WS_SSQ), (bf16_t*)(F.ws + WS_G3), (const LAS float*)(F.lds + L_GB)};
    pg8::gemm_phase<EpiProj, pg8::ProjSched8, true, true>(F.lds, DM / 2, S, E);
}
__device__ __forceinline__ void dilated_unit(Frame& F, int u) {
    const bf16_t* PROJ = (const bf16_t*)(F.ws + WS_PROJ); bf16_t* OG = (bf16_t*)(F.ws + WS_OG); float* LSE = (float*)(F.ws + WS_LSE);
    constexpr int N_G0 = NBC * 4 * 8, N_G1 = NBC * 4 * 4 * 2;
    int g, b, h, res, qb, dil, nq;
    if (u < N_G0) { g = 0; dil = 1; qb = 7 - u / (NBC * 4); const int bh = u % (NBC * 4); b = bh >> 2; h = bh & 3; res = 0; nq = 256; }
    else if (u < N_G0 + N_G1) { const int v = u - N_G0; g = 1; dil = 4; qb = 1 - v / (NBC * 16); const int x = v % (NBC * 16); b = x >> 4; h = (x >> 2) & 3; res = x & 3; nq = 256; }
    else { const int v = u - N_G0 - N_G1; g = 2; dil = 16; qb = 0; b = v >> 5; h = (v >> 3) & 3; res = (v & 7) * 2; nq = 128; }
    att::Desc d; const size_t r0 = (size_t)b * SEQ + res;
    const bf16_t* base = PROJ + r0 * PW + 512 + 768 * g + 64 * h;
    d.Q = base; d.K1 = base + 256; d.V = base + 512; d.K2 = nullptr; d.qpitch = d.k1pitch = d.vpitch = PW; d.k2pitch = 0;
    d.O = OG + ((size_t)g * TC + r0) * 256 + 64 * h; d.opitch = 256; d.lse = LSE + ((size_t)g * TC + r0) * 4 + h; d.lsepitch = 4; d.mask = nullptr;
    d.rstride = dil; d.q0 = qb * 256; d.nq = nq; d.o8 = 0;
    if (g == 2) { d.jlo = 0; d.jhi = 2; att::attn_unit<64, 0, true>(F.lds, d); }
    else { d.jlo = (qb * 4 - 2) > 0 ? (qb * 4 - 2) : 0; d.jhi = 4 * (qb + 1); att::attn_unit<64, 1>(F.lds, d); }
}

struct UpSched {
    static constexpr bool GATHER = false;
    const char* A; const char* B; size_t sB; int lda, ldb, nM, G, c;
    __device__ __forceinline__ bool next(int i, pg8::Unit& u) const { const int v = i * G + c; if (v >= nM * 7) return false; u.pm = v / 7; u.pn = v % 7; u.ord = i; return true; }
    __device__ __forceinline__ const char* a_base(const pg8::Unit& u) const { return A + ((size_t)u.pm * 256 * lda + (u.pn >= 3 ? 256 : 0)) * 2; }
    __device__ __forceinline__ const char* b_base(const pg8::Unit& u) const { return B + (u.pn >= 3 ? sB + (size_t)(u.pn - 3) * 256 * ldb * 2 : (size_t)u.pn * 256 * ldb * 2); }
    __device__ __forceinline__ void a_off(const pg8::Unit&, const int (&R)[2], const int (&C)[2], unsigned (&v)[2][2]) const {
#pragma unroll
        for (int i = 0; i < 2; ++i) { v[0][i] = (unsigned)(R[i] * lda + C[i]) * 2u; v[1][i] = (unsigned)((128 + R[i]) * lda + C[i]) * 2u; }
    }
};
struct EpiUp {
    EpiUpQ q; EpiUpKV kv;
    __device__ __forceinline__ void operator()(const f32x4 (&acc)[2][2][4][2], const pg8::Unit& u, int wr, int wc, int fr, int fq) const {
        if (u.pn < 3) q(acc, u, wr, wc, fr, fq);
        else { pg8::Unit u2 = u; u2.pn = u.pn - 3; kv(acc, u2, wr, wc, fr, fq); }
    }
};
__device__ __forceinline__ void phase_up_scores(Frame& F, int l, int chunk) {
    PHASE_IDS(F);
    const bf16_t* PROJ = (const bf16_t*)(F.ws + WS_PROJ);
    const float* rp = (const float*)(F.ws + WS_ROPE);
    {   UpSched S{(const char*)PROJ, (const char*)(F.ws + WS_WUQ), WS_WUKV - WS_WUQ, PW, 256, TC / 256, F.G, (int)blockIdx.x};
        EpiUp E{{(bf16_t*)(F.ws + WS_QM), rp + 2048 * 8 * 2, (const float*)(F.ws + WS_SSQ)}, {(bf16_t*)(F.ws + WS_KVM), (const float*)(F.ws + WS_SSQ)}};
        pg8::gemm_phase<EpiUp, UpSched, true>(F.lds, 256, S, E); }
    unsigned* qw = queue_word(F, l, chunk, 0); int pre = -1;
    for (;;) {
        const int u = dequeue(F, qw, pre);
        if (u < NBC * 64) { dilated_unit(F, u); continue; }
        if (u >= NBC * 64 + NBC * 72 + NBC * 32) break;
        if (u >= NBC * 64 + NBC * 72) { dilated_unit(F, u - NBC * 72); continue; }
        const int v = u - NBC * 64; const int b = v / 72; int r = v % 72, qh = 0; while (r > (qh >> 1)) { r -= (qh >> 1) + 1; ++qh; }
        idx::score_unit(F.lds, PROJ, (float*)(F.ws + WS_SC), b, qh, r);
    }
}
__device__ __forceinline__ void phase_attn1(Frame& F, int l, int chunk, int tmask = 7) {
    PHASE_IDS(F);
    const bf16_t* PROJ = (const bf16_t*)(F.ws + WS_PROJ); const bf16_t* QM = (const bf16_t*)(F.ws + WS_QM); const bf16_t* KVM = (const bf16_t*)(F.ws + WS_KVM);
    bf16_t* OA = (bf16_t*)(F.ws + WS_OA); bf16_t* OG = (bf16_t*)(F.ws + WS_OG); float* LSE = (float*)(F.ws + WS_LSE);
    constexpr int N_MLA = NBC * 8 * 8, N_SEL = TC / 32;
    unsigned* qw = queue_word(F, l, chunk, 1); int pre = -1;
    for (;;) {
        int u = dequeue(F, qw, pre);
        if (u < N_MLA) {
            if (!(tmask & 1)) continue;
            const int qb = 7 - u / (NBC * 8), bh = u % (NBC * 8), b = bh >> 3, h = bh & 7;
            att::Desc d; const size_t r0 = (size_t)b * SEQ;
            d.Q = QM + r0 * 768 + h * 96; d.qpitch = 768; d.K1 = KVM + r0 * 1024 + h * 128; d.k1pitch = 1024; d.K2 = PROJ + r0 * PW + 384; d.k2pitch = PW;
            d.V = KVM + r0 * 1024 + h * 128 + 64; d.vpitch = 1024; d.O = (bf16_t*)((unsigned char*)OA + r0 * 512 + h * 64); d.opitch = 512; d.o8 = 1; d.lse = nullptr; d.lsepitch = 0; d.mask = nullptr;
            d.rstride = 1; d.q0 = qb * 256; d.nq = 256; d.jlo = 0; d.jhi = 4 * (qb + 1);
            att::attn_unit<96, 0>(F.lds, d); continue; }
        u -= N_MLA;
        if (u >= N_SEL) break;
        if (!(tmask & 4)) continue;
        idx::select_rows4((const float*)(F.ws + WS_SC), (unsigned*)(F.ws + WS_MASK), u * 32 + F.wave * 4, F.lane, (LAS unsigned*)(F.lds + L_GB) + F.wave * 64);
    }
}
__device__ __forceinline__ void phase_attn2(Frame& F, int l, int chunk) {
    PHASE_IDS(F);
    const bf16_t* PROJ = (const bf16_t*)(F.ws + WS_PROJ);
    bf16_t* OC = (bf16_t*)(F.ws + WS_OC);
    unsigned* qw = queue_word(F, l, chunk, 2); int pre = -1;
    for (;;) {
        const int u = dequeue(F, qw, pre);
        if (u >= NBC * 64) break;
        const int qb = 7 - u / (NBC * 8), bh = u % (NBC * 8), b = bh >> 3, h = bh & 7;
        att::Desc d; const size_t r0 = (size_t)b * SEQ;
        d.Q = PROJ + r0 * PW + 2816 + 64 * h; d.K1 = PROJ + r0 * PW + 3840; d.V = PROJ + r0 * PW + 3904; d.K2 = nullptr; d.qpitch = d.k1pitch = d.vpitch = PW; d.k2pitch = 0;
        d.O = (bf16_t*)((unsigned char*)OC + r0 * 512 + 64 * h); d.opitch = 512; d.o8 = 1; d.lse = nullptr; d.lsepitch = 0; d.mask = (const unsigned*)(F.ws + WS_MASK) + r0 * 64;
        d.rstride = 1; d.q0 = qb * 256; d.nq = 256; d.jlo = 0; d.jhi = 4 * (qb + 1);
        att::attn_unit<64, 2>(F.lds, d);
    }
    const bf16_t* OG = (const bf16_t*)(F.ws + WS_OG); const float* LSE = (const float*)(F.ws + WS_LSE); bf16_t* OB = (bf16_t*)(F.ws + WS_OB);
    const int gw = F.vcu * NWAVES + F.wave, NGW = F.G * NWAVES, h = F.lane >> 4;
    for (int row = gw; row < TC; row += NGW) {
        const float l0 = LSE[(size_t)row * 4 + h], l1 = LSE[((size_t)TC + row) * 4 + h], l2 = LSE[((size_t)2 * TC + row) * 4 + h];
        const float mx = fmaxf(l0, fmaxf(l1, l2));
        float w0 = __builtin_amdgcn_exp2f(l0 - mx), w1 = __builtin_amdgcn_exp2f(l1 - mx), w2 = __builtin_amdgcn_exp2f(l2 - mx);
        const float inv = 1.0f / (w0 + w1 + w2); w0 *= inv; w1 *= inv; w2 *= inv;
        const u32x2 a = *(const u32x2*)(OG + (size_t)row * 256 + F.lane * 4), bq = *(const u32x2*)(OG + ((size_t)TC + row) * 256 + F.lane * 4), c = *(const u32x2*)(OG + ((size_t)2 * TC + row) * 256 + F.lane * 4);
        w0 *= 32.f; w1 *= 32.f; w2 *= 32.f;
        *(unsigned*)((unsigned char*)OB + (size_t)row * 512 + F.lane * 4) = pk4_fp8(w0 * bflo(a.x) + w1 * bflo(bq.x) + w2 * bflo(c.x), w0 * bfhi(a.x) + w1 * bfhi(bq.x) + w2 * bfhi(c.x),
                                                                                    w0 * bflo(a.y) + w1 * bflo(bq.y) + w2 * bflo(c.y), w0 * bfhi(a.y) + w1 * bfhi(bq.y) + w2 * bfhi(c.y));
    }
}
constexpr int CW_DEP = 32768;
__device__ __forceinline__ void phase_attn(Frame& F, int l, int chunk) {
    PHASE_IDS(F);
    const bf16_t* PROJ = (const bf16_t*)(F.ws + WS_PROJ); const bf16_t* QM = (const bf16_t*)(F.ws + WS_QM); const bf16_t* KVM = (const bf16_t*)(F.ws + WS_KVM);
    bf16_t* OA = (bf16_t*)(F.ws + WS_OA); bf16_t* OC = (bf16_t*)(F.ws + WS_OC);
    constexpr int N_SEL = TC / 32, NQ = NBC * 8;
    unsigned* dep = (unsigned*)(F.ws + WS_CTL) + CW_DEP + (l * NCHUNK + chunk) * (NBC * 8);
    unsigned* qw = queue_word(F, l, chunk, 1); int pre = -1;
    for (;;) {
        int u = dequeue(F, qw, pre);
        if (u < N_SEL) {
            idx::select_rows4((const float*)(F.ws + WS_SC), (unsigned*)(F.ws + WS_MASK), u * 32 + F.wave * 4, F.lane, (LAS unsigned*)(F.lds + L_GB) + F.wave * 64);
            VM_WAIT();
            __syncthreads();
            if (F.tid == 0) { const int row = u * 32, b = row / SEQ, qb = (row % SEQ) >> 8;
                __builtin_amdgcn_fence(__ATOMIC_RELEASE, "agent");
                __hip_atomic_fetch_add(dep + b * 8 + qb, 1u, __ATOMIC_RELAXED, __HIP_MEMORY_SCOPE_AGENT); }
            continue; }
        u -= N_SEL;
        if (u >= 16 * NQ) break;
        const int qb = 7 - u / (2 * NQ), w = u % (2 * NQ);
        if (w < NQ) {
            const int b = w >> 3, h = w & 7;
            att::Desc d; const size_t r0 = (size_t)b * SEQ;
            d.Q = QM + r0 * 768 + h * 96; d.qpitch = 768; d.K1 = KVM + r0 * 1024 + h * 128; d.k1pitch = 1024; d.K2 = PROJ + r0 * PW + 384; d.k2pitch = PW;
            d.V = KVM + r0 * 1024 + h * 128 + 64; d.vpitch = 1024; d.O = (bf16_t*)((unsigned char*)OA + r0 * 512 + h * 64); d.opitch = 512; d.o8 = 1; d.lse = nullptr; d.lsepitch = 0; d.mask = nullptr;
            d.rstride = 1; d.q0 = qb * 256; d.nq = 256; d.jlo = 0; d.jhi = 4 * (qb + 1);
            att::attn_unit<96, 0>(F.lds, d);
        } else {
            const int bh = w - NQ, b = bh >> 3, h = bh & 7;
            if (F.tid == 0) { while (__hip_atomic_load(dep + b * 8 + qb, __ATOMIC_RELAXED, __HIP_MEMORY_SCOPE_AGENT) < 8u) __builtin_amdgcn_s_sleep(4);
                __builtin_amdgcn_fence(__ATOMIC_ACQUIRE, "agent"); }
            __syncthreads();
            att::Desc d; const size_t r0 = (size_t)b * SEQ;
            d.Q = PROJ + r0 * PW + 2816 + 64 * h; d.K1 = PROJ + r0 * PW + 3840; d.V = PROJ + r0 * PW + 3904; d.K2 = nullptr; d.qpitch = d.k1pitch = d.vpitch = PW; d.k2pitch = 0;
            d.O = (bf16_t*)((unsigned char*)OC + r0 * 512 + 64 * h); d.opitch = 512; d.o8 = 1; d.lse = nullptr; d.lsepitch = 0; d.mask = (const unsigned*)(F.ws + WS_MASK) + r0 * 64;
            d.rstride = 1; d.q0 = qb * 256; d.nq = 256; d.jlo = 0; d.jhi = 4 * (qb + 1);
            att::attn_unit<64, 2>(F.lds, d);
        }
    }
    const bf16_t* OG = (const bf16_t*)(F.ws + WS_OG); const float* LSE = (const float*)(F.ws + WS_LSE); bf16_t* OB = (bf16_t*)(F.ws + WS_OB);
    const int gw = F.vcu * NWAVES + F.wave, NGW = F.G * NWAVES, h = F.lane >> 4;
    for (int row0 = gw; row0 < TC; row0 += 4 * NGW) {
        float l0[4], l1[4], l2[4]; u32x2 a[4], bq[4], c[4]; int rows[4];
#pragma unroll
        for (int i = 0; i < 4; ++i) { const int row = row0 + i * NGW < TC ? row0 + i * NGW : row0; rows[i] = row;
            l0[i] = LSE[(size_t)row * 4 + h]; l1[i] = LSE[((size_t)TC + row) * 4 + h]; l2[i] = LSE[((size_t)2 * TC + row) * 4 + h];
            a[i] = *(const u32x2*)(OG + (size_t)row * 256 + F.lane * 4); bq[i] = *(const u32x2*)(OG + ((size_t)TC + row) * 256 + F.lane * 4); c[i] = *(const u32x2*)(OG + ((size_t)2 * TC + row) * 256 + F.lane * 4); }
#pragma unroll
        for (int i = 0; i < 4; ++i) {
            const float mx = fmaxf(l0[i], fmaxf(l1[i], l2[i]));
            float w0 = __builtin_amdgcn_exp2f(l0[i] - mx), w1 = __builtin_amdgcn_exp2f(l1[i] - mx), w2 = __builtin_amdgcn_exp2f(l2[i] - mx);
            const float inv = 32.0f / (w0 + w1 + w2); w0 *= inv; w1 *= inv; w2 *= inv;
            *(unsigned*)((unsigned char*)OB + (size_t)rows[i] * 512 + F.lane * 4) = pk4_fp8(w0 * bflo(a[i].x) + w1 * bflo(bq[i].x) + w2 * bflo(c[i].x), w0 * bfhi(a[i].x) + w1 * bfhi(bq[i].x) + w2 * bfhi(c[i].x),
                                                                                          w0 * bflo(a[i].y) + w1 * bflo(bq[i].y) + w2 * bflo(c[i].y), w0 * bfhi(a[i].y) + w1 * bfhi(bq[i].y) + w2 * bfhi(c[i].y));
        }
    }
}
__device__ __forceinline__ void phase_branches(Frame& F, int l, int chunk) {
    PHASE_IDS(F);
    static_assert(WS_OB - WS_OA == WS_OC - WS_OB && WS_WB - WS_WA == WS_WC - WS_WB, "equally spaced branch operands");
    BranchSched S{(const char*)(F.ws + WS_OA), (const char*)(F.ws + WS_WA), WS_OB - WS_OA, WS_WB - WS_WA, 256, 256, (int)blockIdx.x, F8_SW, 127 - 5, F.G, (TC / 256) * 4};
    EpiBranchAll E{(bf16_t*)(F.ws + WS_MERGED), (bf16_t*)(F.ws + WS_M0), (bf16_t*)(F.ws + WS_M1), (const bf16_t*)(F.ws + WS_G3)};
    pg8::gemm_phase<EpiBranchAll, BranchSched, true, true>(F.lds, 256, S, E);
}
__device__ __forceinline__ void phase_wo(Frame& F, int l, int chunk) {
    PHASE_IDS(F);
    pg8::DenseSched8 S{{(const bf16_t*)(F.ws + WS_MERGED), (const bf16_t*)(F.ws + WS_WO), DM / 2, DM / 2, TC / 256, 4, F.G, (int)blockIdx.x}, F8_SW, 127 - 6};
    EpiWo E{F.out, l == 0 ? F.in[0] : F.out, chunk * TC};
    pg8::gemm_phase<EpiWo, pg8::DenseSched8, true, true>(F.lds, DM / 2, S, E);
}

__global__ void __launch_bounds__(NTHREADS, 2) fwd_kernel(Args args) {
    extern __shared__ __attribute__((aligned(16))) unsigned char lds_raw[];
    Frame F;
    F.lds = (LAS unsigned char*)lds_raw;
    F.tid = threadIdx.x; F.lane = F.tid & 63; F.wave = __builtin_amdgcn_readfirstlane(F.tid >> 6);
    F.G = gridDim.x; { const int bx = blockIdx.x; F.vcu = (F.G % 8 == 0) ? (bx % 8) * (F.G / 8) + bx / 8 : bx; }
    F.in.p = (intab_t)__builtin_amdgcn_kernarg_segment_ptr(); F.out = args.out; F.ws = args.ws; F.out0 = args.out; F.ws0 = args.ws;
    for (int u = F.tid; u < (LDS_BYTES - L_CTL) / 4; u += NTHREADS) ((LAS unsigned*)(F.lds + L_CTL))[u] = 0u;
    __syncthreads();
    XcdBarrier bar = xcd_barrier_post((unsigned*)(F.ws + WS_CTL) + CW_BAR, (volatile LAS unsigned*)(F.lds + L_BARW));
#define GRID_BAR() xcd_barrier(bar)

    for (int l = 0; l < 2; ++l) {
        phase_conv_moe(F, l);
        phase_conv_mixer(F, l);
        GRID_BAR();
        for (int chunk = 0; chunk < NCHUNK; ++chunk) {
            phase_proj(F, l, chunk);
            GRID_BAR();
            if (DUPMASK & 2) { phase_proj(F, l, chunk); GRID_BAR(); }
            phase_up_scores(F, l, chunk);
            GRID_BAR();
            if (DUPMASK & 4) { phase_up_scores(F, l + 2, chunk); GRID_BAR(); }
            phase_attn(F, l, chunk);
            GRID_BAR();
            phase_branches(F, l, chunk);
            GRID_BAR();
            if (DUPMASK & 32) { phase_branches(F, l, chunk); GRID_BAR(); }
            phase_wo(F, l, chunk);
            if ((DUPMASK & 0x800) && l == 0) { GRID_BAR(); phase_wo(F, l, chunk); }
        }
        GRID_BAR();
        phase_ln1_router(F, l, F.out, false);
        GRID_BAR();
        phase_moe_scatter(F);
        GRID_BAR();
        phase_moe_gemm1(F);
        GRID_BAR();
        if (DUPMASK & 64) { phase_moe_gemm1(F); GRID_BAR(); }
        phase_moe_gemm2(F);
        GRID_BAR();
        if (DUPMASK & 128) { phase_moe_gemm2(F); GRID_BAR(); }
        phase_combine_ln2(F, l);
    }
}

extern "C" void kernel_launch(void* const* d_in, const int* in_sizes, int n_in, void* d_out, int out_size, void* d_ws, size_t ws_size, hipStream_t stream) {
    static int grid = 0;
    if (grid == 0) {
        if (n_in != 23 || out_size != TT * DM || ws_size < WS_END) { fprintf(stderr, "kernel_launch: unexpected shapes n_in %d out %d ws %zu\n", n_in, out_size, ws_size); grid = -1; return; }
        int dev = 0, cus = 0;
        if (hipGetDevice(&dev) != hipSuccess || hipDeviceGetAttribute(&cus, hipDeviceAttributeMultiprocessorCount, dev) != hipSuccess) { grid = -1; return; }
        if (hipFuncSetAttribute((const void*)fwd_kernel, hipFuncAttributeMaxDynamicSharedMemorySize, LDS_BYTES) != hipSuccess) { fprintf(stderr, "kernel_launch: hipFuncSetAttribute failed\n"); grid = -1; return; }
        int per_cu = 0;
        if (hipOccupancyMaxActiveBlocksPerMultiprocessor(&per_cu, (const void*)fwd_kernel, NTHREADS, LDS_BYTES) != hipSuccess || per_cu < 1) fprintf(stderr, "kernel_launch: occupancy query says %d\n", per_cu);
        (void)hipGetLastError();
        grid = cus;
    }
    if (grid < 0) return;
    if (hipMemsetAsync((char*)d_ws + WS_CTL, 0, CTL_ZERO_BYTES, stream) != hipSuccess) return;
    Args a{};
    for (int i = 0; i < 23; ++i) a.in[i] = (const float*)d_in[i];
    a.out = (float*)d_out; a.ws = (unsigned char*)d_ws;
    hipLaunchKernelGGL(fwd_kernel, dim3(grid), dim3(NTHREADS), LDS_BYTES, stream, a);
}
```

```cpp
#include <hip/hip_runtime.h>
#include <cstdio>
#include <cstdint>

#define LAS __attribute__((address_space(3)))
#define GAS __attribute__((address_space(1)))
typedef unsigned short bf16_t;
typedef short bf16x8 __attribute__((ext_vector_type(8)));
typedef float f32x4 __attribute__((ext_vector_type(4)));
typedef float f32x2 __attribute__((ext_vector_type(2)));
typedef float f32x16 __attribute__((ext_vector_type(16)));
typedef unsigned u32x4 __attribute__((ext_vector_type(4)));
typedef unsigned u32x2 __attribute__((ext_vector_type(2)));

constexpr int DM = 1024, NB = 32, SEQ = 2048, TT = NB * SEQ;
constexpr int NEXP = 32, DEXP = 256;
constexpr float LN_EPS = 1e-6f;
constexpr float ALPHA = 1.41421356237309515f;
constexpr int NWAVES = 8, NTHREADS = 512;

__device__ __forceinline__ unsigned f2bf(float f) { unsigned u = __builtin_bit_cast(unsigned, f); return (u + 0x7fffu + ((u >> 16) & 1u)) >> 16; }
__device__ __forceinline__ unsigned pk2(float lo, float hi) { return f2bf(lo) | (f2bf(hi) << 16); }
__device__ __forceinline__ float bf2f(unsigned short b) { return __builtin_bit_cast(float, (unsigned)b << 16); }
__device__ __forceinline__ float bflo(unsigned w) { return __builtin_bit_cast(float, w << 16); }
__device__ __forceinline__ float bfhi(unsigned w) { return __builtin_bit_cast(float, w & 0xffff0000u); }
typedef __bf16 bf16x2_t __attribute__((ext_vector_type(2)));
__device__ __forceinline__ unsigned cvt_pk_bf16(float lo, float hi) { const f32x2 v = {lo, hi}; const bf16x2_t b = __builtin_convertvector(v, bf16x2_t); return __builtin_bit_cast(unsigned, b); }
__device__ __forceinline__ float wave_sum(float v) {
#pragma unroll
    for (int o = 1; o < 64; o <<= 1) v += __shfl_xor(v, o);
    return v;
}
__device__ __forceinline__ float fast_exp(float x) { return __builtin_amdgcn_exp2f(x * 1.4426950408889634f); }
__device__ __forceinline__ float sigmoidf_(float x) { return __builtin_amdgcn_rcpf(1.0f + fast_exp(-x)); }
__device__ __forceinline__ unsigned pk4_fp8(float a, float b, float c, float d) {
    int p = __builtin_amdgcn_cvt_pk_fp8_f32(a, b, 0, false); p = __builtin_amdgcn_cvt_pk_fp8_f32(c, d, p, true); return (unsigned)p; }
__device__ __forceinline__ void store8_fp8(unsigned char* p, const f32x4& v0, const f32x4& v1, float sc) {
    u32x2 w; w.x = pk4_fp8(v0[0] * sc, v0[1] * sc, v0[2] * sc, v0[3] * sc); w.y = pk4_fp8(v1[0] * sc, v1[1] * sc, v1[2] * sc, v1[3] * sc); *(u32x2*)p = w;
}
#define LDS_WAIT() asm volatile("s_waitcnt lgkmcnt(0)" ::: "memory")
#define VM_WAIT() asm volatile("s_waitcnt vmcnt(0)" ::: "memory")

namespace pg8 {
constexpr int BM = 256, BK = 64, HALF = 128, HTB = HALF * BK * 2, STAGE_BYTES = 8 * HTB;
__device__ __forceinline__ int lds_byte(int r, int c) { return r * 128 + ((((c >> 3) ^ (r >> 1)) & 7) * 16) + (c & 7) * 2; }
__device__ __forceinline__ void stage_rc(int b, int& R, int& C) { R = b >> 7; C = ((((b >> 4) ^ (R >> 1)) & 7)) * 8; }
__device__ __forceinline__ int perm32(int rho) { const int n = rho >> 4, i = rho & 15; return 8 * (i >> 2) + 4 * n + (i & 3); }
struct Unit { int pm, pn, ord; };

template <class S, class = void> struct SchedVarK { static constexpr bool value = false; };
template <class S> struct SchedVarK<S, decltype((void)S::VARK)> { static constexpr bool value = S::VARK; };
typedef int v4i_t __attribute__((ext_vector_type(4)));
typedef int v8i_t __attribute__((ext_vector_type(8)));
__device__ __forceinline__ v8i_t cat8(const bf16x8& lo, const bf16x8& hi) { return __builtin_shufflevector(__builtin_bit_cast(v4i_t, lo), __builtin_bit_cast(v4i_t, hi), 0, 1, 2, 3, 4, 5, 6, 7); }
template <class Epi, class Sched, bool ALIGN_EPI, bool F8 = false>
__device__ __forceinline__ void gemm_phase(LAS unsigned char* lds, const int K, const Sched& S, const Epi& E) {
    int tid_ = threadIdx.x; asm volatile("" : "+v"(tid_));
    const int tid = tid_, wid = __builtin_amdgcn_readfirstlane(tid >> 6), lane = tid & 63, wr = wid >> 2, wc = wid & 3, fr = lane & 15, fq = lane >> 4;
    int nt = K / BK;
    int Rr[2], Cc[2]; unsigned vB[2][2];
#pragma unroll
    for (int i = 0; i < 2; ++i) { stage_rc(tid * 16 + i * 8192, Rr[i], Cc[i]); const int Rb = (Rr[i] & ~31) + perm32(Rr[i] & 31);
        vB[0][i] = (unsigned)(Rb * S.ldb + Cc[i]) * 2u; vB[1][i] = (unsigned)((HALF + Rb) * S.ldb + Cc[i]) * 2u; }
    const size_t kstep = (size_t)(BK * 2);
    const unsigned ldsw = (unsigned)wid * 1024u;
    const int aoff = lds_byte(wr * 64 + fr, fq * 8), boff = lds_byte(wc * 32 + fr, fq * 8);
    const int aoff1 = lds_byte(wr * 64 + fr, fq * 8 + 32), boff1 = lds_byte(wc * 32 + fr, fq * 8 + 32);
#define PG8_SA(b, h) (((b) * 2 + (h)) * HTB)
#define PG8_SB(b, h) ((4 + (b) * 2 + (h)) * HTB)
#define PG8_STAGE(bufoff, gbase, voff) do { _Pragma("unroll") for (int _i = 0; _i < 2; ++_i) \
        __builtin_amdgcn_global_load_lds((const unsigned*)((const char*)(gbase) + (voff)[_i]), (LAS unsigned*)(lds + (bufoff) + ldsw + _i * 8192), 16, 0, 0); } while (0)
#define PG8_LDA(dst, b, h) do { _Pragma("unroll") for (int m = 0; m < 4; ++m) { \
        const bf16x8 f0_ = *(const LAS bf16x8*)(lds + PG8_SA(b, h) + aoff + m * 2048), f1_ = *(const LAS bf16x8*)(lds + PG8_SA(b, h) + aoff1 + m * 2048); \
        if constexpr (F8) dst##8[m] = cat8(f0_, f1_); else { dst[m][0] = f0_; dst[m][1] = f1_; } } } while (0)
#define PG8_LDB(dst, b, h) do { _Pragma("unroll") for (int n = 0; n < 2; ++n) { \
        const bf16x8 f0_ = *(const LAS bf16x8*)(lds + PG8_SB(b, h) + boff + n * 2048), f1_ = *(const LAS bf16x8*)(lds + PG8_SB(b, h) + boff1 + n * 2048); \
        if constexpr (F8) dst##8[n] = cat8(f0_, f1_); else { dst[n][0] = f0_; dst[n][1] = f1_; } } } while (0)
#define PG8_MMA(ai, bj, At, Bt) do { __builtin_amdgcn_s_setprio(1); \
        if constexpr (F8) { _Pragma("unroll") for (int m = 0; m < 4; ++m) _Pragma("unroll") for (int n = 0; n < 2; ++n) \
            asm volatile("v_mfma_scale_f32_16x16x128_f8f6f4 %0, %1, %2, %0, %3, %4 op_sel_hi:[0,0,0]" : "+v"(acc[ai][bj][m][n]) : "v"(Bt##8[n]), "v"(At##8[m]), "v"(scw8), "v"(sca8)); } \
              \
        else { _Pragma("unroll") for (int m = 0; m < 4; ++m) _Pragma("unroll") for (int n = 0; n < 2; ++n) _Pragma("unroll") for (int k = 0; k < 2; ++k) \
            acc[ai][bj][m][n] = __builtin_amdgcn_mfma_f32_16x16x32_bf16(Bt[n][k], At[m][k], acc[ai][bj][m][n], 0, 0, 0); } \
        __builtin_amdgcn_s_setprio(0); } while (0)
#define PG8_WAIT_V(n) asm volatile("s_waitcnt vmcnt(" #n ")" ::: "memory")
#define PG8_WAIT_L(n) asm volatile("s_waitcnt lgkmcnt(" #n ")" ::: "memory")
#define PG8_BAR __builtin_amdgcn_s_barrier()
#define PG8_SCHED __builtin_amdgcn_sched_barrier(0)
    int scw8 = 0, sca8 = 0;
    if constexpr (F8) { scw8 = S.sw8 * 0x01010101; sca8 = S.sa8 * 0x01010101; }
    Unit cur, nxt; int ui = 0;
    if (!S.next(0, cur)) return;
    f32x4 acc[2][2][4][2];
#pragma unroll
    for (int a = 0; a < 2; ++a)
#pragma unroll
        for (int b = 0; b < 2; ++b)
#pragma unroll
            for (int m = 0; m < 4; ++m)
#pragma unroll
                for (int n = 0; n < 2; ++n) acc[a][b][m][n] = (f32x4){0.f, 0.f, 0.f, 0.f};
    bf16x8 At[4][2], B0[2][2], B1[2][2]; v8i_t At8[4], B08[2], B18[2];
    unsigned vAc[2][2], vAn[2][2];
    const char* cA = S.a_base(cur); const char* cB = S.b_base(cur);
    S.a_off(cur, Rr, Cc, vAc);
    if constexpr (SchedVarK<Sched>::value) nt = S.ktiles(cur);
    PG8_STAGE(PG8_SB(0, 0), cB, vB[0]); PG8_STAGE(PG8_SB(0, 1), cB, vB[1]); PG8_STAGE(PG8_SA(0, 0), cA, vAc[0]); PG8_STAGE(PG8_SA(0, 1), cA, vAc[1]);
    if (wr == 1) PG8_BAR;
    PG8_WAIT_V(2); PG8_BAR;
    PG8_STAGE(PG8_SB(1, 0), cB + kstep, vB[0]); PG8_STAGE(PG8_SA(1, 0), cA + kstep, vAc[0]); PG8_STAGE(PG8_SB(1, 1), cB + kstep, vB[1]);
    PG8_WAIT_V(6); PG8_BAR;
    bool epi_pend = false;
    for (;;) {
        const bool has_next = S.next(ui + 1, nxt);
        const char* nA = cA; const char* nB = cB;
        if constexpr (Sched::GATHER) {
#pragma unroll
            for (int h = 0; h < 2; ++h)
#pragma unroll
                for (int i = 0; i < 2; ++i) vAn[h][i] = vAc[h][i];
        }
        if (has_next) { nA = S.a_base(nxt); nB = S.b_base(nxt); if constexpr (Sched::GATHER) S.a_off(nxt, Rr, Cc, vAn); }
#pragma nounroll
        for (int t = 0; t < nt; t += 2) {
            const bool last = (t == nt - 2);
            const bool ep_ = epi_pend && t == 0;
            const char* a1 = cA + (size_t)(t + 1) * kstep;
            const char* a2 = last ? nA : cA + (size_t)(t + 2) * kstep; const char* b2 = last ? nB : cB + (size_t)(t + 2) * kstep;
            const char* a3 = a2 + kstep; const char* b3 = b2 + kstep;
            unsigned vA2[2][2];
#pragma unroll
            for (int h = 0; h < 2; ++h)
#pragma unroll
                for (int i = 0; i < 2; ++i) { if constexpr (Sched::GATHER) vA2[h][i] = last ? vAn[h][i] : vAc[h][i]; else vA2[h][i] = vAc[h][i]; }
            PG8_LDB(B0, 0, 0); PG8_LDB(B1, 0, 1); PG8_SCHED; PG8_LDA(At, 0, 0); PG8_STAGE(PG8_SA(1, 1), a1, vAc[1]);
            if (ep_) { PG8_WAIT_V(24); } else { PG8_WAIT_V(8); } PG8_WAIT_L(0); PG8_BAR; PG8_MMA(0, 0, At, B0); PG8_MMA(0, 1, At, B1); PG8_BAR; PG8_SCHED;
            PG8_LDA(At, 0, 1); PG8_STAGE(PG8_SB(0, 0), b2, vB[0]); PG8_STAGE(PG8_SB(0, 1), b2, vB[1]); PG8_STAGE(PG8_SA(0, 0), a2, vA2[0]);
            if (ep_) { PG8_WAIT_V(24); } else { PG8_WAIT_V(8); } PG8_WAIT_L(0); PG8_BAR; PG8_MMA(1, 0, At, B0); PG8_MMA(1, 1, At, B1); PG8_BAR; PG8_SCHED;
            PG8_LDB(B0, 1, 0); PG8_LDB(B1, 1, 1); PG8_SCHED; PG8_LDA(At, 1, 0); PG8_STAGE(PG8_SA(0, 1), a2, vA2[1]);
            PG8_WAIT_V(8); PG8_WAIT_L(0); PG8_BAR; PG8_MMA(0, 0, At, B0); PG8_MMA(0, 1, At, B1); PG8_BAR; PG8_SCHED;
            PG8_LDA(At, 1, 1); PG8_STAGE(PG8_SB(1, 0), b3, vB[0]); PG8_STAGE(PG8_SB(1, 1), b3, vB[1]); PG8_STAGE(PG8_SA(1, 0), a3, vA2[0]);
            PG8_WAIT_V(8); PG8_WAIT_L(0); PG8_BAR; PG8_MMA(1, 0, At, B0); PG8_MMA(1, 1, At, B1); PG8_BAR; PG8_SCHED;
        }
        if constexpr (ALIGN_EPI) { if (wr == 0) PG8_BAR; }
        if constexpr (F8) asm volatile("s_nop 15\n\ts_nop 15" ::: "memory");
        { int l2_ = lane; asm volatile("" : "+v"(l2_)); E(acc, cur, wr, wc, l2_ & 15, l2_ >> 4); }
        if (!has_next) break;
        epi_pend = true;
#pragma unroll
        for (int a = 0; a < 2; ++a)
#pragma unroll
            for (int b = 0; b < 2; ++b)
#pragma unroll
                for (int m = 0; m < 4; ++m)
#pragma unroll
                    for (int n = 0; n < 2; ++n) acc[a][b][m][n] = (f32x4){0.f, 0.f, 0.f, 0.f};
        cur = nxt; cA = nA; cB = nB; ++ui;
        if constexpr (SchedVarK<Sched>::value) nt = S.ktiles(cur);
        if constexpr (Sched::GATHER) {
#pragma unroll
            for (int h = 0; h < 2; ++h)
#pragma unroll
                for (int i = 0; i < 2; ++i) vAc[h][i] = vAn[h][i];
        }
        if constexpr (ALIGN_EPI) { if (wr == 1) PG8_BAR; }
    }
    PG8_WAIT_V(0);
    if constexpr (!ALIGN_EPI) { if (wr == 0) PG8_BAR; }
    asm volatile("s_waitcnt vmcnt(0) lgkmcnt(0)\n\ts_barrier" ::: "memory");
    __builtin_amdgcn_sched_barrier(0);
#undef PG8_SA
#undef PG8_SB
#undef PG8_STAGE
#undef PG8_LDA
#undef PG8_LDB
#undef PG8_MMA
#undef PG8_WAIT_V
#undef PG8_WAIT_L
#undef PG8_BAR
#undef PG8_SCHED
}

struct DenseSched {
    static constexpr bool GATHER = false;
    const bf16_t* A; const bf16_t* Bt; int lda, ldb, nM, nN, G, c;
    __device__ __forceinline__ bool next(int i, Unit& u) const { const int v = i * G + c; if (v >= nM * nN) return false; u.pm = v / nN; u.pn = v % nN; u.ord = i; return true; }
    __device__ __forceinline__ const char* a_base(const Unit& u) const { return (const char*)(A + (size_t)u.pm * BM * lda); }
    __device__ __forceinline__ const char* b_base(const Unit& u) const { return (const char*)(Bt + (size_t)u.pn * BM * ldb); }
    __device__ __forceinline__ void a_off(const Unit&, const int (&R)[2], const int (&C)[2], unsigned (&v)[2][2]) const {
#pragma unroll
        for (int i = 0; i < 2; ++i) { v[0][i] = (unsigned)(R[i] * lda + C[i]) * 2u; v[1][i] = (unsigned)((HALF + R[i]) * lda + C[i]) * 2u; }
    }
};
struct DenseSched8 : DenseSched { int sw8, sa8; };
struct ProjSched8 : DenseSched8 {
    __device__ __forceinline__ bool next(int i, Unit& u) const {
        if (nN != 28 || (nM & 1) || (G & 7)) return DenseSched::next(i, u);
        const int x = c & 7, wl = i * (G >> 3) + (c >> 3), half = nM >> 1;
        if (wl >= half * 7) return false;
        u.pm = (x >> 2) * half + wl / 7; u.pn = 7 * (x & 3) + wl % 7; u.ord = i; return true;
    }
};
}

#define XB_TMO      128
#define XB_XCNT(j)  (256  + 64 * (j))
#define XB_XSUB(j)  (1280 + 64 * (j))
#define XB_XGEN(j)  (2304 + 64 * (j))
#define XB_TOP      3328
#define XB_TOPGEN   3392
#define XCD_BAR_WORDS 3456
#define XB_SPIN_CAP (1u << 18)
__device__ __forceinline__ unsigned xb_ld(unsigned* p)              { return __hip_atomic_load(p, __ATOMIC_RELAXED, __HIP_MEMORY_SCOPE_AGENT); }
__device__ __forceinline__ unsigned xb_add(unsigned* p, unsigned v) { return __hip_atomic_fetch_add(p, v, __ATOMIC_RELAXED, __HIP_MEMORY_SCOPE_AGENT); }
__device__ __forceinline__ unsigned xb_xcc_id() { return (unsigned)__builtin_amdgcn_s_getreg((3 << 11) | 20) & 0xFu; }
#define XB_SPIN(cond, bar) do { unsigned _sp = 0; while (cond) { __builtin_amdgcn_s_sleep(1); \
    if ((++_sp & 255u) == 0u) { if (xb_ld(&(bar)[XB_TMO])) break; if (_sp > XB_SPIN_CAP) { atomicAdd(&(bar)[XB_TMO], 1u); break; } } } } while (0)
struct XcdBarrier { unsigned* bar; unsigned x; volatile LAS unsigned* st; };
__device__ __forceinline__ XcdBarrier xcd_barrier_post(unsigned* bar, volatile LAS unsigned* st) {
    XcdBarrier b; b.bar = bar; b.x = xb_xcc_id(); b.st = st;
    if (threadIdx.x == 0) (void)xb_add(&bar[XB_XCNT(b.x)], 1u);
    return b;
}
__device__ __forceinline__ void xcd_barrier_complete(unsigned* bar, unsigned x, unsigned& nloc, unsigned& nx) {
    const unsigned G = gridDim.x * gridDim.y * gridDim.z;
    unsigned sum, cnt, mine, sp = 0u;
    for (;;) {
        sum = 0u; cnt = 0u; mine = 0u;
#pragma unroll
        for (unsigned j = 0; j < 16; ++j) { const unsigned c = xb_ld(&bar[XB_XCNT(j)]); sum += c; cnt += (c > 0u) ? 1u : 0u; mine = (j == x) ? c : mine; }
        if (sum == G) break;
        __builtin_amdgcn_s_sleep(1);
        if ((++sp & 255u) == 0u) { if (xb_ld(&bar[XB_TMO])) break; if (sp > XB_SPIN_CAP) { atomicAdd(&bar[XB_TMO], 1u); break; } }
    }
    nloc = mine > 0u ? mine : 1u; nx = cnt > 0u ? cnt : 1u;
}
__device__ __forceinline__ void xcd_barrier(const XcdBarrier& b) {
    asm volatile("s_waitcnt vmcnt(0)" ::: "memory");
    __syncthreads();
    if (threadIdx.x == 0) {
        unsigned* bar = b.bar;
        __builtin_amdgcn_s_waitcnt(0);
        unsigned nloc = b.st[0], nx = b.st[1];
        if (nloc == 0u) { xcd_barrier_complete(bar, b.x, nloc, nx); b.st[0] = nloc; b.st[1] = nx; }
        const unsigned old = xb_add(&bar[XB_XSUB(b.x)], 1u);
        const unsigned gen = old / nloc;
        if (old + 1u == (gen + 1u) * nloc) {
            __builtin_amdgcn_fence(__ATOMIC_RELEASE, "agent");
            asm volatile("s_waitcnt vmcnt(0)" ::: "memory");
            const unsigned og = xb_add(&bar[XB_TOP], 1u);
            const unsigned tg = og / nx;
            if (og + 1u == (tg + 1u) * nx) xb_add(&bar[XB_TOPGEN], 1u);
            else XB_SPIN(xb_ld(&bar[XB_TOPGEN]) == tg, bar);
            __builtin_amdgcn_fence(__ATOMIC_ACQUIRE, "agent");
            xb_add(&bar[XB_XGEN(b.x)], 1u);
            asm volatile("s_waitcnt vmcnt(0)" ::: "memory");
        } else {
            XB_SPIN(xb_ld(&bar[XB_XGEN(b.x)]) == gen, bar);
            __builtin_amdgcn_fence(__ATOMIC_ACQUIRE, "agent");
            asm volatile("s_waitcnt vmcnt(0)" ::: "memory");
        }
    }
    __syncthreads();
}

constexpr size_t MiB = 1u << 20;
constexpr size_t WS_CTL = 0, CTL_ZERO_BYTES = 1 * MiB;
constexpr int CW_BAR = 4096;
constexpr int CW_QUEUE = 16384;
constexpr size_t WS_W13 = 2 * MiB;
constexpr size_t WS_W2  = 34 * MiB;
constexpr size_t WS_WR  = 50 * MiB;
constexpr size_t WS_MISC = 51 * MiB;
constexpr size_t WS_ROUTE = 52 * MiB;
constexpr size_t WS_RPOS = 53 * MiB;
constexpr size_t WS_ROWTOK = 54 * MiB;
constexpr size_t WS_ROPE = 55 * MiB;
constexpr size_t WS_WUQ = 56 * MiB;
constexpr size_t WS_WUKV = 57 * MiB;
constexpr size_t WS_WA = 58 * MiB;
constexpr size_t WS_WB = 59 * MiB;
constexpr size_t WS_WC = 60 * MiB;
constexpr size_t WS_WO = 61 * MiB;
constexpr size_t WS_SSQ = 63 * MiB;
constexpr size_t WS_LSE = 64 * MiB;
constexpr size_t WS_MASK = 66 * MiB;
constexpr size_t WS_XB8 = 74 * MiB;
constexpr size_t WS_WIN8 = 138 * MiB;
constexpr size_t WS_H = 146 * MiB;
constexpr size_t WS_Y = 182 * MiB;
constexpr size_t WS_SC = WS_Y;
constexpr size_t WS_G3 = 254 * MiB;
constexpr size_t WS_PROJ = 350 * MiB;
constexpr size_t WS_QM = 606 * MiB;
constexpr size_t WS_KVM = 654 * MiB;
constexpr size_t WS_OA = 718 * MiB;
constexpr size_t WS_OB = 734 * MiB;
constexpr size_t WS_OC = 750 * MiB;
constexpr size_t WS_OG = 766 * MiB;
constexpr size_t WS_M0 = 814 * MiB;
constexpr size_t WS_M1 = 846 * MiB;
constexpr size_t WS_MERGED = 878 * MiB;
constexpr size_t WS_END = 910 * MiB;
constexpr int F8_SA_X = 127 - 4, F8_SW = 127 - 10;
constexpr int MAXROWS = 139264;
constexpr int NBC = 16, TC = NBC * SEQ, NCHUNK = NB / NBC;
constexpr int CIN = 3944, PW = 4096;

constexpr int MI_BLOCKCNT = 0;
constexpr int MI_PANEL_E = 8192;
constexpr int MI_NPAN = 8192 + 1024;

constexpr int RING_BYTES = 131072;
constexpr int L_CTL = RING_BYTES;
constexpr int L_BARW = L_CTL + 32;
constexpr int L_HIST = L_CTL + 256;
constexpr int L_TOT  = L_CTL + 384;
constexpr int L_PRE  = L_CTL + 512;
constexpr int L_BASE = L_CTL + 640;
constexpr int L_RANK = L_CTL + 896;
constexpr int L_PE   = L_CTL + 1024;
constexpr int L_ROWS = L_CTL + 2048;
constexpr int LDS_BYTES = 147456;
constexpr int L_GB = L_ROWS;
static_assert(L_ROWS + 12288 <= LDS_BYTES, "LDS map");

#ifndef DUPMASK
#define DUPMASK 0
#endif
struct Args { const float* in[23]; float* out; unsigned char* ws; };
#define PHASE_IDS(F) do { int t_ = threadIdx.x; asm volatile("" : "+v"(t_)); (F).tid = t_; (F).lane = t_ & 63; { intab_t p_ = (intab_t)__builtin_amdgcn_kernarg_segment_ptr(); asm volatile("" : "+s"(p_)); (F).in.p = p_; } \
    { unsigned char GAS* w_ = (unsigned char GAS*)(F).ws0; asm volatile("" : "+s"(w_)); (F).ws = (unsigned char*)w_; float GAS* o_ = (float GAS*)(F).out0; asm volatile("" : "+s"(o_)); (F).out = (float*)o_; } } while (0)

typedef const float GAS* gfptr_t;
typedef const gfptr_t __attribute__((address_space(4)))* intab_t;
struct InTab { intab_t p; __device__ __forceinline__ const float* operator[](int i) const { return (const float*)p[i]; } };
struct Frame {
    LAS unsigned char* lds;
    int tid, lane, wave, vcu, G;
    InTab in; float* out; unsigned char* ws; float* out0; unsigned char* ws0;
};

template <class F>
__device__ __forceinline__ void conv_item(bf16_t* WT, int ldk, int k0, int n0, LAS float* scr, int lane, F val) {
#pragma unroll 8
    for (int i = 0; i < 32; ++i) { const int kk = 2 * i + (lane >> 5); scr[kk * 33 + (lane & 31)] = val(k0 + kk, n0 + (lane & 31)); }
    LDS_WAIT(); asm volatile("" ::: "memory");
    const int c = lane & 7;
#pragma unroll
    for (int j = 0; j < 4; ++j) { const int n = (lane >> 3) + 8 * j; const LAS float* s = scr + (8 * c) * 33 + n;
        u32x4 o; o.x = pk2(s[0 * 33], s[1 * 33]); o.y = pk2(s[2 * 33], s[3 * 33]); o.z = pk2(s[4 * 33], s[5 * 33]); o.w = pk2(s[6 * 33], s[7 * 33]);
        *(u32x4*)(WT + (size_t)(n0 + n) * ldk + k0 + 8 * c) = o; }
    LDS_WAIT(); asm volatile("" ::: "memory");
}

template <class F>
__device__ __forceinline__ void conv_item8(unsigned char* WT, int ldk, int k0, int n0, LAS float* scr, int lane, F val) {
#pragma unroll 8
    for (int i = 0; i < 32; ++i) { const int kk = 2 * i + (lane >> 5); scr[kk * 33 + (lane & 31)] = val(k0 + kk, n0 + (lane & 31)); }
    LDS_WAIT(); asm volatile("" ::: "memory");
    const int c = lane & 7;
#pragma unroll
    for (int j = 0; j < 4; ++j) { const int n = (lane >> 3) + 8 * j; const LAS float* s = scr + (8 * c) * 33 + n;
        u32x2 o; o.x = pk4_fp8(s[0 * 33], s[1 * 33], s[2 * 33], s[3 * 33]); o.y = pk4_fp8(s[4 * 33], s[5 * 33], s[6 * 33], s[7 * 33]);
        *(u32x2*)(WT + (size_t)(n0 + n) * ldk + k0 + 8 * c) = o; }
    LDS_WAIT(); asm volatile("" ::: "memory");
}

__device__ __forceinline__ void conv_plain8(unsigned char* WT, int ldk, int k0, int n0, LAS float* scr, int lane, const float* src, int pitch, float sc) {
    f32x4 v[8];
#pragma unroll
    for (int i = 0; i < 8; ++i) v[i] = *(const f32x4*)(src + (size_t)(k0 + (lane >> 3) + 8 * i) * pitch + n0 + (lane & 7) * 4);
#pragma unroll
    for (int i = 0; i < 8; ++i) { LAS float* d = scr + ((lane >> 3) + 8 * i) * 33 + (lane & 7) * 4; d[0] = v[i][0] * sc; d[1] = v[i][1] * sc; d[2] = v[i][2] * sc; d[3] = v[i][3] * sc; }
    LDS_WAIT(); asm volatile("" ::: "memory");
    const int c = lane & 7;
#pragma unroll
    for (int j = 0; j < 4; ++j) { const int n = (lane >> 3) + 8 * j; const LAS float* s = scr + (8 * c) * 33 + n;
        u32x2 o; o.x = pk4_fp8(s[0 * 33], s[1 * 33], s[2 * 33], s[3 * 33]); o.y = pk4_fp8(s[4 * 33], s[5 * 33], s[6 * 33], s[7 * 33]);
        *(u32x2*)(WT + (size_t)(n0 + n) * ldk + k0 + 8 * c) = o; }
    LDS_WAIT(); asm volatile("" ::: "memory");
}
__device__ __forceinline__ void conv_pair8(unsigned char* WT, int ldk, int k0, int n0, LAS float* scr, int lane, const float* a, const float* b, int pitch, float sc) {
    f32x2 va[8], vb[8];
#pragma unroll
    for (int i = 0; i < 8; ++i) { const size_t o = (size_t)(k0 + (lane >> 3) + 8 * i) * pitch + (n0 >> 1) + (lane & 7) * 2; va[i] = *(const f32x2*)(a + o); vb[i] = *(const f32x2*)(b + o); }
#pragma unroll
    for (int i = 0; i < 8; ++i) { LAS float* d = scr + ((lane >> 3) + 8 * i) * 33 + (lane & 7) * 4; d[0] = va[i][0] * sc; d[1] = vb[i][0] * sc; d[2] = va[i][1] * sc; d[3] = vb[i][1] * sc; }
    LDS_WAIT(); asm volatile("" ::: "memory");
    const int c = lane & 7;
#pragma unroll
    for (int j = 0; j < 4; ++j) { const int n = (lane >> 3) + 8 * j; const LAS float* s = scr + (8 * c) * 33 + n;
        u32x2 o; o.x = pk4_fp8(s[0 * 33], s[1 * 33], s[2 * 33], s[3 * 33]); o.y = pk4_fp8(s[4 * 33], s[5 * 33], s[6 * 33], s[7 * 33]);
        *(u32x2*)(WT + (size_t)(n0 + n) * ldk + k0 + 8 * c) = o; }
    LDS_WAIT(); asm volatile("" ::: "memory");
}

__device__ __forceinline__ void phase_conv_moe(Frame& F, int l) {
    PHASE_IDS(F);
    LAS float* scr = (LAS float*)(F.lds + F.wave * 16384);
    const int gw = F.vcu * NWAVES + F.wave, NGW = F.G * NWAVES;
    const float* w1 = F.in[18] + (size_t)l * NEXP * DM * DEXP;
    const float* w3 = F.in[19] + (size_t)l * NEXP * DM * DEXP;
    const float* w2 = F.in[20] + (size_t)l * NEXP * DEXP * DM;
    bf16_t* W13 = (bf16_t*)(F.ws + WS_W13); bf16_t* W2 = (bf16_t*)(F.ws + WS_W2);
    constexpr int I13 = (DM / 64) * (512 / 32);
    constexpr int I2 = (DEXP / 64) * (DM / 32);
    for (int it = gw; it < NEXP * (I13 + I2); it += NGW) {
        if (it < NEXP * I13) {
            const int e = it / I13, r = it % I13, kb = r / 16, nb = r % 16;
            const float* a = w1 + (size_t)e * DM * DEXP; const float* b = w3 + (size_t)e * DM * DEXP;
            conv_pair8((unsigned char*)W13 + (size_t)e * 512 * DM, DM, kb * 64, nb * 32, scr, F.lane, a, b, DEXP, 1024.f);
        } else {
            const int it2 = it - NEXP * I13; const int e = it2 / I2, r = it2 % I2, kb = r / 32, nb = r % 32;
            const float* a = w2 + (size_t)e * DEXP * DM;
            conv_plain8((unsigned char*)W2 + (size_t)e * DM * DEXP, DEXP, kb * 64, nb * 32, scr, F.lane, a, DM, 1024.f);
        }
    }
    const float* wg = F.in[14] + (size_t)l * DM * 4; const float* wsb = F.in[16] + (size_t)l * DM * NEXP;
    const float* g1 = F.in[12] + (size_t)l * DM; const float* b1 = F.in[13] + (size_t)l * DM;
    bf16_t* WRH = (bf16_t*)(F.ws + WS_WR); bf16_t* WRL = (bf16_t*)(F.ws + WS_WR + 128 * 1024); float* WRC = (float*)(F.ws + WS_WR + 256 * 1024);
    for (int idx = (F.vcu * NTHREADS + F.tid); idx < 64 * DM; idx += F.G * NTHREADS) {
        const int c = idx / DM, k = idx % DM;
        const float v = (c < 32 ? wsb[(size_t)k * NEXP + c] : (c < 36 ? wg[(size_t)k * 4 + (c - 32)] : 0.f)) * g1[k];
        const unsigned h = f2bf(v); const int it = k >> 5, hi_ = (k >> 4) & 1, st = (k >> 3) & 1, e = k & 7, ln = (c & 31) + 32 * hi_, p0 = 2 * (c >> 5);
        WRH[((((size_t)it * 4 + p0) * 2 + st) * 64 + ln) * 8 + e] = (bf16_t)h;
        WRH[((((size_t)it * 4 + p0 + 1) * 2 + st) * 64 + ln) * 8 + e] = (bf16_t)f2bf(v - __builtin_bit_cast(float, h << 16)); (void)WRL;
    }
    if (gw < 64) {
        const int c = gw; float s1 = 0.f, s2 = 0.f;
        for (int k = F.lane; k < DM; k += 64) { const float w = c < 32 ? wsb[(size_t)k * NEXP + c] : (c < 36 ? wg[(size_t)k * 4 + (c - 32)] : 0.f); s1 += g1[k] * w; s2 += b1[k] * w; }
        s1 = wave_sum(s1); s2 = wave_sum(s2);
        const float bias = c < 32 ? F.in[17][(size_t)l * NEXP + c] : (c < 36 ? F.in[15][(size_t)l * 4 + (c - 32)] : 0.f);
        if (F.lane == 0) { WRC[c] = s1; WRC[64 + c] = s2 + bias; }
    }
}

__device__ __forceinline__ void ln_row(f32x4 (&v)[4], const f32x4 (&g)[4], const f32x4 (&b)[4], float* omean = nullptr, float* orstd = nullptr) {
    float s = 0.f;
#pragma unroll
    for (int j = 0; j < 4; ++j) s += (v[j].x + v[j].y) + (v[j].z + v[j].w);
    const float mean = wave_sum(s) * (1.f / DM); float s2 = 0.f;
#pragma unroll
    for (int j = 0; j < 4; ++j) { v[j] = v[j] - mean; s2 += (v[j].x * v[j].x + v[j].y * v[j].y) + (v[j].z * v[j].z + v[j].w * v[j].w); }
    const float rstd = 1.0f / sqrtf(wave_sum(s2) * (1.f / DM) + LN_EPS);
#pragma unroll
    for (int j = 0; j < 4; ++j) v[j] = v[j] * rstd * g[j] + b[j];
    if (omean) { *omean = mean; *orstd = rstd; }
}
__device__ __forceinline__ void store_row(const f32x4 (&v)[4], float* orow, unsigned char* brow, int lane) {
#pragma unroll
    for (int j = 0; j < 4; ++j) {
        ((f32x4*)orow)[lane + 64 * j] = v[j];
        ((unsigned*)brow)[lane + 64 * j] = pk4_fp8(v[j].x * 16.f, v[j].y * 16.f, v[j].z * 16.f, v[j].w * 16.f);
    }
}

__device__ __forceinline__ void phase_ln1_router(Frame& F, int l, const float* src, bool scale_alpha) {
    PHASE_IDS(F);
    const int lane = F.lane, hi = lane >> 5, r32 = lane & 31;
    const float* lg = F.in[12] + (size_t)l * DM; const float* lb = F.in[13] + (size_t)l * DM;
    f32x4 g[4], b[4];
#pragma unroll
    for (int j = 0; j < 4; ++j) { g[j] = ((const f32x4*)lg)[lane + 64 * j]; b[j] = ((const f32x4*)lb)[lane + 64 * j]; }
    unsigned char* XB = F.ws + WS_XB8;
    const bf16_t* WRH = (const bf16_t*)(F.ws + WS_WR); const bf16_t* WRL = (const bf16_t*)(F.ws + WS_WR + 128 * 1024);
    const float* WRC = (const float*)(F.ws + WS_WR + 256 * 1024); float* stats = (float*)(F.ws + WS_WR + 512 * 1024);
    unsigned* misc = (unsigned*)(F.ws + WS_MISC);
    int* route = (int*)(F.ws + WS_ROUTE);
    LAS unsigned* hist = (LAS unsigned*)(F.lds + L_HIST);
    const float sc = scale_alpha ? ALPHA : 1.0f;
    for (int blk = F.vcu; blk < TT / 256; blk += F.G) {
        if (F.tid < 32) hist[F.tid] = 0u;
        __syncthreads();
        const int row0 = blk * 256 + F.wave * 32;
        float mu_l = 0.f, rs_l = 1.f;
        for (int i = 0; i < 32; i += 2) {
            f32x4 v0[4], v1[4];
            const f32x4* p0 = (const f32x4*)(src + (size_t)(row0 + i) * DM); const f32x4* p1 = (const f32x4*)(src + (size_t)(row0 + i + 1) * DM);
#pragma unroll
            for (int j = 0; j < 4; ++j) { v0[j] = p0[lane + 64 * j] * sc; v1[j] = p1[lane + 64 * j] * sc; }
            float m0, r0, m1, r1;
            ln_row(v0, g, b, &m0, &r0); ln_row(v1, g, b, &m1, &r1);
            mu_l = (r32 == i) ? m0 : ((r32 == i + 1) ? m1 : mu_l); rs_l = (r32 == i) ? r0 : ((r32 == i + 1) ? r1 : rs_l);
#pragma unroll
            for (int j = 0; j < 4; ++j) {
                ((unsigned*)(XB + (size_t)(row0 + i) * DM))[lane + 64 * j] = pk4_fp8(v0[j].x * 16.f, v0[j].y * 16.f, v0[j].z * 16.f, v0[j].w * 16.f);
                ((unsigned*)(XB + (size_t)(row0 + i + 1) * DM))[lane + 64 * j] = pk4_fp8(v1[j].x * 16.f, v1[j].y * 16.f, v1[j].z * 16.f, v1[j].w * 16.f); }
        }
        if (hi == 0) *(f32x2*)(stats + (size_t)(row0 + r32) * 2) = (f32x2){mu_l, rs_l};
        f32x16 acc0 = {}, acc1 = {};
        {
            const bf16_t* WT = WRH; (void)WRL;
            LAS float* xs = (LAS float*)(F.lds + F.wave * 9216);
            const float* xg = src + (size_t)(row0 + (lane >> 3)) * DM + (lane & 7) * 4;
            f32x4 xv[4]; bf16x8 wv[8];
#pragma unroll
            for (int i = 0; i < 4; ++i) xv[i] = *(const f32x4*)(xg + (size_t)(8 * i) * DM);
#pragma unroll
            for (int q = 0; q < 8; ++q) wv[q] = *(const bf16x8*)(WT + ((size_t)q * 64 + lane) * 8);
#pragma unroll 2
            for (int it = 0; it < 32; ++it) {
                LAS float* xb = xs + (it & 1) * 1152;
#pragma unroll
                for (int i = 0; i < 4; ++i) *(LAS f32x4*)(xb + ((lane >> 3) + 8 * i) * 36 + (lane & 7) * 4) = xv[i];
                bf16x8 wc[8];
#pragma unroll
                for (int q = 0; q < 8; ++q) wc[q] = wv[q];
                { const int nx = it + 1 < 32 ? it + 1 : 31;
#pragma unroll
                  for (int i = 0; i < 4; ++i) xv[i] = *(const f32x4*)(xg + (size_t)(8 * i) * DM + nx * 32);
#pragma unroll
                  for (int q = 0; q < 8; ++q) wv[q] = *(const bf16x8*)(WT + (((size_t)nx * 8 + q) * 64 + lane) * 8); }
                f32x4 xa[4];
#pragma unroll
                for (int j = 0; j < 4; ++j) xa[j] = *(const LAS f32x4*)(xb + r32 * 36 + hi * 16 + 4 * j);
#pragma unroll
                for (int st = 0; st < 2; ++st) {
                    const f32x4 x0 = xa[2 * st], x1 = xa[2 * st + 1];
                    u32x4 xh, xl;
                    xh.x = cvt_pk_bf16(x0[0], x0[1]); xh.y = cvt_pk_bf16(x0[2], x0[3]); xh.z = cvt_pk_bf16(x1[0], x1[1]); xh.w = cvt_pk_bf16(x1[2], x1[3]);
                    xl.x = cvt_pk_bf16(x0[0] - bflo(xh.x), x0[1] - bfhi(xh.x)); xl.y = cvt_pk_bf16(x0[2] - bflo(xh.y), x0[3] - bfhi(xh.y));
                    xl.z = cvt_pk_bf16(x1[0] - bflo(xh.z), x1[1] - bfhi(xh.z)); xl.w = cvt_pk_bf16(x1[2] - bflo(xh.w), x1[3] - bfhi(xh.w));
                    const bf16x8 xhv = __builtin_bit_cast(bf16x8, xh), xlv = __builtin_bit_cast(bf16x8, xl);
                    acc0 = __builtin_amdgcn_mfma_f32_32x32x16_bf16(wc[0 + st], xhv, acc0, 0, 0, 0); acc1 = __builtin_amdgcn_mfma_f32_32x32x16_bf16(wc[4 + st], xhv, acc1, 0, 0, 0);
                    acc0 = __builtin_amdgcn_mfma_f32_32x32x16_bf16(wc[2 + st], xhv, acc0, 0, 0, 0); acc1 = __builtin_amdgcn_mfma_f32_32x32x16_bf16(wc[6 + st], xhv, acc1, 0, 0, 0);
                    acc0 = __builtin_amdgcn_mfma_f32_32x32x16_bf16(wc[0 + st], xlv, acc0, 0, 0, 0); acc1 = __builtin_amdgcn_mfma_f32_32x32x16_bf16(wc[4 + st], xlv, acc1, 0, 0, 0);
                }
            }
        }
        float gl[4];
#pragma unroll
        for (int i = 0; i < 4; ++i) gl[i] = rs_l * (acc1[i] - mu_l * WRC[32 + i]) + WRC[64 + 32 + i];
        int gidx = 0; float gmax = gl[0];
#pragma unroll
        for (int i = 1; i < 4; ++i) if (gl[i] > gmax) { gmax = gl[i]; gidx = i; }
        float gsum = 0.f;
#pragma unroll
        for (int i = 0; i < 4; ++i) gsum += fast_exp(gl[i] - gmax);
        float gp = 1.0f / gsum;
        gidx = __shfl(gidx, r32); gp = __shfl(gp, r32);
        float cv[4];
#pragma unroll
        for (int i = 0; i < 4; ++i) {
            const float a = gidx == 0 ? acc0[i] : gidx == 1 ? acc0[4 + i] : gidx == 2 ? acc0[8 + i] : acc0[12 + i];
            cv[i] = rs_l * (a - mu_l * WRC[8 * gidx + 4 * hi + i]) + WRC[64 + 8 * gidx + 4 * hi + i];
        }
        float v1 = cv[0]; int i1 = 0;
#pragma unroll
        for (int i = 1; i < 4; ++i) if (cv[i] > v1) { v1 = cv[i]; i1 = i; }
        float v2 = -INFINITY; int i2 = 0;
#pragma unroll
        for (int i = 0; i < 4; ++i) if (i != i1 && cv[i] > v2) { v2 = cv[i]; i2 = i; }
        i1 += 4 * hi; i2 += 4 * hi;
        const float pv1 = __shfl_xor(v1, 32), pv2 = __shfl_xor(v2, 32); const int pi1 = __shfl_xor(i1, 32), pi2 = __shfl_xor(i2, 32);
        auto better = [](float av, int ai, float bv, int bi) { return av > bv || (av == bv && ai < bi); };
        float fv, sv; int fi, si;
        if (better(v1, i1, pv1, pi1)) { fv = v1; fi = i1; if (better(v2, i2, pv1, pi1)) { sv = v2; si = i2; } else { sv = pv1; si = pi1; } }
        else { fv = pv1; fi = pi1; if (better(v1, i1, pv2, pi2)) { sv = v1; si = i1; } else { sv = pv2; si = pi2; } }
        const float d = fast_exp(sv - fv), inv = 1.0f / (1.0f + d);
        const float w1 = gp * inv, w2 = gp * d * inv;
        const int e1 = 8 * gidx + fi, e2 = 8 * gidx + si;
        if (hi == 0) {
            *(int4*)(route + (size_t)(row0 + r32) * 4) = make_int4(e1, e2, __float_as_int(w1), __float_as_int(w2));
            atomicAdd((unsigned*)&hist[e1], 1u); atomicAdd((unsigned*)&hist[e2], 1u);
        }
        __syncthreads();
        if (F.tid < 32) misc[MI_BLOCKCNT + blk * 32 + F.tid] = hist[F.tid];
        __syncthreads();
    }
}

__device__ __forceinline__ void phase_moe_scatter(Frame& F) {
    PHASE_IDS(F);
    unsigned* misc = (unsigned*)(F.ws + WS_MISC);
    const int* route = (const int*)(F.ws + WS_ROUTE);
    int* rpos = (int*)(F.ws + WS_RPOS); int* rowtok = (int*)(F.ws + WS_ROWTOK);
    LAS unsigned* tot = (LAS unsigned*)(F.lds + L_TOT); LAS unsigned* pre = (LAS unsigned*)(F.lds + L_PRE);
    LAS unsigned* base = (LAS unsigned*)(F.lds + L_BASE); LAS unsigned* rank = (LAS unsigned*)(F.lds + L_RANK);
    for (int blk = F.vcu; blk < TT / 256; blk += F.G) {
        {
            if (F.tid < 32) { tot[F.tid] = 0u; pre[F.tid] = 0u; rank[F.tid] = 0u; }
            __syncthreads();
            const int e = F.tid & 31, part = F.tid >> 5; unsigned cv[16];
#pragma unroll
            for (int i = 0; i < 16; ++i) cv[i] = misc[MI_BLOCKCNT + (part * 16 + i) * 32 + e];
            unsigned t = 0, p = 0;
#pragma unroll
            for (int i = 0; i < 16; ++i) { t += cv[i]; p += (part * 16 + i < blk) ? cv[i] : 0u; }
            atomicAdd((unsigned*)&tot[e], t); atomicAdd((unsigned*)&pre[e], p);
        }
        __syncthreads();
        if (F.tid == 0) { unsigned a = 0; for (int e = 0; e < NEXP; ++e) { base[e] = a; a += (tot[e] + 255u) & ~255u; } base[NEXP] = a; }
        __syncthreads();
        {
            const int tok = blk * 256 + (F.tid >> 1), slot = F.tid & 1;
            const int e = route[(size_t)tok * 4 + slot];
            const unsigned r = atomicAdd((unsigned*)&rank[e], 1u);
            const unsigned pos = base[e] + pre[e] + r;
            rowtok[pos] = tok; rpos[(size_t)tok * 2 + slot] = (int)pos;
        }
        if (blk < NEXP) {
            const int e = blk; const unsigned end = base[e] + tot[e], nxt = base[e + 1];
            for (unsigned p = end + F.tid; p < nxt; p += NTHREADS) rowtok[p] = 0;
            for (unsigned p = base[e] / 256 + F.tid; p < nxt / 256; p += NTHREADS) misc[MI_PANEL_E + p] = (unsigned)e;
        }
        if (blk == 0 && F.tid == 0) misc[MI_NPAN] = base[NEXP] / 256;
        __syncthreads();
    }
}

struct MoeSched1 {
    static constexpr bool GATHER = true;
    const bf16_t* A; const bf16_t* W; int lda, ldb, ntot, G, c; const LAS int* rows; const LAS int* pe; int sw8, sa8;
    __device__ __forceinline__ bool next(int i, pg8::Unit& u) const { const int v = i * G + c; if (v >= ntot) return false; u.pm = v >> 1; u.pn = v & 1; u.ord = i; return true; }
    __device__ __forceinline__ const char* a_base(const pg8::Unit&) const { return (const char*)A; }
    __device__ __forceinline__ const char* b_base(const pg8::Unit& u) const { return (const char*)(W + (size_t)pe[u.ord] * 512 * ldb + (size_t)u.pn * 256 * ldb); }
    __device__ __forceinline__ void a_off(const pg8::Unit& u, const int (&R)[2], const int (&C)[2], unsigned (&v)[2][2]) const {
#pragma unroll
        for (int h = 0; h < 2; ++h)
#pragma unroll
            for (int i = 0; i < 2; ++i) v[h][i] = (unsigned)(rows[u.ord * 256 + h * 128 + R[i]] * lda + C[i]) * 2u;
    }
};
struct MoeSched2 {
    static constexpr bool GATHER = false;
    const bf16_t* A; const bf16_t* W; int lda, ldb, ntot, G, c; const LAS int* pe; int sw8, sa8;
    __device__ __forceinline__ bool next(int i, pg8::Unit& u) const { const int v = i * G + c; if (v >= ntot) return false; u.pm = v >> 2; u.pn = v & 3; u.ord = i; return true; }
    __device__ __forceinline__ const char* a_base(const pg8::Unit& u) const { return (const char*)(A + (size_t)u.pm * 256 * lda); }
    __device__ __forceinline__ const char* b_base(const pg8::Unit& u) const { return (const char*)(W + (size_t)pe[u.ord] * DM * ldb + (size_t)u.pn * 256 * ldb); }
    __device__ __forceinline__ void a_off(const pg8::Unit&, const int (&R)[2], const int (&C)[2], unsigned (&v)[2][2]) const {
#pragma unroll
        for (int i = 0; i < 2; ++i) { v[0][i] = (unsigned)(R[i] * lda + C[i]) * 2u; v[1][i] = (unsigned)((128 + R[i]) * lda + C[i]) * 2u; }
    }
};
struct EpiSwiGLU {
    bf16_t* H;
    __device__ __forceinline__ void operator()(const f32x4 (&acc)[2][2][4][2], const pg8::Unit& u, int wr, int wc, int fr, int fq) const {
        const int row0 = u.pm * 256 + wr * 64 + fr, col0 = u.pn * 128 + wc * 16 + 4 * fq;
#pragma unroll
        for (int ai = 0; ai < 2; ++ai)
#pragma unroll
            for (int m = 0; m < 4; ++m) { bf16_t* rowp = H + (size_t)(row0 + ai * 128 + m * 16) * DEXP + col0;
#pragma unroll
                for (int bj = 0; bj < 2; ++bj) { const f32x4 v0 = acc[ai][bj][m][0], v1 = acc[ai][bj][m][1];
                    const float h0 = v0[0] * sigmoidf_(v0[0]) * v0[1], h1 = v0[2] * sigmoidf_(v0[2]) * v0[3], h2 = v1[0] * sigmoidf_(v1[0]) * v1[1], h3 = v1[2] * sigmoidf_(v1[2]) * v1[3];
                    *(unsigned*)((unsigned char*)H + (size_t)(row0 + ai * 128 + m * 16) * DEXP + col0 + bj * 64) = pk4_fp8(h0 * 16.f, h1 * 16.f, h2 * 16.f, h3 * 16.f); (void)rowp; } }
    }
};
struct EpiStoreBf16 {
    bf16_t* O; int ldc;
    __device__ __forceinline__ void operator()(const f32x4 (&acc)[2][2][4][2], const pg8::Unit& u, int wr, int wc, int fr, int fq) const {
        const int row0 = u.pm * 256 + wr * 64 + fr, col0 = u.pn * 256 + wc * 32 + 8 * fq;
#pragma unroll
        for (int ai = 0; ai < 2; ++ai)
#pragma unroll
            for (int m = 0; m < 4; ++m) { bf16_t* rowp = O + (size_t)(row0 + ai * 128 + m * 16) * ldc + col0;
#pragma unroll
                for (int bj = 0; bj < 2; ++bj) store8_fp8((unsigned char*)O + (size_t)(row0 + ai * 128 + m * 16) * ldc + col0 + bj * 128, acc[ai][bj][m][0], acc[ai][bj][m][1], 64.f); (void)rowp; }
    }
};

__device__ __forceinline__ void phase_moe_gemm1(Frame& F) {
    PHASE_IDS(F);
    const unsigned* misc = (const unsigned*)(F.ws + WS_MISC);
    const int* rowtok = (const int*)(F.ws + WS_ROWTOK);
    const int npan = (int)misc[MI_NPAN];
    LAS int* rows = (LAS int*)(F.lds + L_ROWS); LAS int* pe = (LAS int*)(F.lds + L_PE);
    const int c = (int)blockIdx.x, ntot = npan * 2;
    for (int i = 0; i * F.G + c < ntot && i < 8; ++i) { const int p = (i * F.G + c) >> 1;
        if (F.tid < 256) rows[i * 256 + F.tid] = rowtok[p * 256 + F.tid];
        if (F.tid == 256) pe[i] = (int)misc[MI_PANEL_E + p]; }
    VM_WAIT(); LDS_WAIT(); __syncthreads();
    MoeSched1 S{(const bf16_t*)(F.ws + WS_XB8), (const bf16_t*)(F.ws + WS_W13), DM / 2, DM / 2, ntot, F.G, c, rows, pe, F8_SW, F8_SA_X};
    EpiSwiGLU E{(bf16_t*)(F.ws + WS_H)};
    pg8::gemm_phase<EpiSwiGLU, MoeSched1, true, true>(F.lds, DM / 2, S, E);
}
__device__ __forceinline__ void phase_moe_gemm2(Frame& F) {
    PHASE_IDS(F);
    const unsigned* misc = (const unsigned*)(F.ws + WS_MISC);
    const int npan = (int)misc[MI_NPAN];
    LAS int* pe = (LAS int*)(F.lds + L_PE);
    const int c = (int)blockIdx.x, ntot = npan * 4;
    __syncthreads();
    if (F.tid < 16) { const int v = F.tid * F.G + c; if (v < ntot) pe[F.tid] = (int)misc[MI_PANEL_E + (v >> 2)]; }
    VM_WAIT(); LDS_WAIT(); __syncthreads();
    MoeSched2 S{(const bf16_t*)(F.ws + WS_H), (const bf16_t*)(F.ws + WS_W2), DEXP / 2, DEXP / 2, ntot, F.G, c, pe, F8_SW, 127 - 4};
    EpiStoreBf16 E{(bf16_t*)(F.ws + WS_Y), DM};
    int k2 = DEXP / 2; asm volatile("" : "+s"(k2));
    pg8::gemm_phase<EpiStoreBf16, MoeSched2, true, true>(F.lds, k2, S, E);
}

__device__ __forceinline__ void phase_combine_ln2(Frame& F, int l) {
    PHASE_IDS(F);
    const int lane = F.lane;
    const float* lg = F.in[21] + (size_t)l * DM; const float* lb = F.in[22] + (size_t)l * DM;
    f32x4 g[4], b[4];
#pragma unroll
    for (int j = 0; j < 4; ++j) { g[j] = ((const f32x4*)lg)[lane + 64 * j]; b[j] = ((const f32x4*)lb)[lane + 64 * j]; }
    const bf16_t* Y = (const bf16_t*)(F.ws + WS_Y);
    const float* l1g = F.in[12] + (size_t)l * DM; const float* l1b = F.in[13] + (size_t)l * DM; const float* stats = (const float*)(F.ws + WS_WR + 512 * 1024);
    f32x4 g1[4], b1[4];
#pragma unroll
    for (int j = 0; j < 4; ++j) { g1[j] = ((const f32x4*)l1g)[lane + 64 * j]; b1[j] = ((const f32x4*)l1b)[lane + 64 * j]; }
    const int* route = (const int*)(F.ws + WS_ROUTE); const int* rpos = (const int*)(F.ws + WS_RPOS);
    const int gw = F.vcu * NWAVES + F.wave, NGW = F.G * NWAVES;
    auto recs = [&](int r, int4& rt, int2& rp, f32x2& st) { rt = *(const int4*)(route + (size_t)r * 4); rp = *(const int2*)(rpos + (size_t)r * 2); st = *(const f32x2*)(stats + (size_t)r * 2); };
    auto rowload = [&](int r, const int2& rp, f32x4 (&x)[4], unsigned (&ya)[4], unsigned (&yc)[4]) {
        const f32x4* px = (const f32x4*)(F.out + (size_t)r * DM);
        const unsigned* y0 = (const unsigned*)((const unsigned char*)Y + (size_t)rp.x * DM); const unsigned* y1 = (const unsigned*)((const unsigned char*)Y + (size_t)rp.y * DM);
#pragma unroll
        for (int j = 0; j < 4; ++j) { x[j] = __builtin_nontemporal_load(px + lane + 64 * j); ya[j] = __builtin_nontemporal_load(y0 + lane + 64 * j); yc[j] = __builtin_nontemporal_load(y1 + lane + 64 * j); } };
    int4 rt_c, rt_n; int2 rp_c, rp_n; f32x2 st_c, st_n;
    recs(gw, rt_c, rp_c, st_c);
    { const int r1 = gw + NGW < TT ? gw + NGW : gw; recs(r1, rt_n, rp_n, st_n); }
    f32x4 xc[4]; unsigned yac[4], ycc[4];
    rowload(gw, rp_c, xc, yac, ycc);
    for (int row = gw; row < TT; row += NGW) {
        const int r1 = row + NGW < TT ? row + NGW : row, r2 = row + 2 * NGW < TT ? row + 2 * NGW : row;
        f32x4 xn[4]; unsigned yan[4], ycn[4];
        rowload(r1, rp_n, xn, yan, ycn);
        int4 rt_2; int2 rp_2; f32x2 st_2; recs(r2, rt_2, rp_2, st_2);
        const float w0 = __int_as_float(rt_c.z) * (1.f / 64.f), w1 = __int_as_float(rt_c.w) * (1.f / 64.f);
        f32x4 v[4];
#pragma unroll
        for (int j = 0; j < 4; ++j) {
            const f32x4 x = (xc[j] - st_c[0]) * st_c[1] * g1[j] + b1[j]; const unsigned a = yac[j], c = ycc[j];
            const f32x2 a01 = __builtin_amdgcn_cvt_pk_f32_fp8((int)a, false), a23 = __builtin_amdgcn_cvt_pk_f32_fp8((int)a, true), c01 = __builtin_amdgcn_cvt_pk_f32_fp8((int)c, false), c23 = __builtin_amdgcn_cvt_pk_f32_fp8((int)c, true);
            v[j].x = ALPHA * x.x + w0 * a01[0] + w1 * c01[0]; v[j].y = ALPHA * x.y + w0 * a01[1] + w1 * c01[1];
            v[j].z = ALPHA * x.z + w0 * a23[0] + w1 * c23[0]; v[j].w = ALPHA * x.w + w0 * a23[1] + w1 * c23[1];
        }
        ln_row(v, g, b);
#pragma unroll
        for (int j = 0; j < 4; ++j) __builtin_nontemporal_store(v[j], (f32x4*)(F.out + (size_t)row * DM) + lane + 64 * j);
        if (l == 0) {
#pragma unroll
            for (int j = 0; j < 4; ++j) ((unsigned*)(F.ws + WS_XB8 + (size_t)row * DM))[lane + 64 * j] = pk4_fp8(v[j].x * 16.f, v[j].y * 16.f, v[j].z * 16.f, v[j].w * 16.f);
        }
        rt_c = rt_n; rp_c = rp_n; st_c = st_n; rt_n = rt_2; rp_n = rp_2; st_n = st_2;
#pragma unroll
        for (int j = 0; j < 4; ++j) { xc[j] = xn[j]; yac[j] = yan[j]; ycc[j] = ycn[j]; }
    }
}

constexpr float C2D = 0.18033688011112042f;
constexpr float C2M = 0.14724444602590306f;
constexpr float IWS = 0.044194173824159216f;
constexpr float RMS_EPS = 1e-6f;
constexpr int L_QSLOT = L_CTL + 1152;

__device__ __forceinline__ int rope16(int c) { return c < 16 ? (c >> 1) + 8 * (c & 1) : c; }
__device__ __forceinline__ int win_src(int n, float& sc) {
    sc = 1.f;
    if (n < 384) return n;
    if (n < 416) { const int c = n - 384; return 384 + (c >> 1) + 16 * (c & 1); }
    if (n < 512) return -1;
    if (n < 2816) { const int m = n - 512, g = m / 768, r = m % 768, p = r >> 8, hh = (r & 255) >> 6, c = r & 63; if (p == 0) sc = C2D; return 416 + 768 * g + 256 * p + 64 * hh + (p < 2 ? rope16(c) : c); }
    if (n < 3328) { const int m = n - 2816; sc = C2D; return 2720 + (m & ~63) + rope16(m & 63); }
    if (n < 3840) { const int m = n - 3328; return 3360 + (m & ~63) + rope16(m & 63); }
    const int m = n - 3840;
    if (m < 64) return 3232 + rope16(m);
    if (m < 128) return 3296 + (m - 64);
    if (m < 192) return 3872 + rope16(m - 128);
    if (m < 200) { sc = IWS; return 3936 + (m - 192); }
    return -1;
}

__device__ __forceinline__ void sincos_d(double x, double& s, double& c) {
    const double n = __builtin_rint(x * 0.15915494309189535);
    double r = __builtin_fma(-n, 6.2831854820251465, x); r = __builtin_fma(n, 1.7484556025237907e-07, r);
    const double r2 = r * r; double ss = 1.0, cc = 1.0;
#pragma unroll
    for (int k = 15; k >= 1; --k) { ss = 1.0 - r2 * (1.0 / (double)((2 * k) * (2 * k + 1))) * ss; cc = 1.0 - r2 * (1.0 / (double)((2 * k - 1) * (2 * k))) * cc; }
    s = ss * r; c = cc;
}
__device__ __forceinline__ double inv_freq16(int i) {
    const double t[16] = {1.0, 0.44036660267178046, 0.19392274474868576, 0.08539710028576561, 0.03760603093086393, 0.016560440080994446, 0.007292664737217109, 0.003211445994752591,
                          0.001414213562373095, 0.000622772421914596, 0.0002742481756762073, 0.00012076973741146504, 5.318295896944988e-05, 2.341999896140934e-05, 1.031338537721246e-05, 4.5416704806078695e-06};
    double r = t[0];
#pragma unroll
    for (int k = 1; k < 16; ++k) r = (i == k) ? t[k] : r;
    return r;
}

__device__ __forceinline__ void phase_conv_mixer(Frame& F, int l) {
    PHASE_IDS(F);
    LAS float* scr = (LAS float*)(F.lds + F.wave * 16384);
    const int gw = F.vcu * NWAVES + F.wave, NGW = F.G * NWAVES;
    const float* win = F.in[1] + (size_t)l * DM * CIN;
    const float* qg = F.in[2] + (size_t)l * 256; const float* wuq = F.in[3] + (size_t)l * 256 * 768;
    const float* kg = F.in[4] + (size_t)l * 128; const float* wukv = F.in[5] + (size_t)l * 128 * 1024;
    const float* wgate = F.in[6] + (size_t)l * DM * 3072;
    const float* wa = F.in[8] + (size_t)l * 512 * DM; const float* wb = F.in[9] + (size_t)l * 256 * DM; const float* wc = F.in[10] + (size_t)l * 512 * DM; const float* wo = F.in[11] + (size_t)l * DM * DM;
    unsigned char* WIN8 = F.ws + WS_WIN8; bf16_t* WUQ = (bf16_t*)(F.ws + WS_WUQ); bf16_t* WUKV = (bf16_t*)(F.ws + WS_WUKV);
    bf16_t* WA = (bf16_t*)(F.ws + WS_WA); bf16_t* WB = (bf16_t*)(F.ws + WS_WB); bf16_t* WC = (bf16_t*)(F.ws + WS_WC); bf16_t* WO = (bf16_t*)(F.ws + WS_WO);
    constexpr int I_IN = 16 * 128, I_G = 16 * 96, I_UQ = 4 * 24, I_UKV = 4 * 32, I_A = 8 * 32, I_B = 8 * 32, I_C = 8 * 32, I_O = 16 * 32;
    constexpr int NIT = I_IN + I_G + I_UQ + I_UKV + I_A + I_B + I_C + I_O;
    for (int it = gw; it < NIT; it += NGW) {
        int r = it;
        if (r < I_IN) { conv_item8(WIN8, DM, (r / 128) * 64, (r % 128) * 32, scr, F.lane, [&](int k, int n) { float sc; const int sidx = win_src(n, sc); return sidx < 0 ? 0.f : win[(size_t)k * CIN + sidx] * (sc * 1024.f); }); continue; } r -= I_IN;
        if (r < I_G) { conv_plain8(WIN8 + (size_t)PW * DM, DM, (r / 96) * 64, (r % 96) * 32, scr, F.lane, wgate, 3072, 1024.f); continue; } r -= I_G;
        if (r < I_UQ) { conv_item(WUQ, 256, (r / 24) * 64, (r % 24) * 32, scr, F.lane, [&](int k, int n) { const int hh = n / 96, c = n % 96; const int o = c < 64 ? c : 64 + ((c - 64) >> 1) + 16 * ((c - 64) & 1);
                return qg[k] * wuq[(size_t)k * 768 + hh * 96 + o] * C2M; }); continue; } r -= I_UQ;
        if (r < I_UKV) { conv_item(WUKV, 256, (r / 32) * 64, (r % 32) * 32, scr, F.lane, [&](int k, int n) { return k < 128 ? kg[k] * wukv[(size_t)k * 1024 + n] : 0.f; }); continue; } r -= I_UKV;
        if (r < I_A) { conv_plain8((unsigned char*)WA, 512, (r / 32) * 64, (r % 32) * 32, scr, F.lane, wa, DM, 1024.f); continue; } r -= I_A;
        if (r < I_B) { conv_item8((unsigned char*)WB, 512, (r / 32) * 64, (r % 32) * 32, scr, F.lane, [&](int k, int n) { return k < 256 ? wb[(size_t)k * DM + n] * 1024.f : 0.f; }); continue; } r -= I_B;
        if (r < I_C) { conv_plain8((unsigned char*)WC, 512, (r / 32) * 64, (r % 32) * 32, scr, F.lane, wc, DM, 1024.f); continue; } r -= I_C;
        conv_plain8((unsigned char*)WO, DM, (r / 32) * 64, (r % 32) * 32, scr, F.lane, wo, DM, 1024.f);
    }
    if (l == 0) {
        float* rp = (float*)(F.ws + WS_ROPE); float* rm = rp + 2048 * 8 * 2;
        for (int idx = F.vcu * NTHREADS + F.tid; idx < 2048 * 24; idx += F.G * NTHREADS) {
            const int t = idx / 24, j = idx % 24; double sn, cs;
            if (j < 8) { sincos_d((double)t * inv_freq16(2 * j), sn, cs); rp[(t * 8 + j) * 2] = (float)cs; rp[(t * 8 + j) * 2 + 1] = (float)sn; }
            else { sincos_d((double)t * inv_freq16(j - 8), sn, cs); rm[(t * 16 + (j - 8)) * 2] = (float)cs; rm[(t * 16 + (j - 8)) * 2 + 1] = (float)sn; }
        }
        const f32x4* x4 = (const f32x4*)F.in[0]; unsigned* xb8 = (unsigned*)(F.ws + WS_XB8);
        {
            const size_t NT = (size_t)F.G * NTHREADS, N4 = (size_t)TT * DM / 4;
            for (size_t i0 = (size_t)F.vcu * NTHREADS + F.tid; i0 < N4; i0 += 8 * NT) {
                f32x4 v[8];
#pragma unroll
                for (int q = 0; q < 8; ++q) { const size_t i = i0 + q * NT < N4 ? i0 + q * NT : i0; v[q] = __builtin_nontemporal_load(x4 + i); }
#pragma unroll
                for (int q = 0; q < 8; ++q) { const size_t i = i0 + q * NT < N4 ? i0 + q * NT : i0; const f32x4 w = v[q] * 16.f; xb8[i] = pk4_fp8(w.x, w.y, w.z, w.w); }
            }
        }
    }
}

__device__ __forceinline__ void rope4(f32x4& v0, f32x4& v1, const float* cs) {
    const f32x4 a = *(const f32x4*)cs, b = *(const f32x4*)(cs + 4);
    const f32x4 w0 = {v0[0] * a[0] - v0[1] * a[1], v0[1] * a[0] + v0[0] * a[1], v0[2] * a[2] - v0[3] * a[3], v0[3] * a[2] + v0[2] * a[3]};
    const f32x4 w1 = {v1[0] * b[0] - v1[1] * b[1], v1[1] * b[0] + v1[0] * b[1], v1[2] * b[2] - v1[3] * b[3], v1[3] * b[2] + v1[2] * b[3]};
    v0 = w0; v1 = w1;
}
__device__ __forceinline__ void store8(bf16_t* p, const f32x4& v0, const f32x4& v1) {
    u32x4 w; w.x = cvt_pk_bf16(v0[0], v0[1]); w.y = cvt_pk_bf16(v0[2], v0[3]); w.z = cvt_pk_bf16(v1[0], v1[1]); w.w = cvt_pk_bf16(v1[2], v1[3]); *(u32x4*)p = w;
}
struct EpiProj {
    bf16_t* P; const float* csp; const float* csm; float* ssq; bf16_t* G3; const LAS float* gbias;
    __device__ __forceinline__ void operator()(const f32x4 (&acc)[2][2][4][2], const pg8::Unit& u, int wr, int wc, int fr, int fq) const {
        const int pn = u.pn, row0 = u.pm * 256 + wr * 64 + fr;
        if (pn >= 16) {
#pragma unroll
            for (int bj = 0; bj < 2; ++bj) { const int col = (pn - 16) * 256 + bj * 128 + wc * 32 + fq * 8;
                const f32x4 b0 = *(const LAS f32x4*)(gbias + col), b1 = *(const LAS f32x4*)(gbias + col + 4);
#pragma unroll
                for (int ai = 0; ai < 2; ++ai)
#pragma unroll
                    for (int m = 0; m < 4; ++m) { f32x4 v0 = acc[ai][bj][m][0] + b0, v1 = acc[ai][bj][m][1] + b1;
#pragma unroll
                        for (int e = 0; e < 4; ++e) { v0[e] = sigmoidf_(v0[e]); v1[e] = sigmoidf_(v1[e]); }
                        store8_fp8((unsigned char*)G3 + (size_t)(row0 + ai * 128 + m * 16) * 3072 + col, v0, v1, 64.f); } }
            return;
        }
#pragma unroll
        for (int bj = 0; bj < 2; ++bj) {
            const int wcu = __builtin_amdgcn_readfirstlane(wc);
            bool ropeP = false, ropeM = false;
            if (pn == 1) ropeM = (bj == 1 && wcu == 0);
            else if (pn >= 2 && pn < 11) ropeP = ((pn - 2) % 3) < 2 && !(wcu & 1);
            else if (pn >= 11 && pn < 15) ropeP = !(wcu & 1);
            else if (pn == 15) ropeP = (wcu == 0);
            const int col = pn * 256 + bj * 128 + wc * 32 + fq * 8;
            if (ropeP || ropeM) {
                const bool lr = ropeM || fq < 2;
                const float* cb = ropeM ? csm + 8 * fq : csp + 8 * (fq & 1);
                const int ts = ropeM ? 32 : 16;
#pragma unroll
                for (int ai = 0; ai < 2; ++ai) {
                    f32x4 ca[4], cc[4];
#pragma unroll
                    for (int m = 0; m < 4; ++m) { const int t = (row0 + ai * 128 + m * 16) & (SEQ - 1);
                        ca[m] = *(const f32x4*)(cb + t * ts); cc[m] = *(const f32x4*)(cb + t * ts + 4); }
#pragma unroll
                    for (int m = 0; m < 4; ++m) { const int row = row0 + ai * 128 + m * 16;
                        const f32x4 v0 = acc[ai][bj][m][0], v1 = acc[ai][bj][m][1];
                        f32x4 a = ca[m], b = cc[m];
                        if (!lr) { a = (f32x4){1.f, 0.f, 1.f, 0.f}; b = a; }
                        const f32x4 w0 = {v0[0] * a[0] - v0[1] * a[1], v0[1] * a[0] + v0[0] * a[1], v0[2] * a[2] - v0[3] * a[3], v0[3] * a[2] + v0[2] * a[3]};
                        const f32x4 w1 = {v1[0] * b[0] - v1[1] * b[1], v1[1] * b[0] + v1[0] * b[1], v1[2] * b[2] - v1[3] * b[3], v1[3] * b[2] + v1[2] * b[3]};
                        store8(P + (size_t)row * PW + col, w0, w1); }
                }
            } else {
#pragma unroll
                for (int ai = 0; ai < 2; ++ai)
#pragma unroll
                    for (int m = 0; m < 4; ++m)
                        store8(P + (size_t)(row0 + ai * 128 + m * 16) * PW + col, acc[ai][bj][m][0], acc[ai][bj][m][1]);
            }
        }
        if (pn < 2) {
#pragma unroll
            for (int ai = 0; ai < 2; ++ai)
#pragma unroll
                for (int m = 0; m < 4; ++m) {
                    float sq = 0.f;
#pragma unroll
                    for (int bj = 0; bj < 2; ++bj) if (pn == 0 || bj == 0) {
#pragma unroll
                        for (int n = 0; n < 2; ++n) { const f32x4 x = acc[ai][bj][m][n]; sq += (x[0] * x[0] + x[1] * x[1]) + (x[2] * x[2] + x[3] * x[3]); } }
                    sq += __shfl_xor(sq, 16); sq += __shfl_xor(sq, 32);
                    if (fq == 0) ssq[(size_t)(row0 + ai * 128 + m * 16) * 8 + pn * 4 + wc] = sq;
                }
        }
    }
};
struct EpiUpQ {
    bf16_t* Q; const float* csm; const float* ssq;
    __device__ __forceinline__ void operator()(const f32x4 (&acc)[2][2][4][2], const pg8::Unit& u, int wr, int wc, int fr, int fq) const {
        const int row0 = u.pm * 256 + wr * 64 + fr;
        f32x4 spv[2][4];
#pragma unroll
        for (int ai = 0; ai < 2; ++ai)
#pragma unroll
            for (int m = 0; m < 4; ++m) spv[ai][m] = *(const f32x4*)(ssq + (size_t)(row0 + ai * 128 + m * 16) * 8);
#pragma unroll
        for (int ai = 0; ai < 2; ++ai)
#pragma unroll
            for (int m = 0; m < 4; ++m) { const f32x4 sp = spv[ai][m];
                spv[ai][m][0] = 1.0f / sqrtf(((sp[0] + sp[1]) + (sp[2] + sp[3])) * (1.f / 256.f) + RMS_EPS); }
        const int wcu = __builtin_amdgcn_readfirstlane(wc);
#pragma unroll
        for (int bj = 0; bj < 2; ++bj) {
            const int c0 = u.pn * 256 + bj * 128 + wcu * 32, col = c0 + fq * 8;
            if (((c0 >> 5) % 3) == 2) {
#pragma unroll
                for (int ai = 0; ai < 2; ++ai)
#pragma unroll
                    for (int mh = 0; mh < 2; ++mh) {
                        f32x4 ca[2], cc[2];
#pragma unroll
                        for (int mm = 0; mm < 2; ++mm) { const int t = (row0 + ai * 128 + (2 * mh + mm) * 16) & (SEQ - 1);
                            ca[mm] = *(const f32x4*)(csm + t * 32 + 8 * fq); cc[mm] = *(const f32x4*)(csm + t * 32 + 8 * fq + 4); }
#pragma unroll
                        for (int mm = 0; mm < 2; ++mm) { const int m = 2 * mh + mm, row = row0 + ai * 128 + m * 16;
                            const float rs = spv[ai][m][0];
                            const f32x4 v0 = acc[ai][bj][m][0] * rs, v1 = acc[ai][bj][m][1] * rs, a = ca[mm], b = cc[mm];
                            const f32x4 w0 = {v0[0] * a[0] - v0[1] * a[1], v0[1] * a[0] + v0[0] * a[1], v0[2] * a[2] - v0[3] * a[3], v0[3] * a[2] + v0[2] * a[3]};
                            const f32x4 w1 = {v1[0] * b[0] - v1[1] * b[1], v1[1] * b[0] + v1[0] * b[1], v1[2] * b[2] - v1[3] * b[3], v1[3] * b[2] + v1[2] * b[3]};
                            store8(Q + (size_t)row * 768 + col, w0, w1); }
                    }
            } else {
#pragma unroll
                for (int ai = 0; ai < 2; ++ai)
#pragma unroll
                    for (int m = 0; m < 4; ++m) { const float rs = spv[ai][m][0];
                        store8(Q + (size_t)(row0 + ai * 128 + m * 16) * 768 + col, acc[ai][bj][m][0] * rs, acc[ai][bj][m][1] * rs); }
            }
        }
    }
};
struct EpiUpKV {
    bf16_t* KV; const float* ssq;
    __device__ __forceinline__ void operator()(const f32x4 (&acc)[2][2][4][2], const pg8::Unit& u, int wr, int wc, int fr, int fq) const {
        const int row0 = u.pm * 256 + wr * 64 + fr;
        f32x4 spv[2][4];
#pragma unroll
        for (int ai = 0; ai < 2; ++ai)
#pragma unroll
            for (int m = 0; m < 4; ++m) spv[ai][m] = *(const f32x4*)(ssq + (size_t)(row0 + ai * 128 + m * 16) * 8 + 4);
#pragma unroll
        for (int ai = 0; ai < 2; ++ai)
#pragma unroll
            for (int m = 0; m < 4; ++m) {
                const int row = row0 + ai * 128 + m * 16;
                const f32x4 sp = spv[ai][m];
                const float rs = 1.0f / sqrtf(((sp[0] + sp[1]) + (sp[2] + sp[3])) * (1.f / 128.f) + RMS_EPS);
#pragma unroll
                for (int bj = 0; bj < 2; ++bj) { const int col = u.pn * 256 + bj * 128 + wc * 32 + fq * 8;
                    store8(KV + (size_t)row * 1024 + col, acc[ai][bj][m][0] * rs, acc[ai][bj][m][1] * rs); }
            }
    }
};
template <int T> struct IC { static constexpr int value = T; };
struct EpiBranchAll {
    bf16_t* Mg; bf16_t* M0; bf16_t* M1; const bf16_t* G3;
    __device__ __forceinline__ void operator()(const f32x4 (&acc)[2][2][4][2], const pg8::Unit& u, int wr, int wc, int fr, int fq) const {
        const int row0 = u.pm * 256 + wr * 64 + fr, br = u.ord, col0 = u.pn * 256 + wc * 32 + fq * 8;
        bf16_t* dst = br == 0 ? M0 : (br == 1 ? M1 : Mg);
        auto ldb = [&](auto tc, u32x2 (&gw)[2][2], u32x2 (&ma)[2][2], u32x2 (&mb)[2][2]) { constexpr int t = decltype(tc)::value, ai = t >> 1, mh = t & 1;
#pragma unroll
            for (int mm = 0; mm < 2; ++mm)
#pragma unroll
                for (int bj = 0; bj < 2; ++bj) { const int row = row0 + ai * 128 + (2 * mh + mm) * 16, col = col0 + bj * 128;
                    gw[mm][bj] = *(const u32x2*)((const unsigned char*)G3 + (size_t)row * 3072 + br * 1024 + col);
                    ma[mm][bj] = (u32x2){0u, 0u}; mb[mm][bj] = (u32x2){0u, 0u}; }
            if (br == 2) {
#pragma unroll
                for (int mm = 0; mm < 2; ++mm)
#pragma unroll
                    for (int bj = 0; bj < 2; ++bj) { const size_t off = (size_t)(row0 + ai * 128 + (2 * mh + mm) * 16) * DM + col0 + bj * 128;
                        ma[mm][bj] = *(const u32x2*)((const unsigned char*)M0 + off); mb[mm][bj] = *(const u32x2*)((const unsigned char*)M1 + off); }
            } };
        auto cpb = [&](auto tc, const u32x2 (&gw)[2][2], const u32x2 (&ma)[2][2], const u32x2 (&mb)[2][2]) { constexpr int t = decltype(tc)::value, ai = t >> 1, mh = t & 1;
#pragma unroll
            for (int mm = 0; mm < 2; ++mm)
#pragma unroll
                for (int bj = 0; bj < 2; ++bj) { constexpr int dummy = 0; (void)dummy; const int m = 2 * mh + mm; const size_t off = (size_t)(row0 + ai * 128 + m * 16) * DM + col0 + bj * 128; const u32x2 g = gw[mm][bj], a = ma[mm][bj], b2 = mb[mm][bj];
                    const f32x2 g01 = __builtin_amdgcn_cvt_pk_f32_fp8((int)g.x, false) * (1.f / 64.f), g23 = __builtin_amdgcn_cvt_pk_f32_fp8((int)g.x, true) * (1.f / 64.f);
                    const f32x2 g45 = __builtin_amdgcn_cvt_pk_f32_fp8((int)g.y, false) * (1.f / 64.f), g67 = __builtin_amdgcn_cvt_pk_f32_fp8((int)g.y, true) * (1.f / 64.f);
                    f32x4 v0 = acc[ai][bj][m][0], v1 = acc[ai][bj][m][1];
                    const f32x2 s01 = (__builtin_amdgcn_cvt_pk_f32_fp8((int)a.x, false) + __builtin_amdgcn_cvt_pk_f32_fp8((int)b2.x, false)) * (1.f / 64.f), s23 = (__builtin_amdgcn_cvt_pk_f32_fp8((int)a.x, true) + __builtin_amdgcn_cvt_pk_f32_fp8((int)b2.x, true)) * (1.f / 64.f);
                    const f32x2 s45 = (__builtin_amdgcn_cvt_pk_f32_fp8((int)a.y, false) + __builtin_amdgcn_cvt_pk_f32_fp8((int)b2.y, false)) * (1.f / 64.f), s67 = (__builtin_amdgcn_cvt_pk_f32_fp8((int)a.y, true) + __builtin_amdgcn_cvt_pk_f32_fp8((int)b2.y, true)) * (1.f / 64.f);
                    v0[0] = v0[0] * g01[0] + s01[0]; v0[1] = v0[1] * g01[1] + s01[1]; v0[2] = v0[2] * g23[0] + s23[0]; v0[3] = v0[3] * g23[1] + s23[1];
                    v1[0] = v1[0] * g45[0] + s45[0]; v1[1] = v1[1] * g45[1] + s45[1]; v1[2] = v1[2] * g67[0] + s67[0]; v1[3] = v1[3] * g67[1] + s67[1];
                    store8_fp8((unsigned char*)dst + off, v0, v1, 64.f); } };
        u32x2 gA[2][2], aA[2][2], bA[2][2], gB[2][2], aB[2][2], bB[2][2];
        ldb(IC<0>{}, gA, aA, bA); ldb(IC<1>{}, gB, aB, bB);
        cpb(IC<0>{}, gA, aA, bA); ldb(IC<2>{}, gA, aA, bA);
        cpb(IC<1>{}, gB, aB, bB); ldb(IC<3>{}, gB, aB, bB);
        cpb(IC<2>{}, gA, aA, bA); cpb(IC<3>{}, gB, aB, bB);
    }
};
struct BranchSched {
    static constexpr bool GATHER = false; static constexpr bool VARK = true;
    const char* A0; const char* B0; size_t sA, sB; int lda, ldb, c, sw8, sa8, G, ntile;
    __device__ __forceinline__ int ktiles(const pg8::Unit& u) const { return u.ord == 1 ? 2 : 4; }
    __device__ __forceinline__ bool next(int i, pg8::Unit& u) const { const int t = c + (i / 3) * G; if (t >= ntile) return false; u.pm = t >> 2; u.pn = t & 3; u.ord = i % 3; return true; }
    __device__ __forceinline__ const char* a_base(const pg8::Unit& u) const { return A0 + (size_t)u.ord * sA + (size_t)u.pm * 256 * lda * 2; }
    __device__ __forceinline__ const char* b_base(const pg8::Unit& u) const { return B0 + (size_t)u.ord * sB + (size_t)u.pn * 256 * ldb * 2; }
    __device__ __forceinline__ void a_off(const pg8::Unit&, const int (&R)[2], const int (&C)[2], unsigned (&v)[2][2]) const {
#pragma unroll
        for (int i = 0; i < 2; ++i) { v[0][i] = (unsigned)(R[i] * lda + C[i]) * 2u; v[1][i] = (unsigned)((128 + R[i]) * lda + C[i]) * 2u; }
    }
};
struct EpiWo {
    float* out; const float* xsrc; int rowbase;
    __device__ __forceinline__ void operator()(const f32x4 (&acc)[2][2][4][2], const pg8::Unit& u, int wr, int wc, int fr, int fq) const {
        const int row0 = rowbase + u.pm * 256 + wr * 64 + fr, col0 = u.pn * 256 + wc * 32 + fq * 8;
#pragma unroll
        for (int ai = 0; ai < 2; ++ai)
#pragma unroll
            for (int mh = 0; mh < 2; ++mh) {
                f32x4 x[2][2][2];
#pragma unroll
                for (int mm = 0; mm < 2; ++mm)
#pragma unroll
                    for (int bj = 0; bj < 2; ++bj) { const size_t off = (size_t)(row0 + ai * 128 + (2 * mh + mm) * 16) * DM + col0 + bj * 128;
                        x[mm][bj][0] = *(const f32x4*)(xsrc + off); x[mm][bj][1] = *(const f32x4*)(xsrc + off + 4); }
#pragma unroll
                for (int mm = 0; mm < 2; ++mm)
#pragma unroll
                    for (int bj = 0; bj < 2; ++bj) { const size_t off = (size_t)(row0 + ai * 128 + (2 * mh + mm) * 16) * DM + col0 + bj * 128;
                        *(f32x4*)(out + off) = x[mm][bj][0] * ALPHA + acc[ai][bj][2 * mh + mm][0]; *(f32x4*)(out + off + 4) = x[mm][bj][1] * ALPHA + acc[ai][bj][2 * mh + mm][1]; }
            }
    }
};

__device__ __forceinline__ int dequeue(Frame& F, unsigned* ctr, int& pre) {
    LAS int* slot = (LAS int*)(F.lds + L_QSLOT);
    __syncthreads();
    if (F.tid == 0) {
        *slot = (int)__hip_atomic_fetch_add(ctr, 1u, __ATOMIC_RELAXED, __HIP_MEMORY_SCOPE_AGENT); (void)pre;
    }
    __syncthreads();
    return *slot;
}

namespace att {
constexpr int KSLOT = 12288, VSLOT = 8192, NSLOT = 4;
constexpr int A_K = 0, A_V = NSLOT * KSLOT, A_WS = A_V + NSLOT * VSLOT, A_OST = A_WS + 8 * 256, A_MW = A_OST + 8 * 4096, A_END = A_MW + 8 * NSLOT * 256;
static_assert(A_END <= RING_BYTES, "attention LDS");
typedef short s16x4 __attribute__((ext_vector_type(4)));
__device__ __forceinline__ int crow(int r, int hi) { return (r & 3) + 8 * (r >> 2) + 4 * hi; }
__device__ __forceinline__ void glds16(const void* gsrc, unsigned lds_dst) { unsigned keep;
    asm volatile("s_mov_b32 %0, m0\n\ts_mov_b32 m0, %2\n\ts_nop 0\n\tglobal_load_lds_dwordx4 %1, off\n\ts_mov_b32 m0, %0" : "=&s"(keep) : "v"(gsrc), "s"(lds_dst) : "memory"); }
__device__ __forceinline__ void glds4(const void* gsrc, unsigned lds_dst) { unsigned keep;
    asm volatile("s_mov_b32 %0, m0\n\ts_mov_b32 m0, %2\n\ts_nop 0\n\tglobal_load_lds_dword %1, off\n\ts_mov_b32 m0, %0" : "=&s"(keep) : "v"(gsrc), "s"(lds_dst) : "memory"); }
#define ATT_WAIT_BAR(N) asm volatile("s_waitcnt vmcnt(" #N ") lgkmcnt(0)\n\ts_barrier" ::: "memory")
__device__ __forceinline__ float emax(float a, float b) { return __builtin_elementwise_maximum(a, b); }
__device__ __forceinline__ float halfmax(float m) { auto rr = __builtin_amdgcn_permlane32_swap(__float_as_uint(m), __float_as_uint(m), false, false); return emax(__uint_as_float(rr[0]), __uint_as_float(rr[1])); }
__device__ __forceinline__ float halfsum(float m) { auto rr = __builtin_amdgcn_permlane32_swap(__float_as_uint(m), __float_as_uint(m), false, false); return __uint_as_float(rr[0]) + __uint_as_float(rr[1]); }
typedef short v4i16_t __attribute__((ext_vector_type(4)));
__device__ __forceinline__ s16x4 vtr(const LAS unsigned char* p) { return __builtin_bit_cast(s16x4, __builtin_amdgcn_ds_read_tr16_b64_v4i16((LAS v4i16_t*)p)); }
__device__ __forceinline__ void pv(f32x16* o, f32x16& lacc, const LAS unsigned char* vp, bf16x8 pa0, bf16x8 pa1, bf16x8 pa2, bf16x8 pa3) {
    { const u32x4 one4 = {0x3F803F80u, 0x3F803F80u, 0x3F803F80u, 0x3F803F80u}; const bf16x8 ones = __builtin_bit_cast(bf16x8, one4);
      lacc = __builtin_amdgcn_mfma_f32_32x32x16_bf16(pa0, ones, lacc, 0, 0, 0); lacc = __builtin_amdgcn_mfma_f32_32x32x16_bf16(pa1, ones, lacc, 0, 0, 0);
      lacc = __builtin_amdgcn_mfma_f32_32x32x16_bf16(pa2, ones, lacc, 0, 0, 0); lacc = __builtin_amdgcn_mfma_f32_32x32x16_bf16(pa3, ones, lacc, 0, 0, 0); }
#pragma unroll
    for (int d0 = 0; d0 < 2; ++d0) { s16x4 lo[4], hi[4];
#pragma unroll
        for (int ks = 0; ks < 4; ++ks) { lo[ks] = vtr(vp + d0 * 4096 + ks * 1024); hi[ks] = vtr(vp + d0 * 4096 + ks * 1024 + 512); }
#define ATT_PK(k) (bf16x8){lo[k][0], lo[k][1], lo[k][2], lo[k][3], hi[k][0], hi[k][1], hi[k][2], hi[k][3]}
        o[d0] = __builtin_amdgcn_mfma_f32_32x32x16_bf16(pa0, ATT_PK(0), o[d0], 0, 0, 0);
        o[d0] = __builtin_amdgcn_mfma_f32_32x32x16_bf16(pa1, ATT_PK(1), o[d0], 0, 0, 0);
        o[d0] = __builtin_amdgcn_mfma_f32_32x32x16_bf16(pa2, ATT_PK(2), o[d0], 0, 0, 0);
        o[d0] = __builtin_amdgcn_mfma_f32_32x32x16_bf16(pa3, ATT_PK(3), o[d0], 0, 0, 0);
#undef ATT_PK
    }
}
struct Desc {
    const bf16_t* Q; const bf16_t* K1; const bf16_t* K2; const bf16_t* V; bf16_t* O; float* lse; const unsigned* mask;
    int qpitch, k1pitch, k2pitch, vpitch, opitch, lsepitch;
    int rstride, q0, nq, jlo, jhi;
    int o8;
};
template <int DQK, int MODE, bool DUAL = false>
__device__ __forceinline__ void attn_unit(LAS unsigned char* lds, const Desc& d) {
    static_assert(!DUAL || (DQK == 64 && MODE == 0), "dual mode");
    constexpr int NSLOT = DUAL ? 2 : att::NSLOT, KSLOT = DUAL ? 8192 : att::KSLOT;
    constexpr int A_K = 0, A_V = DUAL ? 32768 : att::A_V, A_WS = DUAL ? 65536 : att::A_WS, A_OST = DUAL ? 67584 : att::A_OST, A_MW = att::A_MW;
    int tid_ = threadIdx.x; asm volatile("" : "+v"(tid_));
    const int tid = tid_, lane = tid & 63, r32 = lane & 31, hi = lane >> 5, wid = __builtin_amdgcn_readfirstlane(tid >> 6);
    constexpr int ND = DQK / 16;
    const unsigned lds0 = (unsigned)(size_t)lds;
    LAS float* wsf = (LAS float*)(lds + A_WS) + wid * 64;
    const int grp = DUAL ? (wid >> 2) : 0, w4 = DUAL ? (wid & 3) : wid, gofs = grp * 16384;
    Desc dd = d;
    if (DUAL) { dd.Q = d.Q + (size_t)grp * d.qpitch; dd.K1 = d.K1 + (size_t)grp * d.k1pitch; dd.V = d.V + (size_t)grp * d.vpitch; dd.O = d.O + (size_t)grp * d.opitch; if (d.lse) dd.lse = d.lse + (size_t)grp * d.lsepitch; }
    const Desc& d_ = dd;
    const int qw = d.q0 + w4 * 32;
    const bool wvalid = DUAL || wid * 32 < d.nq;
    const int kkey = 8 * wid + (lane >> 3), kch = (lane & 7) ^ ((kkey >> 1) & 7);
    const bf16_t* ksrc = d_.K1 + (size_t)kkey * d.rstride * d.k1pitch + kch * 8;
    const int k2key = 16 * (wid & 3) + (lane >> 2), k2ch = (lane & 3) ^ ((k2key >> 2) & 3);
    const bf16_t* k2src = (DQK == 96) ? d_.K2 + (size_t)k2key * d.rstride * d.k2pitch + k2ch * 8 : nullptr;
    int kofs[ND];
#pragma unroll
    for (int d0 = 0; d0 < ND; ++d0) kofs[d0] = d0 < 4 ? r32 * 128 + (((2 * d0 + hi) ^ ((r32 >> 1) & 7)) * 16) : 8192 + r32 * 64 + (((2 * (d0 - 4) + hi) ^ ((r32 >> 2) & 3)) * 16);
    const bf16_t* vsrc = d_.V + (size_t)(16 * (wid & 3) + (lane >> 2)) * d.rstride * d.vpitch + (DUAL ? 0 : (wid >> 2) * 32) + (lane & 3) * 8;
    const int kkeyB = 8 * (2 * w4 + 1) + (lane >> 3);
    const bf16_t* ksrcA = DUAL ? d_.K1 + (size_t)(8 * (2 * w4) + (lane >> 3)) * d.rstride * d.k1pitch + (((lane & 7) ^ (((8 * (2 * w4) + (lane >> 3)) >> 1) & 7)) * 8) : nullptr;
    const bf16_t* ksrcB = DUAL ? d_.K1 + (size_t)kkeyB * d.rstride * d.k1pitch + (((lane & 7) ^ ((kkeyB >> 1) & 7)) * 8) : nullptr;
    const size_t kstep = (size_t)64 * d.rstride * d.k1pitch, k2step = (size_t)64 * d.rstride * d.k2pitch, vstep = (size_t)64 * d.rstride * d.vpitch;
    const bool two = (DQK == 96) && wid < 4;
    const unsigned* msrc = (MODE == 2) ? d.mask + (size_t)(wvalid ? (qw + (lane >> 1)) : d.q0) * 64 + (lane & 1) : nullptr;
#define ATT_ISSUE(j) do { const int sl_ = (j) % NSLOT; \
        if (DUAL) { \
            glds16(ksrcA + (size_t)(j) * kstep, (unsigned)__builtin_amdgcn_readfirstlane(lds0 + A_K + gofs + sl_ * KSLOT + (2 * w4) * 1024)); \
            glds16(ksrcB + (size_t)(j) * kstep, (unsigned)__builtin_amdgcn_readfirstlane(lds0 + A_K + gofs + sl_ * KSLOT + (2 * w4 + 1) * 1024)); \
            glds16(vsrc + (size_t)(j) * vstep, (unsigned)__builtin_amdgcn_readfirstlane(lds0 + A_V + gofs + sl_ * VSLOT + w4 * 1024)); \
            glds16(vsrc + 32 + (size_t)(j) * vstep, (unsigned)__builtin_amdgcn_readfirstlane(lds0 + A_V + gofs + sl_ * VSLOT + (4 + w4) * 1024)); \
            break; } \
        glds16(ksrc + (size_t)(j) * kstep, (unsigned)__builtin_amdgcn_readfirstlane(lds0 + A_K + sl_ * KSLOT + wid * 1024)); \
        if (two) glds16(k2src + (size_t)(j) * k2step, (unsigned)__builtin_amdgcn_readfirstlane(lds0 + A_K + sl_ * KSLOT + (8 + wid) * 1024)); \
        glds16(vsrc + (size_t)(j) * vstep, (unsigned)__builtin_amdgcn_readfirstlane(lds0 + A_V + sl_ * VSLOT + wid * 1024)); \
        if (MODE == 2) glds4(msrc + 2 * (j), (unsigned)__builtin_amdgcn_readfirstlane(lds0 + A_MW + (wid * NSLOT + sl_) * 256)); } while (0)
    ATT_ISSUE(d.jlo);
    if (d.jlo + 1 < d.jhi) ATT_ISSUE(d.jlo + 1);
    bf16x8 qr[ND];
    { const int qi = wvalid ? (qw + r32) : d.q0; const bf16_t* qp = d_.Q + (size_t)qi * d.rstride * d.qpitch + hi * 8;
#pragma unroll
      for (int d0 = 0; d0 < ND; ++d0) qr[d0] = *(const bf16x8*)(qp + d0 * 16); }
#pragma unroll
    for (int d0 = 0; d0 < ND; ++d0) asm volatile("" : "+v"(qr[d0]));
    float mhat = 0.f; f32x16 o[2]; o[0] = f32x16{}; o[1] = f32x16{}; f32x16 lacc = f32x16{};
    bool started = false;
    const LAS unsigned char* vp0 = lds + A_V + gofs + ((lane >> 4) & 1) * 32 + (lane & 3) * 8 + (4 * hi + ((lane & 15) >> 2)) * 64;
    const int qi = qw + r32;
    f32x16 p0 = f32x16{}, p1 = f32x16{};
    f32x16 negm = f32x16{};
#define ATT_REL(j) (wvalid && (64 * (j) <= qw + 31) && (MODE != 1 || (64 * (j) + 63 >= qw - 128)))
#define ATT_QK(j) do { const int sl_ = (j) % NSLOT; \
        const LAS unsigned char* kb = lds + A_K + gofs + sl_ * KSLOT; bf16x8 kf[2 * ND]; \
        _Pragma("unroll") for (int d0 = 0; d0 < ND; ++d0) { kf[2 * d0] = *(const LAS bf16x8*)(kb + kofs[d0]); kf[2 * d0 + 1] = *(const LAS bf16x8*)(kb + kofs[d0] + (d0 < 4 ? 4096 : 2048)); } \
        __builtin_amdgcn_sched_barrier(0); \
        _Pragma("unroll") for (int d0 = 0; d0 < ND; ++d0) { \
            if (d0 == 0) { p0 = __builtin_amdgcn_mfma_f32_32x32x16_bf16(kf[0], qr[0], negm, 0, 0, 0); p1 = __builtin_amdgcn_mfma_f32_32x32x16_bf16(kf[1], qr[0], negm, 0, 0, 0); } \
            else { p0 = __builtin_amdgcn_mfma_f32_32x32x16_bf16(kf[2 * d0], qr[d0], p0, 0, 0, 0); p1 = __builtin_amdgcn_mfma_f32_32x32x16_bf16(kf[2 * d0 + 1], qr[d0], p1, 0, 0, 0); } } } while (0)
#define ATT_SMPV(j) do { const int sl_ = (j) % NSLOT; \
        { bool domask = true; unsigned mx_ = 0u, my_ = 0u;        \
          if (MODE == 2) { const u32x2 mw = *(const LAS u32x2*)(lds + A_MW + (wid * NSLOT + sl_) * 256 + r32 * 8); mx_ = mw.x; my_ = mw.y; } \
          else { \
            bool full = (64 * (j) + 63 <= qw); \
            if (MODE == 1) full = full && (64 * (j) >= qw + 31 - 128); \
            domask = !full; \
            if (domask) { const int a_ = qi - 64 * (j), lo_ = (MODE == 1) ? a_ - 128 : -4096;        \
                { const int h_ = a_ < 31 ? a_ : 31, l_ = lo_ > 0 ? lo_ : 0; mx_ = (h_ < l_) ? 0u : ((0xFFFFFFFFu >> (31 - h_)) & (0xFFFFFFFFu << l_)); } \
                { const int h_ = a_ - 32 < 31 ? a_ - 32 : 31, l_ = lo_ - 32 > 0 ? lo_ - 32 : 0; my_ = (h_ < l_) ? 0u : ((0xFFFFFFFFu >> (31 - h_)) & (0xFFFFFFFFu << l_)); } } \
          } \
          if (domask) { const unsigned w0 = mx_ >> (4 * hi), w1 = my_ >> (4 * hi); \
            _Pragma("unroll") for (int r = 0; r < 16; ++r) { const int bit = (r & 3) + 8 * (r >> 2); \
                const unsigned m0 = (unsigned)__builtin_amdgcn_sbfe((int)w0, bit, 1), m1 = (unsigned)__builtin_amdgcn_sbfe((int)w1, bit, 1);        \
                p0[r] = __uint_as_float((m0 & __float_as_uint(p0[r])) | (~m0 & 0xFF800000u)); p1[r] = __uint_as_float((m1 & __float_as_uint(p1[r])) | (~m1 & 0xFF800000u)); } } } \
        float rm = emax(p0[0], p1[0]), rm2 = emax(p0[1], p1[1]); \
        _Pragma("unroll") for (int r = 2; r < 16; r += 2) { rm = emax(emax(rm, p0[r]), p1[r]); rm2 = emax(emax(rm2, p0[r + 1]), p1[r + 1]); } \
        rm = halfmax(emax(rm, rm2)); \
        bool need; float dl; \
        if (!started) { need = true; dl = emax(rm, -200.f); } else { need = __any(rm > 8.f) != 0; dl = emax(rm, 0.f); } \
        if (need) { mhat += dl; \
            _Pragma("unroll") for (int r = 0; r < 16; ++r) negm[r] = -mhat; \
            _Pragma("unroll") for (int r = 0; r < 16; ++r) { p0[r] -= dl; p1[r] -= dl; } \
            if (started) { const float f = __builtin_amdgcn_exp2f(-dl); \
                if (hi == 0) wsf[r32] = f; \
                LDS_WAIT(); \
                _Pragma("unroll") for (int r = 0; r < 16; ++r) { const float fr_ = wsf[crow(r, hi)]; o[0][r] *= fr_; o[1][r] *= fr_; lacc[r] *= fr_; } } } \
        started = true; \
        __builtin_amdgcn_s_setprio(1);        \
        _Pragma("unroll") for (int r = 0; r < 16; ++r) { p0[r] = __builtin_amdgcn_exp2f(p0[r]); p1[r] = __builtin_amdgcn_exp2f(p1[r]); } \
        const u32x4 pw0 = (u32x4){cvt_pk_bf16(p0[0], p0[1]), cvt_pk_bf16(p0[2], p0[3]), cvt_pk_bf16(p0[4], p0[5]), cvt_pk_bf16(p0[6], p0[7])}; \
        const u32x4 pw1 = (u32x4){cvt_pk_bf16(p0[8], p0[9]), cvt_pk_bf16(p0[10], p0[11]), cvt_pk_bf16(p0[12], p0[13]), cvt_pk_bf16(p0[14], p0[15])}; \
        const u32x4 pw2 = (u32x4){cvt_pk_bf16(p1[0], p1[1]), cvt_pk_bf16(p1[2], p1[3]), cvt_pk_bf16(p1[4], p1[5]), cvt_pk_bf16(p1[6], p1[7])}; \
        const u32x4 pw3 = (u32x4){cvt_pk_bf16(p1[8], p1[9]), cvt_pk_bf16(p1[10], p1[11]), cvt_pk_bf16(p1[12], p1[13]), cvt_pk_bf16(p1[14], p1[15])}; \
        pv(o, lacc, vp0 + sl_ * VSLOT, __builtin_bit_cast(bf16x8, pw0), __builtin_bit_cast(bf16x8, pw1), __builtin_bit_cast(bf16x8, pw2), __builtin_bit_cast(bf16x8, pw3)); \
        __builtin_amdgcn_s_setprio(0); } while (0)
#define ATT_TOPWAIT(j) do { if ((j) + 1 < d.jhi) { if (DUAL) { ATT_WAIT_BAR(4); } else if (MODE == 2 || two) { ATT_WAIT_BAR(3); } else { ATT_WAIT_BAR(2); } } else { ATT_WAIT_BAR(0); } } while (0)
    if (wid < 4) {
        for (int j = d.jlo; j < d.jhi; ++j) {
            ATT_TOPWAIT(j);
            if (j + 2 < d.jhi) ATT_ISSUE(j + 2);
            if (ATT_REL(j)) { ATT_QK(j); ATT_SMPV(j); }
        }
        asm volatile("s_waitcnt lgkmcnt(0)\n\ts_barrier" ::: "memory");
    } else {
        ATT_TOPWAIT(d.jlo);
        if (d.jlo + 2 < d.jhi) ATT_ISSUE(d.jlo + 2);
        if (ATT_REL(d.jlo)) ATT_QK(d.jlo);
        for (int j = d.jlo + 1; j < d.jhi; ++j) {
            ATT_TOPWAIT(j);
            if (j + 2 < d.jhi) ATT_ISSUE(j + 2);
            if (ATT_REL(j - 1)) ATT_SMPV(j - 1);
            if (ATT_REL(j)) ATT_QK(j);
        }
        asm volatile("s_waitcnt lgkmcnt(0)\n\ts_barrier" ::: "memory");
        if (ATT_REL(d.jhi - 1)) ATT_SMPV(d.jhi - 1);
    }
#undef ATT_REL
#undef ATT_QK
#undef ATT_SMPV
#undef ATT_TOPWAIT
#undef ATT_ISSUE
    if (wvalid) {
        LAS bf16_t* stg = (LAS bf16_t*)(lds + A_OST) + wid * 2048;
        if (d_.lse != nullptr && r32 == 0) {
#pragma unroll
            for (int r = 0; r < 16; ++r) wsf[32 + crow(r, hi)] = lacc[r]; }
        if (d.o8) {
            LAS unsigned char* stg8 = (LAS unsigned char*)stg;
#pragma unroll
            for (int r = 0; r < 16; ++r) { const int orow = crow(r, hi); const float rl = __builtin_amdgcn_rcpf(lacc[r]) * 32.f;
                const unsigned p = (unsigned)__builtin_amdgcn_cvt_pk_fp8_f32(o[0][r] * rl, o[1][r] * rl, 0, false);
                stg8[orow * 64 + r32] = (unsigned char)(p & 0xffu); stg8[orow * 64 + 32 + r32] = (unsigned char)((p >> 8) & 0xffu); }
            LDS_WAIT();
#pragma unroll
            for (int i = 0; i < 2; ++i) { const int row = i * 16 + (lane >> 2), ch = lane & 3; const u32x4 v = *(const LAS u32x4*)(stg8 + row * 64 + ch * 16);
                *(u32x4*)((unsigned char*)d_.O + (size_t)(qw + row) * d.rstride * d.opitch + ch * 16) = v; }
        } else {
#pragma unroll
        for (int r = 0; r < 16; ++r) { const int orow = crow(r, hi); const float rl = __builtin_amdgcn_rcpf(lacc[r]);
            stg[orow * 64 + r32] = (bf16_t)f2bf(o[0][r] * rl); stg[orow * 64 + 32 + r32] = (bf16_t)f2bf(o[1][r] * rl); }
        LDS_WAIT();
#pragma unroll
        for (int i = 0; i < 4; ++i) { const int row = i * 8 + (lane >> 3), ch = lane & 7; const u32x4 v = *(const LAS u32x4*)(stg + row * 64 + ch * 8);
            *(u32x4*)(d_.O + (size_t)(qw + row) * d.rstride * d.opitch + ch * 8) = v; }
        }
        if (d_.lse != nullptr && hi == 0) d_.lse[(size_t)(qw + r32) * d.rstride * d.lsepitch] = mhat + __builtin_amdgcn_logf(wsf[32 + r32]);
    }
    asm volatile("s_waitcnt lgkmcnt(0)\n\ts_barrier" ::: "memory");
}
}

namespace idx {
constexpr int KS = 8192, I_K = 0, I_ST = 3 * KS, I_END = I_ST + 8 * 8192;
static_assert(I_END <= RING_BYTES, "indexer LDS");
__device__ __forceinline__ void score_unit(LAS unsigned char* lds, const bf16_t* PROJ, float* SC, int b, int qh  , int jg) {
    int tid_ = threadIdx.x; asm volatile("" : "+v"(tid_));
    const int tid = tid_, lane = tid & 63, r32 = lane & 31, hi = lane >> 5, wid = __builtin_amdgcn_readfirstlane(tid >> 6);
    const int qg = wid >> 1, hh = wid & 1;
    const unsigned lds0 = (unsigned)(size_t)lds;
    const int qrow = b * SEQ + qh * 128 + qg * 32 + r32;
    const bf16_t* kbase = PROJ + (size_t)(b * SEQ) * PW + 3968;
    const int kkey = 8 * wid + (lane >> 3);
    const bf16_t* ksrc = kbase + (size_t)kkey * PW + ((lane & 7) ^ ((kkey >> 1) & 7)) * 8;
    const int j0 = 4 * jg;
#define IDX_ISSUE(j) att::glds16(ksrc + (size_t)(j) * 64 * PW, (unsigned)__builtin_amdgcn_readfirstlane(lds0 + I_K + ((j) % 3) * KS + wid * 1024))
    IDX_ISSUE(j0); IDX_ISSUE(j0 + 1);
    bf16x8 qf[4][4]; float wv[4];
    { const bf16_t* qp = PROJ + (size_t)qrow * PW + 3328 + hh * 256 + hi * 8;
#pragma unroll
      for (int h = 0; h < 4; ++h)
#pragma unroll
          for (int d0 = 0; d0 < 4; ++d0) qf[h][d0] = *(const bf16x8*)(qp + h * 64 + d0 * 16);
      const u32x2 ww = *(const u32x2*)(PROJ + (size_t)qrow * PW + 4032 + hh * 4);
      wv[0] = bflo(ww.x); wv[1] = bfhi(ww.x); wv[2] = bflo(ww.y); wv[3] = bfhi(ww.y); }
#pragma unroll
    for (int h = 0; h < 4; ++h) { asm volatile("" : "+v"(wv[h]));
#pragma unroll
        for (int d0 = 0; d0 < 4; ++d0) asm volatile("" : "+v"(qf[h][d0])); }
    const int qb = qh >> 1;
    unsigned* blk = (unsigned*)SC + ((size_t)b * 36 + (size_t)(qb * (qb + 1) / 2)) * 32768; const int pitch = 128 * (qb + 1);
    f32x4 ve[4] = {};
    LAS unsigned char* stg = lds + I_ST + wid * 8192;
    const LAS unsigned char* stg2 = lds + I_ST + (wid ^ 1) * 8192;
#pragma nounroll
    for (int jj = 0; jj < 4; ++jj) { const int j = j0 + jj;
        if (jj < 2) { ATT_WAIT_BAR(1); } else if (jj == 2) { ATT_WAIT_BAR(5); } else { ATT_WAIT_BAR(4); }
        if (jj + 2 < 4) IDX_ISSUE(j + 2);
        const LAS unsigned char* kb = lds + I_K + (j % 3) * KS + r32 * 128;
#pragma nounroll
        for (int half = 0; half < 2; ++half) {
            bf16x8 kf[4];
#pragma unroll
            for (int d0 = 0; d0 < 4; ++d0) kf[d0] = *(const LAS bf16x8*)(kb + half * 4096 + (((2 * d0 + hi) ^ ((r32 >> 1) & 7)) * 16));
            f32x16 t0 = f32x16{};
#pragma unroll
            for (int h = 0; h < 4; ++h) {
                f32x16 p0 = f32x16{};
#pragma unroll
                for (int d0 = 0; d0 < 4; ++d0) p0 = __builtin_amdgcn_mfma_f32_32x32x16_bf16(kf[d0], qf[h][d0], p0, 0, 0, 0);
#pragma unroll
                for (int r = 0; r < 16; ++r) t0[r] += wv[h] * att::emax(p0[r], 0.f);
            }
#pragma unroll
            for (int g = 0; g < 4; ++g) { const int c0 = 8 * half + 2 * g + hi;
                *(LAS f32x4*)(stg + r32 * 256 + ((c0 ^ (r32 & 15)) * 16)) = (f32x4){t0[4 * g], t0[4 * g + 1], t0[4 * g + 2], t0[4 * g + 3]}; }
        }
        asm volatile("s_waitcnt lgkmcnt(0)\n\ts_barrier" ::: "memory");
#pragma unroll
        for (int i = 0; i < 4; ++i) { const int q = hh * 16 + i * 4 + (lane >> 4), c = lane & 15; const int so = q * 256 + ((c ^ (q & 15)) * 16);
            const f32x4 v = *(const LAS f32x4*)(stg + so) + *(const LAS f32x4*)(stg2 + so);
            if (jj & 1) { const f32x4 e = ve[i]; const u32x4 w = {pk2(e[0], v[0]), pk2(e[1], v[1]), pk2(e[2], v[2]), pk2(e[3], v[3])};
                *(u32x4*)(blk + (size_t)((qh & 1) * 128 + qg * 32 + q) * pitch + 64 * (j >> 1) + 4 * c) = w; }
            else ve[i] = v; }
        LDS_WAIT();
    }
#undef IDX_ISSUE
    asm volatile("s_waitcnt lgkmcnt(0)\n\ts_barrier" ::: "memory");
}

__device__ __forceinline__ int wave_sum_i(int v) {
    v += __builtin_amdgcn_update_dpp(0, v, 0xB1, 0xF, 0xF, true);
    v += __builtin_amdgcn_update_dpp(0, v, 0x4E, 0xF, 0xF, true);
    v += __builtin_amdgcn_update_dpp(0, v, 0x141, 0xF, 0xF, true);
    v += __builtin_amdgcn_update_dpp(0, v, 0x140, 0xF, 0xF, true);
    return __builtin_amdgcn_readlane(v, 0) + __builtin_amdgcn_readlane(v, 16) + __builtin_amdgcn_readlane(v, 32) + __builtin_amdgcn_readlane(v, 48);
}
__device__ __forceinline__ unsigned long long keep_low(unsigned long long m, int k) { while (__builtin_popcountll(m) > k) m &= ~(1ull << (63 - __builtin_clzll(m))); return m; }
__device__ __forceinline__ void select_rows4(const float* SC, unsigned* MASK, int row0  , int lane, LAS unsigned* slot  ) {
    const int b = row0 / SEQ, t0 = row0 % SEQ, qb = t0 >> 8;
    if (t0 < 256) {
#pragma unroll 1
        for (int i = 0; i < 4; ++i) { const int t = t0 + i, lo = 64 * lane;
            const unsigned long long w = (lo + 63 <= t) ? ~0ull : (lo > t ? 0ull : ((2ull << (t - lo)) - 1ull));
            if (lane < 32) ((unsigned long long*)(MASK + (size_t)(row0 + i) * 64))[lane] = w; }
        return;
    }
    const int pitch = 128 * (qb + 1), pmax = pitch - 1;
    const unsigned* srow0 = (const unsigned*)SC + ((size_t)b * 36 + (size_t)(qb * (qb + 1) / 2)) * 32768 + (size_t)(t0 - 256 * qb) * pitch;
    unsigned raw[16];
#pragma unroll
    for (int i = 0; i < 16; ++i) { const int s_ = 64 * i + lane; raw[i] = srow0[s_ < pmax ? s_ : pmax]; }
#pragma unroll 1
    for (int r = 0; r < 4; ++r) {
        const int t = t0 + r;
        unsigned P[16];
#pragma unroll
        for (int i = 0; i < 16; ++i) P[i] = raw[i];
        { const unsigned* nx = srow0 + (size_t)(r < 3 ? r + 1 : 3) * pitch;
#pragma unroll
          for (int i = 0; i < 16; ++i) { const int s_ = 64 * i + lane; raw[i] = nx[s_ < pmax ? s_ : pmax]; } }
#define SEL_TSTAGE(sh, m) _Pragma("unroll") for (int q = 0; q < 16; ++q) if (!(q & (sh))) { const unsigned a_ = P[q], b_ = P[q + (sh)]; \
            P[q] = (a_ & (m)) | ((b_ << (sh)) & ~(m)); P[q + (sh)] = ((a_ >> (sh)) & (m)) | (b_ & ~(m)); }
        SEL_TSTAGE(8, 0x00FF00FFu) SEL_TSTAGE(4, 0x0F0F0F0Fu) SEL_TSTAGE(2, 0x33333333u) SEL_TSTAGE(1, 0x55555555u)
#undef SEL_TSTAGE
        { const unsigned sg = P[15];
#pragma unroll
          for (int q = 0; q < 15; ++q) P[q] ^= sg;
          P[15] = ~sg; }
        const int nj = ((t - lane) >> 6) + 1;
        unsigned A = ((1u << ((nj + 1) >> 1)) - 1u) | (((1u << (nj >> 1)) - 1u) << 16), G = 0u;
        int cab = 0, cntA = t + 1;
#pragma unroll
        for (int bit = 15; bit >= 0; --bit) {
            if (cab + cntA != 256) {
                const unsigned ones = A & P[bit];
                const int c = wave_sum_i(__builtin_popcount(ones));
                if (cab + c >= 256) { A = ones; cntA = c; } else { G |= ones; cab += c; A &= ~ones; cntA -= c; }
            }
        }
        int need = 256 - cab;
        unsigned sel = G | A;
        if (cntA != need) {
            unsigned selA = 0u;
#pragma nounroll
            for (int j = 0; j < 32; ++j) { const int pb = (j >> 1) + 16 * (j & 1);
                unsigned long long m = __ballot((A >> pb) & 1u);
                if (__builtin_popcountll(m) > need) m = keep_low(m, need);
                need -= __builtin_popcountll(m);
                selA |= (unsigned)((m >> lane) & 1ull) << pb;
            }
            sel = G | selA;
        }
        int lo = 0, hi = 0;
#pragma unroll
        for (int j = 0; j < 32; ++j) { const unsigned long long m = __ballot((sel >> ((j >> 1) + 16 * (j & 1))) & 1u);
            lo = (lane == j) ? (int)(unsigned)m : lo; hi = (lane == j) ? (int)(unsigned)(m >> 32) : hi; }
        if (lane < 32) ((unsigned long long*)(MASK + (size_t)(row0 + r) * 64))[lane] = (unsigned long long)(unsigned)lo | ((unsigned long long)(unsigned)hi << 32);
    }
}
}

__device__ __forceinline__ unsigned* queue_word(Frame& F, int l, int chunk, int q) { return (unsigned*)(F.ws + WS_CTL) + CW_QUEUE + 64 * ((l * NCHUNK + chunk) * 4 + q); }

__device__ __forceinline__ void phase_proj(Frame& F, int l, int chunk) {
    PHASE_IDS(F);
    { LAS float* gb = (LAS float*)(F.lds + L_GB); const float* bg = F.in[7] + (size_t)l * 3072;
      __syncthreads();
      for (int i = F.tid; i < 3072; i += NTHREADS) gb[i] = bg[i];
      VM_WAIT(); LDS_WAIT(); __syncthreads(); }
    pg8::ProjSched8 S{{{(const bf16_t*)(F.ws + WS_XB8 + (size_t)chunk * TC * DM), (const bf16_t*)(F.ws + WS_WIN8), DM / 2, DM / 2, TC / 256, (PW + 3072) / 256, F.G, (int)blockIdx.x}, F8_SW, F8_SA_X}};
    const float* rp = (const float*)(F.ws + WS_ROPE);
    EpiProj E{(bf16_t*)(F.ws + WS_PROJ), rp, rp + 2048 * 8 * 2, (float*)(F.ws + WS_SSQ), (bf16_t*)(F.ws + WS_G3), (const LAS float*)(F.lds + L_GB)};
    pg8::gemm_phase<EpiProj, pg8::ProjSched8, true, true>(F.lds, DM / 2, S, E);
}
__device__ __forceinline__ void dilated_unit(Frame& F, int u) {
    const bf16_t* PROJ = (const bf16_t*)(F.ws + WS_PROJ); bf16_t* OG = (bf16_t*)(F.ws + WS_OG); float* LSE = (float*)(F.ws + WS_LSE);
    constexpr int N_G0 = NBC * 4 * 8, N_G1 = NBC * 4 * 4 * 2;
    int g, b, h, res, qb, dil, nq;
    if (u < N_G0) { g = 0; dil = 1; qb = 7 - u / (NBC * 4); const int bh = u % (NBC * 4); b = bh >> 2; h = bh & 3; res = 0; nq = 256; }
    else if (u < N_G0 + N_G1) { const int v = u - N_G0; g = 1; dil = 4; qb = 1 - v / (NBC * 16); const int x = v % (NBC * 16); b = x >> 4; h = (x >> 2) & 3; res = x & 3; nq = 256; }
    else { const int v = u - N_G0 - N_G1; g = 2; dil = 16; qb = 0; b = v >> 5; h = (v >> 3) & 3; res = (v & 7) * 2; nq = 128; }
    att::Desc d; const size_t r0 = (size_t)b * SEQ + res;
    const bf16_t* base = PROJ + r0 * PW + 512 + 768 * g + 64 * h;
    d.Q = base; d.K1 = base + 256; d.V = base + 512; d.K2 = nullptr; d.qpitch = d.k1pitch = d.vpitch = PW; d.k2pitch = 0;
    d.O = OG + ((size_t)g * TC + r0) * 256 + 64 * h; d.opitch = 256; d.lse = LSE + ((size_t)g * TC + r0) * 4 + h; d.lsepitch = 4; d.mask = nullptr;
    d.rstride = dil; d.q0 = qb * 256; d.nq = nq; d.o8 = 0;
    if (g == 2) { d.jlo = 0; d.jhi = 2; att::attn_unit<64, 0, true>(F.lds, d); }
    else { d.jlo = (qb * 4 - 2) > 0 ? (qb * 4 - 2) : 0; d.jhi = 4 * (qb + 1); att::attn_unit<64, 1>(F.lds, d); }
}

struct UpSched {
    static constexpr bool GATHER = false;
    const char* A; const char* B; size_t sB; int lda, ldb, nM, G, c;
    __device__ __forceinline__ bool next(int i, pg8::Unit& u) const { const int v = i * G + c; if (v >= nM * 7) return false; u.pm = v / 7; u.pn = v % 7; u.ord = i; return true; }
    __device__ __forceinline__ const char* a_base(const pg8::Unit& u) const { return A + ((size_t)u.pm * 256 * lda + (u.pn >= 3 ? 256 : 0)) * 2; }
    __device__ __forceinline__ const char* b_base(const pg8::Unit& u) const { return B + (u.pn >= 3 ? sB + (size_t)(u.pn - 3) * 256 * ldb * 2 : (size_t)u.pn * 256 * ldb * 2); }
    __device__ __forceinline__ void a_off(const pg8::Unit&, const int (&R)[2], const int (&C)[2], unsigned (&v)[2][2]) const {
#pragma unroll
        for (int i = 0; i < 2; ++i) { v[0][i] = (unsigned)(R[i] * lda + C[i]) * 2u; v[1][i] = (unsigned)((128 + R[i]) * lda + C[i]) * 2u; }
    }
};
struct EpiUp {
    EpiUpQ q; EpiUpKV kv;
    __device__ __forceinline__ void operator()(const f32x4 (&acc)[2][2][4][2], const pg8::Unit& u, int wr, int wc, int fr, int fq) const {
        if (u.pn < 3) q(acc, u, wr, wc, fr, fq);
        else { pg8::Unit u2 = u; u2.pn = u.pn - 3; kv(acc, u2, wr, wc, fr, fq); }
    }
};
__device__ __forceinline__ void phase_up_scores(Frame& F, int l, int chunk) {
    PHASE_IDS(F);
    const bf16_t* PROJ = (const bf16_t*)(F.ws + WS_PROJ);
    const float* rp = (const float*)(F.ws + WS_ROPE);
    {   UpSched S{(const char*)PROJ, (const char*)(F.ws + WS_WUQ), WS_WUKV - WS_WUQ, PW, 256, TC / 256, F.G, (int)blockIdx.x};
        EpiUp E{{(bf16_t*)(F.ws + WS_QM), rp + 2048 * 8 * 2, (const float*)(F.ws + WS_SSQ)}, {(bf16_t*)(F.ws + WS_KVM), (const float*)(F.ws + WS_SSQ)}};
        pg8::gemm_phase<EpiUp, UpSched, true>(F.lds, 256, S, E); }
    unsigned* qw = queue_word(F, l, chunk, 0); int pre = -1;
    for (;;) {
        const int u = dequeue(F, qw, pre);
        if (u < NBC * 64) { dilated_unit(F, u); continue; }
        if (u >= NBC * 64 + NBC * 72 + NBC * 32) break;
        if (u >= NBC * 64 + NBC * 72) { dilated_unit(F, u - NBC * 72); continue; }
        const int v = u - NBC * 64; const int b = v / 72; int r = v % 72, qh = 0; while (r > (qh >> 1)) { r -= (qh >> 1) + 1; ++qh; }
        idx::score_unit(F.lds, PROJ, (float*)(F.ws + WS_SC), b, qh, r);
    }
}
__device__ __forceinline__ void phase_attn1(Frame& F, int l, int chunk, int tmask = 7) {
    PHASE_IDS(F);
    const bf16_t* PROJ = (const bf16_t*)(F.ws + WS_PROJ); const bf16_t* QM = (const bf16_t*)(F.ws + WS_QM); const bf16_t* KVM = (const bf16_t*)(F.ws + WS_KVM);
    bf16_t* OA = (bf16_t*)(F.ws + WS_OA); bf16_t* OG = (bf16_t*)(F.ws + WS_OG); float* LSE = (float*)(F.ws + WS_LSE);
    constexpr int N_MLA = NBC * 8 * 8, N_SEL = TC / 32;
    unsigned* qw = queue_word(F, l, chunk, 1); int pre = -1;
    for (;;) {
        int u = dequeue(F, qw, pre);
        if (u < N_MLA) {
            if (!(tmask & 1)) continue;
            const int qb = 7 - u / (NBC * 8), bh = u % (NBC * 8), b = bh >> 3, h = bh & 7;
            att::Desc d; const size_t r0 = (size_t)b * SEQ;
            d.Q = QM + r0 * 768 + h * 96; d.qpitch = 768; d.K1 = KVM + r0 * 1024 + h * 128; d.k1pitch = 1024; d.K2 = PROJ + r0 * PW + 384; d.k2pitch = PW;
            d.V = KVM + r0 * 1024 + h * 128 + 64; d.vpitch = 1024; d.O = (bf16_t*)((unsigned char*)OA + r0 * 512 + h * 64); d.opitch = 512; d.o8 = 1; d.lse = nullptr; d.lsepitch = 0; d.mask = nullptr;
            d.rstride = 1; d.q0 = qb * 256; d.nq = 256; d.jlo = 0; d.jhi = 4 * (qb + 1);
            att::attn_unit<96, 0>(F.lds, d); continue; }
        u -= N_MLA;
        if (u >= N_SEL) break;
        if (!(tmask & 4)) continue;
        idx::select_rows4((const float*)(F.ws + WS_SC), (unsigned*)(F.ws + WS_MASK), u * 32 + F.wave * 4, F.lane, (LAS unsigned*)(F.lds + L_GB) + F.wave * 64);
    }
}
__device__ __forceinline__ void phase_attn2(Frame& F, int l, int chunk) {
    PHASE_IDS(F);
    const bf16_t* PROJ = (const bf16_t*)(F.ws + WS_PROJ);
    bf16_t* OC = (bf16_t*)(F.ws + WS_OC);
    unsigned* qw = queue_word(F, l, chunk, 2); int pre = -1;
    for (;;) {
        const int u = dequeue(F, qw, pre);
        if (u >= NBC * 64) break;
        const int qb = 7 - u / (NBC * 8), bh = u % (NBC * 8), b = bh >> 3, h = bh & 7;
        att::Desc d; const size_t r0 = (size_t)b * SEQ;
        d.Q = PROJ + r0 * PW + 2816 + 64 * h; d.K1 = PROJ + r0 * PW + 3840; d.V = PROJ + r0 * PW + 3904; d.K2 = nullptr; d.qpitch = d.k1pitch = d.vpitch = PW; d.k2pitch = 0;
        d.O = (bf16_t*)((unsigned char*)OC + r0 * 512 + 64 * h); d.opitch = 512; d.o8 = 1; d.lse = nullptr; d.lsepitch = 0; d.mask = (const unsigned*)(F.ws + WS_MASK) + r0 * 64;
        d.rstride = 1; d.q0 = qb * 256; d.nq = 256; d.jlo = 0; d.jhi = 4 * (qb + 1);
        att::attn_unit<64, 2>(F.lds, d);
    }
    const bf16_t* OG = (const bf16_t*)(F.ws + WS_OG); const float* LSE = (const float*)(F.ws + WS_LSE); bf16_t* OB = (bf16_t*)(F.ws + WS_OB);
    const int gw = F.vcu * NWAVES + F.wave, NGW = F.G * NWAVES, h = F.lane >> 4;
    for (int row = gw; row < TC; row += NGW) {
        const float l0 = LSE[(size_t)row * 4 + h], l1 = LSE[((size_t)TC + row) * 4 + h], l2 = LSE[((size_t)2 * TC + row) * 4 + h];
        const float mx = fmaxf(l0, fmaxf(l1, l2));
        float w0 = __builtin_amdgcn_exp2f(l0 - mx), w1 = __builtin_amdgcn_exp2f(l1 - mx), w2 = __builtin_amdgcn_exp2f(l2 - mx);
        const float inv = 1.0f / (w0 + w1 + w2); w0 *= inv; w1 *= inv; w2 *= inv;
        const u32x2 a = *(const u32x2*)(OG + (size_t)row * 256 + F.lane * 4), bq = *(const u32x2*)(OG + ((size_t)TC + row) * 256 + F.lane * 4), c = *(const u32x2*)(OG + ((size_t)2 * TC + row) * 256 + F.lane * 4);
        w0 *= 32.f; w1 *= 32.f; w2 *= 32.f;
        *(unsigned*)((unsigned char*)OB + (size_t)row * 512 + F.lane * 4) = pk4_fp8(w0 * bflo(a.x) + w1 * bflo(bq.x) + w2 * bflo(c.x), w0 * bfhi(a.x) + w1 * bfhi(bq.x) + w2 * bfhi(c.x),
                                                                                    w0 * bflo(a.y) + w1 * bflo(bq.y) + w2 * bflo(c.y), w0 * bfhi(a.y) + w1 * bfhi(bq.y) + w2 * bfhi(c.y));
    }
}
constexpr int CW_DEP = 32768;
__device__ __forceinline__ void phase_attn(Frame& F, int l, int chunk) {
    PHASE_IDS(F);
    const bf16_t* PROJ = (const bf16_t*)(F.ws + WS_PROJ); const bf16_t* QM = (const bf16_t*)(F.ws + WS_QM); const bf16_t* KVM = (const bf16_t*)(F.ws + WS_KVM);
    bf16_t* OA = (bf16_t*)(F.ws + WS_OA); bf16_t* OC = (bf16_t*)(F.ws + WS_OC);
    constexpr int N_SEL = TC / 32, NQ = NBC * 8;
    unsigned* dep = (unsigned*)(F.ws + WS_CTL) + CW_DEP + (l * NCHUNK + chunk) * (NBC * 8);
    unsigned* qw = queue_word(F, l, chunk, 1); int pre = -1;
    for (;;) {
        int u = dequeue(F, qw, pre);
        if (u < N_SEL) {
            idx::select_rows4((const float*)(F.ws + WS_SC), (unsigned*)(F.ws + WS_MASK), u * 32 + F.wave * 4, F.lane, (LAS unsigned*)(F.lds + L_GB) + F.wave * 64);
            VM_WAIT();
            __syncthreads();
            if (F.tid == 0) { const int row = u * 32, b = row / SEQ, qb = (row % SEQ) >> 8;
                __builtin_amdgcn_fence(__ATOMIC_RELEASE, "agent");
                __hip_atomic_fetch_add(dep + b * 8 + qb, 1u, __ATOMIC_RELAXED, __HIP_MEMORY_SCOPE_AGENT); }
            continue; }
        u -= N_SEL;
        if (u >= 16 * NQ) break;
        const int qb = 7 - u / (2 * NQ), w = u % (2 * NQ);
        if (w < NQ) {
            const int b = w >> 3, h = w & 7;
            att::Desc d; const size_t r0 = (size_t)b * SEQ;
            d.Q = QM + r0 * 768 + h * 96; d.qpitch = 768; d.K1 = KVM + r0 * 1024 + h * 128; d.k1pitch = 1024; d.K2 = PROJ + r0 * PW + 384; d.k2pitch = PW;
            d.V = KVM + r0 * 1024 + h * 128 + 64; d.vpitch = 1024; d.O = (bf16_t*)((unsigned char*)OA + r0 * 512 + h * 64); d.opitch = 512; d.o8 = 1; d.lse = nullptr; d.lsepitch = 0; d.mask = nullptr;
            d.rstride = 1; d.q0 = qb * 256; d.nq = 256; d.jlo = 0; d.jhi = 4 * (qb + 1);
            att::attn_unit<96, 0>(F.lds, d);
        } else {
            const int bh = w - NQ, b = bh >> 3, h = bh & 7;
            if (F.tid == 0) { while (__hip_atomic_load(dep + b * 8 + qb, __ATOMIC_RELAXED, __HIP_MEMORY_SCOPE_AGENT) < 8u) __builtin_amdgcn_s_sleep(4);
                __builtin_amdgcn_fence(__ATOMIC_ACQUIRE, "agent"); }
            __syncthreads();
            att::Desc d; const size_t r0 = (size_t)b * SEQ;
            d.Q = PROJ + r0 * PW + 2816 + 64 * h; d.K1 = PROJ + r0 * PW + 3840; d.V = PROJ + r0 * PW + 3904; d.K2 = nullptr; d.qpitch = d.k1pitch = d.vpitch = PW; d.k2pitch = 0;
            d.O = (bf16_t*)((unsigned char*)OC + r0 * 512 + 64 * h); d.opitch = 512; d.o8 = 1; d.lse = nullptr; d.lsepitch = 0; d.mask = (const unsigned*)(F.ws + WS_MASK) + r0 * 64;
            d.rstride = 1; d.q0 = qb * 256; d.nq = 256; d.jlo = 0; d.jhi = 4 * (qb + 1);
            att::attn_unit<64, 2>(F.lds, d);
        }
    }
    const bf16_t* OG = (const bf16_t*)(F.ws + WS_OG); const float* LSE = (const float*)(F.ws + WS_LSE); bf16_t* OB = (bf16_t*)(F.ws + WS_OB);
    const int gw = F.vcu * NWAVES + F.wave, NGW = F.G * NWAVES, h = F.lane >> 4;
    for (int row0 = gw; row0 < TC; row0 += 4 * NGW) {
        float l0[4], l1[4], l2[4]; u32x2 a[4], bq[4], c[4]; int rows[4];
#pragma unroll
        for (int i = 0; i < 4; ++i) { const int row = row0 + i * NGW < TC ? row0 + i * NGW : row0; rows[i] = row;
            l0[i] = LSE[(size_t)row * 4 + h]; l1[i] = LSE[((size_t)TC + row) * 4 + h]; l2[i] = LSE[((size_t)2 * TC + row) * 4 + h];
            a[i] = *(const u32x2*)(OG + (size_t)row * 256 + F.lane * 4); bq[i] = *(const u32x2*)(OG + ((size_t)TC + row) * 256 + F.lane * 4); c[i] = *(const u32x2*)(OG + ((size_t)2 * TC + row) * 256 + F.lane * 4); }
#pragma unroll
        for (int i = 0; i < 4; ++i) {
            const float mx = fmaxf(l0[i], fmaxf(l1[i], l2[i]));
            float w0 = __builtin_amdgcn_exp2f(l0[i] - mx), w1 = __builtin_amdgcn_exp2f(l1[i] - mx), w2 = __builtin_amdgcn_exp2f(l2[i] - mx);
            const float inv = 32.0f / (w0 + w1 + w2); w0 *= inv; w1 *= inv; w2 *= inv;
            *(unsigned*)((unsigned char*)OB + (size_t)rows[i] * 512 + F.lane * 4) = pk4_fp8(w0 * bflo(a[i].x) + w1 * bflo(bq[i].x) + w2 * bflo(c[i].x), w0 * bfhi(a[i].x) + w1 * bfhi(bq[i].x) + w2 * bfhi(c[i].x),
                                                                                          w0 * bflo(a[i].y) + w1 * bflo(bq[i].y) + w2 * bflo(c[i].y), w0 * bfhi(a[i].y) + w1 * bfhi(bq[i].y) + w2 * bfhi(c[i].y));
        }
    }
}
__device__ __forceinline__ void phase_branches(Frame& F, int l, int chunk) {
    PHASE_IDS(F);
    static_assert(WS_OB - WS_OA == WS_OC - WS_OB && WS_WB - WS_WA == WS_WC - WS_WB, "equally spaced branch operands");
    BranchSched S{(const char*)(F.ws + WS_OA), (const char*)(F.ws + WS_WA), WS_OB - WS_OA, WS_WB - WS_WA, 256, 256, (int)blockIdx.x, F8_SW, 127 - 5, F.G, (TC / 256) * 4};
    EpiBranchAll E{(bf16_t*)(F.ws + WS_MERGED), (bf16_t*)(F.ws + WS_M0), (bf16_t*)(F.ws + WS_M1), (const bf16_t*)(F.ws + WS_G3)};
    pg8::gemm_phase<EpiBranchAll, BranchSched, true, true>(F.lds, 256, S, E);
}
__device__ __forceinline__ void phase_wo(Frame& F, int l, int chunk) {
    PHASE_IDS(F);
    pg8::DenseSched8 S{{(const bf16_t*)(F.ws + WS_MERGED), (const bf16_t*)(F.ws + WS_WO), DM / 2, DM / 2, TC / 256, 4, F.G, (int)blockIdx.x}, F8_SW, 127 - 6};
    EpiWo E{F.out, l == 0 ? F.in[0] : F.out, chunk * TC};
    pg8::gemm_phase<EpiWo, pg8::DenseSched8, true, true>(F.lds, DM / 2, S, E);
}

__global__ void __launch_bounds__(NTHREADS, 2) fwd_kernel(Args args) {
    extern __shared__ __attribute__((aligned(16))) unsigned char lds_raw[];
    Frame F;
    F.lds = (LAS unsigned char*)lds_raw;
    F.tid = threadIdx.x; F.lane = F.tid & 63; F.wave = __builtin_amdgcn_readfirstlane(F.tid >> 6);
    F.G = gridDim.x; { const int bx = blockIdx.x; F.vcu = (F.G % 8 == 0) ? (bx % 8) * (F.G / 8) + bx / 8 : bx; }
    F.in.p = (intab_t)__builtin_amdgcn_kernarg_segment_ptr(); F.out = args.out; F.ws = args.ws; F.out0 = args.out; F.ws0 = args.ws;
    for (int u = F.tid; u < (LDS_BYTES - L_CTL) / 4; u += NTHREADS) ((LAS unsigned*)(F.lds + L_CTL))[u] = 0u;
    __syncthreads();
    XcdBarrier bar = xcd_barrier_post((unsigned*)(F.ws + WS_CTL) + CW_BAR, (volatile LAS unsigned*)(F.lds + L_BARW));
#define GRID_BAR() xcd_barrier(bar)

    for (int l = 0; l < 2; ++l) {
        phase_conv_moe(F, l);
        phase_conv_mixer(F, l);
        GRID_BAR();
        for (int chunk = 0; chunk < NCHUNK; ++chunk) {
            phase_proj(F, l, chunk);
            GRID_BAR();
            if (DUPMASK & 2) { phase_proj(F, l, chunk); GRID_BAR(); }
            phase_up_scores(F, l, chunk);
            GRID_BAR();
            if (DUPMASK & 4) { phase_up_scores(F, l + 2, chunk); GRID_BAR(); }
            phase_attn(F, l, chunk);
            GRID_BAR();
            phase_branches(F, l, chunk);
            GRID_BAR();
            if (DUPMASK & 32) { phase_branches(F, l, chunk); GRID_BAR(); }
            phase_wo(F, l, chunk);
            if ((DUPMASK & 0x800) && l == 0) { GRID_BAR(); phase_wo(F, l, chunk); }
        }
        GRID_BAR();
        phase_ln1_router(F, l, F.out, false);
        GRID_BAR();
        phase_moe_scatter(F);
        GRID_BAR();
        phase_moe_gemm1(F);
        GRID_BAR();
        if (DUPMASK & 64) { phase_moe_gemm1(F); GRID_BAR(); }
        phase_moe_gemm2(F);
        GRID_BAR();
        if (DUPMASK & 128) { phase_moe_gemm2(F); GRID_BAR(); }
        phase_combine_ln2(F, l);
    }
}

extern "C" void kernel_launch(void* const* d_in, const int* in_sizes, int n_in, void* d_out, int out_size, void* d_ws, size_t ws_size, hipStream_t stream) {
    static int grid = 0;
    if (grid == 0) {
        if (n_in != 23 || out_size != TT * DM || ws_size < WS_END) { fprintf(stderr, "kernel_launch: unexpected shapes n_in %d out %d ws %zu\n", n_in, out_size, ws_size); grid = -1; return; }
        int dev = 0, cus = 0;
        if (hipGetDevice(&dev) != hipSuccess || hipDeviceGetAttribute(&cus, hipDeviceAttributeMultiprocessorCount, dev) != hipSuccess) { grid = -1; return; }
        if (hipFuncSetAttribute((const void*)fwd_kernel, hipFuncAttributeMaxDynamicSharedMemorySize, LDS_BYTES) != hipSuccess) { fprintf(stderr, "kernel_launch: hipFuncSetAttribute failed\n"); grid = -1; return; }
        int per_cu = 0;
        if (hipOccupancyMaxActiveBlocksPerMultiprocessor(&per_cu, (const void*)fwd_kernel, NTHREADS, LDS_BYTES) != hipSuccess || per_cu < 1) fprintf(stderr, "kernel_launch: occupancy query says %d\n", per_cu);
        (void)hipGetLastError();
        grid = cus;
    }
    if (grid < 0) return;
    if (hipMemsetAsync((char*)d_ws + WS_CTL, 0, CTL_ZERO_BYTES, stream) != hipSuccess) return;
    Args a{};
    for (int i = 0; i < 23; ++i) a.in[i] = (const float*)d_in[i];
    a.out = (float*)d_out; a.ws = (unsigned char*)d_ws;
    hipLaunchKernelGGL(fwd_kernel, dim3(grid), dim3(NTHREADS), LDS_BYTES, stream, a);
}
```

```cpp
#include <hip/hip_runtime.h>
#include <cstdio>
#include <cstdint>

#define LAS __attribute__((address_space(3)))
#define GAS __attribute__((address_space(1)))
typedef unsigned short bf16_t;
typedef short bf16x8 __attribute__((ext_vector_type(8)));
typedef float f32x4 __attribute__((ext_vector_type(4)));
typedef float f32x2 __attribute__((ext_vector_type(2)));
typedef float f32x16 __attribute__((ext_vector_type(16)));
typedef unsigned u32x4 __attribute__((ext_vector_type(4)));
typedef unsigned u32x2 __attribute__((ext_vector_type(2)));

constexpr int DM = 1024, NB = 32, SEQ = 2048, TT = NB * SEQ;
constexpr int NEXP = 32, DEXP = 256;
constexpr float LN_EPS = 1e-6f;
constexpr float ALPHA = 1.41421356237309515f;
constexpr int NWAVES = 8, NTHREADS = 512;

__device__ __forceinline__ unsigned f2bf(float f) { unsigned u = __builtin_bit_cast(unsigned, f); return (u + 0x7fffu + ((u >> 16) & 1u)) >> 16; }
__device__ __forceinline__ unsigned pk2(float lo, float hi) { return f2bf(lo) | (f2bf(hi) << 16); }
__device__ __forceinline__ float bf2f(unsigned short b) { return __builtin_bit_cast(float, (unsigned)b << 16); }
__device__ __forceinline__ float bflo(unsigned w) { return __builtin_bit_cast(float, w << 16); }
__device__ __forceinline__ float bfhi(unsigned w) { return __builtin_bit_cast(float, w & 0xffff0000u); }
typedef __bf16 bf16x2_t __attribute__((ext_vector_type(2)));
__device__ __forceinline__ unsigned cvt_pk_bf16(float lo, float hi) { const f32x2 v = {lo, hi}; const bf16x2_t b = __builtin_convertvector(v, bf16x2_t); return __builtin_bit_cast(unsigned, b); }
__device__ __forceinline__ float wave_sum(float v) {
#pragma unroll
    for (int o = 1; o < 64; o <<= 1) v += __shfl_xor(v, o);
    return v;
}
__device__ __forceinline__ float fast_exp(float x) { return __builtin_amdgcn_exp2f(x * 1.4426950408889634f); }
__device__ __forceinline__ float sigmoidf_(float x) { return __builtin_amdgcn_rcpf(1.0f + fast_exp(-x)); }
__device__ __forceinline__ unsigned pk4_fp8(float a, float b, float c, float d) {
    int p = __builtin_amdgcn_cvt_pk_fp8_f32(a, b, 0, false); p = __builtin_amdgcn_cvt_pk_fp8_f32(c, d, p, true); return (unsigned)p; }
__device__ __forceinline__ void store8_fp8(unsigned char* p, const f32x4& v0, const f32x4& v1, float sc) {
    u32x2 w; w.x = pk4_fp8(v0[0] * sc, v0[1] * sc, v0[2] * sc, v0[3] * sc); w.y = pk4_fp8(v1[0] * sc, v1[1] * sc, v1[2] * sc, v1[3] * sc); *(u32x2*)p = w;
}
#define LDS_WAIT() asm volatile("s_waitcnt lgkmcnt(0)" ::: "memory")
#define VM_WAIT() asm volatile("s_waitcnt vmcnt(0)" ::: "memory")

namespace pg8 {
constexpr int BM = 256, BK = 64, HALF = 128, HTB = HALF * BK * 2, STAGE_BYTES = 8 * HTB;
__device__ __forceinline__ int lds_byte(int r, int c) { return r * 128 + ((((c >> 3) ^ (r >> 1)) & 7) * 16) + (c & 7) * 2; }
__device__ __forceinline__ void stage_rc(int b, int& R, int& C) { R = b >> 7; C = ((((b >> 4) ^ (R >> 1)) & 7)) * 8; }
__device__ __forceinline__ int perm32(int rho) { const int n = rho >> 4, i = rho & 15; return 8 * (i >> 2) + 4 * n + (i & 3); }
struct Unit { int pm, pn, ord; };

template <class S, class = void> struct SchedVarK { static constexpr bool value = false; };
template <class S> struct SchedVarK<S, decltype((void)S::VARK)> { static constexpr bool value = S::VARK; };
typedef int v4i_t __attribute__((ext_vector_type(4)));
typedef int v8i_t __attribute__((ext_vector_type(8)));
__device__ __forceinline__ v8i_t cat8(const bf16x8& lo, const bf16x8& hi) { return __builtin_shufflevector(__builtin_bit_cast(v4i_t, lo), __builtin_bit_cast(v4i_t, hi), 0, 1, 2, 3, 4, 5, 6, 7); }
template <class Epi, class Sched, bool ALIGN_EPI, bool F8 = false>
__device__ __forceinline__ void gemm_phase(LAS unsigned char* lds, const int K, const Sched& S, const Epi& E) {
    int tid_ = threadIdx.x; asm volatile("" : "+v"(tid_));
    const int tid = tid_, wid = __builtin_amdgcn_readfirstlane(tid >> 6), lane = tid & 63, wr = wid >> 2, wc = wid & 3, fr = lane & 15, fq = lane >> 4;
    int nt = K / BK;
    int Rr[2], Cc[2]; unsigned vB[2][2];
#pragma unroll
    for (int i = 0; i < 2; ++i) { stage_rc(tid * 16 + i * 8192, Rr[i], Cc[i]); const int Rb = (Rr[i] & ~31) + perm32(Rr[i] & 31);
        vB[0][i] = (unsigned)(Rb * S.ldb + Cc[i]) * 2u; vB[1][i] = (unsigned)((HALF + Rb) * S.ldb + Cc[i]) * 2u; }
    const size_t kstep = (size_t)(BK * 2);
    const unsigned ldsw = (unsigned)wid * 1024u;
    const int aoff = lds_byte(wr * 64 + fr, fq * 8), boff = lds_byte(wc * 32 + fr, fq * 8);
    const int aoff1 = lds_byte(wr * 64 + fr, fq * 8 + 32), boff1 = lds_byte(wc * 32 + fr, fq * 8 + 32);
#define PG8_SA(b, h) (((b) * 2 + (h)) * HTB)
#define PG8_SB(b, h) ((4 + (b) * 2 + (h)) * HTB)
#define PG8_STAGE(bufoff, gbase, voff) do { _Pragma("unroll") for (int _i = 0; _i < 2; ++_i) \
        __builtin_amdgcn_global_load_lds((const unsigned*)((const char*)(gbase) + (voff)[_i]), (LAS unsigned*)(lds + (bufoff) + ldsw + _i * 8192), 16, 0, 0); } while (0)
#define PG8_LDA(dst, b, h) do { _Pragma("unroll") for (int m = 0; m < 4; ++m) { \
        const bf16x8 f0_ = *(const LAS bf16x8*)(lds + PG8_SA(b, h) + aoff + m * 2048), f1_ = *(const LAS bf16x8*)(lds + PG8_SA(b, h) + aoff1 + m * 2048); \
        if constexpr (F8) dst##8[m] = cat8(f0_, f1_); else { dst[m][0] = f0_; dst[m][1] = f1_; } } } while (0)
#define PG8_LDB(dst, b, h) do { _Pragma("unroll") for (int n = 0; n < 2; ++n) { \
        const bf16x8 f0_ = *(const LAS bf16x8*)(lds + PG8_SB(b, h) + boff + n * 2048), f1_ = *(const LAS bf16x8*)(lds + PG8_SB(b, h) + boff1 + n * 2048); \
        if constexpr (F8) dst##8[n] = cat8(f0_, f1_); else { dst[n][0] = f0_; dst[n][1] = f1_; } } } while (0)
#define PG8_MMA(ai, bj, At, Bt) do { __builtin_amdgcn_s_setprio(1); \
        if constexpr (F8) { _Pragma("unroll") for (int m = 0; m < 4; ++m) _Pragma("unroll") for (int n = 0; n < 2; ++n) \
            asm volatile("v_mfma_scale_f32_16x16x128_f8f6f4 %0, %1, %2, %0, %3, %4 op_sel_hi:[0,0,0]" : "+v"(acc[ai][bj][m][n]) : "v"(Bt##8[n]), "v"(At##8[m]), "v"(scw8), "v"(sca8)); } \
              \
        else { _Pragma("unroll") for (int m = 0; m < 4; ++m) _Pragma("unroll") for (int n = 0; n < 2; ++n) _Pragma("unroll") for (int k = 0; k < 2; ++k) \
            acc[ai][bj][m][n] = __builtin_amdgcn_mfma_f32_16x16x32_bf16(Bt[n][k], At[m][k], acc[ai][bj][m][n], 0, 0, 0); } \
        __builtin_amdgcn_s_setprio(0); } while (0)
#define PG8_WAIT_V(n) asm volatile("s_waitcnt vmcnt(" #n ")" ::: "memory")
#define PG8_WAIT_L(n) asm volatile("s_waitcnt lgkmcnt(" #n ")" ::: "memory")
#define PG8_BAR __builtin_amdgcn_s_barrier()
#define PG8_SCHED __builtin_amdgcn_sched_barrier(0)
    int scw8 = 0, sca8 = 0;
    if constexpr (F8) { scw8 = S.sw8 * 0x01010101; sca8 = S.sa8 * 0x01010101; }
    Unit cur, nxt; int ui = 0;
    if (!S.next(0, cur)) return;
    f32x4 acc[2][2][4][2];
#pragma unroll
    for (int a = 0; a < 2; ++a)
#pragma unroll
        for (int b = 0; b < 2; ++b)
#pragma unroll
            for (int m = 0; m < 4; ++m)
#pragma unroll
                for (int n = 0; n < 2; ++n) acc[a][b][m][n] = (f32x4){0.f, 0.f, 0.f, 0.f};
    bf16x8 At[4][2], B0[2][2], B1[2][2]; v8i_t At8[4], B08[2], B18[2];
    unsigned vAc[2][2], vAn[2][2];
    const char* cA = S.a_base(cur); const char* cB = S.b_base(cur);
    S.a_off(cur, Rr, Cc, vAc);
    if constexpr (SchedVarK<Sched>::value) nt = S.ktiles(cur);
    PG8_STAGE(PG8_SB(0, 0), cB, vB[0]); PG8_STAGE(PG8_SB(0, 1), cB, vB[1]); PG8_STAGE(PG8_SA(0, 0), cA, vAc[0]); PG8_STAGE(PG8_SA(0, 1), cA, vAc[1]);
    if (wr == 1) PG8_BAR;
    PG8_WAIT_V(2); PG8_BAR;
    PG8_STAGE(PG8_SB(1, 0), cB + kstep, vB[0]); PG8_STAGE(PG8_SA(1, 0), cA + kstep, vAc[0]); PG8_STAGE(PG8_SB(1, 1), cB + kstep, vB[1]);
    PG8_WAIT_V(6); PG8_BAR;
    bool epi_pend = false;
    for (;;) {
        const bool has_next = S.next(ui + 1, nxt);
        const char* nA = cA; const char* nB = cB;
        if constexpr (Sched::GATHER) {
#pragma unroll
            for (int h = 0; h < 2; ++h)
#pragma unroll
                for (int i = 0; i < 2; ++i) vAn[h][i] = vAc[h][i];
        }
        if (has_next) { nA = S.a_base(nxt); nB = S.b_base(nxt); if constexpr (Sched::GATHER) S.a_off(nxt, Rr, Cc, vAn); }
#pragma nounroll
        for (int t = 0; t < nt; t += 2) {
            const bool last = (t == nt - 2);
            const bool ep_ = epi_pend && t == 0;
            const char* a1 = cA + (size_t)(t + 1) * kstep;
            const char* a2 = last ? nA : cA + (size_t)(t + 2) * kstep; const char* b2 = last ? nB : cB + (size_t)(t + 2) * kstep;
            const char* a3 = a2 + kstep; const char* b3 = b2 + kstep;
            unsigned vA2[2][2];
#pragma unroll
            for (int h = 0; h < 2; ++h)
#pragma unroll
                for (int i = 0; i < 2; ++i) { if constexpr (Sched::GATHER) vA2[h][i] = last ? vAn[h][i] : vAc[h][i]; else vA2[h][i] = vAc[h][i]; }
            PG8_LDB(B0, 0, 0); PG8_LDB(B1, 0, 1); PG8_SCHED; PG8_LDA(At, 0, 0); PG8_STAGE(PG8_SA(1, 1), a1, vAc[1]);
            if (ep_) { PG8_WAIT_V(24); } else { PG8_WAIT_V(8); } PG8_WAIT_L(0); PG8_BAR; PG8_MMA(0, 0, At, B0); PG8_MMA(0, 1, At, B1); PG8_BAR; PG8_SCHED;
            PG8_LDA(At, 0, 1); PG8_STAGE(PG8_SB(0, 0), b2, vB[0]); PG8_STAGE(PG8_SB(0, 1), b2, vB[1]); PG8_STAGE(PG8_SA(0, 0), a2, vA2[0]);
            if (ep_) { PG8_WAIT_V(24); } else { PG8_WAIT_V(8); } PG8_WAIT_L(0); PG8_BAR; PG8_MMA(1, 0, At, B0); PG8_MMA(1, 1, At, B1); PG8_BAR; PG8_SCHED;
            PG8_LDB(B0, 1, 0); PG8_LDB(B1, 1, 1); PG8_SCHED; PG8_LDA(At, 1, 0); PG8_STAGE(PG8_SA(0, 1), a2, vA2[1]);
            PG8_WAIT_V(8); PG8_WAIT_L(0); PG8_BAR; PG8_MMA(0, 0, At, B0); PG8_MMA(0, 1, At, B1); PG8_BAR; PG8_SCHED;
            PG8_LDA(At, 1, 1); PG8_STAGE(PG8_SB(1, 0), b3, vB[0]); PG8_STAGE(PG8_SB(1, 1), b3, vB[1]); PG8_STAGE(PG8_SA(1, 0), a3, vA2[0]);
            PG8_WAIT_V(8); PG8_WAIT_L(0); PG8_BAR; PG8_MMA(1, 0, At, B0); PG8_MMA(1, 1, At, B1); PG8_BAR; PG8_SCHED;
        }
        if constexpr (ALIGN_EPI) { if (wr == 0) PG8_BAR; }
        if constexpr (F8) asm volatile("s_nop 15\n\ts_nop 15" ::: "memory");
        { int l2_ = lane; asm volatile("" : "+v"(l2_)); E(acc, cur, wr, wc, l2_ & 15, l2_ >> 4); }
        if (!has_next) break;
        epi_pend = true;
#pragma unroll
        for (int a = 0; a < 2; ++a)
#pragma unroll
            for (int b = 0; b < 2; ++b)
#pragma unroll
                for (int m = 0; m < 4; ++m)
#pragma unroll
                    for (int n = 0; n < 2; ++n) acc[a][b][m][n] = (f32x4){0.f, 0.f, 0.f, 0.f};
        cur = nxt; cA = nA; cB = nB; ++ui;
        if constexpr (SchedVarK<Sched>::value) nt = S.ktiles(cur);
        if constexpr (Sched::GATHER) {
#pragma unroll
            for (int h = 0; h < 2; ++h)
#pragma unroll
                for (int i = 0; i < 2; ++i) vAc[h][i] = vAn[h][i];
        }
        if constexpr (ALIGN_EPI) { if (wr == 1) PG8_BAR; }
    }
    PG8_WAIT_V(0);
    if constexpr (!ALIGN_EPI) { if (wr == 0) PG8_BAR; }
    asm volatile("s_waitcnt vmcnt(0) lgkmcnt(0)\n\ts_barrier" ::: "memory");
    __builtin_amdgcn_sched_barrier(0);
#undef PG8_SA
#undef PG8_SB
#undef PG8_STAGE
#undef PG8_LDA
#undef PG8_LDB
#undef PG8_MMA
#undef PG8_WAIT_V
#undef PG8_WAIT_L
#undef PG8_BAR
#undef PG8_SCHED
}

struct DenseSched {
    static constexpr bool GATHER = false;
    const bf16_t* A; const bf16_t* Bt; int lda, ldb, nM, nN, G, c;
    __device__ __forceinline__ bool next(int i, Unit& u) const { const int v = i * G + c; if (v >= nM * nN) return false; u.pm = v / nN; u.pn = v % nN; u.ord = i; return true; }
    __device__ __forceinline__ const char* a_base(const Unit& u) const { return (const char*)(A + (size_t)u.pm * BM * lda); }
    __device__ __forceinline__ const char* b_base(const Unit& u) const { return (const char*)(Bt + (size_t)u.pn * BM * ldb); }
    __device__ __forceinline__ void a_off(const Unit&, const int (&R)[2], const int (&C)[2], unsigned (&v)[2][2]) const {
#pragma unroll
        for (int i = 0; i < 2; ++i) { v[0][i] = (unsigned)(R[i] * lda + C[i]) * 2u; v[1][i] = (unsigned)((HALF + R[i]) * lda + C[i]) * 2u; }
    }
};
struct DenseSched8 : DenseSched { int sw8, sa8; };
struct ProjSched8 : DenseSched8 {
    __device__ __forceinline__ bool next(int i, Unit& u) const {
        if (nN != 28 || (nM & 1) || (G & 7)) return DenseSched::next(i, u);
        const int x = c & 7, wl = i * (G >> 3) + (c >> 3), half = nM >> 1;
        if (wl >= half * 7) return false;
        u.pm = (x >> 2) * half + wl / 7; u.pn = 7 * (x & 3) + wl % 7; u.ord = i; return true;
    }
};
}

#define XB_TMO      128
#define XB_XCNT(j)  (256  + 64 * (j))
#define XB_XSUB(j)  (1280 + 64 * (j))
#define XB_XGEN(j)  (2304 + 64 * (j))
#define XB_TOP      3328
#define XB_TOPGEN   3392
#define XCD_BAR_WORDS 3456
#define XB_SPIN_CAP (1u << 18)
__device__ __forceinline__ unsigned xb_ld(unsigned* p)              { return __hip_atomic_load(p, __ATOMIC_RELAXED, __HIP_MEMORY_SCOPE_AGENT); }
__device__ __forceinline__ unsigned xb_add(unsigned* p, unsigned v) { return __hip_atomic_fetch_add(p, v, __ATOMIC_RELAXED, __HIP_MEMORY_SCOPE_AGENT); }
__device__ __forceinline__ unsigned xb_xcc_id() { return (unsigned)__builtin_amdgcn_s_getreg((3 << 11) | 20) & 0xFu; }
#define XB_SPIN(cond, bar) do { unsigned _sp = 0; while (cond) { __builtin_amdgcn_s_sleep(1); \
    if ((++_sp & 255u) == 0u) { if (xb_ld(&(bar)[XB_TMO])) break; if (_sp > XB_SPIN_CAP) { atomicAdd(&(bar)[XB_TMO], 1u); break; } } } } while (0)
struct XcdBarrier { unsigned* bar; unsigned x; volatile LAS unsigned* st; };
__device__ __forceinline__ XcdBarrier xcd_barrier_post(unsigned* bar, volatile LAS unsigned* st) {
    XcdBarrier b; b.bar = bar; b.x = xb_xcc_id(); b.st = st;
    if (threadIdx.x == 0) (void)xb_add(&bar[XB_XCNT(b.x)], 1u);
    return b;
}
__device__ __forceinline__ void xcd_barrier_complete(unsigned* bar, unsigned x, unsigned& nloc, unsigned& nx) {
    const unsigned G = gridDim.x * gridDim.y * gridDim.z;
    unsigned sum, cnt, mine, sp = 0u;
    for (;;) {
        sum = 0u; cnt = 0u; mine = 0u;
#pragma unroll
        for (unsigned j = 0; j < 16; ++j) { const unsigned c = xb_ld(&bar[XB_XCNT(j)]); sum += c; cnt += (c > 0u) ? 1u : 0u; mine = (j == x) ? c : mine; }
        if (sum == G) break;
        __builtin_amdgcn_s_sleep(1);
        if ((++sp & 255u) == 0u) { if (xb_ld(&bar[XB_TMO])) break; if (sp > XB_SPIN_CAP) { atomicAdd(&bar[XB_TMO], 1u); break; } }
    }
    nloc = mine > 0u ? mine : 1u; nx = cnt > 0u ? cnt : 1u;
}
__device__ __forceinline__ void xcd_barrier(const XcdBarrier& b) {
    asm volatile("s_waitcnt vmcnt(0)" ::: "memory");
    __syncthreads();
    if (threadIdx.x == 0) {
        unsigned* bar = b.bar;
        __builtin_amdgcn_s_waitcnt(0);
        unsigned nloc = b.st[0], nx = b.st[1];
        if (nloc == 0u) { xcd_barrier_complete(bar, b.x, nloc, nx); b.st[0] = nloc; b.st[1] = nx; }
        const unsigned old = xb_add(&bar[XB_XSUB(b.x)], 1u);
        const unsigned gen = old / nloc;
        if (old + 1u == (gen + 1u) * nloc) {
            __builtin_amdgcn_fence(__ATOMIC_RELEASE, "agent");
            asm volatile("s_waitcnt vmcnt(0)" ::: "memory");
            const unsigned og = xb_add(&bar[XB_TOP], 1u);
            const unsigned tg = og / nx;
            if (og + 1u == (tg + 1u) * nx) xb_add(&bar[XB_TOPGEN], 1u);
            else XB_SPIN(xb_ld(&bar[XB_TOPGEN]) == tg, bar);
            __builtin_amdgcn_fence(__ATOMIC_ACQUIRE, "agent");
            xb_add(&bar[XB_XGEN(b.x)], 1u);
            asm volatile("s_waitcnt vmcnt(0)" ::: "memory");
        } else {
            XB_SPIN(xb_ld(&bar[XB_XGEN(b.x)]) == gen, bar);
            __builtin_amdgcn_fence(__ATOMIC_ACQUIRE, "agent");
            asm volatile("s_waitcnt vmcnt(0)" ::: "memory");
        }
    }
    __syncthreads();
}

constexpr size_t MiB = 1u << 20;
constexpr size_t WS_CTL = 0, CTL_ZERO_BYTES = 1 * MiB;
constexpr int CW_BAR = 4096;
constexpr int CW_QUEUE = 16384;
constexpr size_t WS_W13 = 2 * MiB;
constexpr size_t WS_W2  = 34 * MiB;
constexpr size_t WS_WR  = 50 * MiB;
constexpr size_t WS_MISC = 51 * MiB;
constexpr size_t WS_ROUTE = 52 * MiB;
constexpr size_t WS_RPOS = 53 * MiB;
constexpr size_t WS_ROWTOK = 54 * MiB;
constexpr size_t WS_ROPE = 55 * MiB;
constexpr size_t WS_WUQ = 56 * MiB;
constexpr size_t WS_WUKV = 57 * MiB;
constexpr size_t WS_WA = 58 * MiB;
constexpr size_t WS_WB = 59 * MiB;
constexpr size_t WS_WC = 60 * MiB;
constexpr size_t WS_WO = 61 * MiB;
constexpr size_t WS_SSQ = 63 * MiB;
constexpr size_t WS_LSE = 64 * MiB;
constexpr size_t WS_MASK = 66 * MiB;
constexpr size_t WS_XB8 = 74 * MiB;
constexpr size_t WS_WIN8 = 138 * MiB;
constexpr size_t WS_H = 146 * MiB;
constexpr size_t WS_Y = 182 * MiB;
constexpr size_t WS_SC = WS_Y;
constexpr size_t WS_G3 = 254 * MiB;
constexpr size_t WS_PROJ = 350 * MiB;
constexpr size_t WS_QM = 606 * MiB;
constexpr size_t WS_KVM = 654 * MiB;
constexpr size_t WS_OA = 718 * MiB;
constexpr size_t WS_OB = 734 * MiB;
constexpr size_t WS_OC = 750 * MiB;
constexpr size_t WS_OG = 766 * MiB;
constexpr size_t WS_M0 = 814 * MiB;
constexpr size_t WS_M1 = 846 * MiB;
constexpr size_t WS_MERGED = 878 * MiB;
constexpr size_t WS_END = 910 * MiB;
constexpr int F8_SA_X = 127 - 4, F8_SW = 127 - 10;
constexpr int MAXROWS = 139264;
constexpr int NBC = 16, TC = NBC * SEQ, NCHUNK = NB / NBC;
constexpr int CIN = 3944, PW = 4096;

constexpr int MI_BLOCKCNT = 0;
constexpr int MI_PANEL_E = 8192;
constexpr int MI_NPAN = 8192 + 1024;

constexpr int RING_BYTES = 131072;
constexpr int L_CTL = RING_BYTES;
constexpr int L_BARW = L_CTL + 32;
constexpr int L_HIST = L_CTL + 256;
constexpr int L_TOT  = L_CTL + 384;
constexpr int L_PRE  = L_CTL + 512;
constexpr int L_BASE = L_CTL + 640;
constexpr int L_RANK = L_CTL + 896;
constexpr int L_PE   = L_CTL + 1024;
constexpr int L_ROWS = L_CTL + 2048;
constexpr int LDS_BYTES = 147456;
constexpr int L_GB = L_ROWS;
static_assert(L_ROWS + 12288 <= LDS_BYTES, "LDS map");

#ifndef DUPMASK
#define DUPMASK 0
#endif
struct Args { const float* in[23]; float* out; unsigned char* ws; };
#define PHASE_IDS(F) do { int t_ = threadIdx.x; asm volatile("" : "+v"(t_)); (F).tid = t_; (F).lane = t_ & 63; { intab_t p_ = (intab_t)__builtin_amdgcn_kernarg_segment_ptr(); asm volatile("" : "+s"(p_)); (F).in.p = p_; } \
    { unsigned char GAS* w_ = (unsigned char GAS*)(F).ws0; asm volatile("" : "+s"(w_)); (F).ws = (unsigned char*)w_; float GAS* o_ = (float GAS*)(F).out0; asm volatile("" : "+s"(o_)); (F).out = (float*)o_; } } while (0)

typedef const float GAS* gfptr_t;
typedef const gfptr_t __attribute__((address_space(4)))* intab_t;
struct InTab { intab_t p; __device__ __forceinline__ const float* operator[](int i) const { return (const float*)p[i]; } };
struct Frame {
    LAS unsigned char* lds;
    int tid, lane, wave, vcu, G;
    InTab in; float* out; unsigned char* ws; float* out0; unsigned char* ws0;
};

template <class F>
__device__ __forceinline__ void conv_item(bf16_t* WT, int ldk, int k0, int n0, LAS float* scr, int lane, F val) {
#pragma unroll 8
    for (int i = 0; i < 32; ++i) { const int kk = 2 * i + (lane >> 5); scr[kk * 33 + (lane & 31)] = val(k0 + kk, n0 + (lane & 31)); }
    LDS_WAIT(); asm volatile("" ::: "memory");
    const int c = lane & 7;
#pragma unroll
    for (int j = 0; j < 4; ++j) { const int n = (lane >> 3) + 8 * j; const LAS float* s = scr + (8 * c) * 33 + n;
        u32x4 o; o.x = pk2(s[0 * 33], s[1 * 33]); o.y = pk2(s[2 * 33], s[3 * 33]); o.z = pk2(s[4 * 33], s[5 * 33]); o.w = pk2(s[6 * 33], s[7 * 33]);
        *(u32x4*)(WT + (size_t)(n0 + n) * ldk + k0 + 8 * c) = o; }
    LDS_WAIT(); asm volatile("" ::: "memory");
}

template <class F>
__device__ __forceinline__ void conv_item8(unsigned char* WT, int ldk, int k0, int n0, LAS float* scr, int lane, F val) {
#pragma unroll 8
    for (int i = 0; i < 32; ++i) { const int kk = 2 * i + (lane >> 5); scr[kk * 33 + (lane & 31)] = val(k0 + kk, n0 + (lane & 31)); }
    LDS_WAIT(); asm volatile("" ::: "memory");
    const int c = lane & 7;
#pragma unroll
    for (int j = 0; j < 4; ++j) { const int n = (lane >> 3) + 8 * j; const LAS float* s = scr + (8 * c) * 33 + n;
        u32x2 o; o.x = pk4_fp8(s[0 * 33], s[1 * 33], s[2 * 33], s[3 * 33]); o.y = pk4_fp8(s[4 * 33], s[5 * 33], s[6 * 33], s[7 * 33]);
        *(u32x2*)(WT + (size_t)(n0 + n) * ldk + k0 + 8 * c) = o; }
    LDS_WAIT(); asm volatile("" ::: "memory");
}

__device__ __forceinline__ void conv_plain8(unsigned char* WT, int ldk, int k0, int n0, LAS float* scr, int lane, const float* src, int pitch, float sc) {
    f32x4 v[8];
#pragma unroll
    for (int i = 0; i < 8; ++i) v[i] = *(const f32x4*)(src + (size_t)(k0 + (lane >> 3) + 8 * i) * pitch + n0 + (lane & 7) * 4);
#pragma unroll
    for (int i = 0; i < 8; ++i) { LAS float* d = scr + ((lane >> 3) + 8 * i) * 33 + (lane & 7) * 4; d[0] = v[i][0] * sc; d[1] = v[i][1] * sc; d[2] = v[i][2] * sc; d[3] = v[i][3] * sc; }
    LDS_WAIT(); asm volatile("" ::: "memory");
    const int c = lane & 7;
#pragma unroll
    for (int j = 0; j < 4; ++j) { const int n = (lane >> 3) + 8 * j; const LAS float* s = scr + (8 * c) * 33 + n;
        u32x2 o; o.x = pk4_fp8(s[0 * 33], s[1 * 33], s[2 * 33], s[3 * 33]); o.y = pk4_fp8(s[4 * 33], s[5 * 33], s[6 * 33], s[7 * 33]);
        *(u32x2*)(WT + (size_t)(n0 + n) * ldk + k0 + 8 * c) = o; }
    LDS_WAIT(); asm volatile("" ::: "memory");
}
__device__ __forceinline__ void conv_pair8(unsigned char* WT, int ldk, int k0, int n0, LAS float* scr, int lane, const float* a, const float* b, int pitch, float sc) {
    f32x2 va[8], vb[8];
#pragma unroll
    for (int i = 0; i < 8; ++i) { const size_t o = (size_t)(k0 + (lane >> 3) + 8 * i) * pitch + (n0 >> 1) + (lane & 7) * 2; va[i] = *(const f32x2*)(a + o); vb[i] = *(const f32x2*)(b + o); }
#pragma unroll
    for (int i = 0; i < 8; ++i) { LAS float* d = scr + ((lane >> 3) + 8 * i) * 33 + (lane & 7) * 4; d[0] = va[i][0] * sc; d[1] = vb[i][0] * sc; d[2] = va[i][1] * sc; d[3] = vb[i][1] * sc; }
    LDS_WAIT(); asm volatile("" ::: "memory");
    const int c = lane & 7;
#pragma unroll
    for (int j = 0; j < 4; ++j) { const int n = (lane >> 3) + 8 * j; const LAS float* s = scr + (8 * c) * 33 + n;
        u32x2 o; o.x = pk4_fp8(s[0 * 33], s[1 * 33], s[2 * 33], s[3 * 33]); o.y = pk4_fp8(s[4 * 33], s[5 * 33], s[6 * 33], s[7 * 33]);
        *(u32x2*)(WT + (size_t)(n0 + n) * ldk + k0 + 8 * c) = o; }
    LDS_WAIT(); asm volatile("" ::: "memory");
}

__device__ __forceinline__ void phase_conv_moe(Frame& F, int l) {
    PHASE_IDS(F);
    LAS float* scr = (LAS float*)(F.lds + F.wave * 16384);
    const int gw = F.vcu * NWAVES + F.wave, NGW = F.G * NWAVES;
    const float* w1 = F.in[18] + (size_t)l * NEXP * DM * DEXP;
    const float* w3 = F.in[19] + (size_t)l * NEXP * DM * DEXP;
    const float* w2 = F.in[20] + (size_t)l * NEXP * DEXP * DM;
    bf16_t* W13 = (bf16_t*)(F.ws + WS_W13); bf16_t* W2 = (bf16_t*)(F.ws + WS_W2);
    constexpr int I13 = (DM / 64) * (512 / 32);
    constexpr int I2 = (DEXP / 64) * (DM / 32);
    for (int it = gw; it < NEXP * (I13 + I2); it += NGW) {
        if (it < NEXP * I13) {
            const int e = it / I13, r = it % I13, kb = r / 16, nb = r % 16;
            const float* a = w1 + (size_t)e * DM * DEXP; const float* b = w3 + (size_t)e * DM * DEXP;
            conv_pair8((unsigned char*)W13 + (size_t)e * 512 * DM, DM, kb * 64, nb * 32, scr, F.lane, a, b, DEXP, 1024.f);
        } else {
            const int it2 = it - NEXP * I13; const int e = it2 / I2, r = it2 % I2, kb = r / 32, nb = r % 32;
            const float* a = w2 + (size_t)e * DEXP * DM;
            conv_plain8((unsigned char*)W2 + (size_t)e * DM * DEXP, DEXP, kb * 64, nb * 32, scr, F.lane, a, DM, 1024.f);
        }
    }
    const float* wg = F.in[14] + (size_t)l * DM * 4; const float* wsb = F.in[16] + (size_t)l * DM * NEXP;
    const float* g1 = F.in[12] + (size_t)l * DM; const float* b1 = F.in[13] + (size_t)l * DM;
    bf16_t* WRH = (bf16_t*)(F.ws + WS_WR); bf16_t* WRL = (bf16_t*)(F.ws + WS_WR + 128 * 1024); float* WRC = (float*)(F.ws + WS_WR + 256 * 1024);
    for (int idx = (F.vcu * NTHREADS + F.tid); idx < 64 * DM; idx += F.G * NTHREADS) {
        const int c = idx / DM, k = idx % DM;
        const float v = (c < 32 ? wsb[(size_t)k * NEXP + c] : (c < 36 ? wg[(size_t)k * 4 + (c - 32)] : 0.f)) * g1[k];
        const unsigned h = f2bf(v); const int it = k >> 5, hi_ = (k >> 4) & 1, st = (k >> 3) & 1, e = k & 7, ln = (c & 31) + 32 * hi_, p0 = 2 * (c >> 5);
        WRH[((((size_t)it * 4 + p0) * 2 + st) * 64 + ln) * 8 + e] = (bf16_t)h;
        WRH[((((size_t)it * 4 + p0 + 1) * 2 + st) * 64 + ln) * 8 + e] = (bf16_t)f2bf(v - __builtin_bit_cast(float, h << 16)); (void)WRL;
    }
    if (gw < 64) {
        const int c = gw; float s1 = 0.f, s2 = 0.f;
        for (int k = F.lane; k < DM; k += 64) { const float w = c < 32 ? wsb[(size_t)k * NEXP + c] : (c < 36 ? wg[(size_t)k * 4 + (c - 32)] : 0.f); s1 += g1[k] * w; s2 += b1[k] * w; }
        s1 = wave_sum(s1); s2 = wave_sum(s2);
        const float bias = c < 32 ? F.in[17][(size_t)l * NEXP + c] : (c < 36 ? F.in[15][(size_t)l * 4 + (c - 32)] : 0.f);
        if (F.lane == 0) { WRC[c] = s1; WRC[64 + c] = s2 + bias; }
    }
}

__device__ __forceinline__ void ln_row(f32x4 (&v)[4], const f32x4 (&g)[4], const f32x4 (&b)[4], float* omean = nullptr, float* orstd = nullptr) {
    float s = 0.f;
#pragma unroll
    for (int j = 0; j < 4; ++j) s += (v[j].x + v[j].y) + (v[j].z + v[j].w);
    const float mean = wave_sum(s) * (1.f / DM); float s2 = 0.f;
#pragma unroll
    for (int j = 0; j < 4; ++j) { v[j] = v[j] - mean; s2 += (v[j].x * v[j].x + v[j].y * v[j].y) + (v[j].z * v[j].z + v[j].w * v[j].w); }
    const float rstd = 1.0f / sqrtf(wave_sum(s2) * (1.f / DM) + LN_EPS);
#pragma unroll
    for (int j = 0; j < 4; ++j) v[j] = v[j] * rstd * g[j] + b[j];
    if (omean) { *omean = mean; *orstd = rstd; }
}
__device__ __forceinline__ void store_row(const f32x4 (&v)[4], float* orow, unsigned char* brow, int lane) {
#pragma unroll
    for (int j = 0; j < 4; ++j) {
        ((f32x4*)orow)[lane + 64 * j] = v[j];
        ((unsigned*)brow)[lane + 64 * j] = pk4_fp8(v[j].x * 16.f, v[j].y * 16.f, v[j].z * 16.f, v[j].w * 16.f);
    }
}

__device__ __forceinline__ void phase_ln1_router(Frame& F, int l, const float* src, bool scale_alpha) {
    PHASE_IDS(F);
    const int lane = F.lane, hi = lane >> 5, r32 = lane & 31;
    const float* lg = F.in[12] + (size_t)l * DM; const float* lb = F.in[13] + (size_t)l * DM;
    f32x4 g[4], b[4];
#pragma unroll
    for (int j = 0; j < 4; ++j) { g[j] = ((const f32x4*)lg)[lane + 64 * j]; b[j] = ((const f32x4*)lb)[lane + 64 * j]; }
    unsigned char* XB = F.ws + WS_XB8;
    const bf16_t* WRH = (const bf16_t*)(F.ws + WS_WR); const bf16_t* WRL = (const bf16_t*)(F.ws + WS_WR + 128 * 1024);
    const float* WRC = (const float*)(F.ws + WS_WR + 256 * 1024); float* stats = (float*)(F.ws + WS_WR + 512 * 1024);
    unsigned* misc = (unsigned*)(F.ws + WS_MISC);
    int* route = (int*)(F.ws + WS_ROUTE);
    LAS unsigned* hist = (LAS unsigned*)(F.lds + L_HIST);
    const float sc = scale_alpha ? ALPHA : 1.0f;
    for (int blk = F.vcu; blk < TT / 256; blk += F.G) {
        if (F.tid < 32) hist[F.tid] = 0u;
        __syncthreads();
        const int row0 = blk * 256 + F.wave * 32;
        float mu_l = 0.f, rs_l = 1.f;
        for (int i = 0; i < 32; i += 2) {
            f32x4 v0[4], v1[4];
            const f32x4* p0 = (const f32x4*)(src + (size_t)(row0 + i) * DM); const f32x4* p1 = (const f32x4*)(src + (size_t)(row0 + i + 1) * DM);
#pragma unroll
            for (int j = 0; j < 4; ++j) { v0[j] = p0[lane + 64 * j] * sc; v1[j] = p1[lane + 64 * j] * sc; }
            float m0, r0, m1, r1;
            ln_row(v0, g, b, &m0, &r0); ln_row(v1, g, b, &m1, &r1);
            mu_l = (r32 == i) ? m0 : ((r32 == i + 1) ? m1 : mu_l); rs_l = (r32 == i) ? r0 : ((r32 == i + 1) ? r1 : rs_l);
#pragma unroll
            for (int j = 0; j < 4; ++j) {
                ((unsigned*)(XB + (size_t)(row0 + i) * DM))[lane + 64 * j] = pk4_fp8(v0[j].x * 16.f, v0[j].y * 16.f, v0[j].z * 16.f, v0[j].w * 16.f);
                ((unsigned*)(XB + (size_t)(row0 + i + 1) * DM))[lane + 64 * j] = pk4_fp8(v1[j].x * 16.f, v1[j].y * 16.f, v1[j].z * 16.f, v1[j].w * 16.f); }
        }
        if (hi == 0) *(f32x2*)(stats + (size_t)(row0 + r32) * 2) = (f32x2){mu_l, rs_l};
        f32x16 acc0 = {}, acc1 = {};
        {
            const bf16_t* WT = WRH; (void)WRL;
            LAS float* xs = (LAS float*)(F.lds + F.wave * 9216);
            const float* xg = src + (size_t)(row0 + (lane >> 3)) * DM + (lane & 7) * 4;
            f32x4 xv[4]; bf16x8 wv[8];
#pragma unroll
            for (int i = 0; i < 4; ++i) xv[i] = *(const f32x4*)(xg + (size_t)(8 * i) * DM);
#pragma unroll
            for (int q = 0; q < 8; ++q) wv[q] = *(const bf16x8*)(WT + ((size_t)q * 64 + lane) * 8);
#pragma unroll 2
            for (int it = 0; it < 32; ++it) {
                LAS float* xb = xs + (it & 1) * 1152;
#pragma unroll
                for (int i = 0; i < 4; ++i) *(LAS f32x4*)(xb + ((lane >> 3) + 8 * i) * 36 + (lane & 7) * 4) = xv[i];
                bf16x8 wc[8];
#pragma unroll
                for (int q = 0; q < 8; ++q) wc[q] = wv[q];
                { const int nx = it + 1 < 32 ? it + 1 : 31;
#pragma unroll
                  for (int i = 0; i < 4; ++i) xv[i] = *(const f32x4*)(xg + (size_t)(8 * i) * DM + nx * 32);
#pragma unroll
                  for (int q = 0; q < 8; ++q) wv[q] = *(const bf16x8*)(WT + (((size_t)nx * 8 + q) * 64 + lane) * 8); }
                f32x4 xa[4];
#pragma unroll
                for (int j = 0; j < 4; ++j) xa[j] = *(const LAS f32x4*)(xb + r32 * 36 + hi * 16 + 4 * j);
#pragma unroll
                for (int st = 0; st < 2; ++st) {
                    const f32x4 x0 = xa[2 * st], x1 = xa[2 * st + 1];
                    u32x4 xh, xl;
                    xh.x = cvt_pk_bf16(x0[0], x0[1]); xh.y = cvt_pk_bf16(x0[2], x0[3]); xh.z = cvt_pk_bf16(x1[0], x1[1]); xh.w = cvt_pk_bf16(x1[2], x1[3]);
                    xl.x = cvt_pk_bf16(x0[0] - bflo(xh.x), x0[1] - bfhi(xh.x)); xl.y = cvt_pk_bf16(x0[2] - bflo(xh.y), x0[3] - bfhi(xh.y));
                    xl.z = cvt_pk_bf16(x1[0] - bflo(xh.z), x1[1] - bfhi(xh.z)); xl.w = cvt_pk_bf16(x1[2] - bflo(xh.w), x1[3] - bfhi(xh.w));
                    const bf16x8 xhv = __builtin_bit_cast(bf16x8, xh), xlv = __builtin_bit_cast(bf16x8, xl);
                    acc0 = __builtin_amdgcn_mfma_f32_32x32x16_bf16(wc[0 + st], xhv, acc0, 0, 0, 0); acc1 = __builtin_amdgcn_mfma_f32_32x32x16_bf16(wc[4 + st], xhv, acc1, 0, 0, 0);
                    acc0 = __builtin_amdgcn_mfma_f32_32x32x16_bf16(wc[2 + st], xhv, acc0, 0, 0, 0); acc1 = __builtin_amdgcn_mfma_f32_32x32x16_bf16(wc[6 + st], xhv, acc1, 0, 0, 0);
                    acc0 = __builtin_amdgcn_mfma_f32_32x32x16_bf16(wc[0 + st], xlv, acc0, 0, 0, 0); acc1 = __builtin_amdgcn_mfma_f32_32x32x16_bf16(wc[4 + st], xlv, acc1, 0, 0, 0);
                }
            }
        }
        float gl[4];
#pragma unroll
        for (int i = 0; i < 4; ++i) gl[i] = rs_l * (acc1[i] - mu_l * WRC[32 + i]) + WRC[64 + 32 + i];
        int gidx = 0; float gmax = gl[0];
#pragma unroll
        for (int i = 1; i < 4; ++i) if (gl[i] > gmax) { gmax = gl[i]; gidx = i; }
        float gsum = 0.f;
#pragma unroll
        for (int i = 0; i < 4; ++i) gsum += fast_exp(gl[i] - gmax);
        float gp = 1.0f / gsum;
        gidx = __shfl(gidx, r32); gp = __shfl(gp, r32);
        float cv[4];
#pragma unroll
        for (int i = 0; i < 4; ++i) {
            const float a = gidx == 0 ? acc0[i] : gidx == 1 ? acc0[4 + i] : gidx == 2 ? acc0[8 + i] : acc0[12 + i];
            cv[i] = rs_l * (a - mu_l * WRC[8 * gidx + 4 * hi + i]) + WRC[64 + 8 * gidx + 4 * hi + i];
        }
        float v1 = cv[0]; int i1 = 0;
#pragma unroll
        for (int i = 1; i < 4; ++i) if (cv[i] > v1) { v1 = cv[i]; i1 = i; }
        float v2 = -INFINITY; int i2 = 0;
#pragma unroll
        for (int i = 0; i < 4; ++i) if (i != i1 && cv[i] > v2) { v2 = cv[i]; i2 = i; }
        i1 += 4 * hi; i2 += 4 * hi;
        const float pv1 = __shfl_xor(v1, 32), pv2 = __shfl_xor(v2, 32); const int pi1 = __shfl_xor(i1, 32), pi2 = __shfl_xor(i2, 32);
        auto better = [](float av, int ai, float bv, int bi) { return av > bv || (av == bv && ai < bi); };
        float fv, sv; int fi, si;
        if (better(v1, i1, pv1, pi1)) { fv = v1; fi = i1; if (better(v2, i2, pv1, pi1)) { sv = v2; si = i2; } else { sv = pv1; si = pi1; } }
        else { fv = pv1; fi = pi1; if (better(v1, i1, pv2, pi2)) { sv = v1; si = i1; } else { sv = pv2; si = pi2; } }
        const float d = fast_exp(sv - fv), inv = 1.0f / (1.0f + d);
        const float w1 = gp * inv, w2 = gp * d * inv;
        const int e1 = 8 * gidx + fi, e2 = 8 * gidx + si;
        if (hi == 0) {
            *(int4*)(route + (size_t)(row0 + r32) * 4) = make_int4(e1, e2, __float_as_int(w1), __float_as_int(w2));
            atomicAdd((unsigned*)&hist[e1], 1u); atomicAdd((unsigned*)&hist[e2], 1u);
        }
        __syncthreads();
        if (F.tid < 32) misc[MI_BLOCKCNT + blk * 32 + F.tid] = hist[F.tid];
        __syncthreads();
    }
}

__device__ __forceinline__ void phase_moe_scatter(Frame& F) {
    PHASE_IDS(F);
    unsigned* misc = (unsigned*)(F.ws + WS_MISC);
    const int* route = (const int*)(F.ws + WS_ROUTE);
    int* rpos = (int*)(F.ws + WS_RPOS); int* rowtok = (int*)(F.ws + WS_ROWTOK);
    LAS unsigned* tot = (LAS unsigned*)(F.lds + L_TOT); LAS unsigned* pre = (LAS unsigned*)(F.lds + L_PRE);
    LAS unsigned* base = (LAS unsigned*)(F.lds + L_BASE); LAS unsigned* rank = (LAS unsigned*)(F.lds + L_RANK);
    for (int blk = F.vcu; blk < TT / 256; blk += F.G) {
        {
            if (F.tid < 32) { tot[F.tid] = 0u; pre[F.tid] = 0u; rank[F.tid] = 0u; }
            __syncthreads();
            const int e = F.tid & 31, part = F.tid >> 5; unsigned cv[16];
#pragma unroll
            for (int i = 0; i < 16; ++i) cv[i] = misc[MI_BLOCKCNT + (part * 16 + i) * 32 + e];
            unsigned t = 0, p = 0;
#pragma unroll
            for (int i = 0; i < 16; ++i) { t += cv[i]; p += (part * 16 + i < blk) ? cv[i] : 0u; }
            atomicAdd((unsigned*)&tot[e], t); atomicAdd((unsigned*)&pre[e], p);
        }
        __syncthreads();
        if (F.tid == 0) { unsigned a = 0; for (int e = 0; e < NEXP; ++e) { base[e] = a; a += (tot[e] + 255u) & ~255u; } base[NEXP] = a; }
        __syncthreads();
        {
            const int tok = blk * 256 + (F.tid >> 1), slot = F.tid & 1;
            const int e = route[(size_t)tok * 4 + slot];
            const unsigned r = atomicAdd((unsigned*)&rank[e], 1u);
            const unsigned pos = base[e] + pre[e] + r;
            rowtok[pos] = tok; rpos[(size_t)tok * 2 + slot] = (int)pos;
        }
        if (blk < NEXP) {
            const int e = blk; const unsigned end = base[e] + tot[e], nxt = base[e + 1];
            for (unsigned p = end + F.tid; p < nxt; p += NTHREADS) rowtok[p] = 0;
            for (unsigned p = base[e] / 256 + F.tid; p < nxt / 256; p += NTHREADS) misc[MI_PANEL_E + p] = (unsigned)e;
        }
        if (blk == 0 && F.tid == 0) misc[MI_NPAN] = base[NEXP] / 256;
        __syncthreads();
    }
}

struct MoeSched1 {
    static constexpr bool GATHER = true;
    const bf16_t* A; const bf16_t* W; int lda, ldb, ntot, G, c; const LAS int* rows; const LAS int* pe; int sw8, sa8;
    __device__ __forceinline__ bool next(int i, pg8::Unit& u) const { const int v = i * G + c; if (v >= ntot) return false; u.pm = v >> 1; u.pn = v & 1; u.ord = i; return true; }
    __device__ __forceinline__ const char* a_base(const pg8::Unit&) const { return (const char*)A; }
    __device__ __forceinline__ const char* b_base(const pg8::Unit& u) const { return (const char*)(W + (size_t)pe[u.ord] * 512 * ldb + (size_t)u.pn * 256 * ldb); }
    __device__ __forceinline__ void a_off(const pg8::Unit& u, const int (&R)[2], const int (&C)[2], unsigned (&v)[2][2]) const {
#pragma unroll
        for (int h = 0; h < 2; ++h)
#pragma unroll
            for (int i = 0; i < 2; ++i) v[h][i] = (unsigned)(rows[u.ord * 256 + h * 128 + R[i]] * lda + C[i]) * 2u;
    }
};
struct MoeSched2 {
    static constexpr bool GATHER = false;
    const bf16_t* A; const bf16_t* W; int lda, ldb, ntot, G, c; const LAS int* pe; int sw8, sa8;
    __device__ __forceinline__ bool next(int i, pg8::Unit& u) const { const int v = i * G + c; if (v >= ntot) return false; u.pm = v >> 2; u.pn = v & 3; u.ord = i; return true; }
    __device__ __forceinline__ const char* a_base(const pg8::Unit& u) const { return (const char*)(A + (size_t)u.pm * 256 * lda); }
    __device__ __forceinline__ const char* b_base(const pg8::Unit& u) const { return (const char*)(W + (size_t)pe[u.ord] * DM * ldb + (size_t)u.pn * 256 * ldb); }
    __device__ __forceinline__ void a_off(const pg8::Unit&, const int (&R)[2], const int (&C)[2], unsigned (&v)[2][2]) const {
#pragma unroll
        for (int i = 0; i < 2; ++i) { v[0][i] = (unsigned)(R[i] * lda + C[i]) * 2u; v[1][i] = (unsigned)((128 + R[i]) * lda + C[i]) * 2u; }
    }
};
struct EpiSwiGLU {
    bf16_t* H;
    __device__ __forceinline__ void operator()(const f32x4 (&acc)[2][2][4][2], const pg8::Unit& u, int wr, int wc, int fr, int fq) const {
        const int row0 = u.pm * 256 + wr * 64 + fr, col0 = u.pn * 128 + wc * 16 + 4 * fq;
#pragma unroll
        for (int ai = 0; ai < 2; ++ai)
#pragma unroll
            for (int m = 0; m < 4; ++m) { bf16_t* rowp = H + (size_t)(row0 + ai * 128 + m * 16) * DEXP + col0;
#pragma unroll
                for (int bj = 0; bj < 2; ++bj) { const f32x4 v0 = acc[ai][bj][m][0], v1 = acc[ai][bj][m][1];
                    const float h0 = v0[0] * sigmoidf_(v0[0]) * v0[1], h1 = v0[2] * sigmoidf_(v0[2]) * v0[3], h2 = v1[0] * sigmoidf_(v1[0]) * v1[1], h3 = v1[2] * sigmoidf_(v1[2]) * v1[3];
                    *(unsigned*)((unsigned char*)H + (size_t)(row0 + ai * 128 + m * 16) * DEXP + col0 + bj * 64) = pk4_fp8(h0 * 16.f, h1 * 16.f, h2 * 16.f, h3 * 16.f); (void)rowp; } }
    }
};
struct EpiStoreBf16 {
    bf16_t* O; int ldc;
    __device__ __forceinline__ void operator()(const f32x4 (&acc)[2][2][4][2], const pg8::Unit& u, int wr, int wc, int fr, int fq) const {
        const int row0 = u.pm * 256 + wr * 64 + fr, col0 = u.pn * 256 + wc * 32 + 8 * fq;
#pragma unroll
        for (int ai = 0; ai < 2; ++ai)
#pragma unroll
            for (int m = 0; m < 4; ++m) { bf16_t* rowp = O + (size_t)(row0 + ai * 128 + m * 16) * ldc + col0;
#pragma unroll
                for (int bj = 0; bj < 2; ++bj) store8_fp8((unsigned char*)O + (size_t)(row0 + ai * 128 + m * 16) * ldc + col0 + bj * 128, acc[ai][bj][m][0], acc[ai][bj][m][1], 64.f); (void)rowp; }
    }
};

__device__ __forceinline__ void phase_moe_gemm1(Frame& F) {
    PHASE_IDS(F);
    const unsigned* misc = (const unsigned*)(F.ws + WS_MISC);
    const int* rowtok = (const int*)(F.ws + WS_ROWTOK);
    const int npan = (int)misc[MI_NPAN];
    LAS int* rows = (LAS int*)(F.lds + L_ROWS); LAS int* pe = (LAS int*)(F.lds + L_PE);
    const int c = (int)blockIdx.x, ntot = npan * 2;
    for (int i = 0; i * F.G + c < ntot && i < 8; ++i) { const int p = (i * F.G + c) >> 1;
        if (F.tid < 256) rows[i * 256 + F.tid] = rowtok[p * 256 + F.tid];
        if (F.tid == 256) pe[i] = (int)misc[MI_PANEL_E + p]; }
    VM_WAIT(); LDS_WAIT(); __syncthreads();
    MoeSched1 S{(const bf16_t*)(F.ws + WS_XB8), (const bf16_t*)(F.ws + WS_W13), DM / 2, DM / 2, ntot, F.G, c, rows, pe, F8_SW, F8_SA_X};
    EpiSwiGLU E{(bf16_t*)(F.ws + WS_H)};
    pg8::gemm_phase<EpiSwiGLU, MoeSched1, true, true>(F.lds, DM / 2, S, E);
}
__device__ __forceinline__ void phase_moe_gemm2(Frame& F) {
    PHASE_IDS(F);
    const unsigned* misc = (const unsigned*)(F.ws + WS_MISC);
    const int npan = (int)misc[MI_NPAN];
    LAS int* pe = (LAS int*)(F.lds + L_PE);
    const int c = (int)blockIdx.x, ntot = npan * 4;
    __syncthreads();
    if (F.tid < 16) { const int v = F.tid * F.G + c; if (v < ntot) pe[F.tid] = (int)misc[MI_PANEL_E + (v >> 2)]; }
    VM_WAIT(); LDS_WAIT(); __syncthreads();
    MoeSched2 S{(const bf16_t*)(F.ws + WS_H), (const bf16_t*)(F.ws + WS_W2), DEXP / 2, DEXP / 2, ntot, F.G, c, pe, F8_SW, 127 - 4};
    EpiStoreBf16 E{(bf16_t*)(F.ws + WS_Y), DM};
    int k2 = DEXP / 2; asm volatile("" : "+s"(k2));
    pg8::gemm_phase<EpiStoreBf16, MoeSched2, true, true>(F.lds, k2, S, E);
}

__device__ __forceinline__ void phase_combine_ln2(Frame& F, int l) {
    PHASE_IDS(F);
    const int lane = F.lane;
    const float* lg = F.in[21] + (size_t)l * DM; const float* lb = F.in[22] + (size_t)l * DM;
    f32x4 g[4], b[4];
#pragma unroll
    for (int j = 0; j < 4; ++j) { g[j] = ((const f32x4*)lg)[lane + 64 * j]; b[j] = ((const f32x4*)lb)[lane + 64 * j]; }
    const bf16_t* Y = (const bf16_t*)(F.ws + WS_Y);
    const float* l1g = F.in[12] + (size_t)l * DM; const float* l1b = F.in[13] + (size_t)l * DM; const float* stats = (const float*)(F.ws + WS_WR + 512 * 1024);
    f32x4 g1[4], b1[4];
#pragma unroll
    for (int j = 0; j < 4; ++j) { g1[j] = ((const f32x4*)l1g)[lane + 64 * j]; b1[j] = ((const f32x4*)l1b)[lane + 64 * j]; }
    const int* route = (const int*)(F.ws + WS_ROUTE); const int* rpos = (const int*)(F.ws + WS_RPOS);
    const int gw = F.vcu * NWAVES + F.wave, NGW = F.G * NWAVES;
    auto recs = [&](int r, int4& rt, int2& rp, f32x2& st) { rt = *(const int4*)(route + (size_t)r * 4); rp = *(const int2*)(rpos + (size_t)r * 2); st = *(const f32x2*)(stats + (size_t)r * 2); };
    auto rowload = [&](int r, const int2& rp, f32x4 (&x)[4], unsigned (&ya)[4], unsigned (&yc)[4]) {
        const f32x4* px = (const f32x4*)(F.out + (size_t)r * DM);
        const unsigned* y0 = (const unsigned*)((const unsigned char*)Y + (size_t)rp.x * DM); const unsigned* y1 = (const unsigned*)((const unsigned char*)Y + (size_t)rp.y * DM);
#pragma unroll
        for (int j = 0; j < 4; ++j) { x[j] = __builtin_nontemporal_load(px + lane + 64 * j); ya[j] = __builtin_nontemporal_load(y0 + lane + 64 * j); yc[j] = __builtin_nontemporal_load(y1 + lane + 64 * j); } };
    int4 rt_c, rt_n; int2 rp_c, rp_n; f32x2 st_c, st_n;
    recs(gw, rt_c, rp_c, st_c);
    { const int r1 = gw + NGW < TT ? gw + NGW : gw; recs(r1, rt_n, rp_n, st_n); }
    f32x4 xc[4]; unsigned yac[4], ycc[4];
    rowload(gw, rp_c, xc, yac, ycc);
    for (int row = gw; row < TT; row += NGW) {
        const int r1 = row + NGW < TT ? row + NGW : row, r2 = row + 2 * NGW < TT ? row + 2 * NGW : row;
        f32x4 xn[4]; unsigned yan[4], ycn[4];
        rowload(r1, rp_n, xn, yan, ycn);
        int4 rt_2; int2 rp_2; f32x2 st_2; recs(r2, rt_2, rp_2, st_2);
        const float w0 = __int_as_float(rt_c.z) * (1.f / 64.f), w1 = __int_as_float(rt_c.w) * (1.f / 64.f);
        f32x4 v[4];
#pragma unroll
        for (int j = 0; j < 4; ++j) {
            const f32x4 x = (xc[j] - st_c[0]) * st_c[1] * g1[j] + b1[j]; const unsigned a = yac[j], c = ycc[j];
            const f32x2 a01 = __builtin_amdgcn_cvt_pk_f32_fp8((int)a, false), a23 = __builtin_amdgcn_cvt_pk_f32_fp8((int)a, true), c01 = __builtin_amdgcn_cvt_pk_f32_fp8((int)c, false), c23 = __builtin_amdgcn_cvt_pk_f32_fp8((int)c, true);
            v[j].x = ALPHA * x.x + w0 * a01[0] + w1 * c01[0]; v[j].y = ALPHA * x.y + w0 * a01[1] + w1 * c01[1];
            v[j].z = ALPHA * x.z + w0 * a23[0] + w1 * c23[0]; v[j].w = ALPHA * x.w + w0 * a23[1] + w1 * c23[1];
        }
        ln_row(v, g, b);
#pragma unroll
        for (int j = 0; j < 4; ++j) __builtin_nontemporal_store(v[j], (f32x4*)(F.out + (size_t)row * DM) + lane + 64 * j);
        if (l == 0) {
#pragma unroll
            for (int j = 0; j < 4; ++j) ((unsigned*)(F.ws + WS_XB8 + (size_t)row * DM))[lane + 64 * j] = pk4_fp8(v[j].x * 16.f, v[j].y * 16.f, v[j].z * 16.f, v[j].w * 16.f);
        }
        rt_c = rt_n; rp_c = rp_n; st_c = st_n; rt_n = rt_2; rp_n = rp_2; st_n = st_2;
#pragma unroll
        for (int j = 0; j < 4; ++j) { xc[j] = xn[j]; yac[j] = yan[j]; ycc[j] = ycn[j]; }
    }
}

constexpr float C2D = 0.18033688011112042f;
constexpr float C2M = 0.14724444602590306f;
constexpr float IWS = 0.044194173824159216f;
constexpr float RMS_EPS = 1e-6f;
constexpr int L_QSLOT = L_CTL + 1152;

__device__ __forceinline__ int rope16(int c) { return c < 16 ? (c >> 1) + 8 * (c & 1) : c; }
__device__ __forceinline__ int win_src(int n, float& sc) {
    sc = 1.f;
    if (n < 384) return n;
    if (n < 416) { const int c = n - 384; return 384 + (c >> 1) + 16 * (c & 1); }
    if (n < 512) return -1;
    if (n < 2816) { const int m = n - 512, g = m / 768, r = m % 768, p = r >> 8, hh = (r & 255) >> 6, c = r & 63; if (p == 0) sc = C2D; return 416 + 768 * g + 256 * p + 64 * hh + (p < 2 ? rope16(c) : c); }
    if (n < 3328) { const int m = n - 2816; sc = C2D; return 2720 + (m & ~63) + rope16(m & 63); }
    if (n < 3840) { const int m = n - 3328; return 3360 + (m & ~63) + rope16(m & 63); }
    const int m = n - 3840;
    if (m < 64) return 3232 + rope16(m);
    if (m < 128) return 3296 + (m - 64);
    if (m < 192) return 3872 + rope16(m - 128);
    if (m < 200) { sc = IWS; return 3936 + (m - 192); }
    return -1;
}

__device__ __forceinline__ void sincos_d(double x, double& s, double& c) {
    const double n = __builtin_rint(x * 0.15915494309189535);
    double r = __builtin_fma(-n, 6.2831854820251465, x); r = __builtin_fma(n, 1.7484556025237907e-07, r);
    const double r2 = r * r; double ss = 1.0, cc = 1.0;
#pragma unroll
    for (int k = 15; k >= 1; --k) { ss = 1.0 - r2 * (1.0 / (double)((2 * k) * (2 * k + 1))) * ss; cc = 1.0 - r2 * (1.0 / (double)((2 * k - 1) * (2 * k))) * cc; }
    s = ss * r; c = cc;
}
__device__ __forceinline__ double inv_freq16(int i) {
    const double t[16] = {1.0, 0.44036660267178046, 0.19392274474868576, 0.08539710028576561, 0.03760603093086393, 0.016560440080994446, 0.007292664737217109, 0.003211445994752591,
                          0.001414213562373095, 0.000622772421914596, 0.0002742481756762073, 0.00012076973741146504, 5.318295896944988e-05, 2.341999896140934e-05, 1.031338537721246e-05, 4.5416704806078695e-06};
    double r = t[0];
#pragma unroll
    for (int k = 1; k < 16; ++k) r = (i == k) ? t[k] : r;
    return r;
}

__device__ __forceinline__ void phase_conv_mixer(Frame& F, int l) {
    PHASE_IDS(F);
    LAS float* scr = (LAS float*)(F.lds + F.wave * 16384);
    const int gw = F.vcu * NWAVES + F.wave, NGW = F.G * NWAVES;
    const float* win = F.in[1] + (size_t)l * DM * CIN;
    const float* qg = F.in[2] + (size_t)l * 256; const float* wuq = F.in[3] + (size_t)l * 256 * 768;
    const float* kg = F.in[4] + (size_t)l * 128; const float* wukv = F.in[5] + (size_t)l * 128 * 1024;
    const float* wgate = F.in[6] + (size_t)l * DM * 3072;
    const float* wa = F.in[8] + (size_t)l * 512 * DM; const float* wb = F.in[9] + (size_t)l * 256 * DM; const float* wc = F.in[10] + (size_t)l * 512 * DM; const float* wo = F.in[11] + (size_t)l * DM * DM;
    unsigned char* WIN8 = F.ws + WS_WIN8; bf16_t* WUQ = (bf16_t*)(F.ws + WS_WUQ); bf16_t* WUKV = (bf16_t*)(F.ws + WS_WUKV);
    bf16_t* WA = (bf16_t*)(F.ws + WS_WA); bf16_t* WB = (bf16_t*)(F.ws + WS_WB); bf16_t* WC = (bf16_t*)(F.ws + WS_WC); bf16_t* WO = (bf16_t*)(F.ws + WS_WO);
    constexpr int I_IN = 16 * 128, I_G = 16 * 96, I_UQ = 4 * 24, I_UKV = 4 * 32, I_A = 8 * 32, I_B = 8 * 32, I_C = 8 * 32, I_O = 16 * 32;
    constexpr int NIT = I_IN + I_G + I_UQ + I_UKV + I_A + I_B + I_C + I_O;
    for (int it = gw; it < NIT; it += NGW) {
        int r = it;
        if (r < I_IN) { conv_item8(WIN8, DM, (r / 128) * 64, (r % 128) * 32, scr, F.lane, [&](int k, int n) { float sc; const int sidx = win_src(n, sc); return sidx < 0 ? 0.f : win[(size_t)k * CIN + sidx] * (sc * 1024.f); }); continue; } r -= I_IN;
        if (r < I_G) { conv_plain8(WIN8 + (size_t)PW * DM, DM, (r / 96) * 64, (r % 96) * 32, scr, F.lane, wgate, 3072, 1024.f); continue; } r -= I_G;
        if (r < I_UQ) { conv_item(WUQ, 256, (r / 24) * 64, (r % 24) * 32, scr, F.lane, [&](int k, int n) { const int hh = n / 96, c = n % 96; const int o = c < 64 ? c : 64 + ((c - 64) >> 1) + 16 * ((c - 64) & 1);
                return qg[k] * wuq[(size_t)k * 768 + hh * 96 + o] * C2M; }); continue; } r -= I_UQ;
        if (r < I_UKV) { conv_item(WUKV, 256, (r / 32) * 64, (r % 32) * 32, scr, F.lane, [&](int k, int n) { return k < 128 ? kg[k] * wukv[(size_t)k * 1024 + n] : 0.f; }); continue; } r -= I_UKV;
        if (r < I_A) { conv_plain8((unsigned char*)WA, 512, (r / 32) * 64, (r % 32) * 32, scr, F.lane, wa, DM, 1024.f); continue; } r -= I_A;
        if (r < I_B) { conv_item8((unsigned char*)WB, 512, (r / 32) * 64, (r % 32) * 32, scr, F.lane, [&](int k, int n) { return k < 256 ? wb[(size_t)k * DM + n] * 1024.f : 0.f; }); continue; } r -= I_B;
        if (r < I_C) { conv_plain8((unsigned char*)WC, 512, (r / 32) * 64, (r % 32) * 32, scr, F.lane, wc, DM, 1024.f); continue; } r -= I_C;
        conv_plain8((unsigned char*)WO, DM, (r / 32) * 64, (r % 32) * 32, scr, F.lane, wo, DM, 1024.f);
    }
    if (l == 0) {
        float* rp = (float*)(F.ws + WS_ROPE); float* rm = rp + 2048 * 8 * 2;
        for (int idx = F.vcu * NTHREADS + F.tid; idx < 2048 * 24; idx += F.G * NTHREADS) {
            const int t = idx / 24, j = idx % 24; double sn, cs;
            if (j < 8) { sincos_d((double)t * inv_freq16(2 * j), sn, cs); rp[(t * 8 + j) * 2] = (float)cs; rp[(t * 8 + j) * 2 + 1] = (float)sn; }
            else { sincos_d((double)t * inv_freq16(j - 8), sn, cs); rm[(t * 16 + (j - 8)) * 2] = (float)cs; rm[(t * 16 + (j - 8)) * 2 + 1] = (float)sn; }
        }
        const f32x4* x4 = (const f32x4*)F.in[0]; unsigned* xb8 = (unsigned*)(F.ws + WS_XB8);
        {
            const size_t NT = (size_t)F.G * NTHREADS, N4 = (size_t)TT * DM / 4;
            for (size_t i0 = (size_t)F.vcu * NTHREADS + F.tid; i0 < N4; i0 += 8 * NT) {
                f32x4 v[8];
#pragma unroll
                for (int q = 0; q < 8; ++q) { const size_t i = i0 + q * NT < N4 ? i0 + q * NT : i0; v[q] = __builtin_nontemporal_load(x4 + i); }
#pragma unroll
                for (int q = 0; q < 8; ++q) { const size_t i = i0 + q * NT < N4 ? i0 + q * NT : i0; const f32x4 w = v[q] * 16.f; xb8[i] = pk4_fp8(w.x, w.y, w.z, w.w); }
            }
        }
    }
}

__device__ __forceinline__ void rope4(f32x4& v0, f32x4& v1, const float* cs) {
    const f32x4 a = *(const f32x4*)cs, b = *(const f32x4*)(cs + 4);
    const f32x4 w0 = {v0[0] * a[0] - v0[1] * a[1], v0[1] * a[0] + v0[0] * a[1], v0[2] * a[2] - v0[3] * a[3], v0[3] * a[2] + v0[2] * a[3]};
    const f32x4 w1 = {v1[0] * b[0] - v1[1] * b[1], v1[1] * b[0] + v1[0] * b[1], v1[2] * b[2] - v1[3] * b[3], v1[3] * b[2] + v1[2] * b[3]};
    v0 = w0; v1 = w1;
}
__device__ __forceinline__ void store8(bf16_t* p, const f32x4& v0, const f32x4& v1) {
    u32x4 w; w.x = cvt_pk_bf16(v0[0], v0[1]); w.y = cvt_pk_bf16(v0[2], v0[3]); w.z = cvt_pk_bf16(v1[0], v1[1]); w.w = cvt_pk_bf16(v1[2], v1[3]); *(u32x4*)p = w;
}
struct EpiProj {
    bf16_t* P; const float* csp; const float* csm; float* ssq; bf16_t* G3; const LAS float* gbias;
    __device__ __forceinline__ void operator()(const f32x4 (&acc)[2][2][4][2], const pg8::Unit& u, int wr, int wc, int fr, int fq) const {
        const int pn = u.pn, row0 = u.pm * 256 + wr * 64 + fr;
        if (pn >= 16) {
#pragma unroll
            for (int bj = 0; bj < 2; ++bj) { const int col = (pn - 16) * 256 + bj * 128 + wc * 32 + fq * 8;
                const f32x4 b0 = *(const LAS f32x4*)(gbias + col), b1 = *(const LAS f32x4*)(gbias + col + 4);
#pragma unroll
                for (int ai = 0; ai < 2; ++ai)
#pragma unroll
                    for (int m = 0; m < 4; ++m) { f32x4 v0 = acc[ai][bj][m][0] + b0, v1 = acc[ai][bj][m][1] + b1;
#pragma unroll
                        for (int e = 0; e < 4; ++e) { v0[e] = sigmoidf_(v0[e]); v1[e] = sigmoidf_(v1[e]); }
                        store8_fp8((unsigned char*)G3 + (size_t)(row0 + ai * 128 + m * 16) * 3072 + col, v0, v1, 64.f); } }
            return;
        }
#pragma unroll
        for (int bj = 0; bj < 2; ++bj) {
            const int wcu = __builtin_amdgcn_readfirstlane(wc);
            bool ropeP = false, ropeM = false;
            if (pn == 1) ropeM = (bj == 1 && wcu == 0);
            else if (pn >= 2 && pn < 11) ropeP = ((pn - 2) % 3) < 2 && !(wcu & 1);
            else if (pn >= 11 && pn < 15) ropeP = !(wcu & 1);
            else if (pn == 15) ropeP = (wcu == 0);
            const int col = pn * 256 + bj * 128 + wc * 32 + fq * 8;
            if (ropeP || ropeM) {
                const bool lr = ropeM || fq < 2;
                const float* cb = ropeM ? csm + 8 * fq : csp + 8 * (fq & 1);
                const int ts = ropeM ? 32 : 16;
#pragma unroll
                for (int ai = 0; ai < 2; ++ai) {
                    f32x4 ca[4], cc[4];
#pragma unroll
                    for (int m = 0; m < 4; ++m) { const int t = (row0 + ai * 128 + m * 16) & (SEQ - 1);
                        ca[m] = *(const f32x4*)(cb + t * ts); cc[m] = *(const f32x4*)(cb + t * ts + 4); }
#pragma unroll
                    for (int m = 0; m < 4; ++m) { const int row = row0 + ai * 128 + m * 16;
                        const f32x4 v0 = acc[ai][bj][m][0], v1 = acc[ai][bj][m][1];
                        f32x4 a = ca[m], b = cc[m];
                        if (!lr) { a = (f32x4){1.f, 0.f, 1.f, 0.f}; b = a; }
                        const f32x4 w0 = {v0[0] * a[0] - v0[1] * a[1], v0[1] * a[0] + v0[0] * a[1], v0[2] * a[2] - v0[3] * a[3], v0[3] * a[2] + v0[2] * a[3]};
                        const f32x4 w1 = {v1[0] * b[0] - v1[1] * b[1], v1[1] * b[0] + v1[0] * b[1], v1[2] * b[2] - v1[3] * b[3], v1[3] * b[2] + v1[2] * b[3]};
                        store8(P + (size_t)row * PW + col, w0, w1); }
                }
            } else {
#pragma unroll
                for (int ai = 0; ai < 2; ++ai)
#pragma unroll
                    for (int m = 0; m < 4; ++m)
                        store8(P + (size_t)(row0 + ai * 128 + m * 16) * PW + col, acc[ai][bj][m][0], acc[ai][bj][m][1]);
            }
        }
        if (pn < 2) {
#pragma unroll
            for (int ai = 0; ai < 2; ++ai)
#pragma unroll
                for (int m = 0; m < 4; ++m) {
                    float sq = 0.f;
#pragma unroll
                    for (int bj = 0; bj < 2; ++bj) if (pn == 0 || bj == 0) {
#pragma unroll
                        for (int n = 0; n < 2; ++n) { const f32x4 x = acc[ai][bj][m][n]; sq += (x[0] * x[0] + x[1] * x[1]) + (x[2] * x[2] + x[3] * x[3]); } }
                    sq += __shfl_xor(sq, 16); sq += __shfl_xor(sq, 32);
                    if (fq == 0) ssq[(size_t)(row0 + ai * 128 + m * 16) * 8 + pn * 4 + wc] = sq;
                }
        }
    }
};
struct EpiUpQ {
    bf16_t* Q; const float* csm; const float* ssq;
    __device__ __forceinline__ void operator()(const f32x4 (&acc)[2][2][4][2], const pg8::Unit& u, int wr, int wc, int fr, int fq) const {
        const int row0 = u.pm * 256 + wr * 64 + fr;
        f32x4 spv[2][4];
#pragma unroll
        for (int ai = 0; ai < 2; ++ai)
#pragma unroll
            for (int m = 0; m < 4; ++m) spv[ai][m] = *(const f32x4*)(ssq + (size_t)(row0 + ai * 128 + m * 16) * 8);
#pragma unroll
        for (int ai = 0; ai < 2; ++ai)
#pragma unroll
            for (int m = 0; m < 4; ++m) { const f32x4 sp = spv[ai][m];
                spv[ai][m][0] = 1.0f / sqrtf(((sp[0] + sp[1]) + (sp[2] + sp[3])) * (1.f / 256.f) + RMS_EPS); }
        const int wcu = __builtin_amdgcn_readfirstlane(wc);
#pragma unroll
        for (int bj = 0; bj < 2; ++bj) {
            const int c0 = u.pn * 256 + bj * 128 + wcu * 32, col = c0 + fq * 8;
            if (((c0 >> 5) % 3) == 2) {
#pragma unroll
                for (int ai = 0; ai < 2; ++ai) {
                    f32x4 ca[4], cc[4];
#pragma unroll
                    for (int m = 0; m < 4; ++m) { const int t = (row0 + ai * 128 + m * 16) & (SEQ - 1);
                        ca[m] = *(const f32x4*)(csm + t * 32 + 8 * fq); cc[m] = *(const f32x4*)(csm + t * 32 + 8 * fq + 4); }
#pragma unroll
                    for (int m = 0; m < 4; ++m) { const int row = row0 + ai * 128 + m * 16;
                        const float rs = spv[ai][m][0];
                        const f32x4 v0 = acc[ai][bj][m][0] * rs, v1 = acc[ai][bj][m][1] * rs, a = ca[m], b = cc[m];
                        const f32x4 w0 = {v0[0] * a[0] - v0[1] * a[1], v0[1] * a[0] + v0[0] * a[1], v0[2] * a[2] - v0[3] * a[3], v0[3] * a[2] + v0[2] * a[3]};
                        const f32x4 w1 = {v1[0] * b[0] - v1[1] * b[1], v1[1] * b[0] + v1[0] * b[1], v1[2] * b[2] - v1[3] * b[3], v1[3] * b[2] + v1[2] * b[3]};
                        store8(Q + (size_t)row * 768 + col, w0, w1); }
                }
            } else {
#pragma unroll
                for (int ai = 0; ai < 2; ++ai)
#pragma unroll
                    for (int m = 0; m < 4; ++m) { const float rs = spv[ai][m][0];
                        store8(Q + (size_t)(row0 + ai * 128 + m * 16) * 768 + col, acc[ai][bj][m][0] * rs, acc[ai][bj][m][1] * rs); }
            }
        }
    }
};
struct EpiUpKV {
    bf16_t* KV; const float* ssq;
    __device__ __forceinline__ void operator()(const f32x4 (&acc)[2][2][4][2], const pg8::Unit& u, int wr, int wc, int fr, int fq) const {
        const int row0 = u.pm * 256 + wr * 64 + fr;
        f32x4 spv[2][4];
#pragma unroll
        for (int ai = 0; ai < 2; ++ai)
#pragma unroll
            for (int m = 0; m < 4; ++m) spv[ai][m] = *(const f32x4*)(ssq + (size_t)(row0 + ai * 128 + m * 16) * 8 + 4);
#pragma unroll
        for (int ai = 0; ai < 2; ++ai)
#pragma unroll
            for (int m = 0; m < 4; ++m) {
                const int row = row0 + ai * 128 + m * 16;
                const f32x4 sp = spv[ai][m];
                const float rs = 1.0f / sqrtf(((sp[0] + sp[1]) + (sp[2] + sp[3])) * (1.f / 128.f) + RMS_EPS);
#pragma unroll
                for (int bj = 0; bj < 2; ++bj) { const int col = u.pn * 256 + bj * 128 + wc * 32 + fq * 8;
                    store8(KV + (size_t)row * 1024 + col, acc[ai][bj][m][0] * rs, acc[ai][bj][m][1] * rs); }
            }
    }
};
template <int T> struct IC { static constexpr int value = T; };
struct EpiBranchAll {
    bf16_t* Mg; bf16_t* M0; bf16_t* M1; const bf16_t* G3;
    __device__ __forceinline__ void operator()(const f32x4 (&acc)[2][2][4][2], const pg8::Unit& u, int wr, int wc, int fr, int fq) const {
        const int row0 = u.pm * 256 + wr * 64 + fr, br = u.ord, col0 = u.pn * 256 + wc * 32 + fq * 8;
        bf16_t* dst = br == 0 ? M0 : (br == 1 ? M1 : Mg);
        auto ldb = [&](auto tc, u32x2 (&gw)[2][2], u32x2 (&ma)[2][2], u32x2 (&mb)[2][2]) { constexpr int t = decltype(tc)::value, ai = t >> 1, mh = t & 1;
#pragma unroll
            for (int mm = 0; mm < 2; ++mm)
#pragma unroll
                for (int bj = 0; bj < 2; ++bj) { const int row = row0 + ai * 128 + (2 * mh + mm) * 16, col = col0 + bj * 128;
                    gw[mm][bj] = *(const u32x2*)((const unsigned char*)G3 + (size_t)row * 3072 + br * 1024 + col);
                    ma[mm][bj] = (u32x2){0u, 0u}; mb[mm][bj] = (u32x2){0u, 0u}; }
            if (br == 2) {
#pragma unroll
                for (int mm = 0; mm < 2; ++mm)
#pragma unroll
                    for (int bj = 0; bj < 2; ++bj) { const size_t off = (size_t)(row0 + ai * 128 + (2 * mh + mm) * 16) * DM + col0 + bj * 128;
                        ma[mm][bj] = *(const u32x2*)((const unsigned char*)M0 + off); mb[mm][bj] = *(const u32x2*)((const unsigned char*)M1 + off); }
            } };
        auto cpb = [&](auto tc, const u32x2 (&gw)[2][2], const u32x2 (&ma)[2][2], const u32x2 (&mb)[2][2]) { constexpr int t = decltype(tc)::value, ai = t >> 1, mh = t & 1;
#pragma unroll
            for (int mm = 0; mm < 2; ++mm)
#pragma unroll
                for (int bj = 0; bj < 2; ++bj) { constexpr int dummy = 0; (void)dummy; const int m = 2 * mh + mm; const size_t off = (size_t)(row0 + ai * 128 + m * 16) * DM + col0 + bj * 128; const u32x2 g = gw[mm][bj], a = ma[mm][bj], b2 = mb[mm][bj];
                    const f32x2 g01 = __builtin_amdgcn_cvt_pk_f32_fp8((int)g.x, false) * (1.f / 64.f), g23 = __builtin_amdgcn_cvt_pk_f32_fp8((int)g.x, true) * (1.f / 64.f);
                    const f32x2 g45 = __builtin_amdgcn_cvt_pk_f32_fp8((int)g.y, false) * (1.f / 64.f), g67 = __builtin_amdgcn_cvt_pk_f32_fp8((int)g.y, true) * (1.f / 64.f);
                    f32x4 v0 = acc[ai][bj][m][0], v1 = acc[ai][bj][m][1];
                    const f32x2 s01 = (__builtin_amdgcn_cvt_pk_f32_fp8((int)a.x, false) + __builtin_amdgcn_cvt_pk_f32_fp8((int)b2.x, false)) * (1.f / 64.f), s23 = (__builtin_amdgcn_cvt_pk_f32_fp8((int)a.x, true) + __builtin_amdgcn_cvt_pk_f32_fp8((int)b2.x, true)) * (1.f / 64.f);
                    const f32x2 s45 = (__builtin_amdgcn_cvt_pk_f32_fp8((int)a.y, false) + __builtin_amdgcn_cvt_pk_f32_fp8((int)b2.y, false)) * (1.f / 64.f), s67 = (__builtin_amdgcn_cvt_pk_f32_fp8((int)a.y, true) + __builtin_amdgcn_cvt_pk_f32_fp8((int)b2.y, true)) * (1.f / 64.f);
                    v0[0] = v0[0] * g01[0] + s01[0]; v0[1] = v0[1] * g01[1] + s01[1]; v0[2] = v0[2] * g23[0] + s23[0]; v0[3] = v0[3] * g23[1] + s23[1];
                    v1[0] = v1[0] * g45[0] + s45[0]; v1[1] = v1[1] * g45[1] + s45[1]; v1[2] = v1[2] * g67[0] + s67[0]; v1[3] = v1[3] * g67[1] + s67[1];
                    store8_fp8((unsigned char*)dst + off, v0, v1, 64.f); } };
        u32x2 gA[2][2], aA[2][2], bA[2][2], gB[2][2], aB[2][2], bB[2][2];
        ldb(IC<0>{}, gA, aA, bA); ldb(IC<1>{}, gB, aB, bB);
        cpb(IC<0>{}, gA, aA, bA); ldb(IC<2>{}, gA, aA, bA);
        cpb(IC<1>{}, gB, aB, bB); ldb(IC<3>{}, gB, aB, bB);
        cpb(IC<2>{}, gA, aA, bA); cpb(IC<3>{}, gB, aB, bB);
    }
};
struct BranchSched {
    static constexpr bool GATHER = false; static constexpr bool VARK = true;
    const char* A0; const char* B0; size_t sA, sB; int lda, ldb, c, sw8, sa8, G, ntile;
    __device__ __forceinline__ int ktiles(const pg8::Unit& u) const { return u.ord == 1 ? 2 : 4; }
    __device__ __forceinline__ bool next(int i, pg8::Unit& u) const { const int t = c + (i / 3) * G; if (t >= ntile) return false; u.pm = t >> 2; u.pn = t & 3; u.ord = i % 3; return true; }
    __device__ __forceinline__ const char* a_base(const pg8::Unit& u) const { return A0 + (size_t)u.ord * sA + (size_t)u.pm * 256 * lda * 2; }
    __device__ __forceinline__ const char* b_base(const pg8::Unit& u) const { return B0 + (size_t)u.ord * sB + (size_t)u.pn * 256 * ldb * 2; }
    __device__ __forceinline__ void a_off(const pg8::Unit&, const int (&R)[2], const int (&C)[2], unsigned (&v)[2][2]) const {
#pragma unroll
        for (int i = 0; i < 2; ++i) { v[0][i] = (unsigned)(R[i] * lda + C[i]) * 2u; v[1][i] = (unsigned)((128 + R[i]) * lda + C[i]) * 2u; }
    }
};
struct EpiWo {
    float* out; const float* xsrc; int rowbase;
    __device__ __forceinline__ void operator()(const f32x4 (&acc)[2][2][4][2], const pg8::Unit& u, int wr, int wc, int fr, int fq) const {
        const int row0 = rowbase + u.pm * 256 + wr * 64 + fr, col0 = u.pn * 256 + wc * 32 + fq * 8;
#pragma unroll
        for (int ai = 0; ai < 2; ++ai)
#pragma unroll
            for (int mh = 0; mh < 2; ++mh) {
                f32x4 x[2][2][2];
#pragma unroll
                for (int mm = 0; mm < 2; ++mm)
#pragma unroll
                    for (int bj = 0; bj < 2; ++bj) { const size_t off = (size_t)(row0 + ai * 128 + (2 * mh + mm) * 16) * DM + col0 + bj * 128;
                        x[mm][bj][0] = *(const f32x4*)(xsrc + off); x[mm][bj][1] = *(const f32x4*)(xsrc + off + 4); }
#pragma unroll
                for (int mm = 0; mm < 2; ++mm)
#pragma unroll
                    for (int bj = 0; bj < 2; ++bj) { const size_t off = (size_t)(row0 + ai * 128 + (2 * mh + mm) * 16) * DM + col0 + bj * 128;
                        *(f32x4*)(out + off) = x[mm][bj][0] * ALPHA + acc[ai][bj][2 * mh + mm][0]; *(f32x4*)(out + off + 4) = x[mm][bj][1] * ALPHA + acc[ai][bj][2 * mh + mm][1]; }
            }
    }
};

__device__ __forceinline__ int dequeue(Frame& F, unsigned* ctr, int& pre) {
    LAS int* slot = (LAS int*)(F.lds + L_QSLOT);
    __syncthreads();
    if (F.tid == 0) {
        *slot = (int)__hip_atomic_fetch_add(ctr, 1u, __ATOMIC_RELAXED, __HIP_MEMORY_SCOPE_AGENT); (void)pre;
    }
    __syncthreads();
    return *slot;
}

namespace att {
constexpr int KSLOT = 12288, VSLOT = 8192, NSLOT = 4;
constexpr int A_K = 0, A_V = NSLOT * KSLOT, A_WS = A_V + NSLOT * VSLOT, A_OST = A_WS + 8 * 256, A_MW = A_OST + 8 * 4096, A_END = A_MW + 8 * NSLOT * 256;
static_assert(A_END <= RING_BYTES, "attention LDS");
typedef short s16x4 __attribute__((ext_vector_type(4)));
__device__ __forceinline__ int crow(int r, int hi) { return (r & 3) + 8 * (r >> 2) + 4 * hi; }
__device__ __forceinline__ void glds16(const void* gsrc, unsigned lds_dst) { unsigned keep;
    asm volatile("s_mov_b32 %0, m0\n\ts_mov_b32 m0, %2\n\ts_nop 0\n\tglobal_load_lds_dwordx4 %1, off\n\ts_mov_b32 m0, %0" : "=&s"(keep) : "v"(gsrc), "s"(lds_dst) : "memory"); }
__device__ __forceinline__ void glds4(const void* gsrc, unsigned lds_dst) { unsigned keep;
    asm volatile("s_mov_b32 %0, m0\n\ts_mov_b32 m0, %2\n\ts_nop 0\n\tglobal_load_lds_dword %1, off\n\ts_mov_b32 m0, %0" : "=&s"(keep) : "v"(gsrc), "s"(lds_dst) : "memory"); }
#define ATT_WAIT_BAR(N) asm volatile("s_waitcnt vmcnt(" #N ") lgkmcnt(0)\n\ts_barrier" ::: "memory")
__device__ __forceinline__ float emax(float a, float b) { return __builtin_elementwise_maximum(a, b); }
__device__ __forceinline__ float halfmax(float m) { auto rr = __builtin_amdgcn_permlane32_swap(__float_as_uint(m), __float_as_uint(m), false, false); return emax(__uint_as_float(rr[0]), __uint_as_float(rr[1])); }
__device__ __forceinline__ float halfsum(float m) { auto rr = __builtin_amdgcn_permlane32_swap(__float_as_uint(m), __float_as_uint(m), false, false); return __uint_as_float(rr[0]) + __uint_as_float(rr[1]); }
typedef short v4i16_t __attribute__((ext_vector_type(4)));
__device__ __forceinline__ s16x4 vtr(const LAS unsigned char* p) { return __builtin_bit_cast(s16x4, __builtin_amdgcn_ds_read_tr16_b64_v4i16((LAS v4i16_t*)p)); }
__device__ __forceinline__ void pv(f32x16* o, f32x16& lacc, const LAS unsigned char* vp, bf16x8 pa0, bf16x8 pa1, bf16x8 pa2, bf16x8 pa3) {
    { const u32x4 one4 = {0x3F803F80u, 0x3F803F80u, 0x3F803F80u, 0x3F803F80u}; const bf16x8 ones = __builtin_bit_cast(bf16x8, one4);
      lacc = __builtin_amdgcn_mfma_f32_32x32x16_bf16(pa0, ones, lacc, 0, 0, 0); lacc = __builtin_amdgcn_mfma_f32_32x32x16_bf16(pa1, ones, lacc, 0, 0, 0);
      lacc = __builtin_amdgcn_mfma_f32_32x32x16_bf16(pa2, ones, lacc, 0, 0, 0); lacc = __builtin_amdgcn_mfma_f32_32x32x16_bf16(pa3, ones, lacc, 0, 0, 0); }
#pragma unroll
    for (int d0 = 0; d0 < 2; ++d0) { s16x4 lo[4], hi[4];
#pragma unroll
        for (int ks = 0; ks < 4; ++ks) { lo[ks] = vtr(vp + d0 * 4096 + ks * 1024); hi[ks] = vtr(vp + d0 * 4096 + ks * 1024 + 512); }
#define ATT_PK(k) (bf16x8){lo[k][0], lo[k][1], lo[k][2], lo[k][3], hi[k][0], hi[k][1], hi[k][2], hi[k][3]}
        o[d0] = __builtin_amdgcn_mfma_f32_32x32x16_bf16(pa0, ATT_PK(0), o[d0], 0, 0, 0);
        o[d0] = __builtin_amdgcn_mfma_f32_32x32x16_bf16(pa1, ATT_PK(1), o[d0], 0, 0, 0);
        o[d0] = __builtin_amdgcn_mfma_f32_32x32x16_bf16(pa2, ATT_PK(2), o[d0], 0, 0, 0);
        o[d0] = __builtin_amdgcn_mfma_f32_32x32x16_bf16(pa3, ATT_PK(3), o[d0], 0, 0, 0);
#undef ATT_PK
    }
}
struct Desc {
    const bf16_t* Q; const bf16_t* K1; const bf16_t* K2; const bf16_t* V; bf16_t* O; float* lse; const unsigned* mask;
    int qpitch, k1pitch, k2pitch, vpitch, opitch, lsepitch;
    int rstride, q0, nq, jlo, jhi;
    int o8;
};
template <int DQK, int MODE, bool DUAL = false>
__device__ __forceinline__ void attn_unit(LAS unsigned char* lds, const Desc& d) {
    static_assert(!DUAL || (DQK == 64 && MODE == 0), "dual mode");
    constexpr int NSLOT = DUAL ? 2 : att::NSLOT, KSLOT = DUAL ? 8192 : att::KSLOT;
    constexpr int A_K = 0, A_V = DUAL ? 32768 : att::A_V, A_WS = DUAL ? 65536 : att::A_WS, A_OST = DUAL ? 67584 : att::A_OST, A_MW = att::A_MW;
    int tid_ = threadIdx.x; asm volatile("" : "+v"(tid_));
    const int tid = tid_, lane = tid & 63, r32 = lane & 31, hi = lane >> 5, wid = __builtin_amdgcn_readfirstlane(tid >> 6);
    constexpr int ND = DQK / 16;
    const unsigned lds0 = (unsigned)(size_t)lds;
    LAS float* wsf = (LAS float*)(lds + A_WS) + wid * 64;
    const int grp = DUAL ? (wid >> 2) : 0, w4 = DUAL ? (wid & 3) : wid, gofs = grp * 16384;
    Desc dd = d;
    if (DUAL) { dd.Q = d.Q + (size_t)grp * d.qpitch; dd.K1 = d.K1 + (size_t)grp * d.k1pitch; dd.V = d.V + (size_t)grp * d.vpitch; dd.O = d.O + (size_t)grp * d.opitch; if (d.lse) dd.lse = d.lse + (size_t)grp * d.lsepitch; }
    const Desc& d_ = dd;
    const int qw = d.q0 + w4 * 32;
    const bool wvalid = DUAL || wid * 32 < d.nq;
    const int kkey = 8 * wid + (lane >> 3), kch = (lane & 7) ^ ((kkey >> 1) & 7);
    const bf16_t* ksrc = d_.K1 + (size_t)kkey * d.rstride * d.k1pitch + kch * 8;
    const int k2key = 16 * (wid & 3) + (lane >> 2), k2ch = (lane & 3) ^ ((k2key >> 2) & 3);
    const bf16_t* k2src = (DQK == 96) ? d_.K2 + (size_t)k2key * d.rstride * d.k2pitch + k2ch * 8 : nullptr;
    int kofs[ND];
#pragma unroll
    for (int d0 = 0; d0 < ND; ++d0) kofs[d0] = d0 < 4 ? r32 * 128 + (((2 * d0 + hi) ^ ((r32 >> 1) & 7)) * 16) : 8192 + r32 * 64 + (((2 * (d0 - 4) + hi) ^ ((r32 >> 2) & 3)) * 16);
    const bf16_t* vsrc = d_.V + (size_t)(16 * (wid & 3) + (lane >> 2)) * d.rstride * d.vpitch + (DUAL ? 0 : (wid >> 2) * 32) + (lane & 3) * 8;
    const int kkeyB = 8 * (2 * w4 + 1) + (lane >> 3);
    const bf16_t* ksrcA = DUAL ? d_.K1 + (size_t)(8 * (2 * w4) + (lane >> 3)) * d.rstride * d.k1pitch + (((lane & 7) ^ (((8 * (2 * w4) + (lane >> 3)) >> 1) & 7)) * 8) : nullptr;
    const bf16_t* ksrcB = DUAL ? d_.K1 + (size_t)kkeyB * d.rstride * d.k1pitch + (((lane & 7) ^ ((kkeyB >> 1) & 7)) * 8) : nullptr;
    const size_t kstep = (size_t)64 * d.rstride * d.k1pitch, k2step = (size_t)64 * d.rstride * d.k2pitch, vstep = (size_t)64 * d.rstride * d.vpitch;
    const bool two = (DQK == 96) && wid < 4;
    const unsigned* msrc = (MODE == 2) ? d.mask + (size_t)(wvalid ? (qw + (lane >> 1)) : d.q0) * 64 + (lane & 1) : nullptr;
#define ATT_ISSUE(j) do { const int sl_ = (j) % NSLOT; \
        if (DUAL) { \
            glds16(ksrcA + (size_t)(j) * kstep, (unsigned)__builtin_amdgcn_readfirstlane(lds0 + A_K + gofs + sl_ * KSLOT + (2 * w4) * 1024)); \
            glds16(ksrcB + (size_t)(j) * kstep, (unsigned)__builtin_amdgcn_readfirstlane(lds0 + A_K + gofs + sl_ * KSLOT + (2 * w4 + 1) * 1024)); \
            glds16(vsrc + (size_t)(j) * vstep, (unsigned)__builtin_amdgcn_readfirstlane(lds0 + A_V + gofs + sl_ * VSLOT + w4 * 1024)); \
            glds16(vsrc + 32 + (size_t)(j) * vstep, (unsigned)__builtin_amdgcn_readfirstlane(lds0 + A_V + gofs + sl_ * VSLOT + (4 + w4) * 1024)); \
            break; } \
        glds16(ksrc + (size_t)(j) * kstep, (unsigned)__builtin_amdgcn_readfirstlane(lds0 + A_K + sl_ * KSLOT + wid * 1024)); \
        if (two) glds16(k2src + (size_t)(j) * k2step, (unsigned)__builtin_amdgcn_readfirstlane(lds0 + A_K + sl_ * KSLOT + (8 + wid) * 1024)); \
        glds16(vsrc + (size_t)(j) * vstep, (unsigned)__builtin_amdgcn_readfirstlane(lds0 + A_V + sl_ * VSLOT + wid * 1024)); \
        if (MODE == 2) glds4(msrc + 2 * (j), (unsigned)__builtin_amdgcn_readfirstlane(lds0 + A_MW + (wid * NSLOT + sl_) * 256)); } while (0)
    ATT_ISSUE(d.jlo);
    if (d.jlo + 1 < d.jhi) ATT_ISSUE(d.jlo + 1);
    bf16x8 qr[ND];
    { const int qi = wvalid ? (qw + r32) : d.q0; const bf16_t* qp = d_.Q + (size_t)qi * d.rstride * d.qpitch + hi * 8;
#pragma unroll
      for (int d0 = 0; d0 < ND; ++d0) qr[d0] = *(const bf16x8*)(qp + d0 * 16); }
#pragma unroll
    for (int d0 = 0; d0 < ND; ++d0) asm volatile("" : "+v"(qr[d0]));
    float mhat = 0.f; f32x16 o[2]; o[0] = f32x16{}; o[1] = f32x16{}; f32x16 lacc = f32x16{};
    bool started = false;
    const LAS unsigned char* vp0 = lds + A_V + gofs + ((lane >> 4) & 1) * 32 + (lane & 3) * 8 + (4 * hi + ((lane & 15) >> 2)) * 64;
    const int qi = qw + r32;
    f32x16 p0 = f32x16{}, p1 = f32x16{};
    f32x16 negm = f32x16{};
#define ATT_REL(j) (wvalid && (64 * (j) <= qw + 31) && (MODE != 1 || (64 * (j) + 63 >= qw - 128)))
#define ATT_QK(j) do { const int sl_ = (j) % NSLOT; \
        const LAS unsigned char* kb = lds + A_K + gofs + sl_ * KSLOT; bf16x8 kf[2 * ND]; \
        _Pragma("unroll") for (int d0 = 0; d0 < ND; ++d0) { kf[2 * d0] = *(const LAS bf16x8*)(kb + kofs[d0]); kf[2 * d0 + 1] = *(const LAS bf16x8*)(kb + kofs[d0] + (d0 < 4 ? 4096 : 2048)); } \
        __builtin_amdgcn_sched_barrier(0); \
        _Pragma("unroll") for (int d0 = 0; d0 < ND; ++d0) { \
            if (d0 == 0) { p0 = __builtin_amdgcn_mfma_f32_32x32x16_bf16(kf[0], qr[0], negm, 0, 0, 0); p1 = __builtin_amdgcn_mfma_f32_32x32x16_bf16(kf[1], qr[0], negm, 0, 0, 0); } \
            else { p0 = __builtin_amdgcn_mfma_f32_32x32x16_bf16(kf[2 * d0], qr[d0], p0, 0, 0, 0); p1 = __builtin_amdgcn_mfma_f32_32x32x16_bf16(kf[2 * d0 + 1], qr[d0], p1, 0, 0, 0); } } } while (0)
#define ATT_SMPV(j) do { const int sl_ = (j) % NSLOT; \
        { bool domask = true; unsigned mx_ = 0u, my_ = 0u;        \
          if (MODE == 2) { const u32x2 mw = *(const LAS u32x2*)(lds + A_MW + (wid * NSLOT + sl_) * 256 + r32 * 8); mx_ = mw.x; my_ = mw.y; } \
          else { \
            bool full = (64 * (j) + 63 <= qw); \
            if (MODE == 1) full = full && (64 * (j) >= qw + 31 - 128); \
            domask = !full; \
            if (domask) { const int a_ = qi - 64 * (j), lo_ = (MODE == 1) ? a_ - 128 : -4096;        \
                { const int h_ = a_ < 31 ? a_ : 31, l_ = lo_ > 0 ? lo_ : 0; mx_ = (h_ < l_) ? 0u : ((0xFFFFFFFFu >> (31 - h_)) & (0xFFFFFFFFu << l_)); } \
                { const int h_ = a_ - 32 < 31 ? a_ - 32 : 31, l_ = lo_ - 32 > 0 ? lo_ - 32 : 0; my_ = (h_ < l_) ? 0u : ((0xFFFFFFFFu >> (31 - h_)) & (0xFFFFFFFFu << l_)); } } \
          } \
          if (domask) { const unsigned w0 = mx_ >> (4 * hi), w1 = my_ >> (4 * hi); \
            _Pragma("unroll") for (int r = 0; r < 16; ++r) { const int bit = (r & 3) + 8 * (r >> 2); \
                const unsigned m0 = (unsigned)__builtin_amdgcn_sbfe((int)w0, bit, 1), m1 = (unsigned)__builtin_amdgcn_sbfe((int)w1, bit, 1);        \
                p0[r] = __uint_as_float((m0 & __float_as_uint(p0[r])) | (~m0 & 0xFF800000u)); p1[r] = __uint_as_float((m1 & __float_as_uint(p1[r])) | (~m1 & 0xFF800000u)); } } } \
        float rm = emax(p0[0], p1[0]), rm2 = emax(p0[1], p1[1]); \
        _Pragma("unroll") for (int r = 2; r < 16; r += 2) { rm = emax(emax(rm, p0[r]), p1[r]); rm2 = emax(emax(rm2, p0[r + 1]), p1[r + 1]); } \
        rm = halfmax(emax(rm, rm2)); \
        bool need; float dl; \
        if (!started) { need = true; dl = emax(rm, -200.f); } else { need = __any(rm > 8.f) != 0; dl = emax(rm, 0.f); } \
        if (need) { mhat += dl; \
            _Pragma("unroll") for (int r = 0; r < 16; ++r) negm[r] = -mhat; \
            _Pragma("unroll") for (int r = 0; r < 16; ++r) { p0[r] -= dl; p1[r] -= dl; } \
            if (started) { const float f = __builtin_amdgcn_exp2f(-dl); \
                if (hi == 0) wsf[r32] = f; \
                LDS_WAIT(); \
                _Pragma("unroll") for (int r = 0; r < 16; ++r) { const float fr_ = wsf[crow(r, hi)]; o[0][r] *= fr_; o[1][r] *= fr_; lacc[r] *= fr_; } } } \
        started = true; \
        __builtin_amdgcn_s_setprio(1);        \
        _Pragma("unroll") for (int r = 0; r < 16; ++r) { p0[r] = __builtin_amdgcn_exp2f(p0[r]); p1[r] = __builtin_amdgcn_exp2f(p1[r]); } \
        const u32x4 pw0 = (u32x4){cvt_pk_bf16(p0[0], p0[1]), cvt_pk_bf16(p0[2], p0[3]), cvt_pk_bf16(p0[4], p0[5]), cvt_pk_bf16(p0[6], p0[7])}; \
        const u32x4 pw1 = (u32x4){cvt_pk_bf16(p0[8], p0[9]), cvt_pk_bf16(p0[10], p0[11]), cvt_pk_bf16(p0[12], p0[13]), cvt_pk_bf16(p0[14], p0[15])}; \
        const u32x4 pw2 = (u32x4){cvt_pk_bf16(p1[0], p1[1]), cvt_pk_bf16(p1[2], p1[3]), cvt_pk_bf16(p1[4], p1[5]), cvt_pk_bf16(p1[6], p1[7])}; \
        const u32x4 pw3 = (u32x4){cvt_pk_bf16(p1[8], p1[9]), cvt_pk_bf16(p1[10], p1[11]), cvt_pk_bf16(p1[12], p1[13]), cvt_pk_bf16(p1[14], p1[15])}; \
        pv(o, lacc, vp0 + sl_ * VSLOT, __builtin_bit_cast(bf16x8, pw0), __builtin_bit_cast(bf16x8, pw1), __builtin_bit_cast(bf16x8, pw2), __builtin_bit_cast(bf16x8, pw3)); \
        __builtin_amdgcn_s_setprio(0); } while (0)
#define ATT_TOPWAIT(j) do { if ((j) + 1 < d.jhi) { if (DUAL) { ATT_WAIT_BAR(4); } else if (MODE == 2 || two) { ATT_WAIT_BAR(3); } else { ATT_WAIT_BAR(2); } } else { ATT_WAIT_BAR(0); } } while (0)
    if (wid < 4) {
        for (int j = d.jlo; j < d.jhi; ++j) {
            ATT_TOPWAIT(j);
            if (j + 2 < d.jhi) ATT_ISSUE(j + 2);
            if (ATT_REL(j)) { ATT_QK(j); ATT_SMPV(j); }
        }
        asm volatile("s_waitcnt lgkmcnt(0)\n\ts_barrier" ::: "memory");
    } else {
        ATT_TOPWAIT(d.jlo);
        if (d.jlo + 2 < d.jhi) ATT_ISSUE(d.jlo + 2);
        if (ATT_REL(d.jlo)) ATT_QK(d.jlo);
        for (int j = d.jlo + 1; j < d.jhi; ++j) {
            ATT_TOPWAIT(j);
            if (j + 2 < d.jhi) ATT_ISSUE(j + 2);
            if (ATT_REL(j - 1)) ATT_SMPV(j - 1);
            if (ATT_REL(j)) ATT_QK(j);
        }
        asm volatile("s_waitcnt lgkmcnt(0)\n\ts_barrier" ::: "memory");
        if (ATT_REL(d.jhi - 1)) ATT_SMPV(d.jhi - 1);
    }
#undef ATT_REL
#undef ATT_QK
#undef ATT_SMPV
#undef ATT_TOPWAIT
#undef ATT_ISSUE
    if (wvalid) {
        LAS bf16_t* stg = (LAS bf16_t*)(lds + A_OST) + wid * 2048;
        if (d_.lse != nullptr && r32 == 0) {
#pragma unroll
            for (int r = 0; r < 16; ++r) wsf[32 + crow(r, hi)] = lacc[r]; }
        if (d.o8) {
            LAS unsigned char* stg8 = (LAS unsigned char*)stg;
#pragma unroll
            for (int r = 0; r < 16; ++r) { const int orow = crow(r, hi); const float rl = __builtin_amdgcn_rcpf(lacc[r]) * 32.f;
                const unsigned p = (unsigned)__builtin_amdgcn_cvt_pk_fp8_f32(o[0][r] * rl, o[1][r] * rl, 0, false);
                stg8[orow * 64 + r32] = (unsigned char)(p & 0xffu); stg8[orow * 64 + 32 + r32] = (unsigned char)((p >> 8) & 0xffu); }
            LDS_WAIT();
#pragma unroll
            for (int i = 0; i < 2; ++i) { const int row = i * 16 + (lane >> 2), ch = lane & 3; const u32x4 v = *(const LAS u32x4*)(stg8 + row * 64 + ch * 16);
                *(u32x4*)((unsigned char*)d_.O + (size_t)(qw + row) * d.rstride * d.opitch + ch * 16) = v; }
        } else {
#pragma unroll
        for (int r = 0; r < 16; ++r) { const int orow = crow(r, hi); const float rl = __builtin_amdgcn_rcpf(lacc[r]);
            stg[orow * 64 + r32] = (bf16_t)f2bf(o[0][r] * rl); stg[orow * 64 + 32 + r32] = (bf16_t)f2bf(o[1][r] * rl); }
        LDS_WAIT();
#pragma unroll
        for (int i = 0; i < 4; ++i) { const int row = i * 8 + (lane >> 3), ch = lane & 7; const u32x4 v = *(const LAS u32x4*)(stg + row * 64 + ch * 8);
            *(u32x4*)(d_.O + (size_t)(qw + row) * d.rstride * d.opitch + ch * 8) = v; }
        }
        if (d_.lse != nullptr && hi == 0) d_.lse[(size_t)(qw + r32) * d.rstride * d.lsepitch] = mhat + __builtin_amdgcn_logf(wsf[32 + r32]);
    }
    asm volatile("s_waitcnt lgkmcnt(0)\n\ts_barrier" ::: "memory");
}
}

namespace idx {
constexpr int KS = 8192, I_K = 0, I_ST = 3 * KS, I_END = I_ST + 8 * 8192;
static_assert(I_END <= RING_BYTES, "indexer LDS");
__device__ __forceinline__ void score_unit(LAS unsigned char* lds, const bf16_t* PROJ, float* SC, int b, int qh  , int jg) {
    int tid_ = threadIdx.x; asm volatile("" : "+v"(tid_));
    const int tid = tid_, lane = tid & 63, r32 = lane & 31, hi = lane >> 5, wid = __builtin_amdgcn_readfirstlane(tid >> 6);
    const int qg = wid >> 1, hh = wid & 1;
    const unsigned lds0 = (unsigned)(size_t)lds;
    const int qrow = b * SEQ + qh * 128 + qg * 32 + r32;
    const bf16_t* kbase = PROJ + (size_t)(b * SEQ) * PW + 3968;
    const int kkey = 8 * wid + (lane >> 3);
    const bf16_t* ksrc = kbase + (size_t)kkey * PW + ((lane & 7) ^ ((kkey >> 1) & 7)) * 8;
    const int j0 = 4 * jg;
#define IDX_ISSUE(j) att::glds16(ksrc + (size_t)(j) * 64 * PW, (unsigned)__builtin_amdgcn_readfirstlane(lds0 + I_K + ((j) % 3) * KS + wid * 1024))
    IDX_ISSUE(j0); IDX_ISSUE(j0 + 1);
    bf16x8 qf[4][4]; float wv[4];
    { const bf16_t* qp = PROJ + (size_t)qrow * PW + 3328 + hh * 256 + hi * 8;
#pragma unroll
      for (int h = 0; h < 4; ++h)
#pragma unroll
          for (int d0 = 0; d0 < 4; ++d0) qf[h][d0] = *(const bf16x8*)(qp + h * 64 + d0 * 16);
      const u32x2 ww = *(const u32x2*)(PROJ + (size_t)qrow * PW + 4032 + hh * 4);
      wv[0] = bflo(ww.x); wv[1] = bfhi(ww.x); wv[2] = bflo(ww.y); wv[3] = bfhi(ww.y); }
#pragma unroll
    for (int h = 0; h < 4; ++h) { asm volatile("" : "+v"(wv[h]));
#pragma unroll
        for (int d0 = 0; d0 < 4; ++d0) asm volatile("" : "+v"(qf[h][d0])); }
    const int qb = qh >> 1;
    unsigned* blk = (unsigned*)SC + ((size_t)b * 36 + (size_t)(qb * (qb + 1) / 2)) * 32768; const int pitch = 128 * (qb + 1);
    f32x4 ve[4] = {};
    LAS unsigned char* stg = lds + I_ST + wid * 8192;
    const LAS unsigned char* stg2 = lds + I_ST + (wid ^ 1) * 8192;
#pragma nounroll
    for (int jj = 0; jj < 4; ++jj) { const int j = j0 + jj;
        if (jj < 2) { ATT_WAIT_BAR(1); } else if (jj == 2) { ATT_WAIT_BAR(5); } else { ATT_WAIT_BAR(4); }
        if (jj + 2 < 4) IDX_ISSUE(j + 2);
        const LAS unsigned char* kb = lds + I_K + (j % 3) * KS + r32 * 128;
#pragma nounroll
        for (int half = 0; half < 2; ++half) {
            bf16x8 kf[4];
#pragma unroll
            for (int d0 = 0; d0 < 4; ++d0) kf[d0] = *(const LAS bf16x8*)(kb + half * 4096 + (((2 * d0 + hi) ^ ((r32 >> 1) & 7)) * 16));
            f32x16 t0 = f32x16{};
#pragma unroll
            for (int h = 0; h < 4; ++h) {
                f32x16 p0 = f32x16{};
#pragma unroll
                for (int d0 = 0; d0 < 4; ++d0) p0 = __builtin_amdgcn_mfma_f32_32x32x16_bf16(kf[d0], qf[h][d0], p0, 0, 0, 0);
#pragma unroll
                for (int r = 0; r < 16; ++r) t0[r] += wv[h] * att::emax(p0[r], 0.f);
            }
#pragma unroll
            for (int g = 0; g < 4; ++g) { const int c0 = 8 * half + 2 * g + hi;
                *(LAS f32x4*)(stg + r32 * 256 + ((c0 ^ (r32 & 15)) * 16)) = (f32x4){t0[4 * g], t0[4 * g + 1], t0[4 * g + 2], t0[4 * g + 3]}; }
        }
        asm volatile("s_waitcnt lgkmcnt(0)\n\ts_barrier" ::: "memory");
#pragma unroll
        for (int i = 0; i < 4; ++i) { const int q = hh * 16 + i * 4 + (lane >> 4), c = lane & 15; const int so = q * 256 + ((c ^ (q & 15)) * 16);
            const f32x4 v = *(const LAS f32x4*)(stg + so) + *(const LAS f32x4*)(stg2 + so);
            if (jj & 1) { const f32x4 e = ve[i]; const u32x4 w = {pk2(e[0], v[0]), pk2(e[1], v[1]), pk2(e[2], v[2]), pk2(e[3], v[3])};
                *(u32x4*)(blk + (size_t)((qh & 1) * 128 + qg * 32 + q) * pitch + 64 * (j >> 1) + 4 * c) = w; }
            else ve[i] = v; }
        LDS_WAIT();
    }
#undef IDX_ISSUE
    asm volatile("s_waitcnt lgkmcnt(0)\n\ts_barrier" ::: "memory");
}

__device__ __forceinline__ int wave_sum_i(int v) {
    v += __builtin_amdgcn_update_dpp(0, v, 0xB1, 0xF, 0xF, true);
    v += __builtin_amdgcn_update_dpp(0, v, 0x4E, 0xF, 0xF, true);
    v += __builtin_amdgcn_update_dpp(0, v, 0x141, 0xF, 0xF, true);
    v += __builtin_amdgcn_update_dpp(0, v, 0x140, 0xF, 0xF, true);
    return __builtin_amdgcn_readlane(v, 0) + __builtin_amdgcn_readlane(v, 16) + __builtin_amdgcn_readlane(v, 32) + __builtin_amdgcn_readlane(v, 48);
}
__device__ __forceinline__ unsigned long long keep_low(unsigned long long m, int k) { while (__builtin_popcountll(m) > k) m &= ~(1ull << (63 - __builtin_clzll(m))); return m; }
__device__ __forceinline__ void select_rows4(const float* SC, unsigned* MASK, int row0  , int lane, LAS unsigned* slot  ) {
    const int b = row0 / SEQ, t0 = row0 % SEQ, qb = t0 >> 8;
    if (t0 < 256) {
#pragma unroll 1
        for (int i = 0; i < 4; ++i) { const int t = t0 + i, lo = 64 * lane;
            const unsigned long long w = (lo + 63 <= t) ? ~0ull : (lo > t ? 0ull : ((2ull << (t - lo)) - 1ull));
            if (lane < 32) ((unsigned long long*)(MASK + (size_t)(row0 + i) * 64))[lane] = w; }
        return;
    }
    const int pitch = 128 * (qb + 1), pmax = pitch - 1;
    const unsigned* srow0 = (const unsigned*)SC + ((size_t)b * 36 + (size_t)(qb * (qb + 1) / 2)) * 32768 + (size_t)(t0 - 256 * qb) * pitch;
    unsigned raw[16];
#pragma unroll
    for (int i = 0; i < 16; ++i) { const int s_ = 64 * i + lane; raw[i] = srow0[s_ < pmax ? s_ : pmax]; }
#pragma unroll 1
    for (int r = 0; r < 4; ++r) {
        const int t = t0 + r;
        unsigned P[16];
#pragma unroll
        for (int i = 0; i < 16; ++i) P[i] = raw[i];
        { const unsigned* nx = srow0 + (size_t)(r < 3 ? r + 1 : 3) * pitch;
#pragma unroll
          for (int i = 0; i < 16; ++i) { const int s_ = 64 * i + lane; raw[i] = nx[s_ < pmax ? s_ : pmax]; } }
#define SEL_TSTAGE(sh, m) _Pragma("unroll") for (int q = 0; q < 16; ++q) if (!(q & (sh))) { const unsigned a_ = P[q], b_ = P[q + (sh)]; \
            P[q] = (a_ & (m)) | ((b_ << (sh)) & ~(m)); P[q + (sh)] = ((a_ >> (sh)) & (m)) | (b_ & ~(m)); }
        SEL_TSTAGE(8, 0x00FF00FFu) SEL_TSTAGE(4, 0x0F0F0F0Fu) SEL_TSTAGE(2, 0x33333333u) SEL_TSTAGE(1, 0x55555555u)
#undef SEL_TSTAGE
        { const unsigned sg = P[15];
#pragma unroll
          for (int q = 0; q < 15; ++q) P[q] ^= sg;
          P[15] = ~sg; }
        const int nj = ((t - lane) >> 6) + 1;
        unsigned A = ((1u << ((nj + 1) >> 1)) - 1u) | (((1u << (nj >> 1)) - 1u) << 16), G = 0u;
        int cab = 0, cntA = t + 1;
#pragma unroll
        for (int bit = 15; bit >= 0; --bit) {
            if (cab + cntA != 256) {
                const unsigned ones = A & P[bit];
                const int c = wave_sum_i(__builtin_popcount(ones));
                if (cab + c >= 256) { A = ones; cntA = c; } else { G |= ones; cab += c; A &= ~ones; cntA -= c; }
            }
        }
        int need = 256 - cab;
        unsigned sel = G | A;
        if (cntA != need) {
            unsigned selA = 0u;
#pragma nounroll
            for (int j = 0; j < 32; ++j) { const int pb = (j >> 1) + 16 * (j & 1);
                unsigned long long m = __ballot((A >> pb) & 1u);
                if (__builtin_popcountll(m) > need) m = keep_low(m, need);
                need -= __builtin_popcountll(m);
                selA |= (unsigned)((m >> lane) & 1ull) << pb;
            }
            sel = G | selA;
        }
        int lo = 0, hi = 0;
#pragma unroll
        for (int j = 0; j < 32; ++j) { const unsigned long long m = __ballot((sel >> ((j >> 1) + 16 * (j & 1))) & 1u);
            lo = (lane == j) ? (int)(unsigned)m : lo; hi = (lane == j) ? (int)(unsigned)(m >> 32) : hi; }
        if (lane < 32) ((unsigned long long*)(MASK + (size_t)(row0 + r) * 64))[lane] = (unsigned long long)(unsigned)lo | ((unsigned long long)(unsigned)hi << 32);
    }
}
}

__device__ __forceinline__ unsigned* queue_word(Frame& F, int l, int chunk, int q) { return (unsigned*)(F.ws + WS_CTL) + CW_QUEUE + 64 * ((l * NCHUNK + chunk) * 4 + q); }

__device__ __forceinline__ void phase_proj(Frame& F, int l, int chunk) {
    PHASE_IDS(F);
    { LAS float* gb = (LAS float*)(F.lds + L_GB); const float* bg = F.in[7] + (size_t)l * 3072;
      __syncthreads();
      for (int i = F.tid; i < 3072; i += NTHREADS) gb[i] = bg[i];
      VM_WAIT(); LDS_WAIT(); __syncthreads(); }
    pg8::ProjSched8 S{{{(const bf16_t*)(F.ws + WS_XB8 + (size_t)chunk * TC * DM), (const bf16_t*)(F.ws + WS_WIN8), DM / 2, DM / 2, TC / 256, (PW + 3072) / 256, F.G, (int)blockIdx.x}, F8_SW, F8_SA_X}};
    const float* rp = (const float*)(F.ws + WS_ROPE);
    EpiProj E{(bf16_t*)(F.ws + WS_PROJ), rp, rp + 2048 * 8 * 2, (float*)(F.ws + WS_SSQ), (bf16_t*)(F.ws + WS_G3), (const LAS float*)(F.lds + L_GB)};
    pg8::gemm_phase<EpiProj, pg8::ProjSched8, true, true>(F.lds, DM / 2, S, E);
}
__device__ __forceinline__ void dilated_unit(Frame& F, int u) {
    const bf16_t* PROJ = (const bf16_t*)(F.ws + WS_PROJ); bf16_t* OG = (bf16_t*)(F.ws + WS_OG); float* LSE = (float*)(F.ws + WS_LSE);
    constexpr int N_G0 = NBC * 4 * 8, N_G1 = NBC * 4 * 4 * 2;
    int g, b, h, res, qb, dil, nq;
    if (u < N_G0) { g = 0; dil = 1; qb = 7 - u / (NBC * 4); const int bh = u % (NBC * 4); b = bh >> 2; h = bh & 3; res = 0; nq = 256; }
    else if (u < N_G0 + N_G1) { const int v = u - N_G0; g = 1; dil = 4; qb = 1 - v / (NBC * 16); const int x = v % (NBC * 16); b = x >> 4; h = (x >> 2) & 3; res = x & 3; nq = 256; }
    else { const int v = u - N_G0 - N_G1; g = 2; dil = 16; qb = 0; b = v >> 5; h = (v >> 3) & 3; res = (v & 7) * 2; nq = 128; }
    att::Desc d; const size_t r0 = (size_t)b * SEQ + res;
    const bf16_t* base = PROJ + r0 * PW + 512 + 768 * g + 64 * h;
    d.Q = base; d.K1 = base + 256; d.V = base + 512; d.K2 = nullptr; d.qpitch = d.k1pitch = d.vpitch = PW; d.k2pitch = 0;
    d.O = OG + ((size_t)g * TC + r0) * 256 + 64 * h; d.opitch = 256; d.lse = LSE + ((size_t)g * TC + r0) * 4 + h; d.lsepitch = 4; d.mask = nullptr;
    d.rstride = dil; d.q0 = qb * 256; d.nq = nq; d.o8 = 0;
    if (g == 2) { d.jlo = 0; d.jhi = 2; att::attn_unit<64, 0, true>(F.lds, d); }
    else { d.jlo = (qb * 4 - 2) > 0 ? (qb * 4 - 2) : 0; d.jhi = 4 * (qb + 1); att::attn_unit<64, 1>(F.lds, d); }
}

struct UpSched {
    static constexpr bool GATHER = false;
    const char* A; const char* B; size_t sB; int lda, ldb, nM, G, c;
    __device__ __forceinline__ bool next(int i, pg8::Unit& u) const { const int v = i * G + c; if (v >= nM * 7) return false; u.pm = v / 7; u.pn = v % 7; u.ord = i; return true; }
    __device__ __forceinline__ const char* a_base(const pg8::Unit& u) const { return A + ((size_t)u.pm * 256 * lda + (u.pn >= 3 ? 256 : 0)) * 2; }
    __device__ __forceinline__ const char* b_base(const pg8::Unit& u) const { return B + (u.pn >= 3 ? sB + (size_t)(u.pn - 3) * 256 * ldb * 2 : (size_t)u.pn * 256 * ldb * 2); }
    __device__ __forceinline__ void a_off(const pg8::Unit&, const int (&R)[2], const int (&C)[2], unsigned (&v)[2][2]) const {
#pragma unroll
        for (int i = 0; i < 2; ++i) { v[0][i] = (unsigned)(R[i] * lda + C[i]) * 2u; v[1][i] = (unsigned)((128 + R[i]) * lda + C[i]) * 2u; }
    }
};
struct EpiUp {
    EpiUpQ q; EpiUpKV kv;
    __device__ __forceinline__ void operator()(const f32x4 (&acc)[2][2][4][2], const pg8::Unit& u, int wr, int wc, int fr, int fq) const {
        if (u.pn < 3) q(acc, u, wr, wc, fr, fq);
        else { pg8::Unit u2 = u; u2.pn = u.pn - 3; kv(acc, u2, wr, wc, fr, fq); }
    }
};
__device__ __forceinline__ void phase_up_scores(Frame& F, int l, int chunk) {
    PHASE_IDS(F);
    const bf16_t* PROJ = (const bf16_t*)(F.ws + WS_PROJ);
    const float* rp = (const float*)(F.ws + WS_ROPE);
    {   UpSched S{(const char*)PROJ, (const char*)(F.ws + WS_WUQ), WS_WUKV - WS_WUQ, PW, 256, TC / 256, F.G, (int)blockIdx.x};
        EpiUp E{{(bf16_t*)(F.ws + WS_QM), rp + 2048 * 8 * 2, (const float*)(F.ws + WS_SSQ)}, {(bf16_t*)(F.ws + WS_KVM), (const float*)(F.ws + WS_SSQ)}};
        pg8::gemm_phase<EpiUp, UpSched, true>(F.lds, 256, S, E); }
    unsigned* qw = queue_word(F, l, chunk, 0); int pre = -1;
    for (;;) {
        const int u = dequeue(F, qw, pre);
        if (u < NBC * 64) { dilated_unit(F, u); continue; }
        if (u >= NBC * 64 + NBC * 72 + NBC * 32) break;
        if (u >= NBC * 64 + NBC * 72) { dilated_unit(F, u - NBC * 72); continue; }
        const int v = u - NBC * 64; const int b = v / 72; int r = v % 72, qh = 0; while (r > (qh >> 1)) { r -= (qh >> 1) + 1; ++qh; }
        idx::score_unit(F.lds, PROJ, (float*)(F.ws + WS_SC), b, qh, r);
    }
}
__device__ __forceinline__ void phase_attn1(Frame& F, int l, int chunk, int tmask = 7) {
    PHASE_IDS(F);
    const bf16_t* PROJ = (const bf16_t*)(F.ws + WS_PROJ); const bf16_t* QM = (const bf16_t*)(F.ws + WS_QM); const bf16_t* KVM = (const bf16_t*)(F.ws + WS_KVM);
    bf16_t* OA = (bf16_t*)(F.ws + WS_OA); bf16_t* OG = (bf16_t*)(F.ws + WS_OG); float* LSE = (float*)(F.ws + WS_LSE);
    constexpr int N_MLA = NBC * 8 * 8, N_SEL = TC / 32;
    unsigned* qw = queue_word(F, l, chunk, 1); int pre = -1;
    for (;;) {
        int u = dequeue(F, qw, pre);
        if (u < N_MLA) {
            if (!(tmask & 1)) continue;
            const int qb = 7 - u / (NBC * 8), bh = u % (NBC * 8), b = bh >> 3, h = bh & 7;
            att::Desc d; const size_t r0 = (size_t)b * SEQ;
            d.Q = QM + r0 * 768 + h * 96; d.qpitch = 768; d.K1 = KVM + r0 * 1024 + h * 128; d.k1pitch = 1024; d.K2 = PROJ + r0 * PW + 384; d.k2pitch = PW;
            d.V = KVM + r0 * 1024 + h * 128 + 64; d.vpitch = 1024; d.O = (bf16_t*)((unsigned char*)OA + r0 * 512 + h * 64); d.opitch = 512; d.o8 = 1; d.lse = nullptr; d.lsepitch = 0; d.mask = nullptr;
            d.rstride = 1; d.q0 = qb * 256; d.nq = 256; d.jlo = 0; d.jhi = 4 * (qb + 1);
            att::attn_unit<96, 0>(F.lds, d); continue; }
        u -= N_MLA;
        if (u >= N_SEL) break;
        if (!(tmask & 4)) continue;
        idx::select_rows4((const float*)(F.ws + WS_SC), (unsigned*)(F.ws + WS_MASK), u * 32 + F.wave * 4, F.lane, (LAS unsigned*)(F.lds + L_GB) + F.wave * 64);
    }
}
__device__ __forceinline__ void phase_attn2(Frame& F, int l, int chunk) {
    PHASE_IDS(F);
    const bf16_t* PROJ = (const bf16_t*)(F.ws + WS_PROJ);
    bf16_t* OC = (bf16_t*)(F.ws + WS_OC);
    unsigned* qw = queue_word(F, l, chunk, 2); int pre = -1;
    for (;;) {
        const int u = dequeue(F, qw, pre);
        if (u >= NBC * 64) break;
        const int qb = 7 - u / (NBC * 8), bh = u % (NBC * 8), b = bh >> 3, h = bh & 7;
        att::Desc d; const size_t r0 = (size_t)b * SEQ;
        d.Q = PROJ + r0 * PW + 2816 + 64 * h; d.K1 = PROJ + r0 * PW + 3840; d.V = PROJ + r0 * PW + 3904; d.K2 = nullptr; d.qpitch = d.k1pitch = d.vpitch = PW; d.k2pitch = 0;
        d.O = (bf16_t*)((unsigned char*)OC + r0 * 512 + 64 * h); d.opitch = 512; d.o8 = 1; d.lse = nullptr; d.lsepitch = 0; d.mask = (const unsigned*)(F.ws + WS_MASK) + r0 * 64;
        d.rstride = 1; d.q0 = qb * 256; d.nq = 256; d.jlo = 0; d.jhi = 4 * (qb + 1);
        att::attn_unit<64, 2>(F.lds, d);
    }
    const bf16_t* OG = (const bf16_t*)(F.ws + WS_OG); const float* LSE = (const float*)(F.ws + WS_LSE); bf16_t* OB = (bf16_t*)(F.ws + WS_OB);
    const int gw = F.vcu * NWAVES + F.wave, NGW = F.G * NWAVES, h = F.lane >> 4;
    for (int row = gw; row < TC; row += NGW) {
        const float l0 = LSE[(size_t)row * 4 + h], l1 = LSE[((size_t)TC + row) * 4 + h], l2 = LSE[((size_t)2 * TC + row) * 4 + h];
        const float mx = fmaxf(l0, fmaxf(l1, l2));
        float w0 = __builtin_amdgcn_exp2f(l0 - mx), w1 = __builtin_amdgcn_exp2f(l1 - mx), w2 = __builtin_amdgcn_exp2f(l2 - mx);
        const float inv = 1.0f / (w0 + w1 + w2); w0 *= inv; w1 *= inv; w2 *= inv;
        const u32x2 a = *(const u32x2*)(OG + (size_t)row * 256 + F.lane * 4), bq = *(const u32x2*)(OG + ((size_t)TC + row) * 256 + F.lane * 4), c = *(const u32x2*)(OG + ((size_t)2 * TC + row) * 256 + F.lane * 4);
        w0 *= 32.f; w1 *= 32.f; w2 *= 32.f;
        *(unsigned*)((unsigned char*)OB + (size_t)row * 512 + F.lane * 4) = pk4_fp8(w0 * bflo(a.x) + w1 * bflo(bq.x) + w2 * bflo(c.x), w0 * bfhi(a.x) + w1 * bfhi(bq.x) + w2 * bfhi(c.x),
                                                                                    w0 * bflo(a.y) + w1 * bflo(bq.y) + w2 * bflo(c.y), w0 * bfhi(a.y) + w1 * bfhi(bq.y) + w2 * bfhi(c.y));
    }
}
constexpr int CW_DEP = 32768;
__device__ __forceinline__ void phase_attn(Frame& F, int l, int chunk) {
    PHASE_IDS(F);
    const bf16_t* PROJ = (const bf16_t*)(F.ws + WS_PROJ); const bf16_t* QM = (const bf16_t*)(F.ws + WS_QM); const bf16_t* KVM = (const bf16_t*)(F.ws + WS_KVM);
    bf16_t* OA = (bf16_t*)(F.ws + WS_OA); bf16_t* OC = (bf16_t*)(F.ws + WS_OC);
    constexpr int N_SEL = TC / 32, NQ = NBC * 8;
    unsigned* dep = (unsigned*)(F.ws + WS_CTL) + CW_DEP + (l * NCHUNK + chunk) * (NBC * 8);
    unsigned* qw = queue_word(F, l, chunk, 1); int pre = -1;
    for (;;) {
        int u = dequeue(F, qw, pre);
        if (u < N_SEL) {
            idx::select_rows4((const float*)(F.ws + WS_SC), (unsigned*)(F.ws + WS_MASK), u * 32 + F.wave * 4, F.lane, (LAS unsigned*)(F.lds + L_GB) + F.wave * 64);
            VM_WAIT();
            __syncthreads();
            if (F.tid == 0) { const int row = u * 32, b = row / SEQ, qb = (row % SEQ) >> 8;
                __builtin_amdgcn_fence(__ATOMIC_RELEASE, "agent");
                __hip_atomic_fetch_add(dep + b * 8 + qb, 1u, __ATOMIC_RELAXED, __HIP_MEMORY_SCOPE_AGENT); }
            continue; }
        u -= N_SEL;
        if (u >= 16 * NQ) break;
        const int qb = 7 - u / (2 * NQ), w = u % (2 * NQ);
        if (w < NQ) {
            const int b = w >> 3, h = w & 7;
            att::Desc d; const size_t r0 = (size_t)b * SEQ;
            d.Q = QM + r0 * 768 + h * 96; d.qpitch = 768; d.K1 = KVM + r0 * 1024 + h * 128; d.k1pitch = 1024; d.K2 = PROJ + r0 * PW + 384; d.k2pitch = PW;
            d.V = KVM + r0 * 1024 + h * 128 + 64; d.vpitch = 1024; d.O = (bf16_t*)((unsigned char*)OA + r0 * 512 + h * 64); d.opitch = 512; d.o8 = 1; d.lse = nullptr; d.lsepitch = 0; d.mask = nullptr;
            d.rstride = 1; d.q0 = qb * 256; d.nq = 256; d.jlo = 0; d.jhi = 4 * (qb + 1);
            att::attn_unit<96, 0>(F.lds, d);
        } else {
            const int bh = w - NQ, b = bh >> 3, h = bh & 7;
            if (F.tid == 0) { while (__hip_atomic_load(dep + b * 8 + qb, __ATOMIC_RELAXED, __HIP_MEMORY_SCOPE_AGENT) < 8u) __builtin_amdgcn_s_sleep(4);
                __builtin_amdgcn_fence(__ATOMIC_ACQUIRE, "agent"); }
            __syncthreads();
            att::Desc d; const size_t r0 = (size_t)b * SEQ;
            d.Q = PROJ + r0 * PW + 2816 + 64 * h; d.K1 = PROJ + r0 * PW + 3840; d.V = PROJ + r0 * PW + 3904; d.K2 = nullptr; d.qpitch = d.k1pitch = d.vpitch = PW; d.k2pitch = 0;
            d.O = (bf16_t*)((unsigned char*)OC + r0 * 512 + 64 * h); d.opitch = 512; d.o8 = 1; d.lse = nullptr; d.lsepitch = 0; d.mask = (const unsigned*)(F.ws + WS_MASK) + r0 * 64;
            d.rstride = 1; d.q0 = qb * 256; d.nq = 256; d.jlo = 0; d.jhi = 4 * (qb + 1);
            att::attn_unit<64, 2>(F.lds, d);
        }
    }
    const bf16_t* OG = (const bf16_t*)(F.ws + WS_OG); const float* LSE = (const float*)(F.ws + WS_LSE); bf16_t* OB = (bf16_t*)(F.ws + WS_OB);
    const int gw = F.vcu * NWAVES + F.wave, NGW = F.G * NWAVES, h = F.lane >> 4;
    for (int row0 = gw; row0 < TC; row0 += 4 * NGW) {
        float l0[4], l1[4], l2[4]; u32x2 a[4], bq[4], c[4]; int rows[4];
#pragma unroll
        for (int i = 0; i < 4; ++i) { const int row = row0 + i * NGW < TC ? row0 + i * NGW : row0; rows[i] = row;
            l0[i] = LSE[(size_t)row * 4 + h]; l1[i] = LSE[((size_t)TC + row) * 4 + h]; l2[i] = LSE[((size_t)2 * TC + row) * 4 + h];
            a[i] = *(const u32x2*)(OG + (size_t)row * 256 + F.lane * 4); bq[i] = *(const u32x2*)(OG + ((size_t)TC + row) * 256 + F.lane * 4); c[i] = *(const u32x2*)(OG + ((size_t)2 * TC + row) * 256 + F.lane * 4); }
#pragma unroll
        for (int i = 0; i < 4; ++i) {
            const float mx = fmaxf(l0[i], fmaxf(l1[i], l2[i]));
            float w0 = __builtin_amdgcn_exp2f(l0[i] - mx), w1 = __builtin_amdgcn_exp2f(l1[i] - mx), w2 = __builtin_amdgcn_exp2f(l2[i] - mx);
            const float inv = 32.0f / (w0 + w1 + w2); w0 *= inv; w1 *= inv; w2 *= inv;
            *(unsigned*)((unsigned char*)OB + (size_t)rows[i] * 512 + F.lane * 4) = pk4_fp8(w0 * bflo(a[i].x) + w1 * bflo(bq[i].x) + w2 * bflo(c[i].x), w0 * bfhi(a[i].x) + w1 * bfhi(bq[i].x) + w2 * bfhi(c[i].x),
                                                                                          w0 * bflo(a[i].y) + w1 * bflo(bq[i].y) + w2 * bflo(c[i].y), w0 * bfhi(a[i].y) + w1 * bfhi(bq[i].y) + w2 * bfhi(c[i].y));
        }
    }
}
__device__ __forceinline__ void phase_branches(Frame& F, int l, int chunk) {
    PHASE_IDS(F);
    static_assert(WS_OB - WS_OA == WS_OC - WS_OB && WS_WB - WS_WA == WS_WC - WS_WB, "equally spaced branch operands");
    BranchSched S{(const char*)(F.ws + WS_OA), (const char*)(F.ws + WS_WA), WS_OB - WS_OA, WS_WB - WS_WA, 256, 256, (int)blockIdx.x, F8_SW, 127 - 5, F.G, (TC / 256) * 4};
    EpiBranchAll E{(bf16_t*)(F.ws + WS_MERGED), (bf16_t*)(F.ws + WS_M0), (bf16_t*)(F.ws + WS_M1), (const bf16_t*)(F.ws + WS_G3)};
    pg8::gemm_phase<EpiBranchAll, BranchSched, true, true>(F.lds, 256, S, E);
}
__device__ __forceinline__ void phase_wo(Frame& F, int l, int chunk) {
    PHASE_IDS(F);
    pg8::DenseSched8 S{{(const bf16_t*)(F.ws + WS_MERGED), (const bf16_t*)(F.ws + WS_WO), DM / 2, DM / 2, TC / 256, 4, F.G, (int)blockIdx.x}, F8_SW, 127 - 6};
    EpiWo E{F.out, l == 0 ? F.in[0] : F.out, chunk * TC};
    pg8::gemm_phase<EpiWo, pg8::DenseSched8, true, true>(F.lds, DM / 2, S, E);
}

__global__ void __launch_bounds__(NTHREADS, 2) fwd_kernel(Args args) {
    extern __shared__ __attribute__((aligned(16))) unsigned char lds_raw[];
    Frame F;
    F.lds = (LAS unsigned char*)lds_raw;
    F.tid = threadIdx.x; F.lane = F.tid & 63; F.wave = __builtin_amdgcn_readfirstlane(F.tid >> 6);
    F.G = gridDim.x; { const int bx = blockIdx.x; F.vcu = (F.G % 8 == 0) ? (bx % 8) * (F.G / 8) + bx / 8 : bx; }
    F.in.p = (intab_t)__builtin_amdgcn_kernarg_segment_ptr(); F.out = args.out; F.ws = args.ws; F.out0 = args.out; F.ws0 = args.ws;
    for (int u = F.tid; u < (LDS_BYTES - L_CTL) / 4; u += NTHREADS) ((LAS unsigned*)(F.lds + L_CTL))[u] = 0u;
    __syncthreads();
    XcdBarrier bar = xcd_barrier_post((unsigned*)(F.ws + WS_CTL) + CW_BAR, (volatile LAS unsigned*)(F.lds + L_BARW));
#define GRID_BAR() xcd_barrier(bar)

    for (int l = 0; l < 2; ++l) {
        phase_conv_moe(F, l);
        phase_conv_mixer(F, l);
        GRID_BAR();
        for (int chunk = 0; chunk < NCHUNK; ++chunk) {
            phase_proj(F, l, chunk);
            GRID_BAR();
            if (DUPMASK & 2) { phase_proj(F, l, chunk); GRID_BAR(); }
            phase_up_scores(F, l, chunk);
            GRID_BAR();
            if (DUPMASK & 4) { phase_up_scores(F, l + 2, chunk); GRID_BAR(); }
            phase_attn(F, l, chunk);
            GRID_BAR();
            phase_branches(F, l, chunk);
            GRID_BAR();
            if (DUPMASK & 32) { phase_branches(F, l, chunk); GRID_BAR(); }
            phase_wo(F, l, chunk);
            if ((DUPMASK & 0x800) && l == 0) { GRID_BAR(); phase_wo(F, l, chunk); }
        }
        GRID_BAR();
        phase_ln1_router(F, l, F.out, false);
        GRID_BAR();
        phase_moe_scatter(F);
        GRID_BAR();
        phase_moe_gemm1(F);
        GRID_BAR();
        if (DUPMASK & 64) { phase_moe_gemm1(F); GRID_BAR(); }
        phase_moe_gemm2(F);
        GRID_BAR();
        if (DUPMASK & 128) { phase_moe_gemm2(F); GRID_BAR(); }
        phase_combine_ln2(F, l);
    }
}

extern "C" void kernel_launch(void* const* d_in, const int* in_sizes, int n_in, void* d_out, int out_size, void* d_ws, size_t ws_size, hipStream_t stream) {
    static int grid = 0;
    if (grid == 0) {
        if (n_in != 23 || out_size != TT * DM || ws_size < WS_END) { fprintf(stderr, "kernel_launch: unexpected shapes n_in %d out %d ws %zu\n", n_in, out_size, ws_size); grid = -1; return; }
        int dev = 0, cus = 0;
        if (hipGetDevice(&dev) != hipSuccess || hipDeviceGetAttribute(&cus, hipDeviceAttributeMultiprocessorCount, dev) != hipSuccess) { grid = -1; return; }
        if (hipFuncSetAttribute((const void*)fwd_kernel, hipFuncAttributeMaxDynamicSharedMemorySize, LDS_BYTES) != hipSuccess) { fprintf(stderr, "kernel_launch: hipFuncSetAttribute failed\n"); grid = -1; return; }
        int per_cu = 0;
        if (hipOccupancyMaxActiveBlocksPerMultiprocessor(&per_cu, (const void*)fwd_kernel, NTHREADS, LDS_BYTES) != hipSuccess || per_cu < 1) fprintf(stderr, "kernel_launch: occupancy query says %d\n", per_cu);
        (void)hipGetLastError();
        grid = cus;
    }
    if (grid < 0) return;
    if (hipMemsetAsync((char*)d_ws + WS_CTL, 0, CTL_ZERO_BYTES, stream) != hipSuccess) return;
    Args a{};
    for (int i = 0; i < 23; ++i) a.in[i] = (const float*)d_in[i];
    a.out = (float*)d_out; a.ws = (unsigned char*)d_ws;
    hipLaunchKernelGGL(fwd_kernel, dim3(grid), dim3(NTHREADS), LDS_BYTES, stream, a);
}
```
